# Optimizing an MI355X kernel written in HIP

```python
import math
import jax
import jax.numpy as jnp
from jax import lax
import numpy as np

D_MODEL = 1024
BATCH = 8
SEQ = 2048
DEPTH = 4

GRID_W = 64
CTX_LEN = 256

A_HEADS = D_MODEL // 256
A_DH = 64
A_DV = 2 * A_DH
B_HEADS = D_MODEL // 128
B_DH = 64
NA_ROWS = 8
NA_COLS = 16
C_HEADS = 4
C_DK = D_MODEL // 2 // C_HEADS
C_DV = D_MODEL // C_HEADS
C_RANK = 16
C_TAU = 16.0
C_CHUNK = 64
N_EXPERTS = 16
N_GROUPS = 4
TOP_K = 2
D_EXPERT = D_MODEL // 2

ROPE_BASE = 10000.0
EPS = 1e-6
Q_BLOCK = 128

A_QK = A_HEADS * 2 * A_DH
A_V = A_HEADS * A_DV
B_W = B_HEADS * B_DH
ATT_IN = 2 * A_QK + A_V + 3 * B_W
ATT_OUT = A_V + B_W
GLA_QK = C_HEADS * C_DK
GLA_V = C_HEADS * C_DV
GLA_IN = 2 * GLA_QK + 2 * GLA_V + 2 * C_RANK
N_ATT = (DEPTH + 1) // 2
N_GLA = DEPTH // 2

kernel_name = 'hybrid_diffusion_trunk'


def rmsnorm(x, g):
    xf = x.astype(jnp.float32)
    y = xf * lax.rsqrt(jnp.mean(xf * xf, axis=-1, keepdims=True) + EPS)
    return (y * g.astype(jnp.float32)).astype(x.dtype)


def modulate(h, shift, scale):
    return h * (1.0 + scale) + shift


def heads(t, n_heads, d):
    b, n, _ = t.shape
    return t.reshape(b, n, n_heads, d).transpose(0, 2, 1, 3)


def rope_1d(x, pos):
    n = x.shape[-1]
    inv = ROPE_BASE ** (-jnp.arange(0, n, 2, dtype=jnp.float32) / n)
    ang = pos.astype(jnp.float32)[:, None] * inv[None, :]
    cos = jnp.cos(ang).astype(x.dtype)
    sin = jnp.sin(ang).astype(x.dtype)
    x1, x2 = jnp.split(x, 2, axis=-1)
    return jnp.concatenate([x1 * cos - x2 * sin, x1 * sin + x2 * cos], axis=-1)


def rope_2d(x, rows, cols):
    xr, xc = jnp.split(x, 2, axis=-1)
    return jnp.concatenate([rope_1d(xr, rows), rope_1d(xc, cols)], axis=-1)


def diff_core(q, k, v, lam):
    s = jnp.einsum('bhcqd,bhckd->bhcqk', q, k).astype(jnp.float32) * (q.shape[-1] ** -0.5)
    p = jax.nn.softmax(s, axis=-1)
    a = p[:, :, 0] - lam * p[:, :, 1]
    return jnp.einsum('bhqk,bhkv->bhqv', a.astype(v.dtype), v)


def softmax_attn(q, k, v):
    s = jnp.einsum('bhqd,bhkd->bhqk', q, k).astype(jnp.float32) * (q.shape[-1] ** -0.5)
    p = jax.nn.softmax(s, axis=-1)
    return jnp.einsum('bhqk,bhkd->bhqd', p.astype(v.dtype), v)


def neighbourhood_attn(q, k, v, kc, vc, bias_table):
    b, h, l, dh = q.shape
    rows = l // GRID_W
    wh = min(NA_ROWS, rows)
    qg = q.reshape(b, h, rows, GRID_W, dh)
    kg = k.reshape(b, h, rows, GRID_W, dh)
    vg = v.reshape(b, h, rows, GRID_W, dh)
    col = jnp.arange(GRID_W)
    col_start = jnp.clip(col - NA_COLS // 2, 0, GRID_W - NA_COLS)
    col_idx = col_start[:, None] + jnp.arange(NA_COLS)[None, :]
    dc = col_idx - col[:, None]
    scale = dh ** -0.5
    n_loc = wh * NA_COLS

    def row_block(r):
        r0 = jnp.clip(r - wh // 2, 0, rows - wh)
        q_r = lax.dynamic_index_in_dim(qg, r, axis=2, keepdims=False)
        k_r = lax.dynamic_slice_in_dim(kg, r0, wh, axis=2)
        v_r = lax.dynamic_slice_in_dim(vg, r0, wh, axis=2)
        k_w = k_r[:, :, :, col_idx]
        v_w = v_r[:, :, :, col_idx]
        dr = r0 + jnp.arange(wh) - r
        bias = bias_table[:, (dr + NA_ROWS - 1)[None, :, None], (dc + NA_COLS - 1)[:, None, :]]
        s_loc = jnp.einsum('bhqd,bhrqcd->bhqrc', q_r, k_w).astype(jnp.float32) * scale + bias[None].astype(jnp.float32)
        s_ctx = jnp.einsum('bhqd,bhkd->bhqk', q_r, kc).astype(jnp.float32) * scale
        s = jnp.concatenate([s_loc.reshape(b, h, GRID_W, n_loc), s_ctx], axis=-1)
        p = jax.nn.softmax(s, axis=-1).astype(v.dtype)
        p_loc = p[..., :n_loc].reshape(b, h, GRID_W, wh, NA_COLS)
        return (jnp.einsum('bhqrc,bhrqcd->bhqd', p_loc, v_w)
                + jnp.einsum('bhqk,bhkd->bhqd', p[..., n_loc:], vc))

    o = lax.map(row_block, jnp.arange(rows))
    return o.transpose(1, 2, 0, 3, 4).reshape(b, h, l, dh)


def attn_layer(hx, hc, w_in, w_out, lam_p, lam_init, subln_g, na_bias, need_ctx):
    b, l, _ = hx.shape
    pos = jnp.arange(l)
    rows_pos, cols_pos = pos // GRID_W, pos % GRID_W
    cuts = [A_QK, 2 * A_QK, 2 * A_QK + A_V, 2 * A_QK + A_V + B_W, 2 * A_QK + A_V + 2 * B_W]

    def project(h):
        n = h.shape[1]
        qa, ka, va, qb, kb, vb = jnp.split(h @ w_in, cuts, axis=-1)
        qa = qa.reshape(b, n, A_HEADS, 2, A_DH).transpose(0, 2, 3, 1, 4)
        ka = ka.reshape(b, n, A_HEADS, 2, A_DH).transpose(0, 2, 3, 1, 4)
        return (qa, ka, heads(va, A_HEADS, A_DV), heads(qb, B_HEADS, B_DH),
                heads(kb, B_HEADS, B_DH), heads(vb, B_HEADS, B_DH))

    qa_x, ka_x, va_x, qb_x, kb_x, vb_x = project(hx)
    qa_c, ka_c, va_c, qb_c, kb_c, vb_c = project(hc)
    lp = lam_p.astype(jnp.float32)
    lam = jnp.exp(jnp.sum(lp[0] * lp[1])) - jnp.exp(jnp.sum(lp[2] * lp[3])) + lam_init

    qa_x = rope_2d(qa_x, rows_pos, cols_pos)
    ka_x = rope_2d(ka_x, rows_pos, cols_pos)
    k_all = jnp.concatenate([ka_x, ka_c], axis=3)
    v_all = jnp.concatenate([va_x, va_c], axis=2)
    nb = l // Q_BLOCK
    q_blocks = qa_x.reshape(b, A_HEADS, 2, nb, Q_BLOCK, A_DH).transpose(3, 0, 1, 2, 4, 5)
    oa_x = lax.map(lambda qq: diff_core(qq, k_all, v_all, lam), q_blocks)
    oa_x = oa_x.transpose(1, 2, 0, 3, 4).reshape(b, A_HEADS, l, A_DV)
    ob_x = neighbourhood_attn(qb_x, kb_x, vb_x, kb_c, vb_c, na_bias)

    def merge(oa, ob):
        n = oa.shape[2]
        oa = rmsnorm(oa, subln_g) * (1.0 - lam_init)
        oa = oa.transpose(0, 2, 1, 3).reshape(b, n, A_V)
        ob = ob.transpose(0, 2, 1, 3).reshape(b, n, B_W)
        return jnp.concatenate([oa, ob], axis=-1) @ w_out

    out_x = merge(oa_x, ob_x)
    if not need_ctx:
        return out_x, None
    out_c = merge(diff_core(qa_c, ka_c, va_c, lam), softmax_attn(qb_c, kb_c, vb_c))
    return out_x, out_c


def gla_chunked(q, k, v, g, s0):
    b, h, l, dk = q.shape
    dv = v.shape[-1]
    nc = l // C_CHUNK
    f32 = jnp.float32
    qc = q.astype(f32).reshape(b, h, nc, C_CHUNK, dk)
    kc = k.astype(f32).reshape(b, h, nc, C_CHUNK, dk)
    vc = v.astype(f32).reshape(b, h, nc, C_CHUNK, dv)
    gc = jnp.cumsum(g.astype(f32).reshape(b, h, nc, C_CHUNK, dk), axis=3)
    g_end = gc[:, :, :, -1:]
    g_mid = gc[:, :, :, C_CHUNK // 2 - 1:C_CHUNK // 2]
    k_to_end = kc * jnp.exp(g_end - gc)
    chunk_decay = jnp.exp(g_end[:, :, :, 0])

    def step(s, inp):
        k_e, v_c, dec = inp
        return s * dec[..., None] + jnp.einsum('bhcd,bhcv->bhdv', k_e, v_c), s

    xs = (jnp.moveaxis(k_to_end, 2, 0), jnp.moveaxis(vc, 2, 0), jnp.moveaxis(chunk_decay, 2, 0))
    s_final, s_start = lax.scan(step, s0.astype(f32), xs)
    o_inter = jnp.einsum('bhncd,nbhdv->bhncv', qc * jnp.exp(gc), s_start)
    a = jnp.einsum('bhncd,bhnsd->bhncs', qc * jnp.exp(gc - g_mid), kc * jnp.exp(g_mid - gc))
    upto_t = jnp.tril(jnp.ones((C_CHUNK, C_CHUNK), dtype=bool))
    a = jnp.where(upto_t, a, 0.0)
    o = o_inter + jnp.einsum('bhncs,bhnsv->bhncv', a, vc)
    return o.reshape(b, h, l, dv).astype(v.dtype), s_final


def gla_final_state(k, v, g):
    gc = jnp.cumsum(g.astype(jnp.float32), axis=2)
    k_to_end = k.astype(jnp.float32) * jnp.exp(gc[:, :, -1:] - gc)
    return jnp.einsum('bhld,bhlv->bhdv', k_to_end, v.astype(jnp.float32))


def gla_layer(hx, hc, w_in, w_gate, b_gate, norm_g, w_out, need_ctx):
    b = hx.shape[0]
    cuts = [GLA_QK, 2 * GLA_QK, 2 * GLA_QK + GLA_V, 2 * GLA_QK + 2 * GLA_V, 2 * GLA_QK + 2 * GLA_V + C_RANK]

    def project(h):
        q, k, v, gate, lf, lb = jnp.split(h @ w_in, cuts, axis=-1)

        def log_decay(lr, d):
            z = (lr @ w_gate[d] + b_gate[d]).astype(jnp.float32)
            return heads(jax.nn.log_sigmoid(z) / C_TAU, C_HEADS, C_DK)

        return (heads(q, C_HEADS, C_DK) * (C_DK ** -0.5), heads(k, C_HEADS, C_DK),
                heads(v, C_HEADS, C_DV), gate, log_decay(lf, 0), log_decay(lb, 1))

    qx, kx, vx, gate_x, gfx, gbx = project(hx)
    qc, kc, vc, gate_c, gfc, gbc = project(hc)
    flip = lambda t: jnp.flip(t, axis=2)
    zero = jnp.zeros((b, C_HEADS, C_DK, C_DV), jnp.float32)
    if need_ctx:
        oc_f, sc_f = gla_chunked(qc, kc, vc, gfc, zero)
        oc_b, sc_b = gla_chunked(flip(qc), flip(kc), flip(vc), flip(gbc), zero)
    else:
        sc_f = gla_final_state(kc, vc, gfc)
        sc_b = gla_final_state(flip(kc), flip(vc), flip(gbc))
    ox_f, _ = gla_chunked(qx, kx, vx, gfx, sc_f)
    ox_b, _ = gla_chunked(flip(qx), flip(kx), flip(vx), flip(gbx), sc_b)

    def readout(o, gate):
        n = o.shape[2]
        o = rmsnorm(o, norm_g).transpose(0, 2, 1, 3).reshape(b, n, GLA_V)
        return (o * jax.nn.silu(gate)) @ w_out

    out_x = readout(ox_f + flip(ox_b), gate_x)
    if not need_ctx:
        return out_x, None
    return out_x, readout(oc_f + flip(oc_b), gate_c)


def moe(h, router_w, router_bias, w1, w3, w2):
    t = h.shape[0]
    per_group = N_EXPERTS // N_GROUPS
    scores = jax.nn.sigmoid((h @ router_w).astype(jnp.float32))
    sel = scores + router_bias.astype(jnp.float32)
    grp_score = lax.top_k(sel.reshape(t, N_GROUPS, per_group), 2)[0].sum(-1)
    grp = jnp.argmax(grp_score, axis=-1)
    in_grp = (jnp.arange(N_EXPERTS) // per_group)[None, :] == grp[:, None]
    _, idx = lax.top_k(jnp.where(in_grp, sel, -jnp.inf), TOP_K)
    w_sel = jnp.take_along_axis(scores, idx, axis=-1)
    w_sel = w_sel / jnp.sum(w_sel, axis=-1, keepdims=True)
    gates = jnp.sum(jax.nn.one_hot(idx, N_EXPERTS, dtype=jnp.float32) * w_sel[..., None], axis=1)
    y = jnp.zeros_like(h)
    for e in range(N_EXPERTS):
        he = jax.nn.silu(h @ w1[e]) * (h @ w3[e])
        y = y + gates[:, e:e + 1].astype(h.dtype) * (he @ w2[e])
    return y


def setup_inputs(seed: int = 0) -> dict:
    key = jax.random.key(seed)
    ks = jax.random.split(key, 24)
    nrm = lambda k, shape, s: jax.random.normal(k, shape, jnp.float32) * s
    d = D_MODEL
    return {
        'x': nrm(ks[0], (BATCH, SEQ, d), 1.0),
        'c': nrm(ks[1], (BATCH, d), 1.0),
        'ctx': nrm(ks[2], (BATCH, CTX_LEN, d), 1.0),
        'c_ctx': nrm(ks[3], (d,), 1.0),
        'w_mod': nrm(ks[4], (DEPTH, d, 6 * d), 0.5 * d ** -0.5),
        'b_mod': nrm(ks[5], (DEPTH, 6 * d), 0.02),
        'norm_g': 1.0 + nrm(ks[6], (DEPTH, 2, d), 0.02),
        'final_g': 1.0 + nrm(ks[7], (d,), 0.02),
        'att_w_in': nrm(ks[8], (N_ATT, d, ATT_IN), d ** -0.5),
        'att_w_out': nrm(ks[9], (N_ATT, ATT_OUT, d), ATT_OUT ** -0.5),
        'att_lambda': nrm(ks[10], (N_ATT, 4, A_DH), 0.1),
        'att_subln_g': 1.0 + nrm(ks[11], (N_ATT, A_DV), 0.02),
        'na_bias': nrm(ks[12], (N_ATT, B_HEADS, 2 * NA_ROWS - 1, 2 * NA_COLS - 1), 0.1),
        'gla_w_in': nrm(ks[13], (N_GLA, d, GLA_IN), d ** -0.5),
        'gla_w_gate': nrm(ks[14], (N_GLA, 2, C_RANK, GLA_QK), C_RANK ** -0.5),
        'gla_b_gate': nrm(ks[15], (N_GLA, 2, GLA_QK), 0.1),
        'gla_norm_g': 1.0 + nrm(ks[16], (N_GLA, C_DV), 0.02),
        'gla_w_out': nrm(ks[17], (N_GLA, GLA_V, d), GLA_V ** -0.5),
        'router_w': nrm(ks[18], (d, N_EXPERTS), d ** -0.5),
        'router_bias': nrm(ks[19], (N_EXPERTS,), 0.01),
        'moe_w1': nrm(ks[20], (DEPTH, N_EXPERTS, d, D_EXPERT), d ** -0.5),
        'moe_w3': nrm(ks[21], (DEPTH, N_EXPERTS, d, D_EXPERT), d ** -0.5),
        'moe_w2': nrm(ks[22], (DEPTH, N_EXPERTS, D_EXPERT, d), D_EXPERT ** -0.5),
    }


def reference(x, c, ctx, c_ctx, w_mod, b_mod, norm_g, final_g, att_w_in, att_w_out, att_lambda,
              att_subln_g, na_bias, gla_w_in, gla_w_gate, gla_b_gate, gla_norm_g, gla_w_out,
              router_w, router_bias, moe_w1, moe_w3, moe_w2):
    b, l, d = x.shape
    n_ctx = ctx.shape[1]
    for i in range(DEPTH):
        last = i == DEPTH - 1
        j = i // 2
        mx = jax.nn.silu(c) @ w_mod[i] + b_mod[i]
        mc = jax.nn.silu(c_ctx) @ w_mod[i] + b_mod[i]
        sh1x, sc1x, g1x, sh2x, sc2x, g2x = jnp.split(mx[:, None, :], 6, axis=-1)
        sh1c, sc1c, g1c, sh2c, sc2c, g2c = jnp.split(mc[None, None, :], 6, axis=-1)
        hx = modulate(rmsnorm(x, norm_g[i, 0]), sh1x, sc1x)
        hc = modulate(rmsnorm(ctx, norm_g[i, 0]), sh1c, sc1c)
        if i % 2 == 0:
            lam_init = 0.8 - 0.6 * math.exp(-0.3 * i)
            ox, oc = attn_layer(hx, hc, att_w_in[j], att_w_out[j], att_lambda[j], lam_init,
                                att_subln_g[j], na_bias[j], not last)
        else:
            ox, oc = gla_layer(hx, hc, gla_w_in[j], gla_w_gate[j], gla_b_gate[j], gla_norm_g[j],
                               gla_w_out[j], not last)
        x = x + g1x * ox
        hx2 = modulate(rmsnorm(x, norm_g[i, 1]), sh2x, sc2x)
        if last:
            x = x + g2x * moe(hx2.reshape(-1, d), router_w, router_bias, moe_w1[i], moe_w3[i],
                              moe_w2[i]).reshape(b, l, d)
        else:
            ctx = ctx + g1c * oc
            hc2 = modulate(rmsnorm(ctx, norm_g[i, 1]), sh2c, sc2c)
            y = moe(jnp.concatenate([hc2, hx2], axis=1).reshape(-1, d), router_w, router_bias,
                    moe_w1[i], moe_w3[i], moe_w2[i]).reshape(b, n_ctx + l, d)
            ctx = ctx + g2c * y[:, :n_ctx]
            x = x + g2x * y[:, n_ctx:]
    return rmsnorm(x, final_g)
```

```cpp
#include <hip/hip_runtime.h>
#include <cstdio>
#include <cstdint>

#ifndef MK_MULTI
#define MK_MULTI 1
#endif

#define GAS __attribute__((address_space(1)))
#define LAS __attribute__((address_space(3)))
typedef unsigned short bf16;
typedef short bf16x8 __attribute__((ext_vector_type(8)));
typedef short bf16x4 __attribute__((ext_vector_type(4)));
typedef float f32x4 __attribute__((ext_vector_type(4)));
typedef float f32x2 __attribute__((ext_vector_type(2)));
typedef unsigned u32x4 __attribute__((ext_vector_type(4)));
typedef unsigned u32x2 __attribute__((ext_vector_type(2)));

constexpr int D = 1024, NB = 8, SEQ = 2048, CTXL = 256;
constexpr int TX = NB * SEQ, TC = NB * CTXL, TALL = TX + TC;
constexpr int NKEY = SEQ + CTXL;
constexpr int NATT = 3072, NGLA = 3328;
constexpr float EPSF = 1e-6f;
constexpr float LOG2E = 1.4426950408889634f;
constexpr int NEXP = 16, DEXP = 512;
constexpr int RT_MAX = 160;

constexpr size_t MiB = 1u << 20;
constexpr size_t WS_CTL = 0, CTL_ZERO_BYTES = 1 * MiB;
constexpr size_t WS_MODV = 1 * MiB;
constexpr size_t WS_TOKI = 2 * MiB;
constexpr size_t WS_TOKW = 2 * MiB + 512 * 1024;
constexpr size_t WS_LIST = 3 * MiB;
constexpr size_t WS_CTX = 5 * MiB;
constexpr size_t WS_WATTIN = 13 * MiB;
constexpr size_t WS_WATTOUT = 25 * MiB;
constexpr size_t WS_WGLAIN = 29 * MiB;
constexpr size_t WS_WGLAOUT = 42 * MiB;
constexpr size_t WS_W13 = 46 * MiB;
constexpr size_t WS_W2 = 174 * MiB;
constexpr size_t WS_H = 238 * MiB;
constexpr size_t WS_AOUT = 274 * MiB;
constexpr size_t WS_BIG = 310 * MiB;
constexpr size_t WS_END = 535 * MiB;
constexpr size_t BG_QKV = 0;
constexpr size_t BG_VAT = 108 * MiB;
constexpr size_t BG_VBT = 126 * MiB;
constexpr size_t BG_QKV2 = 0;
constexpr size_t BG_VGT = 117 * MiB;
constexpr size_t BG_OF = 153 * MiB;
constexpr size_t BG_OB = 189 * MiB;
constexpr size_t BG_HB = 0;
constexpr size_t BG_YB = 40 * MiB;
constexpr int CW_TMO = 0;
constexpr int CW_BAR = 4096;
constexpr int CW_CNT = 8192;

constexpr int RING_BYTES = 131072;
constexpr int LX_OFF = RING_BYTES;
constexpr int LX_MISC = LX_OFF;
constexpr int LX_MOETAB = LX_OFF + 256;
constexpr int LX_ROPE = LX_OFF + 2048;
constexpr int LX_BIAS = LX_OFF + 2048 + 8192;
constexpr int LDS_BYTES = 147456;

#define LDS_WAIT() asm volatile("s_waitcnt lgkmcnt(0)" ::: "memory")
#define VM_WAIT() asm volatile("s_waitcnt vmcnt(0)" ::: "memory")
#define RLX_AGENT __ATOMIC_RELAXED, __HIP_MEMORY_SCOPE_AGENT
__device__ __forceinline__ unsigned f2bf(float f) { unsigned u = __builtin_bit_cast(unsigned, f); return (u + 0x7fffu + ((u >> 16) & 1u)) >> 16; }
__device__ __forceinline__ unsigned pk2(float lo, float hi) { return f2bf(lo) | (f2bf(hi) << 16); }
__device__ __forceinline__ float bf2f(unsigned short b) { return __builtin_bit_cast(float, ((unsigned)b) << 16); }
__device__ __forceinline__ float bflo(unsigned w) { return __builtin_bit_cast(float, w << 16); }
__device__ __forceinline__ float bfhi(unsigned w) { return __builtin_bit_cast(float, w & 0xffff0000u); }
__device__ __forceinline__ float wave_sum(float v) {
#pragma unroll
    for (int o = 1; o < 64; o <<= 1) v += __shfl_xor(v, o);
    return v;
}
__device__ __forceinline__ float fexp2(float x) { return __builtin_amdgcn_exp2f(x); }
__device__ __forceinline__ float fexp(float x) { return __builtin_amdgcn_exp2f(x * LOG2E); }
__device__ __forceinline__ float flog(float x) { return __builtin_amdgcn_logf(x) * 0.6931471805599453f; }
__device__ __forceinline__ float frcp(float x) { return __builtin_amdgcn_rcpf(x); }
__device__ __forceinline__ float silu_f(float x) { return x * frcp(1.0f + fexp(-x)); }

#define XB_TMO      128
#define XB_XCNT(j)  (256  + 64 * (j))
#define XB_XSUB(j)  (1280 + 64 * (j))
#define XB_XGEN(j)  (2304 + 64 * (j))
#define XB_TOP      3328
#define XB_TOPGEN   3392
#define XCD_BAR_WORDS 3456
#define XB_SPIN_CAP (1u << 18)
__device__ __forceinline__ unsigned xb_ld(unsigned* p)              { return __hip_atomic_load(p, __ATOMIC_RELAXED, __HIP_MEMORY_SCOPE_AGENT); }
__device__ __forceinline__ unsigned xb_add(unsigned* p, unsigned v) { return __hip_atomic_fetch_add(p, v, __ATOMIC_RELAXED, __HIP_MEMORY_SCOPE_AGENT); }
__device__ __forceinline__ unsigned xb_xcc_id() { return (unsigned)__builtin_amdgcn_s_getreg((3 << 11) | 20) & 0xFu; }
#define XB_SPIN(cond, bar) do { unsigned _sp = 0; while (cond) { __builtin_amdgcn_s_sleep(1); \
    if ((++_sp & 255u) == 0u) { if (xb_ld(&(bar)[XB_TMO])) break; if (_sp > XB_SPIN_CAP) { atomicAdd(&(bar)[XB_TMO], 1u); break; } } } } while (0)
struct XcdBarrier { unsigned* bar; unsigned x; volatile LAS unsigned* st; };
__device__ __forceinline__ XcdBarrier xcd_barrier_post(unsigned* bar, volatile LAS unsigned* st) {
    XcdBarrier b; b.bar = bar; b.x = xb_xcc_id(); b.st = st;
    if (threadIdx.x == 0) (void)xb_add(&bar[XB_XCNT(b.x)], 1u);
    return b;
}
__device__ __forceinline__ void xcd_barrier_complete(unsigned* bar, unsigned x, unsigned& nloc, unsigned& nx) {
    const unsigned G = gridDim.x * gridDim.y * gridDim.z;
    unsigned sum, cnt, mine, sp = 0u;
    for (;;) {
        sum = 0u; cnt = 0u; mine = 0u;
#pragma unroll
        for (unsigned j = 0; j < 16; ++j) { const unsigned c = xb_ld(&bar[XB_XCNT(j)]); sum += c; cnt += (c > 0u) ? 1u : 0u; mine = (j == x) ? c : mine; }
        if (sum == G) break;
        __builtin_amdgcn_s_sleep(1);
        if ((++sp & 255u) == 0u) { if (xb_ld(&bar[XB_TMO])) break; if (sp > XB_SPIN_CAP) { atomicAdd(&bar[XB_TMO], 1u); break; } }
    }
    nloc = mine > 0u ? mine : 1u; nx = cnt > 0u ? cnt : 1u;
}
__device__ __forceinline__ void xcd_barrier(const XcdBarrier& b) {
    asm volatile("s_waitcnt vmcnt(0)" ::: "memory");
    __syncthreads();
    if (threadIdx.x == 0) {
        unsigned* bar = b.bar;
        __builtin_amdgcn_s_waitcnt(0);
        unsigned nloc = b.st[0], nx = b.st[1];
        if (nloc == 0u) { xcd_barrier_complete(bar, b.x, nloc, nx); b.st[0] = nloc; b.st[1] = nx; }
        const unsigned old = xb_add(&bar[XB_XSUB(b.x)], 1u);
        const unsigned gen = old / nloc;
        if (old + 1u == (gen + 1u) * nloc) {
            __builtin_amdgcn_fence(__ATOMIC_RELEASE, "agent");
            asm volatile("s_waitcnt vmcnt(0)" ::: "memory");
            const unsigned og = xb_add(&bar[XB_TOP], 1u);
            const unsigned tg = og / nx;
            if (og + 1u == (tg + 1u) * nx) xb_add(&bar[XB_TOPGEN], 1u);
            else XB_SPIN(xb_ld(&bar[XB_TOPGEN]) == tg, bar);
            __builtin_amdgcn_fence(__ATOMIC_ACQUIRE, "agent");
            xb_add(&bar[XB_XGEN(b.x)], 1u);
            asm volatile("s_waitcnt vmcnt(0)" ::: "memory");
        } else {
            XB_SPIN(xb_ld(&bar[XB_XGEN(b.x)]) == gen, bar);
            __builtin_amdgcn_fence(__ATOMIC_ACQUIRE, "agent");
            asm volatile("s_waitcnt vmcnt(0)" ::: "memory");
        }
    }
    __syncthreads();
}

namespace pg8 {
constexpr int BM = 256, BK = 64, HALF = 128, HTB = HALF * BK * 2, STAGE_BYTES = 8 * HTB, NXCD = 8, WGM = 8;
__host__ __device__ __forceinline__ int lds_byte(int r, int c) { const int st = (r >> 4) * 2 + (c >> 5), rr = r & 15, cc = c & 31, ob = rr * 64 + cc * 2; return st * 1024 + (ob ^ (((ob >> 9) & 1) << 5)); }
__host__ __device__ __forceinline__ void stage_rc(int b, int& R, int& C) { const int st = b / 1024, sb = b % 1024, swz = sb ^ (((sb >> 9) & 1) << 5); R = (st >> 1) * 16 + swz / 64; C = (st & 1) * 32 + (swz % 64) / 2; }
__host__ __device__ __forceinline__ int perm32(int rho) { const int n = rho >> 4, i = rho & 15; return 8 * (i >> 2) + 4 * n + (i & 3); }

struct Unit { int pm, pn, e, mt; };

__device__ __forceinline__ int xcd_remap(int wgid, int nwg) { const int q = nwg / NXCD, r = nwg % NXCD, xcd = wgid % NXCD, off = wgid / NXCD; return (xcd < r ? xcd * (q + 1) : r * (q + 1) + (xcd - r) * q) + off; }

struct DenseOrder {
    const char* A; const char* B; int K; int nM, nN, nwg, G, c;
    __device__ __forceinline__ void init(const bf16* A_, const bf16* B_, int M, int N, int K_, int G_, int c_) { A = (const char*)A_; B = (const char*)B_; K = K_; nM = M / BM; nN = N / BM; nwg = nM * nN; G = G_; c = c_; }
    __device__ __forceinline__ bool next(int i, Unit& u) const {
        const long L = (long)i * G + c; if (L >= nwg) return false;
        const int wgid = xcd_remap((int)L, nwg);
        const int nig = WGM * nN, gid = wgid / nig, fm = gid * WGM, gsz = (nM - fm) < WGM ? (nM - fm) : WGM;
        u.pm = fm + ((wgid % nig) % gsz); u.pn = (wgid % nig) / gsz; u.e = 0; u.mt = 0; return true;
    }
    __device__ __forceinline__ const char* a_ptr(const Unit& u) const { return A + (size_t)u.pm * BM * K * 2; }
    __device__ __forceinline__ const char* b_ptr(const Unit& u) const { return B + (size_t)u.pn * BM * K * 2; }
    __device__ __forceinline__ int tok(const Unit&, int) const { return 0; }
};
struct MoeOrder {
    const char* A; const char* B; int K; size_t bstride;
    const LAS int* tab; const int* list; int RT, nwg, G, c;
    __device__ __forceinline__ bool next(int i, Unit& u) const {
        const long L = (long)i * G + c; if (L >= nwg) return false;
        const int wgid = xcd_remap((int)L, nwg);
        const int rt = wgid >> 2; u.pm = rt; u.pn = wgid & 3; const int t = tab[rt]; u.e = t & 255; u.mt = t >> 8; return true;
    }
    __device__ __forceinline__ const char* a_ptr(const Unit& u) const { return A + (size_t)u.pm * BM * K * 2; }
    __device__ __forceinline__ const char* b_ptr(const Unit& u) const { return B + (size_t)u.e * bstride + (size_t)u.pn * BM * K * 2; }
    __device__ __forceinline__ int tok(const Unit& u, int r) const { const int cnt = tab[RT_MAX + 1 + u.e]; const int pos = u.mt * BM + r; return pos < cnt ? list[(size_t)u.e * TALL + pos] : 0; }
};

__device__ __forceinline__ unsigned cvt_pk_bf16(float lo, float hi) { unsigned r; asm volatile("v_cvt_pk_bf16_f32 %0, %1, %2" : "=v"(r) : "v"(lo), "v"(hi)); return r; }

template <class Epi, class Sched, bool GATHER>
__device__ __forceinline__ void gemm_phase(LAS unsigned char* lds, const int tid, const int K, const Sched& S, const Epi& E) {
    const int wid = __builtin_amdgcn_readfirstlane(tid >> 6), lane = tid & 63, wr = wid >> 2, wc = wid & 3, fr = lane & 15, fq = lane >> 4;
    const int nt = K / BK;
    unsigned voffA[2], voffB[2]; int RA[2], CA[2];
#pragma unroll
    for (int i = 0; i < 2; ++i) { int R, C; stage_rc(tid * 16 + i * 8192, R, C); const int Rb = Epi::PERM ? ((R & ~31) + perm32(R & 31)) : R;
        RA[i] = R; CA[i] = C; voffA[i] = (unsigned)(R * K + C) * 2u; voffB[i] = (unsigned)(Rb * K + C) * 2u; }
    const size_t kstep = (size_t)(BK * 2);
    const size_t hstep = (size_t)HALF * K * 2;
    const unsigned ldsw = (unsigned)wid * 1024u;
    const int aoff = lds_byte(wr * 64 + fr, fq * 8), boff = lds_byte(wc * 32 + fr, fq * 8);
#define PG8_SA(b, h) (((b) * 2 + (h)) * HTB)
#define PG8_SB(b, h) ((4 + (b) * 2 + (h)) * HTB)
#define PG8_STAGE(bufoff, gbase, voff) do { _Pragma("unroll") for (int _i = 0; _i < 2; ++_i) \
        __builtin_amdgcn_global_load_lds((const unsigned*)((const char*)(gbase) + (voff)[_i]), (LAS unsigned*)(lds + (bufoff) + ldsw + _i * 8192), 16, 0, 0); } while (0)
#define PG8_STAGE_A(bufoff, h, usenext, koff) do { if constexpr (GATHER) { unsigned _vo[2]; _vo[0] = (usenext) ? nvA[h][0] : vA[h][0]; _vo[1] = (usenext) ? nvA[h][1] : vA[h][1]; PG8_STAGE(bufoff, S.A + (koff), _vo); } \
        else { PG8_STAGE(bufoff, ((usenext) ? nA : cA) + (size_t)(h) * hstep + (koff), voffA); } } while (0)
#define PG8_LDA(dst, b, h) do { _Pragma("unroll") for (int m = 0; m < 4; ++m) _Pragma("unroll") for (int k = 0; k < 2; ++k) dst[m][k] = *(const LAS bf16x8*)(lds + PG8_SA(b, h) + aoff + m * 2048 + k * 1024); } while (0)
#define PG8_LDB(dst, b, h) do { _Pragma("unroll") for (int n = 0; n < 2; ++n) _Pragma("unroll") for (int k = 0; k < 2; ++k) dst[n][k] = *(const LAS bf16x8*)(lds + PG8_SB(b, h) + boff + n * 2048 + k * 1024); } while (0)
#define PG8_MMA(ai, bj, At, Bt) do { __builtin_amdgcn_s_setprio(1); _Pragma("unroll") for (int m = 0; m < 4; ++m) _Pragma("unroll") for (int n = 0; n < 2; ++n) _Pragma("unroll") for (int k = 0; k < 2; ++k) \
        acc[ai][bj][m][n] = __builtin_amdgcn_mfma_f32_16x16x32_bf16(Bt[n][k], At[m][k], acc[ai][bj][m][n], 0, 0, 0); __builtin_amdgcn_s_setprio(0); } while (0)
#define PG8_WAIT_V(n) asm volatile("s_waitcnt vmcnt(" #n ")" ::: "memory")
#define PG8_WAIT_L(n) asm volatile("s_waitcnt lgkmcnt(" #n ")" ::: "memory")
#define PG8_BAR __builtin_amdgcn_s_barrier()
#define PG8_SCHED __builtin_amdgcn_sched_barrier(0)
    Unit cur, nxt; int ui = 0;
    if (!S.next(0, cur)) return;
    f32x4 acc[2][2][4][2];
#pragma unroll
    for (int a = 0; a < 2; ++a)
#pragma unroll
        for (int b = 0; b < 2; ++b)
#pragma unroll
            for (int m = 0; m < 4; ++m)
#pragma unroll
                for (int n = 0; n < 2; ++n) acc[a][b][m][n] = (f32x4){0.f, 0.f, 0.f, 0.f};
    bf16x8 At[4][2], B0[2][2], B1[2][2];
    unsigned vA[2][2], nvA[2][2];
    if constexpr (GATHER) {
#pragma unroll
        for (int h = 0; h < 2; ++h)
#pragma unroll
            for (int i = 0; i < 2; ++i) { vA[h][i] = (unsigned)(S.tok(cur, h * HALF + RA[i]) * K + CA[i]) * 2u; nvA[h][i] = vA[h][i]; }
    }
    const char* cA = S.a_ptr(cur); const char* cB = S.b_ptr(cur); const char* nA = cA;
    PG8_STAGE(PG8_SB(0, 0), cB, voffB); PG8_STAGE(PG8_SB(0, 1), cB + hstep, voffB); PG8_STAGE_A(PG8_SA(0, 0), 0, false, 0); PG8_STAGE_A(PG8_SA(0, 1), 1, false, 0);
    if (wr == 1) PG8_BAR;
    PG8_WAIT_V(2); PG8_BAR;
    PG8_STAGE(PG8_SB(1, 0), cB + kstep, voffB); PG8_STAGE_A(PG8_SA(1, 0), 0, false, kstep); PG8_STAGE(PG8_SB(1, 1), cB + hstep + kstep, voffB);
    PG8_WAIT_V(6); PG8_BAR;
    for (;;) {
        const bool has_next = S.next(ui + 1, nxt);
        nA = has_next ? S.a_ptr(nxt) : cA; const char* nB = has_next ? S.b_ptr(nxt) : cB;
        if constexpr (GATHER) {
            if (has_next) {
#pragma unroll
                for (int h = 0; h < 2; ++h)
#pragma unroll
                    for (int i = 0; i < 2; ++i) nvA[h][i] = (unsigned)(S.tok(nxt, h * HALF + RA[i]) * K + CA[i]) * 2u;
            }
        }
        for (int t = 0; t < nt; t += 2) {
            const bool last = (t == nt - 2);
            const size_t k1 = (size_t)(t + 1) * kstep;
            const size_t k2 = last ? 0 : (size_t)(t + 2) * kstep, k3 = k2 + kstep;
            const char* b2 = last ? nB : cB + (size_t)(t + 2) * kstep; const char* b3 = b2 + kstep;
            PG8_LDB(B0, 0, 0); PG8_LDB(B1, 0, 1); PG8_SCHED; PG8_LDA(At, 0, 0); PG8_STAGE_A(PG8_SA(1, 1), 1, false, k1);
            PG8_WAIT_V(8); PG8_WAIT_L(0); PG8_BAR; PG8_MMA(0, 0, At, B0); PG8_MMA(0, 1, At, B1); PG8_BAR; PG8_SCHED;
            PG8_LDA(At, 0, 1); PG8_STAGE(PG8_SB(0, 0), b2, voffB); PG8_STAGE(PG8_SB(0, 1), b2 + hstep, voffB); PG8_STAGE_A(PG8_SA(0, 0), 0, last, k2);
            PG8_WAIT_V(8); PG8_WAIT_L(0); PG8_BAR; PG8_MMA(1, 0, At, B0); PG8_MMA(1, 1, At, B1); PG8_BAR; PG8_SCHED;
            PG8_LDB(B0, 1, 0); PG8_LDB(B1, 1, 1); PG8_SCHED; PG8_LDA(At, 1, 0); PG8_STAGE_A(PG8_SA(0, 1), 1, last, k2);
            PG8_WAIT_V(8); PG8_WAIT_L(0); PG8_BAR; PG8_MMA(0, 0, At, B0); PG8_MMA(0, 1, At, B1); PG8_BAR; PG8_SCHED;
            PG8_LDA(At, 1, 1); PG8_STAGE(PG8_SB(1, 0), b3, voffB); PG8_STAGE(PG8_SB(1, 1), b3 + hstep, voffB); PG8_STAGE_A(PG8_SA(1, 0), 0, last, k3);
            PG8_WAIT_V(8); PG8_WAIT_L(0); PG8_BAR; PG8_MMA(1, 0, At, B0); PG8_MMA(1, 1, At, B1); PG8_BAR; PG8_SCHED;
        }
        if (wr == 0) PG8_BAR;
        E(acc, cur, wr, wc, fr, fq);
        if (!has_next) break;
#pragma unroll
        for (int a = 0; a < 2; ++a)
#pragma unroll
            for (int b = 0; b < 2; ++b)
#pragma unroll
                for (int m = 0; m < 4; ++m)
#pragma unroll
                    for (int n = 0; n < 2; ++n) acc[a][b][m][n] = (f32x4){0.f, 0.f, 0.f, 0.f};
        cur = nxt; cA = nA; cB = nB; ++ui;
        if constexpr (GATHER) {
#pragma unroll
            for (int h = 0; h < 2; ++h)
#pragma unroll
                for (int i = 0; i < 2; ++i) vA[h][i] = nvA[h][i];
        }
        if (wr == 1) PG8_BAR;
    }
    PG8_WAIT_V(0);
    PG8_BAR;
#undef PG8_SA
#undef PG8_SB
#undef PG8_STAGE
#undef PG8_STAGE_A
#undef PG8_LDA
#undef PG8_LDB
#undef PG8_MMA
#undef PG8_WAIT_V
#undef PG8_WAIT_L
#undef PG8_BAR
#undef PG8_SCHED
}
}

namespace pg8 {
__device__ __forceinline__ void row_bt(int row, int& b, int& tok) { if (row < TX) { b = row >> 11; tok = row & 2047; } else { const int r = row - TX; b = r >> 8; tok = SEQ + (r & 255); } }

struct EpiAttnIn {
    static constexpr bool PERM = true;
    bf16* QKV; bf16* VAT; bf16* VBT; const LAS float* rope;
    __device__ __forceinline__ void operator()(const f32x4 (&acc)[2][2][4][2], const Unit& u, int wr, int wc, int fr, int fq) const {
        const int row0 = u.pm * BM + wr * 64 + fr; const int seg = u.pn >> 1;
        const bool latent = u.pm < (TX / BM);
        if (seg == 2 || seg == 5) {
#pragma unroll
            for (int ai = 0; ai < 2; ++ai)
#pragma unroll
                for (int m = 0; m < 4; ++m) { const int row = row0 + ai * HALF + m * 16; int b, tok; row_bt(row, b, tok);
#pragma unroll
                    for (int bj = 0; bj < 2; ++bj) { const int col = u.pn * BM + bj * HALF + wc * 32 + 8 * fq;
                        bf16* dst;
                        if (seg == 2) { const int cs = col - 1024; dst = VAT + ((size_t)(b * 4 + (cs >> 7)) * 128 + (cs & 127)) * NKEY + tok; }
                        else { const int cs = col - 2560; dst = VBT + ((size_t)(b * 8 + (cs >> 6)) * 64 + (cs & 63)) * NKEY + tok; }
#pragma unroll
                        for (int n = 0; n < 2; ++n)
#pragma unroll
                            for (int i = 0; i < 4; ++i) dst[(size_t)(4 * n + i) * NKEY] = (bf16)f2bf(acc[ai][bj][m][n][i]); } }
            return;
        }
        const bool dorope = latent && seg < 2;
        const float qs = (seg == 0 || seg == 3) ? 0.125f : 1.0f;
#pragma unroll
        for (int ai = 0; ai < 2; ++ai)
#pragma unroll
            for (int m = 0; m < 4; ++m) { const int row = row0 + ai * HALF + m * 16;
                f32x4 cs4[4];
                if (dorope) { const int t = row & 2047; const int pos = (wc & 1) ? (t & 63) : (t >> 6);
                    const LAS f32x4* rp = (const LAS f32x4*)(rope + (pos * 16 + 8 * (fq & 1)) * 2);
#pragma unroll
                    for (int j = 0; j < 4; ++j) cs4[j] = rp[j]; }
#pragma unroll
                for (int bj = 0; bj < 2; ++bj) { const int col = u.pn * BM + bj * HALF + wc * 32 + 8 * fq;
                    float v[8];
#pragma unroll
                    for (int n = 0; n < 2; ++n)
#pragma unroll
                        for (int i = 0; i < 4; ++i) v[4 * n + i] = acc[ai][bj][m][n][i];
                    if (dorope) {
#pragma unroll
                        for (int j = 0; j < 8; ++j) { const float other = __shfl_xor(v[j], 32); const float c = cs4[j >> 1][(j & 1) * 2], s = cs4[j >> 1][(j & 1) * 2 + 1];
                            v[j] = (fq < 2) ? (v[j] * c - other * s) : (v[j] * c + other * s); } }
                    u32x4 w; w.x = pk2(v[0] * qs, v[1] * qs); w.y = pk2(v[2] * qs, v[3] * qs); w.z = pk2(v[4] * qs, v[5] * qs); w.w = pk2(v[6] * qs, v[7] * qs);
                    *(u32x4*)(QKV + (size_t)row * NATT + col) = w; } }
    }
};
struct EpiGlaIn {
    static constexpr bool PERM = true;
    bf16* QKV2; bf16* VGT;
    __device__ __forceinline__ void operator()(const f32x4 (&acc)[2][2][4][2], const Unit& u, int wr, int wc, int fr, int fq) const {
        const int row0 = u.pm * BM + wr * 64 + fr;
        if (u.pn >= 4 && u.pn < 8) {
#pragma unroll
            for (int ai = 0; ai < 2; ++ai)
#pragma unroll
                for (int m = 0; m < 4; ++m) { const int row = row0 + ai * HALF + m * 16; int b, tok; row_bt(row, b, tok);
#pragma unroll
                    for (int bj = 0; bj < 2; ++bj) { const int cs = u.pn * BM + bj * HALF + wc * 32 + 8 * fq - 1024;
                        bf16* dst = VGT + ((size_t)(b * 4 + (cs >> 8)) * 256 + (cs & 255)) * NKEY + tok;
#pragma unroll
                        for (int n = 0; n < 2; ++n)
#pragma unroll
                            for (int i = 0; i < 4; ++i) dst[(size_t)(4 * n + i) * NKEY] = (bf16)f2bf(acc[ai][bj][m][n][i]); } }
            return;
        }
        const float qs = (u.pn < 2) ? 0.08838834764831845f : 1.0f;
#pragma unroll
        for (int ai = 0; ai < 2; ++ai)
#pragma unroll
            for (int m = 0; m < 4; ++m) { const int row = row0 + ai * HALF + m * 16;
#pragma unroll
                for (int bj = 0; bj < 2; ++bj) { const int col = u.pn * BM + bj * HALF + wc * 32 + 8 * fq; const f32x4 a = acc[ai][bj][m][0] * qs, c = acc[ai][bj][m][1] * qs;
                    u32x4 w; w.x = pk2(a[0], a[1]); w.y = pk2(a[2], a[3]); w.z = pk2(c[0], c[1]); w.w = pk2(c[2], c[3]);
                    *(u32x4*)(QKV2 + (size_t)row * NGLA + col) = w; } }
    }
};
struct EpiResid {
    static constexpr bool PERM = false;
    float* XL; float* XC; const float* modv;
    __device__ __forceinline__ void operator()(const f32x4 (&acc)[2][2][4][2], const Unit& u, int wr, int wc, int fr, int fq) const {
        const int row0 = u.pm * BM + wr * 64 + fr, col0 = u.pn * BM + wc * 32 + 4 * fq;
        const bool latent = u.pm < (TX / BM); const int bi = latent ? (u.pm >> 3) : 8;
        float* base = latent ? XL : (XC - (size_t)TX * D);
        f32x4 gv[2][2];
#pragma unroll
        for (int bj = 0; bj < 2; ++bj)
#pragma unroll
            for (int n = 0; n < 2; ++n) gv[bj][n] = *(const f32x4*)(modv + bi * 6144 + col0 + bj * HALF + n * 16);
#pragma unroll
        for (int ai = 0; ai < 2; ++ai)
#pragma unroll
            for (int m = 0; m < 4; ++m) { float* rowp = base + (size_t)(row0 + ai * HALF + m * 16) * D + col0;
#pragma unroll
                for (int bj = 0; bj < 2; ++bj)
#pragma unroll
                    for (int n = 0; n < 2; ++n) { f32x4* p = (f32x4*)(rowp + bj * HALF + n * 16); *p = *p + gv[bj][n] * acc[ai][bj][m][n]; } }
    }
};
struct EpiMoe1 {
    static constexpr bool PERM = false;
    bf16* HB;
    __device__ __forceinline__ void operator()(const f32x4 (&acc)[2][2][4][2], const Unit& u, int wr, int wc, int fr, int fq) const {
        const int row0 = u.pm * BM + wr * 64 + fr, col0 = u.pn * 128 + wc * 16 + 4 * fq;
#pragma unroll
        for (int ai = 0; ai < 2; ++ai)
#pragma unroll
            for (int m = 0; m < 4; ++m) { bf16* rowp = HB + (size_t)(row0 + ai * HALF + m * 16) * DEXP + col0;
#pragma unroll
                for (int bj = 0; bj < 2; ++bj) { const f32x4 a = acc[ai][bj][m][0], b = acc[ai][bj][m][1];
                    u32x2 w; w.x = pk2(silu_f(a[0]) * b[0], silu_f(a[1]) * b[1]); w.y = pk2(silu_f(a[2]) * b[2], silu_f(a[3]) * b[3]);
                    *(u32x2*)(rowp + bj * 64) = w; } }
    }
};
struct EpiBf16 {
    static constexpr bool PERM = true;
    bf16* O; int ldc;
    __device__ __forceinline__ void operator()(const f32x4 (&acc)[2][2][4][2], const Unit& u, int wr, int wc, int fr, int fq) const {
        const int row0 = u.pm * BM + wr * 64 + fr, col0 = u.pn * BM + wc * 32 + 8 * fq;
#pragma unroll
        for (int ai = 0; ai < 2; ++ai)
#pragma unroll
            for (int m = 0; m < 4; ++m) { bf16* rowp = O + (size_t)(row0 + ai * HALF + m * 16) * ldc + col0;
#pragma unroll
                for (int bj = 0; bj < 2; ++bj) { const f32x4 a = acc[ai][bj][m][0], c = acc[ai][bj][m][1];
                    u32x4 w; w.x = pk2(a[0], a[1]); w.y = pk2(a[2], a[3]); w.z = pk2(c[0], c[1]); w.w = pk2(c[2], c[3]);
                    *(u32x4*)(rowp + bj * HALF) = w; } }
    }
};
}

struct Args {
    const float *x, *c, *ctx, *c_ctx, *w_mod, *b_mod, *norm_g, *final_g, *att_w_in, *att_w_out, *att_lambda, *att_subln_g, *na_bias,
                *gla_w_in, *gla_w_gate, *gla_b_gate, *gla_norm_g, *gla_w_out, *router_w, *router_bias, *moe_w1, *moe_w3, *moe_w2;
    float* out; unsigned char* ws; int ph_lo, ph_hi;
};

struct RowMapId { int off; __device__ __forceinline__ int operator()(int n) const { return off + n; } };
struct RowMapMoe { int which; __device__ __forceinline__ int operator()(int n) const { return 32 * (n >> 4) + 16 * which + (n & 15); } };
template <class RM>
__device__ __forceinline__ void p0_transpose_item(const float* W, int K, int N, bf16* WT, LAS float* scr, int item, int lane, RM rm) {
    const int nblk = N / 32, kb = item / nblk, nb = item % nblk, k0 = 64 * kb, n0 = 32 * nb;
#pragma unroll 8
    for (int i = 0; i < 32; ++i) { const int kk = 2 * i + (lane >> 5); scr[kk * 33 + (lane & 31)] = W[(size_t)(k0 + kk) * N + n0 + (lane & 31)]; }
    LDS_WAIT(); asm volatile("" ::: "memory");
    const int c = lane & 7;
#pragma unroll
    for (int j = 0; j < 4; ++j) { const int n = (lane >> 3) + 8 * j; const LAS float* s = scr + (8 * c) * 33 + n;
        u32x4 o; o.x = pk2(s[0 * 33], s[1 * 33]); o.y = pk2(s[2 * 33], s[3 * 33]); o.z = pk2(s[4 * 33], s[5 * 33]); o.w = pk2(s[6 * 33], s[7 * 33]);
        *(u32x4*)(WT + (size_t)rm(n0 + n) * K + k0 + 8 * c) = o; }
    LDS_WAIT(); asm volatile("" ::: "memory");
}

template <class AP> __device__ __forceinline__ void p0_prologue(const AP ap, LAS unsigned char* lds, int tid, int lane, int wave, int vcu, int G) {
    const Args a = Args{ap->x, ap->c, ap->ctx, ap->c_ctx, ap->w_mod, ap->b_mod, ap->norm_g, ap->final_g, ap->att_w_in, ap->att_w_out, ap->att_lambda, ap->att_subln_g, ap->na_bias, ap->gla_w_in, ap->gla_w_gate, ap->gla_b_gate, ap->gla_norm_g, ap->gla_w_out, ap->router_w, ap->router_bias, ap->moe_w1, ap->moe_w3, ap->moe_w2, ap->out, ap->ws, 0, 0};
    unsigned char* ws = a.ws;
    LAS float* scr = (LAS float*)(lds + wave * 8448);
    LAS float* S9 = (LAS float*)(lds + 69632);
    LAS float* red = (LAS float*)(lds + 106496);
    const int gw = vcu * 8 + wave, NGW = G * 8;
    constexpr int I_AIN = 16 * 96, I_AOUT = 16 * 32, I_GIN = 16 * 97, I_GOUT = 16 * 32, I_W1 = 16 * 16, I_W2 = 8 * 32;
    constexpr int N_A = 2 * I_AIN, N_B = N_A + 2 * I_AOUT, N_C = N_B + 2 * I_GIN, N_D = N_C + 2 * I_GOUT, N_E = N_D + 64 * I_W1, N_F = N_E + 64 * I_W1, N_G = N_F + 64 * I_W2;
    for (int it = gw; it < N_G; it += NGW) {
        if (it < N_A) { const int j = it / I_AIN, r = it % I_AIN; p0_transpose_item(a.att_w_in + (size_t)j * D * NATT, D, NATT, (bf16*)(ws + WS_WATTIN) + (size_t)j * NATT * D, scr, r, lane, RowMapId{0}); }
        else if (it < N_B) { const int q = it - N_A, j = q / I_AOUT, r = q % I_AOUT; p0_transpose_item(a.att_w_out + (size_t)j * D * D, D, D, (bf16*)(ws + WS_WATTOUT) + (size_t)j * D * D, scr, r, lane, RowMapId{0}); }
        else if (it < N_C) { const int q = it - N_B, j = q / I_GIN, r = q % I_GIN; p0_transpose_item(a.gla_w_in + (size_t)j * D * 3104, D, 3104, (bf16*)(ws + WS_WGLAIN) + (size_t)j * NGLA * D, scr, r, lane, RowMapId{0}); }
        else if (it < N_D) { const int q = it - N_C, j = q / I_GOUT, r = q % I_GOUT; p0_transpose_item(a.gla_w_out + (size_t)j * D * D, D, D, (bf16*)(ws + WS_WGLAOUT) + (size_t)j * D * D, scr, r, lane, RowMapId{0}); }
        else if (it < N_E) { const int q = it - N_D, j = q / I_W1, r = q % I_W1; p0_transpose_item(a.moe_w1 + (size_t)j * D * DEXP, D, DEXP, (bf16*)(ws + WS_W13) + (size_t)j * D * D, scr, r, lane, RowMapMoe{0}); }
        else if (it < N_F) { const int q = it - N_E, j = q / I_W1, r = q % I_W1; p0_transpose_item(a.moe_w3 + (size_t)j * D * DEXP, D, DEXP, (bf16*)(ws + WS_W13) + (size_t)j * D * D, scr, r, lane, RowMapMoe{1}); }
        else { const int q = it - N_F, j = q / I_W2, r = q % I_W2; p0_transpose_item(a.moe_w2 + (size_t)j * DEXP * D, DEXP, D, (bf16*)(ws + WS_W2) + (size_t)j * D * DEXP, scr, r, lane, RowMapId{0}); }
    }
    { const int gt = vcu * 512 + tid, NT = G * 512;
      for (int i = gt; i < 2 * 28672; i += NT) { const int j = i / 28672, r = i % 28672; *(u32x4*)((bf16*)(ws + WS_WGLAIN) + (size_t)j * NGLA * D + (size_t)3104 * D + (size_t)r * 8) = (u32x4){0u, 0u, 0u, 0u}; }
      const f32x4* xs = (const f32x4*)a.x; f32x4* xo = (f32x4*)a.out;
      for (int i = gt; i < TX * D / 4; i += NT) xo[i] = xs[i];
      const f32x4* cs = (const f32x4*)a.ctx; f32x4* co = (f32x4*)(ws + WS_CTX);
      for (int i = gt; i < TC * D / 4; i += NT) co[i] = cs[i];
    }
    __syncthreads();
    for (int i = tid; i < 9 * 1024; i += 512) { const int bi = i >> 10, k = i & 1023; const float v = (bi < 8) ? a.c[bi * D + k] : a.c_ctx[k]; S9[i] = v / (1.0f + __expf(-v)); }
    __syncthreads();
    for (int u = vcu; u < 4 * 96; u += G) {
        const int L = u / 96, n0 = (u % 96) * 64;
        const float* W = a.w_mod + (size_t)L * D * 6144 + n0 + lane;
        float acc[9];
#pragma unroll
        for (int bi = 0; bi < 9; ++bi) acc[bi] = 0.f;
        const int kb = wave * 128;
#pragma unroll 8
        for (int k = 0; k < 128; ++k) { const float w = W[(size_t)(kb + k) * 6144];
#pragma unroll
            for (int bi = 0; bi < 9; ++bi) acc[bi] += S9[bi * 1024 + kb + k] * w; }
#pragma unroll
        for (int bi = 0; bi < 9; ++bi) red[(wave * 9 + bi) * 64 + lane] = acc[bi];
        __syncthreads();
        for (int i = tid; i < 9 * 64; i += 512) { const int bi = i >> 6, l = i & 63; float s = a.b_mod[L * 6144 + n0 + l];
#pragma unroll
            for (int w = 0; w < 8; ++w) s += red[(w * 9 + bi) * 64 + l];
            ((float*)(ws + WS_MODV))[(size_t)(L * 9 + bi) * 6144 + n0 + l] = s; }
        __syncthreads();
    }
}

__device__ __forceinline__ float* xrow_ptr(float* XL, float* XC, int row) { return row < TX ? XL + (size_t)row * D : XC + (size_t)(row - TX) * D; }
__device__ __forceinline__ int row_bi(int row) { return row < TX ? (row >> 11) : 8; }

__device__ __forceinline__ void norm_mod_store(const f32x4 (&v)[4], const float* g, const float* sh, const float* sc, bf16* orow, int lane) {
    float ss = 0.f;
#pragma unroll
    for (int j = 0; j < 4; ++j) ss += (v[j].x * v[j].x + v[j].y * v[j].y) + (v[j].z * v[j].z + v[j].w * v[j].w);
    const float rs = __builtin_amdgcn_rsqf(wave_sum(ss) * (1.0f / D) + EPSF);
#pragma unroll
    for (int j = 0; j < 4; ++j) { const int c = 4 * lane + 256 * j; const f32x4 gg = *(const f32x4*)(g + c), s1 = *(const f32x4*)(sc + c), s0 = *(const f32x4*)(sh + c);
        const f32x4 y = (v[j] * rs) * gg * (1.0f + s1) + s0;
        u32x2 w; w.x = pk2(y.x, y.y); w.y = pk2(y.z, y.w); *(u32x2*)(orow + c) = w; }
}

__device__ __forceinline__ void phase_norm1(float* XL, float* XC, const float* g, const float* modv, bf16* H, int nrows, int lane, int wave, int vcu, int G) {
    for (int row = vcu * 8 + wave; row < nrows; row += G * 8) {
        const f32x4* xr = (const f32x4*)xrow_ptr(XL, XC, row) + lane; f32x4 v[4];
#pragma unroll
        for (int j = 0; j < 4; ++j) v[j] = xr[64 * j];
        const float* mv = modv + row_bi(row) * 6144;
        norm_mod_store(v, g, mv, mv + 1024, H + (size_t)row * D, lane);
    }
}

__device__ __forceinline__ void phase_router(float* XL, float* XC, const float* g, const float* modv, bf16* H, const float* router_w, const float* router_bias,
                                             unsigned* cnt  , int* list, int* toki, float* tokw, int nrows,
                                             LAS unsigned char* lds, int tid, int lane, int wave, int vcu, int G) {
    LAS float* RW = (LAS float*)lds;
    LAS int* lcnt = (LAS int*)(lds + 65536);
    LAS int* rinfo = (LAS int*)(lds + 65536 + 256);
    for (int i = tid; i < 16 * 1024; i += 512) { const int e = i >> 10, k = i & 1023; RW[i] = router_w[k * 16 + e]; }
    if (tid < 32) lcnt[tid] = 0;
    __syncthreads();
    const int rpb = nrows / G, rpw = rpb / 8;
    for (int i = 0; i < rpw; ++i) {
        const int rl = wave * rpw + i, row = vcu * rpb + rl;
        const f32x4* xr = (const f32x4*)xrow_ptr(XL, XC, row) + lane; f32x4 v[4];
#pragma unroll
        for (int j = 0; j < 4; ++j) v[j] = xr[64 * j];
        const float* mv = modv + row_bi(row) * 6144 + 3072;
        float ss = 0.f;
#pragma unroll
        for (int j = 0; j < 4; ++j) ss += (v[j].x * v[j].x + v[j].y * v[j].y) + (v[j].z * v[j].z + v[j].w * v[j].w);
        const float rs = __builtin_amdgcn_rsqf(wave_sum(ss) * (1.0f / D) + EPSF);
        f32x4 y[4];
#pragma unroll
        for (int j = 0; j < 4; ++j) { const int c = 4 * lane + 256 * j; const f32x4 gg = *(const f32x4*)(g + c), s1 = *(const f32x4*)(mv + 1024 + c), s0 = *(const f32x4*)(mv + c);
            y[j] = (v[j] * rs) * gg * (1.0f + s1) + s0;
            u32x2 w; w.x = pk2(y[j].x, y[j].y); w.y = pk2(y[j].z, y[j].w); *(u32x2*)(H + (size_t)row * D + c) = w; }
        float lg[16];
#pragma unroll
        for (int e = 0; e < 16; ++e) { float s = 0.f;
#pragma unroll
            for (int j = 0; j < 4; ++j) { const f32x4 w = *(const LAS f32x4*)(RW + e * 1024 + 4 * lane + 256 * j); s += (y[j].x * w.x + y[j].y * w.y) + (y[j].z * w.z + y[j].w * w.w); }
            lg[e] = wave_sum(s); }
        float sc[16], sel[16];
#pragma unroll
        for (int e = 0; e < 16; ++e) { sc[e] = 1.0f / (1.0f + __expf(-lg[e])); sel[e] = sc[e] + router_bias[e]; }
        int bg = 0; float bgs = -1e30f;
#pragma unroll
        for (int gI = 0; gI < 4; ++gI) { float m1 = -1e30f, m2 = -1e30f;
#pragma unroll
            for (int q = 0; q < 4; ++q) { const float t = sel[gI * 4 + q]; if (t > m1) { m2 = m1; m1 = t; } else if (t > m2) m2 = t; }
            const float gs = m1 + m2; if (gs > bgs) { bgs = gs; bg = gI; } }
        int e0 = 0, e1 = 0; float s0 = -1e30f, s1 = -1e30f, w0 = 0.f, w1 = 0.f;
#pragma unroll
        for (int e = 0; e < 16; ++e) { if ((e >> 2) == bg) { const float t = sel[e];
                if (t > s0) { s1 = s0; e1 = e0; w1 = w0; s0 = t; e0 = e; w0 = sc[e]; } else if (t > s1) { s1 = t; e1 = e; w1 = sc[e]; } } }
        const float wn = 1.0f / (w0 + w1);
        if (lane == 0) { const int p0 = __hip_atomic_fetch_add(&lcnt[e0], 1, __ATOMIC_RELAXED, __HIP_MEMORY_SCOPE_WORKGROUP), p1 = __hip_atomic_fetch_add(&lcnt[e1], 1, __ATOMIC_RELAXED, __HIP_MEMORY_SCOPE_WORKGROUP);
            rinfo[rl * 6 + 0] = e0; rinfo[rl * 6 + 1] = p0; rinfo[rl * 6 + 2] = e1; rinfo[rl * 6 + 3] = p1;
            rinfo[rl * 6 + 4] = __builtin_bit_cast(int, w0 * wn); rinfo[rl * 6 + 5] = __builtin_bit_cast(int, w1 * wn); }
    }
    __syncthreads();
    if (tid < 16) lcnt[16 + tid] = (int)__hip_atomic_fetch_add(cnt + 64 * tid, (unsigned)lcnt[tid], RLX_AGENT);
    __syncthreads();
    if (tid < rpb) { const int row = vcu * rpb + tid; const int e0 = rinfo[tid * 6 + 0], e1 = rinfo[tid * 6 + 2];
        const int p0 = lcnt[16 + e0] + rinfo[tid * 6 + 1], p1 = lcnt[16 + e1] + rinfo[tid * 6 + 3];
        list[(size_t)e0 * TALL + p0] = row; list[(size_t)e1 * TALL + p1] = row;
        toki[row * 4 + 0] = e0; toki[row * 4 + 1] = p0; toki[row * 4 + 2] = e1; toki[row * 4 + 3] = p1;
        tokw[row * 2 + 0] = __builtin_bit_cast(float, rinfo[tid * 6 + 4]); tokw[row * 2 + 1] = __builtin_bit_cast(float, rinfo[tid * 6 + 5]); }
    __syncthreads();
}

__device__ __forceinline__ int build_moe_table(const unsigned* cnt, LAS int* tab, int tid) {
    if (tid == 0) { int rt = 0;
        for (int e = 0; e < 16; ++e) { const int c = (int)__hip_atomic_load(cnt + 64 * e, RLX_AGENT); tab[RT_MAX + 1 + e] = c; const int nt = (c + 255) >> 8;
            for (int m = 0; m < nt; ++m) { if (rt < RT_MAX) tab[rt] = e | (m << 8); ++rt; } }
        tab[RT_MAX] = rt < RT_MAX ? rt : RT_MAX; }
    __syncthreads();
    return tab[RT_MAX];
}

__device__ __forceinline__ void phase_combine(float* XL, float* XC, const float* modv  , const bf16* YB, const unsigned* cnt, const int* toki, const float* tokw,
                                              bool final_layer, const float* gnext, const float* modv_next, bf16* H, int nrows, int lane, int wave, int vcu, int G) {
    int tiles = 0; if (lane < 16) tiles = ((int)__hip_atomic_load(cnt + 64 * lane, RLX_AGENT) + 255) >> 8;
    int incl = tiles;
#pragma unroll
    for (int o = 1; o < 16; o <<= 1) { const int t = __shfl_up(incl, o); if (lane >= o) incl += t; }
    const int mybase = (incl - tiles) * 256;
    for (int row = vcu * 8 + wave; row < nrows; row += G * 8) {
        const int e0 = toki[row * 4 + 0], p0 = toki[row * 4 + 1], e1 = toki[row * 4 + 2], p1 = toki[row * 4 + 3];
        const float w0 = tokw[row * 2 + 0], w1 = tokw[row * 2 + 1];
        const int s0 = __shfl(mybase, e0) + p0, s1 = __shfl(mybase, e1) + p1;
        float* xp = xrow_ptr(XL, XC, row);
        const float* g2 = modv + row_bi(row) * 6144 + 5120;
        f32x4 v[4];
#pragma unroll
        for (int j = 0; j < 4; ++j) { const int c = 4 * lane + 256 * j;
            const u32x2 a = *(const u32x2*)(YB + (size_t)s0 * D + c), b = *(const u32x2*)(YB + (size_t)s1 * D + c);
            f32x4 y; y.x = w0 * bflo(a.x) + w1 * bflo(b.x); y.y = w0 * bfhi(a.x) + w1 * bfhi(b.x); y.z = w0 * bflo(a.y) + w1 * bflo(b.y); y.w = w0 * bfhi(a.y) + w1 * bfhi(b.y);
            v[j] = *(const f32x4*)(xp + c) + *(const f32x4*)(g2 + c) * y; }
        if (final_layer) {
            float ss = 0.f;
#pragma unroll
            for (int j = 0; j < 4; ++j) ss += (v[j].x * v[j].x + v[j].y * v[j].y) + (v[j].z * v[j].z + v[j].w * v[j].w);
            const float rs = __builtin_amdgcn_rsqf(wave_sum(ss) * (1.0f / D) + EPSF);
#pragma unroll
            for (int j = 0; j < 4; ++j) { const int c = 4 * lane + 256 * j; *(f32x4*)(xp + c) = (v[j] * rs) * *(const f32x4*)(gnext + c); }
        } else {
#pragma unroll
            for (int j = 0; j < 4; ++j) *(f32x4*)(xp + 4 * lane + 256 * j) = v[j];
            const float* mv = modv_next + row_bi(row) * 6144;
            norm_mod_store(v, gnext, mv, mv + 1024, H + (size_t)row * D, lane);
        }
    }
}

__device__ __forceinline__ void phase_readout(const bf16* OF, const bf16* OB, const bf16* QKV2, const float* ng, bf16* AOUT, int nrows, int lane, int wave, int vcu, int G) {
    const f32x4 gg = *(const f32x4*)(ng + 4 * lane);
    for (int row = vcu * 8 + wave; row < nrows; row += G * 8) {
#pragma unroll
        for (int j = 0; j < 4; ++j) { const int c = 4 * lane + 256 * j;
            const u32x2 a = *(const u32x2*)(OF + (size_t)row * D + c), b = *(const u32x2*)(OB + (size_t)row * D + c), gt = *(const u32x2*)(QKV2 + (size_t)row * NGLA + 2048 + c);
            f32x4 o; o.x = bflo(a.x) + bflo(b.x); o.y = bfhi(a.x) + bfhi(b.x); o.z = bflo(a.y) + bflo(b.y); o.w = bfhi(a.y) + bfhi(b.y);
            const float ss = wave_sum((o.x * o.x + o.y * o.y) + (o.z * o.z + o.w * o.w));
            const float rs = __builtin_amdgcn_rsqf(ss * (1.0f / 256.0f) + EPSF);
            f32x4 gv; gv.x = silu_f(bflo(gt.x)); gv.y = silu_f(bfhi(gt.x)); gv.z = silu_f(bflo(gt.y)); gv.w = silu_f(bfhi(gt.y));
            const f32x4 y = (o * rs) * gg * gv;
            u32x2 w; w.x = pk2(y.x, y.y); w.y = pk2(y.z, y.w); *(u32x2*)(AOUT + (size_t)row * D + c) = w; }
    }
}

struct AttnOut { float v; };
template <int NMAPS, int DV, bool NA>
__device__ __forceinline__ void attn_unit(LAS unsigned char* lds, int tid, int lane, int wave,
                                          const bf16* QKV, int qcol, int qrow0, int kcol, int krow_lat, int krow_ctx, const bf16* VT, int klo, int khi,
                                          int r_wave, int xq0, const LAS float* biasT,
                                          bf16* AOUT, int ocol, float lam, const float* subg, float outscale) {
    constexpr int KB = 9216;
    constexpr int BUFSZ = NMAPS * KB + DV * 144;
    constexpr int NVB = DV / 16, NVR = DV / 64;
    const int fr = lane & 15, g = lane >> 4;
    bf16x8 qf[NMAPS][2];
    { const bf16* qp = QKV + (size_t)(qrow0 + wave * 16 + fr) * NATT + qcol + 8 * g;
#pragma unroll
      for (int m = 0; m < NMAPS; ++m)
#pragma unroll
          for (int s = 0; s < 2; ++s) qf[m][s] = *(const bf16x8*)(qp + m * 64 + 32 * s); }
    f32x4 O[NMAPS][NVB]; float mrun[NMAPS], lrun[NMAPS];
#pragma unroll
    for (int m = 0; m < NMAPS; ++m) { mrun[m] = -1e30f; lrun[m] = 0.f;
#pragma unroll
        for (int vb = 0; vb < NVB; ++vb) O[m][vb] = (f32x4){0.f, 0.f, 0.f, 0.f}; }
    const int ntiles = 4 + (khi - klo);
    u32x4 kreg[NMAPS], vreg[NVR];
    const int lkey = tid >> 3, lch = tid & 7;
#define AT_LOAD(i) do { const int _i = (i); const int _rowg = (_i < 4 ? krow_ctx + 64 * _i : krow_lat + 64 * (klo + _i - 4)) + lkey; const int _tok0 = (_i < 4 ? SEQ + 64 * _i : 64 * (klo + _i - 4)); \
        _Pragma("unroll") for (int m = 0; m < NMAPS; ++m) kreg[m] = *(const u32x4*)(QKV + (size_t)_rowg * NATT + kcol + m * 64 + lch * 8); \
        _Pragma("unroll") for (int j = 0; j < NVR; ++j) { const int idx = tid + 512 * j; vreg[j] = *(const u32x4*)(VT + (size_t)(idx >> 3) * NKEY + _tok0 + (idx & 7) * 8); } } while (0)
#define AT_STORE(b) do { LAS unsigned char* _p = lds + (b) * BUFSZ; \
        _Pragma("unroll") for (int m = 0; m < NMAPS; ++m) *(LAS u32x4*)(_p + m * KB + lkey * 144 + lch * 16) = kreg[m]; \
        _Pragma("unroll") for (int j = 0; j < NVR; ++j) { const int idx = tid + 512 * j; *(LAS u32x4*)(_p + NMAPS * KB + (idx >> 3) * 144 + (idx & 7) * 16) = vreg[j]; } } while (0)
    AT_LOAD(0); AT_STORE(0); __syncthreads();
    int r0w = 0, xq = 0, cs = 0;
    if constexpr (NA) { r0w = r_wave - 4; r0w = r0w < 0 ? 0 : (r0w > 24 ? 24 : r0w); xq = xq0 + fr; cs = xq - 8; cs = cs < 0 ? 0 : (cs > 48 ? 48 : cs); }
    for (int i = 0; i < ntiles; ++i) {
        if (i + 1 < ntiles) AT_LOAD(i + 1);
        const LAS unsigned char* buf = lds + (i & 1) * BUFSZ;
        bool active = true; int kr = 0;
        if constexpr (NA) { if (i >= 4) { kr = klo + i - 4; active = (kr >= r0w) && (kr < r0w + 8); } }
        if (active) {
#pragma unroll
            for (int m = 0; m < NMAPS; ++m) {
                f32x4 S[4];
#pragma unroll
                for (int kb = 0; kb < 4; ++kb) { S[kb] = (f32x4){0.f, 0.f, 0.f, 0.f};
#pragma unroll
                    for (int s = 0; s < 2; ++s) { const bf16x8 kf = *(const LAS bf16x8*)(buf + m * KB + (16 * kb + fr) * 144 + (8 * g + 32 * s) * 2);
                        S[kb] = __builtin_amdgcn_mfma_f32_16x16x32_bf16(kf, qf[m][s], S[kb], 0, 0, 0); } }
                float mx = -1e30f;
#pragma unroll
                for (int kb = 0; kb < 4; ++kb)
#pragma unroll
                    for (int ii = 0; ii < 4; ++ii) { float t = S[kb][ii] * LOG2E;
                        if constexpr (NA) { if (i >= 4) { const int y = 16 * kb + 4 * g + ii; const bool ok = (y >= cs) && (y < cs + 16);
                                const int bidx = (kr - r_wave + 7) * 31 + (y - xq + 15); const float bv = biasT[ok ? bidx : 0]; t = ok ? t + bv : -1e30f; } }
                        S[kb][ii] = t; mx = fmaxf(mx, t); }
                mx = fmaxf(mx, __shfl_xor(mx, 16)); mx = fmaxf(mx, __shfl_xor(mx, 32));
                const float mnew = fmaxf(mrun[m], mx), alpha = fexp2(mrun[m] - mnew); mrun[m] = mnew;
                float ls = 0.f;
#pragma unroll
                for (int kb = 0; kb < 4; ++kb)
#pragma unroll
                    for (int ii = 0; ii < 4; ++ii) { const float p = fexp2(S[kb][ii] - mnew); S[kb][ii] = p; ls += p; }
                lrun[m] = lrun[m] * alpha + ls;
#pragma unroll
                for (int vb = 0; vb < NVB; ++vb) O[m][vb] = O[m][vb] * alpha;
                bf16x8 pf[2];
#pragma unroll
                for (int t = 0; t < 2; ++t) { u32x4 w; w.x = pk2(S[2 * t][0], S[2 * t][1]); w.y = pk2(S[2 * t][2], S[2 * t][3]); w.z = pk2(S[2 * t + 1][0], S[2 * t + 1][1]); w.w = pk2(S[2 * t + 1][2], S[2 * t + 1][3]);
                    pf[t] = __builtin_bit_cast(bf16x8, w); }
#pragma unroll
                for (int vb = 0; vb < NVB; ++vb)
#pragma unroll
                    for (int t = 0; t < 2; ++t) { const LAS unsigned char* vp = buf + NMAPS * KB + (16 * vb + fr) * 144 + (32 * t + 4 * g) * 2;
                        const u32x2 lo = *(const LAS u32x2*)vp, hi = *(const LAS u32x2*)(vp + 32);
                        u32x4 w; w.x = lo.x; w.y = lo.y; w.z = hi.x; w.w = hi.y;
                        O[m][vb] = __builtin_amdgcn_mfma_f32_16x16x32_bf16(__builtin_bit_cast(bf16x8, w), pf[t], O[m][vb], 0, 0, 0); }
                __builtin_amdgcn_sched_barrier(0);
            }
        }
        if (i + 1 < ntiles) AT_STORE((i + 1) & 1);
        __syncthreads();
    }
#undef AT_LOAD
#undef AT_STORE
    float inv[NMAPS];
#pragma unroll
    for (int m = 0; m < NMAPS; ++m) { float l = lrun[m]; l += __shfl_xor(l, 16); l += __shfl_xor(l, 32); inv[m] = 1.0f / l; }
    const int orow = qrow0 + wave * 16 + fr;
    if constexpr (NMAPS == 2) {
        float ss = 0.f; const float i1 = inv[0], i2 = lam * inv[1];
#pragma unroll
        for (int vb = 0; vb < NVB; ++vb) { O[0][vb] = O[0][vb] * i1 - O[1][vb] * i2; const f32x4 o = O[0][vb]; ss += (o.x * o.x + o.y * o.y) + (o.z * o.z + o.w * o.w); }
        ss += __shfl_xor(ss, 16); ss += __shfl_xor(ss, 32);
        const float rs = __builtin_amdgcn_rsqf(ss * (1.0f / DV) + EPSF) * outscale;
#pragma unroll
        for (int vb = 0; vb < NVB; ++vb) { const f32x4 gg = *(const f32x4*)(subg + 16 * vb + 4 * g); const f32x4 y = O[0][vb] * rs * gg;
            u32x2 w; w.x = pk2(y.x, y.y); w.y = pk2(y.z, y.w); *(u32x2*)(AOUT + (size_t)orow * D + ocol + 16 * vb + 4 * g) = w; }
    } else {
#pragma unroll
        for (int vb = 0; vb < NVB; ++vb) { const f32x4 y = O[0][vb] * inv[0];
            u32x2 w; w.x = pk2(y.x, y.y); w.y = pk2(y.z, y.w); *(u32x2*)(AOUT + (size_t)orow * D + ocol + 16 * vb + 4 * g) = w; }
    }
}

__device__ __forceinline__ int na_r0(int r) { int v = r - 4; return v < 0 ? 0 : (v > 24 ? 24 : v); }

__device__ __forceinline__ void phase_attention(const bf16* QKV, const bf16* VAT, const bf16* VBT, bf16* AOUT, const float* lamp  , float lam_init, const float* subg, const float* nab  ,
                                                LAS unsigned char* lds, int tid, int lane, int wave, int vcu, int G) {
    float part = lamp[lane] * lamp[64 + lane]; float part2 = lamp[128 + lane] * lamp[192 + lane];
    const float lam = __expf(wave_sum(part)) - __expf(wave_sum(part2)) + lam_init;
    for (int u = vcu; u < 576; u += G) {
        int bh, qrow0, khi;
        if (u < 512) { bh = u >> 4; const int qt = u & 15; qrow0 = (bh >> 2) * SEQ + qt * 128; khi = 32; }
        else { const int q = u - 512; bh = q >> 1; const int qt = q & 1; qrow0 = TX + (bh >> 2) * CTXL + qt * 128; khi = 0; }
        const int b = bh >> 2, h = bh & 3;
        attn_unit<2, 128, false>(lds, tid, lane, wave, QKV, h * 128, qrow0, 512 + h * 128, b * SEQ, TX + b * CTXL, VAT + (size_t)bh * 128 * NKEY, 0, khi, 0, 0, nullptr,
                                 AOUT, h * 128, lam, subg, 1.0f - lam_init);
    }
    LAS float* biasT = (LAS float*)(lds + LX_BIAS);
    for (int u = vcu; u < 1152; u += G) {
        int bh, qrow0, klo, khi, rw;
        if (u < 1024) { bh = u >> 4; const int rp = u & 15; qrow0 = (bh >> 3) * SEQ + rp * 128; klo = na_r0(2 * rp); khi = na_r0(2 * rp + 1) + 8; rw = 2 * rp + (wave >> 2); }
        else { const int q = u - 1024; bh = q >> 1; const int qt = q & 1; qrow0 = TX + (bh >> 3) * CTXL + qt * 128; klo = 0; khi = 0; rw = 0; }
        const int b = bh >> 3, h = bh & 7;
        for (int i = tid; i < 15 * 31; i += 512) biasT[i] = nab[h * 465 + i] * LOG2E;
        attn_unit<1, 64, true>(lds, tid, lane, wave, QKV, 1536 + h * 64, qrow0, 2048 + h * 64, b * SEQ, TX + b * CTXL, VBT + (size_t)bh * 64 * NKEY, klo, khi,
                               rw, 16 * (wave & 3), biasT, AOUT, 512 + h * 64, 0.f, nullptr, 1.0f);
    }
}

constexpr int GL_QM = 0, GL_QG = 17408, GL_KM = 34816, GL_KET = 52224, GL_VT = 70656, GL_ST = 79872, GL_LR = 97280, GL_SEG = 101376, GL_DEC = 103424;
__device__ __forceinline__ void phase_gla(const bf16* QKV2, const bf16* VGT, bf16* OF, bf16* OB, const float* wgate  , const float* bgate  ,
                                          LAS unsigned char* lds, int tid, int lane, int wave, int vcu, int G) {
    const int fr = lane & 15, g = lane >> 4;
    const int d = tid & 127, seg = tid >> 7;
    for (int u = vcu; u < 256; u += G) {
        const int slab = u & 3, dir = (u >> 2) & 1, hh = (u >> 3) & 3, b = u >> 5;
        bf16* OUT = dir ? OB : OF;
        float wg[16];
#pragma unroll
        for (int r = 0; r < 16; ++r) wg[r] = wgate[(dir * 16 + r) * 512 + hh * 128 + d];
        const float bgv = bgate[dir * 512 + hh * 128 + d];
        f32x4 Sacc[4];
#pragma unroll
        for (int vb = 0; vb < 4; ++vb) Sacc[vb] = (f32x4){0.f, 0.f, 0.f, 0.f};
        for (int i = tid; i < 17408 / 4; i += 512) ((LAS unsigned*)(lds + GL_ST))[i] = 0u;
        const bf16* vtb = VGT + ((size_t)(b * 4 + hh) * 256 + slab * 64) * NKEY;
        u32x4 qr[2], kr[2], vr, lr4;
#define GL_LOAD(n) do { const int _n = (n); int _row0, _tok0; if (_n < 4) { const int cc = dir ? 3 - _n : _n; _row0 = TX + b * CTXL + 64 * cc; _tok0 = SEQ + 64 * cc; } else { const int lc = dir ? 35 - _n : _n - 4; _row0 = b * SEQ + 64 * lc; _tok0 = 64 * lc; } \
        _Pragma("unroll") for (int j = 0; j < 2; ++j) { const int idx = tid + 512 * j, p = idx >> 4, ch = idx & 15; const bf16* src = QKV2 + (size_t)(_row0 + p) * NGLA + hh * 128 + ch * 8; qr[j] = *(const u32x4*)src; kr[j] = *(const u32x4*)(src + 512); } \
        vr = *(const u32x4*)(vtb + (size_t)(tid >> 3) * NKEY + _tok0 + (tid & 7) * 8); \
        if (tid < 128) lr4 = *(const u32x4*)(QKV2 + (size_t)(_row0 + (tid >> 1)) * NGLA + 3072 + dir * 16 + (tid & 1) * 8); } while (0)
        GL_LOAD(0);
        for (int n = 0; n < 36; ++n) {
            int row0; if (n < 4) { const int cc = dir ? 3 - n : n; row0 = TX + b * CTXL + 64 * cc; } else { const int lc = dir ? 35 - n : n - 4; row0 = b * SEQ + 64 * lc; }
#pragma unroll
            for (int j = 0; j < 2; ++j) { const int idx = tid + 512 * j, p = idx >> 4, ch = idx & 15;
                *(LAS u32x4*)(lds + GL_QM + p * 272 + ch * 16) = qr[j]; *(LAS u32x4*)(lds + GL_KM + p * 272 + ch * 16) = kr[j]; }
            *(LAS u32x4*)(lds + GL_VT + (tid >> 3) * 144 + (tid & 7) * 16) = vr;
            if (tid < 128) { LAS float* lp = (LAS float*)(lds + GL_LR) + (tid >> 1) * 16 + (tid & 1) * 8;
                lp[0] = bflo(lr4.x); lp[1] = bfhi(lr4.x); lp[2] = bflo(lr4.y); lp[3] = bfhi(lr4.y); lp[4] = bflo(lr4.z); lp[5] = bfhi(lr4.z); lp[6] = bflo(lr4.w); lp[7] = bfhi(lr4.w); }
            __syncthreads();
            if (n + 1 < 36) GL_LOAD(n + 1);
            float gc[16];
#pragma unroll
            for (int pi = 0; pi < 16; ++pi) { const LAS f32x4* lp = (const LAS f32x4*)((LAS float*)(lds + GL_LR) + (16 * seg + pi) * 16); float z = bgv;
#pragma unroll
                for (int q = 0; q < 4; ++q) { const f32x4 l4 = lp[q]; z += l4.x * wg[4 * q] + l4.y * wg[4 * q + 1] + l4.z * wg[4 * q + 2] + l4.w * wg[4 * q + 3]; }
                const float az = fabsf(z); gc[pi] = (fminf(z, 0.f) - flog(1.0f + fexp(-az))) * 0.0625f; }
            float run = 0.f;
            if (dir == 0) {
#pragma unroll
                for (int pi = 0; pi < 16; ++pi) { run += gc[pi]; gc[pi] = run; }
            } else {
#pragma unroll
                for (int pi = 15; pi >= 0; --pi) { run += gc[pi]; gc[pi] = run; }
            }
            ((LAS float*)(lds + GL_SEG))[seg * 128 + d] = run;
            __syncthreads();
            float t0 = ((LAS float*)(lds + GL_SEG))[d], t1 = ((LAS float*)(lds + GL_SEG))[128 + d], t2 = ((LAS float*)(lds + GL_SEG))[256 + d], t3 = ((LAS float*)(lds + GL_SEG))[384 + d];
            float off, gmid; const float gend = (t0 + t1) + (t2 + t3);
            if (dir == 0) { off = (seg > 0 ? t0 : 0.f) + (seg > 1 ? t1 : 0.f) + (seg > 2 ? t2 : 0.f); gmid = t0 + t1; }
            else { off = (seg < 3 ? t3 : 0.f) + (seg < 2 ? t2 : 0.f) + (seg < 1 ? t1 : 0.f); gmid = t3 + t2; }
            const float emid = fexp(gmid), eend = fexp(gend - gmid);
            unsigned kep[8];
#pragma unroll
            for (int pi = 0; pi < 16; ++pi) { const int p = 16 * seg + pi; const float rel = off + gc[pi] - gmid; const float E = fexp(rel), Ei = fexp(-rel);
                LAS bf16* qa = (LAS bf16*)(lds + GL_QM) + p * 136 + d; LAS bf16* ka = (LAS bf16*)(lds + GL_KM) + p * 136 + d;
                const float q = bf2f(*qa), k = bf2f(*ka);
                const float qm = q * E, km = k * Ei;
                *qa = (bf16)f2bf(qm); *ka = (bf16)f2bf(km); ((LAS bf16*)(lds + GL_QG))[p * 136 + d] = (bf16)f2bf(qm * emid);
                const unsigned keb = f2bf(km * eend); if (pi & 1) kep[pi >> 1] |= keb << 16; else kep[pi >> 1] = keb; }
            { LAS u32x4* kt = (LAS u32x4*)(lds + GL_KET + d * 144 + seg * 32); kt[0] = (u32x4){kep[0], kep[1], kep[2], kep[3]}; kt[1] = (u32x4){kep[4], kep[5], kep[6], kep[7]}; }
            if (seg == 0) ((LAS float*)(lds + GL_DEC))[d] = fexp(gend);
            __syncthreads();
            { const int cb = wave & 3, vh = wave >> 2;
              f32x4 AT[4];
#pragma unroll
              for (int sb = 0; sb < 4; ++sb) { AT[sb] = (f32x4){0.f, 0.f, 0.f, 0.f};
#pragma unroll
                  for (int ks = 0; ks < 4; ++ks) { const bf16x8 af = *(const LAS bf16x8*)(lds + GL_KM + (16 * sb + fr) * 272 + (8 * g + 32 * ks) * 2);
                      const bf16x8 bfr = *(const LAS bf16x8*)(lds + GL_QM + (16 * cb + fr) * 272 + (8 * g + 32 * ks) * 2);
                      AT[sb] = __builtin_amdgcn_mfma_f32_16x16x32_bf16(af, bfr, AT[sb], 0, 0, 0); }
                  const int c = 16 * cb + fr;
#pragma unroll
                  for (int ii = 0; ii < 4; ++ii) { const int s = 16 * sb + 4 * g + ii; const bool keep = dir ? (s >= c) : (s <= c); AT[sb][ii] = keep ? AT[sb][ii] : 0.f; } }
              bf16x8 pf[2];
#pragma unroll
              for (int t = 0; t < 2; ++t) { u32x4 w; w.x = pk2(AT[2 * t][0], AT[2 * t][1]); w.y = pk2(AT[2 * t][2], AT[2 * t][3]); w.z = pk2(AT[2 * t + 1][0], AT[2 * t + 1][1]); w.w = pk2(AT[2 * t + 1][2], AT[2 * t + 1][3]);
                  pf[t] = __builtin_bit_cast(bf16x8, w); }
#pragma unroll
              for (int v2 = 0; v2 < 2; ++v2) { const int vb = 2 * vh + v2; f32x4 Oa = (f32x4){0.f, 0.f, 0.f, 0.f};
#pragma unroll
                  for (int ks = 0; ks < 4; ++ks) { const bf16x8 af = *(const LAS bf16x8*)(lds + GL_ST + (16 * vb + fr) * 272 + (8 * g + 32 * ks) * 2);
                      const bf16x8 bfr = *(const LAS bf16x8*)(lds + GL_QG + (16 * cb + fr) * 272 + (8 * g + 32 * ks) * 2);
                      Oa = __builtin_amdgcn_mfma_f32_16x16x32_bf16(af, bfr, Oa, 0, 0, 0); }
#pragma unroll
                  for (int t = 0; t < 2; ++t) { const LAS unsigned char* vp = lds + GL_VT + (16 * vb + fr) * 144 + (32 * t + 4 * g) * 2;
                      const u32x2 lo = *(const LAS u32x2*)vp, hi = *(const LAS u32x2*)(vp + 32);
                      u32x4 w; w.x = lo.x; w.y = lo.y; w.z = hi.x; w.w = hi.y;
                      Oa = __builtin_amdgcn_mfma_f32_16x16x32_bf16(__builtin_bit_cast(bf16x8, w), pf[t], Oa, 0, 0, 0); }
                  u32x2 w; w.x = pk2(Oa[0], Oa[1]); w.y = pk2(Oa[2], Oa[3]);
                  *(u32x2*)(OUT + (size_t)(row0 + 16 * cb + fr) * D + hh * 256 + slab * 64 + 16 * vb + 4 * g) = w; }
            }
            { const f32x4 dec = *(const LAS f32x4*)((LAS float*)(lds + GL_DEC) + 16 * wave + 4 * g);
#pragma unroll
              for (int vb = 0; vb < 4; ++vb) { Sacc[vb] = Sacc[vb] * dec;
#pragma unroll
                  for (int t = 0; t < 2; ++t) { const bf16x8 af = *(const LAS bf16x8*)(lds + GL_KET + (16 * wave + fr) * 144 + (8 * g + 32 * t) * 2);
                      const bf16x8 bfr = *(const LAS bf16x8*)(lds + GL_VT + (16 * vb + fr) * 144 + (8 * g + 32 * t) * 2);
                      Sacc[vb] = __builtin_amdgcn_mfma_f32_16x16x32_bf16(af, bfr, Sacc[vb], 0, 0, 0); } }
            }
            __syncthreads();
#pragma unroll
            for (int vb = 0; vb < 4; ++vb) { u32x2 w; w.x = pk2(Sacc[vb][0], Sacc[vb][1]); w.y = pk2(Sacc[vb][2], Sacc[vb][3]);
                *(LAS u32x2*)(lds + GL_ST + (16 * vb + fr) * 272 + (16 * wave + 4 * g) * 2) = w; }
        }
#undef GL_LOAD
        __syncthreads();
    }
}

constexpr int N_PHASES = 34;
typedef const Args __attribute__((address_space(4)))* KArgs;
__device__ __forceinline__ KArgs kargs() { KArgs p = (KArgs)__builtin_amdgcn_kernarg_segment_ptr(); asm volatile("" : "+s"(p)); return p; }
__global__ void __launch_bounds__(512, 2) fwd(Args a_unused) {
    extern __shared__ __attribute__((aligned(16))) unsigned char lds_raw[];
    LAS unsigned char* lds = (LAS unsigned char*)lds_raw;
    const int tid0 = threadIdx.x;
    const int G0 = gridDim.x; const int bx0 = blockIdx.x;
#define PH_ENTRY int tid = tid0; asm volatile("" : "+v"(tid)); int G = G0, bx = bx0; asm volatile("" : "+s"(G), "+s"(bx)); const int lane = tid & 63, wave = __builtin_amdgcn_readfirstlane(tid >> 6); \
        const int vcu = (G % 8 == 0) ? (bx % 8) * (G / 8) + bx / 8 : bx; (void)lane; (void)wave; (void)vcu
    const int tid = tid0;
    const int ph_lo = kargs()->ph_lo, ph_hi = kargs()->ph_hi;
    if (tid < 64) ((LAS unsigned*)(lds + LX_MISC))[tid] = 0u;
    for (int i = tid; i < 1024; i += 512) { const int pos = i >> 4, f = i & 15; const float inv = __builtin_amdgcn_exp2f(-(float)f * (13.287712379549449f / 16.0f)); const float ang = (float)pos * inv;
        ((LAS float*)(lds + LX_ROPE))[2 * i] = __cosf(ang); ((LAS float*)(lds + LX_ROPE))[2 * i + 1] = __sinf(ang); }
    __syncthreads();
    const bool single = (ph_hi - ph_lo) > 1;
    XcdBarrier bar; bar.bar = (unsigned*)(kargs()->ws + WS_CTL) + CW_BAR; bar.x = 0; bar.st = (volatile LAS unsigned*)(lds + LX_MISC);
    if (single) bar = xcd_barrier_post((unsigned*)(kargs()->ws + WS_CTL) + CW_BAR, (volatile LAS unsigned*)(lds + LX_MISC));
#define IN(k) (ph_lo <= (k) && (k) < ph_hi)
#define SEAM(k) do { if (IN(k) && IN((k) + 1)) { bar.bar = (unsigned*)(kargs()->ws + WS_CTL) + CW_BAR; xcd_barrier(bar); } } while (0)
    LAS int* tab = (LAS int*)(lds + LX_MOETAB);

    if (IN(0)) { PH_ENTRY; p0_prologue(kargs(), lds, tid, lane, wave, vcu, G); } SEAM(0);
    if (IN(1)) { PH_ENTRY; KArgs A = kargs(); unsigned char* ws = A->ws; phase_norm1(A->out, (float*)(ws + WS_CTX), A->norm_g, (float*)(ws + WS_MODV), (bf16*)(ws + WS_H), TALL, lane, wave, vcu, G); } SEAM(1);

#pragma nounroll
    for (int L = 0; L < 4; ++L) {
        const int pb = 2 + 8 * L; const bool isattn = !(L & 1); const int j = L >> 1; const bool lastL = (L == 3);
        const int nrows = lastL ? TX : TALL;
        if (IN(pb)) {
            PH_ENTRY; KArgs A = kargs(); unsigned char* ws = A->ws; unsigned char* big = ws + WS_BIG; const bf16* H = (const bf16*)(ws + WS_H);
            if (isattn) {
                pg8::DenseOrder S; S.init(H, (const bf16*)(ws + WS_WATTIN) + (size_t)j * NATT * D, TALL, NATT, D, G, bx);
                pg8::EpiAttnIn E{(bf16*)(big + BG_QKV), (bf16*)(big + BG_VAT), (bf16*)(big + BG_VBT), (const LAS float*)(lds + LX_ROPE)};
                pg8::gemm_phase<pg8::EpiAttnIn, pg8::DenseOrder, false>(lds, tid, D, S, E);
            } else {
                pg8::DenseOrder S; S.init(H, (const bf16*)(ws + WS_WGLAIN) + (size_t)j * NGLA * D, TALL, NGLA, D, G, bx);
                pg8::EpiGlaIn E{(bf16*)(big + BG_QKV2), (bf16*)(big + BG_VGT)};
                pg8::gemm_phase<pg8::EpiGlaIn, pg8::DenseOrder, false>(lds, tid, D, S, E);
            }
        }
        SEAM(pb);
        if (IN(pb + 1)) {
            PH_ENTRY; KArgs A = kargs(); unsigned char* ws = A->ws; unsigned char* big = ws + WS_BIG; bf16* AOUT = (bf16*)(ws + WS_AOUT);
            if (isattn) phase_attention((const bf16*)(big + BG_QKV), (const bf16*)(big + BG_VAT), (const bf16*)(big + BG_VBT), AOUT, A->att_lambda + j * 256, (L == 0) ? 0.2f : 0.470713018f,
                                        A->att_subln_g + j * 128, A->na_bias + j * 8 * 465, lds, tid, lane, wave, vcu, G);
            else phase_gla((const bf16*)(big + BG_QKV2), (const bf16*)(big + BG_VGT), (bf16*)(big + BG_OF), (bf16*)(big + BG_OB), A->gla_w_gate + j * 2 * 16 * 512, A->gla_b_gate + j * 2 * 512,
                           lds, tid, lane, wave, vcu, G);
        }
        SEAM(pb + 1);
        if (!isattn) {
            if (IN(pb + 2)) { PH_ENTRY; KArgs A = kargs(); unsigned char* ws = A->ws; unsigned char* big = ws + WS_BIG;
                phase_readout((const bf16*)(big + BG_OF), (const bf16*)(big + BG_OB), (const bf16*)(big + BG_QKV2), A->gla_norm_g + j * 256, (bf16*)(ws + WS_AOUT), nrows, lane, wave, vcu, G); }
            SEAM(pb + 2);
        }
        if (IN(pb + 3)) {
            PH_ENTRY; KArgs A = kargs(); unsigned char* ws = A->ws;
            pg8::DenseOrder S; S.init((const bf16*)(ws + WS_AOUT), (const bf16*)(ws + (isattn ? WS_WATTOUT : WS_WGLAOUT)) + (size_t)j * D * D, nrows, D, D, G, bx);
            pg8::EpiResid E{A->out, (float*)(ws + WS_CTX), (const float*)(ws + WS_MODV) + (size_t)L * 9 * 6144 + 2048};
            pg8::gemm_phase<pg8::EpiResid, pg8::DenseOrder, false>(lds, tid, D, S, E);
        }
        SEAM(pb + 3);
        if (IN(pb + 4)) { PH_ENTRY; KArgs A = kargs(); unsigned char* ws = A->ws;
            phase_router(A->out, (float*)(ws + WS_CTX), A->norm_g + (L * 2 + 1) * D, (const float*)(ws + WS_MODV) + (size_t)L * 9 * 6144, (bf16*)(ws + WS_H), A->router_w, A->router_bias,
                         (unsigned*)(ws + WS_CTL) + CW_CNT + L * 16 * 64, (int*)(ws + WS_LIST), (int*)(ws + WS_TOKI), (float*)(ws + WS_TOKW), nrows, lds, tid, lane, wave, vcu, G); }
        SEAM(pb + 4);
        if (IN(pb + 5)) {
            PH_ENTRY; KArgs A = kargs(); unsigned char* ws = A->ws;
            const int RT = build_moe_table((unsigned*)(ws + WS_CTL) + CW_CNT + L * 16 * 64, tab, tid);
            pg8::MoeOrder S; S.A = (const char*)(ws + WS_H); S.B = (const char*)(ws + WS_W13) + (size_t)L * 16 * D * D * 2; S.K = D; S.bstride = (size_t)D * D * 2; S.tab = tab; S.list = (const int*)(ws + WS_LIST); S.RT = RT; S.nwg = RT * 4; S.G = G; S.c = bx;
            pg8::EpiMoe1 E{(bf16*)(ws + WS_BIG + BG_HB)};
            pg8::gemm_phase<pg8::EpiMoe1, pg8::MoeOrder, true>(lds, tid, D, S, E);
        }
        SEAM(pb + 5);
        if (IN(pb + 6)) {
            PH_ENTRY; KArgs A = kargs(); unsigned char* ws = A->ws;
            const int RT = build_moe_table((unsigned*)(ws + WS_CTL) + CW_CNT + L * 16 * 64, tab, tid);
            pg8::MoeOrder S; S.A = (const char*)(ws + WS_BIG + BG_HB); S.B = (const char*)(ws + WS_W2) + (size_t)L * 16 * D * DEXP * 2; S.K = DEXP; S.bstride = (size_t)D * DEXP * 2; S.tab = tab; S.list = (const int*)(ws + WS_LIST); S.RT = RT; S.nwg = RT * 4; S.G = G; S.c = bx;
            pg8::EpiBf16 E{(bf16*)(ws + WS_BIG + BG_YB), D};
            pg8::gemm_phase<pg8::EpiBf16, pg8::MoeOrder, false>(lds, tid, DEXP, S, E);
        }
        SEAM(pb + 6);
        if (IN(pb + 7)) { PH_ENTRY; KArgs A = kargs(); unsigned char* ws = A->ws; const float* MODV = (const float*)(ws + WS_MODV);
            phase_combine(A->out, (float*)(ws + WS_CTX), MODV + (size_t)L * 9 * 6144, (const bf16*)(ws + WS_BIG + BG_YB), (unsigned*)(ws + WS_CTL) + CW_CNT + L * 16 * 64, (const int*)(ws + WS_TOKI), (const float*)(ws + WS_TOKW),
                          lastL, lastL ? A->final_g : A->norm_g + ((L + 1) * 2) * D, MODV + (size_t)(lastL ? L : L + 1) * 9 * 6144, (bf16*)(ws + WS_H), nrows, lane, wave, vcu, G); }
        if (!lastL) SEAM(pb + 7);
    }
#undef IN
#undef SEAM
#undef PH_ENTRY
}

extern "C" void kernel_launch(void* const* d_in, const int* in_sizes, int n_in, void* d_out, int out_size, void* d_ws, size_t ws_size, hipStream_t stream) {
    static int ready = 0;
    if (ready == 0) {
        if (n_in != 23 || out_size != TX * D || ws_size < WS_END) { fprintf(stderr, "kernel_launch: unexpected shapes (n_in %d out %d ws %zu)\n", n_in, out_size, ws_size); ready = -1; return; }
        if (hipFuncSetAttribute((const void*)fwd, hipFuncAttributeMaxDynamicSharedMemorySize, LDS_BYTES) != hipSuccess) { fprintf(stderr, "kernel_launch: hipFuncSetAttribute failed\n"); ready = -1; return; }
        int per_cu = 0; (void)hipOccupancyMaxActiveBlocksPerMultiprocessor(&per_cu, (const void*)fwd, 512, LDS_BYTES); (void)hipGetLastError();
        if (per_cu < 1) fprintf(stderr, "kernel_launch: occupancy query reports %d blocks per CU\n", per_cu);
        ready = 1;
    }
    if (ready < 0) return;
    (void)hipMemsetAsync((char*)d_ws + WS_CTL, 0, CTL_ZERO_BYTES, stream);
    Args a{};
    const float** ap = (const float**)&a;
    for (int i = 0; i < 23; ++i) ap[i] = (const float*)d_in[i];
    a.out = (float*)d_out; a.ws = (unsigned char*)d_ws;
    const int grid = 256;
#if MK_MULTI
    for (int k = 0; k < N_PHASES; ++k) { a.ph_lo = k; a.ph_hi = k + 1; hipLaunchKernelGGL(fwd, dim3(grid), dim3(512), LDS_BYTES, stream, a); }
#else
    a.ph_lo = 0; a.ph_hi = N_PHASES;
    hipLaunchKernelGGL(fwd, dim3(grid), dim3(512), LDS_BYTES, stream, a);
#endif
}
```

```cpp
#include <hip/hip_runtime.h>
#include <cstdio>
#include <cstdint>

#ifndef MK_MULTI
#define MK_MULTI 0
#endif

#define GAS __attribute__((address_space(1)))
#define LAS __attribute__((address_space(3)))
typedef unsigned short bf16;
typedef short bf16x8 __attribute__((ext_vector_type(8)));
typedef short bf16x4 __attribute__((ext_vector_type(4)));
typedef float f32x4 __attribute__((ext_vector_type(4)));
typedef float f32x2 __attribute__((ext_vector_type(2)));
typedef unsigned u32x4 __attribute__((ext_vector_type(4)));
typedef unsigned u32x2 __attribute__((ext_vector_type(2)));

constexpr int D = 1024, NB = 8, SEQ = 2048, CTXL = 256;
constexpr int TX = NB * SEQ, TC = NB * CTXL, TALL = TX + TC;
constexpr int NKEY = SEQ + CTXL;
constexpr int NATT = 3072, NGLA = 3328;
constexpr float EPSF = 1e-6f;
constexpr float LOG2E = 1.4426950408889634f;
constexpr int NEXP = 16, DEXP = 512;
constexpr int RT_MAX = 160;

constexpr size_t MiB = 1u << 20;
constexpr size_t WS_CTL = 0, CTL_ZERO_BYTES = 1 * MiB;
constexpr size_t WS_MODV = 1 * MiB;
constexpr size_t WS_TOKI = 2 * MiB;
constexpr size_t WS_TOKW = 2 * MiB + 512 * 1024;
constexpr size_t WS_LIST = 3 * MiB;
constexpr size_t WS_CTX = 5 * MiB;
constexpr size_t WS_WATTIN = 13 * MiB;
constexpr size_t WS_WATTOUT = 25 * MiB;
constexpr size_t WS_WGLAIN = 29 * MiB;
constexpr size_t WS_WGLAOUT = 42 * MiB;
constexpr size_t WS_W13 = 46 * MiB;
constexpr size_t WS_W2 = 174 * MiB;
constexpr size_t WS_H = 238 * MiB;
constexpr size_t WS_AOUT = 274 * MiB;
constexpr size_t WS_BIG = 310 * MiB;
constexpr size_t WS_END = 535 * MiB;
constexpr size_t BG_QKV = 0;
constexpr size_t BG_VAT = 108 * MiB;
constexpr size_t BG_VBT = 126 * MiB;
constexpr size_t BG_QKV2 = 0;
constexpr size_t BG_VGT = 117 * MiB;
constexpr size_t BG_OF = 153 * MiB;
constexpr size_t BG_OB = 189 * MiB;
constexpr size_t BG_HB = 0;
constexpr size_t BG_YB = 40 * MiB;
constexpr int CW_TMO = 0;
constexpr int CW_BAR = 4096;
constexpr int CW_CNT = 8192;

constexpr int RING_BYTES = 131072;
constexpr int LX_OFF = RING_BYTES;
constexpr int LX_MISC = LX_OFF;
constexpr int LX_MOETAB = LX_OFF + 256;
constexpr int LX_ROPE = LX_OFF + 2048;
constexpr int LX_BIAS = LX_OFF + 2048 + 8192;
constexpr int LDS_BYTES = 147456;

#define LDS_WAIT() asm volatile("s_waitcnt lgkmcnt(0)" ::: "memory")
#define VM_WAIT() asm volatile("s_waitcnt vmcnt(0)" ::: "memory")
#define RLX_AGENT __ATOMIC_RELAXED, __HIP_MEMORY_SCOPE_AGENT
__device__ __forceinline__ unsigned f2bf(float f) { unsigned u = __builtin_bit_cast(unsigned, f); return (u + 0x7fffu + ((u >> 16) & 1u)) >> 16; }
__device__ __forceinline__ unsigned pk2(float lo, float hi) { return f2bf(lo) | (f2bf(hi) << 16); }
__device__ __forceinline__ float bf2f(unsigned short b) { return __builtin_bit_cast(float, ((unsigned)b) << 16); }
__device__ __forceinline__ float bflo(unsigned w) { return __builtin_bit_cast(float, w << 16); }
__device__ __forceinline__ float bfhi(unsigned w) { return __builtin_bit_cast(float, w & 0xffff0000u); }
__device__ __forceinline__ float wave_sum(float v) {
#pragma unroll
    for (int o = 1; o < 64; o <<= 1) v += __shfl_xor(v, o);
    return v;
}
__device__ __forceinline__ float fexp2(float x) { return __builtin_amdgcn_exp2f(x); }
__device__ __forceinline__ float fexp(float x) { return __builtin_amdgcn_exp2f(x * LOG2E); }
__device__ __forceinline__ float flog(float x) { return __builtin_amdgcn_logf(x) * 0.6931471805599453f; }
__device__ __forceinline__ float frcp(float x) { return __builtin_amdgcn_rcpf(x); }
__device__ __forceinline__ float silu_f(float x) { return x * frcp(1.0f + fexp(-x)); }

#define XB_TMO      128
#define XB_XCNT(j)  (256  + 64 * (j))
#define XB_XSUB(j)  (1280 + 64 * (j))
#define XB_XGEN(j)  (2304 + 64 * (j))
#define XB_TOP      3328
#define XB_TOPGEN   3392
#define XCD_BAR_WORDS 3456
#define XB_SPIN_CAP (1u << 18)
__device__ __forceinline__ unsigned xb_ld(unsigned* p)              { return __hip_atomic_load(p, __ATOMIC_RELAXED, __HIP_MEMORY_SCOPE_AGENT); }
__device__ __forceinline__ unsigned xb_add(unsigned* p, unsigned v) { return __hip_atomic_fetch_add(p, v, __ATOMIC_RELAXED, __HIP_MEMORY_SCOPE_AGENT); }
__device__ __forceinline__ unsigned xb_xcc_id() { return (unsigned)__builtin_amdgcn_s_getreg((3 << 11) | 20) & 0xFu; }
#define XB_SPIN(cond, bar) do { unsigned _sp = 0; while (cond) { __builtin_amdgcn_s_sleep(1); \
    if ((++_sp & 255u) == 0u) { if (xb_ld(&(bar)[XB_TMO])) break; if (_sp > XB_SPIN_CAP) { atomicAdd(&(bar)[XB_TMO], 1u); break; } } } } while (0)
struct XcdBarrier { unsigned* bar; unsigned x; volatile LAS unsigned* st; };
__device__ __forceinline__ XcdBarrier xcd_barrier_post(unsigned* bar, volatile LAS unsigned* st) {
    XcdBarrier b; b.bar = bar; b.x = xb_xcc_id(); b.st = st;
    if (threadIdx.x == 0) (void)xb_add(&bar[XB_XCNT(b.x)], 1u);
    return b;
}
__device__ __forceinline__ void xcd_barrier_complete(unsigned* bar, unsigned x, unsigned& nloc, unsigned& nx) {
    const unsigned G = gridDim.x * gridDim.y * gridDim.z;
    unsigned sum, cnt, mine, sp = 0u;
    for (;;) {
        sum = 0u; cnt = 0u; mine = 0u;
#pragma unroll
        for (unsigned j = 0; j < 16; ++j) { const unsigned c = xb_ld(&bar[XB_XCNT(j)]); sum += c; cnt += (c > 0u) ? 1u : 0u; mine = (j == x) ? c : mine; }
        if (sum == G) break;
        __builtin_amdgcn_s_sleep(1);
        if ((++sp & 255u) == 0u) { if (xb_ld(&bar[XB_TMO])) break; if (sp > XB_SPIN_CAP) { atomicAdd(&bar[XB_TMO], 1u); break; } }
    }
    nloc = mine > 0u ? mine : 1u; nx = cnt > 0u ? cnt : 1u;
}
__device__ __forceinline__ void xcd_barrier(const XcdBarrier& b) {
    asm volatile("s_waitcnt vmcnt(0)" ::: "memory");
    __syncthreads();
    if (threadIdx.x == 0) {
        unsigned* bar = b.bar;
        __builtin_amdgcn_s_waitcnt(0);
        unsigned nloc = b.st[0], nx = b.st[1];
        if (nloc == 0u) { xcd_barrier_complete(bar, b.x, nloc, nx); b.st[0] = nloc; b.st[1] = nx; }
        const unsigned old = xb_add(&bar[XB_XSUB(b.x)], 1u);
        const unsigned gen = old / nloc;
        if (old + 1u == (gen + 1u) * nloc) {
            __builtin_amdgcn_fence(__ATOMIC_RELEASE, "agent");
            asm volatile("s_waitcnt vmcnt(0)" ::: "memory");
            const unsigned og = xb_add(&bar[XB_TOP], 1u);
            const unsigned tg = og / nx;
            if (og + 1u == (tg + 1u) * nx) xb_add(&bar[XB_TOPGEN], 1u);
            else XB_SPIN(xb_ld(&bar[XB_TOPGEN]) == tg, bar);
            __builtin_amdgcn_fence(__ATOMIC_ACQUIRE, "agent");
            xb_add(&bar[XB_XGEN(b.x)], 1u);
            asm volatile("s_waitcnt vmcnt(0)" ::: "memory");
        } else {
            XB_SPIN(xb_ld(&bar[XB_XGEN(b.x)]) == gen, bar);
            __builtin_amdgcn_fence(__ATOMIC_ACQUIRE, "agent");
            asm volatile("s_waitcnt vmcnt(0)" ::: "memory");
        }
    }
    __syncthreads();
}

namespace pg8 {
constexpr int BM = 256, BK = 64, HALF = 128, HTB = HALF * BK * 2, STAGE_BYTES = 8 * HTB, NXCD = 8, WGM = 8;
__host__ __device__ __forceinline__ int lds_byte(int r, int c) { const int st = (r >> 4) * 2 + (c >> 5), rr = r & 15, cc = c & 31, ob = rr * 64 + cc * 2; return st * 1024 + (ob ^ (((ob >> 9) & 1) << 5)); }
__host__ __device__ __forceinline__ void stage_rc(int b, int& R, int& C) { const int st = b / 1024, sb = b % 1024, swz = sb ^ (((sb >> 9) & 1) << 5); R = (st >> 1) * 16 + swz / 64; C = (st & 1) * 32 + (swz % 64) / 2; }
__host__ __device__ __forceinline__ int perm32(int rho) { const int n = rho >> 4, i = rho & 15; return 8 * (i >> 2) + 4 * n + (i & 3); }

struct Unit { int pm, pn, e, mt; };

__device__ __forceinline__ int xcd_remap(int wgid, int nwg) { const int q = nwg / NXCD, r = nwg % NXCD, xcd = wgid % NXCD, off = wgid / NXCD; return (xcd < r ? xcd * (q + 1) : r * (q + 1) + (xcd - r) * q) + off; }

struct DenseOrder {
    const char* A; const char* B; int K; int nM, nN, nwg, G, c;
    __device__ __forceinline__ void init(const bf16* A_, const bf16* B_, int M, int N, int K_, int G_, int c_) { A = (const char*)A_; B = (const char*)B_; K = K_; nM = M / BM; nN = N / BM; nwg = nM * nN; G = G_; c = c_; }
    __device__ __forceinline__ bool next(int i, Unit& u) const {
        const long L = (long)i * G + c; if (L >= nwg) return false;
        const int wgid = xcd_remap((int)L, nwg);
        const int nig = WGM * nN, gid = wgid / nig, fm = gid * WGM, gsz = (nM - fm) < WGM ? (nM - fm) : WGM;
        u.pm = fm + ((wgid % nig) % gsz); u.pn = (wgid % nig) / gsz; u.e = 0; u.mt = 0; return true;
    }
    __device__ __forceinline__ const char* a_ptr(const Unit& u) const { return A + (size_t)u.pm * BM * K * 2; }
    __device__ __forceinline__ const char* b_ptr(const Unit& u) const { return B + (size_t)u.pn * BM * K * 2; }
    __device__ __forceinline__ int tok(const Unit&, int) const { return 0; }
};
struct MoeOrder {
    const char* A; const char* B; int K; size_t bstride;
    const LAS int* tab; const int* list; int RT, nwg, G, c;
    __device__ __forceinline__ bool next(int i, Unit& u) const {
        const long L = (long)i * G + c; if (L >= nwg) return false;
        const int wgid = xcd_remap((int)L, nwg);
        const int rt = wgid >> 2; u.pm = rt; u.pn = wgid & 3; const int t = tab[rt]; u.e = t & 255; u.mt = t >> 8; return true;
    }
    __device__ __forceinline__ const char* a_ptr(const Unit& u) const { return A + (size_t)u.pm * BM * K * 2; }
    __device__ __forceinline__ const char* b_ptr(const Unit& u) const { return B + (size_t)u.e * bstride + (size_t)u.pn * BM * K * 2; }
    __device__ __forceinline__ int tok(const Unit& u, int r) const { const int cnt = tab[RT_MAX + 1 + u.e]; const int pos = u.mt * BM + r; return pos < cnt ? list[(size_t)u.e * TALL + pos] : 0; }
};

__device__ __forceinline__ unsigned cvt_pk_bf16(float lo, float hi) { unsigned r; asm volatile("v_cvt_pk_bf16_f32 %0, %1, %2" : "=v"(r) : "v"(lo), "v"(hi)); return r; }

template <class Epi, class Sched, bool GATHER>
__device__ __forceinline__ void gemm_phase(LAS unsigned char* lds, const int tid, const int K, const Sched& S, const Epi& E) {
    const int wid = __builtin_amdgcn_readfirstlane(tid >> 6), lane = tid & 63, wr = wid >> 2, wc = wid & 3, fr = lane & 15, fq = lane >> 4;
    const int nt = K / BK;
    unsigned voffA[2], voffB[2]; int RA[2], CA[2];
#pragma unroll
    for (int i = 0; i < 2; ++i) { int R, C; stage_rc(tid * 16 + i * 8192, R, C); const int Rb = Epi::PERM ? ((R & ~31) + perm32(R & 31)) : R;
        RA[i] = R; CA[i] = C; voffA[i] = (unsigned)(R * K + C) * 2u; voffB[i] = (unsigned)(Rb * K + C) * 2u; }
    const size_t kstep = (size_t)(BK * 2);
    const size_t hstep = (size_t)HALF * K * 2;
    const unsigned ldsw = (unsigned)wid * 1024u;
    const int aoff = lds_byte(wr * 64 + fr, fq * 8), boff = lds_byte(wc * 32 + fr, fq * 8);
#define PG8_SA(b, h) (((b) * 2 + (h)) * HTB)
#define PG8_SB(b, h) ((4 + (b) * 2 + (h)) * HTB)
#define PG8_STAGE(bufoff, gbase, voff) do { _Pragma("unroll") for (int _i = 0; _i < 2; ++_i) \
        __builtin_amdgcn_global_load_lds((const unsigned*)((const char*)(gbase) + (voff)[_i]), (LAS unsigned*)(lds + (bufoff) + ldsw + _i * 8192), 16, 0, 0); } while (0)
#define PG8_STAGE_A(bufoff, h, usenext, koff) do { if constexpr (GATHER) { unsigned _vo[2]; _vo[0] = (usenext) ? nvA[h][0] : vA[h][0]; _vo[1] = (usenext) ? nvA[h][1] : vA[h][1]; PG8_STAGE(bufoff, S.A + (koff), _vo); } \
        else { PG8_STAGE(bufoff, ((usenext) ? nA : cA) + (size_t)(h) * hstep + (koff), voffA); } } while (0)
#define PG8_LDA(dst, b, h) do { _Pragma("unroll") for (int m = 0; m < 4; ++m) _Pragma("unroll") for (int k = 0; k < 2; ++k) dst[m][k] = *(const LAS bf16x8*)(lds + PG8_SA(b, h) + aoff + m * 2048 + k * 1024); } while (0)
#define PG8_LDB(dst, b, h) do { _Pragma("unroll") for (int n = 0; n < 2; ++n) _Pragma("unroll") for (int k = 0; k < 2; ++k) dst[n][k] = *(const LAS bf16x8*)(lds + PG8_SB(b, h) + boff + n * 2048 + k * 1024); } while (0)
#define PG8_MMA(ai, bj, At, Bt) do { __builtin_amdgcn_s_setprio(1); _Pragma("unroll") for (int m = 0; m < 4; ++m) _Pragma("unroll") for (int n = 0; n < 2; ++n) _Pragma("unroll") for (int k = 0; k < 2; ++k) \
        acc[ai][bj][m][n] = __builtin_amdgcn_mfma_f32_16x16x32_bf16(Bt[n][k], At[m][k], acc[ai][bj][m][n], 0, 0, 0); __builtin_amdgcn_s_setprio(0); } while (0)
#define PG8_WAIT_V(n) asm volatile("s_waitcnt vmcnt(" #n ")" ::: "memory")
#define PG8_WAIT_L(n) asm volatile("s_waitcnt lgkmcnt(" #n ")" ::: "memory")
#define PG8_BAR __builtin_amdgcn_s_barrier()
#define PG8_SCHED __builtin_amdgcn_sched_barrier(0)
    Unit cur, nxt; int ui = 0;
    if (!S.next(0, cur)) return;
    f32x4 acc[2][2][4][2];
#pragma unroll
    for (int a = 0; a < 2; ++a)
#pragma unroll
        for (int b = 0; b < 2; ++b)
#pragma unroll
            for (int m = 0; m < 4; ++m)
#pragma unroll
                for (int n = 0; n < 2; ++n) acc[a][b][m][n] = (f32x4){0.f, 0.f, 0.f, 0.f};
    bf16x8 At[4][2], B0[2][2], B1[2][2];
    unsigned vA[2][2], nvA[2][2];
    if constexpr (GATHER) {
#pragma unroll
        for (int h = 0; h < 2; ++h)
#pragma unroll
            for (int i = 0; i < 2; ++i) { vA[h][i] = (unsigned)(S.tok(cur, h * HALF + RA[i]) * K + CA[i]) * 2u; nvA[h][i] = vA[h][i]; }
    }
    const char* cA = S.a_ptr(cur); const char* cB = S.b_ptr(cur); const char* nA = cA;
    PG8_STAGE(PG8_SB(0, 0), cB, voffB); PG8_STAGE(PG8_SB(0, 1), cB + hstep, voffB); PG8_STAGE_A(PG8_SA(0, 0), 0, false, 0); PG8_STAGE_A(PG8_SA(0, 1), 1, false, 0);
    if (wr == 1) PG8_BAR;
    PG8_WAIT_V(2); PG8_BAR;
    PG8_STAGE(PG8_SB(1, 0), cB + kstep, voffB); PG8_STAGE_A(PG8_SA(1, 0), 0, false, kstep); PG8_STAGE(PG8_SB(1, 1), cB + hstep + kstep, voffB);
    PG8_WAIT_V(6); PG8_BAR;
    for (;;) {
        const bool has_next = S.next(ui + 1, nxt);
        nA = has_next ? S.a_ptr(nxt) : cA; const char* nB = has_next ? S.b_ptr(nxt) : cB;
        if constexpr (GATHER) {
            if (has_next) {
#pragma unroll
                for (int h = 0; h < 2; ++h)
#pragma unroll
                    for (int i = 0; i < 2; ++i) nvA[h][i] = (unsigned)(S.tok(nxt, h * HALF + RA[i]) * K + CA[i]) * 2u;
            }
        }
        for (int t = 0; t < nt; t += 2) {
            const bool last = (t == nt - 2);
            const size_t k1 = (size_t)(t + 1) * kstep;
            const size_t k2 = last ? 0 : (size_t)(t + 2) * kstep, k3 = k2 + kstep;
            const char* b2 = last ? nB : cB + (size_t)(t + 2) * kstep; const char* b3 = b2 + kstep;
            PG8_LDB(B0, 0, 0); PG8_LDB(B1, 0, 1); PG8_SCHED; PG8_LDA(At, 0, 0); PG8_STAGE_A(PG8_SA(1, 1), 1, false, k1);
            PG8_WAIT_V(8); PG8_WAIT_L(0); PG8_BAR; PG8_MMA(0, 0, At, B0); PG8_MMA(0, 1, At, B1); PG8_BAR; PG8_SCHED;
            PG8_LDA(At, 0, 1); PG8_STAGE(PG8_SB(0, 0), b2, voffB); PG8_STAGE(PG8_SB(0, 1), b2 + hstep, voffB); PG8_STAGE_A(PG8_SA(0, 0), 0, last, k2);
            PG8_WAIT_V(8); PG8_WAIT_L(0); PG8_BAR; PG8_MMA(1, 0, At, B0); PG8_MMA(1, 1, At, B1); PG8_BAR; PG8_SCHED;
            PG8_LDB(B0, 1, 0); PG8_LDB(B1, 1, 1); PG8_SCHED; PG8_LDA(At, 1, 0); PG8_STAGE_A(PG8_SA(0, 1), 1, last, k2);
            PG8_WAIT_V(8); PG8_WAIT_L(0); PG8_BAR; PG8_MMA(0, 0, At, B0); PG8_MMA(0, 1, At, B1); PG8_BAR; PG8_SCHED;
            PG8_LDA(At, 1, 1); PG8_STAGE(PG8_SB(1, 0), b3, voffB); PG8_STAGE(PG8_SB(1, 1), b3 + hstep, voffB); PG8_STAGE_A(PG8_SA(1, 0), 0, last, k3);
            PG8_WAIT_V(8); PG8_WAIT_L(0); PG8_BAR; PG8_MMA(1, 0, At, B0); PG8_MMA(1, 1, At, B1); PG8_BAR; PG8_SCHED;
        }
        if (wr == 0) PG8_BAR;
        E(acc, cur, wr, wc, fr, fq);
        if (!has_next) break;
#pragma unroll
        for (int a = 0; a < 2; ++a)
#pragma unroll
            for (int b = 0; b < 2; ++b)
#pragma unroll
                for (int m = 0; m < 4; ++m)
#pragma unroll
                    for (int n = 0; n < 2; ++n) acc[a][b][m][n] = (f32x4){0.f, 0.f, 0.f, 0.f};
        cur = nxt; cA = nA; cB = nB; ++ui;
        if constexpr (GATHER) {
#pragma unroll
            for (int h = 0; h < 2; ++h)
#pragma unroll
                for (int i = 0; i < 2; ++i) vA[h][i] = nvA[h][i];
        }
        if (wr == 1) PG8_BAR;
    }
    PG8_WAIT_V(0);
    PG8_BAR;
#undef PG8_SA
#undef PG8_SB
#undef PG8_STAGE
#undef PG8_STAGE_A
#undef PG8_LDA
#undef PG8_LDB
#undef PG8_MMA
#undef PG8_WAIT_V
#undef PG8_WAIT_L
#undef PG8_BAR
#undef PG8_SCHED
}
}

namespace pg8 {
__device__ __forceinline__ void row_bt(int row, int& b, int& tok) { if (row < TX) { b = row >> 11; tok = row & 2047; } else { const int r = row - TX; b = r >> 8; tok = SEQ + (r & 255); } }

struct EpiAttnIn {
    static constexpr bool PERM = true;
    bf16* QKV; bf16* VAT; bf16* VBT; const LAS float* rope;
    __device__ __forceinline__ void operator()(const f32x4 (&acc)[2][2][4][2], const Unit& u, int wr, int wc, int fr, int fq) const {
        const int row0 = u.pm * BM + wr * 64 + fr; const int seg = u.pn >> 1;
        const bool latent = u.pm < (TX / BM);
        if (seg == 2 || seg == 5) {
#pragma unroll
            for (int ai = 0; ai < 2; ++ai)
#pragma unroll
                for (int m = 0; m < 4; ++m) { const int row = row0 + ai * HALF + m * 16; int b, tok; row_bt(row, b, tok);
#pragma unroll
                    for (int bj = 0; bj < 2; ++bj) { const int col = u.pn * BM + bj * HALF + wc * 32 + 8 * fq;
                        bf16* dst;
                        if (seg == 2) { const int cs = col - 1024; dst = VAT + ((size_t)(b * 4 + (cs >> 7)) * 128 + (cs & 127)) * NKEY + tok; }
                        else { const int cs = col - 2560; dst = VBT + ((size_t)(b * 8 + (cs >> 6)) * 64 + (cs & 63)) * NKEY + tok; }
#pragma unroll
                        for (int n = 0; n < 2; ++n)
#pragma unroll
                            for (int i = 0; i < 4; ++i) dst[(size_t)(4 * n + i) * NKEY] = (bf16)f2bf(acc[ai][bj][m][n][i]); } }
            return;
        }
        const bool dorope = latent && seg < 2;
        const float qs = (seg == 0 || seg == 3) ? 0.125f : 1.0f;
#pragma unroll
        for (int ai = 0; ai < 2; ++ai)
#pragma unroll
            for (int m = 0; m < 4; ++m) { const int row = row0 + ai * HALF + m * 16;
                f32x4 cs4[4];
                if (dorope) { const int t = row & 2047; const int pos = (wc & 1) ? (t & 63) : (t >> 6);
                    const LAS f32x4* rp = (const LAS f32x4*)(rope + (pos * 16 + 8 * (fq & 1)) * 2);
#pragma unroll
                    for (int j = 0; j < 4; ++j) cs4[j] = rp[j]; }
#pragma unroll
                for (int bj = 0; bj < 2; ++bj) { const int col = u.pn * BM + bj * HALF + wc * 32 + 8 * fq;
                    float v[8];
#pragma unroll
                    for (int n = 0; n < 2; ++n)
#pragma unroll
                        for (int i = 0; i < 4; ++i) v[4 * n + i] = acc[ai][bj][m][n][i];
                    if (dorope) {
#pragma unroll
                        for (int j = 0; j < 8; ++j) { const float other = __shfl_xor(v[j], 32); const float c = cs4[j >> 1][(j & 1) * 2], s = cs4[j >> 1][(j & 1) * 2 + 1];
                            v[j] = (fq < 2) ? (v[j] * c - other * s) : (v[j] * c + other * s); } }
                    u32x4 w; w.x = pk2(v[0] * qs, v[1] * qs); w.y = pk2(v[2] * qs, v[3] * qs); w.z = pk2(v[4] * qs, v[5] * qs); w.w = pk2(v[6] * qs, v[7] * qs);
                    *(u32x4*)(QKV + (size_t)row * NATT + col) = w; } }
    }
};
struct EpiGlaIn {
    static constexpr bool PERM = true;
    bf16* QKV2; bf16* VGT;
    __device__ __forceinline__ void operator()(const f32x4 (&acc)[2][2][4][2], const Unit& u, int wr, int wc, int fr, int fq) const {
        const int row0 = u.pm * BM + wr * 64 + fr;
        if (u.pn >= 4 && u.pn < 8) {
#pragma unroll
            for (int ai = 0; ai < 2; ++ai)
#pragma unroll
                for (int m = 0; m < 4; ++m) { const int row = row0 + ai * HALF + m * 16; int b, tok; row_bt(row, b, tok);
#pragma unroll
                    for (int bj = 0; bj < 2; ++bj) { const int cs = u.pn * BM + bj * HALF + wc * 32 + 8 * fq - 1024;
                        bf16* dst = VGT + ((size_t)(b * 4 + (cs >> 8)) * 256 + (cs & 255)) * NKEY + tok;
#pragma unroll
                        for (int n = 0; n < 2; ++n)
#pragma unroll
                            for (int i = 0; i < 4; ++i) dst[(size_t)(4 * n + i) * NKEY] = (bf16)f2bf(acc[ai][bj][m][n][i]); } }
            return;
        }
        const float qs = (u.pn < 2) ? 0.08838834764831845f : 1.0f;
#pragma unroll
        for (int ai = 0; ai < 2; ++ai)
#pragma unroll
            for (int m = 0; m < 4; ++m) { const int row = row0 + ai * HALF + m * 16;
#pragma unroll
                for (int bj = 0; bj < 2; ++bj) { const int col = u.pn * BM + bj * HALF + wc * 32 + 8 * fq; const f32x4 a = acc[ai][bj][m][0] * qs, c = acc[ai][bj][m][1] * qs;
                    u32x4 w; w.x = pk2(a[0], a[1]); w.y = pk2(a[2], a[3]); w.z = pk2(c[0], c[1]); w.w = pk2(c[2], c[3]);
                    *(u32x4*)(QKV2 + (size_t)row * NGLA + col) = w; } }
    }
};
struct EpiResid {
    static constexpr bool PERM = false;
    float* XL; float* XC; const float* modv;
    __device__ __forceinline__ void operator()(const f32x4 (&acc)[2][2][4][2], const Unit& u, int wr, int wc, int fr, int fq) const {
        const int row0 = u.pm * BM + wr * 64 + fr, col0 = u.pn * BM + wc * 32 + 4 * fq;
        const bool latent = u.pm < (TX / BM); const int bi = latent ? (u.pm >> 3) : 8;
        float* base = latent ? XL : (XC - (size_t)TX * D);
        f32x4 gv[2][2];
#pragma unroll
        for (int bj = 0; bj < 2; ++bj)
#pragma unroll
            for (int n = 0; n < 2; ++n) gv[bj][n] = *(const f32x4*)(modv + bi * 6144 + col0 + bj * HALF + n * 16);
#pragma unroll
        for (int ai = 0; ai < 2; ++ai)
#pragma unroll
            for (int m = 0; m < 4; ++m) { float* rowp = base + (size_t)(row0 + ai * HALF + m * 16) * D + col0;
#pragma unroll
                for (int bj = 0; bj < 2; ++bj)
#pragma unroll
                    for (int n = 0; n < 2; ++n) { f32x4* p = (f32x4*)(rowp + bj * HALF + n * 16); *p = *p + gv[bj][n] * acc[ai][bj][m][n]; } }
    }
};
struct EpiMoe1 {
    static constexpr bool PERM = false;
    bf16* HB;
    __device__ __forceinline__ void operator()(const f32x4 (&acc)[2][2][4][2], const Unit& u, int wr, int wc, int fr, int fq) const {
        const int row0 = u.pm * BM + wr * 64 + fr, col0 = u.pn * 128 + wc * 16 + 4 * fq;
#pragma unroll
        for (int ai = 0; ai < 2; ++ai)
#pragma unroll
            for (int m = 0; m < 4; ++m) { bf16* rowp = HB + (size_t)(row0 + ai * HALF + m * 16) * DEXP + col0;
#pragma unroll
                for (int bj = 0; bj < 2; ++bj) { const f32x4 a = acc[ai][bj][m][0], b = acc[ai][bj][m][1];
                    u32x2 w; w.x = pk2(silu_f(a[0]) * b[0], silu_f(a[1]) * b[1]); w.y = pk2(silu_f(a[2]) * b[2], silu_f(a[3]) * b[3]);
                    *(u32x2*)(rowp + bj * 64) = w; } }
    }
};
struct EpiBf16 {
    static constexpr bool PERM = true;
    bf16* O; int ldc;
    __device__ __forceinline__ void operator()(const f32x4 (&acc)[2][2][4][2], const Unit& u, int wr, int wc, int fr, int fq) const {
        const int row0 = u.pm * BM + wr * 64 + fr, col0 = u.pn * BM + wc * 32 + 8 * fq;
#pragma unroll
        for (int ai = 0; ai < 2; ++ai)
#pragma unroll
            for (int m = 0; m < 4; ++m) { bf16* rowp = O + (size_t)(row0 + ai * HALF + m * 16) * ldc + col0;
#pragma unroll
                for (int bj = 0; bj < 2; ++bj) { const f32x4 a = acc[ai][bj][m][0], c = acc[ai][bj][m][1];
                    u32x4 w; w.x = pk2(a[0], a[1]); w.y = pk2(a[2], a[3]); w.z = pk2(c[0], c[1]); w.w = pk2(c[2], c[3]);
                    *(u32x4*)(rowp + bj * HALF) = w; } }
    }
};
}

struct Args {
    const float *x, *c, *ctx, *c_ctx, *w_mod, *b_mod, *norm_g, *final_g, *att_w_in, *att_w_out, *att_lambda, *att_subln_g, *na_bias,
                *gla_w_in, *gla_w_gate, *gla_b_gate, *gla_norm_g, *gla_w_out, *router_w, *router_bias, *moe_w1, *moe_w3, *moe_w2;
    float* out; unsigned char* ws; int ph_lo, ph_hi;
};

struct RowMapId { int off; __device__ __forceinline__ int operator()(int n) const { return off + n; } };
struct RowMapMoe { int which; __device__ __forceinline__ int operator()(int n) const { return 32 * (n >> 4) + 16 * which + (n & 15); } };
template <class RM>
__device__ __forceinline__ void p0_transpose_item(const float* W, int K, int N, bf16* WT, LAS float* scr, int item, int lane, RM rm) {
    const int nblk = N / 32, kb = item / nblk, nb = item % nblk, k0 = 64 * kb, n0 = 32 * nb;
#pragma unroll 8
    for (int i = 0; i < 32; ++i) { const int kk = 2 * i + (lane >> 5); scr[kk * 33 + (lane & 31)] = W[(size_t)(k0 + kk) * N + n0 + (lane & 31)]; }
    LDS_WAIT(); asm volatile("" ::: "memory");
    const int c = lane & 7;
#pragma unroll
    for (int j = 0; j < 4; ++j) { const int n = (lane >> 3) + 8 * j; const LAS float* s = scr + (8 * c) * 33 + n;
        u32x4 o; o.x = pk2(s[0 * 33], s[1 * 33]); o.y = pk2(s[2 * 33], s[3 * 33]); o.z = pk2(s[4 * 33], s[5 * 33]); o.w = pk2(s[6 * 33], s[7 * 33]);
        *(u32x4*)(WT + (size_t)rm(n0 + n) * K + k0 + 8 * c) = o; }
    LDS_WAIT(); asm volatile("" ::: "memory");
}

template <class AP> __device__ __forceinline__ void p0_prologue(const AP ap, LAS unsigned char* lds, int tid, int lane, int wave, int vcu, int G) {
    const Args a = Args{ap->x, ap->c, ap->ctx, ap->c_ctx, ap->w_mod, ap->b_mod, ap->norm_g, ap->final_g, ap->att_w_in, ap->att_w_out, ap->att_lambda, ap->att_subln_g, ap->na_bias, ap->gla_w_in, ap->gla_w_gate, ap->gla_b_gate, ap->gla_norm_g, ap->gla_w_out, ap->router_w, ap->router_bias, ap->moe_w1, ap->moe_w3, ap->moe_w2, ap->out, ap->ws, 0, 0};
    unsigned char* ws = a.ws;
    LAS float* scr = (LAS float*)(lds + wave * 8448);
    LAS float* S9 = (LAS float*)(lds + 69632);
    LAS float* red = (LAS float*)(lds + 106496);
    const int gw = vcu * 8 + wave, NGW = G * 8;
    constexpr int I_AIN = 16 * 96, I_AOUT = 16 * 32, I_GIN = 16 * 97, I_GOUT = 16 * 32, I_W1 = 16 * 16, I_W2 = 8 * 32;
    constexpr int N_A = 2 * I_AIN, N_B = N_A + 2 * I_AOUT, N_C = N_B + 2 * I_GIN, N_D = N_C + 2 * I_GOUT, N_E = N_D + 64 * I_W1, N_F = N_E + 64 * I_W1, N_G = N_F + 64 * I_W2;
    for (int it = gw; it < N_G; it += NGW) {
        if (it < N_A) { const int j = it / I_AIN, r = it % I_AIN; p0_transpose_item(a.att_w_in + (size_t)j * D * NATT, D, NATT, (bf16*)(ws + WS_WATTIN) + (size_t)j * NATT * D, scr, r, lane, RowMapId{0}); }
        else if (it < N_B) { const int q = it - N_A, j = q / I_AOUT, r = q % I_AOUT; p0_transpose_item(a.att_w_out + (size_t)j * D * D, D, D, (bf16*)(ws + WS_WATTOUT) + (size_t)j * D * D, scr, r, lane, RowMapId{0}); }
        else if (it < N_C) { const int q = it - N_B, j = q / I_GIN, r = q % I_GIN; p0_transpose_item(a.gla_w_in + (size_t)j * D * 3104, D, 3104, (bf16*)(ws + WS_WGLAIN) + (size_t)j * NGLA * D, scr, r, lane, RowMapId{0}); }
        else if (it < N_D) { const int q = it - N_C, j = q / I_GOUT, r = q % I_GOUT; p0_transpose_item(a.gla_w_out + (size_t)j * D * D, D, D, (bf16*)(ws + WS_WGLAOUT) + (size_t)j * D * D, scr, r, lane, RowMapId{0}); }
        else if (it < N_E) { const int q = it - N_D, j = q / I_W1, r = q % I_W1; p0_transpose_item(a.moe_w1 + (size_t)j * D * DEXP, D, DEXP, (bf16*)(ws + WS_W13) + (size_t)j * D * D, scr, r, lane, RowMapMoe{0}); }
        else if (it < N_F) { const int q = it - N_E, j = q / I_W1, r = q % I_W1; p0_transpose_item(a.moe_w3 + (size_t)j * D * DEXP, D, DEXP, (bf16*)(ws + WS_W13) + (size_t)j * D * D, scr, r, lane, RowMapMoe{1}); }
        else { const int q = it - N_F, j = q / I_W2, r = q % I_W2; p0_transpose_item(a.moe_w2 + (size_t)j * DEXP * D, DEXP, D, (bf16*)(ws + WS_W2) + (size_t)j * D * DEXP, scr, r, lane, RowMapId{0}); }
    }
    { const int gt = vcu * 512 + tid, NT = G * 512;
      for (int i = gt; i < 2 * 28672; i += NT) { const int j = i / 28672, r = i % 28672; *(u32x4*)((bf16*)(ws + WS_WGLAIN) + (size_t)j * NGLA * D + (size_t)3104 * D + (size_t)r * 8) = (u32x4){0u, 0u, 0u, 0u}; }
      const f32x4* xs = (const f32x4*)a.x; f32x4* xo = (f32x4*)a.out;
      for (int i = gt; i < TX * D / 4; i += NT) xo[i] = xs[i];
      const f32x4* cs = (const f32x4*)a.ctx; f32x4* co = (f32x4*)(ws + WS_CTX);
      for (int i = gt; i < TC * D / 4; i += NT) co[i] = cs[i];
    }
    __syncthreads();
    for (int i = tid; i < 9 * 1024; i += 512) { const int bi = i >> 10, k = i & 1023; const float v = (bi < 8) ? a.c[bi * D + k] : a.c_ctx[k]; S9[i] = v / (1.0f + __expf(-v)); }
    __syncthreads();
    for (int u = vcu; u < 4 * 96; u += G) {
        const int L = u / 96, n0 = (u % 96) * 64;
        const float* W = a.w_mod + (size_t)L * D * 6144 + n0 + lane;
        float acc[9];
#pragma unroll
        for (int bi = 0; bi < 9; ++bi) acc[bi] = 0.f;
        const int kb = wave * 128;
#pragma unroll 8
        for (int k = 0; k < 128; ++k) { const float w = W[(size_t)(kb + k) * 6144];
#pragma unroll
            for (int bi = 0; bi < 9; ++bi) acc[bi] += S9[bi * 1024 + kb + k] * w; }
#pragma unroll
        for (int bi = 0; bi < 9; ++bi) red[(wave * 9 + bi) * 64 + lane] = acc[bi];
        __syncthreads();
        for (int i = tid; i < 9 * 64; i += 512) { const int bi = i >> 6, l = i & 63; float s = a.b_mod[L * 6144 + n0 + l];
#pragma unroll
            for (int w = 0; w < 8; ++w) s += red[(w * 9 + bi) * 64 + l];
            ((float*)(ws + WS_MODV))[(size_t)(L * 9 + bi) * 6144 + n0 + l] = s; }
        __syncthreads();
    }
}

__device__ __forceinline__ float* xrow_ptr(float* XL, float* XC, int row) { return row < TX ? XL + (size_t)row * D : XC + (size_t)(row - TX) * D; }
__device__ __forceinline__ int row_bi(int row) { return row < TX ? (row >> 11) : 8; }

__device__ __forceinline__ void norm_mod_store(const f32x4 (&v)[4], const float* g, const float* sh, const float* sc, bf16* orow, int lane) {
    float ss = 0.f;
#pragma unroll
    for (int j = 0; j < 4; ++j) ss += (v[j].x * v[j].x + v[j].y * v[j].y) + (v[j].z * v[j].z + v[j].w * v[j].w);
    const float rs = __builtin_amdgcn_rsqf(wave_sum(ss) * (1.0f / D) + EPSF);
#pragma unroll
    for (int j = 0; j < 4; ++j) { const int c = 4 * lane + 256 * j; const f32x4 gg = *(const f32x4*)(g + c), s1 = *(const f32x4*)(sc + c), s0 = *(const f32x4*)(sh + c);
        const f32x4 y = (v[j] * rs) * gg * (1.0f + s1) + s0;
        u32x2 w; w.x = pk2(y.x, y.y); w.y = pk2(y.z, y.w); *(u32x2*)(orow + c) = w; }
}

__device__ __forceinline__ void phase_norm1(float* XL, float* XC, const float* g, const float* modv, bf16* H, int nrows, int lane, int wave, int vcu, int G) {
    for (int row = vcu * 8 + wave; row < nrows; row += G * 8) {
        const f32x4* xr = (const f32x4*)xrow_ptr(XL, XC, row) + lane; f32x4 v[4];
#pragma unroll
        for (int j = 0; j < 4; ++j) v[j] = xr[64 * j];
        const float* mv = modv + row_bi(row) * 6144;
        norm_mod_store(v, g, mv, mv + 1024, H + (size_t)row * D, lane);
    }
}

__device__ __forceinline__ void phase_router(float* XL, float* XC, const float* g, const float* modv, bf16* H, const float* router_w, const float* router_bias,
                                             unsigned* cnt  , int* list, int* toki, float* tokw, int nrows,
                                             LAS unsigned char* lds, int tid, int lane, int wave, int vcu, int G) {
    LAS float* RW = (LAS float*)lds;
    LAS int* lcnt = (LAS int*)(lds + 65536);
    LAS int* rinfo = (LAS int*)(lds + 65536 + 256);
    for (int i = tid; i < 16 * 1024; i += 512) { const int e = i >> 10, k = i & 1023; RW[i] = router_w[k * 16 + e]; }
    if (tid < 32) lcnt[tid] = 0;
    __syncthreads();
    const int rpb = nrows / G, rpw = rpb / 8;
    for (int i = 0; i < rpw; ++i) {
        const int rl = wave * rpw + i, row = vcu * rpb + rl;
        const f32x4* xr = (const f32x4*)xrow_ptr(XL, XC, row) + lane; f32x4 v[4];
#pragma unroll
        for (int j = 0; j < 4; ++j) v[j] = xr[64 * j];
        const float* mv = modv + row_bi(row) * 6144 + 3072;
        float ss = 0.f;
#pragma unroll
        for (int j = 0; j < 4; ++j) ss += (v[j].x * v[j].x + v[j].y * v[j].y) + (v[j].z * v[j].z + v[j].w * v[j].w);
        const float rs = __builtin_amdgcn_rsqf(wave_sum(ss) * (1.0f / D) + EPSF);
        f32x4 y[4];
#pragma unroll
        for (int j = 0; j < 4; ++j) { const int c = 4 * lane + 256 * j; const f32x4 gg = *(const f32x4*)(g + c), s1 = *(const f32x4*)(mv + 1024 + c), s0 = *(const f32x4*)(mv + c);
            y[j] = (v[j] * rs) * gg * (1.0f + s1) + s0;
            u32x2 w; w.x = pk2(y[j].x, y[j].y); w.y = pk2(y[j].z, y[j].w); *(u32x2*)(H + (size_t)row * D + c) = w; }
        float lg[16];
#pragma unroll
        for (int e = 0; e < 16; ++e) { float s = 0.f;
#pragma unroll
            for (int j = 0; j < 4; ++j) { const f32x4 w = *(const LAS f32x4*)(RW + e * 1024 + 4 * lane + 256 * j); s += (y[j].x * w.x + y[j].y * w.y) + (y[j].z * w.z + y[j].w * w.w); }
            lg[e] = wave_sum(s); }
        float sc[16], sel[16];
#pragma unroll
        for (int e = 0; e < 16; ++e) { sc[e] = 1.0f / (1.0f + __expf(-lg[e])); sel[e] = sc[e] + router_bias[e]; }
        int bg = 0; float bgs = -1e30f;
#pragma unroll
        for (int gI = 0; gI < 4; ++gI) { float m1 = -1e30f, m2 = -1e30f;
#pragma unroll
            for (int q = 0; q < 4; ++q) { const float t = sel[gI * 4 + q]; if (t > m1) { m2 = m1; m1 = t; } else if (t > m2) m2 = t; }
            const float gs = m1 + m2; if (gs > bgs) { bgs = gs; bg = gI; } }
        int e0 = 0, e1 = 0; float s0 = -1e30f, s1 = -1e30f, w0 = 0.f, w1 = 0.f;
#pragma unroll
        for (int e = 0; e < 16; ++e) { if ((e >> 2) == bg) { const float t = sel[e];
                if (t > s0) { s1 = s0; e1 = e0; w1 = w0; s0 = t; e0 = e; w0 = sc[e]; } else if (t > s1) { s1 = t; e1 = e; w1 = sc[e]; } } }
        const float wn = 1.0f / (w0 + w1);
        if (lane == 0) { const int p0 = __hip_atomic_fetch_add(&lcnt[e0], 1, __ATOMIC_RELAXED, __HIP_MEMORY_SCOPE_WORKGROUP), p1 = __hip_atomic_fetch_add(&lcnt[e1], 1, __ATOMIC_RELAXED, __HIP_MEMORY_SCOPE_WORKGROUP);
            rinfo[rl * 6 + 0] = e0; rinfo[rl * 6 + 1] = p0; rinfo[rl * 6 + 2] = e1; rinfo[rl * 6 + 3] = p1;
            rinfo[rl * 6 + 4] = __builtin_bit_cast(int, w0 * wn); rinfo[rl * 6 + 5] = __builtin_bit_cast(int, w1 * wn); }
    }
    __syncthreads();
    if (tid < 16) lcnt[16 + tid] = (int)__hip_atomic_fetch_add(cnt + 64 * tid, (unsigned)lcnt[tid], RLX_AGENT);
    __syncthreads();
    if (tid < rpb) { const int row = vcu * rpb + tid; const int e0 = rinfo[tid * 6 + 0], e1 = rinfo[tid * 6 + 2];
        const int p0 = lcnt[16 + e0] + rinfo[tid * 6 + 1], p1 = lcnt[16 + e1] + rinfo[tid * 6 + 3];
        list[(size_t)e0 * TALL + p0] = row; list[(size_t)e1 * TALL + p1] = row;
        toki[row * 4 + 0] = e0; toki[row * 4 + 1] = p0; toki[row * 4 + 2] = e1; toki[row * 4 + 3] = p1;
        tokw[row * 2 + 0] = __builtin_bit_cast(float, rinfo[tid * 6 + 4]); tokw[row * 2 + 1] = __builtin_bit_cast(float, rinfo[tid * 6 + 5]); }
    __syncthreads();
}

__device__ __forceinline__ int build_moe_table(const unsigned* cnt, LAS int* tab, int tid) {
    if (tid == 0) { int rt = 0;
        for (int e = 0; e < 16; ++e) { const int c = (int)__hip_atomic_load(cnt + 64 * e, RLX_AGENT); tab[RT_MAX + 1 + e] = c; const int nt = (c + 255) >> 8;
            for (int m = 0; m < nt; ++m) { if (rt < RT_MAX) tab[rt] = e | (m << 8); ++rt; } }
        tab[RT_MAX] = rt < RT_MAX ? rt : RT_MAX; }
    __syncthreads();
    return tab[RT_MAX];
}

__device__ __forceinline__ void phase_combine(float* XL, float* XC, const float* modv  , const bf16* YB, const unsigned* cnt, const int* toki, const float* tokw,
                                              bool final_layer, const float* gnext, const float* modv_next, bf16* H, int nrows, int lane, int wave, int vcu, int G) {
    int tiles = 0; if (lane < 16) tiles = ((int)__hip_atomic_load(cnt + 64 * lane, RLX_AGENT) + 255) >> 8;
    int incl = tiles;
#pragma unroll
    for (int o = 1; o < 16; o <<= 1) { const int t = __shfl_up(incl, o); if (lane >= o) incl += t; }
    const int mybase = (incl - tiles) * 256;
    for (int row = vcu * 8 + wave; row < nrows; row += G * 8) {
        const int e0 = toki[row * 4 + 0], p0 = toki[row * 4 + 1], e1 = toki[row * 4 + 2], p1 = toki[row * 4 + 3];
        const float w0 = tokw[row * 2 + 0], w1 = tokw[row * 2 + 1];
        const int s0 = __shfl(mybase, e0) + p0, s1 = __shfl(mybase, e1) + p1;
        float* xp = xrow_ptr(XL, XC, row);
        const float* g2 = modv + row_bi(row) * 6144 + 5120;
        f32x4 v[4];
#pragma unroll
        for (int j = 0; j < 4; ++j) { const int c = 4 * lane + 256 * j;
            const u32x2 a = *(const u32x2*)(YB + (size_t)s0 * D + c), b = *(const u32x2*)(YB + (size_t)s1 * D + c);
            f32x4 y; y.x = w0 * bflo(a.x) + w1 * bflo(b.x); y.y = w0 * bfhi(a.x) + w1 * bfhi(b.x); y.z = w0 * bflo(a.y) + w1 * bflo(b.y); y.w = w0 * bfhi(a.y) + w1 * bfhi(b.y);
            v[j] = *(const f32x4*)(xp + c) + *(const f32x4*)(g2 + c) * y; }
        if (final_layer) {
            float ss = 0.f;
#pragma unroll
            for (int j = 0; j < 4; ++j) ss += (v[j].x * v[j].x + v[j].y * v[j].y) + (v[j].z * v[j].z + v[j].w * v[j].w);
            const float rs = __builtin_amdgcn_rsqf(wave_sum(ss) * (1.0f / D) + EPSF);
#pragma unroll
            for (int j = 0; j < 4; ++j) { const int c = 4 * lane + 256 * j; *(f32x4*)(xp + c) = (v[j] * rs) * *(const f32x4*)(gnext + c); }
        } else {
#pragma unroll
            for (int j = 0; j < 4; ++j) *(f32x4*)(xp + 4 * lane + 256 * j) = v[j];
            const float* mv = modv_next + row_bi(row) * 6144;
            norm_mod_store(v, gnext, mv, mv + 1024, H + (size_t)row * D, lane);
        }
    }
}

__device__ __forceinline__ void phase_readout(const bf16* OF, const bf16* OB, const bf16* QKV2, const float* ng, bf16* AOUT, int nrows, int lane, int wave, int vcu, int G) {
    const f32x4 gg = *(const f32x4*)(ng + 4 * lane);
    for (int row = vcu * 8 + wave; row < nrows; row += G * 8) {
#pragma unroll
        for (int j = 0; j < 4; ++j) { const int c = 4 * lane + 256 * j;
            const u32x2 a = *(const u32x2*)(OF + (size_t)row * D + c), b = *(const u32x2*)(OB + (size_t)row * D + c), gt = *(const u32x2*)(QKV2 + (size_t)row * NGLA + 2048 + c);
            f32x4 o; o.x = bflo(a.x) + bflo(b.x); o.y = bfhi(a.x) + bfhi(b.x); o.z = bflo(a.y) + bflo(b.y); o.w = bfhi(a.y) + bfhi(b.y);
            const float ss = wave_sum((o.x * o.x + o.y * o.y) + (o.z * o.z + o.w * o.w));
            const float rs = __builtin_amdgcn_rsqf(ss * (1.0f / 256.0f) + EPSF);
            f32x4 gv; gv.x = silu_f(bflo(gt.x)); gv.y = silu_f(bfhi(gt.x)); gv.z = silu_f(bflo(gt.y)); gv.w = silu_f(bfhi(gt.y));
            const f32x4 y = (o * rs) * gg * gv;
            u32x2 w; w.x = pk2(y.x, y.y); w.y = pk2(y.z, y.w); *(u32x2*)(AOUT + (size_t)row * D + c) = w; }
    }
}

struct AttnOut { float v; };
template <int NMAPS, int DV, bool NA>
__device__ __forceinline__ void attn_unit(LAS unsigned char* lds, int tid, int lane, int wave,
                                          const bf16* QKV, int qcol, int qrow0, int kcol, int krow_lat, int krow_ctx, const bf16* VT, int klo, int khi,
                                          int r_wave, int xq0, const LAS float* biasT,
                                          bf16* AOUT, int ocol, float lam, const float* subg, float outscale) {
    constexpr int KB = 9216;
    constexpr int BUFSZ = NMAPS * KB + DV * 144;
    constexpr int NVB = DV / 16, NVR = DV / 64;
    const int fr = lane & 15, g = lane >> 4;
    bf16x8 qf[NMAPS][2];
    { const bf16* qp = QKV + (size_t)(qrow0 + wave * 16 + fr) * NATT + qcol + 8 * g;
#pragma unroll
      for (int m = 0; m < NMAPS; ++m)
#pragma unroll
          for (int s = 0; s < 2; ++s) qf[m][s] = *(const bf16x8*)(qp + m * 64 + 32 * s); }
    f32x4 O[NMAPS][NVB]; float mrun[NMAPS], lrun[NMAPS];
#pragma unroll
    for (int m = 0; m < NMAPS; ++m) { mrun[m] = -1e30f; lrun[m] = 0.f;
#pragma unroll
        for (int vb = 0; vb < NVB; ++vb) O[m][vb] = (f32x4){0.f, 0.f, 0.f, 0.f}; }
    const int ntiles = 4 + (khi - klo);
    u32x4 kreg[NMAPS], vreg[NVR];
    const int lkey = tid >> 3, lch = tid & 7;
#define AT_LOAD(i) do { const int _i = (i); const int _rowg = (_i < 4 ? krow_ctx + 64 * _i : krow_lat + 64 * (klo + _i - 4)) + lkey; const int _tok0 = (_i < 4 ? SEQ + 64 * _i : 64 * (klo + _i - 4)); \
        _Pragma("unroll") for (int m = 0; m < NMAPS; ++m) kreg[m] = *(const u32x4*)(QKV + (size_t)_rowg * NATT + kcol + m * 64 + lch * 8); \
        _Pragma("unroll") for (int j = 0; j < NVR; ++j) { const int idx = tid + 512 * j; vreg[j] = *(const u32x4*)(VT + (size_t)(idx >> 3) * NKEY + _tok0 + (idx & 7) * 8); } } while (0)
#define AT_STORE(b) do { LAS unsigned char* _p = lds + (b) * BUFSZ; \
        _Pragma("unroll") for (int m = 0; m < NMAPS; ++m) *(LAS u32x4*)(_p + m * KB + lkey * 144 + lch * 16) = kreg[m]; \
        _Pragma("unroll") for (int j = 0; j < NVR; ++j) { const int idx = tid + 512 * j; *(LAS u32x4*)(_p + NMAPS * KB + (idx >> 3) * 144 + (idx & 7) * 16) = vreg[j]; } } while (0)
    AT_LOAD(0); AT_STORE(0); __syncthreads();
    int r0w = 0, xq = 0, cs = 0;
    if constexpr (NA) { r0w = r_wave - 4; r0w = r0w < 0 ? 0 : (r0w > 24 ? 24 : r0w); xq = xq0 + fr; cs = xq - 8; cs = cs < 0 ? 0 : (cs > 48 ? 48 : cs); }
    for (int i = 0; i < ntiles; ++i) {
        if (i + 1 < ntiles) AT_LOAD(i + 1);
        const LAS unsigned char* buf = lds + (i & 1) * BUFSZ;
        bool active = true; int kr = 0;
        if constexpr (NA) { if (i >= 4) { kr = klo + i - 4; active = (kr >= r0w) && (kr < r0w + 8); } }
        if (active) {
#pragma unroll
            for (int m = 0; m < NMAPS; ++m) {
                f32x4 S[4];
#pragma unroll
                for (int kb = 0; kb < 4; ++kb) { S[kb] = (f32x4){0.f, 0.f, 0.f, 0.f};
#pragma unroll
                    for (int s = 0; s < 2; ++s) { const bf16x8 kf = *(const LAS bf16x8*)(buf + m * KB + (16 * kb + fr) * 144 + (8 * g + 32 * s) * 2);
                        S[kb] = __builtin_amdgcn_mfma_f32_16x16x32_bf16(kf, qf[m][s], S[kb], 0, 0, 0); } }
                float mx = -1e30f;
#pragma unroll
                for (int kb = 0; kb < 4; ++kb)
#pragma unroll
                    for (int ii = 0; ii < 4; ++ii) { float t = S[kb][ii] * LOG2E;
                        if constexpr (NA) { if (i >= 4) { const int y = 16 * kb + 4 * g + ii; const bool ok = (y >= cs) && (y < cs + 16);
                                const int bidx = (kr - r_wave + 7) * 31 + (y - xq + 15); const float bv = biasT[ok ? bidx : 0]; t = ok ? t + bv : -1e30f; } }
                        S[kb][ii] = t; mx = fmaxf(mx, t); }
                mx = fmaxf(mx, __shfl_xor(mx, 16)); mx = fmaxf(mx, __shfl_xor(mx, 32));
                const float mnew = fmaxf(mrun[m], mx), alpha = fexp2(mrun[m] - mnew); mrun[m] = mnew;
                float ls = 0.f;
#pragma unroll
                for (int kb = 0; kb < 4; ++kb)
#pragma unroll
                    for (int ii = 0; ii < 4; ++ii) { const float p = fexp2(S[kb][ii] - mnew); S[kb][ii] = p; ls += p; }
                lrun[m] = lrun[m] * alpha + ls;
#pragma unroll
                for (int vb = 0; vb < NVB; ++vb) O[m][vb] = O[m][vb] * alpha;
                bf16x8 pf[2];
#pragma unroll
                for (int t = 0; t < 2; ++t) { u32x4 w; w.x = pk2(S[2 * t][0], S[2 * t][1]); w.y = pk2(S[2 * t][2], S[2 * t][3]); w.z = pk2(S[2 * t + 1][0], S[2 * t + 1][1]); w.w = pk2(S[2 * t + 1][2], S[2 * t + 1][3]);
                    pf[t] = __builtin_bit_cast(bf16x8, w); }
#pragma unroll
                for (int vb = 0; vb < NVB; ++vb)
#pragma unroll
                    for (int t = 0; t < 2; ++t) { const LAS unsigned char* vp = buf + NMAPS * KB + (16 * vb + fr) * 144 + (32 * t + 4 * g) * 2;
                        const u32x2 lo = *(const LAS u32x2*)vp, hi = *(const LAS u32x2*)(vp + 32);
                        u32x4 w; w.x = lo.x; w.y = lo.y; w.z = hi.x; w.w = hi.y;
                        O[m][vb] = __builtin_amdgcn_mfma_f32_16x16x32_bf16(__builtin_bit_cast(bf16x8, w), pf[t], O[m][vb], 0, 0, 0); }
                __builtin_amdgcn_sched_barrier(0);
            }
        }
        if (i + 1 < ntiles) AT_STORE((i + 1) & 1);
        __syncthreads();
    }
#undef AT_LOAD
#undef AT_STORE
    float inv[NMAPS];
#pragma unroll
    for (int m = 0; m < NMAPS; ++m) { float l = lrun[m]; l += __shfl_xor(l, 16); l += __shfl_xor(l, 32); inv[m] = 1.0f / l; }
    const int orow = qrow0 + wave * 16 + fr;
    if constexpr (NMAPS == 2) {
        float ss = 0.f; const float i1 = inv[0], i2 = lam * inv[1];
#pragma unroll
        for (int vb = 0; vb < NVB; ++vb) { O[0][vb] = O[0][vb] * i1 - O[1][vb] * i2; const f32x4 o = O[0][vb]; ss += (o.x * o.x + o.y * o.y) + (o.z * o.z + o.w * o.w); }
        ss += __shfl_xor(ss, 16); ss += __shfl_xor(ss, 32);
        const float rs = __builtin_amdgcn_rsqf(ss * (1.0f / DV) + EPSF) * outscale;
#pragma unroll
        for (int vb = 0; vb < NVB; ++vb) { const f32x4 gg = *(const f32x4*)(subg + 16 * vb + 4 * g); const f32x4 y = O[0][vb] * rs * gg;
            u32x2 w; w.x = pk2(y.x, y.y); w.y = pk2(y.z, y.w); *(u32x2*)(AOUT + (size_t)orow * D + ocol + 16 * vb + 4 * g) = w; }
    } else {
#pragma unroll
        for (int vb = 0; vb < NVB; ++vb) { const f32x4 y = O[0][vb] * inv[0];
            u32x2 w; w.x = pk2(y.x, y.y); w.y = pk2(y.z, y.w); *(u32x2*)(AOUT + (size_t)orow * D + ocol + 16 * vb + 4 * g) = w; }
    }
}

__device__ __forceinline__ int na_r0(int r) { int v = r - 4; return v < 0 ? 0 : (v > 24 ? 24 : v); }

__device__ __forceinline__ void phase_attention(const bf16* QKV, const bf16* VAT, const bf16* VBT, bf16* AOUT, const float* lamp  , float lam_init, const float* subg, const float* nab  ,
                                                LAS unsigned char* lds, int tid, int lane, int wave, int vcu, int G) {
    float part = lamp[lane] * lamp[64 + lane]; float part2 = lamp[128 + lane] * lamp[192 + lane];
    const float lam = __expf(wave_sum(part)) - __expf(wave_sum(part2)) + lam_init;
    for (int u = vcu; u < 576; u += G) {
        int bh, qrow0, khi;
        if (u < 512) { bh = u >> 4; const int qt = u & 15; qrow0 = (bh >> 2) * SEQ + qt * 128; khi = 32; }
        else { const int q = u - 512; bh = q >> 1; const int qt = q & 1; qrow0 = TX + (bh >> 2) * CTXL + qt * 128; khi = 0; }
        const int b = bh >> 2, h = bh & 3;
        attn_unit<2, 128, false>(lds, tid, lane, wave, QKV, h * 128, qrow0, 512 + h * 128, b * SEQ, TX + b * CTXL, VAT + (size_t)bh * 128 * NKEY, 0, khi, 0, 0, nullptr,
                                 AOUT, h * 128, lam, subg, 1.0f - lam_init);
    }
    LAS float* biasT = (LAS float*)(lds + LX_BIAS);
    for (int u = vcu; u < 1152; u += G) {
        int bh, qrow0, klo, khi, rw;
        if (u < 1024) { bh = u >> 4; const int rp = u & 15; qrow0 = (bh >> 3) * SEQ + rp * 128; klo = na_r0(2 * rp); khi = na_r0(2 * rp + 1) + 8; rw = 2 * rp + (wave >> 2); }
        else { const int q = u - 1024; bh = q >> 1; const int qt = q & 1; qrow0 = TX + (bh >> 3) * CTXL + qt * 128; klo = 0; khi = 0; rw = 0; }
        const int b = bh >> 3, h = bh & 7;
        for (int i = tid; i < 15 * 31; i += 512) biasT[i] = nab[h * 465 + i] * LOG2E;
        attn_unit<1, 64, true>(lds, tid, lane, wave, QKV, 1536 + h * 64, qrow0, 2048 + h * 64, b * SEQ, TX + b * CTXL, VBT + (size_t)bh * 64 * NKEY, klo, khi,
                               rw, 16 * (wave & 3), biasT, AOUT, 512 + h * 64, 0.f, nullptr, 1.0f);
    }
}

constexpr int GL_QM = 0, GL_QG = 17408, GL_KM = 34816, GL_KET = 52224, GL_VT = 70656, GL_ST = 79872, GL_LR = 97280, GL_SEG = 101376, GL_DEC = 103424;
__device__ __forceinline__ void phase_gla(const bf16* QKV2, const bf16* VGT, bf16* OF, bf16* OB, const float* wgate  , const float* bgate  ,
                                          LAS unsigned char* lds, int tid, int lane, int wave, int vcu, int G) {
    const int fr = lane & 15, g = lane >> 4;
    const int d = tid & 127, seg = tid >> 7;
    for (int u = vcu; u < 256; u += G) {
        const int slab = u & 3, dir = (u >> 2) & 1, hh = (u >> 3) & 3, b = u >> 5;
        bf16* OUT = dir ? OB : OF;
        float wg[16];
#pragma unroll
        for (int r = 0; r < 16; ++r) wg[r] = wgate[(dir * 16 + r) * 512 + hh * 128 + d];
        const float bgv = bgate[dir * 512 + hh * 128 + d];
        f32x4 Sacc[4];
#pragma unroll
        for (int vb = 0; vb < 4; ++vb) Sacc[vb] = (f32x4){0.f, 0.f, 0.f, 0.f};
        for (int i = tid; i < 17408 / 4; i += 512) ((LAS unsigned*)(lds + GL_ST))[i] = 0u;
        const bf16* vtb = VGT + ((size_t)(b * 4 + hh) * 256 + slab * 64) * NKEY;
        u32x4 qr[2], kr[2], vr, lr4;
#define GL_LOAD(n) do { const int _n = (n); int _row0, _tok0; if (_n < 4) { const int cc = dir ? 3 - _n : _n; _row0 = TX + b * CTXL + 64 * cc; _tok0 = SEQ + 64 * cc; } else { const int lc = dir ? 35 - _n : _n - 4; _row0 = b * SEQ + 64 * lc; _tok0 = 64 * lc; } \
        _Pragma("unroll") for (int j = 0; j < 2; ++j) { const int idx = tid + 512 * j, p = idx >> 4, ch = idx & 15; const bf16* src = QKV2 + (size_t)(_row0 + p) * NGLA + hh * 128 + ch * 8; qr[j] = *(const u32x4*)src; kr[j] = *(const u32x4*)(src + 512); } \
        vr = *(const u32x4*)(vtb + (size_t)(tid >> 3) * NKEY + _tok0 + (tid & 7) * 8); \
        if (tid < 128) lr4 = *(const u32x4*)(QKV2 + (size_t)(_row0 + (tid >> 1)) * NGLA + 3072 + dir * 16 + (tid & 1) * 8); } while (0)
        GL_LOAD(0);
        for (int n = 0; n < 36; ++n) {
            int row0; if (n < 4) { const int cc = dir ? 3 - n : n; row0 = TX + b * CTXL + 64 * cc; } else { const int lc = dir ? 35 - n : n - 4; row0 = b * SEQ + 64 * lc; }
#pragma unroll
            for (int j = 0; j < 2; ++j) { const int idx = tid + 512 * j, p = idx >> 4, ch = idx & 15;
                *(LAS u32x4*)(lds + GL_QM + p * 272 + ch * 16) = qr[j]; *(LAS u32x4*)(lds + GL_KM + p * 272 + ch * 16) = kr[j]; }
            *(LAS u32x4*)(lds + GL_VT + (tid >> 3) * 144 + (tid & 7) * 16) = vr;
            if (tid < 128) { LAS float* lp = (LAS float*)(lds + GL_LR) + (tid >> 1) * 16 + (tid & 1) * 8;
                lp[0] = bflo(lr4.x); lp[1] = bfhi(lr4.x); lp[2] = bflo(lr4.y); lp[3] = bfhi(lr4.y); lp[4] = bflo(lr4.z); lp[5] = bfhi(lr4.z); lp[6] = bflo(lr4.w); lp[7] = bfhi(lr4.w); }
            __syncthreads();
            if (n + 1 < 36) GL_LOAD(n + 1);
            float gc[16];
#pragma unroll
            for (int pi = 0; pi < 16; ++pi) { const LAS f32x4* lp = (const LAS f32x4*)((LAS float*)(lds + GL_LR) + (16 * seg + pi) * 16); float z = bgv;
#pragma unroll
                for (int q = 0; q < 4; ++q) { const f32x4 l4 = lp[q]; z += l4.x * wg[4 * q] + l4.y * wg[4 * q + 1] + l4.z * wg[4 * q + 2] + l4.w * wg[4 * q + 3]; }
                const float az = fabsf(z); gc[pi] = (fminf(z, 0.f) - flog(1.0f + fexp(-az))) * 0.0625f; }
            float run = 0.f;
            if (dir == 0) {
#pragma unroll
                for (int pi = 0; pi < 16; ++pi) { run += gc[pi]; gc[pi] = run; }
            } else {
#pragma unroll
                for (int pi = 15; pi >= 0; --pi) { run += gc[pi]; gc[pi] = run; }
            }
            ((LAS float*)(lds + GL_SEG))[seg * 128 + d] = run;
            __syncthreads();
            float t0 = ((LAS float*)(lds + GL_SEG))[d], t1 = ((LAS float*)(lds + GL_SEG))[128 + d], t2 = ((LAS float*)(lds + GL_SEG))[256 + d], t3 = ((LAS float*)(lds + GL_SEG))[384 + d];
            float off, gmid; const float gend = (t0 + t1) + (t2 + t3);
            if (dir == 0) { off = (seg > 0 ? t0 : 0.f) + (seg > 1 ? t1 : 0.f) + (seg > 2 ? t2 : 0.f); gmid = t0 + t1; }
            else { off = (seg < 3 ? t3 : 0.f) + (seg < 2 ? t2 : 0.f) + (seg < 1 ? t1 : 0.f); gmid = t3 + t2; }
            const float emid = fexp(gmid), eend = fexp(gend - gmid);
            unsigned kep[8];
#pragma unroll
            for (int pi = 0; pi < 16; ++pi) { const int p = 16 * seg + pi; const float rel = off + gc[pi] - gmid; const float E = fexp(rel), Ei = fexp(-rel);
                LAS bf16* qa = (LAS bf16*)(lds + GL_QM) + p * 136 + d; LAS bf16* ka = (LAS bf16*)(lds + GL_KM) + p * 136 + d;
                const float q = bf2f(*qa), k = bf2f(*ka);
                const float qm = q * E, km = k * Ei;
                *qa = (bf16)f2bf(qm); *ka = (bf16)f2bf(km); ((LAS bf16*)(lds + GL_QG))[p * 136 + d] = (bf16)f2bf(qm * emid);
                const unsigned keb = f2bf(km * eend); if (pi & 1) kep[pi >> 1] |= keb << 16; else kep[pi >> 1] = keb; }
            { LAS u32x4* kt = (LAS u32x4*)(lds + GL_KET + d * 144 + seg * 32); kt[0] = (u32x4){kep[0], kep[1], kep[2], kep[3]}; kt[1] = (u32x4){kep[4], kep[5], kep[6], kep[7]}; }
            if (seg == 0) ((LAS float*)(lds + GL_DEC))[d] = fexp(gend);
            __syncthreads();
            { const int cb = wave & 3, vh = wave >> 2;
              f32x4 AT[4];
#pragma unroll
              for (int sb = 0; sb < 4; ++sb) { AT[sb] = (f32x4){0.f, 0.f, 0.f, 0.f};
#pragma unroll
                  for (int ks = 0; ks < 4; ++ks) { const bf16x8 af = *(const LAS bf16x8*)(lds + GL_KM + (16 * sb + fr) * 272 + (8 * g + 32 * ks) * 2);
                      const bf16x8 bfr = *(const LAS bf16x8*)(lds + GL_QM + (16 * cb + fr) * 272 + (8 * g + 32 * ks) * 2);
                      AT[sb] = __builtin_amdgcn_mfma_f32_16x16x32_bf16(af, bfr, AT[sb], 0, 0, 0); }
                  const int c = 16 * cb + fr;
#pragma unroll
                  for (int ii = 0; ii < 4; ++ii) { const int s = 16 * sb + 4 * g + ii; const bool keep = dir ? (s >= c) : (s <= c); AT[sb][ii] = keep ? AT[sb][ii] : 0.f; } }
              bf16x8 pf[2];
#pragma unroll
              for (int t = 0; t < 2; ++t) { u32x4 w; w.x = pk2(AT[2 * t][0], AT[2 * t][1]); w.y = pk2(AT[2 * t][2], AT[2 * t][3]); w.z = pk2(AT[2 * t + 1][0], AT[2 * t + 1][1]); w.w = pk2(AT[2 * t + 1][2], AT[2 * t + 1][3]);
                  pf[t] = __builtin_bit_cast(bf16x8, w); }
#pragma unroll
              for (int v2 = 0; v2 < 2; ++v2) { const int vb = 2 * vh + v2; f32x4 Oa = (f32x4){0.f, 0.f, 0.f, 0.f};
#pragma unroll
                  for (int ks = 0; ks < 4; ++ks) { const bf16x8 af = *(const LAS bf16x8*)(lds + GL_ST + (16 * vb + fr) * 272 + (8 * g + 32 * ks) * 2);
                      const bf16x8 bfr = *(const LAS bf16x8*)(lds + GL_QG + (16 * cb + fr) * 272 + (8 * g + 32 * ks) * 2);
                      Oa = __builtin_amdgcn_mfma_f32_16x16x32_bf16(af, bfr, Oa, 0, 0, 0); }
#pragma unroll
                  for (int t = 0; t < 2; ++t) { const LAS unsigned char* vp = lds + GL_VT + (16 * vb + fr) * 144 + (32 * t + 4 * g) * 2;
                      const u32x2 lo = *(const LAS u32x2*)vp, hi = *(const LAS u32x2*)(vp + 32);
                      u32x4 w; w.x = lo.x; w.y = lo.y; w.z = hi.x; w.w = hi.y;
                      Oa = __builtin_amdgcn_mfma_f32_16x16x32_bf16(__builtin_bit_cast(bf16x8, w), pf[t], Oa, 0, 0, 0); }
                  u32x2 w; w.x = pk2(Oa[0], Oa[1]); w.y = pk2(Oa[2], Oa[3]);
                  *(u32x2*)(OUT + (size_t)(row0 + 16 * cb + fr) * D + hh * 256 + slab * 64 + 16 * vb + 4 * g) = w; }
            }
            { const f32x4 dec = *(const LAS f32x4*)((LAS float*)(lds + GL_DEC) + 16 * wave + 4 * g);
#pragma unroll
              for (int vb = 0; vb < 4; ++vb) { Sacc[vb] = Sacc[vb] * dec;
#pragma unroll
                  for (int t = 0; t < 2; ++t) { const bf16x8 af = *(const LAS bf16x8*)(lds + GL_KET + (16 * wave + fr) * 144 + (8 * g + 32 * t) * 2);
                      const bf16x8 bfr = *(const LAS bf16x8*)(lds + GL_VT + (16 * vb + fr) * 144 + (8 * g + 32 * t) * 2);
                      Sacc[vb] = __builtin_amdgcn_mfma_f32_16x16x32_bf16(af, bfr, Sacc[vb], 0, 0, 0); } }
            }
            __syncthreads();
#pragma unroll
            for (int vb = 0; vb < 4; ++vb) { u32x2 w; w.x = pk2(Sacc[vb][0], Sacc[vb][1]); w.y = pk2(Sacc[vb][2], Sacc[vb][3]);
                *(LAS u32x2*)(lds + GL_ST + (16 * vb + fr) * 272 + (16 * wave + 4 * g) * 2) = w; }
        }
#undef GL_LOAD
        __syncthreads();
    }
}

constexpr int N_PHASES = 34;
typedef const Args __attribute__((address_space(4)))* KArgs;
__device__ __forceinline__ KArgs kargs() { KArgs p = (KArgs)__builtin_amdgcn_kernarg_segment_ptr(); asm volatile("" : "+s"(p)); return p; }
__global__ void __launch_bounds__(512, 2) fwd(Args a_unused) {
    extern __shared__ __attribute__((aligned(16))) unsigned char lds_raw[];
    LAS unsigned char* lds = (LAS unsigned char*)lds_raw;
    const int tid0 = threadIdx.x;
    const int G0 = gridDim.x; const int bx0 = blockIdx.x;
#define PH_ENTRY int tid = tid0; asm volatile("" : "+v"(tid)); int G = G0, bx = bx0; asm volatile("" : "+s"(G), "+s"(bx)); const int lane = tid & 63, wave = __builtin_amdgcn_readfirstlane(tid >> 6); \
        const int vcu = (G % 8 == 0) ? (bx % 8) * (G / 8) + bx / 8 : bx; (void)lane; (void)wave; (void)vcu
    const int tid = tid0;
    const int ph_lo = kargs()->ph_lo, ph_hi = kargs()->ph_hi;
    if (tid < 64) ((LAS unsigned*)(lds + LX_MISC))[tid] = 0u;
    for (int i = tid; i < 1024; i += 512) { const int pos = i >> 4, f = i & 15; const float inv = __builtin_amdgcn_exp2f(-(float)f * (13.287712379549449f / 16.0f)); const float ang = (float)pos * inv;
        ((LAS float*)(lds + LX_ROPE))[2 * i] = __cosf(ang); ((LAS float*)(lds + LX_ROPE))[2 * i + 1] = __sinf(ang); }
    __syncthreads();
    const bool single = (ph_hi - ph_lo) > 1;
    XcdBarrier bar; bar.bar = (unsigned*)(kargs()->ws + WS_CTL) + CW_BAR; bar.x = 0; bar.st = (volatile LAS unsigned*)(lds + LX_MISC);
    if (single) bar = xcd_barrier_post((unsigned*)(kargs()->ws + WS_CTL) + CW_BAR, (volatile LAS unsigned*)(lds + LX_MISC));
#define IN(k) (ph_lo <= (k) && (k) < ph_hi)
#define SEAM(k) do { if (IN(k) && IN((k) + 1)) { bar.bar = (unsigned*)(kargs()->ws + WS_CTL) + CW_BAR; xcd_barrier(bar); } } while (0)
    LAS int* tab = (LAS int*)(lds + LX_MOETAB);

    if (IN(0)) { PH_ENTRY; p0_prologue(kargs(), lds, tid, lane, wave, vcu, G); } SEAM(0);
    if (IN(1)) { PH_ENTRY; KArgs A = kargs(); unsigned char* ws = A->ws; phase_norm1(A->out, (float*)(ws + WS_CTX), A->norm_g, (float*)(ws + WS_MODV), (bf16*)(ws + WS_H), TALL, lane, wave, vcu, G); } SEAM(1);

#pragma nounroll
    for (int L = 0; L < 4; ++L) {
        const int pb = 2 + 8 * L; const bool isattn = !(L & 1); const int j = L >> 1; const bool lastL = (L == 3);
        const int nrows = lastL ? TX : TALL;
        if (IN(pb)) {
            PH_ENTRY; KArgs A = kargs(); unsigned char* ws = A->ws; unsigned char* big = ws + WS_BIG; const bf16* H = (const bf16*)(ws + WS_H);
            if (isattn) {
                pg8::DenseOrder S; S.init(H, (const bf16*)(ws + WS_WATTIN) + (size_t)j * NATT * D, TALL, NATT, D, G, bx);
                pg8::EpiAttnIn E{(bf16*)(big + BG_QKV), (bf16*)(big + BG_VAT), (bf16*)(big + BG_VBT), (const LAS float*)(lds + LX_ROPE)};
                pg8::gemm_phase<pg8::EpiAttnIn, pg8::DenseOrder, false>(lds, tid, D, S, E);
            } else {
                pg8::DenseOrder S; S.init(H, (const bf16*)(ws + WS_WGLAIN) + (size_t)j * NGLA * D, TALL, NGLA, D, G, bx);
                pg8::EpiGlaIn E{(bf16*)(big + BG_QKV2), (bf16*)(big + BG_VGT)};
                pg8::gemm_phase<pg8::EpiGlaIn, pg8::DenseOrder, false>(lds, tid, D, S, E);
            }
        }
        SEAM(pb);
        if (IN(pb + 1)) {
            PH_ENTRY; KArgs A = kargs(); unsigned char* ws = A->ws; unsigned char* big = ws + WS_BIG; bf16* AOUT = (bf16*)(ws + WS_AOUT);
            if (isattn) phase_attention((const bf16*)(big + BG_QKV), (const bf16*)(big + BG_VAT), (const bf16*)(big + BG_VBT), AOUT, A->att_lambda + j * 256, (L == 0) ? 0.2f : 0.470713018f,
                                        A->att_subln_g + j * 128, A->na_bias + j * 8 * 465, lds, tid, lane, wave, vcu, G);
            else phase_gla((const bf16*)(big + BG_QKV2), (const bf16*)(big + BG_VGT), (bf16*)(big + BG_OF), (bf16*)(big + BG_OB), A->gla_w_gate + j * 2 * 16 * 512, A->gla_b_gate + j * 2 * 512,
                           lds, tid, lane, wave, vcu, G);
        }
        SEAM(pb + 1);
        if (!isattn) {
            if (IN(pb + 2)) { PH_ENTRY; KArgs A = kargs(); unsigned char* ws = A->ws; unsigned char* big = ws + WS_BIG;
                phase_readout((const bf16*)(big + BG_OF), (const bf16*)(big + BG_OB), (const bf16*)(big + BG_QKV2), A->gla_norm_g + j * 256, (bf16*)(ws + WS_AOUT), nrows, lane, wave, vcu, G); }
            SEAM(pb + 2);
        }
        if (IN(pb + 3)) {
            PH_ENTRY; KArgs A = kargs(); unsigned char* ws = A->ws;
            pg8::DenseOrder S; S.init((const bf16*)(ws + WS_AOUT), (const bf16*)(ws + (isattn ? WS_WATTOUT : WS_WGLAOUT)) + (size_t)j * D * D, nrows, D, D, G, bx);
            pg8::EpiResid E{A->out, (float*)(ws + WS_CTX), (const float*)(ws + WS_MODV) + (size_t)L * 9 * 6144 + 2048};
            pg8::gemm_phase<pg8::EpiResid, pg8::DenseOrder, false>(lds, tid, D, S, E);
        }
        SEAM(pb + 3);
        if (IN(pb + 4)) { PH_ENTRY; KArgs A = kargs(); unsigned char* ws = A->ws;
            phase_router(A->out, (float*)(ws + WS_CTX), A->norm_g + (L * 2 + 1) * D, (const float*)(ws + WS_MODV) + (size_t)L * 9 * 6144, (bf16*)(ws + WS_H), A->router_w, A->router_bias,
                         (unsigned*)(ws + WS_CTL) + CW_CNT + L * 16 * 64, (int*)(ws + WS_LIST), (int*)(ws + WS_TOKI), (float*)(ws + WS_TOKW), nrows, lds, tid, lane, wave, vcu, G); }
        SEAM(pb + 4);
        if (IN(pb + 5)) {
            PH_ENTRY; KArgs A = kargs(); unsigned char* ws = A->ws;
            const int RT = build_moe_table((unsigned*)(ws + WS_CTL) + CW_CNT + L * 16 * 64, tab, tid);
            pg8::MoeOrder S; S.A = (const char*)(ws + WS_H); S.B = (const char*)(ws + WS_W13) + (size_t)L * 16 * D * D * 2; S.K = D; S.bstride = (size_t)D * D * 2; S.tab = tab; S.list = (const int*)(ws + WS_LIST); S.RT = RT; S.nwg = RT * 4; S.G = G; S.c = bx;
            pg8::EpiMoe1 E{(bf16*)(ws + WS_BIG + BG_HB)};
            pg8::gemm_phase<pg8::EpiMoe1, pg8::MoeOrder, true>(lds, tid, D, S, E);
        }
        SEAM(pb + 5);
        if (IN(pb + 6)) {
            PH_ENTRY; KArgs A = kargs(); unsigned char* ws = A->ws;
            const int RT = build_moe_table((unsigned*)(ws + WS_CTL) + CW_CNT + L * 16 * 64, tab, tid);
            pg8::MoeOrder S; S.A = (const char*)(ws + WS_BIG + BG_HB); S.B = (const char*)(ws + WS_W2) + (size_t)L * 16 * D * DEXP * 2; S.K = DEXP; S.bstride = (size_t)D * DEXP * 2; S.tab = tab; S.list = (const int*)(ws + WS_LIST); S.RT = RT; S.nwg = RT * 4; S.G = G; S.c = bx;
            pg8::EpiBf16 E{(bf16*)(ws + WS_BIG + BG_YB), D};
            pg8::gemm_phase<pg8::EpiBf16, pg8::MoeOrder, false>(lds, tid, DEXP, S, E);
        }
        SEAM(pb + 6);
        if (IN(pb + 7)) { PH_ENTRY; KArgs A = kargs(); unsigned char* ws = A->ws; const float* MODV = (const float*)(ws + WS_MODV);
            phase_combine(A->out, (float*)(ws + WS_CTX), MODV + (size_t)L * 9 * 6144, (const bf16*)(ws + WS_BIG + BG_YB), (unsigned*)(ws + WS_CTL) + CW_CNT + L * 16 * 64, (const int*)(ws + WS_TOKI), (const float*)(ws + WS_TOKW),
                          lastL, lastL ? A->final_g : A->norm_g + ((L + 1) * 2) * D, MODV + (size_t)(lastL ? L : L + 1) * 9 * 6144, (bf16*)(ws + WS_H), nrows, lane, wave, vcu, G); }
        if (!lastL) SEAM(pb + 7);
    }
#undef IN
#undef SEAM
#undef PH_ENTRY
}

extern "C" void kernel_launch(void* const* d_in, const int* in_sizes, int n_in, void* d_out, int out_size, void* d_ws, size_t ws_size, hipStream_t stream) {
    static int ready = 0;
    if (ready == 0) {
        if (n_in != 23 || out_size != TX * D || ws_size < WS_END) { fprintf(stderr, "kernel_launch: unexpected shapes (n_in %d out %d ws %zu)\n", n_in, out_size, ws_size); ready = -1; return; }
        if (hipFuncSetAttribute((const void*)fwd, hipFuncAttributeMaxDynamicSharedMemorySize, LDS_BYTES) != hipSuccess) { fprintf(stderr, "kernel_launch: hipFuncSetAttribute failed\n"); ready = -1; return; }
        int per_cu = 0; (void)hipOccupancyMaxActiveBlocksPerMultiprocessor(&per_cu, (const void*)fwd, 512, LDS_BYTES); (void)hipGetLastError();
        if (per_cu < 1) fprintf(stderr, "kernel_launch: occupancy query reports %d blocks per CU\n", per_cu);
        ready = 1;
    }
    if (ready < 0) return;
    (void)hipMemsetAsync((char*)d_ws + WS_CTL, 0, CTL_ZERO_BYTES, stream);
    Args a{};
    const float** ap = (const float**)&a;
    for (int i = 0; i < 23; ++i) ap[i] = (const float*)d_in[i];
    a.out = (float*)d_out; a.ws = (unsigned char*)d_ws;
    const int grid = 256;
#if MK_MULTI
    for (int k = 0; k < N_PHASES; ++k) { a.ph_lo = k; a.ph_hi = k + 1; hipLaunchKernelGGL(fwd, dim3(grid), dim3(512), LDS_BYTES, stream, a); }
#else
    a.ph_lo = 0; a.ph_hi = N_PHASES;
    hipLaunchKernelGGL(fwd, dim3(grid), dim3(512), LDS_BYTES, stream, a);
#endif
}
```

```cpp
#include <hip/hip_runtime.h>
#include <cstdio>
#include <cstdint>

#ifndef MK_REPMASK
#define MK_REPMASK 0
#endif
#ifndef MK_MULTI
#define MK_MULTI 0
#endif

#define GAS __attribute__((address_space(1)))
#define LAS __attribute__((address_space(3)))
typedef unsigned short bf16;
typedef short bf16x8 __attribute__((ext_vector_type(8)));
typedef short bf16x4 __attribute__((ext_vector_type(4)));
typedef float f32x4 __attribute__((ext_vector_type(4)));
typedef float f32x2 __attribute__((ext_vector_type(2)));
typedef unsigned u32x4 __attribute__((ext_vector_type(4)));
typedef unsigned u32x2 __attribute__((ext_vector_type(2)));

constexpr int D = 1024, NB = 8, SEQ = 2048, CTXL = 256;
constexpr int TX = NB * SEQ, TC = NB * CTXL, TALL = TX + TC;
constexpr int NKEY = SEQ + CTXL;
constexpr int NATT = 3072, NGLA = 3328;
constexpr float EPSF = 1e-6f;
constexpr float LOG2E = 1.4426950408889634f;
constexpr int NEXP = 16, DEXP = 512;
constexpr int RT_MAX = 160;

constexpr size_t MiB = 1u << 20;
constexpr size_t WS_CTL = 0, CTL_ZERO_BYTES = 1 * MiB;
constexpr size_t WS_MODV = 1 * MiB;
constexpr size_t WS_TOKI = 2 * MiB;
constexpr size_t WS_TOKW = 2 * MiB + 512 * 1024;
constexpr size_t WS_LIST = 3 * MiB;
constexpr size_t WS_CTX = 5 * MiB;
constexpr size_t WS_WATTIN = 13 * MiB;
constexpr size_t WS_WATTOUT = 25 * MiB;
constexpr size_t WS_WGLAIN = 29 * MiB;
constexpr size_t WS_WGLAOUT = 42 * MiB;
constexpr size_t WS_W13 = 46 * MiB;
constexpr size_t WS_W2 = 174 * MiB;
constexpr size_t WS_H = 238 * MiB;
constexpr size_t WS_AOUT = 274 * MiB;
constexpr size_t WS_BIG = 310 * MiB;
constexpr size_t WS_END = 535 * MiB;
constexpr size_t BG_QKV = 0;
constexpr size_t BG_VAT = 108 * MiB;
constexpr size_t BG_VBT = 126 * MiB;
constexpr size_t BG_QKV2 = 0;
constexpr size_t BG_VGT = 117 * MiB;
constexpr size_t BG_OF = 153 * MiB;
constexpr size_t BG_OB = 189 * MiB;
constexpr size_t BG_HB = 0;
constexpr size_t BG_YB = 40 * MiB;
constexpr int CW_TMO = 0;
constexpr int CW_BAR = 4096;
constexpr int CW_CNT = 8192;

constexpr int RING_BYTES = 131072;
constexpr int LX_OFF = RING_BYTES;
constexpr int LX_MISC = LX_OFF;
constexpr int LX_MOETAB = LX_OFF + 256;
constexpr int LX_ROPE = LX_OFF + 2048;
constexpr int LX_BIAS = LX_OFF + 2048 + 8192;
constexpr int LDS_BYTES = 147456;

#define LDS_WAIT() asm volatile("s_waitcnt lgkmcnt(0)" ::: "memory")
#define VM_WAIT() asm volatile("s_waitcnt vmcnt(0)" ::: "memory")
#define RLX_AGENT __ATOMIC_RELAXED, __HIP_MEMORY_SCOPE_AGENT
__device__ __forceinline__ unsigned f2bf(float f) { unsigned u = __builtin_bit_cast(unsigned, f); return (u + 0x7fffu + ((u >> 16) & 1u)) >> 16; }
typedef __bf16 hwbf16x2 __attribute__((ext_vector_type(2)));
__device__ __forceinline__ unsigned cvtpk(float lo, float hi) { const f32x2 v = {lo, hi}; const hwbf16x2 b = __builtin_convertvector(v, hwbf16x2); return __builtin_bit_cast(unsigned, b); }
__device__ __forceinline__ unsigned pk2(float lo, float hi) { return cvtpk(lo, hi); }
__device__ __forceinline__ float bf2f(unsigned short b) { return __builtin_bit_cast(float, ((unsigned)b) << 16); }
__device__ __forceinline__ float bflo(unsigned w) { return __builtin_bit_cast(float, w << 16); }
__device__ __forceinline__ float bfhi(unsigned w) { return __builtin_bit_cast(float, w & 0xffff0000u); }
template <int CTRL> __device__ __forceinline__ float dppf(float v) { return __builtin_bit_cast(float, __builtin_amdgcn_update_dpp(0, __builtin_bit_cast(int, v), CTRL, 0xf, 0xf, true)); }
__device__ __forceinline__ float row_sum(float v) { v += dppf<0xB1>(v); v += dppf<0x4E>(v); v += dppf<0x124>(v); v += dppf<0x128>(v); return v; }
__device__ __forceinline__ float swap16_add(float a, float b) { auto r = __builtin_amdgcn_permlane16_swap(__float_as_uint(a), __float_as_uint(b), false, false); const unsigned r0 = r[0], r1 = r[1]; return __uint_as_float(r0) + __uint_as_float(r1); }
__device__ __forceinline__ float swap32_add(float a, float b) { auto r = __builtin_amdgcn_permlane32_swap(__float_as_uint(a), __float_as_uint(b), false, false); const unsigned r0 = r[0], r1 = r[1]; return __uint_as_float(r0) + __uint_as_float(r1); }
__device__ __forceinline__ float swap16_max(float a) { auto r = __builtin_amdgcn_permlane16_swap(__float_as_uint(a), __float_as_uint(a), false, false); const unsigned r0 = r[0], r1 = r[1]; return fmaxf(__uint_as_float(r0), __uint_as_float(r1)); }
__device__ __forceinline__ float swap32_max(float a) { auto r = __builtin_amdgcn_permlane32_swap(__float_as_uint(a), __float_as_uint(a), false, false); const unsigned r0 = r[0], r1 = r[1]; return fmaxf(__uint_as_float(r0), __uint_as_float(r1)); }
__device__ __forceinline__ float readlane_f(float v, int l) { return __int_as_float(__builtin_amdgcn_readlane(__float_as_int(v), l)); }
__device__ __forceinline__ float wave_sum(float v) { v = row_sum(v); v = swap16_add(v, v); return swap32_add(v, v); }
__device__ __forceinline__ float fexp2(float x) { return __builtin_amdgcn_exp2f(x); }
__device__ __forceinline__ float fexp(float x) { return __builtin_amdgcn_exp2f(x * LOG2E); }
__device__ __forceinline__ float flog(float x) { return __builtin_amdgcn_logf(x) * 0.6931471805599453f; }
__device__ __forceinline__ float frcp(float x) { return __builtin_amdgcn_rcpf(x); }
__device__ __forceinline__ float silu_f(float x) { return x * frcp(1.0f + fexp(-x)); }

#define XB_TMO      128
#define XB_XCNT(j)  (256  + 64 * (j))
#define XB_XSUB(j)  (1280 + 64 * (j))
#define XB_XGEN(j)  (2304 + 64 * (j))
#define XB_TOP      3328
#define XB_TOPGEN   3392
#define XCD_BAR_WORDS 3456
#define XB_SPIN_CAP (1u << 18)
__device__ __forceinline__ unsigned xb_ld(unsigned* p)              { return __hip_atomic_load(p, __ATOMIC_RELAXED, __HIP_MEMORY_SCOPE_AGENT); }
__device__ __forceinline__ unsigned xb_add(unsigned* p, unsigned v) { return __hip_atomic_fetch_add(p, v, __ATOMIC_RELAXED, __HIP_MEMORY_SCOPE_AGENT); }
__device__ __forceinline__ unsigned xb_xcc_id() { return (unsigned)__builtin_amdgcn_s_getreg((3 << 11) | 20) & 0xFu; }
#define XB_SPIN(cond, bar) do { unsigned _sp = 0; while (cond) { __builtin_amdgcn_s_sleep(1); \
    if ((++_sp & 255u) == 0u) { if (xb_ld(&(bar)[XB_TMO])) break; if (_sp > XB_SPIN_CAP) { atomicAdd(&(bar)[XB_TMO], 1u); break; } } } } while (0)
struct XcdBarrier { unsigned* bar; unsigned x; volatile LAS unsigned* st; };
__device__ __forceinline__ XcdBarrier xcd_barrier_post(unsigned* bar, volatile LAS unsigned* st) {
    XcdBarrier b; b.bar = bar; b.x = xb_xcc_id(); b.st = st;
    if (threadIdx.x == 0) (void)xb_add(&bar[XB_XCNT(b.x)], 1u);
    return b;
}
__device__ __forceinline__ void xcd_barrier_complete(unsigned* bar, unsigned x, unsigned& nloc, unsigned& nx) {
    const unsigned G = gridDim.x * gridDim.y * gridDim.z;
    unsigned sum, cnt, mine, sp = 0u;
    for (;;) {
        sum = 0u; cnt = 0u; mine = 0u;
#pragma unroll
        for (unsigned j = 0; j < 16; ++j) { const unsigned c = xb_ld(&bar[XB_XCNT(j)]); sum += c; cnt += (c > 0u) ? 1u : 0u; mine = (j == x) ? c : mine; }
        if (sum == G) break;
        __builtin_amdgcn_s_sleep(1);
        if ((++sp & 255u) == 0u) { if (xb_ld(&bar[XB_TMO])) break; if (sp > XB_SPIN_CAP) { atomicAdd(&bar[XB_TMO], 1u); break; } }
    }
    nloc = mine > 0u ? mine : 1u; nx = cnt > 0u ? cnt : 1u;
}
__device__ __forceinline__ void xcd_barrier(const XcdBarrier& b) {
    asm volatile("s_waitcnt vmcnt(0)" ::: "memory");
    __syncthreads();
    if (threadIdx.x == 0) {
        unsigned* bar = b.bar;
        __builtin_amdgcn_s_waitcnt(0);
        unsigned nloc = b.st[0], nx = b.st[1];
        if (nloc == 0u) { xcd_barrier_complete(bar, b.x, nloc, nx); b.st[0] = nloc; b.st[1] = nx; }
        const unsigned old = xb_add(&bar[XB_XSUB(b.x)], 1u);
        const unsigned gen = old / nloc;
        if (old + 1u == (gen + 1u) * nloc) {
            __builtin_amdgcn_fence(__ATOMIC_RELEASE, "agent");
            asm volatile("s_waitcnt vmcnt(0)" ::: "memory");
            const unsigned og = xb_add(&bar[XB_TOP], 1u);
            const unsigned tg = og / nx;
            if (og + 1u == (tg + 1u) * nx) xb_add(&bar[XB_TOPGEN], 1u);
            else XB_SPIN(xb_ld(&bar[XB_TOPGEN]) == tg, bar);
            __builtin_amdgcn_fence(__ATOMIC_ACQUIRE, "agent");
            xb_add(&bar[XB_XGEN(b.x)], 1u);
            asm volatile("s_waitcnt vmcnt(0)" ::: "memory");
        } else {
            XB_SPIN(xb_ld(&bar[XB_XGEN(b.x)]) == gen, bar);
            __builtin_amdgcn_fence(__ATOMIC_ACQUIRE, "agent");
            asm volatile("s_waitcnt vmcnt(0)" ::: "memory");
        }
    }
    __syncthreads();
}

namespace pg8 {
constexpr int BM = 256, BK = 64, HALF = 128, HTB = HALF * BK * 2, STAGE_BYTES = 8 * HTB, NXCD = 8, WGM = 8;
__host__ __device__ __forceinline__ int lds_byte(int r, int c) { const int st = (r >> 4) * 2 + (c >> 5), rr = r & 15, cc = c & 31, ob = rr * 64 + cc * 2; return st * 1024 + (ob ^ (((ob >> 9) & 1) << 5)); }
__host__ __device__ __forceinline__ void stage_rc(int b, int& R, int& C) { const int st = b / 1024, sb = b % 1024, swz = sb ^ (((sb >> 9) & 1) << 5); R = (st >> 1) * 16 + swz / 64; C = (st & 1) * 32 + (swz % 64) / 2; }
__host__ __device__ __forceinline__ int perm32(int rho) { const int n = rho >> 4, i = rho & 15; return 8 * (i >> 2) + 4 * n + (i & 3); }

struct Unit { int pm, pn, e, mt; };

__device__ __forceinline__ int xcd_remap(int wgid, int nwg) { const int q = nwg / NXCD, r = nwg % NXCD, xcd = wgid % NXCD, off = wgid / NXCD; return (xcd < r ? xcd * (q + 1) : r * (q + 1) + (xcd - r) * q) + off; }

struct DenseOrder {
    const char* A; const char* B; int K; int nM, nN, nwg, G, c;
    __device__ __forceinline__ void init(const bf16* A_, const bf16* B_, int M, int N, int K_, int G_, int c_) { A = (const char*)A_; B = (const char*)B_; K = K_; nM = M / BM; nN = N / BM; nwg = nM * nN; G = G_; c = c_; }
    __device__ __forceinline__ bool next(int i, Unit& u) const {
        const long L = (long)i * G + c; if (L >= nwg) return false;
        const int wgid = xcd_remap((int)L, nwg);
        const int nig = WGM * nN, gid = wgid / nig, fm = gid * WGM, gsz = (nM - fm) < WGM ? (nM - fm) : WGM;
        u.pm = fm + ((wgid % nig) % gsz); u.pn = (wgid % nig) / gsz; u.e = 0; u.mt = 0; return true;
    }
    __device__ __forceinline__ const char* a_ptr(const Unit& u) const { return A + (size_t)u.pm * BM * K * 2; }
    __device__ __forceinline__ const char* b_ptr(const Unit& u) const { return B + (size_t)u.pn * BM * K * 2; }
    __device__ __forceinline__ int tok(const Unit&, int) const { return 0; }
};
struct MoeOrder {
    const char* A; const char* B; int K; size_t bstride;
    const LAS int* tab; const int* list; int RT, nwg, G, c;
    __device__ __forceinline__ bool next(int i, Unit& u) const {
        const long L = (long)i * G + c; if (L >= nwg) return false;
        const int wgid = xcd_remap((int)L, nwg);
        const int rt = wgid >> 2; u.pm = rt; u.pn = wgid & 3; const int t = tab[rt]; u.e = t & 255; u.mt = t >> 8; return true;
    }
    __device__ __forceinline__ const char* a_ptr(const Unit& u) const { return A + (size_t)u.pm * BM * K * 2; }
    __device__ __forceinline__ const char* b_ptr(const Unit& u) const { return B + (size_t)u.e * bstride + (size_t)u.pn * BM * K * 2; }
    __device__ __forceinline__ int tok(const Unit& u, int r) const { const int cnt = tab[RT_MAX + 1 + u.e]; const int pos = u.mt * BM + r; return pos < cnt ? list[(size_t)u.e * TALL + pos] : 0; }
};

__device__ __forceinline__ unsigned cvt_pk_bf16(float lo, float hi) { unsigned r; asm volatile("v_cvt_pk_bf16_f32 %0, %1, %2" : "=v"(r) : "v"(lo), "v"(hi)); return r; }

template <class Epi, class Sched, bool GATHER>
__device__ __forceinline__ void gemm_phase(LAS unsigned char* lds, const int tid, const int K, const Sched& S, const Epi& E) {
    const int wid = __builtin_amdgcn_readfirstlane(tid >> 6), lane = tid & 63, wr = wid >> 2, wc = wid & 3, fr = lane & 15, fq = lane >> 4;
    const int nt = K / BK;
    unsigned voffA[2], voffB[2]; int RA[2], CA[2];
#pragma unroll
    for (int i = 0; i < 2; ++i) { int R, C; stage_rc(tid * 16 + i * 8192, R, C); const int Rb = Epi::PERM ? ((R & ~31) + perm32(R & 31)) : R;
        RA[i] = R; CA[i] = C; voffA[i] = (unsigned)(R * K + C) * 2u; voffB[i] = (unsigned)(Rb * K + C) * 2u; }
    const size_t kstep = (size_t)(BK * 2);
    const size_t hstep = (size_t)HALF * K * 2;
    const unsigned ldsw = (unsigned)wid * 1024u;
    const int aoff = lds_byte(wr * 64 + fr, fq * 8), boff = lds_byte(wc * 32 + fr, fq * 8);
#define PG8_SA(b, h) (((b) * 2 + (h)) * HTB)
#define PG8_SB(b, h) ((4 + (b) * 2 + (h)) * HTB)
#define PG8_STAGE(bufoff, gbase, voff) do { _Pragma("unroll") for (int _i = 0; _i < 2; ++_i) \
        __builtin_amdgcn_global_load_lds((const unsigned*)((const char*)(gbase) + (voff)[_i]), (LAS unsigned*)(lds + (bufoff) + ldsw + _i * 8192), 16, 0, 0); } while (0)
#define PG8_STAGE_A(bufoff, h, usenext, koff) do { if constexpr (GATHER) { unsigned _vo[2]; _vo[0] = (usenext) ? nvA[h][0] : vA[h][0]; _vo[1] = (usenext) ? nvA[h][1] : vA[h][1]; PG8_STAGE(bufoff, S.A + (koff), _vo); } \
        else { PG8_STAGE(bufoff, ((usenext) ? nA : cA) + (size_t)(h) * hstep + (koff), voffA); } } while (0)
#define PG8_LDA(dst, b, h) do { _Pragma("unroll") for (int m = 0; m < 4; ++m) _Pragma("unroll") for (int k = 0; k < 2; ++k) dst[m][k] = *(const LAS bf16x8*)(lds + PG8_SA(b, h) + aoff + m * 2048 + k * 1024); } while (0)
#define PG8_LDB(dst, b, h) do { _Pragma("unroll") for (int n = 0; n < 2; ++n) _Pragma("unroll") for (int k = 0; k < 2; ++k) dst[n][k] = *(const LAS bf16x8*)(lds + PG8_SB(b, h) + boff + n * 2048 + k * 1024); } while (0)
#define PG8_MMA(ai, bj, At, Bt) do { __builtin_amdgcn_s_setprio(1); _Pragma("unroll") for (int m = 0; m < 4; ++m) _Pragma("unroll") for (int n = 0; n < 2; ++n) _Pragma("unroll") for (int k = 0; k < 2; ++k) \
        acc[ai][bj][m][n] = __builtin_amdgcn_mfma_f32_16x16x32_bf16(Bt[n][k], At[m][k], acc[ai][bj][m][n], 0, 0, 0); __builtin_amdgcn_s_setprio(0); } while (0)
#define PG8_WAIT_V(n) asm volatile("s_waitcnt vmcnt(" #n ")" ::: "memory")
#define PG8_WAIT_L(n) asm volatile("s_waitcnt lgkmcnt(" #n ")" ::: "memory")
#define PG8_BAR __builtin_amdgcn_s_barrier()
#define PG8_SCHED __builtin_amdgcn_sched_barrier(0)
    Unit cur, nxt; int ui = 0;
    if (!S.next(0, cur)) return;
    f32x4 acc[2][2][4][2];
#pragma unroll
    for (int a = 0; a < 2; ++a)
#pragma unroll
        for (int b = 0; b < 2; ++b)
#pragma unroll
            for (int m = 0; m < 4; ++m)
#pragma unroll
                for (int n = 0; n < 2; ++n) acc[a][b][m][n] = (f32x4){0.f, 0.f, 0.f, 0.f};
    bf16x8 At[4][2], B0[2][2], B1[2][2];
    unsigned vA[2][2], nvA[2][2];
    if constexpr (GATHER) {
#pragma unroll
        for (int h = 0; h < 2; ++h)
#pragma unroll
            for (int i = 0; i < 2; ++i) { vA[h][i] = (unsigned)(S.tok(cur, h * HALF + RA[i]) * K + CA[i]) * 2u; nvA[h][i] = vA[h][i]; }
    }
    const char* cA = S.a_ptr(cur); const char* cB = S.b_ptr(cur); const char* nA = cA;
    PG8_STAGE(PG8_SB(0, 0), cB, voffB); PG8_STAGE(PG8_SB(0, 1), cB + hstep, voffB); PG8_STAGE_A(PG8_SA(0, 0), 0, false, 0); PG8_STAGE_A(PG8_SA(0, 1), 1, false, 0);
    if (wr == 1) PG8_BAR;
    PG8_WAIT_V(2); PG8_BAR;
    PG8_STAGE(PG8_SB(1, 0), cB + kstep, voffB); PG8_STAGE_A(PG8_SA(1, 0), 0, false, kstep); PG8_STAGE(PG8_SB(1, 1), cB + hstep + kstep, voffB);
    PG8_WAIT_V(6); PG8_BAR;
    for (;;) {
        const bool has_next = S.next(ui + 1, nxt);
        nA = has_next ? S.a_ptr(nxt) : cA; const char* nB = has_next ? S.b_ptr(nxt) : cB;
        if constexpr (GATHER) {
            if (has_next) {
#pragma unroll
                for (int h = 0; h < 2; ++h)
#pragma unroll
                    for (int i = 0; i < 2; ++i) nvA[h][i] = (unsigned)(S.tok(nxt, h * HALF + RA[i]) * K + CA[i]) * 2u;
            }
        }
        for (int t = 0; t < nt; t += 2) {
            const bool last = (t == nt - 2);
            const size_t k1 = (size_t)(t + 1) * kstep;
            const size_t k2 = last ? 0 : (size_t)(t + 2) * kstep, k3 = k2 + kstep;
            const char* b2 = last ? nB : cB + (size_t)(t + 2) * kstep; const char* b3 = b2 + kstep;
            PG8_LDB(B0, 0, 0); PG8_LDB(B1, 0, 1); PG8_SCHED; PG8_LDA(At, 0, 0); PG8_STAGE_A(PG8_SA(1, 1), 1, false, k1);
            PG8_WAIT_V(8); PG8_WAIT_L(0); PG8_BAR; PG8_MMA(0, 0, At, B0); PG8_MMA(0, 1, At, B1); PG8_BAR; PG8_SCHED;
            PG8_LDA(At, 0, 1); PG8_STAGE(PG8_SB(0, 0), b2, voffB); PG8_STAGE(PG8_SB(0, 1), b2 + hstep, voffB); PG8_STAGE_A(PG8_SA(0, 0), 0, last, k2);
            PG8_WAIT_V(8); PG8_WAIT_L(0); PG8_BAR; PG8_MMA(1, 0, At, B0); PG8_MMA(1, 1, At, B1); PG8_BAR; PG8_SCHED;
            PG8_LDB(B0, 1, 0); PG8_LDB(B1, 1, 1); PG8_SCHED; PG8_LDA(At, 1, 0); PG8_STAGE_A(PG8_SA(0, 1), 1, last, k2);
            PG8_WAIT_V(8); PG8_WAIT_L(0); PG8_BAR; PG8_MMA(0, 0, At, B0); PG8_MMA(0, 1, At, B1); PG8_BAR; PG8_SCHED;
            PG8_LDA(At, 1, 1); PG8_STAGE(PG8_SB(1, 0), b3, voffB); PG8_STAGE(PG8_SB(1, 1), b3 + hstep, voffB); PG8_STAGE_A(PG8_SA(1, 0), 0, last, k3);
            PG8_WAIT_V(8); PG8_WAIT_L(0); PG8_BAR; PG8_MMA(1, 0, At, B0); PG8_MMA(1, 1, At, B1); PG8_BAR; PG8_SCHED;
        }
        if (wr == 0) PG8_BAR;
        E(acc, cur, wr, wc, fr, fq);
        if (!has_next) break;
#pragma unroll
        for (int a = 0; a < 2; ++a)
#pragma unroll
            for (int b = 0; b < 2; ++b)
#pragma unroll
                for (int m = 0; m < 4; ++m)
#pragma unroll
                    for (int n = 0; n < 2; ++n) acc[a][b][m][n] = (f32x4){0.f, 0.f, 0.f, 0.f};
        cur = nxt; cA = nA; cB = nB; ++ui;
        if constexpr (GATHER) {
#pragma unroll
            for (int h = 0; h < 2; ++h)
#pragma unroll
                for (int i = 0; i < 2; ++i) vA[h][i] = nvA[h][i];
        }
        if (wr == 1) PG8_BAR;
    }
    PG8_WAIT_V(0);
    PG8_BAR;
#undef PG8_SA
#undef PG8_SB
#undef PG8_STAGE
#undef PG8_STAGE_A
#undef PG8_LDA
#undef PG8_LDB
#undef PG8_MMA
#undef PG8_WAIT_V
#undef PG8_WAIT_L
#undef PG8_BAR
#undef PG8_SCHED
}
}

namespace pg8 {
__device__ __forceinline__ void row_bt(int row, int& b, int& tok) { if (row < TX) { b = row >> 11; tok = row & 2047; } else { const int r = row - TX; b = r >> 8; tok = SEQ + (r & 255); } }

struct EpiAttnIn {
    static constexpr bool PERM = true;
    bf16* QKV; bf16* VAT; bf16* VBT; const LAS float* rope;
    __device__ __forceinline__ void operator()(const f32x4 (&acc)[2][2][4][2], const Unit& u, int wr, int wc, int fr, int fq) const {
        const int row0 = u.pm * BM + wr * 64 + fr; const int seg = u.pn >> 1;
        const bool latent = u.pm < (TX / BM);
        if (seg == 2 || seg == 5) {
#pragma unroll
            for (int ai = 0; ai < 2; ++ai)
#pragma unroll
                for (int m = 0; m < 4; ++m) { const int row = row0 + ai * HALF + m * 16; int b, tok; row_bt(row, b, tok);
#pragma unroll
                    for (int bj = 0; bj < 2; ++bj) { const int col = u.pn * BM + bj * HALF + wc * 32 + 8 * fq;
                        bf16* dst;
                        if (seg == 2) { const int cs = col - 1024; dst = VAT + ((size_t)(b * 4 + (cs >> 7)) * 128 + (cs & 127)) * NKEY + tok; }
                        else { const int cs = col - 2560; dst = VBT + ((size_t)(b * 8 + (cs >> 6)) * 64 + (cs & 63)) * NKEY + tok; }
#pragma unroll
                        for (int n = 0; n < 2; ++n)
#pragma unroll
                            for (int i = 0; i < 4; ++i) dst[(size_t)(4 * n + i) * NKEY] = (bf16)f2bf(acc[ai][bj][m][n][i]); } }
            return;
        }
        const bool dorope = latent && seg < 2;
        const float qs = (seg == 0 || seg == 3) ? 0.125f * LOG2E : 1.0f;
#pragma unroll
        for (int ai = 0; ai < 2; ++ai)
#pragma unroll
            for (int m = 0; m < 4; ++m) { const int row = row0 + ai * HALF + m * 16;
                f32x4 cs4[4];
                if (dorope) { const int t = row & 2047; const int pos = (wc & 1) ? (t & 63) : (t >> 6);
                    const LAS f32x4* rp = (const LAS f32x4*)(rope + (pos * 16 + 8 * (fq & 1)) * 2);
#pragma unroll
                    for (int j = 0; j < 4; ++j) cs4[j] = rp[j]; }
#pragma unroll
                for (int bj = 0; bj < 2; ++bj) { const int col = u.pn * BM + bj * HALF + wc * 32 + 8 * fq;
                    float v[8];
#pragma unroll
                    for (int n = 0; n < 2; ++n)
#pragma unroll
                        for (int i = 0; i < 4; ++i) v[4 * n + i] = acc[ai][bj][m][n][i];
                    if (dorope) {
#pragma unroll
                        for (int j = 0; j < 8; ++j) { const float other = __shfl_xor(v[j], 32); const float c = cs4[j >> 1][(j & 1) * 2], s = cs4[j >> 1][(j & 1) * 2 + 1];
                            v[j] = (fq < 2) ? (v[j] * c - other * s) : (v[j] * c + other * s); } }
                    u32x4 w; w.x = pk2(v[0] * qs, v[1] * qs); w.y = pk2(v[2] * qs, v[3] * qs); w.z = pk2(v[4] * qs, v[5] * qs); w.w = pk2(v[6] * qs, v[7] * qs);
                    *(u32x4*)(QKV + (size_t)row * NATT + col) = w; } }
    }
};
struct EpiGlaIn {
    static constexpr bool PERM = true;
    bf16* QKV2; bf16* VGT;
    __device__ __forceinline__ void operator()(const f32x4 (&acc)[2][2][4][2], const Unit& u, int wr, int wc, int fr, int fq) const {
        const int row0 = u.pm * BM + wr * 64 + fr;
        if (u.pn >= 4 && u.pn < 8) {
#pragma unroll
            for (int ai = 0; ai < 2; ++ai)
#pragma unroll
                for (int m = 0; m < 4; ++m) { const int row = row0 + ai * HALF + m * 16; int b, tok; row_bt(row, b, tok);
#pragma unroll
                    for (int bj = 0; bj < 2; ++bj) { const int cs = u.pn * BM + bj * HALF + wc * 32 + 8 * fq - 1024;
                        bf16* dst = VGT + ((size_t)(b * 4 + (cs >> 8)) * 256 + (cs & 255)) * NKEY + tok;
#pragma unroll
                        for (int n = 0; n < 2; ++n)
#pragma unroll
                            for (int i = 0; i < 4; ++i) dst[(size_t)(4 * n + i) * NKEY] = (bf16)f2bf(acc[ai][bj][m][n][i]); } }
            return;
        }
        const float qs = (u.pn < 2) ? 0.08838834764831845f : 1.0f;
#pragma unroll
        for (int ai = 0; ai < 2; ++ai)
#pragma unroll
            for (int m = 0; m < 4; ++m) { const int row = row0 + ai * HALF + m * 16;
#pragma unroll
                for (int bj = 0; bj < 2; ++bj) { const int col = u.pn * BM + bj * HALF + wc * 32 + 8 * fq; const f32x4 a = acc[ai][bj][m][0] * qs, c = acc[ai][bj][m][1] * qs;
                    u32x4 w; w.x = pk2(a[0], a[1]); w.y = pk2(a[2], a[3]); w.z = pk2(c[0], c[1]); w.w = pk2(c[2], c[3]);
                    *(u32x4*)(QKV2 + (size_t)row * NGLA + col) = w; } }
    }
};
struct EpiResid {
    static constexpr bool PERM = false;
    float* XL; float* XC; const float* modv;
    __device__ __forceinline__ void operator()(const f32x4 (&acc)[2][2][4][2], const Unit& u, int wr, int wc, int fr, int fq) const {
        const int row0 = u.pm * BM + wr * 64 + fr, col0 = u.pn * BM + wc * 32 + 4 * fq;
        const bool latent = u.pm < (TX / BM); const int bi = latent ? (u.pm >> 3) : 8;
        float* base = latent ? XL : (XC - (size_t)TX * D);
        f32x4 gv[2][2];
#pragma unroll
        for (int bj = 0; bj < 2; ++bj)
#pragma unroll
            for (int n = 0; n < 2; ++n) gv[bj][n] = *(const f32x4*)(modv + bi * 6144 + col0 + bj * HALF + n * 16);
#pragma unroll
        for (int ai = 0; ai < 2; ++ai)
#pragma unroll
            for (int m = 0; m < 4; ++m) { float* rowp = base + (size_t)(row0 + ai * HALF + m * 16) * D + col0;
#pragma unroll
                for (int bj = 0; bj < 2; ++bj)
#pragma unroll
                    for (int n = 0; n < 2; ++n) { f32x4* p = (f32x4*)(rowp + bj * HALF + n * 16); *p = *p + gv[bj][n] * acc[ai][bj][m][n]; } }
    }
};
struct EpiMoe1 {
    static constexpr bool PERM = false;
    bf16* HB;
    __device__ __forceinline__ void operator()(const f32x4 (&acc)[2][2][4][2], const Unit& u, int wr, int wc, int fr, int fq) const {
        const int row0 = u.pm * BM + wr * 64 + fr, col0 = u.pn * 128 + wc * 16 + 4 * fq;
#pragma unroll
        for (int ai = 0; ai < 2; ++ai)
#pragma unroll
            for (int m = 0; m < 4; ++m) { bf16* rowp = HB + (size_t)(row0 + ai * HALF + m * 16) * DEXP + col0;
#pragma unroll
                for (int bj = 0; bj < 2; ++bj) { const f32x4 a = acc[ai][bj][m][0], b = acc[ai][bj][m][1];
                    u32x2 w; w.x = pk2(silu_f(a[0]) * b[0], silu_f(a[1]) * b[1]); w.y = pk2(silu_f(a[2]) * b[2], silu_f(a[3]) * b[3]);
                    *(u32x2*)(rowp + bj * 64) = w; } }
    }
};
struct EpiBf16 {
    static constexpr bool PERM = true;
    bf16* O; int ldc;
    __device__ __forceinline__ void operator()(const f32x4 (&acc)[2][2][4][2], const Unit& u, int wr, int wc, int fr, int fq) const {
        const int row0 = u.pm * BM + wr * 64 + fr, col0 = u.pn * BM + wc * 32 + 8 * fq;
#pragma unroll
        for (int ai = 0; ai < 2; ++ai)
#pragma unroll
            for (int m = 0; m < 4; ++m) { bf16* rowp = O + (size_t)(row0 + ai * HALF + m * 16) * ldc + col0;
#pragma unroll
                for (int bj = 0; bj < 2; ++bj) { const f32x4 a = acc[ai][bj][m][0], c = acc[ai][bj][m][1];
                    u32x4 w; w.x = pk2(a[0], a[1]); w.y = pk2(a[2], a[3]); w.z = pk2(c[0], c[1]); w.w = pk2(c[2], c[3]);
                    *(u32x4*)(rowp + bj * HALF) = w; } }
    }
};
}

struct Args {
    const float *x, *c, *ctx, *c_ctx, *w_mod, *b_mod, *norm_g, *final_g, *att_w_in, *att_w_out, *att_lambda, *att_subln_g, *na_bias,
                *gla_w_in, *gla_w_gate, *gla_b_gate, *gla_norm_g, *gla_w_out, *router_w, *router_bias, *moe_w1, *moe_w3, *moe_w2;
    float* out; unsigned char* ws; int ph_lo, ph_hi, rep, pad;
};

struct RowMapId { int off; __device__ __forceinline__ int operator()(int n) const { return off + n; } };
struct RowMapMoe { int which; __device__ __forceinline__ int operator()(int n) const { return 32 * (n >> 4) + 16 * which + (n & 15); } };
template <class RM>
__device__ __forceinline__ void p0_transpose_item(const float* W, int K, int N, bf16* WT, LAS float* scr, int item, int lane, RM rm) {
    const int nblk = N / 32, kb = item / nblk, nb = item % nblk, k0 = 64 * kb, n0 = 32 * nb;
#pragma unroll 8
    for (int i = 0; i < 32; ++i) { const int kk = 2 * i + (lane >> 5); scr[kk * 33 + (lane & 31)] = W[(size_t)(k0 + kk) * N + n0 + (lane & 31)]; }
    LDS_WAIT(); asm volatile("" ::: "memory");
    const int c = lane & 7;
#pragma unroll
    for (int j = 0; j < 4; ++j) { const int n = (lane >> 3) + 8 * j; const LAS float* s = scr + (8 * c) * 33 + n;
        u32x4 o; o.x = pk2(s[0 * 33], s[1 * 33]); o.y = pk2(s[2 * 33], s[3 * 33]); o.z = pk2(s[4 * 33], s[5 * 33]); o.w = pk2(s[6 * 33], s[7 * 33]);
        *(u32x4*)(WT + (size_t)rm(n0 + n) * K + k0 + 8 * c) = o; }
    LDS_WAIT(); asm volatile("" ::: "memory");
}

template <class AP> __device__ __forceinline__ void p0_prologue(const AP ap, LAS unsigned char* lds, int tid, int lane, int wave, int vcu, int G) {
    const Args a = Args{ap->x, ap->c, ap->ctx, ap->c_ctx, ap->w_mod, ap->b_mod, ap->norm_g, ap->final_g, ap->att_w_in, ap->att_w_out, ap->att_lambda, ap->att_subln_g, ap->na_bias, ap->gla_w_in, ap->gla_w_gate, ap->gla_b_gate, ap->gla_norm_g, ap->gla_w_out, ap->router_w, ap->router_bias, ap->moe_w1, ap->moe_w3, ap->moe_w2, ap->out, ap->ws, 0, 0, 0, 0};
    unsigned char* ws = a.ws;
    LAS float* scr = (LAS float*)(lds + wave * 8448);
    LAS float* S9 = (LAS float*)(lds + 69632);
    LAS float* red = (LAS float*)(lds + 106496);
    const int gw = vcu * 8 + wave, NGW = G * 8;
    constexpr int I_AIN = 16 * 96, I_AOUT = 16 * 32, I_GIN = 16 * 97, I_GOUT = 16 * 32, I_W1 = 16 * 16, I_W2 = 8 * 32;
    constexpr int N_A = 2 * I_AIN, N_B = N_A + 2 * I_AOUT, N_C = N_B + 2 * I_GIN, N_D = N_C + 2 * I_GOUT, N_E = N_D + 64 * I_W1, N_F = N_E + 64 * I_W1, N_G = N_F + 64 * I_W2;
    for (int it = gw; it < N_G; it += NGW) {
        if (it < N_A) { const int j = it / I_AIN, r = it % I_AIN; p0_transpose_item(a.att_w_in + (size_t)j * D * NATT, D, NATT, (bf16*)(ws + WS_WATTIN) + (size_t)j * NATT * D, scr, r, lane, RowMapId{0}); }
        else if (it < N_B) { const int q = it - N_A, j = q / I_AOUT, r = q % I_AOUT; p0_transpose_item(a.att_w_out + (size_t)j * D * D, D, D, (bf16*)(ws + WS_WATTOUT) + (size_t)j * D * D, scr, r, lane, RowMapId{0}); }
        else if (it < N_C) { const int q = it - N_B, j = q / I_GIN, r = q % I_GIN; p0_transpose_item(a.gla_w_in + (size_t)j * D * 3104, D, 3104, (bf16*)(ws + WS_WGLAIN) + (size_t)j * NGLA * D, scr, r, lane, RowMapId{0}); }
        else if (it < N_D) { const int q = it - N_C, j = q / I_GOUT, r = q % I_GOUT; p0_transpose_item(a.gla_w_out + (size_t)j * D * D, D, D, (bf16*)(ws + WS_WGLAOUT) + (size_t)j * D * D, scr, r, lane, RowMapId{0}); }
        else if (it < N_E) { const int q = it - N_D, j = q / I_W1, r = q % I_W1; p0_transpose_item(a.moe_w1 + (size_t)j * D * DEXP, D, DEXP, (bf16*)(ws + WS_W13) + (size_t)j * D * D, scr, r, lane, RowMapMoe{0}); }
        else if (it < N_F) { const int q = it - N_E, j = q / I_W1, r = q % I_W1; p0_transpose_item(a.moe_w3 + (size_t)j * D * DEXP, D, DEXP, (bf16*)(ws + WS_W13) + (size_t)j * D * D, scr, r, lane, RowMapMoe{1}); }
        else { const int q = it - N_F, j = q / I_W2, r = q % I_W2; p0_transpose_item(a.moe_w2 + (size_t)j * DEXP * D, DEXP, D, (bf16*)(ws + WS_W2) + (size_t)j * D * DEXP, scr, r, lane, RowMapId{0}); }
    }
    { const int gt = vcu * 512 + tid, NT = G * 512;
      for (int i = gt; i < 2 * 28672; i += NT) { const int j = i / 28672, r = i % 28672; *(u32x4*)((bf16*)(ws + WS_WGLAIN) + (size_t)j * NGLA * D + (size_t)3104 * D + (size_t)r * 8) = (u32x4){0u, 0u, 0u, 0u}; }
      const f32x4* xs = (const f32x4*)a.x; f32x4* xo = (f32x4*)a.out;
      for (int i = gt; i < TX * D / 4; i += NT) xo[i] = xs[i];
      const f32x4* cs = (const f32x4*)a.ctx; f32x4* co = (f32x4*)(ws + WS_CTX);
      for (int i = gt; i < TC * D / 4; i += NT) co[i] = cs[i];
    }
    __syncthreads();
    for (int i = tid; i < 9 * 1024; i += 512) { const int bi = i >> 10, k = i & 1023; const float v = (bi < 8) ? a.c[bi * D + k] : a.c_ctx[k]; S9[i] = v / (1.0f + __expf(-v)); }
    __syncthreads();
    for (int u = vcu; u < 4 * 96; u += G) {
        const int L = u / 96, n0 = (u % 96) * 64;
        const float* W = a.w_mod + (size_t)L * D * 6144 + n0 + lane;
        float acc[9];
#pragma unroll
        for (int bi = 0; bi < 9; ++bi) acc[bi] = 0.f;
        const int kb = wave * 128;
#pragma unroll 8
        for (int k = 0; k < 128; ++k) { const float w = W[(size_t)(kb + k) * 6144];
#pragma unroll
            for (int bi = 0; bi < 9; ++bi) acc[bi] += S9[bi * 1024 + kb + k] * w; }
#pragma unroll
        for (int bi = 0; bi < 9; ++bi) red[(wave * 9 + bi) * 64 + lane] = acc[bi];
        __syncthreads();
        for (int i = tid; i < 9 * 64; i += 512) { const int bi = i >> 6, l = i & 63; float s = a.b_mod[L * 6144 + n0 + l];
#pragma unroll
            for (int w = 0; w < 8; ++w) s += red[(w * 9 + bi) * 64 + l];
            ((float*)(ws + WS_MODV))[(size_t)(L * 9 + bi) * 6144 + n0 + l] = s; }
        __syncthreads();
    }
}

__device__ __forceinline__ float* xrow_ptr(float* XL, float* XC, int row) { return row < TX ? XL + (size_t)row * D : XC + (size_t)(row - TX) * D; }
__device__ __forceinline__ int row_bi(int row) { return row < TX ? (row >> 11) : 8; }

__device__ __forceinline__ void norm_mod_store(const f32x4 (&v)[4], const float* g, const float* sh, const float* sc, bf16* orow, int lane) {
    float ss = 0.f;
#pragma unroll
    for (int j = 0; j < 4; ++j) ss += (v[j].x * v[j].x + v[j].y * v[j].y) + (v[j].z * v[j].z + v[j].w * v[j].w);
    const float rs = __builtin_amdgcn_rsqf(wave_sum(ss) * (1.0f / D) + EPSF);
#pragma unroll
    for (int j = 0; j < 4; ++j) { const int c = 4 * lane + 256 * j; const f32x4 gg = *(const f32x4*)(g + c), s1 = *(const f32x4*)(sc + c), s0 = *(const f32x4*)(sh + c);
        const f32x4 y = (v[j] * rs) * gg * (1.0f + s1) + s0;
        u32x2 w; w.x = pk2(y.x, y.y); w.y = pk2(y.z, y.w); *(u32x2*)(orow + c) = w; }
}

__device__ __forceinline__ void phase_norm1(float* XL, float* XC, const float* g, const float* modv, bf16* H, int nrows, int lane, int wave, int vcu, int G) {
    for (int row = vcu * 8 + wave; row < nrows; row += G * 8) {
        const f32x4* xr = (const f32x4*)xrow_ptr(XL, XC, row) + lane; f32x4 v[4];
#pragma unroll
        for (int j = 0; j < 4; ++j) v[j] = xr[64 * j];
        const float* mv = modv + row_bi(row) * 6144;
        norm_mod_store(v, g, mv, mv + 1024, H + (size_t)row * D, lane);
    }
}

__device__ __forceinline__ void phase_router(float* XL, float* XC, const float* g, const float* modv, bf16* H, const float* router_w, const float* router_bias,
                                             unsigned* cnt  , int* list, int* toki, float* tokw, int nrows,
                                             LAS unsigned char* lds, int tid, int lane, int wave, int vcu, int G, int probe) {
    LAS float* RW = (LAS float*)lds;
    LAS int* lcnt = (LAS int*)(lds + 65536);
    LAS int* rinfo = (LAS int*)(lds + 65536 + 256);
    for (int it = 0; it < 8; ++it) { const int idx = tid + 512 * it, k = idx >> 2, q = idx & 3; const f32x4 w = *(const f32x4*)(router_w + k * 16 + 4 * q);
        RW[(4 * q + 0) * 1024 + k] = w.x; RW[(4 * q + 1) * 1024 + k] = w.y; RW[(4 * q + 2) * 1024 + k] = w.z; RW[(4 * q + 3) * 1024 + k] = w.w; }
    if (tid < 32) lcnt[tid] = 0;
    __syncthreads();
    const int rpb = nrows / G, rpw = rpb / 8;
    const int gI = lane >> 4;
    const f32x4 rb = *(const f32x4*)(router_bias + 4 * gI);
    for (int rep = (probe ? 0 : 1); rep < 2; ++rep)
    for (int i0 = 0; i0 < rpw; i0 += 3) {
        asm volatile("" ::: "memory");
        f32x4 y[3][4];
#pragma unroll
        for (int r = 0; r < 3; ++r) {
            const int ii = (i0 + r < rpw) ? i0 + r : rpw - 1; const int row = vcu * rpb + wave * rpw + ii;
            const f32x4* xr = (const f32x4*)xrow_ptr(XL, XC, row) + lane; f32x4 v[4];
#pragma unroll
            for (int j = 0; j < 4; ++j) v[j] = xr[64 * j];
            const float* mv = modv + row_bi(row) * 6144 + 3072;
            float ss = 0.f;
#pragma unroll
            for (int j = 0; j < 4; ++j) ss += (v[j].x * v[j].x + v[j].y * v[j].y) + (v[j].z * v[j].z + v[j].w * v[j].w);
            const float rs = __builtin_amdgcn_rsqf(wave_sum(ss) * (1.0f / D) + EPSF);
#pragma unroll
            for (int j = 0; j < 4; ++j) { const int c = 4 * lane + 256 * j; const f32x4 gg = *(const f32x4*)(g + c), s1 = *(const f32x4*)(mv + 1024 + c), s0 = *(const f32x4*)(mv + c);
                y[r][j] = (v[j] * rs) * gg * (1.0f + s1) + s0;
                u32x2 w; w.x = cvtpk(y[r][j].x, y[r][j].y); w.y = cvtpk(y[r][j].z, y[r][j].w); *(u32x2*)(H + (size_t)row * D + c) = w; }
            __builtin_amdgcn_sched_barrier(0);
        }
        float p[3][16];
#pragma unroll
        for (int e = 0; e < 16; ++e) {
#pragma unroll
            for (int r = 0; r < 3; ++r) p[r][e] = 0.f;
#pragma unroll
            for (int j = 0; j < 4; ++j) { const f32x4 w = *(const LAS f32x4*)(RW + e * 1024 + 4 * lane + 256 * j);
#pragma unroll
                for (int r = 0; r < 3; ++r) p[r][e] += (y[r][j].x * w.x + y[r][j].y * w.y) + (y[r][j].z * w.z + y[r][j].w * w.w); }
#pragma unroll
            for (int r = 0; r < 3; ++r) asm volatile("" : "+v"(p[r][e])); }
#pragma unroll
        for (int r = 0; r < 3; ++r) {
            float q8[8], lg[4];
#pragma unroll
            for (int j = 0; j < 8; ++j) q8[j] = swap32_add(p[r][j], p[r][j + 8]);
#pragma unroll
            for (int j = 0; j < 4; ++j) lg[j] = row_sum(swap16_add(q8[j], q8[j + 4]));
            float sc[4], sel[4];
#pragma unroll
            for (int j = 0; j < 4; ++j) { sc[j] = 1.0f / (1.0f + __expf(-lg[j])); sel[j] = sc[j] + rb[j]; }
            int i1 = 0, i2 = 0; float m1 = -1e30f, m2 = -1e30f, w1 = 0.f, w2 = 0.f;
#pragma unroll
            for (int j = 0; j < 4; ++j) { const float t = sel[j];
                if (t > m1) { m2 = m1; i2 = i1; w2 = w1; m1 = t; i1 = j; w1 = sc[j]; } else if (t > m2) { m2 = t; i2 = j; w2 = sc[j]; } }
            const float gs = m1 + m2;
            const float g0 = readlane_f(gs, 0), g1 = readlane_f(gs, 16), g2 = readlane_f(gs, 32), g3 = readlane_f(gs, 48);
            int bg = 0; float bgs = g0; if (g1 > bgs) { bgs = g1; bg = 1; } if (g2 > bgs) { bgs = g2; bg = 2; } if (g3 > bgs) { bgs = g3; bg = 3; }
            bg = __builtin_amdgcn_readfirstlane(bg);
            const int e0 = 4 * bg + __builtin_amdgcn_readlane(i1, 16 * bg), e1 = 4 * bg + __builtin_amdgcn_readlane(i2, 16 * bg);
            const float w0 = readlane_f(w1, 16 * bg), w1s = readlane_f(w2, 16 * bg);
            const float wn = 1.0f / (w0 + w1s);
            if (lane == 0 && rep == 1 && i0 + r < rpw) { const int rl = wave * rpw + i0 + r;
                const int p0 = __hip_atomic_fetch_add(&lcnt[e0], 1, __ATOMIC_RELAXED, __HIP_MEMORY_SCOPE_WORKGROUP), p1 = __hip_atomic_fetch_add(&lcnt[e1], 1, __ATOMIC_RELAXED, __HIP_MEMORY_SCOPE_WORKGROUP);
                rinfo[rl * 6 + 0] = e0; rinfo[rl * 6 + 1] = p0; rinfo[rl * 6 + 2] = e1; rinfo[rl * 6 + 3] = p1;
                rinfo[rl * 6 + 4] = __builtin_bit_cast(int, w0 * wn); rinfo[rl * 6 + 5] = __builtin_bit_cast(int, w1s * wn); }
        }
    }
    __syncthreads();
    if (tid < 16) lcnt[16 + tid] = (int)__hip_atomic_fetch_add(cnt + 64 * tid, (unsigned)lcnt[tid], RLX_AGENT);
    __syncthreads();
    if (tid < rpb) { const int row = vcu * rpb + tid; const int e0 = rinfo[tid * 6 + 0], e1 = rinfo[tid * 6 + 2];
        const int p0 = lcnt[16 + e0] + rinfo[tid * 6 + 1], p1 = lcnt[16 + e1] + rinfo[tid * 6 + 3];
        list[(size_t)e0 * TALL + p0] = row; list[(size_t)e1 * TALL + p1] = row;
        toki[row * 4 + 0] = e0; toki[row * 4 + 1] = p0; toki[row * 4 + 2] = e1; toki[row * 4 + 3] = p1;
        tokw[row * 2 + 0] = __builtin_bit_cast(float, rinfo[tid * 6 + 4]); tokw[row * 2 + 1] = __builtin_bit_cast(float, rinfo[tid * 6 + 5]); }
    __syncthreads();
}

__device__ __forceinline__ int build_moe_table(const unsigned* cnt, LAS int* tab, int tid) {
    if (tid == 0) { int rt = 0;
        for (int e = 0; e < 16; ++e) { const int c = (int)__hip_atomic_load(cnt + 64 * e, RLX_AGENT); tab[RT_MAX + 1 + e] = c; const int nt = (c + 255) >> 8;
            for (int m = 0; m < nt; ++m) { if (rt < RT_MAX) tab[rt] = e | (m << 8); ++rt; } }
        tab[RT_MAX] = rt < RT_MAX ? rt : RT_MAX; }
    __syncthreads();
    return tab[RT_MAX];
}

__device__ __forceinline__ void phase_combine(float* XL, float* XC, const float* modv  , const bf16* YB, const unsigned* cnt, const int* toki, const float* tokw,
                                              bool final_layer, const float* gnext, const float* modv_next, bf16* H, int nrows, int lane, int wave, int vcu, int G, int probe) {
    int tiles = 0; if (lane < 16) tiles = ((int)__hip_atomic_load(cnt + 64 * lane, RLX_AGENT) + 255) >> 8;
    int incl = tiles;
#pragma unroll
    for (int o = 1; o < 16; o <<= 1) { const int t = __shfl_up(incl, o); if (lane >= o) incl += t; }
    const int mybase = (incl - tiles) * 256;
    for (int rep = (probe ? 0 : 1); rep < 2; ++rep)
    for (int row = vcu * 8 + wave; row < nrows; row += G * 8) {
        const int e0 = toki[row * 4 + 0], p0 = toki[row * 4 + 1], e1 = toki[row * 4 + 2], p1 = toki[row * 4 + 3];
        const float w0 = tokw[row * 2 + 0], w1 = tokw[row * 2 + 1];
        const int s0 = __shfl(mybase, e0) + p0, s1 = __shfl(mybase, e1) + p1;
        float* xp = xrow_ptr(XL, XC, row);
        const float* g2 = modv + row_bi(row) * 6144 + 5120;
        f32x4 v[4];
#pragma unroll
        for (int j = 0; j < 4; ++j) { const int c = 4 * lane + 256 * j;
            const u32x2 a = *(const u32x2*)(YB + (size_t)s0 * D + c), b = *(const u32x2*)(YB + (size_t)s1 * D + c);
            f32x4 y; y.x = w0 * bflo(a.x) + w1 * bflo(b.x); y.y = w0 * bfhi(a.x) + w1 * bfhi(b.x); y.z = w0 * bflo(a.y) + w1 * bflo(b.y); y.w = w0 * bfhi(a.y) + w1 * bfhi(b.y);
            v[j] = *(const f32x4*)(xp + c) + *(const f32x4*)(g2 + c) * y; }
        if (final_layer) {
            float ss = 0.f;
#pragma unroll
            for (int j = 0; j < 4; ++j) ss += (v[j].x * v[j].x + v[j].y * v[j].y) + (v[j].z * v[j].z + v[j].w * v[j].w);
            const float rs = __builtin_amdgcn_rsqf(wave_sum(ss) * (1.0f / D) + EPSF);
#pragma unroll
            for (int j = 0; j < 4; ++j) { const int c = 4 * lane + 256 * j; if (rep == 1) *(f32x4*)(xp + c) = (v[j] * rs) * *(const f32x4*)(gnext + c); }
        } else {
            if (rep == 1) {
#pragma unroll
            for (int j = 0; j < 4; ++j) *(f32x4*)(xp + 4 * lane + 256 * j) = v[j]; }
            const float* mv = modv_next + row_bi(row) * 6144;
            norm_mod_store(v, gnext, mv, mv + 1024, H + (size_t)row * D, lane);
        }
    }
}

__device__ __forceinline__ void phase_readout(const bf16* OF, const bf16* OB, const bf16* QKV2, const float* ng, bf16* AOUT, int nrows, int lane, int wave, int vcu, int G) {
    const f32x4 gg = *(const f32x4*)(ng + 4 * lane);
    for (int row = vcu * 8 + wave; row < nrows; row += G * 8) {
#pragma unroll
        for (int j = 0; j < 4; ++j) { const int c = 4 * lane + 256 * j;
            const u32x2 a = *(const u32x2*)(OF + (size_t)row * D + c), b = *(const u32x2*)(OB + (size_t)row * D + c), gt = *(const u32x2*)(QKV2 + (size_t)row * NGLA + 2048 + c);
            f32x4 o; o.x = bflo(a.x) + bflo(b.x); o.y = bfhi(a.x) + bfhi(b.x); o.z = bflo(a.y) + bflo(b.y); o.w = bfhi(a.y) + bfhi(b.y);
            const float ss = wave_sum((o.x * o.x + o.y * o.y) + (o.z * o.z + o.w * o.w));
            const float rs = __builtin_amdgcn_rsqf(ss * (1.0f / 256.0f) + EPSF);
            f32x4 gv; gv.x = silu_f(bflo(gt.x)); gv.y = silu_f(bfhi(gt.x)); gv.z = silu_f(bflo(gt.y)); gv.w = silu_f(bfhi(gt.y));
            const f32x4 y = (o * rs) * gg * gv;
            u32x2 w; w.x = pk2(y.x, y.y); w.y = pk2(y.z, y.w); *(u32x2*)(AOUT + (size_t)row * D + c) = w; }
    }
}

__device__ __forceinline__ int na_r0(int r) { int v = r - 4; return v < 0 ? 0 : (v > 24 ? 24 : v); }
template <int NMAPS, int DV, bool NA>
__device__ __forceinline__ void attn_unit(LAS unsigned char* lds, int tid, int lane, int wave,
                                          const bf16* QKV, int qcol, int qrow0, int kcol, int krow_lat, int krow_ctx, const bf16* VT, int klo, int khi,
                                          int r_wave, int xq0, const LAS float* biasT,
                                          bf16* AOUT, int ocol, float lam, const float* subg, float outscale) {
    constexpr int KB = 9216;
    constexpr int BUFSZ = NMAPS * KB + DV * 144;
    constexpr int NVB = DV / 16, NVR = DV / 64;
    const int fr = lane & 15, g = lane >> 4;
    bf16x8 qf[NMAPS][2];
    { const bf16* qp = QKV + (size_t)(qrow0 + wave * 16 + fr) * NATT + qcol + 8 * g;
#pragma unroll
      for (int m = 0; m < NMAPS; ++m)
#pragma unroll
          for (int s = 0; s < 2; ++s) qf[m][s] = *(const bf16x8*)(qp + m * 64 + 32 * s); }
    f32x4 O[NMAPS][NVB]; float mrun[NMAPS]; f32x2 lrun[NMAPS];
#pragma unroll
    for (int m = 0; m < NMAPS; ++m) { mrun[m] = -1e30f; lrun[m] = (f32x2){0.f, 0.f};
#pragma unroll
        for (int vb = 0; vb < NVB; ++vb) O[m][vb] = (f32x4){0.f, 0.f, 0.f, 0.f}; }
    const int ntiles = 4 + (khi - klo);
    u32x4 kreg[NMAPS], vreg[NVR];
    const int lkey = tid >> 3, lch = tid & 7;
#define AT_LOAD(i) do { const int _i = (i); const int _rowg = (_i < 4 ? krow_ctx + 64 * _i : krow_lat + 64 * (klo + _i - 4)) + lkey; const int _tok0 = (_i < 4 ? SEQ + 64 * _i : 64 * (klo + _i - 4)); \
        _Pragma("unroll") for (int m = 0; m < NMAPS; ++m) kreg[m] = *(const u32x4*)(QKV + (size_t)_rowg * NATT + kcol + m * 64 + lch * 8); \
        _Pragma("unroll") for (int j = 0; j < NVR; ++j) { const int idx = tid + 512 * j; vreg[j] = *(const u32x4*)(VT + (size_t)(idx >> 3) * NKEY + _tok0 + (idx & 7) * 8); } } while (0)
#define AT_STORE(b) do { LAS unsigned char* _p = lds + (b) * BUFSZ; \
        _Pragma("unroll") for (int m = 0; m < NMAPS; ++m) *(LAS u32x4*)(_p + m * KB + lkey * 144 + lch * 16) = kreg[m]; \
        _Pragma("unroll") for (int j = 0; j < NVR; ++j) { const int idx = tid + 512 * j; *(LAS u32x4*)(_p + NMAPS * KB + (idx >> 3) * 144 + (idx & 7) * 16) = vreg[j]; } } while (0)
    AT_LOAD(0); AT_STORE(0); __syncthreads();
    const int kbase0 = (8 * (fr >> 2) + (fr & 3)) * 144 + 16 * g;
    const int vbase = fr * 144 + 16 * g;
    int r0w = 0, xq = 0, tmask = 3; float pen[4][4];
    if constexpr (NA) { r0w = na_r0(r_wave); xq = xq0 + fr; int cs = xq - 8; cs = cs < 0 ? 0 : (cs > 48 ? 48 : cs);
        int c0 = xq0 - 8; c0 = c0 < 0 ? 0 : (c0 > 48 ? 48 : c0); int c1 = xq0 + 15 - 8; c1 = (c1 < 0 ? 0 : (c1 > 48 ? 48 : c1)) + 16;
        tmask = (c0 < 32 ? 1 : 0) | (c1 > 32 ? 2 : 0);
#pragma unroll
        for (int kb = 0; kb < 4; ++kb)
#pragma unroll
            for (int ii = 0; ii < 4; ++ii) { const int y = 32 * (kb >> 1) + 8 * g + 4 * (kb & 1) + ii; pen[kb][ii] = (y >= cs && y < cs + 16) ? 0.f : -1e30f; } }
    for (int i = 0; i < ntiles; ++i) {
        if (i + 1 < ntiles) AT_LOAD(i + 1);
        const LAS unsigned char* buf = lds + (i & 1) * BUFSZ;
        bool active = true; int kr = 0; bool local = false;
        if constexpr (NA) { if (i >= 4) { local = true; kr = klo + i - 4; active = (kr >= r0w) && (kr < r0w + 8); } }
        if (active) {
            const int tm = local ? tmask : 3;
            bf16x8 pf[NMAPS][2];
#pragma unroll
            for (int m = 0; m < NMAPS; ++m) {
                f32x4 S[4];
#pragma unroll
                for (int kb = 0; kb < 4; ++kb) { S[kb] = (f32x4){0.f, 0.f, 0.f, 0.f};
                    if (!NA || (tm >> (kb >> 1)) & 1) {
#pragma unroll
                        for (int s = 0; s < 2; ++s) { const bf16x8 kf = *(const LAS bf16x8*)(buf + m * KB + kbase0 + (kb & 1) * (4 * 144) + (kb >> 1) * (32 * 144) + s * 64);
                            S[kb] = __builtin_amdgcn_mfma_f32_16x16x32_bf16(kf, qf[m][s], S[kb], 0, 0, 0); } } }
                if constexpr (NA) { if (local) {
                        const LAS float* bp = biasT + (kr - r_wave + 7) * 31 + (8 * g - xq + 15);
#pragma unroll
                        for (int kb = 0; kb < 4; ++kb)
#pragma unroll
                            for (int ii = 0; ii < 4; ++ii) { const float t = (tm >> (kb >> 1)) & 1 ? (S[kb][ii] + pen[kb][ii]) + bp[32 * (kb >> 1) + 4 * (kb & 1) + ii] : -1e30f; S[kb][ii] = t; } } }
                float mx = fmaxf(fmaxf(S[0][0], S[0][1]), fmaxf(S[0][2], S[0][3]));
#pragma unroll
                for (int kb = 1; kb < 4; ++kb) mx = fmaxf(fmaxf(mx, S[kb][0]), fmaxf(fmaxf(S[kb][1], S[kb][2]), S[kb][3]));
                mx = swap32_max(swap16_max(mx));
                if (__any(mx > mrun[m] + 8.0f)) {
                    const float mnew = fmaxf(mrun[m], mx), alpha = fexp2(mrun[m] - mnew); mrun[m] = mnew; lrun[m] = lrun[m] * alpha;
#pragma unroll
                    for (int vb = 0; vb < NVB; ++vb) O[m][vb] = O[m][vb] * alpha;
                }
                const f32x2 mm = (f32x2){mrun[m], mrun[m]};
                unsigned pw[8];
#pragma unroll
                for (int kb = 0; kb < 4; ++kb) { f32x2 a = (f32x2){S[kb][0], S[kb][1]} - mm, b = (f32x2){S[kb][2], S[kb][3]} - mm;
                    a.x = fexp2(a.x); a.y = fexp2(a.y); b.x = fexp2(b.x); b.y = fexp2(b.y);
                    lrun[m] = lrun[m] + a; lrun[m] = lrun[m] + b;
                    pw[2 * kb] = cvtpk(a.x, a.y); pw[2 * kb + 1] = cvtpk(b.x, b.y); }
                pf[m][0] = __builtin_bit_cast(bf16x8, (u32x4){pw[0], pw[1], pw[2], pw[3]});
                pf[m][1] = __builtin_bit_cast(bf16x8, (u32x4){pw[4], pw[5], pw[6], pw[7]});
            }
#pragma unroll
            for (int vb = 0; vb < NVB; ++vb)
#pragma unroll
                for (int t = 0; t < 2; ++t) { if (!NA || (tm >> t) & 1) {
                        const bf16x8 vf = *(const LAS bf16x8*)(buf + NMAPS * KB + vbase + vb * (16 * 144) + t * 64);
#pragma unroll
                        for (int m = 0; m < NMAPS; ++m) O[m][vb] = __builtin_amdgcn_mfma_f32_16x16x32_bf16(vf, pf[m][t], O[m][vb], 0, 0, 0); } }
        }
        if (i + 1 < ntiles) AT_STORE((i + 1) & 1);
        __syncthreads();
    }
#undef AT_LOAD
#undef AT_STORE
    float inv[NMAPS];
#pragma unroll
    for (int m = 0; m < NMAPS; ++m) { float l = lrun[m].x + lrun[m].y; l = swap16_add(l, l); l = swap32_add(l, l); inv[m] = 1.0f / l; }
    const int orow = qrow0 + wave * 16 + fr;
    if constexpr (NMAPS == 2) {
        float ss = 0.f; const float i1 = inv[0], i2 = lam * inv[1];
#pragma unroll
        for (int vb = 0; vb < NVB; ++vb) { O[0][vb] = O[0][vb] * i1 - O[1][vb] * i2; const f32x4 o = O[0][vb]; ss += (o.x * o.x + o.y * o.y) + (o.z * o.z + o.w * o.w); }
        ss = swap16_add(ss, ss); ss = swap32_add(ss, ss);
        const float rs = __builtin_amdgcn_rsqf(ss * (1.0f / DV) + EPSF) * outscale;
#pragma unroll
        for (int vb = 0; vb < NVB; ++vb) { const f32x4 gg = *(const f32x4*)(subg + 16 * vb + 4 * g); const f32x4 y = O[0][vb] * rs * gg;
            u32x2 w; w.x = cvtpk(y.x, y.y); w.y = cvtpk(y.z, y.w); *(u32x2*)(AOUT + (size_t)orow * D + ocol + 16 * vb + 4 * g) = w; }
    } else {
#pragma unroll
        for (int vb = 0; vb < NVB; ++vb) { const f32x4 y = O[0][vb] * inv[0];
            u32x2 w; w.x = cvtpk(y.x, y.y); w.y = cvtpk(y.z, y.w); *(u32x2*)(AOUT + (size_t)orow * D + ocol + 16 * vb + 4 * g) = w; }
    }
}


__device__ __forceinline__ void phase_attention(const bf16* QKV, const bf16* VAT, const bf16* VBT, bf16* AOUT, const float* lamp  , float lam_init, const float* subg, const float* nab  ,
                                                LAS unsigned char* lds, int tid, int lane, int wave, int vcu, int G, int repmask) {
    float part = lamp[lane] * lamp[64 + lane]; float part2 = lamp[128 + lane] * lamp[192 + lane];
    const float lam = __expf(wave_sum(part)) - __expf(wave_sum(part2)) + lam_init;
    for (int rep = 0; rep <= ((repmask >> 8) & 1); ++rep)
    for (int u = vcu; u < 576; u += G) {
        int bh, qrow0, khi;
        if (u < 512) { bh = u >> 4; const int qt = u & 15; qrow0 = (bh >> 2) * SEQ + qt * 128; khi = 32; }
        else { const int q = u - 512; bh = q >> 1; const int qt = q & 1; qrow0 = TX + (bh >> 2) * CTXL + qt * 128; khi = 0; }
        const int b = bh >> 2, h = bh & 3;
        attn_unit<2, 128, false>(lds, tid, lane, wave, QKV, h * 128, qrow0, 512 + h * 128, b * SEQ, TX + b * CTXL, VAT + (size_t)bh * 128 * NKEY, 0, khi, 0, 0, nullptr,
                                 AOUT, h * 128, lam, subg, 1.0f - lam_init);
    }
    LAS float* biasT = (LAS float*)(lds + LX_BIAS) + 64;
    for (int rep = 0; rep <= ((repmask >> 9) & 1); ++rep)
    for (int u = vcu; u < 1152; u += G) {
        int bh, qrow0, klo, khi, rw;
        if (u < 1024) { bh = u >> 4; const int rp = u & 15; qrow0 = (bh >> 3) * SEQ + rp * 128; klo = na_r0(2 * rp); khi = na_r0(2 * rp + 1) + 8; rw = 2 * rp + (wave >> 2); }
        else { const int q = u - 1024; bh = q >> 1; const int qt = q & 1; qrow0 = TX + (bh >> 3) * CTXL + qt * 128; klo = 0; khi = 0; rw = 0; }
        const int b = bh >> 3, h = bh & 7;
        for (int i = tid; i < 640; i += 512) { const int k = i - 64; biasT[k] = (k >= 0 && k < 465) ? nab[h * 465 + k] * LOG2E : 0.f; }
        attn_unit<1, 64, true>(lds, tid, lane, wave, QKV, 1536 + h * 64, qrow0, 2048 + h * 64, b * SEQ, TX + b * CTXL, VBT + (size_t)bh * 64 * NKEY, klo, khi,
                               rw, 16 * (wave & 3), biasT, AOUT, 512 + h * 64, 0.f, nullptr, 1.0f);
    }
}

constexpr int GL_QM = 0, GL_QG = 17408, GL_KM = 34816, GL_KET = 52224, GL_VT = 70656, GL_ST = 79872, GL_LR = 97280, GL_SEG = 101376, GL_DEC = 103424;
__device__ __forceinline__ void phase_gla(const bf16* QKV2, const bf16* VGT, bf16* OF, bf16* OB, const float* wgate  , const float* bgate  ,
                                          LAS unsigned char* lds, int tid, int lane, int wave, int vcu, int G) {
    const int fr = lane & 15, g = lane >> 4;
    const int d = tid & 127, seg = tid >> 7;
    for (int u = vcu; u < 256; u += G) {
        const int slab = u & 3, dir = (u >> 2) & 1, hh = (u >> 3) & 3, b = u >> 5;
        bf16* OUT = dir ? OB : OF;
        float wg[16];
#pragma unroll
        for (int r = 0; r < 16; ++r) wg[r] = wgate[(dir * 16 + r) * 512 + hh * 128 + d];
        const float bgv = bgate[dir * 512 + hh * 128 + d];
        f32x4 Sacc[4];
#pragma unroll
        for (int vb = 0; vb < 4; ++vb) Sacc[vb] = (f32x4){0.f, 0.f, 0.f, 0.f};
        for (int i = tid; i < 17408 / 4; i += 512) ((LAS unsigned*)(lds + GL_ST))[i] = 0u;
        const bf16* vtb = VGT + ((size_t)(b * 4 + hh) * 256 + slab * 64) * NKEY;
        u32x4 qr[2], kr[2], vr, lr4;
#define GL_LOAD(n) do { const int _n = (n); int _row0, _tok0; if (_n < 4) { const int cc = dir ? 3 - _n : _n; _row0 = TX + b * CTXL + 64 * cc; _tok0 = SEQ + 64 * cc; } else { const int lc = dir ? 35 - _n : _n - 4; _row0 = b * SEQ + 64 * lc; _tok0 = 64 * lc; } \
        _Pragma("unroll") for (int j = 0; j < 2; ++j) { const int idx = tid + 512 * j, p = idx >> 4, ch = idx & 15; const bf16* src = QKV2 + (size_t)(_row0 + p) * NGLA + hh * 128 + ch * 8; qr[j] = *(const u32x4*)src; kr[j] = *(const u32x4*)(src + 512); } \
        vr = *(const u32x4*)(vtb + (size_t)(tid >> 3) * NKEY + _tok0 + (tid & 7) * 8); \
        if (tid < 128) lr4 = *(const u32x4*)(QKV2 + (size_t)(_row0 + (tid >> 1)) * NGLA + 3072 + dir * 16 + (tid & 1) * 8); } while (0)
        GL_LOAD(0);
        for (int n = 0; n < 36; ++n) {
            int row0; if (n < 4) { const int cc = dir ? 3 - n : n; row0 = TX + b * CTXL + 64 * cc; } else { const int lc = dir ? 35 - n : n - 4; row0 = b * SEQ + 64 * lc; }
#pragma unroll
            for (int j = 0; j < 2; ++j) { const int idx = tid + 512 * j, p = idx >> 4, ch = idx & 15;
                *(LAS u32x4*)(lds + GL_QM + p * 272 + ch * 16) = qr[j]; *(LAS u32x4*)(lds + GL_KM + p * 272 + ch * 16) = kr[j]; }
            *(LAS u32x4*)(lds + GL_VT + (tid >> 3) * 144 + (tid & 7) * 16) = vr;
            if (tid < 128) { LAS float* lp = (LAS float*)(lds + GL_LR) + (tid >> 1) * 16 + (tid & 1) * 8;
                lp[0] = bflo(lr4.x); lp[1] = bfhi(lr4.x); lp[2] = bflo(lr4.y); lp[3] = bfhi(lr4.y); lp[4] = bflo(lr4.z); lp[5] = bfhi(lr4.z); lp[6] = bflo(lr4.w); lp[7] = bfhi(lr4.w); }
            __syncthreads();
            if (n + 1 < 36) GL_LOAD(n + 1);
            float gc[16];
#pragma unroll
            for (int pi = 0; pi < 16; ++pi) { const LAS f32x4* lp = (const LAS f32x4*)((LAS float*)(lds + GL_LR) + (16 * seg + pi) * 16); float z = bgv;
#pragma unroll
                for (int q = 0; q < 4; ++q) { const f32x4 l4 = lp[q]; z += l4.x * wg[4 * q] + l4.y * wg[4 * q + 1] + l4.z * wg[4 * q + 2] + l4.w * wg[4 * q + 3]; }
                const float az = fabsf(z); gc[pi] = (fminf(z, 0.f) - flog(1.0f + fexp(-az))) * 0.0625f; }
            float run = 0.f;
            if (dir == 0) {
#pragma unroll
                for (int pi = 0; pi < 16; ++pi) { run += gc[pi]; gc[pi] = run; }
            } else {
#pragma unroll
                for (int pi = 15; pi >= 0; --pi) { run += gc[pi]; gc[pi] = run; }
            }
            ((LAS float*)(lds + GL_SEG))[seg * 128 + d] = run;
            __syncthreads();
            float t0 = ((LAS float*)(lds + GL_SEG))[d], t1 = ((LAS float*)(lds + GL_SEG))[128 + d], t2 = ((LAS float*)(lds + GL_SEG))[256 + d], t3 = ((LAS float*)(lds + GL_SEG))[384 + d];
            float off, gmid; const float gend = (t0 + t1) + (t2 + t3);
            if (dir == 0) { off = (seg > 0 ? t0 : 0.f) + (seg > 1 ? t1 : 0.f) + (seg > 2 ? t2 : 0.f); gmid = t0 + t1; }
            else { off = (seg < 3 ? t3 : 0.f) + (seg < 2 ? t2 : 0.f) + (seg < 1 ? t1 : 0.f); gmid = t3 + t2; }
            const float emid = fexp(gmid), eend = fexp(gend - gmid);
            unsigned kep[8];
#pragma unroll
            for (int pi = 0; pi < 16; ++pi) { const int p = 16 * seg + pi; const float rel = off + gc[pi] - gmid; const float E = fexp(rel), Ei = fexp(-rel);
                LAS bf16* qa = (LAS bf16*)(lds + GL_QM) + p * 136 + d; LAS bf16* ka = (LAS bf16*)(lds + GL_KM) + p * 136 + d;
                const float q = bf2f(*qa), k = bf2f(*ka);
                const float qm = q * E, km = k * Ei;
                *qa = (bf16)f2bf(qm); *ka = (bf16)f2bf(km); ((LAS bf16*)(lds + GL_QG))[p * 136 + d] = (bf16)f2bf(qm * emid);
                const unsigned keb = f2bf(km * eend); if (pi & 1) kep[pi >> 1] |= keb << 16; else kep[pi >> 1] = keb; }
            { LAS u32x4* kt = (LAS u32x4*)(lds + GL_KET + d * 144 + seg * 32); kt[0] = (u32x4){kep[0], kep[1], kep[2], kep[3]}; kt[1] = (u32x4){kep[4], kep[5], kep[6], kep[7]}; }
            if (seg == 0) ((LAS float*)(lds + GL_DEC))[d] = fexp(gend);
            __syncthreads();
            { const int cb = wave & 3, vh = wave >> 2;
              f32x4 AT[4];
#pragma unroll
              for (int sb = 0; sb < 4; ++sb) { AT[sb] = (f32x4){0.f, 0.f, 0.f, 0.f};
#pragma unroll
                  for (int ks = 0; ks < 4; ++ks) { const bf16x8 af = *(const LAS bf16x8*)(lds + GL_KM + (16 * sb + fr) * 272 + (8 * g + 32 * ks) * 2);
                      const bf16x8 bfr = *(const LAS bf16x8*)(lds + GL_QM + (16 * cb + fr) * 272 + (8 * g + 32 * ks) * 2);
                      AT[sb] = __builtin_amdgcn_mfma_f32_16x16x32_bf16(af, bfr, AT[sb], 0, 0, 0); }
                  const int c = 16 * cb + fr;
#pragma unroll
                  for (int ii = 0; ii < 4; ++ii) { const int s = 16 * sb + 4 * g + ii; const bool keep = dir ? (s >= c) : (s <= c); AT[sb][ii] = keep ? AT[sb][ii] : 0.f; } }
              bf16x8 pf[2];
#pragma unroll
              for (int t = 0; t < 2; ++t) { u32x4 w; w.x = pk2(AT[2 * t][0], AT[2 * t][1]); w.y = pk2(AT[2 * t][2], AT[2 * t][3]); w.z = pk2(AT[2 * t + 1][0], AT[2 * t + 1][1]); w.w = pk2(AT[2 * t + 1][2], AT[2 * t + 1][3]);
                  pf[t] = __builtin_bit_cast(bf16x8, w); }
#pragma unroll
              for (int v2 = 0; v2 < 2; ++v2) { const int vb = 2 * vh + v2; f32x4 Oa = (f32x4){0.f, 0.f, 0.f, 0.f};
#pragma unroll
                  for (int ks = 0; ks < 4; ++ks) { const bf16x8 af = *(const LAS bf16x8*)(lds + GL_ST + (16 * vb + fr) * 272 + (8 * g + 32 * ks) * 2);
                      const bf16x8 bfr = *(const LAS bf16x8*)(lds + GL_QG + (16 * cb + fr) * 272 + (8 * g + 32 * ks) * 2);
                      Oa = __builtin_amdgcn_mfma_f32_16x16x32_bf16(af, bfr, Oa, 0, 0, 0); }
#pragma unroll
                  for (int t = 0; t < 2; ++t) { const LAS unsigned char* vp = lds + GL_VT + (16 * vb + fr) * 144 + (32 * t + 4 * g) * 2;
                      const u32x2 lo = *(const LAS u32x2*)vp, hi = *(const LAS u32x2*)(vp + 32);
                      u32x4 w; w.x = lo.x; w.y = lo.y; w.z = hi.x; w.w = hi.y;
                      Oa = __builtin_amdgcn_mfma_f32_16x16x32_bf16(__builtin_bit_cast(bf16x8, w), pf[t], Oa, 0, 0, 0); }
                  u32x2 w; w.x = pk2(Oa[0], Oa[1]); w.y = pk2(Oa[2], Oa[3]);
                  *(u32x2*)(OUT + (size_t)(row0 + 16 * cb + fr) * D + hh * 256 + slab * 64 + 16 * vb + 4 * g) = w; }
            }
            { const f32x4 dec = *(const LAS f32x4*)((LAS float*)(lds + GL_DEC) + 16 * wave + 4 * g);
#pragma unroll
              for (int vb = 0; vb < 4; ++vb) { Sacc[vb] = Sacc[vb] * dec;
#pragma unroll
                  for (int t = 0; t < 2; ++t) { const bf16x8 af = *(const LAS bf16x8*)(lds + GL_KET + (16 * wave + fr) * 144 + (8 * g + 32 * t) * 2);
                      const bf16x8 bfr = *(const LAS bf16x8*)(lds + GL_VT + (16 * vb + fr) * 144 + (8 * g + 32 * t) * 2);
                      Sacc[vb] = __builtin_amdgcn_mfma_f32_16x16x32_bf16(af, bfr, Sacc[vb], 0, 0, 0); } }
            }
            __syncthreads();
#pragma unroll
            for (int vb = 0; vb < 4; ++vb) { u32x2 w; w.x = pk2(Sacc[vb][0], Sacc[vb][1]); w.y = pk2(Sacc[vb][2], Sacc[vb][3]);
                *(LAS u32x2*)(lds + GL_ST + (16 * vb + fr) * 272 + (16 * wave + 4 * g) * 2) = w; }
        }
#undef GL_LOAD
        __syncthreads();
    }
}

constexpr int N_PHASES = 34;
typedef const Args __attribute__((address_space(4)))* KArgs;
__device__ __forceinline__ KArgs kargs() { KArgs p = (KArgs)__builtin_amdgcn_kernarg_segment_ptr(); asm volatile("" : "+s"(p)); return p; }
__global__ void __launch_bounds__(512, 2) fwd(Args a_unused) {
    extern __shared__ __attribute__((aligned(16))) unsigned char lds_raw[];
    LAS unsigned char* lds = (LAS unsigned char*)lds_raw;
    const int tid0 = threadIdx.x;
    const int G0 = gridDim.x; const int bx0 = blockIdx.x;
#define PH_ENTRY int tid = tid0; asm volatile("" : "+v"(tid)); int G = G0, bx = bx0; asm volatile("" : "+s"(G), "+s"(bx)); const int lane = tid & 63, wave = __builtin_amdgcn_readfirstlane(tid >> 6); \
        const int vcu = (G % 8 == 0) ? (bx % 8) * (G / 8) + bx / 8 : bx; (void)lane; (void)wave; (void)vcu
    const int tid = tid0;
    const int ph_lo = kargs()->ph_lo, ph_hi = kargs()->ph_hi;
    const int repmask = kargs()->rep;
    if (tid < 64) ((LAS unsigned*)(lds + LX_MISC))[tid] = 0u;
    for (int i = tid; i < 1024; i += 512) { const int pos = i >> 4, f = i & 15; const float inv = __builtin_amdgcn_exp2f(-(float)f * (13.287712379549449f / 16.0f)); const float ang = (float)pos * inv;
        ((LAS float*)(lds + LX_ROPE))[2 * i] = __cosf(ang); ((LAS float*)(lds + LX_ROPE))[2 * i + 1] = __sinf(ang); }
    __syncthreads();
    const bool single = (ph_hi - ph_lo) > 1;
    XcdBarrier bar; bar.bar = (unsigned*)(kargs()->ws + WS_CTL) + CW_BAR; bar.x = 0; bar.st = (volatile LAS unsigned*)(lds + LX_MISC);
    if (single) bar = xcd_barrier_post((unsigned*)(kargs()->ws + WS_CTL) + CW_BAR, (volatile LAS unsigned*)(lds + LX_MISC));
#define IN(k) (ph_lo <= (k) && (k) < ph_hi)
#define REPLOOP(t) for (int rep_ = 0, nrep_ = 1 + ((repmask >> (t)) & 1); rep_ < nrep_; ++rep_, (rep_ < nrep_ ? (bar.bar = (unsigned*)(kargs()->ws + WS_CTL) + CW_BAR, xcd_barrier(bar)) : (void)0))
#define SEAM(k) do { if (IN(k) && IN((k) + 1)) { bar.bar = (unsigned*)(kargs()->ws + WS_CTL) + CW_BAR; xcd_barrier(bar); if ((repmask >> 10) & 1) xcd_barrier(bar); } } while (0)
    LAS int* tab = (LAS int*)(lds + LX_MOETAB);

    if (IN(0)) REPLOOP(0) { PH_ENTRY; p0_prologue(kargs(), lds, tid, lane, wave, vcu, G); } SEAM(0);
    if (IN(1)) { PH_ENTRY; KArgs A = kargs(); unsigned char* ws = A->ws; phase_norm1(A->out, (float*)(ws + WS_CTX), A->norm_g, (float*)(ws + WS_MODV), (bf16*)(ws + WS_H), TALL, lane, wave, vcu, G); } SEAM(1);

#pragma nounroll
    for (int L = 0; L < 4; ++L) {
        const int pb = 2 + 8 * L; const bool isattn = !(L & 1); const int j = L >> 1; const bool lastL = (L == 3);
        const int nrows = lastL ? TX : TALL;
        if (IN(pb)) REPLOOP(isattn ? 1 : 3) {
            PH_ENTRY; KArgs A = kargs(); unsigned char* ws = A->ws; unsigned char* big = ws + WS_BIG; const bf16* H = (const bf16*)(ws + WS_H);
            if (isattn) {
                pg8::DenseOrder S; S.init(H, (const bf16*)(ws + WS_WATTIN) + (size_t)j * NATT * D, TALL, NATT, D, G, bx);
                pg8::EpiAttnIn E{(bf16*)(big + BG_QKV), (bf16*)(big + BG_VAT), (bf16*)(big + BG_VBT), (const LAS float*)(lds + LX_ROPE)};
                pg8::gemm_phase<pg8::EpiAttnIn, pg8::DenseOrder, false>(lds, tid, D, S, E);
            } else {
                pg8::DenseOrder S; S.init(H, (const bf16*)(ws + WS_WGLAIN) + (size_t)j * NGLA * D, TALL, NGLA, D, G, bx);
                pg8::EpiGlaIn E{(bf16*)(big + BG_QKV2), (bf16*)(big + BG_VGT)};
                pg8::gemm_phase<pg8::EpiGlaIn, pg8::DenseOrder, false>(lds, tid, D, S, E);
            }
        }
        SEAM(pb);
        if (IN(pb + 1)) REPLOOP(isattn ? 2 : 4) {
            PH_ENTRY; KArgs A = kargs(); unsigned char* ws = A->ws; unsigned char* big = ws + WS_BIG; bf16* AOUT = (bf16*)(ws + WS_AOUT);
            if (isattn) phase_attention((const bf16*)(big + BG_QKV), (const bf16*)(big + BG_VAT), (const bf16*)(big + BG_VBT), AOUT, A->att_lambda + j * 256, (L == 0) ? 0.2f : 0.470713018f,
                                        A->att_subln_g + j * 128, A->na_bias + j * 8 * 465, lds, tid, lane, wave, vcu, G, repmask);
            else phase_gla((const bf16*)(big + BG_QKV2), (const bf16*)(big + BG_VGT), (bf16*)(big + BG_OF), (bf16*)(big + BG_OB), A->gla_w_gate + j * 2 * 16 * 512, A->gla_b_gate + j * 2 * 512,
                           lds, tid, lane, wave, vcu, G);
        }
        SEAM(pb + 1);
        if (!isattn) {
            if (IN(pb + 2)) REPLOOP(5) { PH_ENTRY; KArgs A = kargs(); unsigned char* ws = A->ws; unsigned char* big = ws + WS_BIG;
                phase_readout((const bf16*)(big + BG_OF), (const bf16*)(big + BG_OB), (const bf16*)(big + BG_QKV2), A->gla_norm_g + j * 256, (bf16*)(ws + WS_AOUT), nrows, lane, wave, vcu, G); }
            SEAM(pb + 2);
        }
        if (IN(pb + 3)) {
            PH_ENTRY; KArgs A = kargs(); unsigned char* ws = A->ws;
            pg8::DenseOrder S; S.init((const bf16*)(ws + WS_AOUT), (const bf16*)(ws + (isattn ? WS_WATTOUT : WS_WGLAOUT)) + (size_t)j * D * D, nrows, D, D, G, bx);
            pg8::EpiResid E{A->out, (float*)(ws + WS_CTX), (const float*)(ws + WS_MODV) + (size_t)L * 9 * 6144 + 2048};
            pg8::gemm_phase<pg8::EpiResid, pg8::DenseOrder, false>(lds, tid, D, S, E);
        }
        SEAM(pb + 3);
        if (IN(pb + 4)) { PH_ENTRY; KArgs A = kargs(); unsigned char* ws = A->ws;
            phase_router(A->out, (float*)(ws + WS_CTX), A->norm_g + (L * 2 + 1) * D, (const float*)(ws + WS_MODV) + (size_t)L * 9 * 6144, (bf16*)(ws + WS_H), A->router_w, A->router_bias,
                         (unsigned*)(ws + WS_CTL) + CW_CNT + L * 16 * 64, (int*)(ws + WS_LIST), (int*)(ws + WS_TOKI), (float*)(ws + WS_TOKW), nrows, lds, tid, lane, wave, vcu, G, (repmask >> 11) & 1); }
        SEAM(pb + 4);
        if (IN(pb + 5)) REPLOOP(6) {
            PH_ENTRY; KArgs A = kargs(); unsigned char* ws = A->ws;
            const int RT = build_moe_table((unsigned*)(ws + WS_CTL) + CW_CNT + L * 16 * 64, tab, tid);
            pg8::MoeOrder S; S.A = (const char*)(ws + WS_H); S.B = (const char*)(ws + WS_W13) + (size_t)L * 16 * D * D * 2; S.K = D; S.bstride = (size_t)D * D * 2; S.tab = tab; S.list = (const int*)(ws + WS_LIST); S.RT = RT; S.nwg = RT * 4; S.G = G; S.c = bx;
            pg8::EpiMoe1 E{(bf16*)(ws + WS_BIG + BG_HB)};
            pg8::gemm_phase<pg8::EpiMoe1, pg8::MoeOrder, true>(lds, tid, D, S, E);
        }
        SEAM(pb + 5);
        if (IN(pb + 6)) REPLOOP(7) {
            PH_ENTRY; KArgs A = kargs(); unsigned char* ws = A->ws;
            const int RT = build_moe_table((unsigned*)(ws + WS_CTL) + CW_CNT + L * 16 * 64, tab, tid);
            pg8::MoeOrder S; S.A = (const char*)(ws + WS_BIG + BG_HB); S.B = (const char*)(ws + WS_W2) + (size_t)L * 16 * D * DEXP * 2; S.K = DEXP; S.bstride = (size_t)D * DEXP * 2; S.tab = tab; S.list = (const int*)(ws + WS_LIST); S.RT = RT; S.nwg = RT * 4; S.G = G; S.c = bx;
            pg8::EpiBf16 E{(bf16*)(ws + WS_BIG + BG_YB), D};
            pg8::gemm_phase<pg8::EpiBf16, pg8::MoeOrder, false>(lds, tid, DEXP, S, E);
        }
        SEAM(pb + 6);
        if (IN(pb + 7)) { PH_ENTRY; KArgs A = kargs(); unsigned char* ws = A->ws; const float* MODV = (const float*)(ws + WS_MODV);
            phase_combine(A->out, (float*)(ws + WS_CTX), MODV + (size_t)L * 9 * 6144, (const bf16*)(ws + WS_BIG + BG_YB), (unsigned*)(ws + WS_CTL) + CW_CNT + L * 16 * 64, (const int*)(ws + WS_TOKI), (const float*)(ws + WS_TOKW),
                          lastL, lastL ? A->final_g : A->norm_g + ((L + 1) * 2) * D, MODV + (size_t)(lastL ? L : L + 1) * 9 * 6144, (bf16*)(ws + WS_H), nrows, lane, wave, vcu, G, (repmask >> 12) & 1); }
        if (!lastL) SEAM(pb + 7);
    }
#undef IN
#undef REPLOOP
#undef SEAM
#undef PH_ENTRY
}

extern "C" void kernel_launch(void* const* d_in, const int* in_sizes, int n_in, void* d_out, int out_size, void* d_ws, size_t ws_size, hipStream_t stream) {
    static int ready = 0;
    if (ready == 0) {
        if (n_in != 23 || out_size != TX * D || ws_size < WS_END) { fprintf(stderr, "kernel_launch: unexpected shapes (n_in %d out %d ws %zu)\n", n_in, out_size, ws_size); ready = -1; return; }
        if (hipFuncSetAttribute((const void*)fwd, hipFuncAttributeMaxDynamicSharedMemorySize, LDS_BYTES) != hipSuccess) { fprintf(stderr, "kernel_launch: hipFuncSetAttribute failed\n"); ready = -1; return; }
        int per_cu = 0; (void)hipOccupancyMaxActiveBlocksPerMultiprocessor(&per_cu, (const void*)fwd, 512, LDS_BYTES); (void)hipGetLastError();
        if (per_cu < 1) fprintf(stderr, "kernel_launch: occupancy query reports %d blocks per CU\n", per_cu);
        ready = 1;
    }
    if (ready < 0) return;
    (void)hipMemsetAsync((char*)d_ws + WS_CTL, 0, CTL_ZERO_BYTES, stream);
    Args a{};
    const float** ap = (const float**)&a;
    for (int i = 0; i < 23; ++i) ap[i] = (const float*)d_in[i];
    a.out = (float*)d_out; a.ws = (unsigned char*)d_ws;
    const int grid = 256;
#if MK_MULTI
    for (int k = 0; k < N_PHASES; ++k) { a.ph_lo = k; a.ph_hi = k + 1; hipLaunchKernelGGL(fwd, dim3(grid), dim3(512), LDS_BYTES, stream, a); }
#else
    a.ph_lo = 0; a.ph_hi = N_PHASES; a.rep = MK_REPMASK;
    hipLaunchKernelGGL(fwd, dim3(grid), dim3(512), LDS_BYTES, stream, a);
#endif
}
```

```cpp
#include <hip/hip_runtime.h>
#include <cstdio>
#include <cstdint>

#ifndef MK_REPMASK
#define MK_REPMASK 0
#endif
#ifndef MK_MULTI
#define MK_MULTI 0
#endif

#define GAS __attribute__((address_space(1)))
#define LAS __attribute__((address_space(3)))
typedef unsigned short bf16;
typedef short bf16x8 __attribute__((ext_vector_type(8)));
typedef short bf16x4 __attribute__((ext_vector_type(4)));
typedef float f32x4 __attribute__((ext_vector_type(4)));
typedef float f32x2 __attribute__((ext_vector_type(2)));
typedef unsigned u32x4 __attribute__((ext_vector_type(4)));
typedef unsigned u32x2 __attribute__((ext_vector_type(2)));

constexpr int D = 1024, NB = 8, SEQ = 2048, CTXL = 256;
constexpr int TX = NB * SEQ, TC = NB * CTXL, TALL = TX + TC;
constexpr int NKEY = SEQ + CTXL;
constexpr int NATT = 3072, NGLA = 3328;
constexpr float EPSF = 1e-6f;
constexpr float LOG2E = 1.4426950408889634f;
constexpr int NEXP = 16, DEXP = 512;
constexpr int RT_MAX = 160;

constexpr size_t MiB = 1u << 20;
constexpr size_t WS_CTL = 0, CTL_ZERO_BYTES = 1 * MiB;
constexpr size_t WS_MODV = 1 * MiB;
constexpr size_t WS_TOKI = 2 * MiB;
constexpr size_t WS_TOKW = 2 * MiB + 512 * 1024;
constexpr size_t WS_LIST = 3 * MiB;
constexpr size_t WS_CTX = 5 * MiB;
constexpr size_t WS_WATTIN = 13 * MiB;
constexpr size_t WS_WATTOUT = 25 * MiB;
constexpr size_t WS_WGLAIN = 29 * MiB;
constexpr size_t WS_WGLAOUT = 42 * MiB;
constexpr size_t WS_W13 = 46 * MiB;
constexpr size_t WS_W2 = 174 * MiB;
constexpr size_t WS_H = 238 * MiB;
constexpr size_t WS_AOUT = 274 * MiB;
constexpr size_t WS_BIG = 310 * MiB;
constexpr size_t WS_END = 539 * MiB;
constexpr size_t BG_QKV = 0;
constexpr size_t BG_VAT = 108 * MiB;
constexpr size_t BG_VBT = 126 * MiB;
constexpr size_t BG_QKV2 = 0;
constexpr size_t BG_VGT = 117 * MiB;
constexpr size_t BG_OF = 153 * MiB;
constexpr size_t BG_OB = 189 * MiB;
constexpr size_t BG_FAC = 225 * MiB;
constexpr size_t WS_QG = WS_H, WS_KET = WS_AOUT;
constexpr size_t BG_HB = 0;
constexpr size_t BG_YB = 40 * MiB;
constexpr int CW_TMO = 0;
constexpr int CW_BAR = 4096;
constexpr int CW_CNT = 8192;

constexpr int RING_BYTES = 131072;
constexpr int LX_OFF = RING_BYTES;
constexpr int LX_MISC = LX_OFF;
constexpr int LX_MOETAB = LX_OFF + 256;
constexpr int LX_ROPE = LX_OFF + 2048;
constexpr int LX_BIAS = LX_OFF + 2048 + 8192;
constexpr int LDS_BYTES = 147456;

#define LDS_WAIT() asm volatile("s_waitcnt lgkmcnt(0)" ::: "memory")
#define VM_WAIT() asm volatile("s_waitcnt vmcnt(0)" ::: "memory")
#define RLX_AGENT __ATOMIC_RELAXED, __HIP_MEMORY_SCOPE_AGENT
__device__ __forceinline__ unsigned f2bf(float f) { unsigned u = __builtin_bit_cast(unsigned, f); return (u + 0x7fffu + ((u >> 16) & 1u)) >> 16; }
typedef __bf16 hwbf16x2 __attribute__((ext_vector_type(2)));
__device__ __forceinline__ unsigned cvtpk(float lo, float hi) { const f32x2 v = {lo, hi}; const hwbf16x2 b = __builtin_convertvector(v, hwbf16x2); return __builtin_bit_cast(unsigned, b); }
__device__ __forceinline__ unsigned pk2(float lo, float hi) { return cvtpk(lo, hi); }
__device__ __forceinline__ float bf2f(unsigned short b) { return __builtin_bit_cast(float, ((unsigned)b) << 16); }
__device__ __forceinline__ float bflo(unsigned w) { return __builtin_bit_cast(float, w << 16); }
__device__ __forceinline__ float bfhi(unsigned w) { return __builtin_bit_cast(float, w & 0xffff0000u); }
template <int CTRL> __device__ __forceinline__ float dppf(float v) { return __builtin_bit_cast(float, __builtin_amdgcn_update_dpp(0, __builtin_bit_cast(int, v), CTRL, 0xf, 0xf, true)); }
__device__ __forceinline__ float row_sum(float v) { v += dppf<0xB1>(v); v += dppf<0x4E>(v); v += dppf<0x124>(v); v += dppf<0x128>(v); return v; }
__device__ __forceinline__ float swap16_add(float a, float b) { auto r = __builtin_amdgcn_permlane16_swap(__float_as_uint(a), __float_as_uint(b), false, false); const unsigned r0 = r[0], r1 = r[1]; return __uint_as_float(r0) + __uint_as_float(r1); }
__device__ __forceinline__ float swap32_add(float a, float b) { auto r = __builtin_amdgcn_permlane32_swap(__float_as_uint(a), __float_as_uint(b), false, false); const unsigned r0 = r[0], r1 = r[1]; return __uint_as_float(r0) + __uint_as_float(r1); }
__device__ __forceinline__ float swap16_max(float a) { auto r = __builtin_amdgcn_permlane16_swap(__float_as_uint(a), __float_as_uint(a), false, false); const unsigned r0 = r[0], r1 = r[1]; return fmaxf(__uint_as_float(r0), __uint_as_float(r1)); }
__device__ __forceinline__ float swap32_max(float a) { auto r = __builtin_amdgcn_permlane32_swap(__float_as_uint(a), __float_as_uint(a), false, false); const unsigned r0 = r[0], r1 = r[1]; return fmaxf(__uint_as_float(r0), __uint_as_float(r1)); }
__device__ __forceinline__ float readlane_f(float v, int l) { return __int_as_float(__builtin_amdgcn_readlane(__float_as_int(v), l)); }
__device__ __forceinline__ float wave_sum(float v) { v = row_sum(v); v = swap16_add(v, v); return swap32_add(v, v); }
__device__ __forceinline__ float fexp2(float x) { return __builtin_amdgcn_exp2f(x); }
__device__ __forceinline__ float fexp(float x) { return __builtin_amdgcn_exp2f(x * LOG2E); }
__device__ __forceinline__ float flog(float x) { return __builtin_amdgcn_logf(x) * 0.6931471805599453f; }
__device__ __forceinline__ float frcp(float x) { return __builtin_amdgcn_rcpf(x); }
__device__ __forceinline__ float silu_f(float x) { return x * frcp(1.0f + fexp(-x)); }

#define XB_TMO      128
#define XB_XCNT(j)  (256  + 64 * (j))
#define XB_XSUB(j)  (1280 + 64 * (j))
#define XB_XGEN(j)  (2304 + 64 * (j))
#define XB_TOP      3328
#define XB_TOPGEN   3392
#define XCD_BAR_WORDS 3456
#define XB_SPIN_CAP (1u << 18)
__device__ __forceinline__ unsigned xb_ld(unsigned* p)              { return __hip_atomic_load(p, __ATOMIC_RELAXED, __HIP_MEMORY_SCOPE_AGENT); }
__device__ __forceinline__ unsigned xb_add(unsigned* p, unsigned v) { return __hip_atomic_fetch_add(p, v, __ATOMIC_RELAXED, __HIP_MEMORY_SCOPE_AGENT); }
__device__ __forceinline__ unsigned xb_xcc_id() { return (unsigned)__builtin_amdgcn_s_getreg((3 << 11) | 20) & 0xFu; }
#define XB_SPIN(cond, bar) do { unsigned _sp = 0; while (cond) { __builtin_amdgcn_s_sleep(1); \
    if ((++_sp & 255u) == 0u) { if (xb_ld(&(bar)[XB_TMO])) break; if (_sp > XB_SPIN_CAP) { atomicAdd(&(bar)[XB_TMO], 1u); break; } } } } while (0)
struct XcdBarrier { unsigned* bar; unsigned x; volatile LAS unsigned* st; };
__device__ __forceinline__ XcdBarrier xcd_barrier_post(unsigned* bar, volatile LAS unsigned* st) {
    XcdBarrier b; b.bar = bar; b.x = xb_xcc_id(); b.st = st;
    if (threadIdx.x == 0) (void)xb_add(&bar[XB_XCNT(b.x)], 1u);
    return b;
}
__device__ __forceinline__ void xcd_barrier_complete(unsigned* bar, unsigned x, unsigned& nloc, unsigned& nx) {
    const unsigned G = gridDim.x * gridDim.y * gridDim.z;
    unsigned sum, cnt, mine, sp = 0u;
    for (;;) {
        sum = 0u; cnt = 0u; mine = 0u;
#pragma unroll
        for (unsigned j = 0; j < 16; ++j) { const unsigned c = xb_ld(&bar[XB_XCNT(j)]); sum += c; cnt += (c > 0u) ? 1u : 0u; mine = (j == x) ? c : mine; }
        if (sum == G) break;
        __builtin_amdgcn_s_sleep(1);
        if ((++sp & 255u) == 0u) { if (xb_ld(&bar[XB_TMO])) break; if (sp > XB_SPIN_CAP) { atomicAdd(&bar[XB_TMO], 1u); break; } }
    }
    nloc = mine > 0u ? mine : 1u; nx = cnt > 0u ? cnt : 1u;
}
__device__ __forceinline__ void xcd_barrier(const XcdBarrier& b) {
    asm volatile("s_waitcnt vmcnt(0)" ::: "memory");
    __syncthreads();
    if (threadIdx.x == 0) {
        unsigned* bar = b.bar;
        __builtin_amdgcn_s_waitcnt(0);
        unsigned nloc = b.st[0], nx = b.st[1];
        if (nloc == 0u) { xcd_barrier_complete(bar, b.x, nloc, nx); b.st[0] = nloc; b.st[1] = nx; }
        const unsigned old = xb_add(&bar[XB_XSUB(b.x)], 1u);
        const unsigned gen = old / nloc;
        if (old + 1u == (gen + 1u) * nloc) {
            __builtin_amdgcn_fence(__ATOMIC_RELEASE, "agent");
            asm volatile("s_waitcnt vmcnt(0)" ::: "memory");
            const unsigned og = xb_add(&bar[XB_TOP], 1u);
            const unsigned tg = og / nx;
            if (og + 1u == (tg + 1u) * nx) xb_add(&bar[XB_TOPGEN], 1u);
            else XB_SPIN(xb_ld(&bar[XB_TOPGEN]) == tg, bar);
            __builtin_amdgcn_fence(__ATOMIC_ACQUIRE, "agent");
            xb_add(&bar[XB_XGEN(b.x)], 1u);
            asm volatile("s_waitcnt vmcnt(0)" ::: "memory");
        } else {
            XB_SPIN(xb_ld(&bar[XB_XGEN(b.x)]) == gen, bar);
            __builtin_amdgcn_fence(__ATOMIC_ACQUIRE, "agent");
            asm volatile("s_waitcnt vmcnt(0)" ::: "memory");
        }
    }
    __syncthreads();
}

namespace pg8 {
constexpr int BM = 256, BK = 64, HALF = 128, HTB = HALF * BK * 2, STAGE_BYTES = 8 * HTB, NXCD = 8, WGM = 8;
__host__ __device__ __forceinline__ int lds_byte(int r, int c) { const int st = (r >> 4) * 2 + (c >> 5), rr = r & 15, cc = c & 31, ob = rr * 64 + cc * 2; return st * 1024 + (ob ^ (((ob >> 9) & 1) << 5)); }
__host__ __device__ __forceinline__ void stage_rc(int b, int& R, int& C) { const int st = b / 1024, sb = b % 1024, swz = sb ^ (((sb >> 9) & 1) << 5); R = (st >> 1) * 16 + swz / 64; C = (st & 1) * 32 + (swz % 64) / 2; }
__host__ __device__ __forceinline__ int perm32(int rho) { const int n = rho >> 4, i = rho & 15; return 8 * (i >> 2) + 4 * n + (i & 3); }

struct Unit { int pm, pn, e, mt; };

__device__ __forceinline__ int xcd_remap(int wgid, int nwg) { const int q = nwg / NXCD, r = nwg % NXCD, xcd = wgid % NXCD, off = wgid / NXCD; return (xcd < r ? xcd * (q + 1) : r * (q + 1) + (xcd - r) * q) + off; }

struct DenseOrder {
    const char* A; const char* B; int K; int nM, nN, nwg, G, c;
    __device__ __forceinline__ void init(const bf16* A_, const bf16* B_, int M, int N, int K_, int G_, int c_) { A = (const char*)A_; B = (const char*)B_; K = K_; nM = M / BM; nN = N / BM; nwg = nM * nN; G = G_; c = c_; }
    __device__ __forceinline__ bool next(int i, Unit& u) const {
        const long L = (long)i * G + c; if (L >= nwg) return false;
        const int wgid = xcd_remap((int)L, nwg);
        const int nig = WGM * nN, gid = wgid / nig, fm = gid * WGM, gsz = (nM - fm) < WGM ? (nM - fm) : WGM;
        u.pm = fm + ((wgid % nig) % gsz); u.pn = (wgid % nig) / gsz; u.e = 0; u.mt = 0; return true;
    }
    __device__ __forceinline__ const char* a_ptr(const Unit& u) const { return A + (size_t)u.pm * BM * K * 2; }
    __device__ __forceinline__ const char* b_ptr(const Unit& u) const { return B + (size_t)u.pn * BM * K * 2; }
    __device__ __forceinline__ int tok(const Unit&, int) const { return 0; }
};
struct MoeOrder {
    const char* A; const char* B; int K; size_t bstride;
    const LAS int* tab; const int* list; int RT, nwg, G, c;
    __device__ __forceinline__ bool next(int i, Unit& u) const {
        const long L = (long)i * G + c; if (L >= nwg) return false;
        const int wgid = xcd_remap((int)L, nwg);
        const int rt = wgid >> 2; u.pm = rt; u.pn = wgid & 3; const int t = tab[rt]; u.e = t & 255; u.mt = t >> 8; return true;
    }
    __device__ __forceinline__ const char* a_ptr(const Unit& u) const { return A + (size_t)u.pm * BM * K * 2; }
    __device__ __forceinline__ const char* b_ptr(const Unit& u) const { return B + (size_t)u.e * bstride + (size_t)u.pn * BM * K * 2; }
    __device__ __forceinline__ int tok(const Unit& u, int r) const { const int cnt = tab[RT_MAX + 1 + u.e]; const int pos = u.mt * BM + r; return pos < cnt ? list[(size_t)u.e * TALL + pos] : 0; }
};

__device__ __forceinline__ unsigned cvt_pk_bf16(float lo, float hi) { unsigned r; asm volatile("v_cvt_pk_bf16_f32 %0, %1, %2" : "=v"(r) : "v"(lo), "v"(hi)); return r; }

template <class Epi, class Sched, bool GATHER>
__device__ __forceinline__ void gemm_phase(LAS unsigned char* lds, const int tid, const int K, const Sched& S, const Epi& E) {
    const int wid = __builtin_amdgcn_readfirstlane(tid >> 6), lane = tid & 63, wr = wid >> 2, wc = wid & 3, fr = lane & 15, fq = lane >> 4;
    const int nt = K / BK;
    unsigned voffA[2], voffB[2]; int RA[2], CA[2];
#pragma unroll
    for (int i = 0; i < 2; ++i) { int R, C; stage_rc(tid * 16 + i * 8192, R, C); const int Rb = Epi::PERM ? ((R & ~31) + perm32(R & 31)) : R;
        RA[i] = R; CA[i] = C; voffA[i] = (unsigned)(R * K + C) * 2u; voffB[i] = (unsigned)(Rb * K + C) * 2u; }
    const size_t kstep = (size_t)(BK * 2);
    const size_t hstep = (size_t)HALF * K * 2;
    const unsigned ldsw = (unsigned)wid * 1024u;
    const int aoff = lds_byte(wr * 64 + fr, fq * 8), boff = lds_byte(wc * 32 + fr, fq * 8);
#define PG8_SA(b, h) (((b) * 2 + (h)) * HTB)
#define PG8_SB(b, h) ((4 + (b) * 2 + (h)) * HTB)
#define PG8_STAGE(bufoff, gbase, voff) do { _Pragma("unroll") for (int _i = 0; _i < 2; ++_i) \
        __builtin_amdgcn_global_load_lds((const unsigned*)((const char*)(gbase) + (voff)[_i]), (LAS unsigned*)(lds + (bufoff) + ldsw + _i * 8192), 16, 0, 0); } while (0)
#define PG8_STAGE_A(bufoff, h, usenext, koff) do { if constexpr (GATHER) { unsigned _vo[2]; _vo[0] = (usenext) ? nvA[h][0] : vA[h][0]; _vo[1] = (usenext) ? nvA[h][1] : vA[h][1]; PG8_STAGE(bufoff, S.A + (koff), _vo); } \
        else { PG8_STAGE(bufoff, ((usenext) ? nA : cA) + (size_t)(h) * hstep + (koff), voffA); } } while (0)
#define PG8_LDA(dst, b, h) do { _Pragma("unroll") for (int m = 0; m < 4; ++m) _Pragma("unroll") for (int k = 0; k < 2; ++k) dst[m][k] = *(const LAS bf16x8*)(lds + PG8_SA(b, h) + aoff + m * 2048 + k * 1024); } while (0)
#define PG8_LDB(dst, b, h) do { _Pragma("unroll") for (int n = 0; n < 2; ++n) _Pragma("unroll") for (int k = 0; k < 2; ++k) dst[n][k] = *(const LAS bf16x8*)(lds + PG8_SB(b, h) + boff + n * 2048 + k * 1024); } while (0)
#define PG8_MMA(ai, bj, At, Bt) do { __builtin_amdgcn_s_setprio(1); _Pragma("unroll") for (int m = 0; m < 4; ++m) _Pragma("unroll") for (int n = 0; n < 2; ++n) _Pragma("unroll") for (int k = 0; k < 2; ++k) \
        acc[ai][bj][m][n] = __builtin_amdgcn_mfma_f32_16x16x32_bf16(Bt[n][k], At[m][k], acc[ai][bj][m][n], 0, 0, 0); __builtin_amdgcn_s_setprio(0); } while (0)
#define PG8_WAIT_V(n) asm volatile("s_waitcnt vmcnt(" #n ")" ::: "memory")
#define PG8_WAIT_L(n) asm volatile("s_waitcnt lgkmcnt(" #n ")" ::: "memory")
#define PG8_BAR __builtin_amdgcn_s_barrier()
#define PG8_SCHED __builtin_amdgcn_sched_barrier(0)
    Unit cur, nxt; int ui = 0;
    if (!S.next(0, cur)) return;
    f32x4 acc[2][2][4][2];
#pragma unroll
    for (int a = 0; a < 2; ++a)
#pragma unroll
        for (int b = 0; b < 2; ++b)
#pragma unroll
            for (int m = 0; m < 4; ++m)
#pragma unroll
                for (int n = 0; n < 2; ++n) acc[a][b][m][n] = (f32x4){0.f, 0.f, 0.f, 0.f};
    bf16x8 At[4][2], B0[2][2], B1[2][2];
    unsigned vA[2][2], nvA[2][2];
    if constexpr (GATHER) {
#pragma unroll
        for (int h = 0; h < 2; ++h)
#pragma unroll
            for (int i = 0; i < 2; ++i) { vA[h][i] = (unsigned)(S.tok(cur, h * HALF + RA[i]) * K + CA[i]) * 2u; nvA[h][i] = vA[h][i]; }
    }
    const char* cA = S.a_ptr(cur); const char* cB = S.b_ptr(cur); const char* nA = cA;
    PG8_STAGE(PG8_SB(0, 0), cB, voffB); PG8_STAGE(PG8_SB(0, 1), cB + hstep, voffB); PG8_STAGE_A(PG8_SA(0, 0), 0, false, 0); PG8_STAGE_A(PG8_SA(0, 1), 1, false, 0);
    if (wr == 1) PG8_BAR;
    PG8_WAIT_V(2); PG8_BAR;
    PG8_STAGE(PG8_SB(1, 0), cB + kstep, voffB); PG8_STAGE_A(PG8_SA(1, 0), 0, false, kstep); PG8_STAGE(PG8_SB(1, 1), cB + hstep + kstep, voffB);
    PG8_WAIT_V(6); PG8_BAR;
    for (;;) {
        const bool has_next = S.next(ui + 1, nxt);
        nA = has_next ? S.a_ptr(nxt) : cA; const char* nB = has_next ? S.b_ptr(nxt) : cB;
        if constexpr (GATHER) {
            if (has_next) {
#pragma unroll
                for (int h = 0; h < 2; ++h)
#pragma unroll
                    for (int i = 0; i < 2; ++i) nvA[h][i] = (unsigned)(S.tok(nxt, h * HALF + RA[i]) * K + CA[i]) * 2u;
            }
        }
        for (int t = 0; t < nt; t += 2) {
            const bool last = (t == nt - 2);
            const size_t k1 = (size_t)(t + 1) * kstep;
            const size_t k2 = last ? 0 : (size_t)(t + 2) * kstep, k3 = k2 + kstep;
            const char* b2 = last ? nB : cB + (size_t)(t + 2) * kstep; const char* b3 = b2 + kstep;
            PG8_LDB(B0, 0, 0); PG8_LDB(B1, 0, 1); PG8_SCHED; PG8_LDA(At, 0, 0); PG8_STAGE_A(PG8_SA(1, 1), 1, false, k1);
            PG8_WAIT_V(8); PG8_WAIT_L(0); PG8_BAR; PG8_MMA(0, 0, At, B0); PG8_MMA(0, 1, At, B1); PG8_BAR; PG8_SCHED;
            PG8_LDA(At, 0, 1); PG8_STAGE(PG8_SB(0, 0), b2, voffB); PG8_STAGE(PG8_SB(0, 1), b2 + hstep, voffB); PG8_STAGE_A(PG8_SA(0, 0), 0, last, k2);
            PG8_WAIT_V(8); PG8_WAIT_L(0); PG8_BAR; PG8_MMA(1, 0, At, B0); PG8_MMA(1, 1, At, B1); PG8_BAR; PG8_SCHED;
            PG8_LDB(B0, 1, 0); PG8_LDB(B1, 1, 1); PG8_SCHED; PG8_LDA(At, 1, 0); PG8_STAGE_A(PG8_SA(0, 1), 1, last, k2);
            PG8_WAIT_V(8); PG8_WAIT_L(0); PG8_BAR; PG8_MMA(0, 0, At, B0); PG8_MMA(0, 1, At, B1); PG8_BAR; PG8_SCHED;
            PG8_LDA(At, 1, 1); PG8_STAGE(PG8_SB(1, 0), b3, voffB); PG8_STAGE(PG8_SB(1, 1), b3 + hstep, voffB); PG8_STAGE_A(PG8_SA(1, 0), 0, last, k3);
            PG8_WAIT_V(8); PG8_WAIT_L(0); PG8_BAR; PG8_MMA(1, 0, At, B0); PG8_MMA(1, 1, At, B1); PG8_BAR; PG8_SCHED;
        }
        if (wr == 0) PG8_BAR;
        E(acc, cur, wr, wc, fr, fq);
        if (!has_next) break;
#pragma unroll
        for (int a = 0; a < 2; ++a)
#pragma unroll
            for (int b = 0; b < 2; ++b)
#pragma unroll
                for (int m = 0; m < 4; ++m)
#pragma unroll
                    for (int n = 0; n < 2; ++n) acc[a][b][m][n] = (f32x4){0.f, 0.f, 0.f, 0.f};
        cur = nxt; cA = nA; cB = nB; ++ui;
        if constexpr (GATHER) {
#pragma unroll
            for (int h = 0; h < 2; ++h)
#pragma unroll
                for (int i = 0; i < 2; ++i) vA[h][i] = nvA[h][i];
        }
        if (wr == 1) PG8_BAR;
    }
    PG8_WAIT_V(0);
    PG8_BAR;
#undef PG8_SA
#undef PG8_SB
#undef PG8_STAGE
#undef PG8_STAGE_A
#undef PG8_LDA
#undef PG8_LDB
#undef PG8_MMA
#undef PG8_WAIT_V
#undef PG8_WAIT_L
#undef PG8_BAR
#undef PG8_SCHED
}
}

namespace pg8 {
__device__ __forceinline__ void row_bt(int row, int& b, int& tok) { if (row < TX) { b = row >> 11; tok = row & 2047; } else { const int r = row - TX; b = r >> 8; tok = SEQ + (r & 255); } }

struct EpiAttnIn {
    static constexpr bool PERM = true;
    bf16* QKV; bf16* VAT; bf16* VBT; const LAS float* rope;
    __device__ __forceinline__ void operator()(const f32x4 (&acc)[2][2][4][2], const Unit& u, int wr, int wc, int fr, int fq) const {
        const int row0 = u.pm * BM + wr * 64 + fr; const int seg = u.pn >> 1;
        const bool latent = u.pm < (TX / BM);
        if (seg == 2 || seg == 5) {
#pragma unroll
            for (int ai = 0; ai < 2; ++ai)
#pragma unroll
                for (int m = 0; m < 4; ++m) { const int row = row0 + ai * HALF + m * 16; int b, tok; row_bt(row, b, tok);
#pragma unroll
                    for (int bj = 0; bj < 2; ++bj) { const int col = u.pn * BM + bj * HALF + wc * 32 + 8 * fq;
                        bf16* dst;
                        if (seg == 2) { const int cs = col - 1024; dst = VAT + ((size_t)(b * 4 + (cs >> 7)) * 128 + (cs & 127)) * NKEY + tok; }
                        else { const int cs = col - 2560; dst = VBT + ((size_t)(b * 8 + (cs >> 6)) * 64 + (cs & 63)) * NKEY + tok; }
#pragma unroll
                        for (int n = 0; n < 2; ++n)
#pragma unroll
                            for (int i = 0; i < 4; ++i) dst[(size_t)(4 * n + i) * NKEY] = (bf16)f2bf(acc[ai][bj][m][n][i]); } }
            return;
        }
        const bool dorope = latent && seg < 2;
        const float qs = (seg == 0 || seg == 3) ? 0.125f * LOG2E : 1.0f;
#pragma unroll
        for (int ai = 0; ai < 2; ++ai)
#pragma unroll
            for (int m = 0; m < 4; ++m) { const int row = row0 + ai * HALF + m * 16;
                f32x4 cs4[4];
                if (dorope) { const int t = row & 2047; const int pos = (wc & 1) ? (t & 63) : (t >> 6);
                    const LAS f32x4* rp = (const LAS f32x4*)(rope + (pos * 16 + 8 * (fq & 1)) * 2);
#pragma unroll
                    for (int j = 0; j < 4; ++j) cs4[j] = rp[j]; }
#pragma unroll
                for (int bj = 0; bj < 2; ++bj) { const int col = u.pn * BM + bj * HALF + wc * 32 + 8 * fq;
                    float v[8];
#pragma unroll
                    for (int n = 0; n < 2; ++n)
#pragma unroll
                        for (int i = 0; i < 4; ++i) v[4 * n + i] = acc[ai][bj][m][n][i];
                    if (dorope) {
#pragma unroll
                        for (int j = 0; j < 8; ++j) { const float other = __shfl_xor(v[j], 32); const float c = cs4[j >> 1][(j & 1) * 2], s = cs4[j >> 1][(j & 1) * 2 + 1];
                            v[j] = (fq < 2) ? (v[j] * c - other * s) : (v[j] * c + other * s); } }
                    u32x4 w; w.x = pk2(v[0] * qs, v[1] * qs); w.y = pk2(v[2] * qs, v[3] * qs); w.z = pk2(v[4] * qs, v[5] * qs); w.w = pk2(v[6] * qs, v[7] * qs);
                    *(u32x4*)(QKV + (size_t)row * NATT + col) = w; } }
    }
};
struct EpiGlaIn {
    static constexpr bool PERM = true;
    bf16* QKV2; bf16* VGT;
    __device__ __forceinline__ void operator()(const f32x4 (&acc)[2][2][4][2], const Unit& u, int wr, int wc, int fr, int fq) const {
        const int row0 = u.pm * BM + wr * 64 + fr;
        if (u.pn >= 4 && u.pn < 8) {
#pragma unroll
            for (int ai = 0; ai < 2; ++ai)
#pragma unroll
                for (int m = 0; m < 4; ++m) { const int row = row0 + ai * HALF + m * 16; int b, tok; row_bt(row, b, tok);
#pragma unroll
                    for (int bj = 0; bj < 2; ++bj) { const int cs = u.pn * BM + bj * HALF + wc * 32 + 8 * fq - 1024;
                        bf16* dst = VGT + ((size_t)(b * 4 + (cs >> 8)) * 256 + (cs & 255)) * NKEY + tok;
#pragma unroll
                        for (int n = 0; n < 2; ++n)
#pragma unroll
                            for (int i = 0; i < 4; ++i) dst[(size_t)(4 * n + i) * NKEY] = (bf16)f2bf(acc[ai][bj][m][n][i]); } }
            return;
        }
        const float qs = (u.pn < 2) ? 0.08838834764831845f : 1.0f;
#pragma unroll
        for (int ai = 0; ai < 2; ++ai)
#pragma unroll
            for (int m = 0; m < 4; ++m) { const int row = row0 + ai * HALF + m * 16;
#pragma unroll
                for (int bj = 0; bj < 2; ++bj) { const int col = u.pn * BM + bj * HALF + wc * 32 + 8 * fq; const f32x4 a = acc[ai][bj][m][0] * qs, c = acc[ai][bj][m][1] * qs;
                    u32x4 w; w.x = pk2(a[0], a[1]); w.y = pk2(a[2], a[3]); w.z = pk2(c[0], c[1]); w.w = pk2(c[2], c[3]);
                    *(u32x4*)(QKV2 + (size_t)row * NGLA + col) = w; } }
    }
};
struct EpiResid {
    static constexpr bool PERM = false;
    float* XL; float* XC; const float* modv;
    __device__ __forceinline__ void operator()(const f32x4 (&acc)[2][2][4][2], const Unit& u, int wr, int wc, int fr, int fq) const {
        const int row0 = u.pm * BM + wr * 64 + fr, col0 = u.pn * BM + wc * 32 + 4 * fq;
        const bool latent = u.pm < (TX / BM); const int bi = latent ? (u.pm >> 3) : 8;
        float* base = latent ? XL : (XC - (size_t)TX * D);
        f32x4 gv[2][2];
#pragma unroll
        for (int bj = 0; bj < 2; ++bj)
#pragma unroll
            for (int n = 0; n < 2; ++n) gv[bj][n] = *(const f32x4*)(modv + bi * 6144 + col0 + bj * HALF + n * 16);
#pragma unroll
        for (int ai = 0; ai < 2; ++ai)
#pragma unroll
            for (int m = 0; m < 4; ++m) { float* rowp = base + (size_t)(row0 + ai * HALF + m * 16) * D + col0;
#pragma unroll
                for (int bj = 0; bj < 2; ++bj)
#pragma unroll
                    for (int n = 0; n < 2; ++n) { f32x4* p = (f32x4*)(rowp + bj * HALF + n * 16); *p = *p + gv[bj][n] * acc[ai][bj][m][n]; } }
    }
};
struct EpiMoe1 {
    static constexpr bool PERM = false;
    bf16* HB;
    __device__ __forceinline__ void operator()(const f32x4 (&acc)[2][2][4][2], const Unit& u, int wr, int wc, int fr, int fq) const {
        const int row0 = u.pm * BM + wr * 64 + fr, col0 = u.pn * 128 + wc * 16 + 4 * fq;
#pragma unroll
        for (int ai = 0; ai < 2; ++ai)
#pragma unroll
            for (int m = 0; m < 4; ++m) { bf16* rowp = HB + (size_t)(row0 + ai * HALF + m * 16) * DEXP + col0;
#pragma unroll
                for (int bj = 0; bj < 2; ++bj) { const f32x4 a = acc[ai][bj][m][0], b = acc[ai][bj][m][1];
                    u32x2 w; w.x = pk2(silu_f(a[0]) * b[0], silu_f(a[1]) * b[1]); w.y = pk2(silu_f(a[2]) * b[2], silu_f(a[3]) * b[3]);
                    *(u32x2*)(rowp + bj * 64) = w; } }
    }
};
struct EpiBf16 {
    static constexpr bool PERM = true;
    bf16* O; int ldc;
    __device__ __forceinline__ void operator()(const f32x4 (&acc)[2][2][4][2], const Unit& u, int wr, int wc, int fr, int fq) const {
        const int row0 = u.pm * BM + wr * 64 + fr, col0 = u.pn * BM + wc * 32 + 8 * fq;
#pragma unroll
        for (int ai = 0; ai < 2; ++ai)
#pragma unroll
            for (int m = 0; m < 4; ++m) { bf16* rowp = O + (size_t)(row0 + ai * HALF + m * 16) * ldc + col0;
#pragma unroll
                for (int bj = 0; bj < 2; ++bj) { const f32x4 a = acc[ai][bj][m][0], c = acc[ai][bj][m][1];
                    u32x4 w; w.x = pk2(a[0], a[1]); w.y = pk2(a[2], a[3]); w.z = pk2(c[0], c[1]); w.w = pk2(c[2], c[3]);
                    *(u32x4*)(rowp + bj * HALF) = w; } }
    }
};
}

struct Args {
    const float *x, *c, *ctx, *c_ctx, *w_mod, *b_mod, *norm_g, *final_g, *att_w_in, *att_w_out, *att_lambda, *att_subln_g, *na_bias,
                *gla_w_in, *gla_w_gate, *gla_b_gate, *gla_norm_g, *gla_w_out, *router_w, *router_bias, *moe_w1, *moe_w3, *moe_w2;
    float* out; unsigned char* ws; int ph_lo, ph_hi, rep, pad;
};

struct RowMapId { int off; __device__ __forceinline__ int operator()(int n) const { return off + n; } };
struct RowMapMoe { int which; __device__ __forceinline__ int operator()(int n) const { return 32 * (n >> 4) + 16 * which + (n & 15); } };
template <class RM>
__device__ __forceinline__ void p0_transpose_item(const float* W, int K, int N, bf16* WT, LAS float* scr, int item, int lane, RM rm) {
    const int nblk = N / 32, kb = item / nblk, nb = item % nblk, k0 = 64 * kb, n0 = 32 * nb;
#pragma unroll 8
    for (int i = 0; i < 32; ++i) { const int kk = 2 * i + (lane >> 5); scr[kk * 33 + (lane & 31)] = W[(size_t)(k0 + kk) * N + n0 + (lane & 31)]; }
    LDS_WAIT(); asm volatile("" ::: "memory");
    const int c = lane & 7;
#pragma unroll
    for (int j = 0; j < 4; ++j) { const int n = (lane >> 3) + 8 * j; const LAS float* s = scr + (8 * c) * 33 + n;
        u32x4 o; o.x = pk2(s[0 * 33], s[1 * 33]); o.y = pk2(s[2 * 33], s[3 * 33]); o.z = pk2(s[4 * 33], s[5 * 33]); o.w = pk2(s[6 * 33], s[7 * 33]);
        *(u32x4*)(WT + (size_t)rm(n0 + n) * K + k0 + 8 * c) = o; }
    LDS_WAIT(); asm volatile("" ::: "memory");
}

template <class AP> __device__ __forceinline__ void p0_prologue(const AP ap, LAS unsigned char* lds, int tid, int lane, int wave, int vcu, int G) {
    const Args a = Args{ap->x, ap->c, ap->ctx, ap->c_ctx, ap->w_mod, ap->b_mod, ap->norm_g, ap->final_g, ap->att_w_in, ap->att_w_out, ap->att_lambda, ap->att_subln_g, ap->na_bias, ap->gla_w_in, ap->gla_w_gate, ap->gla_b_gate, ap->gla_norm_g, ap->gla_w_out, ap->router_w, ap->router_bias, ap->moe_w1, ap->moe_w3, ap->moe_w2, ap->out, ap->ws, 0, 0, 0, 0};
    unsigned char* ws = a.ws;
    LAS float* scr = (LAS float*)(lds + wave * 8448);
    LAS float* S9 = (LAS float*)(lds + 69632);
    LAS float* red = (LAS float*)(lds + 106496);
    const int gw = vcu * 8 + wave, NGW = G * 8;
    constexpr int I_AIN = 16 * 96, I_AOUT = 16 * 32, I_GIN = 16 * 97, I_GOUT = 16 * 32, I_W1 = 16 * 16, I_W2 = 8 * 32;
    constexpr int N_A = 2 * I_AIN, N_B = N_A + 2 * I_AOUT, N_C = N_B + 2 * I_GIN, N_D = N_C + 2 * I_GOUT, N_E = N_D + 64 * I_W1, N_F = N_E + 64 * I_W1, N_G = N_F + 64 * I_W2;
    for (int it = gw; it < N_G; it += NGW) {
        if (it < N_A) { const int j = it / I_AIN, r = it % I_AIN; p0_transpose_item(a.att_w_in + (size_t)j * D * NATT, D, NATT, (bf16*)(ws + WS_WATTIN) + (size_t)j * NATT * D, scr, r, lane, RowMapId{0}); }
        else if (it < N_B) { const int q = it - N_A, j = q / I_AOUT, r = q % I_AOUT; p0_transpose_item(a.att_w_out + (size_t)j * D * D, D, D, (bf16*)(ws + WS_WATTOUT) + (size_t)j * D * D, scr, r, lane, RowMapId{0}); }
        else if (it < N_C) { const int q = it - N_B, j = q / I_GIN, r = q % I_GIN; p0_transpose_item(a.gla_w_in + (size_t)j * D * 3104, D, 3104, (bf16*)(ws + WS_WGLAIN) + (size_t)j * NGLA * D, scr, r, lane, RowMapId{0}); }
        else if (it < N_D) { const int q = it - N_C, j = q / I_GOUT, r = q % I_GOUT; p0_transpose_item(a.gla_w_out + (size_t)j * D * D, D, D, (bf16*)(ws + WS_WGLAOUT) + (size_t)j * D * D, scr, r, lane, RowMapId{0}); }
        else if (it < N_E) { const int q = it - N_D, j = q / I_W1, r = q % I_W1; p0_transpose_item(a.moe_w1 + (size_t)j * D * DEXP, D, DEXP, (bf16*)(ws + WS_W13) + (size_t)j * D * D, scr, r, lane, RowMapMoe{0}); }
        else if (it < N_F) { const int q = it - N_E, j = q / I_W1, r = q % I_W1; p0_transpose_item(a.moe_w3 + (size_t)j * D * DEXP, D, DEXP, (bf16*)(ws + WS_W13) + (size_t)j * D * D, scr, r, lane, RowMapMoe{1}); }
        else { const int q = it - N_F, j = q / I_W2, r = q % I_W2; p0_transpose_item(a.moe_w2 + (size_t)j * DEXP * D, DEXP, D, (bf16*)(ws + WS_W2) + (size_t)j * D * DEXP, scr, r, lane, RowMapId{0}); }
    }
    { const int gt = vcu * 512 + tid, NT = G * 512;
      for (int i = gt; i < 2 * 28672; i += NT) { const int j = i / 28672, r = i % 28672; *(u32x4*)((bf16*)(ws + WS_WGLAIN) + (size_t)j * NGLA * D + (size_t)3104 * D + (size_t)r * 8) = (u32x4){0u, 0u, 0u, 0u}; }
      const f32x4* xs = (const f32x4*)a.x; f32x4* xo = (f32x4*)a.out;
      for (int i = gt; i < TX * D / 4; i += NT) xo[i] = xs[i];
      const f32x4* cs = (const f32x4*)a.ctx; f32x4* co = (f32x4*)(ws + WS_CTX);
      for (int i = gt; i < TC * D / 4; i += NT) co[i] = cs[i];
    }
    __syncthreads();
    for (int i = tid; i < 9 * 1024; i += 512) { const int bi = i >> 10, k = i & 1023; const float v = (bi < 8) ? a.c[bi * D + k] : a.c_ctx[k]; S9[i] = v / (1.0f + __expf(-v)); }
    __syncthreads();
    for (int u = vcu; u < 4 * 96; u += G) {
        const int L = u / 96, n0 = (u % 96) * 64;
        const float* W = a.w_mod + (size_t)L * D * 6144 + n0 + lane;
        float acc[9];
#pragma unroll
        for (int bi = 0; bi < 9; ++bi) acc[bi] = 0.f;
        const int kb = wave * 128;
#pragma unroll 8
        for (int k = 0; k < 128; ++k) { const float w = W[(size_t)(kb + k) * 6144];
#pragma unroll
            for (int bi = 0; bi < 9; ++bi) acc[bi] += S9[bi * 1024 + kb + k] * w; }
#pragma unroll
        for (int bi = 0; bi < 9; ++bi) red[(wave * 9 + bi) * 64 + lane] = acc[bi];
        __syncthreads();
        for (int i = tid; i < 9 * 64; i += 512) { const int bi = i >> 6, l = i & 63; float s = a.b_mod[L * 6144 + n0 + l];
#pragma unroll
            for (int w = 0; w < 8; ++w) s += red[(w * 9 + bi) * 64 + l];
            ((float*)(ws + WS_MODV))[(size_t)(L * 9 + bi) * 6144 + n0 + l] = s; }
        __syncthreads();
    }
}

__device__ __forceinline__ float* xrow_ptr(float* XL, float* XC, int row) { return row < TX ? XL + (size_t)row * D : XC + (size_t)(row - TX) * D; }
__device__ __forceinline__ int row_bi(int row) { return row < TX ? (row >> 11) : 8; }

__device__ __forceinline__ void norm_mod_store(const f32x4 (&v)[4], const float* g, const float* sh, const float* sc, bf16* orow, int lane) {
    float ss = 0.f;
#pragma unroll
    for (int j = 0; j < 4; ++j) ss += (v[j].x * v[j].x + v[j].y * v[j].y) + (v[j].z * v[j].z + v[j].w * v[j].w);
    const float rs = __builtin_amdgcn_rsqf(wave_sum(ss) * (1.0f / D) + EPSF);
#pragma unroll
    for (int j = 0; j < 4; ++j) { const int c = 4 * lane + 256 * j; const f32x4 gg = *(const f32x4*)(g + c), s1 = *(const f32x4*)(sc + c), s0 = *(const f32x4*)(sh + c);
        const f32x4 y = (v[j] * rs) * gg * (1.0f + s1) + s0;
        u32x2 w; w.x = pk2(y.x, y.y); w.y = pk2(y.z, y.w); *(u32x2*)(orow + c) = w; }
}

__device__ __forceinline__ void phase_norm1(float* XL, float* XC, const float* g, const float* modv, bf16* H, int nrows, int lane, int wave, int vcu, int G) {
    for (int row = vcu * 8 + wave; row < nrows; row += G * 8) {
        const f32x4* xr = (const f32x4*)xrow_ptr(XL, XC, row) + lane; f32x4 v[4];
#pragma unroll
        for (int j = 0; j < 4; ++j) v[j] = xr[64 * j];
        const float* mv = modv + row_bi(row) * 6144;
        norm_mod_store(v, g, mv, mv + 1024, H + (size_t)row * D, lane);
    }
}

__device__ __forceinline__ void phase_router(float* XL, float* XC, const float* g, const float* modv, bf16* H, const float* router_w, const float* router_bias,
                                             unsigned* cnt  , int* list, int* toki, float* tokw, int nrows,
                                             LAS unsigned char* lds, int tid, int lane, int wave, int vcu, int G, int probe) {
    LAS float* RW = (LAS float*)lds;
    LAS int* lcnt = (LAS int*)(lds + 65536);
    LAS int* rinfo = (LAS int*)(lds + 65536 + 256);
    for (int it = 0; it < 8; ++it) { const int idx = tid + 512 * it, k = idx >> 2, q = idx & 3; const f32x4 w = *(const f32x4*)(router_w + k * 16 + 4 * q);
        RW[(4 * q + 0) * 1024 + k] = w.x; RW[(4 * q + 1) * 1024 + k] = w.y; RW[(4 * q + 2) * 1024 + k] = w.z; RW[(4 * q + 3) * 1024 + k] = w.w; }
    if (tid < 32) lcnt[tid] = 0;
    __syncthreads();
    const int rpb = nrows / G, rpw = rpb / 8;
    const int gI = lane >> 4;
    const f32x4 rb = *(const f32x4*)(router_bias + 4 * gI);
    for (int rep = (probe ? 0 : 1); rep < 2; ++rep)
    for (int i0 = 0; i0 < rpw; i0 += 3) {
        asm volatile("" ::: "memory");
        f32x4 y[3][4];
#pragma unroll
        for (int r = 0; r < 3; ++r) {
            const int ii = (i0 + r < rpw) ? i0 + r : rpw - 1; const int row = vcu * rpb + wave * rpw + ii;
            const f32x4* xr = (const f32x4*)xrow_ptr(XL, XC, row) + lane; f32x4 v[4];
#pragma unroll
            for (int j = 0; j < 4; ++j) v[j] = xr[64 * j];
            const float* mv = modv + row_bi(row) * 6144 + 3072;
            float ss = 0.f;
#pragma unroll
            for (int j = 0; j < 4; ++j) ss += (v[j].x * v[j].x + v[j].y * v[j].y) + (v[j].z * v[j].z + v[j].w * v[j].w);
            const float rs = __builtin_amdgcn_rsqf(wave_sum(ss) * (1.0f / D) + EPSF);
#pragma unroll
            for (int j = 0; j < 4; ++j) { const int c = 4 * lane + 256 * j; const f32x4 gg = *(const f32x4*)(g + c), s1 = *(const f32x4*)(mv + 1024 + c), s0 = *(const f32x4*)(mv + c);
                y[r][j] = (v[j] * rs) * gg * (1.0f + s1) + s0;
                u32x2 w; w.x = cvtpk(y[r][j].x, y[r][j].y); w.y = cvtpk(y[r][j].z, y[r][j].w); *(u32x2*)(H + (size_t)row * D + c) = w; }
            __builtin_amdgcn_sched_barrier(0);
        }
        float p[3][16];
#pragma unroll
        for (int e = 0; e < 16; ++e) {
#pragma unroll
            for (int r = 0; r < 3; ++r) p[r][e] = 0.f;
#pragma unroll
            for (int j = 0; j < 4; ++j) { const f32x4 w = *(const LAS f32x4*)(RW + e * 1024 + 4 * lane + 256 * j);
#pragma unroll
                for (int r = 0; r < 3; ++r) p[r][e] += (y[r][j].x * w.x + y[r][j].y * w.y) + (y[r][j].z * w.z + y[r][j].w * w.w); }
#pragma unroll
            for (int r = 0; r < 3; ++r) asm volatile("" : "+v"(p[r][e])); }
#pragma unroll
        for (int r = 0; r < 3; ++r) {
            float q8[8], lg[4];
#pragma unroll
            for (int j = 0; j < 8; ++j) q8[j] = swap32_add(p[r][j], p[r][j + 8]);
#pragma unroll
            for (int j = 0; j < 4; ++j) lg[j] = row_sum(swap16_add(q8[j], q8[j + 4]));
            float sc[4], sel[4];
#pragma unroll
            for (int j = 0; j < 4; ++j) { sc[j] = 1.0f / (1.0f + __expf(-lg[j])); sel[j] = sc[j] + rb[j]; }
            int i1 = 0, i2 = 0; float m1 = -1e30f, m2 = -1e30f, w1 = 0.f, w2 = 0.f;
#pragma unroll
            for (int j = 0; j < 4; ++j) { const float t = sel[j];
                if (t > m1) { m2 = m1; i2 = i1; w2 = w1; m1 = t; i1 = j; w1 = sc[j]; } else if (t > m2) { m2 = t; i2 = j; w2 = sc[j]; } }
            const float gs = m1 + m2;
            const float g0 = readlane_f(gs, 0), g1 = readlane_f(gs, 16), g2 = readlane_f(gs, 32), g3 = readlane_f(gs, 48);
            int bg = 0; float bgs = g0; if (g1 > bgs) { bgs = g1; bg = 1; } if (g2 > bgs) { bgs = g2; bg = 2; } if (g3 > bgs) { bgs = g3; bg = 3; }
            bg = __builtin_amdgcn_readfirstlane(bg);
            const int e0 = 4 * bg + __builtin_amdgcn_readlane(i1, 16 * bg), e1 = 4 * bg + __builtin_amdgcn_readlane(i2, 16 * bg);
            const float w0 = readlane_f(w1, 16 * bg), w1s = readlane_f(w2, 16 * bg);
            const float wn = 1.0f / (w0 + w1s);
            if (lane == 0 && rep == 1 && i0 + r < rpw) { const int rl = wave * rpw + i0 + r;
                const int p0 = __hip_atomic_fetch_add(&lcnt[e0], 1, __ATOMIC_RELAXED, __HIP_MEMORY_SCOPE_WORKGROUP), p1 = __hip_atomic_fetch_add(&lcnt[e1], 1, __ATOMIC_RELAXED, __HIP_MEMORY_SCOPE_WORKGROUP);
                rinfo[rl * 6 + 0] = e0; rinfo[rl * 6 + 1] = p0; rinfo[rl * 6 + 2] = e1; rinfo[rl * 6 + 3] = p1;
                rinfo[rl * 6 + 4] = __builtin_bit_cast(int, w0 * wn); rinfo[rl * 6 + 5] = __builtin_bit_cast(int, w1s * wn); }
        }
    }
    __syncthreads();
    if (tid < 16) lcnt[16 + tid] = (int)__hip_atomic_fetch_add(cnt + 64 * tid, (unsigned)lcnt[tid], RLX_AGENT);
    __syncthreads();
    if (tid < rpb) { const int row = vcu * rpb + tid; const int e0 = rinfo[tid * 6 + 0], e1 = rinfo[tid * 6 + 2];
        const int p0 = lcnt[16 + e0] + rinfo[tid * 6 + 1], p1 = lcnt[16 + e1] + rinfo[tid * 6 + 3];
        list[(size_t)e0 * TALL + p0] = row; list[(size_t)e1 * TALL + p1] = row;
        toki[row * 4 + 0] = e0; toki[row * 4 + 1] = p0; toki[row * 4 + 2] = e1; toki[row * 4 + 3] = p1;
        tokw[row * 2 + 0] = __builtin_bit_cast(float, rinfo[tid * 6 + 4]); tokw[row * 2 + 1] = __builtin_bit_cast(float, rinfo[tid * 6 + 5]); }
    __syncthreads();
}

__device__ __forceinline__ int build_moe_table(const unsigned* cnt, LAS int* tab, int tid) {
    if (tid == 0) { int rt = 0;
        for (int e = 0; e < 16; ++e) { const int c = (int)__hip_atomic_load(cnt + 64 * e, RLX_AGENT); tab[RT_MAX + 1 + e] = c; const int nt = (c + 255) >> 8;
            for (int m = 0; m < nt; ++m) { if (rt < RT_MAX) tab[rt] = e | (m << 8); ++rt; } }
        tab[RT_MAX] = rt < RT_MAX ? rt : RT_MAX; }
    __syncthreads();
    return tab[RT_MAX];
}

__device__ __forceinline__ void phase_combine(float* XL, float* XC, const float* modv  , const bf16* YB, const unsigned* cnt, const int* toki, const float* tokw,
                                              bool final_layer, const float* gnext, const float* modv_next, bf16* H, int nrows, int lane, int wave, int vcu, int G, int probe) {
    int tiles = 0; if (lane < 16) tiles = ((int)__hip_atomic_load(cnt + 64 * lane, RLX_AGENT) + 255) >> 8;
    int incl = tiles;
#pragma unroll
    for (int o = 1; o < 16; o <<= 1) { const int t = __shfl_up(incl, o); if (lane >= o) incl += t; }
    const int mybase = (incl - tiles) * 256;
    for (int rep = (probe ? 0 : 1); rep < 2; ++rep)
    for (int row = vcu * 8 + wave; row < nrows; row += G * 8) {
        const int e0 = toki[row * 4 + 0], p0 = toki[row * 4 + 1], e1 = toki[row * 4 + 2], p1 = toki[row * 4 + 3];
        const float w0 = tokw[row * 2 + 0], w1 = tokw[row * 2 + 1];
        const int s0 = __shfl(mybase, e0) + p0, s1 = __shfl(mybase, e1) + p1;
        float* xp = xrow_ptr(XL, XC, row);
        const float* g2 = modv + row_bi(row) * 6144 + 5120;
        f32x4 v[4];
#pragma unroll
        for (int j = 0; j < 4; ++j) { const int c = 4 * lane + 256 * j;
            const u32x2 a = *(const u32x2*)(YB + (size_t)s0 * D + c), b = *(const u32x2*)(YB + (size_t)s1 * D + c);
            f32x4 y; y.x = w0 * bflo(a.x) + w1 * bflo(b.x); y.y = w0 * bfhi(a.x) + w1 * bfhi(b.x); y.z = w0 * bflo(a.y) + w1 * bflo(b.y); y.w = w0 * bfhi(a.y) + w1 * bfhi(b.y);
            v[j] = *(const f32x4*)(xp + c) + *(const f32x4*)(g2 + c) * y; }
        if (final_layer) {
            float ss = 0.f;
#pragma unroll
            for (int j = 0; j < 4; ++j) ss += (v[j].x * v[j].x + v[j].y * v[j].y) + (v[j].z * v[j].z + v[j].w * v[j].w);
            const float rs = __builtin_amdgcn_rsqf(wave_sum(ss) * (1.0f / D) + EPSF);
#pragma unroll
            for (int j = 0; j < 4; ++j) { const int c = 4 * lane + 256 * j; if (rep == 1) *(f32x4*)(xp + c) = (v[j] * rs) * *(const f32x4*)(gnext + c); }
        } else {
            if (rep == 1) {
#pragma unroll
            for (int j = 0; j < 4; ++j) *(f32x4*)(xp + 4 * lane + 256 * j) = v[j]; }
            const float* mv = modv_next + row_bi(row) * 6144;
            norm_mod_store(v, gnext, mv, mv + 1024, H + (size_t)row * D, lane);
        }
    }
}

__device__ __forceinline__ void phase_readout(const bf16* OF, const bf16* OB, const bf16* QKV2, const float* ng, bf16* AOUT, int nrows, int lane, int wave, int vcu, int G) {
    const f32x4 gg = *(const f32x4*)(ng + 4 * lane);
    for (int row = vcu * 8 + wave; row < nrows; row += G * 8) {
#pragma unroll
        for (int j = 0; j < 4; ++j) { const int c = 4 * lane + 256 * j;
            const u32x2 a = *(const u32x2*)(OF + (size_t)row * D + c), b = *(const u32x2*)(OB + (size_t)row * D + c), gt = *(const u32x2*)(QKV2 + (size_t)row * NGLA + 2048 + c);
            f32x4 o; o.x = bflo(a.x) + bflo(b.x); o.y = bfhi(a.x) + bfhi(b.x); o.z = bflo(a.y) + bflo(b.y); o.w = bfhi(a.y) + bfhi(b.y);
            const float ss = wave_sum((o.x * o.x + o.y * o.y) + (o.z * o.z + o.w * o.w));
            const float rs = __builtin_amdgcn_rsqf(ss * (1.0f / 256.0f) + EPSF);
            f32x4 gv; gv.x = silu_f(bflo(gt.x)); gv.y = silu_f(bfhi(gt.x)); gv.z = silu_f(bflo(gt.y)); gv.w = silu_f(bfhi(gt.y));
            const f32x4 y = (o * rs) * gg * gv;
            u32x2 w; w.x = pk2(y.x, y.y); w.y = pk2(y.z, y.w); *(u32x2*)(AOUT + (size_t)row * D + c) = w; }
    }
}

__device__ __forceinline__ int na_r0(int r) { int v = r - 4; return v < 0 ? 0 : (v > 24 ? 24 : v); }
template <int NMAPS, int DV, bool NA>
__device__ __forceinline__ void attn_unit(LAS unsigned char* lds, int tid, int lane, int wave,
                                          const bf16* QKV, int qcol, int qrow0, int kcol, int krow_lat, int krow_ctx, const bf16* VT, int klo, int khi,
                                          int r_wave, int xq0, const LAS float* biasT,
                                          bf16* AOUT, int ocol, float lam, const float* subg, float outscale) {
    constexpr int KB = 9216;
    constexpr int BUFSZ = NMAPS * KB + DV * 144;
    constexpr int NVB = DV / 16, NVR = DV / 64;
    const int fr = lane & 15, g = lane >> 4;
    bf16x8 qf[NMAPS][2];
    { const bf16* qp = QKV + (size_t)(qrow0 + wave * 16 + fr) * NATT + qcol + 8 * g;
#pragma unroll
      for (int m = 0; m < NMAPS; ++m)
#pragma unroll
          for (int s = 0; s < 2; ++s) qf[m][s] = *(const bf16x8*)(qp + m * 64 + 32 * s); }
    f32x4 O[NMAPS][NVB]; float mrun[NMAPS]; f32x2 lrun[NMAPS];
#pragma unroll
    for (int m = 0; m < NMAPS; ++m) { mrun[m] = -1e30f; lrun[m] = (f32x2){0.f, 0.f};
#pragma unroll
        for (int vb = 0; vb < NVB; ++vb) O[m][vb] = (f32x4){0.f, 0.f, 0.f, 0.f}; }
    const int ntiles = 4 + (khi - klo);
    u32x4 kreg[NMAPS], vreg[NVR];
    const int lkey = tid >> 3, lch = tid & 7;
#define AT_LOAD(i) do { const int _i = (i); const int _rowg = (_i < 4 ? krow_ctx + 64 * _i : krow_lat + 64 * (klo + _i - 4)) + lkey; const int _tok0 = (_i < 4 ? SEQ + 64 * _i : 64 * (klo + _i - 4)); \
        _Pragma("unroll") for (int m = 0; m < NMAPS; ++m) kreg[m] = *(const u32x4*)(QKV + (size_t)_rowg * NATT + kcol + m * 64 + lch * 8); \
        _Pragma("unroll") for (int j = 0; j < NVR; ++j) { const int idx = tid + 512 * j; vreg[j] = *(const u32x4*)(VT + (size_t)(idx >> 3) * NKEY + _tok0 + (idx & 7) * 8); } } while (0)
#define AT_STORE(b) do { LAS unsigned char* _p = lds + (b) * BUFSZ; \
        _Pragma("unroll") for (int m = 0; m < NMAPS; ++m) *(LAS u32x4*)(_p + m * KB + lkey * 144 + lch * 16) = kreg[m]; \
        _Pragma("unroll") for (int j = 0; j < NVR; ++j) { const int idx = tid + 512 * j; *(LAS u32x4*)(_p + NMAPS * KB + (idx >> 3) * 144 + (idx & 7) * 16) = vreg[j]; } } while (0)
    AT_LOAD(0); AT_STORE(0); __syncthreads();
    const int kbase0 = (8 * (fr >> 2) + (fr & 3)) * 144 + 16 * g;
    const int vbase = fr * 144 + 16 * g;
    int r0w = 0, xq = 0, tmask = 3; float pen[4][4];
    if constexpr (NA) { r0w = na_r0(r_wave); xq = xq0 + fr; int cs = xq - 8; cs = cs < 0 ? 0 : (cs > 48 ? 48 : cs);
        int c0 = xq0 - 8; c0 = c0 < 0 ? 0 : (c0 > 48 ? 48 : c0); int c1 = xq0 + 15 - 8; c1 = (c1 < 0 ? 0 : (c1 > 48 ? 48 : c1)) + 16;
        tmask = (c0 < 32 ? 1 : 0) | (c1 > 32 ? 2 : 0);
#pragma unroll
        for (int kb = 0; kb < 4; ++kb)
#pragma unroll
            for (int ii = 0; ii < 4; ++ii) { const int y = 32 * (kb >> 1) + 8 * g + 4 * (kb & 1) + ii; pen[kb][ii] = (y >= cs && y < cs + 16) ? 0.f : -1e30f; } }
    for (int i = 0; i < ntiles; ++i) {
        if (i + 1 < ntiles) AT_LOAD(i + 1);
        const LAS unsigned char* buf = lds + (i & 1) * BUFSZ;
        bool active = true; int kr = 0; bool local = false;
        if constexpr (NA) { if (i >= 4) { local = true; kr = klo + i - 4; active = (kr >= r0w) && (kr < r0w + 8); } }
        if (active) {
            const int tm = local ? tmask : 3;
            bf16x8 kf[NMAPS][4][2];
#pragma unroll
            for (int m = 0; m < NMAPS; ++m)
#pragma unroll
                for (int kb = 0; kb < 4; ++kb)
#pragma unroll
                    for (int s = 0; s < 2; ++s) kf[m][kb][s] = *(const LAS bf16x8*)(buf + m * KB + kbase0 + (kb & 1) * (4 * 144) + (kb >> 1) * (32 * 144) + s * 64);
            __builtin_amdgcn_sched_barrier(0);
            f32x4 S[NMAPS][4];
#pragma unroll
            for (int m = 0; m < NMAPS; ++m)
#pragma unroll
                for (int kb = 0; kb < 4; ++kb) { S[m][kb] = (f32x4){0.f, 0.f, 0.f, 0.f};
                    if (!NA || (tm >> (kb >> 1)) & 1) {
#pragma unroll
                        for (int s = 0; s < 2; ++s) S[m][kb] = __builtin_amdgcn_mfma_f32_16x16x32_bf16(kf[m][kb][s], qf[m][s], S[m][kb], 0, 0, 0); } }
            bf16x8 vf0[4][2];
#pragma unroll
            for (int vb = 0; vb < 4; ++vb)
#pragma unroll
                for (int t = 0; t < 2; ++t) vf0[vb][t] = *(const LAS bf16x8*)(buf + NMAPS * KB + vbase + vb * (16 * 144) + t * 64);
            __builtin_amdgcn_sched_barrier(0);
            bf16x8 pf[NMAPS][2];
#pragma unroll
            for (int m = 0; m < NMAPS; ++m) {
                if constexpr (NA) { if (local) {
                        const LAS float* bp = biasT + (kr - r_wave + 7) * 31 + (8 * g - xq + 15);
#pragma unroll
                        for (int kb = 0; kb < 4; ++kb)
#pragma unroll
                            for (int ii = 0; ii < 4; ++ii) { const float t = (tm >> (kb >> 1)) & 1 ? (S[m][kb][ii] + pen[kb][ii]) + bp[32 * (kb >> 1) + 4 * (kb & 1) + ii] : -1e30f; S[m][kb][ii] = t; } } }
                float mx = fmaxf(fmaxf(S[m][0][0], S[m][0][1]), fmaxf(S[m][0][2], S[m][0][3]));
#pragma unroll
                for (int kb = 1; kb < 4; ++kb) mx = fmaxf(fmaxf(mx, S[m][kb][0]), fmaxf(fmaxf(S[m][kb][1], S[m][kb][2]), S[m][kb][3]));
                mx = swap32_max(swap16_max(mx));
                if (__any(mx > mrun[m] + 8.0f)) {
                    const float mnew = fmaxf(mrun[m], mx), alpha = fexp2(mrun[m] - mnew); mrun[m] = mnew; lrun[m] = lrun[m] * alpha;
#pragma unroll
                    for (int vb = 0; vb < NVB; ++vb) O[m][vb] = O[m][vb] * alpha;
                }
                const float mm = mrun[m];
                unsigned pw[8]; float l0 = 0.f, l1 = 0.f;
#pragma unroll
                for (int kb = 0; kb < 4; ++kb) { const float a0 = fexp2(S[m][kb][0] - mm), a1 = fexp2(S[m][kb][1] - mm), a2 = fexp2(S[m][kb][2] - mm), a3 = fexp2(S[m][kb][3] - mm);
                    l0 += a0 + a1; l1 += a2 + a3;
                    pw[2 * kb] = cvtpk(a0, a1); pw[2 * kb + 1] = cvtpk(a2, a3); }
                lrun[m].x += l0; lrun[m].y += l1;
                pf[m][0] = __builtin_bit_cast(bf16x8, (u32x4){pw[0], pw[1], pw[2], pw[3]});
                pf[m][1] = __builtin_bit_cast(bf16x8, (u32x4){pw[4], pw[5], pw[6], pw[7]});
            }
            __builtin_amdgcn_sched_barrier(0);
            if constexpr (NVB == 8) {
                bf16x8 vf1[4][2];
#pragma unroll
                for (int vb = 0; vb < 4; ++vb)
#pragma unroll
                    for (int t = 0; t < 2; ++t) vf1[vb][t] = *(const LAS bf16x8*)(buf + NMAPS * KB + vbase + (4 + vb) * (16 * 144) + t * 64);
                __builtin_amdgcn_sched_barrier(0);
#pragma unroll
                for (int vb = 0; vb < 4; ++vb)
#pragma unroll
                    for (int t = 0; t < 2; ++t)
#pragma unroll
                        for (int m = 0; m < NMAPS; ++m) O[m][vb] = __builtin_amdgcn_mfma_f32_16x16x32_bf16(vf0[vb][t], pf[m][t], O[m][vb], 0, 0, 0);
                __builtin_amdgcn_sched_barrier(0);
#pragma unroll
                for (int vb = 0; vb < 4; ++vb)
#pragma unroll
                    for (int t = 0; t < 2; ++t)
#pragma unroll
                        for (int m = 0; m < NMAPS; ++m) O[m][4 + vb] = __builtin_amdgcn_mfma_f32_16x16x32_bf16(vf1[vb][t], pf[m][t], O[m][4 + vb], 0, 0, 0);
            } else {
#pragma unroll
                for (int vb = 0; vb < 4; ++vb)
#pragma unroll
                    for (int t = 0; t < 2; ++t) { if (!NA || (tm >> t) & 1) {
#pragma unroll
                            for (int m = 0; m < NMAPS; ++m) O[m][vb] = __builtin_amdgcn_mfma_f32_16x16x32_bf16(vf0[vb][t], pf[m][t], O[m][vb], 0, 0, 0); } }
            }
            __builtin_amdgcn_sched_barrier(0);
        }
        if (i + 1 < ntiles) AT_STORE((i + 1) & 1);
        __syncthreads();
    }
#undef AT_LOAD
#undef AT_STORE
    float inv[NMAPS];
#pragma unroll
    for (int m = 0; m < NMAPS; ++m) { float l = lrun[m].x + lrun[m].y; l = swap16_add(l, l); l = swap32_add(l, l); inv[m] = 1.0f / l; }
    const int orow = qrow0 + wave * 16 + fr;
    if constexpr (NMAPS == 2) {
        float ss = 0.f; const float i1 = inv[0], i2 = lam * inv[1];
#pragma unroll
        for (int vb = 0; vb < NVB; ++vb) { O[0][vb] = O[0][vb] * i1 - O[1][vb] * i2; const f32x4 o = O[0][vb]; ss += (o.x * o.x + o.y * o.y) + (o.z * o.z + o.w * o.w); }
        ss = swap16_add(ss, ss); ss = swap32_add(ss, ss);
        const float rs = __builtin_amdgcn_rsqf(ss * (1.0f / DV) + EPSF) * outscale;
#pragma unroll
        for (int vb = 0; vb < NVB; ++vb) { const f32x4 gg = *(const f32x4*)(subg + 16 * vb + 4 * g); const f32x4 y = O[0][vb] * rs * gg;
            u32x2 w; w.x = cvtpk(y.x, y.y); w.y = cvtpk(y.z, y.w); *(u32x2*)(AOUT + (size_t)orow * D + ocol + 16 * vb + 4 * g) = w; }
    } else {
#pragma unroll
        for (int vb = 0; vb < NVB; ++vb) { const f32x4 y = O[0][vb] * inv[0];
            u32x2 w; w.x = cvtpk(y.x, y.y); w.y = cvtpk(y.z, y.w); *(u32x2*)(AOUT + (size_t)orow * D + ocol + 16 * vb + 4 * g) = w; }
    }
}


__device__ __forceinline__ void phase_attention(const bf16* QKV, const bf16* VAT, const bf16* VBT, bf16* AOUT, const float* lamp  , float lam_init, const float* subg, const float* nab  ,
                                                LAS unsigned char* lds, int tid, int lane, int wave, int vcu, int G, int repmask) {
    float part = lamp[lane] * lamp[64 + lane]; float part2 = lamp[128 + lane] * lamp[192 + lane];
    const float lam = __expf(wave_sum(part)) - __expf(wave_sum(part2)) + lam_init;
    for (int rep = 0; rep <= ((repmask >> 8) & 1); ++rep)
    for (int u = vcu; u < 576; u += G) {
        int bh, qrow0, khi;
        if (u < 512) { bh = u >> 4; const int qt = u & 15; qrow0 = (bh >> 2) * SEQ + qt * 128; khi = 32; }
        else { const int q = u - 512; bh = q >> 1; const int qt = q & 1; qrow0 = TX + (bh >> 2) * CTXL + qt * 128; khi = 0; }
        const int b = bh >> 2, h = bh & 3;
        attn_unit<2, 128, false>(lds, tid, lane, wave, QKV, h * 128, qrow0, 512 + h * 128, b * SEQ, TX + b * CTXL, VAT + (size_t)bh * 128 * NKEY, 0, khi, 0, 0, nullptr,
                                 AOUT, h * 128, lam, subg, 1.0f - lam_init);
    }
    LAS float* biasT = (LAS float*)(lds + LX_BIAS) + 64;
    for (int rep = 0; rep <= ((repmask >> 9) & 1); ++rep)
    for (int u = vcu; u < 1152; u += G) {
        int bh, qrow0, klo, khi, rw;
        if (u < 1024) { bh = u >> 4; const int rp = u & 15; qrow0 = (bh >> 3) * SEQ + rp * 128; klo = na_r0(2 * rp); khi = na_r0(2 * rp + 1) + 8; rw = 2 * rp + (wave >> 2); }
        else { const int q = u - 1024; bh = q >> 1; const int qt = q & 1; qrow0 = TX + (bh >> 3) * CTXL + qt * 128; klo = 0; khi = 0; rw = 0; }
        const int b = bh >> 3, h = bh & 7;
        for (int i = tid; i < 640; i += 512) { const int k = i - 64; biasT[k] = (k >= 0 && k < 465) ? nab[h * 465 + k] * LOG2E : 0.f; }
        attn_unit<1, 64, true>(lds, tid, lane, wave, QKV, 1536 + h * 64, qrow0, 2048 + h * 64, b * SEQ, TX + b * CTXL, VBT + (size_t)bh * 64 * NKEY, klo, khi,
                               rw, 16 * (wave & 3), biasT, AOUT, 512 + h * 64, 0.f, nullptr, 1.0f);
    }
}

__device__ __forceinline__ void gla_chunk_rows(int b, int dir, int n, int& row0, int& tok0) {
    if (n < 4) { const int cc = dir ? 3 - n : n; row0 = TX + b * CTXL + 64 * cc; tok0 = SEQ + 64 * cc; } else { const int lc = dir ? 35 - n : n - 4; row0 = b * SEQ + 64 * lc; tok0 = 64 * lc; }
}
constexpr int GP_QM = 0, GP_KM = 17408, GP_VT = 34816, GP_LR = 71680, GP_SEG = 75776;
__device__ __forceinline__ void phase_gla_prep(const bf16* QKV2, const bf16* VGT, const float* wgate  , const float* bgate  ,
                                               bf16* QG, bf16* KET, float* FACD, bf16* OF, bf16* OB,
                                               LAS unsigned char* lds, int tid, int lane, int wave, int vcu, int G) {
    const int fr = lane & 15, g = lane >> 4;
    const int d = tid & 127, seg = tid >> 7;
    LAS float* LR = (LAS float*)(lds + GP_LR);
    LAS float* SEG = (LAS float*)(lds + GP_SEG);
    for (int ub = vcu * 9; ub < 2304; ub += G * 9) {
        const int q = ub / 36, n0 = ub % 36, dir = q & 1, hh = (q >> 1) & 3, b = q >> 3;
        bf16* OUT = dir ? OB : OF;
        float wg[16];
#pragma unroll
        for (int r = 0; r < 16; ++r) wg[r] = wgate[(dir * 16 + r) * 512 + hh * 128 + d];
        const float bgv = bgate[dir * 512 + hh * 128 + d];
        const bf16* vtb = VGT + (size_t)(b * 4 + hh) * 256 * NKEY;
        u32x4 qr[2], kr[2], vr[4], lr4;
#define GP_LOAD(n) do { int _row0, _tok0; gla_chunk_rows(b, dir, (n), _row0, _tok0); \
        _Pragma("unroll") for (int j = 0; j < 2; ++j) { const int idx = tid + 512 * j, p = idx >> 4, ch = idx & 15; const bf16* src = QKV2 + (size_t)(_row0 + p) * NGLA + hh * 128 + ch * 8; qr[j] = *(const u32x4*)src; kr[j] = *(const u32x4*)(src + 512); } \
        _Pragma("unroll") for (int j = 0; j < 4; ++j) { const int idx = tid + 512 * j; vr[j] = *(const u32x4*)(vtb + (size_t)(idx >> 3) * NKEY + _tok0 + (idx & 7) * 8); } \
        if (tid < 128) lr4 = *(const u32x4*)(QKV2 + (size_t)(_row0 + (tid >> 1)) * NGLA + 3072 + dir * 16 + (tid & 1) * 8); } while (0)
        GP_LOAD(n0);
        for (int k9 = 0; k9 < 9; ++k9) {
            const int n = n0 + k9, u = ub + k9; int row0, tok0; gla_chunk_rows(b, dir, n, row0, tok0);
#pragma unroll
            for (int j = 0; j < 2; ++j) { const int idx = tid + 512 * j, p = idx >> 4, ch = idx & 15;
                *(LAS u32x4*)(lds + GP_QM + p * 272 + ch * 16) = qr[j]; *(LAS u32x4*)(lds + GP_KM + p * 272 + ch * 16) = kr[j]; }
#pragma unroll
            for (int j = 0; j < 4; ++j) { const int idx = tid + 512 * j; *(LAS u32x4*)(lds + GP_VT + (idx >> 3) * 144 + (idx & 7) * 16) = vr[j]; }
            if (tid < 128) { LAS float* lp = LR + (tid >> 1) * 16 + (tid & 1) * 8;
                lp[0] = bflo(lr4.x); lp[1] = bfhi(lr4.x); lp[2] = bflo(lr4.y); lp[3] = bfhi(lr4.y); lp[4] = bflo(lr4.z); lp[5] = bfhi(lr4.z); lp[6] = bflo(lr4.w); lp[7] = bfhi(lr4.w); }
            __syncthreads();
            if (k9 + 1 < 9) GP_LOAD(n + 1);
            float gc[16];
#pragma unroll
            for (int pi = 0; pi < 16; ++pi) { const LAS f32x4* lp = (const LAS f32x4*)(LR + (16 * seg + pi) * 16); float z = bgv;
#pragma unroll
                for (int k = 0; k < 4; ++k) { const f32x4 l4 = lp[k]; z += l4.x * wg[4 * k] + l4.y * wg[4 * k + 1] + l4.z * wg[4 * k + 2] + l4.w * wg[4 * k + 3]; }
                const float az = fabsf(z); gc[pi] = (fminf(z, 0.f) - flog(1.0f + fexp(-az))) * 0.0625f; }
            float run = 0.f;
            if (dir == 0) {
#pragma unroll
                for (int pi = 0; pi < 16; ++pi) { run += gc[pi]; gc[pi] = run; }
            } else {
#pragma unroll
                for (int pi = 15; pi >= 0; --pi) { run += gc[pi]; gc[pi] = run; }
            }
            SEG[seg * 128 + d] = run;
            __syncthreads();
            const float t0 = SEG[d], t1 = SEG[128 + d], t2 = SEG[256 + d], t3 = SEG[384 + d];
            float off, gmid; const float gend = (t0 + t1) + (t2 + t3);
            if (dir == 0) { off = (seg > 0 ? t0 : 0.f) + (seg > 1 ? t1 : 0.f) + (seg > 2 ? t2 : 0.f); gmid = t0 + t1; }
            else { off = (seg < 3 ? t3 : 0.f) + (seg < 2 ? t2 : 0.f) + (seg < 1 ? t1 : 0.f); gmid = t3 + t2; }
            const float emid = fexp(gmid), eend = fexp(gend - gmid);
            unsigned kep[8];
            bf16* qgp = QG + ((size_t)u * 64 + 16 * seg) * 128 + d;
#pragma unroll
            for (int pi = 0; pi < 16; ++pi) { const int p = 16 * seg + pi; const float rel = off + gc[pi] - gmid; const float Ep = fexp(rel), Ei = fexp(-rel);
                LAS bf16* qa = (LAS bf16*)(lds + GP_QM) + p * 136 + d; LAS bf16* ka = (LAS bf16*)(lds + GP_KM) + p * 136 + d;
                const float qv = bf2f(*qa), kv = bf2f(*ka);
                const float qm = qv * Ep, km = kv * Ei;
                const unsigned w1 = cvtpk(qm, qm * emid), w2 = cvtpk(km, km * eend);
                *qa = (bf16)(w1 & 0xffffu); qgp[pi * 128] = (bf16)(w1 >> 16); *ka = (bf16)(w2 & 0xffffu);
                if (pi & 1) kep[pi >> 1] |= (w2 & 0xffff0000u); else kep[pi >> 1] = w2 >> 16; }
            { u32x4* kt = (u32x4*)(KET + ((size_t)u * 128 + d) * 64 + 16 * seg); kt[0] = (u32x4){kep[0], kep[1], kep[2], kep[3]}; kt[1] = (u32x4){kep[4], kep[5], kep[6], kep[7]}; }
            if (seg == 0) FACD[(size_t)u * 128 + d] = fexp(gend);
            __syncthreads();
            { const int cb = wave & 3, half = wave >> 2;
              bf16x8 qfr[4];
#pragma unroll
              for (int ks = 0; ks < 4; ++ks) qfr[ks] = *(const LAS bf16x8*)(lds + GP_QM + (16 * cb + fr) * 272 + (8 * g + 32 * ks) * 2);
              f32x4 AT[4];
#pragma unroll
              for (int sb = 0; sb < 4; ++sb) { AT[sb] = (f32x4){0.f, 0.f, 0.f, 0.f};
#pragma unroll
                  for (int ks = 0; ks < 4; ++ks) { const bf16x8 af = *(const LAS bf16x8*)(lds + GP_KM + (16 * sb + fr) * 272 + (8 * g + 32 * ks) * 2);
                      AT[sb] = __builtin_amdgcn_mfma_f32_16x16x32_bf16(af, qfr[ks], AT[sb], 0, 0, 0); }
                  const int c = 16 * cb + fr;
#pragma unroll
                  for (int ii = 0; ii < 4; ++ii) { const int sp = 16 * sb + 4 * g + ii; const bool keep = dir ? (sp >= c) : (sp <= c); AT[sb][ii] = keep ? AT[sb][ii] : 0.f; } }
              bf16x8 pf[2];
#pragma unroll
              for (int t = 0; t < 2; ++t) { u32x4 w; w.x = pk2(AT[2 * t][0], AT[2 * t][1]); w.y = pk2(AT[2 * t][2], AT[2 * t][3]); w.z = pk2(AT[2 * t + 1][0], AT[2 * t + 1][1]); w.w = pk2(AT[2 * t + 1][2], AT[2 * t + 1][3]);
                  pf[t] = __builtin_bit_cast(bf16x8, w); }
#pragma unroll
              for (int v8 = 0; v8 < 8; ++v8) { const int vb = 8 * half + v8; f32x4 Oa = (f32x4){0.f, 0.f, 0.f, 0.f};
#pragma unroll
                  for (int t = 0; t < 2; ++t) { const LAS unsigned char* vp = lds + GP_VT + (16 * vb + fr) * 144 + (32 * t + 4 * g) * 2;
                      const u32x2 lo = *(const LAS u32x2*)vp, hi = *(const LAS u32x2*)(vp + 32);
                      u32x4 w; w.x = lo.x; w.y = lo.y; w.z = hi.x; w.w = hi.y;
                      Oa = __builtin_amdgcn_mfma_f32_16x16x32_bf16(__builtin_bit_cast(bf16x8, w), pf[t], Oa, 0, 0, 0); }
                  u32x2 w; w.x = pk2(Oa[0], Oa[1]); w.y = pk2(Oa[2], Oa[3]);
                  *(u32x2*)(OUT + (size_t)(row0 + 16 * cb + fr) * D + hh * 256 + 16 * vb + 4 * g) = w; }
            }
            __syncthreads();
        }
#undef GP_LOAD
    }
}

constexpr int GS_BUF = 45056, GS_QG = 0, GS_KET = 17408, GS_VT = 35840, GS_ST = 2 * GS_BUF, GS_DEC = GS_ST + 2 * 17408;
__device__ __forceinline__ void phase_gla(const bf16* VGT, bf16* OF, bf16* OB, const bf16* QG, const bf16* KET, const float* FACD,
                                          LAS unsigned char* lds, int tid, int lane, int wave, int vcu, int G) {
    const int fr = lane & 15, g = lane >> 4;
    for (int u = vcu; u < 256; u += G) {
        const int slab = u & 3, dir = (u >> 2) & 1, hh = (u >> 3) & 3, b = u >> 5;
        bf16* OUT = dir ? OB : OF;
        const int upb = ((b * 4 + hh) * 2 + dir) * 36;
        f32x4 Sacc[4];
#pragma unroll
        for (int vb = 0; vb < 4; ++vb) Sacc[vb] = (f32x4){0.f, 0.f, 0.f, 0.f};
        for (int i = tid; i < 17408 / 4; i += 512) ((LAS unsigned*)(lds + GS_ST))[i] = 0u;
        const bf16* vtb = VGT + ((size_t)(b * 4 + hh) * 256 + slab * 64) * NKEY;
        const int cb = wave & 3, vh = wave >> 2;
        const int ocol = hh * 256 + slab * 64 + 32 * vh + 4 * g;
        struct GsRegs { u32x4 qg[2], ket[2], v; u32x2 oi[2]; float dec; };
        GsRegs R0, R1; R0.dec = 0.f; R1.dec = 0.f;
#define GS_LOAD(R, n) do { int _row0, _tok0; gla_chunk_rows(b, dir, (n), _row0, _tok0); const size_t _u = (size_t)(upb + (n)); \
        _Pragma("unroll") for (int j = 0; j < 2; ++j) { const int idx = tid + 512 * j; R.qg[j] = *(const u32x4*)(QG + _u * 8192 + idx * 8); R.ket[j] = *(const u32x4*)(KET + _u * 8192 + idx * 8); } \
        R.v = *(const u32x4*)(vtb + (size_t)(tid >> 3) * NKEY + _tok0 + (tid & 7) * 8); \
        if (tid < 128) R.dec = FACD[_u * 128 + tid]; \
        _Pragma("unroll") for (int v2 = 0; v2 < 2; ++v2) R.oi[v2] = *(const u32x2*)(OUT + (size_t)(_row0 + 16 * cb + fr) * D + ocol + 16 * v2); } while (0)
#define GS_STORE(R, bf) do { LAS unsigned char* _p = lds + (bf) * GS_BUF; \
        _Pragma("unroll") for (int j = 0; j < 2; ++j) { const int idx = tid + 512 * j; *(LAS u32x4*)(_p + GS_QG + (idx >> 4) * 272 + (idx & 15) * 16) = R.qg[j]; *(LAS u32x4*)(_p + GS_KET + (idx >> 3) * 144 + (idx & 7) * 16) = R.ket[j]; } \
        *(LAS u32x4*)(_p + GS_VT + (tid >> 3) * 144 + (tid & 7) * 16) = R.v; \
        if (tid < 128) ((LAS float*)(lds + GS_DEC))[(bf) * 128 + tid] = R.dec; } while (0)
#define GS_ITER(n, RN, RF) do { const int _n = (n); int row0, tok0; gla_chunk_rows(b, dir, _n, row0, tok0); const int cur = _n & 1; \
            if (_n + 2 < 36) GS_LOAD(RF, _n + 2); \
            const LAS unsigned char* bufp = lds + cur * GS_BUF; const LAS unsigned char* stp = lds + GS_ST + cur * 17408; \
            { bf16x8 qfr[4]; \
              _Pragma("unroll") for (int ks = 0; ks < 4; ++ks) qfr[ks] = *(const LAS bf16x8*)(bufp + GS_QG + (16 * cb + fr) * 272 + (8 * g + 32 * ks) * 2); \
              _Pragma("unroll") for (int v2 = 0; v2 < 2; ++v2) { const int vb = 2 * vh + v2; const u32x2 oin = v2 ? oc1 : oc0; \
                  f32x4 Oa = (f32x4){bflo(oin.x), bfhi(oin.x), bflo(oin.y), bfhi(oin.y)}; \
                  _Pragma("unroll") for (int ks = 0; ks < 4; ++ks) { const bf16x8 af = *(const LAS bf16x8*)(stp + (16 * vb + fr) * 272 + (8 * g + 32 * ks) * 2); \
                      Oa = __builtin_amdgcn_mfma_f32_16x16x32_bf16(af, qfr[ks], Oa, 0, 0, 0); } \
                  u32x2 w; w.x = pk2(Oa[0], Oa[1]); w.y = pk2(Oa[2], Oa[3]); \
                  *(u32x2*)(OUT + (size_t)(row0 + 16 * cb + fr) * D + ocol + 16 * v2) = w; } } \
            { const f32x4 dec = *(const LAS f32x4*)((LAS float*)(lds + GS_DEC) + cur * 128 + 16 * wave + 4 * g); \
              LAS unsigned char* stn = lds + GS_ST + (cur ^ 1) * 17408; \
              _Pragma("unroll") for (int vb = 0; vb < 4; ++vb) { Sacc[vb] = Sacc[vb] * dec; \
                  _Pragma("unroll") for (int t = 0; t < 2; ++t) { const bf16x8 af = *(const LAS bf16x8*)(bufp + GS_KET + (16 * wave + fr) * 144 + (8 * g + 32 * t) * 2); \
                      const bf16x8 bfr = *(const LAS bf16x8*)(bufp + GS_VT + (16 * vb + fr) * 144 + (8 * g + 32 * t) * 2); \
                      Sacc[vb] = __builtin_amdgcn_mfma_f32_16x16x32_bf16(af, bfr, Sacc[vb], 0, 0, 0); } \
                  u32x2 w; w.x = pk2(Sacc[vb][0], Sacc[vb][1]); w.y = pk2(Sacc[vb][2], Sacc[vb][3]); \
                  *(LAS u32x2*)(stn + (16 * vb + fr) * 272 + (16 * wave + 4 * g) * 2) = w; } } \
            if (_n + 1 < 36) { GS_STORE(RN, cur ^ 1); oc0 = RN.oi[0]; oc1 = RN.oi[1]; } \
            __syncthreads(); } while (0)
        GS_LOAD(R0, 0); GS_STORE(R0, 0);
        u32x2 oc0 = R0.oi[0], oc1 = R0.oi[1];
        GS_LOAD(R0, 1);
        __syncthreads();
        for (int n = 0; n < 36; n += 2) { GS_ITER(n, R0, R1); GS_ITER(n + 1, R1, R0); }
#undef GS_ITER
#undef GS_LOAD
#undef GS_STORE
    }
}

constexpr int N_PHASES = 34;
typedef const Args __attribute__((address_space(4)))* KArgs;
__device__ __forceinline__ KArgs kargs() { KArgs p = (KArgs)__builtin_amdgcn_kernarg_segment_ptr(); asm volatile("" : "+s"(p)); return p; }
__global__ void __launch_bounds__(512, 2) fwd(Args a_unused) {
    extern __shared__ __attribute__((aligned(16))) unsigned char lds_raw[];
    LAS unsigned char* lds = (LAS unsigned char*)lds_raw;
    const int tid0 = threadIdx.x;
    const int G0 = gridDim.x; const int bx0 = blockIdx.x;
#define PH_ENTRY int tid = tid0; asm volatile("" : "+v"(tid)); int G = G0, bx = bx0; asm volatile("" : "+s"(G), "+s"(bx)); const int lane = tid & 63, wave = __builtin_amdgcn_readfirstlane(tid >> 6); \
        const int vcu = (G % 8 == 0) ? (bx % 8) * (G / 8) + bx / 8 : bx; (void)lane; (void)wave; (void)vcu
    const int tid = tid0;
    const int ph_lo = kargs()->ph_lo, ph_hi = kargs()->ph_hi;
    const int repmask = kargs()->rep;
    if (tid < 64) ((LAS unsigned*)(lds + LX_MISC))[tid] = 0u;
    for (int i = tid; i < 1024; i += 512) { const int pos = i >> 4, f = i & 15; const float inv = __builtin_amdgcn_exp2f(-(float)f * (13.287712379549449f / 16.0f)); const float ang = (float)pos * inv;
        ((LAS float*)(lds + LX_ROPE))[2 * i] = __cosf(ang); ((LAS float*)(lds + LX_ROPE))[2 * i + 1] = __sinf(ang); }
    __syncthreads();
    const bool single = (ph_hi - ph_lo) > 1;
    XcdBarrier bar; bar.bar = (unsigned*)(kargs()->ws + WS_CTL) + CW_BAR; bar.x = 0; bar.st = (volatile LAS unsigned*)(lds + LX_MISC);
    if (single) bar = xcd_barrier_post((unsigned*)(kargs()->ws + WS_CTL) + CW_BAR, (volatile LAS unsigned*)(lds + LX_MISC));
#define IN(k) (ph_lo <= (k) && (k) < ph_hi)
#define REPLOOP(t) for (int rep_ = 0, nrep_ = 1 + ((repmask >> (t)) & 1); rep_ < nrep_; ++rep_, (rep_ < nrep_ ? (bar.bar = (unsigned*)(kargs()->ws + WS_CTL) + CW_BAR, xcd_barrier(bar)) : (void)0))
#define SEAM(k) do { if (IN(k) && IN((k) + 1)) { bar.bar = (unsigned*)(kargs()->ws + WS_CTL) + CW_BAR; xcd_barrier(bar); if ((repmask >> 10) & 1) xcd_barrier(bar); } } while (0)
    LAS int* tab = (LAS int*)(lds + LX_MOETAB);

    if (IN(0)) REPLOOP(0) { PH_ENTRY; p0_prologue(kargs(), lds, tid, lane, wave, vcu, G); } SEAM(0);
    if (IN(1)) { PH_ENTRY; KArgs A = kargs(); unsigned char* ws = A->ws; phase_norm1(A->out, (float*)(ws + WS_CTX), A->norm_g, (float*)(ws + WS_MODV), (bf16*)(ws + WS_H), TALL, lane, wave, vcu, G); } SEAM(1);

#pragma nounroll
    for (int L = 0; L < 4; ++L) {
        const int pb = 2 + 8 * L; const bool isattn = !(L & 1); const int j = L >> 1; const bool lastL = (L == 3);
        const int nrows = lastL ? TX : TALL;
        if (IN(pb)) REPLOOP(isattn ? 1 : 3) {
            PH_ENTRY; KArgs A = kargs(); unsigned char* ws = A->ws; unsigned char* big = ws + WS_BIG; const bf16* H = (const bf16*)(ws + WS_H);
            if (isattn) {
                pg8::DenseOrder S; S.init(H, (const bf16*)(ws + WS_WATTIN) + (size_t)j * NATT * D, TALL, NATT, D, G, bx);
                pg8::EpiAttnIn E{(bf16*)(big + BG_QKV), (bf16*)(big + BG_VAT), (bf16*)(big + BG_VBT), (const LAS float*)(lds + LX_ROPE)};
                pg8::gemm_phase<pg8::EpiAttnIn, pg8::DenseOrder, false>(lds, tid, D, S, E);
            } else {
                pg8::DenseOrder S; S.init(H, (const bf16*)(ws + WS_WGLAIN) + (size_t)j * NGLA * D, TALL, NGLA, D, G, bx);
                pg8::EpiGlaIn E{(bf16*)(big + BG_QKV2), (bf16*)(big + BG_VGT)};
                pg8::gemm_phase<pg8::EpiGlaIn, pg8::DenseOrder, false>(lds, tid, D, S, E);
            }
        }
        SEAM(pb);
        if (!isattn && IN(pb + 1)) {
            for (int rep_ = 0; rep_ <= ((repmask >> 13) & 1); ++rep_)
            { PH_ENTRY; KArgs A = kargs(); unsigned char* ws = A->ws;
              phase_gla_prep((const bf16*)(ws + WS_BIG + BG_QKV2), (const bf16*)(ws + WS_BIG + BG_VGT), A->gla_w_gate + j * 2 * 16 * 512, A->gla_b_gate + j * 2 * 512,
                             (bf16*)(ws + WS_QG), (bf16*)(ws + WS_KET), (float*)(ws + WS_BIG + BG_FAC), (bf16*)(ws + WS_BIG + BG_OF), (bf16*)(ws + WS_BIG + BG_OB), lds, tid, lane, wave, vcu, G); }
            if (single) { bar.bar = (unsigned*)(kargs()->ws + WS_CTL) + CW_BAR; xcd_barrier(bar); }
        }
        if (IN(pb + 1)) REPLOOP(isattn ? 2 : 4) {
            PH_ENTRY; KArgs A = kargs(); unsigned char* ws = A->ws; unsigned char* big = ws + WS_BIG; bf16* AOUT = (bf16*)(ws + WS_AOUT);
            if (isattn) phase_attention((const bf16*)(big + BG_QKV), (const bf16*)(big + BG_VAT), (const bf16*)(big + BG_VBT), AOUT, A->att_lambda + j * 256, (L == 0) ? 0.2f : 0.470713018f,
                                        A->att_subln_g + j * 128, A->na_bias + j * 8 * 465, lds, tid, lane, wave, vcu, G, repmask);
            else phase_gla((const bf16*)(big + BG_VGT), (bf16*)(big + BG_OF), (bf16*)(big + BG_OB), (const bf16*)(ws + WS_QG), (const bf16*)(ws + WS_KET), (const float*)(big + BG_FAC),
                           lds, tid, lane, wave, vcu, G);
        }
        SEAM(pb + 1);
        if (!isattn) {
            if (IN(pb + 2)) REPLOOP(5) { PH_ENTRY; KArgs A = kargs(); unsigned char* ws = A->ws; unsigned char* big = ws + WS_BIG;
                phase_readout((const bf16*)(big + BG_OF), (const bf16*)(big + BG_OB), (const bf16*)(big + BG_QKV2), A->gla_norm_g + j * 256, (bf16*)(ws + WS_AOUT), nrows, lane, wave, vcu, G); }
            SEAM(pb + 2);
        }
        if (IN(pb + 3)) {
            PH_ENTRY; KArgs A = kargs(); unsigned char* ws = A->ws;
            pg8::DenseOrder S; S.init((const bf16*)(ws + WS_AOUT), (const bf16*)(ws + (isattn ? WS_WATTOUT : WS_WGLAOUT)) + (size_t)j * D * D, nrows, D, D, G, bx);
            pg8::EpiResid E{A->out, (float*)(ws + WS_CTX), (const float*)(ws + WS_MODV) + (size_t)L * 9 * 6144 + 2048};
            pg8::gemm_phase<pg8::EpiResid, pg8::DenseOrder, false>(lds, tid, D, S, E);
        }
        SEAM(pb + 3);
        if (IN(pb + 4)) { PH_ENTRY; KArgs A = kargs(); unsigned char* ws = A->ws;
            phase_router(A->out, (float*)(ws + WS_CTX), A->norm_g + (L * 2 + 1) * D, (const float*)(ws + WS_MODV) + (size_t)L * 9 * 6144, (bf16*)(ws + WS_H), A->router_w, A->router_bias,
                         (unsigned*)(ws + WS_CTL) + CW_CNT + L * 16 * 64, (int*)(ws + WS_LIST), (int*)(ws + WS_TOKI), (float*)(ws + WS_TOKW), nrows, lds, tid, lane, wave, vcu, G, (repmask >> 11) & 1); }
        SEAM(pb + 4);
        if (IN(pb + 5)) REPLOOP(6) {
            PH_ENTRY; KArgs A = kargs(); unsigned char* ws = A->ws;
            const int RT = build_moe_table((unsigned*)(ws + WS_CTL) + CW_CNT + L * 16 * 64, tab, tid);
            pg8::MoeOrder S; S.A = (const char*)(ws + WS_H); S.B = (const char*)(ws + WS_W13) + (size_t)L * 16 * D * D * 2; S.K = D; S.bstride = (size_t)D * D * 2; S.tab = tab; S.list = (const int*)(ws + WS_LIST); S.RT = RT; S.nwg = RT * 4; S.G = G; S.c = bx;
            pg8::EpiMoe1 E{(bf16*)(ws + WS_BIG + BG_HB)};
            pg8::gemm_phase<pg8::EpiMoe1, pg8::MoeOrder, true>(lds, tid, D, S, E);
        }
        SEAM(pb + 5);
        if (IN(pb + 6)) REPLOOP(7) {
            PH_ENTRY; KArgs A = kargs(); unsigned char* ws = A->ws;
            const int RT = build_moe_table((unsigned*)(ws + WS_CTL) + CW_CNT + L * 16 * 64, tab, tid);
            pg8::MoeOrder S; S.A = (const char*)(ws + WS_BIG + BG_HB); S.B = (const char*)(ws + WS_W2) + (size_t)L * 16 * D * DEXP * 2; S.K = DEXP; S.bstride = (size_t)D * DEXP * 2; S.tab = tab; S.list = (const int*)(ws + WS_LIST); S.RT = RT; S.nwg = RT * 4; S.G = G; S.c = bx;
            pg8::EpiBf16 E{(bf16*)(ws + WS_BIG + BG_YB), D};
            pg8::gemm_phase<pg8::EpiBf16, pg8::MoeOrder, false>(lds, tid, DEXP, S, E);
        }
        SEAM(pb + 6);
        if (IN(pb + 7)) { PH_ENTRY; KArgs A = kargs(); unsigned char* ws = A->ws; const float* MODV = (const float*)(ws + WS_MODV);
            phase_combine(A->out, (float*)(ws + WS_CTX), MODV + (size_t)L * 9 * 6144, (const bf16*)(ws + WS_BIG + BG_YB), (unsigned*)(ws + WS_CTL) + CW_CNT + L * 16 * 64, (const int*)(ws + WS_TOKI), (const float*)(ws + WS_TOKW),
                          lastL, lastL ? A->final_g : A->norm_g + ((L + 1) * 2) * D, MODV + (size_t)(lastL ? L : L + 1) * 9 * 6144, (bf16*)(ws + WS_H), nrows, lane, wave, vcu, G, (repmask >> 12) & 1); }
        if (!lastL) SEAM(pb + 7);
    }
#undef IN
#undef REPLOOP
#undef SEAM
#undef PH_ENTRY
}

extern "C" void kernel_launch(void* const* d_in, const int* in_sizes, int n_in, void* d_out, int out_size, void* d_ws, size_t ws_size, hipStream_t stream) {
    static int ready = 0;
    if (ready == 0) {
        if (n_in != 23 || out_size != TX * D || ws_size < WS_END) { fprintf(stderr, "kernel_launch: unexpected shapes (n_in %d out %d ws %zu)\n", n_in, out_size, ws_size); ready = -1; return; }
        if (hipFuncSetAttribute((const void*)fwd, hipFuncAttributeMaxDynamicSharedMemorySize, LDS_BYTES) != hipSuccess) { fprintf(stderr, "kernel_launch: hipFuncSetAttribute failed\n"); ready = -1; return; }
        int per_cu = 0; (void)hipOccupancyMaxActiveBlocksPerMultiprocessor(&per_cu, (const void*)fwd, 512, LDS_BYTES); (void)hipGetLastError();
        if (per_cu < 1) fprintf(stderr, "kernel_launch: occupancy query reports %d blocks per CU\n", per_cu);
        ready = 1;
    }
    if (ready < 0) return;
    (void)hipMemsetAsync((char*)d_ws + WS_CTL, 0, CTL_ZERO_BYTES, stream);
    Args a{};
    const float** ap = (const float**)&a;
    for (int i = 0; i < 23; ++i) ap[i] = (const float*)d_in[i];
    a.out = (float*)d_out; a.ws = (unsigned char*)d_ws;
    const int grid = 256;
#if MK_MULTI
    for (int k = 0; k < N_PHASES; ++k) { a.ph_lo = k; a.ph_hi = k + 1; hipLaunchKernelGGL(fwd, dim3(grid), dim3(512), LDS_BYTES, stream, a); }
#else
    a.ph_lo = 0; a.ph_hi = N_PHASES; a.rep = MK_REPMASK;
    hipLaunchKernelGGL(fwd, dim3(grid), dim3(512), LDS_BYTES, stream, a);
#endif
}
```

```cpp
#include <hip/hip_runtime.h>
#include <cstdio>
#include <cstdint>

#ifndef MK_BUBBLES
#define MK_BUBBLES 0
#endif
#ifndef MK_REPMASK
#define MK_REPMASK 0
#endif

#define GAS __attribute__((address_space(1)))
#define LAS __attribute__((address_space(3)))
typedef unsigned short bf16;
typedef short bf16x8 __attribute__((ext_vector_type(8)));
typedef short bf16x4 __attribute__((ext_vector_type(4)));
typedef float f32x4 __attribute__((ext_vector_type(4)));
typedef float f32x2 __attribute__((ext_vector_type(2)));
typedef unsigned u32x4 __attribute__((ext_vector_type(4)));
typedef unsigned u32x2 __attribute__((ext_vector_type(2)));

constexpr int D = 1024, NB = 8, SEQ = 2048, CTXL = 256;
constexpr int TX = NB * SEQ, TC = NB * CTXL, TALL = TX + TC;
constexpr int NKEY = SEQ + CTXL;
constexpr int NATT = 3072, NGLA = 3328;
constexpr float EPSF = 1e-6f;
constexpr float LOG2E = 1.4426950408889634f;
constexpr int NEXP = 16, DEXP = 512;
constexpr int RT_MAX = 160;

constexpr size_t MiB = 1u << 20;
constexpr size_t WS_CTL = 0, CTL_ZERO_BYTES = 1 * MiB;
constexpr size_t WS_MODV = 1 * MiB;
constexpr size_t WS_TOKI = 2 * MiB;
constexpr size_t WS_TOKW = 2 * MiB + 512 * 1024;
constexpr size_t WS_LIST = 3 * MiB;
constexpr size_t WS_CTX = 5 * MiB;
constexpr size_t WS_WATTIN = 13 * MiB;
constexpr size_t WS_WATTOUT = 25 * MiB;
constexpr size_t WS_WGLAIN = 29 * MiB;
constexpr size_t WS_WGLAOUT = 42 * MiB;
constexpr size_t WS_W13 = 46 * MiB;
constexpr size_t WS_W2 = 174 * MiB;
constexpr size_t WS_H = 238 * MiB;
constexpr size_t WS_AOUT = 274 * MiB;
constexpr size_t WS_BIG = 310 * MiB;
constexpr size_t WS_END = 539 * MiB;
constexpr size_t BG_QKV = 0;
constexpr size_t BG_VAT = 108 * MiB;
constexpr size_t BG_VBT = 126 * MiB;
constexpr size_t BG_QKV2 = 0;
constexpr size_t BG_VGT = 117 * MiB;
constexpr size_t BG_OF = 153 * MiB;
constexpr size_t BG_OB = 189 * MiB;
constexpr size_t BG_FAC = 225 * MiB;
constexpr size_t WS_QG = WS_H, WS_KET = WS_AOUT;
constexpr size_t BG_HB = 0;
constexpr size_t BG_YB = 40 * MiB;
constexpr int CW_TMO = 0;
constexpr int CW_BAR = 4096;
constexpr int CW_CNT = 8192;

constexpr int RING_BYTES = 131072;
constexpr int LX_OFF = RING_BYTES;
constexpr int LX_MISC = LX_OFF;
constexpr int LX_MOETAB = LX_OFF + 256;
constexpr int LX_ROPE = LX_OFF + 2048;
constexpr int LX_BIAS = LX_OFF + 2048 + 8192;
constexpr int LDS_BYTES = 147456;

#define LDS_WAIT() asm volatile("s_waitcnt lgkmcnt(0)" ::: "memory")
#define VM_WAIT() asm volatile("s_waitcnt vmcnt(0)" ::: "memory")
#define RLX_AGENT __ATOMIC_RELAXED, __HIP_MEMORY_SCOPE_AGENT
__device__ __forceinline__ unsigned f2bf(float f) { unsigned u = __builtin_bit_cast(unsigned, f); return (u + 0x7fffu + ((u >> 16) & 1u)) >> 16; }
typedef __bf16 hwbf16x2 __attribute__((ext_vector_type(2)));
__device__ __forceinline__ unsigned cvtpk(float lo, float hi) { const f32x2 v = {lo, hi}; const hwbf16x2 b = __builtin_convertvector(v, hwbf16x2); return __builtin_bit_cast(unsigned, b); }
__device__ __forceinline__ unsigned pk2(float lo, float hi) { return cvtpk(lo, hi); }
__device__ __forceinline__ float bf2f(unsigned short b) { return __builtin_bit_cast(float, ((unsigned)b) << 16); }
__device__ __forceinline__ float bflo(unsigned w) { return __builtin_bit_cast(float, w << 16); }
__device__ __forceinline__ float bfhi(unsigned w) { return __builtin_bit_cast(float, w & 0xffff0000u); }
template <int CTRL> __device__ __forceinline__ float dppf(float v) { return __builtin_bit_cast(float, __builtin_amdgcn_update_dpp(0, __builtin_bit_cast(int, v), CTRL, 0xf, 0xf, true)); }
__device__ __forceinline__ float row_sum(float v) { v += dppf<0xB1>(v); v += dppf<0x4E>(v); v += dppf<0x124>(v); v += dppf<0x128>(v); return v; }
__device__ __forceinline__ float swap16_add(float a, float b) { auto r = __builtin_amdgcn_permlane16_swap(__float_as_uint(a), __float_as_uint(b), false, false); const unsigned r0 = r[0], r1 = r[1]; return __uint_as_float(r0) + __uint_as_float(r1); }
__device__ __forceinline__ float swap32_add(float a, float b) { auto r = __builtin_amdgcn_permlane32_swap(__float_as_uint(a), __float_as_uint(b), false, false); const unsigned r0 = r[0], r1 = r[1]; return __uint_as_float(r0) + __uint_as_float(r1); }
__device__ __forceinline__ float swap16_max(float a) { auto r = __builtin_amdgcn_permlane16_swap(__float_as_uint(a), __float_as_uint(a), false, false); const unsigned r0 = r[0], r1 = r[1]; return fmaxf(__uint_as_float(r0), __uint_as_float(r1)); }
__device__ __forceinline__ float swap32_max(float a) { auto r = __builtin_amdgcn_permlane32_swap(__float_as_uint(a), __float_as_uint(a), false, false); const unsigned r0 = r[0], r1 = r[1]; return fmaxf(__uint_as_float(r0), __uint_as_float(r1)); }
__device__ __forceinline__ float readlane_f(float v, int l) { return __int_as_float(__builtin_amdgcn_readlane(__float_as_int(v), l)); }
__device__ __forceinline__ float wave_sum(float v) { v = row_sum(v); v = swap16_add(v, v); return swap32_add(v, v); }
__device__ __forceinline__ float fexp2(float x) { return __builtin_amdgcn_exp2f(x); }
__device__ __forceinline__ float fexp(float x) { return __builtin_amdgcn_exp2f(x * LOG2E); }
__device__ __forceinline__ float flog(float x) { return __builtin_amdgcn_logf(x) * 0.6931471805599453f; }
__device__ __forceinline__ float frcp(float x) { return __builtin_amdgcn_rcpf(x); }
__device__ __forceinline__ float silu_f(float x) { return x * frcp(1.0f + fexp(-x)); }

#define XB_TMO      128
#define XB_XCNT(j)  (256  + 64 * (j))
#define XB_XSUB(j)  (1280 + 64 * (j))
#define XB_XGEN(j)  (2304 + 64 * (j))
#define XB_TOP      3328
#define XB_TOPGEN   3392
#define XCD_BAR_WORDS 3456
#define XB_SPIN_CAP (1u << 18)
__device__ __forceinline__ unsigned xb_ld(unsigned* p)              { return __hip_atomic_load(p, __ATOMIC_RELAXED, __HIP_MEMORY_SCOPE_AGENT); }
__device__ __forceinline__ unsigned xb_add(unsigned* p, unsigned v) { return __hip_atomic_fetch_add(p, v, __ATOMIC_RELAXED, __HIP_MEMORY_SCOPE_AGENT); }
__device__ __forceinline__ unsigned xb_xcc_id() { return (unsigned)__builtin_amdgcn_s_getreg((3 << 11) | 20) & 0xFu; }
#define XB_SPIN(cond, bar) do { unsigned _sp = 0; while (cond) { __builtin_amdgcn_s_sleep(1); \
    if ((++_sp & 255u) == 0u) { if (xb_ld(&(bar)[XB_TMO])) break; if (_sp > XB_SPIN_CAP) { atomicAdd(&(bar)[XB_TMO], 1u); break; } } } } while (0)
struct XcdBarrier { unsigned* bar; unsigned x; volatile LAS unsigned* st; };
__device__ __forceinline__ XcdBarrier xcd_barrier_post(unsigned* bar, volatile LAS unsigned* st) {
    XcdBarrier b; b.bar = bar; b.x = xb_xcc_id(); b.st = st;
    if (threadIdx.x == 0) (void)xb_add(&bar[XB_XCNT(b.x)], 1u);
    return b;
}
__device__ __forceinline__ void xcd_barrier_complete(unsigned* bar, unsigned x, unsigned& nloc, unsigned& nx) {
    const unsigned G = gridDim.x * gridDim.y * gridDim.z;
    unsigned sum, cnt, mine, sp = 0u;
    for (;;) {
        sum = 0u; cnt = 0u; mine = 0u;
#pragma unroll
        for (unsigned j = 0; j < 16; ++j) { const unsigned c = xb_ld(&bar[XB_XCNT(j)]); sum += c; cnt += (c > 0u) ? 1u : 0u; mine = (j == x) ? c : mine; }
        if (sum == G) break;
        __builtin_amdgcn_s_sleep(1);
        if ((++sp & 255u) == 0u) { if (xb_ld(&bar[XB_TMO])) break; if (sp > XB_SPIN_CAP) { atomicAdd(&bar[XB_TMO], 1u); break; } }
    }
    nloc = mine > 0u ? mine : 1u; nx = cnt > 0u ? cnt : 1u;
}
__device__ __forceinline__ void xcd_barrier(const XcdBarrier& b) {
    asm volatile("s_waitcnt vmcnt(0)" ::: "memory");
    __syncthreads();
    if (threadIdx.x == 0) {
        unsigned* bar = b.bar;
        __builtin_amdgcn_s_waitcnt(0);
        unsigned nloc = b.st[0], nx = b.st[1];
        if (nloc == 0u) { xcd_barrier_complete(bar, b.x, nloc, nx); b.st[0] = nloc; b.st[1] = nx; }
        const unsigned old = xb_add(&bar[XB_XSUB(b.x)], 1u);
        const unsigned gen = old / nloc;
        if (old + 1u == (gen + 1u) * nloc) {
            __builtin_amdgcn_fence(__ATOMIC_RELEASE, "agent");
            asm volatile("s_waitcnt vmcnt(0)" ::: "memory");
            const unsigned og = xb_add(&bar[XB_TOP], 1u);
            const unsigned tg = og / nx;
            if (og + 1u == (tg + 1u) * nx) xb_add(&bar[XB_TOPGEN], 1u);
            else XB_SPIN(xb_ld(&bar[XB_TOPGEN]) == tg, bar);
            __builtin_amdgcn_fence(__ATOMIC_ACQUIRE, "agent");
            xb_add(&bar[XB_XGEN(b.x)], 1u);
            asm volatile("s_waitcnt vmcnt(0)" ::: "memory");
        } else {
            XB_SPIN(xb_ld(&bar[XB_XGEN(b.x)]) == gen, bar);
            __builtin_amdgcn_fence(__ATOMIC_ACQUIRE, "agent");
            asm volatile("s_waitcnt vmcnt(0)" ::: "memory");
        }
    }
    __syncthreads();
}

namespace pg8 {
constexpr int BM = 256, BK = 64, HALF = 128, HTB = HALF * BK * 2, STAGE_BYTES = 8 * HTB, NXCD = 8, WGM = 8;
__host__ __device__ __forceinline__ int lds_byte(int r, int c) { const int st = (r >> 4) * 2 + (c >> 5), rr = r & 15, cc = c & 31, ob = rr * 64 + cc * 2; return st * 1024 + (ob ^ (((ob >> 9) & 1) << 5)); }
__host__ __device__ __forceinline__ void stage_rc(int b, int& R, int& C) { const int st = b / 1024, sb = b % 1024, swz = sb ^ (((sb >> 9) & 1) << 5); R = (st >> 1) * 16 + swz / 64; C = (st & 1) * 32 + (swz % 64) / 2; }
__host__ __device__ __forceinline__ int perm32(int rho) { const int n = rho >> 4, i = rho & 15; return 8 * (i >> 2) + 4 * n + (i & 3); }

struct Unit { int pm, pn, e, mt; };

__device__ __forceinline__ int xcd_remap(int wgid, int nwg) { const int q = nwg / NXCD, r = nwg % NXCD, xcd = wgid % NXCD, off = wgid / NXCD; return (xcd < r ? xcd * (q + 1) : r * (q + 1) + (xcd - r) * q) + off; }

struct DenseOrder {
    const char* A; const char* B; int K; int nM, nN, nwg, G, c;
    __device__ __forceinline__ void init(const bf16* A_, const bf16* B_, int M, int N, int K_, int G_, int c_) { A = (const char*)A_; B = (const char*)B_; K = K_; nM = M / BM; nN = N / BM; nwg = nM * nN; G = G_; c = c_; }
    __device__ __forceinline__ bool next(int i, Unit& u) const {
        const long L = (long)i * G + c; if (L >= nwg) return false;
        const int wgid = xcd_remap((int)L, nwg);
        const int nig = WGM * nN, gid = wgid / nig, fm = gid * WGM, gsz = (nM - fm) < WGM ? (nM - fm) : WGM;
        u.pm = fm + ((wgid % nig) % gsz); u.pn = (wgid % nig) / gsz; u.e = 0; u.mt = 0; return true;
    }
    __device__ __forceinline__ const char* a_ptr(const Unit& u) const { return A + (size_t)u.pm * BM * K * 2; }
    __device__ __forceinline__ const char* b_ptr(const Unit& u) const { return B + (size_t)u.pn * BM * K * 2; }
    __device__ __forceinline__ int tok(const Unit&, int) const { return 0; }
};
struct MoeOrder {
    const char* A; const char* B; int K; size_t bstride;
    const LAS int* tab; const int* list; int RT, nwg, G, c;
    __device__ __forceinline__ bool next(int i, Unit& u) const {
        const long L = (long)i * G + c; if (L >= nwg) return false;
        const int wgid = xcd_remap((int)L, nwg);
        const int rt = wgid >> 2; u.pm = rt; u.pn = wgid & 3; const int t = tab[rt]; u.e = t & 255; u.mt = t >> 8; return true;
    }
    __device__ __forceinline__ const char* a_ptr(const Unit& u) const { return A + (size_t)u.pm * BM * K * 2; }
    __device__ __forceinline__ const char* b_ptr(const Unit& u) const { return B + (size_t)u.e * bstride + (size_t)u.pn * BM * K * 2; }
    __device__ __forceinline__ int tok(const Unit& u, int r) const { const int cnt = tab[RT_MAX + 1 + u.e]; const int pos = u.mt * BM + r; return pos < cnt ? list[(size_t)u.e * TALL + pos] : 0; }
};

__device__ __forceinline__ unsigned cvt_pk_bf16(float lo, float hi) { unsigned r; asm volatile("v_cvt_pk_bf16_f32 %0, %1, %2" : "=v"(r) : "v"(lo), "v"(hi)); return r; }

template <class Epi, class Sched, bool GATHER>
__device__ __forceinline__ void gemm_phase(LAS unsigned char* lds, const int tid, const int K, const Sched& S, const Epi& E) {
    const int wid = __builtin_amdgcn_readfirstlane(tid >> 6), lane = tid & 63, wr = wid >> 2, wc = wid & 3, fr = lane & 15, fq = lane >> 4;
    const int nt = K / BK;
    unsigned voffA[2], voffB[2]; int RA[2], CA[2];
#pragma unroll
    for (int i = 0; i < 2; ++i) { int R, C; stage_rc(tid * 16 + i * 8192, R, C); const int Rb = Epi::PERM ? ((R & ~31) + perm32(R & 31)) : R;
        RA[i] = R; CA[i] = C; voffA[i] = (unsigned)(R * K + C) * 2u; voffB[i] = (unsigned)(Rb * K + C) * 2u; }
    const size_t kstep = (size_t)(BK * 2);
    const size_t hstep = (size_t)HALF * K * 2;
    const unsigned ldsw = (unsigned)wid * 1024u;
    const int aoff = lds_byte(wr * 64 + fr, fq * 8), boff = lds_byte(wc * 32 + fr, fq * 8);
#define PG8_SA(b, h) (((b) * 2 + (h)) * HTB)
#define PG8_SB(b, h) ((4 + (b) * 2 + (h)) * HTB)
#define PG8_STAGE(bufoff, gbase, voff) do { _Pragma("unroll") for (int _i = 0; _i < 2; ++_i) \
        __builtin_amdgcn_global_load_lds((const unsigned*)((const char*)(gbase) + (voff)[_i]), (LAS unsigned*)(lds + (bufoff) + ldsw + _i * 8192), 16, 0, 0); } while (0)
#define PG8_STAGE_A(bufoff, h, usenext, koff) do { if constexpr (GATHER) { unsigned _vo[2]; _vo[0] = (usenext) ? nvA[h][0] : vA[h][0]; _vo[1] = (usenext) ? nvA[h][1] : vA[h][1]; PG8_STAGE(bufoff, S.A + (koff), _vo); } \
        else { PG8_STAGE(bufoff, ((usenext) ? nA : cA) + (size_t)(h) * hstep + (koff), voffA); } } while (0)
#define PG8_LDA(dst, b, h) do { _Pragma("unroll") for (int m = 0; m < 4; ++m) _Pragma("unroll") for (int k = 0; k < 2; ++k) dst[m][k] = *(const LAS bf16x8*)(lds + PG8_SA(b, h) + aoff + m * 2048 + k * 1024); } while (0)
#define PG8_LDB(dst, b, h) do { _Pragma("unroll") for (int n = 0; n < 2; ++n) _Pragma("unroll") for (int k = 0; k < 2; ++k) dst[n][k] = *(const LAS bf16x8*)(lds + PG8_SB(b, h) + boff + n * 2048 + k * 1024); } while (0)
#define PG8_MMA(ai, bj, At, Bt) do { __builtin_amdgcn_s_setprio(1); _Pragma("unroll") for (int m = 0; m < 4; ++m) _Pragma("unroll") for (int n = 0; n < 2; ++n) _Pragma("unroll") for (int k = 0; k < 2; ++k) \
        acc[ai][bj][m][n] = __builtin_amdgcn_mfma_f32_16x16x32_bf16(Bt[n][k], At[m][k], acc[ai][bj][m][n], 0, 0, 0); __builtin_amdgcn_s_setprio(0); } while (0)
#define PG8_WAIT_V(n) asm volatile("s_waitcnt vmcnt(" #n ")" ::: "memory")
#define PG8_WAIT_L(n) asm volatile("s_waitcnt lgkmcnt(" #n ")" ::: "memory")
#define PG8_BAR __builtin_amdgcn_s_barrier()
#define PG8_SCHED __builtin_amdgcn_sched_barrier(0)
    Unit cur, nxt; int ui = 0;
    if (!S.next(0, cur)) return;
    f32x4 acc[2][2][4][2];
#pragma unroll
    for (int a = 0; a < 2; ++a)
#pragma unroll
        for (int b = 0; b < 2; ++b)
#pragma unroll
            for (int m = 0; m < 4; ++m)
#pragma unroll
                for (int n = 0; n < 2; ++n) acc[a][b][m][n] = (f32x4){0.f, 0.f, 0.f, 0.f};
    bf16x8 At[4][2], B0[2][2], B1[2][2];
    unsigned vA[2][2], nvA[2][2];
    if constexpr (GATHER) {
#pragma unroll
        for (int h = 0; h < 2; ++h)
#pragma unroll
            for (int i = 0; i < 2; ++i) { vA[h][i] = (unsigned)(S.tok(cur, h * HALF + RA[i]) * K + CA[i]) * 2u; nvA[h][i] = vA[h][i]; }
    }
    const char* cA = S.a_ptr(cur); const char* cB = S.b_ptr(cur); const char* nA = cA;
    PG8_STAGE(PG8_SB(0, 0), cB, voffB); PG8_STAGE(PG8_SB(0, 1), cB + hstep, voffB); PG8_STAGE_A(PG8_SA(0, 0), 0, false, 0); PG8_STAGE_A(PG8_SA(0, 1), 1, false, 0);
    if (wr == 1) PG8_BAR;
    PG8_WAIT_V(2); PG8_BAR;
    PG8_STAGE(PG8_SB(1, 0), cB + kstep, voffB); PG8_STAGE_A(PG8_SA(1, 0), 0, false, kstep); PG8_STAGE(PG8_SB(1, 1), cB + hstep + kstep, voffB);
    PG8_WAIT_V(6); PG8_BAR;
    for (;;) {
        const bool has_next = S.next(ui + 1, nxt);
        nA = has_next ? S.a_ptr(nxt) : cA; const char* nB = has_next ? S.b_ptr(nxt) : cB;
        if constexpr (GATHER) {
            if (has_next) {
#pragma unroll
                for (int h = 0; h < 2; ++h)
#pragma unroll
                    for (int i = 0; i < 2; ++i) nvA[h][i] = (unsigned)(S.tok(nxt, h * HALF + RA[i]) * K + CA[i]) * 2u;
            }
        }
        for (int t = 0; t < nt; t += 2) {
            const bool last = (t == nt - 2);
            const size_t k1 = (size_t)(t + 1) * kstep;
            const size_t k2 = last ? 0 : (size_t)(t + 2) * kstep, k3 = k2 + kstep;
            const char* b2 = last ? nB : cB + (size_t)(t + 2) * kstep; const char* b3 = b2 + kstep;
            PG8_LDB(B0, 0, 0); PG8_LDB(B1, 0, 1); PG8_SCHED; PG8_LDA(At, 0, 0); PG8_STAGE_A(PG8_SA(1, 1), 1, false, k1);
            PG8_WAIT_V(8); PG8_WAIT_L(0); PG8_BAR; PG8_MMA(0, 0, At, B0); PG8_MMA(0, 1, At, B1); PG8_BAR; PG8_SCHED;
            PG8_LDA(At, 0, 1); PG8_STAGE(PG8_SB(0, 0), b2, voffB); PG8_STAGE(PG8_SB(0, 1), b2 + hstep, voffB); PG8_STAGE_A(PG8_SA(0, 0), 0, last, k2);
            PG8_WAIT_V(8); PG8_WAIT_L(0); PG8_BAR; PG8_MMA(1, 0, At, B0); PG8_MMA(1, 1, At, B1); PG8_BAR; PG8_SCHED;
            PG8_LDB(B0, 1, 0); PG8_LDB(B1, 1, 1); PG8_SCHED; PG8_LDA(At, 1, 0); PG8_STAGE_A(PG8_SA(0, 1), 1, last, k2);
            PG8_WAIT_V(8); PG8_WAIT_L(0); PG8_BAR; PG8_MMA(0, 0, At, B0); PG8_MMA(0, 1, At, B1); PG8_BAR; PG8_SCHED;
            PG8_LDA(At, 1, 1); PG8_STAGE(PG8_SB(1, 0), b3, voffB); PG8_STAGE(PG8_SB(1, 1), b3 + hstep, voffB); PG8_STAGE_A(PG8_SA(1, 0), 0, last, k3);
            PG8_WAIT_V(8); PG8_WAIT_L(0); PG8_BAR; PG8_MMA(1, 0, At, B0); PG8_MMA(1, 1, At, B1); PG8_BAR; PG8_SCHED;
        }
        if (wr == 0) PG8_BAR;
        E(acc, cur, wr, wc, fr, fq);
        if (!has_next) break;
#pragma unroll
        for (int a = 0; a < 2; ++a)
#pragma unroll
            for (int b = 0; b < 2; ++b)
#pragma unroll
                for (int m = 0; m < 4; ++m)
#pragma unroll
                    for (int n = 0; n < 2; ++n) acc[a][b][m][n] = (f32x4){0.f, 0.f, 0.f, 0.f};
        cur = nxt; cA = nA; cB = nB; ++ui;
        if constexpr (GATHER) {
#pragma unroll
            for (int h = 0; h < 2; ++h)
#pragma unroll
                for (int i = 0; i < 2; ++i) vA[h][i] = nvA[h][i];
        }
        if (wr == 1) PG8_BAR;
    }
    PG8_WAIT_V(0);
    PG8_BAR;
#undef PG8_SA
#undef PG8_SB
#undef PG8_STAGE
#undef PG8_STAGE_A
#undef PG8_LDA
#undef PG8_LDB
#undef PG8_MMA
#undef PG8_WAIT_V
#undef PG8_WAIT_L
#undef PG8_BAR
#undef PG8_SCHED
}
}

namespace pg8 {
__device__ __forceinline__ void row_bt(int row, int& b, int& tok) { if (row < TX) { b = row >> 11; tok = row & 2047; } else { const int r = row - TX; b = r >> 8; tok = SEQ + (r & 255); } }

struct EpiAttnIn {
    static constexpr bool PERM = true;
    bf16* QKV; bf16* VAT; bf16* VBT; const LAS float* rope;
    __device__ __forceinline__ void operator()(const f32x4 (&acc)[2][2][4][2], const Unit& u, int wr, int wc, int fr, int fq) const {
        const int row0 = u.pm * BM + wr * 64 + fr; const int seg = u.pn >> 1;
        const bool latent = u.pm < (TX / BM);
        if (seg == 2 || seg == 5) {
#pragma unroll
            for (int ai = 0; ai < 2; ++ai)
#pragma unroll
                for (int m = 0; m < 4; ++m) { const int row = row0 + ai * HALF + m * 16; int b, tok; row_bt(row, b, tok);
#pragma unroll
                    for (int bj = 0; bj < 2; ++bj) { const int col = u.pn * BM + bj * HALF + wc * 32 + 8 * fq;
                        bf16* dst;
                        if (seg == 2) { const int cs = col - 1024; dst = VAT + ((size_t)(b * 4 + (cs >> 7)) * 128 + (cs & 127)) * NKEY + tok; }
                        else { const int cs = col - 2560; dst = VBT + ((size_t)(b * 8 + (cs >> 6)) * 64 + (cs & 63)) * NKEY + tok; }
#pragma unroll
                        for (int n = 0; n < 2; ++n)
#pragma unroll
                            for (int i = 0; i < 4; ++i) dst[(size_t)(4 * n + i) * NKEY] = (bf16)f2bf(acc[ai][bj][m][n][i]); } }
            return;
        }
        const bool dorope = latent && seg < 2;
        const float qs = (seg == 0 || seg == 3) ? 0.125f * LOG2E : 1.0f;
#pragma unroll
        for (int ai = 0; ai < 2; ++ai)
#pragma unroll
            for (int m = 0; m < 4; ++m) { const int row = row0 + ai * HALF + m * 16;
                f32x4 cs4[4];
                if (dorope) { const int t = row & 2047; const int pos = (wc & 1) ? (t & 63) : (t >> 6);
                    const LAS f32x4* rp = (const LAS f32x4*)(rope + (pos * 16 + 8 * (fq & 1)) * 2);
#pragma unroll
                    for (int j = 0; j < 4; ++j) cs4[j] = rp[j]; }
#pragma unroll
                for (int bj = 0; bj < 2; ++bj) { const int col = u.pn * BM + bj * HALF + wc * 32 + 8 * fq;
                    float v[8];
#pragma unroll
                    for (int n = 0; n < 2; ++n)
#pragma unroll
                        for (int i = 0; i < 4; ++i) v[4 * n + i] = acc[ai][bj][m][n][i];
                    if (dorope) {
#pragma unroll
                        for (int j = 0; j < 8; ++j) { const float other = __shfl_xor(v[j], 32); const float c = cs4[j >> 1][(j & 1) * 2], s = cs4[j >> 1][(j & 1) * 2 + 1];
                            v[j] = (fq < 2) ? (v[j] * c - other * s) : (v[j] * c + other * s); } }
                    u32x4 w; w.x = pk2(v[0] * qs, v[1] * qs); w.y = pk2(v[2] * qs, v[3] * qs); w.z = pk2(v[4] * qs, v[5] * qs); w.w = pk2(v[6] * qs, v[7] * qs);
                    *(u32x4*)(QKV + (size_t)row * NATT + col) = w; } }
    }
};
struct EpiGlaIn {
    static constexpr bool PERM = true;
    bf16* QKV2; bf16* VGT;
    __device__ __forceinline__ void operator()(const f32x4 (&acc)[2][2][4][2], const Unit& u, int wr, int wc, int fr, int fq) const {
        const int row0 = u.pm * BM + wr * 64 + fr;
        if (u.pn >= 4 && u.pn < 8) {
#pragma unroll
            for (int ai = 0; ai < 2; ++ai)
#pragma unroll
                for (int m = 0; m < 4; ++m) { const int row = row0 + ai * HALF + m * 16; int b, tok; row_bt(row, b, tok);
#pragma unroll
                    for (int bj = 0; bj < 2; ++bj) { const int cs = u.pn * BM + bj * HALF + wc * 32 + 8 * fq - 1024;
                        bf16* dst = VGT + ((size_t)(b * 4 + (cs >> 8)) * 256 + (cs & 255)) * NKEY + tok;
#pragma unroll
                        for (int n = 0; n < 2; ++n)
#pragma unroll
                            for (int i = 0; i < 4; ++i) dst[(size_t)(4 * n + i) * NKEY] = (bf16)f2bf(acc[ai][bj][m][n][i]); } }
            return;
        }
        const float qs = (u.pn < 2) ? 0.08838834764831845f : 1.0f;
#pragma unroll
        for (int ai = 0; ai < 2; ++ai)
#pragma unroll
            for (int m = 0; m < 4; ++m) { const int row = row0 + ai * HALF + m * 16;
#pragma unroll
                for (int bj = 0; bj < 2; ++bj) { const int col = u.pn * BM + bj * HALF + wc * 32 + 8 * fq; const f32x4 a = acc[ai][bj][m][0] * qs, c = acc[ai][bj][m][1] * qs;
                    u32x4 w; w.x = pk2(a[0], a[1]); w.y = pk2(a[2], a[3]); w.z = pk2(c[0], c[1]); w.w = pk2(c[2], c[3]);
                    *(u32x4*)(QKV2 + (size_t)row * NGLA + col) = w; } }
    }
};
struct EpiResid {
    static constexpr bool PERM = false;
    const float* IL; const float* IC; float* XL; float* XC; const float* modv;
    __device__ __forceinline__ void operator()(const f32x4 (&acc)[2][2][4][2], const Unit& u, int wr, int wc, int fr, int fq) const {
        const int row0 = u.pm * BM + wr * 64 + fr, col0 = u.pn * BM + wc * 32 + 4 * fq;
        const bool latent = u.pm < (TX / BM); const int bi = latent ? (u.pm >> 3) : 8;
        float* base = latent ? XL : (XC - (size_t)TX * D); const float* ibase = latent ? IL : (IC - (size_t)TX * D);
        f32x4 gv[2][2];
#pragma unroll
        for (int bj = 0; bj < 2; ++bj)
#pragma unroll
            for (int n = 0; n < 2; ++n) gv[bj][n] = *(const f32x4*)(modv + bi * 6144 + col0 + bj * HALF + n * 16);
#pragma unroll
        for (int ai = 0; ai < 2; ++ai)
#pragma unroll
            for (int m = 0; m < 4; ++m) { const size_t ro = (size_t)(row0 + ai * HALF + m * 16) * D + col0;
#pragma unroll
                for (int bj = 0; bj < 2; ++bj)
#pragma unroll
                    for (int n = 0; n < 2; ++n) { const size_t o = ro + bj * HALF + n * 16; *(f32x4*)(base + o) = *(const f32x4*)(ibase + o) + gv[bj][n] * acc[ai][bj][m][n]; } }
    }
};
struct EpiMoe1 {
    static constexpr bool PERM = false;
    bf16* HB;
    __device__ __forceinline__ void operator()(const f32x4 (&acc)[2][2][4][2], const Unit& u, int wr, int wc, int fr, int fq) const {
        const int row0 = u.pm * BM + wr * 64 + fr, col0 = u.pn * 128 + wc * 16 + 4 * fq;
#pragma unroll
        for (int ai = 0; ai < 2; ++ai)
#pragma unroll
            for (int m = 0; m < 4; ++m) { bf16* rowp = HB + (size_t)(row0 + ai * HALF + m * 16) * DEXP + col0;
#pragma unroll
                for (int bj = 0; bj < 2; ++bj) { const f32x4 a = acc[ai][bj][m][0], b = acc[ai][bj][m][1];
                    u32x2 w; w.x = pk2(silu_f(a[0]) * b[0], silu_f(a[1]) * b[1]); w.y = pk2(silu_f(a[2]) * b[2], silu_f(a[3]) * b[3]);
                    *(u32x2*)(rowp + bj * 64) = w; } }
    }
};
struct EpiBf16 {
    static constexpr bool PERM = true;
    bf16* O; int ldc;
    __device__ __forceinline__ void operator()(const f32x4 (&acc)[2][2][4][2], const Unit& u, int wr, int wc, int fr, int fq) const {
        const int row0 = u.pm * BM + wr * 64 + fr, col0 = u.pn * BM + wc * 32 + 8 * fq;
#pragma unroll
        for (int ai = 0; ai < 2; ++ai)
#pragma unroll
            for (int m = 0; m < 4; ++m) { bf16* rowp = O + (size_t)(row0 + ai * HALF + m * 16) * ldc + col0;
#pragma unroll
                for (int bj = 0; bj < 2; ++bj) { const f32x4 a = acc[ai][bj][m][0], c = acc[ai][bj][m][1];
                    u32x4 w; w.x = pk2(a[0], a[1]); w.y = pk2(a[2], a[3]); w.z = pk2(c[0], c[1]); w.w = pk2(c[2], c[3]);
                    *(u32x4*)(rowp + bj * HALF) = w; } }
    }
};
}

struct Args {
    const float *x, *c, *ctx, *c_ctx, *w_mod, *b_mod, *norm_g, *final_g, *att_w_in, *att_w_out, *att_lambda, *att_subln_g, *na_bias,
                *gla_w_in, *gla_w_gate, *gla_b_gate, *gla_norm_g, *gla_w_out, *router_w, *router_bias, *moe_w1, *moe_w3, *moe_w2;
    float* out; unsigned char* ws; int ph_lo, ph_hi, rep, pad;
};

struct RowMapId { int off; __device__ __forceinline__ int operator()(int n) const { return off + n; } };
struct RowMapMoe { int which; __device__ __forceinline__ int operator()(int n) const { return 32 * (n >> 4) + 16 * which + (n & 15); } };
template <class RM>
__device__ __forceinline__ void p0_transpose_item(const float* W, int K, int N, bf16* WT, LAS float* scr, int item, int lane, RM rm) {
    const int nblk = N / 32, kb = item / nblk, nb = item % nblk, k0 = 64 * kb, n0 = 32 * nb;
    float ld[32];
#pragma unroll
    for (int i = 0; i < 32; ++i) ld[i] = W[(size_t)(k0 + 2 * i + (lane >> 5)) * N + n0 + (lane & 31)];
#pragma unroll
    for (int i = 0; i < 32; ++i) scr[(2 * i + (lane >> 5)) * 33 + (lane & 31)] = ld[i];
    LDS_WAIT(); asm volatile("" ::: "memory");
    const int c = lane & 7;
#pragma unroll
    for (int j = 0; j < 4; ++j) { const int n = (lane >> 3) + 8 * j; const LAS float* s = scr + (8 * c) * 33 + n;
        u32x4 o; o.x = pk2(s[0 * 33], s[1 * 33]); o.y = pk2(s[2 * 33], s[3 * 33]); o.z = pk2(s[4 * 33], s[5 * 33]); o.w = pk2(s[6 * 33], s[7 * 33]);
        *(u32x4*)(WT + (size_t)rm(n0 + n) * K + k0 + 8 * c) = o; }
    LDS_WAIT(); asm volatile("" ::: "memory");
}

constexpr int CV_ATTIN = 1536, CV_ATTOUT = 512, CV_GLAIN = 1552, CV_GLAPAD = 28, CV_GLAOUT = 512, CV_W = 4096, CV_MOE = 3 * CV_W;
constexpr int CT_ATTN0 = CV_ATTIN + CV_ATTOUT, CT_MOE0 = CT_ATTN0 + CV_MOE, CT_GLA0 = CT_MOE0 + CV_GLAIN + CV_GLAPAD + CV_GLAOUT, CT_MOE1 = CT_GLA0 + CV_MOE,
              CT_ATTN1 = CT_MOE1 + CV_ATTIN + CV_ATTOUT, CT_MOE2 = CT_ATTN1 + CV_MOE, CT_GLA1 = CT_MOE2 + CV_GLAIN + CV_GLAPAD + CV_GLAOUT, CT_MOE3 = CT_GLA1 + CV_MOE, CV_TOTAL = CT_MOE3;
constexpr int CW_CONV_NEXT = 12288 + 64, CW_CONV_DONE = 12288 + 128, CW_BLKDONE = 12288 + 256;
constexpr int CV_CH = 8;
struct ConvPtrs { const float *att_w_in, *att_w_out, *gla_w_in, *gla_w_out, *moe_w1, *moe_w3, *moe_w2; unsigned char* ws; };
struct RowMapAny { int moe, which; __device__ __forceinline__ int operator()(int n) const { return moe ? 32 * (n >> 4) + 16 * which + (n & 15) : n; } };
__device__ __forceinline__ void conv_item(const ConvPtrs& P, int it, LAS float* scr, int lane) {
    int seg, r;
    if (it < CT_ATTN0) { seg = 0; r = it; } else if (it < CT_MOE0) { seg = 1; r = it - CT_ATTN0; } else if (it < CT_GLA0) { seg = 2; r = it - CT_MOE0; } else if (it < CT_MOE1) { seg = 3; r = it - CT_GLA0; }
    else if (it < CT_ATTN1) { seg = 4; r = it - CT_MOE1; } else if (it < CT_MOE2) { seg = 5; r = it - CT_ATTN1; } else if (it < CT_GLA1) { seg = 6; r = it - CT_MOE2; } else { seg = 7; r = it - CT_GLA1; }
    const float* W; bf16* WT; int K = D, N = D, sub = r; RowMapAny rm{0, 0};
    if (seg & 1) {
        const int L = seg >> 1, which = r / CV_W, q = r % CV_W, e = q >> 8, j = L * 16 + e; sub = q & 255;
        if (which < 2) { W = (which ? P.moe_w3 : P.moe_w1) + (size_t)j * D * DEXP; N = DEXP; WT = (bf16*)(P.ws + WS_W13) + (size_t)j * D * D; rm.moe = 1; rm.which = which; }
        else { W = P.moe_w2 + (size_t)j * DEXP * D; K = DEXP; WT = (bf16*)(P.ws + WS_W2) + (size_t)j * D * DEXP; }
    } else if ((seg & 2) == 0) {
        const int j = seg >> 2;
        if (r < CV_ATTIN) { W = P.att_w_in + (size_t)j * D * NATT; N = NATT; WT = (bf16*)(P.ws + WS_WATTIN) + (size_t)j * NATT * D; }
        else { W = P.att_w_out + (size_t)j * D * D; WT = (bf16*)(P.ws + WS_WATTOUT) + (size_t)j * D * D; sub = r - CV_ATTIN; }
    } else {
        const int j = seg >> 2;
        if (r < CV_GLAIN) { W = P.gla_w_in + (size_t)j * D * 3104; N = 3104; WT = (bf16*)(P.ws + WS_WGLAIN) + (size_t)j * NGLA * D; }
        else if (r < CV_GLAIN + CV_GLAPAD) { const int c0 = (r - CV_GLAIN) * 1024;
            for (int i = lane; i < 1024; i += 64) *(u32x4*)((bf16*)(P.ws + WS_WGLAIN) + (size_t)j * NGLA * D + (size_t)3104 * D + (size_t)(c0 + i) * 8) = (u32x4){0u, 0u, 0u, 0u};
            return; }
        else { W = P.gla_w_out + (size_t)j * D * D; WT = (bf16*)(P.ws + WS_WGLAOUT) + (size_t)j * D * D; sub = r - CV_GLAIN - CV_GLAPAD; }
    }
    p0_transpose_item(W, K, N, WT, scr, sub, lane, rm);
}
__device__ __forceinline__ void conv_until(const ConvPtrs& P, unsigned* ctl, int need, LAS unsigned char* lds, int tid, int lane, int wave, int vcu, int G) {
    LAS float* scr = (LAS float*)(lds + wave * 8448);
    int cur = (int)__hip_atomic_load(ctl + CW_CONV_NEXT, RLX_AGENT); cur = __builtin_amdgcn_readfirstlane(cur); if (cur > CV_TOTAL) cur = CV_TOTAL;
    for (int it = cur + vcu * 8 + wave; it < need; it += G * 8) conv_item(P, it, scr, lane);
    __syncthreads();
    if (vcu == 0 && tid == 0 && cur < need) { __hip_atomic_store(ctl + CW_CONV_NEXT, (unsigned)need, RLX_AGENT); __hip_atomic_store(ctl + CW_CONV_DONE, (unsigned)need, RLX_AGENT); }
}
__device__ __forceinline__ void conv_bubble(const ConvPtrs& P, unsigned* ctl, int pid, int G, LAS unsigned char* lds, int tid, int lane, int wave) {
    __syncthreads();
    if (tid == 0) __hip_atomic_fetch_add(ctl + CW_BLKDONE + 64 * pid, 1u, RLX_AGENT);
    LAS float* scr = (LAS float*)(lds + wave * 8448);
    for (;;) {
        int go = 0; if (lane == 0) go = ((int)__hip_atomic_load(ctl + CW_BLKDONE + 64 * pid, RLX_AGENT) < G) && ((int)__hip_atomic_load(ctl + CW_CONV_NEXT, RLX_AGENT) < CV_TOTAL);
        if (!__builtin_amdgcn_readfirstlane(go)) break;
        int i0 = 0; if (lane == 0) i0 = (int)__hip_atomic_fetch_add(ctl + CW_CONV_NEXT, (unsigned)CV_CH, RLX_AGENT);
        i0 = __builtin_amdgcn_readfirstlane(i0);
        if (i0 >= CV_TOTAL) break;
        const int n = (CV_TOTAL - i0) < CV_CH ? (CV_TOTAL - i0) : CV_CH;
        for (int k = 0; k < n; ++k) conv_item(P, i0 + k, scr, lane);
        VM_WAIT();
        if (lane == 0) __hip_atomic_fetch_add(ctl + CW_CONV_DONE, (unsigned)n, RLX_AGENT);
    }
}

template <class AP> __device__ __forceinline__ void p0_prologue(const AP ap, LAS unsigned char* lds, int tid, int lane, int wave, int vcu, int G) {
    unsigned char* ws = ap->ws;
    LAS float* S9 = (LAS float*)(lds + 69632);
    LAS float* red = (LAS float*)(lds + 106496);
    { const ConvPtrs P{ap->att_w_in, ap->att_w_out, ap->gla_w_in, ap->gla_w_out, ap->moe_w1, ap->moe_w3, ap->moe_w2, ws};
      conv_until(P, (unsigned*)(ws + WS_CTL), CV_TOTAL, lds, tid, lane, wave, vcu, G); }
    __syncthreads();
    { const float* cc = ap->c; const float* cx = ap->c_ctx;
      for (int i = tid; i < 9 * 1024; i += 512) { const int bi = i >> 10, k = i & 1023; const float v = (bi < 8) ? cc[bi * D + k] : cx[k]; S9[i] = v / (1.0f + __expf(-v)); } }
    __syncthreads();
    const float* w_mod = ap->w_mod; const float* b_mod = ap->b_mod;
    for (int u = vcu; u < 4 * 96; u += G) {
        const int L = u / 96, n0 = (u % 96) * 64;
        const float* W = w_mod + (size_t)L * D * 6144 + n0 + lane;
        float acc[9];
#pragma unroll
        for (int bi = 0; bi < 9; ++bi) acc[bi] = 0.f;
        const int kb = wave * 128;
#pragma unroll 8
        for (int k = 0; k < 128; ++k) { const float w = W[(size_t)(kb + k) * 6144];
#pragma unroll
            for (int bi = 0; bi < 9; ++bi) acc[bi] += S9[bi * 1024 + kb + k] * w; }
#pragma unroll
        for (int bi = 0; bi < 9; ++bi) red[(wave * 9 + bi) * 64 + lane] = acc[bi];
        __syncthreads();
        for (int i = tid; i < 9 * 64; i += 512) { const int bi = i >> 6, l = i & 63; float sm = b_mod[L * 6144 + n0 + l];
#pragma unroll
            for (int w = 0; w < 8; ++w) sm += red[(w * 9 + bi) * 64 + l];
            ((float*)(ws + WS_MODV))[(size_t)(L * 9 + bi) * 6144 + n0 + l] = sm; }
        __syncthreads();
    }
}

__device__ __forceinline__ float* xrow_ptr(float* XL, float* XC, int row) { return row < TX ? XL + (size_t)row * D : XC + (size_t)(row - TX) * D; }
__device__ __forceinline__ int row_bi(int row) { return row < TX ? (row >> 11) : 8; }

__device__ __forceinline__ void norm_mod_store(const f32x4 (&v)[4], const float* g, const float* sh, const float* sc, bf16* orow, int lane) {
    float ss = 0.f;
#pragma unroll
    for (int j = 0; j < 4; ++j) ss += (v[j].x * v[j].x + v[j].y * v[j].y) + (v[j].z * v[j].z + v[j].w * v[j].w);
    const float rs = __builtin_amdgcn_rsqf(wave_sum(ss) * (1.0f / D) + EPSF);
#pragma unroll
    for (int j = 0; j < 4; ++j) { const int c = 4 * lane + 256 * j; const f32x4 gg = *(const f32x4*)(g + c), s1 = *(const f32x4*)(sc + c), s0 = *(const f32x4*)(sh + c);
        const f32x4 y = (v[j] * rs) * gg * (1.0f + s1) + s0;
        u32x2 w; w.x = pk2(y.x, y.y); w.y = pk2(y.z, y.w); *(u32x2*)(orow + c) = w; }
}

__device__ __forceinline__ void phase_norm1(const float* XL, const float* XC, const float* g, const float* modv, bf16* H, int nrows, int lane, int wave, int vcu, int G) {
    for (int row = vcu * 8 + wave; row < nrows; row += G * 8) {
        const f32x4* xr = (const f32x4*)(row < TX ? XL + (size_t)row * D : XC + (size_t)(row - TX) * D) + lane; f32x4 v[4];
#pragma unroll
        for (int j = 0; j < 4; ++j) v[j] = xr[64 * j];
        const float* mv = modv + row_bi(row) * 6144;
        norm_mod_store(v, g, mv, mv + 1024, H + (size_t)row * D, lane);
    }
}

__device__ __forceinline__ void phase_router(float* XL, float* XC, const float* g, const float* modv, bf16* H, const float* router_w, const float* router_bias,
                                             unsigned* cnt  , int* list, int* toki, float* tokw, int nrows,
                                             LAS unsigned char* lds, int tid, int lane, int wave, int vcu, int G, int probe) {
    LAS float* RW = (LAS float*)lds;
    LAS int* lcnt = (LAS int*)(lds + 65536);
    LAS int* rinfo = (LAS int*)(lds + 65536 + 256);
    for (int it = 0; it < 8; ++it) { const int idx = tid + 512 * it, k = idx >> 2, q = idx & 3; const f32x4 w = *(const f32x4*)(router_w + k * 16 + 4 * q);
        RW[(4 * q + 0) * 1024 + k] = w.x; RW[(4 * q + 1) * 1024 + k] = w.y; RW[(4 * q + 2) * 1024 + k] = w.z; RW[(4 * q + 3) * 1024 + k] = w.w; }
    if (tid < 32) lcnt[tid] = 0;
    __syncthreads();
    const int rpb = nrows / G, rpw = rpb / 8;
    const int gI = lane >> 4;
    const f32x4 rb = *(const f32x4*)(router_bias + 4 * gI);
    for (int rep = (probe ? 0 : 1); rep < 2; ++rep)
    for (int i0 = 0; i0 < rpw; i0 += 3) {
        asm volatile("" ::: "memory");
        f32x4 y[3][4];
#pragma unroll
        for (int r = 0; r < 3; ++r) {
            const int ii = (i0 + r < rpw) ? i0 + r : rpw - 1; const int row = vcu * rpb + wave * rpw + ii;
            const f32x4* xr = (const f32x4*)xrow_ptr(XL, XC, row) + lane; f32x4 v[4];
#pragma unroll
            for (int j = 0; j < 4; ++j) v[j] = xr[64 * j];
            const float* mv = modv + row_bi(row) * 6144 + 3072;
            float ss = 0.f;
#pragma unroll
            for (int j = 0; j < 4; ++j) ss += (v[j].x * v[j].x + v[j].y * v[j].y) + (v[j].z * v[j].z + v[j].w * v[j].w);
            const float rs = __builtin_amdgcn_rsqf(wave_sum(ss) * (1.0f / D) + EPSF);
#pragma unroll
            for (int j = 0; j < 4; ++j) { const int c = 4 * lane + 256 * j; const f32x4 gg = *(const f32x4*)(g + c), s1 = *(const f32x4*)(mv + 1024 + c), s0 = *(const f32x4*)(mv + c);
                y[r][j] = (v[j] * rs) * gg * (1.0f + s1) + s0;
                u32x2 w; w.x = cvtpk(y[r][j].x, y[r][j].y); w.y = cvtpk(y[r][j].z, y[r][j].w); *(u32x2*)(H + (size_t)row * D + c) = w; }
            __builtin_amdgcn_sched_barrier(0);
        }
        float p[3][16];
#pragma unroll
        for (int e = 0; e < 16; ++e) {
#pragma unroll
            for (int r = 0; r < 3; ++r) p[r][e] = 0.f;
#pragma unroll
            for (int j = 0; j < 4; ++j) { const f32x4 w = *(const LAS f32x4*)(RW + e * 1024 + 4 * lane + 256 * j);
#pragma unroll
                for (int r = 0; r < 3; ++r) p[r][e] += (y[r][j].x * w.x + y[r][j].y * w.y) + (y[r][j].z * w.z + y[r][j].w * w.w); }
#pragma unroll
            for (int r = 0; r < 3; ++r) asm volatile("" : "+v"(p[r][e])); }
#pragma unroll
        for (int r = 0; r < 3; ++r) {
            float q8[8], lg[4];
#pragma unroll
            for (int j = 0; j < 8; ++j) q8[j] = swap32_add(p[r][j], p[r][j + 8]);
#pragma unroll
            for (int j = 0; j < 4; ++j) lg[j] = row_sum(swap16_add(q8[j], q8[j + 4]));
            float sc[4], sel[4];
#pragma unroll
            for (int j = 0; j < 4; ++j) { sc[j] = 1.0f / (1.0f + __expf(-lg[j])); sel[j] = sc[j] + rb[j]; }
            int i1 = 0, i2 = 0; float m1 = -1e30f, m2 = -1e30f, w1 = 0.f, w2 = 0.f;
#pragma unroll
            for (int j = 0; j < 4; ++j) { const float t = sel[j];
                if (t > m1) { m2 = m1; i2 = i1; w2 = w1; m1 = t; i1 = j; w1 = sc[j]; } else if (t > m2) { m2 = t; i2 = j; w2 = sc[j]; } }
            const float gs = m1 + m2;
            const float g0 = readlane_f(gs, 0), g1 = readlane_f(gs, 16), g2 = readlane_f(gs, 32), g3 = readlane_f(gs, 48);
            int bg = 0; float bgs = g0; if (g1 > bgs) { bgs = g1; bg = 1; } if (g2 > bgs) { bgs = g2; bg = 2; } if (g3 > bgs) { bgs = g3; bg = 3; }
            bg = __builtin_amdgcn_readfirstlane(bg);
            const int e0 = 4 * bg + __builtin_amdgcn_readlane(i1, 16 * bg), e1 = 4 * bg + __builtin_amdgcn_readlane(i2, 16 * bg);
            const float w0 = readlane_f(w1, 16 * bg), w1s = readlane_f(w2, 16 * bg);
            const float wn = 1.0f / (w0 + w1s);
            if (lane == 0 && rep == 1 && i0 + r < rpw) { const int rl = wave * rpw + i0 + r;
                const int p0 = __hip_atomic_fetch_add(&lcnt[e0], 1, __ATOMIC_RELAXED, __HIP_MEMORY_SCOPE_WORKGROUP), p1 = __hip_atomic_fetch_add(&lcnt[e1], 1, __ATOMIC_RELAXED, __HIP_MEMORY_SCOPE_WORKGROUP);
                rinfo[rl * 6 + 0] = e0; rinfo[rl * 6 + 1] = p0; rinfo[rl * 6 + 2] = e1; rinfo[rl * 6 + 3] = p1;
                rinfo[rl * 6 + 4] = __builtin_bit_cast(int, w0 * wn); rinfo[rl * 6 + 5] = __builtin_bit_cast(int, w1s * wn); }
        }
    }
    __syncthreads();
    if (tid < 16) lcnt[16 + tid] = (int)__hip_atomic_fetch_add(cnt + 64 * tid, (unsigned)lcnt[tid], RLX_AGENT);
    __syncthreads();
    if (tid < rpb) { const int row = vcu * rpb + tid; const int e0 = rinfo[tid * 6 + 0], e1 = rinfo[tid * 6 + 2];
        const int p0 = lcnt[16 + e0] + rinfo[tid * 6 + 1], p1 = lcnt[16 + e1] + rinfo[tid * 6 + 3];
        list[(size_t)e0 * TALL + p0] = row; list[(size_t)e1 * TALL + p1] = row;
        toki[row * 4 + 0] = e0; toki[row * 4 + 1] = p0; toki[row * 4 + 2] = e1; toki[row * 4 + 3] = p1;
        tokw[row * 2 + 0] = __builtin_bit_cast(float, rinfo[tid * 6 + 4]); tokw[row * 2 + 1] = __builtin_bit_cast(float, rinfo[tid * 6 + 5]); }
    __syncthreads();
}

__device__ __forceinline__ int build_moe_table(const unsigned* cnt, LAS int* tab, int tid) {
    if (tid == 0) { int rt = 0;
        for (int e = 0; e < 16; ++e) { const int c = (int)__hip_atomic_load(cnt + 64 * e, RLX_AGENT); tab[RT_MAX + 1 + e] = c; const int nt = (c + 255) >> 8;
            for (int m = 0; m < nt; ++m) { if (rt < RT_MAX) tab[rt] = e | (m << 8); ++rt; } }
        tab[RT_MAX] = rt < RT_MAX ? rt : RT_MAX; }
    __syncthreads();
    return tab[RT_MAX];
}

__device__ __forceinline__ void phase_combine(float* XL, float* XC, const float* modv  , const bf16* YB, const unsigned* cnt, const int* toki, const float* tokw,
                                              bool final_layer, const float* gnext, const float* modv_next, bf16* H, int nrows, int lane, int wave, int vcu, int G, int probe) {
    int tiles = 0; if (lane < 16) tiles = ((int)__hip_atomic_load(cnt + 64 * lane, RLX_AGENT) + 255) >> 8;
    int incl = tiles;
#pragma unroll
    for (int o = 1; o < 16; o <<= 1) { const int t = __shfl_up(incl, o); if (lane >= o) incl += t; }
    const int mybase = (incl - tiles) * 256;
    for (int rep = (probe ? 0 : 1); rep < 2; ++rep)
    for (int row = vcu * 8 + wave; row < nrows; row += G * 8) {
        const int e0 = toki[row * 4 + 0], p0 = toki[row * 4 + 1], e1 = toki[row * 4 + 2], p1 = toki[row * 4 + 3];
        const float w0 = tokw[row * 2 + 0], w1 = tokw[row * 2 + 1];
        const int s0 = __shfl(mybase, e0) + p0, s1 = __shfl(mybase, e1) + p1;
        float* xp = xrow_ptr(XL, XC, row);
        const float* g2 = modv + row_bi(row) * 6144 + 5120;
        f32x4 v[4];
#pragma unroll
        for (int j = 0; j < 4; ++j) { const int c = 4 * lane + 256 * j;
            const u32x2 a = *(const u32x2*)(YB + (size_t)s0 * D + c), b = *(const u32x2*)(YB + (size_t)s1 * D + c);
            f32x4 y; y.x = w0 * bflo(a.x) + w1 * bflo(b.x); y.y = w0 * bfhi(a.x) + w1 * bfhi(b.x); y.z = w0 * bflo(a.y) + w1 * bflo(b.y); y.w = w0 * bfhi(a.y) + w1 * bfhi(b.y);
            v[j] = *(const f32x4*)(xp + c) + *(const f32x4*)(g2 + c) * y; }
        if (final_layer) {
            float ss = 0.f;
#pragma unroll
            for (int j = 0; j < 4; ++j) ss += (v[j].x * v[j].x + v[j].y * v[j].y) + (v[j].z * v[j].z + v[j].w * v[j].w);
            const float rs = __builtin_amdgcn_rsqf(wave_sum(ss) * (1.0f / D) + EPSF);
#pragma unroll
            for (int j = 0; j < 4; ++j) { const int c = 4 * lane + 256 * j; if (rep == 1) *(f32x4*)(xp + c) = (v[j] * rs) * *(const f32x4*)(gnext + c); }
        } else {
            if (rep == 1) {
#pragma unroll
            for (int j = 0; j < 4; ++j) *(f32x4*)(xp + 4 * lane + 256 * j) = v[j]; }
            const float* mv = modv_next + row_bi(row) * 6144;
            norm_mod_store(v, gnext, mv, mv + 1024, H + (size_t)row * D, lane);
        }
    }
}

__device__ __forceinline__ void phase_readout(const bf16* OF, const bf16* OB, const bf16* QKV2, const float* ng, bf16* AOUT, int nrows, int lane, int wave, int vcu, int G) {
    const f32x4 gg = *(const f32x4*)(ng + 4 * lane);
    for (int row = vcu * 8 + wave; row < nrows; row += G * 8) {
#pragma unroll
        for (int j = 0; j < 4; ++j) { const int c = 4 * lane + 256 * j;
            const u32x2 a = *(const u32x2*)(OF + (size_t)row * D + c), b = *(const u32x2*)(OB + (size_t)row * D + c), gt = *(const u32x2*)(QKV2 + (size_t)row * NGLA + 2048 + c);
            f32x4 o; o.x = bflo(a.x) + bflo(b.x); o.y = bfhi(a.x) + bfhi(b.x); o.z = bflo(a.y) + bflo(b.y); o.w = bfhi(a.y) + bfhi(b.y);
            const float ss = wave_sum((o.x * o.x + o.y * o.y) + (o.z * o.z + o.w * o.w));
            const float rs = __builtin_amdgcn_rsqf(ss * (1.0f / 256.0f) + EPSF);
            f32x4 gv; gv.x = silu_f(bflo(gt.x)); gv.y = silu_f(bfhi(gt.x)); gv.z = silu_f(bflo(gt.y)); gv.w = silu_f(bfhi(gt.y));
            const f32x4 y = (o * rs) * gg * gv;
            u32x2 w; w.x = pk2(y.x, y.y); w.y = pk2(y.z, y.w); *(u32x2*)(AOUT + (size_t)row * D + c) = w; }
    }
}

__device__ __forceinline__ int na_r0(int r) { int v = r - 4; return v < 0 ? 0 : (v > 24 ? 24 : v); }
template <int NMAPS, int DV, bool NA>
__device__ __forceinline__ void attn_unit(LAS unsigned char* lds, int tid, int lane, int wave,
                                          const bf16* QKV, int qcol, int qrow0, int kcol, int krow_lat, int krow_ctx, const bf16* VT, int klo, int khi,
                                          int r_wave, int xq0, const LAS float* biasT,
                                          bf16* AOUT, int ocol, float lam, const float* subg, float outscale) {
    constexpr int KB = 9216;
    constexpr int BUFSZ = NMAPS * KB + DV * 144;
    constexpr int NVB = DV / 16, NVR = DV / 64;
    const int fr = lane & 15, g = lane >> 4;
    bf16x8 qf[NMAPS][2];
    { const bf16* qp = QKV + (size_t)(qrow0 + wave * 16 + fr) * NATT + qcol + 8 * g;
#pragma unroll
      for (int m = 0; m < NMAPS; ++m)
#pragma unroll
          for (int s = 0; s < 2; ++s) qf[m][s] = *(const bf16x8*)(qp + m * 64 + 32 * s); }
    f32x4 O[NMAPS][NVB]; float mrun[NMAPS]; f32x2 lrun[NMAPS];
#pragma unroll
    for (int m = 0; m < NMAPS; ++m) { mrun[m] = -1e30f; lrun[m] = (f32x2){0.f, 0.f};
#pragma unroll
        for (int vb = 0; vb < NVB; ++vb) O[m][vb] = (f32x4){0.f, 0.f, 0.f, 0.f}; }
    const int ntiles = 4 + (khi - klo);
    u32x4 kreg[NMAPS], vreg[NVR];
    const int lkey = tid >> 3, lch = tid & 7;
#define AT_LOAD(i) do { const int _i = (i); const int _rowg = (_i < 4 ? krow_ctx + 64 * _i : krow_lat + 64 * (klo + _i - 4)) + lkey; const int _tok0 = (_i < 4 ? SEQ + 64 * _i : 64 * (klo + _i - 4)); \
        _Pragma("unroll") for (int m = 0; m < NMAPS; ++m) kreg[m] = *(const u32x4*)(QKV + (size_t)_rowg * NATT + kcol + m * 64 + lch * 8); \
        _Pragma("unroll") for (int j = 0; j < NVR; ++j) { const int idx = tid + 512 * j; vreg[j] = *(const u32x4*)(VT + (size_t)(idx >> 3) * NKEY + _tok0 + (idx & 7) * 8); } } while (0)
#define AT_STORE(b) do { LAS unsigned char* _p = lds + (b) * BUFSZ; \
        _Pragma("unroll") for (int m = 0; m < NMAPS; ++m) *(LAS u32x4*)(_p + m * KB + lkey * 144 + lch * 16) = kreg[m]; \
        _Pragma("unroll") for (int j = 0; j < NVR; ++j) { const int idx = tid + 512 * j; *(LAS u32x4*)(_p + NMAPS * KB + (idx >> 3) * 144 + (idx & 7) * 16) = vreg[j]; } } while (0)
    AT_LOAD(0); AT_STORE(0); __syncthreads();
    const int kbase0 = (8 * (fr >> 2) + (fr & 3)) * 144 + 16 * g;
    const int vbase = fr * 144 + 16 * g;
    int r0w = 0, xq = 0, tmask = 3; float pen[4][4];
    if constexpr (NA) { r0w = na_r0(r_wave); xq = xq0 + fr; int cs = xq - 8; cs = cs < 0 ? 0 : (cs > 48 ? 48 : cs);
        int c0 = xq0 - 8; c0 = c0 < 0 ? 0 : (c0 > 48 ? 48 : c0); int c1 = xq0 + 15 - 8; c1 = (c1 < 0 ? 0 : (c1 > 48 ? 48 : c1)) + 16;
        tmask = (c0 < 32 ? 1 : 0) | (c1 > 32 ? 2 : 0);
#pragma unroll
        for (int kb = 0; kb < 4; ++kb)
#pragma unroll
            for (int ii = 0; ii < 4; ++ii) { const int y = 32 * (kb >> 1) + 8 * g + 4 * (kb & 1) + ii; pen[kb][ii] = (y >= cs && y < cs + 16) ? 0.f : -1e30f; } }
    for (int i = 0; i < ntiles; ++i) {
        if (i + 1 < ntiles) AT_LOAD(i + 1);
        const LAS unsigned char* buf = lds + (i & 1) * BUFSZ;
        bool active = true; int kr = 0; bool local = false;
        if constexpr (NA) { if (i >= 4) { local = true; kr = klo + i - 4; active = (kr >= r0w) && (kr < r0w + 8); } }
        if (active) {
            const int tm = local ? tmask : 3;
            bf16x8 kf[NMAPS][4][2];
#pragma unroll
            for (int m = 0; m < NMAPS; ++m)
#pragma unroll
                for (int kb = 0; kb < 4; ++kb)
#pragma unroll
                    for (int s = 0; s < 2; ++s) kf[m][kb][s] = *(const LAS bf16x8*)(buf + m * KB + kbase0 + (kb & 1) * (4 * 144) + (kb >> 1) * (32 * 144) + s * 64);
            __builtin_amdgcn_sched_barrier(0);
            f32x4 S[NMAPS][4];
#pragma unroll
            for (int m = 0; m < NMAPS; ++m)
#pragma unroll
                for (int kb = 0; kb < 4; ++kb) { S[m][kb] = (f32x4){0.f, 0.f, 0.f, 0.f};
                    if (!NA || (tm >> (kb >> 1)) & 1) {
#pragma unroll
                        for (int s = 0; s < 2; ++s) S[m][kb] = __builtin_amdgcn_mfma_f32_16x16x32_bf16(kf[m][kb][s], qf[m][s], S[m][kb], 0, 0, 0); } }
            bf16x8 vf0[4][2];
#pragma unroll
            for (int vb = 0; vb < 4; ++vb)
#pragma unroll
                for (int t = 0; t < 2; ++t) vf0[vb][t] = *(const LAS bf16x8*)(buf + NMAPS * KB + vbase + vb * (16 * 144) + t * 64);
            __builtin_amdgcn_sched_barrier(0);
            bf16x8 pf[NMAPS][2];
#pragma unroll
            for (int m = 0; m < NMAPS; ++m) {
                if constexpr (NA) { if (local) {
                        const LAS float* bp = biasT + (kr - r_wave + 7) * 31 + (8 * g - xq + 15);
#pragma unroll
                        for (int kb = 0; kb < 4; ++kb)
#pragma unroll
                            for (int ii = 0; ii < 4; ++ii) { const float t = (tm >> (kb >> 1)) & 1 ? (S[m][kb][ii] + pen[kb][ii]) + bp[32 * (kb >> 1) + 4 * (kb & 1) + ii] : -1e30f; S[m][kb][ii] = t; } } }
                float mx = fmaxf(fmaxf(S[m][0][0], S[m][0][1]), fmaxf(S[m][0][2], S[m][0][3]));
#pragma unroll
                for (int kb = 1; kb < 4; ++kb) mx = fmaxf(fmaxf(mx, S[m][kb][0]), fmaxf(fmaxf(S[m][kb][1], S[m][kb][2]), S[m][kb][3]));
                mx = swap32_max(swap16_max(mx));
                if (__any(mx > mrun[m] + 8.0f)) {
                    const float mnew = fmaxf(mrun[m], mx), alpha = fexp2(mrun[m] - mnew); mrun[m] = mnew; lrun[m] = lrun[m] * alpha;
#pragma unroll
                    for (int vb = 0; vb < NVB; ++vb) O[m][vb] = O[m][vb] * alpha;
                }
                const float mm = mrun[m];
                unsigned pw[8]; float l0 = 0.f, l1 = 0.f;
#pragma unroll
                for (int kb = 0; kb < 4; ++kb) { const float a0 = fexp2(S[m][kb][0] - mm), a1 = fexp2(S[m][kb][1] - mm), a2 = fexp2(S[m][kb][2] - mm), a3 = fexp2(S[m][kb][3] - mm);
                    l0 += a0 + a1; l1 += a2 + a3;
                    pw[2 * kb] = cvtpk(a0, a1); pw[2 * kb + 1] = cvtpk(a2, a3); }
                lrun[m].x += l0; lrun[m].y += l1;
                pf[m][0] = __builtin_bit_cast(bf16x8, (u32x4){pw[0], pw[1], pw[2], pw[3]});
                pf[m][1] = __builtin_bit_cast(bf16x8, (u32x4){pw[4], pw[5], pw[6], pw[7]});
            }
            __builtin_amdgcn_sched_barrier(0);
            if constexpr (NVB == 8) {
                bf16x8 vf1[4][2];
#pragma unroll
                for (int vb = 0; vb < 4; ++vb)
#pragma unroll
                    for (int t = 0; t < 2; ++t) vf1[vb][t] = *(const LAS bf16x8*)(buf + NMAPS * KB + vbase + (4 + vb) * (16 * 144) + t * 64);
                __builtin_amdgcn_sched_barrier(0);
#pragma unroll
                for (int vb = 0; vb < 4; ++vb)
#pragma unroll
                    for (int t = 0; t < 2; ++t)
#pragma unroll
                        for (int m = 0; m < NMAPS; ++m) O[m][vb] = __builtin_amdgcn_mfma_f32_16x16x32_bf16(vf0[vb][t], pf[m][t], O[m][vb], 0, 0, 0);
                __builtin_amdgcn_sched_barrier(0);
#pragma unroll
                for (int vb = 0; vb < 4; ++vb)
#pragma unroll
                    for (int t = 0; t < 2; ++t)
#pragma unroll
                        for (int m = 0; m < NMAPS; ++m) O[m][4 + vb] = __builtin_amdgcn_mfma_f32_16x16x32_bf16(vf1[vb][t], pf[m][t], O[m][4 + vb], 0, 0, 0);
            } else {
#pragma unroll
                for (int vb = 0; vb < 4; ++vb)
#pragma unroll
                    for (int t = 0; t < 2; ++t) { if (!NA || (tm >> t) & 1) {
#pragma unroll
                            for (int m = 0; m < NMAPS; ++m) O[m][vb] = __builtin_amdgcn_mfma_f32_16x16x32_bf16(vf0[vb][t], pf[m][t], O[m][vb], 0, 0, 0); } }
            }
            __builtin_amdgcn_sched_barrier(0);
        }
        if (i + 1 < ntiles) AT_STORE((i + 1) & 1);
        __syncthreads();
    }
#undef AT_LOAD
#undef AT_STORE
    float inv[NMAPS];
#pragma unroll
    for (int m = 0; m < NMAPS; ++m) { float l = lrun[m].x + lrun[m].y; l = swap16_add(l, l); l = swap32_add(l, l); inv[m] = 1.0f / l; }
    const int orow = qrow0 + wave * 16 + fr;
    if constexpr (NMAPS == 2) {
        float ss = 0.f; const float i1 = inv[0], i2 = lam * inv[1];
#pragma unroll
        for (int vb = 0; vb < NVB; ++vb) { O[0][vb] = O[0][vb] * i1 - O[1][vb] * i2; const f32x4 o = O[0][vb]; ss += (o.x * o.x + o.y * o.y) + (o.z * o.z + o.w * o.w); }
        ss = swap16_add(ss, ss); ss = swap32_add(ss, ss);
        const float rs = __builtin_amdgcn_rsqf(ss * (1.0f / DV) + EPSF) * outscale;
#pragma unroll
        for (int vb = 0; vb < NVB; ++vb) { const f32x4 gg = *(const f32x4*)(subg + 16 * vb + 4 * g); const f32x4 y = O[0][vb] * rs * gg;
            u32x2 w; w.x = cvtpk(y.x, y.y); w.y = cvtpk(y.z, y.w); *(u32x2*)(AOUT + (size_t)orow * D + ocol + 16 * vb + 4 * g) = w; }
    } else {
#pragma unroll
        for (int vb = 0; vb < NVB; ++vb) { const f32x4 y = O[0][vb] * inv[0];
            u32x2 w; w.x = cvtpk(y.x, y.y); w.y = cvtpk(y.z, y.w); *(u32x2*)(AOUT + (size_t)orow * D + ocol + 16 * vb + 4 * g) = w; }
    }
}


__device__ __forceinline__ void phase_attention(const bf16* QKV, const bf16* VAT, const bf16* VBT, bf16* AOUT, const float* lamp  , float lam_init, const float* subg, const float* nab  ,
                                                LAS unsigned char* lds, int tid, int lane, int wave, int vcu, int G, int repmask) {
    float part = lamp[lane] * lamp[64 + lane]; float part2 = lamp[128 + lane] * lamp[192 + lane];
    const float lam = __expf(wave_sum(part)) - __expf(wave_sum(part2)) + lam_init;
    for (int rep = 0; rep <= ((repmask >> 8) & 1); ++rep)
    for (int u = vcu; u < 576; u += G) {
        int bh, qrow0, khi;
        if (u < 512) { bh = u >> 4; const int qt = u & 15; qrow0 = (bh >> 2) * SEQ + qt * 128; khi = 32; }
        else { const int q = u - 512; bh = q >> 1; const int qt = q & 1; qrow0 = TX + (bh >> 2) * CTXL + qt * 128; khi = 0; }
        const int b = bh >> 2, h = bh & 3;
        attn_unit<2, 128, false>(lds, tid, lane, wave, QKV, h * 128, qrow0, 512 + h * 128, b * SEQ, TX + b * CTXL, VAT + (size_t)bh * 128 * NKEY, 0, khi, 0, 0, nullptr,
                                 AOUT, h * 128, lam, subg, 1.0f - lam_init);
    }
    LAS float* biasT = (LAS float*)(lds + LX_BIAS) + 64;
    for (int rep = 0; rep <= ((repmask >> 9) & 1); ++rep)
    for (int u = vcu; u < 1152; u += G) {
        int bh, qrow0, klo, khi, rw;
        if (u < 1024) { bh = u >> 4; const int rp = u & 15; qrow0 = (bh >> 3) * SEQ + rp * 128; klo = na_r0(2 * rp); khi = na_r0(2 * rp + 1) + 8; rw = 2 * rp + (wave >> 2); }
        else { const int q = u - 1024; bh = q >> 1; const int qt = q & 1; qrow0 = TX + (bh >> 3) * CTXL + qt * 128; klo = 0; khi = 0; rw = 0; }
        const int b = bh >> 3, h = bh & 7;
        for (int i = tid; i < 640; i += 512) { const int k = i - 64; biasT[k] = (k >= 0 && k < 465) ? nab[h * 465 + k] * LOG2E : 0.f; }
        attn_unit<1, 64, true>(lds, tid, lane, wave, QKV, 1536 + h * 64, qrow0, 2048 + h * 64, b * SEQ, TX + b * CTXL, VBT + (size_t)bh * 64 * NKEY, klo, khi,
                               rw, 16 * (wave & 3), biasT, AOUT, 512 + h * 64, 0.f, nullptr, 1.0f);
    }
}

__device__ __forceinline__ void gla_chunk_rows(int b, int dir, int n, int& row0, int& tok0) {
    if (n < 4) { const int cc = dir ? 3 - n : n; row0 = TX + b * CTXL + 64 * cc; tok0 = SEQ + 64 * cc; } else { const int lc = dir ? 35 - n : n - 4; row0 = b * SEQ + 64 * lc; tok0 = 64 * lc; }
}
constexpr int GP_QM = 0, GP_KM = 17408, GP_VT = 34816, GP_LR = 71680, GP_SEG = 75776;
__device__ __forceinline__ void phase_gla_prep(const bf16* QKV2, const bf16* VGT, const float* wgate  , const float* bgate  ,
                                               bf16* QG, bf16* KET, float* FACD, bf16* OF, bf16* OB,
                                               LAS unsigned char* lds, int tid, int lane, int wave, int vcu, int G) {
    const int fr = lane & 15, g = lane >> 4;
    const int d = tid & 127, seg = tid >> 7;
    LAS float* LR = (LAS float*)(lds + GP_LR);
    LAS float* SEG = (LAS float*)(lds + GP_SEG);
    for (int ub = vcu * 9; ub < 2304; ub += G * 9) {
        const int q = ub / 36, n0 = ub % 36, dir = q & 1, hh = (q >> 1) & 3, b = q >> 3;
        bf16* OUT = dir ? OB : OF;
        float wg[16];
#pragma unroll
        for (int r = 0; r < 16; ++r) wg[r] = wgate[(dir * 16 + r) * 512 + hh * 128 + d];
        const float bgv = bgate[dir * 512 + hh * 128 + d];
        const bf16* vtb = VGT + (size_t)(b * 4 + hh) * 256 * NKEY;
        u32x4 qr[2], kr[2], vr[4], lr4;
#define GP_LOAD(n) do { int _row0, _tok0; gla_chunk_rows(b, dir, (n), _row0, _tok0); \
        _Pragma("unroll") for (int j = 0; j < 2; ++j) { const int idx = tid + 512 * j, p = idx >> 4, ch = idx & 15; const bf16* src = QKV2 + (size_t)(_row0 + p) * NGLA + hh * 128 + ch * 8; qr[j] = *(const u32x4*)src; kr[j] = *(const u32x4*)(src + 512); } \
        _Pragma("unroll") for (int j = 0; j < 4; ++j) { const int idx = tid + 512 * j; vr[j] = *(const u32x4*)(vtb + (size_t)(idx >> 3) * NKEY + _tok0 + (idx & 7) * 8); } \
        if (tid < 128) lr4 = *(const u32x4*)(QKV2 + (size_t)(_row0 + (tid >> 1)) * NGLA + 3072 + dir * 16 + (tid & 1) * 8); } while (0)
        GP_LOAD(n0);
        for (int k9 = 0; k9 < 9; ++k9) {
            const int n = n0 + k9, u = ub + k9; int row0, tok0; gla_chunk_rows(b, dir, n, row0, tok0);
#pragma unroll
            for (int j = 0; j < 2; ++j) { const int idx = tid + 512 * j, p = idx >> 4, ch = idx & 15;
                *(LAS u32x4*)(lds + GP_QM + p * 272 + ch * 16) = qr[j]; *(LAS u32x4*)(lds + GP_KM + p * 272 + ch * 16) = kr[j]; }
#pragma unroll
            for (int j = 0; j < 4; ++j) { const int idx = tid + 512 * j; *(LAS u32x4*)(lds + GP_VT + (idx >> 3) * 144 + (idx & 7) * 16) = vr[j]; }
            if (tid < 128) { LAS float* lp = LR + (tid >> 1) * 16 + (tid & 1) * 8;
                lp[0] = bflo(lr4.x); lp[1] = bfhi(lr4.x); lp[2] = bflo(lr4.y); lp[3] = bfhi(lr4.y); lp[4] = bflo(lr4.z); lp[5] = bfhi(lr4.z); lp[6] = bflo(lr4.w); lp[7] = bfhi(lr4.w); }
            __syncthreads();
            if (k9 + 1 < 9) GP_LOAD(n + 1);
            float gc[16];
#pragma unroll
            for (int pi = 0; pi < 16; ++pi) { const LAS f32x4* lp = (const LAS f32x4*)(LR + (16 * seg + pi) * 16); float z = bgv;
#pragma unroll
                for (int k = 0; k < 4; ++k) { const f32x4 l4 = lp[k]; z += l4.x * wg[4 * k] + l4.y * wg[4 * k + 1] + l4.z * wg[4 * k + 2] + l4.w * wg[4 * k + 3]; }
                const float az = fabsf(z); gc[pi] = (fminf(z, 0.f) - flog(1.0f + fexp(-az))) * 0.0625f; }
            float run = 0.f;
            if (dir == 0) {
#pragma unroll
                for (int pi = 0; pi < 16; ++pi) { run += gc[pi]; gc[pi] = run; }
            } else {
#pragma unroll
                for (int pi = 15; pi >= 0; --pi) { run += gc[pi]; gc[pi] = run; }
            }
            SEG[seg * 128 + d] = run;
            __syncthreads();
            const float t0 = SEG[d], t1 = SEG[128 + d], t2 = SEG[256 + d], t3 = SEG[384 + d];
            float off, gmid; const float gend = (t0 + t1) + (t2 + t3);
            if (dir == 0) { off = (seg > 0 ? t0 : 0.f) + (seg > 1 ? t1 : 0.f) + (seg > 2 ? t2 : 0.f); gmid = t0 + t1; }
            else { off = (seg < 3 ? t3 : 0.f) + (seg < 2 ? t2 : 0.f) + (seg < 1 ? t1 : 0.f); gmid = t3 + t2; }
            const float emid = fexp(gmid), eend = fexp(gend - gmid);
            unsigned kep[8];
            bf16* qgp = QG + ((size_t)u * 64 + 16 * seg) * 128 + d;
#pragma unroll
            for (int pi = 0; pi < 16; ++pi) { const int p = 16 * seg + pi; const float rel = off + gc[pi] - gmid; const float Ep = fexp(rel), Ei = fexp(-rel);
                LAS bf16* qa = (LAS bf16*)(lds + GP_QM) + p * 136 + d; LAS bf16* ka = (LAS bf16*)(lds + GP_KM) + p * 136 + d;
                const float qv = bf2f(*qa), kv = bf2f(*ka);
                const float qm = qv * Ep, km = kv * Ei;
                const unsigned w1 = cvtpk(qm, qm * emid), w2 = cvtpk(km, km * eend);
                *qa = (bf16)(w1 & 0xffffu); qgp[pi * 128] = (bf16)(w1 >> 16); *ka = (bf16)(w2 & 0xffffu);
                if (pi & 1) kep[pi >> 1] |= (w2 & 0xffff0000u); else kep[pi >> 1] = w2 >> 16; }
            { u32x4* kt = (u32x4*)(KET + ((size_t)u * 128 + d) * 64 + 16 * seg); kt[0] = (u32x4){kep[0], kep[1], kep[2], kep[3]}; kt[1] = (u32x4){kep[4], kep[5], kep[6], kep[7]}; }
            if (seg == 0) FACD[(size_t)u * 128 + d] = fexp(gend);
            __syncthreads();
            { const int cb = wave & 3, half = wave >> 2;
              bf16x8 qfr[4];
#pragma unroll
              for (int ks = 0; ks < 4; ++ks) qfr[ks] = *(const LAS bf16x8*)(lds + GP_QM + (16 * cb + fr) * 272 + (8 * g + 32 * ks) * 2);
              f32x4 AT[4];
#pragma unroll
              for (int sb = 0; sb < 4; ++sb) { AT[sb] = (f32x4){0.f, 0.f, 0.f, 0.f};
#pragma unroll
                  for (int ks = 0; ks < 4; ++ks) { const bf16x8 af = *(const LAS bf16x8*)(lds + GP_KM + (16 * sb + fr) * 272 + (8 * g + 32 * ks) * 2);
                      AT[sb] = __builtin_amdgcn_mfma_f32_16x16x32_bf16(af, qfr[ks], AT[sb], 0, 0, 0); }
                  const int c = 16 * cb + fr;
#pragma unroll
                  for (int ii = 0; ii < 4; ++ii) { const int sp = 16 * sb + 4 * g + ii; const bool keep = dir ? (sp >= c) : (sp <= c); AT[sb][ii] = keep ? AT[sb][ii] : 0.f; } }
              bf16x8 pf[2];
#pragma unroll
              for (int t = 0; t < 2; ++t) { u32x4 w; w.x = pk2(AT[2 * t][0], AT[2 * t][1]); w.y = pk2(AT[2 * t][2], AT[2 * t][3]); w.z = pk2(AT[2 * t + 1][0], AT[2 * t + 1][1]); w.w = pk2(AT[2 * t + 1][2], AT[2 * t + 1][3]);
                  pf[t] = __builtin_bit_cast(bf16x8, w); }
#pragma unroll
              for (int v8 = 0; v8 < 8; ++v8) { const int vb = 8 * half + v8; f32x4 Oa = (f32x4){0.f, 0.f, 0.f, 0.f};
#pragma unroll
                  for (int t = 0; t < 2; ++t) { const LAS unsigned char* vp = lds + GP_VT + (16 * vb + fr) * 144 + (32 * t + 4 * g) * 2;
                      const u32x2 lo = *(const LAS u32x2*)vp, hi = *(const LAS u32x2*)(vp + 32);
                      u32x4 w; w.x = lo.x; w.y = lo.y; w.z = hi.x; w.w = hi.y;
                      Oa = __builtin_amdgcn_mfma_f32_16x16x32_bf16(__builtin_bit_cast(bf16x8, w), pf[t], Oa, 0, 0, 0); }
                  u32x2 w; w.x = pk2(Oa[0], Oa[1]); w.y = pk2(Oa[2], Oa[3]);
                  *(u32x2*)(OUT + (size_t)(row0 + 16 * cb + fr) * D + hh * 256 + 16 * vb + 4 * g) = w; }
            }
            __syncthreads();
        }
#undef GP_LOAD
    }
}

constexpr int GS_BUF = 45056, GS_QG = 0, GS_KET = 17408, GS_VT = 35840, GS_ST = 2 * GS_BUF, GS_DEC = GS_ST + 2 * 17408;
__device__ __forceinline__ void phase_gla(const bf16* VGT, bf16* OF, bf16* OB, const bf16* QG, const bf16* KET, const float* FACD,
                                          LAS unsigned char* lds, int tid, int lane, int wave, int vcu, int G) {
    const int fr = lane & 15, g = lane >> 4;
    for (int u = vcu; u < 256; u += G) {
        const int slab = u & 3, dir = (u >> 2) & 1, hh = (u >> 3) & 3, b = u >> 5;
        bf16* OUT = dir ? OB : OF;
        const int upb = ((b * 4 + hh) * 2 + dir) * 36;
        f32x4 Sacc[4];
#pragma unroll
        for (int vb = 0; vb < 4; ++vb) Sacc[vb] = (f32x4){0.f, 0.f, 0.f, 0.f};
        for (int i = tid; i < 17408 / 4; i += 512) ((LAS unsigned*)(lds + GS_ST))[i] = 0u;
        const bf16* vtb = VGT + ((size_t)(b * 4 + hh) * 256 + slab * 64) * NKEY;
        const int cb = wave & 3, vh = wave >> 2;
        const int ocol = hh * 256 + slab * 64 + 32 * vh + 4 * g;
        struct GsRegs { u32x4 qg[2], ket[2], v; u32x2 oi[2]; float dec; };
        GsRegs R0, R1; R0.dec = 0.f; R1.dec = 0.f;
#define GS_LOAD(R, n) do { int _row0, _tok0; gla_chunk_rows(b, dir, (n), _row0, _tok0); const size_t _u = (size_t)(upb + (n)); \
        _Pragma("unroll") for (int j = 0; j < 2; ++j) { const int idx = tid + 512 * j; R.qg[j] = *(const u32x4*)(QG + _u * 8192 + idx * 8); R.ket[j] = *(const u32x4*)(KET + _u * 8192 + idx * 8); } \
        R.v = *(const u32x4*)(vtb + (size_t)(tid >> 3) * NKEY + _tok0 + (tid & 7) * 8); \
        if (tid < 128) R.dec = FACD[_u * 128 + tid]; \
        _Pragma("unroll") for (int v2 = 0; v2 < 2; ++v2) R.oi[v2] = *(const u32x2*)(OUT + (size_t)(_row0 + 16 * cb + fr) * D + ocol + 16 * v2); } while (0)
#define GS_STORE(R, bf) do { LAS unsigned char* _p = lds + (bf) * GS_BUF; \
        _Pragma("unroll") for (int j = 0; j < 2; ++j) { const int idx = tid + 512 * j; *(LAS u32x4*)(_p + GS_QG + (idx >> 4) * 272 + (idx & 15) * 16) = R.qg[j]; *(LAS u32x4*)(_p + GS_KET + (idx >> 3) * 144 + (idx & 7) * 16) = R.ket[j]; } \
        *(LAS u32x4*)(_p + GS_VT + (tid >> 3) * 144 + (tid & 7) * 16) = R.v; \
        if (tid < 128) ((LAS float*)(lds + GS_DEC))[(bf) * 128 + tid] = R.dec; } while (0)
#define GS_ITER(n, RN, RF) do { const int _n = (n); int row0, tok0; gla_chunk_rows(b, dir, _n, row0, tok0); const int cur = _n & 1; \
            if (_n + 2 < 36) GS_LOAD(RF, _n + 2); \
            const LAS unsigned char* bufp = lds + cur * GS_BUF; const LAS unsigned char* stp = lds + GS_ST + cur * 17408; \
            { bf16x8 qfr[4]; \
              _Pragma("unroll") for (int ks = 0; ks < 4; ++ks) qfr[ks] = *(const LAS bf16x8*)(bufp + GS_QG + (16 * cb + fr) * 272 + (8 * g + 32 * ks) * 2); \
              _Pragma("unroll") for (int v2 = 0; v2 < 2; ++v2) { const int vb = 2 * vh + v2; const u32x2 oin = v2 ? oc1 : oc0; \
                  f32x4 Oa = (f32x4){bflo(oin.x), bfhi(oin.x), bflo(oin.y), bfhi(oin.y)}; \
                  _Pragma("unroll") for (int ks = 0; ks < 4; ++ks) { const bf16x8 af = *(const LAS bf16x8*)(stp + (16 * vb + fr) * 272 + (8 * g + 32 * ks) * 2); \
                      Oa = __builtin_amdgcn_mfma_f32_16x16x32_bf16(af, qfr[ks], Oa, 0, 0, 0); } \
                  u32x2 w; w.x = pk2(Oa[0], Oa[1]); w.y = pk2(Oa[2], Oa[3]); \
                  *(u32x2*)(OUT + (size_t)(row0 + 16 * cb + fr) * D + ocol + 16 * v2) = w; } } \
            { const f32x4 dec = *(const LAS f32x4*)((LAS float*)(lds + GS_DEC) + cur * 128 + 16 * wave + 4 * g); \
              LAS unsigned char* stn = lds + GS_ST + (cur ^ 1) * 17408; \
              _Pragma("unroll") for (int vb = 0; vb < 4; ++vb) { Sacc[vb] = Sacc[vb] * dec; \
                  _Pragma("unroll") for (int t = 0; t < 2; ++t) { const bf16x8 af = *(const LAS bf16x8*)(bufp + GS_KET + (16 * wave + fr) * 144 + (8 * g + 32 * t) * 2); \
                      const bf16x8 bfr = *(const LAS bf16x8*)(bufp + GS_VT + (16 * vb + fr) * 144 + (8 * g + 32 * t) * 2); \
                      Sacc[vb] = __builtin_amdgcn_mfma_f32_16x16x32_bf16(af, bfr, Sacc[vb], 0, 0, 0); } \
                  u32x2 w; w.x = pk2(Sacc[vb][0], Sacc[vb][1]); w.y = pk2(Sacc[vb][2], Sacc[vb][3]); \
                  *(LAS u32x2*)(stn + (16 * vb + fr) * 272 + (16 * wave + 4 * g) * 2) = w; } } \
            if (_n + 1 < 36) { GS_STORE(RN, cur ^ 1); oc0 = RN.oi[0]; oc1 = RN.oi[1]; } \
            __syncthreads(); } while (0)
        GS_LOAD(R0, 0); GS_STORE(R0, 0);
        u32x2 oc0 = R0.oi[0], oc1 = R0.oi[1];
        GS_LOAD(R0, 1);
        __syncthreads();
        for (int n = 0; n < 36; n += 2) { GS_ITER(n, R0, R1); GS_ITER(n + 1, R1, R0); }
#undef GS_ITER
#undef GS_LOAD
#undef GS_STORE
    }
}

constexpr int N_PHASES = 34;
typedef const Args __attribute__((address_space(4)))* KArgs;
__device__ __forceinline__ KArgs kargs() { KArgs p = (KArgs)__builtin_amdgcn_kernarg_segment_ptr(); asm volatile("" : "+s"(p)); return p; }
__global__ void __launch_bounds__(512, 2) fwd(Args a_unused) {
    extern __shared__ __attribute__((aligned(16))) unsigned char lds_raw[];
    LAS unsigned char* lds = (LAS unsigned char*)lds_raw;
    const int tid0 = threadIdx.x;
    const int G0 = gridDim.x; const int bx0 = blockIdx.x;
#define PH_ENTRY int tid = tid0; asm volatile("" : "+v"(tid)); int G = G0, bx = bx0; asm volatile("" : "+s"(G), "+s"(bx)); const int lane = tid & 63, wave = __builtin_amdgcn_readfirstlane(tid >> 6); \
        const int vcu = (G % 8 == 0) ? (bx % 8) * (G / 8) + bx / 8 : bx; (void)lane; (void)wave; (void)vcu
    const int tid = tid0;
    const int ph_lo = kargs()->ph_lo, ph_hi = kargs()->ph_hi;
    const int repmask = kargs()->rep;
    if (tid < 64) ((LAS unsigned*)(lds + LX_MISC))[tid] = 0u;
    for (int i = tid; i < 1024; i += 512) { const int pos = i >> 4, f = i & 15; const float inv = __builtin_amdgcn_exp2f(-(float)f * (13.287712379549449f / 16.0f)); const float ang = (float)pos * inv;
        ((LAS float*)(lds + LX_ROPE))[2 * i] = __cosf(ang); ((LAS float*)(lds + LX_ROPE))[2 * i + 1] = __sinf(ang); }
    __syncthreads();
    const bool single = (ph_hi - ph_lo) > 1;
    XcdBarrier bar; bar.bar = (unsigned*)(kargs()->ws + WS_CTL) + CW_BAR; bar.x = 0; bar.st = (volatile LAS unsigned*)(lds + LX_MISC);
    if (single) bar = xcd_barrier_post((unsigned*)(kargs()->ws + WS_CTL) + CW_BAR, (volatile LAS unsigned*)(lds + LX_MISC));
#define IN(k) (ph_lo <= (k) && (k) < ph_hi)
#define REPLOOP(t) for (int rep_ = 0, nrep_ = 1 + ((repmask >> (t)) & 1); rep_ < nrep_; ++rep_, (rep_ < nrep_ ? (bar.bar = (unsigned*)(kargs()->ws + WS_CTL) + CW_BAR, xcd_barrier(bar)) : (void)0))
#define SEAM(k) do { if (IN(k) && IN((k) + 1)) { bar.bar = (unsigned*)(kargs()->ws + WS_CTL) + CW_BAR; xcd_barrier(bar); if ((repmask >> 10) & 1) xcd_barrier(bar); } } while (0)
    LAS int* tab = (LAS int*)(lds + LX_MOETAB);
#define CONV_PTRS(A) ConvPtrs{(A)->att_w_in, (A)->att_w_out, (A)->gla_w_in, (A)->gla_w_out, (A)->moe_w1, (A)->moe_w3, (A)->moe_w2, (A)->ws}
#define CONV_REQUIRE(need) do { KArgs A_ = kargs(); unsigned* ctl_ = (unsigned*)(A_->ws + WS_CTL); \
        if ((int)__hip_atomic_load(ctl_ + CW_CONV_DONE, RLX_AGENT) < (need)) { { PH_ENTRY; const ConvPtrs P_ = CONV_PTRS(A_); conv_until(P_, ctl_, (need), lds, tid, lane, wave, vcu, G); } \
            bar.bar = ctl_ + CW_BAR; xcd_barrier(bar); } } while (0)
#define CONV_BUBBLE(pid) do { if (!((MK_BUBBLES >> ((pid) & 7)) & 1)) break; KArgs A_ = kargs(); const ConvPtrs P_ = CONV_PTRS(A_); conv_bubble(P_, (unsigned*)(A_->ws + WS_CTL), (pid), G, lds, tid, lane, wave); } while (0)

    if (IN(0)) REPLOOP(0) { PH_ENTRY; p0_prologue(kargs(), lds, tid, lane, wave, vcu, G); } SEAM(0);
    if (IN(1)) { PH_ENTRY; KArgs A = kargs(); unsigned char* ws = A->ws; phase_norm1(A->x, A->ctx, A->norm_g, (float*)(ws + WS_MODV), (bf16*)(ws + WS_H), TALL, lane, wave, vcu, G); } SEAM(1);

#pragma nounroll
    for (int L = 0; L < 4; ++L) {
        const int pb = 2 + 8 * L; const bool isattn = !(L & 1); const int j = L >> 1; const bool lastL = (L == 3);
        const int nrows = lastL ? TX : TALL;
        if (IN(pb) && L > 0) CONV_REQUIRE(L == 1 ? CT_GLA0 : (L == 2 ? CT_ATTN1 : CT_GLA1));
        if (IN(pb)) REPLOOP(isattn ? 1 : 3) {
            PH_ENTRY; KArgs A = kargs(); unsigned char* ws = A->ws; unsigned char* big = ws + WS_BIG; const bf16* H = (const bf16*)(ws + WS_H);
            if (isattn) {
                pg8::DenseOrder S; S.init(H, (const bf16*)(ws + WS_WATTIN) + (size_t)j * NATT * D, TALL, NATT, D, G, bx);
                pg8::EpiAttnIn E{(bf16*)(big + BG_QKV), (bf16*)(big + BG_VAT), (bf16*)(big + BG_VBT), (const LAS float*)(lds + LX_ROPE)};
                pg8::gemm_phase<pg8::EpiAttnIn, pg8::DenseOrder, false>(lds, tid, D, S, E);
                CONV_BUBBLE(L * 8 + 0);
            } else {
                pg8::DenseOrder S; S.init(H, (const bf16*)(ws + WS_WGLAIN) + (size_t)j * NGLA * D, TALL, NGLA, D, G, bx);
                pg8::EpiGlaIn E{(bf16*)(big + BG_QKV2), (bf16*)(big + BG_VGT)};
                pg8::gemm_phase<pg8::EpiGlaIn, pg8::DenseOrder, false>(lds, tid, D, S, E);
                CONV_BUBBLE(L * 8 + 0);
            }
        }
        SEAM(pb);
        if (!isattn && IN(pb + 1)) {
            for (int rep_ = 0; rep_ <= ((repmask >> 13) & 1); ++rep_)
            { PH_ENTRY; KArgs A = kargs(); unsigned char* ws = A->ws;
              phase_gla_prep((const bf16*)(ws + WS_BIG + BG_QKV2), (const bf16*)(ws + WS_BIG + BG_VGT), A->gla_w_gate + j * 2 * 16 * 512, A->gla_b_gate + j * 2 * 512,
                             (bf16*)(ws + WS_QG), (bf16*)(ws + WS_KET), (float*)(ws + WS_BIG + BG_FAC), (bf16*)(ws + WS_BIG + BG_OF), (bf16*)(ws + WS_BIG + BG_OB), lds, tid, lane, wave, vcu, G); }
            if (single) { bar.bar = (unsigned*)(kargs()->ws + WS_CTL) + CW_BAR; xcd_barrier(bar); }
        }
        if (IN(pb + 1)) REPLOOP(isattn ? 2 : 4) {
            PH_ENTRY; KArgs A = kargs(); unsigned char* ws = A->ws; unsigned char* big = ws + WS_BIG; bf16* AOUT = (bf16*)(ws + WS_AOUT);
            if (isattn) { phase_attention((const bf16*)(big + BG_QKV), (const bf16*)(big + BG_VAT), (const bf16*)(big + BG_VBT), AOUT, A->att_lambda + j * 256, (L == 0) ? 0.2f : 0.470713018f,
                                        A->att_subln_g + j * 128, A->na_bias + j * 8 * 465, lds, tid, lane, wave, vcu, G, repmask);
              CONV_BUBBLE(L * 8 + 1); }
            else phase_gla((const bf16*)(big + BG_VGT), (bf16*)(big + BG_OF), (bf16*)(big + BG_OB), (const bf16*)(ws + WS_QG), (const bf16*)(ws + WS_KET), (const float*)(big + BG_FAC),
                           lds, tid, lane, wave, vcu, G);
        }
        SEAM(pb + 1);
        if (!isattn) {
            if (IN(pb + 2)) REPLOOP(5) { PH_ENTRY; KArgs A = kargs(); unsigned char* ws = A->ws; unsigned char* big = ws + WS_BIG;
                phase_readout((const bf16*)(big + BG_OF), (const bf16*)(big + BG_OB), (const bf16*)(big + BG_QKV2), A->gla_norm_g + j * 256, (bf16*)(ws + WS_AOUT), nrows, lane, wave, vcu, G); }
            SEAM(pb + 2);
        }
        if (IN(pb + 3)) {
            PH_ENTRY; KArgs A = kargs(); unsigned char* ws = A->ws;
            pg8::DenseOrder S; S.init((const bf16*)(ws + WS_AOUT), (const bf16*)(ws + (isattn ? WS_WATTOUT : WS_WGLAOUT)) + (size_t)j * D * D, nrows, D, D, G, bx);
            pg8::EpiResid E{L == 0 ? A->x : A->out, L == 0 ? A->ctx : (const float*)(ws + WS_CTX), A->out, (float*)(ws + WS_CTX), (const float*)(ws + WS_MODV) + (size_t)L * 9 * 6144 + 2048};
            pg8::gemm_phase<pg8::EpiResid, pg8::DenseOrder, false>(lds, tid, D, S, E);
            CONV_BUBBLE(L * 8 + 3);
        }
        SEAM(pb + 3);
        if (IN(pb + 4)) { PH_ENTRY; KArgs A = kargs(); unsigned char* ws = A->ws;
            phase_router(A->out, (float*)(ws + WS_CTX), A->norm_g + (L * 2 + 1) * D, (const float*)(ws + WS_MODV) + (size_t)L * 9 * 6144, (bf16*)(ws + WS_H), A->router_w, A->router_bias,
                         (unsigned*)(ws + WS_CTL) + CW_CNT + L * 16 * 64, (int*)(ws + WS_LIST), (int*)(ws + WS_TOKI), (float*)(ws + WS_TOKW), nrows, lds, tid, lane, wave, vcu, G, (repmask >> 11) & 1); }
        SEAM(pb + 4);
        if (IN(pb + 5)) CONV_REQUIRE(L == 0 ? CT_MOE0 : (L == 1 ? CT_MOE1 : (L == 2 ? CT_MOE2 : CT_MOE3)));
        if (IN(pb + 5)) REPLOOP(6) {
            PH_ENTRY; KArgs A = kargs(); unsigned char* ws = A->ws;
            const int RT = build_moe_table((unsigned*)(ws + WS_CTL) + CW_CNT + L * 16 * 64, tab, tid);
            pg8::MoeOrder S; S.A = (const char*)(ws + WS_H); S.B = (const char*)(ws + WS_W13) + (size_t)L * 16 * D * D * 2; S.K = D; S.bstride = (size_t)D * D * 2; S.tab = tab; S.list = (const int*)(ws + WS_LIST); S.RT = RT; S.nwg = RT * 4; S.G = G; S.c = bx;
            pg8::EpiMoe1 E{(bf16*)(ws + WS_BIG + BG_HB)};
            pg8::gemm_phase<pg8::EpiMoe1, pg8::MoeOrder, true>(lds, tid, D, S, E);
            CONV_BUBBLE(L * 8 + 5);
        }
        SEAM(pb + 5);
        if (IN(pb + 6)) REPLOOP(7) {
            PH_ENTRY; KArgs A = kargs(); unsigned char* ws = A->ws;
            const int RT = build_moe_table((unsigned*)(ws + WS_CTL) + CW_CNT + L * 16 * 64, tab, tid);
            pg8::MoeOrder S; S.A = (const char*)(ws + WS_BIG + BG_HB); S.B = (const char*)(ws + WS_W2) + (size_t)L * 16 * D * DEXP * 2; S.K = DEXP; S.bstride = (size_t)D * DEXP * 2; S.tab = tab; S.list = (const int*)(ws + WS_LIST); S.RT = RT; S.nwg = RT * 4; S.G = G; S.c = bx;
            pg8::EpiBf16 E{(bf16*)(ws + WS_BIG + BG_YB), D};
            pg8::gemm_phase<pg8::EpiBf16, pg8::MoeOrder, false>(lds, tid, DEXP, S, E);
            CONV_BUBBLE(L * 8 + 6);
        }
        SEAM(pb + 6);
        if (IN(pb + 7)) { PH_ENTRY; KArgs A = kargs(); unsigned char* ws = A->ws; const float* MODV = (const float*)(ws + WS_MODV);
            phase_combine(A->out, (float*)(ws + WS_CTX), MODV + (size_t)L * 9 * 6144, (const bf16*)(ws + WS_BIG + BG_YB), (unsigned*)(ws + WS_CTL) + CW_CNT + L * 16 * 64, (const int*)(ws + WS_TOKI), (const float*)(ws + WS_TOKW),
                          lastL, lastL ? A->final_g : A->norm_g + ((L + 1) * 2) * D, MODV + (size_t)(lastL ? L : L + 1) * 9 * 6144, (bf16*)(ws + WS_H), nrows, lane, wave, vcu, G, (repmask >> 12) & 1); }
        if (!lastL) SEAM(pb + 7);
    }
#undef IN
#undef REPLOOP
#undef SEAM
#undef CONV_PTRS
#undef CONV_REQUIRE
#undef CONV_BUBBLE
#undef PH_ENTRY
}

extern "C" void kernel_launch(void* const* d_in, const int* in_sizes, int n_in, void* d_out, int out_size, void* d_ws, size_t ws_size, hipStream_t stream) {
    static int ready = 0;
    if (ready == 0) {
        if (n_in != 23 || out_size != TX * D || ws_size < WS_END) { fprintf(stderr, "kernel_launch: unexpected shapes (n_in %d out %d ws %zu)\n", n_in, out_size, ws_size); ready = -1; return; }
        if (hipFuncSetAttribute((const void*)fwd, hipFuncAttributeMaxDynamicSharedMemorySize, LDS_BYTES) != hipSuccess) { fprintf(stderr, "kernel_launch: hipFuncSetAttribute failed\n"); ready = -1; return; }
        int per_cu = 0; (void)hipOccupancyMaxActiveBlocksPerMultiprocessor(&per_cu, (const void*)fwd, 512, LDS_BYTES); (void)hipGetLastError();
        if (per_cu < 1) fprintf(stderr, "kernel_launch: occupancy query reports %d blocks per CU\n", per_cu);
        ready = 1;
    }
    if (ready < 0) return;
    (void)hipMemsetAsync((char*)d_ws + WS_CTL, 0, CTL_ZERO_BYTES, stream);
    Args a{};
    const float** ap = (const float**)&a;
    for (int i = 0; i < 23; ++i) ap[i] = (const float*)d_in[i];
    a.out = (float*)d_out; a.ws = (unsigned char*)d_ws;
    const int grid = 256;
    a.ph_lo = 0; a.ph_hi = N_PHASES; a.rep = MK_REPMASK;
    hipLaunchKernelGGL(fwd, dim3(grid), dim3(512), LDS_BYTES, stream, a);
}
```

```cpp
#include <hip/hip_runtime.h>
#include <cstdio>
#include <cstdint>

#ifndef MK_BUBBLES
#define MK_BUBBLES 0
#endif
#ifndef MK_REPMASK
#define MK_REPMASK 0
#endif

#define GAS __attribute__((address_space(1)))
#define LAS __attribute__((address_space(3)))
typedef unsigned short bf16;
typedef short bf16x8 __attribute__((ext_vector_type(8)));
typedef short bf16x4 __attribute__((ext_vector_type(4)));
typedef float f32x4 __attribute__((ext_vector_type(4)));
typedef float f32x2 __attribute__((ext_vector_type(2)));
typedef unsigned u32x4 __attribute__((ext_vector_type(4)));
typedef unsigned u32x2 __attribute__((ext_vector_type(2)));

constexpr int D = 1024, NB = 8, SEQ = 2048, CTXL = 256;
constexpr int TX = NB * SEQ, TC = NB * CTXL, TALL = TX + TC;
constexpr int NKEY = SEQ + CTXL;
constexpr int NATT = 3072, NGLA = 3328;
constexpr float EPSF = 1e-6f;
constexpr float LOG2E = 1.4426950408889634f;
constexpr int NEXP = 16, DEXP = 512;
constexpr int RT_MAX = 160;

constexpr size_t MiB = 1u << 20;
constexpr size_t WS_CTL = 0, CTL_ZERO_BYTES = 1 * MiB;
constexpr size_t WS_MODV = 1 * MiB;
constexpr size_t WS_TOKI = 2 * MiB;
constexpr size_t WS_TOKW = 2 * MiB + 512 * 1024;
constexpr size_t WS_LIST = 3 * MiB;
constexpr size_t WS_CTX = 5 * MiB;
constexpr size_t WS_WATTIN = 13 * MiB;
constexpr size_t WS_WATTOUT = 25 * MiB;
constexpr size_t WS_WGLAIN = 29 * MiB;
constexpr size_t WS_WGLAOUT = 42 * MiB;
constexpr size_t WS_W13 = 46 * MiB;
constexpr size_t WS_W2 = 174 * MiB;
constexpr size_t WS_H = 238 * MiB;
constexpr size_t WS_AOUT = 274 * MiB;
constexpr size_t WS_BIG = 310 * MiB;
constexpr size_t WS_END = 539 * MiB;
constexpr size_t BG_QKV = 0;
constexpr size_t BG_VAT = 108 * MiB;
constexpr size_t BG_VBT = 126 * MiB;
constexpr size_t BG_QKV2 = 0;
constexpr size_t BG_VGT = 117 * MiB;
constexpr size_t BG_OF = 153 * MiB;
constexpr size_t BG_OB = 189 * MiB;
constexpr size_t BG_FAC = 225 * MiB;
constexpr size_t WS_QG = WS_H, WS_KET = WS_AOUT;
constexpr size_t BG_HB = 0;
constexpr size_t BG_YB = 40 * MiB;
constexpr int CW_TMO = 0;
constexpr int CW_BAR = 4096;
constexpr int CW_NAQ = 15360;
constexpr int CW_CNT = 8192;

constexpr int RING_BYTES = 131072;
constexpr int LX_OFF = RING_BYTES;
constexpr int LX_MISC = LX_OFF;
constexpr int LX_MOETAB = LX_OFF + 256;
constexpr int LX_ROPE = LX_OFF + 2048;
constexpr int LX_BIAS = LX_OFF + 2048 + 8192;
constexpr int LDS_BYTES = 147456;

#define LDS_WAIT() asm volatile("s_waitcnt lgkmcnt(0)" ::: "memory")
#define VM_WAIT() asm volatile("s_waitcnt vmcnt(0)" ::: "memory")
#define RLX_AGENT __ATOMIC_RELAXED, __HIP_MEMORY_SCOPE_AGENT
__device__ __forceinline__ unsigned f2bf(float f) { unsigned u = __builtin_bit_cast(unsigned, f); return (u + 0x7fffu + ((u >> 16) & 1u)) >> 16; }
typedef __bf16 hwbf16x2 __attribute__((ext_vector_type(2)));
__device__ __forceinline__ unsigned cvtpk(float lo, float hi) { const f32x2 v = {lo, hi}; const hwbf16x2 b = __builtin_convertvector(v, hwbf16x2); return __builtin_bit_cast(unsigned, b); }
__device__ __forceinline__ unsigned pk2(float lo, float hi) { return cvtpk(lo, hi); }
__device__ __forceinline__ float bf2f(unsigned short b) { return __builtin_bit_cast(float, ((unsigned)b) << 16); }
__device__ __forceinline__ float bflo(unsigned w) { return __builtin_bit_cast(float, w << 16); }
__device__ __forceinline__ float bfhi(unsigned w) { return __builtin_bit_cast(float, w & 0xffff0000u); }
template <int CTRL> __device__ __forceinline__ float dppf(float v) { return __builtin_bit_cast(float, __builtin_amdgcn_update_dpp(0, __builtin_bit_cast(int, v), CTRL, 0xf, 0xf, true)); }
__device__ __forceinline__ float row_sum(float v) { v += dppf<0xB1>(v); v += dppf<0x4E>(v); v += dppf<0x124>(v); v += dppf<0x128>(v); return v; }
__device__ __forceinline__ float swap16_add(float a, float b) { auto r = __builtin_amdgcn_permlane16_swap(__float_as_uint(a), __float_as_uint(b), false, false); const unsigned r0 = r[0], r1 = r[1]; return __uint_as_float(r0) + __uint_as_float(r1); }
__device__ __forceinline__ float swap32_add(float a, float b) { auto r = __builtin_amdgcn_permlane32_swap(__float_as_uint(a), __float_as_uint(b), false, false); const unsigned r0 = r[0], r1 = r[1]; return __uint_as_float(r0) + __uint_as_float(r1); }
__device__ __forceinline__ float swap16_max(float a) { auto r = __builtin_amdgcn_permlane16_swap(__float_as_uint(a), __float_as_uint(a), false, false); const unsigned r0 = r[0], r1 = r[1]; return fmaxf(__uint_as_float(r0), __uint_as_float(r1)); }
__device__ __forceinline__ float swap32_max(float a) { auto r = __builtin_amdgcn_permlane32_swap(__float_as_uint(a), __float_as_uint(a), false, false); const unsigned r0 = r[0], r1 = r[1]; return fmaxf(__uint_as_float(r0), __uint_as_float(r1)); }
__device__ __forceinline__ float readlane_f(float v, int l) { return __int_as_float(__builtin_amdgcn_readlane(__float_as_int(v), l)); }
__device__ __forceinline__ float wave_sum(float v) { v = row_sum(v); v = swap16_add(v, v); return swap32_add(v, v); }
__device__ __forceinline__ float fexp2(float x) { return __builtin_amdgcn_exp2f(x); }
__device__ __forceinline__ float fexp(float x) { return __builtin_amdgcn_exp2f(x * LOG2E); }
__device__ __forceinline__ float flog(float x) { return __builtin_amdgcn_logf(x) * 0.6931471805599453f; }
__device__ __forceinline__ float frcp(float x) { return __builtin_amdgcn_rcpf(x); }
__device__ __forceinline__ float silu_f(float x) { return x * frcp(1.0f + fexp(-x)); }

#define XB_TMO      128
#define XB_XCNT(j)  (256  + 64 * (j))
#define XB_XSUB(j)  (1280 + 64 * (j))
#define XB_XGEN(j)  (2304 + 64 * (j))
#define XB_TOP      3328
#define XB_TOPGEN   3392
#define XCD_BAR_WORDS 3456
#define XB_SPIN_CAP (1u << 18)
__device__ __forceinline__ unsigned xb_ld(unsigned* p)              { return __hip_atomic_load(p, __ATOMIC_RELAXED, __HIP_MEMORY_SCOPE_AGENT); }
__device__ __forceinline__ unsigned xb_add(unsigned* p, unsigned v) { return __hip_atomic_fetch_add(p, v, __ATOMIC_RELAXED, __HIP_MEMORY_SCOPE_AGENT); }
__device__ __forceinline__ unsigned xb_xcc_id() { return (unsigned)__builtin_amdgcn_s_getreg((3 << 11) | 20) & 0xFu; }
#define XB_SPIN(cond, bar) do { unsigned _sp = 0; while (cond) { __builtin_amdgcn_s_sleep(1); \
    if ((++_sp & 255u) == 0u) { if (xb_ld(&(bar)[XB_TMO])) break; if (_sp > XB_SPIN_CAP) { atomicAdd(&(bar)[XB_TMO], 1u); break; } } } } while (0)
struct XcdBarrier { unsigned* bar; unsigned x; volatile LAS unsigned* st; };
__device__ __forceinline__ XcdBarrier xcd_barrier_post(unsigned* bar, volatile LAS unsigned* st) {
    XcdBarrier b; b.bar = bar; b.x = xb_xcc_id(); b.st = st;
    if (threadIdx.x == 0) (void)xb_add(&bar[XB_XCNT(b.x)], 1u);
    return b;
}
__device__ __forceinline__ void xcd_barrier_complete(unsigned* bar, unsigned x, unsigned& nloc, unsigned& nx) {
    const unsigned G = gridDim.x * gridDim.y * gridDim.z;
    unsigned sum, cnt, mine, sp = 0u;
    for (;;) {
        sum = 0u; cnt = 0u; mine = 0u;
#pragma unroll
        for (unsigned j = 0; j < 16; ++j) { const unsigned c = xb_ld(&bar[XB_XCNT(j)]); sum += c; cnt += (c > 0u) ? 1u : 0u; mine = (j == x) ? c : mine; }
        if (sum == G) break;
        __builtin_amdgcn_s_sleep(1);
        if ((++sp & 255u) == 0u) { if (xb_ld(&bar[XB_TMO])) break; if (sp > XB_SPIN_CAP) { atomicAdd(&bar[XB_TMO], 1u); break; } }
    }
    nloc = mine > 0u ? mine : 1u; nx = cnt > 0u ? cnt : 1u;
}
__device__ __forceinline__ void xcd_barrier(const XcdBarrier& b) {
    asm volatile("s_waitcnt vmcnt(0)" ::: "memory");
    __syncthreads();
    if (threadIdx.x == 0) {
        unsigned* bar = b.bar;
        __builtin_amdgcn_s_waitcnt(0);
        unsigned nloc = b.st[0], nx = b.st[1];
        if (nloc == 0u) { xcd_barrier_complete(bar, b.x, nloc, nx); b.st[0] = nloc; b.st[1] = nx; }
        const unsigned old = xb_add(&bar[XB_XSUB(b.x)], 1u);
        const unsigned gen = old / nloc;
        if (old + 1u == (gen + 1u) * nloc) {
            __builtin_amdgcn_fence(__ATOMIC_RELEASE, "agent");
            asm volatile("s_waitcnt vmcnt(0)" ::: "memory");
            const unsigned og = xb_add(&bar[XB_TOP], 1u);
            const unsigned tg = og / nx;
            if (og + 1u == (tg + 1u) * nx) xb_add(&bar[XB_TOPGEN], 1u);
            else XB_SPIN(xb_ld(&bar[XB_TOPGEN]) == tg, bar);
            __builtin_amdgcn_fence(__ATOMIC_ACQUIRE, "agent");
            xb_add(&bar[XB_XGEN(b.x)], 1u);
            asm volatile("s_waitcnt vmcnt(0)" ::: "memory");
        } else {
            XB_SPIN(xb_ld(&bar[XB_XGEN(b.x)]) == gen, bar);
            __builtin_amdgcn_fence(__ATOMIC_ACQUIRE, "agent");
            asm volatile("s_waitcnt vmcnt(0)" ::: "memory");
        }
    }
    __syncthreads();
}

namespace pg8 {
constexpr int BM = 256, BK = 64, HALF = 128, HTB = HALF * BK * 2, STAGE_BYTES = 8 * HTB, NXCD = 8, WGM = 8;
__host__ __device__ __forceinline__ int lds_byte(int r, int c) { const int st = (r >> 4) * 2 + (c >> 5), rr = r & 15, cc = c & 31, ob = rr * 64 + cc * 2; return st * 1024 + (ob ^ (((ob >> 9) & 1) << 5)); }
__host__ __device__ __forceinline__ void stage_rc(int b, int& R, int& C) { const int st = b / 1024, sb = b % 1024, swz = sb ^ (((sb >> 9) & 1) << 5); R = (st >> 1) * 16 + swz / 64; C = (st & 1) * 32 + (swz % 64) / 2; }
__host__ __device__ __forceinline__ int perm32(int rho) { const int n = rho >> 4, i = rho & 15; return 8 * (i >> 2) + 4 * n + (i & 3); }

struct Unit { int pm, pn, e, mt, roff, nai; };
__device__ __forceinline__ bool split_index(long L, int nwg, int G, int& uidx, int& roff, int& nai) {
    const int R = nwg / G, r = nwg % G; const bool split = (r > 0) && (2 * r <= G);
    if (L < (long)R * G || !split) { if (L >= nwg) return false; uidx = (int)L; roff = 0; nai = 2; return true; }
    const int h = (int)(L - (long)R * G); if (h >= 2 * r) return false; uidx = R * G + (h >> 1); roff = (h & 1) * 128; nai = 1; return true;
}

__device__ __forceinline__ int xcd_remap(int wgid, int nwg) { const int q = nwg / NXCD, r = nwg % NXCD, xcd = wgid % NXCD, off = wgid / NXCD; return (xcd < r ? xcd * (q + 1) : r * (q + 1) + (xcd - r) * q) + off; }

struct DenseOrder {
    const char* A; const char* B; int K; int nM, nN, nwg, G, c;
    __device__ __forceinline__ void init(const bf16* A_, const bf16* B_, int M, int N, int K_, int G_, int c_) { A = (const char*)A_; B = (const char*)B_; K = K_; nM = M / BM; nN = N / BM; nwg = nM * nN; G = G_; c = c_; }
    __device__ __forceinline__ bool next(int i, Unit& u) const {
        int uidx; if (!split_index((long)i * G + c, nwg, G, uidx, u.roff, u.nai)) return false;
        const int wgid = xcd_remap(uidx, nwg);
        const int nig = WGM * nN, gid = wgid / nig, fm = gid * WGM, gsz = (nM - fm) < WGM ? (nM - fm) : WGM;
        u.pm = fm + ((wgid % nig) % gsz); u.pn = (wgid % nig) / gsz; u.e = 0; u.mt = 0; return true;
    }
    __device__ __forceinline__ const char* a_ptr(const Unit& u) const { return A + (size_t)(u.pm * BM + u.roff) * K * 2; }
    __device__ __forceinline__ const char* b_ptr(const Unit& u) const { return B + (size_t)u.pn * BM * K * 2; }
    __device__ __forceinline__ int tok(const Unit&, int) const { return 0; }
};
struct MoeOrder {
    const char* A; const char* B; int K; size_t bstride;
    const LAS int* tab; const int* list; int RT, nwg, G, c;
    __device__ __forceinline__ bool next(int i, Unit& u) const {
        int uidx; if (!split_index((long)i * G + c, nwg, G, uidx, u.roff, u.nai)) return false;
        const int wgid = xcd_remap(uidx, nwg);
        const int rt = wgid >> 2; u.pm = rt; u.pn = wgid & 3; const int t = tab[rt]; u.e = t & 255; u.mt = t >> 8; return true;
    }
    __device__ __forceinline__ const char* a_ptr(const Unit& u) const { return A + (size_t)(u.pm * BM + u.roff) * K * 2; }
    __device__ __forceinline__ const char* b_ptr(const Unit& u) const { return B + (size_t)u.e * bstride + (size_t)u.pn * BM * K * 2; }
    __device__ __forceinline__ int tok(const Unit& u, int r) const { const int cnt = tab[RT_MAX + 1 + u.e]; const int pos = u.mt * BM + u.roff + r; return pos < cnt ? list[(size_t)u.e * TALL + pos] : 0; }
};

__device__ __forceinline__ unsigned cvt_pk_bf16(float lo, float hi) { unsigned r; asm volatile("v_cvt_pk_bf16_f32 %0, %1, %2" : "=v"(r) : "v"(lo), "v"(hi)); return r; }

template <class Epi, class Sched, bool GATHER>
__device__ __forceinline__ void gemm_phase(LAS unsigned char* lds, const int tid, const int K, const Sched& S, const Epi& E) {
    const int wid = __builtin_amdgcn_readfirstlane(tid >> 6), lane = tid & 63, wr = wid >> 2, wc = wid & 3, fr = lane & 15, fq = lane >> 4;
    const int nt = K / BK;
    unsigned voffA[2], voffB[2]; int RA[2], CA[2];
#pragma unroll
    for (int i = 0; i < 2; ++i) { int R, C; stage_rc(tid * 16 + i * 8192, R, C); const int Rb = Epi::PERM ? ((R & ~31) + perm32(R & 31)) : R;
        RA[i] = R; CA[i] = C; voffA[i] = (unsigned)(R * K + C) * 2u; voffB[i] = (unsigned)(Rb * K + C) * 2u; }
    const size_t kstep = (size_t)(BK * 2);
    const size_t hstep = (size_t)HALF * K * 2;
    const unsigned ldsw = (unsigned)wid * 1024u;
    const int aoff = lds_byte(wr * 64 + fr, fq * 8), boff = lds_byte(wc * 32 + fr, fq * 8);
#define PG8_SA(b, h) (((b) * 2 + (h)) * HTB)
#define PG8_SB(b, h) ((4 + (b) * 2 + (h)) * HTB)
#define PG8_STAGE(bufoff, gbase, voff) do { _Pragma("unroll") for (int _i = 0; _i < 2; ++_i) \
        __builtin_amdgcn_global_load_lds((const unsigned*)((const char*)(gbase) + (voff)[_i]), (LAS unsigned*)(lds + (bufoff) + ldsw + _i * 8192), 16, 0, 0); } while (0)
#define PG8_STAGE_A(bufoff, h, usenext, koff) do { if constexpr (GATHER) { unsigned _vo[2]; _vo[0] = (usenext) ? nvA[h][0] : vA[h][0]; _vo[1] = (usenext) ? nvA[h][1] : vA[h][1]; PG8_STAGE(bufoff, S.A + (koff), _vo); } \
        else { PG8_STAGE(bufoff, ((usenext) ? nA : cA) + (size_t)(h) * hstep + (koff), voffA); } } while (0)
#define PG8_LDA(dst, b, h) do { _Pragma("unroll") for (int m = 0; m < 4; ++m) _Pragma("unroll") for (int k = 0; k < 2; ++k) dst[m][k] = *(const LAS bf16x8*)(lds + PG8_SA(b, h) + aoff + m * 2048 + k * 1024); } while (0)
#define PG8_LDB(dst, b, h) do { _Pragma("unroll") for (int n = 0; n < 2; ++n) _Pragma("unroll") for (int k = 0; k < 2; ++k) dst[n][k] = *(const LAS bf16x8*)(lds + PG8_SB(b, h) + boff + n * 2048 + k * 1024); } while (0)
#define PG8_MMA(ai, bj, At, Bt) do { __builtin_amdgcn_s_setprio(1); _Pragma("unroll") for (int m = 0; m < 4; ++m) _Pragma("unroll") for (int n = 0; n < 2; ++n) _Pragma("unroll") for (int k = 0; k < 2; ++k) \
        acc[ai][bj][m][n] = __builtin_amdgcn_mfma_f32_16x16x32_bf16(Bt[n][k], At[m][k], acc[ai][bj][m][n], 0, 0, 0); __builtin_amdgcn_s_setprio(0); } while (0)
#define PG8_WAIT_V(n) asm volatile("s_waitcnt vmcnt(" #n ")" ::: "memory")
#define PG8_WAIT_L(n) asm volatile("s_waitcnt lgkmcnt(" #n ")" ::: "memory")
#define PG8_BAR __builtin_amdgcn_s_barrier()
#define PG8_SCHED __builtin_amdgcn_sched_barrier(0)
    Unit cur, nxt; int ui = 0;
    if (!S.next(0, cur)) return;
    f32x4 acc[2][2][4][2];
#pragma unroll
    for (int a = 0; a < 2; ++a)
#pragma unroll
        for (int b = 0; b < 2; ++b)
#pragma unroll
            for (int m = 0; m < 4; ++m)
#pragma unroll
                for (int n = 0; n < 2; ++n) acc[a][b][m][n] = (f32x4){0.f, 0.f, 0.f, 0.f};
    bf16x8 At[4][2], B0[2][2], B1[2][2];
    unsigned vA[2][2], nvA[2][2];
    if constexpr (GATHER) {
#pragma unroll
        for (int h = 0; h < 2; ++h)
#pragma unroll
            for (int i = 0; i < 2; ++i) { vA[h][i] = (unsigned)(S.tok(cur, h * HALF + RA[i]) * K + CA[i]) * 2u; nvA[h][i] = vA[h][i]; }
    }
    const char* cA = S.a_ptr(cur); const char* cB = S.b_ptr(cur); const char* nA = cA;
    PG8_STAGE(PG8_SB(0, 0), cB, voffB); PG8_STAGE(PG8_SB(0, 1), cB + hstep, voffB); PG8_STAGE_A(PG8_SA(0, 0), 0, false, 0); PG8_STAGE_A(PG8_SA(0, 1), 1, false, 0);
    if (wr == 1) PG8_BAR;
    PG8_WAIT_V(2); PG8_BAR;
    PG8_STAGE(PG8_SB(1, 0), cB + kstep, voffB); PG8_STAGE_A(PG8_SA(1, 0), 0, false, kstep); PG8_STAGE(PG8_SB(1, 1), cB + hstep + kstep, voffB);
    PG8_WAIT_V(6); PG8_BAR;
    for (;;) {
        const bool has_next = S.next(ui + 1, nxt);
        nA = has_next ? S.a_ptr(nxt) : cA; const char* nB = has_next ? S.b_ptr(nxt) : cB;
        if constexpr (GATHER) {
            if (has_next) {
#pragma unroll
                for (int h = 0; h < 2; ++h)
#pragma unroll
                    for (int i = 0; i < 2; ++i) nvA[h][i] = (unsigned)(S.tok(nxt, h * HALF + RA[i]) * K + CA[i]) * 2u;
            }
        }
        const bool full = (cur.nai == 2);
        for (int t = 0; t < nt; t += 2) {
            const bool last = (t == nt - 2);
            const size_t k1 = (size_t)(t + 1) * kstep;
            const size_t k2 = last ? 0 : (size_t)(t + 2) * kstep, k3 = k2 + kstep;
            const char* b2 = last ? nB : cB + (size_t)(t + 2) * kstep; const char* b3 = b2 + kstep;
            PG8_LDB(B0, 0, 0); PG8_LDB(B1, 0, 1); PG8_SCHED; PG8_LDA(At, 0, 0); PG8_STAGE_A(PG8_SA(1, 1), 1, false, k1);
            PG8_WAIT_V(8); PG8_WAIT_L(0); PG8_BAR; PG8_MMA(0, 0, At, B0); PG8_MMA(0, 1, At, B1); PG8_BAR; PG8_SCHED;
            if (full) PG8_LDA(At, 0, 1); PG8_STAGE(PG8_SB(0, 0), b2, voffB); PG8_STAGE(PG8_SB(0, 1), b2 + hstep, voffB); PG8_STAGE_A(PG8_SA(0, 0), 0, last, k2);
            PG8_WAIT_V(8); PG8_WAIT_L(0); PG8_BAR; if (full) { PG8_MMA(1, 0, At, B0); PG8_MMA(1, 1, At, B1); } PG8_BAR; PG8_SCHED;
            PG8_LDB(B0, 1, 0); PG8_LDB(B1, 1, 1); PG8_SCHED; PG8_LDA(At, 1, 0); PG8_STAGE_A(PG8_SA(0, 1), 1, last, k2);
            PG8_WAIT_V(8); PG8_WAIT_L(0); PG8_BAR; PG8_MMA(0, 0, At, B0); PG8_MMA(0, 1, At, B1); PG8_BAR; PG8_SCHED;
            if (full) PG8_LDA(At, 1, 1); PG8_STAGE(PG8_SB(1, 0), b3, voffB); PG8_STAGE(PG8_SB(1, 1), b3 + hstep, voffB); PG8_STAGE_A(PG8_SA(1, 0), 0, last, k3);
            PG8_WAIT_V(8); PG8_WAIT_L(0); PG8_BAR; if (full) { PG8_MMA(1, 0, At, B0); PG8_MMA(1, 1, At, B1); } PG8_BAR; PG8_SCHED;
        }
        if (wr == 0) PG8_BAR;
        E(acc, cur, wr, wc, fr, fq);
        if (!has_next) break;
#pragma unroll
        for (int a = 0; a < 2; ++a)
#pragma unroll
            for (int b = 0; b < 2; ++b)
#pragma unroll
                for (int m = 0; m < 4; ++m)
#pragma unroll
                    for (int n = 0; n < 2; ++n) acc[a][b][m][n] = (f32x4){0.f, 0.f, 0.f, 0.f};
        cur = nxt; cA = nA; cB = nB; ++ui;
        if constexpr (GATHER) {
#pragma unroll
            for (int h = 0; h < 2; ++h)
#pragma unroll
                for (int i = 0; i < 2; ++i) vA[h][i] = nvA[h][i];
        }
        if (wr == 1) PG8_BAR;
    }
    PG8_WAIT_V(0);
    PG8_BAR;
#undef PG8_SA
#undef PG8_SB
#undef PG8_STAGE
#undef PG8_STAGE_A
#undef PG8_LDA
#undef PG8_LDB
#undef PG8_MMA
#undef PG8_WAIT_V
#undef PG8_WAIT_L
#undef PG8_BAR
#undef PG8_SCHED
}
}

namespace pg8 {
__device__ __forceinline__ void row_bt(int row, int& b, int& tok) { if (row < TX) { b = row >> 11; tok = row & 2047; } else { const int r = row - TX; b = r >> 8; tok = SEQ + (r & 255); } }

struct EpiAttnIn {
    static constexpr bool PERM = true;
    bf16* QKV; bf16* VAT; bf16* VBT; const LAS float* rope;
    __device__ __forceinline__ void operator()(const f32x4 (&acc)[2][2][4][2], const Unit& u, int wr, int wc, int fr, int fq) const {
        const int row0 = u.pm * BM + u.roff + wr * 64 + fr; const int seg = u.pn >> 1;
        const bool latent = u.pm < (TX / BM);
        if (seg == 2 || seg == 5) {
#pragma unroll
            for (int ai = 0; ai < 2; ++ai) if (ai < u.nai)
#pragma unroll
                for (int m = 0; m < 4; ++m) { const int row = row0 + ai * HALF + m * 16; int b, tok; row_bt(row, b, tok);
#pragma unroll
                    for (int bj = 0; bj < 2; ++bj) { const int col = u.pn * BM + bj * HALF + wc * 32 + 8 * fq;
                        bf16* dst;
                        if (seg == 2) { const int cs = col - 1024; dst = VAT + ((size_t)(b * 4 + (cs >> 7)) * 128 + (cs & 127)) * NKEY + tok; }
                        else { const int cs = col - 2560; dst = VBT + ((size_t)(b * 8 + (cs >> 6)) * 64 + (cs & 63)) * NKEY + tok; }
#pragma unroll
                        for (int n = 0; n < 2; ++n)
#pragma unroll
                            for (int i = 0; i < 4; ++i) dst[(size_t)(4 * n + i) * NKEY] = (bf16)f2bf(acc[ai][bj][m][n][i]); } }
            return;
        }
        const bool dorope = latent && seg < 2;
        const float qs = (seg == 0 || seg == 3) ? 0.125f * LOG2E : 1.0f;
#pragma unroll
        for (int ai = 0; ai < 2; ++ai) if (ai < u.nai)
#pragma unroll
            for (int m = 0; m < 4; ++m) { const int row = row0 + ai * HALF + m * 16;
                f32x4 cs4[4];
                if (dorope) { const int t = row & 2047; const int pos = (wc & 1) ? (t & 63) : (t >> 6);
                    const LAS f32x4* rp = (const LAS f32x4*)(rope + (pos * 16 + 8 * (fq & 1)) * 2);
#pragma unroll
                    for (int j = 0; j < 4; ++j) cs4[j] = rp[j]; }
#pragma unroll
                for (int bj = 0; bj < 2; ++bj) { const int col = u.pn * BM + bj * HALF + wc * 32 + 8 * fq;
                    float v[8];
#pragma unroll
                    for (int n = 0; n < 2; ++n)
#pragma unroll
                        for (int i = 0; i < 4; ++i) v[4 * n + i] = acc[ai][bj][m][n][i];
                    if (dorope) {
#pragma unroll
                        for (int j = 0; j < 8; ++j) { const float other = __shfl_xor(v[j], 32); const float c = cs4[j >> 1][(j & 1) * 2], s = cs4[j >> 1][(j & 1) * 2 + 1];
                            v[j] = (fq < 2) ? (v[j] * c - other * s) : (v[j] * c + other * s); } }
                    u32x4 w; w.x = pk2(v[0] * qs, v[1] * qs); w.y = pk2(v[2] * qs, v[3] * qs); w.z = pk2(v[4] * qs, v[5] * qs); w.w = pk2(v[6] * qs, v[7] * qs);
                    *(u32x4*)(QKV + (size_t)row * NATT + col) = w; } }
    }
};
struct EpiGlaIn {
    static constexpr bool PERM = true;
    bf16* QKV2; bf16* VGT;
    __device__ __forceinline__ void operator()(const f32x4 (&acc)[2][2][4][2], const Unit& u, int wr, int wc, int fr, int fq) const {
        const int row0 = u.pm * BM + u.roff + wr * 64 + fr;
        if (u.pn >= 4 && u.pn < 8) {
#pragma unroll
            for (int ai = 0; ai < 2; ++ai) if (ai < u.nai)
#pragma unroll
                for (int m = 0; m < 4; ++m) { const int row = row0 + ai * HALF + m * 16; int b, tok; row_bt(row, b, tok);
#pragma unroll
                    for (int bj = 0; bj < 2; ++bj) { const int cs = u.pn * BM + bj * HALF + wc * 32 + 8 * fq - 1024;
                        bf16* dst = VGT + ((size_t)(b * 4 + (cs >> 8)) * 256 + (cs & 255)) * NKEY + tok;
#pragma unroll
                        for (int n = 0; n < 2; ++n)
#pragma unroll
                            for (int i = 0; i < 4; ++i) dst[(size_t)(4 * n + i) * NKEY] = (bf16)f2bf(acc[ai][bj][m][n][i]); } }
            return;
        }
        const float qs = (u.pn < 2) ? 0.08838834764831845f : 1.0f;
#pragma unroll
        for (int ai = 0; ai < 2; ++ai) if (ai < u.nai)
#pragma unroll
            for (int m = 0; m < 4; ++m) { const int row = row0 + ai * HALF + m * 16;
#pragma unroll
                for (int bj = 0; bj < 2; ++bj) { const int col = u.pn * BM + bj * HALF + wc * 32 + 8 * fq; const f32x4 a = acc[ai][bj][m][0] * qs, c = acc[ai][bj][m][1] * qs;
                    u32x4 w; w.x = pk2(a[0], a[1]); w.y = pk2(a[2], a[3]); w.z = pk2(c[0], c[1]); w.w = pk2(c[2], c[3]);
                    *(u32x4*)(QKV2 + (size_t)row * NGLA + col) = w; } }
    }
};
struct EpiResid {
    static constexpr bool PERM = false;
    const float* IL; const float* IC; float* XL; float* XC; const float* modv;
    __device__ __forceinline__ void operator()(const f32x4 (&acc)[2][2][4][2], const Unit& u, int wr, int wc, int fr, int fq) const {
        const int row0 = u.pm * BM + u.roff + wr * 64 + fr, col0 = u.pn * BM + wc * 32 + 4 * fq;
        const bool latent = u.pm < (TX / BM); const int bi = latent ? (u.pm >> 3) : 8;
        float* base = latent ? XL : (XC - (size_t)TX * D); const float* ibase = latent ? IL : (IC - (size_t)TX * D);
        f32x4 gv[2][2];
#pragma unroll
        for (int bj = 0; bj < 2; ++bj)
#pragma unroll
            for (int n = 0; n < 2; ++n) gv[bj][n] = *(const f32x4*)(modv + bi * 6144 + col0 + bj * HALF + n * 16);
#pragma unroll
        for (int ai = 0; ai < 2; ++ai) if (ai < u.nai)
#pragma unroll
            for (int m = 0; m < 4; ++m) { const size_t ro = (size_t)(row0 + ai * HALF + m * 16) * D + col0;
#pragma unroll
                for (int bj = 0; bj < 2; ++bj)
#pragma unroll
                    for (int n = 0; n < 2; ++n) { const size_t o = ro + bj * HALF + n * 16; *(f32x4*)(base + o) = *(const f32x4*)(ibase + o) + gv[bj][n] * acc[ai][bj][m][n]; } }
    }
};
struct EpiMoe1 {
    static constexpr bool PERM = false;
    bf16* HB;
    __device__ __forceinline__ void operator()(const f32x4 (&acc)[2][2][4][2], const Unit& u, int wr, int wc, int fr, int fq) const {
        const int row0 = u.pm * BM + u.roff + wr * 64 + fr, col0 = u.pn * 128 + wc * 16 + 4 * fq;
#pragma unroll
        for (int ai = 0; ai < 2; ++ai) if (ai < u.nai)
#pragma unroll
            for (int m = 0; m < 4; ++m) { bf16* rowp = HB + (size_t)(row0 + ai * HALF + m * 16) * DEXP + col0;
#pragma unroll
                for (int bj = 0; bj < 2; ++bj) { const f32x4 a = acc[ai][bj][m][0], b = acc[ai][bj][m][1];
                    u32x2 w; w.x = pk2(silu_f(a[0]) * b[0], silu_f(a[1]) * b[1]); w.y = pk2(silu_f(a[2]) * b[2], silu_f(a[3]) * b[3]);
                    *(u32x2*)(rowp + bj * 64) = w; } }
    }
};
struct EpiBf16 {
    static constexpr bool PERM = true;
    bf16* O; int ldc;
    __device__ __forceinline__ void operator()(const f32x4 (&acc)[2][2][4][2], const Unit& u, int wr, int wc, int fr, int fq) const {
        const int row0 = u.pm * BM + u.roff + wr * 64 + fr, col0 = u.pn * BM + wc * 32 + 8 * fq;
#pragma unroll
        for (int ai = 0; ai < 2; ++ai) if (ai < u.nai)
#pragma unroll
            for (int m = 0; m < 4; ++m) { bf16* rowp = O + (size_t)(row0 + ai * HALF + m * 16) * ldc + col0;
#pragma unroll
                for (int bj = 0; bj < 2; ++bj) { const f32x4 a = acc[ai][bj][m][0], c = acc[ai][bj][m][1];
                    u32x4 w; w.x = pk2(a[0], a[1]); w.y = pk2(a[2], a[3]); w.z = pk2(c[0], c[1]); w.w = pk2(c[2], c[3]);
                    *(u32x4*)(rowp + bj * HALF) = w; } }
    }
};
}

struct Args {
    const float *x, *c, *ctx, *c_ctx, *w_mod, *b_mod, *norm_g, *final_g, *att_w_in, *att_w_out, *att_lambda, *att_subln_g, *na_bias,
                *gla_w_in, *gla_w_gate, *gla_b_gate, *gla_norm_g, *gla_w_out, *router_w, *router_bias, *moe_w1, *moe_w3, *moe_w2;
    float* out; unsigned char* ws; int ph_lo, ph_hi, rep, pad;
};

struct RowMapId { int off; __device__ __forceinline__ int operator()(int n) const { return off + n; } };
struct RowMapMoe { int which; __device__ __forceinline__ int operator()(int n) const { return 32 * (n >> 4) + 16 * which + (n & 15); } };
template <class RM>
__device__ __forceinline__ void p0_transpose_item(const float* W, int K, int N, bf16* WT, LAS float* scr, int item, int lane, RM rm) {
    const int nblk = N / 32, kb = item / nblk, nb = item % nblk, k0 = 64 * kb, n0 = 32 * nb;
    float ld[32];
#pragma unroll
    for (int i = 0; i < 32; ++i) ld[i] = W[(size_t)(k0 + 2 * i + (lane >> 5)) * N + n0 + (lane & 31)];
#pragma unroll
    for (int i = 0; i < 32; ++i) scr[(2 * i + (lane >> 5)) * 33 + (lane & 31)] = ld[i];
    LDS_WAIT(); asm volatile("" ::: "memory");
    const int c = lane & 7;
#pragma unroll
    for (int j = 0; j < 4; ++j) { const int n = (lane >> 3) + 8 * j; const LAS float* s = scr + (8 * c) * 33 + n;
        u32x4 o; o.x = pk2(s[0 * 33], s[1 * 33]); o.y = pk2(s[2 * 33], s[3 * 33]); o.z = pk2(s[4 * 33], s[5 * 33]); o.w = pk2(s[6 * 33], s[7 * 33]);
        *(u32x4*)(WT + (size_t)rm(n0 + n) * K + k0 + 8 * c) = o; }
    LDS_WAIT(); asm volatile("" ::: "memory");
}

constexpr int CV_ATTIN = 1536, CV_ATTOUT = 512, CV_GLAIN = 1552, CV_GLAPAD = 28, CV_GLAOUT = 512, CV_W = 4096, CV_MOE = 3 * CV_W;
constexpr int CT_ATTN0 = CV_ATTIN + CV_ATTOUT, CT_MOE0 = CT_ATTN0 + CV_MOE, CT_GLA0 = CT_MOE0 + CV_GLAIN + CV_GLAPAD + CV_GLAOUT, CT_MOE1 = CT_GLA0 + CV_MOE,
              CT_ATTN1 = CT_MOE1 + CV_ATTIN + CV_ATTOUT, CT_MOE2 = CT_ATTN1 + CV_MOE, CT_GLA1 = CT_MOE2 + CV_GLAIN + CV_GLAPAD + CV_GLAOUT, CT_MOE3 = CT_GLA1 + CV_MOE, CV_TOTAL = CT_MOE3;
constexpr int CW_CONV_NEXT = 12288 + 64, CW_CONV_DONE = 12288 + 128, CW_BLKDONE = 12288 + 256;
constexpr int CV_CH = 8;
struct ConvPtrs { const float *att_w_in, *att_w_out, *gla_w_in, *gla_w_out, *moe_w1, *moe_w3, *moe_w2; unsigned char* ws; };
struct RowMapAny { int moe, which; __device__ __forceinline__ int operator()(int n) const { return moe ? 32 * (n >> 4) + 16 * which + (n & 15) : n; } };
__device__ __forceinline__ void conv_item(const ConvPtrs& P, int it, LAS float* scr, int lane) {
    int seg, r;
    if (it < CT_ATTN0) { seg = 0; r = it; } else if (it < CT_MOE0) { seg = 1; r = it - CT_ATTN0; } else if (it < CT_GLA0) { seg = 2; r = it - CT_MOE0; } else if (it < CT_MOE1) { seg = 3; r = it - CT_GLA0; }
    else if (it < CT_ATTN1) { seg = 4; r = it - CT_MOE1; } else if (it < CT_MOE2) { seg = 5; r = it - CT_ATTN1; } else if (it < CT_GLA1) { seg = 6; r = it - CT_MOE2; } else { seg = 7; r = it - CT_GLA1; }
    const float* W; bf16* WT; int K = D, N = D, sub = r; RowMapAny rm{0, 0};
    if (seg & 1) {
        const int L = seg >> 1, which = r / CV_W, q = r % CV_W, e = q >> 8, j = L * 16 + e; sub = q & 255;
        if (which < 2) { W = (which ? P.moe_w3 : P.moe_w1) + (size_t)j * D * DEXP; N = DEXP; WT = (bf16*)(P.ws + WS_W13) + (size_t)j * D * D; rm.moe = 1; rm.which = which; }
        else { W = P.moe_w2 + (size_t)j * DEXP * D; K = DEXP; WT = (bf16*)(P.ws + WS_W2) + (size_t)j * D * DEXP; }
    } else if ((seg & 2) == 0) {
        const int j = seg >> 2;
        if (r < CV_ATTIN) { W = P.att_w_in + (size_t)j * D * NATT; N = NATT; WT = (bf16*)(P.ws + WS_WATTIN) + (size_t)j * NATT * D; }
        else { W = P.att_w_out + (size_t)j * D * D; WT = (bf16*)(P.ws + WS_WATTOUT) + (size_t)j * D * D; sub = r - CV_ATTIN; }
    } else {
        const int j = seg >> 2;
        if (r < CV_GLAIN) { W = P.gla_w_in + (size_t)j * D * 3104; N = 3104; WT = (bf16*)(P.ws + WS_WGLAIN) + (size_t)j * NGLA * D; }
        else if (r < CV_GLAIN + CV_GLAPAD) { const int c0 = (r - CV_GLAIN) * 1024;
            for (int i = lane; i < 1024; i += 64) *(u32x4*)((bf16*)(P.ws + WS_WGLAIN) + (size_t)j * NGLA * D + (size_t)3104 * D + (size_t)(c0 + i) * 8) = (u32x4){0u, 0u, 0u, 0u};
            return; }
        else { W = P.gla_w_out + (size_t)j * D * D; WT = (bf16*)(P.ws + WS_WGLAOUT) + (size_t)j * D * D; sub = r - CV_GLAIN - CV_GLAPAD; }
    }
    p0_transpose_item(W, K, N, WT, scr, sub, lane, rm);
}
__device__ __forceinline__ void conv_until(const ConvPtrs& P, unsigned* ctl, int need, LAS unsigned char* lds, int tid, int lane, int wave, int vcu, int G) {
    LAS float* scr = (LAS float*)(lds + wave * 8448);
    int cur = (int)__hip_atomic_load(ctl + CW_CONV_NEXT, RLX_AGENT); cur = __builtin_amdgcn_readfirstlane(cur); if (cur > CV_TOTAL) cur = CV_TOTAL;
    for (int it = cur + vcu * 8 + wave; it < need; it += G * 8) conv_item(P, it, scr, lane);
    __syncthreads();
    if (vcu == 0 && tid == 0 && cur < need) { __hip_atomic_store(ctl + CW_CONV_NEXT, (unsigned)need, RLX_AGENT); __hip_atomic_store(ctl + CW_CONV_DONE, (unsigned)need, RLX_AGENT); }
}
__device__ __forceinline__ void conv_bubble(const ConvPtrs& P, unsigned* ctl, int pid, int G, LAS unsigned char* lds, int tid, int lane, int wave) {
    __syncthreads();
    if (tid == 0) __hip_atomic_fetch_add(ctl + CW_BLKDONE + 64 * pid, 1u, RLX_AGENT);
    LAS float* scr = (LAS float*)(lds + wave * 8448);
    for (;;) {
        int go = 0; if (lane == 0) go = ((int)__hip_atomic_load(ctl + CW_BLKDONE + 64 * pid, RLX_AGENT) < G) && ((int)__hip_atomic_load(ctl + CW_CONV_NEXT, RLX_AGENT) < CV_TOTAL);
        if (!__builtin_amdgcn_readfirstlane(go)) break;
        int i0 = 0; if (lane == 0) i0 = (int)__hip_atomic_fetch_add(ctl + CW_CONV_NEXT, (unsigned)CV_CH, RLX_AGENT);
        i0 = __builtin_amdgcn_readfirstlane(i0);
        if (i0 >= CV_TOTAL) break;
        const int n = (CV_TOTAL - i0) < CV_CH ? (CV_TOTAL - i0) : CV_CH;
        for (int k = 0; k < n; ++k) conv_item(P, i0 + k, scr, lane);
        VM_WAIT();
        if (lane == 0) __hip_atomic_fetch_add(ctl + CW_CONV_DONE, (unsigned)n, RLX_AGENT);
    }
}

template <class AP> __device__ __forceinline__ void p0_prologue(const AP ap, LAS unsigned char* lds, int tid, int lane, int wave, int vcu, int G) {
    unsigned char* ws = ap->ws;
    LAS float* S9 = (LAS float*)(lds + 69632);
    LAS float* red = (LAS float*)(lds + 106496);
    { const ConvPtrs P{ap->att_w_in, ap->att_w_out, ap->gla_w_in, ap->gla_w_out, ap->moe_w1, ap->moe_w3, ap->moe_w2, ws};
      conv_until(P, (unsigned*)(ws + WS_CTL), CV_TOTAL, lds, tid, lane, wave, vcu, G); }
    __syncthreads();
    { const float* cc = ap->c; const float* cx = ap->c_ctx;
      for (int i = tid; i < 9 * 1024; i += 512) { const int bi = i >> 10, k = i & 1023; const float v = (bi < 8) ? cc[bi * D + k] : cx[k]; S9[i] = v / (1.0f + __expf(-v)); } }
    __syncthreads();
    const float* w_mod = ap->w_mod; const float* b_mod = ap->b_mod;
    for (int u = vcu; u < 4 * 96; u += G) {
        const int L = u / 96, n0 = (u % 96) * 64;
        const float* W = w_mod + (size_t)L * D * 6144 + n0 + lane;
        float acc[9];
#pragma unroll
        for (int bi = 0; bi < 9; ++bi) acc[bi] = 0.f;
        const int kb = wave * 128;
#pragma unroll 8
        for (int k = 0; k < 128; ++k) { const float w = W[(size_t)(kb + k) * 6144];
#pragma unroll
            for (int bi = 0; bi < 9; ++bi) acc[bi] += S9[bi * 1024 + kb + k] * w; }
#pragma unroll
        for (int bi = 0; bi < 9; ++bi) red[(wave * 9 + bi) * 64 + lane] = acc[bi];
        __syncthreads();
        for (int i = tid; i < 9 * 64; i += 512) { const int bi = i >> 6, l = i & 63; float sm = b_mod[L * 6144 + n0 + l];
#pragma unroll
            for (int w = 0; w < 8; ++w) sm += red[(w * 9 + bi) * 64 + l];
            ((float*)(ws + WS_MODV))[(size_t)(L * 9 + bi) * 6144 + n0 + l] = sm; }
        __syncthreads();
    }
}

__device__ __forceinline__ float* xrow_ptr(float* XL, float* XC, int row) { return row < TX ? XL + (size_t)row * D : XC + (size_t)(row - TX) * D; }
__device__ __forceinline__ int row_bi(int row) { return row < TX ? (row >> 11) : 8; }

__device__ __forceinline__ void norm_mod_store(const f32x4 (&v)[4], const float* g, const float* sh, const float* sc, bf16* orow, int lane) {
    float ss = 0.f;
#pragma unroll
    for (int j = 0; j < 4; ++j) ss += (v[j].x * v[j].x + v[j].y * v[j].y) + (v[j].z * v[j].z + v[j].w * v[j].w);
    const float rs = __builtin_amdgcn_rsqf(wave_sum(ss) * (1.0f / D) + EPSF);
#pragma unroll
    for (int j = 0; j < 4; ++j) { const int c = 4 * lane + 256 * j; const f32x4 gg = *(const f32x4*)(g + c), s1 = *(const f32x4*)(sc + c), s0 = *(const f32x4*)(sh + c);
        const f32x4 y = (v[j] * rs) * gg * (1.0f + s1) + s0;
        u32x2 w; w.x = pk2(y.x, y.y); w.y = pk2(y.z, y.w); *(u32x2*)(orow + c) = w; }
}

__device__ __forceinline__ void phase_norm1(const float* XL, const float* XC, const float* g, const float* modv, bf16* H, int nrows, int lane, int wave, int vcu, int G) {
    for (int row = vcu * 8 + wave; row < nrows; row += G * 8) {
        const f32x4* xr = (const f32x4*)(row < TX ? XL + (size_t)row * D : XC + (size_t)(row - TX) * D) + lane; f32x4 v[4];
#pragma unroll
        for (int j = 0; j < 4; ++j) v[j] = xr[64 * j];
        const float* mv = modv + row_bi(row) * 6144;
        norm_mod_store(v, g, mv, mv + 1024, H + (size_t)row * D, lane);
    }
}

__device__ __forceinline__ void phase_router(float* XL, float* XC, const float* g, const float* modv, bf16* H, const float* router_w, const float* router_bias,
                                             unsigned* cnt  , int* list, int* toki, float* tokw, int nrows,
                                             LAS unsigned char* lds, int tid, int lane, int wave, int vcu, int G, int probe) {
    LAS float* RW = (LAS float*)lds;
    LAS int* lcnt = (LAS int*)(lds + 65536);
    LAS int* rinfo = (LAS int*)(lds + 65536 + 256);
    for (int it = 0; it < 8; ++it) { const int idx = tid + 512 * it, k = idx >> 2, q = idx & 3; const f32x4 w = *(const f32x4*)(router_w + k * 16 + 4 * q);
        RW[(4 * q + 0) * 1024 + k] = w.x; RW[(4 * q + 1) * 1024 + k] = w.y; RW[(4 * q + 2) * 1024 + k] = w.z; RW[(4 * q + 3) * 1024 + k] = w.w; }
    if (tid < 32) lcnt[tid] = 0;
    __syncthreads();
    const int rpb = nrows / G, rpw = rpb / 8;
    const int gI = lane >> 4;
    const f32x4 rb = *(const f32x4*)(router_bias + 4 * gI);
    for (int rep = (probe ? 0 : 1); rep < 2; ++rep)
    for (int i0 = 0; i0 < rpw; i0 += 3) {
        asm volatile("" ::: "memory");
        f32x4 y[3][4];
#pragma unroll
        for (int r = 0; r < 3; ++r) {
            const int ii = (i0 + r < rpw) ? i0 + r : rpw - 1; const int row = vcu * rpb + wave * rpw + ii;
            const f32x4* xr = (const f32x4*)xrow_ptr(XL, XC, row) + lane; f32x4 v[4];
#pragma unroll
            for (int j = 0; j < 4; ++j) v[j] = xr[64 * j];
            const float* mv = modv + row_bi(row) * 6144 + 3072;
            float ss = 0.f;
#pragma unroll
            for (int j = 0; j < 4; ++j) ss += (v[j].x * v[j].x + v[j].y * v[j].y) + (v[j].z * v[j].z + v[j].w * v[j].w);
            const float rs = __builtin_amdgcn_rsqf(wave_sum(ss) * (1.0f / D) + EPSF);
#pragma unroll
            for (int j = 0; j < 4; ++j) { const int c = 4 * lane + 256 * j; const f32x4 gg = *(const f32x4*)(g + c), s1 = *(const f32x4*)(mv + 1024 + c), s0 = *(const f32x4*)(mv + c);
                y[r][j] = (v[j] * rs) * gg * (1.0f + s1) + s0;
                u32x2 w; w.x = cvtpk(y[r][j].x, y[r][j].y); w.y = cvtpk(y[r][j].z, y[r][j].w); *(u32x2*)(H + (size_t)row * D + c) = w; }
            __builtin_amdgcn_sched_barrier(0);
        }
        float p[3][16];
#pragma unroll
        for (int e = 0; e < 16; ++e) {
#pragma unroll
            for (int r = 0; r < 3; ++r) p[r][e] = 0.f;
#pragma unroll
            for (int j = 0; j < 4; ++j) { const f32x4 w = *(const LAS f32x4*)(RW + e * 1024 + 4 * lane + 256 * j);
#pragma unroll
                for (int r = 0; r < 3; ++r) p[r][e] += (y[r][j].x * w.x + y[r][j].y * w.y) + (y[r][j].z * w.z + y[r][j].w * w.w); }
#pragma unroll
            for (int r = 0; r < 3; ++r) asm volatile("" : "+v"(p[r][e])); }
#pragma unroll
        for (int r = 0; r < 3; ++r) {
            float q8[8], lg[4];
#pragma unroll
            for (int j = 0; j < 8; ++j) q8[j] = swap32_add(p[r][j], p[r][j + 8]);
#pragma unroll
            for (int j = 0; j < 4; ++j) lg[j] = row_sum(swap16_add(q8[j], q8[j + 4]));
            float sc[4], sel[4];
#pragma unroll
            for (int j = 0; j < 4; ++j) { sc[j] = 1.0f / (1.0f + __expf(-lg[j])); sel[j] = sc[j] + rb[j]; }
            int i1 = 0, i2 = 0; float m1 = -1e30f, m2 = -1e30f, w1 = 0.f, w2 = 0.f;
#pragma unroll
            for (int j = 0; j < 4; ++j) { const float t = sel[j];
                if (t > m1) { m2 = m1; i2 = i1; w2 = w1; m1 = t; i1 = j; w1 = sc[j]; } else if (t > m2) { m2 = t; i2 = j; w2 = sc[j]; } }
            const float gs = m1 + m2;
            const float g0 = readlane_f(gs, 0), g1 = readlane_f(gs, 16), g2 = readlane_f(gs, 32), g3 = readlane_f(gs, 48);
            int bg = 0; float bgs = g0; if (g1 > bgs) { bgs = g1; bg = 1; } if (g2 > bgs) { bgs = g2; bg = 2; } if (g3 > bgs) { bgs = g3; bg = 3; }
            bg = __builtin_amdgcn_readfirstlane(bg);
            const int e0 = 4 * bg + __builtin_amdgcn_readlane(i1, 16 * bg), e1 = 4 * bg + __builtin_amdgcn_readlane(i2, 16 * bg);
            const float w0 = readlane_f(w1, 16 * bg), w1s = readlane_f(w2, 16 * bg);
            const float wn = 1.0f / (w0 + w1s);
            if (lane == 0 && rep == 1 && i0 + r < rpw) { const int rl = wave * rpw + i0 + r;
                const int p0 = __hip_atomic_fetch_add(&lcnt[e0], 1, __ATOMIC_RELAXED, __HIP_MEMORY_SCOPE_WORKGROUP), p1 = __hip_atomic_fetch_add(&lcnt[e1], 1, __ATOMIC_RELAXED, __HIP_MEMORY_SCOPE_WORKGROUP);
                rinfo[rl * 6 + 0] = e0; rinfo[rl * 6 + 1] = p0; rinfo[rl * 6 + 2] = e1; rinfo[rl * 6 + 3] = p1;
                rinfo[rl * 6 + 4] = __builtin_bit_cast(int, w0 * wn); rinfo[rl * 6 + 5] = __builtin_bit_cast(int, w1s * wn); }
        }
    }
    __syncthreads();
    if (tid < 16) lcnt[16 + tid] = (int)__hip_atomic_fetch_add(cnt + 64 * tid, (unsigned)lcnt[tid], RLX_AGENT);
    __syncthreads();
    if (tid < rpb) { const int row = vcu * rpb + tid; const int e0 = rinfo[tid * 6 + 0], e1 = rinfo[tid * 6 + 2];
        const int p0 = lcnt[16 + e0] + rinfo[tid * 6 + 1], p1 = lcnt[16 + e1] + rinfo[tid * 6 + 3];
        list[(size_t)e0 * TALL + p0] = row; list[(size_t)e1 * TALL + p1] = row;
        toki[row * 4 + 0] = e0; toki[row * 4 + 1] = p0; toki[row * 4 + 2] = e1; toki[row * 4 + 3] = p1;
        tokw[row * 2 + 0] = __builtin_bit_cast(float, rinfo[tid * 6 + 4]); tokw[row * 2 + 1] = __builtin_bit_cast(float, rinfo[tid * 6 + 5]); }
    __syncthreads();
}

__device__ __forceinline__ int build_moe_table(const unsigned* cnt, LAS int* tab, int tid) {
    if (tid < 16) tab[RT_MAX + 1 + tid] = (int)__hip_atomic_load(cnt + 64 * tid, RLX_AGENT);
    __syncthreads();
    if (tid == 0) { int rt = 0;
        for (int e = 0; e < 16; ++e) { const int c = tab[RT_MAX + 1 + e]; const int nt = (c + 255) >> 8;
            for (int m = 0; m < nt; ++m) { if (rt < RT_MAX) tab[rt] = e | (m << 8); ++rt; } }
        tab[RT_MAX] = rt < RT_MAX ? rt : RT_MAX; }
    __syncthreads();
    return tab[RT_MAX];
}

__device__ __forceinline__ void phase_combine(float* XL, float* XC, const float* modv  , const bf16* YB, const unsigned* cnt, const int* toki, const float* tokw,
                                              bool final_layer, const float* gnext, const float* modv_next, bf16* H, int nrows, int lane, int wave, int vcu, int G, int probe) {
    int tiles = 0; if (lane < 16) tiles = ((int)__hip_atomic_load(cnt + 64 * lane, RLX_AGENT) + 255) >> 8;
    int incl = tiles;
#pragma unroll
    for (int o = 1; o < 16; o <<= 1) { const int t = __shfl_up(incl, o); if (lane >= o) incl += t; }
    const int mybase = (incl - tiles) * 256;
    for (int rep = (probe ? 0 : 1); rep < 2; ++rep)
    for (int row = vcu * 8 + wave; row < nrows; row += G * 8) {
        const int e0 = toki[row * 4 + 0], p0 = toki[row * 4 + 1], e1 = toki[row * 4 + 2], p1 = toki[row * 4 + 3];
        const float w0 = tokw[row * 2 + 0], w1 = tokw[row * 2 + 1];
        const int s0 = __shfl(mybase, e0) + p0, s1 = __shfl(mybase, e1) + p1;
        float* xp = xrow_ptr(XL, XC, row);
        const float* g2 = modv + row_bi(row) * 6144 + 5120;
        f32x4 v[4];
#pragma unroll
        for (int j = 0; j < 4; ++j) { const int c = 4 * lane + 256 * j;
            const u32x2 a = *(const u32x2*)(YB + (size_t)s0 * D + c), b = *(const u32x2*)(YB + (size_t)s1 * D + c);
            f32x4 y; y.x = w0 * bflo(a.x) + w1 * bflo(b.x); y.y = w0 * bfhi(a.x) + w1 * bfhi(b.x); y.z = w0 * bflo(a.y) + w1 * bflo(b.y); y.w = w0 * bfhi(a.y) + w1 * bfhi(b.y);
            v[j] = *(const f32x4*)(xp + c) + *(const f32x4*)(g2 + c) * y; }
        if (final_layer) {
            float ss = 0.f;
#pragma unroll
            for (int j = 0; j < 4; ++j) ss += (v[j].x * v[j].x + v[j].y * v[j].y) + (v[j].z * v[j].z + v[j].w * v[j].w);
            const float rs = __builtin_amdgcn_rsqf(wave_sum(ss) * (1.0f / D) + EPSF);
#pragma unroll
            for (int j = 0; j < 4; ++j) { const int c = 4 * lane + 256 * j; if (rep == 1) *(f32x4*)(xp + c) = (v[j] * rs) * *(const f32x4*)(gnext + c); }
        } else {
            if (rep == 1) {
#pragma unroll
            for (int j = 0; j < 4; ++j) *(f32x4*)(xp + 4 * lane + 256 * j) = v[j]; }
            const float* mv = modv_next + row_bi(row) * 6144;
            norm_mod_store(v, gnext, mv, mv + 1024, H + (size_t)row * D, lane);
        }
    }
}

__device__ __forceinline__ void phase_readout(const bf16* OF, const bf16* OB, const bf16* QKV2, const float* ng, bf16* AOUT, int nrows, int lane, int wave, int vcu, int G) {
    const f32x4 gg = *(const f32x4*)(ng + 4 * lane);
    for (int row = vcu * 8 + wave; row < nrows; row += G * 8) {
#pragma unroll
        for (int j = 0; j < 4; ++j) { const int c = 4 * lane + 256 * j;
            const u32x2 a = *(const u32x2*)(OF + (size_t)row * D + c), b = *(const u32x2*)(OB + (size_t)row * D + c), gt = *(const u32x2*)(QKV2 + (size_t)row * NGLA + 2048 + c);
            f32x4 o; o.x = bflo(a.x) + bflo(b.x); o.y = bfhi(a.x) + bfhi(b.x); o.z = bflo(a.y) + bflo(b.y); o.w = bfhi(a.y) + bfhi(b.y);
            const float ss = wave_sum((o.x * o.x + o.y * o.y) + (o.z * o.z + o.w * o.w));
            const float rs = __builtin_amdgcn_rsqf(ss * (1.0f / 256.0f) + EPSF);
            f32x4 gv; gv.x = silu_f(bflo(gt.x)); gv.y = silu_f(bfhi(gt.x)); gv.z = silu_f(bflo(gt.y)); gv.w = silu_f(bfhi(gt.y));
            const f32x4 y = (o * rs) * gg * gv;
            u32x2 w; w.x = pk2(y.x, y.y); w.y = pk2(y.z, y.w); *(u32x2*)(AOUT + (size_t)row * D + c) = w; }
    }
}

__device__ __forceinline__ int na_r0(int r) { int v = r - 4; return v < 0 ? 0 : (v > 24 ? 24 : v); }
template <int NMAPS, int DV, bool NA>
__device__ __forceinline__ void attn_unit(LAS unsigned char* lds, int tid, int lane, int wave,
                                          const bf16* QKV, int qcol, int qrow0, int kcol, int krow_lat, int krow_ctx, const bf16* VT, int klo, int khi,
                                          int r_wave, int xq0, const LAS float* biasT,
                                          bf16* AOUT, int ocol, float lam, const float* subg, float outscale) {
    constexpr int KB = 9216;
    constexpr int BUFSZ = NMAPS * KB + DV * 144;
    constexpr int NVB = DV / 16, NVR = DV / 64;
    const int fr = lane & 15, g = lane >> 4;
    bf16x8 qf[NMAPS][2];
    { const bf16* qp = QKV + (size_t)(qrow0 + wave * 16 + fr) * NATT + qcol + 8 * g;
#pragma unroll
      for (int m = 0; m < NMAPS; ++m)
#pragma unroll
          for (int s = 0; s < 2; ++s) qf[m][s] = *(const bf16x8*)(qp + m * 64 + 32 * s); }
    f32x4 O[NMAPS][NVB]; float mrun[NMAPS]; f32x2 lrun[NMAPS];
#pragma unroll
    for (int m = 0; m < NMAPS; ++m) { mrun[m] = -1e30f; lrun[m] = (f32x2){0.f, 0.f};
#pragma unroll
        for (int vb = 0; vb < NVB; ++vb) O[m][vb] = (f32x4){0.f, 0.f, 0.f, 0.f}; }
    const int ntiles = 4 + (khi - klo);
    u32x4 kreg[NMAPS], vreg[NVR];
    const int lkey = tid >> 3, lch = tid & 7;
#define AT_LOAD(i) do { const int _i = (i); const int _rowg = (_i < 4 ? krow_ctx + 64 * _i : krow_lat + 64 * (klo + _i - 4)) + lkey; const int _tok0 = (_i < 4 ? SEQ + 64 * _i : 64 * (klo + _i - 4)); \
        _Pragma("unroll") for (int m = 0; m < NMAPS; ++m) kreg[m] = *(const u32x4*)(QKV + (size_t)_rowg * NATT + kcol + m * 64 + lch * 8); \
        _Pragma("unroll") for (int j = 0; j < NVR; ++j) { const int idx = tid + 512 * j; vreg[j] = *(const u32x4*)(VT + (size_t)(idx >> 3) * NKEY + _tok0 + (idx & 7) * 8); } } while (0)
#define AT_STORE(b) do { LAS unsigned char* _p = lds + (b) * BUFSZ; \
        _Pragma("unroll") for (int m = 0; m < NMAPS; ++m) *(LAS u32x4*)(_p + m * KB + lkey * 144 + lch * 16) = kreg[m]; \
        _Pragma("unroll") for (int j = 0; j < NVR; ++j) { const int idx = tid + 512 * j; *(LAS u32x4*)(_p + NMAPS * KB + (idx >> 3) * 144 + (idx & 7) * 16) = vreg[j]; } } while (0)
    AT_LOAD(0); AT_STORE(0); __syncthreads();
    const int kbase0 = (8 * (fr >> 2) + (fr & 3)) * 144 + 16 * g;
    const int vbase = fr * 144 + 16 * g;
    int r0w = 0, xq = 0, tmask = 3, c0w = 0; float pen[4][4];
    if constexpr (NA) { r0w = na_r0(r_wave); xq = xq0 + fr; int cs = xq - 8; cs = cs < 0 ? 0 : (cs > 48 ? 48 : cs);
        c0w = xq0 - 8; c0w = c0w < 0 ? 0 : (c0w > 32 ? 32 : c0w);
        tmask = 1;
#pragma unroll
        for (int kb = 0; kb < 4; ++kb)
#pragma unroll
            for (int ii = 0; ii < 4; ++ii) { const int y = c0w + 32 * (kb >> 1) + 8 * g + 4 * (kb & 1) + ii; pen[kb][ii] = (y >= cs && y < cs + 16) ? 0.f : -1e30f; } }
    for (int i = 0; i < ntiles; ++i) {
        if (i + 1 < ntiles) AT_LOAD(i + 1);
        const LAS unsigned char* buf = lds + (i & 1) * BUFSZ;
        bool active = true; int kr = 0; bool local = false;
        if constexpr (NA) { if (i >= 4) { local = true; kr = klo + i - 4; active = (kr >= r0w) && (kr < r0w + 8); } }
        if (active) {
            const int tm = local ? tmask : 3;
            const int koffw = local ? c0w * 144 : 0, voffw = local ? c0w * 2 : 0;
            bf16x8 kf[NMAPS][4][2];
#pragma unroll
            for (int m = 0; m < NMAPS; ++m)
#pragma unroll
                for (int kb = 0; kb < 4; ++kb)
#pragma unroll
                    for (int s = 0; s < 2; ++s) kf[m][kb][s] = *(const LAS bf16x8*)(buf + m * KB + kbase0 + koffw + (kb & 1) * (4 * 144) + (kb >> 1) * (32 * 144) + s * 64);
            __builtin_amdgcn_sched_barrier(0);
            f32x4 S[NMAPS][4];
#pragma unroll
            for (int m = 0; m < NMAPS; ++m)
#pragma unroll
                for (int kb = 0; kb < 4; ++kb) { S[m][kb] = (f32x4){0.f, 0.f, 0.f, 0.f};
                    if (!NA || (tm >> (kb >> 1)) & 1) {
#pragma unroll
                        for (int s = 0; s < 2; ++s) S[m][kb] = __builtin_amdgcn_mfma_f32_16x16x32_bf16(kf[m][kb][s], qf[m][s], S[m][kb], 0, 0, 0); } }
            bf16x8 vf0[4][2];
#pragma unroll
            for (int vb = 0; vb < 4; ++vb)
#pragma unroll
                for (int t = 0; t < 2; ++t) vf0[vb][t] = *(const LAS bf16x8*)(buf + NMAPS * KB + vbase + voffw + vb * (16 * 144) + t * 64);
            __builtin_amdgcn_sched_barrier(0);
            bf16x8 pf[NMAPS][2];
#pragma unroll
            for (int m = 0; m < NMAPS; ++m) {
                if constexpr (NA) { if (local) {
                        const LAS float* bp = biasT + (kr - r_wave + 7) * 31 + (c0w + 8 * g - xq + 15);
#pragma unroll
                        for (int kb = 0; kb < 4; ++kb)
#pragma unroll
                            for (int ii = 0; ii < 4; ++ii) { const float t = (tm >> (kb >> 1)) & 1 ? (S[m][kb][ii] + pen[kb][ii]) + bp[32 * (kb >> 1) + 4 * (kb & 1) + ii] : -1e30f; S[m][kb][ii] = t; } } }
                float mx = fmaxf(fmaxf(S[m][0][0], S[m][0][1]), fmaxf(S[m][0][2], S[m][0][3]));
#pragma unroll
                for (int kb = 1; kb < 4; ++kb) mx = fmaxf(fmaxf(mx, S[m][kb][0]), fmaxf(fmaxf(S[m][kb][1], S[m][kb][2]), S[m][kb][3]));
                mx = swap32_max(swap16_max(mx));
                if (__any(mx > mrun[m] + 8.0f)) {
                    const float mnew = fmaxf(mrun[m], mx), alpha = fexp2(mrun[m] - mnew); mrun[m] = mnew; lrun[m] = lrun[m] * alpha;
#pragma unroll
                    for (int vb = 0; vb < NVB; ++vb) O[m][vb] = O[m][vb] * alpha;
                }
                const float mm = mrun[m];
                unsigned pw[8]; float l0 = 0.f, l1 = 0.f;
#pragma unroll
                for (int kb = 0; kb < 4; ++kb) { const float a0 = fexp2(S[m][kb][0] - mm), a1 = fexp2(S[m][kb][1] - mm), a2 = fexp2(S[m][kb][2] - mm), a3 = fexp2(S[m][kb][3] - mm);
                    l0 += a0 + a1; l1 += a2 + a3;
                    pw[2 * kb] = cvtpk(a0, a1); pw[2 * kb + 1] = cvtpk(a2, a3); }
                lrun[m].x += l0; lrun[m].y += l1;
                pf[m][0] = __builtin_bit_cast(bf16x8, (u32x4){pw[0], pw[1], pw[2], pw[3]});
                pf[m][1] = __builtin_bit_cast(bf16x8, (u32x4){pw[4], pw[5], pw[6], pw[7]});
            }
            __builtin_amdgcn_sched_barrier(0);
            if constexpr (NVB == 8) {
                bf16x8 vf1[4][2];
#pragma unroll
                for (int vb = 0; vb < 4; ++vb)
#pragma unroll
                    for (int t = 0; t < 2; ++t) vf1[vb][t] = *(const LAS bf16x8*)(buf + NMAPS * KB + vbase + (4 + vb) * (16 * 144) + t * 64);
                __builtin_amdgcn_sched_barrier(0);
#pragma unroll
                for (int vb = 0; vb < 4; ++vb)
#pragma unroll
                    for (int t = 0; t < 2; ++t)
#pragma unroll
                        for (int m = 0; m < NMAPS; ++m) O[m][vb] = __builtin_amdgcn_mfma_f32_16x16x32_bf16(vf0[vb][t], pf[m][t], O[m][vb], 0, 0, 0);
                __builtin_amdgcn_sched_barrier(0);
#pragma unroll
                for (int vb = 0; vb < 4; ++vb)
#pragma unroll
                    for (int t = 0; t < 2; ++t)
#pragma unroll
                        for (int m = 0; m < NMAPS; ++m) O[m][4 + vb] = __builtin_amdgcn_mfma_f32_16x16x32_bf16(vf1[vb][t], pf[m][t], O[m][4 + vb], 0, 0, 0);
            } else {
#pragma unroll
                for (int vb = 0; vb < 4; ++vb)
#pragma unroll
                    for (int t = 0; t < 2; ++t) { if (!NA || (tm >> t) & 1) {
#pragma unroll
                            for (int m = 0; m < NMAPS; ++m) O[m][vb] = __builtin_amdgcn_mfma_f32_16x16x32_bf16(vf0[vb][t], pf[m][t], O[m][vb], 0, 0, 0); } }
            }
            __builtin_amdgcn_sched_barrier(0);
        }
        if (i + 1 < ntiles) AT_STORE((i + 1) & 1);
        __syncthreads();
    }
#undef AT_LOAD
#undef AT_STORE
    float inv[NMAPS];
#pragma unroll
    for (int m = 0; m < NMAPS; ++m) { float l = lrun[m].x + lrun[m].y; l = swap16_add(l, l); l = swap32_add(l, l); inv[m] = 1.0f / l; }
    const int orow = qrow0 + wave * 16 + fr;
    if constexpr (NMAPS == 2) {
        float ss = 0.f; const float i1 = inv[0], i2 = lam * inv[1];
#pragma unroll
        for (int vb = 0; vb < NVB; ++vb) { O[0][vb] = O[0][vb] * i1 - O[1][vb] * i2; const f32x4 o = O[0][vb]; ss += (o.x * o.x + o.y * o.y) + (o.z * o.z + o.w * o.w); }
        ss = swap16_add(ss, ss); ss = swap32_add(ss, ss);
        const float rs = __builtin_amdgcn_rsqf(ss * (1.0f / DV) + EPSF) * outscale;
#pragma unroll
        for (int vb = 0; vb < NVB; ++vb) { const f32x4 gg = *(const f32x4*)(subg + 16 * vb + 4 * g); const f32x4 y = O[0][vb] * rs * gg;
            u32x2 w; w.x = cvtpk(y.x, y.y); w.y = cvtpk(y.z, y.w); *(u32x2*)(AOUT + (size_t)orow * D + ocol + 16 * vb + 4 * g) = w; }
    } else {
#pragma unroll
        for (int vb = 0; vb < NVB; ++vb) { const f32x4 y = O[0][vb] * inv[0];
            u32x2 w; w.x = cvtpk(y.x, y.y); w.y = cvtpk(y.z, y.w); *(u32x2*)(AOUT + (size_t)orow * D + ocol + 16 * vb + 4 * g) = w; }
    }
}


__device__ __forceinline__ void phase_attention(const bf16* QKV, const bf16* VAT, const bf16* VBT, bf16* AOUT, const float* lamp  , float lam_init, const float* subg, const float* nab  ,
                                                unsigned* naq, LAS unsigned char* lds, int tid, int lane, int wave, int vcu, int G, int repmask) {
    float part = lamp[lane] * lamp[64 + lane]; float part2 = lamp[128 + lane] * lamp[192 + lane];
    const float lam = __expf(wave_sum(part)) - __expf(wave_sum(part2)) + lam_init;
    for (int rep = 0; rep <= ((repmask >> 8) & 1); ++rep)
    for (int u = vcu; u < 576; u += G) {
        int bh, qrow0, khi;
        if (u < 512) { bh = u >> 4; const int qt = u & 15; qrow0 = (bh >> 2) * SEQ + qt * 128; khi = 32; }
        else { const int q = u - 512; bh = q >> 1; const int qt = q & 1; qrow0 = TX + (bh >> 2) * CTXL + qt * 128; khi = 0; }
        const int b = bh >> 2, h = bh & 3;
        attn_unit<2, 128, false>(lds, tid, lane, wave, QKV, h * 128, qrow0, 512 + h * 128, b * SEQ, TX + b * CTXL, VAT + (size_t)bh * 128 * NKEY, 0, khi, 0, 0, nullptr,
                                 AOUT, h * 128, lam, subg, 1.0f - lam_init);
    }
    LAS float* biasT = (LAS float*)(lds + LX_BIAS) + 64;
    for (;;) {
        __syncthreads();
        if (tid == 0) *(LAS int*)(lds + LX_MISC + 64) = (int)__hip_atomic_fetch_add(naq, 1u, RLX_AGENT);
        __syncthreads();
        const int u = *(LAS int*)(lds + LX_MISC + 64);
        if (u >= 1152) break;
        int bh, qrow0, klo, khi, rw;
        if (u < 1024) { bh = u >> 4; const int rp = u & 15; qrow0 = (bh >> 3) * SEQ + rp * 128; klo = na_r0(2 * rp); khi = na_r0(2 * rp + 1) + 8; rw = 2 * rp + (wave >> 2); }
        else { const int q = u - 1024; bh = q >> 1; const int qt = q & 1; qrow0 = TX + (bh >> 3) * CTXL + qt * 128; klo = 0; khi = 0; rw = 0; }
        const int b = bh >> 3, h = bh & 7;
        for (int i = tid; i < 640; i += 512) { const int k = i - 64; biasT[k] = (k >= 0 && k < 465) ? nab[h * 465 + k] * LOG2E : 0.f; }
        attn_unit<1, 64, true>(lds, tid, lane, wave, QKV, 1536 + h * 64, qrow0, 2048 + h * 64, b * SEQ, TX + b * CTXL, VBT + (size_t)bh * 64 * NKEY, klo, khi,
                               rw, 16 * (wave & 3), biasT, AOUT, 512 + h * 64, 0.f, nullptr, 1.0f);
    }
}

__device__ __forceinline__ void gla_chunk_rows(int b, int dir, int n, int& row0, int& tok0) {
    if (n < 4) { const int cc = dir ? 3 - n : n; row0 = TX + b * CTXL + 64 * cc; tok0 = SEQ + 64 * cc; } else { const int lc = dir ? 35 - n : n - 4; row0 = b * SEQ + 64 * lc; tok0 = 64 * lc; }
}
constexpr int GP_QM = 0, GP_KM = 17408, GP_VT = 34816, GP_LR = 71680, GP_SEG = 75776;
__device__ __forceinline__ void phase_gla_prep(const bf16* QKV2, const bf16* VGT, const float* wgate  , const float* bgate  ,
                                               bf16* QG, bf16* KET, float* FACD, bf16* OF, bf16* OB,
                                               LAS unsigned char* lds, int tid, int lane, int wave, int vcu, int G) {
    const int fr = lane & 15, g = lane >> 4;
    const int d = tid & 127, seg = tid >> 7;
    LAS float* LR = (LAS float*)(lds + GP_LR);
    LAS float* SEG = (LAS float*)(lds + GP_SEG);
    for (int ub = vcu * 9; ub < 2304; ub += G * 9) {
        const int q = ub / 36, n0 = ub % 36, dir = q & 1, hh = (q >> 1) & 3, b = q >> 3;
        bf16* OUT = dir ? OB : OF;
        float wg[16];
#pragma unroll
        for (int r = 0; r < 16; ++r) wg[r] = wgate[(dir * 16 + r) * 512 + hh * 128 + d];
        const float bgv = bgate[dir * 512 + hh * 128 + d];
        const bf16* vtb = VGT + (size_t)(b * 4 + hh) * 256 * NKEY;
        u32x4 qr[2], kr[2], vr[4], lr4;
#define GP_LOAD(n) do { int _row0, _tok0; gla_chunk_rows(b, dir, (n), _row0, _tok0); \
        _Pragma("unroll") for (int j = 0; j < 2; ++j) { const int idx = tid + 512 * j, p = idx >> 4, ch = idx & 15; const bf16* src = QKV2 + (size_t)(_row0 + p) * NGLA + hh * 128 + ch * 8; qr[j] = *(const u32x4*)src; kr[j] = *(const u32x4*)(src + 512); } \
        _Pragma("unroll") for (int j = 0; j < 4; ++j) { const int idx = tid + 512 * j; vr[j] = *(const u32x4*)(vtb + (size_t)(idx >> 3) * NKEY + _tok0 + (idx & 7) * 8); } \
        if (tid < 128) lr4 = *(const u32x4*)(QKV2 + (size_t)(_row0 + (tid >> 1)) * NGLA + 3072 + dir * 16 + (tid & 1) * 8); } while (0)
        GP_LOAD(n0);
        for (int k9 = 0; k9 < 9; ++k9) {
            const int n = n0 + k9, u = ub + k9; int row0, tok0; gla_chunk_rows(b, dir, n, row0, tok0);
#pragma unroll
            for (int j = 0; j < 2; ++j) { const int idx = tid + 512 * j, p = idx >> 4, ch = idx & 15;
                *(LAS u32x4*)(lds + GP_QM + p * 272 + ch * 16) = qr[j]; *(LAS u32x4*)(lds + GP_KM + p * 272 + ch * 16) = kr[j]; }
#pragma unroll
            for (int j = 0; j < 4; ++j) { const int idx = tid + 512 * j; *(LAS u32x4*)(lds + GP_VT + (idx >> 3) * 144 + (idx & 7) * 16) = vr[j]; }
            if (tid < 128) { LAS float* lp = LR + (tid >> 1) * 16 + (tid & 1) * 8;
                lp[0] = bflo(lr4.x); lp[1] = bfhi(lr4.x); lp[2] = bflo(lr4.y); lp[3] = bfhi(lr4.y); lp[4] = bflo(lr4.z); lp[5] = bfhi(lr4.z); lp[6] = bflo(lr4.w); lp[7] = bfhi(lr4.w); }
            __syncthreads();
            if (k9 + 1 < 9) GP_LOAD(n + 1);
            float gc[16];
#pragma unroll
            for (int pi = 0; pi < 16; ++pi) { const LAS f32x4* lp = (const LAS f32x4*)(LR + (16 * seg + pi) * 16); float z = bgv;
#pragma unroll
                for (int k = 0; k < 4; ++k) { const f32x4 l4 = lp[k]; z += l4.x * wg[4 * k] + l4.y * wg[4 * k + 1] + l4.z * wg[4 * k + 2] + l4.w * wg[4 * k + 3]; }
                const float az = fabsf(z); gc[pi] = (fminf(z, 0.f) - flog(1.0f + fexp(-az))) * 0.0625f; }
            float run = 0.f;
            if (dir == 0) {
#pragma unroll
                for (int pi = 0; pi < 16; ++pi) { run += gc[pi]; gc[pi] = run; }
            } else {
#pragma unroll
                for (int pi = 15; pi >= 0; --pi) { run += gc[pi]; gc[pi] = run; }
            }
            SEG[seg * 128 + d] = run;
            __syncthreads();
            const float t0 = SEG[d], t1 = SEG[128 + d], t2 = SEG[256 + d], t3 = SEG[384 + d];
            float off, gmid; const float gend = (t0 + t1) + (t2 + t3);
            if (dir == 0) { off = (seg > 0 ? t0 : 0.f) + (seg > 1 ? t1 : 0.f) + (seg > 2 ? t2 : 0.f); gmid = t0 + t1; }
            else { off = (seg < 3 ? t3 : 0.f) + (seg < 2 ? t2 : 0.f) + (seg < 1 ? t1 : 0.f); gmid = t3 + t2; }
            const float emid = fexp(gmid), eend = fexp(gend - gmid);
            unsigned kep[8];
            bf16* qgp = QG + ((size_t)u * 64 + 16 * seg) * 128 + d;
#pragma unroll
            for (int pi = 0; pi < 16; ++pi) { const int p = 16 * seg + pi; const float rel = off + gc[pi] - gmid; const float Ep = fexp(rel), Ei = fexp(-rel);
                LAS bf16* qa = (LAS bf16*)(lds + GP_QM) + p * 136 + d; LAS bf16* ka = (LAS bf16*)(lds + GP_KM) + p * 136 + d;
                const float qv = bf2f(*qa), kv = bf2f(*ka);
                const float qm = qv * Ep, km = kv * Ei;
                const unsigned w1 = cvtpk(qm, qm * emid), w2 = cvtpk(km, km * eend);
                *qa = (bf16)(w1 & 0xffffu); qgp[pi * 128] = (bf16)(w1 >> 16); *ka = (bf16)(w2 & 0xffffu);
                if (pi & 1) kep[pi >> 1] |= (w2 & 0xffff0000u); else kep[pi >> 1] = w2 >> 16; }
            { u32x4* kt = (u32x4*)(KET + ((size_t)u * 128 + d) * 64 + 16 * seg); kt[0] = (u32x4){kep[0], kep[1], kep[2], kep[3]}; kt[1] = (u32x4){kep[4], kep[5], kep[6], kep[7]}; }
            if (seg == 0) FACD[(size_t)u * 128 + d] = fexp(gend);
            __syncthreads();
            { const int cb = wave & 3, half = wave >> 2;
              bf16x8 qfr[4];
#pragma unroll
              for (int ks = 0; ks < 4; ++ks) qfr[ks] = *(const LAS bf16x8*)(lds + GP_QM + (16 * cb + fr) * 272 + (8 * g + 32 * ks) * 2);
              f32x4 AT[4];
#pragma unroll
              for (int sb = 0; sb < 4; ++sb) { AT[sb] = (f32x4){0.f, 0.f, 0.f, 0.f};
#pragma unroll
                  for (int ks = 0; ks < 4; ++ks) { const bf16x8 af = *(const LAS bf16x8*)(lds + GP_KM + (16 * sb + fr) * 272 + (8 * g + 32 * ks) * 2);
                      AT[sb] = __builtin_amdgcn_mfma_f32_16x16x32_bf16(af, qfr[ks], AT[sb], 0, 0, 0); }
                  const int c = 16 * cb + fr;
#pragma unroll
                  for (int ii = 0; ii < 4; ++ii) { const int sp = 16 * sb + 4 * g + ii; const bool keep = dir ? (sp >= c) : (sp <= c); AT[sb][ii] = keep ? AT[sb][ii] : 0.f; } }
              bf16x8 pf[2];
#pragma unroll
              for (int t = 0; t < 2; ++t) { u32x4 w; w.x = pk2(AT[2 * t][0], AT[2 * t][1]); w.y = pk2(AT[2 * t][2], AT[2 * t][3]); w.z = pk2(AT[2 * t + 1][0], AT[2 * t + 1][1]); w.w = pk2(AT[2 * t + 1][2], AT[2 * t + 1][3]);
                  pf[t] = __builtin_bit_cast(bf16x8, w); }
#pragma unroll
              for (int v8 = 0; v8 < 8; ++v8) { const int vb = 8 * half + v8; f32x4 Oa = (f32x4){0.f, 0.f, 0.f, 0.f};
#pragma unroll
                  for (int t = 0; t < 2; ++t) { const LAS unsigned char* vp = lds + GP_VT + (16 * vb + fr) * 144 + (32 * t + 4 * g) * 2;
                      const u32x2 lo = *(const LAS u32x2*)vp, hi = *(const LAS u32x2*)(vp + 32);
                      u32x4 w; w.x = lo.x; w.y = lo.y; w.z = hi.x; w.w = hi.y;
                      Oa = __builtin_amdgcn_mfma_f32_16x16x32_bf16(__builtin_bit_cast(bf16x8, w), pf[t], Oa, 0, 0, 0); }
                  u32x2 w; w.x = pk2(Oa[0], Oa[1]); w.y = pk2(Oa[2], Oa[3]);
                  *(u32x2*)(OUT + (size_t)(row0 + 16 * cb + fr) * D + hh * 256 + 16 * vb + 4 * g) = w; }
            }
            __syncthreads();
        }
#undef GP_LOAD
    }
}

constexpr int GS_BUF = 45056, GS_QG = 0, GS_KET = 17408, GS_VT = 35840, GS_ST = 2 * GS_BUF, GS_DEC = GS_ST + 2 * 17408;
__device__ __forceinline__ void phase_gla(const bf16* VGT, bf16* OF, bf16* OB, const bf16* QG, const bf16* KET, const float* FACD,
                                          LAS unsigned char* lds, int tid, int lane, int wave, int vcu, int G) {
    const int fr = lane & 15, g = lane >> 4;
    for (int u = vcu; u < 256; u += G) {
        const int slab = u & 3, dir = (u >> 2) & 1, hh = (u >> 3) & 3, b = u >> 5;
        bf16* OUT = dir ? OB : OF;
        const int upb = ((b * 4 + hh) * 2 + dir) * 36;
        f32x4 Sacc[4];
#pragma unroll
        for (int vb = 0; vb < 4; ++vb) Sacc[vb] = (f32x4){0.f, 0.f, 0.f, 0.f};
        for (int i = tid; i < 17408 / 4; i += 512) ((LAS unsigned*)(lds + GS_ST))[i] = 0u;
        const bf16* vtb = VGT + ((size_t)(b * 4 + hh) * 256 + slab * 64) * NKEY;
        const int cb = wave & 3, vh = wave >> 2;
        const int ocol = hh * 256 + slab * 64 + 32 * vh + 4 * g;
        struct GsRegs { u32x4 qg[2], ket[2], v; u32x2 oi[2]; float dec; };
        GsRegs R0, R1; R0.dec = 0.f; R1.dec = 0.f;
#define GS_LOAD(R, n) do { int _row0, _tok0; gla_chunk_rows(b, dir, (n), _row0, _tok0); const size_t _u = (size_t)(upb + (n)); \
        _Pragma("unroll") for (int j = 0; j < 2; ++j) { const int idx = tid + 512 * j; R.qg[j] = *(const u32x4*)(QG + _u * 8192 + idx * 8); R.ket[j] = *(const u32x4*)(KET + _u * 8192 + idx * 8); } \
        R.v = *(const u32x4*)(vtb + (size_t)(tid >> 3) * NKEY + _tok0 + (tid & 7) * 8); \
        if (tid < 128) R.dec = FACD[_u * 128 + tid]; \
        _Pragma("unroll") for (int v2 = 0; v2 < 2; ++v2) R.oi[v2] = *(const u32x2*)(OUT + (size_t)(_row0 + 16 * cb + fr) * D + ocol + 16 * v2); } while (0)
#define GS_STORE(R, bf) do { LAS unsigned char* _p = lds + (bf) * GS_BUF; \
        _Pragma("unroll") for (int j = 0; j < 2; ++j) { const int idx = tid + 512 * j; *(LAS u32x4*)(_p + GS_QG + (idx >> 4) * 272 + (idx & 15) * 16) = R.qg[j]; *(LAS u32x4*)(_p + GS_KET + (idx >> 3) * 144 + (idx & 7) * 16) = R.ket[j]; } \
        *(LAS u32x4*)(_p + GS_VT + (tid >> 3) * 144 + (tid & 7) * 16) = R.v; \
        if (tid < 128) ((LAS float*)(lds + GS_DEC))[(bf) * 128 + tid] = R.dec; } while (0)
#define GS_ITER(n, RN, RF) do { const int _n = (n); int row0, tok0; gla_chunk_rows(b, dir, _n, row0, tok0); const int cur = _n & 1; \
            if (_n + 2 < 36) GS_LOAD(RF, _n + 2); \
            const LAS unsigned char* bufp = lds + cur * GS_BUF; const LAS unsigned char* stp = lds + GS_ST + cur * 17408; \
            { bf16x8 qfr[4]; \
              _Pragma("unroll") for (int ks = 0; ks < 4; ++ks) qfr[ks] = *(const LAS bf16x8*)(bufp + GS_QG + (16 * cb + fr) * 272 + (8 * g + 32 * ks) * 2); \
              _Pragma("unroll") for (int v2 = 0; v2 < 2; ++v2) { const int vb = 2 * vh + v2; const u32x2 oin = v2 ? oc1 : oc0; \
                  f32x4 Oa = (f32x4){bflo(oin.x), bfhi(oin.x), bflo(oin.y), bfhi(oin.y)}; \
                  _Pragma("unroll") for (int ks = 0; ks < 4; ++ks) { const bf16x8 af = *(const LAS bf16x8*)(stp + (16 * vb + fr) * 272 + (8 * g + 32 * ks) * 2); \
                      Oa = __builtin_amdgcn_mfma_f32_16x16x32_bf16(af, qfr[ks], Oa, 0, 0, 0); } \
                  u32x2 w; w.x = pk2(Oa[0], Oa[1]); w.y = pk2(Oa[2], Oa[3]); \
                  *(u32x2*)(OUT + (size_t)(row0 + 16 * cb + fr) * D + ocol + 16 * v2) = w; } } \
            { const f32x4 dec = *(const LAS f32x4*)((LAS float*)(lds + GS_DEC) + cur * 128 + 16 * wave + 4 * g); \
              LAS unsigned char* stn = lds + GS_ST + (cur ^ 1) * 17408; \
              _Pragma("unroll") for (int vb = 0; vb < 4; ++vb) { Sacc[vb] = Sacc[vb] * dec; \
                  _Pragma("unroll") for (int t = 0; t < 2; ++t) { const bf16x8 af = *(const LAS bf16x8*)(bufp + GS_KET + (16 * wave + fr) * 144 + (8 * g + 32 * t) * 2); \
                      const bf16x8 bfr = *(const LAS bf16x8*)(bufp + GS_VT + (16 * vb + fr) * 144 + (8 * g + 32 * t) * 2); \
                      Sacc[vb] = __builtin_amdgcn_mfma_f32_16x16x32_bf16(af, bfr, Sacc[vb], 0, 0, 0); } \
                  u32x2 w; w.x = pk2(Sacc[vb][0], Sacc[vb][1]); w.y = pk2(Sacc[vb][2], Sacc[vb][3]); \
                  *(LAS u32x2*)(stn + (16 * vb + fr) * 272 + (16 * wave + 4 * g) * 2) = w; } } \
            if (_n + 1 < 36) { GS_STORE(RN, cur ^ 1); oc0 = RN.oi[0]; oc1 = RN.oi[1]; } \
            __syncthreads(); } while (0)
        GS_LOAD(R0, 0); GS_STORE(R0, 0);
        u32x2 oc0 = R0.oi[0], oc1 = R0.oi[1];
        GS_LOAD(R0, 1);
        __syncthreads();
        for (int n = 0; n < 36; n += 2) { GS_ITER(n, R0, R1); GS_ITER(n + 1, R1, R0); }
#undef GS_ITER
#undef GS_LOAD
#undef GS_STORE
    }
}

constexpr int N_PHASES = 34;
typedef const Args __attribute__((address_space(4)))* KArgs;
__device__ __forceinline__ KArgs kargs() { KArgs p = (KArgs)__builtin_amdgcn_kernarg_segment_ptr(); asm volatile("" : "+s"(p)); return p; }
__global__ void __launch_bounds__(512, 2) fwd(Args a_unused) {
    extern __shared__ __attribute__((aligned(16))) unsigned char lds_raw[];
    LAS unsigned char* lds = (LAS unsigned char*)lds_raw;
    const int tid0 = threadIdx.x;
    const int G0 = gridDim.x; const int bx0 = blockIdx.x;
#define PH_ENTRY int tid = tid0; asm volatile("" : "+v"(tid)); int G = G0, bx = bx0; asm volatile("" : "+s"(G), "+s"(bx)); const int lane = tid & 63, wave = __builtin_amdgcn_readfirstlane(tid >> 6); \
        const int vcu = (G % 8 == 0) ? (bx % 8) * (G / 8) + bx / 8 : bx; (void)lane; (void)wave; (void)vcu
    const int tid = tid0;
    const int ph_lo = kargs()->ph_lo, ph_hi = kargs()->ph_hi;
    const int repmask = kargs()->rep;
    if (tid < 64) ((LAS unsigned*)(lds + LX_MISC))[tid] = 0u;
    for (int i = tid; i < 1024; i += 512) { const int pos = i >> 4, f = i & 15; const float inv = __builtin_amdgcn_exp2f(-(float)f * (13.287712379549449f / 16.0f)); const float ang = (float)pos * inv;
        ((LAS float*)(lds + LX_ROPE))[2 * i] = __cosf(ang); ((LAS float*)(lds + LX_ROPE))[2 * i + 1] = __sinf(ang); }
    __syncthreads();
    const bool single = (ph_hi - ph_lo) > 1;
    XcdBarrier bar; bar.bar = (unsigned*)(kargs()->ws + WS_CTL) + CW_BAR; bar.x = 0; bar.st = (volatile LAS unsigned*)(lds + LX_MISC);
    if (single) bar = xcd_barrier_post((unsigned*)(kargs()->ws + WS_CTL) + CW_BAR, (volatile LAS unsigned*)(lds + LX_MISC));
#define IN(k) (ph_lo <= (k) && (k) < ph_hi)
#define REPLOOP(t) for (int rep_ = 0, nrep_ = 1 + ((repmask >> (t)) & 1); rep_ < nrep_; ++rep_, (rep_ < nrep_ ? (bar.bar = (unsigned*)(kargs()->ws + WS_CTL) + CW_BAR, xcd_barrier(bar)) : (void)0))
#define SEAM(k) do { if (IN(k) && IN((k) + 1)) { bar.bar = (unsigned*)(kargs()->ws + WS_CTL) + CW_BAR; xcd_barrier(bar); if ((repmask >> 10) & 1) xcd_barrier(bar); } } while (0)
    LAS int* tab = (LAS int*)(lds + LX_MOETAB);
#define CONV_PTRS(A) ConvPtrs{(A)->att_w_in, (A)->att_w_out, (A)->gla_w_in, (A)->gla_w_out, (A)->moe_w1, (A)->moe_w3, (A)->moe_w2, (A)->ws}
#define CONV_REQUIRE(need) do { KArgs A_ = kargs(); unsigned* ctl_ = (unsigned*)(A_->ws + WS_CTL); \
        if ((int)__hip_atomic_load(ctl_ + CW_CONV_DONE, RLX_AGENT) < (need)) { { PH_ENTRY; const ConvPtrs P_ = CONV_PTRS(A_); conv_until(P_, ctl_, (need), lds, tid, lane, wave, vcu, G); } \
            bar.bar = ctl_ + CW_BAR; xcd_barrier(bar); } } while (0)
#define CONV_BUBBLE(pid) do { if (!((MK_BUBBLES >> ((pid) & 7)) & 1)) break; KArgs A_ = kargs(); const ConvPtrs P_ = CONV_PTRS(A_); conv_bubble(P_, (unsigned*)(A_->ws + WS_CTL), (pid), G, lds, tid, lane, wave); } while (0)

    if (IN(0)) REPLOOP(0) { PH_ENTRY; p0_prologue(kargs(), lds, tid, lane, wave, vcu, G); } SEAM(0);
    if (IN(1)) { PH_ENTRY; KArgs A = kargs(); unsigned char* ws = A->ws; phase_norm1(A->x, A->ctx, A->norm_g, (float*)(ws + WS_MODV), (bf16*)(ws + WS_H), TALL, lane, wave, vcu, G); } SEAM(1);

#pragma nounroll
    for (int L = 0; L < 4; ++L) {
        const int pb = 2 + 8 * L; const bool isattn = !(L & 1); const int j = L >> 1; const bool lastL = (L == 3);
        const int nrows = lastL ? TX : TALL;
        if (IN(pb) && L > 0) CONV_REQUIRE(L == 1 ? CT_GLA0 : (L == 2 ? CT_ATTN1 : CT_GLA1));
        if (IN(pb)) REPLOOP(isattn ? 1 : 3) {
            PH_ENTRY; KArgs A = kargs(); unsigned char* ws = A->ws; unsigned char* big = ws + WS_BIG; const bf16* H = (const bf16*)(ws + WS_H);
            if (isattn) {
                pg8::DenseOrder S; S.init(H, (const bf16*)(ws + WS_WATTIN) + (size_t)j * NATT * D, TALL, NATT, D, G, bx);
                pg8::EpiAttnIn E{(bf16*)(big + BG_QKV), (bf16*)(big + BG_VAT), (bf16*)(big + BG_VBT), (const LAS float*)(lds + LX_ROPE)};
                pg8::gemm_phase<pg8::EpiAttnIn, pg8::DenseOrder, false>(lds, tid, D, S, E);
                CONV_BUBBLE(L * 8 + 0);
            } else {
                pg8::DenseOrder S; S.init(H, (const bf16*)(ws + WS_WGLAIN) + (size_t)j * NGLA * D, TALL, NGLA, D, G, bx);
                pg8::EpiGlaIn E{(bf16*)(big + BG_QKV2), (bf16*)(big + BG_VGT)};
                pg8::gemm_phase<pg8::EpiGlaIn, pg8::DenseOrder, false>(lds, tid, D, S, E);
                CONV_BUBBLE(L * 8 + 0);
            }
        }
        SEAM(pb);
        if (!isattn && IN(pb + 1)) {
            for (int rep_ = 0; rep_ <= ((repmask >> 13) & 1); ++rep_)
            { PH_ENTRY; KArgs A = kargs(); unsigned char* ws = A->ws;
              phase_gla_prep((const bf16*)(ws + WS_BIG + BG_QKV2), (const bf16*)(ws + WS_BIG + BG_VGT), A->gla_w_gate + j * 2 * 16 * 512, A->gla_b_gate + j * 2 * 512,
                             (bf16*)(ws + WS_QG), (bf16*)(ws + WS_KET), (float*)(ws + WS_BIG + BG_FAC), (bf16*)(ws + WS_BIG + BG_OF), (bf16*)(ws + WS_BIG + BG_OB), lds, tid, lane, wave, vcu, G); }
            if (single) { bar.bar = (unsigned*)(kargs()->ws + WS_CTL) + CW_BAR; xcd_barrier(bar); }
        }
        if (IN(pb + 1)) REPLOOP(isattn ? 2 : 4) {
            PH_ENTRY; KArgs A = kargs(); unsigned char* ws = A->ws; unsigned char* big = ws + WS_BIG; bf16* AOUT = (bf16*)(ws + WS_AOUT);
            if (isattn) { phase_attention((const bf16*)(big + BG_QKV), (const bf16*)(big + BG_VAT), (const bf16*)(big + BG_VBT), AOUT, A->att_lambda + j * 256, (L == 0) ? 0.2f : 0.470713018f,
                                        A->att_subln_g + j * 128, A->na_bias + j * 8 * 465, (unsigned*)(ws + WS_CTL) + CW_NAQ + 64 * j, lds, tid, lane, wave, vcu, G, repmask);
              CONV_BUBBLE(L * 8 + 1); }
            else phase_gla((const bf16*)(big + BG_VGT), (bf16*)(big + BG_OF), (bf16*)(big + BG_OB), (const bf16*)(ws + WS_QG), (const bf16*)(ws + WS_KET), (const float*)(big + BG_FAC),
                           lds, tid, lane, wave, vcu, G);
        }
        SEAM(pb + 1);
        if (!isattn) {
            if (IN(pb + 2)) REPLOOP(5) { PH_ENTRY; KArgs A = kargs(); unsigned char* ws = A->ws; unsigned char* big = ws + WS_BIG;
                phase_readout((const bf16*)(big + BG_OF), (const bf16*)(big + BG_OB), (const bf16*)(big + BG_QKV2), A->gla_norm_g + j * 256, (bf16*)(ws + WS_AOUT), nrows, lane, wave, vcu, G); }
            SEAM(pb + 2);
        }
        if (IN(pb + 3)) {
            PH_ENTRY; KArgs A = kargs(); unsigned char* ws = A->ws;
            pg8::DenseOrder S; S.init((const bf16*)(ws + WS_AOUT), (const bf16*)(ws + (isattn ? WS_WATTOUT : WS_WGLAOUT)) + (size_t)j * D * D, nrows, D, D, G, bx);
            pg8::EpiResid E{L == 0 ? A->x : A->out, L == 0 ? A->ctx : (const float*)(ws + WS_CTX), A->out, (float*)(ws + WS_CTX), (const float*)(ws + WS_MODV) + (size_t)L * 9 * 6144 + 2048};
            pg8::gemm_phase<pg8::EpiResid, pg8::DenseOrder, false>(lds, tid, D, S, E);
            CONV_BUBBLE(L * 8 + 3);
        }
        SEAM(pb + 3);
        if (IN(pb + 4)) { PH_ENTRY; KArgs A = kargs(); unsigned char* ws = A->ws;
            phase_router(A->out, (float*)(ws + WS_CTX), A->norm_g + (L * 2 + 1) * D, (const float*)(ws + WS_MODV) + (size_t)L * 9 * 6144, (bf16*)(ws + WS_H), A->router_w, A->router_bias,
                         (unsigned*)(ws + WS_CTL) + CW_CNT + L * 16 * 64, (int*)(ws + WS_LIST), (int*)(ws + WS_TOKI), (float*)(ws + WS_TOKW), nrows, lds, tid, lane, wave, vcu, G, (repmask >> 11) & 1); }
        SEAM(pb + 4);
        if (IN(pb + 5)) CONV_REQUIRE(L == 0 ? CT_MOE0 : (L == 1 ? CT_MOE1 : (L == 2 ? CT_MOE2 : CT_MOE3)));
        if (IN(pb + 5)) REPLOOP(6) {
            PH_ENTRY; KArgs A = kargs(); unsigned char* ws = A->ws;
            const int RT = build_moe_table((unsigned*)(ws + WS_CTL) + CW_CNT + L * 16 * 64, tab, tid);
            pg8::MoeOrder S; S.A = (const char*)(ws + WS_H); S.B = (const char*)(ws + WS_W13) + (size_t)L * 16 * D * D * 2; S.K = D; S.bstride = (size_t)D * D * 2; S.tab = tab; S.list = (const int*)(ws + WS_LIST); S.RT = RT; S.nwg = RT * 4; S.G = G; S.c = bx;
            pg8::EpiMoe1 E{(bf16*)(ws + WS_BIG + BG_HB)};
            pg8::gemm_phase<pg8::EpiMoe1, pg8::MoeOrder, true>(lds, tid, D, S, E);
            CONV_BUBBLE(L * 8 + 5);
        }
        SEAM(pb + 5);
        if (IN(pb + 6)) REPLOOP(7) {
            PH_ENTRY; KArgs A = kargs(); unsigned char* ws = A->ws;
            const int RT = build_moe_table((unsigned*)(ws + WS_CTL) + CW_CNT + L * 16 * 64, tab, tid);
            pg8::MoeOrder S; S.A = (const char*)(ws + WS_BIG + BG_HB); S.B = (const char*)(ws + WS_W2) + (size_t)L * 16 * D * DEXP * 2; S.K = DEXP; S.bstride = (size_t)D * DEXP * 2; S.tab = tab; S.list = (const int*)(ws + WS_LIST); S.RT = RT; S.nwg = RT * 4; S.G = G; S.c = bx;
            pg8::EpiBf16 E{(bf16*)(ws + WS_BIG + BG_YB), D};
            pg8::gemm_phase<pg8::EpiBf16, pg8::MoeOrder, false>(lds, tid, DEXP, S, E);
            CONV_BUBBLE(L * 8 + 6);
        }
        SEAM(pb + 6);
        if (IN(pb + 7)) { PH_ENTRY; KArgs A = kargs(); unsigned char* ws = A->ws; const float* MODV = (const float*)(ws + WS_MODV);
            phase_combine(A->out, (float*)(ws + WS_CTX), MODV + (size_t)L * 9 * 6144, (const bf16*)(ws + WS_BIG + BG_YB), (unsigned*)(ws + WS_CTL) + CW_CNT + L * 16 * 64, (const int*)(ws + WS_TOKI), (const float*)(ws + WS_TOKW),
                          lastL, lastL ? A->final_g : A->norm_g + ((L + 1) * 2) * D, MODV + (size_t)(lastL ? L : L + 1) * 9 * 6144, (bf16*)(ws + WS_H), nrows, lane, wave, vcu, G, (repmask >> 12) & 1); }
        if (!lastL) SEAM(pb + 7);
    }
#undef IN
#undef REPLOOP
#undef SEAM
#undef CONV_PTRS
#undef CONV_REQUIRE
#undef CONV_BUBBLE
#undef PH_ENTRY
}

extern "C" void kernel_launch(void* const* d_in, const int* in_sizes, int n_in, void* d_out, int out_size, void* d_ws, size_t ws_size, hipStream_t stream) {
    static int ready = 0;
    if (ready == 0) {
        if (n_in != 23 || out_size != TX * D || ws_size < WS_END) { fprintf(stderr, "kernel_launch: unexpected shapes (n_in %d out %d ws %zu)\n", n_in, out_size, ws_size); ready = -1; return; }
        if (hipFuncSetAttribute((const void*)fwd, hipFuncAttributeMaxDynamicSharedMemorySize, LDS_BYTES) != hipSuccess) { fprintf(stderr, "kernel_launch: hipFuncSetAttribute failed\n"); ready = -1; return; }
        int per_cu = 0; (void)hipOccupancyMaxActiveBlocksPerMultiprocessor(&per_cu, (const void*)fwd, 512, LDS_BYTES); (void)hipGetLastError();
        if (per_cu < 1) fprintf(stderr, "kernel_launch: occupancy query reports %d blocks per CU\n", per_cu);
        ready = 1;
    }
    if (ready < 0) return;
    (void)hipMemsetAsync((char*)d_ws + WS_CTL, 0, CTL_ZERO_BYTES, stream);
    Args a{};
    const float** ap = (const float**)&a;
    for (int i = 0; i < 23; ++i) ap[i] = (const float*)d_in[i];
    a.out = (float*)d_out; a.ws = (unsigned char*)d_ws;
    const int grid = 256;
    a.ph_lo = 0; a.ph_hi = N_PHASES; a.rep = MK_REPMASK;
    hipLaunchKernelGGL(fwd, dim3(grid), dim3(512), LDS_BYTES, stream, a);
}
```

```cpp
#include <hip/hip_runtime.h>
#include <cstdio>
#include <cstdint>

#ifndef MK_CONVQ
#define MK_CONVQ 1
#endif
#ifndef MK_REPMASK
#define MK_REPMASK 0
#endif

#define GAS __attribute__((address_space(1)))
#define LAS __attribute__((address_space(3)))
typedef unsigned short bf16;
typedef short bf16x8 __attribute__((ext_vector_type(8)));
typedef short bf16x4 __attribute__((ext_vector_type(4)));
typedef float f32x4 __attribute__((ext_vector_type(4)));
typedef float f32x2 __attribute__((ext_vector_type(2)));
typedef unsigned u32x4 __attribute__((ext_vector_type(4)));
typedef unsigned u32x2 __attribute__((ext_vector_type(2)));

constexpr int D = 1024, NB = 8, SEQ = 2048, CTXL = 256;
constexpr int TX = NB * SEQ, TC = NB * CTXL, TALL = TX + TC;
constexpr int NKEY = SEQ + CTXL;
constexpr int NATT = 3072, NGLA = 3328;
constexpr float EPSF = 1e-6f;
constexpr float LOG2E = 1.4426950408889634f;
constexpr int NEXP = 16, DEXP = 512;
constexpr int RT_MAX = 160;

constexpr size_t MiB = 1u << 20;
constexpr size_t WS_CTL = 0, CTL_ZERO_BYTES = 1 * MiB;
constexpr size_t WS_MODV = 1 * MiB;
constexpr size_t WS_TOKI = 2 * MiB;
constexpr size_t WS_TOKW = 2 * MiB + 512 * 1024;
constexpr size_t WS_LIST = 3 * MiB;
constexpr size_t WS_CTX = 5 * MiB;
constexpr size_t WS_WATTIN = 13 * MiB;
constexpr size_t WS_WATTOUT = 25 * MiB;
constexpr size_t WS_WGLAIN = 29 * MiB;
constexpr size_t WS_WGLAOUT = 42 * MiB;
constexpr size_t WS_W13 = 46 * MiB;
constexpr size_t WS_W2 = 174 * MiB;
constexpr size_t WS_H = 238 * MiB;
constexpr size_t WS_AOUT = 274 * MiB;
constexpr size_t WS_BIG = 310 * MiB;
constexpr size_t WS_END = 539 * MiB;
constexpr size_t BG_QKV = 0;
constexpr size_t BG_VAT = 108 * MiB;
constexpr size_t BG_VBT = 126 * MiB;
constexpr size_t BG_QKV2 = 0;
constexpr size_t BG_VGT = 117 * MiB;
constexpr size_t BG_OF = 153 * MiB;
constexpr size_t BG_OB = 189 * MiB;
constexpr size_t BG_FAC = 225 * MiB;
constexpr size_t WS_QG = WS_H, WS_KET = WS_AOUT;
constexpr size_t BG_HB = 0;
constexpr size_t BG_YB = 40 * MiB;
constexpr int CW_TMO = 0;
constexpr int CW_BAR = 4096;
constexpr int CW_NAQ = 15360;
constexpr int CW_CNT = 8192;

constexpr int RING_BYTES = 131072;
constexpr int LX_OFF = RING_BYTES;
constexpr int LX_MISC = LX_OFF;
constexpr int LX_MOETAB = LX_OFF + 256;
constexpr int LX_ROPE = LX_OFF + 2048;
constexpr int LX_BIAS = LX_OFF + 2048 + 8192;
constexpr int LDS_BYTES = 147456;

#define LDS_WAIT() asm volatile("s_waitcnt lgkmcnt(0)" ::: "memory")
#define VM_WAIT() asm volatile("s_waitcnt vmcnt(0)" ::: "memory")
#define RLX_AGENT __ATOMIC_RELAXED, __HIP_MEMORY_SCOPE_AGENT
__device__ __forceinline__ unsigned f2bf(float f) { unsigned u = __builtin_bit_cast(unsigned, f); return (u + 0x7fffu + ((u >> 16) & 1u)) >> 16; }
typedef __bf16 hwbf16x2 __attribute__((ext_vector_type(2)));
__device__ __forceinline__ unsigned cvtpk(float lo, float hi) { const f32x2 v = {lo, hi}; const hwbf16x2 b = __builtin_convertvector(v, hwbf16x2); return __builtin_bit_cast(unsigned, b); }
__device__ __forceinline__ unsigned pk2(float lo, float hi) { return cvtpk(lo, hi); }
__device__ __forceinline__ float bf2f(unsigned short b) { return __builtin_bit_cast(float, ((unsigned)b) << 16); }
__device__ __forceinline__ float bflo(unsigned w) { return __builtin_bit_cast(float, w << 16); }
__device__ __forceinline__ float bfhi(unsigned w) { return __builtin_bit_cast(float, w & 0xffff0000u); }
template <int CTRL> __device__ __forceinline__ float dppf(float v) { return __builtin_bit_cast(float, __builtin_amdgcn_update_dpp(0, __builtin_bit_cast(int, v), CTRL, 0xf, 0xf, true)); }
__device__ __forceinline__ float row_sum(float v) { v += dppf<0xB1>(v); v += dppf<0x4E>(v); v += dppf<0x124>(v); v += dppf<0x128>(v); return v; }
__device__ __forceinline__ float swap16_add(float a, float b) { auto r = __builtin_amdgcn_permlane16_swap(__float_as_uint(a), __float_as_uint(b), false, false); const unsigned r0 = r[0], r1 = r[1]; return __uint_as_float(r0) + __uint_as_float(r1); }
__device__ __forceinline__ float swap32_add(float a, float b) { auto r = __builtin_amdgcn_permlane32_swap(__float_as_uint(a), __float_as_uint(b), false, false); const unsigned r0 = r[0], r1 = r[1]; return __uint_as_float(r0) + __uint_as_float(r1); }
__device__ __forceinline__ float swap16_max(float a) { auto r = __builtin_amdgcn_permlane16_swap(__float_as_uint(a), __float_as_uint(a), false, false); const unsigned r0 = r[0], r1 = r[1]; return fmaxf(__uint_as_float(r0), __uint_as_float(r1)); }
__device__ __forceinline__ float swap32_max(float a) { auto r = __builtin_amdgcn_permlane32_swap(__float_as_uint(a), __float_as_uint(a), false, false); const unsigned r0 = r[0], r1 = r[1]; return fmaxf(__uint_as_float(r0), __uint_as_float(r1)); }
__device__ __forceinline__ float readlane_f(float v, int l) { return __int_as_float(__builtin_amdgcn_readlane(__float_as_int(v), l)); }
__device__ __forceinline__ float wave_sum(float v) { v = row_sum(v); v = swap16_add(v, v); return swap32_add(v, v); }
__device__ __forceinline__ float fexp2(float x) { return __builtin_amdgcn_exp2f(x); }
__device__ __forceinline__ float fexp(float x) { return __builtin_amdgcn_exp2f(x * LOG2E); }
__device__ __forceinline__ float flog(float x) { return __builtin_amdgcn_logf(x) * 0.6931471805599453f; }
__device__ __forceinline__ float frcp(float x) { return __builtin_amdgcn_rcpf(x); }
__device__ __forceinline__ float silu_f(float x) { return x * frcp(1.0f + fexp(-x)); }

#define XB_TMO      128
#define XB_XCNT(j)  (256  + 64 * (j))
#define XB_XSUB(j)  (1280 + 64 * (j))
#define XB_XGEN(j)  (2304 + 64 * (j))
#define XB_TOP      3328
#define XB_TOPGEN   3392
#define XCD_BAR_WORDS 3456
#define XB_SPIN_CAP (1u << 18)
__device__ __forceinline__ unsigned xb_ld(unsigned* p)              { return __hip_atomic_load(p, __ATOMIC_RELAXED, __HIP_MEMORY_SCOPE_AGENT); }
__device__ __forceinline__ unsigned xb_add(unsigned* p, unsigned v) { return __hip_atomic_fetch_add(p, v, __ATOMIC_RELAXED, __HIP_MEMORY_SCOPE_AGENT); }
__device__ __forceinline__ unsigned xb_xcc_id() { return (unsigned)__builtin_amdgcn_s_getreg((3 << 11) | 20) & 0xFu; }
#define XB_SPIN(cond, bar) do { unsigned _sp = 0; while (cond) { __builtin_amdgcn_s_sleep(1); \
    if ((++_sp & 255u) == 0u) { if (xb_ld(&(bar)[XB_TMO])) break; if (_sp > XB_SPIN_CAP) { atomicAdd(&(bar)[XB_TMO], 1u); break; } } } } while (0)
struct XcdBarrier { unsigned* bar; unsigned x; volatile LAS unsigned* st; };
__device__ __forceinline__ XcdBarrier xcd_barrier_post(unsigned* bar, volatile LAS unsigned* st) {
    XcdBarrier b; b.bar = bar; b.x = xb_xcc_id(); b.st = st;
    if (threadIdx.x == 0) (void)xb_add(&bar[XB_XCNT(b.x)], 1u);
    return b;
}
__device__ __forceinline__ void xcd_barrier_complete(unsigned* bar, unsigned x, unsigned& nloc, unsigned& nx) {
    const unsigned G = gridDim.x * gridDim.y * gridDim.z;
    unsigned sum, cnt, mine, sp = 0u;
    for (;;) {
        sum = 0u; cnt = 0u; mine = 0u;
#pragma unroll
        for (unsigned j = 0; j < 16; ++j) { const unsigned c = xb_ld(&bar[XB_XCNT(j)]); sum += c; cnt += (c > 0u) ? 1u : 0u; mine = (j == x) ? c : mine; }
        if (sum == G) break;
        __builtin_amdgcn_s_sleep(1);
        if ((++sp & 255u) == 0u) { if (xb_ld(&bar[XB_TMO])) break; if (sp > XB_SPIN_CAP) { atomicAdd(&bar[XB_TMO], 1u); break; } }
    }
    nloc = mine > 0u ? mine : 1u; nx = cnt > 0u ? cnt : 1u;
}
__device__ __forceinline__ void xcd_barrier(const XcdBarrier& b) {
    asm volatile("s_waitcnt vmcnt(0)" ::: "memory");
    __syncthreads();
    if (threadIdx.x == 0) {
        unsigned* bar = b.bar;
        __builtin_amdgcn_s_waitcnt(0);
        unsigned nloc = b.st[0], nx = b.st[1];
        if (nloc == 0u) { xcd_barrier_complete(bar, b.x, nloc, nx); b.st[0] = nloc; b.st[1] = nx; }
        const unsigned old = xb_add(&bar[XB_XSUB(b.x)], 1u);
        const unsigned gen = old / nloc;
        if (old + 1u == (gen + 1u) * nloc) {
            __builtin_amdgcn_fence(__ATOMIC_RELEASE, "agent");
            asm volatile("s_waitcnt vmcnt(0)" ::: "memory");
            const unsigned og = xb_add(&bar[XB_TOP], 1u);
            const unsigned tg = og / nx;
            if (og + 1u == (tg + 1u) * nx) xb_add(&bar[XB_TOPGEN], 1u);
            else XB_SPIN(xb_ld(&bar[XB_TOPGEN]) == tg, bar);
            __builtin_amdgcn_fence(__ATOMIC_ACQUIRE, "agent");
            xb_add(&bar[XB_XGEN(b.x)], 1u);
            asm volatile("s_waitcnt vmcnt(0)" ::: "memory");
        } else {
            XB_SPIN(xb_ld(&bar[XB_XGEN(b.x)]) == gen, bar);
            __builtin_amdgcn_fence(__ATOMIC_ACQUIRE, "agent");
            asm volatile("s_waitcnt vmcnt(0)" ::: "memory");
        }
    }
    __syncthreads();
}

namespace pg8 {
constexpr int BM = 256, BK = 64, HALF = 128, HTB = HALF * BK * 2, STAGE_BYTES = 8 * HTB, NXCD = 8, WGM = 8;
__host__ __device__ __forceinline__ int lds_byte(int r, int c) { const int st = (r >> 4) * 2 + (c >> 5), rr = r & 15, cc = c & 31, ob = rr * 64 + cc * 2; return st * 1024 + (ob ^ (((ob >> 9) & 1) << 5)); }
__host__ __device__ __forceinline__ void stage_rc(int b, int& R, int& C) { const int st = b / 1024, sb = b % 1024, swz = sb ^ (((sb >> 9) & 1) << 5); R = (st >> 1) * 16 + swz / 64; C = (st & 1) * 32 + (swz % 64) / 2; }
__host__ __device__ __forceinline__ int perm32(int rho) { const int n = rho >> 4, i = rho & 15; return 8 * (i >> 2) + 4 * n + (i & 3); }

struct Unit { int pm, pn, e, mt, roff, nai; };
__device__ __forceinline__ bool split_index(long L, int nwg, int G, int& uidx, int& roff, int& nai) {
    const int R = nwg / G, r = nwg % G; const bool split = (r > 0) && (2 * r <= G);
    if (L < (long)R * G || !split) { if (L >= nwg) return false; uidx = (int)L; roff = 0; nai = 2; return true; }
    const int h = (int)(L - (long)R * G); if (h >= 2 * r) return false; uidx = R * G + (h >> 1); roff = (h & 1) * 128; nai = 1; return true;
}

__device__ __forceinline__ int xcd_remap(int wgid, int nwg) { const int q = nwg / NXCD, r = nwg % NXCD, xcd = wgid % NXCD, off = wgid / NXCD; return (xcd < r ? xcd * (q + 1) : r * (q + 1) + (xcd - r) * q) + off; }

struct DenseOrder {
    const char* A; const char* B; int K; int nM, nN, nwg, G, c;
    __device__ __forceinline__ void init(const bf16* A_, const bf16* B_, int M, int N, int K_, int G_, int c_) { A = (const char*)A_; B = (const char*)B_; K = K_; nM = M / BM; nN = N / BM; nwg = nM * nN; G = G_; c = c_; }
    __device__ __forceinline__ bool next(int i, Unit& u) const {
        int uidx; if (!split_index((long)i * G + c, nwg, G, uidx, u.roff, u.nai)) return false;
        const int wgid = xcd_remap(uidx, nwg);
        const int nig = WGM * nN, gid = wgid / nig, fm = gid * WGM, gsz = (nM - fm) < WGM ? (nM - fm) : WGM;
        u.pm = fm + ((wgid % nig) % gsz); u.pn = (wgid % nig) / gsz; u.e = 0; u.mt = 0; return true;
    }
    __device__ __forceinline__ const char* a_ptr(const Unit& u) const { return A + (size_t)(u.pm * BM + u.roff) * K * 2; }
    __device__ __forceinline__ const char* b_ptr(const Unit& u) const { return B + (size_t)u.pn * BM * K * 2; }
    __device__ __forceinline__ int tok(const Unit&, int) const { return 0; }
};
struct MoeOrder {
    const char* A; const char* B; int K; size_t bstride;
    const LAS int* tab; const int* list; int RT, nwg, G, c;
    __device__ __forceinline__ bool next(int i, Unit& u) const {
        int uidx; if (!split_index((long)i * G + c, nwg, G, uidx, u.roff, u.nai)) return false;
        const int wgid = xcd_remap(uidx, nwg);
        const int rt = wgid >> 2; u.pm = rt; u.pn = wgid & 3; const int t = tab[rt]; u.e = t & 255; u.mt = t >> 8; return true;
    }
    __device__ __forceinline__ const char* a_ptr(const Unit& u) const { return A + (size_t)(u.pm * BM + u.roff) * K * 2; }
    __device__ __forceinline__ const char* b_ptr(const Unit& u) const { return B + (size_t)u.e * bstride + (size_t)u.pn * BM * K * 2; }
    __device__ __forceinline__ int tok(const Unit& u, int r) const { const int cnt = tab[RT_MAX + 1 + u.e]; const int pos = u.mt * BM + u.roff + r; return pos < cnt ? list[(size_t)u.e * TALL + pos] : 0; }
};

__device__ __forceinline__ unsigned cvt_pk_bf16(float lo, float hi) { unsigned r; asm volatile("v_cvt_pk_bf16_f32 %0, %1, %2" : "=v"(r) : "v"(lo), "v"(hi)); return r; }

template <class Epi, class Sched, bool GATHER>
__device__ __forceinline__ void gemm_phase(LAS unsigned char* lds, const int tid, const int K, const Sched& S, const Epi& E) {
    const int wid = __builtin_amdgcn_readfirstlane(tid >> 6), lane = tid & 63, wr = wid >> 2, wc = wid & 3, fr = lane & 15, fq = lane >> 4;
    const int nt = K / BK;
    unsigned voffA[2], voffB[2]; int RA[2], CA[2];
#pragma unroll
    for (int i = 0; i < 2; ++i) { int R, C; stage_rc(tid * 16 + i * 8192, R, C); const int Rb = Epi::PERM ? ((R & ~31) + perm32(R & 31)) : R;
        RA[i] = R; CA[i] = C; voffA[i] = (unsigned)(R * K + C) * 2u; voffB[i] = (unsigned)(Rb * K + C) * 2u; }
    const size_t kstep = (size_t)(BK * 2);
    const size_t hstep = (size_t)HALF * K * 2;
    const unsigned ldsw = (unsigned)wid * 1024u;
    const int aoff = lds_byte(wr * 64 + fr, fq * 8), boff = lds_byte(wc * 32 + fr, fq * 8);
#define PG8_SA(b, h) (((b) * 2 + (h)) * HTB)
#define PG8_SB(b, h) ((4 + (b) * 2 + (h)) * HTB)
#define PG8_STAGE(bufoff, gbase, voff) do { _Pragma("unroll") for (int _i = 0; _i < 2; ++_i) \
        __builtin_amdgcn_global_load_lds((const unsigned*)((const char*)(gbase) + (voff)[_i]), (LAS unsigned*)(lds + (bufoff) + ldsw + _i * 8192), 16, 0, 0); } while (0)
#define PG8_STAGE_A(bufoff, h, usenext, koff) do { if constexpr (GATHER) { unsigned _vo[2]; _vo[0] = (usenext) ? nvA[h][0] : vA[h][0]; _vo[1] = (usenext) ? nvA[h][1] : vA[h][1]; PG8_STAGE(bufoff, S.A + (koff), _vo); } \
        else { PG8_STAGE(bufoff, ((usenext) ? nA : cA) + (size_t)(h) * hstep + (koff), voffA); } } while (0)
#define PG8_LDA(dst, b, h) do { _Pragma("unroll") for (int m = 0; m < 4; ++m) _Pragma("unroll") for (int k = 0; k < 2; ++k) dst[m][k] = *(const LAS bf16x8*)(lds + PG8_SA(b, h) + aoff + m * 2048 + k * 1024); } while (0)
#define PG8_LDB(dst, b, h) do { _Pragma("unroll") for (int n = 0; n < 2; ++n) _Pragma("unroll") for (int k = 0; k < 2; ++k) dst[n][k] = *(const LAS bf16x8*)(lds + PG8_SB(b, h) + boff + n * 2048 + k * 1024); } while (0)
#define PG8_MMA(ai, bj, At, Bt) do { __builtin_amdgcn_s_setprio(1); _Pragma("unroll") for (int m = 0; m < 4; ++m) _Pragma("unroll") for (int n = 0; n < 2; ++n) _Pragma("unroll") for (int k = 0; k < 2; ++k) \
        acc[ai][bj][m][n] = __builtin_amdgcn_mfma_f32_16x16x32_bf16(Bt[n][k], At[m][k], acc[ai][bj][m][n], 0, 0, 0); __builtin_amdgcn_s_setprio(0); } while (0)
#define PG8_WAIT_V(n) asm volatile("s_waitcnt vmcnt(" #n ")" ::: "memory")
#define PG8_WAIT_L(n) asm volatile("s_waitcnt lgkmcnt(" #n ")" ::: "memory")
#define PG8_BAR __builtin_amdgcn_s_barrier()
#define PG8_SCHED __builtin_amdgcn_sched_barrier(0)
    Unit cur, nxt; int ui = 0;
    if (!S.next(0, cur)) return;
    f32x4 acc[2][2][4][2];
#pragma unroll
    for (int a = 0; a < 2; ++a)
#pragma unroll
        for (int b = 0; b < 2; ++b)
#pragma unroll
            for (int m = 0; m < 4; ++m)
#pragma unroll
                for (int n = 0; n < 2; ++n) acc[a][b][m][n] = (f32x4){0.f, 0.f, 0.f, 0.f};
    bf16x8 At[4][2], B0[2][2], B1[2][2];
    unsigned vA[2][2], nvA[2][2];
    if constexpr (GATHER) {
#pragma unroll
        for (int h = 0; h < 2; ++h)
#pragma unroll
            for (int i = 0; i < 2; ++i) { vA[h][i] = (unsigned)(S.tok(cur, h * HALF + RA[i]) * K + CA[i]) * 2u; nvA[h][i] = vA[h][i]; }
    }
    const char* cA = S.a_ptr(cur); const char* cB = S.b_ptr(cur); const char* nA = cA;
    PG8_STAGE(PG8_SB(0, 0), cB, voffB); PG8_STAGE(PG8_SB(0, 1), cB + hstep, voffB); PG8_STAGE_A(PG8_SA(0, 0), 0, false, 0); PG8_STAGE_A(PG8_SA(0, 1), 1, false, 0);
    if (wr == 1) PG8_BAR;
    PG8_WAIT_V(2); PG8_BAR;
    PG8_STAGE(PG8_SB(1, 0), cB + kstep, voffB); PG8_STAGE_A(PG8_SA(1, 0), 0, false, kstep); PG8_STAGE(PG8_SB(1, 1), cB + hstep + kstep, voffB);
    PG8_WAIT_V(6); PG8_BAR;
    for (;;) {
        const bool has_next = S.next(ui + 1, nxt);
        nA = has_next ? S.a_ptr(nxt) : cA; const char* nB = has_next ? S.b_ptr(nxt) : cB;
        if constexpr (GATHER) {
            if (has_next) {
#pragma unroll
                for (int h = 0; h < 2; ++h)
#pragma unroll
                    for (int i = 0; i < 2; ++i) nvA[h][i] = (unsigned)(S.tok(nxt, h * HALF + RA[i]) * K + CA[i]) * 2u;
            }
        }
        const bool full = (cur.nai == 2);
        for (int t = 0; t < nt; t += 2) {
            const bool last = (t == nt - 2);
            const size_t k1 = (size_t)(t + 1) * kstep;
            const size_t k2 = last ? 0 : (size_t)(t + 2) * kstep, k3 = k2 + kstep;
            const char* b2 = last ? nB : cB + (size_t)(t + 2) * kstep; const char* b3 = b2 + kstep;
            PG8_LDB(B0, 0, 0); PG8_LDB(B1, 0, 1); PG8_SCHED; PG8_LDA(At, 0, 0); PG8_STAGE_A(PG8_SA(1, 1), 1, false, k1);
            PG8_WAIT_V(8); PG8_WAIT_L(0); PG8_BAR; PG8_MMA(0, 0, At, B0); PG8_MMA(0, 1, At, B1); PG8_BAR; PG8_SCHED;
            if (full) PG8_LDA(At, 0, 1); PG8_STAGE(PG8_SB(0, 0), b2, voffB); PG8_STAGE(PG8_SB(0, 1), b2 + hstep, voffB); PG8_STAGE_A(PG8_SA(0, 0), 0, last, k2);
            PG8_WAIT_V(8); PG8_WAIT_L(0); PG8_BAR; if (full) { PG8_MMA(1, 0, At, B0); PG8_MMA(1, 1, At, B1); } PG8_BAR; PG8_SCHED;
            PG8_LDB(B0, 1, 0); PG8_LDB(B1, 1, 1); PG8_SCHED; PG8_LDA(At, 1, 0); PG8_STAGE_A(PG8_SA(0, 1), 1, last, k2);
            PG8_WAIT_V(8); PG8_WAIT_L(0); PG8_BAR; PG8_MMA(0, 0, At, B0); PG8_MMA(0, 1, At, B1); PG8_BAR; PG8_SCHED;
            if (full) PG8_LDA(At, 1, 1); PG8_STAGE(PG8_SB(1, 0), b3, voffB); PG8_STAGE(PG8_SB(1, 1), b3 + hstep, voffB); PG8_STAGE_A(PG8_SA(1, 0), 0, last, k3);
            PG8_WAIT_V(8); PG8_WAIT_L(0); PG8_BAR; if (full) { PG8_MMA(1, 0, At, B0); PG8_MMA(1, 1, At, B1); } PG8_BAR; PG8_SCHED;
        }
        if (wr == 0) PG8_BAR;
        E(acc, cur, wr, wc, fr, fq);
        if (!has_next) break;
#pragma unroll
        for (int a = 0; a < 2; ++a)
#pragma unroll
            for (int b = 0; b < 2; ++b)
#pragma unroll
                for (int m = 0; m < 4; ++m)
#pragma unroll
                    for (int n = 0; n < 2; ++n) acc[a][b][m][n] = (f32x4){0.f, 0.f, 0.f, 0.f};
        cur = nxt; cA = nA; cB = nB; ++ui;
        if constexpr (GATHER) {
#pragma unroll
            for (int h = 0; h < 2; ++h)
#pragma unroll
                for (int i = 0; i < 2; ++i) vA[h][i] = nvA[h][i];
        }
        if (wr == 1) PG8_BAR;
    }
    PG8_WAIT_V(0);
    PG8_BAR;
#undef PG8_SA
#undef PG8_SB
#undef PG8_STAGE
#undef PG8_STAGE_A
#undef PG8_LDA
#undef PG8_LDB
#undef PG8_MMA
#undef PG8_WAIT_V
#undef PG8_WAIT_L
#undef PG8_BAR
#undef PG8_SCHED
}
}

namespace pg8 {
__device__ __forceinline__ void row_bt(int row, int& b, int& tok) { if (row < TX) { b = row >> 11; tok = row & 2047; } else { const int r = row - TX; b = r >> 8; tok = SEQ + (r & 255); } }

struct EpiAttnIn {
    static constexpr bool PERM = true;
    bf16* QKV; bf16* VAT; bf16* VBT; const LAS float* rope;
    __device__ __forceinline__ void operator()(const f32x4 (&acc)[2][2][4][2], const Unit& u, int wr, int wc, int fr, int fq) const {
        const int row0 = u.pm * BM + u.roff + wr * 64 + fr; const int seg = u.pn >> 1;
        const bool latent = u.pm < (TX / BM);
        if (seg == 2 || seg == 5) {
#pragma unroll
            for (int ai = 0; ai < 2; ++ai) if (ai < u.nai)
#pragma unroll
                for (int m = 0; m < 4; ++m) { const int row = row0 + ai * HALF + m * 16; int b, tok; row_bt(row, b, tok);
#pragma unroll
                    for (int bj = 0; bj < 2; ++bj) { const int col = u.pn * BM + bj * HALF + wc * 32 + 8 * fq;
                        bf16* dst;
                        if (seg == 2) { const int cs = col - 1024; dst = VAT + ((size_t)(b * 4 + (cs >> 7)) * 128 + (cs & 127)) * NKEY + tok; }
                        else { const int cs = col - 2560; dst = VBT + ((size_t)(b * 8 + (cs >> 6)) * 64 + (cs & 63)) * NKEY + tok; }
#pragma unroll
                        for (int n = 0; n < 2; ++n)
#pragma unroll
                            for (int i = 0; i < 4; ++i) dst[(size_t)(4 * n + i) * NKEY] = (bf16)f2bf(acc[ai][bj][m][n][i]); } }
            return;
        }
        const bool dorope = latent && seg < 2;
        const float qs = (seg == 0 || seg == 3) ? 0.125f * LOG2E : 1.0f;
#pragma unroll
        for (int ai = 0; ai < 2; ++ai) if (ai < u.nai)
#pragma unroll
            for (int m = 0; m < 4; ++m) { const int row = row0 + ai * HALF + m * 16;
                f32x4 cs4[4];
                if (dorope) { const int t = row & 2047; const int pos = (wc & 1) ? (t & 63) : (t >> 6);
                    const LAS f32x4* rp = (const LAS f32x4*)(rope + (pos * 16 + 8 * (fq & 1)) * 2);
#pragma unroll
                    for (int j = 0; j < 4; ++j) cs4[j] = rp[j]; }
#pragma unroll
                for (int bj = 0; bj < 2; ++bj) { const int col = u.pn * BM + bj * HALF + wc * 32 + 8 * fq;
                    float v[8];
#pragma unroll
                    for (int n = 0; n < 2; ++n)
#pragma unroll
                        for (int i = 0; i < 4; ++i) v[4 * n + i] = acc[ai][bj][m][n][i];
                    if (dorope) {
#pragma unroll
                        for (int j = 0; j < 8; ++j) { const float other = __shfl_xor(v[j], 32); const float c = cs4[j >> 1][(j & 1) * 2], s = cs4[j >> 1][(j & 1) * 2 + 1];
                            v[j] = (fq < 2) ? (v[j] * c - other * s) : (v[j] * c + other * s); } }
                    u32x4 w; w.x = pk2(v[0] * qs, v[1] * qs); w.y = pk2(v[2] * qs, v[3] * qs); w.z = pk2(v[4] * qs, v[5] * qs); w.w = pk2(v[6] * qs, v[7] * qs);
                    *(u32x4*)(QKV + (size_t)row * NATT + col) = w; } }
    }
};
struct EpiGlaIn {
    static constexpr bool PERM = true;
    bf16* QKV2; bf16* VGT;
    __device__ __forceinline__ void operator()(const f32x4 (&acc)[2][2][4][2], const Unit& u, int wr, int wc, int fr, int fq) const {
        const int row0 = u.pm * BM + u.roff + wr * 64 + fr;
        if (u.pn >= 4 && u.pn < 8) {
#pragma unroll
            for (int ai = 0; ai < 2; ++ai) if (ai < u.nai)
#pragma unroll
                for (int m = 0; m < 4; ++m) { const int row = row0 + ai * HALF + m * 16; int b, tok; row_bt(row, b, tok);
#pragma unroll
                    for (int bj = 0; bj < 2; ++bj) { const int cs = u.pn * BM + bj * HALF + wc * 32 + 8 * fq - 1024;
                        bf16* dst = VGT + ((size_t)(b * 4 + (cs >> 8)) * 256 + (cs & 255)) * NKEY + tok;
#pragma unroll
                        for (int n = 0; n < 2; ++n)
#pragma unroll
                            for (int i = 0; i < 4; ++i) dst[(size_t)(4 * n + i) * NKEY] = (bf16)f2bf(acc[ai][bj][m][n][i]); } }
            return;
        }
        const float qs = (u.pn < 2) ? 0.08838834764831845f : 1.0f;
#pragma unroll
        for (int ai = 0; ai < 2; ++ai) if (ai < u.nai)
#pragma unroll
            for (int m = 0; m < 4; ++m) { const int row = row0 + ai * HALF + m * 16;
#pragma unroll
                for (int bj = 0; bj < 2; ++bj) { const int col = u.pn * BM + bj * HALF + wc * 32 + 8 * fq; const f32x4 a = acc[ai][bj][m][0] * qs, c = acc[ai][bj][m][1] * qs;
                    u32x4 w; w.x = pk2(a[0], a[1]); w.y = pk2(a[2], a[3]); w.z = pk2(c[0], c[1]); w.w = pk2(c[2], c[3]);
                    *(u32x4*)(QKV2 + (size_t)row * NGLA + col) = w; } }
    }
};
struct EpiResid {
    static constexpr bool PERM = false;
    const float* IL; const float* IC; float* XL; float* XC; const float* modv;
    __device__ __forceinline__ void operator()(const f32x4 (&acc)[2][2][4][2], const Unit& u, int wr, int wc, int fr, int fq) const {
        const int row0 = u.pm * BM + u.roff + wr * 64 + fr, col0 = u.pn * BM + wc * 32 + 4 * fq;
        const bool latent = u.pm < (TX / BM); const int bi = latent ? (u.pm >> 3) : 8;
        float* base = latent ? XL : (XC - (size_t)TX * D); const float* ibase = latent ? IL : (IC - (size_t)TX * D);
        f32x4 gv[2][2];
#pragma unroll
        for (int bj = 0; bj < 2; ++bj)
#pragma unroll
            for (int n = 0; n < 2; ++n) gv[bj][n] = *(const f32x4*)(modv + bi * 6144 + col0 + bj * HALF + n * 16);
#pragma unroll
        for (int ai = 0; ai < 2; ++ai) if (ai < u.nai)
#pragma unroll
            for (int m = 0; m < 4; ++m) { const size_t ro = (size_t)(row0 + ai * HALF + m * 16) * D + col0;
#pragma unroll
                for (int bj = 0; bj < 2; ++bj)
#pragma unroll
                    for (int n = 0; n < 2; ++n) { const size_t o = ro + bj * HALF + n * 16; *(f32x4*)(base + o) = *(const f32x4*)(ibase + o) + gv[bj][n] * acc[ai][bj][m][n]; } }
    }
};
struct EpiMoe1 {
    static constexpr bool PERM = false;
    bf16* HB;
    __device__ __forceinline__ void operator()(const f32x4 (&acc)[2][2][4][2], const Unit& u, int wr, int wc, int fr, int fq) const {
        const int row0 = u.pm * BM + u.roff + wr * 64 + fr, col0 = u.pn * 128 + wc * 16 + 4 * fq;
#pragma unroll
        for (int ai = 0; ai < 2; ++ai) if (ai < u.nai)
#pragma unroll
            for (int m = 0; m < 4; ++m) { bf16* rowp = HB + (size_t)(row0 + ai * HALF + m * 16) * DEXP + col0;
#pragma unroll
                for (int bj = 0; bj < 2; ++bj) { const f32x4 a = acc[ai][bj][m][0], b = acc[ai][bj][m][1];
                    u32x2 w; w.x = pk2(silu_f(a[0]) * b[0], silu_f(a[1]) * b[1]); w.y = pk2(silu_f(a[2]) * b[2], silu_f(a[3]) * b[3]);
                    *(u32x2*)(rowp + bj * 64) = w; } }
    }
};
struct EpiBf16 {
    static constexpr bool PERM = true;
    bf16* O; int ldc;
    __device__ __forceinline__ void operator()(const f32x4 (&acc)[2][2][4][2], const Unit& u, int wr, int wc, int fr, int fq) const {
        const int row0 = u.pm * BM + u.roff + wr * 64 + fr, col0 = u.pn * BM + wc * 32 + 8 * fq;
#pragma unroll
        for (int ai = 0; ai < 2; ++ai) if (ai < u.nai)
#pragma unroll
            for (int m = 0; m < 4; ++m) { bf16* rowp = O + (size_t)(row0 + ai * HALF + m * 16) * ldc + col0;
#pragma unroll
                for (int bj = 0; bj < 2; ++bj) { const f32x4 a = acc[ai][bj][m][0], c = acc[ai][bj][m][1];
                    u32x4 w; w.x = pk2(a[0], a[1]); w.y = pk2(a[2], a[3]); w.z = pk2(c[0], c[1]); w.w = pk2(c[2], c[3]);
                    *(u32x4*)(rowp + bj * HALF) = w; } }
    }
};
}

struct Args {
    const float *x, *c, *ctx, *c_ctx, *w_mod, *b_mod, *norm_g, *final_g, *att_w_in, *att_w_out, *att_lambda, *att_subln_g, *na_bias,
                *gla_w_in, *gla_w_gate, *gla_b_gate, *gla_norm_g, *gla_w_out, *router_w, *router_bias, *moe_w1, *moe_w3, *moe_w2;
    float* out; unsigned char* ws; int ph_lo, ph_hi, rep, pad;
};

struct RowMapId { int off; __device__ __forceinline__ int operator()(int n) const { return off + n; } };
struct RowMapMoe { int which; __device__ __forceinline__ int operator()(int n) const { return 32 * (n >> 4) + 16 * which + (n & 15); } };
template <class RM>
__device__ __forceinline__ void p0_transpose_item(const float* W, int K, int N, bf16* WT, LAS float* scr, int item, int lane, RM rm) {
    const int nblk = N / 32, kb = item / nblk, nb = item % nblk, k0 = 64 * kb, n0 = 32 * nb;
    float ld[32];
#pragma unroll
    for (int i = 0; i < 32; ++i) ld[i] = W[(size_t)(k0 + 2 * i + (lane >> 5)) * N + n0 + (lane & 31)];
#pragma unroll
    for (int i = 0; i < 32; ++i) scr[(2 * i + (lane >> 5)) * 33 + (lane & 31)] = ld[i];
    LDS_WAIT(); asm volatile("" ::: "memory");
    const int c = lane & 7;
#pragma unroll
    for (int j = 0; j < 4; ++j) { const int n = (lane >> 3) + 8 * j; const LAS float* s = scr + (8 * c) * 33 + n;
        u32x4 o; o.x = pk2(s[0 * 33], s[1 * 33]); o.y = pk2(s[2 * 33], s[3 * 33]); o.z = pk2(s[4 * 33], s[5 * 33]); o.w = pk2(s[6 * 33], s[7 * 33]);
        *(u32x4*)(WT + (size_t)rm(n0 + n) * K + k0 + 8 * c) = o; }
    LDS_WAIT(); asm volatile("" ::: "memory");
}

constexpr int CV_ATTIN = 1536, CV_ATTOUT = 512, CV_GLAIN = 1552, CV_GLAPAD = 28, CV_GLAOUT = 512, CV_W = 4096, CV_MOE = 3 * CV_W;
constexpr int CT_ATTN0 = CV_ATTIN + CV_ATTOUT, CT_MOE0 = CT_ATTN0 + CV_MOE, CT_GLA0 = CT_MOE0 + CV_GLAIN + CV_GLAPAD + CV_GLAOUT, CT_ATTN1 = CT_GLA0 + CV_ATTIN + CV_ATTOUT, CT_MOE1 = CT_ATTN1 + CV_MOE,
              CT_MOE2 = CT_MOE1 + CV_MOE, CT_GLA1 = CT_MOE2 + CV_GLAIN + CV_GLAPAD + CV_GLAOUT, CT_MOE3 = CT_GLA1 + CV_MOE, CV_TOTAL = CT_MOE3;
constexpr int CV_UNIT = 16;
struct ConvPtrs { const float *att_w_in, *att_w_out, *gla_w_in, *gla_w_out, *moe_w1, *moe_w3, *moe_w2; unsigned char* ws; };
struct RowMapAny { int moe, which; __device__ __forceinline__ int operator()(int n) const { return moe ? 32 * (n >> 4) + 16 * which + (n & 15) : n; } };
__device__ __forceinline__ void conv_item(const ConvPtrs& P, int it, LAS float* scr, int lane) {
    int kind, j, r;
    if (it < CT_ATTN0) { kind = 0; j = 0; r = it; } else if (it < CT_MOE0) { kind = 2; j = 0; r = it - CT_ATTN0; } else if (it < CT_GLA0) { kind = 1; j = 0; r = it - CT_MOE0; }
    else if (it < CT_ATTN1) { kind = 0; j = 1; r = it - CT_GLA0; } else if (it < CT_MOE1) { kind = 2; j = 1; r = it - CT_ATTN1; } else if (it < CT_MOE2) { kind = 2; j = 2; r = it - CT_MOE1; }
    else if (it < CT_GLA1) { kind = 1; j = 1; r = it - CT_MOE2; } else { kind = 2; j = 3; r = it - CT_GLA1; }
    const float* W; bf16* WT; int K = D, N = D, sub = r; RowMapAny rm{0, 0};
    if (kind == 2) {
        const int which = r / CV_W, q = r % CV_W, e = q >> 8, je = j * 16 + e; sub = q & 255;
        if (which < 2) { W = (which ? P.moe_w3 : P.moe_w1) + (size_t)je * D * DEXP; N = DEXP; WT = (bf16*)(P.ws + WS_W13) + (size_t)je * D * D; rm.moe = 1; rm.which = which; }
        else { W = P.moe_w2 + (size_t)je * DEXP * D; K = DEXP; WT = (bf16*)(P.ws + WS_W2) + (size_t)je * D * DEXP; }
    } else if (kind == 0) {
        if (r < CV_ATTIN) { W = P.att_w_in + (size_t)j * D * NATT; N = NATT; WT = (bf16*)(P.ws + WS_WATTIN) + (size_t)j * NATT * D; }
        else { W = P.att_w_out + (size_t)j * D * D; WT = (bf16*)(P.ws + WS_WATTOUT) + (size_t)j * D * D; sub = r - CV_ATTIN; }
    } else {
        if (r < CV_GLAIN) { W = P.gla_w_in + (size_t)j * D * 3104; N = 3104; WT = (bf16*)(P.ws + WS_WGLAIN) + (size_t)j * NGLA * D; }
        else if (r < CV_GLAIN + CV_GLAPAD) { const int c0 = (r - CV_GLAIN) * 1024;
            for (int i = lane; i < 1024; i += 64) *(u32x4*)((bf16*)(P.ws + WS_WGLAIN) + (size_t)j * NGLA * D + (size_t)3104 * D + (size_t)(c0 + i) * 8) = (u32x4){0u, 0u, 0u, 0u};
            return; }
        else { W = P.gla_w_out + (size_t)j * D * D; WT = (bf16*)(P.ws + WS_WGLAOUT) + (size_t)j * D * D; sub = r - CV_GLAIN - CV_GLAPAD; }
    }
    p0_transpose_item(W, K, N, WT, scr, sub, lane, rm);
}
__device__ __forceinline__ void conv_static(const ConvPtrs& P, int cur, int need, LAS unsigned char* lds, int lane, int wave, int vcu, int G) {
    LAS float* scr = (LAS float*)(lds + wave * 8448);
    for (int it = cur + vcu * 8 + wave; it < need; it += G * 8) conv_item(P, it, scr, lane);
}
__device__ __forceinline__ void conv_unit(const ConvPtrs& P, int i0, int hi, LAS unsigned char* lds, int lane, int wave) {
    LAS float* scr = (LAS float*)(lds + wave * 8448);
#pragma unroll 1
    for (int k = 0; k < CV_UNIT / 8; ++k) { const int it = i0 + wave * (CV_UNIT / 8) + k; if (it < hi) conv_item(P, it, scr, lane); }
}

template <class AP> __device__ __forceinline__ void p0_prologue(const AP ap, LAS unsigned char* lds, int tid, int lane, int wave, int vcu, int G) {
    unsigned char* ws = ap->ws;
    LAS float* S9 = (LAS float*)(lds + 69632);
    LAS float* red = (LAS float*)(lds + 106496);
    { const ConvPtrs P{ap->att_w_in, ap->att_w_out, ap->gla_w_in, ap->gla_w_out, ap->moe_w1, ap->moe_w3, ap->moe_w2, ws};
      conv_static(P, 0, MK_CONVQ ? CT_ATTN0 : CV_TOTAL, lds, lane, wave, vcu, G); }
    __syncthreads();
    { const float* cc = ap->c; const float* cx = ap->c_ctx;
      for (int i = tid; i < 9 * 1024; i += 512) { const int bi = i >> 10, k = i & 1023; const float v = (bi < 8) ? cc[bi * D + k] : cx[k]; S9[i] = v / (1.0f + __expf(-v)); } }
    __syncthreads();
    const float* w_mod = ap->w_mod; const float* b_mod = ap->b_mod;
    for (int u = vcu; u < 4 * 96; u += G) {
        const int L = u / 96, n0 = (u % 96) * 64;
        const float* W = w_mod + (size_t)L * D * 6144 + n0 + lane;
        float acc[9];
#pragma unroll
        for (int bi = 0; bi < 9; ++bi) acc[bi] = 0.f;
        const int kb = wave * 128;
#pragma unroll 8
        for (int k = 0; k < 128; ++k) { const float w = W[(size_t)(kb + k) * 6144];
#pragma unroll
            for (int bi = 0; bi < 9; ++bi) acc[bi] += S9[bi * 1024 + kb + k] * w; }
#pragma unroll
        for (int bi = 0; bi < 9; ++bi) red[(wave * 9 + bi) * 64 + lane] = acc[bi];
        __syncthreads();
        for (int i = tid; i < 9 * 64; i += 512) { const int bi = i >> 6, l = i & 63; float sm = b_mod[L * 6144 + n0 + l];
#pragma unroll
            for (int w = 0; w < 8; ++w) sm += red[(w * 9 + bi) * 64 + l];
            ((float*)(ws + WS_MODV))[(size_t)(L * 9 + bi) * 6144 + n0 + l] = sm; }
        __syncthreads();
    }
}

__device__ __forceinline__ float* xrow_ptr(float* XL, float* XC, int row) { return row < TX ? XL + (size_t)row * D : XC + (size_t)(row - TX) * D; }
__device__ __forceinline__ int row_bi(int row) { return row < TX ? (row >> 11) : 8; }

__device__ __forceinline__ void norm_mod_store(const f32x4 (&v)[4], const float* g, const float* sh, const float* sc, bf16* orow, int lane) {
    float ss = 0.f;
#pragma unroll
    for (int j = 0; j < 4; ++j) ss += (v[j].x * v[j].x + v[j].y * v[j].y) + (v[j].z * v[j].z + v[j].w * v[j].w);
    const float rs = __builtin_amdgcn_rsqf(wave_sum(ss) * (1.0f / D) + EPSF);
#pragma unroll
    for (int j = 0; j < 4; ++j) { const int c = 4 * lane + 256 * j; const f32x4 gg = *(const f32x4*)(g + c), s1 = *(const f32x4*)(sc + c), s0 = *(const f32x4*)(sh + c);
        const f32x4 y = (v[j] * rs) * gg * (1.0f + s1) + s0;
        u32x2 w; w.x = pk2(y.x, y.y); w.y = pk2(y.z, y.w); *(u32x2*)(orow + c) = w; }
}

__device__ __forceinline__ void phase_norm1(const float* XL, const float* XC, const float* g, const float* modv, bf16* H, int nrows, int lane, int wave, int vcu, int G) {
    for (int row = vcu * 8 + wave; row < nrows; row += G * 8) {
        const f32x4* xr = (const f32x4*)(row < TX ? XL + (size_t)row * D : XC + (size_t)(row - TX) * D) + lane; f32x4 v[4];
#pragma unroll
        for (int j = 0; j < 4; ++j) v[j] = xr[64 * j];
        const float* mv = modv + row_bi(row) * 6144;
        norm_mod_store(v, g, mv, mv + 1024, H + (size_t)row * D, lane);
    }
}

__device__ __forceinline__ void phase_router(float* XL, float* XC, const float* g, const float* modv, bf16* H, const float* router_w, const float* router_bias,
                                             unsigned* cnt  , int* list, int* toki, float* tokw, int nrows,
                                             LAS unsigned char* lds, int tid, int lane, int wave, int vcu, int G, int probe) {
    LAS float* RW = (LAS float*)lds;
    LAS int* lcnt = (LAS int*)(lds + 65536);
    LAS int* rinfo = (LAS int*)(lds + 65536 + 256);
    for (int it = 0; it < 8; ++it) { const int idx = tid + 512 * it, k = idx >> 2, q = idx & 3; const f32x4 w = *(const f32x4*)(router_w + k * 16 + 4 * q);
        RW[(4 * q + 0) * 1024 + k] = w.x; RW[(4 * q + 1) * 1024 + k] = w.y; RW[(4 * q + 2) * 1024 + k] = w.z; RW[(4 * q + 3) * 1024 + k] = w.w; }
    if (tid < 32) lcnt[tid] = 0;
    __syncthreads();
    const int rpb = nrows / G, rpw = rpb / 8;
    const int gI = lane >> 4;
    const f32x4 rb = *(const f32x4*)(router_bias + 4 * gI);
    for (int rep = (probe ? 0 : 1); rep < 2; ++rep)
    for (int i0 = 0; i0 < rpw; i0 += 3) {
        asm volatile("" ::: "memory");
        f32x4 y[3][4];
#pragma unroll
        for (int r = 0; r < 3; ++r) {
            const int ii = (i0 + r < rpw) ? i0 + r : rpw - 1; const int row = vcu * rpb + wave * rpw + ii;
            const f32x4* xr = (const f32x4*)xrow_ptr(XL, XC, row) + lane; f32x4 v[4];
#pragma unroll
            for (int j = 0; j < 4; ++j) v[j] = xr[64 * j];
            const float* mv = modv + row_bi(row) * 6144 + 3072;
            float ss = 0.f;
#pragma unroll
            for (int j = 0; j < 4; ++j) ss += (v[j].x * v[j].x + v[j].y * v[j].y) + (v[j].z * v[j].z + v[j].w * v[j].w);
            const float rs = __builtin_amdgcn_rsqf(wave_sum(ss) * (1.0f / D) + EPSF);
#pragma unroll
            for (int j = 0; j < 4; ++j) { const int c = 4 * lane + 256 * j; const f32x4 gg = *(const f32x4*)(g + c), s1 = *(const f32x4*)(mv + 1024 + c), s0 = *(const f32x4*)(mv + c);
                y[r][j] = (v[j] * rs) * gg * (1.0f + s1) + s0;
                u32x2 w; w.x = cvtpk(y[r][j].x, y[r][j].y); w.y = cvtpk(y[r][j].z, y[r][j].w); *(u32x2*)(H + (size_t)row * D + c) = w; }
            __builtin_amdgcn_sched_barrier(0);
        }
        float p[3][16];
#pragma unroll
        for (int e = 0; e < 16; ++e) {
#pragma unroll
            for (int r = 0; r < 3; ++r) p[r][e] = 0.f;
#pragma unroll
            for (int j = 0; j < 4; ++j) { const f32x4 w = *(const LAS f32x4*)(RW + e * 1024 + 4 * lane + 256 * j);
#pragma unroll
                for (int r = 0; r < 3; ++r) p[r][e] += (y[r][j].x * w.x + y[r][j].y * w.y) + (y[r][j].z * w.z + y[r][j].w * w.w); }
#pragma unroll
            for (int r = 0; r < 3; ++r) asm volatile("" : "+v"(p[r][e])); }
#pragma unroll
        for (int r = 0; r < 3; ++r) {
            float q8[8], lg[4];
#pragma unroll
            for (int j = 0; j < 8; ++j) q8[j] = swap32_add(p[r][j], p[r][j + 8]);
#pragma unroll
            for (int j = 0; j < 4; ++j) lg[j] = row_sum(swap16_add(q8[j], q8[j + 4]));
            float sc[4], sel[4];
#pragma unroll
            for (int j = 0; j < 4; ++j) { sc[j] = 1.0f / (1.0f + __expf(-lg[j])); sel[j] = sc[j] + rb[j]; }
            int i1 = 0, i2 = 0; float m1 = -1e30f, m2 = -1e30f, w1 = 0.f, w2 = 0.f;
#pragma unroll
            for (int j = 0; j < 4; ++j) { const float t = sel[j];
                if (t > m1) { m2 = m1; i2 = i1; w2 = w1; m1 = t; i1 = j; w1 = sc[j]; } else if (t > m2) { m2 = t; i2 = j; w2 = sc[j]; } }
            const float gs = m1 + m2;
            const float g0 = readlane_f(gs, 0), g1 = readlane_f(gs, 16), g2 = readlane_f(gs, 32), g3 = readlane_f(gs, 48);
            int bg = 0; float bgs = g0; if (g1 > bgs) { bgs = g1; bg = 1; } if (g2 > bgs) { bgs = g2; bg = 2; } if (g3 > bgs) { bgs = g3; bg = 3; }
            bg = __builtin_amdgcn_readfirstlane(bg);
            const int e0 = 4 * bg + __builtin_amdgcn_readlane(i1, 16 * bg), e1 = 4 * bg + __builtin_amdgcn_readlane(i2, 16 * bg);
            const float w0 = readlane_f(w1, 16 * bg), w1s = readlane_f(w2, 16 * bg);
            const float wn = 1.0f / (w0 + w1s);
            if (lane == 0 && rep == 1 && i0 + r < rpw) { const int rl = wave * rpw + i0 + r;
                const int p0 = __hip_atomic_fetch_add(&lcnt[e0], 1, __ATOMIC_RELAXED, __HIP_MEMORY_SCOPE_WORKGROUP), p1 = __hip_atomic_fetch_add(&lcnt[e1], 1, __ATOMIC_RELAXED, __HIP_MEMORY_SCOPE_WORKGROUP);
                rinfo[rl * 6 + 0] = e0; rinfo[rl * 6 + 1] = p0; rinfo[rl * 6 + 2] = e1; rinfo[rl * 6 + 3] = p1;
                rinfo[rl * 6 + 4] = __builtin_bit_cast(int, w0 * wn); rinfo[rl * 6 + 5] = __builtin_bit_cast(int, w1s * wn); }
        }
    }
    __syncthreads();
    if (tid < 16) lcnt[16 + tid] = (int)__hip_atomic_fetch_add(cnt + 64 * tid, (unsigned)lcnt[tid], RLX_AGENT);
    __syncthreads();
    if (tid < rpb) { const int row = vcu * rpb + tid; const int e0 = rinfo[tid * 6 + 0], e1 = rinfo[tid * 6 + 2];
        const int p0 = lcnt[16 + e0] + rinfo[tid * 6 + 1], p1 = lcnt[16 + e1] + rinfo[tid * 6 + 3];
        list[(size_t)e0 * TALL + p0] = row; list[(size_t)e1 * TALL + p1] = row;
        toki[row * 4 + 0] = e0; toki[row * 4 + 1] = p0; toki[row * 4 + 2] = e1; toki[row * 4 + 3] = p1;
        tokw[row * 2 + 0] = __builtin_bit_cast(float, rinfo[tid * 6 + 4]); tokw[row * 2 + 1] = __builtin_bit_cast(float, rinfo[tid * 6 + 5]); }
    __syncthreads();
}

__device__ __forceinline__ int build_moe_table(const unsigned* cnt, LAS int* tab, int tid) {
    if (tid < 16) tab[RT_MAX + 1 + tid] = (int)__hip_atomic_load(cnt + 64 * tid, RLX_AGENT);
    __syncthreads();
    if (tid == 0) { int rt = 0;
        for (int e = 0; e < 16; ++e) { const int c = tab[RT_MAX + 1 + e]; const int nt = (c + 255) >> 8;
            for (int m = 0; m < nt; ++m) { if (rt < RT_MAX) tab[rt] = e | (m << 8); ++rt; } }
        tab[RT_MAX] = rt < RT_MAX ? rt : RT_MAX; }
    __syncthreads();
    return tab[RT_MAX];
}

__device__ __forceinline__ void phase_combine(float* XL, float* XC, const float* modv  , const bf16* YB, const unsigned* cnt, const int* toki, const float* tokw,
                                              bool final_layer, const float* gnext, const float* modv_next, bf16* H, int nrows, int lane, int wave, int vcu, int G, int probe) {
    int tiles = 0; if (lane < 16) tiles = ((int)__hip_atomic_load(cnt + 64 * lane, RLX_AGENT) + 255) >> 8;
    int incl = tiles;
#pragma unroll
    for (int o = 1; o < 16; o <<= 1) { const int t = __shfl_up(incl, o); if (lane >= o) incl += t; }
    const int mybase = (incl - tiles) * 256;
    for (int rep = (probe ? 0 : 1); rep < 2; ++rep)
    for (int row = vcu * 8 + wave; row < nrows; row += G * 8) {
        const int e0 = toki[row * 4 + 0], p0 = toki[row * 4 + 1], e1 = toki[row * 4 + 2], p1 = toki[row * 4 + 3];
        const float w0 = tokw[row * 2 + 0], w1 = tokw[row * 2 + 1];
        const int s0 = __shfl(mybase, e0) + p0, s1 = __shfl(mybase, e1) + p1;
        float* xp = xrow_ptr(XL, XC, row);
        const float* g2 = modv + row_bi(row) * 6144 + 5120;
        f32x4 v[4];
#pragma unroll
        for (int j = 0; j < 4; ++j) { const int c = 4 * lane + 256 * j;
            const u32x2 a = *(const u32x2*)(YB + (size_t)s0 * D + c), b = *(const u32x2*)(YB + (size_t)s1 * D + c);
            f32x4 y; y.x = w0 * bflo(a.x) + w1 * bflo(b.x); y.y = w0 * bfhi(a.x) + w1 * bfhi(b.x); y.z = w0 * bflo(a.y) + w1 * bflo(b.y); y.w = w0 * bfhi(a.y) + w1 * bfhi(b.y);
            v[j] = *(const f32x4*)(xp + c) + *(const f32x4*)(g2 + c) * y; }
        if (final_layer) {
            float ss = 0.f;
#pragma unroll
            for (int j = 0; j < 4; ++j) ss += (v[j].x * v[j].x + v[j].y * v[j].y) + (v[j].z * v[j].z + v[j].w * v[j].w);
            const float rs = __builtin_amdgcn_rsqf(wave_sum(ss) * (1.0f / D) + EPSF);
#pragma unroll
            for (int j = 0; j < 4; ++j) { const int c = 4 * lane + 256 * j; if (rep == 1) *(f32x4*)(xp + c) = (v[j] * rs) * *(const f32x4*)(gnext + c); }
        } else {
            if (rep == 1) {
#pragma unroll
            for (int j = 0; j < 4; ++j) *(f32x4*)(xp + 4 * lane + 256 * j) = v[j]; }
            const float* mv = modv_next + row_bi(row) * 6144;
            norm_mod_store(v, gnext, mv, mv + 1024, H + (size_t)row * D, lane);
        }
    }
}

__device__ __forceinline__ void phase_readout(const bf16* OF, const bf16* OB, const bf16* QKV2, const float* ng, bf16* AOUT, int nrows, int lane, int wave, int vcu, int G) {
    const f32x4 gg = *(const f32x4*)(ng + 4 * lane);
    for (int row = vcu * 8 + wave; row < nrows; row += G * 8) {
#pragma unroll
        for (int j = 0; j < 4; ++j) { const int c = 4 * lane + 256 * j;
            const u32x2 a = *(const u32x2*)(OF + (size_t)row * D + c), b = *(const u32x2*)(OB + (size_t)row * D + c), gt = *(const u32x2*)(QKV2 + (size_t)row * NGLA + 2048 + c);
            f32x4 o; o.x = bflo(a.x) + bflo(b.x); o.y = bfhi(a.x) + bfhi(b.x); o.z = bflo(a.y) + bflo(b.y); o.w = bfhi(a.y) + bfhi(b.y);
            const float ss = wave_sum((o.x * o.x + o.y * o.y) + (o.z * o.z + o.w * o.w));
            const float rs = __builtin_amdgcn_rsqf(ss * (1.0f / 256.0f) + EPSF);
            f32x4 gv; gv.x = silu_f(bflo(gt.x)); gv.y = silu_f(bfhi(gt.x)); gv.z = silu_f(bflo(gt.y)); gv.w = silu_f(bfhi(gt.y));
            const f32x4 y = (o * rs) * gg * gv;
            u32x2 w; w.x = pk2(y.x, y.y); w.y = pk2(y.z, y.w); *(u32x2*)(AOUT + (size_t)row * D + c) = w; }
    }
}

__device__ __forceinline__ int na_r0(int r) { int v = r - 4; return v < 0 ? 0 : (v > 24 ? 24 : v); }
template <int NMAPS, int DV, bool NA>
__device__ __forceinline__ void attn_unit(LAS unsigned char* lds, int tid, int lane, int wave,
                                          const bf16* QKV, int qcol, int qrow0, int kcol, int krow_lat, int krow_ctx, const bf16* VT, int klo, int khi,
                                          int r_wave, int xq0, const LAS float* biasT,
                                          bf16* AOUT, int ocol, float lam, const float* subg, float outscale) {
    constexpr int KB = 9216;
    constexpr int BUFSZ = NMAPS * KB + DV * 144;
    constexpr int NVB = DV / 16, NVR = DV / 64;
    const int fr = lane & 15, g = lane >> 4;
    bf16x8 qf[NMAPS][2];
    { const bf16* qp = QKV + (size_t)(qrow0 + wave * 16 + fr) * NATT + qcol + 8 * g;
#pragma unroll
      for (int m = 0; m < NMAPS; ++m)
#pragma unroll
          for (int s = 0; s < 2; ++s) qf[m][s] = *(const bf16x8*)(qp + m * 64 + 32 * s); }
    f32x4 O[NMAPS][NVB]; float mrun[NMAPS]; f32x2 lrun[NMAPS];
#pragma unroll
    for (int m = 0; m < NMAPS; ++m) { mrun[m] = -1e30f; lrun[m] = (f32x2){0.f, 0.f};
#pragma unroll
        for (int vb = 0; vb < NVB; ++vb) O[m][vb] = (f32x4){0.f, 0.f, 0.f, 0.f}; }
    const int ntiles = 4 + (khi - klo);
    u32x4 kreg[NMAPS], vreg[NVR];
    const int lkey = tid >> 3, lch = tid & 7;
#define AT_LOAD(i) do { const int _i = (i); const int _rowg = (_i < 4 ? krow_ctx + 64 * _i : krow_lat + 64 * (klo + _i - 4)) + lkey; const int _tok0 = (_i < 4 ? SEQ + 64 * _i : 64 * (klo + _i - 4)); \
        _Pragma("unroll") for (int m = 0; m < NMAPS; ++m) kreg[m] = *(const u32x4*)(QKV + (size_t)_rowg * NATT + kcol + m * 64 + lch * 8); \
        _Pragma("unroll") for (int j = 0; j < NVR; ++j) { const int idx = tid + 512 * j; vreg[j] = *(const u32x4*)(VT + (size_t)(idx >> 3) * NKEY + _tok0 + (idx & 7) * 8); } } while (0)
#define AT_STORE(b) do { LAS unsigned char* _p = lds + (b) * BUFSZ; \
        _Pragma("unroll") for (int m = 0; m < NMAPS; ++m) *(LAS u32x4*)(_p + m * KB + lkey * 144 + lch * 16) = kreg[m]; \
        _Pragma("unroll") for (int j = 0; j < NVR; ++j) { const int idx = tid + 512 * j; *(LAS u32x4*)(_p + NMAPS * KB + (idx >> 3) * 144 + (idx & 7) * 16) = vreg[j]; } } while (0)
    AT_LOAD(0); AT_STORE(0); __syncthreads();
    const int kbase0 = (8 * (fr >> 2) + (fr & 3)) * 144 + 16 * g;
    const int vbase = fr * 144 + 16 * g;
    int r0w = 0, xq = 0, tmask = 3, c0w = 0; float pen[4][4];
    if constexpr (NA) { r0w = na_r0(r_wave); xq = xq0 + fr; int cs = xq - 8; cs = cs < 0 ? 0 : (cs > 48 ? 48 : cs);
        c0w = xq0 - 8; c0w = c0w < 0 ? 0 : (c0w > 32 ? 32 : c0w);
        tmask = 1;
#pragma unroll
        for (int kb = 0; kb < 4; ++kb)
#pragma unroll
            for (int ii = 0; ii < 4; ++ii) { const int y = c0w + 32 * (kb >> 1) + 8 * g + 4 * (kb & 1) + ii; pen[kb][ii] = (y >= cs && y < cs + 16) ? 0.f : -1e30f; } }
    for (int i = 0; i < ntiles; ++i) {
        if (i + 1 < ntiles) AT_LOAD(i + 1);
        const LAS unsigned char* buf = lds + (i & 1) * BUFSZ;
        bool active = true; int kr = 0; bool local = false;
        if constexpr (NA) { if (i >= 4) { local = true; kr = klo + i - 4; active = (kr >= r0w) && (kr < r0w + 8); } }
        if (active) {
            const int tm = local ? tmask : 3;
            const int koffw = local ? c0w * 144 : 0, voffw = local ? c0w * 2 : 0;
            bf16x8 kf[NMAPS][4][2];
#pragma unroll
            for (int m = 0; m < NMAPS; ++m)
#pragma unroll
                for (int kb = 0; kb < 4; ++kb)
#pragma unroll
                    for (int s = 0; s < 2; ++s) kf[m][kb][s] = *(const LAS bf16x8*)(buf + m * KB + kbase0 + koffw + (kb & 1) * (4 * 144) + (kb >> 1) * (32 * 144) + s * 64);
            __builtin_amdgcn_sched_barrier(0);
            f32x4 S[NMAPS][4];
#pragma unroll
            for (int m = 0; m < NMAPS; ++m)
#pragma unroll
                for (int kb = 0; kb < 4; ++kb) { S[m][kb] = (f32x4){0.f, 0.f, 0.f, 0.f};
                    if (!NA || (tm >> (kb >> 1)) & 1) {
#pragma unroll
                        for (int s = 0; s < 2; ++s) S[m][kb] = __builtin_amdgcn_mfma_f32_16x16x32_bf16(kf[m][kb][s], qf[m][s], S[m][kb], 0, 0, 0); } }
            bf16x8 vf0[4][2];
#pragma unroll
            for (int vb = 0; vb < 4; ++vb)
#pragma unroll
                for (int t = 0; t < 2; ++t) vf0[vb][t] = *(const LAS bf16x8*)(buf + NMAPS * KB + vbase + voffw + vb * (16 * 144) + t * 64);
            __builtin_amdgcn_sched_barrier(0);
            bf16x8 pf[NMAPS][2];
#pragma unroll
            for (int m = 0; m < NMAPS; ++m) {
                if constexpr (NA) { if (local) {
                        const LAS float* bp = biasT + (kr - r_wave + 7) * 31 + (c0w + 8 * g - xq + 15);
#pragma unroll
                        for (int kb = 0; kb < 4; ++kb)
#pragma unroll
                            for (int ii = 0; ii < 4; ++ii) { const float t = (tm >> (kb >> 1)) & 1 ? (S[m][kb][ii] + pen[kb][ii]) + bp[32 * (kb >> 1) + 4 * (kb & 1) + ii] : -1e30f; S[m][kb][ii] = t; } } }
                float mx = fmaxf(fmaxf(S[m][0][0], S[m][0][1]), fmaxf(S[m][0][2], S[m][0][3]));
#pragma unroll
                for (int kb = 1; kb < 4; ++kb) mx = fmaxf(fmaxf(mx, S[m][kb][0]), fmaxf(fmaxf(S[m][kb][1], S[m][kb][2]), S[m][kb][3]));
                mx = swap32_max(swap16_max(mx));
                if (__any(mx > mrun[m] + 8.0f)) {
                    const float mnew = fmaxf(mrun[m], mx), alpha = fexp2(mrun[m] - mnew); mrun[m] = mnew; lrun[m] = lrun[m] * alpha;
#pragma unroll
                    for (int vb = 0; vb < NVB; ++vb) O[m][vb] = O[m][vb] * alpha;
                }
                const float mm = mrun[m];
                unsigned pw[8]; float l0 = 0.f, l1 = 0.f;
#pragma unroll
                for (int kb = 0; kb < 4; ++kb) { const float a0 = fexp2(S[m][kb][0] - mm), a1 = fexp2(S[m][kb][1] - mm), a2 = fexp2(S[m][kb][2] - mm), a3 = fexp2(S[m][kb][3] - mm);
                    l0 += a0 + a1; l1 += a2 + a3;
                    pw[2 * kb] = cvtpk(a0, a1); pw[2 * kb + 1] = cvtpk(a2, a3); }
                lrun[m].x += l0; lrun[m].y += l1;
                pf[m][0] = __builtin_bit_cast(bf16x8, (u32x4){pw[0], pw[1], pw[2], pw[3]});
                pf[m][1] = __builtin_bit_cast(bf16x8, (u32x4){pw[4], pw[5], pw[6], pw[7]});
            }
            __builtin_amdgcn_sched_barrier(0);
            if constexpr (NVB == 8) {
                bf16x8 vf1[4][2];
#pragma unroll
                for (int vb = 0; vb < 4; ++vb)
#pragma unroll
                    for (int t = 0; t < 2; ++t) vf1[vb][t] = *(const LAS bf16x8*)(buf + NMAPS * KB + vbase + (4 + vb) * (16 * 144) + t * 64);
                __builtin_amdgcn_sched_barrier(0);
#pragma unroll
                for (int vb = 0; vb < 4; ++vb)
#pragma unroll
                    for (int t = 0; t < 2; ++t)
#pragma unroll
                        for (int m = 0; m < NMAPS; ++m) O[m][vb] = __builtin_amdgcn_mfma_f32_16x16x32_bf16(vf0[vb][t], pf[m][t], O[m][vb], 0, 0, 0);
                __builtin_amdgcn_sched_barrier(0);
#pragma unroll
                for (int vb = 0; vb < 4; ++vb)
#pragma unroll
                    for (int t = 0; t < 2; ++t)
#pragma unroll
                        for (int m = 0; m < NMAPS; ++m) O[m][4 + vb] = __builtin_amdgcn_mfma_f32_16x16x32_bf16(vf1[vb][t], pf[m][t], O[m][4 + vb], 0, 0, 0);
            } else {
#pragma unroll
                for (int vb = 0; vb < 4; ++vb)
#pragma unroll
                    for (int t = 0; t < 2; ++t) { if (!NA || (tm >> t) & 1) {
#pragma unroll
                            for (int m = 0; m < NMAPS; ++m) O[m][vb] = __builtin_amdgcn_mfma_f32_16x16x32_bf16(vf0[vb][t], pf[m][t], O[m][vb], 0, 0, 0); } }
            }
            __builtin_amdgcn_sched_barrier(0);
        }
        if (i + 1 < ntiles) AT_STORE((i + 1) & 1);
        __syncthreads();
    }
#undef AT_LOAD
#undef AT_STORE
    float inv[NMAPS];
#pragma unroll
    for (int m = 0; m < NMAPS; ++m) { float l = lrun[m].x + lrun[m].y; l = swap16_add(l, l); l = swap32_add(l, l); inv[m] = 1.0f / l; }
    const int orow = qrow0 + wave * 16 + fr;
    if constexpr (NMAPS == 2) {
        float ss = 0.f; const float i1 = inv[0], i2 = lam * inv[1];
#pragma unroll
        for (int vb = 0; vb < NVB; ++vb) { O[0][vb] = O[0][vb] * i1 - O[1][vb] * i2; const f32x4 o = O[0][vb]; ss += (o.x * o.x + o.y * o.y) + (o.z * o.z + o.w * o.w); }
        ss = swap16_add(ss, ss); ss = swap32_add(ss, ss);
        const float rs = __builtin_amdgcn_rsqf(ss * (1.0f / DV) + EPSF) * outscale;
#pragma unroll
        for (int vb = 0; vb < NVB; ++vb) { const f32x4 gg = *(const f32x4*)(subg + 16 * vb + 4 * g); const f32x4 y = O[0][vb] * rs * gg;
            u32x2 w; w.x = cvtpk(y.x, y.y); w.y = cvtpk(y.z, y.w); *(u32x2*)(AOUT + (size_t)orow * D + ocol + 16 * vb + 4 * g) = w; }
    } else {
#pragma unroll
        for (int vb = 0; vb < NVB; ++vb) { const f32x4 y = O[0][vb] * inv[0];
            u32x2 w; w.x = cvtpk(y.x, y.y); w.y = cvtpk(y.z, y.w); *(u32x2*)(AOUT + (size_t)orow * D + ocol + 16 * vb + 4 * g) = w; }
    }
}


__device__ __forceinline__ void phase_attention(const bf16* QKV, const bf16* VAT, const bf16* VBT, bf16* AOUT, const float* lamp  , float lam_init, const float* subg, const float* nab  ,
                                                unsigned* naq, const ConvPtrs& CP, int clo, int chi, LAS unsigned char* lds, int tid, int lane, int wave) {
    float part = lamp[lane] * lamp[64 + lane]; float part2 = lamp[128 + lane] * lamp[192 + lane];
    const float lam = __expf(wave_sum(part)) - __expf(wave_sum(part2)) + lam_init;
    LAS float* biasT = (LAS float*)(lds + LX_BIAS) + 64;
    constexpr int NATT_U = 576 + 1152;
    const int ncu = (chi - clo + CV_UNIT - 1) / CV_UNIT, nq = NATT_U + ncu;
    for (;;) {
        __syncthreads();
        if (tid == 0) *(LAS int*)(lds + LX_MISC + 64) = (int)__hip_atomic_fetch_add(naq, 1u, RLX_AGENT);
        __syncthreads();
        const int q = *(LAS int*)(lds + LX_MISC + 64);
        if (q >= nq) break;
        const int ai = (int)(((long)q * NATT_U) / nq); const bool isatt = (int)(((long)(q + 1) * NATT_U) / nq) > ai;
        if (!isatt) { conv_unit(CP, clo + (q - ai) * CV_UNIT, chi, lds, lane, wave); continue; }
        if (ai < 512 || (ai >= 1536 && ai < 1600)) {
            int bh, qrow0, khi;
            if (ai < 512) { bh = ai >> 4; const int qt = ai & 15; qrow0 = (bh >> 2) * SEQ + qt * 128; khi = 32; }
            else { const int u = ai - 1536; bh = u >> 1; const int qt = u & 1; qrow0 = TX + (bh >> 2) * CTXL + qt * 128; khi = 0; }
            const int b = bh >> 2, h = bh & 3;
            attn_unit<2, 128, false>(lds, tid, lane, wave, QKV, h * 128, qrow0, 512 + h * 128, b * SEQ, TX + b * CTXL, VAT + (size_t)bh * 128 * NKEY, 0, khi, 0, 0, nullptr,
                                     AOUT, h * 128, lam, subg, 1.0f - lam_init);
        } else {
            int bh, qrow0, klo, khi, rw;
            if (ai < 1536) { const int u = ai - 512; bh = u >> 4; const int rp = u & 15; qrow0 = (bh >> 3) * SEQ + rp * 128; klo = na_r0(2 * rp); khi = na_r0(2 * rp + 1) + 8; rw = 2 * rp + (wave >> 2); }
            else { const int u = ai - 1600; bh = u >> 1; const int qt = u & 1; qrow0 = TX + (bh >> 3) * CTXL + qt * 128; klo = 0; khi = 0; rw = 0; }
            const int b = bh >> 3, h = bh & 7;
            for (int i = tid; i < 640; i += 512) { const int k = i - 64; biasT[k] = (k >= 0 && k < 465) ? nab[h * 465 + k] * LOG2E : 0.f; }
            attn_unit<1, 64, true>(lds, tid, lane, wave, QKV, 1536 + h * 64, qrow0, 2048 + h * 64, b * SEQ, TX + b * CTXL, VBT + (size_t)bh * 64 * NKEY, klo, khi,
                                   rw, 16 * (wave & 3), biasT, AOUT, 512 + h * 64, 0.f, nullptr, 1.0f);
        }
    }
}

__device__ __forceinline__ void gla_chunk_rows(int b, int dir, int n, int& row0, int& tok0) {
    if (n < 4) { const int cc = dir ? 3 - n : n; row0 = TX + b * CTXL + 64 * cc; tok0 = SEQ + 64 * cc; } else { const int lc = dir ? 35 - n : n - 4; row0 = b * SEQ + 64 * lc; tok0 = 64 * lc; }
}
constexpr int GP_QM = 0, GP_KM = 17408, GP_VT = 34816, GP_LR = 71680, GP_SEG = 75776;
__device__ __forceinline__ void phase_gla_prep(const bf16* QKV2, const bf16* VGT, const float* wgate  , const float* bgate  ,
                                               bf16* QG, bf16* KET, float* FACD, bf16* OF, bf16* OB,
                                               LAS unsigned char* lds, int tid, int lane, int wave, int vcu, int G) {
    const int fr = lane & 15, g = lane >> 4;
    const int d = tid & 127, seg = tid >> 7;
    LAS float* LR = (LAS float*)(lds + GP_LR);
    LAS float* SEG = (LAS float*)(lds + GP_SEG);
    for (int ub = vcu * 9; ub < 2304; ub += G * 9) {
        const int q = ub / 36, n0 = ub % 36, dir = q & 1, hh = (q >> 1) & 3, b = q >> 3;
        bf16* OUT = dir ? OB : OF;
        float wg[16];
#pragma unroll
        for (int r = 0; r < 16; ++r) wg[r] = wgate[(dir * 16 + r) * 512 + hh * 128 + d];
        const float bgv = bgate[dir * 512 + hh * 128 + d];
        const bf16* vtb = VGT + (size_t)(b * 4 + hh) * 256 * NKEY;
        u32x4 qr[2], kr[2], vr[4], lr4;
#define GP_LOAD(n) do { int _row0, _tok0; gla_chunk_rows(b, dir, (n), _row0, _tok0); \
        _Pragma("unroll") for (int j = 0; j < 2; ++j) { const int idx = tid + 512 * j, p = idx >> 4, ch = idx & 15; const bf16* src = QKV2 + (size_t)(_row0 + p) * NGLA + hh * 128 + ch * 8; qr[j] = *(const u32x4*)src; kr[j] = *(const u32x4*)(src + 512); } \
        _Pragma("unroll") for (int j = 0; j < 4; ++j) { const int idx = tid + 512 * j; vr[j] = *(const u32x4*)(vtb + (size_t)(idx >> 3) * NKEY + _tok0 + (idx & 7) * 8); } \
        if (tid < 128) lr4 = *(const u32x4*)(QKV2 + (size_t)(_row0 + (tid >> 1)) * NGLA + 3072 + dir * 16 + (tid & 1) * 8); } while (0)
        GP_LOAD(n0);
        for (int k9 = 0; k9 < 9; ++k9) {
            const int n = n0 + k9, u = ub + k9; int row0, tok0; gla_chunk_rows(b, dir, n, row0, tok0);
#pragma unroll
            for (int j = 0; j < 2; ++j) { const int idx = tid + 512 * j, p = idx >> 4, ch = idx & 15;
                *(LAS u32x4*)(lds + GP_QM + p * 272 + ch * 16) = qr[j]; *(LAS u32x4*)(lds + GP_KM + p * 272 + ch * 16) = kr[j]; }
#pragma unroll
            for (int j = 0; j < 4; ++j) { const int idx = tid + 512 * j; *(LAS u32x4*)(lds + GP_VT + (idx >> 3) * 144 + (idx & 7) * 16) = vr[j]; }
            if (tid < 128) { LAS float* lp = LR + (tid >> 1) * 16 + (tid & 1) * 8;
                lp[0] = bflo(lr4.x); lp[1] = bfhi(lr4.x); lp[2] = bflo(lr4.y); lp[3] = bfhi(lr4.y); lp[4] = bflo(lr4.z); lp[5] = bfhi(lr4.z); lp[6] = bflo(lr4.w); lp[7] = bfhi(lr4.w); }
            __syncthreads();
            if (k9 + 1 < 9) GP_LOAD(n + 1);
            float gc[16];
#pragma unroll
            for (int pi = 0; pi < 16; ++pi) { const LAS f32x4* lp = (const LAS f32x4*)(LR + (16 * seg + pi) * 16); float z = bgv;
#pragma unroll
                for (int k = 0; k < 4; ++k) { const f32x4 l4 = lp[k]; z += l4.x * wg[4 * k] + l4.y * wg[4 * k + 1] + l4.z * wg[4 * k + 2] + l4.w * wg[4 * k + 3]; }
                const float az = fabsf(z); gc[pi] = (fminf(z, 0.f) - flog(1.0f + fexp(-az))) * 0.0625f; }
            float run = 0.f;
            if (dir == 0) {
#pragma unroll
                for (int pi = 0; pi < 16; ++pi) { run += gc[pi]; gc[pi] = run; }
            } else {
#pragma unroll
                for (int pi = 15; pi >= 0; --pi) { run += gc[pi]; gc[pi] = run; }
            }
            SEG[seg * 128 + d] = run;
            __syncthreads();
            const float t0 = SEG[d], t1 = SEG[128 + d], t2 = SEG[256 + d], t3 = SEG[384 + d];
            float off, gmid; const float gend = (t0 + t1) + (t2 + t3);
            if (dir == 0) { off = (seg > 0 ? t0 : 0.f) + (seg > 1 ? t1 : 0.f) + (seg > 2 ? t2 : 0.f); gmid = t0 + t1; }
            else { off = (seg < 3 ? t3 : 0.f) + (seg < 2 ? t2 : 0.f) + (seg < 1 ? t1 : 0.f); gmid = t3 + t2; }
            const float emid = fexp(gmid), eend = fexp(gend - gmid);
            unsigned kep[8];
            bf16* qgp = QG + ((size_t)u * 64 + 16 * seg) * 128 + d;
#pragma unroll
            for (int pi = 0; pi < 16; ++pi) { const int p = 16 * seg + pi; const float rel = off + gc[pi] - gmid; const float Ep = fexp(rel), Ei = fexp(-rel);
                LAS bf16* qa = (LAS bf16*)(lds + GP_QM) + p * 136 + d; LAS bf16* ka = (LAS bf16*)(lds + GP_KM) + p * 136 + d;
                const float qv = bf2f(*qa), kv = bf2f(*ka);
                const float qm = qv * Ep, km = kv * Ei;
                const unsigned w1 = cvtpk(qm, qm * emid), w2 = cvtpk(km, km * eend);
                *qa = (bf16)(w1 & 0xffffu); qgp[pi * 128] = (bf16)(w1 >> 16); *ka = (bf16)(w2 & 0xffffu);
                if (pi & 1) kep[pi >> 1] |= (w2 & 0xffff0000u); else kep[pi >> 1] = w2 >> 16; }
            { u32x4* kt = (u32x4*)(KET + ((size_t)u * 128 + d) * 64 + 16 * seg); kt[0] = (u32x4){kep[0], kep[1], kep[2], kep[3]}; kt[1] = (u32x4){kep[4], kep[5], kep[6], kep[7]}; }
            if (seg == 0) FACD[(size_t)u * 128 + d] = fexp(gend);
            __syncthreads();
            { const int cb = wave & 3, half = wave >> 2;
              bf16x8 qfr[4];
#pragma unroll
              for (int ks = 0; ks < 4; ++ks) qfr[ks] = *(const LAS bf16x8*)(lds + GP_QM + (16 * cb + fr) * 272 + (8 * g + 32 * ks) * 2);
              f32x4 AT[4];
#pragma unroll
              for (int sb = 0; sb < 4; ++sb) { AT[sb] = (f32x4){0.f, 0.f, 0.f, 0.f};
#pragma unroll
                  for (int ks = 0; ks < 4; ++ks) { const bf16x8 af = *(const LAS bf16x8*)(lds + GP_KM + (16 * sb + fr) * 272 + (8 * g + 32 * ks) * 2);
                      AT[sb] = __builtin_amdgcn_mfma_f32_16x16x32_bf16(af, qfr[ks], AT[sb], 0, 0, 0); }
                  const int c = 16 * cb + fr;
#pragma unroll
                  for (int ii = 0; ii < 4; ++ii) { const int sp = 16 * sb + 4 * g + ii; const bool keep = dir ? (sp >= c) : (sp <= c); AT[sb][ii] = keep ? AT[sb][ii] : 0.f; } }
              bf16x8 pf[2];
#pragma unroll
              for (int t = 0; t < 2; ++t) { u32x4 w; w.x = pk2(AT[2 * t][0], AT[2 * t][1]); w.y = pk2(AT[2 * t][2], AT[2 * t][3]); w.z = pk2(AT[2 * t + 1][0], AT[2 * t + 1][1]); w.w = pk2(AT[2 * t + 1][2], AT[2 * t + 1][3]);
                  pf[t] = __builtin_bit_cast(bf16x8, w); }
#pragma unroll
              for (int v8 = 0; v8 < 8; ++v8) { const int vb = 8 * half + v8; f32x4 Oa = (f32x4){0.f, 0.f, 0.f, 0.f};
#pragma unroll
                  for (int t = 0; t < 2; ++t) { const LAS unsigned char* vp = lds + GP_VT + (16 * vb + fr) * 144 + (32 * t + 4 * g) * 2;
                      const u32x2 lo = *(const LAS u32x2*)vp, hi = *(const LAS u32x2*)(vp + 32);
                      u32x4 w; w.x = lo.x; w.y = lo.y; w.z = hi.x; w.w = hi.y;
                      Oa = __builtin_amdgcn_mfma_f32_16x16x32_bf16(__builtin_bit_cast(bf16x8, w), pf[t], Oa, 0, 0, 0); }
                  u32x2 w; w.x = pk2(Oa[0], Oa[1]); w.y = pk2(Oa[2], Oa[3]);
                  *(u32x2*)(OUT + (size_t)(row0 + 16 * cb + fr) * D + hh * 256 + 16 * vb + 4 * g) = w; }
            }
            __syncthreads();
        }
#undef GP_LOAD
    }
}

constexpr int GS_BUF = 45056, GS_QG = 0, GS_KET = 17408, GS_VT = 35840, GS_ST = 2 * GS_BUF, GS_DEC = GS_ST + 2 * 17408;
__device__ __forceinline__ void phase_gla(const bf16* VGT, bf16* OF, bf16* OB, const bf16* QG, const bf16* KET, const float* FACD,
                                          LAS unsigned char* lds, int tid, int lane, int wave, int vcu, int G) {
    const int fr = lane & 15, g = lane >> 4;
    for (int u = vcu; u < 256; u += G) {
        const int slab = u & 3, dir = (u >> 2) & 1, hh = (u >> 3) & 3, b = u >> 5;
        bf16* OUT = dir ? OB : OF;
        const int upb = ((b * 4 + hh) * 2 + dir) * 36;
        f32x4 Sacc[4];
#pragma unroll
        for (int vb = 0; vb < 4; ++vb) Sacc[vb] = (f32x4){0.f, 0.f, 0.f, 0.f};
        for (int i = tid; i < 17408 / 4; i += 512) ((LAS unsigned*)(lds + GS_ST))[i] = 0u;
        const bf16* vtb = VGT + ((size_t)(b * 4 + hh) * 256 + slab * 64) * NKEY;
        const int cb = wave & 3, vh = wave >> 2;
        const int ocol = hh * 256 + slab * 64 + 32 * vh + 4 * g;
        struct GsRegs { u32x4 qg[2], ket[2], v; u32x2 oi[2]; float dec; };
        GsRegs R0, R1; R0.dec = 0.f; R1.dec = 0.f;
#define GS_LOAD(R, n) do { int _row0, _tok0; gla_chunk_rows(b, dir, (n), _row0, _tok0); const size_t _u = (size_t)(upb + (n)); \
        _Pragma("unroll") for (int j = 0; j < 2; ++j) { const int idx = tid + 512 * j; R.qg[j] = *(const u32x4*)(QG + _u * 8192 + idx * 8); R.ket[j] = *(const u32x4*)(KET + _u * 8192 + idx * 8); } \
        R.v = *(const u32x4*)(vtb + (size_t)(tid >> 3) * NKEY + _tok0 + (tid & 7) * 8); \
        if (tid < 128) R.dec = FACD[_u * 128 + tid]; \
        _Pragma("unroll") for (int v2 = 0; v2 < 2; ++v2) R.oi[v2] = *(const u32x2*)(OUT + (size_t)(_row0 + 16 * cb + fr) * D + ocol + 16 * v2); } while (0)
#define GS_STORE(R, bf) do { LAS unsigned char* _p = lds + (bf) * GS_BUF; \
        _Pragma("unroll") for (int j = 0; j < 2; ++j) { const int idx = tid + 512 * j; *(LAS u32x4*)(_p + GS_QG + (idx >> 4) * 272 + (idx & 15) * 16) = R.qg[j]; *(LAS u32x4*)(_p + GS_KET + (idx >> 3) * 144 + (idx & 7) * 16) = R.ket[j]; } \
        *(LAS u32x4*)(_p + GS_VT + (tid >> 3) * 144 + (tid & 7) * 16) = R.v; \
        if (tid < 128) ((LAS float*)(lds + GS_DEC))[(bf) * 128 + tid] = R.dec; } while (0)
#define GS_ITER(n, RN, RF) do { const int _n = (n); int row0, tok0; gla_chunk_rows(b, dir, _n, row0, tok0); const int cur = _n & 1; \
            if (_n + 2 < 36) GS_LOAD(RF, _n + 2); \
            const LAS unsigned char* bufp = lds + cur * GS_BUF; const LAS unsigned char* stp = lds + GS_ST + cur * 17408; \
            { bf16x8 qfr[4]; \
              _Pragma("unroll") for (int ks = 0; ks < 4; ++ks) qfr[ks] = *(const LAS bf16x8*)(bufp + GS_QG + (16 * cb + fr) * 272 + (8 * g + 32 * ks) * 2); \
              _Pragma("unroll") for (int v2 = 0; v2 < 2; ++v2) { const int vb = 2 * vh + v2; const u32x2 oin = v2 ? oc1 : oc0; \
                  f32x4 Oa = (f32x4){bflo(oin.x), bfhi(oin.x), bflo(oin.y), bfhi(oin.y)}; \
                  _Pragma("unroll") for (int ks = 0; ks < 4; ++ks) { const bf16x8 af = *(const LAS bf16x8*)(stp + (16 * vb + fr) * 272 + (8 * g + 32 * ks) * 2); \
                      Oa = __builtin_amdgcn_mfma_f32_16x16x32_bf16(af, qfr[ks], Oa, 0, 0, 0); } \
                  u32x2 w; w.x = pk2(Oa[0], Oa[1]); w.y = pk2(Oa[2], Oa[3]); \
                  *(u32x2*)(OUT + (size_t)(row0 + 16 * cb + fr) * D + ocol + 16 * v2) = w; } } \
            { const f32x4 dec = *(const LAS f32x4*)((LAS float*)(lds + GS_DEC) + cur * 128 + 16 * wave + 4 * g); \
              LAS unsigned char* stn = lds + GS_ST + (cur ^ 1) * 17408; \
              _Pragma("unroll") for (int vb = 0; vb < 4; ++vb) { Sacc[vb] = Sacc[vb] * dec; \
                  _Pragma("unroll") for (int t = 0; t < 2; ++t) { const bf16x8 af = *(const LAS bf16x8*)(bufp + GS_KET + (16 * wave + fr) * 144 + (8 * g + 32 * t) * 2); \
                      const bf16x8 bfr = *(const LAS bf16x8*)(bufp + GS_VT + (16 * vb + fr) * 144 + (8 * g + 32 * t) * 2); \
                      Sacc[vb] = __builtin_amdgcn_mfma_f32_16x16x32_bf16(af, bfr, Sacc[vb], 0, 0, 0); } \
                  u32x2 w; w.x = pk2(Sacc[vb][0], Sacc[vb][1]); w.y = pk2(Sacc[vb][2], Sacc[vb][3]); \
                  *(LAS u32x2*)(stn + (16 * vb + fr) * 272 + (16 * wave + 4 * g) * 2) = w; } } \
            if (_n + 1 < 36) { GS_STORE(RN, cur ^ 1); oc0 = RN.oi[0]; oc1 = RN.oi[1]; } \
            __syncthreads(); } while (0)
        GS_LOAD(R0, 0); GS_STORE(R0, 0);
        u32x2 oc0 = R0.oi[0], oc1 = R0.oi[1];
        GS_LOAD(R0, 1);
        __syncthreads();
        for (int n = 0; n < 36; n += 2) { GS_ITER(n, R0, R1); GS_ITER(n + 1, R1, R0); }
#undef GS_ITER
#undef GS_LOAD
#undef GS_STORE
    }
}

constexpr int N_PHASES = 34;
typedef const Args __attribute__((address_space(4)))* KArgs;
__device__ __forceinline__ KArgs kargs() { KArgs p = (KArgs)__builtin_amdgcn_kernarg_segment_ptr(); asm volatile("" : "+s"(p)); return p; }
__global__ void __launch_bounds__(512, 2) fwd(Args a_unused) {
    extern __shared__ __attribute__((aligned(16))) unsigned char lds_raw[];
    LAS unsigned char* lds = (LAS unsigned char*)lds_raw;
    const int tid0 = threadIdx.x;
    const int G0 = gridDim.x; const int bx0 = blockIdx.x;
#define PH_ENTRY int tid = tid0; asm volatile("" : "+v"(tid)); int G = G0, bx = bx0; asm volatile("" : "+s"(G), "+s"(bx)); const int lane = tid & 63, wave = __builtin_amdgcn_readfirstlane(tid >> 6); \
        const int vcu = (G % 8 == 0) ? (bx % 8) * (G / 8) + bx / 8 : bx; (void)lane; (void)wave; (void)vcu
    const int tid = tid0;
    const int ph_lo = kargs()->ph_lo, ph_hi = kargs()->ph_hi;
    const int repmask = kargs()->rep;
    if (tid < 64) ((LAS unsigned*)(lds + LX_MISC))[tid] = 0u;
    for (int i = tid; i < 1024; i += 512) { const int pos = i >> 4, f = i & 15; const float inv = __builtin_amdgcn_exp2f(-(float)f * (13.287712379549449f / 16.0f)); const float ang = (float)pos * inv;
        ((LAS float*)(lds + LX_ROPE))[2 * i] = __cosf(ang); ((LAS float*)(lds + LX_ROPE))[2 * i + 1] = __sinf(ang); }
    __syncthreads();
    const bool single = (ph_hi - ph_lo) > 1;
    XcdBarrier bar; bar.bar = (unsigned*)(kargs()->ws + WS_CTL) + CW_BAR; bar.x = 0; bar.st = (volatile LAS unsigned*)(lds + LX_MISC);
    if (single) bar = xcd_barrier_post((unsigned*)(kargs()->ws + WS_CTL) + CW_BAR, (volatile LAS unsigned*)(lds + LX_MISC));
#define IN(k) (ph_lo <= (k) && (k) < ph_hi)
#define REPLOOP(t) for (int rep_ = 0, nrep_ = 1 + ((repmask >> (t)) & 1); rep_ < nrep_; ++rep_, (rep_ < nrep_ ? (bar.bar = (unsigned*)(kargs()->ws + WS_CTL) + CW_BAR, xcd_barrier(bar)) : (void)0))
#define SEAM(k) do { if (IN(k) && IN((k) + 1)) { bar.bar = (unsigned*)(kargs()->ws + WS_CTL) + CW_BAR; xcd_barrier(bar); if ((repmask >> 10) & 1) xcd_barrier(bar); } } while (0)
    LAS int* tab = (LAS int*)(lds + LX_MOETAB);
#define CONV_PTRS(A) ConvPtrs{(A)->att_w_in, (A)->att_w_out, (A)->gla_w_in, (A)->gla_w_out, (A)->moe_w1, (A)->moe_w3, (A)->moe_w2, (A)->ws}

    if (IN(0)) REPLOOP(0) { PH_ENTRY; p0_prologue(kargs(), lds, tid, lane, wave, vcu, G); } SEAM(0);
    if (IN(1)) { PH_ENTRY; KArgs A = kargs(); unsigned char* ws = A->ws; phase_norm1(A->x, A->ctx, A->norm_g, (float*)(ws + WS_MODV), (bf16*)(ws + WS_H), TALL, lane, wave, vcu, G); } SEAM(1);

#pragma nounroll
    for (int L = 0; L < 4; ++L) {
        const int pb = 2 + 8 * L; const bool isattn = !(L & 1); const int j = L >> 1; const bool lastL = (L == 3);
        const int nrows = lastL ? TX : TALL;
        if (IN(pb)) REPLOOP(isattn ? 1 : 3) {
            PH_ENTRY; KArgs A = kargs(); unsigned char* ws = A->ws; unsigned char* big = ws + WS_BIG; const bf16* H = (const bf16*)(ws + WS_H);
            if (isattn) {
                pg8::DenseOrder S; S.init(H, (const bf16*)(ws + WS_WATTIN) + (size_t)j * NATT * D, TALL, NATT, D, G, bx);
                pg8::EpiAttnIn E{(bf16*)(big + BG_QKV), (bf16*)(big + BG_VAT), (bf16*)(big + BG_VBT), (const LAS float*)(lds + LX_ROPE)};
                pg8::gemm_phase<pg8::EpiAttnIn, pg8::DenseOrder, false>(lds, tid, D, S, E);
            } else {
                pg8::DenseOrder S; S.init(H, (const bf16*)(ws + WS_WGLAIN) + (size_t)j * NGLA * D, TALL, NGLA, D, G, bx);
                pg8::EpiGlaIn E{(bf16*)(big + BG_QKV2), (bf16*)(big + BG_VGT)};
                pg8::gemm_phase<pg8::EpiGlaIn, pg8::DenseOrder, false>(lds, tid, D, S, E);
            }
        }
        SEAM(pb);
        if (!isattn && IN(pb + 1)) {
            for (int rep_ = 0; rep_ <= ((repmask >> 13) & 1); ++rep_)
            { PH_ENTRY; KArgs A = kargs(); unsigned char* ws = A->ws;
              phase_gla_prep((const bf16*)(ws + WS_BIG + BG_QKV2), (const bf16*)(ws + WS_BIG + BG_VGT), A->gla_w_gate + j * 2 * 16 * 512, A->gla_b_gate + j * 2 * 512,
                             (bf16*)(ws + WS_QG), (bf16*)(ws + WS_KET), (float*)(ws + WS_BIG + BG_FAC), (bf16*)(ws + WS_BIG + BG_OF), (bf16*)(ws + WS_BIG + BG_OB), lds, tid, lane, wave, vcu, G); }
            if (single) { bar.bar = (unsigned*)(kargs()->ws + WS_CTL) + CW_BAR; xcd_barrier(bar); }
        }
        if (IN(pb + 1)) REPLOOP(isattn ? 2 : 4) {
            PH_ENTRY; KArgs A = kargs(); unsigned char* ws = A->ws; unsigned char* big = ws + WS_BIG; bf16* AOUT = (bf16*)(ws + WS_AOUT);
            if (isattn) { const ConvPtrs CP = CONV_PTRS(A);
                phase_attention((const bf16*)(big + BG_QKV), (const bf16*)(big + BG_VAT), (const bf16*)(big + BG_VBT), AOUT, A->att_lambda + j * 256, (L == 0) ? 0.2f : 0.470713018f,
                                A->att_subln_g + j * 128, A->na_bias + j * 8 * 465, (unsigned*)(ws + WS_CTL) + CW_NAQ + 64 * j, CP,
                                MK_CONVQ ? (L == 0 ? CT_ATTN0 : CT_MOE1) : 0, MK_CONVQ ? (L == 0 ? CT_MOE1 : CT_MOE3) : 0, lds, tid, lane, wave); }
            else phase_gla((const bf16*)(big + BG_VGT), (bf16*)(big + BG_OF), (bf16*)(big + BG_OB), (const bf16*)(ws + WS_QG), (const bf16*)(ws + WS_KET), (const float*)(big + BG_FAC),
                           lds, tid, lane, wave, vcu, G);
        }
        SEAM(pb + 1);
        if (!isattn) {
            if (IN(pb + 2)) REPLOOP(5) { PH_ENTRY; KArgs A = kargs(); unsigned char* ws = A->ws; unsigned char* big = ws + WS_BIG;
                phase_readout((const bf16*)(big + BG_OF), (const bf16*)(big + BG_OB), (const bf16*)(big + BG_QKV2), A->gla_norm_g + j * 256, (bf16*)(ws + WS_AOUT), nrows, lane, wave, vcu, G); }
            SEAM(pb + 2);
        }
        if (IN(pb + 3)) {
            PH_ENTRY; KArgs A = kargs(); unsigned char* ws = A->ws;
            pg8::DenseOrder S; S.init((const bf16*)(ws + WS_AOUT), (const bf16*)(ws + (isattn ? WS_WATTOUT : WS_WGLAOUT)) + (size_t)j * D * D, nrows, D, D, G, bx);
            pg8::EpiResid E{L == 0 ? A->x : A->out, L == 0 ? A->ctx : (const float*)(ws + WS_CTX), A->out, (float*)(ws + WS_CTX), (const float*)(ws + WS_MODV) + (size_t)L * 9 * 6144 + 2048};
            pg8::gemm_phase<pg8::EpiResid, pg8::DenseOrder, false>(lds, tid, D, S, E);
        }
        SEAM(pb + 3);
        if (IN(pb + 4)) { PH_ENTRY; KArgs A = kargs(); unsigned char* ws = A->ws;
            phase_router(A->out, (float*)(ws + WS_CTX), A->norm_g + (L * 2 + 1) * D, (const float*)(ws + WS_MODV) + (size_t)L * 9 * 6144, (bf16*)(ws + WS_H), A->router_w, A->router_bias,
                         (unsigned*)(ws + WS_CTL) + CW_CNT + L * 16 * 64, (int*)(ws + WS_LIST), (int*)(ws + WS_TOKI), (float*)(ws + WS_TOKW), nrows, lds, tid, lane, wave, vcu, G, (repmask >> 11) & 1); }
        SEAM(pb + 4);
        if (IN(pb + 5)) REPLOOP(6) {
            PH_ENTRY; KArgs A = kargs(); unsigned char* ws = A->ws;
            const int RT = build_moe_table((unsigned*)(ws + WS_CTL) + CW_CNT + L * 16 * 64, tab, tid);
            pg8::MoeOrder S; S.A = (const char*)(ws + WS_H); S.B = (const char*)(ws + WS_W13) + (size_t)L * 16 * D * D * 2; S.K = D; S.bstride = (size_t)D * D * 2; S.tab = tab; S.list = (const int*)(ws + WS_LIST); S.RT = RT; S.nwg = RT * 4; S.G = G; S.c = bx;
            pg8::EpiMoe1 E{(bf16*)(ws + WS_BIG + BG_HB)};
            pg8::gemm_phase<pg8::EpiMoe1, pg8::MoeOrder, true>(lds, tid, D, S, E);
        }
        SEAM(pb + 5);
        if (IN(pb + 6)) REPLOOP(7) {
            PH_ENTRY; KArgs A = kargs(); unsigned char* ws = A->ws;
            const int RT = build_moe_table((unsigned*)(ws + WS_CTL) + CW_CNT + L * 16 * 64, tab, tid);
            pg8::MoeOrder S; S.A = (const char*)(ws + WS_BIG + BG_HB); S.B = (const char*)(ws + WS_W2) + (size_t)L * 16 * D * DEXP * 2; S.K = DEXP; S.bstride = (size_t)D * DEXP * 2; S.tab = tab; S.list = (const int*)(ws + WS_LIST); S.RT = RT; S.nwg = RT * 4; S.G = G; S.c = bx;
            pg8::EpiBf16 E{(bf16*)(ws + WS_BIG + BG_YB), D};
            pg8::gemm_phase<pg8::EpiBf16, pg8::MoeOrder, false>(lds, tid, DEXP, S, E);
        }
        SEAM(pb + 6);
        if (IN(pb + 7)) { PH_ENTRY; KArgs A = kargs(); unsigned char* ws = A->ws; const float* MODV = (const float*)(ws + WS_MODV);
            phase_combine(A->out, (float*)(ws + WS_CTX), MODV + (size_t)L * 9 * 6144, (const bf16*)(ws + WS_BIG + BG_YB), (unsigned*)(ws + WS_CTL) + CW_CNT + L * 16 * 64, (const int*)(ws + WS_TOKI), (const float*)(ws + WS_TOKW),
                          lastL, lastL ? A->final_g : A->norm_g + ((L + 1) * 2) * D, MODV + (size_t)(lastL ? L : L + 1) * 9 * 6144, (bf16*)(ws + WS_H), nrows, lane, wave, vcu, G, (repmask >> 12) & 1); }
        if (!lastL) SEAM(pb + 7);
    }
#undef IN
#undef REPLOOP
#undef SEAM
#undef CONV_PTRS

#undef PH_ENTRY
}

extern "C" void kernel_launch(void* const* d_in, const int* in_sizes, int n_in, void* d_out, int out_size, void* d_ws, size_t ws_size, hipStream_t stream) {
    static int ready = 0;
    if (ready == 0) {
        if (n_in != 23 || out_size != TX * D || ws_size < WS_END) { fprintf(stderr, "kernel_launch: unexpected shapes (n_in %d out %d ws %zu)\n", n_in, out_size, ws_size); ready = -1; return; }
        if (hipFuncSetAttribute((const void*)fwd, hipFuncAttributeMaxDynamicSharedMemorySize, LDS_BYTES) != hipSuccess) { fprintf(stderr, "kernel_launch: hipFuncSetAttribute failed\n"); ready = -1; return; }
        int per_cu = 0; (void)hipOccupancyMaxActiveBlocksPerMultiprocessor(&per_cu, (const void*)fwd, 512, LDS_BYTES); (void)hipGetLastError();
        if (per_cu < 1) fprintf(stderr, "kernel_launch: occupancy query reports %d blocks per CU\n", per_cu);
        ready = 1;
    }
    if (ready < 0) return;
    (void)hipMemsetAsync((char*)d_ws + WS_CTL, 0, CTL_ZERO_BYTES, stream);
    Args a{};
    const float** ap = (const float**)&a;
    for (int i = 0; i < 23; ++i) ap[i] = (const float*)d_in[i];
    a.out = (float*)d_out; a.ws = (unsigned char*)d_ws;
    const int grid = 256;
    a.ph_lo = 0; a.ph_hi = N_PHASES; a.rep = MK_REPMASK;
    hipLaunchKernelGGL(fwd, dim3(grid), dim3(512), LDS_BYTES, stream, a);
}
```

```cpp
#include <hip/hip_runtime.h>
#include <cstdio>
#include <cstdint>

#ifndef MK_CONVQ
#define MK_CONVQ 1
#endif
#ifndef MK_REPMASK
#define MK_REPMASK 0
#endif

#define GAS __attribute__((address_space(1)))
#define LAS __attribute__((address_space(3)))
typedef unsigned short bf16;
typedef short bf16x8 __attribute__((ext_vector_type(8)));
typedef short bf16x4 __attribute__((ext_vector_type(4)));
typedef float f32x4 __attribute__((ext_vector_type(4)));
typedef float f32x2 __attribute__((ext_vector_type(2)));
typedef unsigned u32x4 __attribute__((ext_vector_type(4)));
typedef unsigned u32x2 __attribute__((ext_vector_type(2)));

constexpr int D = 1024, NB = 8, SEQ = 2048, CTXL = 256;
constexpr int TX = NB * SEQ, TC = NB * CTXL, TALL = TX + TC;
constexpr int NKEY = SEQ + CTXL;
constexpr int NATT = 3072, NGLA = 3328;
constexpr float EPSF = 1e-6f;
constexpr float LOG2E = 1.4426950408889634f;
constexpr int NEXP = 16, DEXP = 512;
constexpr int RT_MAX = 160;

constexpr size_t MiB = 1u << 20;
constexpr size_t WS_CTL = 0, CTL_ZERO_BYTES = 1 * MiB;
constexpr size_t WS_MODV = 1 * MiB;
constexpr size_t WS_TOKI = 2 * MiB;
constexpr size_t WS_TOKW = 2 * MiB + 512 * 1024;
constexpr size_t WS_LIST = 3 * MiB;
constexpr size_t WS_CTX = 5 * MiB;
constexpr size_t WS_WATTIN = 13 * MiB;
constexpr size_t WS_WATTOUT = 25 * MiB;
constexpr size_t WS_WGLAIN = 29 * MiB;
constexpr size_t WS_WGLAOUT = 42 * MiB;
constexpr size_t WS_W13 = 46 * MiB;
constexpr size_t WS_W2 = 174 * MiB;
constexpr size_t WS_H = 238 * MiB;
constexpr size_t WS_AOUT = 274 * MiB;
constexpr size_t WS_BIG = 310 * MiB;
constexpr size_t WS_END = 539 * MiB;
constexpr size_t BG_QKV = 0;
constexpr size_t BG_VAT = 108 * MiB;
constexpr size_t BG_VBT = 126 * MiB;
constexpr size_t BG_QKV2 = 0;
constexpr size_t BG_VGT = 117 * MiB;
constexpr size_t BG_OF = 153 * MiB;
constexpr size_t BG_OB = 189 * MiB;
constexpr size_t BG_FAC = 225 * MiB;
constexpr size_t WS_QG = WS_H, WS_KET = WS_AOUT;
constexpr size_t BG_HB = 0;
constexpr size_t BG_YB = 40 * MiB;
constexpr int CW_TMO = 0;
constexpr int CW_BAR = 4096;
constexpr int CW_NAQ = 15360;
constexpr int CW_CNT = 8192;

constexpr int RING_BYTES = 131072;
constexpr int LX_OFF = RING_BYTES;
constexpr int LX_MISC = LX_OFF;
constexpr int LX_MOETAB = LX_OFF + 256;
constexpr int LX_ROPE = LX_OFF + 2048;
constexpr int LX_BIAS = LX_OFF + 2048 + 8192;
constexpr int LDS_BYTES = 147456;

#define LDS_WAIT() asm volatile("s_waitcnt lgkmcnt(0)" ::: "memory")
#define VM_WAIT() asm volatile("s_waitcnt vmcnt(0)" ::: "memory")
#define RLX_AGENT __ATOMIC_RELAXED, __HIP_MEMORY_SCOPE_AGENT
__device__ __forceinline__ unsigned f2bf(float f) { unsigned u = __builtin_bit_cast(unsigned, f); return (u + 0x7fffu + ((u >> 16) & 1u)) >> 16; }
typedef __bf16 hwbf16x2 __attribute__((ext_vector_type(2)));
__device__ __forceinline__ unsigned cvtpk(float lo, float hi) { const f32x2 v = {lo, hi}; const hwbf16x2 b = __builtin_convertvector(v, hwbf16x2); return __builtin_bit_cast(unsigned, b); }
__device__ __forceinline__ unsigned pk2(float lo, float hi) { return cvtpk(lo, hi); }
__device__ __forceinline__ float bf2f(unsigned short b) { return __builtin_bit_cast(float, ((unsigned)b) << 16); }
__device__ __forceinline__ float bflo(unsigned w) { return __builtin_bit_cast(float, w << 16); }
__device__ __forceinline__ float bfhi(unsigned w) { return __builtin_bit_cast(float, w & 0xffff0000u); }
template <int CTRL> __device__ __forceinline__ float dppf(float v) { return __builtin_bit_cast(float, __builtin_amdgcn_update_dpp(0, __builtin_bit_cast(int, v), CTRL, 0xf, 0xf, true)); }
__device__ __forceinline__ float row_sum(float v) { v += dppf<0xB1>(v); v += dppf<0x4E>(v); v += dppf<0x124>(v); v += dppf<0x128>(v); return v; }
__device__ __forceinline__ float swap16_add(float a, float b) { auto r = __builtin_amdgcn_permlane16_swap(__float_as_uint(a), __float_as_uint(b), false, false); const unsigned r0 = r[0], r1 = r[1]; return __uint_as_float(r0) + __uint_as_float(r1); }
__device__ __forceinline__ float swap32_add(float a, float b) { auto r = __builtin_amdgcn_permlane32_swap(__float_as_uint(a), __float_as_uint(b), false, false); const unsigned r0 = r[0], r1 = r[1]; return __uint_as_float(r0) + __uint_as_float(r1); }
__device__ __forceinline__ float swap16_max(float a) { auto r = __builtin_amdgcn_permlane16_swap(__float_as_uint(a), __float_as_uint(a), false, false); const unsigned r0 = r[0], r1 = r[1]; return fmaxf(__uint_as_float(r0), __uint_as_float(r1)); }
__device__ __forceinline__ float swap32_max(float a) { auto r = __builtin_amdgcn_permlane32_swap(__float_as_uint(a), __float_as_uint(a), false, false); const unsigned r0 = r[0], r1 = r[1]; return fmaxf(__uint_as_float(r0), __uint_as_float(r1)); }
__device__ __forceinline__ float readlane_f(float v, int l) { return __int_as_float(__builtin_amdgcn_readlane(__float_as_int(v), l)); }
__device__ __forceinline__ float wave_sum(float v) { v = row_sum(v); v = swap16_add(v, v); return swap32_add(v, v); }
__device__ __forceinline__ float fexp2(float x) { return __builtin_amdgcn_exp2f(x); }
__device__ __forceinline__ float fexp(float x) { return __builtin_amdgcn_exp2f(x * LOG2E); }
__device__ __forceinline__ float flog(float x) { return __builtin_amdgcn_logf(x) * 0.6931471805599453f; }
__device__ __forceinline__ float frcp(float x) { return __builtin_amdgcn_rcpf(x); }
__device__ __forceinline__ float silu_f(float x) { return x * frcp(1.0f + fexp(-x)); }

#define XB_TMO      128
#define XB_XCNT(j)  (256  + 64 * (j))
#define XB_XSUB(j)  (1280 + 64 * (j))
#define XB_XGEN(j)  (2304 + 64 * (j))
#define XB_TOP      3328
#define XB_TOPGEN   3392
#define XCD_BAR_WORDS 3456
#define XB_SPIN_CAP (1u << 18)
__device__ __forceinline__ unsigned xb_ld(unsigned* p)              { return __hip_atomic_load(p, __ATOMIC_RELAXED, __HIP_MEMORY_SCOPE_AGENT); }
__device__ __forceinline__ unsigned xb_add(unsigned* p, unsigned v) { return __hip_atomic_fetch_add(p, v, __ATOMIC_RELAXED, __HIP_MEMORY_SCOPE_AGENT); }
__device__ __forceinline__ unsigned xb_xcc_id() { return (unsigned)__builtin_amdgcn_s_getreg((3 << 11) | 20) & 0xFu; }
#define XB_SPIN(cond, bar) do { unsigned _sp = 0; while (cond) { __builtin_amdgcn_s_sleep(1); \
    if ((++_sp & 255u) == 0u) { if (xb_ld(&(bar)[XB_TMO])) break; if (_sp > XB_SPIN_CAP) { atomicAdd(&(bar)[XB_TMO], 1u); break; } } } } while (0)
struct XcdBarrier { unsigned* bar; unsigned x; volatile LAS unsigned* st; };
__device__ __forceinline__ XcdBarrier xcd_barrier_post(unsigned* bar, volatile LAS unsigned* st) {
    XcdBarrier b; b.bar = bar; b.x = xb_xcc_id(); b.st = st;
    if (threadIdx.x == 0) (void)xb_add(&bar[XB_XCNT(b.x)], 1u);
    return b;
}
__device__ __forceinline__ void xcd_barrier_complete(unsigned* bar, unsigned x, unsigned& nloc, unsigned& nx) {
    const unsigned G = gridDim.x * gridDim.y * gridDim.z;
    unsigned sum, cnt, mine, sp = 0u;
    for (;;) {
        sum = 0u; cnt = 0u; mine = 0u;
#pragma unroll
        for (unsigned j = 0; j < 16; ++j) { const unsigned c = xb_ld(&bar[XB_XCNT(j)]); sum += c; cnt += (c > 0u) ? 1u : 0u; mine = (j == x) ? c : mine; }
        if (sum == G) break;
        __builtin_amdgcn_s_sleep(1);
        if ((++sp & 255u) == 0u) { if (xb_ld(&bar[XB_TMO])) break; if (sp > XB_SPIN_CAP) { atomicAdd(&bar[XB_TMO], 1u); break; } }
    }
    nloc = mine > 0u ? mine : 1u; nx = cnt > 0u ? cnt : 1u;
}
__device__ __forceinline__ void xcd_barrier(const XcdBarrier& b) {
    asm volatile("s_waitcnt vmcnt(0)" ::: "memory");
    __syncthreads();
    if (threadIdx.x == 0) {
        unsigned* bar = b.bar;
        __builtin_amdgcn_s_waitcnt(0);
        unsigned nloc = b.st[0], nx = b.st[1];
        if (nloc == 0u) { xcd_barrier_complete(bar, b.x, nloc, nx); b.st[0] = nloc; b.st[1] = nx; }
        const unsigned old = xb_add(&bar[XB_XSUB(b.x)], 1u);
        const unsigned gen = old / nloc;
        if (old + 1u == (gen + 1u) * nloc) {
            __builtin_amdgcn_fence(__ATOMIC_RELEASE, "agent");
            asm volatile("s_waitcnt vmcnt(0)" ::: "memory");
            const unsigned og = xb_add(&bar[XB_TOP], 1u);
            const unsigned tg = og / nx;
            if (og + 1u == (tg + 1u) * nx) xb_add(&bar[XB_TOPGEN], 1u);
            else XB_SPIN(xb_ld(&bar[XB_TOPGEN]) == tg, bar);
            __builtin_amdgcn_fence(__ATOMIC_ACQUIRE, "agent");
            xb_add(&bar[XB_XGEN(b.x)], 1u);
            asm volatile("s_waitcnt vmcnt(0)" ::: "memory");
        } else {
            XB_SPIN(xb_ld(&bar[XB_XGEN(b.x)]) == gen, bar);
            __builtin_amdgcn_fence(__ATOMIC_ACQUIRE, "agent");
            asm volatile("s_waitcnt vmcnt(0)" ::: "memory");
        }
    }
    __syncthreads();
}

namespace pg8 {
constexpr int BM = 256, BK = 64, HALF = 128, HTB = HALF * BK * 2, STAGE_BYTES = 8 * HTB, NXCD = 8, WGM = 8;
__host__ __device__ __forceinline__ int lds_byte(int r, int c) { const int st = (r >> 4) * 2 + (c >> 5), rr = r & 15, cc = c & 31, ob = rr * 64 + cc * 2; return st * 1024 + (ob ^ (((ob >> 9) & 1) << 5)); }
__host__ __device__ __forceinline__ void stage_rc(int b, int& R, int& C) { const int st = b / 1024, sb = b % 1024, swz = sb ^ (((sb >> 9) & 1) << 5); R = (st >> 1) * 16 + swz / 64; C = (st & 1) * 32 + (swz % 64) / 2; }
__host__ __device__ __forceinline__ int perm32(int rho) { const int n = rho >> 4, i = rho & 15; return 8 * (i >> 2) + 4 * n + (i & 3); }

struct Unit { int pm, pn, e, mt, roff, nai; };
__device__ __forceinline__ bool split_index(long L, int nwg, int G, int& uidx, int& roff, int& nai) {
    const int R = nwg / G, r = nwg % G; const bool split = (r > 0) && (2 * r <= G);
    if (L < (long)R * G || !split) { if (L >= nwg) return false; uidx = (int)L; roff = 0; nai = 2; return true; }
    const int h = (int)(L - (long)R * G); if (h >= 2 * r) return false; uidx = R * G + (h >> 1); roff = (h & 1) * 128; nai = 1; return true;
}

__device__ __forceinline__ int xcd_remap(int wgid, int nwg) { const int q = nwg / NXCD, r = nwg % NXCD, xcd = wgid % NXCD, off = wgid / NXCD; return (xcd < r ? xcd * (q + 1) : r * (q + 1) + (xcd - r) * q) + off; }

struct DenseOrder {
    const char* A; const char* B; int K; int nM, nN, nwg, G, c;
    __device__ __forceinline__ void init(const bf16* A_, const bf16* B_, int M, int N, int K_, int G_, int c_) { A = (const char*)A_; B = (const char*)B_; K = K_; nM = M / BM; nN = N / BM; nwg = nM * nN; G = G_; c = c_; }
    __device__ __forceinline__ bool next(int i, Unit& u) const {
        int uidx; if (!split_index((long)i * G + c, nwg, G, uidx, u.roff, u.nai)) return false;
        const int wgid = xcd_remap(uidx, nwg);
        const int nig = WGM * nN, gid = wgid / nig, fm = gid * WGM, gsz = (nM - fm) < WGM ? (nM - fm) : WGM;
        u.pm = fm + ((wgid % nig) % gsz); u.pn = (wgid % nig) / gsz; u.e = 0; u.mt = 0; return true;
    }
    __device__ __forceinline__ const char* a_ptr(const Unit& u) const { return A + (size_t)(u.pm * BM + u.roff) * K * 2; }
    __device__ __forceinline__ const char* b_ptr(const Unit& u) const { return B + (size_t)u.pn * BM * K * 2; }
    __device__ __forceinline__ int tok(const Unit&, int) const { return 0; }
};
struct MoeOrder {
    const char* A; const char* B; int K; size_t bstride;
    const LAS int* tab; const int* list; int RT, nwg, G, c;
    __device__ __forceinline__ bool next(int i, Unit& u) const {
        int uidx; if (!split_index((long)i * G + c, nwg, G, uidx, u.roff, u.nai)) return false;
        const int wgid = xcd_remap(uidx, nwg);
        const int rt = wgid >> 2; u.pm = rt; u.pn = wgid & 3; const int t = tab[rt]; u.e = t & 255; u.mt = t >> 8; return true;
    }
    __device__ __forceinline__ const char* a_ptr(const Unit& u) const { return A + (size_t)(u.pm * BM + u.roff) * K * 2; }
    __device__ __forceinline__ const char* b_ptr(const Unit& u) const { return B + (size_t)u.e * bstride + (size_t)u.pn * BM * K * 2; }
    __device__ __forceinline__ int tok(const Unit& u, int r) const { const int cnt = tab[RT_MAX + 1 + u.e]; const int pos = u.mt * BM + u.roff + r; return pos < cnt ? list[(size_t)u.e * TALL + pos] : 0; }
};

__device__ __forceinline__ unsigned cvt_pk_bf16(float lo, float hi) { unsigned r; asm volatile("v_cvt_pk_bf16_f32 %0, %1, %2" : "=v"(r) : "v"(lo), "v"(hi)); return r; }

template <class Epi, class Sched, bool GATHER>
__device__ __forceinline__ void gemm_phase(LAS unsigned char* lds, const int tid, const int K, const Sched& S, const Epi& E) {
    const int wid = __builtin_amdgcn_readfirstlane(tid >> 6), lane = tid & 63, wr = wid >> 2, wc = wid & 3, fr = lane & 15, fq = lane >> 4;
    const int nt = K / BK;
    unsigned voffA[2], voffB[2]; int RA[2], CA[2];
#pragma unroll
    for (int i = 0; i < 2; ++i) { int R, C; stage_rc(tid * 16 + i * 8192, R, C); const int Rb = Epi::PERM ? ((R & ~31) + perm32(R & 31)) : R;
        RA[i] = R; CA[i] = C; voffA[i] = (unsigned)(R * K + C) * 2u; voffB[i] = (unsigned)(Rb * K + C) * 2u; }
    const size_t kstep = (size_t)(BK * 2);
    const size_t hstep = (size_t)HALF * K * 2;
    const unsigned ldsw = (unsigned)wid * 1024u;
    const int aoff = lds_byte(wr * 64 + fr, fq * 8), boff = lds_byte(wc * 32 + fr, fq * 8);
#define PG8_SA(b, h) (((b) * 2 + (h)) * HTB)
#define PG8_SB(b, h) ((4 + (b) * 2 + (h)) * HTB)
#define PG8_STAGE(bufoff, gbase, voff) do { _Pragma("unroll") for (int _i = 0; _i < 2; ++_i) \
        __builtin_amdgcn_global_load_lds((const unsigned*)((const char*)(gbase) + (voff)[_i]), (LAS unsigned*)(lds + (bufoff) + ldsw + _i * 8192), 16, 0, 0); } while (0)
#define PG8_STAGE_A(bufoff, h, usenext, koff) do { if constexpr (GATHER) { unsigned _vo[2]; _vo[0] = (usenext) ? nvA[h][0] : vA[h][0]; _vo[1] = (usenext) ? nvA[h][1] : vA[h][1]; PG8_STAGE(bufoff, S.A + (koff), _vo); } \
        else { PG8_STAGE(bufoff, ((usenext) ? nA : cA) + (size_t)(h) * hstep + (koff), voffA); } } while (0)
#define PG8_LDA(dst, b, h) do { _Pragma("unroll") for (int m = 0; m < 4; ++m) _Pragma("unroll") for (int k = 0; k < 2; ++k) dst[m][k] = *(const LAS bf16x8*)(lds + PG8_SA(b, h) + aoff + m * 2048 + k * 1024); } while (0)
#define PG8_LDB(dst, b, h) do { _Pragma("unroll") for (int n = 0; n < 2; ++n) _Pragma("unroll") for (int k = 0; k < 2; ++k) dst[n][k] = *(const LAS bf16x8*)(lds + PG8_SB(b, h) + boff + n * 2048 + k * 1024); } while (0)
#define PG8_MMA(ai, bj, At, Bt) do { __builtin_amdgcn_s_setprio(1); _Pragma("unroll") for (int m = 0; m < 4; ++m) _Pragma("unroll") for (int n = 0; n < 2; ++n) _Pragma("unroll") for (int k = 0; k < 2; ++k) \
        acc[ai][bj][m][n] = __builtin_amdgcn_mfma_f32_16x16x32_bf16(Bt[n][k], At[m][k], acc[ai][bj][m][n], 0, 0, 0); __builtin_amdgcn_s_setprio(0); } while (0)
#define PG8_WAIT_V(n) asm volatile("s_waitcnt vmcnt(" #n ")" ::: "memory")
#define PG8_WAIT_L(n) asm volatile("s_waitcnt lgkmcnt(" #n ")" ::: "memory")
#define PG8_BAR __builtin_amdgcn_s_barrier()
#define PG8_SCHED __builtin_amdgcn_sched_barrier(0)
    Unit cur, nxt; int ui = 0;
    if (!S.next(0, cur)) return;
    f32x4 acc[2][2][4][2];
#pragma unroll
    for (int a = 0; a < 2; ++a)
#pragma unroll
        for (int b = 0; b < 2; ++b)
#pragma unroll
            for (int m = 0; m < 4; ++m)
#pragma unroll
                for (int n = 0; n < 2; ++n) acc[a][b][m][n] = (f32x4){0.f, 0.f, 0.f, 0.f};
    bf16x8 At[4][2], B0[2][2], B1[2][2];
    unsigned vA[2][2], nvA[2][2];
    if constexpr (GATHER) {
#pragma unroll
        for (int h = 0; h < 2; ++h)
#pragma unroll
            for (int i = 0; i < 2; ++i) { vA[h][i] = (unsigned)(S.tok(cur, h * HALF + RA[i]) * K + CA[i]) * 2u; nvA[h][i] = vA[h][i]; }
    }
    const char* cA = S.a_ptr(cur); const char* cB = S.b_ptr(cur); const char* nA = cA;
    PG8_STAGE(PG8_SB(0, 0), cB, voffB); PG8_STAGE(PG8_SB(0, 1), cB + hstep, voffB); PG8_STAGE_A(PG8_SA(0, 0), 0, false, 0); PG8_STAGE_A(PG8_SA(0, 1), 1, false, 0);
    if (wr == 1) PG8_BAR;
    PG8_WAIT_V(2); PG8_BAR;
    PG8_STAGE(PG8_SB(1, 0), cB + kstep, voffB); PG8_STAGE_A(PG8_SA(1, 0), 0, false, kstep); PG8_STAGE(PG8_SB(1, 1), cB + hstep + kstep, voffB);
    PG8_WAIT_V(6); PG8_BAR;
    for (;;) {
        const bool has_next = S.next(ui + 1, nxt);
        nA = has_next ? S.a_ptr(nxt) : cA; const char* nB = has_next ? S.b_ptr(nxt) : cB;
        if constexpr (GATHER) {
            if (has_next) {
#pragma unroll
                for (int h = 0; h < 2; ++h)
#pragma unroll
                    for (int i = 0; i < 2; ++i) nvA[h][i] = (unsigned)(S.tok(nxt, h * HALF + RA[i]) * K + CA[i]) * 2u;
            }
        }
        const bool full = (cur.nai == 2);
        for (int t = 0; t < nt; t += 2) {
            const bool last = (t == nt - 2);
            const size_t k1 = (size_t)(t + 1) * kstep;
            const size_t k2 = last ? 0 : (size_t)(t + 2) * kstep, k3 = k2 + kstep;
            const char* b2 = last ? nB : cB + (size_t)(t + 2) * kstep; const char* b3 = b2 + kstep;
            PG8_LDB(B0, 0, 0); PG8_LDB(B1, 0, 1); PG8_SCHED; PG8_LDA(At, 0, 0); PG8_STAGE_A(PG8_SA(1, 1), 1, false, k1);
            PG8_WAIT_V(8); PG8_WAIT_L(0); PG8_BAR; PG8_MMA(0, 0, At, B0); PG8_MMA(0, 1, At, B1); PG8_BAR; PG8_SCHED;
            if (full) PG8_LDA(At, 0, 1); PG8_STAGE(PG8_SB(0, 0), b2, voffB); PG8_STAGE(PG8_SB(0, 1), b2 + hstep, voffB); PG8_STAGE_A(PG8_SA(0, 0), 0, last, k2);
            PG8_WAIT_V(8); PG8_WAIT_L(0); PG8_BAR; if (full) { PG8_MMA(1, 0, At, B0); PG8_MMA(1, 1, At, B1); } PG8_BAR; PG8_SCHED;
            PG8_LDB(B0, 1, 0); PG8_LDB(B1, 1, 1); PG8_SCHED; PG8_LDA(At, 1, 0); PG8_STAGE_A(PG8_SA(0, 1), 1, last, k2);
            PG8_WAIT_V(8); PG8_WAIT_L(0); PG8_BAR; PG8_MMA(0, 0, At, B0); PG8_MMA(0, 1, At, B1); PG8_BAR; PG8_SCHED;
            if (full) PG8_LDA(At, 1, 1); PG8_STAGE(PG8_SB(1, 0), b3, voffB); PG8_STAGE(PG8_SB(1, 1), b3 + hstep, voffB); PG8_STAGE_A(PG8_SA(1, 0), 0, last, k3);
            PG8_WAIT_V(8); PG8_WAIT_L(0); PG8_BAR; if (full) { PG8_MMA(1, 0, At, B0); PG8_MMA(1, 1, At, B1); } PG8_BAR; PG8_SCHED;
        }
        if (wr == 0) PG8_BAR;
        E(acc, cur, wr, wc, fr, fq);
        if (!has_next) break;
#pragma unroll
        for (int a = 0; a < 2; ++a)
#pragma unroll
            for (int b = 0; b < 2; ++b)
#pragma unroll
                for (int m = 0; m < 4; ++m)
#pragma unroll
                    for (int n = 0; n < 2; ++n) acc[a][b][m][n] = (f32x4){0.f, 0.f, 0.f, 0.f};
        cur = nxt; cA = nA; cB = nB; ++ui;
        if constexpr (GATHER) {
#pragma unroll
            for (int h = 0; h < 2; ++h)
#pragma unroll
                for (int i = 0; i < 2; ++i) vA[h][i] = nvA[h][i];
        }
        if (wr == 1) PG8_BAR;
    }
    PG8_WAIT_V(0);
    PG8_BAR;
#undef PG8_SA
#undef PG8_SB
#undef PG8_STAGE
#undef PG8_STAGE_A
#undef PG8_LDA
#undef PG8_LDB
#undef PG8_MMA
#undef PG8_WAIT_V
#undef PG8_WAIT_L
#undef PG8_BAR
#undef PG8_SCHED
}
}

namespace pg8 {
__device__ __forceinline__ void row_bt(int row, int& b, int& tok) { if (row < TX) { b = row >> 11; tok = row & 2047; } else { const int r = row - TX; b = r >> 8; tok = SEQ + (r & 255); } }

struct EpiAttnIn {
    static constexpr bool PERM = true;
    bf16* QKV; bf16* VAT; bf16* VBT; const LAS float* rope;
    __device__ __forceinline__ void operator()(const f32x4 (&acc)[2][2][4][2], const Unit& u, int wr, int wc, int fr, int fq) const {
        const int row0 = u.pm * BM + u.roff + wr * 64 + fr; const int seg = u.pn >> 1;
        const bool latent = u.pm < (TX / BM);
        if (seg == 2 || seg == 5) {
#pragma unroll
            for (int ai = 0; ai < 2; ++ai) if (ai < u.nai)
#pragma unroll
                for (int m = 0; m < 4; ++m) { const int row = row0 + ai * HALF + m * 16; int b, tok; row_bt(row, b, tok);
#pragma unroll
                    for (int bj = 0; bj < 2; ++bj) { const int col = u.pn * BM + bj * HALF + wc * 32 + 8 * fq;
                        bf16* dst;
                        if (seg == 2) { const int cs = col - 1024; dst = VAT + ((size_t)(b * 4 + (cs >> 7)) * 128 + (cs & 127)) * NKEY + tok; }
                        else { const int cs = col - 2560; dst = VBT + ((size_t)(b * 8 + (cs >> 6)) * 64 + (cs & 63)) * NKEY + tok; }
#pragma unroll
                        for (int n = 0; n < 2; ++n)
#pragma unroll
                            for (int i = 0; i < 4; ++i) dst[(size_t)(4 * n + i) * NKEY] = (bf16)f2bf(acc[ai][bj][m][n][i]); } }
            return;
        }
        const bool dorope = latent && seg < 2;
        const float qs = (seg == 0 || seg == 3) ? 0.125f * LOG2E : 1.0f;
#pragma unroll
        for (int ai = 0; ai < 2; ++ai) if (ai < u.nai)
#pragma unroll
            for (int m = 0; m < 4; ++m) { const int row = row0 + ai * HALF + m * 16;
                f32x4 cs4[4];
                if (dorope) { const int t = row & 2047; const int pos = (wc & 1) ? (t & 63) : (t >> 6);
                    const LAS f32x4* rp = (const LAS f32x4*)(rope + (pos * 16 + 8 * (fq & 1)) * 2);
#pragma unroll
                    for (int j = 0; j < 4; ++j) cs4[j] = rp[j]; }
#pragma unroll
                for (int bj = 0; bj < 2; ++bj) { const int col = u.pn * BM + bj * HALF + wc * 32 + 8 * fq;
                    float v[8];
#pragma unroll
                    for (int n = 0; n < 2; ++n)
#pragma unroll
                        for (int i = 0; i < 4; ++i) v[4 * n + i] = acc[ai][bj][m][n][i];
                    if (dorope) {
#pragma unroll
                        for (int j = 0; j < 8; ++j) { const float other = __shfl_xor(v[j], 32); const float c = cs4[j >> 1][(j & 1) * 2], s = cs4[j >> 1][(j & 1) * 2 + 1];
                            v[j] = (fq < 2) ? (v[j] * c - other * s) : (v[j] * c + other * s); } }
                    u32x4 w; w.x = pk2(v[0] * qs, v[1] * qs); w.y = pk2(v[2] * qs, v[3] * qs); w.z = pk2(v[4] * qs, v[5] * qs); w.w = pk2(v[6] * qs, v[7] * qs);
                    *(u32x4*)(QKV + (size_t)row * NATT + col) = w; } }
    }
};
struct EpiGlaIn {
    static constexpr bool PERM = true;
    bf16* QKV2; bf16* VGT;
    __device__ __forceinline__ void operator()(const f32x4 (&acc)[2][2][4][2], const Unit& u, int wr, int wc, int fr, int fq) const {
        const int row0 = u.pm * BM + u.roff + wr * 64 + fr;
        if (u.pn >= 4 && u.pn < 8) {
#pragma unroll
            for (int ai = 0; ai < 2; ++ai) if (ai < u.nai)
#pragma unroll
                for (int m = 0; m < 4; ++m) { const int row = row0 + ai * HALF + m * 16; int b, tok; row_bt(row, b, tok);
#pragma unroll
                    for (int bj = 0; bj < 2; ++bj) { const int cs = u.pn * BM + bj * HALF + wc * 32 + 8 * fq - 1024;
                        bf16* dst = VGT + ((size_t)(b * 4 + (cs >> 8)) * 256 + (cs & 255)) * NKEY + tok;
#pragma unroll
                        for (int n = 0; n < 2; ++n)
#pragma unroll
                            for (int i = 0; i < 4; ++i) dst[(size_t)(4 * n + i) * NKEY] = (bf16)f2bf(acc[ai][bj][m][n][i]); } }
            return;
        }
        const float qs = (u.pn < 2) ? 0.08838834764831845f : 1.0f;
#pragma unroll
        for (int ai = 0; ai < 2; ++ai) if (ai < u.nai)
#pragma unroll
            for (int m = 0; m < 4; ++m) { const int row = row0 + ai * HALF + m * 16;
#pragma unroll
                for (int bj = 0; bj < 2; ++bj) { const int col = u.pn * BM + bj * HALF + wc * 32 + 8 * fq; const f32x4 a = acc[ai][bj][m][0] * qs, c = acc[ai][bj][m][1] * qs;
                    u32x4 w; w.x = pk2(a[0], a[1]); w.y = pk2(a[2], a[3]); w.z = pk2(c[0], c[1]); w.w = pk2(c[2], c[3]);
                    *(u32x4*)(QKV2 + (size_t)row * NGLA + col) = w; } }
    }
};
struct EpiResid {
    static constexpr bool PERM = false;
    const float* IL; const float* IC; float* XL; float* XC; const float* modv;
    __device__ __forceinline__ void operator()(const f32x4 (&acc)[2][2][4][2], const Unit& u, int wr, int wc, int fr, int fq) const {
        const int row0 = u.pm * BM + u.roff + wr * 64 + fr, col0 = u.pn * BM + wc * 32 + 4 * fq;
        const bool latent = u.pm < (TX / BM); const int bi = latent ? (u.pm >> 3) : 8;
        float* base = latent ? XL : (XC - (size_t)TX * D); const float* ibase = latent ? IL : (IC - (size_t)TX * D);
        f32x4 gv[2][2];
#pragma unroll
        for (int bj = 0; bj < 2; ++bj)
#pragma unroll
            for (int n = 0; n < 2; ++n) gv[bj][n] = *(const f32x4*)(modv + bi * 6144 + col0 + bj * HALF + n * 16);
#pragma unroll
        for (int ai = 0; ai < 2; ++ai) if (ai < u.nai)
#pragma unroll
            for (int m = 0; m < 4; ++m) { const size_t ro = (size_t)(row0 + ai * HALF + m * 16) * D + col0;
#pragma unroll
                for (int bj = 0; bj < 2; ++bj)
#pragma unroll
                    for (int n = 0; n < 2; ++n) { const size_t o = ro + bj * HALF + n * 16; *(f32x4*)(base + o) = *(const f32x4*)(ibase + o) + gv[bj][n] * acc[ai][bj][m][n]; } }
    }
};
struct EpiMoe1 {
    static constexpr bool PERM = false;
    bf16* HB;
    __device__ __forceinline__ void operator()(const f32x4 (&acc)[2][2][4][2], const Unit& u, int wr, int wc, int fr, int fq) const {
        const int row0 = u.pm * BM + u.roff + wr * 64 + fr, col0 = u.pn * 128 + wc * 16 + 4 * fq;
#pragma unroll
        for (int ai = 0; ai < 2; ++ai) if (ai < u.nai)
#pragma unroll
            for (int m = 0; m < 4; ++m) { bf16* rowp = HB + (size_t)(row0 + ai * HALF + m * 16) * DEXP + col0;
#pragma unroll
                for (int bj = 0; bj < 2; ++bj) { const f32x4 a = acc[ai][bj][m][0], b = acc[ai][bj][m][1];
                    u32x2 w; w.x = pk2(silu_f(a[0]) * b[0], silu_f(a[1]) * b[1]); w.y = pk2(silu_f(a[2]) * b[2], silu_f(a[3]) * b[3]);
                    *(u32x2*)(rowp + bj * 64) = w; } }
    }
};
struct EpiBf16 {
    static constexpr bool PERM = true;
    bf16* O; int ldc;
    __device__ __forceinline__ void operator()(const f32x4 (&acc)[2][2][4][2], const Unit& u, int wr, int wc, int fr, int fq) const {
        const int row0 = u.pm * BM + u.roff + wr * 64 + fr, col0 = u.pn * BM + wc * 32 + 8 * fq;
#pragma unroll
        for (int ai = 0; ai < 2; ++ai) if (ai < u.nai)
#pragma unroll
            for (int m = 0; m < 4; ++m) { bf16* rowp = O + (size_t)(row0 + ai * HALF + m * 16) * ldc + col0;
#pragma unroll
                for (int bj = 0; bj < 2; ++bj) { const f32x4 a = acc[ai][bj][m][0], c = acc[ai][bj][m][1];
                    u32x4 w; w.x = pk2(a[0], a[1]); w.y = pk2(a[2], a[3]); w.z = pk2(c[0], c[1]); w.w = pk2(c[2], c[3]);
                    *(u32x4*)(rowp + bj * HALF) = w; } }
    }
};
}

struct Args {
    const float *x, *c, *ctx, *c_ctx, *w_mod, *b_mod, *norm_g, *final_g, *att_w_in, *att_w_out, *att_lambda, *att_subln_g, *na_bias,
                *gla_w_in, *gla_w_gate, *gla_b_gate, *gla_norm_g, *gla_w_out, *router_w, *router_bias, *moe_w1, *moe_w3, *moe_w2;
    float* out; unsigned char* ws; int ph_lo, ph_hi, rep, pad;
};

struct RowMapId { int off; __device__ __forceinline__ int operator()(int n) const { return off + n; } };
struct RowMapMoe { int which; __device__ __forceinline__ int operator()(int n) const { return 32 * (n >> 4) + 16 * which + (n & 15); } };
template <class RM>
__device__ __forceinline__ void p0_transpose_item(const float* W, int K, int N, bf16* WT, LAS float* scr, int item, int lane, RM rm) {
    const int nblk = N / 32, kb = item / nblk, nb = item % nblk, k0 = 64 * kb, n0 = 32 * nb;
    float ld[32];
#pragma unroll
    for (int i = 0; i < 32; ++i) ld[i] = W[(size_t)(k0 + 2 * i + (lane >> 5)) * N + n0 + (lane & 31)];
#pragma unroll
    for (int i = 0; i < 32; ++i) scr[(2 * i + (lane >> 5)) * 33 + (lane & 31)] = ld[i];
    LDS_WAIT(); asm volatile("" ::: "memory");
    const int c = lane & 7;
#pragma unroll
    for (int j = 0; j < 4; ++j) { const int n = (lane >> 3) + 8 * j; const LAS float* s = scr + (8 * c) * 33 + n;
        u32x4 o; o.x = pk2(s[0 * 33], s[1 * 33]); o.y = pk2(s[2 * 33], s[3 * 33]); o.z = pk2(s[4 * 33], s[5 * 33]); o.w = pk2(s[6 * 33], s[7 * 33]);
        *(u32x4*)(WT + (size_t)rm(n0 + n) * K + k0 + 8 * c) = o; }
    LDS_WAIT(); asm volatile("" ::: "memory");
}

constexpr int CV_ATTIN = 1536, CV_ATTOUT = 512, CV_GLAIN = 1552, CV_GLAPAD = 28, CV_GLAOUT = 512, CV_W = 4096, CV_MOE = 3 * CV_W;
constexpr int CT_ATTN0 = CV_ATTIN + CV_ATTOUT, CT_MOE0 = CT_ATTN0 + CV_MOE, CT_GLA0 = CT_MOE0 + CV_GLAIN + CV_GLAPAD + CV_GLAOUT, CT_ATTN1 = CT_GLA0 + CV_ATTIN + CV_ATTOUT, CT_MOE1 = CT_ATTN1 + CV_MOE,
              CT_MOE2 = CT_MOE1 + CV_MOE, CT_GLA1 = CT_MOE2 + CV_GLAIN + CV_GLAPAD + CV_GLAOUT, CT_MOE3 = CT_GLA1 + CV_MOE, CV_TOTAL = CT_MOE3;
constexpr int CV_UNIT = 16;
struct ConvPtrs { const float *att_w_in, *att_w_out, *gla_w_in, *gla_w_out, *moe_w1, *moe_w3, *moe_w2; unsigned char* ws; };
struct RowMapAny { int moe, which; __device__ __forceinline__ int operator()(int n) const { return moe ? 32 * (n >> 4) + 16 * which + (n & 15) : n; } };
__device__ __forceinline__ void conv_item(const ConvPtrs& P, int it, LAS float* scr, int lane) {
    int kind, j, r;
    if (it < CT_ATTN0) { kind = 0; j = 0; r = it; } else if (it < CT_MOE0) { kind = 2; j = 0; r = it - CT_ATTN0; } else if (it < CT_GLA0) { kind = 1; j = 0; r = it - CT_MOE0; }
    else if (it < CT_ATTN1) { kind = 0; j = 1; r = it - CT_GLA0; } else if (it < CT_MOE1) { kind = 2; j = 1; r = it - CT_ATTN1; } else if (it < CT_MOE2) { kind = 2; j = 2; r = it - CT_MOE1; }
    else if (it < CT_GLA1) { kind = 1; j = 1; r = it - CT_MOE2; } else { kind = 2; j = 3; r = it - CT_GLA1; }
    const float* W; bf16* WT; int K = D, N = D, sub = r; RowMapAny rm{0, 0};
    if (kind == 2) {
        const int which = r / CV_W, q = r % CV_W, e = q >> 8, je = j * 16 + e; sub = q & 255;
        if (which < 2) { W = (which ? P.moe_w3 : P.moe_w1) + (size_t)je * D * DEXP; N = DEXP; WT = (bf16*)(P.ws + WS_W13) + (size_t)je * D * D; rm.moe = 1; rm.which = which; }
        else { W = P.moe_w2 + (size_t)je * DEXP * D; K = DEXP; WT = (bf16*)(P.ws + WS_W2) + (size_t)je * D * DEXP; }
    } else if (kind == 0) {
        if (r < CV_ATTIN) { W = P.att_w_in + (size_t)j * D * NATT; N = NATT; WT = (bf16*)(P.ws + WS_WATTIN) + (size_t)j * NATT * D; }
        else { W = P.att_w_out + (size_t)j * D * D; WT = (bf16*)(P.ws + WS_WATTOUT) + (size_t)j * D * D; sub = r - CV_ATTIN; }
    } else {
        if (r < CV_GLAIN) { W = P.gla_w_in + (size_t)j * D * 3104; N = 3104; WT = (bf16*)(P.ws + WS_WGLAIN) + (size_t)j * NGLA * D; }
        else if (r < CV_GLAIN + CV_GLAPAD) { const int c0 = (r - CV_GLAIN) * 1024;
            for (int i = lane; i < 1024; i += 64) *(u32x4*)((bf16*)(P.ws + WS_WGLAIN) + (size_t)j * NGLA * D + (size_t)3104 * D + (size_t)(c0 + i) * 8) = (u32x4){0u, 0u, 0u, 0u};
            return; }
        else { W = P.gla_w_out + (size_t)j * D * D; WT = (bf16*)(P.ws + WS_WGLAOUT) + (size_t)j * D * D; sub = r - CV_GLAIN - CV_GLAPAD; }
    }
    p0_transpose_item(W, K, N, WT, scr, sub, lane, rm);
}
__device__ __forceinline__ void conv_static(const ConvPtrs& P, int cur, int need, LAS unsigned char* lds, int lane, int wave, int vcu, int G) {
    LAS float* scr = (LAS float*)(lds + wave * 8448);
    for (int it = cur + vcu * 8 + wave; it < need; it += G * 8) conv_item(P, it, scr, lane);
}
__device__ __forceinline__ void conv_unit(const ConvPtrs& P, int i0, int hi, LAS unsigned char* lds, int lane, int wave) {
    LAS float* scr = (LAS float*)(lds + wave * 8448);
#pragma unroll 1
    for (int k = 0; k < CV_UNIT / 8; ++k) { const int it = i0 + wave * (CV_UNIT / 8) + k; if (it < hi) conv_item(P, it, scr, lane); }
}

template <class AP> __device__ __forceinline__ void p0_prologue(const AP ap, LAS unsigned char* lds, int tid, int lane, int wave, int vcu, int G) {
    unsigned char* ws = ap->ws;
    LAS float* S9 = (LAS float*)(lds + 69632);
    LAS float* red = (LAS float*)(lds + 106496);
    { const ConvPtrs P{ap->att_w_in, ap->att_w_out, ap->gla_w_in, ap->gla_w_out, ap->moe_w1, ap->moe_w3, ap->moe_w2, ws};
      conv_static(P, 0, MK_CONVQ ? CT_ATTN0 : CV_TOTAL, lds, lane, wave, vcu, G); }
    __syncthreads();
    { const float* cc = ap->c; const float* cx = ap->c_ctx;
      for (int i = tid; i < 9 * 1024; i += 512) { const int bi = i >> 10, k = i & 1023; const float v = (bi < 8) ? cc[bi * D + k] : cx[k]; S9[i] = v / (1.0f + __expf(-v)); } }
    __syncthreads();
    const float* w_mod = ap->w_mod; const float* b_mod = ap->b_mod;
    for (int u = vcu; u < 4 * 96; u += G) {
        const int L = u / 96, n0 = (u % 96) * 64;
        const float* W = w_mod + (size_t)L * D * 6144 + n0 + lane;
        float acc[9];
#pragma unroll
        for (int bi = 0; bi < 9; ++bi) acc[bi] = 0.f;
        const int kb = wave * 128;
        for (int k0 = 0; k0 < 128; k0 += 32) { float wv[32];
#pragma unroll
            for (int k = 0; k < 32; ++k) wv[k] = W[(size_t)(kb + k0 + k) * 6144];
#pragma unroll
            for (int k = 0; k < 32; ++k)
#pragma unroll
                for (int bi = 0; bi < 9; ++bi) acc[bi] += S9[bi * 1024 + kb + k0 + k] * wv[k]; }
#pragma unroll
        for (int bi = 0; bi < 9; ++bi) red[(wave * 9 + bi) * 64 + lane] = acc[bi];
        __syncthreads();
        for (int i = tid; i < 9 * 64; i += 512) { const int bi = i >> 6, l = i & 63; float sm = b_mod[L * 6144 + n0 + l];
#pragma unroll
            for (int w = 0; w < 8; ++w) sm += red[(w * 9 + bi) * 64 + l];
            ((float*)(ws + WS_MODV))[(size_t)(L * 9 + bi) * 6144 + n0 + l] = sm; }
        __syncthreads();
    }
}

__device__ __forceinline__ float* xrow_ptr(float* XL, float* XC, int row) { return row < TX ? XL + (size_t)row * D : XC + (size_t)(row - TX) * D; }
__device__ __forceinline__ int row_bi(int row) { return row < TX ? (row >> 11) : 8; }

__device__ __forceinline__ void norm_mod_store(const f32x4 (&v)[4], const float* g, const float* sh, const float* sc, bf16* orow, int lane) {
    float ss = 0.f;
#pragma unroll
    for (int j = 0; j < 4; ++j) ss += (v[j].x * v[j].x + v[j].y * v[j].y) + (v[j].z * v[j].z + v[j].w * v[j].w);
    const float rs = __builtin_amdgcn_rsqf(wave_sum(ss) * (1.0f / D) + EPSF);
#pragma unroll
    for (int j = 0; j < 4; ++j) { const int c = 4 * lane + 256 * j; const f32x4 gg = *(const f32x4*)(g + c), s1 = *(const f32x4*)(sc + c), s0 = *(const f32x4*)(sh + c);
        const f32x4 y = (v[j] * rs) * gg * (1.0f + s1) + s0;
        u32x2 w; w.x = pk2(y.x, y.y); w.y = pk2(y.z, y.w); *(u32x2*)(orow + c) = w; }
}

__device__ __forceinline__ void phase_norm1(const float* XL, const float* XC, const float* g, const float* modv, bf16* H, int nrows, int lane, int wave, int vcu, int G) {
    for (int row = vcu * 8 + wave; row < nrows; row += G * 8) {
        const f32x4* xr = (const f32x4*)(row < TX ? XL + (size_t)row * D : XC + (size_t)(row - TX) * D) + lane; f32x4 v[4];
#pragma unroll
        for (int j = 0; j < 4; ++j) v[j] = xr[64 * j];
        const float* mv = modv + row_bi(row) * 6144;
        norm_mod_store(v, g, mv, mv + 1024, H + (size_t)row * D, lane);
    }
}

__device__ __forceinline__ void phase_router(float* XL, float* XC, const float* g, const float* modv, bf16* H, const float* router_w, const float* router_bias,
                                             unsigned* cnt  , int* list, int* toki, float* tokw, int nrows,
                                             LAS unsigned char* lds, int tid, int lane, int wave, int vcu, int G, int probe) {
    LAS float* RW = (LAS float*)lds;
    LAS int* lcnt = (LAS int*)(lds + 65536);
    LAS int* rinfo = (LAS int*)(lds + 65536 + 256);
    for (int it = 0; it < 8; ++it) { const int idx = tid + 512 * it, k = idx >> 2, q = idx & 3; const f32x4 w = *(const f32x4*)(router_w + k * 16 + 4 * q);
        RW[(4 * q + 0) * 1024 + k] = w.x; RW[(4 * q + 1) * 1024 + k] = w.y; RW[(4 * q + 2) * 1024 + k] = w.z; RW[(4 * q + 3) * 1024 + k] = w.w; }
    if (tid < 32) lcnt[tid] = 0;
    __syncthreads();
    const int rpb = nrows / G, rpw = rpb / 8;
    const int gI = lane >> 4;
    const f32x4 rb = *(const f32x4*)(router_bias + 4 * gI);
    for (int rep = (probe ? 0 : 1); rep < 2; ++rep)
    for (int i0 = 0; i0 < rpw; i0 += 3) {
        asm volatile("" ::: "memory");
        f32x4 y[3][4];
#pragma unroll
        for (int r = 0; r < 3; ++r) {
            const int ii = (i0 + r < rpw) ? i0 + r : rpw - 1; const int row = vcu * rpb + wave * rpw + ii;
            const f32x4* xr = (const f32x4*)xrow_ptr(XL, XC, row) + lane; f32x4 v[4];
#pragma unroll
            for (int j = 0; j < 4; ++j) v[j] = xr[64 * j];
            const float* mv = modv + row_bi(row) * 6144 + 3072;
            float ss = 0.f;
#pragma unroll
            for (int j = 0; j < 4; ++j) ss += (v[j].x * v[j].x + v[j].y * v[j].y) + (v[j].z * v[j].z + v[j].w * v[j].w);
            const float rs = __builtin_amdgcn_rsqf(wave_sum(ss) * (1.0f / D) + EPSF);
#pragma unroll
            for (int j = 0; j < 4; ++j) { const int c = 4 * lane + 256 * j; const f32x4 gg = *(const f32x4*)(g + c), s1 = *(const f32x4*)(mv + 1024 + c), s0 = *(const f32x4*)(mv + c);
                y[r][j] = (v[j] * rs) * gg * (1.0f + s1) + s0;
                u32x2 w; w.x = cvtpk(y[r][j].x, y[r][j].y); w.y = cvtpk(y[r][j].z, y[r][j].w); *(u32x2*)(H + (size_t)row * D + c) = w; }
            __builtin_amdgcn_sched_barrier(0);
        }
        float p[3][16];
#pragma unroll
        for (int e = 0; e < 16; ++e) {
#pragma unroll
            for (int r = 0; r < 3; ++r) p[r][e] = 0.f;
#pragma unroll
            for (int j = 0; j < 4; ++j) { const f32x4 w = *(const LAS f32x4*)(RW + e * 1024 + 4 * lane + 256 * j);
#pragma unroll
                for (int r = 0; r < 3; ++r) p[r][e] += (y[r][j].x * w.x + y[r][j].y * w.y) + (y[r][j].z * w.z + y[r][j].w * w.w); }
#pragma unroll
            for (int r = 0; r < 3; ++r) asm volatile("" : "+v"(p[r][e])); }
#pragma unroll
        for (int r = 0; r < 3; ++r) {
            float q8[8], lg[4];
#pragma unroll
            for (int j = 0; j < 8; ++j) q8[j] = swap32_add(p[r][j], p[r][j + 8]);
#pragma unroll
            for (int j = 0; j < 4; ++j) lg[j] = row_sum(swap16_add(q8[j], q8[j + 4]));
            float sc[4], sel[4];
#pragma unroll
            for (int j = 0; j < 4; ++j) { sc[j] = 1.0f / (1.0f + __expf(-lg[j])); sel[j] = sc[j] + rb[j]; }
            int i1 = 0, i2 = 0; float m1 = -1e30f, m2 = -1e30f, w1 = 0.f, w2 = 0.f;
#pragma unroll
            for (int j = 0; j < 4; ++j) { const float t = sel[j];
                if (t > m1) { m2 = m1; i2 = i1; w2 = w1; m1 = t; i1 = j; w1 = sc[j]; } else if (t > m2) { m2 = t; i2 = j; w2 = sc[j]; } }
            const float gs = m1 + m2;
            const float g0 = readlane_f(gs, 0), g1 = readlane_f(gs, 16), g2 = readlane_f(gs, 32), g3 = readlane_f(gs, 48);
            int bg = 0; float bgs = g0; if (g1 > bgs) { bgs = g1; bg = 1; } if (g2 > bgs) { bgs = g2; bg = 2; } if (g3 > bgs) { bgs = g3; bg = 3; }
            bg = __builtin_amdgcn_readfirstlane(bg);
            const int e0 = 4 * bg + __builtin_amdgcn_readlane(i1, 16 * bg), e1 = 4 * bg + __builtin_amdgcn_readlane(i2, 16 * bg);
            const float w0 = readlane_f(w1, 16 * bg), w1s = readlane_f(w2, 16 * bg);
            const float wn = 1.0f / (w0 + w1s);
            if (lane == 0 && rep == 1 && i0 + r < rpw) { const int rl = wave * rpw + i0 + r;
                const int p0 = __hip_atomic_fetch_add(&lcnt[e0], 1, __ATOMIC_RELAXED, __HIP_MEMORY_SCOPE_WORKGROUP), p1 = __hip_atomic_fetch_add(&lcnt[e1], 1, __ATOMIC_RELAXED, __HIP_MEMORY_SCOPE_WORKGROUP);
                rinfo[rl * 6 + 0] = e0; rinfo[rl * 6 + 1] = p0; rinfo[rl * 6 + 2] = e1; rinfo[rl * 6 + 3] = p1;
                rinfo[rl * 6 + 4] = __builtin_bit_cast(int, w0 * wn); rinfo[rl * 6 + 5] = __builtin_bit_cast(int, w1s * wn); }
        }
    }
    __syncthreads();
    if (tid < 16) lcnt[16 + tid] = (int)__hip_atomic_fetch_add(cnt + 64 * tid, (unsigned)lcnt[tid], RLX_AGENT);
    __syncthreads();
    if (tid < rpb) { const int row = vcu * rpb + tid; const int e0 = rinfo[tid * 6 + 0], e1 = rinfo[tid * 6 + 2];
        const int p0 = lcnt[16 + e0] + rinfo[tid * 6 + 1], p1 = lcnt[16 + e1] + rinfo[tid * 6 + 3];
        list[(size_t)e0 * TALL + p0] = row; list[(size_t)e1 * TALL + p1] = row;
        toki[row * 4 + 0] = e0; toki[row * 4 + 1] = p0; toki[row * 4 + 2] = e1; toki[row * 4 + 3] = p1;
        tokw[row * 2 + 0] = __builtin_bit_cast(float, rinfo[tid * 6 + 4]); tokw[row * 2 + 1] = __builtin_bit_cast(float, rinfo[tid * 6 + 5]); }
    __syncthreads();
}

__device__ __forceinline__ int build_moe_table(const unsigned* cnt, LAS int* tab, int tid) {
    if (tid < 16) tab[RT_MAX + 1 + tid] = (int)__hip_atomic_load(cnt + 64 * tid, RLX_AGENT);
    __syncthreads();
    if (tid == 0) { int rt = 0;
        for (int e = 0; e < 16; ++e) { const int c = tab[RT_MAX + 1 + e]; const int nt = (c + 255) >> 8;
            for (int m = 0; m < nt; ++m) { if (rt < RT_MAX) tab[rt] = e | (m << 8); ++rt; } }
        tab[RT_MAX] = rt < RT_MAX ? rt : RT_MAX; }
    __syncthreads();
    return tab[RT_MAX];
}

__device__ __forceinline__ void phase_combine(float* XL, float* XC, const float* modv  , const bf16* YB, const unsigned* cnt, const int* toki, const float* tokw,
                                              bool final_layer, const float* gnext, const float* modv_next, bf16* H, int nrows, int lane, int wave, int vcu, int G, int probe) {
    int tiles = 0; if (lane < 16) tiles = ((int)__hip_atomic_load(cnt + 64 * lane, RLX_AGENT) + 255) >> 8;
    int incl = tiles;
#pragma unroll
    for (int o = 1; o < 16; o <<= 1) { const int t = __shfl_up(incl, o); if (lane >= o) incl += t; }
    const int mybase = (incl - tiles) * 256;
    for (int rep = (probe ? 0 : 1); rep < 2; ++rep)
    for (int row = vcu * 8 + wave; row < nrows; row += G * 8) {
        const int e0 = toki[row * 4 + 0], p0 = toki[row * 4 + 1], e1 = toki[row * 4 + 2], p1 = toki[row * 4 + 3];
        const float w0 = tokw[row * 2 + 0], w1 = tokw[row * 2 + 1];
        const int s0 = __shfl(mybase, e0) + p0, s1 = __shfl(mybase, e1) + p1;
        float* xp = xrow_ptr(XL, XC, row);
        const float* g2 = modv + row_bi(row) * 6144 + 5120;
        f32x4 v[4];
#pragma unroll
        for (int j = 0; j < 4; ++j) { const int c = 4 * lane + 256 * j;
            const u32x2 a = *(const u32x2*)(YB + (size_t)s0 * D + c), b = *(const u32x2*)(YB + (size_t)s1 * D + c);
            f32x4 y; y.x = w0 * bflo(a.x) + w1 * bflo(b.x); y.y = w0 * bfhi(a.x) + w1 * bfhi(b.x); y.z = w0 * bflo(a.y) + w1 * bflo(b.y); y.w = w0 * bfhi(a.y) + w1 * bfhi(b.y);
            v[j] = *(const f32x4*)(xp + c) + *(const f32x4*)(g2 + c) * y; }
        if (final_layer) {
            float ss = 0.f;
#pragma unroll
            for (int j = 0; j < 4; ++j) ss += (v[j].x * v[j].x + v[j].y * v[j].y) + (v[j].z * v[j].z + v[j].w * v[j].w);
            const float rs = __builtin_amdgcn_rsqf(wave_sum(ss) * (1.0f / D) + EPSF);
#pragma unroll
            for (int j = 0; j < 4; ++j) { const int c = 4 * lane + 256 * j; if (rep == 1) *(f32x4*)(xp + c) = (v[j] * rs) * *(const f32x4*)(gnext + c); }
        } else {
            if (rep == 1) {
#pragma unroll
            for (int j = 0; j < 4; ++j) *(f32x4*)(xp + 4 * lane + 256 * j) = v[j]; }
            const float* mv = modv_next + row_bi(row) * 6144;
            norm_mod_store(v, gnext, mv, mv + 1024, H + (size_t)row * D, lane);
        }
    }
}

__device__ __forceinline__ void phase_readout(const bf16* OF, const bf16* OB, const bf16* QKV2, const float* ng, bf16* AOUT, int nrows, int lane, int wave, int vcu, int G) {
    const f32x4 gg = *(const f32x4*)(ng + 4 * lane);
    for (int row = vcu * 8 + wave; row < nrows; row += G * 8) {
#pragma unroll
        for (int j = 0; j < 4; ++j) { const int c = 4 * lane + 256 * j;
            const u32x2 a = *(const u32x2*)(OF + (size_t)row * D + c), b = *(const u32x2*)(OB + (size_t)row * D + c), gt = *(const u32x2*)(QKV2 + (size_t)row * NGLA + 2048 + c);
            f32x4 o; o.x = bflo(a.x) + bflo(b.x); o.y = bfhi(a.x) + bfhi(b.x); o.z = bflo(a.y) + bflo(b.y); o.w = bfhi(a.y) + bfhi(b.y);
            const float ss = wave_sum((o.x * o.x + o.y * o.y) + (o.z * o.z + o.w * o.w));
            const float rs = __builtin_amdgcn_rsqf(ss * (1.0f / 256.0f) + EPSF);
            f32x4 gv; gv.x = silu_f(bflo(gt.x)); gv.y = silu_f(bfhi(gt.x)); gv.z = silu_f(bflo(gt.y)); gv.w = silu_f(bfhi(gt.y));
            const f32x4 y = (o * rs) * gg * gv;
            u32x2 w; w.x = pk2(y.x, y.y); w.y = pk2(y.z, y.w); *(u32x2*)(AOUT + (size_t)row * D + c) = w; }
    }
}

__device__ __forceinline__ int na_r0(int r) { int v = r - 4; return v < 0 ? 0 : (v > 24 ? 24 : v); }
template <int NMAPS, int DV, bool NA>
__device__ __forceinline__ void attn_unit(LAS unsigned char* lds, int tid, int lane, int wave,
                                          const bf16* QKV, int qcol, int qrow0, int kcol, int krow_lat, int krow_ctx, const bf16* VT, int klo, int khi,
                                          int r_wave, int xq0, const LAS float* biasT,
                                          bf16* AOUT, int ocol, float lam, const float* subg, float outscale) {
    constexpr int KB = 9216;
    constexpr int BUFSZ = NMAPS * KB + DV * 144;
    constexpr int NVB = DV / 16, NVR = DV / 64;
    const int fr = lane & 15, g = lane >> 4;
    bf16x8 qf[NMAPS][2];
    { const bf16* qp = QKV + (size_t)(qrow0 + wave * 16 + fr) * NATT + qcol + 8 * g;
#pragma unroll
      for (int m = 0; m < NMAPS; ++m)
#pragma unroll
          for (int s = 0; s < 2; ++s) qf[m][s] = *(const bf16x8*)(qp + m * 64 + 32 * s); }
    f32x4 O[NMAPS][NVB]; float mrun[NMAPS]; float lrun[NMAPS];
#pragma unroll
    for (int m = 0; m < NMAPS; ++m) { mrun[m] = -1e30f; lrun[m] = 0.f;
#pragma unroll
        for (int vb = 0; vb < NVB; ++vb) O[m][vb] = (f32x4){0.f, 0.f, 0.f, 0.f}; }
    const int ntiles = 4 + (khi - klo);
    u32x4 kreg[NMAPS], vreg[NVR];
    const int lkey = tid >> 3, lch = tid & 7;
#define AT_LOAD(i) do { const int _i = (i); const int _rowg = (_i < 4 ? krow_ctx + 64 * _i : krow_lat + 64 * (klo + _i - 4)) + lkey; const int _tok0 = (_i < 4 ? SEQ + 64 * _i : 64 * (klo + _i - 4)); \
        _Pragma("unroll") for (int m = 0; m < NMAPS; ++m) kreg[m] = *(const u32x4*)(QKV + (size_t)_rowg * NATT + kcol + m * 64 + lch * 8); \
        _Pragma("unroll") for (int j = 0; j < NVR; ++j) { const int idx = tid + 512 * j; vreg[j] = *(const u32x4*)(VT + (size_t)(idx >> 3) * NKEY + _tok0 + (idx & 7) * 8); } } while (0)
#define AT_STORE(b) do { LAS unsigned char* _p = lds + (b) * BUFSZ; \
        _Pragma("unroll") for (int m = 0; m < NMAPS; ++m) *(LAS u32x4*)(_p + m * KB + lkey * 144 + lch * 16) = kreg[m]; \
        _Pragma("unroll") for (int j = 0; j < NVR; ++j) { const int idx = tid + 512 * j; *(LAS u32x4*)(_p + NMAPS * KB + (idx >> 3) * 144 + (idx & 7) * 16) = vreg[j]; } } while (0)
    AT_LOAD(0); AT_STORE(0); __syncthreads();
    const int kbase0 = (8 * (fr >> 2) + (fr & 3)) * 144 + 16 * g;
    const int vbase = fr * 144 + 16 * g;
    int r0w = 0, xq = 0, tmask = 3, c0w = 0; float pen[4][4];
    if constexpr (NA) { r0w = na_r0(r_wave); xq = xq0 + fr; int cs = xq - 8; cs = cs < 0 ? 0 : (cs > 48 ? 48 : cs);
        c0w = xq0 - 8; c0w = c0w < 0 ? 0 : (c0w > 32 ? 32 : c0w);
        tmask = 1;
#pragma unroll
        for (int kb = 0; kb < 4; ++kb)
#pragma unroll
            for (int ii = 0; ii < 4; ++ii) { const int y = c0w + 32 * (kb >> 1) + 8 * g + 4 * (kb & 1) + ii; pen[kb][ii] = (y >= cs && y < cs + 16) ? 0.f : -1e30f; } }
    for (int i = 0; i < ntiles; ++i) {
        if (i + 1 < ntiles) AT_LOAD(i + 1);
        const LAS unsigned char* buf = lds + (i & 1) * BUFSZ;
        bool active = true; int kr = 0; bool local = false;
        if constexpr (NA) { if (i >= 4) { local = true; kr = klo + i - 4; active = (kr >= r0w) && (kr < r0w + 8); } }
        if (active) {
            const int tm = local ? tmask : 3;
            const int koffw = local ? c0w * 144 : 0, voffw = local ? c0w * 2 : 0;
            bf16x8 kf[NMAPS][4][2];
#pragma unroll
            for (int m = 0; m < NMAPS; ++m)
#pragma unroll
                for (int kb = 0; kb < 4; ++kb)
#pragma unroll
                    for (int s = 0; s < 2; ++s) kf[m][kb][s] = *(const LAS bf16x8*)(buf + m * KB + kbase0 + koffw + (kb & 1) * (4 * 144) + (kb >> 1) * (32 * 144) + s * 64);
            __builtin_amdgcn_sched_barrier(0);
            f32x4 S[NMAPS][4];
#pragma unroll
            for (int m = 0; m < NMAPS; ++m)
#pragma unroll
                for (int kb = 0; kb < 4; ++kb) { S[m][kb] = (f32x4){0.f, 0.f, 0.f, 0.f};
                    if (!NA || (tm >> (kb >> 1)) & 1) {
#pragma unroll
                        for (int s = 0; s < 2; ++s) S[m][kb] = __builtin_amdgcn_mfma_f32_16x16x32_bf16(kf[m][kb][s], qf[m][s], S[m][kb], 0, 0, 0); } }
            bf16x8 vf0[4][2];
#pragma unroll
            for (int vb = 0; vb < 4; ++vb)
#pragma unroll
                for (int t = 0; t < 2; ++t) vf0[vb][t] = *(const LAS bf16x8*)(buf + NMAPS * KB + vbase + voffw + vb * (16 * 144) + t * 64);
            __builtin_amdgcn_sched_barrier(0);
            bf16x8 pf[NMAPS][2];
#pragma unroll
            for (int m = 0; m < NMAPS; ++m) {
                if constexpr (NA) { if (local) {
                        const LAS float* bp = biasT + (kr - r_wave + 7) * 31 + (c0w + 8 * g - xq + 15);
#pragma unroll
                        for (int kb = 0; kb < 4; ++kb)
#pragma unroll
                            for (int ii = 0; ii < 4; ++ii) { const float t = (tm >> (kb >> 1)) & 1 ? (S[m][kb][ii] + pen[kb][ii]) + bp[32 * (kb >> 1) + 4 * (kb & 1) + ii] : -1e30f; S[m][kb][ii] = t; } } }
                float mx = fmaxf(fmaxf(S[m][0][0], S[m][0][1]), fmaxf(S[m][0][2], S[m][0][3]));
#pragma unroll
                for (int kb = 1; kb < 4; ++kb) mx = fmaxf(fmaxf(mx, S[m][kb][0]), fmaxf(fmaxf(S[m][kb][1], S[m][kb][2]), S[m][kb][3]));
                mx = swap32_max(swap16_max(mx));
                if (__any(mx > mrun[m] + 8.0f)) {
                    const float mnew = fmaxf(mrun[m], mx), alpha = fexp2(mrun[m] - mnew); mrun[m] = mnew; lrun[m] = lrun[m] * alpha;
#pragma unroll
                    for (int vb = 0; vb < NVB; ++vb) O[m][vb] = O[m][vb] * alpha;
                }
                const float mm = mrun[m];
                unsigned pw[8]; float l0 = 0.f, l1 = 0.f;
#pragma unroll
                for (int kb = 0; kb < 4; ++kb) { const float a0 = fexp2(S[m][kb][0] - mm), a1 = fexp2(S[m][kb][1] - mm), a2 = fexp2(S[m][kb][2] - mm), a3 = fexp2(S[m][kb][3] - mm);
                    l0 += a0 + a1; l1 += a2 + a3;
                    pw[2 * kb] = cvtpk(a0, a1); pw[2 * kb + 1] = cvtpk(a2, a3); }
                lrun[m] += l0 + l1;
                pf[m][0] = __builtin_bit_cast(bf16x8, (u32x4){pw[0], pw[1], pw[2], pw[3]});
                pf[m][1] = __builtin_bit_cast(bf16x8, (u32x4){pw[4], pw[5], pw[6], pw[7]});
            }
            __builtin_amdgcn_sched_barrier(0);
            if constexpr (NVB == 8) {
                bf16x8 vf1[4][2];
#pragma unroll
                for (int vb = 0; vb < 4; ++vb)
#pragma unroll
                    for (int t = 0; t < 2; ++t) vf1[vb][t] = *(const LAS bf16x8*)(buf + NMAPS * KB + vbase + (4 + vb) * (16 * 144) + t * 64);
                __builtin_amdgcn_sched_barrier(0);
#pragma unroll
                for (int vb = 0; vb < 4; ++vb)
#pragma unroll
                    for (int t = 0; t < 2; ++t)
#pragma unroll
                        for (int m = 0; m < NMAPS; ++m) O[m][vb] = __builtin_amdgcn_mfma_f32_16x16x32_bf16(vf0[vb][t], pf[m][t], O[m][vb], 0, 0, 0);
                __builtin_amdgcn_sched_barrier(0);
#pragma unroll
                for (int vb = 0; vb < 4; ++vb)
#pragma unroll
                    for (int t = 0; t < 2; ++t)
#pragma unroll
                        for (int m = 0; m < NMAPS; ++m) O[m][4 + vb] = __builtin_amdgcn_mfma_f32_16x16x32_bf16(vf1[vb][t], pf[m][t], O[m][4 + vb], 0, 0, 0);
            } else {
#pragma unroll
                for (int vb = 0; vb < 4; ++vb)
#pragma unroll
                    for (int t = 0; t < 2; ++t) { if (!NA || (tm >> t) & 1) {
#pragma unroll
                            for (int m = 0; m < NMAPS; ++m) O[m][vb] = __builtin_amdgcn_mfma_f32_16x16x32_bf16(vf0[vb][t], pf[m][t], O[m][vb], 0, 0, 0); } }
            }
            __builtin_amdgcn_sched_barrier(0);
        }
        if (i + 1 < ntiles) AT_STORE((i + 1) & 1);
        __syncthreads();
    }
#undef AT_LOAD
#undef AT_STORE
    float inv[NMAPS];
#pragma unroll
    for (int m = 0; m < NMAPS; ++m) { float l = lrun[m]; l = swap16_add(l, l); l = swap32_add(l, l); inv[m] = 1.0f / l; }
    const int orow = qrow0 + wave * 16 + fr;
    if constexpr (NMAPS == 2) {
        float ss = 0.f; const float i1 = inv[0], i2 = lam * inv[1];
#pragma unroll
        for (int vb = 0; vb < NVB; ++vb) { O[0][vb] = O[0][vb] * i1 - O[1][vb] * i2; const f32x4 o = O[0][vb]; ss += (o.x * o.x + o.y * o.y) + (o.z * o.z + o.w * o.w); }
        ss = swap16_add(ss, ss); ss = swap32_add(ss, ss);
        const float rs = __builtin_amdgcn_rsqf(ss * (1.0f / DV) + EPSF) * outscale;
#pragma unroll
        for (int vb = 0; vb < NVB; ++vb) { const f32x4 gg = *(const f32x4*)(subg + 16 * vb + 4 * g); const f32x4 y = O[0][vb] * rs * gg;
            u32x2 w; w.x = cvtpk(y.x, y.y); w.y = cvtpk(y.z, y.w); *(u32x2*)(AOUT + (size_t)orow * D + ocol + 16 * vb + 4 * g) = w; }
    } else {
#pragma unroll
        for (int vb = 0; vb < NVB; ++vb) { const f32x4 y = O[0][vb] * inv[0];
            u32x2 w; w.x = cvtpk(y.x, y.y); w.y = cvtpk(y.z, y.w); *(u32x2*)(AOUT + (size_t)orow * D + ocol + 16 * vb + 4 * g) = w; }
    }
}


__device__ __forceinline__ void phase_attention(const bf16* QKV, const bf16* VAT, const bf16* VBT, bf16* AOUT, const float* lamp  , float lam_init, const float* subg, const float* nab  ,
                                                unsigned* naq, const ConvPtrs& CP, int clo, int chi, LAS unsigned char* lds, int tid, int lane, int wave) {
    float part = lamp[lane] * lamp[64 + lane]; float part2 = lamp[128 + lane] * lamp[192 + lane];
    const float lam = __expf(wave_sum(part)) - __expf(wave_sum(part2)) + lam_init;
    LAS float* biasT = (LAS float*)(lds + LX_BIAS) + 64;
    constexpr int NATT_U = 576 + 1152;
    const int ncu = (chi - clo + CV_UNIT - 1) / CV_UNIT, nq = NATT_U + ncu;
    int mine = 0; if (tid == 0) mine = (int)__hip_atomic_fetch_add(naq, 1u, RLX_AGENT);
    for (;;) {
        __syncthreads();
        if (tid == 0) *(LAS int*)(lds + LX_MISC + 64) = mine;
        __syncthreads();
        const int q = *(LAS int*)(lds + LX_MISC + 64);
        if (q >= nq) break;
        if (tid == 0) mine = (int)__hip_atomic_fetch_add(naq, 1u, RLX_AGENT);
        const int ai = (int)(((long)q * NATT_U) / nq); const bool isatt = (int)(((long)(q + 1) * NATT_U) / nq) > ai;
        if (!isatt) { conv_unit(CP, clo + (q - ai) * CV_UNIT, chi, lds, lane, wave); continue; }
        if (ai < 512 || (ai >= 1536 && ai < 1600)) {
            int bh, qrow0, khi;
            if (ai < 512) { bh = ai >> 4; const int qt = ai & 15; qrow0 = (bh >> 2) * SEQ + qt * 128; khi = 32; }
            else { const int u = ai - 1536; bh = u >> 1; const int qt = u & 1; qrow0 = TX + (bh >> 2) * CTXL + qt * 128; khi = 0; }
            const int b = bh >> 2, h = bh & 3;
            attn_unit<2, 128, false>(lds, tid, lane, wave, QKV, h * 128, qrow0, 512 + h * 128, b * SEQ, TX + b * CTXL, VAT + (size_t)bh * 128 * NKEY, 0, khi, 0, 0, nullptr,
                                     AOUT, h * 128, lam, subg, 1.0f - lam_init);
        } else {
            int bh, qrow0, klo, khi, rw;
            if (ai < 1536) { const int u = ai - 512; bh = u >> 4; const int rp = u & 15; qrow0 = (bh >> 3) * SEQ + rp * 128; klo = na_r0(2 * rp); khi = na_r0(2 * rp + 1) + 8; rw = 2 * rp + (wave >> 2); }
            else { const int u = ai - 1600; bh = u >> 1; const int qt = u & 1; qrow0 = TX + (bh >> 3) * CTXL + qt * 128; klo = 0; khi = 0; rw = 0; }
            const int b = bh >> 3, h = bh & 7;
            for (int i = tid; i < 640; i += 512) { const int k = i - 64; biasT[k] = (k >= 0 && k < 465) ? nab[h * 465 + k] * LOG2E : 0.f; }
            attn_unit<1, 64, true>(lds, tid, lane, wave, QKV, 1536 + h * 64, qrow0, 2048 + h * 64, b * SEQ, TX + b * CTXL, VBT + (size_t)bh * 64 * NKEY, klo, khi,
                                   rw, 16 * (wave & 3), biasT, AOUT, 512 + h * 64, 0.f, nullptr, 1.0f);
        }
    }
}

__device__ __forceinline__ void gla_chunk_rows(int b, int dir, int n, int& row0, int& tok0) {
    if (n < 4) { const int cc = dir ? 3 - n : n; row0 = TX + b * CTXL + 64 * cc; tok0 = SEQ + 64 * cc; } else { const int lc = dir ? 35 - n : n - 4; row0 = b * SEQ + 64 * lc; tok0 = 64 * lc; }
}
constexpr int GP_QM = 0, GP_KM = 17408, GP_VT = 34816, GP_LR = 71680, GP_SEG = 75776;
__device__ __forceinline__ void phase_gla_prep(const bf16* QKV2, const bf16* VGT, const float* wgate  , const float* bgate  ,
                                               bf16* QG, bf16* KET, float* FACD, bf16* OF, bf16* OB,
                                               LAS unsigned char* lds, int tid, int lane, int wave, int vcu, int G) {
    const int fr = lane & 15, g = lane >> 4;
    const int d = tid & 127, seg = tid >> 7;
    LAS float* LR = (LAS float*)(lds + GP_LR);
    LAS float* SEG = (LAS float*)(lds + GP_SEG);
    for (int ub = vcu * 9; ub < 2304; ub += G * 9) {
        const int q = ub / 36, n0 = ub % 36, dir = q & 1, hh = (q >> 1) & 3, b = q >> 3;
        bf16* OUT = dir ? OB : OF;
        float wg[16];
#pragma unroll
        for (int r = 0; r < 16; ++r) wg[r] = wgate[(dir * 16 + r) * 512 + hh * 128 + d];
        const float bgv = bgate[dir * 512 + hh * 128 + d];
        const bf16* vtb = VGT + (size_t)(b * 4 + hh) * 256 * NKEY;
        u32x4 qr[2], kr[2], vr[4], lr4;
#define GP_LOAD(n) do { int _row0, _tok0; gla_chunk_rows(b, dir, (n), _row0, _tok0); \
        _Pragma("unroll") for (int j = 0; j < 2; ++j) { const int idx = tid + 512 * j, p = idx >> 4, ch = idx & 15; const bf16* src = QKV2 + (size_t)(_row0 + p) * NGLA + hh * 128 + ch * 8; qr[j] = *(const u32x4*)src; kr[j] = *(const u32x4*)(src + 512); } \
        _Pragma("unroll") for (int j = 0; j < 4; ++j) { const int idx = tid + 512 * j; vr[j] = *(const u32x4*)(vtb + (size_t)(idx >> 3) * NKEY + _tok0 + (idx & 7) * 8); } \
        if (tid < 128) lr4 = *(const u32x4*)(QKV2 + (size_t)(_row0 + (tid >> 1)) * NGLA + 3072 + dir * 16 + (tid & 1) * 8); } while (0)
        GP_LOAD(n0);
        for (int k9 = 0; k9 < 9; ++k9) {
            const int n = n0 + k9, u = ub + k9; int row0, tok0; gla_chunk_rows(b, dir, n, row0, tok0);
#pragma unroll
            for (int j = 0; j < 2; ++j) { const int idx = tid + 512 * j, p = idx >> 4, ch = idx & 15;
                *(LAS u32x4*)(lds + GP_QM + p * 272 + ch * 16) = qr[j]; *(LAS u32x4*)(lds + GP_KM + p * 272 + ch * 16) = kr[j]; }
#pragma unroll
            for (int j = 0; j < 4; ++j) { const int idx = tid + 512 * j; *(LAS u32x4*)(lds + GP_VT + (idx >> 3) * 144 + (idx & 7) * 16) = vr[j]; }
            if (tid < 128) { LAS float* lp = LR + (tid >> 1) * 16 + (tid & 1) * 8;
                lp[0] = bflo(lr4.x); lp[1] = bfhi(lr4.x); lp[2] = bflo(lr4.y); lp[3] = bfhi(lr4.y); lp[4] = bflo(lr4.z); lp[5] = bfhi(lr4.z); lp[6] = bflo(lr4.w); lp[7] = bfhi(lr4.w); }
            __syncthreads();
            if (k9 + 1 < 9) GP_LOAD(n + 1);
            float gc[16];
#pragma unroll
            for (int pi = 0; pi < 16; ++pi) { const LAS f32x4* lp = (const LAS f32x4*)(LR + (16 * seg + pi) * 16); float z = bgv;
#pragma unroll
                for (int k = 0; k < 4; ++k) { const f32x4 l4 = lp[k]; z += l4.x * wg[4 * k] + l4.y * wg[4 * k + 1] + l4.z * wg[4 * k + 2] + l4.w * wg[4 * k + 3]; }
                const float az = fabsf(z); gc[pi] = (fminf(z, 0.f) - flog(1.0f + fexp(-az))) * 0.0625f; }
            float run = 0.f;
            if (dir == 0) {
#pragma unroll
                for (int pi = 0; pi < 16; ++pi) { run += gc[pi]; gc[pi] = run; }
            } else {
#pragma unroll
                for (int pi = 15; pi >= 0; --pi) { run += gc[pi]; gc[pi] = run; }
            }
            SEG[seg * 128 + d] = run;
            __syncthreads();
            const float t0 = SEG[d], t1 = SEG[128 + d], t2 = SEG[256 + d], t3 = SEG[384 + d];
            float off, gmid; const float gend = (t0 + t1) + (t2 + t3);
            if (dir == 0) { off = (seg > 0 ? t0 : 0.f) + (seg > 1 ? t1 : 0.f) + (seg > 2 ? t2 : 0.f); gmid = t0 + t1; }
            else { off = (seg < 3 ? t3 : 0.f) + (seg < 2 ? t2 : 0.f) + (seg < 1 ? t1 : 0.f); gmid = t3 + t2; }
            const float emid = fexp(gmid), eend = fexp(gend - gmid);
            unsigned kep[8];
            bf16* qgp = QG + ((size_t)u * 64 + 16 * seg) * 128 + d;
#pragma unroll
            for (int pi = 0; pi < 16; ++pi) { const int p = 16 * seg + pi; const float rel = off + gc[pi] - gmid; const float Ep = fexp(rel), Ei = fexp(-rel);
                LAS bf16* qa = (LAS bf16*)(lds + GP_QM) + p * 136 + d; LAS bf16* ka = (LAS bf16*)(lds + GP_KM) + p * 136 + d;
                const float qv = bf2f(*qa), kv = bf2f(*ka);
                const float qm = qv * Ep, km = kv * Ei;
                const unsigned w1 = cvtpk(qm, qm * emid), w2 = cvtpk(km, km * eend);
                *qa = (bf16)(w1 & 0xffffu); qgp[pi * 128] = (bf16)(w1 >> 16); *ka = (bf16)(w2 & 0xffffu);
                if (pi & 1) kep[pi >> 1] |= (w2 & 0xffff0000u); else kep[pi >> 1] = w2 >> 16; }
            { u32x4* kt = (u32x4*)(KET + ((size_t)u * 128 + d) * 64 + 16 * seg); kt[0] = (u32x4){kep[0], kep[1], kep[2], kep[3]}; kt[1] = (u32x4){kep[4], kep[5], kep[6], kep[7]}; }
            if (seg == 0) FACD[(size_t)u * 128 + d] = fexp(gend);
            __syncthreads();
            { const int cb = wave & 3, half = wave >> 2;
              bf16x8 qfr[4];
#pragma unroll
              for (int ks = 0; ks < 4; ++ks) qfr[ks] = *(const LAS bf16x8*)(lds + GP_QM + (16 * cb + fr) * 272 + (8 * g + 32 * ks) * 2);
              f32x4 AT[4];
#pragma unroll
              for (int sb = 0; sb < 4; ++sb) { AT[sb] = (f32x4){0.f, 0.f, 0.f, 0.f};
#pragma unroll
                  for (int ks = 0; ks < 4; ++ks) { const bf16x8 af = *(const LAS bf16x8*)(lds + GP_KM + (16 * sb + fr) * 272 + (8 * g + 32 * ks) * 2);
                      AT[sb] = __builtin_amdgcn_mfma_f32_16x16x32_bf16(af, qfr[ks], AT[sb], 0, 0, 0); }
                  const int c = 16 * cb + fr;
#pragma unroll
                  for (int ii = 0; ii < 4; ++ii) { const int sp = 16 * sb + 4 * g + ii; const bool keep = dir ? (sp >= c) : (sp <= c); AT[sb][ii] = keep ? AT[sb][ii] : 0.f; } }
              bf16x8 pf[2];
#pragma unroll
              for (int t = 0; t < 2; ++t) { u32x4 w; w.x = pk2(AT[2 * t][0], AT[2 * t][1]); w.y = pk2(AT[2 * t][2], AT[2 * t][3]); w.z = pk2(AT[2 * t + 1][0], AT[2 * t + 1][1]); w.w = pk2(AT[2 * t + 1][2], AT[2 * t + 1][3]);
                  pf[t] = __builtin_bit_cast(bf16x8, w); }
#pragma unroll
              for (int v8 = 0; v8 < 8; ++v8) { const int vb = 8 * half + v8; f32x4 Oa = (f32x4){0.f, 0.f, 0.f, 0.f};
#pragma unroll
                  for (int t = 0; t < 2; ++t) { const LAS unsigned char* vp = lds + GP_VT + (16 * vb + fr) * 144 + (32 * t + 4 * g) * 2;
                      const u32x2 lo = *(const LAS u32x2*)vp, hi = *(const LAS u32x2*)(vp + 32);
                      u32x4 w; w.x = lo.x; w.y = lo.y; w.z = hi.x; w.w = hi.y;
                      Oa = __builtin_amdgcn_mfma_f32_16x16x32_bf16(__builtin_bit_cast(bf16x8, w), pf[t], Oa, 0, 0, 0); }
                  u32x2 w; w.x = pk2(Oa[0], Oa[1]); w.y = pk2(Oa[2], Oa[3]);
                  *(u32x2*)(OUT + (size_t)(row0 + 16 * cb + fr) * D + hh * 256 + 16 * vb + 4 * g) = w; }
            }
            __syncthreads();
        }
#undef GP_LOAD
    }
}

constexpr int GS_BUF = 45056, GS_QG = 0, GS_KET = 17408, GS_VT = 35840, GS_ST = 2 * GS_BUF, GS_DEC = GS_ST + 2 * 17408;
__device__ __forceinline__ void phase_gla(const bf16* VGT, bf16* OF, bf16* OB, const bf16* QG, const bf16* KET, const float* FACD,
                                          LAS unsigned char* lds, int tid, int lane, int wave, int vcu, int G) {
    const int fr = lane & 15, g = lane >> 4;
    for (int u = vcu; u < 256; u += G) {
        const int slab = u & 3, dir = (u >> 2) & 1, hh = (u >> 3) & 3, b = u >> 5;
        bf16* OUT = dir ? OB : OF;
        const int upb = ((b * 4 + hh) * 2 + dir) * 36;
        f32x4 Sacc[4];
#pragma unroll
        for (int vb = 0; vb < 4; ++vb) Sacc[vb] = (f32x4){0.f, 0.f, 0.f, 0.f};
        for (int i = tid; i < 17408 / 4; i += 512) ((LAS unsigned*)(lds + GS_ST))[i] = 0u;
        const bf16* vtb = VGT + ((size_t)(b * 4 + hh) * 256 + slab * 64) * NKEY;
        const int cb = wave & 3, vh = wave >> 2;
        const int ocol = hh * 256 + slab * 64 + 32 * vh + 4 * g;
        struct GsRegs { u32x4 qg[2], ket[2], v; u32x2 oi[2]; float dec; };
        GsRegs R0, R1; R0.dec = 0.f; R1.dec = 0.f;
#define GS_LOAD(R, n) do { int _row0, _tok0; gla_chunk_rows(b, dir, (n), _row0, _tok0); const size_t _u = (size_t)(upb + (n)); \
        _Pragma("unroll") for (int j = 0; j < 2; ++j) { const int idx = tid + 512 * j; R.qg[j] = *(const u32x4*)(QG + _u * 8192 + idx * 8); R.ket[j] = *(const u32x4*)(KET + _u * 8192 + idx * 8); } \
        R.v = *(const u32x4*)(vtb + (size_t)(tid >> 3) * NKEY + _tok0 + (tid & 7) * 8); \
        if (tid < 128) R.dec = FACD[_u * 128 + tid]; \
        _Pragma("unroll") for (int v2 = 0; v2 < 2; ++v2) R.oi[v2] = *(const u32x2*)(OUT + (size_t)(_row0 + 16 * cb + fr) * D + ocol + 16 * v2); } while (0)
#define GS_STORE(R, bf) do { LAS unsigned char* _p = lds + (bf) * GS_BUF; \
        _Pragma("unroll") for (int j = 0; j < 2; ++j) { const int idx = tid + 512 * j; *(LAS u32x4*)(_p + GS_QG + (idx >> 4) * 272 + (idx & 15) * 16) = R.qg[j]; *(LAS u32x4*)(_p + GS_KET + (idx >> 3) * 144 + (idx & 7) * 16) = R.ket[j]; } \
        *(LAS u32x4*)(_p + GS_VT + (tid >> 3) * 144 + (tid & 7) * 16) = R.v; \
        if (tid < 128) ((LAS float*)(lds + GS_DEC))[(bf) * 128 + tid] = R.dec; } while (0)
#define GS_ITER(n, RN, RF) do { const int _n = (n); int row0, tok0; gla_chunk_rows(b, dir, _n, row0, tok0); const int cur = _n & 1; \
            if (_n + 2 < 36) GS_LOAD(RF, _n + 2); \
            const LAS unsigned char* bufp = lds + cur * GS_BUF; const LAS unsigned char* stp = lds + GS_ST + cur * 17408; \
            { bf16x8 qfr[4]; \
              _Pragma("unroll") for (int ks = 0; ks < 4; ++ks) qfr[ks] = *(const LAS bf16x8*)(bufp + GS_QG + (16 * cb + fr) * 272 + (8 * g + 32 * ks) * 2); \
              _Pragma("unroll") for (int v2 = 0; v2 < 2; ++v2) { const int vb = 2 * vh + v2; const u32x2 oin = v2 ? oc1 : oc0; \
                  f32x4 Oa = (f32x4){bflo(oin.x), bfhi(oin.x), bflo(oin.y), bfhi(oin.y)}; \
                  _Pragma("unroll") for (int ks = 0; ks < 4; ++ks) { const bf16x8 af = *(const LAS bf16x8*)(stp + (16 * vb + fr) * 272 + (8 * g + 32 * ks) * 2); \
                      Oa = __builtin_amdgcn_mfma_f32_16x16x32_bf16(af, qfr[ks], Oa, 0, 0, 0); } \
                  u32x2 w; w.x = pk2(Oa[0], Oa[1]); w.y = pk2(Oa[2], Oa[3]); \
                  *(u32x2*)(OUT + (size_t)(row0 + 16 * cb + fr) * D + ocol + 16 * v2) = w; } } \
            { const f32x4 dec = *(const LAS f32x4*)((LAS float*)(lds + GS_DEC) + cur * 128 + 16 * wave + 4 * g); \
              LAS unsigned char* stn = lds + GS_ST + (cur ^ 1) * 17408; \
              _Pragma("unroll") for (int vb = 0; vb < 4; ++vb) { Sacc[vb] = Sacc[vb] * dec; \
                  _Pragma("unroll") for (int t = 0; t < 2; ++t) { const bf16x8 af = *(const LAS bf16x8*)(bufp + GS_KET + (16 * wave + fr) * 144 + (8 * g + 32 * t) * 2); \
                      const bf16x8 bfr = *(const LAS bf16x8*)(bufp + GS_VT + (16 * vb + fr) * 144 + (8 * g + 32 * t) * 2); \
                      Sacc[vb] = __builtin_amdgcn_mfma_f32_16x16x32_bf16(af, bfr, Sacc[vb], 0, 0, 0); } \
                  u32x2 w; w.x = pk2(Sacc[vb][0], Sacc[vb][1]); w.y = pk2(Sacc[vb][2], Sacc[vb][3]); \
                  *(LAS u32x2*)(stn + (16 * vb + fr) * 272 + (16 * wave + 4 * g) * 2) = w; } } \
            if (_n + 1 < 36) { GS_STORE(RN, cur ^ 1); oc0 = RN.oi[0]; oc1 = RN.oi[1]; } \
            __syncthreads(); } while (0)
        GS_LOAD(R0, 0); GS_STORE(R0, 0);
        u32x2 oc0 = R0.oi[0], oc1 = R0.oi[1];
        GS_LOAD(R0, 1);
        __syncthreads();
        for (int n = 0; n < 36; n += 2) { GS_ITER(n, R0, R1); GS_ITER(n + 1, R1, R0); }
#undef GS_ITER
#undef GS_LOAD
#undef GS_STORE
    }
}

constexpr int N_PHASES = 34;
typedef const Args __attribute__((address_space(4)))* KArgs;
__device__ __forceinline__ KArgs kargs() { KArgs p = (KArgs)__builtin_amdgcn_kernarg_segment_ptr(); asm volatile("" : "+s"(p)); return p; }
__global__ void __launch_bounds__(512, 2) fwd(Args a_unused) {
    extern __shared__ __attribute__((aligned(16))) unsigned char lds_raw[];
    LAS unsigned char* lds = (LAS unsigned char*)lds_raw;
    const int tid0 = threadIdx.x;
    const int G0 = gridDim.x; const int bx0 = blockIdx.x;
#define PH_ENTRY int tid = tid0; asm volatile("" : "+v"(tid)); int G = G0, bx = bx0; asm volatile("" : "+s"(G), "+s"(bx)); const int lane = tid & 63, wave = __builtin_amdgcn_readfirstlane(tid >> 6); \
        const int vcu = (G % 8 == 0) ? (bx % 8) * (G / 8) + bx / 8 : bx; (void)lane; (void)wave; (void)vcu
    const int tid = tid0;
    const int ph_lo = kargs()->ph_lo, ph_hi = kargs()->ph_hi;
    const int repmask = kargs()->rep;
    if (tid < 64) ((LAS unsigned*)(lds + LX_MISC))[tid] = 0u;
    for (int i = tid; i < 1024; i += 512) { const int pos = i >> 4, f = i & 15; const float inv = __builtin_amdgcn_exp2f(-(float)f * (13.287712379549449f / 16.0f)); const float ang = (float)pos * inv;
        ((LAS float*)(lds + LX_ROPE))[2 * i] = __cosf(ang); ((LAS float*)(lds + LX_ROPE))[2 * i + 1] = __sinf(ang); }
    __syncthreads();
    const bool single = (ph_hi - ph_lo) > 1;
    XcdBarrier bar; bar.bar = (unsigned*)(kargs()->ws + WS_CTL) + CW_BAR; bar.x = 0; bar.st = (volatile LAS unsigned*)(lds + LX_MISC);
    if (single) bar = xcd_barrier_post((unsigned*)(kargs()->ws + WS_CTL) + CW_BAR, (volatile LAS unsigned*)(lds + LX_MISC));
#define IN(k) (ph_lo <= (k) && (k) < ph_hi)
#define REPLOOP(t) for (int rep_ = 0, nrep_ = 1 + ((repmask >> (t)) & 1); rep_ < nrep_; ++rep_, (rep_ < nrep_ ? (bar.bar = (unsigned*)(kargs()->ws + WS_CTL) + CW_BAR, xcd_barrier(bar)) : (void)0))
#define SEAM(k) do { if (IN(k) && IN((k) + 1)) { bar.bar = (unsigned*)(kargs()->ws + WS_CTL) + CW_BAR; xcd_barrier(bar); if ((repmask >> 10) & 1) xcd_barrier(bar); } } while (0)
    LAS int* tab = (LAS int*)(lds + LX_MOETAB);
#define CONV_PTRS(A) ConvPtrs{(A)->att_w_in, (A)->att_w_out, (A)->gla_w_in, (A)->gla_w_out, (A)->moe_w1, (A)->moe_w3, (A)->moe_w2, (A)->ws}

    if (IN(0)) REPLOOP(0) { PH_ENTRY; p0_prologue(kargs(), lds, tid, lane, wave, vcu, G); } SEAM(0);
    if (IN(1)) { PH_ENTRY; KArgs A = kargs(); unsigned char* ws = A->ws; phase_norm1(A->x, A->ctx, A->norm_g, (float*)(ws + WS_MODV), (bf16*)(ws + WS_H), TALL, lane, wave, vcu, G); } SEAM(1);

#pragma nounroll
    for (int L = 0; L < 4; ++L) {
        const int pb = 2 + 8 * L; const bool isattn = !(L & 1); const int j = L >> 1; const bool lastL = (L == 3);
        const int nrows = lastL ? TX : TALL;
        if (IN(pb)) REPLOOP(isattn ? 1 : 3) {
            PH_ENTRY; KArgs A = kargs(); unsigned char* ws = A->ws; unsigned char* big = ws + WS_BIG; const bf16* H = (const bf16*)(ws + WS_H);
            if (isattn) {
                pg8::DenseOrder S; S.init(H, (const bf16*)(ws + WS_WATTIN) + (size_t)j * NATT * D, TALL, NATT, D, G, bx);
                pg8::EpiAttnIn E{(bf16*)(big + BG_QKV), (bf16*)(big + BG_VAT), (bf16*)(big + BG_VBT), (const LAS float*)(lds + LX_ROPE)};
                pg8::gemm_phase<pg8::EpiAttnIn, pg8::DenseOrder, false>(lds, tid, D, S, E);
            } else {
                pg8::DenseOrder S; S.init(H, (const bf16*)(ws + WS_WGLAIN) + (size_t)j * NGLA * D, TALL, NGLA, D, G, bx);
                pg8::EpiGlaIn E{(bf16*)(big + BG_QKV2), (bf16*)(big + BG_VGT)};
                pg8::gemm_phase<pg8::EpiGlaIn, pg8::DenseOrder, false>(lds, tid, D, S, E);
            }
        }
        SEAM(pb);
        if (!isattn && IN(pb + 1)) {
            for (int rep_ = 0; rep_ <= ((repmask >> 13) & 1); ++rep_)
            { PH_ENTRY; KArgs A = kargs(); unsigned char* ws = A->ws;
              phase_gla_prep((const bf16*)(ws + WS_BIG + BG_QKV2), (const bf16*)(ws + WS_BIG + BG_VGT), A->gla_w_gate + j * 2 * 16 * 512, A->gla_b_gate + j * 2 * 512,
                             (bf16*)(ws + WS_QG), (bf16*)(ws + WS_KET), (float*)(ws + WS_BIG + BG_FAC), (bf16*)(ws + WS_BIG + BG_OF), (bf16*)(ws + WS_BIG + BG_OB), lds, tid, lane, wave, vcu, G); }
            if (single) { bar.bar = (unsigned*)(kargs()->ws + WS_CTL) + CW_BAR; xcd_barrier(bar); }
        }
        if (IN(pb + 1)) REPLOOP(isattn ? 2 : 4) {
            PH_ENTRY; KArgs A = kargs(); unsigned char* ws = A->ws; unsigned char* big = ws + WS_BIG; bf16* AOUT = (bf16*)(ws + WS_AOUT);
            if (isattn) { const ConvPtrs CP = CONV_PTRS(A);
                phase_attention((const bf16*)(big + BG_QKV), (const bf16*)(big + BG_VAT), (const bf16*)(big + BG_VBT), AOUT, A->att_lambda + j * 256, (L == 0) ? 0.2f : 0.470713018f,
                                A->att_subln_g + j * 128, A->na_bias + j * 8 * 465, (unsigned*)(ws + WS_CTL) + CW_NAQ + 64 * j, CP,
                                MK_CONVQ ? (L == 0 ? CT_ATTN0 : CT_MOE1) : 0, MK_CONVQ ? (L == 0 ? CT_MOE1 : CT_MOE3) : 0, lds, tid, lane, wave); }
            else phase_gla((const bf16*)(big + BG_VGT), (bf16*)(big + BG_OF), (bf16*)(big + BG_OB), (const bf16*)(ws + WS_QG), (const bf16*)(ws + WS_KET), (const float*)(big + BG_FAC),
                           lds, tid, lane, wave, vcu, G);
        }
        SEAM(pb + 1);
        if (!isattn) {
            if (IN(pb + 2)) REPLOOP(5) { PH_ENTRY; KArgs A = kargs(); unsigned char* ws = A->ws; unsigned char* big = ws + WS_BIG;
                phase_readout((const bf16*)(big + BG_OF), (const bf16*)(big + BG_OB), (const bf16*)(big + BG_QKV2), A->gla_norm_g + j * 256, (bf16*)(ws + WS_AOUT), nrows, lane, wave, vcu, G); }
            SEAM(pb + 2);
        }
        if (IN(pb + 3)) {
            PH_ENTRY; KArgs A = kargs(); unsigned char* ws = A->ws;
            pg8::DenseOrder S; S.init((const bf16*)(ws + WS_AOUT), (const bf16*)(ws + (isattn ? WS_WATTOUT : WS_WGLAOUT)) + (size_t)j * D * D, nrows, D, D, G, bx);
            pg8::EpiResid E{L == 0 ? A->x : A->out, L == 0 ? A->ctx : (const float*)(ws + WS_CTX), A->out, (float*)(ws + WS_CTX), (const float*)(ws + WS_MODV) + (size_t)L * 9 * 6144 + 2048};
            pg8::gemm_phase<pg8::EpiResid, pg8::DenseOrder, false>(lds, tid, D, S, E);
        }
        SEAM(pb + 3);
        if (IN(pb + 4)) { PH_ENTRY; KArgs A = kargs(); unsigned char* ws = A->ws;
            phase_router(A->out, (float*)(ws + WS_CTX), A->norm_g + (L * 2 + 1) * D, (const float*)(ws + WS_MODV) + (size_t)L * 9 * 6144, (bf16*)(ws + WS_H), A->router_w, A->router_bias,
                         (unsigned*)(ws + WS_CTL) + CW_CNT + L * 16 * 64, (int*)(ws + WS_LIST), (int*)(ws + WS_TOKI), (float*)(ws + WS_TOKW), nrows, lds, tid, lane, wave, vcu, G, (repmask >> 11) & 1); }
        SEAM(pb + 4);
        if (IN(pb + 5)) REPLOOP(6) {
            PH_ENTRY; KArgs A = kargs(); unsigned char* ws = A->ws;
            const int RT = build_moe_table((unsigned*)(ws + WS_CTL) + CW_CNT + L * 16 * 64, tab, tid);
            pg8::MoeOrder S; S.A = (const char*)(ws + WS_H); S.B = (const char*)(ws + WS_W13) + (size_t)L * 16 * D * D * 2; S.K = D; S.bstride = (size_t)D * D * 2; S.tab = tab; S.list = (const int*)(ws + WS_LIST); S.RT = RT; S.nwg = RT * 4; S.G = G; S.c = bx;
            pg8::EpiMoe1 E{(bf16*)(ws + WS_BIG + BG_HB)};
            pg8::gemm_phase<pg8::EpiMoe1, pg8::MoeOrder, true>(lds, tid, D, S, E);
        }
        SEAM(pb + 5);
        if (IN(pb + 6)) REPLOOP(7) {
            PH_ENTRY; KArgs A = kargs(); unsigned char* ws = A->ws;
            const int RT = build_moe_table((unsigned*)(ws + WS_CTL) + CW_CNT + L * 16 * 64, tab, tid);
            pg8::MoeOrder S; S.A = (const char*)(ws + WS_BIG + BG_HB); S.B = (const char*)(ws + WS_W2) + (size_t)L * 16 * D * DEXP * 2; S.K = DEXP; S.bstride = (size_t)D * DEXP * 2; S.tab = tab; S.list = (const int*)(ws + WS_LIST); S.RT = RT; S.nwg = RT * 4; S.G = G; S.c = bx;
            pg8::EpiBf16 E{(bf16*)(ws + WS_BIG + BG_YB), D};
            pg8::gemm_phase<pg8::EpiBf16, pg8::MoeOrder, false>(lds, tid, DEXP, S, E);
        }
        SEAM(pb + 6);
        if (IN(pb + 7)) { PH_ENTRY; KArgs A = kargs(); unsigned char* ws = A->ws; const float* MODV = (const float*)(ws + WS_MODV);
            phase_combine(A->out, (float*)(ws + WS_CTX), MODV + (size_t)L * 9 * 6144, (const bf16*)(ws + WS_BIG + BG_YB), (unsigned*)(ws + WS_CTL) + CW_CNT + L * 16 * 64, (const int*)(ws + WS_TOKI), (const float*)(ws + WS_TOKW),
                          lastL, lastL ? A->final_g : A->norm_g + ((L + 1) * 2) * D, MODV + (size_t)(lastL ? L : L + 1) * 9 * 6144, (bf16*)(ws + WS_H), nrows, lane, wave, vcu, G, (repmask >> 12) & 1); }
        if (!lastL) SEAM(pb + 7);
    }
#undef IN
#undef REPLOOP
#undef SEAM
#undef CONV_PTRS

#undef PH_ENTRY
}

extern "C" void kernel_launch(void* const* d_in, const int* in_sizes, int n_in, void* d_out, int out_size, void* d_ws, size_t ws_size, hipStream_t stream) {
    static int ready = 0;
    if (ready == 0) {
        if (n_in != 23 || out_size != TX * D || ws_size < WS_END) { fprintf(stderr, "kernel_launch: unexpected shapes (n_in %d out %d ws %zu)\n", n_in, out_size, ws_size); ready = -1; return; }
        if (hipFuncSetAttribute((const void*)fwd, hipFuncAttributeMaxDynamicSharedMemorySize, LDS_BYTES) != hipSuccess) { fprintf(stderr, "kernel_launch: hipFuncSetAttribute failed\n"); ready = -1; return; }
        int per_cu = 0; (void)hipOccupancyMaxActiveBlocksPerMultiprocessor(&per_cu, (const void*)fwd, 512, LDS_BYTES); (void)hipGetLastError();
        if (per_cu < 1) fprintf(stderr, "kernel_launch: occupancy query reports %d blocks per CU\n", per_cu);
        ready = 1;
    }
    if (ready < 0) return;
    (void)hipMemsetAsync((char*)d_ws + WS_CTL, 0, CTL_ZERO_BYTES, stream);
    Args a{};
    const float** ap = (const float**)&a;
    for (int i = 0; i < 23; ++i) ap[i] = (const float*)d_in[i];
    a.out = (float*)d_out; a.ws = (unsigned char*)d_ws;
    const int grid = 256;
    a.ph_lo = 0; a.ph_hi = N_PHASES; a.rep = MK_REPMASK;
    hipLaunchKernelGGL(fwd, dim3(grid), dim3(512), LDS_BYTES, stream, a);
}
```

```cpp
#include <hip/hip_runtime.h>
#include <cstdio>
#include <cstdint>

#ifndef MK_CONVQ
#define MK_CONVQ 1
#endif
#ifndef MK_REPMASK
#define MK_REPMASK 0
#endif

#define GAS __attribute__((address_space(1)))
#define LAS __attribute__((address_space(3)))
typedef unsigned short bf16;
typedef short bf16x8 __attribute__((ext_vector_type(8)));
typedef short bf16x4 __attribute__((ext_vector_type(4)));
typedef float f32x4 __attribute__((ext_vector_type(4)));
typedef float f32x2 __attribute__((ext_vector_type(2)));
typedef unsigned u32x4 __attribute__((ext_vector_type(4)));
typedef unsigned u32x2 __attribute__((ext_vector_type(2)));

constexpr int D = 1024, NB = 8, SEQ = 2048, CTXL = 256;
constexpr int TX = NB * SEQ, TC = NB * CTXL, TALL = TX + TC;
constexpr int NKEY = SEQ + CTXL;
constexpr int NATT = 3072, NGLA = 3328;
constexpr float EPSF = 1e-6f;
constexpr float LOG2E = 1.4426950408889634f;
constexpr int NEXP = 16, DEXP = 512;
constexpr int RT_MAX = 160;

constexpr size_t MiB = 1u << 20;
constexpr size_t WS_CTL = 0, CTL_ZERO_BYTES = 65536;
constexpr size_t WS_MODV = 1 * MiB;
constexpr size_t WS_TOKI = 2 * MiB;
constexpr size_t WS_TOKW = 2 * MiB + 512 * 1024;
constexpr size_t WS_LIST = 3 * MiB;
constexpr size_t WS_CTX = 5 * MiB;
constexpr size_t WS_WATTIN = 13 * MiB;
constexpr size_t WS_WATTOUT = 25 * MiB;
constexpr size_t WS_WGLAIN = 29 * MiB;
constexpr size_t WS_WGLAOUT = 42 * MiB;
constexpr size_t WS_W13 = 46 * MiB;
constexpr size_t WS_W2 = 174 * MiB;
constexpr size_t WS_H = 238 * MiB;
constexpr size_t WS_AOUT = 274 * MiB;
constexpr size_t WS_BIG = 310 * MiB;
constexpr size_t WS_END = 539 * MiB;
constexpr size_t BG_QKV = 0;
constexpr size_t BG_VAT = 108 * MiB;
constexpr size_t BG_VBT = 126 * MiB;
constexpr size_t BG_QKV2 = 0;
constexpr size_t BG_VGT = 117 * MiB;
constexpr size_t BG_OF = 153 * MiB;
constexpr size_t BG_OB = 189 * MiB;
constexpr size_t BG_FAC = 225 * MiB;
constexpr size_t WS_QG = WS_H, WS_KET = WS_AOUT;
constexpr size_t BG_HB = 0;
constexpr size_t BG_YB = 40 * MiB;
constexpr int CW_TMO = 0;
constexpr int CW_BAR = 4096;
constexpr int CW_NAQ = 15360;
constexpr int CW_CNT = 8192;

constexpr int RING_BYTES = 131072;
constexpr int LX_OFF = RING_BYTES;
constexpr int LX_MISC = LX_OFF;
constexpr int LX_MOETAB = LX_OFF + 256;
constexpr int LX_ROPE = LX_OFF + 2048;
constexpr int LX_BIAS = LX_OFF + 2048 + 8192;
constexpr int LDS_BYTES = 147456;

#define LDS_WAIT() asm volatile("s_waitcnt lgkmcnt(0)" ::: "memory")
#define VM_WAIT() asm volatile("s_waitcnt vmcnt(0)" ::: "memory")
#define RLX_AGENT __ATOMIC_RELAXED, __HIP_MEMORY_SCOPE_AGENT
__device__ __forceinline__ unsigned f2bf(float f) { unsigned u = __builtin_bit_cast(unsigned, f); return (u + 0x7fffu + ((u >> 16) & 1u)) >> 16; }
typedef __bf16 hwbf16x2 __attribute__((ext_vector_type(2)));
__device__ __forceinline__ unsigned cvtpk(float lo, float hi) { const f32x2 v = {lo, hi}; const hwbf16x2 b = __builtin_convertvector(v, hwbf16x2); return __builtin_bit_cast(unsigned, b); }
__device__ __forceinline__ unsigned pk2(float lo, float hi) { return cvtpk(lo, hi); }
__device__ __forceinline__ float bf2f(unsigned short b) { return __builtin_bit_cast(float, ((unsigned)b) << 16); }
__device__ __forceinline__ float bflo(unsigned w) { return __builtin_bit_cast(float, w << 16); }
__device__ __forceinline__ float bfhi(unsigned w) { return __builtin_bit_cast(float, w & 0xffff0000u); }
template <int CTRL> __device__ __forceinline__ float dppf(float v) { return __builtin_bit_cast(float, __builtin_amdgcn_update_dpp(0, __builtin_bit_cast(int, v), CTRL, 0xf, 0xf, true)); }
__device__ __forceinline__ float row_sum(float v) { v += dppf<0xB1>(v); v += dppf<0x4E>(v); v += dppf<0x124>(v); v += dppf<0x128>(v); return v; }
__device__ __forceinline__ float swap16_add(float a, float b) { auto r = __builtin_amdgcn_permlane16_swap(__float_as_uint(a), __float_as_uint(b), false, false); const unsigned r0 = r[0], r1 = r[1]; return __uint_as_float(r0) + __uint_as_float(r1); }
__device__ __forceinline__ float swap32_add(float a, float b) { auto r = __builtin_amdgcn_permlane32_swap(__float_as_uint(a), __float_as_uint(b), false, false); const unsigned r0 = r[0], r1 = r[1]; return __uint_as_float(r0) + __uint_as_float(r1); }
__device__ __forceinline__ float swap16_max(float a) { auto r = __builtin_amdgcn_permlane16_swap(__float_as_uint(a), __float_as_uint(a), false, false); const unsigned r0 = r[0], r1 = r[1]; return fmaxf(__uint_as_float(r0), __uint_as_float(r1)); }
__device__ __forceinline__ float swap32_max(float a) { auto r = __builtin_amdgcn_permlane32_swap(__float_as_uint(a), __float_as_uint(a), false, false); const unsigned r0 = r[0], r1 = r[1]; return fmaxf(__uint_as_float(r0), __uint_as_float(r1)); }
__device__ __forceinline__ float readlane_f(float v, int l) { return __int_as_float(__builtin_amdgcn_readlane(__float_as_int(v), l)); }
__device__ __forceinline__ float wave_sum(float v) { v = row_sum(v); v = swap16_add(v, v); return swap32_add(v, v); }
__device__ __forceinline__ float fexp2(float x) { return __builtin_amdgcn_exp2f(x); }
__device__ __forceinline__ float fexp(float x) { return __builtin_amdgcn_exp2f(x * LOG2E); }
__device__ __forceinline__ float flog(float x) { return __builtin_amdgcn_logf(x) * 0.6931471805599453f; }
__device__ __forceinline__ float frcp(float x) { return __builtin_amdgcn_rcpf(x); }
__device__ __forceinline__ float silu_f(float x) { return x * frcp(1.0f + fexp(-x)); }

#define XB_TMO      128
#define XB_XCNT(j)  (256  + 64 * (j))
#define XB_XSUB(j)  (1280 + 64 * (j))
#define XB_XGEN(j)  (2304 + 64 * (j))
#define XB_TOP      3328
#define XB_TOPGEN   3392
#define XCD_BAR_WORDS 3456
#define XB_SPIN_CAP (1u << 18)
__device__ __forceinline__ unsigned xb_ld(unsigned* p)              { return __hip_atomic_load(p, __ATOMIC_RELAXED, __HIP_MEMORY_SCOPE_AGENT); }
__device__ __forceinline__ unsigned xb_add(unsigned* p, unsigned v) { return __hip_atomic_fetch_add(p, v, __ATOMIC_RELAXED, __HIP_MEMORY_SCOPE_AGENT); }
__device__ __forceinline__ unsigned xb_xcc_id() { return (unsigned)__builtin_amdgcn_s_getreg((3 << 11) | 20) & 0xFu; }
#define XB_SPIN(cond, bar) do { unsigned _sp = 0; while (cond) { __builtin_amdgcn_s_sleep(1); \
    if ((++_sp & 255u) == 0u) { if (xb_ld(&(bar)[XB_TMO])) break; if (_sp > XB_SPIN_CAP) { atomicAdd(&(bar)[XB_TMO], 1u); break; } } } } while (0)
struct XcdBarrier { unsigned* bar; unsigned x; volatile LAS unsigned* st; };
__device__ __forceinline__ XcdBarrier xcd_barrier_post(unsigned* bar, volatile LAS unsigned* st) {
    XcdBarrier b; b.bar = bar; b.x = xb_xcc_id(); b.st = st;
    if (threadIdx.x == 0) (void)xb_add(&bar[XB_XCNT(b.x)], 1u);
    return b;
}
__device__ __forceinline__ void xcd_barrier_complete(unsigned* bar, unsigned x, unsigned& nloc, unsigned& nx) {
    const unsigned G = gridDim.x * gridDim.y * gridDim.z;
    unsigned sum, cnt, mine, sp = 0u;
    for (;;) {
        sum = 0u; cnt = 0u; mine = 0u;
#pragma unroll
        for (unsigned j = 0; j < 16; ++j) { const unsigned c = xb_ld(&bar[XB_XCNT(j)]); sum += c; cnt += (c > 0u) ? 1u : 0u; mine = (j == x) ? c : mine; }
        if (sum == G) break;
        __builtin_amdgcn_s_sleep(1);
        if ((++sp & 255u) == 0u) { if (xb_ld(&bar[XB_TMO])) break; if (sp > XB_SPIN_CAP) { atomicAdd(&bar[XB_TMO], 1u); break; } }
    }
    nloc = mine > 0u ? mine : 1u; nx = cnt > 0u ? cnt : 1u;
}
__device__ __forceinline__ void xcd_barrier(const XcdBarrier& b) {
    asm volatile("s_waitcnt vmcnt(0)" ::: "memory");
    __syncthreads();
    if (threadIdx.x == 0) {
        unsigned* bar = b.bar;
        __builtin_amdgcn_s_waitcnt(0);
        unsigned nloc = b.st[0], nx = b.st[1];
        if (nloc == 0u) { xcd_barrier_complete(bar, b.x, nloc, nx); b.st[0] = nloc; b.st[1] = nx; }
        const unsigned old = xb_add(&bar[XB_XSUB(b.x)], 1u);
        const unsigned gen = old / nloc;
        if (old + 1u == (gen + 1u) * nloc) {
            __builtin_amdgcn_fence(__ATOMIC_RELEASE, "agent");
            asm volatile("s_waitcnt vmcnt(0)" ::: "memory");
            const unsigned og = xb_add(&bar[XB_TOP], 1u);
            const unsigned tg = og / nx;
            if (og + 1u == (tg + 1u) * nx) xb_add(&bar[XB_TOPGEN], 1u);
            else XB_SPIN(xb_ld(&bar[XB_TOPGEN]) == tg, bar);
            __builtin_amdgcn_fence(__ATOMIC_ACQUIRE, "agent");
            xb_add(&bar[XB_XGEN(b.x)], 1u);
            asm volatile("s_waitcnt vmcnt(0)" ::: "memory");
        } else {
            XB_SPIN(xb_ld(&bar[XB_XGEN(b.x)]) == gen, bar);
            __builtin_amdgcn_fence(__ATOMIC_ACQUIRE, "agent");
            asm volatile("s_waitcnt vmcnt(0)" ::: "memory");
        }
    }
    __syncthreads();
}

namespace pg8 {
constexpr int BM = 256, BK = 64, HALF = 128, HTB = HALF * BK * 2, STAGE_BYTES = 8 * HTB, NXCD = 8, WGM = 8;
__host__ __device__ __forceinline__ int lds_byte(int r, int c) { const int st = (r >> 4) * 2 + (c >> 5), rr = r & 15, cc = c & 31, ob = rr * 64 + cc * 2; return st * 1024 + (ob ^ (((ob >> 9) & 1) << 5)); }
__host__ __device__ __forceinline__ void stage_rc(int b, int& R, int& C) { const int st = b / 1024, sb = b % 1024, swz = sb ^ (((sb >> 9) & 1) << 5); R = (st >> 1) * 16 + swz / 64; C = (st & 1) * 32 + (swz % 64) / 2; }
__host__ __device__ __forceinline__ int perm32(int rho) { const int n = rho >> 4, i = rho & 15; return 8 * (i >> 2) + 4 * n + (i & 3); }

struct Unit { int pm, pn, e, mt, roff, nai; };
__device__ __forceinline__ bool split_index(long L, int nwg, int G, int& uidx, int& roff, int& nai) {
    const int R = nwg / G, r = nwg % G; const bool split = (r > 0) && (2 * r <= G);
    if (L < (long)R * G || !split) { if (L >= nwg) return false; uidx = (int)L; roff = 0; nai = 2; return true; }
    const int h = (int)(L - (long)R * G); if (h >= 2 * r) return false; uidx = R * G + (h >> 1); roff = (h & 1) * 128; nai = 1; return true;
}

__device__ __forceinline__ int xcd_remap(int wgid, int nwg) { const int q = nwg / NXCD, r = nwg % NXCD, xcd = wgid % NXCD, off = wgid / NXCD; return (xcd < r ? xcd * (q + 1) : r * (q + 1) + (xcd - r) * q) + off; }

struct DenseOrder {
    const char* A; const char* B; int K; int nM, nN, nwg, G, c;
    __device__ __forceinline__ void init(const bf16* A_, const bf16* B_, int M, int N, int K_, int G_, int c_) { A = (const char*)A_; B = (const char*)B_; K = K_; nM = M / BM; nN = N / BM; nwg = nM * nN; G = G_; c = c_; }
    __device__ __forceinline__ bool next(int i, Unit& u) const {
        int uidx; if (!split_index((long)i * G + c, nwg, G, uidx, u.roff, u.nai)) return false;
        const int wgid = xcd_remap(uidx, nwg);
        const int nig = WGM * nN, gid = wgid / nig, fm = gid * WGM, gsz = (nM - fm) < WGM ? (nM - fm) : WGM;
        u.pm = fm + ((wgid % nig) % gsz); u.pn = (wgid % nig) / gsz; u.e = 0; u.mt = 0; return true;
    }
    __device__ __forceinline__ const char* a_ptr(const Unit& u) const { return A + (size_t)(u.pm * BM + u.roff) * K * 2; }
    __device__ __forceinline__ const char* b_ptr(const Unit& u) const { return B + (size_t)u.pn * BM * K * 2; }
    __device__ __forceinline__ int tok(const Unit&, int) const { return 0; }
};
struct MoeOrder {
    const char* A; const char* B; int K; size_t bstride;
    const LAS int* tab; const int* list; int RT, nwg, G, c;
    __device__ __forceinline__ bool next(int i, Unit& u) const {
        int uidx; if (!split_index((long)i * G + c, nwg, G, uidx, u.roff, u.nai)) return false;
        const int wgid = xcd_remap(uidx, nwg);
        const int rt = wgid >> 2; u.pm = rt; u.pn = wgid & 3; const int t = tab[rt]; u.e = t & 255; u.mt = t >> 8; return true;
    }
    __device__ __forceinline__ const char* a_ptr(const Unit& u) const { return A + (size_t)(u.pm * BM + u.roff) * K * 2; }
    __device__ __forceinline__ const char* b_ptr(const Unit& u) const { return B + (size_t)u.e * bstride + (size_t)u.pn * BM * K * 2; }
    __device__ __forceinline__ int tok(const Unit& u, int r) const { const int cnt = tab[RT_MAX + 1 + u.e]; const int pos = u.mt * BM + u.roff + r; return pos < cnt ? list[(size_t)u.e * TALL + pos] : 0; }
};

__device__ __forceinline__ unsigned cvt_pk_bf16(float lo, float hi) { unsigned r; asm volatile("v_cvt_pk_bf16_f32 %0, %1, %2" : "=v"(r) : "v"(lo), "v"(hi)); return r; }

template <class Epi, class Sched, bool GATHER>
__device__ __forceinline__ void gemm_phase(LAS unsigned char* lds, const int tid, const int K, const Sched& S, const Epi& E) {
    const int wid = __builtin_amdgcn_readfirstlane(tid >> 6), lane = tid & 63, wr = wid >> 2, wc = wid & 3, fr = lane & 15, fq = lane >> 4;
    const int nt = K / BK;
    unsigned voffA[2], voffB[2]; int RA[2], CA[2];
#pragma unroll
    for (int i = 0; i < 2; ++i) { int R, C; stage_rc(tid * 16 + i * 8192, R, C); const int Rb = Epi::PERM ? ((R & ~31) + perm32(R & 31)) : R;
        RA[i] = R; CA[i] = C; voffA[i] = (unsigned)(R * K + C) * 2u; voffB[i] = (unsigned)(Rb * K + C) * 2u; }
    const size_t kstep = (size_t)(BK * 2);
    const size_t hstep = (size_t)HALF * K * 2;
    const unsigned ldsw = (unsigned)wid * 1024u;
    const int aoff = lds_byte(wr * 64 + fr, fq * 8), boff = lds_byte(wc * 32 + fr, fq * 8);
#define PG8_SA(b, h) (((b) * 2 + (h)) * HTB)
#define PG8_SB(b, h) ((4 + (b) * 2 + (h)) * HTB)
#define PG8_STAGE(bufoff, gbase, voff) do { _Pragma("unroll") for (int _i = 0; _i < 2; ++_i) \
        __builtin_amdgcn_global_load_lds((const unsigned*)((const char*)(gbase) + (voff)[_i]), (LAS unsigned*)(lds + (bufoff) + ldsw + _i * 8192), 16, 0, 0); } while (0)
#define PG8_STAGE_A(bufoff, h, usenext, koff) do { if constexpr (GATHER) { unsigned _vo[2]; _vo[0] = (usenext) ? nvA[h][0] : vA[h][0]; _vo[1] = (usenext) ? nvA[h][1] : vA[h][1]; PG8_STAGE(bufoff, S.A + (koff), _vo); } \
        else { PG8_STAGE(bufoff, ((usenext) ? nA : cA) + (size_t)(h) * hstep + (koff), voffA); } } while (0)
#define PG8_LDA(dst, b, h) do { _Pragma("unroll") for (int m = 0; m < 4; ++m) _Pragma("unroll") for (int k = 0; k < 2; ++k) dst[m][k] = *(const LAS bf16x8*)(lds + PG8_SA(b, h) + aoff + m * 2048 + k * 1024); } while (0)
#define PG8_LDB(dst, b, h) do { _Pragma("unroll") for (int n = 0; n < 2; ++n) _Pragma("unroll") for (int k = 0; k < 2; ++k) dst[n][k] = *(const LAS bf16x8*)(lds + PG8_SB(b, h) + boff + n * 2048 + k * 1024); } while (0)
#define PG8_MMA(ai, bj, At, Bt) do { __builtin_amdgcn_s_setprio(1); _Pragma("unroll") for (int m = 0; m < 4; ++m) _Pragma("unroll") for (int n = 0; n < 2; ++n) _Pragma("unroll") for (int k = 0; k < 2; ++k) \
        acc[ai][bj][m][n] = __builtin_amdgcn_mfma_f32_16x16x32_bf16(Bt[n][k], At[m][k], acc[ai][bj][m][n], 0, 0, 0); __builtin_amdgcn_s_setprio(0); } while (0)
#define PG8_WAIT_V(n) asm volatile("s_waitcnt vmcnt(" #n ")" ::: "memory")
#define PG8_WAIT_L(n) asm volatile("s_waitcnt lgkmcnt(" #n ")" ::: "memory")
#define PG8_BAR __builtin_amdgcn_s_barrier()
#define PG8_SCHED __builtin_amdgcn_sched_barrier(0)
    Unit cur, nxt; int ui = 0;
    if (!S.next(0, cur)) return;
    f32x4 acc[2][2][4][2];
#pragma unroll
    for (int a = 0; a < 2; ++a)
#pragma unroll
        for (int b = 0; b < 2; ++b)
#pragma unroll
            for (int m = 0; m < 4; ++m)
#pragma unroll
                for (int n = 0; n < 2; ++n) acc[a][b][m][n] = (f32x4){0.f, 0.f, 0.f, 0.f};
    bf16x8 At[4][2], B0[2][2], B1[2][2];
    unsigned vA[2][2], nvA[2][2];
    if constexpr (GATHER) {
#pragma unroll
        for (int h = 0; h < 2; ++h)
#pragma unroll
            for (int i = 0; i < 2; ++i) { vA[h][i] = (unsigned)(S.tok(cur, h * HALF + RA[i]) * K + CA[i]) * 2u; nvA[h][i] = vA[h][i]; }
    }
    const char* cA = S.a_ptr(cur); const char* cB = S.b_ptr(cur); const char* nA = cA;
    PG8_STAGE(PG8_SB(0, 0), cB, voffB); PG8_STAGE(PG8_SB(0, 1), cB + hstep, voffB); PG8_STAGE_A(PG8_SA(0, 0), 0, false, 0); PG8_STAGE_A(PG8_SA(0, 1), 1, false, 0);
    if (wr == 1) PG8_BAR;
    PG8_WAIT_V(2); PG8_BAR;
    PG8_STAGE(PG8_SB(1, 0), cB + kstep, voffB); PG8_STAGE_A(PG8_SA(1, 0), 0, false, kstep); PG8_STAGE(PG8_SB(1, 1), cB + hstep + kstep, voffB);
    PG8_WAIT_V(6); PG8_BAR;
    for (;;) {
        const bool has_next = S.next(ui + 1, nxt);
        nA = has_next ? S.a_ptr(nxt) : cA; const char* nB = has_next ? S.b_ptr(nxt) : cB;
        if constexpr (GATHER) {
            if (has_next) {
#pragma unroll
                for (int h = 0; h < 2; ++h)
#pragma unroll
                    for (int i = 0; i < 2; ++i) nvA[h][i] = (unsigned)(S.tok(nxt, h * HALF + RA[i]) * K + CA[i]) * 2u;
            }
        }
        const bool full = (cur.nai == 2);
        for (int t = 0; t < nt; t += 2) {
            const bool last = (t == nt - 2);
            const size_t k1 = (size_t)(t + 1) * kstep;
            const size_t k2 = last ? 0 : (size_t)(t + 2) * kstep, k3 = k2 + kstep;
            const char* b2 = last ? nB : cB + (size_t)(t + 2) * kstep; const char* b3 = b2 + kstep;
            PG8_LDB(B0, 0, 0); PG8_LDB(B1, 0, 1); PG8_SCHED; PG8_LDA(At, 0, 0); PG8_STAGE_A(PG8_SA(1, 1), 1, false, k1);
            PG8_WAIT_V(8); PG8_WAIT_L(0); PG8_BAR; PG8_MMA(0, 0, At, B0); PG8_MMA(0, 1, At, B1); PG8_BAR; PG8_SCHED;
            if (full) PG8_LDA(At, 0, 1); PG8_STAGE(PG8_SB(0, 0), b2, voffB); PG8_STAGE(PG8_SB(0, 1), b2 + hstep, voffB); PG8_STAGE_A(PG8_SA(0, 0), 0, last, k2);
            PG8_WAIT_V(8); PG8_WAIT_L(0); PG8_BAR; if (full) { PG8_MMA(1, 0, At, B0); PG8_MMA(1, 1, At, B1); } PG8_BAR; PG8_SCHED;
            PG8_LDB(B0, 1, 0); PG8_LDB(B1, 1, 1); PG8_SCHED; PG8_LDA(At, 1, 0); PG8_STAGE_A(PG8_SA(0, 1), 1, last, k2);
            PG8_WAIT_V(8); PG8_WAIT_L(0); PG8_BAR; PG8_MMA(0, 0, At, B0); PG8_MMA(0, 1, At, B1); PG8_BAR; PG8_SCHED;
            if (full) PG8_LDA(At, 1, 1); PG8_STAGE(PG8_SB(1, 0), b3, voffB); PG8_STAGE(PG8_SB(1, 1), b3 + hstep, voffB); PG8_STAGE_A(PG8_SA(1, 0), 0, last, k3);
            PG8_WAIT_V(8); PG8_WAIT_L(0); PG8_BAR; if (full) { PG8_MMA(1, 0, At, B0); PG8_MMA(1, 1, At, B1); } PG8_BAR; PG8_SCHED;
        }
        if (wr == 0) PG8_BAR;
        E(acc, cur, wr, wc, fr, fq);
        if (!has_next) break;
#pragma unroll
        for (int a = 0; a < 2; ++a)
#pragma unroll
            for (int b = 0; b < 2; ++b)
#pragma unroll
                for (int m = 0; m < 4; ++m)
#pragma unroll
                    for (int n = 0; n < 2; ++n) acc[a][b][m][n] = (f32x4){0.f, 0.f, 0.f, 0.f};
        cur = nxt; cA = nA; cB = nB; ++ui;
        if constexpr (GATHER) {
#pragma unroll
            for (int h = 0; h < 2; ++h)
#pragma unroll
                for (int i = 0; i < 2; ++i) vA[h][i] = nvA[h][i];
        }
        if (wr == 1) PG8_BAR;
    }
    PG8_WAIT_V(0);
    PG8_BAR;
#undef PG8_SA
#undef PG8_SB
#undef PG8_STAGE
#undef PG8_STAGE_A
#undef PG8_LDA
#undef PG8_LDB
#undef PG8_MMA
#undef PG8_WAIT_V
#undef PG8_WAIT_L
#undef PG8_BAR
#undef PG8_SCHED
}
}

namespace pg8 {
__device__ __forceinline__ void row_bt(int row, int& b, int& tok) { if (row < TX) { b = row >> 11; tok = row & 2047; } else { const int r = row - TX; b = r >> 8; tok = SEQ + (r & 255); } }

struct EpiAttnIn {
    static constexpr bool PERM = true;
    bf16* QKV; bf16* VAT; bf16* VBT; const LAS float* rope;
    __device__ __forceinline__ void operator()(const f32x4 (&acc)[2][2][4][2], const Unit& u, int wr, int wc, int fr, int fq) const {
        const int row0 = u.pm * BM + u.roff + wr * 64 + fr; const int seg = u.pn >> 1;
        const bool latent = u.pm < (TX / BM);
        if (seg == 2 || seg == 5) {
#pragma unroll
            for (int ai = 0; ai < 2; ++ai) if (ai < u.nai)
#pragma unroll
                for (int m = 0; m < 4; ++m) { const int row = row0 + ai * HALF + m * 16; int b, tok; row_bt(row, b, tok);
#pragma unroll
                    for (int bj = 0; bj < 2; ++bj) { const int col = u.pn * BM + bj * HALF + wc * 32 + 8 * fq;
                        bf16* dst;
                        if (seg == 2) { const int cs = col - 1024; dst = VAT + ((size_t)(b * 4 + (cs >> 7)) * 128 + (cs & 127)) * NKEY + tok; }
                        else { const int cs = col - 2560; dst = VBT + ((size_t)(b * 8 + (cs >> 6)) * 64 + (cs & 63)) * NKEY + tok; }
#pragma unroll
                        for (int n = 0; n < 2; ++n)
#pragma unroll
                            for (int i = 0; i < 4; ++i) dst[(size_t)(4 * n + i) * NKEY] = (bf16)f2bf(acc[ai][bj][m][n][i]); } }
            return;
        }
        const bool dorope = latent && seg < 2;
        const float qs = (seg == 0 || seg == 3) ? 0.125f * LOG2E : 1.0f;
#pragma unroll
        for (int ai = 0; ai < 2; ++ai) if (ai < u.nai)
#pragma unroll
            for (int m = 0; m < 4; ++m) { const int row = row0 + ai * HALF + m * 16;
                f32x4 cs4[4];
                if (dorope) { const int t = row & 2047; const int pos = (wc & 1) ? (t & 63) : (t >> 6);
                    const LAS f32x4* rp = (const LAS f32x4*)(rope + (pos * 16 + 8 * (fq & 1)) * 2);
#pragma unroll
                    for (int j = 0; j < 4; ++j) cs4[j] = rp[j]; }
#pragma unroll
                for (int bj = 0; bj < 2; ++bj) { const int col = u.pn * BM + bj * HALF + wc * 32 + 8 * fq;
                    float v[8];
#pragma unroll
                    for (int n = 0; n < 2; ++n)
#pragma unroll
                        for (int i = 0; i < 4; ++i) v[4 * n + i] = acc[ai][bj][m][n][i];
                    if (dorope) {
#pragma unroll
                        for (int j = 0; j < 8; ++j) { const float other = __shfl_xor(v[j], 32); const float c = cs4[j >> 1][(j & 1) * 2], s = cs4[j >> 1][(j & 1) * 2 + 1];
                            v[j] = (fq < 2) ? (v[j] * c - other * s) : (v[j] * c + other * s); } }
                    u32x4 w; w.x = pk2(v[0] * qs, v[1] * qs); w.y = pk2(v[2] * qs, v[3] * qs); w.z = pk2(v[4] * qs, v[5] * qs); w.w = pk2(v[6] * qs, v[7] * qs);
                    *(u32x4*)(QKV + (size_t)row * NATT + col) = w; } }
    }
};
struct EpiGlaIn {
    static constexpr bool PERM = true;
    bf16* QKV2; bf16* VGT;
    __device__ __forceinline__ void operator()(const f32x4 (&acc)[2][2][4][2], const Unit& u, int wr, int wc, int fr, int fq) const {
        const int row0 = u.pm * BM + u.roff + wr * 64 + fr;
        if (u.pn >= 4 && u.pn < 8) {
#pragma unroll
            for (int ai = 0; ai < 2; ++ai) if (ai < u.nai)
#pragma unroll
                for (int m = 0; m < 4; ++m) { const int row = row0 + ai * HALF + m * 16; int b, tok; row_bt(row, b, tok);
#pragma unroll
                    for (int bj = 0; bj < 2; ++bj) { const int cs = u.pn * BM + bj * HALF + wc * 32 + 8 * fq - 1024;
                        bf16* dst = VGT + ((size_t)(b * 4 + (cs >> 8)) * 256 + (cs & 255)) * NKEY + tok;
#pragma unroll
                        for (int n = 0; n < 2; ++n)
#pragma unroll
                            for (int i = 0; i < 4; ++i) dst[(size_t)(4 * n + i) * NKEY] = (bf16)f2bf(acc[ai][bj][m][n][i]); } }
            return;
        }
        const float qs = (u.pn < 2) ? 0.08838834764831845f : 1.0f;
#pragma unroll
        for (int ai = 0; ai < 2; ++ai) if (ai < u.nai)
#pragma unroll
            for (int m = 0; m < 4; ++m) { const int row = row0 + ai * HALF + m * 16;
#pragma unroll
                for (int bj = 0; bj < 2; ++bj) { const int col = u.pn * BM + bj * HALF + wc * 32 + 8 * fq; const f32x4 a = acc[ai][bj][m][0] * qs, c = acc[ai][bj][m][1] * qs;
                    u32x4 w; w.x = pk2(a[0], a[1]); w.y = pk2(a[2], a[3]); w.z = pk2(c[0], c[1]); w.w = pk2(c[2], c[3]);
                    *(u32x4*)(QKV2 + (size_t)row * NGLA + col) = w; } }
    }
};
struct EpiResid {
    static constexpr bool PERM = false;
    const float* IL; const float* IC; float* XL; float* XC; const float* modv;
    __device__ __forceinline__ void operator()(const f32x4 (&acc)[2][2][4][2], const Unit& u, int wr, int wc, int fr, int fq) const {
        const int row0 = u.pm * BM + u.roff + wr * 64 + fr, col0 = u.pn * BM + wc * 32 + 4 * fq;
        const bool latent = u.pm < (TX / BM); const int bi = latent ? (u.pm >> 3) : 8;
        float* base = latent ? XL : (XC - (size_t)TX * D); const float* ibase = latent ? IL : (IC - (size_t)TX * D);
        f32x4 gv[2][2];
#pragma unroll
        for (int bj = 0; bj < 2; ++bj)
#pragma unroll
            for (int n = 0; n < 2; ++n) gv[bj][n] = *(const f32x4*)(modv + bi * 6144 + col0 + bj * HALF + n * 16);
#pragma unroll
        for (int ai = 0; ai < 2; ++ai) if (ai < u.nai)
#pragma unroll
            for (int m = 0; m < 4; ++m) { const size_t ro = (size_t)(row0 + ai * HALF + m * 16) * D + col0;
#pragma unroll
                for (int bj = 0; bj < 2; ++bj)
#pragma unroll
                    for (int n = 0; n < 2; ++n) { const size_t o = ro + bj * HALF + n * 16; *(f32x4*)(base + o) = *(const f32x4*)(ibase + o) + gv[bj][n] * acc[ai][bj][m][n]; } }
    }
};
struct EpiMoe1 {
    static constexpr bool PERM = false;
    bf16* HB;
    __device__ __forceinline__ void operator()(const f32x4 (&acc)[2][2][4][2], const Unit& u, int wr, int wc, int fr, int fq) const {
        const int row0 = u.pm * BM + u.roff + wr * 64 + fr, col0 = u.pn * 128 + wc * 16 + 4 * fq;
#pragma unroll
        for (int ai = 0; ai < 2; ++ai) if (ai < u.nai)
#pragma unroll
            for (int m = 0; m < 4; ++m) { bf16* rowp = HB + (size_t)(row0 + ai * HALF + m * 16) * DEXP + col0;
#pragma unroll
                for (int bj = 0; bj < 2; ++bj) { const f32x4 a = acc[ai][bj][m][0], b = acc[ai][bj][m][1];
                    u32x2 w; w.x = pk2(silu_f(a[0]) * b[0], silu_f(a[1]) * b[1]); w.y = pk2(silu_f(a[2]) * b[2], silu_f(a[3]) * b[3]);
                    *(u32x2*)(rowp + bj * 64) = w; } }
    }
};
struct EpiBf16 {
    static constexpr bool PERM = true;
    bf16* O; int ldc;
    __device__ __forceinline__ void operator()(const f32x4 (&acc)[2][2][4][2], const Unit& u, int wr, int wc, int fr, int fq) const {
        const int row0 = u.pm * BM + u.roff + wr * 64 + fr, col0 = u.pn * BM + wc * 32 + 8 * fq;
#pragma unroll
        for (int ai = 0; ai < 2; ++ai) if (ai < u.nai)
#pragma unroll
            for (int m = 0; m < 4; ++m) { bf16* rowp = O + (size_t)(row0 + ai * HALF + m * 16) * ldc + col0;
#pragma unroll
                for (int bj = 0; bj < 2; ++bj) { const f32x4 a = acc[ai][bj][m][0], c = acc[ai][bj][m][1];
                    u32x4 w; w.x = pk2(a[0], a[1]); w.y = pk2(a[2], a[3]); w.z = pk2(c[0], c[1]); w.w = pk2(c[2], c[3]);
                    *(u32x4*)(rowp + bj * HALF) = w; } }
    }
};
}

struct Args {
    const float *x, *c, *ctx, *c_ctx, *w_mod, *b_mod, *norm_g, *final_g, *att_w_in, *att_w_out, *att_lambda, *att_subln_g, *na_bias,
                *gla_w_in, *gla_w_gate, *gla_b_gate, *gla_norm_g, *gla_w_out, *router_w, *router_bias, *moe_w1, *moe_w3, *moe_w2;
    float* out; unsigned char* ws; int ph_lo, ph_hi, rep, pad;
};

struct RowMapId { int off; __device__ __forceinline__ int operator()(int n) const { return off + n; } };
struct RowMapMoe { int which; __device__ __forceinline__ int operator()(int n) const { return 32 * (n >> 4) + 16 * which + (n & 15); } };
template <class RM>
__device__ __forceinline__ void p0_transpose_item(const float* W, int K, int N, bf16* WT, LAS float* scr, int item, int lane, RM rm) {
    const int nblk = N / 32, kb = item / nblk, nb = item % nblk, k0 = 64 * kb, n0 = 32 * nb;
    float ld[32];
#pragma unroll
    for (int i = 0; i < 32; ++i) ld[i] = W[(size_t)(k0 + 2 * i + (lane >> 5)) * N + n0 + (lane & 31)];
#pragma unroll
    for (int i = 0; i < 32; ++i) scr[(2 * i + (lane >> 5)) * 33 + (lane & 31)] = ld[i];
    LDS_WAIT(); asm volatile("" ::: "memory");
    const int c = lane & 7;
#pragma unroll
    for (int j = 0; j < 4; ++j) { const int n = (lane >> 3) + 8 * j; const LAS float* s = scr + (8 * c) * 33 + n;
        u32x4 o; o.x = pk2(s[0 * 33], s[1 * 33]); o.y = pk2(s[2 * 33], s[3 * 33]); o.z = pk2(s[4 * 33], s[5 * 33]); o.w = pk2(s[6 * 33], s[7 * 33]);
        *(u32x4*)(WT + (size_t)rm(n0 + n) * K + k0 + 8 * c) = o; }
    LDS_WAIT(); asm volatile("" ::: "memory");
}

constexpr int CV_ATTIN = 1536, CV_ATTOUT = 512, CV_GLAIN = 1552, CV_GLAPAD = 28, CV_GLAOUT = 512, CV_W = 4096, CV_MOE = 3 * CV_W;
constexpr int CT_ATTN0 = CV_ATTIN + CV_ATTOUT, CT_MOE0 = CT_ATTN0 + CV_MOE, CT_GLA0 = CT_MOE0 + CV_GLAIN + CV_GLAPAD + CV_GLAOUT, CT_ATTN1 = CT_GLA0 + CV_ATTIN + CV_ATTOUT, CT_MOE1 = CT_ATTN1 + CV_MOE,
              CT_MOE2 = CT_MOE1 + CV_MOE, CT_GLA1 = CT_MOE2 + CV_GLAIN + CV_GLAPAD + CV_GLAOUT, CT_MOE3 = CT_GLA1 + CV_MOE, CV_TOTAL = CT_MOE3;
constexpr int CV_UNIT = 16;
struct ConvPtrs { const float *att_w_in, *att_w_out, *gla_w_in, *gla_w_out, *moe_w1, *moe_w3, *moe_w2; unsigned char* ws; };
struct RowMapAny { int moe, which; __device__ __forceinline__ int operator()(int n) const { return moe ? 32 * (n >> 4) + 16 * which + (n & 15) : n; } };
__device__ __forceinline__ void conv_item(const ConvPtrs& P, int it, LAS float* scr, int lane) {
    int kind, j, r;
    if (it < CT_ATTN0) { kind = 0; j = 0; r = it; } else if (it < CT_MOE0) { kind = 2; j = 0; r = it - CT_ATTN0; } else if (it < CT_GLA0) { kind = 1; j = 0; r = it - CT_MOE0; }
    else if (it < CT_ATTN1) { kind = 0; j = 1; r = it - CT_GLA0; } else if (it < CT_MOE1) { kind = 2; j = 1; r = it - CT_ATTN1; } else if (it < CT_MOE2) { kind = 2; j = 2; r = it - CT_MOE1; }
    else if (it < CT_GLA1) { kind = 1; j = 1; r = it - CT_MOE2; } else { kind = 2; j = 3; r = it - CT_GLA1; }
    const float* W; bf16* WT; int K = D, N = D, sub = r; RowMapAny rm{0, 0};
    if (kind == 2) {
        const int which = r / CV_W, q = r % CV_W, e = q >> 8, je = j * 16 + e; sub = q & 255;
        if (which < 2) { W = (which ? P.moe_w3 : P.moe_w1) + (size_t)je * D * DEXP; N = DEXP; WT = (bf16*)(P.ws + WS_W13) + (size_t)je * D * D; rm.moe = 1; rm.which = which; }
        else { W = P.moe_w2 + (size_t)je * DEXP * D; K = DEXP; WT = (bf16*)(P.ws + WS_W2) + (size_t)je * D * DEXP; }
    } else if (kind == 0) {
        if (r < CV_ATTIN) { W = P.att_w_in + (size_t)j * D * NATT; N = NATT; WT = (bf16*)(P.ws + WS_WATTIN) + (size_t)j * NATT * D; }
        else { W = P.att_w_out + (size_t)j * D * D; WT = (bf16*)(P.ws + WS_WATTOUT) + (size_t)j * D * D; sub = r - CV_ATTIN; }
    } else {
        if (r < CV_GLAIN) { W = P.gla_w_in + (size_t)j * D * 3104; N = 3104; WT = (bf16*)(P.ws + WS_WGLAIN) + (size_t)j * NGLA * D; }
        else if (r < CV_GLAIN + CV_GLAPAD) { const int c0 = (r - CV_GLAIN) * 1024;
            for (int i = lane; i < 1024; i += 64) *(u32x4*)((bf16*)(P.ws + WS_WGLAIN) + (size_t)j * NGLA * D + (size_t)3104 * D + (size_t)(c0 + i) * 8) = (u32x4){0u, 0u, 0u, 0u};
            return; }
        else { W = P.gla_w_out + (size_t)j * D * D; WT = (bf16*)(P.ws + WS_WGLAOUT) + (size_t)j * D * D; sub = r - CV_GLAIN - CV_GLAPAD; }
    }
    p0_transpose_item(W, K, N, WT, scr, sub, lane, rm);
}
__device__ __forceinline__ void conv_static(const ConvPtrs& P, int cur, int need, LAS unsigned char* lds, int lane, int wave, int vcu, int G) {
    LAS float* scr = (LAS float*)(lds + wave * 8448);
    for (int it = cur + vcu * 8 + wave; it < need; it += G * 8) conv_item(P, it, scr, lane);
}
__device__ __forceinline__ void conv_unit(const ConvPtrs& P, int i0, int hi, LAS unsigned char* lds, int lane, int wave) {
    LAS float* scr = (LAS float*)(lds + wave * 8448);
#pragma unroll 1
    for (int k = 0; k < CV_UNIT / 8; ++k) { const int it = i0 + wave * (CV_UNIT / 8) + k; if (it < hi) conv_item(P, it, scr, lane); }
}

template <class AP> __device__ __forceinline__ void p0_prologue(const AP ap, LAS unsigned char* lds, int tid, int lane, int wave, int vcu, int G) {
    unsigned char* ws = ap->ws;
    LAS float* S9 = (LAS float*)(lds + 69632);
    LAS float* red = (LAS float*)(lds + 106496);
    { const ConvPtrs P{ap->att_w_in, ap->att_w_out, ap->gla_w_in, ap->gla_w_out, ap->moe_w1, ap->moe_w3, ap->moe_w2, ws};
      conv_static(P, 0, MK_CONVQ ? CT_ATTN0 : CV_TOTAL, lds, lane, wave, vcu, G); }
    __syncthreads();
    { const float* cc = ap->c; const float* cx = ap->c_ctx;
      for (int i = tid; i < 9 * 1024; i += 512) { const int bi = i >> 10, k = i & 1023; const float v = (bi < 8) ? cc[bi * D + k] : cx[k]; S9[i] = v / (1.0f + __expf(-v)); } }
    __syncthreads();
    const float* w_mod = ap->w_mod; const float* b_mod = ap->b_mod;
    for (int u = vcu; u < 4 * 96; u += G) {
        const int L = u / 96, n0 = (u % 96) * 64;
        const float* W = w_mod + (size_t)L * D * 6144 + n0 + lane;
        float acc[9];
#pragma unroll
        for (int bi = 0; bi < 9; ++bi) acc[bi] = 0.f;
        const int kb = wave * 128;
        for (int k0 = 0; k0 < 128; k0 += 32) { float wv[32];
#pragma unroll
            for (int k = 0; k < 32; ++k) wv[k] = W[(size_t)(kb + k0 + k) * 6144];
#pragma unroll
            for (int k = 0; k < 32; ++k)
#pragma unroll
                for (int bi = 0; bi < 9; ++bi) acc[bi] += S9[bi * 1024 + kb + k0 + k] * wv[k]; }
#pragma unroll
        for (int bi = 0; bi < 9; ++bi) red[(wave * 9 + bi) * 64 + lane] = acc[bi];
        __syncthreads();
        for (int i = tid; i < 9 * 64; i += 512) { const int bi = i >> 6, l = i & 63; float sm = b_mod[L * 6144 + n0 + l];
#pragma unroll
            for (int w = 0; w < 8; ++w) sm += red[(w * 9 + bi) * 64 + l];
            ((float*)(ws + WS_MODV))[(size_t)(L * 9 + bi) * 6144 + n0 + l] = sm; }
        __syncthreads();
    }
}

__device__ __forceinline__ float* xrow_ptr(float* XL, float* XC, int row) { return row < TX ? XL + (size_t)row * D : XC + (size_t)(row - TX) * D; }
__device__ __forceinline__ int row_bi(int row) { return row < TX ? (row >> 11) : 8; }

__device__ __forceinline__ void norm_mod_store(const f32x4 (&v)[4], const float* g, const float* sh, const float* sc, bf16* orow, int lane) {
    float ss = 0.f;
#pragma unroll
    for (int j = 0; j < 4; ++j) ss += (v[j].x * v[j].x + v[j].y * v[j].y) + (v[j].z * v[j].z + v[j].w * v[j].w);
    const float rs = __builtin_amdgcn_rsqf(wave_sum(ss) * (1.0f / D) + EPSF);
#pragma unroll
    for (int j = 0; j < 4; ++j) { const int c = 4 * lane + 256 * j; const f32x4 gg = *(const f32x4*)(g + c), s1 = *(const f32x4*)(sc + c), s0 = *(const f32x4*)(sh + c);
        const f32x4 y = (v[j] * rs) * gg * (1.0f + s1) + s0;
        u32x2 w; w.x = pk2(y.x, y.y); w.y = pk2(y.z, y.w); *(u32x2*)(orow + c) = w; }
}

__device__ __forceinline__ void phase_norm1(const float* XL, const float* XC, const float* g, const float* modv, bf16* H, int nrows, int lane, int wave, int vcu, int G) {
    for (int row = vcu * 8 + wave; row < nrows; row += G * 8) {
        const f32x4* xr = (const f32x4*)(row < TX ? XL + (size_t)row * D : XC + (size_t)(row - TX) * D) + lane; f32x4 v[4];
#pragma unroll
        for (int j = 0; j < 4; ++j) v[j] = xr[64 * j];
        const float* mv = modv + row_bi(row) * 6144;
        norm_mod_store(v, g, mv, mv + 1024, H + (size_t)row * D, lane);
    }
}

__device__ __forceinline__ void phase_router(float* XL, float* XC, const float* g, const float* modv, bf16* H, const float* router_w, const float* router_bias,
                                             unsigned* cnt  , int* list, int* toki, float* tokw, int nrows,
                                             LAS unsigned char* lds, int tid, int lane, int wave, int vcu, int G, int probe) {
    LAS float* RW = (LAS float*)lds;
    LAS int* lcnt = (LAS int*)(lds + 65536);
    LAS int* rinfo = (LAS int*)(lds + 65536 + 256);
    for (int it = 0; it < 8; ++it) { const int idx = tid + 512 * it, k = idx >> 2, q = idx & 3; const f32x4 w = *(const f32x4*)(router_w + k * 16 + 4 * q);
        RW[(4 * q + 0) * 1024 + k] = w.x; RW[(4 * q + 1) * 1024 + k] = w.y; RW[(4 * q + 2) * 1024 + k] = w.z; RW[(4 * q + 3) * 1024 + k] = w.w; }
    if (tid < 32) lcnt[tid] = 0;
    __syncthreads();
    const int rpb = nrows / G, rpw = rpb / 8;
    const int gI = lane >> 4;
    const f32x4 rb = *(const f32x4*)(router_bias + 4 * gI);
    for (int rep = (probe ? 0 : 1); rep < 2; ++rep)
    for (int i0 = 0; i0 < rpw; i0 += 3) {
        asm volatile("" ::: "memory");
        f32x4 y[3][4];
#pragma unroll
        for (int r = 0; r < 3; ++r) {
            const int ii = (i0 + r < rpw) ? i0 + r : rpw - 1; const int row = vcu * rpb + wave * rpw + ii;
            const f32x4* xr = (const f32x4*)xrow_ptr(XL, XC, row) + lane; f32x4 v[4];
#pragma unroll
            for (int j = 0; j < 4; ++j) v[j] = xr[64 * j];
            const float* mv = modv + row_bi(row) * 6144 + 3072;
            float ss = 0.f;
#pragma unroll
            for (int j = 0; j < 4; ++j) ss += (v[j].x * v[j].x + v[j].y * v[j].y) + (v[j].z * v[j].z + v[j].w * v[j].w);
            const float rs = __builtin_amdgcn_rsqf(wave_sum(ss) * (1.0f / D) + EPSF);
#pragma unroll
            for (int j = 0; j < 4; ++j) { const int c = 4 * lane + 256 * j; const f32x4 gg = *(const f32x4*)(g + c), s1 = *(const f32x4*)(mv + 1024 + c), s0 = *(const f32x4*)(mv + c);
                y[r][j] = (v[j] * rs) * gg * (1.0f + s1) + s0;
                u32x2 w; w.x = cvtpk(y[r][j].x, y[r][j].y); w.y = cvtpk(y[r][j].z, y[r][j].w); *(u32x2*)(H + (size_t)row * D + c) = w; }
            __builtin_amdgcn_sched_barrier(0);
        }
        float p[3][16];
#pragma unroll
        for (int e = 0; e < 16; ++e) {
#pragma unroll
            for (int r = 0; r < 3; ++r) p[r][e] = 0.f;
#pragma unroll
            for (int j = 0; j < 4; ++j) { const f32x4 w = *(const LAS f32x4*)(RW + e * 1024 + 4 * lane + 256 * j);
#pragma unroll
                for (int r = 0; r < 3; ++r) p[r][e] += (y[r][j].x * w.x + y[r][j].y * w.y) + (y[r][j].z * w.z + y[r][j].w * w.w); }
#pragma unroll
            for (int r = 0; r < 3; ++r) asm volatile("" : "+v"(p[r][e])); }
#pragma unroll
        for (int r = 0; r < 3; ++r) {
            float q8[8], lg[4];
#pragma unroll
            for (int j = 0; j < 8; ++j) q8[j] = swap32_add(p[r][j], p[r][j + 8]);
#pragma unroll
            for (int j = 0; j < 4; ++j) lg[j] = row_sum(swap16_add(q8[j], q8[j + 4]));
            float sc[4], sel[4];
#pragma unroll
            for (int j = 0; j < 4; ++j) { sc[j] = 1.0f / (1.0f + __expf(-lg[j])); sel[j] = sc[j] + rb[j]; }
            int i1 = 0, i2 = 0; float m1 = -1e30f, m2 = -1e30f, w1 = 0.f, w2 = 0.f;
#pragma unroll
            for (int j = 0; j < 4; ++j) { const float t = sel[j];
                if (t > m1) { m2 = m1; i2 = i1; w2 = w1; m1 = t; i1 = j; w1 = sc[j]; } else if (t > m2) { m2 = t; i2 = j; w2 = sc[j]; } }
            const float gs = m1 + m2;
            const float g0 = readlane_f(gs, 0), g1 = readlane_f(gs, 16), g2 = readlane_f(gs, 32), g3 = readlane_f(gs, 48);
            int bg = 0; float bgs = g0; if (g1 > bgs) { bgs = g1; bg = 1; } if (g2 > bgs) { bgs = g2; bg = 2; } if (g3 > bgs) { bgs = g3; bg = 3; }
            bg = __builtin_amdgcn_readfirstlane(bg);
            const int e0 = 4 * bg + __builtin_amdgcn_readlane(i1, 16 * bg), e1 = 4 * bg + __builtin_amdgcn_readlane(i2, 16 * bg);
            const float w0 = readlane_f(w1, 16 * bg), w1s = readlane_f(w2, 16 * bg);
            const float wn = 1.0f / (w0 + w1s);
            if (lane == 0 && rep == 1 && i0 + r < rpw) { const int rl = wave * rpw + i0 + r;
                const int p0 = __hip_atomic_fetch_add(&lcnt[e0], 1, __ATOMIC_RELAXED, __HIP_MEMORY_SCOPE_WORKGROUP), p1 = __hip_atomic_fetch_add(&lcnt[e1], 1, __ATOMIC_RELAXED, __HIP_MEMORY_SCOPE_WORKGROUP);
                rinfo[rl * 6 + 0] = e0; rinfo[rl * 6 + 1] = p0; rinfo[rl * 6 + 2] = e1; rinfo[rl * 6 + 3] = p1;
                rinfo[rl * 6 + 4] = __builtin_bit_cast(int, w0 * wn); rinfo[rl * 6 + 5] = __builtin_bit_cast(int, w1s * wn); }
        }
    }
    __syncthreads();
    if (tid < 16) lcnt[16 + tid] = (int)__hip_atomic_fetch_add(cnt + 64 * tid, (unsigned)lcnt[tid], RLX_AGENT);
    __syncthreads();
    if (tid < rpb) { const int row = vcu * rpb + tid; const int e0 = rinfo[tid * 6 + 0], e1 = rinfo[tid * 6 + 2];
        const int p0 = lcnt[16 + e0] + rinfo[tid * 6 + 1], p1 = lcnt[16 + e1] + rinfo[tid * 6 + 3];
        list[(size_t)e0 * TALL + p0] = row; list[(size_t)e1 * TALL + p1] = row;
        toki[row * 4 + 0] = e0; toki[row * 4 + 1] = p0; toki[row * 4 + 2] = e1; toki[row * 4 + 3] = p1;
        tokw[row * 2 + 0] = __builtin_bit_cast(float, rinfo[tid * 6 + 4]); tokw[row * 2 + 1] = __builtin_bit_cast(float, rinfo[tid * 6 + 5]); }
    __syncthreads();
}

__device__ __forceinline__ int build_moe_table(const unsigned* cnt, LAS int* tab, int tid) {
    if (tid < 16) tab[RT_MAX + 1 + tid] = (int)__hip_atomic_load(cnt + 64 * tid, RLX_AGENT);
    __syncthreads();
    if (tid == 0) { int rt = 0;
        for (int e = 0; e < 16; ++e) { const int c = tab[RT_MAX + 1 + e]; const int nt = (c + 255) >> 8;
            for (int m = 0; m < nt; ++m) { if (rt < RT_MAX) tab[rt] = e | (m << 8); ++rt; } }
        tab[RT_MAX] = rt < RT_MAX ? rt : RT_MAX; }
    __syncthreads();
    return tab[RT_MAX];
}

__device__ __forceinline__ void phase_combine(float* XL, float* XC, const float* modv  , const bf16* YB, const unsigned* cnt, const int* toki, const float* tokw,
                                              bool final_layer, const float* gnext, const float* modv_next, bf16* H, int nrows, int lane, int wave, int vcu, int G, int probe) {
    int tiles = 0; if (lane < 16) tiles = ((int)__hip_atomic_load(cnt + 64 * lane, RLX_AGENT) + 255) >> 8;
    int incl = tiles;
#pragma unroll
    for (int o = 1; o < 16; o <<= 1) { const int t = __shfl_up(incl, o); if (lane >= o) incl += t; }
    const int mybase = (incl - tiles) * 256;
    for (int rep = (probe ? 0 : 1); rep < 2; ++rep)
    for (int row = vcu * 8 + wave; row < nrows; row += G * 8) {
        const int e0 = toki[row * 4 + 0], p0 = toki[row * 4 + 1], e1 = toki[row * 4 + 2], p1 = toki[row * 4 + 3];
        const float w0 = tokw[row * 2 + 0], w1 = tokw[row * 2 + 1];
        const int s0 = __shfl(mybase, e0) + p0, s1 = __shfl(mybase, e1) + p1;
        float* xp = xrow_ptr(XL, XC, row);
        const float* g2 = modv + row_bi(row) * 6144 + 5120;
        f32x4 v[4];
#pragma unroll
        for (int j = 0; j < 4; ++j) { const int c = 4 * lane + 256 * j;
            const u32x2 a = *(const u32x2*)(YB + (size_t)s0 * D + c), b = *(const u32x2*)(YB + (size_t)s1 * D + c);
            f32x4 y; y.x = w0 * bflo(a.x) + w1 * bflo(b.x); y.y = w0 * bfhi(a.x) + w1 * bfhi(b.x); y.z = w0 * bflo(a.y) + w1 * bflo(b.y); y.w = w0 * bfhi(a.y) + w1 * bfhi(b.y);
            v[j] = *(const f32x4*)(xp + c) + *(const f32x4*)(g2 + c) * y; }
        if (final_layer) {
            float ss = 0.f;
#pragma unroll
            for (int j = 0; j < 4; ++j) ss += (v[j].x * v[j].x + v[j].y * v[j].y) + (v[j].z * v[j].z + v[j].w * v[j].w);
            const float rs = __builtin_amdgcn_rsqf(wave_sum(ss) * (1.0f / D) + EPSF);
#pragma unroll
            for (int j = 0; j < 4; ++j) { const int c = 4 * lane + 256 * j; if (rep == 1) *(f32x4*)(xp + c) = (v[j] * rs) * *(const f32x4*)(gnext + c); }
        } else {
            if (rep == 1) {
#pragma unroll
            for (int j = 0; j < 4; ++j) *(f32x4*)(xp + 4 * lane + 256 * j) = v[j]; }
            const float* mv = modv_next + row_bi(row) * 6144;
            norm_mod_store(v, gnext, mv, mv + 1024, H + (size_t)row * D, lane);
        }
    }
}

__device__ __forceinline__ void phase_readout(const bf16* OF, const bf16* OB, const bf16* QKV2, const float* ng, bf16* AOUT, int nrows, int lane, int wave, int vcu, int G) {
    const f32x4 gg = *(const f32x4*)(ng + 4 * lane);
    for (int row = vcu * 8 + wave; row < nrows; row += G * 8) {
#pragma unroll
        for (int j = 0; j < 4; ++j) { const int c = 4 * lane + 256 * j;
            const u32x2 a = *(const u32x2*)(OF + (size_t)row * D + c), b = *(const u32x2*)(OB + (size_t)row * D + c), gt = *(const u32x2*)(QKV2 + (size_t)row * NGLA + 2048 + c);
            f32x4 o; o.x = bflo(a.x) + bflo(b.x); o.y = bfhi(a.x) + bfhi(b.x); o.z = bflo(a.y) + bflo(b.y); o.w = bfhi(a.y) + bfhi(b.y);
            const float ss = wave_sum((o.x * o.x + o.y * o.y) + (o.z * o.z + o.w * o.w));
            const float rs = __builtin_amdgcn_rsqf(ss * (1.0f / 256.0f) + EPSF);
            f32x4 gv; gv.x = silu_f(bflo(gt.x)); gv.y = silu_f(bfhi(gt.x)); gv.z = silu_f(bflo(gt.y)); gv.w = silu_f(bfhi(gt.y));
            const f32x4 y = (o * rs) * gg * gv;
            u32x2 w; w.x = pk2(y.x, y.y); w.y = pk2(y.z, y.w); *(u32x2*)(AOUT + (size_t)row * D + c) = w; }
    }
}

__device__ __forceinline__ int na_r0(int r) { int v = r - 4; return v < 0 ? 0 : (v > 24 ? 24 : v); }
template <int NMAPS, int DV, bool NA>
__device__ __forceinline__ void attn_unit(LAS unsigned char* lds, int tid, int lane, int wave,
                                          const bf16* QKV, int qcol, int qrow0, int kcol, int krow_lat, int krow_ctx, const bf16* VT, int klo, int khi,
                                          int r_wave, int xq0, const LAS float* biasT,
                                          bf16* AOUT, int ocol, float lam, const float* subg, float outscale) {
    constexpr int KB = 9216;
    constexpr int BUFSZ = NMAPS * KB + DV * 144;
    constexpr int NVB = DV / 16, NVR = DV / 64;
    const int fr = lane & 15, g = lane >> 4;
    bf16x8 qf[NMAPS][2];
    { const bf16* qp = QKV + (size_t)(qrow0 + wave * 16 + fr) * NATT + qcol + 8 * g;
#pragma unroll
      for (int m = 0; m < NMAPS; ++m)
#pragma unroll
          for (int s = 0; s < 2; ++s) qf[m][s] = *(const bf16x8*)(qp + m * 64 + 32 * s); }
    f32x4 O[NMAPS][NVB]; float mrun[NMAPS]; float lrun[NMAPS];
#pragma unroll
    for (int m = 0; m < NMAPS; ++m) { mrun[m] = -1e30f; lrun[m] = 0.f;
#pragma unroll
        for (int vb = 0; vb < NVB; ++vb) O[m][vb] = (f32x4){0.f, 0.f, 0.f, 0.f}; }
    const int ntiles = 4 + (khi - klo);
    u32x4 kreg[NMAPS], vreg[NVR];
    const int lkey = tid >> 3, lch = tid & 7;
#define AT_LOAD(i) do { const int _i = (i); const int _rowg = (_i < 4 ? krow_ctx + 64 * _i : krow_lat + 64 * (klo + _i - 4)) + lkey; const int _tok0 = (_i < 4 ? SEQ + 64 * _i : 64 * (klo + _i - 4)); \
        _Pragma("unroll") for (int m = 0; m < NMAPS; ++m) kreg[m] = *(const u32x4*)(QKV + (size_t)_rowg * NATT + kcol + m * 64 + lch * 8); \
        _Pragma("unroll") for (int j = 0; j < NVR; ++j) { const int idx = tid + 512 * j; vreg[j] = *(const u32x4*)(VT + (size_t)(idx >> 3) * NKEY + _tok0 + (idx & 7) * 8); } } while (0)
#define AT_STORE(b) do { LAS unsigned char* _p = lds + (b) * BUFSZ; \
        _Pragma("unroll") for (int m = 0; m < NMAPS; ++m) *(LAS u32x4*)(_p + m * KB + lkey * 144 + lch * 16) = kreg[m]; \
        _Pragma("unroll") for (int j = 0; j < NVR; ++j) { const int idx = tid + 512 * j; *(LAS u32x4*)(_p + NMAPS * KB + (idx >> 3) * 144 + (idx & 7) * 16) = vreg[j]; } } while (0)
    AT_LOAD(0); AT_STORE(0); __syncthreads();
    const int kbase0 = (8 * (fr >> 2) + (fr & 3)) * 144 + 16 * g;
    const int vbase = fr * 144 + 16 * g;
    int r0w = 0, xq = 0, tmask = 3, c0w = 0; float pen[4][4];
    if constexpr (NA) { r0w = na_r0(r_wave); xq = xq0 + fr; int cs = xq - 8; cs = cs < 0 ? 0 : (cs > 48 ? 48 : cs);
        c0w = xq0 - 8; c0w = c0w < 0 ? 0 : (c0w > 32 ? 32 : c0w);
        tmask = 1;
#pragma unroll
        for (int kb = 0; kb < 4; ++kb)
#pragma unroll
            for (int ii = 0; ii < 4; ++ii) { const int y = c0w + 32 * (kb >> 1) + 8 * g + 4 * (kb & 1) + ii; pen[kb][ii] = (y >= cs && y < cs + 16) ? 0.f : -1e30f; } }
    for (int i = 0; i < ntiles; ++i) {
        if (i + 1 < ntiles) AT_LOAD(i + 1);
        const LAS unsigned char* buf = lds + (i & 1) * BUFSZ;
        bool active = true; int kr = 0; bool local = false;
        if constexpr (NA) { if (i >= 4) { local = true; kr = klo + i - 4; active = (kr >= r0w) && (kr < r0w + 8); } }
        if (active) {
            const int tm = local ? tmask : 3;
            const int koffw = local ? c0w * 144 : 0, voffw = local ? c0w * 2 : 0;
            bf16x8 kf[NMAPS][4][2];
#pragma unroll
            for (int m = 0; m < NMAPS; ++m)
#pragma unroll
                for (int kb = 0; kb < 4; ++kb)
#pragma unroll
                    for (int s = 0; s < 2; ++s) kf[m][kb][s] = *(const LAS bf16x8*)(buf + m * KB + kbase0 + koffw + (kb & 1) * (4 * 144) + (kb >> 1) * (32 * 144) + s * 64);
            __builtin_amdgcn_sched_barrier(0);
            f32x4 S[NMAPS][4];
#pragma unroll
            for (int m = 0; m < NMAPS; ++m)
#pragma unroll
                for (int kb = 0; kb < 4; ++kb) { S[m][kb] = (f32x4){0.f, 0.f, 0.f, 0.f};
                    if (!NA || (tm >> (kb >> 1)) & 1) {
#pragma unroll
                        for (int s = 0; s < 2; ++s) S[m][kb] = __builtin_amdgcn_mfma_f32_16x16x32_bf16(kf[m][kb][s], qf[m][s], S[m][kb], 0, 0, 0); } }
            bf16x8 vf0[4][2];
#pragma unroll
            for (int vb = 0; vb < 4; ++vb)
#pragma unroll
                for (int t = 0; t < 2; ++t) vf0[vb][t] = *(const LAS bf16x8*)(buf + NMAPS * KB + vbase + voffw + vb * (16 * 144) + t * 64);
            __builtin_amdgcn_sched_barrier(0);
            bf16x8 pf[NMAPS][2];
#pragma unroll
            for (int m = 0; m < NMAPS; ++m) {
                if constexpr (NA) { if (local) {
                        const LAS float* bp = biasT + (kr - r_wave + 7) * 31 + (c0w + 8 * g - xq + 15);
#pragma unroll
                        for (int kb = 0; kb < 4; ++kb)
#pragma unroll
                            for (int ii = 0; ii < 4; ++ii) { const float t = (tm >> (kb >> 1)) & 1 ? (S[m][kb][ii] + pen[kb][ii]) + bp[32 * (kb >> 1) + 4 * (kb & 1) + ii] : -1e30f; S[m][kb][ii] = t; } } }
                float mx = fmaxf(fmaxf(S[m][0][0], S[m][0][1]), fmaxf(S[m][0][2], S[m][0][3]));
#pragma unroll
                for (int kb = 1; kb < 4; ++kb) mx = fmaxf(fmaxf(mx, S[m][kb][0]), fmaxf(fmaxf(S[m][kb][1], S[m][kb][2]), S[m][kb][3]));
                mx = swap32_max(swap16_max(mx));
                if (__any(mx > mrun[m] + 8.0f)) {
                    const float mnew = fmaxf(mrun[m], mx), alpha = fexp2(mrun[m] - mnew); mrun[m] = mnew; lrun[m] = lrun[m] * alpha;
#pragma unroll
                    for (int vb = 0; vb < NVB; ++vb) O[m][vb] = O[m][vb] * alpha;
                }
                const float mm = mrun[m];
                unsigned pw[8]; float l0 = 0.f, l1 = 0.f;
#pragma unroll
                for (int kb = 0; kb < 4; ++kb) { const float a0 = fexp2(S[m][kb][0] - mm), a1 = fexp2(S[m][kb][1] - mm), a2 = fexp2(S[m][kb][2] - mm), a3 = fexp2(S[m][kb][3] - mm);
                    l0 += a0 + a1; l1 += a2 + a3;
                    pw[2 * kb] = cvtpk(a0, a1); pw[2 * kb + 1] = cvtpk(a2, a3); }
                lrun[m] += l0 + l1;
                pf[m][0] = __builtin_bit_cast(bf16x8, (u32x4){pw[0], pw[1], pw[2], pw[3]});
                pf[m][1] = __builtin_bit_cast(bf16x8, (u32x4){pw[4], pw[5], pw[6], pw[7]});
            }
            __builtin_amdgcn_sched_barrier(0);
            if constexpr (NVB == 8) {
                bf16x8 vf1[4][2];
#pragma unroll
                for (int vb = 0; vb < 4; ++vb)
#pragma unroll
                    for (int t = 0; t < 2; ++t) vf1[vb][t] = *(const LAS bf16x8*)(buf + NMAPS * KB + vbase + (4 + vb) * (16 * 144) + t * 64);
                __builtin_amdgcn_sched_barrier(0);
#pragma unroll
                for (int vb = 0; vb < 4; ++vb)
#pragma unroll
                    for (int t = 0; t < 2; ++t)
#pragma unroll
                        for (int m = 0; m < NMAPS; ++m) O[m][vb] = __builtin_amdgcn_mfma_f32_16x16x32_bf16(vf0[vb][t], pf[m][t], O[m][vb], 0, 0, 0);
                __builtin_amdgcn_sched_barrier(0);
#pragma unroll
                for (int vb = 0; vb < 4; ++vb)
#pragma unroll
                    for (int t = 0; t < 2; ++t)
#pragma unroll
                        for (int m = 0; m < NMAPS; ++m) O[m][4 + vb] = __builtin_amdgcn_mfma_f32_16x16x32_bf16(vf1[vb][t], pf[m][t], O[m][4 + vb], 0, 0, 0);
            } else {
#pragma unroll
                for (int vb = 0; vb < 4; ++vb)
#pragma unroll
                    for (int t = 0; t < 2; ++t) { if (!NA || (tm >> t) & 1) {
#pragma unroll
                            for (int m = 0; m < NMAPS; ++m) O[m][vb] = __builtin_amdgcn_mfma_f32_16x16x32_bf16(vf0[vb][t], pf[m][t], O[m][vb], 0, 0, 0); } }
            }
            __builtin_amdgcn_sched_barrier(0);
        }
        if (i + 1 < ntiles) AT_STORE((i + 1) & 1);
        __syncthreads();
    }
#undef AT_LOAD
#undef AT_STORE
    float inv[NMAPS];
#pragma unroll
    for (int m = 0; m < NMAPS; ++m) { float l = lrun[m]; l = swap16_add(l, l); l = swap32_add(l, l); inv[m] = 1.0f / l; }
    const int orow = qrow0 + wave * 16 + fr;
    if constexpr (NMAPS == 2) {
        float ss = 0.f; const float i1 = inv[0], i2 = lam * inv[1];
#pragma unroll
        for (int vb = 0; vb < NVB; ++vb) { O[0][vb] = O[0][vb] * i1 - O[1][vb] * i2; const f32x4 o = O[0][vb]; ss += (o.x * o.x + o.y * o.y) + (o.z * o.z + o.w * o.w); }
        ss = swap16_add(ss, ss); ss = swap32_add(ss, ss);
        const float rs = __builtin_amdgcn_rsqf(ss * (1.0f / DV) + EPSF) * outscale;
#pragma unroll
        for (int vb = 0; vb < NVB; ++vb) { const f32x4 gg = *(const f32x4*)(subg + 16 * vb + 4 * g); const f32x4 y = O[0][vb] * rs * gg;
            u32x2 w; w.x = cvtpk(y.x, y.y); w.y = cvtpk(y.z, y.w); *(u32x2*)(AOUT + (size_t)orow * D + ocol + 16 * vb + 4 * g) = w; }
    } else {
#pragma unroll
        for (int vb = 0; vb < NVB; ++vb) { const f32x4 y = O[0][vb] * inv[0];
            u32x2 w; w.x = cvtpk(y.x, y.y); w.y = cvtpk(y.z, y.w); *(u32x2*)(AOUT + (size_t)orow * D + ocol + 16 * vb + 4 * g) = w; }
    }
}


__device__ __forceinline__ void na_unit(LAS unsigned char* lds, int tid, int lane, int wave,
                                        const bf16* QKV, int qcol, int qrow0, int kcol, int krow_lat, int krow_ctx, const bf16* VT, int klo, int khi,
                                        int r_wave, int xq0, const LAS float* biasT, bf16* AOUT, int ocol) {
    constexpr int KB = 9216, TSZ = 2 * KB, GT = 3, SLOT = GT * TSZ;
    const int fr = lane & 15, g = lane >> 4;
    bf16x8 qf[2];
    { const bf16* qp = QKV + (size_t)(qrow0 + wave * 16 + fr) * NATT + qcol + 8 * g; qf[0] = *(const bf16x8*)qp; qf[1] = *(const bf16x8*)(qp + 32); }
    f32x4 O[4]; float mrun = -1e30f, lrun = 0.f;
#pragma unroll
    for (int vb = 0; vb < 4; ++vb) O[vb] = (f32x4){0.f, 0.f, 0.f, 0.f};
    const int ntiles = 4 + (khi - klo), ng = (ntiles + GT - 1) / GT;
    u32x4 kreg[GT], vreg[GT];
#pragma unroll
    for (int t = 0; t < GT; ++t) { kreg[t] = (u32x4){0u, 0u, 0u, 0u}; vreg[t] = kreg[t]; }
    const int lkey = tid >> 3, lch = tid & 7;
#define NA_LOADG(gi_) do { _Pragma("unroll") for (int t = 0; t < GT; ++t) { const int _i = GT * (gi_) + t; if (_i < ntiles) { \
            const int _rowg = (_i < 4 ? krow_ctx + 64 * _i : krow_lat + 64 * (klo + _i - 4)) + lkey; const int _tok0 = (_i < 4 ? SEQ + 64 * _i : 64 * (klo + _i - 4)); \
            kreg[t] = *(const u32x4*)(QKV + (size_t)_rowg * NATT + kcol + lch * 8); vreg[t] = *(const u32x4*)(VT + (size_t)lkey * NKEY + _tok0 + lch * 8); } } } while (0)
#define NA_STOREG(sl_) do { LAS unsigned char* _p = lds + (sl_) * SLOT + lkey * 144 + lch * 16; \
        _Pragma("unroll") for (int t = 0; t < GT; ++t) { *(LAS u32x4*)(_p + t * TSZ) = kreg[t]; *(LAS u32x4*)(_p + t * TSZ + KB) = vreg[t]; } } while (0)
    NA_LOADG(0); NA_STOREG(0); __syncthreads();
    const int kbase0 = (8 * (fr >> 2) + (fr & 3)) * 144 + 16 * g;
    const int vbase = KB + fr * 144 + 16 * g;
    const int r0w = na_r0(r_wave), xq = xq0 + fr;
    int cs = xq - 8; cs = cs < 0 ? 0 : (cs > 48 ? 48 : cs);
    int c0w = xq0 - 8; c0w = c0w < 0 ? 0 : (c0w > 32 ? 32 : c0w);
    float pen[2][4];
#pragma unroll
    for (int kb = 0; kb < 2; ++kb)
#pragma unroll
        for (int ii = 0; ii < 4; ++ii) { const int y = c0w + 8 * g + 4 * kb + ii; pen[kb][ii] = (y >= cs && y < cs + 16) ? 0.f : -1e30f; }
    for (int gi = 0; gi < ng; ++gi) {
        if (gi + 1 < ng) NA_LOADG(gi + 1);
#pragma unroll 1
        for (int t = 0; t < GT; ++t) {
            const int i = GT * gi + t; if (i >= ntiles) break;
            const LAS unsigned char* buf = lds + (gi & 1) * SLOT + t * TSZ;
            const bool local = i >= 4; const int kr = klo + i - 4;
            if (local && !(kr >= r0w && kr < r0w + 8)) continue;
            const int koffw = local ? c0w * 144 : 0, voffw = local ? c0w * 2 : 0;
            f32x4 S[4];
#pragma unroll
            for (int kb = 0; kb < 4; ++kb) { S[kb] = (f32x4){0.f, 0.f, 0.f, 0.f};
                if (kb < 2 || !local) {
#pragma unroll
                    for (int s = 0; s < 2; ++s) { const bf16x8 kf = *(const LAS bf16x8*)(buf + kbase0 + koffw + (kb & 1) * (4 * 144) + (kb >> 1) * (32 * 144) + s * 64);
                        S[kb] = __builtin_amdgcn_mfma_f32_16x16x32_bf16(kf, qf[s], S[kb], 0, 0, 0); } } }
            if (local) {
                const LAS float* bp = biasT + (kr - r_wave + 7) * 31 + (c0w + 8 * g - xq + 15);
#pragma unroll
                for (int kb = 0; kb < 2; ++kb)
#pragma unroll
                    for (int ii = 0; ii < 4; ++ii) S[kb][ii] = (S[kb][ii] + pen[kb][ii]) + bp[4 * kb + ii];
#pragma unroll
                for (int ii = 0; ii < 4; ++ii) { S[2][ii] = -1e30f; S[3][ii] = -1e30f; }
            }
            float mx = fmaxf(fmaxf(S[0][0], S[0][1]), fmaxf(S[0][2], S[0][3]));
#pragma unroll
            for (int kb = 1; kb < 4; ++kb) mx = fmaxf(fmaxf(mx, S[kb][0]), fmaxf(fmaxf(S[kb][1], S[kb][2]), S[kb][3]));
            mx = swap32_max(swap16_max(mx));
            if (__any(mx > mrun + 8.0f)) {
                const float mnew = fmaxf(mrun, mx), alpha = fexp2(mrun - mnew); mrun = mnew; lrun *= alpha;
#pragma unroll
                for (int vb = 0; vb < 4; ++vb) O[vb] = O[vb] * alpha;
            }
            unsigned pw[8]; float l0 = 0.f, l1 = 0.f;
#pragma unroll
            for (int kb = 0; kb < 4; ++kb) { const float a0 = fexp2(S[kb][0] - mrun), a1 = fexp2(S[kb][1] - mrun), a2 = fexp2(S[kb][2] - mrun), a3 = fexp2(S[kb][3] - mrun);
                l0 += a0 + a1; l1 += a2 + a3; pw[2 * kb] = cvtpk(a0, a1); pw[2 * kb + 1] = cvtpk(a2, a3); }
            lrun += l0 + l1;
            const bf16x8 pf0 = __builtin_bit_cast(bf16x8, (u32x4){pw[0], pw[1], pw[2], pw[3]}), pf1 = __builtin_bit_cast(bf16x8, (u32x4){pw[4], pw[5], pw[6], pw[7]});
#pragma unroll
            for (int vb = 0; vb < 4; ++vb) { const LAS unsigned char* vp = buf + vbase + voffw + vb * (16 * 144);
                O[vb] = __builtin_amdgcn_mfma_f32_16x16x32_bf16(*(const LAS bf16x8*)vp, pf0, O[vb], 0, 0, 0);
                if (!local) O[vb] = __builtin_amdgcn_mfma_f32_16x16x32_bf16(*(const LAS bf16x8*)(vp + 64), pf1, O[vb], 0, 0, 0); }
        }
        if (gi + 1 < ng) NA_STOREG((gi + 1) & 1);
        __syncthreads();
    }
#undef NA_LOADG
#undef NA_STOREG
    float l = lrun; l = swap16_add(l, l); l = swap32_add(l, l); const float inv = 1.0f / l;
    const int orow = qrow0 + wave * 16 + fr;
#pragma unroll
    for (int vb = 0; vb < 4; ++vb) { const f32x4 y = O[vb] * inv;
        u32x2 w; w.x = cvtpk(y.x, y.y); w.y = cvtpk(y.z, y.w); *(u32x2*)(AOUT + (size_t)orow * D + ocol + 16 * vb + 4 * g) = w; }
}

typedef float f32x16 __attribute__((ext_vector_type(16)));
__device__ __forceinline__ void diff_unit32(LAS unsigned char* lds, int tid, int lane, int wave,
                                            const bf16* QKV, int qcol, int qrow0, int kcol, int krow_lat, int krow_ctx, const bf16* VT, int khi,
                                            bf16* AOUT, int ocol, float lam, const float* subg, float outscale) {
    constexpr int KB = 9216, VOFF = 2 * KB, BUFSZ = 2 * KB + 128 * 144;
    const int r = lane & 31, hf = lane >> 5, map = wave >> 2, wq = wave & 3;
    const int swz = ((r >> 4) & 1) << 2;
    bf16x8 qf[4];
    { const bf16* qp = QKV + (size_t)(qrow0 + 32 * wq + r) * NATT + qcol + map * 64 + 8 * hf;
#pragma unroll
      for (int ks = 0; ks < 4; ++ks) qf[ks] = *(const bf16x8*)(qp + 16 * ks); }
    f32x16 O[4];
#pragma unroll
    for (int blk = 0; blk < 4; ++blk)
#pragma unroll
        for (int i = 0; i < 16; ++i) O[blk][i] = 0.f;
    float negm = 0.f, lrun = 0.f;
    const int ntiles = 4 + khi;
    u32x4 kreg[2], vreg[2];
    const int lkey = tid >> 3, lch = tid & 7;
    const int kst = lkey * 144 + ((lch ^ (((lkey >> 4) & 1) << 2)) * 16);
#define D32_LOAD(i) do { const int _i = (i); const int _rowg = (_i < 4 ? krow_ctx + 64 * _i : krow_lat + 64 * (_i - 4)) + lkey; const int _tok0 = (_i < 4 ? SEQ + 64 * _i : 64 * (_i - 4)); \
        _Pragma("unroll") for (int m = 0; m < 2; ++m) kreg[m] = *(const u32x4*)(QKV + (size_t)_rowg * NATT + kcol + m * 64 + lch * 8); \
        _Pragma("unroll") for (int j = 0; j < 2; ++j) { const int idx = tid + 512 * j; vreg[j] = *(const u32x4*)(VT + (size_t)(idx >> 3) * NKEY + _tok0 + (idx & 7) * 8); } } while (0)
#define D32_STORE(b) do { LAS unsigned char* _p = lds + (b) * BUFSZ; \
        _Pragma("unroll") for (int m = 0; m < 2; ++m) *(LAS u32x4*)(_p + m * KB + kst) = kreg[m]; \
        _Pragma("unroll") for (int j = 0; j < 2; ++j) { const int idx = tid + 512 * j, vr = idx >> 3; *(LAS u32x4*)(_p + VOFF + vr * 144 + (((idx & 7) ^ (((vr >> 4) & 1) << 2)) * 16)) = vreg[j]; } } while (0)
    D32_LOAD(0); D32_STORE(0); D32_STORE(2); __syncthreads();
    const int krow = (r & 0x13) | ((r & 4) << 1) | ((r & 8) >> 1);
    const int kbase = map * KB + krow * 144, vbase = VOFF + r * 144;
    bf16x8 pfp[2][2];
#pragma unroll
    for (int kb = 0; kb < 2; ++kb)
#pragma unroll
        for (int sx = 0; sx < 2; ++sx) pfp[kb][sx] = (bf16x8){0, 0, 0, 0, 0, 0, 0, 0};
    int slot = 0;
    for (int i = 0; i < ntiles; ++i) {
        if (i + 1 < ntiles) D32_LOAD(i + 1);
        const int slotn = slot == 2 ? 0 : slot + 1, slotp = slot == 0 ? 2 : slot - 1;
        const LAS unsigned char* buf = lds + slot * BUFSZ; const LAS unsigned char* bufp = lds + slotp * BUFSZ;
        f32x16 S[2];
#pragma unroll
        for (int kb = 0; kb < 2; ++kb) {
#pragma unroll
            for (int ii = 0; ii < 16; ++ii) S[kb][ii] = negm;
#pragma unroll
            for (int ks = 0; ks < 4; ++ks) { const bf16x8 kf = *(const LAS bf16x8*)(buf + kbase + kb * (32 * 144) + (((2 * ks + hf) ^ swz) * 16));
                S[kb] = __builtin_amdgcn_mfma_f32_32x32x16_bf16(kf, qf[ks], S[kb], 0, 0, 0); } }
        __builtin_amdgcn_sched_barrier(0);
        float mx = -1e30f;
#pragma unroll
        for (int kb = 0; kb < 2; ++kb)
#pragma unroll
            for (int ii = 0; ii < 16; ii += 4) mx = fmaxf(fmaxf(mx, S[kb][ii]), fmaxf(fmaxf(S[kb][ii + 1], S[kb][ii + 2]), S[kb][ii + 3]));
        mx = swap32_max(mx);
        const bool resc = (i == 0) || __any(mx > 8.0f);
        float alpha = 1.0f;
        if (resc) { const float dlt = (i == 0) ? mx : fmaxf(mx, 0.f); alpha = fexp2(-dlt); negm -= dlt; lrun *= alpha;
#pragma unroll
            for (int kb = 0; kb < 2; ++kb)
#pragma unroll
                for (int ii = 0; ii < 16; ++ii) S[kb][ii] -= dlt; }
        __builtin_amdgcn_sched_barrier(0);
        bf16x8 pf[2][2]; float l0 = 0.f, l1 = 0.f;
#pragma unroll
        for (int kb = 0; kb < 2; ++kb)
#pragma unroll
            for (int sx = 0; sx < 2; ++sx) { unsigned pw[4];
#pragma unroll
                for (int j = 0; j < 4; ++j) { const float a0 = fexp2(S[kb][8 * sx + 2 * j]), a1 = fexp2(S[kb][8 * sx + 2 * j + 1]); l0 += a0; l1 += a1; pw[j] = cvtpk(a0, a1); }
                pf[kb][sx] = __builtin_bit_cast(bf16x8, (u32x4){pw[0], pw[1], pw[2], pw[3]}); }
        lrun += l0 + l1;
#pragma unroll
        for (int blk = 0; blk < 4; ++blk)
#pragma unroll
            for (int kb = 0; kb < 2; ++kb)
#pragma unroll
                for (int sx = 0; sx < 2; ++sx) { const bf16x8 vf = *(const LAS bf16x8*)(bufp + vbase + blk * (32 * 144) + (((4 * kb + 2 * sx + hf) ^ swz) * 16));
                    O[blk] = __builtin_amdgcn_mfma_f32_32x32x16_bf16(vf, pfp[kb][sx], O[blk], 0, 0, 0); }
#pragma unroll
        for (int k = 0; k < 16; ++k) { __builtin_amdgcn_sched_group_barrier(0x100, 1, 0); __builtin_amdgcn_sched_group_barrier(0x008, 1, 0); __builtin_amdgcn_sched_group_barrier(0x400, 2, 0); __builtin_amdgcn_sched_group_barrier(0x002, 4, 0); }
        __builtin_amdgcn_sched_barrier(0);
        if (resc) {
#pragma unroll
            for (int blk = 0; blk < 4; ++blk) O[blk] = O[blk] * alpha; }
#pragma unroll
        for (int kb = 0; kb < 2; ++kb)
#pragma unroll
            for (int sx = 0; sx < 2; ++sx) pfp[kb][sx] = pf[kb][sx];
        if (i + 1 < ntiles) D32_STORE(slotn);
        slot = slotn;
        __syncthreads();
    }
    { const LAS unsigned char* bufp = lds + (slot == 0 ? 2 : slot - 1) * BUFSZ;
#pragma unroll
      for (int blk = 0; blk < 4; ++blk)
#pragma unroll
          for (int kb = 0; kb < 2; ++kb)
#pragma unroll
              for (int sx = 0; sx < 2; ++sx) { const bf16x8 vf = *(const LAS bf16x8*)(bufp + vbase + blk * (32 * 144) + (((4 * kb + 2 * sx + hf) ^ swz) * 16));
                  O[blk] = __builtin_amdgcn_mfma_f32_32x32x16_bf16(vf, pfp[kb][sx], O[blk], 0, 0, 0); } }
    __syncthreads();
#undef D32_LOAD
#undef D32_STORE
    float l = lrun; l = swap32_add(l, l); const float inv = 1.0f / l;
    LAS float* X = (LAS float*)lds + (size_t)wq * 4096 + lane;
    if (map == 1) {
#pragma unroll
        for (int blk = 0; blk < 4; ++blk)
#pragma unroll
            for (int i = 0; i < 16; ++i) X[(blk * 16 + i) * 64] = O[blk][i] * inv;
    }
    __syncthreads();
    if (map == 0) {
        float ss = 0.f;
#pragma unroll
        for (int blk = 0; blk < 4; ++blk)
#pragma unroll
            for (int i = 0; i < 16; ++i) { const float o = O[blk][i] * inv - lam * X[(blk * 16 + i) * 64]; O[blk][i] = o; ss += o * o; }
        ss = swap32_add(ss, ss);
        const float rs = __builtin_amdgcn_rsqf(ss * (1.0f / 128.0f) + EPSF) * outscale;
        bf16* op = AOUT + (size_t)(qrow0 + 32 * wq + r) * D + ocol + 4 * hf;
#pragma unroll
        for (int blk = 0; blk < 4; ++blk)
#pragma unroll
            for (int g4 = 0; g4 < 4; ++g4) { const int dv0 = 32 * blk + 8 * g4; const f32x4 gg = *(const f32x4*)(subg + dv0 + 4 * hf);
                u32x2 w; w.x = cvtpk(O[blk][4 * g4] * rs * gg.x, O[blk][4 * g4 + 1] * rs * gg.y); w.y = cvtpk(O[blk][4 * g4 + 2] * rs * gg.z, O[blk][4 * g4 + 3] * rs * gg.w);
                *(u32x2*)(op + dv0) = w; }
    }
    __syncthreads();
}

__device__ __forceinline__ void phase_attention(const bf16* QKV, const bf16* VAT, const bf16* VBT, bf16* AOUT, const float* lamp  , float lam_init, const float* subg, const float* nab  ,
                                                unsigned* naq, const ConvPtrs& CP, int clo, int chi, LAS unsigned char* lds, int tid, int lane, int wave) {
    LAS float* biasT = (LAS float*)(lds + LX_BIAS) + 64;
    constexpr int NATT_U = 576 + 1152;
    const int ncu = (chi - clo + CV_UNIT - 1) / CV_UNIT, nq = NATT_U + ncu;
    int mine = 0; if (tid == 0) mine = (int)__hip_atomic_fetch_add(naq, 1u, RLX_AGENT);
    for (;;) {
        __syncthreads();
        if (tid == 0) *(LAS int*)(lds + LX_MISC + 64) = mine;
        __syncthreads();
        const int q = *(LAS int*)(lds + LX_MISC + 64);
        if (q >= nq) break;
        if (tid == 0) mine = (int)__hip_atomic_fetch_add(naq, 1u, RLX_AGENT);
        const int ai = (int)(((long)q * NATT_U) / nq); const bool isatt = (int)(((long)(q + 1) * NATT_U) / nq) > ai;
        if (!isatt) { conv_unit(CP, clo + (q - ai) * CV_UNIT, chi, lds, lane, wave); continue; }
        if (ai < 512 || (ai >= 1536 && ai < 1600)) {
            int bh, qrow0, khi;
            if (ai < 512) { bh = ai >> 4; const int qt = ai & 15; qrow0 = (bh >> 2) * SEQ + qt * 128; khi = 32; }
            else { const int u = ai - 1536; bh = u >> 1; const int qt = u & 1; qrow0 = TX + (bh >> 2) * CTXL + qt * 128; khi = 0; }
            const int b = bh >> 2, h = bh & 3;
            const float lam = __expf(wave_sum(lamp[lane] * lamp[64 + lane])) - __expf(wave_sum(lamp[128 + lane] * lamp[192 + lane])) + lam_init;
            diff_unit32(lds, tid, lane, wave, QKV, h * 128, qrow0, 512 + h * 128, b * SEQ, TX + b * CTXL, VAT + (size_t)bh * 128 * NKEY, khi,
                        AOUT, h * 128, lam, subg, 1.0f - lam_init);
        } else {
            int bh, qrow0, klo, khi, rw;
            if (ai < 1536) { const int u = ai - 512; bh = u >> 4; const int rp = u & 15; qrow0 = (bh >> 3) * SEQ + rp * 128; klo = na_r0(2 * rp); khi = na_r0(2 * rp + 1) + 8; rw = 2 * rp + (wave >> 2); }
            else { const int u = ai - 1600; bh = u >> 1; const int qt = u & 1; qrow0 = TX + (bh >> 3) * CTXL + qt * 128; klo = 0; khi = 0; rw = 0; }
            const int b = bh >> 3, h = bh & 7;
            for (int i = tid; i < 640; i += 512) { const int k = i - 64; biasT[k] = (k >= 0 && k < 465) ? nab[h * 465 + k] * LOG2E : 0.f; }
            na_unit(lds, tid, lane, wave, QKV, 1536 + h * 64, qrow0, 2048 + h * 64, b * SEQ, TX + b * CTXL, VBT + (size_t)bh * 64 * NKEY, klo, khi,
                    rw, 16 * (wave & 3), biasT, AOUT, 512 + h * 64);
        }
    }
}

__device__ __forceinline__ void gla_chunk_rows(int b, int dir, int n, int& row0, int& tok0) {
    if (n < 4) { const int cc = dir ? 3 - n : n; row0 = TX + b * CTXL + 64 * cc; tok0 = SEQ + 64 * cc; } else { const int lc = dir ? 35 - n : n - 4; row0 = b * SEQ + 64 * lc; tok0 = 64 * lc; }
}
constexpr int GP_QM = 0, GP_KM = 17408, GP_VT = 34816, GP_LR = 71680, GP_SEG = 75776;
__device__ __forceinline__ void phase_gla_prep(const bf16* QKV2, const bf16* VGT, const float* wgate  , const float* bgate  ,
                                               bf16* QG, bf16* KET, float* FACD, bf16* OF, bf16* OB,
                                               LAS unsigned char* lds, int tid, int lane, int wave, int vcu, int G) {
    const int fr = lane & 15, g = lane >> 4;
    const int d = tid & 127, seg = tid >> 7;
    LAS float* LR = (LAS float*)(lds + GP_LR);
    LAS float* SEG = (LAS float*)(lds + GP_SEG);
    for (int ub = vcu * 9; ub < 2304; ub += G * 9) {
        const int q = ub / 36, n0 = ub % 36, dir = q & 1, hh = (q >> 1) & 3, b = q >> 3;
        bf16* OUT = dir ? OB : OF;
        float wg[16];
#pragma unroll
        for (int r = 0; r < 16; ++r) wg[r] = wgate[(dir * 16 + r) * 512 + hh * 128 + d];
        const float bgv = bgate[dir * 512 + hh * 128 + d];
        const bf16* vtb = VGT + (size_t)(b * 4 + hh) * 256 * NKEY;
        u32x4 qr[2], kr[2], vr[4], lr4;
#define GP_LOAD(n) do { int _row0, _tok0; gla_chunk_rows(b, dir, (n), _row0, _tok0); \
        _Pragma("unroll") for (int j = 0; j < 2; ++j) { const int idx = tid + 512 * j, p = idx >> 4, ch = idx & 15; const bf16* src = QKV2 + (size_t)(_row0 + p) * NGLA + hh * 128 + ch * 8; qr[j] = *(const u32x4*)src; kr[j] = *(const u32x4*)(src + 512); } \
        _Pragma("unroll") for (int j = 0; j < 4; ++j) { const int idx = tid + 512 * j; vr[j] = *(const u32x4*)(vtb + (size_t)(idx >> 3) * NKEY + _tok0 + (idx & 7) * 8); } \
        if (tid < 128) lr4 = *(const u32x4*)(QKV2 + (size_t)(_row0 + (tid >> 1)) * NGLA + 3072 + dir * 16 + (tid & 1) * 8); } while (0)
#define GP_N(i) (dir ? ((i) < 4 ? 3 - (i) : 39 - (i)) : (i))
        GP_LOAD(GP_N(n0));
        for (int k9 = 0; k9 < 9; ++k9) {
            const int n = GP_N(n0 + k9), u = ub - n0 + n; int row0, tok0; gla_chunk_rows(b, dir, n, row0, tok0);
#pragma unroll
            for (int j = 0; j < 2; ++j) { const int idx = tid + 512 * j, p = idx >> 4, ch = idx & 15;
                *(LAS u32x4*)(lds + GP_QM + p * 272 + ch * 16) = qr[j]; *(LAS u32x4*)(lds + GP_KM + p * 272 + ch * 16) = kr[j]; }
#pragma unroll
            for (int j = 0; j < 4; ++j) { const int idx = tid + 512 * j; *(LAS u32x4*)(lds + GP_VT + (idx >> 3) * 144 + (idx & 7) * 16) = vr[j]; }
            if (tid < 128) { LAS float* lp = LR + (tid >> 1) * 16 + (tid & 1) * 8;
                lp[0] = bflo(lr4.x); lp[1] = bfhi(lr4.x); lp[2] = bflo(lr4.y); lp[3] = bfhi(lr4.y); lp[4] = bflo(lr4.z); lp[5] = bfhi(lr4.z); lp[6] = bflo(lr4.w); lp[7] = bfhi(lr4.w); }
            __syncthreads();
            if (k9 + 1 < 9) GP_LOAD(GP_N(n0 + k9 + 1));
            float gc[16];
#pragma unroll
            for (int pi = 0; pi < 16; ++pi) { const LAS f32x4* lp = (const LAS f32x4*)(LR + (16 * seg + pi) * 16); float z = bgv;
#pragma unroll
                for (int k = 0; k < 4; ++k) { const f32x4 l4 = lp[k]; z += l4.x * wg[4 * k] + l4.y * wg[4 * k + 1] + l4.z * wg[4 * k + 2] + l4.w * wg[4 * k + 3]; }
                const float az = fabsf(z); gc[pi] = (fminf(z, 0.f) - flog(1.0f + fexp(-az))) * 0.0625f; }
            float run = 0.f;
            if (dir == 0) {
#pragma unroll
                for (int pi = 0; pi < 16; ++pi) { run += gc[pi]; gc[pi] = run; }
            } else {
#pragma unroll
                for (int pi = 15; pi >= 0; --pi) { run += gc[pi]; gc[pi] = run; }
            }
            SEG[seg * 128 + d] = run;
            __syncthreads();
            const float t0 = SEG[d], t1 = SEG[128 + d], t2 = SEG[256 + d], t3 = SEG[384 + d];
            float off, gmid; const float gend = (t0 + t1) + (t2 + t3);
            if (dir == 0) { off = (seg > 0 ? t0 : 0.f) + (seg > 1 ? t1 : 0.f) + (seg > 2 ? t2 : 0.f); gmid = t0 + t1; }
            else { off = (seg < 3 ? t3 : 0.f) + (seg < 2 ? t2 : 0.f) + (seg < 1 ? t1 : 0.f); gmid = t3 + t2; }
            const float emid = fexp(gmid), eend = fexp(gend - gmid);
            unsigned kep[8];
            bf16* qgp = QG + ((size_t)u * 64 + 16 * seg) * 128 + d;
#pragma unroll
            for (int pi = 0; pi < 16; ++pi) { const int p = 16 * seg + pi; const float rel = off + gc[pi] - gmid; const float Ep = fexp(rel), Ei = fexp(-rel);
                LAS bf16* qa = (LAS bf16*)(lds + GP_QM) + p * 136 + d; LAS bf16* ka = (LAS bf16*)(lds + GP_KM) + p * 136 + d;
                const float qv = bf2f(*qa), kv = bf2f(*ka);
                const float qm = qv * Ep, km = kv * Ei;
                const unsigned w1 = cvtpk(qm, qm * emid), w2 = cvtpk(km, km * eend);
                *qa = (bf16)(w1 & 0xffffu); qgp[pi * 128] = (bf16)(w1 >> 16); *ka = (bf16)(w2 & 0xffffu);
                if (pi & 1) kep[pi >> 1] |= (w2 & 0xffff0000u); else kep[pi >> 1] = w2 >> 16; }
            { u32x4* kt = (u32x4*)(KET + ((size_t)u * 128 + d) * 64 + 16 * seg); kt[0] = (u32x4){kep[0], kep[1], kep[2], kep[3]}; kt[1] = (u32x4){kep[4], kep[5], kep[6], kep[7]}; }
            if (seg == 0) FACD[(size_t)u * 128 + d] = fexp(gend);
            __syncthreads();
            { const int cb = wave & 3, half = wave >> 2;
              bf16x8 qfr[4];
#pragma unroll
              for (int ks = 0; ks < 4; ++ks) qfr[ks] = *(const LAS bf16x8*)(lds + GP_QM + (16 * cb + fr) * 272 + (8 * g + 32 * ks) * 2);
              f32x4 AT[4];
#pragma unroll
              for (int sb = 0; sb < 4; ++sb) { AT[sb] = (f32x4){0.f, 0.f, 0.f, 0.f};
#pragma unroll
                  for (int ks = 0; ks < 4; ++ks) { const bf16x8 af = *(const LAS bf16x8*)(lds + GP_KM + (16 * sb + fr) * 272 + (8 * g + 32 * ks) * 2);
                      AT[sb] = __builtin_amdgcn_mfma_f32_16x16x32_bf16(af, qfr[ks], AT[sb], 0, 0, 0); }
                  const int c = 16 * cb + fr;
#pragma unroll
                  for (int ii = 0; ii < 4; ++ii) { const int sp = 16 * sb + 4 * g + ii; const bool keep = dir ? (sp >= c) : (sp <= c); AT[sb][ii] = keep ? AT[sb][ii] : 0.f; } }
              bf16x8 pf[2];
#pragma unroll
              for (int t = 0; t < 2; ++t) { u32x4 w; w.x = pk2(AT[2 * t][0], AT[2 * t][1]); w.y = pk2(AT[2 * t][2], AT[2 * t][3]); w.z = pk2(AT[2 * t + 1][0], AT[2 * t + 1][1]); w.w = pk2(AT[2 * t + 1][2], AT[2 * t + 1][3]);
                  pf[t] = __builtin_bit_cast(bf16x8, w); }
#pragma unroll
              for (int v8 = 0; v8 < 8; ++v8) { const int vb = 8 * half + v8; f32x4 Oa = (f32x4){0.f, 0.f, 0.f, 0.f};
#pragma unroll
                  for (int t = 0; t < 2; ++t) { const LAS unsigned char* vp = lds + GP_VT + (16 * vb + fr) * 144 + (32 * t + 4 * g) * 2;
                      const u32x2 lo = *(const LAS u32x2*)vp, hi = *(const LAS u32x2*)(vp + 32);
                      u32x4 w; w.x = lo.x; w.y = lo.y; w.z = hi.x; w.w = hi.y;
                      Oa = __builtin_amdgcn_mfma_f32_16x16x32_bf16(__builtin_bit_cast(bf16x8, w), pf[t], Oa, 0, 0, 0); }
                  u32x2 w; w.x = pk2(Oa[0], Oa[1]); w.y = pk2(Oa[2], Oa[3]);
                  *(u32x2*)(OUT + (size_t)(row0 + 16 * cb + fr) * D + hh * 256 + 16 * vb + 4 * g) = w; }
            }
            __syncthreads();
        }
#undef GP_LOAD
#undef GP_N
    }
}

constexpr int GS_BUF = 45056, GS_QG = 0, GS_KET = 17408, GS_VT = 35840, GS_ST = 2 * GS_BUF, GS_DEC = GS_ST + 2 * 17408;
__device__ __forceinline__ void phase_gla(const bf16* VGT, bf16* OF, bf16* OB, const bf16* QG, const bf16* KET, const float* FACD,
                                          LAS unsigned char* lds, int tid, int lane, int wave, int vcu, int G) {
    const int fr = lane & 15, g = lane >> 4;
    for (int u = vcu; u < 256; u += G) {
        const int slab = u & 3, dir = (u >> 2) & 1, hh = (u >> 3) & 3, b = u >> 5;
        bf16* OUT = dir ? OB : OF;
        const int upb = ((b * 4 + hh) * 2 + dir) * 36;
        f32x4 Sacc[4];
#pragma unroll
        for (int vb = 0; vb < 4; ++vb) Sacc[vb] = (f32x4){0.f, 0.f, 0.f, 0.f};
        for (int i = tid; i < 17408 / 4; i += 512) ((LAS unsigned*)(lds + GS_ST))[i] = 0u;
        const bf16* vtb = VGT + ((size_t)(b * 4 + hh) * 256 + slab * 64) * NKEY;
        const int cb = wave & 3, vh = wave >> 2;
        const int ocol = hh * 256 + slab * 64 + 32 * vh + 4 * g;
        struct GsRegs { u32x4 qg[2], ket[2], v; u32x2 oi[2]; float dec; };
        GsRegs R0, R1; R0.dec = 0.f; R1.dec = 0.f;
#define GS_LOAD(R, n) do { int _row0, _tok0; gla_chunk_rows(b, dir, (n), _row0, _tok0); const size_t _u = (size_t)(upb + (n)); \
        _Pragma("unroll") for (int j = 0; j < 2; ++j) { const int idx = tid + 512 * j; R.qg[j] = *(const u32x4*)(QG + _u * 8192 + idx * 8); R.ket[j] = *(const u32x4*)(KET + _u * 8192 + idx * 8); } \
        R.v = *(const u32x4*)(vtb + (size_t)(tid >> 3) * NKEY + _tok0 + (tid & 7) * 8); \
        if (tid < 128) R.dec = FACD[_u * 128 + tid]; \
        _Pragma("unroll") for (int v2 = 0; v2 < 2; ++v2) R.oi[v2] = *(const u32x2*)(OUT + (size_t)(_row0 + 16 * cb + fr) * D + ocol + 16 * v2); } while (0)
#define GS_STORE(R, bf) do { LAS unsigned char* _p = lds + (bf) * GS_BUF; \
        _Pragma("unroll") for (int j = 0; j < 2; ++j) { const int idx = tid + 512 * j; *(LAS u32x4*)(_p + GS_QG + (idx >> 4) * 272 + (idx & 15) * 16) = R.qg[j]; *(LAS u32x4*)(_p + GS_KET + (idx >> 3) * 144 + (idx & 7) * 16) = R.ket[j]; } \
        *(LAS u32x4*)(_p + GS_VT + (tid >> 3) * 144 + (tid & 7) * 16) = R.v; \
        if (tid < 128) ((LAS float*)(lds + GS_DEC))[(bf) * 128 + tid] = R.dec; } while (0)
#define GS_ITER(n, RN, RF) do { const int _n = (n); int row0, tok0; gla_chunk_rows(b, dir, _n, row0, tok0); const int cur = _n & 1; \
            if (_n + 2 < 36) GS_LOAD(RF, _n + 2); \
            const LAS unsigned char* bufp = lds + cur * GS_BUF; const LAS unsigned char* stp = lds + GS_ST + cur * 17408; \
            { bf16x8 qfr[4]; \
              _Pragma("unroll") for (int ks = 0; ks < 4; ++ks) qfr[ks] = *(const LAS bf16x8*)(bufp + GS_QG + (16 * cb + fr) * 272 + (8 * g + 32 * ks) * 2); \
              _Pragma("unroll") for (int v2 = 0; v2 < 2; ++v2) { const int vb = 2 * vh + v2; const u32x2 oin = v2 ? oc1 : oc0; \
                  f32x4 Oa = (f32x4){bflo(oin.x), bfhi(oin.x), bflo(oin.y), bfhi(oin.y)}; \
                  _Pragma("unroll") for (int ks = 0; ks < 4; ++ks) { const bf16x8 af = *(const LAS bf16x8*)(stp + (16 * vb + fr) * 272 + (8 * g + 32 * ks) * 2); \
                      Oa = __builtin_amdgcn_mfma_f32_16x16x32_bf16(af, qfr[ks], Oa, 0, 0, 0); } \
                  u32x2 w; w.x = pk2(Oa[0], Oa[1]); w.y = pk2(Oa[2], Oa[3]); \
                  *(u32x2*)(OUT + (size_t)(row0 + 16 * cb + fr) * D + ocol + 16 * v2) = w; } } \
            { const f32x4 dec = *(const LAS f32x4*)((LAS float*)(lds + GS_DEC) + cur * 128 + 16 * wave + 4 * g); \
              LAS unsigned char* stn = lds + GS_ST + (cur ^ 1) * 17408; \
              _Pragma("unroll") for (int vb = 0; vb < 4; ++vb) { Sacc[vb] = Sacc[vb] * dec; \
                  _Pragma("unroll") for (int t = 0; t < 2; ++t) { const bf16x8 af = *(const LAS bf16x8*)(bufp + GS_KET + (16 * wave + fr) * 144 + (8 * g + 32 * t) * 2); \
                      const bf16x8 bfr = *(const LAS bf16x8*)(bufp + GS_VT + (16 * vb + fr) * 144 + (8 * g + 32 * t) * 2); \
                      Sacc[vb] = __builtin_amdgcn_mfma_f32_16x16x32_bf16(af, bfr, Sacc[vb], 0, 0, 0); } \
                  u32x2 w; w.x = pk2(Sacc[vb][0], Sacc[vb][1]); w.y = pk2(Sacc[vb][2], Sacc[vb][3]); \
                  *(LAS u32x2*)(stn + (16 * vb + fr) * 272 + (16 * wave + 4 * g) * 2) = w; } } \
            if (_n + 1 < 36) { GS_STORE(RN, cur ^ 1); oc0 = RN.oi[0]; oc1 = RN.oi[1]; } \
            __syncthreads(); } while (0)
        GS_LOAD(R0, 0); GS_STORE(R0, 0);
        u32x2 oc0 = R0.oi[0], oc1 = R0.oi[1];
        GS_LOAD(R0, 1);
        __syncthreads();
        for (int n = 0; n < 36; n += 2) { GS_ITER(n, R0, R1); GS_ITER(n + 1, R1, R0); }
#undef GS_ITER
#undef GS_LOAD
#undef GS_STORE
    }
}

constexpr int N_PHASES = 34;
typedef const Args __attribute__((address_space(4)))* KArgs;
__device__ __forceinline__ KArgs kargs() { KArgs p = (KArgs)__builtin_amdgcn_kernarg_segment_ptr(); asm volatile("" : "+s"(p)); return p; }
__global__ void __launch_bounds__(512, 2) fwd(Args a_unused) {
    extern __shared__ __attribute__((aligned(16))) unsigned char lds_raw[];
    LAS unsigned char* lds = (LAS unsigned char*)lds_raw;
    const int tid0 = threadIdx.x;
    const int G0 = gridDim.x; const int bx0 = blockIdx.x;
#define PH_ENTRY int tid = tid0; asm volatile("" : "+v"(tid)); int G = G0, bx = bx0; asm volatile("" : "+s"(G), "+s"(bx)); const int lane = tid & 63, wave = __builtin_amdgcn_readfirstlane(tid >> 6); \
        const int vcu = (G % 8 == 0) ? (bx % 8) * (G / 8) + bx / 8 : bx; (void)lane; (void)wave; (void)vcu
    const int tid = tid0;
    const int ph_lo = kargs()->ph_lo, ph_hi = kargs()->ph_hi;
    const int repmask = kargs()->rep;
    if (tid < 64) ((LAS unsigned*)(lds + LX_MISC))[tid] = 0u;
    for (int i = tid; i < 1024; i += 512) { const int pos = i >> 4, f = i & 15; const float inv = __builtin_amdgcn_exp2f(-(float)f * (13.287712379549449f / 16.0f)); const float ang = (float)pos * inv;
        ((LAS float*)(lds + LX_ROPE))[2 * i] = __cosf(ang); ((LAS float*)(lds + LX_ROPE))[2 * i + 1] = __sinf(ang); }
    __syncthreads();
    const bool single = (ph_hi - ph_lo) > 1;
    XcdBarrier bar; bar.bar = (unsigned*)(kargs()->ws + WS_CTL) + CW_BAR; bar.x = 0; bar.st = (volatile LAS unsigned*)(lds + LX_MISC);
    if (single) bar = xcd_barrier_post((unsigned*)(kargs()->ws + WS_CTL) + CW_BAR, (volatile LAS unsigned*)(lds + LX_MISC));
#define IN(k) (ph_lo <= (k) && (k) < ph_hi)
#define REPLOOP(t) for (int rep_ = 0, nrep_ = 1 + ((repmask >> (t)) & 1); rep_ < nrep_; ++rep_, (rep_ < nrep_ ? (bar.bar = (unsigned*)(kargs()->ws + WS_CTL) + CW_BAR, xcd_barrier(bar)) : (void)0))
#define SEAM(k) do { if (IN(k) && IN((k) + 1)) { bar.bar = (unsigned*)(kargs()->ws + WS_CTL) + CW_BAR; xcd_barrier(bar); if ((repmask >> 10) & 1) xcd_barrier(bar); } } while (0)
    LAS int* tab = (LAS int*)(lds + LX_MOETAB);
#define CONV_PTRS(A) ConvPtrs{(A)->att_w_in, (A)->att_w_out, (A)->gla_w_in, (A)->gla_w_out, (A)->moe_w1, (A)->moe_w3, (A)->moe_w2, (A)->ws}

    if (IN(0)) REPLOOP(0) { PH_ENTRY; p0_prologue(kargs(), lds, tid, lane, wave, vcu, G); } SEAM(0);
    if (IN(1)) { PH_ENTRY; KArgs A = kargs(); unsigned char* ws = A->ws; phase_norm1(A->x, A->ctx, A->norm_g, (float*)(ws + WS_MODV), (bf16*)(ws + WS_H), TALL, lane, wave, vcu, G); } SEAM(1);

#pragma nounroll
    for (int L = 0; L < 4; ++L) {
        const int pb = 2 + 8 * L; const bool isattn = !(L & 1); const int j = L >> 1; const bool lastL = (L == 3);
        const int nrows = lastL ? TX : TALL;
        if (IN(pb)) REPLOOP(isattn ? 1 : 3) {
            PH_ENTRY; KArgs A = kargs(); unsigned char* ws = A->ws; unsigned char* big = ws + WS_BIG; const bf16* H = (const bf16*)(ws + WS_H);
            if (isattn) {
                pg8::DenseOrder S; S.init(H, (const bf16*)(ws + WS_WATTIN) + (size_t)j * NATT * D, TALL, NATT, D, G, bx);
                pg8::EpiAttnIn E{(bf16*)(big + BG_QKV), (bf16*)(big + BG_VAT), (bf16*)(big + BG_VBT), (const LAS float*)(lds + LX_ROPE)};
                pg8::gemm_phase<pg8::EpiAttnIn, pg8::DenseOrder, false>(lds, tid, D, S, E);
            } else {
                pg8::DenseOrder S; S.init(H, (const bf16*)(ws + WS_WGLAIN) + (size_t)j * NGLA * D, TALL, NGLA, D, G, bx);
                pg8::EpiGlaIn E{(bf16*)(big + BG_QKV2), (bf16*)(big + BG_VGT)};
                pg8::gemm_phase<pg8::EpiGlaIn, pg8::DenseOrder, false>(lds, tid, D, S, E);
            }
        }
        SEAM(pb);
        if (!isattn && IN(pb + 1)) {
            for (int rep_ = 0; rep_ <= ((repmask >> 13) & 1); ++rep_)
            { PH_ENTRY; KArgs A = kargs(); unsigned char* ws = A->ws;
              phase_gla_prep((const bf16*)(ws + WS_BIG + BG_QKV2), (const bf16*)(ws + WS_BIG + BG_VGT), A->gla_w_gate + j * 2 * 16 * 512, A->gla_b_gate + j * 2 * 512,
                             (bf16*)(ws + WS_QG), (bf16*)(ws + WS_KET), (float*)(ws + WS_BIG + BG_FAC), (bf16*)(ws + WS_BIG + BG_OF), (bf16*)(ws + WS_BIG + BG_OB), lds, tid, lane, wave, vcu, G); }
            if (single) { bar.bar = (unsigned*)(kargs()->ws + WS_CTL) + CW_BAR; xcd_barrier(bar); }
        }
        if (IN(pb + 1)) REPLOOP(isattn ? 2 : 4) {
            PH_ENTRY; KArgs A = kargs(); unsigned char* ws = A->ws; unsigned char* big = ws + WS_BIG; bf16* AOUT = (bf16*)(ws + WS_AOUT);
            if (isattn) { const ConvPtrs CP = CONV_PTRS(A);
                phase_attention((const bf16*)(big + BG_QKV), (const bf16*)(big + BG_VAT), (const bf16*)(big + BG_VBT), AOUT, A->att_lambda + j * 256, (L == 0) ? 0.2f : 0.470713018f,
                                A->att_subln_g + j * 128, A->na_bias + j * 8 * 465, (unsigned*)(ws + WS_CTL) + CW_NAQ + 64 * j, CP,
                                MK_CONVQ ? (L == 0 ? CT_ATTN0 : CT_MOE1) : 0, MK_CONVQ ? (L == 0 ? CT_MOE1 : CT_MOE3) : 0, lds, tid, lane, wave); }
            else phase_gla((const bf16*)(big + BG_VGT), (bf16*)(big + BG_OF), (bf16*)(big + BG_OB), (const bf16*)(ws + WS_QG), (const bf16*)(ws + WS_KET), (const float*)(big + BG_FAC),
                           lds, tid, lane, wave, vcu, G);
        }
        SEAM(pb + 1);
        if (!isattn) {
            if (IN(pb + 2)) REPLOOP(5) { PH_ENTRY; KArgs A = kargs(); unsigned char* ws = A->ws; unsigned char* big = ws + WS_BIG;
                phase_readout((const bf16*)(big + BG_OF), (const bf16*)(big + BG_OB), (const bf16*)(big + BG_QKV2), A->gla_norm_g + j * 256, (bf16*)(ws + WS_AOUT), nrows, lane, wave, vcu, G); }
            SEAM(pb + 2);
        }
        if (IN(pb + 3)) {
            PH_ENTRY; KArgs A = kargs(); unsigned char* ws = A->ws;
            pg8::DenseOrder S; S.init((const bf16*)(ws + WS_AOUT), (const bf16*)(ws + (isattn ? WS_WATTOUT : WS_WGLAOUT)) + (size_t)j * D * D, nrows, D, D, G, bx);
            pg8::EpiResid E{L == 0 ? A->x : A->out, L == 0 ? A->ctx : (const float*)(ws + WS_CTX), A->out, (float*)(ws + WS_CTX), (const float*)(ws + WS_MODV) + (size_t)L * 9 * 6144 + 2048};
            pg8::gemm_phase<pg8::EpiResid, pg8::DenseOrder, false>(lds, tid, D, S, E);
        }
        SEAM(pb + 3);
        if (IN(pb + 4)) { PH_ENTRY; KArgs A = kargs(); unsigned char* ws = A->ws;
            phase_router(A->out, (float*)(ws + WS_CTX), A->norm_g + (L * 2 + 1) * D, (const float*)(ws + WS_MODV) + (size_t)L * 9 * 6144, (bf16*)(ws + WS_H), A->router_w, A->router_bias,
                         (unsigned*)(ws + WS_CTL) + CW_CNT + L * 16 * 64, (int*)(ws + WS_LIST), (int*)(ws + WS_TOKI), (float*)(ws + WS_TOKW), nrows, lds, tid, lane, wave, vcu, G, (repmask >> 11) & 1); }
        SEAM(pb + 4);
        if (IN(pb + 5)) REPLOOP(6) {
            PH_ENTRY; KArgs A = kargs(); unsigned char* ws = A->ws;
            const int RT = build_moe_table((unsigned*)(ws + WS_CTL) + CW_CNT + L * 16 * 64, tab, tid);
            pg8::MoeOrder S; S.A = (const char*)(ws + WS_H); S.B = (const char*)(ws + WS_W13) + (size_t)L * 16 * D * D * 2; S.K = D; S.bstride = (size_t)D * D * 2; S.tab = tab; S.list = (const int*)(ws + WS_LIST); S.RT = RT; S.nwg = RT * 4; S.G = G; S.c = bx;
            pg8::EpiMoe1 E{(bf16*)(ws + WS_BIG + BG_HB)};
            pg8::gemm_phase<pg8::EpiMoe1, pg8::MoeOrder, true>(lds, tid, D, S, E);
        }
        SEAM(pb + 5);
        if (IN(pb + 6)) REPLOOP(7) {
            PH_ENTRY; KArgs A = kargs(); unsigned char* ws = A->ws;
            const int RT = build_moe_table((unsigned*)(ws + WS_CTL) + CW_CNT + L * 16 * 64, tab, tid);
            pg8::MoeOrder S; S.A = (const char*)(ws + WS_BIG + BG_HB); S.B = (const char*)(ws + WS_W2) + (size_t)L * 16 * D * DEXP * 2; S.K = DEXP; S.bstride = (size_t)D * DEXP * 2; S.tab = tab; S.list = (const int*)(ws + WS_LIST); S.RT = RT; S.nwg = RT * 4; S.G = G; S.c = bx;
            pg8::EpiBf16 E{(bf16*)(ws + WS_BIG + BG_YB), D};
            pg8::gemm_phase<pg8::EpiBf16, pg8::MoeOrder, false>(lds, tid, DEXP, S, E);
        }
        SEAM(pb + 6);
        if (IN(pb + 7)) { PH_ENTRY; KArgs A = kargs(); unsigned char* ws = A->ws; const float* MODV = (const float*)(ws + WS_MODV);
            phase_combine(A->out, (float*)(ws + WS_CTX), MODV + (size_t)L * 9 * 6144, (const bf16*)(ws + WS_BIG + BG_YB), (unsigned*)(ws + WS_CTL) + CW_CNT + L * 16 * 64, (const int*)(ws + WS_TOKI), (const float*)(ws + WS_TOKW),
                          lastL, lastL ? A->final_g : A->norm_g + ((L + 1) * 2) * D, MODV + (size_t)(lastL ? L : L + 1) * 9 * 6144, (bf16*)(ws + WS_H), nrows, lane, wave, vcu, G, (repmask >> 12) & 1); }
        if (!lastL) SEAM(pb + 7);
    }
#undef IN
#undef REPLOOP
#undef SEAM
#undef CONV_PTRS

#undef PH_ENTRY
}

extern "C" void kernel_launch(void* const* d_in, const int* in_sizes, int n_in, void* d_out, int out_size, void* d_ws, size_t ws_size, hipStream_t stream) {
    static int ready = 0;
    if (ready == 0) {
        if (n_in != 23 || out_size != TX * D || ws_size < WS_END) { fprintf(stderr, "kernel_launch: unexpected shapes (n_in %d out %d ws %zu)\n", n_in, out_size, ws_size); ready = -1; return; }
        if (hipFuncSetAttribute((const void*)fwd, hipFuncAttributeMaxDynamicSharedMemorySize, LDS_BYTES) != hipSuccess) { fprintf(stderr, "kernel_launch: hipFuncSetAttribute failed\n"); ready = -1; return; }
        int per_cu = 0; (void)hipOccupancyMaxActiveBlocksPerMultiprocessor(&per_cu, (const void*)fwd, 512, LDS_BYTES); (void)hipGetLastError();
        if (per_cu < 1) fprintf(stderr, "kernel_launch: occupancy query reports %d blocks per CU\n", per_cu);
        ready = 1;
    }
    if (ready < 0) return;
    (void)hipMemsetAsync((char*)d_ws + WS_CTL, 0, CTL_ZERO_BYTES, stream);
    Args a{};
    const float** ap = (const float**)&a;
    for (int i = 0; i < 23; ++i) ap[i] = (const float*)d_in[i];
    a.out = (float*)d_out; a.ws = (unsigned char*)d_ws;
    const int grid = 256;
    a.ph_lo = 0; a.ph_hi = N_PHASES; a.rep = MK_REPMASK;
    hipLaunchKernelGGL(fwd, dim3(grid), dim3(512), LDS_BYTES, stream, a);
}
```

```cpp
#include <hip/hip_runtime.h>
#include <cstdio>
#include <cstdint>

#ifndef MK_CONVQ
#define MK_CONVQ 1
#endif
#ifndef MK_REPMASK
#define MK_REPMASK 0
#endif

#define GAS __attribute__((address_space(1)))
#define LAS __attribute__((address_space(3)))
typedef unsigned short bf16;
typedef short bf16x8 __attribute__((ext_vector_type(8)));
typedef short bf16x4 __attribute__((ext_vector_type(4)));
typedef float f32x4 __attribute__((ext_vector_type(4)));
typedef float f32x2 __attribute__((ext_vector_type(2)));
typedef unsigned u32x4 __attribute__((ext_vector_type(4)));
typedef unsigned u32x2 __attribute__((ext_vector_type(2)));

constexpr int D = 1024, NB = 8, SEQ = 2048, CTXL = 256;
constexpr int TX = NB * SEQ, TC = NB * CTXL, TALL = TX + TC;
constexpr int NKEY = SEQ + CTXL;
constexpr int NATT = 3072, NGLA = 3328;
constexpr float EPSF = 1e-6f;
constexpr float LOG2E = 1.4426950408889634f;
constexpr int NEXP = 16, DEXP = 512;
constexpr int RT_MAX = 160;

constexpr size_t MiB = 1u << 20;
constexpr size_t WS_CTL = 0, CTL_ZERO_BYTES = 65536;
constexpr size_t WS_MODV = 1 * MiB;
constexpr size_t WS_TOKI = 2 * MiB;
constexpr size_t WS_TOKW = 2 * MiB + 512 * 1024;
constexpr size_t WS_LIST = 3 * MiB;
constexpr size_t WS_CTX = 5 * MiB;
constexpr size_t WS_WATTIN = 13 * MiB;
constexpr size_t WS_WATTOUT = 25 * MiB;
constexpr size_t WS_WGLAIN = 29 * MiB;
constexpr size_t WS_WGLAOUT = 42 * MiB;
constexpr size_t WS_W13 = 46 * MiB;
constexpr size_t WS_W2 = 174 * MiB;
constexpr size_t WS_H = 238 * MiB;
constexpr size_t WS_AOUT = 274 * MiB;
constexpr size_t WS_BIG = 310 * MiB;
constexpr size_t WS_END = 539 * MiB;
constexpr size_t BG_QKV = 0;
constexpr size_t BG_VAT = 108 * MiB;
constexpr size_t BG_VBT = 126 * MiB;
constexpr size_t BG_QKV2 = 0;
constexpr size_t BG_VGT = 117 * MiB;
constexpr size_t BG_OF = 153 * MiB;
constexpr size_t BG_OB = 189 * MiB;
constexpr size_t BG_FAC = 225 * MiB;
constexpr size_t WS_QG = WS_H, WS_KET = WS_AOUT;
constexpr size_t BG_HB = 0;
constexpr size_t BG_YB = 40 * MiB;
constexpr int CW_TMO = 0;
constexpr int CW_BAR = 4096;
constexpr int CW_NAQ = 15360;
constexpr int CW_CNT = 8192;

constexpr int RING_BYTES = 131072;
constexpr int LX_OFF = RING_BYTES;
constexpr int LX_MISC = LX_OFF;
constexpr int LX_MOETAB = LX_OFF + 256;
constexpr int LX_ROPE = LX_OFF + 2048;
constexpr int LX_BIAS = LX_OFF + 2048 + 8192;
constexpr int LDS_BYTES = 147456;

#define LDS_WAIT() asm volatile("s_waitcnt lgkmcnt(0)" ::: "memory")
#define VM_WAIT() asm volatile("s_waitcnt vmcnt(0)" ::: "memory")
#define RLX_AGENT __ATOMIC_RELAXED, __HIP_MEMORY_SCOPE_AGENT
__device__ __forceinline__ unsigned f2bf(float f) { unsigned u = __builtin_bit_cast(unsigned, f); return (u + 0x7fffu + ((u >> 16) & 1u)) >> 16; }
typedef __bf16 hwbf16x2 __attribute__((ext_vector_type(2)));
__device__ __forceinline__ unsigned cvtpk(float lo, float hi) { const f32x2 v = {lo, hi}; const hwbf16x2 b = __builtin_convertvector(v, hwbf16x2); return __builtin_bit_cast(unsigned, b); }
__device__ __forceinline__ unsigned pk2(float lo, float hi) { return cvtpk(lo, hi); }
__device__ __forceinline__ float bf2f(unsigned short b) { return __builtin_bit_cast(float, ((unsigned)b) << 16); }
__device__ __forceinline__ float bflo(unsigned w) { return __builtin_bit_cast(float, w << 16); }
__device__ __forceinline__ float bfhi(unsigned w) { return __builtin_bit_cast(float, w & 0xffff0000u); }
template <int CTRL> __device__ __forceinline__ float dppf(float v) { return __builtin_bit_cast(float, __builtin_amdgcn_update_dpp(0, __builtin_bit_cast(int, v), CTRL, 0xf, 0xf, true)); }
__device__ __forceinline__ float row_sum(float v) { v += dppf<0xB1>(v); v += dppf<0x4E>(v); v += dppf<0x124>(v); v += dppf<0x128>(v); return v; }
__device__ __forceinline__ float swap16_add(float a, float b) { auto r = __builtin_amdgcn_permlane16_swap(__float_as_uint(a), __float_as_uint(b), false, false); const unsigned r0 = r[0], r1 = r[1]; return __uint_as_float(r0) + __uint_as_float(r1); }
__device__ __forceinline__ float swap32_add(float a, float b) { auto r = __builtin_amdgcn_permlane32_swap(__float_as_uint(a), __float_as_uint(b), false, false); const unsigned r0 = r[0], r1 = r[1]; return __uint_as_float(r0) + __uint_as_float(r1); }
__device__ __forceinline__ float swap16_max(float a) { auto r = __builtin_amdgcn_permlane16_swap(__float_as_uint(a), __float_as_uint(a), false, false); const unsigned r0 = r[0], r1 = r[1]; return fmaxf(__uint_as_float(r0), __uint_as_float(r1)); }
__device__ __forceinline__ float swap32_max(float a) { auto r = __builtin_amdgcn_permlane32_swap(__float_as_uint(a), __float_as_uint(a), false, false); const unsigned r0 = r[0], r1 = r[1]; return fmaxf(__uint_as_float(r0), __uint_as_float(r1)); }
__device__ __forceinline__ float readlane_f(float v, int l) { return __int_as_float(__builtin_amdgcn_readlane(__float_as_int(v), l)); }
__device__ __forceinline__ float wave_sum(float v) { v = row_sum(v); v = swap16_add(v, v); return swap32_add(v, v); }
__device__ __forceinline__ float fexp2(float x) { return __builtin_amdgcn_exp2f(x); }
__device__ __forceinline__ float fexp(float x) { return __builtin_amdgcn_exp2f(x * LOG2E); }
__device__ __forceinline__ float flog(float x) { return __builtin_amdgcn_logf(x) * 0.6931471805599453f; }
__device__ __forceinline__ float frcp(float x) { return __builtin_amdgcn_rcpf(x); }
__device__ __forceinline__ float silu_f(float x) { return x * frcp(1.0f + fexp(-x)); }

#define XB_TMO      128
#define XB_XCNT(j)  (256  + 64 * (j))
#define XB_XSUB(j)  (1280 + 64 * (j))
#define XB_XGEN(j)  (2304 + 64 * (j))
#define XB_TOP      3328
#define XB_TOPGEN   3392
#define XCD_BAR_WORDS 3456
#define XB_SPIN_CAP (1u << 18)
__device__ __forceinline__ unsigned xb_ld(unsigned* p)              { return __hip_atomic_load(p, __ATOMIC_RELAXED, __HIP_MEMORY_SCOPE_AGENT); }
__device__ __forceinline__ unsigned xb_add(unsigned* p, unsigned v) { return __hip_atomic_fetch_add(p, v, __ATOMIC_RELAXED, __HIP_MEMORY_SCOPE_AGENT); }
__device__ __forceinline__ unsigned xb_xcc_id() { return (unsigned)__builtin_amdgcn_s_getreg((3 << 11) | 20) & 0xFu; }
#define XB_SPIN(cond, bar) do { unsigned _sp = 0; while (cond) { __builtin_amdgcn_s_sleep(1); \
    if ((++_sp & 255u) == 0u) { if (xb_ld(&(bar)[XB_TMO])) break; if (_sp > XB_SPIN_CAP) { atomicAdd(&(bar)[XB_TMO], 1u); break; } } } } while (0)
struct XcdBarrier { unsigned* bar; unsigned x; volatile LAS unsigned* st; };
__device__ __forceinline__ XcdBarrier xcd_barrier_post(unsigned* bar, volatile LAS unsigned* st) {
    XcdBarrier b; b.bar = bar; b.x = xb_xcc_id(); b.st = st;
    if (threadIdx.x == 0) (void)xb_add(&bar[XB_XCNT(b.x)], 1u);
    return b;
}
__device__ __forceinline__ void xcd_barrier_complete(unsigned* bar, unsigned x, unsigned& nloc, unsigned& nx) {
    const unsigned G = gridDim.x * gridDim.y * gridDim.z;
    unsigned sum, cnt, mine, sp = 0u;
    for (;;) {
        sum = 0u; cnt = 0u; mine = 0u;
#pragma unroll
        for (unsigned j = 0; j < 16; ++j) { const unsigned c = xb_ld(&bar[XB_XCNT(j)]); sum += c; cnt += (c > 0u) ? 1u : 0u; mine = (j == x) ? c : mine; }
        if (sum == G) break;
        __builtin_amdgcn_s_sleep(1);
        if ((++sp & 255u) == 0u) { if (xb_ld(&bar[XB_TMO])) break; if (sp > XB_SPIN_CAP) { atomicAdd(&bar[XB_TMO], 1u); break; } }
    }
    nloc = mine > 0u ? mine : 1u; nx = cnt > 0u ? cnt : 1u;
}
__device__ __forceinline__ void xcd_barrier(const XcdBarrier& b) {
    asm volatile("s_waitcnt vmcnt(0)" ::: "memory");
    __syncthreads();
    if (threadIdx.x == 0) {
        unsigned* bar = b.bar;
        __builtin_amdgcn_s_waitcnt(0);
        unsigned nloc = b.st[0], nx = b.st[1];
        if (nloc == 0u) { xcd_barrier_complete(bar, b.x, nloc, nx); b.st[0] = nloc; b.st[1] = nx; }
        const unsigned old = xb_add(&bar[XB_XSUB(b.x)], 1u);
        const unsigned gen = old / nloc;
        if (old + 1u == (gen + 1u) * nloc) {
            __builtin_amdgcn_fence(__ATOMIC_RELEASE, "agent");
            asm volatile("s_waitcnt vmcnt(0)" ::: "memory");
            const unsigned og = xb_add(&bar[XB_TOP], 1u);
            const unsigned tg = og / nx;
            if (og + 1u == (tg + 1u) * nx) xb_add(&bar[XB_TOPGEN], 1u);
            else XB_SPIN(xb_ld(&bar[XB_TOPGEN]) == tg, bar);
            __builtin_amdgcn_fence(__ATOMIC_ACQUIRE, "agent");
            xb_add(&bar[XB_XGEN(b.x)], 1u);
            asm volatile("s_waitcnt vmcnt(0)" ::: "memory");
        } else {
            XB_SPIN(xb_ld(&bar[XB_XGEN(b.x)]) == gen, bar);
            __builtin_amdgcn_fence(__ATOMIC_ACQUIRE, "agent");
            asm volatile("s_waitcnt vmcnt(0)" ::: "memory");
        }
    }
    __syncthreads();
}

namespace pg8 {
constexpr int BM = 256, BK = 64, HALF = 128, HTB = HALF * BK * 2, STAGE_BYTES = 8 * HTB, NXCD = 8, WGM = 8;
__host__ __device__ __forceinline__ int lds_byte(int r, int c) { const int st = (r >> 4) * 2 + (c >> 5), rr = r & 15, cc = c & 31, ob = rr * 64 + cc * 2; return st * 1024 + (ob ^ (((ob >> 9) & 1) << 5)); }
__host__ __device__ __forceinline__ void stage_rc(int b, int& R, int& C) { const int st = b / 1024, sb = b % 1024, swz = sb ^ (((sb >> 9) & 1) << 5); R = (st >> 1) * 16 + swz / 64; C = (st & 1) * 32 + (swz % 64) / 2; }
__host__ __device__ __forceinline__ int perm32(int rho) { const int n = rho >> 4, i = rho & 15; return 8 * (i >> 2) + 4 * n + (i & 3); }

struct Unit { int pm, pn, e, mt, roff, nai; };
__device__ __forceinline__ bool split_index(long L, int nwg, int G, int& uidx, int& roff, int& nai) {
    const int R = nwg / G, r = nwg % G; const bool split = (r > 0) && (2 * r <= G);
    if (L < (long)R * G || !split) { if (L >= nwg) return false; uidx = (int)L; roff = 0; nai = 2; return true; }
    const int h = (int)(L - (long)R * G); if (h >= 2 * r) return false; uidx = R * G + (h >> 1); roff = (h & 1) * 128; nai = 1; return true;
}

__device__ __forceinline__ int xcd_remap(int wgid, int nwg) { const int q = nwg / NXCD, r = nwg % NXCD, xcd = wgid % NXCD, off = wgid / NXCD; return (xcd < r ? xcd * (q + 1) : r * (q + 1) + (xcd - r) * q) + off; }

struct DenseOrder {
    const char* A; const char* B; int K; int nM, nN, nwg, G, c;
    __device__ __forceinline__ void init(const bf16* A_, const bf16* B_, int M, int N, int K_, int G_, int c_) { A = (const char*)A_; B = (const char*)B_; K = K_; nM = M / BM; nN = N / BM; nwg = nM * nN; G = G_; c = c_; }
    __device__ __forceinline__ bool next(int i, Unit& u) const {
        int uidx; if (!split_index((long)i * G + c, nwg, G, uidx, u.roff, u.nai)) return false;
        const int wgid = xcd_remap(uidx, nwg);
        const int nig = WGM * nN, gid = wgid / nig, fm = gid * WGM, gsz = (nM - fm) < WGM ? (nM - fm) : WGM;
        u.pm = fm + ((wgid % nig) % gsz); u.pn = (wgid % nig) / gsz; u.e = 0; u.mt = 0; return true;
    }
    __device__ __forceinline__ const char* a_ptr(const Unit& u) const { return A + (size_t)(u.pm * BM + u.roff) * K * 2; }
    __device__ __forceinline__ const char* b_ptr(const Unit& u) const { return B + (size_t)u.pn * BM * K * 2; }
    __device__ __forceinline__ int tok(const Unit&, int) const { return 0; }
};
struct MoeOrder {
    const char* A; const char* B; int K; size_t bstride;
    const LAS int* tab; const int* list; int RT, nwg, G, c;
    __device__ __forceinline__ bool next(int i, Unit& u) const {
        int uidx; if (!split_index((long)i * G + c, nwg, G, uidx, u.roff, u.nai)) return false;
        const int wgid = xcd_remap(uidx, nwg);
        const int rt = wgid >> 2; u.pm = rt; u.pn = wgid & 3; const int t = tab[rt]; u.e = t & 255; u.mt = t >> 8; return true;
    }
    __device__ __forceinline__ const char* a_ptr(const Unit& u) const { return A + (size_t)(u.pm * BM + u.roff) * K * 2; }
    __device__ __forceinline__ const char* b_ptr(const Unit& u) const { return B + (size_t)u.e * bstride + (size_t)u.pn * BM * K * 2; }
    __device__ __forceinline__ int tok(const Unit& u, int r) const { const int cnt = tab[RT_MAX + 1 + u.e]; const int pos = u.mt * BM + u.roff + r; return pos < cnt ? list[(size_t)u.e * TALL + pos] : 0; }
};

__device__ __forceinline__ unsigned cvt_pk_bf16(float lo, float hi) { unsigned r; asm volatile("v_cvt_pk_bf16_f32 %0, %1, %2" : "=v"(r) : "v"(lo), "v"(hi)); return r; }

template <class Epi, class Sched, bool GATHER>
__device__ __forceinline__ void gemm_phase(LAS unsigned char* lds, const int tid, const int K, const Sched& S, const Epi& E) {
    const int wid = __builtin_amdgcn_readfirstlane(tid >> 6), lane = tid & 63, wr = wid >> 2, wc = wid & 3, fr = lane & 15, fq = lane >> 4;
    const int nt = K / BK;
    unsigned voffA[2], voffB[2]; int RA[2], CA[2];
#pragma unroll
    for (int i = 0; i < 2; ++i) { int R, C; stage_rc(tid * 16 + i * 8192, R, C); const int Rb = Epi::PERM ? ((R & ~31) + perm32(R & 31)) : R;
        RA[i] = R; CA[i] = C; voffA[i] = (unsigned)(R * K + C) * 2u; voffB[i] = (unsigned)(Rb * K + C) * 2u; }
    const size_t kstep = (size_t)(BK * 2);
    const size_t hstep = (size_t)HALF * K * 2;
    const unsigned ldsw = (unsigned)wid * 1024u;
    const int aoff = lds_byte(wr * 64 + fr, fq * 8), boff = lds_byte(wc * 32 + fr, fq * 8);
#define PG8_SA(b, h) (((b) * 2 + (h)) * HTB)
#define PG8_SB(b, h) ((4 + (b) * 2 + (h)) * HTB)
#define PG8_STAGE(bufoff, gbase, voff) do { _Pragma("unroll") for (int _i = 0; _i < 2; ++_i) \
        __builtin_amdgcn_global_load_lds((const unsigned*)((const char*)(gbase) + (voff)[_i]), (LAS unsigned*)(lds + (bufoff) + ldsw + _i * 8192), 16, 0, 0); } while (0)
#define PG8_STAGE_A(bufoff, h, usenext, koff) do { if constexpr (GATHER) { unsigned _vo[2]; _vo[0] = (usenext) ? nvA[h][0] : vA[h][0]; _vo[1] = (usenext) ? nvA[h][1] : vA[h][1]; PG8_STAGE(bufoff, S.A + (koff), _vo); } \
        else { PG8_STAGE(bufoff, ((usenext) ? nA : cA) + (size_t)(h) * hstep + (koff), voffA); } } while (0)
#define PG8_LDA(dst, b, h) do { _Pragma("unroll") for (int m = 0; m < 4; ++m) _Pragma("unroll") for (int k = 0; k < 2; ++k) dst[m][k] = *(const LAS bf16x8*)(lds + PG8_SA(b, h) + aoff + m * 2048 + k * 1024); } while (0)
#define PG8_LDB(dst, b, h) do { _Pragma("unroll") for (int n = 0; n < 2; ++n) _Pragma("unroll") for (int k = 0; k < 2; ++k) dst[n][k] = *(const LAS bf16x8*)(lds + PG8_SB(b, h) + boff + n * 2048 + k * 1024); } while (0)
#define PG8_MMA(ai, bj, At, Bt) do { __builtin_amdgcn_s_setprio(1); _Pragma("unroll") for (int m = 0; m < 4; ++m) _Pragma("unroll") for (int n = 0; n < 2; ++n) _Pragma("unroll") for (int k = 0; k < 2; ++k) \
        acc[ai][bj][m][n] = __builtin_amdgcn_mfma_f32_16x16x32_bf16(Bt[n][k], At[m][k], acc[ai][bj][m][n], 0, 0, 0); __builtin_amdgcn_s_setprio(0); } while (0)
#define PG8_WAIT_V(n) asm volatile("s_waitcnt vmcnt(" #n ")" ::: "memory")
#define PG8_WAIT_L(n) asm volatile("s_waitcnt lgkmcnt(" #n ")" ::: "memory")
#define PG8_BAR __builtin_amdgcn_s_barrier()
#define PG8_SCHED __builtin_amdgcn_sched_barrier(0)
    Unit cur, nxt; int ui = 0;
    if (!S.next(0, cur)) return;
    f32x4 acc[2][2][4][2];
#pragma unroll
    for (int a = 0; a < 2; ++a)
#pragma unroll
        for (int b = 0; b < 2; ++b)
#pragma unroll
            for (int m = 0; m < 4; ++m)
#pragma unroll
                for (int n = 0; n < 2; ++n) acc[a][b][m][n] = (f32x4){0.f, 0.f, 0.f, 0.f};
    bf16x8 At[4][2], B0[2][2], B1[2][2];
    unsigned vA[2][2], nvA[2][2];
    if constexpr (GATHER) {
#pragma unroll
        for (int h = 0; h < 2; ++h)
#pragma unroll
            for (int i = 0; i < 2; ++i) { vA[h][i] = (unsigned)(S.tok(cur, h * HALF + RA[i]) * K + CA[i]) * 2u; nvA[h][i] = vA[h][i]; }
    }
    const char* cA = S.a_ptr(cur); const char* cB = S.b_ptr(cur); const char* nA = cA;
    PG8_STAGE(PG8_SB(0, 0), cB, voffB); PG8_STAGE(PG8_SB(0, 1), cB + hstep, voffB); PG8_STAGE_A(PG8_SA(0, 0), 0, false, 0); PG8_STAGE_A(PG8_SA(0, 1), 1, false, 0);
    if (wr == 1) PG8_BAR;
    PG8_WAIT_V(2); PG8_BAR;
    PG8_STAGE(PG8_SB(1, 0), cB + kstep, voffB); PG8_STAGE_A(PG8_SA(1, 0), 0, false, kstep); PG8_STAGE(PG8_SB(1, 1), cB + hstep + kstep, voffB);
    PG8_WAIT_V(6); PG8_BAR;
    for (;;) {
        const bool has_next = S.next(ui + 1, nxt);
        nA = has_next ? S.a_ptr(nxt) : cA; const char* nB = has_next ? S.b_ptr(nxt) : cB;
        if constexpr (GATHER) {
            if (has_next) {
#pragma unroll
                for (int h = 0; h < 2; ++h)
#pragma unroll
                    for (int i = 0; i < 2; ++i) nvA[h][i] = (unsigned)(S.tok(nxt, h * HALF + RA[i]) * K + CA[i]) * 2u;
            }
        }
        const bool full = (cur.nai == 2);
        for (int t = 0; t < nt; t += 2) {
            const bool last = (t == nt - 2);
            const size_t k1 = (size_t)(t + 1) * kstep;
            const size_t k2 = last ? 0 : (size_t)(t + 2) * kstep, k3 = k2 + kstep;
            const char* b2 = last ? nB : cB + (size_t)(t + 2) * kstep; const char* b3 = b2 + kstep;
            PG8_LDB(B0, 0, 0); PG8_LDB(B1, 0, 1); PG8_SCHED; PG8_LDA(At, 0, 0); PG8_STAGE_A(PG8_SA(1, 1), 1, false, k1);
            PG8_WAIT_V(8); PG8_WAIT_L(0); PG8_BAR; PG8_MMA(0, 0, At, B0); PG8_MMA(0, 1, At, B1); PG8_BAR; PG8_SCHED;
            if (full) PG8_LDA(At, 0, 1); PG8_STAGE(PG8_SB(0, 0), b2, voffB); PG8_STAGE(PG8_SB(0, 1), b2 + hstep, voffB); PG8_STAGE_A(PG8_SA(0, 0), 0, last, k2);
            PG8_WAIT_V(8); PG8_WAIT_L(0); PG8_BAR; if (full) { PG8_MMA(1, 0, At, B0); PG8_MMA(1, 1, At, B1); } PG8_BAR; PG8_SCHED;
            PG8_LDB(B0, 1, 0); PG8_LDB(B1, 1, 1); PG8_SCHED; PG8_LDA(At, 1, 0); PG8_STAGE_A(PG8_SA(0, 1), 1, last, k2);
            PG8_WAIT_V(8); PG8_WAIT_L(0); PG8_BAR; PG8_MMA(0, 0, At, B0); PG8_MMA(0, 1, At, B1); PG8_BAR; PG8_SCHED;
            if (full) PG8_LDA(At, 1, 1); PG8_STAGE(PG8_SB(1, 0), b3, voffB); PG8_STAGE(PG8_SB(1, 1), b3 + hstep, voffB); PG8_STAGE_A(PG8_SA(1, 0), 0, last, k3);
            PG8_WAIT_V(8); PG8_WAIT_L(0); PG8_BAR; if (full) { PG8_MMA(1, 0, At, B0); PG8_MMA(1, 1, At, B1); } PG8_BAR; PG8_SCHED;
        }
        if (wr == 0) PG8_BAR;
        E(acc, cur, wr, wc, fr, fq);
        if (!has_next) break;
#pragma unroll
        for (int a = 0; a < 2; ++a)
#pragma unroll
            for (int b = 0; b < 2; ++b)
#pragma unroll
                for (int m = 0; m < 4; ++m)
#pragma unroll
                    for (int n = 0; n < 2; ++n) acc[a][b][m][n] = (f32x4){0.f, 0.f, 0.f, 0.f};
        cur = nxt; cA = nA; cB = nB; ++ui;
        if constexpr (GATHER) {
#pragma unroll
            for (int h = 0; h < 2; ++h)
#pragma unroll
                for (int i = 0; i < 2; ++i) vA[h][i] = nvA[h][i];
        }
        if (wr == 1) PG8_BAR;
    }
    PG8_WAIT_V(0);
    PG8_BAR;
#undef PG8_SA
#undef PG8_SB
#undef PG8_STAGE
#undef PG8_STAGE_A
#undef PG8_LDA
#undef PG8_LDB
#undef PG8_MMA
#undef PG8_WAIT_V
#undef PG8_WAIT_L
#undef PG8_BAR
#undef PG8_SCHED
}
}

namespace pg8 {
__device__ __forceinline__ void row_bt(int row, int& b, int& tok) { if (row < TX) { b = row >> 11; tok = row & 2047; } else { const int r = row - TX; b = r >> 8; tok = SEQ + (r & 255); } }

struct EpiAttnIn {
    static constexpr bool PERM = true;
    bf16* QKV; bf16* VAT; bf16* VBT; const LAS float* rope;
    __device__ __forceinline__ void operator()(const f32x4 (&acc)[2][2][4][2], const Unit& u, int wr, int wc, int fr, int fq) const {
        const int row0 = u.pm * BM + u.roff + wr * 64 + fr; const int seg = u.pn >> 1;
        const bool latent = u.pm < (TX / BM);
        if (seg == 2 || seg == 5) {
#pragma unroll
            for (int ai = 0; ai < 2; ++ai) if (ai < u.nai)
#pragma unroll
                for (int m = 0; m < 4; ++m) { const int row = row0 + ai * HALF + m * 16; int b, tok; row_bt(row, b, tok);
#pragma unroll
                    for (int bj = 0; bj < 2; ++bj) { const int col = u.pn * BM + bj * HALF + wc * 32 + 8 * fq;
                        bf16* dst;
                        if (seg == 2) { const int cs = col - 1024; dst = VAT + ((size_t)(b * 4 + (cs >> 7)) * 128 + (cs & 127)) * NKEY + tok; }
                        else { const int cs = col - 2560; dst = VBT + ((size_t)(b * 8 + (cs >> 6)) * 64 + (cs & 63)) * NKEY + tok; }
#pragma unroll
                        for (int n = 0; n < 2; ++n)
#pragma unroll
                            for (int i = 0; i < 4; ++i) dst[(size_t)(4 * n + i) * NKEY] = (bf16)f2bf(acc[ai][bj][m][n][i]); } }
            return;
        }
        const bool dorope = latent && seg < 2;
        const float qs = (seg == 0 || seg == 3) ? 0.125f * LOG2E : 1.0f;
#pragma unroll
        for (int ai = 0; ai < 2; ++ai) if (ai < u.nai)
#pragma unroll
            for (int m = 0; m < 4; ++m) { const int row = row0 + ai * HALF + m * 16;
                f32x4 cs4[4];
                if (dorope) { const int t = row & 2047; const int pos = (wc & 1) ? (t & 63) : (t >> 6);
                    const LAS f32x4* rp = (const LAS f32x4*)(rope + (pos * 16 + 8 * (fq & 1)) * 2);
#pragma unroll
                    for (int j = 0; j < 4; ++j) cs4[j] = rp[j]; }
#pragma unroll
                for (int bj = 0; bj < 2; ++bj) { const int col = u.pn * BM + bj * HALF + wc * 32 + 8 * fq;
                    float v[8];
#pragma unroll
                    for (int n = 0; n < 2; ++n)
#pragma unroll
                        for (int i = 0; i < 4; ++i) v[4 * n + i] = acc[ai][bj][m][n][i];
                    if (dorope) {
#pragma unroll
                        for (int j = 0; j < 8; ++j) { const float other = __shfl_xor(v[j], 32); const float c = cs4[j >> 1][(j & 1) * 2], s = cs4[j >> 1][(j & 1) * 2 + 1];
                            v[j] = (fq < 2) ? (v[j] * c - other * s) : (v[j] * c + other * s); } }
                    u32x4 w; w.x = pk2(v[0] * qs, v[1] * qs); w.y = pk2(v[2] * qs, v[3] * qs); w.z = pk2(v[4] * qs, v[5] * qs); w.w = pk2(v[6] * qs, v[7] * qs);
                    *(u32x4*)(QKV + (size_t)row * NATT + col) = w; } }
    }
};
struct EpiGlaIn {
    static constexpr bool PERM = true;
    bf16* QKV2; bf16* VGT;
    __device__ __forceinline__ void operator()(const f32x4 (&acc)[2][2][4][2], const Unit& u, int wr, int wc, int fr, int fq) const {
        const int row0 = u.pm * BM + u.roff + wr * 64 + fr;
        if (u.pn >= 4 && u.pn < 8) {
#pragma unroll
            for (int ai = 0; ai < 2; ++ai) if (ai < u.nai)
#pragma unroll
                for (int m = 0; m < 4; ++m) { const int row = row0 + ai * HALF + m * 16; int b, tok; row_bt(row, b, tok);
#pragma unroll
                    for (int bj = 0; bj < 2; ++bj) { const int cs = u.pn * BM + bj * HALF + wc * 32 + 8 * fq - 1024;
                        bf16* dst = VGT + ((size_t)(b * 4 + (cs >> 8)) * 256 + (cs & 255)) * NKEY + tok;
#pragma unroll
                        for (int n = 0; n < 2; ++n)
#pragma unroll
                            for (int i = 0; i < 4; ++i) dst[(size_t)(4 * n + i) * NKEY] = (bf16)f2bf(acc[ai][bj][m][n][i]); } }
            return;
        }
        const float qs = (u.pn < 2) ? 0.08838834764831845f : 1.0f;
#pragma unroll
        for (int ai = 0; ai < 2; ++ai) if (ai < u.nai)
#pragma unroll
            for (int m = 0; m < 4; ++m) { const int row = row0 + ai * HALF + m * 16;
#pragma unroll
                for (int bj = 0; bj < 2; ++bj) { const int col = u.pn * BM + bj * HALF + wc * 32 + 8 * fq; const f32x4 a = acc[ai][bj][m][0] * qs, c = acc[ai][bj][m][1] * qs;
                    u32x4 w; w.x = pk2(a[0], a[1]); w.y = pk2(a[2], a[3]); w.z = pk2(c[0], c[1]); w.w = pk2(c[2], c[3]);
                    *(u32x4*)(QKV2 + (size_t)row * NGLA + col) = w; } }
    }
};
struct EpiResid {
    static constexpr bool PERM = false;
    const float* IL; const float* IC; float* XL; float* XC; const float* modv;
    __device__ __forceinline__ void operator()(const f32x4 (&acc)[2][2][4][2], const Unit& u, int wr, int wc, int fr, int fq) const {
        const int row0 = u.pm * BM + u.roff + wr * 64 + fr, col0 = u.pn * BM + wc * 32 + 4 * fq;
        const bool latent = u.pm < (TX / BM); const int bi = latent ? (u.pm >> 3) : 8;
        float* base = latent ? XL : (XC - (size_t)TX * D); const float* ibase = latent ? IL : (IC - (size_t)TX * D);
        f32x4 gv[2][2];
#pragma unroll
        for (int bj = 0; bj < 2; ++bj)
#pragma unroll
            for (int n = 0; n < 2; ++n) gv[bj][n] = *(const f32x4*)(modv + bi * 6144 + col0 + bj * HALF + n * 16);
#pragma unroll
        for (int ai = 0; ai < 2; ++ai) if (ai < u.nai)
#pragma unroll
            for (int m = 0; m < 4; ++m) { const size_t ro = (size_t)(row0 + ai * HALF + m * 16) * D + col0;
#pragma unroll
                for (int bj = 0; bj < 2; ++bj)
#pragma unroll
                    for (int n = 0; n < 2; ++n) { const size_t o = ro + bj * HALF + n * 16; *(f32x4*)(base + o) = *(const f32x4*)(ibase + o) + gv[bj][n] * acc[ai][bj][m][n]; } }
    }
};
struct EpiMoe1 {
    static constexpr bool PERM = false;
    bf16* HB;
    __device__ __forceinline__ void operator()(const f32x4 (&acc)[2][2][4][2], const Unit& u, int wr, int wc, int fr, int fq) const {
        const int row0 = u.pm * BM + u.roff + wr * 64 + fr, col0 = u.pn * 128 + wc * 16 + 4 * fq;
#pragma unroll
        for (int ai = 0; ai < 2; ++ai) if (ai < u.nai)
#pragma unroll
            for (int m = 0; m < 4; ++m) { bf16* rowp = HB + (size_t)(row0 + ai * HALF + m * 16) * DEXP + col0;
#pragma unroll
                for (int bj = 0; bj < 2; ++bj) { const f32x4 a = acc[ai][bj][m][0], b = acc[ai][bj][m][1];
                    u32x2 w; w.x = pk2(silu_f(a[0]) * b[0], silu_f(a[1]) * b[1]); w.y = pk2(silu_f(a[2]) * b[2], silu_f(a[3]) * b[3]);
                    *(u32x2*)(rowp + bj * 64) = w; } }
    }
};
struct EpiBf16 {
    static constexpr bool PERM = true;
    bf16* O; int ldc;
    __device__ __forceinline__ void operator()(const f32x4 (&acc)[2][2][4][2], const Unit& u, int wr, int wc, int fr, int fq) const {
        const int row0 = u.pm * BM + u.roff + wr * 64 + fr, col0 = u.pn * BM + wc * 32 + 8 * fq;
#pragma unroll
        for (int ai = 0; ai < 2; ++ai) if (ai < u.nai)
#pragma unroll
            for (int m = 0; m < 4; ++m) { bf16* rowp = O + (size_t)(row0 + ai * HALF + m * 16) * ldc + col0;
#pragma unroll
                for (int bj = 0; bj < 2; ++bj) { const f32x4 a = acc[ai][bj][m][0], c = acc[ai][bj][m][1];
                    u32x4 w; w.x = pk2(a[0], a[1]); w.y = pk2(a[2], a[3]); w.z = pk2(c[0], c[1]); w.w = pk2(c[2], c[3]);
                    *(u32x4*)(rowp + bj * HALF) = w; } }
    }
};
}

struct Args {
    const float *x, *c, *ctx, *c_ctx, *w_mod, *b_mod, *norm_g, *final_g, *att_w_in, *att_w_out, *att_lambda, *att_subln_g, *na_bias,
                *gla_w_in, *gla_w_gate, *gla_b_gate, *gla_norm_g, *gla_w_out, *router_w, *router_bias, *moe_w1, *moe_w3, *moe_w2;
    float* out; unsigned char* ws; int ph_lo, ph_hi, rep, pad;
};

struct RowMapId { int off; __device__ __forceinline__ int operator()(int n) const { return off + n; } };
struct RowMapMoe { int which; __device__ __forceinline__ int operator()(int n) const { return 32 * (n >> 4) + 16 * which + (n & 15); } };
__device__ __forceinline__ void ti_load(float (&ld)[32], const float* W, int N, int item, int lane) {
    const int nblk = N / 32, kb = item / nblk, nb = item % nblk, k0 = 64 * kb, n0 = 32 * nb;
#pragma unroll
    for (int i = 0; i < 32; ++i) ld[i] = W[(size_t)(k0 + 2 * i + (lane >> 5)) * N + n0 + (lane & 31)];
}
template <class RM>
__device__ __forceinline__ void ti_finish(const float (&ld)[32], int K, int N, bf16* WT, LAS float* scr, int item, int lane, RM rm) {
    const int nblk = N / 32, kb = item / nblk, nb = item % nblk, k0 = 64 * kb, n0 = 32 * nb;
#pragma unroll
    for (int i = 0; i < 32; ++i) scr[(2 * i + (lane >> 5)) * 33 + (lane & 31)] = ld[i];
    LDS_WAIT(); asm volatile("" ::: "memory");
    const int c = lane & 7;
#pragma unroll
    for (int j = 0; j < 4; ++j) { const int n = (lane >> 3) + 8 * j; const LAS float* s = scr + (8 * c) * 33 + n;
        u32x4 o; o.x = pk2(s[0 * 33], s[1 * 33]); o.y = pk2(s[2 * 33], s[3 * 33]); o.z = pk2(s[4 * 33], s[5 * 33]); o.w = pk2(s[6 * 33], s[7 * 33]);
        *(u32x4*)(WT + (size_t)rm(n0 + n) * K + k0 + 8 * c) = o; }
    LDS_WAIT(); asm volatile("" ::: "memory");
}
template <class RM>
__device__ __forceinline__ void p0_transpose_item(const float* W, int K, int N, bf16* WT, LAS float* scr, int item, int lane, RM rm) {
    float ld[32]; ti_load(ld, W, N, item, lane); ti_finish(ld, K, N, WT, scr, item, lane, rm);
}

constexpr int CV_ATTIN = 1536, CV_ATTOUT = 512, CV_GLAIN = 1552, CV_GLAPAD = 28, CV_GLAOUT = 512, CV_W = 4096, CV_MOE = 3 * CV_W;
constexpr int CT_ATTN0 = CV_ATTIN + CV_ATTOUT, CT_MOE0 = CT_ATTN0 + CV_MOE, CT_GLA0 = CT_MOE0 + CV_GLAIN + CV_GLAPAD + CV_GLAOUT, CT_ATTN1 = CT_GLA0 + CV_ATTIN + CV_ATTOUT, CT_MOE1 = CT_ATTN1 + CV_MOE,
              CT_MOE2 = CT_MOE1 + CV_MOE, CT_GLA1 = CT_MOE2 + CV_GLAIN + CV_GLAPAD + CV_GLAOUT, CT_MOE3 = CT_GLA1 + CV_MOE, CV_TOTAL = CT_MOE3;
constexpr int CV_UNIT = 32;
struct ConvPtrs { const float *att_w_in, *att_w_out, *gla_w_in, *gla_w_out, *moe_w1, *moe_w3, *moe_w2; unsigned char* ws; };
struct RowMapAny { int moe, which; __device__ __forceinline__ int operator()(int n) const { return moe ? 32 * (n >> 4) + 16 * which + (n & 15) : n; } };
struct ConvDesc { const float* W; bf16* WT; int K, N, sub, kind  ; RowMapAny rm; };
__device__ __forceinline__ ConvDesc conv_decode(const ConvPtrs& P, int it, int hi) {
    ConvDesc d; d.W = nullptr; d.WT = nullptr; d.K = D; d.N = D; d.sub = 0; d.kind = 0; d.rm = RowMapAny{0, 0};
    if (it >= hi) return d;
    int kind, j, r;
    if (it < CT_ATTN0) { kind = 0; j = 0; r = it; } else if (it < CT_MOE0) { kind = 2; j = 0; r = it - CT_ATTN0; } else if (it < CT_GLA0) { kind = 1; j = 0; r = it - CT_MOE0; }
    else if (it < CT_ATTN1) { kind = 0; j = 1; r = it - CT_GLA0; } else if (it < CT_MOE1) { kind = 2; j = 1; r = it - CT_ATTN1; } else if (it < CT_MOE2) { kind = 2; j = 2; r = it - CT_MOE1; }
    else if (it < CT_GLA1) { kind = 1; j = 1; r = it - CT_MOE2; } else { kind = 2; j = 3; r = it - CT_GLA1; }
    d.kind = 1; d.sub = r;
    if (kind == 2) {
        const int which = r / CV_W, q = r % CV_W, e = q >> 8, je = j * 16 + e; d.sub = q & 255;
        if (which < 2) { d.W = (which ? P.moe_w3 : P.moe_w1) + (size_t)je * D * DEXP; d.N = DEXP; d.WT = (bf16*)(P.ws + WS_W13) + (size_t)je * D * D; d.rm.moe = 1; d.rm.which = which; }
        else { d.W = P.moe_w2 + (size_t)je * DEXP * D; d.K = DEXP; d.WT = (bf16*)(P.ws + WS_W2) + (size_t)je * D * DEXP; }
    } else if (kind == 0) {
        if (r < CV_ATTIN) { d.W = P.att_w_in + (size_t)j * D * NATT; d.N = NATT; d.WT = (bf16*)(P.ws + WS_WATTIN) + (size_t)j * NATT * D; }
        else { d.W = P.att_w_out + (size_t)j * D * D; d.WT = (bf16*)(P.ws + WS_WATTOUT) + (size_t)j * D * D; d.sub = r - CV_ATTIN; }
    } else {
        if (r < CV_GLAIN) { d.W = P.gla_w_in + (size_t)j * D * 3104; d.N = 3104; d.WT = (bf16*)(P.ws + WS_WGLAIN) + (size_t)j * NGLA * D; }
        else if (r < CV_GLAIN + CV_GLAPAD) { d.kind = 2; d.sub = (r - CV_GLAIN) * 1024; d.WT = (bf16*)(P.ws + WS_WGLAIN) + (size_t)j * NGLA * D + (size_t)3104 * D; }
        else { d.W = P.gla_w_out + (size_t)j * D * D; d.WT = (bf16*)(P.ws + WS_WGLAOUT) + (size_t)j * D * D; d.sub = r - CV_GLAIN - CV_GLAPAD; }
    }
    return d;
}
__device__ __forceinline__ void conv_load(const ConvDesc& d, float (&ld)[32], int lane) { if (d.kind == 1) ti_load(ld, d.W, d.N, d.sub, lane); }
__device__ __forceinline__ void conv_finish(const ConvDesc& d, const float (&ld)[32], LAS float* scr, int lane) {
    if (d.kind == 1) ti_finish(ld, d.K, d.N, d.WT, scr, d.sub, lane, d.rm);
    else if (d.kind == 2) { for (int i = lane; i < 1024; i += 64) *(u32x4*)(d.WT + (size_t)(d.sub + i) * 8) = (u32x4){0u, 0u, 0u, 0u}; }
}
__device__ __forceinline__ void conv_item(const ConvPtrs& P, int it, LAS float* scr, int lane) {
    const ConvDesc d = conv_decode(P, it, it + 1); float ld[32]; conv_load(d, ld, lane); conv_finish(d, ld, scr, lane);
}
__device__ __forceinline__ void conv_static(const ConvPtrs& P, int cur, int need, LAS unsigned char* lds, int lane, int wave, int vcu, int G) {
    LAS float* scr = (LAS float*)(lds + wave * 8448);
    for (int it = cur + vcu * 8 + wave; it < need; it += G * 8) conv_item(P, it, scr, lane);
}
__device__ __forceinline__ void conv_unit(const ConvPtrs& P, int i0, int hi, LAS unsigned char* lds, int lane, int wave) {
    LAS float* scr = (LAS float*)(lds + wave * 8448);
    constexpr int NPW = CV_UNIT / 8; static_assert(NPW == 4, "four items per wave");
    const int it0 = i0 + wave * NPW;
    float la[32], lb[32];
    ConvDesc dA = conv_decode(P, it0, hi); conv_load(dA, la, lane);
    ConvDesc dB = conv_decode(P, it0 + 1, hi); conv_load(dB, lb, lane);
    conv_finish(dA, la, scr, lane);
    dA = conv_decode(P, it0 + 2, hi); conv_load(dA, la, lane);
    conv_finish(dB, lb, scr, lane);
    dB = conv_decode(P, it0 + 3, hi); conv_load(dB, lb, lane);
    conv_finish(dA, la, scr, lane);
    conv_finish(dB, lb, scr, lane);
}

template <class AP> __device__ __forceinline__ void p0_prologue(const AP ap, LAS unsigned char* lds, int tid, int lane, int wave, int vcu, int G) {
    unsigned char* ws = ap->ws;
    LAS float* S9 = (LAS float*)(lds + 69632);
    LAS float* red = (LAS float*)(lds + 106496);
    { const ConvPtrs P{ap->att_w_in, ap->att_w_out, ap->gla_w_in, ap->gla_w_out, ap->moe_w1, ap->moe_w3, ap->moe_w2, ws};
      conv_static(P, 0, MK_CONVQ ? CT_ATTN0 : CV_TOTAL, lds, lane, wave, vcu, G); }
    __syncthreads();
    { const float* cc = ap->c; const float* cx = ap->c_ctx;
      for (int i = tid; i < 9 * 1024; i += 512) { const int bi = i >> 10, k = i & 1023; const float v = (bi < 8) ? cc[bi * D + k] : cx[k]; S9[i] = v / (1.0f + __expf(-v)); } }
    __syncthreads();
    const float* w_mod = ap->w_mod; const float* b_mod = ap->b_mod;
    for (int u = vcu; u < 4 * 96; u += G) {
        const int L = u / 96, n0 = (u % 96) * 64;
        const float* W = w_mod + (size_t)L * D * 6144 + n0 + lane;
        float acc[9];
#pragma unroll
        for (int bi = 0; bi < 9; ++bi) acc[bi] = 0.f;
        const int kb = wave * 128;
        for (int k0 = 0; k0 < 128; k0 += 32) { float wv[32];
#pragma unroll
            for (int k = 0; k < 32; ++k) wv[k] = W[(size_t)(kb + k0 + k) * 6144];
#pragma unroll
            for (int k = 0; k < 32; ++k)
#pragma unroll
                for (int bi = 0; bi < 9; ++bi) acc[bi] += S9[bi * 1024 + kb + k0 + k] * wv[k]; }
#pragma unroll
        for (int bi = 0; bi < 9; ++bi) red[(wave * 9 + bi) * 64 + lane] = acc[bi];
        __syncthreads();
        for (int i = tid; i < 9 * 64; i += 512) { const int bi = i >> 6, l = i & 63; float sm = b_mod[L * 6144 + n0 + l];
#pragma unroll
            for (int w = 0; w < 8; ++w) sm += red[(w * 9 + bi) * 64 + l];
            ((float*)(ws + WS_MODV))[(size_t)(L * 9 + bi) * 6144 + n0 + l] = sm; }
        __syncthreads();
    }
}

__device__ __forceinline__ float* xrow_ptr(float* XL, float* XC, int row) { return row < TX ? XL + (size_t)row * D : XC + (size_t)(row - TX) * D; }
__device__ __forceinline__ int row_bi(int row) { return row < TX ? (row >> 11) : 8; }

__device__ __forceinline__ void norm_mod_store(const f32x4 (&v)[4], const float* g, const float* sh, const float* sc, bf16* orow, int lane) {
    float ss = 0.f;
#pragma unroll
    for (int j = 0; j < 4; ++j) ss += (v[j].x * v[j].x + v[j].y * v[j].y) + (v[j].z * v[j].z + v[j].w * v[j].w);
    const float rs = __builtin_amdgcn_rsqf(wave_sum(ss) * (1.0f / D) + EPSF);
#pragma unroll
    for (int j = 0; j < 4; ++j) { const int c = 4 * lane + 256 * j; const f32x4 gg = *(const f32x4*)(g + c), s1 = *(const f32x4*)(sc + c), s0 = *(const f32x4*)(sh + c);
        const f32x4 y = (v[j] * rs) * gg * (1.0f + s1) + s0;
        u32x2 w; w.x = pk2(y.x, y.y); w.y = pk2(y.z, y.w); *(u32x2*)(orow + c) = w; }
}

__device__ __forceinline__ void phase_norm1(const float* XL, const float* XC, const float* g, const float* modv, bf16* H, int nrows, int lane, int wave, int vcu, int G) {
    for (int row = vcu * 8 + wave; row < nrows; row += G * 8) {
        const f32x4* xr = (const f32x4*)(row < TX ? XL + (size_t)row * D : XC + (size_t)(row - TX) * D) + lane; f32x4 v[4];
#pragma unroll
        for (int j = 0; j < 4; ++j) v[j] = xr[64 * j];
        const float* mv = modv + row_bi(row) * 6144;
        norm_mod_store(v, g, mv, mv + 1024, H + (size_t)row * D, lane);
    }
}

__device__ __forceinline__ void phase_router(float* XL, float* XC, const float* g, const float* modv, bf16* H, const float* router_w, const float* router_bias,
                                             unsigned* cnt  , int* list, int* toki, float* tokw, int nrows,
                                             LAS unsigned char* lds, int tid, int lane, int wave, int vcu, int G, int probe) {
    LAS float* RW = (LAS float*)lds;
    LAS int* lcnt = (LAS int*)(lds + 65536);
    LAS int* rinfo = (LAS int*)(lds + 65536 + 256);
    for (int it = 0; it < 8; ++it) { const int idx = tid + 512 * it, k = idx >> 2, q = idx & 3; const f32x4 w = *(const f32x4*)(router_w + k * 16 + 4 * q);
        RW[(4 * q + 0) * 1024 + k] = w.x; RW[(4 * q + 1) * 1024 + k] = w.y; RW[(4 * q + 2) * 1024 + k] = w.z; RW[(4 * q + 3) * 1024 + k] = w.w; }
    if (tid < 32) lcnt[tid] = 0;
    __syncthreads();
    const int rpb = nrows / G, rpw = rpb / 8;
    const int gI = lane >> 4;
    const f32x4 rb = *(const f32x4*)(router_bias + 4 * gI);
    for (int rep = (probe ? 0 : 1); rep < 2; ++rep)
    for (int i0 = 0; i0 < rpw; i0 += 3) {
        asm volatile("" ::: "memory");
        f32x4 y[3][4];
#pragma unroll
        for (int r = 0; r < 3; ++r) {
            const int ii = (i0 + r < rpw) ? i0 + r : rpw - 1; const int row = vcu * rpb + wave * rpw + ii;
            const f32x4* xr = (const f32x4*)xrow_ptr(XL, XC, row) + lane; f32x4 v[4];
#pragma unroll
            for (int j = 0; j < 4; ++j) v[j] = xr[64 * j];
            const float* mv = modv + row_bi(row) * 6144 + 3072;
            float ss = 0.f;
#pragma unroll
            for (int j = 0; j < 4; ++j) ss += (v[j].x * v[j].x + v[j].y * v[j].y) + (v[j].z * v[j].z + v[j].w * v[j].w);
            const float rs = __builtin_amdgcn_rsqf(wave_sum(ss) * (1.0f / D) + EPSF);
#pragma unroll
            for (int j = 0; j < 4; ++j) { const int c = 4 * lane + 256 * j; const f32x4 gg = *(const f32x4*)(g + c), s1 = *(const f32x4*)(mv + 1024 + c), s0 = *(const f32x4*)(mv + c);
                y[r][j] = (v[j] * rs) * gg * (1.0f + s1) + s0;
                u32x2 w; w.x = cvtpk(y[r][j].x, y[r][j].y); w.y = cvtpk(y[r][j].z, y[r][j].w); *(u32x2*)(H + (size_t)row * D + c) = w; }
            __builtin_amdgcn_sched_barrier(0);
        }
        float p[3][16];
#pragma unroll
        for (int e = 0; e < 16; ++e) {
#pragma unroll
            for (int r = 0; r < 3; ++r) p[r][e] = 0.f;
#pragma unroll
            for (int j = 0; j < 4; ++j) { const f32x4 w = *(const LAS f32x4*)(RW + e * 1024 + 4 * lane + 256 * j);
#pragma unroll
                for (int r = 0; r < 3; ++r) p[r][e] += (y[r][j].x * w.x + y[r][j].y * w.y) + (y[r][j].z * w.z + y[r][j].w * w.w); }
#pragma unroll
            for (int r = 0; r < 3; ++r) asm volatile("" : "+v"(p[r][e])); }
#pragma unroll
        for (int r = 0; r < 3; ++r) {
            float q8[8], lg[4];
#pragma unroll
            for (int j = 0; j < 8; ++j) q8[j] = swap32_add(p[r][j], p[r][j + 8]);
#pragma unroll
            for (int j = 0; j < 4; ++j) lg[j] = row_sum(swap16_add(q8[j], q8[j + 4]));
            float sc[4], sel[4];
#pragma unroll
            for (int j = 0; j < 4; ++j) { sc[j] = 1.0f / (1.0f + __expf(-lg[j])); sel[j] = sc[j] + rb[j]; }
            int i1 = 0, i2 = 0; float m1 = -1e30f, m2 = -1e30f, w1 = 0.f, w2 = 0.f;
#pragma unroll
            for (int j = 0; j < 4; ++j) { const float t = sel[j];
                if (t > m1) { m2 = m1; i2 = i1; w2 = w1; m1 = t; i1 = j; w1 = sc[j]; } else if (t > m2) { m2 = t; i2 = j; w2 = sc[j]; } }
            const float gs = m1 + m2;
            const float g0 = readlane_f(gs, 0), g1 = readlane_f(gs, 16), g2 = readlane_f(gs, 32), g3 = readlane_f(gs, 48);
            int bg = 0; float bgs = g0; if (g1 > bgs) { bgs = g1; bg = 1; } if (g2 > bgs) { bgs = g2; bg = 2; } if (g3 > bgs) { bgs = g3; bg = 3; }
            bg = __builtin_amdgcn_readfirstlane(bg);
            const int e0 = 4 * bg + __builtin_amdgcn_readlane(i1, 16 * bg), e1 = 4 * bg + __builtin_amdgcn_readlane(i2, 16 * bg);
            const float w0 = readlane_f(w1, 16 * bg), w1s = readlane_f(w2, 16 * bg);
            const float wn = 1.0f / (w0 + w1s);
            if (lane == 0 && rep == 1 && i0 + r < rpw) { const int rl = wave * rpw + i0 + r;
                const int p0 = __hip_atomic_fetch_add(&lcnt[e0], 1, __ATOMIC_RELAXED, __HIP_MEMORY_SCOPE_WORKGROUP), p1 = __hip_atomic_fetch_add(&lcnt[e1], 1, __ATOMIC_RELAXED, __HIP_MEMORY_SCOPE_WORKGROUP);
                rinfo[rl * 6 + 0] = e0; rinfo[rl * 6 + 1] = p0; rinfo[rl * 6 + 2] = e1; rinfo[rl * 6 + 3] = p1;
                rinfo[rl * 6 + 4] = __builtin_bit_cast(int, w0 * wn); rinfo[rl * 6 + 5] = __builtin_bit_cast(int, w1s * wn); }
        }
    }
    __syncthreads();
    if (tid < 16) lcnt[16 + tid] = (int)__hip_atomic_fetch_add(cnt + 64 * tid, (unsigned)lcnt[tid], RLX_AGENT);
    __syncthreads();
    if (tid < rpb) { const int row = vcu * rpb + tid; const int e0 = rinfo[tid * 6 + 0], e1 = rinfo[tid * 6 + 2];
        const int p0 = lcnt[16 + e0] + rinfo[tid * 6 + 1], p1 = lcnt[16 + e1] + rinfo[tid * 6 + 3];
        list[(size_t)e0 * TALL + p0] = row; list[(size_t)e1 * TALL + p1] = row;
        toki[row * 4 + 0] = e0; toki[row * 4 + 1] = p0; toki[row * 4 + 2] = e1; toki[row * 4 + 3] = p1;
        tokw[row * 2 + 0] = __builtin_bit_cast(float, rinfo[tid * 6 + 4]); tokw[row * 2 + 1] = __builtin_bit_cast(float, rinfo[tid * 6 + 5]); }
    __syncthreads();
}

__device__ __forceinline__ int build_moe_table(const unsigned* cnt, LAS int* tab, int tid) {
    if (tid < 16) tab[RT_MAX + 1 + tid] = (int)__hip_atomic_load(cnt + 64 * tid, RLX_AGENT);
    __syncthreads();
    if (tid == 0) { int rt = 0;
        for (int e = 0; e < 16; ++e) { const int c = tab[RT_MAX + 1 + e]; const int nt = (c + 255) >> 8;
            for (int m = 0; m < nt; ++m) { if (rt < RT_MAX) tab[rt] = e | (m << 8); ++rt; } }
        tab[RT_MAX] = rt < RT_MAX ? rt : RT_MAX; }
    __syncthreads();
    return tab[RT_MAX];
}

__device__ __forceinline__ void phase_combine(float* XL, float* XC, const float* modv  , const bf16* YB, const unsigned* cnt, const int* toki, const float* tokw,
                                              bool final_layer, const float* gnext, const float* modv_next, bf16* H, int nrows, int lane, int wave, int vcu, int G, int probe) {
    int tiles = 0; if (lane < 16) tiles = ((int)__hip_atomic_load(cnt + 64 * lane, RLX_AGENT) + 255) >> 8;
    int incl = tiles;
#pragma unroll
    for (int o = 1; o < 16; o <<= 1) { const int t = __shfl_up(incl, o); if (lane >= o) incl += t; }
    const int mybase = (incl - tiles) * 256;
    for (int rep = (probe ? 0 : 1); rep < 2; ++rep)
    for (int row = vcu * 8 + wave; row < nrows; row += G * 8) {
        const int e0 = toki[row * 4 + 0], p0 = toki[row * 4 + 1], e1 = toki[row * 4 + 2], p1 = toki[row * 4 + 3];
        const float w0 = tokw[row * 2 + 0], w1 = tokw[row * 2 + 1];
        const int s0 = __shfl(mybase, e0) + p0, s1 = __shfl(mybase, e1) + p1;
        float* xp = xrow_ptr(XL, XC, row);
        const float* g2 = modv + row_bi(row) * 6144 + 5120;
        f32x4 v[4];
#pragma unroll
        for (int j = 0; j < 4; ++j) { const int c = 4 * lane + 256 * j;
            const u32x2 a = *(const u32x2*)(YB + (size_t)s0 * D + c), b = *(const u32x2*)(YB + (size_t)s1 * D + c);
            f32x4 y; y.x = w0 * bflo(a.x) + w1 * bflo(b.x); y.y = w0 * bfhi(a.x) + w1 * bfhi(b.x); y.z = w0 * bflo(a.y) + w1 * bflo(b.y); y.w = w0 * bfhi(a.y) + w1 * bfhi(b.y);
            v[j] = *(const f32x4*)(xp + c) + *(const f32x4*)(g2 + c) * y; }
        if (final_layer) {
            float ss = 0.f;
#pragma unroll
            for (int j = 0; j < 4; ++j) ss += (v[j].x * v[j].x + v[j].y * v[j].y) + (v[j].z * v[j].z + v[j].w * v[j].w);
            const float rs = __builtin_amdgcn_rsqf(wave_sum(ss) * (1.0f / D) + EPSF);
#pragma unroll
            for (int j = 0; j < 4; ++j) { const int c = 4 * lane + 256 * j; if (rep == 1) *(f32x4*)(xp + c) = (v[j] * rs) * *(const f32x4*)(gnext + c); }
        } else {
            if (rep == 1) {
#pragma unroll
            for (int j = 0; j < 4; ++j) *(f32x4*)(xp + 4 * lane + 256 * j) = v[j]; }
            const float* mv = modv_next + row_bi(row) * 6144;
            norm_mod_store(v, gnext, mv, mv + 1024, H + (size_t)row * D, lane);
        }
    }
}

__device__ __forceinline__ void phase_readout(const bf16* OF, const bf16* OB, const bf16* QKV2, const float* ng, bf16* AOUT, int nrows, int lane, int wave, int vcu, int G) {
    const f32x4 gg = *(const f32x4*)(ng + 4 * lane);
    for (int row = vcu * 8 + wave; row < nrows; row += G * 8) {
#pragma unroll
        for (int j = 0; j < 4; ++j) { const int c = 4 * lane + 256 * j;
            const u32x2 a = *(const u32x2*)(OF + (size_t)row * D + c), b = *(const u32x2*)(OB + (size_t)row * D + c), gt = *(const u32x2*)(QKV2 + (size_t)row * NGLA + 2048 + c);
            f32x4 o; o.x = bflo(a.x) + bflo(b.x); o.y = bfhi(a.x) + bfhi(b.x); o.z = bflo(a.y) + bflo(b.y); o.w = bfhi(a.y) + bfhi(b.y);
            const float ss = wave_sum((o.x * o.x + o.y * o.y) + (o.z * o.z + o.w * o.w));
            const float rs = __builtin_amdgcn_rsqf(ss * (1.0f / 256.0f) + EPSF);
            f32x4 gv; gv.x = silu_f(bflo(gt.x)); gv.y = silu_f(bfhi(gt.x)); gv.z = silu_f(bflo(gt.y)); gv.w = silu_f(bfhi(gt.y));
            const f32x4 y = (o * rs) * gg * gv;
            u32x2 w; w.x = pk2(y.x, y.y); w.y = pk2(y.z, y.w); *(u32x2*)(AOUT + (size_t)row * D + c) = w; }
    }
}

__device__ __forceinline__ int na_r0(int r) { int v = r - 4; return v < 0 ? 0 : (v > 24 ? 24 : v); }
template <int NMAPS, int DV, bool NA>
__device__ __forceinline__ void attn_unit(LAS unsigned char* lds, int tid, int lane, int wave,
                                          const bf16* QKV, int qcol, int qrow0, int kcol, int krow_lat, int krow_ctx, const bf16* VT, int klo, int khi,
                                          int r_wave, int xq0, const LAS float* biasT,
                                          bf16* AOUT, int ocol, float lam, const float* subg, float outscale) {
    constexpr int KB = 9216;
    constexpr int BUFSZ = NMAPS * KB + DV * 144;
    constexpr int NVB = DV / 16, NVR = DV / 64;
    const int fr = lane & 15, g = lane >> 4;
    bf16x8 qf[NMAPS][2];
    { const bf16* qp = QKV + (size_t)(qrow0 + wave * 16 + fr) * NATT + qcol + 8 * g;
#pragma unroll
      for (int m = 0; m < NMAPS; ++m)
#pragma unroll
          for (int s = 0; s < 2; ++s) qf[m][s] = *(const bf16x8*)(qp + m * 64 + 32 * s); }
    f32x4 O[NMAPS][NVB]; float mrun[NMAPS]; float lrun[NMAPS];
#pragma unroll
    for (int m = 0; m < NMAPS; ++m) { mrun[m] = -1e30f; lrun[m] = 0.f;
#pragma unroll
        for (int vb = 0; vb < NVB; ++vb) O[m][vb] = (f32x4){0.f, 0.f, 0.f, 0.f}; }
    const int ntiles = 4 + (khi - klo);
    u32x4 kreg[NMAPS], vreg[NVR];
    const int lkey = tid >> 3, lch = tid & 7;
#define AT_LOAD(i) do { const int _i = (i); const int _rowg = (_i < 4 ? krow_ctx + 64 * _i : krow_lat + 64 * (klo + _i - 4)) + lkey; const int _tok0 = (_i < 4 ? SEQ + 64 * _i : 64 * (klo + _i - 4)); \
        _Pragma("unroll") for (int m = 0; m < NMAPS; ++m) kreg[m] = *(const u32x4*)(QKV + (size_t)_rowg * NATT + kcol + m * 64 + lch * 8); \
        _Pragma("unroll") for (int j = 0; j < NVR; ++j) { const int idx = tid + 512 * j; vreg[j] = *(const u32x4*)(VT + (size_t)(idx >> 3) * NKEY + _tok0 + (idx & 7) * 8); } } while (0)
#define AT_STORE(b) do { LAS unsigned char* _p = lds + (b) * BUFSZ; \
        _Pragma("unroll") for (int m = 0; m < NMAPS; ++m) *(LAS u32x4*)(_p + m * KB + lkey * 144 + lch * 16) = kreg[m]; \
        _Pragma("unroll") for (int j = 0; j < NVR; ++j) { const int idx = tid + 512 * j; *(LAS u32x4*)(_p + NMAPS * KB + (idx >> 3) * 144 + (idx & 7) * 16) = vreg[j]; } } while (0)
    AT_LOAD(0); AT_STORE(0); __syncthreads();
    const int kbase0 = (8 * (fr >> 2) + (fr & 3)) * 144 + 16 * g;
    const int vbase = fr * 144 + 16 * g;
    int r0w = 0, xq = 0, tmask = 3, c0w = 0; float pen[4][4];
    if constexpr (NA) { r0w = na_r0(r_wave); xq = xq0 + fr; int cs = xq - 8; cs = cs < 0 ? 0 : (cs > 48 ? 48 : cs);
        c0w = xq0 - 8; c0w = c0w < 0 ? 0 : (c0w > 32 ? 32 : c0w);
        tmask = 1;
#pragma unroll
        for (int kb = 0; kb < 4; ++kb)
#pragma unroll
            for (int ii = 0; ii < 4; ++ii) { const int y = c0w + 32 * (kb >> 1) + 8 * g + 4 * (kb & 1) + ii; pen[kb][ii] = (y >= cs && y < cs + 16) ? 0.f : -1e30f; } }
    for (int i = 0; i < ntiles; ++i) {
        if (i + 1 < ntiles) AT_LOAD(i + 1);
        const LAS unsigned char* buf = lds + (i & 1) * BUFSZ;
        bool active = true; int kr = 0; bool local = false;
        if constexpr (NA) { if (i >= 4) { local = true; kr = klo + i - 4; active = (kr >= r0w) && (kr < r0w + 8); } }
        if (active) {
            const int tm = local ? tmask : 3;
            const int koffw = local ? c0w * 144 : 0, voffw = local ? c0w * 2 : 0;
            bf16x8 kf[NMAPS][4][2];
#pragma unroll
            for (int m = 0; m < NMAPS; ++m)
#pragma unroll
                for (int kb = 0; kb < 4; ++kb)
#pragma unroll
                    for (int s = 0; s < 2; ++s) kf[m][kb][s] = *(const LAS bf16x8*)(buf + m * KB + kbase0 + koffw + (kb & 1) * (4 * 144) + (kb >> 1) * (32 * 144) + s * 64);
            __builtin_amdgcn_sched_barrier(0);
            f32x4 S[NMAPS][4];
#pragma unroll
            for (int m = 0; m < NMAPS; ++m)
#pragma unroll
                for (int kb = 0; kb < 4; ++kb) { S[m][kb] = (f32x4){0.f, 0.f, 0.f, 0.f};
                    if (!NA || (tm >> (kb >> 1)) & 1) {
#pragma unroll
                        for (int s = 0; s < 2; ++s) S[m][kb] = __builtin_amdgcn_mfma_f32_16x16x32_bf16(kf[m][kb][s], qf[m][s], S[m][kb], 0, 0, 0); } }
            bf16x8 vf0[4][2];
#pragma unroll
            for (int vb = 0; vb < 4; ++vb)
#pragma unroll
                for (int t = 0; t < 2; ++t) vf0[vb][t] = *(const LAS bf16x8*)(buf + NMAPS * KB + vbase + voffw + vb * (16 * 144) + t * 64);
            __builtin_amdgcn_sched_barrier(0);
            bf16x8 pf[NMAPS][2];
#pragma unroll
            for (int m = 0; m < NMAPS; ++m) {
                if constexpr (NA) { if (local) {
                        const LAS float* bp = biasT + (kr - r_wave + 7) * 31 + (c0w + 8 * g - xq + 15);
#pragma unroll
                        for (int kb = 0; kb < 4; ++kb)
#pragma unroll
                            for (int ii = 0; ii < 4; ++ii) { const float t = (tm >> (kb >> 1)) & 1 ? (S[m][kb][ii] + pen[kb][ii]) + bp[32 * (kb >> 1) + 4 * (kb & 1) + ii] : -1e30f; S[m][kb][ii] = t; } } }
                float mx = fmaxf(fmaxf(S[m][0][0], S[m][0][1]), fmaxf(S[m][0][2], S[m][0][3]));
#pragma unroll
                for (int kb = 1; kb < 4; ++kb) mx = fmaxf(fmaxf(mx, S[m][kb][0]), fmaxf(fmaxf(S[m][kb][1], S[m][kb][2]), S[m][kb][3]));
                mx = swap32_max(swap16_max(mx));
                if (__any(mx > mrun[m] + 8.0f)) {
                    const float mnew = fmaxf(mrun[m], mx), alpha = fexp2(mrun[m] - mnew); mrun[m] = mnew; lrun[m] = lrun[m] * alpha;
#pragma unroll
                    for (int vb = 0; vb < NVB; ++vb) O[m][vb] = O[m][vb] * alpha;
                }
                const float mm = mrun[m];
                unsigned pw[8]; float l0 = 0.f, l1 = 0.f;
#pragma unroll
                for (int kb = 0; kb < 4; ++kb) { const float a0 = fexp2(S[m][kb][0] - mm), a1 = fexp2(S[m][kb][1] - mm), a2 = fexp2(S[m][kb][2] - mm), a3 = fexp2(S[m][kb][3] - mm);
                    l0 += a0 + a1; l1 += a2 + a3;
                    pw[2 * kb] = cvtpk(a0, a1); pw[2 * kb + 1] = cvtpk(a2, a3); }
                lrun[m] += l0 + l1;
                pf[m][0] = __builtin_bit_cast(bf16x8, (u32x4){pw[0], pw[1], pw[2], pw[3]});
                pf[m][1] = __builtin_bit_cast(bf16x8, (u32x4){pw[4], pw[5], pw[6], pw[7]});
            }
            __builtin_amdgcn_sched_barrier(0);
            if constexpr (NVB == 8) {
                bf16x8 vf1[4][2];
#pragma unroll
                for (int vb = 0; vb < 4; ++vb)
#pragma unroll
                    for (int t = 0; t < 2; ++t) vf1[vb][t] = *(const LAS bf16x8*)(buf + NMAPS * KB + vbase + (4 + vb) * (16 * 144) + t * 64);
                __builtin_amdgcn_sched_barrier(0);
#pragma unroll
                for (int vb = 0; vb < 4; ++vb)
#pragma unroll
                    for (int t = 0; t < 2; ++t)
#pragma unroll
                        for (int m = 0; m < NMAPS; ++m) O[m][vb] = __builtin_amdgcn_mfma_f32_16x16x32_bf16(vf0[vb][t], pf[m][t], O[m][vb], 0, 0, 0);
                __builtin_amdgcn_sched_barrier(0);
#pragma unroll
                for (int vb = 0; vb < 4; ++vb)
#pragma unroll
                    for (int t = 0; t < 2; ++t)
#pragma unroll
                        for (int m = 0; m < NMAPS; ++m) O[m][4 + vb] = __builtin_amdgcn_mfma_f32_16x16x32_bf16(vf1[vb][t], pf[m][t], O[m][4 + vb], 0, 0, 0);
            } else {
#pragma unroll
                for (int vb = 0; vb < 4; ++vb)
#pragma unroll
                    for (int t = 0; t < 2; ++t) { if (!NA || (tm >> t) & 1) {
#pragma unroll
                            for (int m = 0; m < NMAPS; ++m) O[m][vb] = __builtin_amdgcn_mfma_f32_16x16x32_bf16(vf0[vb][t], pf[m][t], O[m][vb], 0, 0, 0); } }
            }
            __builtin_amdgcn_sched_barrier(0);
        }
        if (i + 1 < ntiles) AT_STORE((i + 1) & 1);
        __syncthreads();
    }
#undef AT_LOAD
#undef AT_STORE
    float inv[NMAPS];
#pragma unroll
    for (int m = 0; m < NMAPS; ++m) { float l = lrun[m]; l = swap16_add(l, l); l = swap32_add(l, l); inv[m] = 1.0f / l; }
    const int orow = qrow0 + wave * 16 + fr;
    if constexpr (NMAPS == 2) {
        float ss = 0.f; const float i1 = inv[0], i2 = lam * inv[1];
#pragma unroll
        for (int vb = 0; vb < NVB; ++vb) { O[0][vb] = O[0][vb] * i1 - O[1][vb] * i2; const f32x4 o = O[0][vb]; ss += (o.x * o.x + o.y * o.y) + (o.z * o.z + o.w * o.w); }
        ss = swap16_add(ss, ss); ss = swap32_add(ss, ss);
        const float rs = __builtin_amdgcn_rsqf(ss * (1.0f / DV) + EPSF) * outscale;
#pragma unroll
        for (int vb = 0; vb < NVB; ++vb) { const f32x4 gg = *(const f32x4*)(subg + 16 * vb + 4 * g); const f32x4 y = O[0][vb] * rs * gg;
            u32x2 w; w.x = cvtpk(y.x, y.y); w.y = cvtpk(y.z, y.w); *(u32x2*)(AOUT + (size_t)orow * D + ocol + 16 * vb + 4 * g) = w; }
    } else {
#pragma unroll
        for (int vb = 0; vb < NVB; ++vb) { const f32x4 y = O[0][vb] * inv[0];
            u32x2 w; w.x = cvtpk(y.x, y.y); w.y = cvtpk(y.z, y.w); *(u32x2*)(AOUT + (size_t)orow * D + ocol + 16 * vb + 4 * g) = w; }
    }
}


typedef float f32x16 __attribute__((ext_vector_type(16)));
__device__ __forceinline__ void diff_unit32(LAS unsigned char* lds, int tid, int lane, int wave,
                                            const bf16* QKV, int qcol, int qrow0, int kcol, int krow_lat, int krow_ctx, const bf16* VT, int khi,
                                            bf16* AOUT, int ocol, float lam, const float* subg, float outscale) {
    constexpr int KB = 9216, VOFF = 2 * KB, BUFSZ = 2 * KB + 128 * 144;
    const int r = lane & 31, hf = lane >> 5, map = wave >> 2, wq = wave & 3;
    const int swz = ((r >> 4) & 1) << 2;
    bf16x8 qf[4];
    { const bf16* qp = QKV + (size_t)(qrow0 + 32 * wq + r) * NATT + qcol + map * 64 + 8 * hf;
#pragma unroll
      for (int ks = 0; ks < 4; ++ks) qf[ks] = *(const bf16x8*)(qp + 16 * ks); }
    f32x16 O[4];
#pragma unroll
    for (int blk = 0; blk < 4; ++blk)
#pragma unroll
        for (int i = 0; i < 16; ++i) O[blk][i] = 0.f;
    float negm = 0.f, lrun = 0.f;
    const int ntiles = 4 + khi;
    u32x4 kreg[2], vreg[2];
    const int lkey = tid >> 3, lch = tid & 7;
    const int kst = lkey * 144 + ((lch ^ (((lkey >> 4) & 1) << 2)) * 16);
#define D32_LOAD(i) do { const int _i = (i); const int _rowg = (_i < 4 ? krow_ctx + 64 * _i : krow_lat + 64 * (_i - 4)) + lkey; const int _tok0 = (_i < 4 ? SEQ + 64 * _i : 64 * (_i - 4)); \
        _Pragma("unroll") for (int m = 0; m < 2; ++m) kreg[m] = *(const u32x4*)(QKV + (size_t)_rowg * NATT + kcol + m * 64 + lch * 8); \
        _Pragma("unroll") for (int j = 0; j < 2; ++j) { const int idx = tid + 512 * j; vreg[j] = *(const u32x4*)(VT + (size_t)(idx >> 3) * NKEY + _tok0 + (idx & 7) * 8); } } while (0)
#define D32_STORE(b) do { LAS unsigned char* _p = lds + (b) * BUFSZ; \
        _Pragma("unroll") for (int m = 0; m < 2; ++m) *(LAS u32x4*)(_p + m * KB + kst) = kreg[m]; \
        _Pragma("unroll") for (int j = 0; j < 2; ++j) { const int idx = tid + 512 * j, vr = idx >> 3; *(LAS u32x4*)(_p + VOFF + vr * 144 + (((idx & 7) ^ (((vr >> 4) & 1) << 2)) * 16)) = vreg[j]; } } while (0)
    D32_LOAD(0); D32_STORE(0); D32_STORE(2); __syncthreads();
    const int krow = (r & 0x13) | ((r & 4) << 1) | ((r & 8) >> 1);
    const int kbase = map * KB + krow * 144, vbase = VOFF + r * 144;
    bf16x8 pfp[2][2];
#pragma unroll
    for (int kb = 0; kb < 2; ++kb)
#pragma unroll
        for (int sx = 0; sx < 2; ++sx) pfp[kb][sx] = (bf16x8){0, 0, 0, 0, 0, 0, 0, 0};
    int slot = 0;
    for (int i = 0; i < ntiles; ++i) {
        if (i + 1 < ntiles) D32_LOAD(i + 1);
        const int slotn = slot == 2 ? 0 : slot + 1, slotp = slot == 0 ? 2 : slot - 1;
        const LAS unsigned char* buf = lds + slot * BUFSZ; const LAS unsigned char* bufp = lds + slotp * BUFSZ;
        f32x16 S[2];
#pragma unroll
        for (int kb = 0; kb < 2; ++kb) {
#pragma unroll
            for (int ii = 0; ii < 16; ++ii) S[kb][ii] = negm;
#pragma unroll
            for (int ks = 0; ks < 4; ++ks) { const bf16x8 kf = *(const LAS bf16x8*)(buf + kbase + kb * (32 * 144) + (((2 * ks + hf) ^ swz) * 16));
                S[kb] = __builtin_amdgcn_mfma_f32_32x32x16_bf16(kf, qf[ks], S[kb], 0, 0, 0); } }
        __builtin_amdgcn_sched_barrier(0);
        float mx = -1e30f;
#pragma unroll
        for (int kb = 0; kb < 2; ++kb)
#pragma unroll
            for (int ii = 0; ii < 16; ii += 4) mx = fmaxf(fmaxf(mx, S[kb][ii]), fmaxf(fmaxf(S[kb][ii + 1], S[kb][ii + 2]), S[kb][ii + 3]));
        mx = swap32_max(mx);
        const bool resc = (i == 0) || __any(mx > 8.0f);
        float alpha = 1.0f;
        if (resc) { const float dlt = (i == 0) ? mx : fmaxf(mx, 0.f); alpha = fexp2(-dlt); negm -= dlt; lrun *= alpha;
#pragma unroll
            for (int kb = 0; kb < 2; ++kb)
#pragma unroll
                for (int ii = 0; ii < 16; ++ii) S[kb][ii] -= dlt; }
        __builtin_amdgcn_sched_barrier(0);
        bf16x8 pf[2][2]; float l0 = 0.f, l1 = 0.f;
#pragma unroll
        for (int kb = 0; kb < 2; ++kb)
#pragma unroll
            for (int sx = 0; sx < 2; ++sx) { unsigned pw[4];
#pragma unroll
                for (int j = 0; j < 4; ++j) { const float a0 = fexp2(S[kb][8 * sx + 2 * j]), a1 = fexp2(S[kb][8 * sx + 2 * j + 1]); l0 += a0; l1 += a1; pw[j] = cvtpk(a0, a1); }
                pf[kb][sx] = __builtin_bit_cast(bf16x8, (u32x4){pw[0], pw[1], pw[2], pw[3]}); }
        lrun += l0 + l1;
#pragma unroll
        for (int blk = 0; blk < 4; ++blk)
#pragma unroll
            for (int kb = 0; kb < 2; ++kb)
#pragma unroll
                for (int sx = 0; sx < 2; ++sx) { const bf16x8 vf = *(const LAS bf16x8*)(bufp + vbase + blk * (32 * 144) + (((4 * kb + 2 * sx + hf) ^ swz) * 16));
                    O[blk] = __builtin_amdgcn_mfma_f32_32x32x16_bf16(vf, pfp[kb][sx], O[blk], 0, 0, 0); }
#pragma unroll
        for (int k = 0; k < 16; ++k) { __builtin_amdgcn_sched_group_barrier(0x100, 1, 0); __builtin_amdgcn_sched_group_barrier(0x008, 1, 0); __builtin_amdgcn_sched_group_barrier(0x400, 2, 0); __builtin_amdgcn_sched_group_barrier(0x002, 4, 0); }
        __builtin_amdgcn_sched_barrier(0);
        if (resc) {
#pragma unroll
            for (int blk = 0; blk < 4; ++blk) O[blk] = O[blk] * alpha; }
#pragma unroll
        for (int kb = 0; kb < 2; ++kb)
#pragma unroll
            for (int sx = 0; sx < 2; ++sx) pfp[kb][sx] = pf[kb][sx];
        if (i + 1 < ntiles) D32_STORE(slotn);
        slot = slotn;
        __syncthreads();
    }
    { const LAS unsigned char* bufp = lds + (slot == 0 ? 2 : slot - 1) * BUFSZ;
#pragma unroll
      for (int blk = 0; blk < 4; ++blk)
#pragma unroll
          for (int kb = 0; kb < 2; ++kb)
#pragma unroll
              for (int sx = 0; sx < 2; ++sx) { const bf16x8 vf = *(const LAS bf16x8*)(bufp + vbase + blk * (32 * 144) + (((4 * kb + 2 * sx + hf) ^ swz) * 16));
                  O[blk] = __builtin_amdgcn_mfma_f32_32x32x16_bf16(vf, pfp[kb][sx], O[blk], 0, 0, 0); } }
    __syncthreads();
#undef D32_LOAD
#undef D32_STORE
    float l = lrun; l = swap32_add(l, l); const float inv = 1.0f / l;
    LAS float* X = (LAS float*)lds + (size_t)wq * 4096 + lane;
    if (map == 1) {
#pragma unroll
        for (int blk = 0; blk < 4; ++blk)
#pragma unroll
            for (int i = 0; i < 16; ++i) X[(blk * 16 + i) * 64] = O[blk][i] * inv;
    }
    __syncthreads();
    if (map == 0) {
        float ss = 0.f;
#pragma unroll
        for (int blk = 0; blk < 4; ++blk)
#pragma unroll
            for (int i = 0; i < 16; ++i) { const float o = O[blk][i] * inv - lam * X[(blk * 16 + i) * 64]; O[blk][i] = o; ss += o * o; }
        ss = swap32_add(ss, ss);
        const float rs = __builtin_amdgcn_rsqf(ss * (1.0f / 128.0f) + EPSF) * outscale;
        bf16* op = AOUT + (size_t)(qrow0 + 32 * wq + r) * D + ocol + 4 * hf;
#pragma unroll
        for (int blk = 0; blk < 4; ++blk)
#pragma unroll
            for (int g4 = 0; g4 < 4; ++g4) { const int dv0 = 32 * blk + 8 * g4; const f32x4 gg = *(const f32x4*)(subg + dv0 + 4 * hf);
                u32x2 w; w.x = cvtpk(O[blk][4 * g4] * rs * gg.x, O[blk][4 * g4 + 1] * rs * gg.y); w.y = cvtpk(O[blk][4 * g4 + 2] * rs * gg.z, O[blk][4 * g4 + 3] * rs * gg.w);
                *(u32x2*)(op + dv0) = w; }
    }
    __syncthreads();
}

__device__ __forceinline__ void phase_attention(const bf16* QKV, const bf16* VAT, const bf16* VBT, bf16* AOUT, const float* lamp  , float lam_init, const float* subg, const float* nab  ,
                                                unsigned* naq, const ConvPtrs& CP, int clo, int chi, LAS unsigned char* lds, int tid, int lane, int wave) {
    LAS float* biasT = (LAS float*)(lds + LX_BIAS) + 64;
    constexpr int NATT_U = 576 + 1152;
    const int ncu = (chi - clo + CV_UNIT - 1) / CV_UNIT, nq = NATT_U + ncu;
    int mine = 0; if (tid == 0) mine = (int)__hip_atomic_fetch_add(naq, 1u, RLX_AGENT);
    for (;;) {
        __syncthreads();
        if (tid == 0) *(LAS int*)(lds + LX_MISC + 64) = mine;
        __syncthreads();
        const int q = *(LAS int*)(lds + LX_MISC + 64);
        if (q >= nq) break;
        if (tid == 0) mine = (int)__hip_atomic_fetch_add(naq, 1u, RLX_AGENT);
        const int ai = (int)(((long)q * NATT_U) / nq); const bool isatt = (int)(((long)(q + 1) * NATT_U) / nq) > ai;
        if (!isatt) { conv_unit(CP, clo + (q - ai) * CV_UNIT, chi, lds, lane, wave); continue; }
        if (ai < 512 || (ai >= 1536 && ai < 1600)) {
            int bh, qrow0, khi;
            if (ai < 512) { bh = ai >> 4; const int qt = ai & 15; qrow0 = (bh >> 2) * SEQ + qt * 128; khi = 32; }
            else { const int u = ai - 1536; bh = u >> 1; const int qt = u & 1; qrow0 = TX + (bh >> 2) * CTXL + qt * 128; khi = 0; }
            const int b = bh >> 2, h = bh & 3;
            const float lam = __expf(wave_sum(lamp[lane] * lamp[64 + lane])) - __expf(wave_sum(lamp[128 + lane] * lamp[192 + lane])) + lam_init;
            diff_unit32(lds, tid, lane, wave, QKV, h * 128, qrow0, 512 + h * 128, b * SEQ, TX + b * CTXL, VAT + (size_t)bh * 128 * NKEY, khi,
                        AOUT, h * 128, lam, subg, 1.0f - lam_init);
        } else {
            int bh, qrow0, klo, khi, rw;
            if (ai < 1536) { const int u = ai - 512; bh = u >> 4; const int rp = u & 15; qrow0 = (bh >> 3) * SEQ + rp * 128; klo = na_r0(2 * rp); khi = na_r0(2 * rp + 1) + 8; rw = 2 * rp + (wave >> 2); }
            else { const int u = ai - 1600; bh = u >> 1; const int qt = u & 1; qrow0 = TX + (bh >> 3) * CTXL + qt * 128; klo = 0; khi = 0; rw = 0; }
            const int b = bh >> 3, h = bh & 7;
            for (int i = tid; i < 640; i += 512) { const int k = i - 64; biasT[k] = (k >= 0 && k < 465) ? nab[h * 465 + k] * LOG2E : 0.f; }
            attn_unit<1, 64, true>(lds, tid, lane, wave, QKV, 1536 + h * 64, qrow0, 2048 + h * 64, b * SEQ, TX + b * CTXL, VBT + (size_t)bh * 64 * NKEY, klo, khi,
                                   rw, 16 * (wave & 3), biasT, AOUT, 512 + h * 64, 0.f, nullptr, 1.0f);
        }
    }
}

__device__ __forceinline__ void gla_chunk_rows(int b, int dir, int n, int& row0, int& tok0) {
    if (n < 4) { const int cc = dir ? 3 - n : n; row0 = TX + b * CTXL + 64 * cc; tok0 = SEQ + 64 * cc; } else { const int lc = dir ? 35 - n : n - 4; row0 = b * SEQ + 64 * lc; tok0 = 64 * lc; }
}
constexpr int GP_QM = 0, GP_KM = 17408, GP_VT = 34816, GP_LR = 71680, GP_SEG = 75776;
__device__ __forceinline__ void phase_gla_prep(const bf16* QKV2, const bf16* VGT, const float* wgate  , const float* bgate  ,
                                               bf16* QG, bf16* KET, float* FACD, bf16* OF, bf16* OB,
                                               LAS unsigned char* lds, int tid, int lane, int wave, int vcu, int G) {
    const int fr = lane & 15, g = lane >> 4;
    const int d = tid & 127, seg = tid >> 7;
    LAS float* LR = (LAS float*)(lds + GP_LR);
    LAS float* SEG = (LAS float*)(lds + GP_SEG);
    for (int ub = vcu * 9; ub < 2304; ub += G * 9) {
        const int q = ub / 36, n0 = ub % 36, dir = q & 1, hh = (q >> 1) & 3, b = q >> 3;
        bf16* OUT = dir ? OB : OF;
        float wg[16];
#pragma unroll
        for (int r = 0; r < 16; ++r) wg[r] = wgate[(dir * 16 + r) * 512 + hh * 128 + d];
        const float bgv = bgate[dir * 512 + hh * 128 + d];
        const bf16* vtb = VGT + (size_t)(b * 4 + hh) * 256 * NKEY;
        u32x4 qr[2], kr[2], vr[4], lr4;
#define GP_LOAD(n) do { int _row0, _tok0; gla_chunk_rows(b, dir, (n), _row0, _tok0); \
        _Pragma("unroll") for (int j = 0; j < 2; ++j) { const int idx = tid + 512 * j, p = idx >> 4, ch = idx & 15; const bf16* src = QKV2 + (size_t)(_row0 + p) * NGLA + hh * 128 + ch * 8; qr[j] = *(const u32x4*)src; kr[j] = *(const u32x4*)(src + 512); } \
        _Pragma("unroll") for (int j = 0; j < 4; ++j) { const int idx = tid + 512 * j; vr[j] = *(const u32x4*)(vtb + (size_t)(idx >> 3) * NKEY + _tok0 + (idx & 7) * 8); } \
        if (tid < 128) lr4 = *(const u32x4*)(QKV2 + (size_t)(_row0 + (tid >> 1)) * NGLA + 3072 + dir * 16 + (tid & 1) * 8); } while (0)
#define GP_N(i) (dir ? ((i) < 4 ? 3 - (i) : 39 - (i)) : (i))
        GP_LOAD(GP_N(n0));
        for (int k9 = 0; k9 < 9; ++k9) {
            const int n = GP_N(n0 + k9), u = ub - n0 + n; int row0, tok0; gla_chunk_rows(b, dir, n, row0, tok0);
#pragma unroll
            for (int j = 0; j < 2; ++j) { const int idx = tid + 512 * j, p = idx >> 4, ch = idx & 15;
                *(LAS u32x4*)(lds + GP_QM + p * 272 + ch * 16) = qr[j]; *(LAS u32x4*)(lds + GP_KM + p * 272 + ch * 16) = kr[j]; }
#pragma unroll
            for (int j = 0; j < 4; ++j) { const int idx = tid + 512 * j; *(LAS u32x4*)(lds + GP_VT + (idx >> 3) * 144 + (idx & 7) * 16) = vr[j]; }
            if (tid < 128) { LAS float* lp = LR + (tid >> 1) * 16 + (tid & 1) * 8;
                lp[0] = bflo(lr4.x); lp[1] = bfhi(lr4.x); lp[2] = bflo(lr4.y); lp[3] = bfhi(lr4.y); lp[4] = bflo(lr4.z); lp[5] = bfhi(lr4.z); lp[6] = bflo(lr4.w); lp[7] = bfhi(lr4.w); }
            __syncthreads();
            if (k9 + 1 < 9) GP_LOAD(GP_N(n0 + k9 + 1));
            float gc[16];
#pragma unroll
            for (int pi = 0; pi < 16; ++pi) { const LAS f32x4* lp = (const LAS f32x4*)(LR + (16 * seg + pi) * 16); float z = bgv;
#pragma unroll
                for (int k = 0; k < 4; ++k) { const f32x4 l4 = lp[k]; z += l4.x * wg[4 * k] + l4.y * wg[4 * k + 1] + l4.z * wg[4 * k + 2] + l4.w * wg[4 * k + 3]; }
                const float az = fabsf(z); gc[pi] = (fminf(z, 0.f) - flog(1.0f + fexp(-az))) * 0.0625f; }
            float run = 0.f;
            if (dir == 0) {
#pragma unroll
                for (int pi = 0; pi < 16; ++pi) { run += gc[pi]; gc[pi] = run; }
            } else {
#pragma unroll
                for (int pi = 15; pi >= 0; --pi) { run += gc[pi]; gc[pi] = run; }
            }
            SEG[seg * 128 + d] = run;
            __syncthreads();
            const float t0 = SEG[d], t1 = SEG[128 + d], t2 = SEG[256 + d], t3 = SEG[384 + d];
            float off, gmid; const float gend = (t0 + t1) + (t2 + t3);
            if (dir == 0) { off = (seg > 0 ? t0 : 0.f) + (seg > 1 ? t1 : 0.f) + (seg > 2 ? t2 : 0.f); gmid = t0 + t1; }
            else { off = (seg < 3 ? t3 : 0.f) + (seg < 2 ? t2 : 0.f) + (seg < 1 ? t1 : 0.f); gmid = t3 + t2; }
            const float emid = fexp(gmid), eend = fexp(gend - gmid);
            unsigned kep[8];
            bf16* qgp = QG + ((size_t)u * 64 + 16 * seg) * 128 + d;
#pragma unroll
            for (int pi = 0; pi < 16; ++pi) { const int p = 16 * seg + pi; const float rel = off + gc[pi] - gmid; const float Ep = fexp(rel), Ei = fexp(-rel);
                LAS bf16* qa = (LAS bf16*)(lds + GP_QM) + p * 136 + d; LAS bf16* ka = (LAS bf16*)(lds + GP_KM) + p * 136 + d;
                const float qv = bf2f(*qa), kv = bf2f(*ka);
                const float qm = qv * Ep, km = kv * Ei;
                const unsigned w1 = cvtpk(qm, qm * emid), w2 = cvtpk(km, km * eend);
                *qa = (bf16)(w1 & 0xffffu); qgp[pi * 128] = (bf16)(w1 >> 16); *ka = (bf16)(w2 & 0xffffu);
                if (pi & 1) kep[pi >> 1] |= (w2 & 0xffff0000u); else kep[pi >> 1] = w2 >> 16; }
            { u32x4* kt = (u32x4*)(KET + ((size_t)u * 128 + d) * 64 + 16 * seg); kt[0] = (u32x4){kep[0], kep[1], kep[2], kep[3]}; kt[1] = (u32x4){kep[4], kep[5], kep[6], kep[7]}; }
            if (seg == 0) FACD[(size_t)u * 128 + d] = fexp(gend);
            __syncthreads();
            { const int cb = wave & 3, half = wave >> 2;
              bf16x8 qfr[4];
#pragma unroll
              for (int ks = 0; ks < 4; ++ks) qfr[ks] = *(const LAS bf16x8*)(lds + GP_QM + (16 * cb + fr) * 272 + (8 * g + 32 * ks) * 2);
              f32x4 AT[4];
#pragma unroll
              for (int sb = 0; sb < 4; ++sb) { AT[sb] = (f32x4){0.f, 0.f, 0.f, 0.f};
#pragma unroll
                  for (int ks = 0; ks < 4; ++ks) { const bf16x8 af = *(const LAS bf16x8*)(lds + GP_KM + (16 * sb + fr) * 272 + (8 * g + 32 * ks) * 2);
                      AT[sb] = __builtin_amdgcn_mfma_f32_16x16x32_bf16(af, qfr[ks], AT[sb], 0, 0, 0); }
                  const int c = 16 * cb + fr;
#pragma unroll
                  for (int ii = 0; ii < 4; ++ii) { const int sp = 16 * sb + 4 * g + ii; const bool keep = dir ? (sp >= c) : (sp <= c); AT[sb][ii] = keep ? AT[sb][ii] : 0.f; } }
              bf16x8 pf[2];
#pragma unroll
              for (int t = 0; t < 2; ++t) { u32x4 w; w.x = pk2(AT[2 * t][0], AT[2 * t][1]); w.y = pk2(AT[2 * t][2], AT[2 * t][3]); w.z = pk2(AT[2 * t + 1][0], AT[2 * t + 1][1]); w.w = pk2(AT[2 * t + 1][2], AT[2 * t + 1][3]);
                  pf[t] = __builtin_bit_cast(bf16x8, w); }
#pragma unroll
              for (int v8 = 0; v8 < 8; ++v8) { const int vb = 8 * half + v8; f32x4 Oa = (f32x4){0.f, 0.f, 0.f, 0.f};
#pragma unroll
                  for (int t = 0; t < 2; ++t) { const LAS unsigned char* vp = lds + GP_VT + (16 * vb + fr) * 144 + (32 * t + 4 * g) * 2;
                      const u32x2 lo = *(const LAS u32x2*)vp, hi = *(const LAS u32x2*)(vp + 32);
                      u32x4 w; w.x = lo.x; w.y = lo.y; w.z = hi.x; w.w = hi.y;
                      Oa = __builtin_amdgcn_mfma_f32_16x16x32_bf16(__builtin_bit_cast(bf16x8, w), pf[t], Oa, 0, 0, 0); }
                  u32x2 w; w.x = pk2(Oa[0], Oa[1]); w.y = pk2(Oa[2], Oa[3]);
                  *(u32x2*)(OUT + (size_t)(row0 + 16 * cb + fr) * D + hh * 256 + 16 * vb + 4 * g) = w; }
            }
            __syncthreads();
        }
#undef GP_LOAD
#undef GP_N
    }
}

constexpr int GS_BUF = 45056, GS_QG = 0, GS_KET = 17408, GS_VT = 35840, GS_ST = 2 * GS_BUF, GS_DEC = GS_ST + 2 * 17408;
__device__ __forceinline__ void phase_gla(const bf16* VGT, bf16* OF, bf16* OB, const bf16* QG, const bf16* KET, const float* FACD,
                                          LAS unsigned char* lds, int tid, int lane, int wave, int vcu, int G) {
    const int fr = lane & 15, g = lane >> 4;
    for (int u = vcu; u < 256; u += G) {
        const int slab = u & 3, dir = (u >> 2) & 1, hh = (u >> 3) & 3, b = u >> 5;
        bf16* OUT = dir ? OB : OF;
        const int upb = ((b * 4 + hh) * 2 + dir) * 36;
        f32x4 Sacc[4];
#pragma unroll
        for (int vb = 0; vb < 4; ++vb) Sacc[vb] = (f32x4){0.f, 0.f, 0.f, 0.f};
        for (int i = tid; i < 17408 / 4; i += 512) ((LAS unsigned*)(lds + GS_ST))[i] = 0u;
        const bf16* vtb = VGT + ((size_t)(b * 4 + hh) * 256 + slab * 64) * NKEY;
        const int cb = wave & 3, vh = wave >> 2;
        const int ocol = hh * 256 + slab * 64 + 32 * vh + 4 * g;
        struct GsRegs { u32x4 qg[2], ket[2], v; u32x2 oi[2]; float dec; };
        GsRegs R0, R1; R0.dec = 0.f; R1.dec = 0.f;
#define GS_LOAD(R, n) do { int _row0, _tok0; gla_chunk_rows(b, dir, (n), _row0, _tok0); const size_t _u = (size_t)(upb + (n)); \
        _Pragma("unroll") for (int j = 0; j < 2; ++j) { const int idx = tid + 512 * j; R.qg[j] = *(const u32x4*)(QG + _u * 8192 + idx * 8); R.ket[j] = *(const u32x4*)(KET + _u * 8192 + idx * 8); } \
        R.v = *(const u32x4*)(vtb + (size_t)(tid >> 3) * NKEY + _tok0 + (tid & 7) * 8); \
        if (tid < 128) R.dec = FACD[_u * 128 + tid]; \
        _Pragma("unroll") for (int v2 = 0; v2 < 2; ++v2) R.oi[v2] = *(const u32x2*)(OUT + (size_t)(_row0 + 16 * cb + fr) * D + ocol + 16 * v2); } while (0)
#define GS_STORE(R, bf) do { LAS unsigned char* _p = lds + (bf) * GS_BUF; \
        _Pragma("unroll") for (int j = 0; j < 2; ++j) { const int idx = tid + 512 * j; *(LAS u32x4*)(_p + GS_QG + (idx >> 4) * 272 + (idx & 15) * 16) = R.qg[j]; *(LAS u32x4*)(_p + GS_KET + (idx >> 3) * 144 + (idx & 7) * 16) = R.ket[j]; } \
        *(LAS u32x4*)(_p + GS_VT + (tid >> 3) * 144 + (tid & 7) * 16) = R.v; \
        if (tid < 128) ((LAS float*)(lds + GS_DEC))[(bf) * 128 + tid] = R.dec; } while (0)
#define GS_ITER(n, RN, RF) do { const int _n = (n); int row0, tok0; gla_chunk_rows(b, dir, _n, row0, tok0); const int cur = _n & 1; \
            if (_n + 2 < 36) GS_LOAD(RF, _n + 2); \
            const LAS unsigned char* bufp = lds + cur * GS_BUF; const LAS unsigned char* stp = lds + GS_ST + cur * 17408; \
            { bf16x8 qfr[4]; \
              _Pragma("unroll") for (int ks = 0; ks < 4; ++ks) qfr[ks] = *(const LAS bf16x8*)(bufp + GS_QG + (16 * cb + fr) * 272 + (8 * g + 32 * ks) * 2); \
              _Pragma("unroll") for (int v2 = 0; v2 < 2; ++v2) { const int vb = 2 * vh + v2; const u32x2 oin = v2 ? oc1 : oc0; \
                  f32x4 Oa = (f32x4){bflo(oin.x), bfhi(oin.x), bflo(oin.y), bfhi(oin.y)}; \
                  _Pragma("unroll") for (int ks = 0; ks < 4; ++ks) { const bf16x8 af = *(const LAS bf16x8*)(stp + (16 * vb + fr) * 272 + (8 * g + 32 * ks) * 2); \
                      Oa = __builtin_amdgcn_mfma_f32_16x16x32_bf16(af, qfr[ks], Oa, 0, 0, 0); } \
                  u32x2 w; w.x = pk2(Oa[0], Oa[1]); w.y = pk2(Oa[2], Oa[3]); \
                  *(u32x2*)(OUT + (size_t)(row0 + 16 * cb + fr) * D + ocol + 16 * v2) = w; } } \
            { const f32x4 dec = *(const LAS f32x4*)((LAS float*)(lds + GS_DEC) + cur * 128 + 16 * wave + 4 * g); \
              LAS unsigned char* stn = lds + GS_ST + (cur ^ 1) * 17408; \
              _Pragma("unroll") for (int vb = 0; vb < 4; ++vb) { Sacc[vb] = Sacc[vb] * dec; \
                  _Pragma("unroll") for (int t = 0; t < 2; ++t) { const bf16x8 af = *(const LAS bf16x8*)(bufp + GS_KET + (16 * wave + fr) * 144 + (8 * g + 32 * t) * 2); \
                      const bf16x8 bfr = *(const LAS bf16x8*)(bufp + GS_VT + (16 * vb + fr) * 144 + (8 * g + 32 * t) * 2); \
                      Sacc[vb] = __builtin_amdgcn_mfma_f32_16x16x32_bf16(af, bfr, Sacc[vb], 0, 0, 0); } \
                  u32x2 w; w.x = pk2(Sacc[vb][0], Sacc[vb][1]); w.y = pk2(Sacc[vb][2], Sacc[vb][3]); \
                  *(LAS u32x2*)(stn + (16 * vb + fr) * 272 + (16 * wave + 4 * g) * 2) = w; } } \
            if (_n + 1 < 36) { GS_STORE(RN, cur ^ 1); oc0 = RN.oi[0]; oc1 = RN.oi[1]; } \
            __syncthreads(); } while (0)
        GS_LOAD(R0, 0); GS_STORE(R0, 0);
        u32x2 oc0 = R0.oi[0], oc1 = R0.oi[1];
        GS_LOAD(R0, 1);
        __syncthreads();
        for (int n = 0; n < 36; n += 2) { GS_ITER(n, R0, R1); GS_ITER(n + 1, R1, R0); }
#undef GS_ITER
#undef GS_LOAD
#undef GS_STORE
    }
}

constexpr int N_PHASES = 34;
typedef const Args __attribute__((address_space(4)))* KArgs;
__device__ __forceinline__ KArgs kargs() { KArgs p = (KArgs)__builtin_amdgcn_kernarg_segment_ptr(); asm volatile("" : "+s"(p)); return p; }
__global__ void __launch_bounds__(512, 2) fwd(Args a_unused) {
    extern __shared__ __attribute__((aligned(16))) unsigned char lds_raw[];
    LAS unsigned char* lds = (LAS unsigned char*)lds_raw;
    const int tid0 = threadIdx.x;
    const int G0 = gridDim.x; const int bx0 = blockIdx.x;
#define PH_ENTRY int tid = tid0; asm volatile("" : "+v"(tid)); int G = G0, bx = bx0; asm volatile("" : "+s"(G), "+s"(bx)); const int lane = tid & 63, wave = __builtin_amdgcn_readfirstlane(tid >> 6); \
        const int vcu = (G % 8 == 0) ? (bx % 8) * (G / 8) + bx / 8 : bx; (void)lane; (void)wave; (void)vcu
    const int tid = tid0;
    const int ph_lo = kargs()->ph_lo, ph_hi = kargs()->ph_hi;
    const int repmask = kargs()->rep;
    if (tid < 64) ((LAS unsigned*)(lds + LX_MISC))[tid] = 0u;
    for (int i = tid; i < 1024; i += 512) { const int pos = i >> 4, f = i & 15; const float inv = __builtin_amdgcn_exp2f(-(float)f * (13.287712379549449f / 16.0f)); const float ang = (float)pos * inv;
        ((LAS float*)(lds + LX_ROPE))[2 * i] = __cosf(ang); ((LAS float*)(lds + LX_ROPE))[2 * i + 1] = __sinf(ang); }
    __syncthreads();
    const bool single = (ph_hi - ph_lo) > 1;
    XcdBarrier bar; bar.bar = (unsigned*)(kargs()->ws + WS_CTL) + CW_BAR; bar.x = 0; bar.st = (volatile LAS unsigned*)(lds + LX_MISC);
    if (single) bar = xcd_barrier_post((unsigned*)(kargs()->ws + WS_CTL) + CW_BAR, (volatile LAS unsigned*)(lds + LX_MISC));
#define IN(k) (ph_lo <= (k) && (k) < ph_hi)
#define REPLOOP(t) for (int rep_ = 0, nrep_ = 1 + ((repmask >> (t)) & 1); rep_ < nrep_; ++rep_, (rep_ < nrep_ ? (bar.bar = (unsigned*)(kargs()->ws + WS_CTL) + CW_BAR, xcd_barrier(bar)) : (void)0))
#define SEAM(k) do { if (IN(k) && IN((k) + 1)) { bar.bar = (unsigned*)(kargs()->ws + WS_CTL) + CW_BAR; xcd_barrier(bar); if ((repmask >> 10) & 1) xcd_barrier(bar); } } while (0)
    LAS int* tab = (LAS int*)(lds + LX_MOETAB);
#define CONV_PTRS(A) ConvPtrs{(A)->att_w_in, (A)->att_w_out, (A)->gla_w_in, (A)->gla_w_out, (A)->moe_w1, (A)->moe_w3, (A)->moe_w2, (A)->ws}

    if (IN(0)) REPLOOP(0) { PH_ENTRY; p0_prologue(kargs(), lds, tid, lane, wave, vcu, G); } SEAM(0);
    if (IN(1)) { PH_ENTRY; KArgs A = kargs(); unsigned char* ws = A->ws; phase_norm1(A->x, A->ctx, A->norm_g, (float*)(ws + WS_MODV), (bf16*)(ws + WS_H), TALL, lane, wave, vcu, G); } SEAM(1);

#pragma nounroll
    for (int L = 0; L < 4; ++L) {
        const int pb = 2 + 8 * L; const bool isattn = !(L & 1); const int j = L >> 1; const bool lastL = (L == 3);
        const int nrows = lastL ? TX : TALL;
        if (IN(pb)) REPLOOP(isattn ? 1 : 3) {
            PH_ENTRY; KArgs A = kargs(); unsigned char* ws = A->ws; unsigned char* big = ws + WS_BIG; const bf16* H = (const bf16*)(ws + WS_H);
            if (isattn) {
                pg8::DenseOrder S; S.init(H, (const bf16*)(ws + WS_WATTIN) + (size_t)j * NATT * D, TALL, NATT, D, G, bx);
                pg8::EpiAttnIn E{(bf16*)(big + BG_QKV), (bf16*)(big + BG_VAT), (bf16*)(big + BG_VBT), (const LAS float*)(lds + LX_ROPE)};
                pg8::gemm_phase<pg8::EpiAttnIn, pg8::DenseOrder, false>(lds, tid, D, S, E);
            } else {
                pg8::DenseOrder S; S.init(H, (const bf16*)(ws + WS_WGLAIN) + (size_t)j * NGLA * D, TALL, NGLA, D, G, bx);
                pg8::EpiGlaIn E{(bf16*)(big + BG_QKV2), (bf16*)(big + BG_VGT)};
                pg8::gemm_phase<pg8::EpiGlaIn, pg8::DenseOrder, false>(lds, tid, D, S, E);
            }
        }
        SEAM(pb);
        if (!isattn && IN(pb + 1)) {
            for (int rep_ = 0; rep_ <= ((repmask >> 13) & 1); ++rep_)
            { PH_ENTRY; KArgs A = kargs(); unsigned char* ws = A->ws;
              phase_gla_prep((const bf16*)(ws + WS_BIG + BG_QKV2), (const bf16*)(ws + WS_BIG + BG_VGT), A->gla_w_gate + j * 2 * 16 * 512, A->gla_b_gate + j * 2 * 512,
                             (bf16*)(ws + WS_QG), (bf16*)(ws + WS_KET), (float*)(ws + WS_BIG + BG_FAC), (bf16*)(ws + WS_BIG + BG_OF), (bf16*)(ws + WS_BIG + BG_OB), lds, tid, lane, wave, vcu, G); }
            if (single) { bar.bar = (unsigned*)(kargs()->ws + WS_CTL) + CW_BAR; xcd_barrier(bar); }
        }
        if (IN(pb + 1)) REPLOOP(isattn ? 2 : 4) {
            PH_ENTRY; KArgs A = kargs(); unsigned char* ws = A->ws; unsigned char* big = ws + WS_BIG; bf16* AOUT = (bf16*)(ws + WS_AOUT);
            if (isattn) { const ConvPtrs CP = CONV_PTRS(A);
                phase_attention((const bf16*)(big + BG_QKV), (const bf16*)(big + BG_VAT), (const bf16*)(big + BG_VBT), AOUT, A->att_lambda + j * 256, (L == 0) ? 0.2f : 0.470713018f,
                                A->att_subln_g + j * 128, A->na_bias + j * 8 * 465, (unsigned*)(ws + WS_CTL) + CW_NAQ + 64 * j, CP,
                                MK_CONVQ ? (L == 0 ? CT_ATTN0 : CT_MOE1) : 0, MK_CONVQ ? (L == 0 ? CT_MOE1 : CT_MOE3) : 0, lds, tid, lane, wave); }
            else phase_gla((const bf16*)(big + BG_VGT), (bf16*)(big + BG_OF), (bf16*)(big + BG_OB), (const bf16*)(ws + WS_QG), (const bf16*)(ws + WS_KET), (const float*)(big + BG_FAC),
                           lds, tid, lane, wave, vcu, G);
        }
        SEAM(pb + 1);
        if (!isattn) {
            if (IN(pb + 2)) REPLOOP(5) { PH_ENTRY; KArgs A = kargs(); unsigned char* ws = A->ws; unsigned char* big = ws + WS_BIG;
                phase_readout((const bf16*)(big + BG_OF), (const bf16*)(big + BG_OB), (const bf16*)(big + BG_QKV2), A->gla_norm_g + j * 256, (bf16*)(ws + WS_AOUT), nrows, lane, wave, vcu, G); }
            SEAM(pb + 2);
        }
        if (IN(pb + 3)) {
            PH_ENTRY; KArgs A = kargs(); unsigned char* ws = A->ws;
            pg8::DenseOrder S; S.init((const bf16*)(ws + WS_AOUT), (const bf16*)(ws + (isattn ? WS_WATTOUT : WS_WGLAOUT)) + (size_t)j * D * D, nrows, D, D, G, bx);
            pg8::EpiResid E{L == 0 ? A->x : A->out, L == 0 ? A->ctx : (const float*)(ws + WS_CTX), A->out, (float*)(ws + WS_CTX), (const float*)(ws + WS_MODV) + (size_t)L * 9 * 6144 + 2048};
            pg8::gemm_phase<pg8::EpiResid, pg8::DenseOrder, false>(lds, tid, D, S, E);
        }
        SEAM(pb + 3);
        if (IN(pb + 4)) { PH_ENTRY; KArgs A = kargs(); unsigned char* ws = A->ws;
            phase_router(A->out, (float*)(ws + WS_CTX), A->norm_g + (L * 2 + 1) * D, (const float*)(ws + WS_MODV) + (size_t)L * 9 * 6144, (bf16*)(ws + WS_H), A->router_w, A->router_bias,
                         (unsigned*)(ws + WS_CTL) + CW_CNT + L * 16 * 64, (int*)(ws + WS_LIST), (int*)(ws + WS_TOKI), (float*)(ws + WS_TOKW), nrows, lds, tid, lane, wave, vcu, G, (repmask >> 11) & 1); }
        SEAM(pb + 4);
        if (IN(pb + 5)) REPLOOP(6) {
            PH_ENTRY; KArgs A = kargs(); unsigned char* ws = A->ws;
            const int RT = build_moe_table((unsigned*)(ws + WS_CTL) + CW_CNT + L * 16 * 64, tab, tid);
            pg8::MoeOrder S; S.A = (const char*)(ws + WS_H); S.B = (const char*)(ws + WS_W13) + (size_t)L * 16 * D * D * 2; S.K = D; S.bstride = (size_t)D * D * 2; S.tab = tab; S.list = (const int*)(ws + WS_LIST); S.RT = RT; S.nwg = RT * 4; S.G = G; S.c = bx;
            pg8::EpiMoe1 E{(bf16*)(ws + WS_BIG + BG_HB)};
            pg8::gemm_phase<pg8::EpiMoe1, pg8::MoeOrder, true>(lds, tid, D, S, E);
        }
        SEAM(pb + 5);
        if (IN(pb + 6)) REPLOOP(7) {
            PH_ENTRY; KArgs A = kargs(); unsigned char* ws = A->ws;
            const int RT = build_moe_table((unsigned*)(ws + WS_CTL) + CW_CNT + L * 16 * 64, tab, tid);
            pg8::MoeOrder S; S.A = (const char*)(ws + WS_BIG + BG_HB); S.B = (const char*)(ws + WS_W2) + (size_t)L * 16 * D * DEXP * 2; S.K = DEXP; S.bstride = (size_t)D * DEXP * 2; S.tab = tab; S.list = (const int*)(ws + WS_LIST); S.RT = RT; S.nwg = RT * 4; S.G = G; S.c = bx;
            pg8::EpiBf16 E{(bf16*)(ws + WS_BIG + BG_YB), D};
            pg8::gemm_phase<pg8::EpiBf16, pg8::MoeOrder, false>(lds, tid, DEXP, S, E);
        }
        SEAM(pb + 6);
        if (IN(pb + 7)) { PH_ENTRY; KArgs A = kargs(); unsigned char* ws = A->ws; const float* MODV = (const float*)(ws + WS_MODV);
            phase_combine(A->out, (float*)(ws + WS_CTX), MODV + (size_t)L * 9 * 6144, (const bf16*)(ws + WS_BIG + BG_YB), (unsigned*)(ws + WS_CTL) + CW_CNT + L * 16 * 64, (const int*)(ws + WS_TOKI), (const float*)(ws + WS_TOKW),
                          lastL, lastL ? A->final_g : A->norm_g + ((L + 1) * 2) * D, MODV + (size_t)(lastL ? L : L + 1) * 9 * 6144, (bf16*)(ws + WS_H), nrows, lane, wave, vcu, G, (repmask >> 12) & 1); }
        if (!lastL) SEAM(pb + 7);
    }
#undef IN
#undef REPLOOP
#undef SEAM
#undef CONV_PTRS

#undef PH_ENTRY
}

extern "C" void kernel_launch(void* const* d_in, const int* in_sizes, int n_in, void* d_out, int out_size, void* d_ws, size_t ws_size, hipStream_t stream) {
    static int ready = 0;
    if (ready == 0) {
        if (n_in != 23 || out_size != TX * D || ws_size < WS_END) { fprintf(stderr, "kernel_launch: unexpected shapes (n_in %d out %d ws %zu)\n", n_in, out_size, ws_size); ready = -1; return; }
        if (hipFuncSetAttribute((const void*)fwd, hipFuncAttributeMaxDynamicSharedMemorySize, LDS_BYTES) != hipSuccess) { fprintf(stderr, "kernel_launch: hipFuncSetAttribute failed\n"); ready = -1; return; }
        int per_cu = 0; (void)hipOccupancyMaxActiveBlocksPerMultiprocessor(&per_cu, (const void*)fwd, 512, LDS_BYTES); (void)hipGetLastError();
        if (per_cu < 1) fprintf(stderr, "kernel_launch: occupancy query reports %d blocks per CU\n", per_cu);
        ready = 1;
    }
    if (ready < 0) return;
    (void)hipMemsetAsync((char*)d_ws + WS_CTL, 0, CTL_ZERO_BYTES, stream);
    Args a{};
    const float** ap = (const float**)&a;
    for (int i = 0; i < 23; ++i) ap[i] = (const float*)d_in[i];
    a.out = (float*)d_out; a.ws = (unsigned char*)d_ws;
    const int grid = 256;
    a.ph_lo = 0; a.ph_hi = N_PHASES; a.rep = MK_REPMASK;
    hipLaunchKernelGGL(fwd, dim3(grid), dim3(512), LDS_BYTES, stream, a);
}
```

```cpp
#include <hip/hip_runtime.h>
#include <cstdio>
#include <cstdint>

#ifndef MK_CONVQ
#define MK_CONVQ 1
#endif
#ifndef MK_REPMASK
#define MK_REPMASK 0
#endif

#define GAS __attribute__((address_space(1)))
#define LAS __attribute__((address_space(3)))
typedef unsigned short bf16;
typedef short bf16x8 __attribute__((ext_vector_type(8)));
typedef short bf16x4 __attribute__((ext_vector_type(4)));
typedef float f32x4 __attribute__((ext_vector_type(4)));
typedef float f32x2 __attribute__((ext_vector_type(2)));
typedef unsigned u32x4 __attribute__((ext_vector_type(4)));
typedef unsigned u32x2 __attribute__((ext_vector_type(2)));

constexpr int D = 1024, NB = 8, SEQ = 2048, CTXL = 256;
constexpr int TX = NB * SEQ, TC = NB * CTXL, TALL = TX + TC;
constexpr int NKEY = SEQ + CTXL;
constexpr int NATT = 3072, NGLA = 3328;
constexpr float EPSF = 1e-6f;
constexpr float LOG2E = 1.4426950408889634f;
constexpr int NEXP = 16, DEXP = 512;
constexpr int RT_MAX = 160;

constexpr size_t MiB = 1u << 20;
constexpr size_t WS_CTL = 0, CTL_ZERO_BYTES = 65536;
constexpr size_t WS_MODV = 1 * MiB;
constexpr size_t WS_TOKI = 2 * MiB;
constexpr size_t WS_TOKW = 2 * MiB + 512 * 1024;
constexpr size_t WS_LIST = 3 * MiB;
constexpr size_t WS_CTX = 5 * MiB;
constexpr size_t WS_WATTIN = 13 * MiB;
constexpr size_t WS_WATTOUT = 25 * MiB;
constexpr size_t WS_WGLAIN = 29 * MiB;
constexpr size_t WS_WGLAOUT = 42 * MiB;
constexpr size_t WS_W13 = 46 * MiB;
constexpr size_t WS_W2 = 174 * MiB;
constexpr size_t WS_H = 238 * MiB;
constexpr size_t WS_AOUT = 274 * MiB;
constexpr size_t WS_BIG = 310 * MiB;
constexpr size_t WS_END = 539 * MiB;
constexpr size_t BG_QKV = 0;
constexpr size_t BG_VAT = 108 * MiB;
constexpr size_t BG_VBT = 126 * MiB;
constexpr size_t BG_QKV2 = 0;
constexpr size_t BG_VGT = 117 * MiB;
constexpr size_t BG_OF = 153 * MiB;
constexpr size_t BG_OB = 189 * MiB;
constexpr size_t BG_FAC = 225 * MiB;
constexpr size_t WS_QG = WS_H, WS_KET = WS_AOUT;
constexpr size_t BG_HB = 0;
constexpr size_t BG_YB = 40 * MiB;
constexpr int CW_TMO = 0;
constexpr int CW_BAR = 4096;
constexpr int CW_NAQ = 15360;
constexpr int CW_CNT = 8192;

constexpr int RING_BYTES = 131072;
constexpr int LX_OFF = RING_BYTES;
constexpr int LX_MISC = LX_OFF;
constexpr int LX_MOETAB = LX_OFF + 256;
constexpr int LX_ROPE = LX_OFF + 2048;
constexpr int LX_BIAS = LX_OFF + 2048 + 8192;
constexpr int LDS_BYTES = 147456;

#define LDS_WAIT() asm volatile("s_waitcnt lgkmcnt(0)" ::: "memory")
#define VM_WAIT() asm volatile("s_waitcnt vmcnt(0)" ::: "memory")
#define RLX_AGENT __ATOMIC_RELAXED, __HIP_MEMORY_SCOPE_AGENT
__device__ __forceinline__ unsigned f2bf(float f) { unsigned u = __builtin_bit_cast(unsigned, f); return (u + 0x7fffu + ((u >> 16) & 1u)) >> 16; }
typedef __bf16 hwbf16x2 __attribute__((ext_vector_type(2)));
__device__ __forceinline__ unsigned cvtpk(float lo, float hi) { const f32x2 v = {lo, hi}; const hwbf16x2 b = __builtin_convertvector(v, hwbf16x2); return __builtin_bit_cast(unsigned, b); }
__device__ __forceinline__ unsigned pk2(float lo, float hi) { return cvtpk(lo, hi); }
__device__ __forceinline__ float bf2f(unsigned short b) { return __builtin_bit_cast(float, ((unsigned)b) << 16); }
__device__ __forceinline__ float bflo(unsigned w) { return __builtin_bit_cast(float, w << 16); }
__device__ __forceinline__ float bfhi(unsigned w) { return __builtin_bit_cast(float, w & 0xffff0000u); }
template <int CTRL> __device__ __forceinline__ float dppf(float v) { return __builtin_bit_cast(float, __builtin_amdgcn_update_dpp(0, __builtin_bit_cast(int, v), CTRL, 0xf, 0xf, true)); }
__device__ __forceinline__ float row_sum(float v) { v += dppf<0xB1>(v); v += dppf<0x4E>(v); v += dppf<0x124>(v); v += dppf<0x128>(v); return v; }
__device__ __forceinline__ float swap16_add(float a, float b) { auto r = __builtin_amdgcn_permlane16_swap(__float_as_uint(a), __float_as_uint(b), false, false); const unsigned r0 = r[0], r1 = r[1]; return __uint_as_float(r0) + __uint_as_float(r1); }
__device__ __forceinline__ float swap32_add(float a, float b) { auto r = __builtin_amdgcn_permlane32_swap(__float_as_uint(a), __float_as_uint(b), false, false); const unsigned r0 = r[0], r1 = r[1]; return __uint_as_float(r0) + __uint_as_float(r1); }
__device__ __forceinline__ float swap16_max(float a) { auto r = __builtin_amdgcn_permlane16_swap(__float_as_uint(a), __float_as_uint(a), false, false); const unsigned r0 = r[0], r1 = r[1]; return fmaxf(__uint_as_float(r0), __uint_as_float(r1)); }
__device__ __forceinline__ float swap32_max(float a) { auto r = __builtin_amdgcn_permlane32_swap(__float_as_uint(a), __float_as_uint(a), false, false); const unsigned r0 = r[0], r1 = r[1]; return fmaxf(__uint_as_float(r0), __uint_as_float(r1)); }
__device__ __forceinline__ float readlane_f(float v, int l) { return __int_as_float(__builtin_amdgcn_readlane(__float_as_int(v), l)); }
__device__ __forceinline__ float wave_sum(float v) { v = row_sum(v); v = swap16_add(v, v); return swap32_add(v, v); }
__device__ __forceinline__ float fexp2(float x) { return __builtin_amdgcn_exp2f(x); }
__device__ __forceinline__ float fexp(float x) { return __builtin_amdgcn_exp2f(x * LOG2E); }
__device__ __forceinline__ float flog(float x) { return __builtin_amdgcn_logf(x) * 0.6931471805599453f; }
__device__ __forceinline__ float frcp(float x) { return __builtin_amdgcn_rcpf(x); }
__device__ __forceinline__ float silu_f(float x) { return x * frcp(1.0f + fexp(-x)); }

#define XB_TMO      128
#define XB_XCNT(j)  (256  + 64 * (j))
#define XB_XSUB(j)  (1280 + 64 * (j))
#define XB_XGEN(j)  (2304 + 64 * (j))
#define XB_TOP      3328
#define XB_TOPGEN   3392
#define XCD_BAR_WORDS 3456
#define XB_SPIN_CAP (1u << 18)
__device__ __forceinline__ unsigned xb_ld(unsigned* p)              { return __hip_atomic_load(p, __ATOMIC_RELAXED, __HIP_MEMORY_SCOPE_AGENT); }
__device__ __forceinline__ unsigned xb_add(unsigned* p, unsigned v) { return __hip_atomic_fetch_add(p, v, __ATOMIC_RELAXED, __HIP_MEMORY_SCOPE_AGENT); }
__device__ __forceinline__ unsigned xb_xcc_id() { return (unsigned)__builtin_amdgcn_s_getreg((3 << 11) | 20) & 0xFu; }
#define XB_SPIN(cond, bar) do { unsigned _sp = 0; while (cond) { __builtin_amdgcn_s_sleep(1); \
    if ((++_sp & 255u) == 0u) { if (xb_ld(&(bar)[XB_TMO])) break; if (_sp > XB_SPIN_CAP) { atomicAdd(&(bar)[XB_TMO], 1u); break; } } } } while (0)
struct XcdBarrier { unsigned* bar; unsigned x; volatile LAS unsigned* st; };
__device__ __forceinline__ XcdBarrier xcd_barrier_post(unsigned* bar, volatile LAS unsigned* st) {
    XcdBarrier b; b.bar = bar; b.x = xb_xcc_id(); b.st = st;
    if (threadIdx.x == 0) (void)xb_add(&bar[XB_XCNT(b.x)], 1u);
    return b;
}
__device__ __forceinline__ void xcd_barrier_complete(unsigned* bar, unsigned x, unsigned& nloc, unsigned& nx) {
    const unsigned G = gridDim.x * gridDim.y * gridDim.z;
    unsigned sum, cnt, mine, sp = 0u;
    for (;;) {
        sum = 0u; cnt = 0u; mine = 0u;
#pragma unroll
        for (unsigned j = 0; j < 16; ++j) { const unsigned c = xb_ld(&bar[XB_XCNT(j)]); sum += c; cnt += (c > 0u) ? 1u : 0u; mine = (j == x) ? c : mine; }
        if (sum == G) break;
        __builtin_amdgcn_s_sleep(1);
        if ((++sp & 255u) == 0u) { if (xb_ld(&bar[XB_TMO])) break; if (sp > XB_SPIN_CAP) { atomicAdd(&bar[XB_TMO], 1u); break; } }
    }
    nloc = mine > 0u ? mine : 1u; nx = cnt > 0u ? cnt : 1u;
}
__device__ __forceinline__ void xcd_barrier(const XcdBarrier& b) {
    asm volatile("s_waitcnt vmcnt(0)" ::: "memory");
    __syncthreads();
    if (threadIdx.x == 0) {
        unsigned* bar = b.bar;
        __builtin_amdgcn_s_waitcnt(0);
        unsigned nloc = b.st[0], nx = b.st[1];
        if (nloc == 0u) { xcd_barrier_complete(bar, b.x, nloc, nx); b.st[0] = nloc; b.st[1] = nx; }
        const unsigned old = xb_add(&bar[XB_XSUB(b.x)], 1u);
        const unsigned gen = old / nloc;
        if (old + 1u == (gen + 1u) * nloc) {
            __builtin_amdgcn_fence(__ATOMIC_RELEASE, "agent");
            asm volatile("s_waitcnt vmcnt(0)" ::: "memory");
            const unsigned og = xb_add(&bar[XB_TOP], 1u);
            const unsigned tg = og / nx;
            if (og + 1u == (tg + 1u) * nx) xb_add(&bar[XB_TOPGEN], 1u);
            else XB_SPIN(xb_ld(&bar[XB_TOPGEN]) == tg, bar);
            __builtin_amdgcn_fence(__ATOMIC_ACQUIRE, "agent");
            xb_add(&bar[XB_XGEN(b.x)], 1u);
            asm volatile("s_waitcnt vmcnt(0)" ::: "memory");
        } else {
            XB_SPIN(xb_ld(&bar[XB_XGEN(b.x)]) == gen, bar);
            __builtin_amdgcn_fence(__ATOMIC_ACQUIRE, "agent");
            asm volatile("s_waitcnt vmcnt(0)" ::: "memory");
        }
    }
    __syncthreads();
}

namespace pg8 {
constexpr int BM = 256, BK = 64, HALF = 128, HTB = HALF * BK * 2, STAGE_BYTES = 8 * HTB, NXCD = 8, WGM = 8;
__host__ __device__ __forceinline__ int lds_byte(int r, int c) { const int st = (r >> 4) * 2 + (c >> 5), rr = r & 15, cc = c & 31, ob = rr * 64 + cc * 2; return st * 1024 + (ob ^ (((ob >> 9) & 1) << 5)); }
__host__ __device__ __forceinline__ void stage_rc(int b, int& R, int& C) { const int st = b / 1024, sb = b % 1024, swz = sb ^ (((sb >> 9) & 1) << 5); R = (st >> 1) * 16 + swz / 64; C = (st & 1) * 32 + (swz % 64) / 2; }
__host__ __device__ __forceinline__ int perm32(int rho) { const int n = rho >> 4, i = rho & 15; return 8 * (i >> 2) + 4 * n + (i & 3); }

struct Unit { int pm, pn, e, mt, roff, nai; };
__device__ __forceinline__ bool split_index(long L, int nwg, int G, int& uidx, int& roff, int& nai) {
    const int R = nwg / G, r = nwg % G; const bool split = (r > 0) && (2 * r <= G);
    if (L < (long)R * G || !split) { if (L >= nwg) return false; uidx = (int)L; roff = 0; nai = 2; return true; }
    const int h = (int)(L - (long)R * G); if (h >= 2 * r) return false; uidx = R * G + (h >> 1); roff = (h & 1) * 128; nai = 1; return true;
}

__device__ __forceinline__ int xcd_remap(int wgid, int nwg) { const int q = nwg / NXCD, r = nwg % NXCD, xcd = wgid % NXCD, off = wgid / NXCD; return (xcd < r ? xcd * (q + 1) : r * (q + 1) + (xcd - r) * q) + off; }

struct DenseOrder {
    const char* A; const char* B; int K; int nM, nN, nwg, G, c;
    __device__ __forceinline__ void init(const bf16* A_, const bf16* B_, int M, int N, int K_, int G_, int c_) { A = (const char*)A_; B = (const char*)B_; K = K_; nM = M / BM; nN = N / BM; nwg = nM * nN; G = G_; c = c_; }
    __device__ __forceinline__ bool next(int i, Unit& u) const {
        int uidx; if (!split_index((long)i * G + c, nwg, G, uidx, u.roff, u.nai)) return false;
        const int wgid = xcd_remap(uidx, nwg);
        const int nig = WGM * nN, gid = wgid / nig, fm = gid * WGM, gsz = (nM - fm) < WGM ? (nM - fm) : WGM;
        u.pm = fm + ((wgid % nig) % gsz); u.pn = (wgid % nig) / gsz; u.e = 0; u.mt = 0; return true;
    }
    __device__ __forceinline__ const char* a_ptr(const Unit& u) const { return A + (size_t)(u.pm * BM + u.roff) * K * 2; }
    __device__ __forceinline__ const char* b_ptr(const Unit& u) const { return B + (size_t)u.pn * BM * K * 2; }
    __device__ __forceinline__ int tok(const Unit&, int) const { return 0; }
};
struct MoeOrder {
    const char* A; const char* B; int K; size_t bstride;
    const LAS int* tab; const int* list; int RT, nwg, G, c;
    __device__ __forceinline__ bool next(int i, Unit& u) const {
        int uidx; if (!split_index((long)i * G + c, nwg, G, uidx, u.roff, u.nai)) return false;
        const int wgid = xcd_remap(uidx, nwg);
        const int rt = wgid >> 2; u.pm = rt; u.pn = wgid & 3; const int t = tab[rt]; u.e = t & 255; u.mt = t >> 8; return true;
    }
    __device__ __forceinline__ const char* a_ptr(const Unit& u) const { return A + (size_t)(u.pm * BM + u.roff) * K * 2; }
    __device__ __forceinline__ const char* b_ptr(const Unit& u) const { return B + (size_t)u.e * bstride + (size_t)u.pn * BM * K * 2; }
    __device__ __forceinline__ int tok(const Unit& u, int r) const { const int cnt = tab[RT_MAX + 1 + u.e]; const int pos = u.mt * BM + u.roff + r; return pos < cnt ? list[(size_t)u.e * TALL + pos] : 0; }
};

__device__ __forceinline__ unsigned cvt_pk_bf16(float lo, float hi) { unsigned r; asm volatile("v_cvt_pk_bf16_f32 %0, %1, %2" : "=v"(r) : "v"(lo), "v"(hi)); return r; }

template <class Epi, class Sched, bool GATHER>
__device__ __forceinline__ void gemm_phase(LAS unsigned char* lds, const int tid, const int K, const Sched& S, const Epi& E) {
    const int wid = __builtin_amdgcn_readfirstlane(tid >> 6), lane = tid & 63, wr = wid >> 2, wc = wid & 3, fr = lane & 15, fq = lane >> 4;
    const int nt = K / BK;
    unsigned voffA[2], voffB[2]; int RA[2], CA[2];
#pragma unroll
    for (int i = 0; i < 2; ++i) { int R, C; stage_rc(tid * 16 + i * 8192, R, C); const int Rb = Epi::PERM ? ((R & ~31) + perm32(R & 31)) : R;
        RA[i] = R; CA[i] = C; voffA[i] = (unsigned)(R * K + C) * 2u; voffB[i] = (unsigned)(Rb * K + C) * 2u; }
    const size_t kstep = (size_t)(BK * 2);
    const size_t hstep = (size_t)HALF * K * 2;
    const unsigned ldsw = (unsigned)wid * 1024u;
    const int aoff = lds_byte(wr * 64 + fr, fq * 8), boff = lds_byte(wc * 32 + fr, fq * 8);
#define PG8_SA(b, h) (((b) * 2 + (h)) * HTB)
#define PG8_SB(b, h) ((4 + (b) * 2 + (h)) * HTB)
#define PG8_STAGE(bufoff, gbase, voff) do { _Pragma("unroll") for (int _i = 0; _i < 2; ++_i) \
        __builtin_amdgcn_global_load_lds((const unsigned*)((const char*)(gbase) + (voff)[_i]), (LAS unsigned*)(lds + (bufoff) + ldsw + _i * 8192), 16, 0, 0); } while (0)
#define PG8_STAGE_A(bufoff, h, usenext, koff) do { if constexpr (GATHER) { unsigned _vo[2]; _vo[0] = (usenext) ? nvA[h][0] : vA[h][0]; _vo[1] = (usenext) ? nvA[h][1] : vA[h][1]; PG8_STAGE(bufoff, S.A + (koff), _vo); } \
        else { PG8_STAGE(bufoff, ((usenext) ? nA : cA) + (size_t)(h) * hstep + (koff), voffA); } } while (0)
#define PG8_LDA(dst, b, h) do { _Pragma("unroll") for (int m = 0; m < 4; ++m) _Pragma("unroll") for (int k = 0; k < 2; ++k) dst[m][k] = *(const LAS bf16x8*)(lds + PG8_SA(b, h) + aoff + m * 2048 + k * 1024); } while (0)
#define PG8_LDB(dst, b, h) do { _Pragma("unroll") for (int n = 0; n < 2; ++n) _Pragma("unroll") for (int k = 0; k < 2; ++k) dst[n][k] = *(const LAS bf16x8*)(lds + PG8_SB(b, h) + boff + n * 2048 + k * 1024); } while (0)
#define PG8_MMA(ai, bj, At, Bt) do { __builtin_amdgcn_s_setprio(1); _Pragma("unroll") for (int m = 0; m < 4; ++m) _Pragma("unroll") for (int n = 0; n < 2; ++n) _Pragma("unroll") for (int k = 0; k < 2; ++k) \
        acc[ai][bj][m][n] = __builtin_amdgcn_mfma_f32_16x16x32_bf16(Bt[n][k], At[m][k], acc[ai][bj][m][n], 0, 0, 0); __builtin_amdgcn_s_setprio(0); } while (0)
#define PG8_WAIT_V(n) asm volatile("s_waitcnt vmcnt(" #n ")" ::: "memory")
#define PG8_WAIT_L(n) asm volatile("s_waitcnt lgkmcnt(" #n ")" ::: "memory")
#define PG8_BAR __builtin_amdgcn_s_barrier()
#define PG8_SCHED __builtin_amdgcn_sched_barrier(0)
    Unit cur, nxt; int ui = 0;
    if (!S.next(0, cur)) return;
    f32x4 acc[2][2][4][2];
#pragma unroll
    for (int a = 0; a < 2; ++a)
#pragma unroll
        for (int b = 0; b < 2; ++b)
#pragma unroll
            for (int m = 0; m < 4; ++m)
#pragma unroll
                for (int n = 0; n < 2; ++n) acc[a][b][m][n] = (f32x4){0.f, 0.f, 0.f, 0.f};
    bf16x8 At[4][2], B0[2][2], B1[2][2];
    unsigned vA[2][2], nvA[2][2];
    if constexpr (GATHER) {
#pragma unroll
        for (int h = 0; h < 2; ++h)
#pragma unroll
            for (int i = 0; i < 2; ++i) { vA[h][i] = (unsigned)(S.tok(cur, h * HALF + RA[i]) * K + CA[i]) * 2u; nvA[h][i] = vA[h][i]; }
    }
    const char* cA = S.a_ptr(cur); const char* cB = S.b_ptr(cur); const char* nA = cA;
    PG8_STAGE(PG8_SB(0, 0), cB, voffB); PG8_STAGE(PG8_SB(0, 1), cB + hstep, voffB); PG8_STAGE_A(PG8_SA(0, 0), 0, false, 0); PG8_STAGE_A(PG8_SA(0, 1), 1, false, 0);
    if (wr == 1) PG8_BAR;
    PG8_WAIT_V(2); PG8_BAR;
    PG8_STAGE(PG8_SB(1, 0), cB + kstep, voffB); PG8_STAGE_A(PG8_SA(1, 0), 0, false, kstep); PG8_STAGE(PG8_SB(1, 1), cB + hstep + kstep, voffB);
    PG8_WAIT_V(6); PG8_BAR;
    for (;;) {
        const bool has_next = S.next(ui + 1, nxt);
        nA = has_next ? S.a_ptr(nxt) : cA; const char* nB = has_next ? S.b_ptr(nxt) : cB;
        if constexpr (GATHER) {
            if (has_next) {
#pragma unroll
                for (int h = 0; h < 2; ++h)
#pragma unroll
                    for (int i = 0; i < 2; ++i) nvA[h][i] = (unsigned)(S.tok(nxt, h * HALF + RA[i]) * K + CA[i]) * 2u;
            }
        }
        const bool full = (cur.nai == 2);
        for (int t = 0; t < nt; t += 2) {
            const bool last = (t == nt - 2);
            const size_t k1 = (size_t)(t + 1) * kstep;
            const size_t k2 = last ? 0 : (size_t)(t + 2) * kstep, k3 = k2 + kstep;
            const char* b2 = last ? nB : cB + (size_t)(t + 2) * kstep; const char* b3 = b2 + kstep;
            PG8_LDB(B0, 0, 0); PG8_LDB(B1, 0, 1); PG8_SCHED; PG8_LDA(At, 0, 0); PG8_STAGE_A(PG8_SA(1, 1), 1, false, k1);
            PG8_WAIT_V(8); PG8_WAIT_L(0); PG8_BAR; PG8_MMA(0, 0, At, B0); PG8_MMA(0, 1, At, B1); PG8_BAR; PG8_SCHED;
            if (full) PG8_LDA(At, 0, 1); PG8_STAGE(PG8_SB(0, 0), b2, voffB); PG8_STAGE(PG8_SB(0, 1), b2 + hstep, voffB); PG8_STAGE_A(PG8_SA(0, 0), 0, last, k2);
            PG8_WAIT_V(8); PG8_WAIT_L(0); PG8_BAR; if (full) { PG8_MMA(1, 0, At, B0); PG8_MMA(1, 1, At, B1); } PG8_BAR; PG8_SCHED;
            PG8_LDB(B0, 1, 0); PG8_LDB(B1, 1, 1); PG8_SCHED; PG8_LDA(At, 1, 0); PG8_STAGE_A(PG8_SA(0, 1), 1, last, k2);
            PG8_WAIT_V(8); PG8_WAIT_L(0); PG8_BAR; PG8_MMA(0, 0, At, B0); PG8_MMA(0, 1, At, B1); PG8_BAR; PG8_SCHED;
            if (full) PG8_LDA(At, 1, 1); PG8_STAGE(PG8_SB(1, 0), b3, voffB); PG8_STAGE(PG8_SB(1, 1), b3 + hstep, voffB); PG8_STAGE_A(PG8_SA(1, 0), 0, last, k3);
            PG8_WAIT_V(8); PG8_WAIT_L(0); PG8_BAR; if (full) { PG8_MMA(1, 0, At, B0); PG8_MMA(1, 1, At, B1); } PG8_BAR; PG8_SCHED;
        }
        if (wr == 0) PG8_BAR;
        E(acc, cur, wr, wc, fr, fq);
        if (!has_next) break;
#pragma unroll
        for (int a = 0; a < 2; ++a)
#pragma unroll
            for (int b = 0; b < 2; ++b)
#pragma unroll
                for (int m = 0; m < 4; ++m)
#pragma unroll
                    for (int n = 0; n < 2; ++n) acc[a][b][m][n] = (f32x4){0.f, 0.f, 0.f, 0.f};
        cur = nxt; cA = nA; cB = nB; ++ui;
        if constexpr (GATHER) {
#pragma unroll
            for (int h = 0; h < 2; ++h)
#pragma unroll
                for (int i = 0; i < 2; ++i) vA[h][i] = nvA[h][i];
        }
        if (wr == 1) PG8_BAR;
    }
    PG8_WAIT_V(0);
    PG8_BAR;
#undef PG8_SA
#undef PG8_SB
#undef PG8_STAGE
#undef PG8_STAGE_A
#undef PG8_LDA
#undef PG8_LDB
#undef PG8_MMA
#undef PG8_WAIT_V
#undef PG8_WAIT_L
#undef PG8_BAR
#undef PG8_SCHED
}
}

namespace pg8 {
__device__ __forceinline__ void row_bt(int row, int& b, int& tok) { if (row < TX) { b = row >> 11; tok = row & 2047; } else { const int r = row - TX; b = r >> 8; tok = SEQ + (r & 255); } }

struct EpiAttnIn {
    static constexpr bool PERM = true;
    bf16* QKV; bf16* VAT; bf16* VBT; const LAS float* rope;
    __device__ __forceinline__ void operator()(const f32x4 (&acc)[2][2][4][2], const Unit& u, int wr, int wc, int fr, int fq) const {
        const int row0 = u.pm * BM + u.roff + wr * 64 + fr; const int seg = u.pn >> 1;
        const bool latent = u.pm < (TX / BM);
        if (seg == 2 || seg == 5) {
#pragma unroll
            for (int ai = 0; ai < 2; ++ai) if (ai < u.nai)
#pragma unroll
                for (int m = 0; m < 4; ++m) { const int row = row0 + ai * HALF + m * 16; int b, tok; row_bt(row, b, tok);
#pragma unroll
                    for (int bj = 0; bj < 2; ++bj) { const int col = u.pn * BM + bj * HALF + wc * 32 + 8 * fq;
                        bf16* dst;
                        if (seg == 2) { const int cs = col - 1024; dst = VAT + ((size_t)(b * 4 + (cs >> 7)) * 128 + (cs & 127)) * NKEY + tok; }
                        else { const int cs = col - 2560; dst = VBT + ((size_t)(b * 8 + (cs >> 6)) * 64 + (cs & 63)) * NKEY + tok; }
#pragma unroll
                        for (int n = 0; n < 2; ++n)
#pragma unroll
                            for (int i = 0; i < 4; ++i) dst[(size_t)(4 * n + i) * NKEY] = (bf16)f2bf(acc[ai][bj][m][n][i]); } }
            return;
        }
        const bool dorope = latent && seg < 2;
        const float qs = (seg == 0 || seg == 3) ? 0.125f * LOG2E : 1.0f;
#pragma unroll
        for (int ai = 0; ai < 2; ++ai) if (ai < u.nai)
#pragma unroll
            for (int m = 0; m < 4; ++m) { const int row = row0 + ai * HALF + m * 16;
                f32x4 cs4[4];
                if (dorope) { const int t = row & 2047; const int pos = (wc & 1) ? (t & 63) : (t >> 6);
                    const LAS f32x4* rp = (const LAS f32x4*)(rope + (pos * 16 + 8 * (fq & 1)) * 2);
#pragma unroll
                    for (int j = 0; j < 4; ++j) cs4[j] = rp[j]; }
#pragma unroll
                for (int bj = 0; bj < 2; ++bj) { const int col = u.pn * BM + bj * HALF + wc * 32 + 8 * fq;
                    float v[8];
#pragma unroll
                    for (int n = 0; n < 2; ++n)
#pragma unroll
                        for (int i = 0; i < 4; ++i) v[4 * n + i] = acc[ai][bj][m][n][i];
                    if (dorope) {
#pragma unroll
                        for (int j = 0; j < 8; ++j) { const float other = __shfl_xor(v[j], 32); const float c = cs4[j >> 1][(j & 1) * 2], s = cs4[j >> 1][(j & 1) * 2 + 1];
                            v[j] = (fq < 2) ? (v[j] * c - other * s) : (v[j] * c + other * s); } }
                    u32x4 w; w.x = pk2(v[0] * qs, v[1] * qs); w.y = pk2(v[2] * qs, v[3] * qs); w.z = pk2(v[4] * qs, v[5] * qs); w.w = pk2(v[6] * qs, v[7] * qs);
                    *(u32x4*)(QKV + (size_t)row * NATT + col) = w; } }
    }
};
struct EpiGlaIn {
    static constexpr bool PERM = true;
    bf16* QKV2; bf16* VGT;
    __device__ __forceinline__ void operator()(const f32x4 (&acc)[2][2][4][2], const Unit& u, int wr, int wc, int fr, int fq) const {
        const int row0 = u.pm * BM + u.roff + wr * 64 + fr;
        if (u.pn >= 4 && u.pn < 8) {
#pragma unroll
            for (int ai = 0; ai < 2; ++ai) if (ai < u.nai)
#pragma unroll
                for (int m = 0; m < 4; ++m) { const int row = row0 + ai * HALF + m * 16; int b, tok; row_bt(row, b, tok);
#pragma unroll
                    for (int bj = 0; bj < 2; ++bj) { const int cs = u.pn * BM + bj * HALF + wc * 32 + 8 * fq - 1024;
                        bf16* dst = VGT + ((size_t)(b * 4 + (cs >> 8)) * 256 + (cs & 255)) * NKEY + tok;
#pragma unroll
                        for (int n = 0; n < 2; ++n)
#pragma unroll
                            for (int i = 0; i < 4; ++i) dst[(size_t)(4 * n + i) * NKEY] = (bf16)f2bf(acc[ai][bj][m][n][i]); } }
            return;
        }
        const float qs = (u.pn < 2) ? 0.08838834764831845f : 1.0f;
#pragma unroll
        for (int ai = 0; ai < 2; ++ai) if (ai < u.nai)
#pragma unroll
            for (int m = 0; m < 4; ++m) { const int row = row0 + ai * HALF + m * 16;
#pragma unroll
                for (int bj = 0; bj < 2; ++bj) { const int col = u.pn * BM + bj * HALF + wc * 32 + 8 * fq; const f32x4 a = acc[ai][bj][m][0] * qs, c = acc[ai][bj][m][1] * qs;
                    u32x4 w; w.x = pk2(a[0], a[1]); w.y = pk2(a[2], a[3]); w.z = pk2(c[0], c[1]); w.w = pk2(c[2], c[3]);
                    *(u32x4*)(QKV2 + (size_t)row * NGLA + col) = w; } }
    }
};
struct EpiResid {
    static constexpr bool PERM = false;
    const float* IL; const float* IC; float* XL; float* XC; const float* modv;
    __device__ __forceinline__ void operator()(const f32x4 (&acc)[2][2][4][2], const Unit& u, int wr, int wc, int fr, int fq) const {
        const int row0 = u.pm * BM + u.roff + wr * 64 + fr, col0 = u.pn * BM + wc * 32 + 4 * fq;
        const bool latent = u.pm < (TX / BM); const int bi = latent ? (u.pm >> 3) : 8;
        float* base = latent ? XL : (XC - (size_t)TX * D); const float* ibase = latent ? IL : (IC - (size_t)TX * D);
        f32x4 gv[2][2];
#pragma unroll
        for (int bj = 0; bj < 2; ++bj)
#pragma unroll
            for (int n = 0; n < 2; ++n) gv[bj][n] = *(const f32x4*)(modv + bi * 6144 + col0 + bj * HALF + n * 16);
#pragma unroll
        for (int ai = 0; ai < 2; ++ai) if (ai < u.nai)
#pragma unroll
            for (int m = 0; m < 4; ++m) { const size_t ro = (size_t)(row0 + ai * HALF + m * 16) * D + col0;
#pragma unroll
                for (int bj = 0; bj < 2; ++bj)
#pragma unroll
                    for (int n = 0; n < 2; ++n) { const size_t o = ro + bj * HALF + n * 16; *(f32x4*)(base + o) = *(const f32x4*)(ibase + o) + gv[bj][n] * acc[ai][bj][m][n]; } }
    }
};
struct EpiMoe1 {
    static constexpr bool PERM = false;
    bf16* HB;
    __device__ __forceinline__ void operator()(const f32x4 (&acc)[2][2][4][2], const Unit& u, int wr, int wc, int fr, int fq) const {
        const int row0 = u.pm * BM + u.roff + wr * 64 + fr, col0 = u.pn * 128 + wc * 16 + 4 * fq;
#pragma unroll
        for (int ai = 0; ai < 2; ++ai) if (ai < u.nai)
#pragma unroll
            for (int m = 0; m < 4; ++m) { bf16* rowp = HB + (size_t)(row0 + ai * HALF + m * 16) * DEXP + col0;
#pragma unroll
                for (int bj = 0; bj < 2; ++bj) { const f32x4 a = acc[ai][bj][m][0], b = acc[ai][bj][m][1];
                    u32x2 w; w.x = pk2(silu_f(a[0]) * b[0], silu_f(a[1]) * b[1]); w.y = pk2(silu_f(a[2]) * b[2], silu_f(a[3]) * b[3]);
                    *(u32x2*)(rowp + bj * 64) = w; } }
    }
};
struct EpiBf16 {
    static constexpr bool PERM = true;
    bf16* O; int ldc;
    __device__ __forceinline__ void operator()(const f32x4 (&acc)[2][2][4][2], const Unit& u, int wr, int wc, int fr, int fq) const {
        const int row0 = u.pm * BM + u.roff + wr * 64 + fr, col0 = u.pn * BM + wc * 32 + 8 * fq;
#pragma unroll
        for (int ai = 0; ai < 2; ++ai) if (ai < u.nai)
#pragma unroll
            for (int m = 0; m < 4; ++m) { bf16* rowp = O + (size_t)(row0 + ai * HALF + m * 16) * ldc + col0;
#pragma unroll
                for (int bj = 0; bj < 2; ++bj) { const f32x4 a = acc[ai][bj][m][0], c = acc[ai][bj][m][1];
                    u32x4 w; w.x = pk2(a[0], a[1]); w.y = pk2(a[2], a[3]); w.z = pk2(c[0], c[1]); w.w = pk2(c[2], c[3]);
                    *(u32x4*)(rowp + bj * HALF) = w; } }
    }
};
}

struct Args {
    const float *x, *c, *ctx, *c_ctx, *w_mod, *b_mod, *norm_g, *final_g, *att_w_in, *att_w_out, *att_lambda, *att_subln_g, *na_bias,
                *gla_w_in, *gla_w_gate, *gla_b_gate, *gla_norm_g, *gla_w_out, *router_w, *router_bias, *moe_w1, *moe_w3, *moe_w2;
    float* out; unsigned char* ws; int ph_lo, ph_hi, rep, pad;
};

struct RowMapId { int off; __device__ __forceinline__ int operator()(int n) const { return off + n; } };
struct RowMapMoe { int which; __device__ __forceinline__ int operator()(int n) const { return 32 * (n >> 4) + 16 * which + (n & 15); } };
__device__ __forceinline__ void ti_load(float (&ld)[32], const float* W, int N, int item, int lane) {
    const int nblk = N / 32, kb = item / nblk, nb = item % nblk, k0 = 64 * kb, n0 = 32 * nb;
#pragma unroll
    for (int i = 0; i < 32; ++i) ld[i] = W[(size_t)(k0 + 2 * i + (lane >> 5)) * N + n0 + (lane & 31)];
}
template <class RM>
__device__ __forceinline__ void ti_finish(const float (&ld)[32], int K, int N, bf16* WT, LAS float* scr, int item, int lane, RM rm) {
    const int nblk = N / 32, kb = item / nblk, nb = item % nblk, k0 = 64 * kb, n0 = 32 * nb;
#pragma unroll
    for (int i = 0; i < 32; ++i) scr[(2 * i + (lane >> 5)) * 33 + (lane & 31)] = ld[i];
    LDS_WAIT(); asm volatile("" ::: "memory");
    const int c = lane & 7;
#pragma unroll
    for (int j = 0; j < 4; ++j) { const int n = (lane >> 3) + 8 * j; const LAS float* s = scr + (8 * c) * 33 + n;
        u32x4 o; o.x = pk2(s[0 * 33], s[1 * 33]); o.y = pk2(s[2 * 33], s[3 * 33]); o.z = pk2(s[4 * 33], s[5 * 33]); o.w = pk2(s[6 * 33], s[7 * 33]);
        *(u32x4*)(WT + (size_t)rm(n0 + n) * K + k0 + 8 * c) = o; }
    LDS_WAIT(); asm volatile("" ::: "memory");
}
template <class RM>
__device__ __forceinline__ void p0_transpose_item(const float* W, int K, int N, bf16* WT, LAS float* scr, int item, int lane, RM rm) {
    float ld[32]; ti_load(ld, W, N, item, lane); ti_finish(ld, K, N, WT, scr, item, lane, rm);
}

constexpr int CV_ATTIN = 1536, CV_ATTOUT = 512, CV_GLAIN = 1552, CV_GLAPAD = 28, CV_GLAOUT = 512, CV_W = 4096, CV_MOE = 3 * CV_W;
constexpr int CT_ATTN0 = CV_ATTIN + CV_ATTOUT, CT_MOE0 = CT_ATTN0 + CV_MOE, CT_GLA0 = CT_MOE0 + CV_GLAIN + CV_GLAPAD + CV_GLAOUT, CT_ATTN1 = CT_GLA0 + CV_ATTIN + CV_ATTOUT, CT_MOE1 = CT_ATTN1 + CV_MOE,
              CT_MOE2 = CT_MOE1 + CV_MOE, CT_GLA1 = CT_MOE2 + CV_GLAIN + CV_GLAPAD + CV_GLAOUT, CT_MOE3 = CT_GLA1 + CV_MOE, CV_TOTAL = CT_MOE3;
constexpr int CV_UNIT = 32;
struct ConvPtrs { const float *att_w_in, *att_w_out, *gla_w_in, *gla_w_out, *moe_w1, *moe_w3, *moe_w2; unsigned char* ws; };
struct RowMapAny { int moe, which; __device__ __forceinline__ int operator()(int n) const { return moe ? 32 * (n >> 4) + 16 * which + (n & 15) : n; } };
struct ConvDesc { const float* W; bf16* WT; int K, N, sub, kind  ; RowMapAny rm; };
__device__ __forceinline__ ConvDesc conv_decode(const ConvPtrs& P, int it, int hi) {
    ConvDesc d; d.W = nullptr; d.WT = nullptr; d.K = D; d.N = D; d.sub = 0; d.kind = 0; d.rm = RowMapAny{0, 0};
    if (it >= hi) return d;
    int kind, j, r;
    if (it < CT_ATTN0) { kind = 0; j = 0; r = it; } else if (it < CT_MOE0) { kind = 2; j = 0; r = it - CT_ATTN0; } else if (it < CT_GLA0) { kind = 1; j = 0; r = it - CT_MOE0; }
    else if (it < CT_ATTN1) { kind = 0; j = 1; r = it - CT_GLA0; } else if (it < CT_MOE1) { kind = 2; j = 1; r = it - CT_ATTN1; } else if (it < CT_MOE2) { kind = 2; j = 2; r = it - CT_MOE1; }
    else if (it < CT_GLA1) { kind = 1; j = 1; r = it - CT_MOE2; } else { kind = 2; j = 3; r = it - CT_GLA1; }
    d.kind = 1; d.sub = r;
    if (kind == 2) {
        const int which = r / CV_W, q = r % CV_W, e = q >> 8, je = j * 16 + e; d.sub = q & 255;
        if (which < 2) { d.W = (which ? P.moe_w3 : P.moe_w1) + (size_t)je * D * DEXP; d.N = DEXP; d.WT = (bf16*)(P.ws + WS_W13) + (size_t)je * D * D; d.rm.moe = 1; d.rm.which = which; }
        else { d.W = P.moe_w2 + (size_t)je * DEXP * D; d.K = DEXP; d.WT = (bf16*)(P.ws + WS_W2) + (size_t)je * D * DEXP; }
    } else if (kind == 0) {
        if (r < CV_ATTIN) { d.W = P.att_w_in + (size_t)j * D * NATT; d.N = NATT; d.WT = (bf16*)(P.ws + WS_WATTIN) + (size_t)j * NATT * D; }
        else { d.W = P.att_w_out + (size_t)j * D * D; d.WT = (bf16*)(P.ws + WS_WATTOUT) + (size_t)j * D * D; d.sub = r - CV_ATTIN; }
    } else {
        if (r < CV_GLAIN) { d.W = P.gla_w_in + (size_t)j * D * 3104; d.N = 3104; d.WT = (bf16*)(P.ws + WS_WGLAIN) + (size_t)j * NGLA * D; }
        else if (r < CV_GLAIN + CV_GLAPAD) { d.kind = 2; d.sub = (r - CV_GLAIN) * 1024; d.WT = (bf16*)(P.ws + WS_WGLAIN) + (size_t)j * NGLA * D + (size_t)3104 * D; }
        else { d.W = P.gla_w_out + (size_t)j * D * D; d.WT = (bf16*)(P.ws + WS_WGLAOUT) + (size_t)j * D * D; d.sub = r - CV_GLAIN - CV_GLAPAD; }
    }
    return d;
}
__device__ __forceinline__ void conv_load(const ConvDesc& d, float (&ld)[32], int lane) { if (d.kind == 1) ti_load(ld, d.W, d.N, d.sub, lane); }
__device__ __forceinline__ void conv_finish(const ConvDesc& d, const float (&ld)[32], LAS float* scr, int lane) {
    if (d.kind == 1) ti_finish(ld, d.K, d.N, d.WT, scr, d.sub, lane, d.rm);
    else if (d.kind == 2) { for (int i = lane; i < 1024; i += 64) *(u32x4*)(d.WT + (size_t)(d.sub + i) * 8) = (u32x4){0u, 0u, 0u, 0u}; }
}
__device__ __forceinline__ void conv_item(const ConvPtrs& P, int it, LAS float* scr, int lane) {
    const ConvDesc d = conv_decode(P, it, it + 1); float ld[32]; conv_load(d, ld, lane); conv_finish(d, ld, scr, lane);
}
__device__ __forceinline__ void conv_static(const ConvPtrs& P, int cur, int need, LAS unsigned char* lds, int lane, int wave, int vcu, int G) {
    LAS float* scr = (LAS float*)(lds + wave * 8448);
    for (int it = cur + vcu * 8 + wave; it < need; it += G * 8) conv_item(P, it, scr, lane);
}
__device__ __forceinline__ void conv_unit(const ConvPtrs& P, int i0, int hi, LAS unsigned char* lds, int lane, int wave) {
    LAS float* scr = (LAS float*)(lds + wave * 8448);
    constexpr int NPW = CV_UNIT / 8; static_assert(NPW == 4, "four items per wave");
    const int it0 = i0 + wave * NPW;
    float la[32], lb[32];
    ConvDesc dA = conv_decode(P, it0, hi); conv_load(dA, la, lane);
    ConvDesc dB = conv_decode(P, it0 + 1, hi); conv_load(dB, lb, lane);
    conv_finish(dA, la, scr, lane);
    dA = conv_decode(P, it0 + 2, hi); conv_load(dA, la, lane);
    conv_finish(dB, lb, scr, lane);
    dB = conv_decode(P, it0 + 3, hi); conv_load(dB, lb, lane);
    conv_finish(dA, la, scr, lane);
    conv_finish(dB, lb, scr, lane);
}

template <class AP> __device__ __forceinline__ void p0_prologue(const AP ap, LAS unsigned char* lds, int tid, int lane, int wave, int vcu, int G) {
    unsigned char* ws = ap->ws;
    LAS float* S9 = (LAS float*)(lds + 69632);
    LAS float* red = (LAS float*)(lds + 106496);
    { const ConvPtrs P{ap->att_w_in, ap->att_w_out, ap->gla_w_in, ap->gla_w_out, ap->moe_w1, ap->moe_w3, ap->moe_w2, ws};
      conv_static(P, 0, MK_CONVQ ? CT_ATTN0 : CV_TOTAL, lds, lane, wave, vcu, G); }
    __syncthreads();
    { const float* cc = ap->c; const float* cx = ap->c_ctx;
      for (int i = tid; i < 9 * 1024; i += 512) { const int bi = i >> 10, k = i & 1023; const float v = (bi < 8) ? cc[bi * D + k] : cx[k]; S9[i] = v / (1.0f + __expf(-v)); } }
    __syncthreads();
    const float* w_mod = ap->w_mod; const float* b_mod = ap->b_mod;
    for (int u = vcu; u < 4 * 96; u += G) {
        const int L = u / 96, n0 = (u % 96) * 64;
        const float* W = w_mod + (size_t)L * D * 6144 + n0 + lane;
        float acc[9];
#pragma unroll
        for (int bi = 0; bi < 9; ++bi) acc[bi] = 0.f;
        const int kb = wave * 128;
        for (int k0 = 0; k0 < 128; k0 += 32) { float wv[32];
#pragma unroll
            for (int k = 0; k < 32; ++k) wv[k] = W[(size_t)(kb + k0 + k) * 6144];
#pragma unroll
            for (int k = 0; k < 32; ++k)
#pragma unroll
                for (int bi = 0; bi < 9; ++bi) acc[bi] += S9[bi * 1024 + kb + k0 + k] * wv[k]; }
#pragma unroll
        for (int bi = 0; bi < 9; ++bi) red[(wave * 9 + bi) * 64 + lane] = acc[bi];
        __syncthreads();
        for (int i = tid; i < 9 * 64; i += 512) { const int bi = i >> 6, l = i & 63; float sm = b_mod[L * 6144 + n0 + l];
#pragma unroll
            for (int w = 0; w < 8; ++w) sm += red[(w * 9 + bi) * 64 + l];
            ((float*)(ws + WS_MODV))[(size_t)(L * 9 + bi) * 6144 + n0 + l] = sm; }
        __syncthreads();
    }
}

__device__ __forceinline__ float* xrow_ptr(float* XL, float* XC, int row) { return row < TX ? XL + (size_t)row * D : XC + (size_t)(row - TX) * D; }
__device__ __forceinline__ int row_bi(int row) { return row < TX ? (row >> 11) : 8; }

__device__ __forceinline__ void norm_mod_store(const f32x4 (&v)[4], const float* g, const float* sh, const float* sc, bf16* orow, int lane) {
    float ss = 0.f;
#pragma unroll
    for (int j = 0; j < 4; ++j) ss += (v[j].x * v[j].x + v[j].y * v[j].y) + (v[j].z * v[j].z + v[j].w * v[j].w);
    const float rs = __builtin_amdgcn_rsqf(wave_sum(ss) * (1.0f / D) + EPSF);
#pragma unroll
    for (int j = 0; j < 4; ++j) { const int c = 4 * lane + 256 * j; const f32x4 gg = *(const f32x4*)(g + c), s1 = *(const f32x4*)(sc + c), s0 = *(const f32x4*)(sh + c);
        const f32x4 y = (v[j] * rs) * gg * (1.0f + s1) + s0;
        u32x2 w; w.x = pk2(y.x, y.y); w.y = pk2(y.z, y.w); *(u32x2*)(orow + c) = w; }
}

constexpr int TROWS = 9;
__device__ __forceinline__ int thin_row(int vcu, int wave, int i) { return vcu * 8 + wave + 2048 * i; }

struct N1Row { f32x4 x[4], s0[4], s1[4]; };
__device__ __forceinline__ void n1_issue(N1Row& r, const float* XL, const float* XC, const float* modv, int row, int lane) {
    const f32x4* xr = (const f32x4*)(row < TX ? XL + (size_t)row * D : XC + (size_t)(row - TX) * D) + lane; const float* mv = modv + row_bi(row) * 6144;
#pragma unroll
    for (int j = 0; j < 4; ++j) { r.x[j] = xr[64 * j]; r.s0[j] = *(const f32x4*)(mv + 4 * lane + 256 * j); r.s1[j] = *(const f32x4*)(mv + 1024 + 4 * lane + 256 * j); }
}
__device__ __forceinline__ void n1_finish(const N1Row& r, const f32x4 (&gg)[4], bf16* orow, int lane) {
    float ss = 0.f;
#pragma unroll
    for (int j = 0; j < 4; ++j) ss += (r.x[j].x * r.x[j].x + r.x[j].y * r.x[j].y) + (r.x[j].z * r.x[j].z + r.x[j].w * r.x[j].w);
    const float rs = __builtin_amdgcn_rsqf(wave_sum(ss) * (1.0f / D) + EPSF);
#pragma unroll
    for (int j = 0; j < 4; ++j) { const f32x4 y = (r.x[j] * rs) * gg[j] * (1.0f + r.s1[j]) + r.s0[j];
        u32x2 w; w.x = pk2(y.x, y.y); w.y = pk2(y.z, y.w); *(u32x2*)(orow + 4 * lane + 256 * j) = w; }
}
__device__ __forceinline__ void phase_norm1(const float* XL, const float* XC, const float* g, const float* modv, bf16* H, int nrows, int lane, int wave, int vcu, int G) {
    f32x4 gg[4];
#pragma unroll
    for (int j = 0; j < 4; ++j) gg[j] = *(const f32x4*)(g + 4 * lane + 256 * j);
    N1Row ra, rb;
    n1_issue(ra, XL, XC, modv, thin_row(vcu, wave, 0), lane);
#pragma unroll
    for (int i = 0; i < TROWS; ++i) {
        const int row = thin_row(vcu, wave, i), rown = thin_row(vcu, wave, i + 1);
        if (i + 1 < TROWS) n1_issue((i & 1) ? ra : rb, XL, XC, modv, rown < nrows ? rown : row, lane);
        if (row < nrows) n1_finish((i & 1) ? rb : ra, gg, H + (size_t)row * D, lane);
    }
}

__device__ __forceinline__ void phase_router(float* XL, float* XC, const float* g, const float* modv, bf16* H, const float* router_w, const float* router_bias,
                                             unsigned* cnt  , int* list, int* toki, float* tokw, int nrows,
                                             LAS unsigned char* lds, int tid, int lane, int wave, int vcu, int G, int probe) {
    LAS float* RW = (LAS float*)lds;
    LAS int* lcnt = (LAS int*)(lds + 65536);
    LAS int* rinfo = (LAS int*)(lds + 65536 + 256);
    for (int it = 0; it < 8; ++it) { const int idx = tid + 512 * it, k = idx >> 2, q = idx & 3; const f32x4 w = *(const f32x4*)(router_w + k * 16 + 4 * q);
        RW[(4 * q + 0) * 1024 + k] = w.x; RW[(4 * q + 1) * 1024 + k] = w.y; RW[(4 * q + 2) * 1024 + k] = w.z; RW[(4 * q + 3) * 1024 + k] = w.w; }
    if (tid < 32) lcnt[tid] = 0;
    __syncthreads();
    const int rpb = nrows / G, rpw = rpb / 8;
    const int gI = lane >> 4;
    const f32x4 rb = *(const f32x4*)(router_bias + 4 * gI);
    for (int rep = (probe ? 0 : 1); rep < 2; ++rep)
    for (int i0 = 0; i0 < rpw; i0 += 3) {
        asm volatile("" ::: "memory");
        f32x4 y[3][4];
#pragma unroll
        for (int r = 0; r < 3; ++r) {
            const int ii = (i0 + r < rpw) ? i0 + r : rpw - 1; const int row = vcu * rpb + wave * rpw + ii;
            const f32x4* xr = (const f32x4*)xrow_ptr(XL, XC, row) + lane; f32x4 v[4];
#pragma unroll
            for (int j = 0; j < 4; ++j) v[j] = xr[64 * j];
            const float* mv = modv + row_bi(row) * 6144 + 3072;
            float ss = 0.f;
#pragma unroll
            for (int j = 0; j < 4; ++j) ss += (v[j].x * v[j].x + v[j].y * v[j].y) + (v[j].z * v[j].z + v[j].w * v[j].w);
            const float rs = __builtin_amdgcn_rsqf(wave_sum(ss) * (1.0f / D) + EPSF);
#pragma unroll
            for (int j = 0; j < 4; ++j) { const int c = 4 * lane + 256 * j; const f32x4 gg = *(const f32x4*)(g + c), s1 = *(const f32x4*)(mv + 1024 + c), s0 = *(const f32x4*)(mv + c);
                y[r][j] = (v[j] * rs) * gg * (1.0f + s1) + s0;
                u32x2 w; w.x = cvtpk(y[r][j].x, y[r][j].y); w.y = cvtpk(y[r][j].z, y[r][j].w); *(u32x2*)(H + (size_t)row * D + c) = w; }
            __builtin_amdgcn_sched_barrier(0);
        }
        float p[3][16];
#pragma unroll
        for (int e = 0; e < 16; ++e) {
#pragma unroll
            for (int r = 0; r < 3; ++r) p[r][e] = 0.f;
#pragma unroll
            for (int j = 0; j < 4; ++j) { const f32x4 w = *(const LAS f32x4*)(RW + e * 1024 + 4 * lane + 256 * j);
#pragma unroll
                for (int r = 0; r < 3; ++r) p[r][e] += (y[r][j].x * w.x + y[r][j].y * w.y) + (y[r][j].z * w.z + y[r][j].w * w.w); }
#pragma unroll
            for (int r = 0; r < 3; ++r) asm volatile("" : "+v"(p[r][e])); }
#pragma unroll
        for (int r = 0; r < 3; ++r) {
            float q8[8], lg[4];
#pragma unroll
            for (int j = 0; j < 8; ++j) q8[j] = swap32_add(p[r][j], p[r][j + 8]);
#pragma unroll
            for (int j = 0; j < 4; ++j) lg[j] = row_sum(swap16_add(q8[j], q8[j + 4]));
            float sc[4], sel[4];
#pragma unroll
            for (int j = 0; j < 4; ++j) { sc[j] = 1.0f / (1.0f + __expf(-lg[j])); sel[j] = sc[j] + rb[j]; }
            int i1 = 0, i2 = 0; float m1 = -1e30f, m2 = -1e30f, w1 = 0.f, w2 = 0.f;
#pragma unroll
            for (int j = 0; j < 4; ++j) { const float t = sel[j];
                if (t > m1) { m2 = m1; i2 = i1; w2 = w1; m1 = t; i1 = j; w1 = sc[j]; } else if (t > m2) { m2 = t; i2 = j; w2 = sc[j]; } }
            const float gs = m1 + m2;
            const float g0 = readlane_f(gs, 0), g1 = readlane_f(gs, 16), g2 = readlane_f(gs, 32), g3 = readlane_f(gs, 48);
            int bg = 0; float bgs = g0; if (g1 > bgs) { bgs = g1; bg = 1; } if (g2 > bgs) { bgs = g2; bg = 2; } if (g3 > bgs) { bgs = g3; bg = 3; }
            bg = __builtin_amdgcn_readfirstlane(bg);
            const int e0 = 4 * bg + __builtin_amdgcn_readlane(i1, 16 * bg), e1 = 4 * bg + __builtin_amdgcn_readlane(i2, 16 * bg);
            const float w0 = readlane_f(w1, 16 * bg), w1s = readlane_f(w2, 16 * bg);
            const float wn = 1.0f / (w0 + w1s);
            if (lane == 0 && rep == 1 && i0 + r < rpw) { const int rl = wave * rpw + i0 + r;
                const int p0 = __hip_atomic_fetch_add(&lcnt[e0], 1, __ATOMIC_RELAXED, __HIP_MEMORY_SCOPE_WORKGROUP), p1 = __hip_atomic_fetch_add(&lcnt[e1], 1, __ATOMIC_RELAXED, __HIP_MEMORY_SCOPE_WORKGROUP);
                rinfo[rl * 6 + 0] = e0; rinfo[rl * 6 + 1] = p0; rinfo[rl * 6 + 2] = e1; rinfo[rl * 6 + 3] = p1;
                rinfo[rl * 6 + 4] = __builtin_bit_cast(int, w0 * wn); rinfo[rl * 6 + 5] = __builtin_bit_cast(int, w1s * wn); }
        }
    }
    __syncthreads();
    if (tid < 16) lcnt[16 + tid] = (int)__hip_atomic_fetch_add(cnt + 64 * tid, (unsigned)lcnt[tid], RLX_AGENT);
    __syncthreads();
    if (tid < rpb) { const int row = vcu * rpb + tid; const int e0 = rinfo[tid * 6 + 0], e1 = rinfo[tid * 6 + 2];
        const int p0 = lcnt[16 + e0] + rinfo[tid * 6 + 1], p1 = lcnt[16 + e1] + rinfo[tid * 6 + 3];
        list[(size_t)e0 * TALL + p0] = row; list[(size_t)e1 * TALL + p1] = row;
        toki[row * 4 + 0] = e0; toki[row * 4 + 1] = p0; toki[row * 4 + 2] = e1; toki[row * 4 + 3] = p1;
        tokw[row * 2 + 0] = __builtin_bit_cast(float, rinfo[tid * 6 + 4]); tokw[row * 2 + 1] = __builtin_bit_cast(float, rinfo[tid * 6 + 5]); }
    __syncthreads();
}

__device__ __forceinline__ int build_moe_table(const unsigned* cnt, LAS int* tab, int tid) {
    if (tid < 16) tab[RT_MAX + 1 + tid] = (int)__hip_atomic_load(cnt + 64 * tid, RLX_AGENT);
    __syncthreads();
    if (tid == 0) { int rt = 0;
        for (int e = 0; e < 16; ++e) { const int c = tab[RT_MAX + 1 + e]; const int nt = (c + 255) >> 8;
            for (int m = 0; m < nt; ++m) { if (rt < RT_MAX) tab[rt] = e | (m << 8); ++rt; } }
        tab[RT_MAX] = rt < RT_MAX ? rt : RT_MAX; }
    __syncthreads();
    return tab[RT_MAX];
}

struct CbTok { int e0, p0, e1, p1; float w0, w1; };
struct CbRow { f32x4 x[4], g2[4], s0[4], s1[4]; u32x2 ya[4], yb[4]; };
__device__ __forceinline__ void cb_tok(CbTok& t, const int* toki, const float* tokw, int row) {
    const int4 q = *(const int4*)(toki + row * 4); const float2 w = *(const float2*)(tokw + row * 2); t.e0 = q.x; t.p0 = q.y; t.e1 = q.z; t.p1 = q.w; t.w0 = w.x; t.w1 = w.y;
}
template <bool FINAL>
__device__ __forceinline__ void cb_issue(CbRow& r, const CbTok& t, int mybase, float* XL, float* XC, const float* modv, const float* modv_next, const bf16* YB, int row, int lane) {
    const int s0 = __shfl(mybase, t.e0) + t.p0, s1 = __shfl(mybase, t.e1) + t.p1;
    const float* xp = xrow_ptr(XL, XC, row); const int bi = row_bi(row); const float* g2 = modv + bi * 6144 + 5120; const float* mv = modv_next + bi * 6144;
#pragma unroll
    for (int j = 0; j < 4; ++j) { const int c = 4 * lane + 256 * j;
        r.ya[j] = *(const u32x2*)(YB + (size_t)s0 * D + c); r.yb[j] = *(const u32x2*)(YB + (size_t)s1 * D + c);
        r.x[j] = *(const f32x4*)(xp + c); r.g2[j] = *(const f32x4*)(g2 + c);
        if constexpr (!FINAL) { r.s0[j] = *(const f32x4*)(mv + c); r.s1[j] = *(const f32x4*)(mv + 1024 + c); } }
}
template <bool FINAL>
__device__ __forceinline__ void cb_finish(const CbRow& r, const CbTok& t, const f32x4 (&gn)[4], float* xp, bf16* hrow, int lane) {
    f32x4 v[4]; float ss = 0.f;
#pragma unroll
    for (int j = 0; j < 4; ++j) { const u32x2 a = r.ya[j], b = r.yb[j]; const float w0 = t.w0, w1 = t.w1;
        f32x4 y; y.x = w0 * bflo(a.x) + w1 * bflo(b.x); y.y = w0 * bfhi(a.x) + w1 * bfhi(b.x); y.z = w0 * bflo(a.y) + w1 * bflo(b.y); y.w = w0 * bfhi(a.y) + w1 * bfhi(b.y);
        v[j] = r.x[j] + r.g2[j] * y;
        ss += (v[j].x * v[j].x + v[j].y * v[j].y) + (v[j].z * v[j].z + v[j].w * v[j].w); }
    const float rs = __builtin_amdgcn_rsqf(wave_sum(ss) * (1.0f / D) + EPSF);
#pragma unroll
    for (int j = 0; j < 4; ++j) { const int c = 4 * lane + 256 * j;
        if constexpr (FINAL) *(f32x4*)(xp + c) = (v[j] * rs) * gn[j];
        else { *(f32x4*)(xp + c) = v[j];
            const f32x4 y = (v[j] * rs) * gn[j] * (1.0f + r.s1[j]) + r.s0[j];
            u32x2 w; w.x = pk2(y.x, y.y); w.y = pk2(y.z, y.w); *(u32x2*)(hrow + c) = w; } }
}
template <bool FINAL>
__device__ __forceinline__ void phase_combine(float* XL, float* XC, const float* modv  , const bf16* YB, const unsigned* cnt, const int* toki, const float* tokw,
                                              const float* gnext, const float* modv_next, bf16* H, int nrows, int lane, int wave, int vcu, int G) {
    int tiles = 0; if (lane < 16) tiles = ((int)__hip_atomic_load(cnt + 64 * lane, RLX_AGENT) + 255) >> 8;
    int incl = tiles;
#pragma unroll
    for (int o = 1; o < 16; o <<= 1) { const int t = __shfl_up(incl, o); if (lane >= o) incl += t; }
    const int mybase = (incl - tiles) * 256;
    f32x4 gn[4];
#pragma unroll
    for (int j = 0; j < 4; ++j) gn[j] = *(const f32x4*)(gnext + 4 * lane + 256 * j);
    CbTok ta, tb, tc; CbRow ra, rb;
    cb_tok(ta, toki, tokw, thin_row(vcu, wave, 0)); cb_tok(tb, toki, tokw, thin_row(vcu, wave, 1));
    cb_issue<FINAL>(ra, ta, mybase, XL, XC, modv, modv_next, YB, thin_row(vcu, wave, 0), lane);
#pragma unroll
    for (int i = 0; i < TROWS; ++i) {
        const int row = thin_row(vcu, wave, i), row1 = thin_row(vcu, wave, i + 1), row2 = thin_row(vcu, wave, i + 2);
        CbTok& tcur = (i % 3 == 0) ? ta : (i % 3 == 1) ? tb : tc; CbTok& tnx = (i % 3 == 0) ? tb : (i % 3 == 1) ? tc : ta; CbTok& tn2 = (i % 3 == 0) ? tc : (i % 3 == 1) ? ta : tb;
        if (i + 2 < TROWS) cb_tok(tn2, toki, tokw, row2 < nrows ? row2 : row);
        if (i + 1 < TROWS) cb_issue<FINAL>((i & 1) ? ra : rb, tnx, mybase, XL, XC, modv, modv_next, YB, row1 < nrows ? row1 : row, lane);
        if (row < nrows) cb_finish<FINAL>((i & 1) ? rb : ra, tcur, gn, xrow_ptr(XL, XC, row), H + (size_t)row * D, lane);
    }
}

struct RoRow { u32x2 a[4], b[4], gt[4]; };
__device__ __forceinline__ void ro_issue(RoRow& r, const bf16* OF, const bf16* OB, const bf16* QKV2, int row, int lane) {
#pragma unroll
    for (int j = 0; j < 4; ++j) { const int c = 4 * lane + 256 * j;
        r.a[j] = *(const u32x2*)(OF + (size_t)row * D + c); r.b[j] = *(const u32x2*)(OB + (size_t)row * D + c); r.gt[j] = *(const u32x2*)(QKV2 + (size_t)row * NGLA + 2048 + c); }
}
__device__ __forceinline__ void ro_finish(const RoRow& r, const f32x4 gg, bf16* orow, int lane) {
#pragma unroll
    for (int j = 0; j < 4; ++j) { const u32x2 a = r.a[j], b = r.b[j], gt = r.gt[j];
        f32x4 o; o.x = bflo(a.x) + bflo(b.x); o.y = bfhi(a.x) + bfhi(b.x); o.z = bflo(a.y) + bflo(b.y); o.w = bfhi(a.y) + bfhi(b.y);
        const float ss = wave_sum((o.x * o.x + o.y * o.y) + (o.z * o.z + o.w * o.w));
        const float rs = __builtin_amdgcn_rsqf(ss * (1.0f / 256.0f) + EPSF);
        f32x4 gv; gv.x = silu_f(bflo(gt.x)); gv.y = silu_f(bfhi(gt.x)); gv.z = silu_f(bflo(gt.y)); gv.w = silu_f(bfhi(gt.y));
        const f32x4 y = (o * rs) * gg * gv;
        u32x2 w; w.x = pk2(y.x, y.y); w.y = pk2(y.z, y.w); *(u32x2*)(orow + 4 * lane + 256 * j) = w; }
}
__device__ __forceinline__ void phase_readout(const bf16* OF, const bf16* OB, const bf16* QKV2, const float* ng, bf16* AOUT, int nrows, int lane, int wave, int vcu, int G) {
    const f32x4 gg = *(const f32x4*)(ng + 4 * lane);
    RoRow ra, rb, rc;
    ro_issue(ra, OF, OB, QKV2, thin_row(vcu, wave, 0), lane); ro_issue(rb, OF, OB, QKV2, thin_row(vcu, wave, 1), lane);
#pragma unroll
    for (int i = 0; i < TROWS; ++i) {
        const int row = thin_row(vcu, wave, i), row2 = thin_row(vcu, wave, i + 2);
        RoRow& cur = (i % 3 == 0) ? ra : (i % 3 == 1) ? rb : rc; RoRow& n2 = (i % 3 == 0) ? rc : (i % 3 == 1) ? ra : rb;
        if (i + 2 < TROWS) ro_issue(n2, OF, OB, QKV2, row2 < nrows ? row2 : row, lane);
        if (row < nrows) ro_finish(cur, gg, AOUT + (size_t)row * D, lane);
    }
}

__device__ __forceinline__ int na_r0(int r) { int v = r - 4; return v < 0 ? 0 : (v > 24 ? 24 : v); }
template <int NMAPS, int DV, bool NA>
__device__ __forceinline__ void attn_unit(LAS unsigned char* lds, int tid, int lane, int wave,
                                          const bf16* QKV, int qcol, int qrow0, int kcol, int krow_lat, int krow_ctx, const bf16* VT, int klo, int khi,
                                          int r_wave, int xq0, const LAS float* biasT,
                                          bf16* AOUT, int ocol, float lam, const float* subg, float outscale) {
    constexpr int KB = 9216;
    constexpr int BUFSZ = NMAPS * KB + DV * 144;
    constexpr int NVB = DV / 16, NVR = DV / 64;
    const int fr = lane & 15, g = lane >> 4;
    bf16x8 qf[NMAPS][2];
    { const bf16* qp = QKV + (size_t)(qrow0 + wave * 16 + fr) * NATT + qcol + 8 * g;
#pragma unroll
      for (int m = 0; m < NMAPS; ++m)
#pragma unroll
          for (int s = 0; s < 2; ++s) qf[m][s] = *(const bf16x8*)(qp + m * 64 + 32 * s); }
    f32x4 O[NMAPS][NVB]; float mrun[NMAPS]; float lrun[NMAPS];
#pragma unroll
    for (int m = 0; m < NMAPS; ++m) { mrun[m] = -1e30f; lrun[m] = 0.f;
#pragma unroll
        for (int vb = 0; vb < NVB; ++vb) O[m][vb] = (f32x4){0.f, 0.f, 0.f, 0.f}; }
    const int ntiles = 4 + (khi - klo);
    u32x4 kreg[NMAPS], vreg[NVR];
    const int lkey = tid >> 3, lch = tid & 7;
#define AT_LOAD(i) do { const int _i = (i); const int _rowg = (_i < 4 ? krow_ctx + 64 * _i : krow_lat + 64 * (klo + _i - 4)) + lkey; const int _tok0 = (_i < 4 ? SEQ + 64 * _i : 64 * (klo + _i - 4)); \
        _Pragma("unroll") for (int m = 0; m < NMAPS; ++m) kreg[m] = *(const u32x4*)(QKV + (size_t)_rowg * NATT + kcol + m * 64 + lch * 8); \
        _Pragma("unroll") for (int j = 0; j < NVR; ++j) { const int idx = tid + 512 * j; vreg[j] = *(const u32x4*)(VT + (size_t)(idx >> 3) * NKEY + _tok0 + (idx & 7) * 8); } } while (0)
#define AT_STORE(b) do { LAS unsigned char* _p = lds + (b) * BUFSZ; \
        _Pragma("unroll") for (int m = 0; m < NMAPS; ++m) *(LAS u32x4*)(_p + m * KB + lkey * 144 + lch * 16) = kreg[m]; \
        _Pragma("unroll") for (int j = 0; j < NVR; ++j) { const int idx = tid + 512 * j; *(LAS u32x4*)(_p + NMAPS * KB + (idx >> 3) * 144 + (idx & 7) * 16) = vreg[j]; } } while (0)
    AT_LOAD(0); AT_STORE(0); __syncthreads();
    const int kbase0 = (8 * (fr >> 2) + (fr & 3)) * 144 + 16 * g;
    const int vbase = fr * 144 + 16 * g;
    int r0w = 0, xq = 0, tmask = 3, c0w = 0; float pen[4][4];
    if constexpr (NA) { r0w = na_r0(r_wave); xq = xq0 + fr; int cs = xq - 8; cs = cs < 0 ? 0 : (cs > 48 ? 48 : cs);
        c0w = xq0 - 8; c0w = c0w < 0 ? 0 : (c0w > 32 ? 32 : c0w);
        tmask = 1;
#pragma unroll
        for (int kb = 0; kb < 4; ++kb)
#pragma unroll
            for (int ii = 0; ii < 4; ++ii) { const int y = c0w + 32 * (kb >> 1) + 8 * g + 4 * (kb & 1) + ii; pen[kb][ii] = (y >= cs && y < cs + 16) ? 0.f : -1e30f; } }
    for (int i = 0; i < ntiles; ++i) {
        if (i + 1 < ntiles) AT_LOAD(i + 1);
        const LAS unsigned char* buf = lds + (i & 1) * BUFSZ;
        bool active = true; int kr = 0; bool local = false;
        if constexpr (NA) { if (i >= 4) { local = true; kr = klo + i - 4; active = (kr >= r0w) && (kr < r0w + 8); } }
        if (active) {
            const int tm = local ? tmask : 3;
            const int koffw = local ? c0w * 144 : 0, voffw = local ? c0w * 2 : 0;
            bf16x8 kf[NMAPS][4][2];
#pragma unroll
            for (int m = 0; m < NMAPS; ++m)
#pragma unroll
                for (int kb = 0; kb < 4; ++kb)
#pragma unroll
                    for (int s = 0; s < 2; ++s) kf[m][kb][s] = *(const LAS bf16x8*)(buf + m * KB + kbase0 + koffw + (kb & 1) * (4 * 144) + (kb >> 1) * (32 * 144) + s * 64);
            __builtin_amdgcn_sched_barrier(0);
            f32x4 S[NMAPS][4];
#pragma unroll
            for (int m = 0; m < NMAPS; ++m)
#pragma unroll
                for (int kb = 0; kb < 4; ++kb) { S[m][kb] = (f32x4){0.f, 0.f, 0.f, 0.f};
                    if (!NA || (tm >> (kb >> 1)) & 1) {
#pragma unroll
                        for (int s = 0; s < 2; ++s) S[m][kb] = __builtin_amdgcn_mfma_f32_16x16x32_bf16(kf[m][kb][s], qf[m][s], S[m][kb], 0, 0, 0); } }
            bf16x8 vf0[4][2];
#pragma unroll
            for (int vb = 0; vb < 4; ++vb)
#pragma unroll
                for (int t = 0; t < 2; ++t) vf0[vb][t] = *(const LAS bf16x8*)(buf + NMAPS * KB + vbase + voffw + vb * (16 * 144) + t * 64);
            __builtin_amdgcn_sched_barrier(0);
            bf16x8 pf[NMAPS][2];
#pragma unroll
            for (int m = 0; m < NMAPS; ++m) {
                if constexpr (NA) { if (local) {
                        const LAS float* bp = biasT + (kr - r_wave + 7) * 31 + (c0w + 8 * g - xq + 15);
#pragma unroll
                        for (int kb = 0; kb < 4; ++kb)
#pragma unroll
                            for (int ii = 0; ii < 4; ++ii) { const float t = (tm >> (kb >> 1)) & 1 ? (S[m][kb][ii] + pen[kb][ii]) + bp[32 * (kb >> 1) + 4 * (kb & 1) + ii] : -1e30f; S[m][kb][ii] = t; } } }
                float mx = fmaxf(fmaxf(S[m][0][0], S[m][0][1]), fmaxf(S[m][0][2], S[m][0][3]));
#pragma unroll
                for (int kb = 1; kb < 4; ++kb) mx = fmaxf(fmaxf(mx, S[m][kb][0]), fmaxf(fmaxf(S[m][kb][1], S[m][kb][2]), S[m][kb][3]));
                mx = swap32_max(swap16_max(mx));
                if (__any(mx > mrun[m] + 8.0f)) {
                    const float mnew = fmaxf(mrun[m], mx), alpha = fexp2(mrun[m] - mnew); mrun[m] = mnew; lrun[m] = lrun[m] * alpha;
#pragma unroll
                    for (int vb = 0; vb < NVB; ++vb) O[m][vb] = O[m][vb] * alpha;
                }
                const float mm = mrun[m];
                unsigned pw[8]; float l0 = 0.f, l1 = 0.f;
#pragma unroll
                for (int kb = 0; kb < 4; ++kb) { const float a0 = fexp2(S[m][kb][0] - mm), a1 = fexp2(S[m][kb][1] - mm), a2 = fexp2(S[m][kb][2] - mm), a3 = fexp2(S[m][kb][3] - mm);
                    l0 += a0 + a1; l1 += a2 + a3;
                    pw[2 * kb] = cvtpk(a0, a1); pw[2 * kb + 1] = cvtpk(a2, a3); }
                lrun[m] += l0 + l1;
                pf[m][0] = __builtin_bit_cast(bf16x8, (u32x4){pw[0], pw[1], pw[2], pw[3]});
                pf[m][1] = __builtin_bit_cast(bf16x8, (u32x4){pw[4], pw[5], pw[6], pw[7]});
            }
            __builtin_amdgcn_sched_barrier(0);
            if constexpr (NVB == 8) {
                bf16x8 vf1[4][2];
#pragma unroll
                for (int vb = 0; vb < 4; ++vb)
#pragma unroll
                    for (int t = 0; t < 2; ++t) vf1[vb][t] = *(const LAS bf16x8*)(buf + NMAPS * KB + vbase + (4 + vb) * (16 * 144) + t * 64);
                __builtin_amdgcn_sched_barrier(0);
#pragma unroll
                for (int vb = 0; vb < 4; ++vb)
#pragma unroll
                    for (int t = 0; t < 2; ++t)
#pragma unroll
                        for (int m = 0; m < NMAPS; ++m) O[m][vb] = __builtin_amdgcn_mfma_f32_16x16x32_bf16(vf0[vb][t], pf[m][t], O[m][vb], 0, 0, 0);
                __builtin_amdgcn_sched_barrier(0);
#pragma unroll
                for (int vb = 0; vb < 4; ++vb)
#pragma unroll
                    for (int t = 0; t < 2; ++t)
#pragma unroll
                        for (int m = 0; m < NMAPS; ++m) O[m][4 + vb] = __builtin_amdgcn_mfma_f32_16x16x32_bf16(vf1[vb][t], pf[m][t], O[m][4 + vb], 0, 0, 0);
            } else {
#pragma unroll
                for (int vb = 0; vb < 4; ++vb)
#pragma unroll
                    for (int t = 0; t < 2; ++t) { if (!NA || (tm >> t) & 1) {
#pragma unroll
                            for (int m = 0; m < NMAPS; ++m) O[m][vb] = __builtin_amdgcn_mfma_f32_16x16x32_bf16(vf0[vb][t], pf[m][t], O[m][vb], 0, 0, 0); } }
            }
            __builtin_amdgcn_sched_barrier(0);
        }
        if (i + 1 < ntiles) AT_STORE((i + 1) & 1);
        __syncthreads();
    }
#undef AT_LOAD
#undef AT_STORE
    float inv[NMAPS];
#pragma unroll
    for (int m = 0; m < NMAPS; ++m) { float l = lrun[m]; l = swap16_add(l, l); l = swap32_add(l, l); inv[m] = 1.0f / l; }
    const int orow = qrow0 + wave * 16 + fr;
    if constexpr (NMAPS == 2) {
        float ss = 0.f; const float i1 = inv[0], i2 = lam * inv[1];
#pragma unroll
        for (int vb = 0; vb < NVB; ++vb) { O[0][vb] = O[0][vb] * i1 - O[1][vb] * i2; const f32x4 o = O[0][vb]; ss += (o.x * o.x + o.y * o.y) + (o.z * o.z + o.w * o.w); }
        ss = swap16_add(ss, ss); ss = swap32_add(ss, ss);
        const float rs = __builtin_amdgcn_rsqf(ss * (1.0f / DV) + EPSF) * outscale;
#pragma unroll
        for (int vb = 0; vb < NVB; ++vb) { const f32x4 gg = *(const f32x4*)(subg + 16 * vb + 4 * g); const f32x4 y = O[0][vb] * rs * gg;
            u32x2 w; w.x = cvtpk(y.x, y.y); w.y = cvtpk(y.z, y.w); *(u32x2*)(AOUT + (size_t)orow * D + ocol + 16 * vb + 4 * g) = w; }
    } else {
#pragma unroll
        for (int vb = 0; vb < NVB; ++vb) { const f32x4 y = O[0][vb] * inv[0];
            u32x2 w; w.x = cvtpk(y.x, y.y); w.y = cvtpk(y.z, y.w); *(u32x2*)(AOUT + (size_t)orow * D + ocol + 16 * vb + 4 * g) = w; }
    }
}


typedef float f32x16 __attribute__((ext_vector_type(16)));
__device__ __forceinline__ void diff_unit32(LAS unsigned char* lds, int tid, int lane, int wave,
                                            const bf16* QKV, int qcol, int qrow0, int kcol, int krow_lat, int krow_ctx, const bf16* VT, int khi,
                                            bf16* AOUT, int ocol, float lam, const float* subg, float outscale) {
    constexpr int KB = 9216, VOFF = 2 * KB, BUFSZ = 2 * KB + 128 * 144;
    const int r = lane & 31, hf = lane >> 5, map = wave >> 2, wq = wave & 3;
    const int swz = ((r >> 4) & 1) << 2;
    bf16x8 qf[4];
    { const bf16* qp = QKV + (size_t)(qrow0 + 32 * wq + r) * NATT + qcol + map * 64 + 8 * hf;
#pragma unroll
      for (int ks = 0; ks < 4; ++ks) qf[ks] = *(const bf16x8*)(qp + 16 * ks); }
    f32x16 O[4];
#pragma unroll
    for (int blk = 0; blk < 4; ++blk)
#pragma unroll
        for (int i = 0; i < 16; ++i) O[blk][i] = 0.f;
    float negm = 0.f, lrun = 0.f;
    const int ntiles = 4 + khi;
    u32x4 kreg[2], vreg[2];
    const int lkey = tid >> 3, lch = tid & 7;
    const int kst = lkey * 144 + ((lch ^ (((lkey >> 4) & 1) << 2)) * 16);
#define D32_LOAD(i) do { const int _i = (i); const int _rowg = (_i < 4 ? krow_ctx + 64 * _i : krow_lat + 64 * (_i - 4)) + lkey; const int _tok0 = (_i < 4 ? SEQ + 64 * _i : 64 * (_i - 4)); \
        _Pragma("unroll") for (int m = 0; m < 2; ++m) kreg[m] = *(const u32x4*)(QKV + (size_t)_rowg * NATT + kcol + m * 64 + lch * 8); \
        _Pragma("unroll") for (int j = 0; j < 2; ++j) { const int idx = tid + 512 * j; vreg[j] = *(const u32x4*)(VT + (size_t)(idx >> 3) * NKEY + _tok0 + (idx & 7) * 8); } } while (0)
#define D32_STORE(b) do { LAS unsigned char* _p = lds + (b) * BUFSZ; \
        _Pragma("unroll") for (int m = 0; m < 2; ++m) *(LAS u32x4*)(_p + m * KB + kst) = kreg[m]; \
        _Pragma("unroll") for (int j = 0; j < 2; ++j) { const int idx = tid + 512 * j, vr = idx >> 3; *(LAS u32x4*)(_p + VOFF + vr * 144 + (((idx & 7) ^ (((vr >> 4) & 1) << 2)) * 16)) = vreg[j]; } } while (0)
    D32_LOAD(0); D32_STORE(0); D32_STORE(2); __syncthreads();
    const int krow = (r & 0x13) | ((r & 4) << 1) | ((r & 8) >> 1);
    const int kbase = map * KB + krow * 144, vbase = VOFF + r * 144;
    bf16x8 pfp[2][2];
#pragma unroll
    for (int kb = 0; kb < 2; ++kb)
#pragma unroll
        for (int sx = 0; sx < 2; ++sx) pfp[kb][sx] = (bf16x8){0, 0, 0, 0, 0, 0, 0, 0};
    int slot = 0;
    for (int i = 0; i < ntiles; ++i) {
        if (i + 1 < ntiles) D32_LOAD(i + 1);
        const int slotn = slot == 2 ? 0 : slot + 1, slotp = slot == 0 ? 2 : slot - 1;
        const LAS unsigned char* buf = lds + slot * BUFSZ; const LAS unsigned char* bufp = lds + slotp * BUFSZ;
        f32x16 S[2];
#pragma unroll
        for (int kb = 0; kb < 2; ++kb) {
#pragma unroll
            for (int ii = 0; ii < 16; ++ii) S[kb][ii] = negm;
#pragma unroll
            for (int ks = 0; ks < 4; ++ks) { const bf16x8 kf = *(const LAS bf16x8*)(buf + kbase + kb * (32 * 144) + (((2 * ks + hf) ^ swz) * 16));
                S[kb] = __builtin_amdgcn_mfma_f32_32x32x16_bf16(kf, qf[ks], S[kb], 0, 0, 0); } }
        __builtin_amdgcn_sched_barrier(0);
        float mx = -1e30f;
#pragma unroll
        for (int kb = 0; kb < 2; ++kb)
#pragma unroll
            for (int ii = 0; ii < 16; ii += 4) mx = fmaxf(fmaxf(mx, S[kb][ii]), fmaxf(fmaxf(S[kb][ii + 1], S[kb][ii + 2]), S[kb][ii + 3]));
        mx = swap32_max(mx);
        const bool resc = (i == 0) || __any(mx > 8.0f);
        float alpha = 1.0f;
        if (resc) { const float dlt = (i == 0) ? mx : fmaxf(mx, 0.f); alpha = fexp2(-dlt); negm -= dlt; lrun *= alpha;
#pragma unroll
            for (int kb = 0; kb < 2; ++kb)
#pragma unroll
                for (int ii = 0; ii < 16; ++ii) S[kb][ii] -= dlt; }
        __builtin_amdgcn_sched_barrier(0);
        bf16x8 pf[2][2]; float l0 = 0.f, l1 = 0.f;
#pragma unroll
        for (int kb = 0; kb < 2; ++kb)
#pragma unroll
            for (int sx = 0; sx < 2; ++sx) { unsigned pw[4];
#pragma unroll
                for (int j = 0; j < 4; ++j) { const float a0 = fexp2(S[kb][8 * sx + 2 * j]), a1 = fexp2(S[kb][8 * sx + 2 * j + 1]); l0 += a0; l1 += a1; pw[j] = cvtpk(a0, a1); }
                pf[kb][sx] = __builtin_bit_cast(bf16x8, (u32x4){pw[0], pw[1], pw[2], pw[3]}); }
        lrun += l0 + l1;
#pragma unroll
        for (int blk = 0; blk < 4; ++blk)
#pragma unroll
            for (int kb = 0; kb < 2; ++kb)
#pragma unroll
                for (int sx = 0; sx < 2; ++sx) { const bf16x8 vf = *(const LAS bf16x8*)(bufp + vbase + blk * (32 * 144) + (((4 * kb + 2 * sx + hf) ^ swz) * 16));
                    O[blk] = __builtin_amdgcn_mfma_f32_32x32x16_bf16(vf, pfp[kb][sx], O[blk], 0, 0, 0); }
#pragma unroll
        for (int k = 0; k < 16; ++k) { __builtin_amdgcn_sched_group_barrier(0x100, 1, 0); __builtin_amdgcn_sched_group_barrier(0x008, 1, 0); __builtin_amdgcn_sched_group_barrier(0x400, 2, 0); __builtin_amdgcn_sched_group_barrier(0x002, 4, 0); }
        __builtin_amdgcn_sched_barrier(0);
        if (resc) {
#pragma unroll
            for (int blk = 0; blk < 4; ++blk) O[blk] = O[blk] * alpha; }
#pragma unroll
        for (int kb = 0; kb < 2; ++kb)
#pragma unroll
            for (int sx = 0; sx < 2; ++sx) pfp[kb][sx] = pf[kb][sx];
        if (i + 1 < ntiles) D32_STORE(slotn);
        slot = slotn;
        __syncthreads();
    }
    { const LAS unsigned char* bufp = lds + (slot == 0 ? 2 : slot - 1) * BUFSZ;
#pragma unroll
      for (int blk = 0; blk < 4; ++blk)
#pragma unroll
          for (int kb = 0; kb < 2; ++kb)
#pragma unroll
              for (int sx = 0; sx < 2; ++sx) { const bf16x8 vf = *(const LAS bf16x8*)(bufp + vbase + blk * (32 * 144) + (((4 * kb + 2 * sx + hf) ^ swz) * 16));
                  O[blk] = __builtin_amdgcn_mfma_f32_32x32x16_bf16(vf, pfp[kb][sx], O[blk], 0, 0, 0); } }
    __syncthreads();
#undef D32_LOAD
#undef D32_STORE
    float l = lrun; l = swap32_add(l, l); const float inv = 1.0f / l;
    LAS float* X = (LAS float*)lds + (size_t)wq * 4096 + lane;
    if (map == 1) {
#pragma unroll
        for (int blk = 0; blk < 4; ++blk)
#pragma unroll
            for (int i = 0; i < 16; ++i) X[(blk * 16 + i) * 64] = O[blk][i] * inv;
    }
    __syncthreads();
    if (map == 0) {
        float ss = 0.f;
#pragma unroll
        for (int blk = 0; blk < 4; ++blk)
#pragma unroll
            for (int i = 0; i < 16; ++i) { const float o = O[blk][i] * inv - lam * X[(blk * 16 + i) * 64]; O[blk][i] = o; ss += o * o; }
        ss = swap32_add(ss, ss);
        const float rs = __builtin_amdgcn_rsqf(ss * (1.0f / 128.0f) + EPSF) * outscale;
        bf16* op = AOUT + (size_t)(qrow0 + 32 * wq + r) * D + ocol + 4 * hf;
#pragma unroll
        for (int blk = 0; blk < 4; ++blk)
#pragma unroll
            for (int g4 = 0; g4 < 4; ++g4) { const int dv0 = 32 * blk + 8 * g4; const f32x4 gg = *(const f32x4*)(subg + dv0 + 4 * hf);
                u32x2 w; w.x = cvtpk(O[blk][4 * g4] * rs * gg.x, O[blk][4 * g4 + 1] * rs * gg.y); w.y = cvtpk(O[blk][4 * g4 + 2] * rs * gg.z, O[blk][4 * g4 + 3] * rs * gg.w);
                *(u32x2*)(op + dv0) = w; }
    }
    __syncthreads();
}

__device__ __forceinline__ void phase_attention(const bf16* QKV, const bf16* VAT, const bf16* VBT, bf16* AOUT, const float* lamp  , float lam_init, const float* subg, const float* nab  ,
                                                unsigned* naq, const ConvPtrs& CP, int clo, int chi, LAS unsigned char* lds, int tid, int lane, int wave) {
    LAS float* biasT = (LAS float*)(lds + LX_BIAS) + 64;
    constexpr int NATT_U = 576 + 1152;
    const int ncu = (chi - clo + CV_UNIT - 1) / CV_UNIT, nq = NATT_U + ncu;
    int mine = 0; if (tid == 0) mine = (int)__hip_atomic_fetch_add(naq, 1u, RLX_AGENT);
    for (;;) {
        __syncthreads();
        if (tid == 0) *(LAS int*)(lds + LX_MISC + 64) = mine;
        __syncthreads();
        const int q = *(LAS int*)(lds + LX_MISC + 64);
        if (q >= nq) break;
        if (tid == 0) mine = (int)__hip_atomic_fetch_add(naq, 1u, RLX_AGENT);
        const int ai = (int)(((long)q * NATT_U) / nq); const bool isatt = (int)(((long)(q + 1) * NATT_U) / nq) > ai;
        if (!isatt) { conv_unit(CP, clo + (q - ai) * CV_UNIT, chi, lds, lane, wave); continue; }
        if (ai < 512 || (ai >= 1536 && ai < 1600)) {
            int bh, qrow0, khi;
            if (ai < 512) { bh = ai >> 4; const int qt = ai & 15; qrow0 = (bh >> 2) * SEQ + qt * 128; khi = 32; }
            else { const int u = ai - 1536; bh = u >> 1; const int qt = u & 1; qrow0 = TX + (bh >> 2) * CTXL + qt * 128; khi = 0; }
            const int b = bh >> 2, h = bh & 3;
            const float lam = __expf(wave_sum(lamp[lane] * lamp[64 + lane])) - __expf(wave_sum(lamp[128 + lane] * lamp[192 + lane])) + lam_init;
            diff_unit32(lds, tid, lane, wave, QKV, h * 128, qrow0, 512 + h * 128, b * SEQ, TX + b * CTXL, VAT + (size_t)bh * 128 * NKEY, khi,
                        AOUT, h * 128, lam, subg, 1.0f - lam_init);
        } else {
            int bh, qrow0, klo, khi, rw;
            if (ai < 1536) { const int u = ai - 512; bh = u >> 4; const int rp = u & 15; qrow0 = (bh >> 3) * SEQ + rp * 128; klo = na_r0(2 * rp); khi = na_r0(2 * rp + 1) + 8; rw = 2 * rp + (wave >> 2); }
            else { const int u = ai - 1600; bh = u >> 1; const int qt = u & 1; qrow0 = TX + (bh >> 3) * CTXL + qt * 128; klo = 0; khi = 0; rw = 0; }
            const int b = bh >> 3, h = bh & 7;
            for (int i = tid; i < 640; i += 512) { const int k = i - 64; biasT[k] = (k >= 0 && k < 465) ? nab[h * 465 + k] * LOG2E : 0.f; }
            attn_unit<1, 64, true>(lds, tid, lane, wave, QKV, 1536 + h * 64, qrow0, 2048 + h * 64, b * SEQ, TX + b * CTXL, VBT + (size_t)bh * 64 * NKEY, klo, khi,
                                   rw, 16 * (wave & 3), biasT, AOUT, 512 + h * 64, 0.f, nullptr, 1.0f);
        }
    }
}

__device__ __forceinline__ void gla_chunk_rows(int b, int dir, int n, int& row0, int& tok0) {
    if (n < 4) { const int cc = dir ? 3 - n : n; row0 = TX + b * CTXL + 64 * cc; tok0 = SEQ + 64 * cc; } else { const int lc = dir ? 35 - n : n - 4; row0 = b * SEQ + 64 * lc; tok0 = 64 * lc; }
}
constexpr int GP_QM = 0, GP_KM = 17408, GP_VT = 34816, GP_LR = 71680, GP_SEG = 75776;
__device__ __forceinline__ void phase_gla_prep(const bf16* QKV2, const bf16* VGT, const float* wgate  , const float* bgate  ,
                                               bf16* QG, bf16* KET, float* FACD, bf16* OF, bf16* OB,
                                               LAS unsigned char* lds, int tid, int lane, int wave, int vcu, int G) {
    const int fr = lane & 15, g = lane >> 4;
    const int d = tid & 127, seg = tid >> 7;
    LAS float* LR = (LAS float*)(lds + GP_LR);
    LAS float* SEG = (LAS float*)(lds + GP_SEG);
    for (int ub = vcu * 9; ub < 2304; ub += G * 9) {
        const int q = ub / 36, n0 = ub % 36, dir = q & 1, hh = (q >> 1) & 3, b = q >> 3;
        bf16* OUT = dir ? OB : OF;
        float wg[16];
#pragma unroll
        for (int r = 0; r < 16; ++r) wg[r] = wgate[(dir * 16 + r) * 512 + hh * 128 + d];
        const float bgv = bgate[dir * 512 + hh * 128 + d];
        const bf16* vtb = VGT + (size_t)(b * 4 + hh) * 256 * NKEY;
        u32x4 qr[2], kr[2], vr[4], lr4;
#define GP_LOAD(n) do { int _row0, _tok0; gla_chunk_rows(b, dir, (n), _row0, _tok0); \
        _Pragma("unroll") for (int j = 0; j < 2; ++j) { const int idx = tid + 512 * j, p = idx >> 4, ch = idx & 15; const bf16* src = QKV2 + (size_t)(_row0 + p) * NGLA + hh * 128 + ch * 8; qr[j] = *(const u32x4*)src; kr[j] = *(const u32x4*)(src + 512); } \
        _Pragma("unroll") for (int j = 0; j < 4; ++j) { const int idx = tid + 512 * j; vr[j] = *(const u32x4*)(vtb + (size_t)(idx >> 3) * NKEY + _tok0 + (idx & 7) * 8); } \
        if (tid < 128) lr4 = *(const u32x4*)(QKV2 + (size_t)(_row0 + (tid >> 1)) * NGLA + 3072 + dir * 16 + (tid & 1) * 8); } while (0)
#define GP_N(i) (dir ? ((i) < 4 ? 3 - (i) : 39 - (i)) : (i))
        GP_LOAD(GP_N(n0));
        for (int k9 = 0; k9 < 9; ++k9) {
            const int n = GP_N(n0 + k9), u = ub - n0 + n; int row0, tok0; gla_chunk_rows(b, dir, n, row0, tok0);
#pragma unroll
            for (int j = 0; j < 2; ++j) { const int idx = tid + 512 * j, p = idx >> 4, ch = idx & 15;
                *(LAS u32x4*)(lds + GP_QM + p * 272 + ch * 16) = qr[j]; *(LAS u32x4*)(lds + GP_KM + p * 272 + ch * 16) = kr[j]; }
#pragma unroll
            for (int j = 0; j < 4; ++j) { const int idx = tid + 512 * j; *(LAS u32x4*)(lds + GP_VT + (idx >> 3) * 144 + (idx & 7) * 16) = vr[j]; }
            if (tid < 128) { LAS float* lp = LR + (tid >> 1) * 16 + (tid & 1) * 8;
                lp[0] = bflo(lr4.x); lp[1] = bfhi(lr4.x); lp[2] = bflo(lr4.y); lp[3] = bfhi(lr4.y); lp[4] = bflo(lr4.z); lp[5] = bfhi(lr4.z); lp[6] = bflo(lr4.w); lp[7] = bfhi(lr4.w); }
            __syncthreads();
            if (k9 + 1 < 9) GP_LOAD(GP_N(n0 + k9 + 1));
            float gc[16];
#pragma unroll
            for (int pi = 0; pi < 16; ++pi) { const LAS f32x4* lp = (const LAS f32x4*)(LR + (16 * seg + pi) * 16); float z = bgv;
#pragma unroll
                for (int k = 0; k < 4; ++k) { const f32x4 l4 = lp[k]; z += l4.x * wg[4 * k] + l4.y * wg[4 * k + 1] + l4.z * wg[4 * k + 2] + l4.w * wg[4 * k + 3]; }
                const float az = fabsf(z); gc[pi] = (fminf(z, 0.f) - flog(1.0f + fexp(-az))) * 0.0625f; }
            float run = 0.f;
            if (dir == 0) {
#pragma unroll
                for (int pi = 0; pi < 16; ++pi) { run += gc[pi]; gc[pi] = run; }
            } else {
#pragma unroll
                for (int pi = 15; pi >= 0; --pi) { run += gc[pi]; gc[pi] = run; }
            }
            SEG[seg * 128 + d] = run;
            __syncthreads();
            const float t0 = SEG[d], t1 = SEG[128 + d], t2 = SEG[256 + d], t3 = SEG[384 + d];
            float off, gmid; const float gend = (t0 + t1) + (t2 + t3);
            if (dir == 0) { off = (seg > 0 ? t0 : 0.f) + (seg > 1 ? t1 : 0.f) + (seg > 2 ? t2 : 0.f); gmid = t0 + t1; }
            else { off = (seg < 3 ? t3 : 0.f) + (seg < 2 ? t2 : 0.f) + (seg < 1 ? t1 : 0.f); gmid = t3 + t2; }
            const float emid = fexp(gmid), eend = fexp(gend - gmid);
            unsigned kep[8];
            bf16* qgp = QG + ((size_t)u * 64 + 16 * seg) * 128 + d;
#pragma unroll
            for (int pi = 0; pi < 16; ++pi) { const int p = 16 * seg + pi; const float rel = off + gc[pi] - gmid; const float Ep = fexp(rel), Ei = fexp(-rel);
                LAS bf16* qa = (LAS bf16*)(lds + GP_QM) + p * 136 + d; LAS bf16* ka = (LAS bf16*)(lds + GP_KM) + p * 136 + d;
                const float qv = bf2f(*qa), kv = bf2f(*ka);
                const float qm = qv * Ep, km = kv * Ei;
                const unsigned w1 = cvtpk(qm, qm * emid), w2 = cvtpk(km, km * eend);
                *qa = (bf16)(w1 & 0xffffu); qgp[pi * 128] = (bf16)(w1 >> 16); *ka = (bf16)(w2 & 0xffffu);
                if (pi & 1) kep[pi >> 1] |= (w2 & 0xffff0000u); else kep[pi >> 1] = w2 >> 16; }
            { u32x4* kt = (u32x4*)(KET + ((size_t)u * 128 + d) * 64 + 16 * seg); kt[0] = (u32x4){kep[0], kep[1], kep[2], kep[3]}; kt[1] = (u32x4){kep[4], kep[5], kep[6], kep[7]}; }
            if (seg == 0) FACD[(size_t)u * 128 + d] = fexp(gend);
            __syncthreads();
            { const int cb = wave & 3, half = wave >> 2;
              bf16x8 qfr[4];
#pragma unroll
              for (int ks = 0; ks < 4; ++ks) qfr[ks] = *(const LAS bf16x8*)(lds + GP_QM + (16 * cb + fr) * 272 + (8 * g + 32 * ks) * 2);
              f32x4 AT[4];
#pragma unroll
              for (int sb = 0; sb < 4; ++sb) { AT[sb] = (f32x4){0.f, 0.f, 0.f, 0.f};
#pragma unroll
                  for (int ks = 0; ks < 4; ++ks) { const bf16x8 af = *(const LAS bf16x8*)(lds + GP_KM + (16 * sb + fr) * 272 + (8 * g + 32 * ks) * 2);
                      AT[sb] = __builtin_amdgcn_mfma_f32_16x16x32_bf16(af, qfr[ks], AT[sb], 0, 0, 0); }
                  const int c = 16 * cb + fr;
#pragma unroll
                  for (int ii = 0; ii < 4; ++ii) { const int sp = 16 * sb + 4 * g + ii; const bool keep = dir ? (sp >= c) : (sp <= c); AT[sb][ii] = keep ? AT[sb][ii] : 0.f; } }
              bf16x8 pf[2];
#pragma unroll
              for (int t = 0; t < 2; ++t) { u32x4 w; w.x = pk2(AT[2 * t][0], AT[2 * t][1]); w.y = pk2(AT[2 * t][2], AT[2 * t][3]); w.z = pk2(AT[2 * t + 1][0], AT[2 * t + 1][1]); w.w = pk2(AT[2 * t + 1][2], AT[2 * t + 1][3]);
                  pf[t] = __builtin_bit_cast(bf16x8, w); }
#pragma unroll
              for (int v8 = 0; v8 < 8; ++v8) { const int vb = 8 * half + v8; f32x4 Oa = (f32x4){0.f, 0.f, 0.f, 0.f};
#pragma unroll
                  for (int t = 0; t < 2; ++t) { const LAS unsigned char* vp = lds + GP_VT + (16 * vb + fr) * 144 + (32 * t + 4 * g) * 2;
                      const u32x2 lo = *(const LAS u32x2*)vp, hi = *(const LAS u32x2*)(vp + 32);
                      u32x4 w; w.x = lo.x; w.y = lo.y; w.z = hi.x; w.w = hi.y;
                      Oa = __builtin_amdgcn_mfma_f32_16x16x32_bf16(__builtin_bit_cast(bf16x8, w), pf[t], Oa, 0, 0, 0); }
                  u32x2 w; w.x = pk2(Oa[0], Oa[1]); w.y = pk2(Oa[2], Oa[3]);
                  *(u32x2*)(OUT + (size_t)(row0 + 16 * cb + fr) * D + hh * 256 + 16 * vb + 4 * g) = w; }
            }
            __syncthreads();
        }
#undef GP_LOAD
#undef GP_N
    }
}

constexpr int GS_BUF = 45056, GS_QG = 0, GS_KET = 17408, GS_VT = 35840, GS_ST = 2 * GS_BUF, GS_DEC = GS_ST + 2 * 17408;
__device__ __forceinline__ void phase_gla(const bf16* VGT, bf16* OF, bf16* OB, const bf16* QG, const bf16* KET, const float* FACD,
                                          LAS unsigned char* lds, int tid, int lane, int wave, int vcu, int G) {
    const int fr = lane & 15, g = lane >> 4;
    for (int u = vcu; u < 256; u += G) {
        const int slab = u & 3, dir = (u >> 2) & 1, hh = (u >> 3) & 3, b = u >> 5;
        bf16* OUT = dir ? OB : OF;
        const int upb = ((b * 4 + hh) * 2 + dir) * 36;
        f32x4 Sacc[4];
#pragma unroll
        for (int vb = 0; vb < 4; ++vb) Sacc[vb] = (f32x4){0.f, 0.f, 0.f, 0.f};
        for (int i = tid; i < 17408 / 4; i += 512) ((LAS unsigned*)(lds + GS_ST))[i] = 0u;
        const bf16* vtb = VGT + ((size_t)(b * 4 + hh) * 256 + slab * 64) * NKEY;
        const int cb = wave & 3, vh = wave >> 2;
        const int ocol = hh * 256 + slab * 64 + 32 * vh + 4 * g;
        struct GsRegs { u32x4 qg[2], ket[2], v; u32x2 oi[2]; float dec; };
        GsRegs R0, R1; R0.dec = 0.f; R1.dec = 0.f;
#define GS_LOAD(R, n) do { int _row0, _tok0; gla_chunk_rows(b, dir, (n), _row0, _tok0); const size_t _u = (size_t)(upb + (n)); \
        _Pragma("unroll") for (int j = 0; j < 2; ++j) { const int idx = tid + 512 * j; R.qg[j] = *(const u32x4*)(QG + _u * 8192 + idx * 8); R.ket[j] = *(const u32x4*)(KET + _u * 8192 + idx * 8); } \
        R.v = *(const u32x4*)(vtb + (size_t)(tid >> 3) * NKEY + _tok0 + (tid & 7) * 8); \
        if (tid < 128) R.dec = FACD[_u * 128 + tid]; \
        _Pragma("unroll") for (int v2 = 0; v2 < 2; ++v2) R.oi[v2] = *(const u32x2*)(OUT + (size_t)(_row0 + 16 * cb + fr) * D + ocol + 16 * v2); } while (0)
#define GS_STORE(R, bf) do { LAS unsigned char* _p = lds + (bf) * GS_BUF; \
        _Pragma("unroll") for (int j = 0; j < 2; ++j) { const int idx = tid + 512 * j; *(LAS u32x4*)(_p + GS_QG + (idx >> 4) * 272 + (idx & 15) * 16) = R.qg[j]; *(LAS u32x4*)(_p + GS_KET + (idx >> 3) * 144 + (idx & 7) * 16) = R.ket[j]; } \
        *(LAS u32x4*)(_p + GS_VT + (tid >> 3) * 144 + (tid & 7) * 16) = R.v; \
        if (tid < 128) ((LAS float*)(lds + GS_DEC))[(bf) * 128 + tid] = R.dec; } while (0)
#define GS_ITER(n, RN, RF) do { const int _n = (n); int row0, tok0; gla_chunk_rows(b, dir, _n, row0, tok0); const int cur = _n & 1; \
            if (_n + 2 < 36) GS_LOAD(RF, _n + 2); \
            const LAS unsigned char* bufp = lds + cur * GS_BUF; const LAS unsigned char* stp = lds + GS_ST + cur * 17408; \
            { bf16x8 qfr[4]; \
              _Pragma("unroll") for (int ks = 0; ks < 4; ++ks) qfr[ks] = *(const LAS bf16x8*)(bufp + GS_QG + (16 * cb + fr) * 272 + (8 * g + 32 * ks) * 2); \
              _Pragma("unroll") for (int v2 = 0; v2 < 2; ++v2) { const int vb = 2 * vh + v2; const u32x2 oin = v2 ? oc1 : oc0; \
                  f32x4 Oa = (f32x4){bflo(oin.x), bfhi(oin.x), bflo(oin.y), bfhi(oin.y)}; \
                  _Pragma("unroll") for (int ks = 0; ks < 4; ++ks) { const bf16x8 af = *(const LAS bf16x8*)(stp + (16 * vb + fr) * 272 + (8 * g + 32 * ks) * 2); \
                      Oa = __builtin_amdgcn_mfma_f32_16x16x32_bf16(af, qfr[ks], Oa, 0, 0, 0); } \
                  u32x2 w; w.x = pk2(Oa[0], Oa[1]); w.y = pk2(Oa[2], Oa[3]); \
                  *(u32x2*)(OUT + (size_t)(row0 + 16 * cb + fr) * D + ocol + 16 * v2) = w; } } \
            { const f32x4 dec = *(const LAS f32x4*)((LAS float*)(lds + GS_DEC) + cur * 128 + 16 * wave + 4 * g); \
              LAS unsigned char* stn = lds + GS_ST + (cur ^ 1) * 17408; \
              _Pragma("unroll") for (int vb = 0; vb < 4; ++vb) { Sacc[vb] = Sacc[vb] * dec; \
                  _Pragma("unroll") for (int t = 0; t < 2; ++t) { const bf16x8 af = *(const LAS bf16x8*)(bufp + GS_KET + (16 * wave + fr) * 144 + (8 * g + 32 * t) * 2); \
                      const bf16x8 bfr = *(const LAS bf16x8*)(bufp + GS_VT + (16 * vb + fr) * 144 + (8 * g + 32 * t) * 2); \
                      Sacc[vb] = __builtin_amdgcn_mfma_f32_16x16x32_bf16(af, bfr, Sacc[vb], 0, 0, 0); } \
                  u32x2 w; w.x = pk2(Sacc[vb][0], Sacc[vb][1]); w.y = pk2(Sacc[vb][2], Sacc[vb][3]); \
                  *(LAS u32x2*)(stn + (16 * vb + fr) * 272 + (16 * wave + 4 * g) * 2) = w; } } \
            if (_n + 1 < 36) { GS_STORE(RN, cur ^ 1); oc0 = RN.oi[0]; oc1 = RN.oi[1]; } \
            __syncthreads(); } while (0)
        GS_LOAD(R0, 0); GS_STORE(R0, 0);
        u32x2 oc0 = R0.oi[0], oc1 = R0.oi[1];
        GS_LOAD(R0, 1);
        __syncthreads();
        for (int n = 0; n < 36; n += 2) { GS_ITER(n, R0, R1); GS_ITER(n + 1, R1, R0); }
#undef GS_ITER
#undef GS_LOAD
#undef GS_STORE
    }
}

constexpr int N_PHASES = 34;
typedef const Args __attribute__((address_space(4)))* KArgs;
__device__ __forceinline__ KArgs kargs() { KArgs p = (KArgs)__builtin_amdgcn_kernarg_segment_ptr(); asm volatile("" : "+s"(p)); return p; }
__global__ void __launch_bounds__(512, 2) fwd(Args a_unused) {
    extern __shared__ __attribute__((aligned(16))) unsigned char lds_raw[];
    LAS unsigned char* lds = (LAS unsigned char*)lds_raw;
    const int tid0 = threadIdx.x;
    const int G0 = gridDim.x; const int bx0 = blockIdx.x;
#define PH_ENTRY int tid = tid0; asm volatile("" : "+v"(tid)); int G = G0, bx = bx0; asm volatile("" : "+s"(G), "+s"(bx)); const int lane = tid & 63, wave = __builtin_amdgcn_readfirstlane(tid >> 6); \
        const int vcu = (G % 8 == 0) ? (bx % 8) * (G / 8) + bx / 8 : bx; (void)lane; (void)wave; (void)vcu
    const int tid = tid0;
    const int ph_lo = kargs()->ph_lo, ph_hi = kargs()->ph_hi;
    const int repmask = kargs()->rep;
    if (tid < 64) ((LAS unsigned*)(lds + LX_MISC))[tid] = 0u;
    for (int i = tid; i < 1024; i += 512) { const int pos = i >> 4, f = i & 15; const float inv = __builtin_amdgcn_exp2f(-(float)f * (13.287712379549449f / 16.0f)); const float ang = (float)pos * inv;
        ((LAS float*)(lds + LX_ROPE))[2 * i] = __cosf(ang); ((LAS float*)(lds + LX_ROPE))[2 * i + 1] = __sinf(ang); }
    __syncthreads();
    const bool single = (ph_hi - ph_lo) > 1;
    XcdBarrier bar; bar.bar = (unsigned*)(kargs()->ws + WS_CTL) + CW_BAR; bar.x = 0; bar.st = (volatile LAS unsigned*)(lds + LX_MISC);
    if (single) bar = xcd_barrier_post((unsigned*)(kargs()->ws + WS_CTL) + CW_BAR, (volatile LAS unsigned*)(lds + LX_MISC));
#define IN(k) (ph_lo <= (k) && (k) < ph_hi)
#define REPLOOP(t) for (int rep_ = 0, nrep_ = 1 + ((repmask >> (t)) & 1); rep_ < nrep_; ++rep_, (rep_ < nrep_ ? (bar.bar = (unsigned*)(kargs()->ws + WS_CTL) + CW_BAR, xcd_barrier(bar)) : (void)0))
#define SEAM(k) do { if (IN(k) && IN((k) + 1)) { bar.bar = (unsigned*)(kargs()->ws + WS_CTL) + CW_BAR; xcd_barrier(bar); if ((repmask >> 10) & 1) xcd_barrier(bar); } } while (0)
    LAS int* tab = (LAS int*)(lds + LX_MOETAB);
#define CONV_PTRS(A) ConvPtrs{(A)->att_w_in, (A)->att_w_out, (A)->gla_w_in, (A)->gla_w_out, (A)->moe_w1, (A)->moe_w3, (A)->moe_w2, (A)->ws}

    if (IN(0)) REPLOOP(0) { PH_ENTRY; p0_prologue(kargs(), lds, tid, lane, wave, vcu, G); } SEAM(0);
    if (IN(1)) { PH_ENTRY; KArgs A = kargs(); unsigned char* ws = A->ws; phase_norm1(A->x, A->ctx, A->norm_g, (float*)(ws + WS_MODV), (bf16*)(ws + WS_H), TALL, lane, wave, vcu, G); } SEAM(1);

#pragma nounroll
    for (int L = 0; L < 4; ++L) {
        const int pb = 2 + 8 * L; const bool isattn = !(L & 1); const int j = L >> 1; const bool lastL = (L == 3);
        const int nrows = lastL ? TX : TALL;
        if (IN(pb)) REPLOOP(isattn ? 1 : 3) {
            PH_ENTRY; KArgs A = kargs(); unsigned char* ws = A->ws; unsigned char* big = ws + WS_BIG; const bf16* H = (const bf16*)(ws + WS_H);
            if (isattn) {
                pg8::DenseOrder S; S.init(H, (const bf16*)(ws + WS_WATTIN) + (size_t)j * NATT * D, TALL, NATT, D, G, bx);
                pg8::EpiAttnIn E{(bf16*)(big + BG_QKV), (bf16*)(big + BG_VAT), (bf16*)(big + BG_VBT), (const LAS float*)(lds + LX_ROPE)};
                pg8::gemm_phase<pg8::EpiAttnIn, pg8::DenseOrder, false>(lds, tid, D, S, E);
            } else {
                pg8::DenseOrder S; S.init(H, (const bf16*)(ws + WS_WGLAIN) + (size_t)j * NGLA * D, TALL, NGLA, D, G, bx);
                pg8::EpiGlaIn E{(bf16*)(big + BG_QKV2), (bf16*)(big + BG_VGT)};
                pg8::gemm_phase<pg8::EpiGlaIn, pg8::DenseOrder, false>(lds, tid, D, S, E);
            }
        }
        SEAM(pb);
        if (!isattn && IN(pb + 1)) {
            for (int rep_ = 0; rep_ <= ((repmask >> 13) & 1); ++rep_)
            { PH_ENTRY; KArgs A = kargs(); unsigned char* ws = A->ws;
              phase_gla_prep((const bf16*)(ws + WS_BIG + BG_QKV2), (const bf16*)(ws + WS_BIG + BG_VGT), A->gla_w_gate + j * 2 * 16 * 512, A->gla_b_gate + j * 2 * 512,
                             (bf16*)(ws + WS_QG), (bf16*)(ws + WS_KET), (float*)(ws + WS_BIG + BG_FAC), (bf16*)(ws + WS_BIG + BG_OF), (bf16*)(ws + WS_BIG + BG_OB), lds, tid, lane, wave, vcu, G); }
            if (single) { bar.bar = (unsigned*)(kargs()->ws + WS_CTL) + CW_BAR; xcd_barrier(bar); }
        }
        if (IN(pb + 1)) REPLOOP(isattn ? 2 : 4) {
            PH_ENTRY; KArgs A = kargs(); unsigned char* ws = A->ws; unsigned char* big = ws + WS_BIG; bf16* AOUT = (bf16*)(ws + WS_AOUT);
            if (isattn) { const ConvPtrs CP = CONV_PTRS(A);
                phase_attention((const bf16*)(big + BG_QKV), (const bf16*)(big + BG_VAT), (const bf16*)(big + BG_VBT), AOUT, A->att_lambda + j * 256, (L == 0) ? 0.2f : 0.470713018f,
                                A->att_subln_g + j * 128, A->na_bias + j * 8 * 465, (unsigned*)(ws + WS_CTL) + CW_NAQ + 64 * j, CP,
                                MK_CONVQ ? (L == 0 ? CT_ATTN0 : CT_MOE1) : 0, MK_CONVQ ? (L == 0 ? CT_MOE1 : CT_MOE3) : 0, lds, tid, lane, wave); }
            else phase_gla((const bf16*)(big + BG_VGT), (bf16*)(big + BG_OF), (bf16*)(big + BG_OB), (const bf16*)(ws + WS_QG), (const bf16*)(ws + WS_KET), (const float*)(big + BG_FAC),
                           lds, tid, lane, wave, vcu, G);
        }
        SEAM(pb + 1);
        if (!isattn) {
            if (IN(pb + 2)) REPLOOP(5) { PH_ENTRY; KArgs A = kargs(); unsigned char* ws = A->ws; unsigned char* big = ws + WS_BIG;
                phase_readout((const bf16*)(big + BG_OF), (const bf16*)(big + BG_OB), (const bf16*)(big + BG_QKV2), A->gla_norm_g + j * 256, (bf16*)(ws + WS_AOUT), nrows, lane, wave, vcu, G); }
            SEAM(pb + 2);
        }
        if (IN(pb + 3)) {
            PH_ENTRY; KArgs A = kargs(); unsigned char* ws = A->ws;
            pg8::DenseOrder S; S.init((const bf16*)(ws + WS_AOUT), (const bf16*)(ws + (isattn ? WS_WATTOUT : WS_WGLAOUT)) + (size_t)j * D * D, nrows, D, D, G, bx);
            pg8::EpiResid E{L == 0 ? A->x : A->out, L == 0 ? A->ctx : (const float*)(ws + WS_CTX), A->out, (float*)(ws + WS_CTX), (const float*)(ws + WS_MODV) + (size_t)L * 9 * 6144 + 2048};
            pg8::gemm_phase<pg8::EpiResid, pg8::DenseOrder, false>(lds, tid, D, S, E);
        }
        SEAM(pb + 3);
        if (IN(pb + 4)) { PH_ENTRY; KArgs A = kargs(); unsigned char* ws = A->ws;
            phase_router(A->out, (float*)(ws + WS_CTX), A->norm_g + (L * 2 + 1) * D, (const float*)(ws + WS_MODV) + (size_t)L * 9 * 6144, (bf16*)(ws + WS_H), A->router_w, A->router_bias,
                         (unsigned*)(ws + WS_CTL) + CW_CNT + L * 16 * 64, (int*)(ws + WS_LIST), (int*)(ws + WS_TOKI), (float*)(ws + WS_TOKW), nrows, lds, tid, lane, wave, vcu, G, (repmask >> 11) & 1); }
        SEAM(pb + 4);
        if (IN(pb + 5)) REPLOOP(6) {
            PH_ENTRY; KArgs A = kargs(); unsigned char* ws = A->ws;
            const int RT = build_moe_table((unsigned*)(ws + WS_CTL) + CW_CNT + L * 16 * 64, tab, tid);
            pg8::MoeOrder S; S.A = (const char*)(ws + WS_H); S.B = (const char*)(ws + WS_W13) + (size_t)L * 16 * D * D * 2; S.K = D; S.bstride = (size_t)D * D * 2; S.tab = tab; S.list = (const int*)(ws + WS_LIST); S.RT = RT; S.nwg = RT * 4; S.G = G; S.c = bx;
            pg8::EpiMoe1 E{(bf16*)(ws + WS_BIG + BG_HB)};
            pg8::gemm_phase<pg8::EpiMoe1, pg8::MoeOrder, true>(lds, tid, D, S, E);
        }
        SEAM(pb + 5);
        if (IN(pb + 6)) REPLOOP(7) {
            PH_ENTRY; KArgs A = kargs(); unsigned char* ws = A->ws;
            const int RT = build_moe_table((unsigned*)(ws + WS_CTL) + CW_CNT + L * 16 * 64, tab, tid);
            pg8::MoeOrder S; S.A = (const char*)(ws + WS_BIG + BG_HB); S.B = (const char*)(ws + WS_W2) + (size_t)L * 16 * D * DEXP * 2; S.K = DEXP; S.bstride = (size_t)D * DEXP * 2; S.tab = tab; S.list = (const int*)(ws + WS_LIST); S.RT = RT; S.nwg = RT * 4; S.G = G; S.c = bx;
            pg8::EpiBf16 E{(bf16*)(ws + WS_BIG + BG_YB), D};
            pg8::gemm_phase<pg8::EpiBf16, pg8::MoeOrder, false>(lds, tid, DEXP, S, E);
        }
        SEAM(pb + 6);
        if (IN(pb + 7)) { PH_ENTRY; KArgs A = kargs(); unsigned char* ws = A->ws; const float* MODV = (const float*)(ws + WS_MODV);
            if (lastL) phase_combine<true>(A->out, (float*)(ws + WS_CTX), MODV + (size_t)L * 9 * 6144, (const bf16*)(ws + WS_BIG + BG_YB), (unsigned*)(ws + WS_CTL) + CW_CNT + L * 16 * 64, (const int*)(ws + WS_TOKI), (const float*)(ws + WS_TOKW),
                                           A->final_g, MODV + (size_t)L * 9 * 6144, (bf16*)(ws + WS_H), nrows, lane, wave, vcu, G);
            else phase_combine<false>(A->out, (float*)(ws + WS_CTX), MODV + (size_t)L * 9 * 6144, (const bf16*)(ws + WS_BIG + BG_YB), (unsigned*)(ws + WS_CTL) + CW_CNT + L * 16 * 64, (const int*)(ws + WS_TOKI), (const float*)(ws + WS_TOKW),
                                      A->norm_g + ((L + 1) * 2) * D, MODV + (size_t)(L + 1) * 9 * 6144, (bf16*)(ws + WS_H), nrows, lane, wave, vcu, G); }
        if (!lastL) SEAM(pb + 7);
    }
#undef IN
#undef REPLOOP
#undef SEAM
#undef CONV_PTRS

#undef PH_ENTRY
}

extern "C" void kernel_launch(void* const* d_in, const int* in_sizes, int n_in, void* d_out, int out_size, void* d_ws, size_t ws_size, hipStream_t stream) {
    static int ready = 0;
    if (ready == 0) {
        if (n_in != 23 || out_size != TX * D || ws_size < WS_END) { fprintf(stderr, "kernel_launch: unexpected shapes (n_in %d out %d ws %zu)\n", n_in, out_size, ws_size); ready = -1; return; }
        if (hipFuncSetAttribute((const void*)fwd, hipFuncAttributeMaxDynamicSharedMemorySize, LDS_BYTES) != hipSuccess) { fprintf(stderr, "kernel_launch: hipFuncSetAttribute failed\n"); ready = -1; return; }
        int per_cu = 0; (void)hipOccupancyMaxActiveBlocksPerMultiprocessor(&per_cu, (const void*)fwd, 512, LDS_BYTES); (void)hipGetLastError();
        if (per_cu < 1) fprintf(stderr, "kernel_launch: occupancy query reports %d blocks per CU\n", per_cu);
        ready = 1;
    }
    if (ready < 0) return;
    (void)hipMemsetAsync((char*)d_ws + WS_CTL, 0, CTL_ZERO_BYTES, stream);
    Args a{};
    const float** ap = (const float**)&a;
    for (int i = 0; i < 23; ++i) ap[i] = (const float*)d_in[i];
    a.out = (float*)d_out; a.ws = (unsigned char*)d_ws;
    const int grid = 256;
    a.ph_lo = 0; a.ph_hi = N_PHASES; a.rep = MK_REPMASK;
    hipLaunchKernelGGL(fwd, dim3(grid), dim3(512), LDS_BYTES, stream, a);
}
```

```cpp
#include <hip/hip_runtime.h>
#include <cstdio>
#include <cstdint>

#ifndef MK_CONVQ
#define MK_CONVQ 1
#endif
#ifndef MK_REPMASK
#define MK_REPMASK 0
#endif

#define GAS __attribute__((address_space(1)))
#define LAS __attribute__((address_space(3)))
typedef unsigned short bf16;
typedef short bf16x8 __attribute__((ext_vector_type(8)));
typedef short bf16x4 __attribute__((ext_vector_type(4)));
typedef float f32x4 __attribute__((ext_vector_type(4)));
typedef float f32x2 __attribute__((ext_vector_type(2)));
typedef unsigned u32x4 __attribute__((ext_vector_type(4)));
typedef unsigned u32x2 __attribute__((ext_vector_type(2)));

constexpr int D = 1024, NB = 8, SEQ = 2048, CTXL = 256;
constexpr int TX = NB * SEQ, TC = NB * CTXL, TALL = TX + TC;
constexpr int NKEY = SEQ + CTXL;
constexpr int NATT = 3072, NGLA = 3328;
constexpr float EPSF = 1e-6f;
constexpr float LOG2E = 1.4426950408889634f;
constexpr int NEXP = 16, DEXP = 512;
constexpr int RT_MAX = 160;

constexpr size_t MiB = 1u << 20;
constexpr size_t WS_CTL = 0, CTL_ZERO_BYTES = 65536;
constexpr size_t WS_MODV = 1 * MiB;
constexpr size_t WS_TOKI = 2 * MiB;
constexpr size_t WS_TOKW = 2 * MiB + 512 * 1024;
constexpr size_t WS_LIST = 3 * MiB;
constexpr size_t WS_CTX = 5 * MiB;
constexpr size_t WS_WATTIN = 13 * MiB;
constexpr size_t WS_WATTOUT = 25 * MiB;
constexpr size_t WS_WGLAIN = 29 * MiB;
constexpr size_t WS_WGLAOUT = 42 * MiB;
constexpr size_t WS_W13 = 46 * MiB;
constexpr size_t WS_W2 = 174 * MiB;
constexpr size_t WS_H = 238 * MiB;
constexpr size_t WS_AOUT = 274 * MiB;
constexpr size_t WS_BIG = 310 * MiB;
constexpr size_t WS_END = 539 * MiB;
constexpr size_t BG_QKV = 0;
constexpr size_t BG_VAT = 108 * MiB;
constexpr size_t BG_VBT = 126 * MiB;
constexpr size_t BG_QKV2 = 0;
constexpr size_t BG_VGT = 117 * MiB;
constexpr size_t BG_OF = 153 * MiB;
constexpr size_t BG_OB = 189 * MiB;
constexpr size_t BG_FAC = 225 * MiB;
constexpr size_t WS_QG = WS_H, WS_KET = WS_AOUT;
constexpr size_t BG_HB = 0;
constexpr size_t BG_YB = 40 * MiB;
constexpr int CW_TMO = 0;
constexpr int CW_BAR = 4096;
constexpr int CW_NAQ = 15360;
constexpr int CW_CNT = 8192;

constexpr int RING_BYTES = 131072;
constexpr int LX_OFF = RING_BYTES;
constexpr int LX_MISC = LX_OFF;
constexpr int LX_MOETAB = LX_OFF + 256;
constexpr int LX_ROPE = LX_OFF + 2048;
constexpr int LX_BIAS = LX_OFF + 2048 + 8192;
constexpr int LDS_BYTES = 147456;

#define LDS_WAIT() asm volatile("s_waitcnt lgkmcnt(0)" ::: "memory")
#define VM_WAIT() asm volatile("s_waitcnt vmcnt(0)" ::: "memory")
#define RLX_AGENT __ATOMIC_RELAXED, __HIP_MEMORY_SCOPE_AGENT
__device__ __forceinline__ unsigned f2bf(float f) { unsigned u = __builtin_bit_cast(unsigned, f); return (u + 0x7fffu + ((u >> 16) & 1u)) >> 16; }
typedef __bf16 hwbf16x2 __attribute__((ext_vector_type(2)));
__device__ __forceinline__ unsigned cvtpk(float lo, float hi) { const f32x2 v = {lo, hi}; const hwbf16x2 b = __builtin_convertvector(v, hwbf16x2); return __builtin_bit_cast(unsigned, b); }
__device__ __forceinline__ unsigned pk2(float lo, float hi) { return cvtpk(lo, hi); }
__device__ __forceinline__ float bf2f(unsigned short b) { return __builtin_bit_cast(float, ((unsigned)b) << 16); }
__device__ __forceinline__ float bflo(unsigned w) { return __builtin_bit_cast(float, w << 16); }
__device__ __forceinline__ float bfhi(unsigned w) { return __builtin_bit_cast(float, w & 0xffff0000u); }
template <int CTRL> __device__ __forceinline__ float dppf(float v) { return __builtin_bit_cast(float, __builtin_amdgcn_update_dpp(0, __builtin_bit_cast(int, v), CTRL, 0xf, 0xf, true)); }
__device__ __forceinline__ float row_sum(float v) { v += dppf<0xB1>(v); v += dppf<0x4E>(v); v += dppf<0x124>(v); v += dppf<0x128>(v); return v; }
__device__ __forceinline__ float swap16_add(float a, float b) { auto r = __builtin_amdgcn_permlane16_swap(__float_as_uint(a), __float_as_uint(b), false, false); const unsigned r0 = r[0], r1 = r[1]; return __uint_as_float(r0) + __uint_as_float(r1); }
__device__ __forceinline__ float swap32_add(float a, float b) { auto r = __builtin_amdgcn_permlane32_swap(__float_as_uint(a), __float_as_uint(b), false, false); const unsigned r0 = r[0], r1 = r[1]; return __uint_as_float(r0) + __uint_as_float(r1); }
__device__ __forceinline__ float swap16_max(float a) { auto r = __builtin_amdgcn_permlane16_swap(__float_as_uint(a), __float_as_uint(a), false, false); const unsigned r0 = r[0], r1 = r[1]; return fmaxf(__uint_as_float(r0), __uint_as_float(r1)); }
__device__ __forceinline__ float swap32_max(float a) { auto r = __builtin_amdgcn_permlane32_swap(__float_as_uint(a), __float_as_uint(a), false, false); const unsigned r0 = r[0], r1 = r[1]; return fmaxf(__uint_as_float(r0), __uint_as_float(r1)); }
__device__ __forceinline__ float readlane_f(float v, int l) { return __int_as_float(__builtin_amdgcn_readlane(__float_as_int(v), l)); }
__device__ __forceinline__ float wave_sum(float v) { v = row_sum(v); v = swap16_add(v, v); return swap32_add(v, v); }
__device__ __forceinline__ float fexp2(float x) { return __builtin_amdgcn_exp2f(x); }
__device__ __forceinline__ float fexp(float x) { return __builtin_amdgcn_exp2f(x * LOG2E); }
__device__ __forceinline__ float flog(float x) { return __builtin_amdgcn_logf(x) * 0.6931471805599453f; }
__device__ __forceinline__ float frcp(float x) { return __builtin_amdgcn_rcpf(x); }
__device__ __forceinline__ float silu_f(float x) { return x * frcp(1.0f + fexp(-x)); }

#define XB_TMO      128
#define XB_XCNT(j)  (256  + 64 * (j))
#define XB_XSUB(j)  (1280 + 64 * (j))
#define XB_XGEN(j)  (2304 + 64 * (j))
#define XB_TOP      3328
#define XB_TOPGEN   3392
#define XCD_BAR_WORDS 3456
#define XB_SPIN_CAP (1u << 18)
__device__ __forceinline__ unsigned xb_ld(unsigned* p)              { return __hip_atomic_load(p, __ATOMIC_RELAXED, __HIP_MEMORY_SCOPE_AGENT); }
__device__ __forceinline__ unsigned xb_add(unsigned* p, unsigned v) { return __hip_atomic_fetch_add(p, v, __ATOMIC_RELAXED, __HIP_MEMORY_SCOPE_AGENT); }
__device__ __forceinline__ unsigned xb_xcc_id() { return (unsigned)__builtin_amdgcn_s_getreg((3 << 11) | 20) & 0xFu; }
#define XB_SPIN(cond, bar) do { unsigned _sp = 0; while (cond) { __builtin_amdgcn_s_sleep(1); \
    if ((++_sp & 255u) == 0u) { if (xb_ld(&(bar)[XB_TMO])) break; if (_sp > XB_SPIN_CAP) { atomicAdd(&(bar)[XB_TMO], 1u); break; } } } } while (0)
struct XcdBarrier { unsigned* bar; unsigned x; volatile LAS unsigned* st; };
__device__ __forceinline__ XcdBarrier xcd_barrier_post(unsigned* bar, volatile LAS unsigned* st) {
    XcdBarrier b; b.bar = bar; b.x = xb_xcc_id(); b.st = st;
    if (threadIdx.x == 0) (void)xb_add(&bar[XB_XCNT(b.x)], 1u);
    return b;
}
__device__ __forceinline__ void xcd_barrier_complete(unsigned* bar, unsigned x, unsigned& nloc, unsigned& nx) {
    const unsigned G = gridDim.x * gridDim.y * gridDim.z;
    unsigned sum, cnt, mine, sp = 0u;
    for (;;) {
        sum = 0u; cnt = 0u; mine = 0u;
#pragma unroll
        for (unsigned j = 0; j < 16; ++j) { const unsigned c = xb_ld(&bar[XB_XCNT(j)]); sum += c; cnt += (c > 0u) ? 1u : 0u; mine = (j == x) ? c : mine; }
        if (sum == G) break;
        __builtin_amdgcn_s_sleep(1);
        if ((++sp & 255u) == 0u) { if (xb_ld(&bar[XB_TMO])) break; if (sp > XB_SPIN_CAP) { atomicAdd(&bar[XB_TMO], 1u); break; } }
    }
    nloc = mine > 0u ? mine : 1u; nx = cnt > 0u ? cnt : 1u;
}
__device__ __forceinline__ void xcd_barrier(const XcdBarrier& b) {
    asm volatile("s_waitcnt vmcnt(0)" ::: "memory");
    __syncthreads();
    if (threadIdx.x == 0) {
        unsigned* bar = b.bar;
        __builtin_amdgcn_s_waitcnt(0);
        unsigned nloc = b.st[0], nx = b.st[1];
        if (nloc == 0u) { xcd_barrier_complete(bar, b.x, nloc, nx); b.st[0] = nloc; b.st[1] = nx; }
        const unsigned old = xb_add(&bar[XB_XSUB(b.x)], 1u);
        const unsigned gen = old / nloc;
        if (old + 1u == (gen + 1u) * nloc) {
            __builtin_amdgcn_fence(__ATOMIC_RELEASE, "agent");
            asm volatile("s_waitcnt vmcnt(0)" ::: "memory");
            const unsigned og = xb_add(&bar[XB_TOP], 1u);
            const unsigned tg = og / nx;
            if (og + 1u == (tg + 1u) * nx) xb_add(&bar[XB_TOPGEN], 1u);
            else XB_SPIN(xb_ld(&bar[XB_TOPGEN]) == tg, bar);
            __builtin_amdgcn_fence(__ATOMIC_ACQUIRE, "agent");
            xb_add(&bar[XB_XGEN(b.x)], 1u);
            asm volatile("s_waitcnt vmcnt(0)" ::: "memory");
        } else {
            XB_SPIN(xb_ld(&bar[XB_XGEN(b.x)]) == gen, bar);
            __builtin_amdgcn_fence(__ATOMIC_ACQUIRE, "agent");
            asm volatile("s_waitcnt vmcnt(0)" ::: "memory");
        }
    }
    __syncthreads();
}

namespace pg8 {
constexpr int BM = 256, BK = 64, HALF = 128, HTB = HALF * BK * 2, STAGE_BYTES = 8 * HTB, NXCD = 8, WGM = 8;
__host__ __device__ __forceinline__ int lds_byte(int r, int c) { const int st = (r >> 4) * 2 + (c >> 5), rr = r & 15, cc = c & 31, ob = rr * 64 + cc * 2; return st * 1024 + (ob ^ (((ob >> 9) & 1) << 5)); }
__host__ __device__ __forceinline__ void stage_rc(int b, int& R, int& C) { const int st = b / 1024, sb = b % 1024, swz = sb ^ (((sb >> 9) & 1) << 5); R = (st >> 1) * 16 + swz / 64; C = (st & 1) * 32 + (swz % 64) / 2; }
__host__ __device__ __forceinline__ int perm32(int rho) { const int n = rho >> 4, i = rho & 15; return 8 * (i >> 2) + 4 * n + (i & 3); }

struct Unit { int pm, pn, e, mt, roff, nai; };
__device__ __forceinline__ bool split_index(long L, int nwg, int G, int& uidx, int& roff, int& nai) {
    const int R = nwg / G, r = nwg % G; const bool split = (r > 0) && (2 * r <= G);
    if (L < (long)R * G || !split) { if (L >= nwg) return false; uidx = (int)L; roff = 0; nai = 2; return true; }
    const int h = (int)(L - (long)R * G); if (h >= 2 * r) return false; uidx = R * G + (h >> 1); roff = (h & 1) * 128; nai = 1; return true;
}

__device__ __forceinline__ int xcd_remap(int wgid, int nwg) { const int q = nwg / NXCD, r = nwg % NXCD, xcd = wgid % NXCD, off = wgid / NXCD; return (xcd < r ? xcd * (q + 1) : r * (q + 1) + (xcd - r) * q) + off; }

struct DenseOrder {
    const char* A; const char* B; int K; int nM, nN, nwg, G, c;
    __device__ __forceinline__ void init(const bf16* A_, const bf16* B_, int M, int N, int K_, int G_, int c_) { A = (const char*)A_; B = (const char*)B_; K = K_; nM = M / BM; nN = N / BM; nwg = nM * nN; G = G_; c = c_; }
    __device__ __forceinline__ bool next(int i, Unit& u) const {
        int uidx; if (!split_index((long)i * G + c, nwg, G, uidx, u.roff, u.nai)) return false;
        const int wgid = xcd_remap(uidx, nwg);
        const int nig = WGM * nN, gid = wgid / nig, fm = gid * WGM, gsz = (nM - fm) < WGM ? (nM - fm) : WGM;
        u.pm = fm + ((wgid % nig) % gsz); u.pn = (wgid % nig) / gsz; u.e = 0; u.mt = 0; return true;
    }
    __device__ __forceinline__ const char* a_ptr(const Unit& u) const { return A + (size_t)(u.pm * BM + u.roff) * K * 2; }
    __device__ __forceinline__ const char* b_ptr(const Unit& u) const { return B + (size_t)u.pn * BM * K * 2; }
    __device__ __forceinline__ int tok(const Unit&, int) const { return 0; }
};
struct MoeOrder {
    const char* A; const char* B; int K; size_t bstride;
    const LAS int* tab; const int* list; int RT, nwg, G, c;
    __device__ __forceinline__ bool next(int i, Unit& u) const {
        int uidx; if (!split_index((long)i * G + c, nwg, G, uidx, u.roff, u.nai)) return false;
        const int wgid = xcd_remap(uidx, nwg);
        const int rt = wgid >> 2; u.pm = rt; u.pn = wgid & 3; const int t = tab[rt]; u.e = t & 255; u.mt = t >> 8; return true;
    }
    __device__ __forceinline__ const char* a_ptr(const Unit& u) const { return A + (size_t)(u.pm * BM + u.roff) * K * 2; }
    __device__ __forceinline__ const char* b_ptr(const Unit& u) const { return B + (size_t)u.e * bstride + (size_t)u.pn * BM * K * 2; }
    __device__ __forceinline__ int tok(const Unit& u, int r) const { const int cnt = tab[RT_MAX + 1 + u.e]; const int pos = u.mt * BM + u.roff + r; return pos < cnt ? list[(size_t)u.e * TALL + pos] : 0; }
};

__device__ __forceinline__ unsigned cvt_pk_bf16(float lo, float hi) { unsigned r; asm volatile("v_cvt_pk_bf16_f32 %0, %1, %2" : "=v"(r) : "v"(lo), "v"(hi)); return r; }

template <class Epi, class Sched, bool GATHER>
__device__ __forceinline__ void gemm_phase(LAS unsigned char* lds, const int tid, const int K, const Sched& S, const Epi& E) {
    const int wid = __builtin_amdgcn_readfirstlane(tid >> 6), lane = tid & 63, wr = wid >> 2, wc = wid & 3, fr = lane & 15, fq = lane >> 4;
    const int nt = K / BK;
    unsigned voffA[2], voffB[2]; int RA[2], CA[2];
#pragma unroll
    for (int i = 0; i < 2; ++i) { int R, C; stage_rc(tid * 16 + i * 8192, R, C); const int Rb = Epi::PERM ? ((R & ~31) + perm32(R & 31)) : R;
        RA[i] = R; CA[i] = C; voffA[i] = (unsigned)(R * K + C) * 2u; voffB[i] = (unsigned)(Rb * K + C) * 2u; }
    const size_t kstep = (size_t)(BK * 2);
    const size_t hstep = (size_t)HALF * K * 2;
    const unsigned ldsw = (unsigned)wid * 1024u;
    const int aoff = lds_byte(wr * 64 + fr, fq * 8), boff = lds_byte(wc * 32 + fr, fq * 8);
#define PG8_SA(b, h) (((b) * 2 + (h)) * HTB)
#define PG8_SB(b, h) ((4 + (b) * 2 + (h)) * HTB)
#define PG8_STAGE(bufoff, gbase, voff) do { _Pragma("unroll") for (int _i = 0; _i < 2; ++_i) \
        __builtin_amdgcn_global_load_lds((const unsigned*)((const char*)(gbase) + (voff)[_i]), (LAS unsigned*)(lds + (bufoff) + ldsw + _i * 8192), 16, 0, 0); } while (0)
#define PG8_STAGE_A(bufoff, h, usenext, koff) do { if constexpr (GATHER) { unsigned _vo[2]; _vo[0] = (usenext) ? nvA[h][0] : vA[h][0]; _vo[1] = (usenext) ? nvA[h][1] : vA[h][1]; PG8_STAGE(bufoff, S.A + (koff), _vo); } \
        else { PG8_STAGE(bufoff, ((usenext) ? nA : cA) + (size_t)(h) * hstep + (koff), voffA); } } while (0)
#define PG8_LDA(dst, b, h) do { _Pragma("unroll") for (int m = 0; m < 4; ++m) _Pragma("unroll") for (int k = 0; k < 2; ++k) dst[m][k] = *(const LAS bf16x8*)(lds + PG8_SA(b, h) + aoff + m * 2048 + k * 1024); } while (0)
#define PG8_LDB(dst, b, h) do { _Pragma("unroll") for (int n = 0; n < 2; ++n) _Pragma("unroll") for (int k = 0; k < 2; ++k) dst[n][k] = *(const LAS bf16x8*)(lds + PG8_SB(b, h) + boff + n * 2048 + k * 1024); } while (0)
#define PG8_MMA(ai, bj, At, Bt) do { __builtin_amdgcn_s_setprio(1); _Pragma("unroll") for (int m = 0; m < 4; ++m) _Pragma("unroll") for (int n = 0; n < 2; ++n) _Pragma("unroll") for (int k = 0; k < 2; ++k) \
        acc[ai][bj][m][n] = __builtin_amdgcn_mfma_f32_16x16x32_bf16(Bt[n][k], At[m][k], acc[ai][bj][m][n], 0, 0, 0); __builtin_amdgcn_s_setprio(0); } while (0)
#define PG8_WAIT_V(n) asm volatile("s_waitcnt vmcnt(" #n ")" ::: "memory")
#define PG8_WAIT_L(n) asm volatile("s_waitcnt lgkmcnt(" #n ")" ::: "memory")
#define PG8_BAR __builtin_amdgcn_s_barrier()
#define PG8_SCHED __builtin_amdgcn_sched_barrier(0)
    Unit cur, nxt; int ui = 0;
    if (!S.next(0, cur)) return;
    f32x4 acc[2][2][4][2];
#pragma unroll
    for (int a = 0; a < 2; ++a)
#pragma unroll
        for (int b = 0; b < 2; ++b)
#pragma unroll
            for (int m = 0; m < 4; ++m)
#pragma unroll
                for (int n = 0; n < 2; ++n) acc[a][b][m][n] = (f32x4){0.f, 0.f, 0.f, 0.f};
    bf16x8 At[4][2], B0[2][2], B1[2][2];
    unsigned vA[2][2], nvA[2][2];
    if constexpr (GATHER) {
#pragma unroll
        for (int h = 0; h < 2; ++h)
#pragma unroll
            for (int i = 0; i < 2; ++i) { vA[h][i] = (unsigned)(S.tok(cur, h * HALF + RA[i]) * K + CA[i]) * 2u; nvA[h][i] = vA[h][i]; }
    }
    const char* cA = S.a_ptr(cur); const char* cB = S.b_ptr(cur); const char* nA = cA;
    PG8_STAGE(PG8_SB(0, 0), cB, voffB); PG8_STAGE(PG8_SB(0, 1), cB + hstep, voffB); PG8_STAGE_A(PG8_SA(0, 0), 0, false, 0); PG8_STAGE_A(PG8_SA(0, 1), 1, false, 0);
    if (wr == 1) PG8_BAR;
    PG8_WAIT_V(2); PG8_BAR;
    PG8_STAGE(PG8_SB(1, 0), cB + kstep, voffB); PG8_STAGE_A(PG8_SA(1, 0), 0, false, kstep); PG8_STAGE(PG8_SB(1, 1), cB + hstep + kstep, voffB);
    PG8_WAIT_V(6); PG8_BAR;
    for (;;) {
        const bool has_next = S.next(ui + 1, nxt);
        nA = has_next ? S.a_ptr(nxt) : cA; const char* nB = has_next ? S.b_ptr(nxt) : cB;
        if constexpr (GATHER) {
            if (has_next) {
#pragma unroll
                for (int h = 0; h < 2; ++h)
#pragma unroll
                    for (int i = 0; i < 2; ++i) nvA[h][i] = (unsigned)(S.tok(nxt, h * HALF + RA[i]) * K + CA[i]) * 2u;
            }
        }
        const bool full = (cur.nai == 2);
        for (int t = 0; t < nt; t += 2) {
            const bool last = (t == nt - 2);
            const size_t k1 = (size_t)(t + 1) * kstep;
            const size_t k2 = last ? 0 : (size_t)(t + 2) * kstep, k3 = k2 + kstep;
            const char* b2 = last ? nB : cB + (size_t)(t + 2) * kstep; const char* b3 = b2 + kstep;
            PG8_LDB(B0, 0, 0); PG8_LDB(B1, 0, 1); PG8_SCHED; PG8_LDA(At, 0, 0); PG8_STAGE_A(PG8_SA(1, 1), 1, false, k1);
            PG8_WAIT_V(8); PG8_WAIT_L(0); PG8_BAR; PG8_MMA(0, 0, At, B0); PG8_MMA(0, 1, At, B1); PG8_BAR; PG8_SCHED;
            if (full) PG8_LDA(At, 0, 1); PG8_STAGE(PG8_SB(0, 0), b2, voffB); PG8_STAGE(PG8_SB(0, 1), b2 + hstep, voffB); PG8_STAGE_A(PG8_SA(0, 0), 0, last, k2);
            PG8_WAIT_V(8); PG8_WAIT_L(0); PG8_BAR; if (full) { PG8_MMA(1, 0, At, B0); PG8_MMA(1, 1, At, B1); } PG8_BAR; PG8_SCHED;
            PG8_LDB(B0, 1, 0); PG8_LDB(B1, 1, 1); PG8_SCHED; PG8_LDA(At, 1, 0); PG8_STAGE_A(PG8_SA(0, 1), 1, last, k2);
            PG8_WAIT_V(8); PG8_WAIT_L(0); PG8_BAR; PG8_MMA(0, 0, At, B0); PG8_MMA(0, 1, At, B1); PG8_BAR; PG8_SCHED;
            if (full) PG8_LDA(At, 1, 1); PG8_STAGE(PG8_SB(1, 0), b3, voffB); PG8_STAGE(PG8_SB(1, 1), b3 + hstep, voffB); PG8_STAGE_A(PG8_SA(1, 0), 0, last, k3);
            PG8_WAIT_V(8); PG8_WAIT_L(0); PG8_BAR; if (full) { PG8_MMA(1, 0, At, B0); PG8_MMA(1, 1, At, B1); } PG8_BAR; PG8_SCHED;
        }
        if (wr == 0) PG8_BAR;
        E(acc, cur, wr, wc, fr, fq);
        if (!has_next) break;
#pragma unroll
        for (int a = 0; a < 2; ++a)
#pragma unroll
            for (int b = 0; b < 2; ++b)
#pragma unroll
                for (int m = 0; m < 4; ++m)
#pragma unroll
                    for (int n = 0; n < 2; ++n) acc[a][b][m][n] = (f32x4){0.f, 0.f, 0.f, 0.f};
        cur = nxt; cA = nA; cB = nB; ++ui;
        if constexpr (GATHER) {
#pragma unroll
            for (int h = 0; h < 2; ++h)
#pragma unroll
                for (int i = 0; i < 2; ++i) vA[h][i] = nvA[h][i];
        }
        if (wr == 1) PG8_BAR;
    }
    PG8_WAIT_V(0);
    PG8_BAR;
#undef PG8_SA
#undef PG8_SB
#undef PG8_STAGE
#undef PG8_STAGE_A
#undef PG8_LDA
#undef PG8_LDB
#undef PG8_MMA
#undef PG8_WAIT_V
#undef PG8_WAIT_L
#undef PG8_BAR
#undef PG8_SCHED
}
}

namespace pg8 {
__device__ __forceinline__ void row_bt(int row, int& b, int& tok) { if (row < TX) { b = row >> 11; tok = row & 2047; } else { const int r = row - TX; b = r >> 8; tok = SEQ + (r & 255); } }

struct EpiAttnIn {
    static constexpr bool PERM = true;
    bf16* QKV; bf16* VAT; bf16* VBT; const LAS float* rope;
    __device__ __forceinline__ void operator()(const f32x4 (&acc)[2][2][4][2], const Unit& u, int wr, int wc, int fr, int fq) const {
        const int row0 = u.pm * BM + u.roff + wr * 64 + fr; const int seg = u.pn >> 1;
        const bool latent = u.pm < (TX / BM);
        if (seg == 2 || seg == 5) {
#pragma unroll
            for (int ai = 0; ai < 2; ++ai) if (ai < u.nai)
#pragma unroll
                for (int m = 0; m < 4; ++m) { const int row = row0 + ai * HALF + m * 16; int b, tok; row_bt(row, b, tok);
#pragma unroll
                    for (int bj = 0; bj < 2; ++bj) { const int col = u.pn * BM + bj * HALF + wc * 32 + 8 * fq;
                        bf16* dst;
                        if (seg == 2) { const int cs = col - 1024; dst = VAT + ((size_t)(b * 4 + (cs >> 7)) * 128 + (cs & 127)) * NKEY + tok; }
                        else { const int cs = col - 2560; dst = VBT + ((size_t)(b * 8 + (cs >> 6)) * 64 + (cs & 63)) * NKEY + tok; }
#pragma unroll
                        for (int n = 0; n < 2; ++n)
#pragma unroll
                            for (int i = 0; i < 4; ++i) dst[(size_t)(4 * n + i) * NKEY] = (bf16)f2bf(acc[ai][bj][m][n][i]); } }
            return;
        }
        const bool dorope = latent && seg < 2;
        const float qs = (seg == 0 || seg == 3) ? 0.125f * LOG2E : 1.0f;
#pragma unroll
        for (int ai = 0; ai < 2; ++ai) if (ai < u.nai)
#pragma unroll
            for (int m = 0; m < 4; ++m) { const int row = row0 + ai * HALF + m * 16;
                f32x4 cs4[4];
                if (dorope) { const int t = row & 2047; const int pos = (wc & 1) ? (t & 63) : (t >> 6);
                    const LAS f32x4* rp = (const LAS f32x4*)(rope + (pos * 16 + 8 * (fq & 1)) * 2);
#pragma unroll
                    for (int j = 0; j < 4; ++j) cs4[j] = rp[j]; }
#pragma unroll
                for (int bj = 0; bj < 2; ++bj) { const int col = u.pn * BM + bj * HALF + wc * 32 + 8 * fq;
                    float v[8];
#pragma unroll
                    for (int n = 0; n < 2; ++n)
#pragma unroll
                        for (int i = 0; i < 4; ++i) v[4 * n + i] = acc[ai][bj][m][n][i];
                    if (dorope) {
#pragma unroll
                        for (int j = 0; j < 8; ++j) { const float other = __shfl_xor(v[j], 32); const float c = cs4[j >> 1][(j & 1) * 2], s = cs4[j >> 1][(j & 1) * 2 + 1];
                            v[j] = (fq < 2) ? (v[j] * c - other * s) : (v[j] * c + other * s); } }
                    u32x4 w; w.x = pk2(v[0] * qs, v[1] * qs); w.y = pk2(v[2] * qs, v[3] * qs); w.z = pk2(v[4] * qs, v[5] * qs); w.w = pk2(v[6] * qs, v[7] * qs);
                    *(u32x4*)(QKV + (size_t)row * NATT + col) = w; } }
    }
};
struct EpiGlaIn {
    static constexpr bool PERM = true;
    bf16* QKV2; bf16* VGT;
    __device__ __forceinline__ void operator()(const f32x4 (&acc)[2][2][4][2], const Unit& u, int wr, int wc, int fr, int fq) const {
        const int row0 = u.pm * BM + u.roff + wr * 64 + fr;
        if (u.pn >= 4 && u.pn < 8) {
#pragma unroll
            for (int ai = 0; ai < 2; ++ai) if (ai < u.nai)
#pragma unroll
                for (int m = 0; m < 4; ++m) { const int row = row0 + ai * HALF + m * 16; int b, tok; row_bt(row, b, tok);
#pragma unroll
                    for (int bj = 0; bj < 2; ++bj) { const int cs = u.pn * BM + bj * HALF + wc * 32 + 8 * fq - 1024;
                        bf16* dst = VGT + ((size_t)(b * 4 + (cs >> 8)) * 256 + (cs & 255)) * NKEY + tok;
#pragma unroll
                        for (int n = 0; n < 2; ++n)
#pragma unroll
                            for (int i = 0; i < 4; ++i) dst[(size_t)(4 * n + i) * NKEY] = (bf16)f2bf(acc[ai][bj][m][n][i]); } }
            return;
        }
        const float qs = (u.pn < 2) ? 0.08838834764831845f : 1.0f;
#pragma unroll
        for (int ai = 0; ai < 2; ++ai) if (ai < u.nai)
#pragma unroll
            for (int m = 0; m < 4; ++m) { const int row = row0 + ai * HALF + m * 16;
#pragma unroll
                for (int bj = 0; bj < 2; ++bj) { const int col = u.pn * BM + bj * HALF + wc * 32 + 8 * fq; const f32x4 a = acc[ai][bj][m][0] * qs, c = acc[ai][bj][m][1] * qs;
                    u32x4 w; w.x = pk2(a[0], a[1]); w.y = pk2(a[2], a[3]); w.z = pk2(c[0], c[1]); w.w = pk2(c[2], c[3]);
                    *(u32x4*)(QKV2 + (size_t)row * NGLA + col) = w; } }
    }
};
struct EpiResid {
    static constexpr bool PERM = false;
    const float* IL; const float* IC; float* XL; float* XC; const float* modv;
    __device__ __forceinline__ void operator()(const f32x4 (&acc)[2][2][4][2], const Unit& u, int wr, int wc, int fr, int fq) const {
        const int row0 = u.pm * BM + u.roff + wr * 64 + fr, col0 = u.pn * BM + wc * 32 + 4 * fq;
        const bool latent = u.pm < (TX / BM); const int bi = latent ? (u.pm >> 3) : 8;
        float* base = latent ? XL : (XC - (size_t)TX * D); const float* ibase = latent ? IL : (IC - (size_t)TX * D);
        f32x4 gv[2][2];
#pragma unroll
        for (int bj = 0; bj < 2; ++bj)
#pragma unroll
            for (int n = 0; n < 2; ++n) gv[bj][n] = *(const f32x4*)(modv + bi * 6144 + col0 + bj * HALF + n * 16);
#pragma unroll
        for (int ai = 0; ai < 2; ++ai) if (ai < u.nai) {
            f32x4 res[4][2][2];
#pragma unroll
            for (int m = 0; m < 4; ++m) { const size_t ro = (size_t)(row0 + ai * HALF + m * 16) * D + col0;
#pragma unroll
                for (int bj = 0; bj < 2; ++bj)
#pragma unroll
                    for (int n = 0; n < 2; ++n) res[m][bj][n] = *(const f32x4*)(ibase + ro + bj * HALF + n * 16); }
#pragma unroll
            for (int m = 0; m < 4; ++m) { const size_t ro = (size_t)(row0 + ai * HALF + m * 16) * D + col0;
#pragma unroll
                for (int bj = 0; bj < 2; ++bj)
#pragma unroll
                    for (int n = 0; n < 2; ++n) *(f32x4*)(base + ro + bj * HALF + n * 16) = res[m][bj][n] + gv[bj][n] * acc[ai][bj][m][n]; }
        }
    }
};
struct EpiMoe1 {
    static constexpr bool PERM = false;
    bf16* HB;
    __device__ __forceinline__ void operator()(const f32x4 (&acc)[2][2][4][2], const Unit& u, int wr, int wc, int fr, int fq) const {
        const int row0 = u.pm * BM + u.roff + wr * 64 + fr, col0 = u.pn * 128 + wc * 16 + 4 * fq;
#pragma unroll
        for (int ai = 0; ai < 2; ++ai) if (ai < u.nai)
#pragma unroll
            for (int m = 0; m < 4; ++m) { bf16* rowp = HB + (size_t)(row0 + ai * HALF + m * 16) * DEXP + col0;
#pragma unroll
                for (int bj = 0; bj < 2; ++bj) { const f32x4 a = acc[ai][bj][m][0], b = acc[ai][bj][m][1];
                    u32x2 w; w.x = pk2(silu_f(a[0]) * b[0], silu_f(a[1]) * b[1]); w.y = pk2(silu_f(a[2]) * b[2], silu_f(a[3]) * b[3]);
                    *(u32x2*)(rowp + bj * 64) = w; } }
    }
};
struct EpiBf16 {
    static constexpr bool PERM = true;
    bf16* O; int ldc;
    __device__ __forceinline__ void operator()(const f32x4 (&acc)[2][2][4][2], const Unit& u, int wr, int wc, int fr, int fq) const {
        const int row0 = u.pm * BM + u.roff + wr * 64 + fr, col0 = u.pn * BM + wc * 32 + 8 * fq;
#pragma unroll
        for (int ai = 0; ai < 2; ++ai) if (ai < u.nai)
#pragma unroll
            for (int m = 0; m < 4; ++m) { bf16* rowp = O + (size_t)(row0 + ai * HALF + m * 16) * ldc + col0;
#pragma unroll
                for (int bj = 0; bj < 2; ++bj) { const f32x4 a = acc[ai][bj][m][0], c = acc[ai][bj][m][1];
                    u32x4 w; w.x = pk2(a[0], a[1]); w.y = pk2(a[2], a[3]); w.z = pk2(c[0], c[1]); w.w = pk2(c[2], c[3]);
                    *(u32x4*)(rowp + bj * HALF) = w; } }
    }
};
}

struct Args {
    const float *x, *c, *ctx, *c_ctx, *w_mod, *b_mod, *norm_g, *final_g, *att_w_in, *att_w_out, *att_lambda, *att_subln_g, *na_bias,
                *gla_w_in, *gla_w_gate, *gla_b_gate, *gla_norm_g, *gla_w_out, *router_w, *router_bias, *moe_w1, *moe_w3, *moe_w2;
    float* out; unsigned char* ws; int ph_lo, ph_hi, rep, pad;
};

struct RowMapId { int off; __device__ __forceinline__ int operator()(int n) const { return off + n; } };
struct RowMapMoe { int which; __device__ __forceinline__ int operator()(int n) const { return 32 * (n >> 4) + 16 * which + (n & 15); } };
__device__ __forceinline__ void ti_load(float (&ld)[32], const float* W, int N, int item, int lane) {
    const int nblk = N / 32, kb = item / nblk, nb = item % nblk, k0 = 64 * kb, n0 = 32 * nb;
#pragma unroll
    for (int i = 0; i < 32; ++i) ld[i] = W[(size_t)(k0 + 2 * i + (lane >> 5)) * N + n0 + (lane & 31)];
}
template <class RM>
__device__ __forceinline__ void ti_finish(const float (&ld)[32], int K, int N, bf16* WT, LAS float* scr, int item, int lane, RM rm) {
    const int nblk = N / 32, kb = item / nblk, nb = item % nblk, k0 = 64 * kb, n0 = 32 * nb;
#pragma unroll
    for (int i = 0; i < 32; ++i) scr[(2 * i + (lane >> 5)) * 33 + (lane & 31)] = ld[i];
    LDS_WAIT(); asm volatile("" ::: "memory");
    const int c = lane & 7;
#pragma unroll
    for (int j = 0; j < 4; ++j) { const int n = (lane >> 3) + 8 * j; const LAS float* s = scr + (8 * c) * 33 + n;
        u32x4 o; o.x = pk2(s[0 * 33], s[1 * 33]); o.y = pk2(s[2 * 33], s[3 * 33]); o.z = pk2(s[4 * 33], s[5 * 33]); o.w = pk2(s[6 * 33], s[7 * 33]);
        *(u32x4*)(WT + (size_t)rm(n0 + n) * K + k0 + 8 * c) = o; }
    LDS_WAIT(); asm volatile("" ::: "memory");
}
template <class RM>
__device__ __forceinline__ void p0_transpose_item(const float* W, int K, int N, bf16* WT, LAS float* scr, int item, int lane, RM rm) {
    float ld[32]; ti_load(ld, W, N, item, lane); ti_finish(ld, K, N, WT, scr, item, lane, rm);
}

constexpr int CV_ATTIN = 1536, CV_ATTOUT = 512, CV_GLAIN = 1552, CV_GLAPAD = 28, CV_GLAOUT = 512, CV_W = 4096, CV_MOE = 3 * CV_W;
constexpr int CT_ATTN0 = CV_ATTIN + CV_ATTOUT, CT_MOE0 = CT_ATTN0 + CV_MOE, CT_GLA0 = CT_MOE0 + CV_GLAIN + CV_GLAPAD + CV_GLAOUT, CT_ATTN1 = CT_GLA0 + CV_ATTIN + CV_ATTOUT, CT_MOE1 = CT_ATTN1 + CV_MOE,
              CT_MOE2 = CT_MOE1 + CV_MOE, CT_GLA1 = CT_MOE2 + CV_GLAIN + CV_GLAPAD + CV_GLAOUT, CT_MOE3 = CT_GLA1 + CV_MOE, CV_TOTAL = CT_MOE3;
constexpr int CV_UNIT = 32;
struct ConvPtrs { const float *att_w_in, *att_w_out, *gla_w_in, *gla_w_out, *moe_w1, *moe_w3, *moe_w2; unsigned char* ws; };
struct RowMapAny { int moe, which; __device__ __forceinline__ int operator()(int n) const { return moe ? 32 * (n >> 4) + 16 * which + (n & 15) : n; } };
struct ConvDesc { const float* W; bf16* WT; int K, N, sub, kind  ; RowMapAny rm; };
__device__ __forceinline__ ConvDesc conv_decode(const ConvPtrs& P, int it, int hi) {
    ConvDesc d; d.W = nullptr; d.WT = nullptr; d.K = D; d.N = D; d.sub = 0; d.kind = 0; d.rm = RowMapAny{0, 0};
    if (it >= hi) return d;
    int kind, j, r;
    if (it < CT_ATTN0) { kind = 0; j = 0; r = it; } else if (it < CT_MOE0) { kind = 2; j = 0; r = it - CT_ATTN0; } else if (it < CT_GLA0) { kind = 1; j = 0; r = it - CT_MOE0; }
    else if (it < CT_ATTN1) { kind = 0; j = 1; r = it - CT_GLA0; } else if (it < CT_MOE1) { kind = 2; j = 1; r = it - CT_ATTN1; } else if (it < CT_MOE2) { kind = 2; j = 2; r = it - CT_MOE1; }
    else if (it < CT_GLA1) { kind = 1; j = 1; r = it - CT_MOE2; } else { kind = 2; j = 3; r = it - CT_GLA1; }
    d.kind = 1; d.sub = r;
    if (kind == 2) {
        const int which = r / CV_W, q = r % CV_W, e = q >> 8, je = j * 16 + e; d.sub = q & 255;
        if (which < 2) { d.W = (which ? P.moe_w3 : P.moe_w1) + (size_t)je * D * DEXP; d.N = DEXP; d.WT = (bf16*)(P.ws + WS_W13) + (size_t)je * D * D; d.rm.moe = 1; d.rm.which = which; }
        else { d.W = P.moe_w2 + (size_t)je * DEXP * D; d.K = DEXP; d.WT = (bf16*)(P.ws + WS_W2) + (size_t)je * D * DEXP; }
    } else if (kind == 0) {
        if (r < CV_ATTIN) { d.W = P.att_w_in + (size_t)j * D * NATT; d.N = NATT; d.WT = (bf16*)(P.ws + WS_WATTIN) + (size_t)j * NATT * D; }
        else { d.W = P.att_w_out + (size_t)j * D * D; d.WT = (bf16*)(P.ws + WS_WATTOUT) + (size_t)j * D * D; d.sub = r - CV_ATTIN; }
    } else {
        if (r < CV_GLAIN) { d.W = P.gla_w_in + (size_t)j * D * 3104; d.N = 3104; d.WT = (bf16*)(P.ws + WS_WGLAIN) + (size_t)j * NGLA * D; }
        else if (r < CV_GLAIN + CV_GLAPAD) { d.kind = 2; d.sub = (r - CV_GLAIN) * 1024; d.WT = (bf16*)(P.ws + WS_WGLAIN) + (size_t)j * NGLA * D + (size_t)3104 * D; }
        else { d.W = P.gla_w_out + (size_t)j * D * D; d.WT = (bf16*)(P.ws + WS_WGLAOUT) + (size_t)j * D * D; d.sub = r - CV_GLAIN - CV_GLAPAD; }
    }
    return d;
}
__device__ __forceinline__ void conv_load(const ConvDesc& d, float (&ld)[32], int lane) { if (d.kind == 1) ti_load(ld, d.W, d.N, d.sub, lane); }
__device__ __forceinline__ void conv_finish(const ConvDesc& d, const float (&ld)[32], LAS float* scr, int lane) {
    if (d.kind == 1) ti_finish(ld, d.K, d.N, d.WT, scr, d.sub, lane, d.rm);
    else if (d.kind == 2) { for (int i = lane; i < 1024; i += 64) *(u32x4*)(d.WT + (size_t)(d.sub + i) * 8) = (u32x4){0u, 0u, 0u, 0u}; }
}
__device__ __forceinline__ void conv_item(const ConvPtrs& P, int it, LAS float* scr, int lane) {
    const ConvDesc d = conv_decode(P, it, it + 1); float ld[32]; conv_load(d, ld, lane); conv_finish(d, ld, scr, lane);
}
__device__ __forceinline__ void conv_static(const ConvPtrs& P, int cur, int need, LAS unsigned char* lds, int lane, int wave, int vcu, int G) {
    LAS float* scr = (LAS float*)(lds + wave * 8448);
    for (int it = cur + vcu * 8 + wave; it < need; it += G * 8) conv_item(P, it, scr, lane);
}
__device__ __forceinline__ void conv_unit(const ConvPtrs& P, int i0, int hi, LAS unsigned char* lds, int lane, int wave) {
    LAS float* scr = (LAS float*)(lds + wave * 8448);
    constexpr int NPW = CV_UNIT / 8; static_assert(NPW == 4, "four items per wave");
    const int it0 = i0 + wave * NPW;
    float la[32], lb[32];
    ConvDesc dA = conv_decode(P, it0, hi); conv_load(dA, la, lane);
    ConvDesc dB = conv_decode(P, it0 + 1, hi); conv_load(dB, lb, lane);
    conv_finish(dA, la, scr, lane);
    dA = conv_decode(P, it0 + 2, hi); conv_load(dA, la, lane);
    conv_finish(dB, lb, scr, lane);
    dB = conv_decode(P, it0 + 3, hi); conv_load(dB, lb, lane);
    conv_finish(dA, la, scr, lane);
    conv_finish(dB, lb, scr, lane);
}

template <class AP> __device__ __forceinline__ void p0_prologue(const AP ap, LAS unsigned char* lds, int tid, int lane, int wave, int vcu, int G) {
    unsigned char* ws = ap->ws;
    LAS float* S9 = (LAS float*)(lds + 69632);
    LAS float* red = (LAS float*)(lds + 106496);
    { const ConvPtrs P{ap->att_w_in, ap->att_w_out, ap->gla_w_in, ap->gla_w_out, ap->moe_w1, ap->moe_w3, ap->moe_w2, ws};
      conv_static(P, 0, MK_CONVQ ? CT_ATTN0 : CV_TOTAL, lds, lane, wave, vcu, G); }
    __syncthreads();
    { const float* cc = ap->c; const float* cx = ap->c_ctx;
      for (int i = tid; i < 9 * 1024; i += 512) { const int bi = i >> 10, k = i & 1023; const float v = (bi < 8) ? cc[bi * D + k] : cx[k]; S9[i] = v / (1.0f + __expf(-v)); } }
    __syncthreads();
    const float* w_mod = ap->w_mod; const float* b_mod = ap->b_mod;
    for (int u = vcu; u < 4 * 96; u += G) {
        const int L = u / 96, n0 = (u % 96) * 64;
        const float* W = w_mod + (size_t)L * D * 6144 + n0 + lane;
        float acc[9];
#pragma unroll
        for (int bi = 0; bi < 9; ++bi) acc[bi] = 0.f;
        const int kb = wave * 128;
        for (int k0 = 0; k0 < 128; k0 += 32) { float wv[32];
#pragma unroll
            for (int k = 0; k < 32; ++k) wv[k] = W[(size_t)(kb + k0 + k) * 6144];
#pragma unroll
            for (int k = 0; k < 32; ++k)
#pragma unroll
                for (int bi = 0; bi < 9; ++bi) acc[bi] += S9[bi * 1024 + kb + k0 + k] * wv[k]; }
#pragma unroll
        for (int bi = 0; bi < 9; ++bi) red[(wave * 9 + bi) * 64 + lane] = acc[bi];
        __syncthreads();
        for (int i = tid; i < 9 * 64; i += 512) { const int bi = i >> 6, l = i & 63; float sm = b_mod[L * 6144 + n0 + l];
#pragma unroll
            for (int w = 0; w < 8; ++w) sm += red[(w * 9 + bi) * 64 + l];
            ((float*)(ws + WS_MODV))[(size_t)(L * 9 + bi) * 6144 + n0 + l] = sm; }
        __syncthreads();
    }
}

__device__ __forceinline__ float* xrow_ptr(float* XL, float* XC, int row) { return row < TX ? XL + (size_t)row * D : XC + (size_t)(row - TX) * D; }
__device__ __forceinline__ int row_bi(int row) { return row < TX ? (row >> 11) : 8; }

__device__ __forceinline__ void norm_mod_store(const f32x4 (&v)[4], const float* g, const float* sh, const float* sc, bf16* orow, int lane) {
    float ss = 0.f;
#pragma unroll
    for (int j = 0; j < 4; ++j) ss += (v[j].x * v[j].x + v[j].y * v[j].y) + (v[j].z * v[j].z + v[j].w * v[j].w);
    const float rs = __builtin_amdgcn_rsqf(wave_sum(ss) * (1.0f / D) + EPSF);
#pragma unroll
    for (int j = 0; j < 4; ++j) { const int c = 4 * lane + 256 * j; const f32x4 gg = *(const f32x4*)(g + c), s1 = *(const f32x4*)(sc + c), s0 = *(const f32x4*)(sh + c);
        const f32x4 y = (v[j] * rs) * gg * (1.0f + s1) + s0;
        u32x2 w; w.x = pk2(y.x, y.y); w.y = pk2(y.z, y.w); *(u32x2*)(orow + c) = w; }
}

constexpr int TROWS = 9;
__device__ __forceinline__ int thin_row(int vcu, int wave, int i) { return vcu * 8 + wave + 2048 * i; }

struct N1Row { f32x4 x[4], s0[4], s1[4]; };
__device__ __forceinline__ void n1_issue(N1Row& r, const float* XL, const float* XC, const float* modv, int row, int lane) {
    const f32x4* xr = (const f32x4*)(row < TX ? XL + (size_t)row * D : XC + (size_t)(row - TX) * D) + lane; const float* mv = modv + row_bi(row) * 6144;
#pragma unroll
    for (int j = 0; j < 4; ++j) { r.x[j] = xr[64 * j]; r.s0[j] = *(const f32x4*)(mv + 4 * lane + 256 * j); r.s1[j] = *(const f32x4*)(mv + 1024 + 4 * lane + 256 * j); }
}
__device__ __forceinline__ void n1_finish(const N1Row& r, const f32x4 (&gg)[4], bf16* orow, int lane) {
    float ss = 0.f;
#pragma unroll
    for (int j = 0; j < 4; ++j) ss += (r.x[j].x * r.x[j].x + r.x[j].y * r.x[j].y) + (r.x[j].z * r.x[j].z + r.x[j].w * r.x[j].w);
    const float rs = __builtin_amdgcn_rsqf(wave_sum(ss) * (1.0f / D) + EPSF);
#pragma unroll
    for (int j = 0; j < 4; ++j) { const f32x4 y = (r.x[j] * rs) * gg[j] * (1.0f + r.s1[j]) + r.s0[j];
        u32x2 w; w.x = pk2(y.x, y.y); w.y = pk2(y.z, y.w); *(u32x2*)(orow + 4 * lane + 256 * j) = w; }
}
__device__ __forceinline__ void phase_norm1(const float* XL, const float* XC, const float* g, const float* modv, bf16* H, int nrows, int lane, int wave, int vcu, int G) {
    f32x4 gg[4];
#pragma unroll
    for (int j = 0; j < 4; ++j) gg[j] = *(const f32x4*)(g + 4 * lane + 256 * j);
    N1Row ra, rb;
    n1_issue(ra, XL, XC, modv, thin_row(vcu, wave, 0), lane);
#pragma unroll
    for (int i = 0; i < TROWS; ++i) {
        const int row = thin_row(vcu, wave, i), rown = thin_row(vcu, wave, i + 1);
        if (i + 1 < TROWS) n1_issue((i & 1) ? ra : rb, XL, XC, modv, rown < nrows ? rown : row, lane);
        if (row < nrows) n1_finish((i & 1) ? rb : ra, gg, H + (size_t)row * D, lane);
    }
}

__device__ __forceinline__ void phase_router(float* XL, float* XC, const float* g, const float* modv, bf16* H, const float* router_w, const float* router_bias,
                                             unsigned* cnt  , int* list, int* toki, float* tokw, int nrows,
                                             LAS unsigned char* lds, int tid, int lane, int wave, int vcu, int G, int probe) {
    LAS float* RW = (LAS float*)lds;
    LAS int* lcnt = (LAS int*)(lds + 65536);
    LAS int* rinfo = (LAS int*)(lds + 65536 + 256);
    for (int it = 0; it < 8; ++it) { const int idx = tid + 512 * it, k = idx >> 2, q = idx & 3; const f32x4 w = *(const f32x4*)(router_w + k * 16 + 4 * q);
        RW[(4 * q + 0) * 1024 + k] = w.x; RW[(4 * q + 1) * 1024 + k] = w.y; RW[(4 * q + 2) * 1024 + k] = w.z; RW[(4 * q + 3) * 1024 + k] = w.w; }
    if (tid < 32) lcnt[tid] = 0;
    __syncthreads();
    const int rpb = nrows / G, rpw = rpb / 8;
    const int gI = lane >> 4;
    const f32x4 rb = *(const f32x4*)(router_bias + 4 * gI);
    f32x4 gg[4];
#pragma unroll
    for (int j = 0; j < 4; ++j) gg[j] = *(const f32x4*)(g + 4 * lane + 256 * j);
    const int rowbase = vcu * rpb + wave * rpw;
    f32x4 xa[3][4], xb[3][4];
#pragma unroll
    for (int r = 0; r < 3; ++r) { const f32x4* xr = (const f32x4*)xrow_ptr(XL, XC, rowbase + (r < rpw ? r : rpw - 1)) + lane;
#pragma unroll
        for (int j = 0; j < 4; ++j) xa[r][j] = xr[64 * j]; }
#pragma unroll
    for (int bt = 0; bt < 3; ++bt) {
        const int i0 = 3 * bt;
        asm volatile("" ::: "memory");
        f32x4 (&y)[3][4] = (bt & 1) ? xb : xa; f32x4 (&xn)[3][4] = (bt & 1) ? xa : xb;
        f32x4 s0v[3][4], s1v[3][4];
#pragma unroll
        for (int r = 0; r < 3; ++r) { const int ii = (i0 + r < rpw) ? i0 + r : rpw - 1; const float* mv = modv + row_bi(rowbase + ii) * 6144 + 3072;
#pragma unroll
            for (int j = 0; j < 4; ++j) { const int c = 4 * lane + 256 * j; s0v[r][j] = *(const f32x4*)(mv + c); s1v[r][j] = *(const f32x4*)(mv + 1024 + c); } }
        if (bt + 1 < 3) {
#pragma unroll
            for (int r = 0; r < 3; ++r) { const int ii = (i0 + 3 + r < rpw) ? i0 + 3 + r : rpw - 1; const f32x4* xr = (const f32x4*)xrow_ptr(XL, XC, rowbase + ii) + lane;
#pragma unroll
                for (int j = 0; j < 4; ++j) xn[r][j] = xr[64 * j]; } }
#pragma unroll
        for (int r = 0; r < 3; ++r) {
            const int ii = (i0 + r < rpw) ? i0 + r : rpw - 1; const int row = rowbase + ii;
            float ss = 0.f;
#pragma unroll
            for (int j = 0; j < 4; ++j) ss += (y[r][j].x * y[r][j].x + y[r][j].y * y[r][j].y) + (y[r][j].z * y[r][j].z + y[r][j].w * y[r][j].w);
            const float rs = __builtin_amdgcn_rsqf(wave_sum(ss) * (1.0f / D) + EPSF);
#pragma unroll
            for (int j = 0; j < 4; ++j) { const int c = 4 * lane + 256 * j;
                y[r][j] = (y[r][j] * rs) * gg[j] * (1.0f + s1v[r][j]) + s0v[r][j];
                u32x2 w; w.x = cvtpk(y[r][j].x, y[r][j].y); w.y = cvtpk(y[r][j].z, y[r][j].w); *(u32x2*)(H + (size_t)row * D + c) = w; }
        }
        float p[3][16];
#pragma unroll
        for (int e = 0; e < 16; ++e) {
#pragma unroll
            for (int r = 0; r < 3; ++r) p[r][e] = 0.f;
#pragma unroll
            for (int j = 0; j < 4; ++j) { const f32x4 w = *(const LAS f32x4*)(RW + e * 1024 + 4 * lane + 256 * j);
#pragma unroll
                for (int r = 0; r < 3; ++r) p[r][e] += (y[r][j].x * w.x + y[r][j].y * w.y) + (y[r][j].z * w.z + y[r][j].w * w.w); }
#pragma unroll
            for (int r = 0; r < 3; ++r) asm volatile("" : "+v"(p[r][e])); }
#pragma unroll
        for (int r = 0; r < 3; ++r) {
            float q8[8], lg[4];
#pragma unroll
            for (int j = 0; j < 8; ++j) q8[j] = swap32_add(p[r][j], p[r][j + 8]);
#pragma unroll
            for (int j = 0; j < 4; ++j) lg[j] = row_sum(swap16_add(q8[j], q8[j + 4]));
            float sc[4], sel[4];
#pragma unroll
            for (int j = 0; j < 4; ++j) { sc[j] = 1.0f / (1.0f + __expf(-lg[j])); sel[j] = sc[j] + rb[j]; }
            int i1 = 0, i2 = 0; float m1 = -1e30f, m2 = -1e30f, w1 = 0.f, w2 = 0.f;
#pragma unroll
            for (int j = 0; j < 4; ++j) { const float t = sel[j];
                if (t > m1) { m2 = m1; i2 = i1; w2 = w1; m1 = t; i1 = j; w1 = sc[j]; } else if (t > m2) { m2 = t; i2 = j; w2 = sc[j]; } }
            const float gs = m1 + m2;
            const float g0 = readlane_f(gs, 0), g1 = readlane_f(gs, 16), g2 = readlane_f(gs, 32), g3 = readlane_f(gs, 48);
            int bg = 0; float bgs = g0; if (g1 > bgs) { bgs = g1; bg = 1; } if (g2 > bgs) { bgs = g2; bg = 2; } if (g3 > bgs) { bgs = g3; bg = 3; }
            bg = __builtin_amdgcn_readfirstlane(bg);
            const int e0 = 4 * bg + __builtin_amdgcn_readlane(i1, 16 * bg), e1 = 4 * bg + __builtin_amdgcn_readlane(i2, 16 * bg);
            const float w0 = readlane_f(w1, 16 * bg), w1s = readlane_f(w2, 16 * bg);
            const float wn = 1.0f / (w0 + w1s);
            if (lane == 0 && i0 + r < rpw) { const int rl = wave * rpw + i0 + r;
                const int p0 = __hip_atomic_fetch_add(&lcnt[e0], 1, __ATOMIC_RELAXED, __HIP_MEMORY_SCOPE_WORKGROUP), p1 = __hip_atomic_fetch_add(&lcnt[e1], 1, __ATOMIC_RELAXED, __HIP_MEMORY_SCOPE_WORKGROUP);
                rinfo[rl * 6 + 0] = e0; rinfo[rl * 6 + 1] = p0; rinfo[rl * 6 + 2] = e1; rinfo[rl * 6 + 3] = p1;
                rinfo[rl * 6 + 4] = __builtin_bit_cast(int, w0 * wn); rinfo[rl * 6 + 5] = __builtin_bit_cast(int, w1s * wn); }
        }
    }
    __syncthreads();
    if (tid < 16) lcnt[16 + tid] = (int)__hip_atomic_fetch_add(cnt + 64 * tid, (unsigned)lcnt[tid], RLX_AGENT);
    __syncthreads();
    if (tid < rpb) { const int row = vcu * rpb + tid; const int e0 = rinfo[tid * 6 + 0], e1 = rinfo[tid * 6 + 2];
        const int p0 = lcnt[16 + e0] + rinfo[tid * 6 + 1], p1 = lcnt[16 + e1] + rinfo[tid * 6 + 3];
        list[(size_t)e0 * TALL + p0] = row; list[(size_t)e1 * TALL + p1] = row;
        toki[row * 4 + 0] = e0; toki[row * 4 + 1] = p0; toki[row * 4 + 2] = e1; toki[row * 4 + 3] = p1;
        tokw[row * 2 + 0] = __builtin_bit_cast(float, rinfo[tid * 6 + 4]); tokw[row * 2 + 1] = __builtin_bit_cast(float, rinfo[tid * 6 + 5]); }
    __syncthreads();
}

__device__ __forceinline__ int build_moe_table(const unsigned* cnt, LAS int* tab, int tid) {
    if (tid < 16) tab[RT_MAX + 1 + tid] = (int)__hip_atomic_load(cnt + 64 * tid, RLX_AGENT);
    __syncthreads();
    if (tid == 0) { int rt = 0;
        for (int e = 0; e < 16; ++e) { const int c = tab[RT_MAX + 1 + e]; const int nt = (c + 255) >> 8;
            for (int m = 0; m < nt; ++m) { if (rt < RT_MAX) tab[rt] = e | (m << 8); ++rt; } }
        tab[RT_MAX] = rt < RT_MAX ? rt : RT_MAX; }
    __syncthreads();
    return tab[RT_MAX];
}

struct CbTok { int e0, p0, e1, p1; float w0, w1; };
struct CbRow { f32x4 x[4], g2[4], s0[4], s1[4]; u32x2 ya[4], yb[4]; };
__device__ __forceinline__ void cb_tok(CbTok& t, const int* toki, const float* tokw, int row) {
    const int4 q = *(const int4*)(toki + row * 4); const float2 w = *(const float2*)(tokw + row * 2); t.e0 = q.x; t.p0 = q.y; t.e1 = q.z; t.p1 = q.w; t.w0 = w.x; t.w1 = w.y;
}
template <bool FINAL>
__device__ __forceinline__ void cb_issue(CbRow& r, const CbTok& t, int mybase, float* XL, float* XC, const float* modv, const float* modv_next, const bf16* YB, int row, int lane) {
    const int s0 = __shfl(mybase, t.e0) + t.p0, s1 = __shfl(mybase, t.e1) + t.p1;
    const float* xp = xrow_ptr(XL, XC, row); const int bi = row_bi(row); const float* g2 = modv + bi * 6144 + 5120; const float* mv = modv_next + bi * 6144;
#pragma unroll
    for (int j = 0; j < 4; ++j) { const int c = 4 * lane + 256 * j;
        r.ya[j] = *(const u32x2*)(YB + (size_t)s0 * D + c); r.yb[j] = *(const u32x2*)(YB + (size_t)s1 * D + c);
        r.x[j] = *(const f32x4*)(xp + c); r.g2[j] = *(const f32x4*)(g2 + c);
        if constexpr (!FINAL) { r.s0[j] = *(const f32x4*)(mv + c); r.s1[j] = *(const f32x4*)(mv + 1024 + c); } }
}
template <bool FINAL>
__device__ __forceinline__ void cb_finish(const CbRow& r, const CbTok& t, const f32x4 (&gn)[4], float* xp, bf16* hrow, int lane) {
    f32x4 v[4]; float ss = 0.f;
#pragma unroll
    for (int j = 0; j < 4; ++j) { const u32x2 a = r.ya[j], b = r.yb[j]; const float w0 = t.w0, w1 = t.w1;
        f32x4 y; y.x = w0 * bflo(a.x) + w1 * bflo(b.x); y.y = w0 * bfhi(a.x) + w1 * bfhi(b.x); y.z = w0 * bflo(a.y) + w1 * bflo(b.y); y.w = w0 * bfhi(a.y) + w1 * bfhi(b.y);
        v[j] = r.x[j] + r.g2[j] * y;
        ss += (v[j].x * v[j].x + v[j].y * v[j].y) + (v[j].z * v[j].z + v[j].w * v[j].w); }
    const float rs = __builtin_amdgcn_rsqf(wave_sum(ss) * (1.0f / D) + EPSF);
#pragma unroll
    for (int j = 0; j < 4; ++j) { const int c = 4 * lane + 256 * j;
        if constexpr (FINAL) *(f32x4*)(xp + c) = (v[j] * rs) * gn[j];
        else { *(f32x4*)(xp + c) = v[j];
            const f32x4 y = (v[j] * rs) * gn[j] * (1.0f + r.s1[j]) + r.s0[j];
            u32x2 w; w.x = pk2(y.x, y.y); w.y = pk2(y.z, y.w); *(u32x2*)(hrow + c) = w; } }
}
template <bool FINAL>
__device__ __forceinline__ void phase_combine(float* XL, float* XC, const float* modv  , const bf16* YB, const unsigned* cnt, const int* toki, const float* tokw,
                                              const float* gnext, const float* modv_next, bf16* H, int nrows, int lane, int wave, int vcu, int G) {
    int tiles = 0; if (lane < 16) tiles = ((int)__hip_atomic_load(cnt + 64 * lane, RLX_AGENT) + 255) >> 8;
    int incl = tiles;
#pragma unroll
    for (int o = 1; o < 16; o <<= 1) { const int t = __shfl_up(incl, o); if (lane >= o) incl += t; }
    const int mybase = (incl - tiles) * 256;
    f32x4 gn[4];
#pragma unroll
    for (int j = 0; j < 4; ++j) gn[j] = *(const f32x4*)(gnext + 4 * lane + 256 * j);
    CbTok ta, tb, tc; CbRow ra, rb;
    cb_tok(ta, toki, tokw, thin_row(vcu, wave, 0)); cb_tok(tb, toki, tokw, thin_row(vcu, wave, 1));
    cb_issue<FINAL>(ra, ta, mybase, XL, XC, modv, modv_next, YB, thin_row(vcu, wave, 0), lane);
#pragma unroll
    for (int i = 0; i < TROWS; ++i) {
        const int row = thin_row(vcu, wave, i), row1 = thin_row(vcu, wave, i + 1), row2 = thin_row(vcu, wave, i + 2);
        CbTok& tcur = (i % 3 == 0) ? ta : (i % 3 == 1) ? tb : tc; CbTok& tnx = (i % 3 == 0) ? tb : (i % 3 == 1) ? tc : ta; CbTok& tn2 = (i % 3 == 0) ? tc : (i % 3 == 1) ? ta : tb;
        if (i + 2 < TROWS) cb_tok(tn2, toki, tokw, row2 < nrows ? row2 : row);
        if (i + 1 < TROWS) cb_issue<FINAL>((i & 1) ? ra : rb, tnx, mybase, XL, XC, modv, modv_next, YB, row1 < nrows ? row1 : row, lane);
        if (row < nrows) cb_finish<FINAL>((i & 1) ? rb : ra, tcur, gn, xrow_ptr(XL, XC, row), H + (size_t)row * D, lane);
    }
}

struct RoRow { u32x2 a[4], b[4], gt[4]; };
__device__ __forceinline__ void ro_issue(RoRow& r, const bf16* OF, const bf16* OB, const bf16* QKV2, int row, int lane) {
#pragma unroll
    for (int j = 0; j < 4; ++j) { const int c = 4 * lane + 256 * j;
        r.a[j] = *(const u32x2*)(OF + (size_t)row * D + c); r.b[j] = *(const u32x2*)(OB + (size_t)row * D + c); r.gt[j] = *(const u32x2*)(QKV2 + (size_t)row * NGLA + 2048 + c); }
}
__device__ __forceinline__ void ro_finish(const RoRow& r, const f32x4 gg, bf16* orow, int lane) {
#pragma unroll
    for (int j = 0; j < 4; ++j) { const u32x2 a = r.a[j], b = r.b[j], gt = r.gt[j];
        f32x4 o; o.x = bflo(a.x) + bflo(b.x); o.y = bfhi(a.x) + bfhi(b.x); o.z = bflo(a.y) + bflo(b.y); o.w = bfhi(a.y) + bfhi(b.y);
        const float ss = wave_sum((o.x * o.x + o.y * o.y) + (o.z * o.z + o.w * o.w));
        const float rs = __builtin_amdgcn_rsqf(ss * (1.0f / 256.0f) + EPSF);
        f32x4 gv; gv.x = silu_f(bflo(gt.x)); gv.y = silu_f(bfhi(gt.x)); gv.z = silu_f(bflo(gt.y)); gv.w = silu_f(bfhi(gt.y));
        const f32x4 y = (o * rs) * gg * gv;
        u32x2 w; w.x = pk2(y.x, y.y); w.y = pk2(y.z, y.w); *(u32x2*)(orow + 4 * lane + 256 * j) = w; }
}
__device__ __forceinline__ void phase_readout(const bf16* OF, const bf16* OB, const bf16* QKV2, const float* ng, bf16* AOUT, int nrows, int lane, int wave, int vcu, int G) {
    const f32x4 gg = *(const f32x4*)(ng + 4 * lane);
    RoRow ra, rb, rc;
    ro_issue(ra, OF, OB, QKV2, thin_row(vcu, wave, 0), lane); ro_issue(rb, OF, OB, QKV2, thin_row(vcu, wave, 1), lane);
#pragma unroll
    for (int i = 0; i < TROWS; ++i) {
        const int row = thin_row(vcu, wave, i), row2 = thin_row(vcu, wave, i + 2);
        RoRow& cur = (i % 3 == 0) ? ra : (i % 3 == 1) ? rb : rc; RoRow& n2 = (i % 3 == 0) ? rc : (i % 3 == 1) ? ra : rb;
        if (i + 2 < TROWS) ro_issue(n2, OF, OB, QKV2, row2 < nrows ? row2 : row, lane);
        if (row < nrows) ro_finish(cur, gg, AOUT + (size_t)row * D, lane);
    }
}

__device__ __forceinline__ int na_r0(int r) { int v = r - 4; return v < 0 ? 0 : (v > 24 ? 24 : v); }
template <int NMAPS, int DV, bool NA>
__device__ __forceinline__ void attn_unit(LAS unsigned char* lds, int tid, int lane, int wave,
                                          const bf16* QKV, int qcol, int qrow0, int kcol, int krow_lat, int krow_ctx, const bf16* VT, int klo, int khi,
                                          int r_wave, int xq0, const LAS float* biasT,
                                          bf16* AOUT, int ocol, float lam, const float* subg, float outscale) {
    constexpr int KB = 9216;
    constexpr int BUFSZ = NMAPS * KB + DV * 144;
    constexpr int NVB = DV / 16, NVR = DV / 64;
    const int fr = lane & 15, g = lane >> 4;
    bf16x8 qf[NMAPS][2];
    { const bf16* qp = QKV + (size_t)(qrow0 + wave * 16 + fr) * NATT + qcol + 8 * g;
#pragma unroll
      for (int m = 0; m < NMAPS; ++m)
#pragma unroll
          for (int s = 0; s < 2; ++s) qf[m][s] = *(const bf16x8*)(qp + m * 64 + 32 * s); }
    f32x4 O[NMAPS][NVB]; float mrun[NMAPS]; float lrun[NMAPS];
#pragma unroll
    for (int m = 0; m < NMAPS; ++m) { mrun[m] = -1e30f; lrun[m] = 0.f;
#pragma unroll
        for (int vb = 0; vb < NVB; ++vb) O[m][vb] = (f32x4){0.f, 0.f, 0.f, 0.f}; }
    const int ntiles = 4 + (khi - klo);
    u32x4 kreg[NMAPS], vreg[NVR];
    const int lkey = tid >> 3, lch = tid & 7;
#define AT_LOAD(i) do { const int _i = (i); const int _rowg = (_i < 4 ? krow_ctx + 64 * _i : krow_lat + 64 * (klo + _i - 4)) + lkey; const int _tok0 = (_i < 4 ? SEQ + 64 * _i : 64 * (klo + _i - 4)); \
        _Pragma("unroll") for (int m = 0; m < NMAPS; ++m) kreg[m] = *(const u32x4*)(QKV + (size_t)_rowg * NATT + kcol + m * 64 + lch * 8); \
        _Pragma("unroll") for (int j = 0; j < NVR; ++j) { const int idx = tid + 512 * j; vreg[j] = *(const u32x4*)(VT + (size_t)(idx >> 3) * NKEY + _tok0 + (idx & 7) * 8); } } while (0)
#define AT_STORE(b) do { LAS unsigned char* _p = lds + (b) * BUFSZ; \
        _Pragma("unroll") for (int m = 0; m < NMAPS; ++m) *(LAS u32x4*)(_p + m * KB + lkey * 144 + lch * 16) = kreg[m]; \
        _Pragma("unroll") for (int j = 0; j < NVR; ++j) { const int idx = tid + 512 * j; *(LAS u32x4*)(_p + NMAPS * KB + (idx >> 3) * 144 + (idx & 7) * 16) = vreg[j]; } } while (0)
    AT_LOAD(0); AT_STORE(0); __syncthreads();
    const int kbase0 = (8 * (fr >> 2) + (fr & 3)) * 144 + 16 * g;
    const int vbase = fr * 144 + 16 * g;
    int r0w = 0, xq = 0, tmask = 3, c0w = 0; float pen[4][4];
    if constexpr (NA) { r0w = na_r0(r_wave); xq = xq0 + fr; int cs = xq - 8; cs = cs < 0 ? 0 : (cs > 48 ? 48 : cs);
        c0w = xq0 - 8; c0w = c0w < 0 ? 0 : (c0w > 32 ? 32 : c0w);
        tmask = 1;
#pragma unroll
        for (int kb = 0; kb < 4; ++kb)
#pragma unroll
            for (int ii = 0; ii < 4; ++ii) { const int y = c0w + 32 * (kb >> 1) + 8 * g + 4 * (kb & 1) + ii; pen[kb][ii] = (y >= cs && y < cs + 16) ? 0.f : -1e30f; } }
    for (int i = 0; i < ntiles; ++i) {
        if (i + 1 < ntiles) AT_LOAD(i + 1);
        const LAS unsigned char* buf = lds + (i & 1) * BUFSZ;
        bool active = true; int kr = 0; bool local = false;
        if constexpr (NA) { if (i >= 4) { local = true; kr = klo + i - 4; active = (kr >= r0w) && (kr < r0w + 8); } }
        if (active) {
            const int tm = local ? tmask : 3;
            const int koffw = local ? c0w * 144 : 0, voffw = local ? c0w * 2 : 0;
            bf16x8 kf[NMAPS][4][2];
#pragma unroll
            for (int m = 0; m < NMAPS; ++m)
#pragma unroll
                for (int kb = 0; kb < 4; ++kb)
#pragma unroll
                    for (int s = 0; s < 2; ++s) kf[m][kb][s] = *(const LAS bf16x8*)(buf + m * KB + kbase0 + koffw + (kb & 1) * (4 * 144) + (kb >> 1) * (32 * 144) + s * 64);
            __builtin_amdgcn_sched_barrier(0);
            f32x4 S[NMAPS][4];
#pragma unroll
            for (int m = 0; m < NMAPS; ++m)
#pragma unroll
                for (int kb = 0; kb < 4; ++kb) { S[m][kb] = (f32x4){0.f, 0.f, 0.f, 0.f};
                    if (!NA || (tm >> (kb >> 1)) & 1) {
#pragma unroll
                        for (int s = 0; s < 2; ++s) S[m][kb] = __builtin_amdgcn_mfma_f32_16x16x32_bf16(kf[m][kb][s], qf[m][s], S[m][kb], 0, 0, 0); } }
            bf16x8 vf0[4][2];
#pragma unroll
            for (int vb = 0; vb < 4; ++vb)
#pragma unroll
                for (int t = 0; t < 2; ++t) vf0[vb][t] = *(const LAS bf16x8*)(buf + NMAPS * KB + vbase + voffw + vb * (16 * 144) + t * 64);
            __builtin_amdgcn_sched_barrier(0);
            bf16x8 pf[NMAPS][2];
#pragma unroll
            for (int m = 0; m < NMAPS; ++m) {
                if constexpr (NA) { if (local) {
                        const LAS float* bp = biasT + (kr - r_wave + 7) * 31 + (c0w + 8 * g - xq + 15);
#pragma unroll
                        for (int kb = 0; kb < 4; ++kb)
#pragma unroll
                            for (int ii = 0; ii < 4; ++ii) { const float t = (tm >> (kb >> 1)) & 1 ? (S[m][kb][ii] + pen[kb][ii]) + bp[32 * (kb >> 1) + 4 * (kb & 1) + ii] : -1e30f; S[m][kb][ii] = t; } } }
                float mx = fmaxf(fmaxf(S[m][0][0], S[m][0][1]), fmaxf(S[m][0][2], S[m][0][3]));
#pragma unroll
                for (int kb = 1; kb < 4; ++kb) mx = fmaxf(fmaxf(mx, S[m][kb][0]), fmaxf(fmaxf(S[m][kb][1], S[m][kb][2]), S[m][kb][3]));
                mx = swap32_max(swap16_max(mx));
                if (__any(mx > mrun[m] + 8.0f)) {
                    const float mnew = fmaxf(mrun[m], mx), alpha = fexp2(mrun[m] - mnew); mrun[m] = mnew; lrun[m] = lrun[m] * alpha;
#pragma unroll
                    for (int vb = 0; vb < NVB; ++vb) O[m][vb] = O[m][vb] * alpha;
                }
                const float mm = mrun[m];
                unsigned pw[8]; float l0 = 0.f, l1 = 0.f;
#pragma unroll
                for (int kb = 0; kb < 4; ++kb) { const float a0 = fexp2(S[m][kb][0] - mm), a1 = fexp2(S[m][kb][1] - mm), a2 = fexp2(S[m][kb][2] - mm), a3 = fexp2(S[m][kb][3] - mm);
                    l0 += a0 + a1; l1 += a2 + a3;
                    pw[2 * kb] = cvtpk(a0, a1); pw[2 * kb + 1] = cvtpk(a2, a3); }
                lrun[m] += l0 + l1;
                pf[m][0] = __builtin_bit_cast(bf16x8, (u32x4){pw[0], pw[1], pw[2], pw[3]});
                pf[m][1] = __builtin_bit_cast(bf16x8, (u32x4){pw[4], pw[5], pw[6], pw[7]});
            }
            __builtin_amdgcn_sched_barrier(0);
            if constexpr (NVB == 8) {
                bf16x8 vf1[4][2];
#pragma unroll
                for (int vb = 0; vb < 4; ++vb)
#pragma unroll
                    for (int t = 0; t < 2; ++t) vf1[vb][t] = *(const LAS bf16x8*)(buf + NMAPS * KB + vbase + (4 + vb) * (16 * 144) + t * 64);
                __builtin_amdgcn_sched_barrier(0);
#pragma unroll
                for (int vb = 0; vb < 4; ++vb)
#pragma unroll
                    for (int t = 0; t < 2; ++t)
#pragma unroll
                        for (int m = 0; m < NMAPS; ++m) O[m][vb] = __builtin_amdgcn_mfma_f32_16x16x32_bf16(vf0[vb][t], pf[m][t], O[m][vb], 0, 0, 0);
                __builtin_amdgcn_sched_barrier(0);
#pragma unroll
                for (int vb = 0; vb < 4; ++vb)
#pragma unroll
                    for (int t = 0; t < 2; ++t)
#pragma unroll
                        for (int m = 0; m < NMAPS; ++m) O[m][4 + vb] = __builtin_amdgcn_mfma_f32_16x16x32_bf16(vf1[vb][t], pf[m][t], O[m][4 + vb], 0, 0, 0);
            } else {
#pragma unroll
                for (int vb = 0; vb < 4; ++vb)
#pragma unroll
                    for (int t = 0; t < 2; ++t) { if (!NA || (tm >> t) & 1) {
#pragma unroll
                            for (int m = 0; m < NMAPS; ++m) O[m][vb] = __builtin_amdgcn_mfma_f32_16x16x32_bf16(vf0[vb][t], pf[m][t], O[m][vb], 0, 0, 0); } }
            }
            __builtin_amdgcn_sched_barrier(0);
        }
        if (i + 1 < ntiles) AT_STORE((i + 1) & 1);
        __syncthreads();
    }
#undef AT_LOAD
#undef AT_STORE
    float inv[NMAPS];
#pragma unroll
    for (int m = 0; m < NMAPS; ++m) { float l = lrun[m]; l = swap16_add(l, l); l = swap32_add(l, l); inv[m] = 1.0f / l; }
    const int orow = qrow0 + wave * 16 + fr;
    if constexpr (NMAPS == 2) {
        float ss = 0.f; const float i1 = inv[0], i2 = lam * inv[1];
#pragma unroll
        for (int vb = 0; vb < NVB; ++vb) { O[0][vb] = O[0][vb] * i1 - O[1][vb] * i2; const f32x4 o = O[0][vb]; ss += (o.x * o.x + o.y * o.y) + (o.z * o.z + o.w * o.w); }
        ss = swap16_add(ss, ss); ss = swap32_add(ss, ss);
        const float rs = __builtin_amdgcn_rsqf(ss * (1.0f / DV) + EPSF) * outscale;
#pragma unroll
        for (int vb = 0; vb < NVB; ++vb) { const f32x4 gg = *(const f32x4*)(subg + 16 * vb + 4 * g); const f32x4 y = O[0][vb] * rs * gg;
            u32x2 w; w.x = cvtpk(y.x, y.y); w.y = cvtpk(y.z, y.w); *(u32x2*)(AOUT + (size_t)orow * D + ocol + 16 * vb + 4 * g) = w; }
    } else {
#pragma unroll
        for (int vb = 0; vb < NVB; ++vb) { const f32x4 y = O[0][vb] * inv[0];
            u32x2 w; w.x = cvtpk(y.x, y.y); w.y = cvtpk(y.z, y.w); *(u32x2*)(AOUT + (size_t)orow * D + ocol + 16 * vb + 4 * g) = w; }
    }
}


typedef float f32x16 __attribute__((ext_vector_type(16)));
__device__ __forceinline__ void diff_unit32(LAS unsigned char* lds, int tid, int lane, int wave,
                                            const bf16* QKV, int qcol, int qrow0, int kcol, int krow_lat, int krow_ctx, const bf16* VT, int khi,
                                            bf16* AOUT, int ocol, float lam, const float* subg, float outscale) {
    constexpr int KB = 9216, VOFF = 2 * KB, BUFSZ = 2 * KB + 128 * 144;
    const int r = lane & 31, hf = lane >> 5, map = wave >> 2, wq = wave & 3;
    const int swz = ((r >> 4) & 1) << 2;
    bf16x8 qf[4];
    { const bf16* qp = QKV + (size_t)(qrow0 + 32 * wq + r) * NATT + qcol + map * 64 + 8 * hf;
#pragma unroll
      for (int ks = 0; ks < 4; ++ks) qf[ks] = *(const bf16x8*)(qp + 16 * ks); }
    f32x16 O[4];
#pragma unroll
    for (int blk = 0; blk < 4; ++blk)
#pragma unroll
        for (int i = 0; i < 16; ++i) O[blk][i] = 0.f;
    float negm = 0.f, lrun = 0.f;
    const int ntiles = 4 + khi;
    u32x4 kreg[2], vreg[2];
    const int lkey = tid >> 3, lch = tid & 7;
    const int kst = lkey * 144 + ((lch ^ (((lkey >> 4) & 1) << 2)) * 16);
#define D32_LOAD(i) do { const int _i = (i); const int _rowg = (_i < 4 ? krow_ctx + 64 * _i : krow_lat + 64 * (_i - 4)) + lkey; const int _tok0 = (_i < 4 ? SEQ + 64 * _i : 64 * (_i - 4)); \
        _Pragma("unroll") for (int m = 0; m < 2; ++m) kreg[m] = *(const u32x4*)(QKV + (size_t)_rowg * NATT + kcol + m * 64 + lch * 8); \
        _Pragma("unroll") for (int j = 0; j < 2; ++j) { const int idx = tid + 512 * j; vreg[j] = *(const u32x4*)(VT + (size_t)(idx >> 3) * NKEY + _tok0 + (idx & 7) * 8); } } while (0)
#define D32_STORE(b) do { LAS unsigned char* _p = lds + (b) * BUFSZ; \
        _Pragma("unroll") for (int m = 0; m < 2; ++m) *(LAS u32x4*)(_p + m * KB + kst) = kreg[m]; \
        _Pragma("unroll") for (int j = 0; j < 2; ++j) { const int idx = tid + 512 * j, vr = idx >> 3; *(LAS u32x4*)(_p + VOFF + vr * 144 + (((idx & 7) ^ (((vr >> 4) & 1) << 2)) * 16)) = vreg[j]; } } while (0)
    D32_LOAD(0); D32_STORE(0); D32_STORE(2); __syncthreads();
    const int krow = (r & 0x13) | ((r & 4) << 1) | ((r & 8) >> 1);
    const int kbase = map * KB + krow * 144, vbase = VOFF + r * 144;
    bf16x8 pfp[2][2];
#pragma unroll
    for (int kb = 0; kb < 2; ++kb)
#pragma unroll
        for (int sx = 0; sx < 2; ++sx) pfp[kb][sx] = (bf16x8){0, 0, 0, 0, 0, 0, 0, 0};
    int slot = 0;
    for (int i = 0; i < ntiles; ++i) {
        if (i + 1 < ntiles) D32_LOAD(i + 1);
        const int slotn = slot == 2 ? 0 : slot + 1, slotp = slot == 0 ? 2 : slot - 1;
        const LAS unsigned char* buf = lds + slot * BUFSZ; const LAS unsigned char* bufp = lds + slotp * BUFSZ;
        f32x16 S[2];
#pragma unroll
        for (int kb = 0; kb < 2; ++kb) {
#pragma unroll
            for (int ii = 0; ii < 16; ++ii) S[kb][ii] = negm;
#pragma unroll
            for (int ks = 0; ks < 4; ++ks) { const bf16x8 kf = *(const LAS bf16x8*)(buf + kbase + kb * (32 * 144) + (((2 * ks + hf) ^ swz) * 16));
                S[kb] = __builtin_amdgcn_mfma_f32_32x32x16_bf16(kf, qf[ks], S[kb], 0, 0, 0); } }
        __builtin_amdgcn_sched_barrier(0);
        float mx = -1e30f;
#pragma unroll
        for (int kb = 0; kb < 2; ++kb)
#pragma unroll
            for (int ii = 0; ii < 16; ii += 4) mx = fmaxf(fmaxf(mx, S[kb][ii]), fmaxf(fmaxf(S[kb][ii + 1], S[kb][ii + 2]), S[kb][ii + 3]));
        mx = swap32_max(mx);
        const bool resc = (i == 0) || __any(mx > 8.0f);
        float alpha = 1.0f;
        if (resc) { const float dlt = (i == 0) ? mx : fmaxf(mx, 0.f); alpha = fexp2(-dlt); negm -= dlt; lrun *= alpha;
#pragma unroll
            for (int kb = 0; kb < 2; ++kb)
#pragma unroll
                for (int ii = 0; ii < 16; ++ii) S[kb][ii] -= dlt; }
        __builtin_amdgcn_sched_barrier(0);
        bf16x8 pf[2][2]; float l0 = 0.f, l1 = 0.f;
#pragma unroll
        for (int kb = 0; kb < 2; ++kb)
#pragma unroll
            for (int sx = 0; sx < 2; ++sx) { unsigned pw[4];
#pragma unroll
                for (int j = 0; j < 4; ++j) { const float a0 = fexp2(S[kb][8 * sx + 2 * j]), a1 = fexp2(S[kb][8 * sx + 2 * j + 1]); l0 += a0; l1 += a1; pw[j] = cvtpk(a0, a1); }
                pf[kb][sx] = __builtin_bit_cast(bf16x8, (u32x4){pw[0], pw[1], pw[2], pw[3]}); }
        lrun += l0 + l1;
#pragma unroll
        for (int blk = 0; blk < 4; ++blk)
#pragma unroll
            for (int kb = 0; kb < 2; ++kb)
#pragma unroll
                for (int sx = 0; sx < 2; ++sx) { const bf16x8 vf = *(const LAS bf16x8*)(bufp + vbase + blk * (32 * 144) + (((4 * kb + 2 * sx + hf) ^ swz) * 16));
                    O[blk] = __builtin_amdgcn_mfma_f32_32x32x16_bf16(vf, pfp[kb][sx], O[blk], 0, 0, 0); }
#pragma unroll
        for (int k = 0; k < 16; ++k) { __builtin_amdgcn_sched_group_barrier(0x100, 1, 0); __builtin_amdgcn_sched_group_barrier(0x008, 1, 0); __builtin_amdgcn_sched_group_barrier(0x400, 2, 0); __builtin_amdgcn_sched_group_barrier(0x002, 4, 0); }
        __builtin_amdgcn_sched_barrier(0);
        if (resc) {
#pragma unroll
            for (int blk = 0; blk < 4; ++blk) O[blk] = O[blk] * alpha; }
#pragma unroll
        for (int kb = 0; kb < 2; ++kb)
#pragma unroll
            for (int sx = 0; sx < 2; ++sx) pfp[kb][sx] = pf[kb][sx];
        if (i + 1 < ntiles) D32_STORE(slotn);
        slot = slotn;
        __syncthreads();
    }
    { const LAS unsigned char* bufp = lds + (slot == 0 ? 2 : slot - 1) * BUFSZ;
#pragma unroll
      for (int blk = 0; blk < 4; ++blk)
#pragma unroll
          for (int kb = 0; kb < 2; ++kb)
#pragma unroll
              for (int sx = 0; sx < 2; ++sx) { const bf16x8 vf = *(const LAS bf16x8*)(bufp + vbase + blk * (32 * 144) + (((4 * kb + 2 * sx + hf) ^ swz) * 16));
                  O[blk] = __builtin_amdgcn_mfma_f32_32x32x16_bf16(vf, pfp[kb][sx], O[blk], 0, 0, 0); } }
    __syncthreads();
#undef D32_LOAD
#undef D32_STORE
    float l = lrun; l = swap32_add(l, l); const float inv = 1.0f / l;
    LAS float* X = (LAS float*)lds + (size_t)wq * 4096 + lane;
    if (map == 1) {
#pragma unroll
        for (int blk = 0; blk < 4; ++blk)
#pragma unroll
            for (int i = 0; i < 16; ++i) X[(blk * 16 + i) * 64] = O[blk][i] * inv;
    }
    __syncthreads();
    if (map == 0) {
        float ss = 0.f;
#pragma unroll
        for (int blk = 0; blk < 4; ++blk)
#pragma unroll
            for (int i = 0; i < 16; ++i) { const float o = O[blk][i] * inv - lam * X[(blk * 16 + i) * 64]; O[blk][i] = o; ss += o * o; }
        ss = swap32_add(ss, ss);
        const float rs = __builtin_amdgcn_rsqf(ss * (1.0f / 128.0f) + EPSF) * outscale;
        bf16* op = AOUT + (size_t)(qrow0 + 32 * wq + r) * D + ocol + 4 * hf;
#pragma unroll
        for (int blk = 0; blk < 4; ++blk)
#pragma unroll
            for (int g4 = 0; g4 < 4; ++g4) { const int dv0 = 32 * blk + 8 * g4; const f32x4 gg = *(const f32x4*)(subg + dv0 + 4 * hf);
                u32x2 w; w.x = cvtpk(O[blk][4 * g4] * rs * gg.x, O[blk][4 * g4 + 1] * rs * gg.y); w.y = cvtpk(O[blk][4 * g4 + 2] * rs * gg.z, O[blk][4 * g4 + 3] * rs * gg.w);
                *(u32x2*)(op + dv0) = w; }
    }
    __syncthreads();
}

__device__ __forceinline__ void phase_attention(const bf16* QKV, const bf16* VAT, const bf16* VBT, bf16* AOUT, const float* lamp  , float lam_init, const float* subg, const float* nab  ,
                                                unsigned* naq, const ConvPtrs& CP, int clo, int chi, LAS unsigned char* lds, int tid, int lane, int wave) {
    LAS float* biasT = (LAS float*)(lds + LX_BIAS) + 64;
    constexpr int NATT_U = 576 + 1152;
    const int ncu = (chi - clo + CV_UNIT - 1) / CV_UNIT, nq = NATT_U + ncu;
    int mine = 0; if (tid == 0) mine = (int)__hip_atomic_fetch_add(naq, 1u, RLX_AGENT);
    for (;;) {
        __syncthreads();
        if (tid == 0) *(LAS int*)(lds + LX_MISC + 64) = mine;
        __syncthreads();
        const int q = *(LAS int*)(lds + LX_MISC + 64);
        if (q >= nq) break;
        if (tid == 0) mine = (int)__hip_atomic_fetch_add(naq, 1u, RLX_AGENT);
        const int ai = (int)(((long)q * NATT_U) / nq); const bool isatt = (int)(((long)(q + 1) * NATT_U) / nq) > ai;
        if (!isatt) { conv_unit(CP, clo + (q - ai) * CV_UNIT, chi, lds, lane, wave); continue; }
        if (ai < 512 || (ai >= 1536 && ai < 1600)) {
            int bh, qrow0, khi;
            if (ai < 512) { bh = ai >> 4; const int qt = ai & 15; qrow0 = (bh >> 2) * SEQ + qt * 128; khi = 32; }
            else { const int u = ai - 1536; bh = u >> 1; const int qt = u & 1; qrow0 = TX + (bh >> 2) * CTXL + qt * 128; khi = 0; }
            const int b = bh >> 2, h = bh & 3;
            const float lam = __expf(wave_sum(lamp[lane] * lamp[64 + lane])) - __expf(wave_sum(lamp[128 + lane] * lamp[192 + lane])) + lam_init;
            diff_unit32(lds, tid, lane, wave, QKV, h * 128, qrow0, 512 + h * 128, b * SEQ, TX + b * CTXL, VAT + (size_t)bh * 128 * NKEY, khi,
                        AOUT, h * 128, lam, subg, 1.0f - lam_init);
        } else {
            int bh, qrow0, klo, khi, rw;
            if (ai < 1536) { const int u = ai - 512; bh = u >> 4; const int rp = u & 15; qrow0 = (bh >> 3) * SEQ + rp * 128; klo = na_r0(2 * rp); khi = na_r0(2 * rp + 1) + 8; rw = 2 * rp + (wave >> 2); }
            else { const int u = ai - 1600; bh = u >> 1; const int qt = u & 1; qrow0 = TX + (bh >> 3) * CTXL + qt * 128; klo = 0; khi = 0; rw = 0; }
            const int b = bh >> 3, h = bh & 7;
            for (int i = tid; i < 640; i += 512) { const int k = i - 64; biasT[k] = (k >= 0 && k < 465) ? nab[h * 465 + k] * LOG2E : 0.f; }
            attn_unit<1, 64, true>(lds, tid, lane, wave, QKV, 1536 + h * 64, qrow0, 2048 + h * 64, b * SEQ, TX + b * CTXL, VBT + (size_t)bh * 64 * NKEY, klo, khi,
                                   rw, 16 * (wave & 3), biasT, AOUT, 512 + h * 64, 0.f, nullptr, 1.0f);
        }
    }
}

__device__ __forceinline__ void gla_chunk_rows(int b, int dir, int n, int& row0, int& tok0) {
    if (n < 4) { const int cc = dir ? 3 - n : n; row0 = TX + b * CTXL + 64 * cc; tok0 = SEQ + 64 * cc; } else { const int lc = dir ? 35 - n : n - 4; row0 = b * SEQ + 64 * lc; tok0 = 64 * lc; }
}
constexpr int GP_QM = 0, GP_KM = 17408, GP_VT = 34816, GP_LR = 71680, GP_SEG = 75776;
__device__ __forceinline__ void phase_gla_prep(const bf16* QKV2, const bf16* VGT, const float* wgate  , const float* bgate  ,
                                               bf16* QG, bf16* KET, float* FACD, bf16* OF, bf16* OB,
                                               LAS unsigned char* lds, int tid, int lane, int wave, int vcu, int G) {
    const int fr = lane & 15, g = lane >> 4;
    const int d = tid & 127, seg = tid >> 7;
    LAS float* LR = (LAS float*)(lds + GP_LR);
    LAS float* SEG = (LAS float*)(lds + GP_SEG);
    for (int ub = vcu * 9; ub < 2304; ub += G * 9) {
        const int q = ub / 36, n0 = ub % 36, dir = q & 1, hh = (q >> 1) & 3, b = q >> 3;
        bf16* OUT = dir ? OB : OF;
        float wg[16];
#pragma unroll
        for (int r = 0; r < 16; ++r) wg[r] = wgate[(dir * 16 + r) * 512 + hh * 128 + d];
        const float bgv = bgate[dir * 512 + hh * 128 + d];
        const bf16* vtb = VGT + (size_t)(b * 4 + hh) * 256 * NKEY;
        u32x4 qr[2], kr[2], vr[4], lr4;
#define GP_LOAD(n) do { int _row0, _tok0; gla_chunk_rows(b, dir, (n), _row0, _tok0); \
        _Pragma("unroll") for (int j = 0; j < 2; ++j) { const int idx = tid + 512 * j, p = idx >> 4, ch = idx & 15; const bf16* src = QKV2 + (size_t)(_row0 + p) * NGLA + hh * 128 + ch * 8; qr[j] = *(const u32x4*)src; kr[j] = *(const u32x4*)(src + 512); } \
        _Pragma("unroll") for (int j = 0; j < 4; ++j) { const int idx = tid + 512 * j; vr[j] = *(const u32x4*)(vtb + (size_t)(idx >> 3) * NKEY + _tok0 + (idx & 7) * 8); } \
        if (tid < 128) lr4 = *(const u32x4*)(QKV2 + (size_t)(_row0 + (tid >> 1)) * NGLA + 3072 + dir * 16 + (tid & 1) * 8); } while (0)
#define GP_N(i) (dir ? ((i) < 4 ? 3 - (i) : 39 - (i)) : (i))
        GP_LOAD(GP_N(n0));
        for (int k9 = 0; k9 < 9; ++k9) {
            const int n = GP_N(n0 + k9), u = ub - n0 + n; int row0, tok0; gla_chunk_rows(b, dir, n, row0, tok0);
#pragma unroll
            for (int j = 0; j < 2; ++j) { const int idx = tid + 512 * j, p = idx >> 4, ch = idx & 15;
                *(LAS u32x4*)(lds + GP_QM + p * 272 + ch * 16) = qr[j]; *(LAS u32x4*)(lds + GP_KM + p * 272 + ch * 16) = kr[j]; }
#pragma unroll
            for (int j = 0; j < 4; ++j) { const int idx = tid + 512 * j; *(LAS u32x4*)(lds + GP_VT + (idx >> 3) * 144 + (idx & 7) * 16) = vr[j]; }
            if (tid < 128) { LAS float* lp = LR + (tid >> 1) * 16 + (tid & 1) * 8;
                lp[0] = bflo(lr4.x); lp[1] = bfhi(lr4.x); lp[2] = bflo(lr4.y); lp[3] = bfhi(lr4.y); lp[4] = bflo(lr4.z); lp[5] = bfhi(lr4.z); lp[6] = bflo(lr4.w); lp[7] = bfhi(lr4.w); }
            __syncthreads();
            if (k9 + 1 < 9) GP_LOAD(GP_N(n0 + k9 + 1));
            float gc[16];
#pragma unroll
            for (int pi = 0; pi < 16; ++pi) { const LAS f32x4* lp = (const LAS f32x4*)(LR + (16 * seg + pi) * 16); float z = bgv;
#pragma unroll
                for (int k = 0; k < 4; ++k) { const f32x4 l4 = lp[k]; z += l4.x * wg[4 * k] + l4.y * wg[4 * k + 1] + l4.z * wg[4 * k + 2] + l4.w * wg[4 * k + 3]; }
                const float az = fabsf(z); gc[pi] = (fminf(z, 0.f) - flog(1.0f + fexp(-az))) * 0.0625f; }
            float run = 0.f;
            if (dir == 0) {
#pragma unroll
                for (int pi = 0; pi < 16; ++pi) { run += gc[pi]; gc[pi] = run; }
            } else {
#pragma unroll
                for (int pi = 15; pi >= 0; --pi) { run += gc[pi]; gc[pi] = run; }
            }
            SEG[seg * 128 + d] = run;
            __syncthreads();
            const float t0 = SEG[d], t1 = SEG[128 + d], t2 = SEG[256 + d], t3 = SEG[384 + d];
            float off, gmid; const float gend = (t0 + t1) + (t2 + t3);
            if (dir == 0) { off = (seg > 0 ? t0 : 0.f) + (seg > 1 ? t1 : 0.f) + (seg > 2 ? t2 : 0.f); gmid = t0 + t1; }
            else { off = (seg < 3 ? t3 : 0.f) + (seg < 2 ? t2 : 0.f) + (seg < 1 ? t1 : 0.f); gmid = t3 + t2; }
            const float emid = fexp(gmid), eend = fexp(gend - gmid);
            unsigned kep[8];
            bf16* qgp = QG + ((size_t)u * 64 + 16 * seg) * 128 + d;
#pragma unroll
            for (int pi = 0; pi < 16; ++pi) { const int p = 16 * seg + pi; const float rel = off + gc[pi] - gmid; const float Ep = fexp(rel), Ei = fexp(-rel);
                LAS bf16* qa = (LAS bf16*)(lds + GP_QM) + p * 136 + d; LAS bf16* ka = (LAS bf16*)(lds + GP_KM) + p * 136 + d;
                const float qv = bf2f(*qa), kv = bf2f(*ka);
                const float qm = qv * Ep, km = kv * Ei;
                const unsigned w1 = cvtpk(qm, qm * emid), w2 = cvtpk(km, km * eend);
                *qa = (bf16)(w1 & 0xffffu); qgp[pi * 128] = (bf16)(w1 >> 16); *ka = (bf16)(w2 & 0xffffu);
                if (pi & 1) kep[pi >> 1] |= (w2 & 0xffff0000u); else kep[pi >> 1] = w2 >> 16; }
            { u32x4* kt = (u32x4*)(KET + ((size_t)u * 128 + d) * 64 + 16 * seg); kt[0] = (u32x4){kep[0], kep[1], kep[2], kep[3]}; kt[1] = (u32x4){kep[4], kep[5], kep[6], kep[7]}; }
            if (seg == 0) FACD[(size_t)u * 128 + d] = fexp(gend);
            __syncthreads();
            { const int cb = wave & 3, half = wave >> 2;
              bf16x8 qfr[4];
#pragma unroll
              for (int ks = 0; ks < 4; ++ks) qfr[ks] = *(const LAS bf16x8*)(lds + GP_QM + (16 * cb + fr) * 272 + (8 * g + 32 * ks) * 2);
              f32x4 AT[4];
#pragma unroll
              for (int sb = 0; sb < 4; ++sb) { AT[sb] = (f32x4){0.f, 0.f, 0.f, 0.f};
#pragma unroll
                  for (int ks = 0; ks < 4; ++ks) { const bf16x8 af = *(const LAS bf16x8*)(lds + GP_KM + (16 * sb + fr) * 272 + (8 * g + 32 * ks) * 2);
                      AT[sb] = __builtin_amdgcn_mfma_f32_16x16x32_bf16(af, qfr[ks], AT[sb], 0, 0, 0); }
                  const int c = 16 * cb + fr;
#pragma unroll
                  for (int ii = 0; ii < 4; ++ii) { const int sp = 16 * sb + 4 * g + ii; const bool keep = dir ? (sp >= c) : (sp <= c); AT[sb][ii] = keep ? AT[sb][ii] : 0.f; } }
              bf16x8 pf[2];
#pragma unroll
              for (int t = 0; t < 2; ++t) { u32x4 w; w.x = pk2(AT[2 * t][0], AT[2 * t][1]); w.y = pk2(AT[2 * t][2], AT[2 * t][3]); w.z = pk2(AT[2 * t + 1][0], AT[2 * t + 1][1]); w.w = pk2(AT[2 * t + 1][2], AT[2 * t + 1][3]);
                  pf[t] = __builtin_bit_cast(bf16x8, w); }
#pragma unroll
              for (int v8 = 0; v8 < 8; ++v8) { const int vb = 8 * half + v8; f32x4 Oa = (f32x4){0.f, 0.f, 0.f, 0.f};
#pragma unroll
                  for (int t = 0; t < 2; ++t) { const LAS unsigned char* vp = lds + GP_VT + (16 * vb + fr) * 144 + (32 * t + 4 * g) * 2;
                      const u32x2 lo = *(const LAS u32x2*)vp, hi = *(const LAS u32x2*)(vp + 32);
                      u32x4 w; w.x = lo.x; w.y = lo.y; w.z = hi.x; w.w = hi.y;
                      Oa = __builtin_amdgcn_mfma_f32_16x16x32_bf16(__builtin_bit_cast(bf16x8, w), pf[t], Oa, 0, 0, 0); }
                  u32x2 w; w.x = pk2(Oa[0], Oa[1]); w.y = pk2(Oa[2], Oa[3]);
                  *(u32x2*)(OUT + (size_t)(row0 + 16 * cb + fr) * D + hh * 256 + 16 * vb + 4 * g) = w; }
            }
            __syncthreads();
        }
#undef GP_LOAD
#undef GP_N
    }
}

constexpr int GS_BUF = 45056, GS_QG = 0, GS_KET = 17408, GS_VT = 35840, GS_ST = 2 * GS_BUF, GS_DEC = GS_ST + 2 * 17408;
__device__ __forceinline__ void phase_gla(const bf16* VGT, bf16* OF, bf16* OB, const bf16* QG, const bf16* KET, const float* FACD,
                                          LAS unsigned char* lds, int tid, int lane, int wave, int vcu, int G) {
    const int fr = lane & 15, g = lane >> 4;
    for (int u = vcu; u < 256; u += G) {
        const int slab = u & 3, dir = (u >> 2) & 1, hh = (u >> 3) & 3, b = u >> 5;
        bf16* OUT = dir ? OB : OF;
        const int upb = ((b * 4 + hh) * 2 + dir) * 36;
        f32x4 Sacc[4];
#pragma unroll
        for (int vb = 0; vb < 4; ++vb) Sacc[vb] = (f32x4){0.f, 0.f, 0.f, 0.f};
        for (int i = tid; i < 17408 / 4; i += 512) ((LAS unsigned*)(lds + GS_ST))[i] = 0u;
        const bf16* vtb = VGT + ((size_t)(b * 4 + hh) * 256 + slab * 64) * NKEY;
        const int cb = wave & 3, vh = wave >> 2;
        const int ocol = hh * 256 + slab * 64 + 32 * vh + 4 * g;
        struct GsRegs { u32x4 qg[2], ket[2], v; u32x2 oi[2]; float dec; };
        GsRegs R0, R1; R0.dec = 0.f; R1.dec = 0.f;
#define GS_LOAD(R, n) do { int _row0, _tok0; gla_chunk_rows(b, dir, (n), _row0, _tok0); const size_t _u = (size_t)(upb + (n)); \
        _Pragma("unroll") for (int j = 0; j < 2; ++j) { const int idx = tid + 512 * j; R.qg[j] = *(const u32x4*)(QG + _u * 8192 + idx * 8); R.ket[j] = *(const u32x4*)(KET + _u * 8192 + idx * 8); } \
        R.v = *(const u32x4*)(vtb + (size_t)(tid >> 3) * NKEY + _tok0 + (tid & 7) * 8); \
        if (tid < 128) R.dec = FACD[_u * 128 + tid]; \
        _Pragma("unroll") for (int v2 = 0; v2 < 2; ++v2) R.oi[v2] = *(const u32x2*)(OUT + (size_t)(_row0 + 16 * cb + fr) * D + ocol + 16 * v2); } while (0)
#define GS_STORE(R, bf) do { LAS unsigned char* _p = lds + (bf) * GS_BUF; \
        _Pragma("unroll") for (int j = 0; j < 2; ++j) { const int idx = tid + 512 * j; *(LAS u32x4*)(_p + GS_QG + (idx >> 4) * 272 + (idx & 15) * 16) = R.qg[j]; *(LAS u32x4*)(_p + GS_KET + (idx >> 3) * 144 + (idx & 7) * 16) = R.ket[j]; } \
        *(LAS u32x4*)(_p + GS_VT + (tid >> 3) * 144 + (tid & 7) * 16) = R.v; \
        if (tid < 128) ((LAS float*)(lds + GS_DEC))[(bf) * 128 + tid] = R.dec; } while (0)
#define GS_ITER(n, RN, RF) do { const int _n = (n); int row0, tok0; gla_chunk_rows(b, dir, _n, row0, tok0); const int cur = _n & 1; \
            if (_n + 2 < 36) GS_LOAD(RF, _n + 2); \
            const LAS unsigned char* bufp = lds + cur * GS_BUF; const LAS unsigned char* stp = lds + GS_ST + cur * 17408; \
            { bf16x8 qfr[4]; \
              _Pragma("unroll") for (int ks = 0; ks < 4; ++ks) qfr[ks] = *(const LAS bf16x8*)(bufp + GS_QG + (16 * cb + fr) * 272 + (8 * g + 32 * ks) * 2); \
              _Pragma("unroll") for (int v2 = 0; v2 < 2; ++v2) { const int vb = 2 * vh + v2; const u32x2 oin = v2 ? oc1 : oc0; \
                  f32x4 Oa = (f32x4){bflo(oin.x), bfhi(oin.x), bflo(oin.y), bfhi(oin.y)}; \
                  _Pragma("unroll") for (int ks = 0; ks < 4; ++ks) { const bf16x8 af = *(const LAS bf16x8*)(stp + (16 * vb + fr) * 272 + (8 * g + 32 * ks) * 2); \
                      Oa = __builtin_amdgcn_mfma_f32_16x16x32_bf16(af, qfr[ks], Oa, 0, 0, 0); } \
                  u32x2 w; w.x = pk2(Oa[0], Oa[1]); w.y = pk2(Oa[2], Oa[3]); \
                  *(u32x2*)(OUT + (size_t)(row0 + 16 * cb + fr) * D + ocol + 16 * v2) = w; } } \
            { const f32x4 dec = *(const LAS f32x4*)((LAS float*)(lds + GS_DEC) + cur * 128 + 16 * wave + 4 * g); \
              LAS unsigned char* stn = lds + GS_ST + (cur ^ 1) * 17408; \
              _Pragma("unroll") for (int vb = 0; vb < 4; ++vb) { Sacc[vb] = Sacc[vb] * dec; \
                  _Pragma("unroll") for (int t = 0; t < 2; ++t) { const bf16x8 af = *(const LAS bf16x8*)(bufp + GS_KET + (16 * wave + fr) * 144 + (8 * g + 32 * t) * 2); \
                      const bf16x8 bfr = *(const LAS bf16x8*)(bufp + GS_VT + (16 * vb + fr) * 144 + (8 * g + 32 * t) * 2); \
                      Sacc[vb] = __builtin_amdgcn_mfma_f32_16x16x32_bf16(af, bfr, Sacc[vb], 0, 0, 0); } \
                  u32x2 w; w.x = pk2(Sacc[vb][0], Sacc[vb][1]); w.y = pk2(Sacc[vb][2], Sacc[vb][3]); \
                  *(LAS u32x2*)(stn + (16 * vb + fr) * 272 + (16 * wave + 4 * g) * 2) = w; } } \
            if (_n + 1 < 36) { GS_STORE(RN, cur ^ 1); oc0 = RN.oi[0]; oc1 = RN.oi[1]; } \
            __syncthreads(); } while (0)
        GS_LOAD(R0, 0); GS_STORE(R0, 0);
        u32x2 oc0 = R0.oi[0], oc1 = R0.oi[1];
        GS_LOAD(R0, 1);
        __syncthreads();
        for (int n = 0; n < 36; n += 2) { GS_ITER(n, R0, R1); GS_ITER(n + 1, R1, R0); }
#undef GS_ITER
#undef GS_LOAD
#undef GS_STORE
    }
}

constexpr int N_PHASES = 34;
typedef const Args __attribute__((address_space(4)))* KArgs;
__device__ __forceinline__ KArgs kargs() { KArgs p = (KArgs)__builtin_amdgcn_kernarg_segment_ptr(); asm volatile("" : "+s"(p)); return p; }
__global__ void __launch_bounds__(512, 2) fwd(Args a_unused) {
    extern __shared__ __attribute__((aligned(16))) unsigned char lds_raw[];
    LAS unsigned char* lds = (LAS unsigned char*)lds_raw;
    const int tid0 = threadIdx.x;
    const int G0 = gridDim.x; const int bx0 = blockIdx.x;
#define PH_ENTRY int tid = tid0; asm volatile("" : "+v"(tid)); int G = G0, bx = bx0; asm volatile("" : "+s"(G), "+s"(bx)); const int lane = tid & 63, wave = __builtin_amdgcn_readfirstlane(tid >> 6); \
        const int vcu = (G % 8 == 0) ? (bx % 8) * (G / 8) + bx / 8 : bx; (void)lane; (void)wave; (void)vcu
    const int tid = tid0;
    const int ph_lo = kargs()->ph_lo, ph_hi = kargs()->ph_hi;
    const int repmask = kargs()->rep;
    if (tid < 64) ((LAS unsigned*)(lds + LX_MISC))[tid] = 0u;
    for (int i = tid; i < 1024; i += 512) { const int pos = i >> 4, f = i & 15; const float inv = __builtin_amdgcn_exp2f(-(float)f * (13.287712379549449f / 16.0f)); const float ang = (float)pos * inv;
        ((LAS float*)(lds + LX_ROPE))[2 * i] = __cosf(ang); ((LAS float*)(lds + LX_ROPE))[2 * i + 1] = __sinf(ang); }
    __syncthreads();
    const bool single = (ph_hi - ph_lo) > 1;
    XcdBarrier bar; bar.bar = (unsigned*)(kargs()->ws + WS_CTL) + CW_BAR; bar.x = 0; bar.st = (volatile LAS unsigned*)(lds + LX_MISC);
    if (single) bar = xcd_barrier_post((unsigned*)(kargs()->ws + WS_CTL) + CW_BAR, (volatile LAS unsigned*)(lds + LX_MISC));
#define IN(k) (ph_lo <= (k) && (k) < ph_hi)
#define REPLOOP(t) for (int rep_ = 0, nrep_ = 1 + ((repmask >> (t)) & 1); rep_ < nrep_; ++rep_, (rep_ < nrep_ ? (bar.bar = (unsigned*)(kargs()->ws + WS_CTL) + CW_BAR, xcd_barrier(bar)) : (void)0))
#define SEAM(k) do { if (IN(k) && IN((k) + 1)) { bar.bar = (unsigned*)(kargs()->ws + WS_CTL) + CW_BAR; xcd_barrier(bar); if ((repmask >> 10) & 1) xcd_barrier(bar); } } while (0)
    LAS int* tab = (LAS int*)(lds + LX_MOETAB);
#define CONV_PTRS(A) ConvPtrs{(A)->att_w_in, (A)->att_w_out, (A)->gla_w_in, (A)->gla_w_out, (A)->moe_w1, (A)->moe_w3, (A)->moe_w2, (A)->ws}

    if (IN(0)) REPLOOP(0) { PH_ENTRY; p0_prologue(kargs(), lds, tid, lane, wave, vcu, G); } SEAM(0);
    if (IN(1)) { PH_ENTRY; KArgs A = kargs(); unsigned char* ws = A->ws; phase_norm1(A->x, A->ctx, A->norm_g, (float*)(ws + WS_MODV), (bf16*)(ws + WS_H), TALL, lane, wave, vcu, G); } SEAM(1);

#pragma nounroll
    for (int L = 0; L < 4; ++L) {
        const int pb = 2 + 8 * L; const bool isattn = !(L & 1); const int j = L >> 1; const bool lastL = (L == 3);
        const int nrows = lastL ? TX : TALL;
        if (IN(pb)) REPLOOP(isattn ? 1 : 3) {
            PH_ENTRY; KArgs A = kargs(); unsigned char* ws = A->ws; unsigned char* big = ws + WS_BIG; const bf16* H = (const bf16*)(ws + WS_H);
            if (isattn) {
                pg8::DenseOrder S; S.init(H, (const bf16*)(ws + WS_WATTIN) + (size_t)j * NATT * D, TALL, NATT, D, G, bx);
                pg8::EpiAttnIn E{(bf16*)(big + BG_QKV), (bf16*)(big + BG_VAT), (bf16*)(big + BG_VBT), (const LAS float*)(lds + LX_ROPE)};
                pg8::gemm_phase<pg8::EpiAttnIn, pg8::DenseOrder, false>(lds, tid, D, S, E);
            } else {
                pg8::DenseOrder S; S.init(H, (const bf16*)(ws + WS_WGLAIN) + (size_t)j * NGLA * D, TALL, NGLA, D, G, bx);
                pg8::EpiGlaIn E{(bf16*)(big + BG_QKV2), (bf16*)(big + BG_VGT)};
                pg8::gemm_phase<pg8::EpiGlaIn, pg8::DenseOrder, false>(lds, tid, D, S, E);
            }
        }
        SEAM(pb);
        if (!isattn && IN(pb + 1)) {
            for (int rep_ = 0; rep_ <= ((repmask >> 13) & 1); ++rep_)
            { PH_ENTRY; KArgs A = kargs(); unsigned char* ws = A->ws;
              phase_gla_prep((const bf16*)(ws + WS_BIG + BG_QKV2), (const bf16*)(ws + WS_BIG + BG_VGT), A->gla_w_gate + j * 2 * 16 * 512, A->gla_b_gate + j * 2 * 512,
                             (bf16*)(ws + WS_QG), (bf16*)(ws + WS_KET), (float*)(ws + WS_BIG + BG_FAC), (bf16*)(ws + WS_BIG + BG_OF), (bf16*)(ws + WS_BIG + BG_OB), lds, tid, lane, wave, vcu, G); }
            if (single) { bar.bar = (unsigned*)(kargs()->ws + WS_CTL) + CW_BAR; xcd_barrier(bar); }
        }
        if (IN(pb + 1)) REPLOOP(isattn ? 2 : 4) {
            PH_ENTRY; KArgs A = kargs(); unsigned char* ws = A->ws; unsigned char* big = ws + WS_BIG; bf16* AOUT = (bf16*)(ws + WS_AOUT);
            if (isattn) { const ConvPtrs CP = CONV_PTRS(A);
                phase_attention((const bf16*)(big + BG_QKV), (const bf16*)(big + BG_VAT), (const bf16*)(big + BG_VBT), AOUT, A->att_lambda + j * 256, (L == 0) ? 0.2f : 0.470713018f,
                                A->att_subln_g + j * 128, A->na_bias + j * 8 * 465, (unsigned*)(ws + WS_CTL) + CW_NAQ + 64 * j, CP,
                                MK_CONVQ ? (L == 0 ? CT_ATTN0 : CT_MOE1) : 0, MK_CONVQ ? (L == 0 ? CT_MOE1 : CT_MOE3) : 0, lds, tid, lane, wave); }
            else phase_gla((const bf16*)(big + BG_VGT), (bf16*)(big + BG_OF), (bf16*)(big + BG_OB), (const bf16*)(ws + WS_QG), (const bf16*)(ws + WS_KET), (const float*)(big + BG_FAC),
                           lds, tid, lane, wave, vcu, G);
        }
        SEAM(pb + 1);
        if (!isattn) {
            if (IN(pb + 2)) REPLOOP(5) { PH_ENTRY; KArgs A = kargs(); unsigned char* ws = A->ws; unsigned char* big = ws + WS_BIG;
                phase_readout((const bf16*)(big + BG_OF), (const bf16*)(big + BG_OB), (const bf16*)(big + BG_QKV2), A->gla_norm_g + j * 256, (bf16*)(ws + WS_AOUT), nrows, lane, wave, vcu, G); }
            SEAM(pb + 2);
        }
        if (IN(pb + 3)) {
            PH_ENTRY; KArgs A = kargs(); unsigned char* ws = A->ws;
            pg8::DenseOrder S; S.init((const bf16*)(ws + WS_AOUT), (const bf16*)(ws + (isattn ? WS_WATTOUT : WS_WGLAOUT)) + (size_t)j * D * D, nrows, D, D, G, bx);
            pg8::EpiResid E{L == 0 ? A->x : A->out, L == 0 ? A->ctx : (const float*)(ws + WS_CTX), A->out, (float*)(ws + WS_CTX), (const float*)(ws + WS_MODV) + (size_t)L * 9 * 6144 + 2048};
            pg8::gemm_phase<pg8::EpiResid, pg8::DenseOrder, false>(lds, tid, D, S, E);
        }
        SEAM(pb + 3);
        if (IN(pb + 4)) { PH_ENTRY; KArgs A = kargs(); unsigned char* ws = A->ws;
            phase_router(A->out, (float*)(ws + WS_CTX), A->norm_g + (L * 2 + 1) * D, (const float*)(ws + WS_MODV) + (size_t)L * 9 * 6144, (bf16*)(ws + WS_H), A->router_w, A->router_bias,
                         (unsigned*)(ws + WS_CTL) + CW_CNT + L * 16 * 64, (int*)(ws + WS_LIST), (int*)(ws + WS_TOKI), (float*)(ws + WS_TOKW), nrows, lds, tid, lane, wave, vcu, G, (repmask >> 11) & 1); }
        SEAM(pb + 4);
        if (IN(pb + 5)) REPLOOP(6) {
            PH_ENTRY; KArgs A = kargs(); unsigned char* ws = A->ws;
            const int RT = build_moe_table((unsigned*)(ws + WS_CTL) + CW_CNT + L * 16 * 64, tab, tid);
            pg8::MoeOrder S; S.A = (const char*)(ws + WS_H); S.B = (const char*)(ws + WS_W13) + (size_t)L * 16 * D * D * 2; S.K = D; S.bstride = (size_t)D * D * 2; S.tab = tab; S.list = (const int*)(ws + WS_LIST); S.RT = RT; S.nwg = RT * 4; S.G = G; S.c = bx;
            pg8::EpiMoe1 E{(bf16*)(ws + WS_BIG + BG_HB)};
            pg8::gemm_phase<pg8::EpiMoe1, pg8::MoeOrder, true>(lds, tid, D, S, E);
        }
        SEAM(pb + 5);
        if (IN(pb + 6)) REPLOOP(7) {
            PH_ENTRY; KArgs A = kargs(); unsigned char* ws = A->ws;
            const int RT = build_moe_table((unsigned*)(ws + WS_CTL) + CW_CNT + L * 16 * 64, tab, tid);
            pg8::MoeOrder S; S.A = (const char*)(ws + WS_BIG + BG_HB); S.B = (const char*)(ws + WS_W2) + (size_t)L * 16 * D * DEXP * 2; S.K = DEXP; S.bstride = (size_t)D * DEXP * 2; S.tab = tab; S.list = (const int*)(ws + WS_LIST); S.RT = RT; S.nwg = RT * 4; S.G = G; S.c = bx;
            pg8::EpiBf16 E{(bf16*)(ws + WS_BIG + BG_YB), D};
            pg8::gemm_phase<pg8::EpiBf16, pg8::MoeOrder, false>(lds, tid, DEXP, S, E);
        }
        SEAM(pb + 6);
        if (IN(pb + 7)) { PH_ENTRY; KArgs A = kargs(); unsigned char* ws = A->ws; const float* MODV = (const float*)(ws + WS_MODV);
            if (lastL) phase_combine<true>(A->out, (float*)(ws + WS_CTX), MODV + (size_t)L * 9 * 6144, (const bf16*)(ws + WS_BIG + BG_YB), (unsigned*)(ws + WS_CTL) + CW_CNT + L * 16 * 64, (const int*)(ws + WS_TOKI), (const float*)(ws + WS_TOKW),
                                           A->final_g, MODV + (size_t)L * 9 * 6144, (bf16*)(ws + WS_H), nrows, lane, wave, vcu, G);
            else phase_combine<false>(A->out, (float*)(ws + WS_CTX), MODV + (size_t)L * 9 * 6144, (const bf16*)(ws + WS_BIG + BG_YB), (unsigned*)(ws + WS_CTL) + CW_CNT + L * 16 * 64, (const int*)(ws + WS_TOKI), (const float*)(ws + WS_TOKW),
                                      A->norm_g + ((L + 1) * 2) * D, MODV + (size_t)(L + 1) * 9 * 6144, (bf16*)(ws + WS_H), nrows, lane, wave, vcu, G); }
        if (!lastL) SEAM(pb + 7);
    }
#undef IN
#undef REPLOOP
#undef SEAM
#undef CONV_PTRS

#undef PH_ENTRY
}

extern "C" void kernel_launch(void* const* d_in, const int* in_sizes, int n_in, void* d_out, int out_size, void* d_ws, size_t ws_size, hipStream_t stream) {
    static int ready = 0;
    if (ready == 0) {
        if (n_in != 23 || out_size != TX * D || ws_size < WS_END) { fprintf(stderr, "kernel_launch: unexpected shapes (n_in %d out %d ws %zu)\n", n_in, out_size, ws_size); ready = -1; return; }
        if (hipFuncSetAttribute((const void*)fwd, hipFuncAttributeMaxDynamicSharedMemorySize, LDS_BYTES) != hipSuccess) { fprintf(stderr, "kernel_launch: hipFuncSetAttribute failed\n"); ready = -1; return; }
        int per_cu = 0; (void)hipOccupancyMaxActiveBlocksPerMultiprocessor(&per_cu, (const void*)fwd, 512, LDS_BYTES); (void)hipGetLastError();
        if (per_cu < 1) fprintf(stderr, "kernel_launch: occupancy query reports %d blocks per CU\n", per_cu);
        ready = 1;
    }
    if (ready < 0) return;
    (void)hipMemsetAsync((char*)d_ws + WS_CTL, 0, CTL_ZERO_BYTES, stream);
    Args a{};
    const float** ap = (const float**)&a;
    for (int i = 0; i < 23; ++i) ap[i] = (const float*)d_in[i];
    a.out = (float*)d_out; a.ws = (unsigned char*)d_ws;
    const int grid = 256;
    a.ph_lo = 0; a.ph_hi = N_PHASES; a.rep = MK_REPMASK;
    hipLaunchKernelGGL(fwd, dim3(grid), dim3(512), LDS_BYTES, stream, a);
}
```

```cpp
#include <hip/hip_runtime.h>
#include <cstdio>
#include <cstdint>

#ifndef MK_CONVQ
#define MK_CONVQ 1
#endif
#ifndef MK_REPMASK
#define MK_REPMASK 0
#endif

#define GAS __attribute__((address_space(1)))
#define LAS __attribute__((address_space(3)))
typedef unsigned short bf16;
typedef short bf16x8 __attribute__((ext_vector_type(8)));
typedef short bf16x4 __attribute__((ext_vector_type(4)));
typedef float f32x4 __attribute__((ext_vector_type(4)));
typedef float f32x2 __attribute__((ext_vector_type(2)));
typedef unsigned u32x4 __attribute__((ext_vector_type(4)));
typedef unsigned u32x2 __attribute__((ext_vector_type(2)));

constexpr int D = 1024, NB = 8, SEQ = 2048, CTXL = 256;
constexpr int TX = NB * SEQ, TC = NB * CTXL, TALL = TX + TC;
constexpr int NKEY = SEQ + CTXL;
constexpr int NATT = 3072, NGLA = 3328;
constexpr float EPSF = 1e-6f;
constexpr float LOG2E = 1.4426950408889634f;
constexpr int NEXP = 16, DEXP = 512;
constexpr int RT_MAX = 160;

constexpr size_t MiB = 1u << 20;
constexpr size_t WS_CTL = 0, CTL_ZERO_BYTES = 65536;
constexpr size_t WS_MODV = 1 * MiB;
constexpr size_t WS_TOKI = 2 * MiB;
constexpr size_t WS_TOKW = 2 * MiB + 512 * 1024;
constexpr size_t WS_LIST = 3 * MiB;
constexpr size_t WS_CTX = 5 * MiB;
constexpr size_t WS_WATTIN = 13 * MiB;
constexpr size_t WS_WATTOUT = 25 * MiB;
constexpr size_t WS_WGLAIN = 29 * MiB;
constexpr size_t WS_WGLAOUT = 42 * MiB;
constexpr size_t WS_W13 = 46 * MiB;
constexpr size_t WS_W2 = 174 * MiB;
constexpr size_t WS_H = 238 * MiB;
constexpr size_t WS_AOUT = 274 * MiB;
constexpr size_t WS_BIG = 310 * MiB;
constexpr size_t WS_END = 539 * MiB;
constexpr size_t BG_QKV = 0;
constexpr size_t BG_VAT = 108 * MiB;
constexpr size_t BG_VBT = 126 * MiB;
constexpr size_t BG_QKV2 = 0;
constexpr size_t BG_VGT = 117 * MiB;
constexpr size_t BG_OF = 153 * MiB;
constexpr size_t BG_OB = 189 * MiB;
constexpr size_t BG_FAC = 225 * MiB;
constexpr size_t WS_QG = WS_H, WS_KET = WS_AOUT;
constexpr size_t BG_HB = 0;
constexpr size_t BG_YB = 40 * MiB;
constexpr int CW_TMO = 0;
constexpr int CW_BAR = 4096;
constexpr int CW_NAQ = 15360;
constexpr int CW_CNT = 8192;

constexpr int RING_BYTES = 131072;
constexpr int LX_OFF = RING_BYTES;
constexpr int LX_MISC = LX_OFF;
constexpr int LX_MOETAB = LX_OFF + 256;
constexpr int LX_ROPE = LX_OFF + 2048;
constexpr int LX_BIAS = LX_OFF + 2048 + 8192;
constexpr int LDS_BYTES = 147456;

#define LDS_WAIT() asm volatile("s_waitcnt lgkmcnt(0)" ::: "memory")
#define VM_WAIT() asm volatile("s_waitcnt vmcnt(0)" ::: "memory")
#define RLX_AGENT __ATOMIC_RELAXED, __HIP_MEMORY_SCOPE_AGENT
__device__ __forceinline__ unsigned f2bf(float f) { unsigned u = __builtin_bit_cast(unsigned, f); return (u + 0x7fffu + ((u >> 16) & 1u)) >> 16; }
typedef __bf16 hwbf16x2 __attribute__((ext_vector_type(2)));
__device__ __forceinline__ unsigned cvtpk(float lo, float hi) { const f32x2 v = {lo, hi}; const hwbf16x2 b = __builtin_convertvector(v, hwbf16x2); return __builtin_bit_cast(unsigned, b); }
__device__ __forceinline__ unsigned pk2(float lo, float hi) { return cvtpk(lo, hi); }
__device__ __forceinline__ float bf2f(unsigned short b) { return __builtin_bit_cast(float, ((unsigned)b) << 16); }
__device__ __forceinline__ float bflo(unsigned w) { return __builtin_bit_cast(float, w << 16); }
__device__ __forceinline__ float bfhi(unsigned w) { return __builtin_bit_cast(float, w & 0xffff0000u); }
template <int CTRL> __device__ __forceinline__ float dppf(float v) { return __builtin_bit_cast(float, __builtin_amdgcn_update_dpp(0, __builtin_bit_cast(int, v), CTRL, 0xf, 0xf, true)); }
__device__ __forceinline__ float row_sum(float v) { v += dppf<0xB1>(v); v += dppf<0x4E>(v); v += dppf<0x124>(v); v += dppf<0x128>(v); return v; }
__device__ __forceinline__ float swap16_add(float a, float b) { auto r = __builtin_amdgcn_permlane16_swap(__float_as_uint(a), __float_as_uint(b), false, false); const unsigned r0 = r[0], r1 = r[1]; return __uint_as_float(r0) + __uint_as_float(r1); }
__device__ __forceinline__ float swap32_add(float a, float b) { auto r = __builtin_amdgcn_permlane32_swap(__float_as_uint(a), __float_as_uint(b), false, false); const unsigned r0 = r[0], r1 = r[1]; return __uint_as_float(r0) + __uint_as_float(r1); }
__device__ __forceinline__ float swap16_max(float a) { auto r = __builtin_amdgcn_permlane16_swap(__float_as_uint(a), __float_as_uint(a), false, false); const unsigned r0 = r[0], r1 = r[1]; return fmaxf(__uint_as_float(r0), __uint_as_float(r1)); }
__device__ __forceinline__ float swap32_max(float a) { auto r = __builtin_amdgcn_permlane32_swap(__float_as_uint(a), __float_as_uint(a), false, false); const unsigned r0 = r[0], r1 = r[1]; return fmaxf(__uint_as_float(r0), __uint_as_float(r1)); }
__device__ __forceinline__ float readlane_f(float v, int l) { return __int_as_float(__builtin_amdgcn_readlane(__float_as_int(v), l)); }
__device__ __forceinline__ float wave_sum(float v) { v = row_sum(v); v = swap16_add(v, v); return swap32_add(v, v); }
__device__ __forceinline__ float fexp2(float x) { return __builtin_amdgcn_exp2f(x); }
__device__ __forceinline__ float fexp(float x) { return __builtin_amdgcn_exp2f(x * LOG2E); }
__device__ __forceinline__ float flog(float x) { return __builtin_amdgcn_logf(x) * 0.6931471805599453f; }
__device__ __forceinline__ float frcp(float x) { return __builtin_amdgcn_rcpf(x); }
__device__ __forceinline__ float silu_f(float x) { return x * frcp(1.0f + fexp(-x)); }

#define XB_TMO      128
#define XB_XCNT(j)  (256  + 64 * (j))
#define XB_XSUB(j)  (1280 + 64 * (j))
#define XB_XGEN(j)  (2304 + 64 * (j))
#define XB_TOP      3328
#define XB_TOPGEN   3392
#define XCD_BAR_WORDS 3456
#define XB_SPIN_CAP (1u << 18)
__device__ __forceinline__ unsigned xb_ld(unsigned* p)              { return __hip_atomic_load(p, __ATOMIC_RELAXED, __HIP_MEMORY_SCOPE_AGENT); }
__device__ __forceinline__ unsigned xb_add(unsigned* p, unsigned v) { return __hip_atomic_fetch_add(p, v, __ATOMIC_RELAXED, __HIP_MEMORY_SCOPE_AGENT); }
__device__ __forceinline__ unsigned xb_xcc_id() { return (unsigned)__builtin_amdgcn_s_getreg((3 << 11) | 20) & 0xFu; }
#define XB_SPIN(cond, bar) do { unsigned _sp = 0; while (cond) { __builtin_amdgcn_s_sleep(1); \
    if ((++_sp & 255u) == 0u) { if (xb_ld(&(bar)[XB_TMO])) break; if (_sp > XB_SPIN_CAP) { atomicAdd(&(bar)[XB_TMO], 1u); break; } } } } while (0)
struct XcdBarrier { unsigned* bar; unsigned x; volatile LAS unsigned* st; };
__device__ __forceinline__ XcdBarrier xcd_barrier_post(unsigned* bar, volatile LAS unsigned* st) {
    XcdBarrier b; b.bar = bar; b.x = xb_xcc_id(); b.st = st;
    if (threadIdx.x == 0) (void)xb_add(&bar[XB_XCNT(b.x)], 1u);
    return b;
}
__device__ __forceinline__ void xcd_barrier_complete(unsigned* bar, unsigned x, unsigned& nloc, unsigned& nx) {
    const unsigned G = gridDim.x * gridDim.y * gridDim.z;
    unsigned sum, cnt, mine, sp = 0u;
    for (;;) {
        sum = 0u; cnt = 0u; mine = 0u;
#pragma unroll
        for (unsigned j = 0; j < 16; ++j) { const unsigned c = xb_ld(&bar[XB_XCNT(j)]); sum += c; cnt += (c > 0u) ? 1u : 0u; mine = (j == x) ? c : mine; }
        if (sum == G) break;
        __builtin_amdgcn_s_sleep(1);
        if ((++sp & 255u) == 0u) { if (xb_ld(&bar[XB_TMO])) break; if (sp > XB_SPIN_CAP) { atomicAdd(&bar[XB_TMO], 1u); break; } }
    }
    nloc = mine > 0u ? mine : 1u; nx = cnt > 0u ? cnt : 1u;
}
__device__ __forceinline__ void xcd_barrier(const XcdBarrier& b) {
    asm volatile("s_waitcnt vmcnt(0)" ::: "memory");
    __syncthreads();
    if (threadIdx.x == 0) {
        unsigned* bar = b.bar;
        __builtin_amdgcn_s_waitcnt(0);
        unsigned nloc = b.st[0], nx = b.st[1];
        if (nloc == 0u) { xcd_barrier_complete(bar, b.x, nloc, nx); b.st[0] = nloc; b.st[1] = nx; }
        const unsigned old = xb_add(&bar[XB_XSUB(b.x)], 1u);
        const unsigned gen = old / nloc;
        if (old + 1u == (gen + 1u) * nloc) {
            __builtin_amdgcn_fence(__ATOMIC_RELEASE, "agent");
            asm volatile("s_waitcnt vmcnt(0)" ::: "memory");
            const unsigned og = xb_add(&bar[XB_TOP], 1u);
            const unsigned tg = og / nx;
            if (og + 1u == (tg + 1u) * nx) xb_add(&bar[XB_TOPGEN], 1u);
            else XB_SPIN(xb_ld(&bar[XB_TOPGEN]) == tg, bar);
            __builtin_amdgcn_fence(__ATOMIC_ACQUIRE, "agent");
            xb_add(&bar[XB_XGEN(b.x)], 1u);
            asm volatile("s_waitcnt vmcnt(0)" ::: "memory");
        } else {
            XB_SPIN(xb_ld(&bar[XB_XGEN(b.x)]) == gen, bar);
            __builtin_amdgcn_fence(__ATOMIC_ACQUIRE, "agent");
            asm volatile("s_waitcnt vmcnt(0)" ::: "memory");
        }
    }
    __syncthreads();
}

namespace pg8 {
constexpr int BM = 256, BK = 64, HALF = 128, HTB = HALF * BK * 2, STAGE_BYTES = 8 * HTB, NXCD = 8, WGM = 8;
__host__ __device__ __forceinline__ int lds_byte(int r, int c) { const int st = (r >> 4) * 2 + (c >> 5), rr = r & 15, cc = c & 31, ob = rr * 64 + cc * 2; return st * 1024 + (ob ^ (((ob >> 9) & 1) << 5)); }
__host__ __device__ __forceinline__ void stage_rc(int b, int& R, int& C) { const int st = b / 1024, sb = b % 1024, swz = sb ^ (((sb >> 9) & 1) << 5); R = (st >> 1) * 16 + swz / 64; C = (st & 1) * 32 + (swz % 64) / 2; }
__host__ __device__ __forceinline__ int perm32(int rho) { const int n = rho >> 4, i = rho & 15; return 8 * (i >> 2) + 4 * n + (i & 3); }

struct Unit { int pm, pn, e, mt, roff, nai, ord; };
__device__ __forceinline__ bool split_index(long L, int nwg, int G, int& uidx, int& roff, int& nai) {
    const int R = nwg / G, r = nwg % G; const bool split = (r > 0) && (2 * r <= G);
    if (L < (long)R * G || !split) { if (L >= nwg) return false; uidx = (int)L; roff = 0; nai = 2; return true; }
    const int h = (int)(L - (long)R * G); if (h >= 2 * r) return false; uidx = R * G + (h >> 1); roff = (h & 1) * 128; nai = 1; return true;
}

__device__ __forceinline__ int xcd_remap(int wgid, int nwg) { const int q = nwg / NXCD, r = nwg % NXCD, xcd = wgid % NXCD, off = wgid / NXCD; return (xcd < r ? xcd * (q + 1) : r * (q + 1) + (xcd - r) * q) + off; }

struct DenseOrder {
    const char* A; const char* B; int K; int nM, nN, nwg, G, c;
    __device__ __forceinline__ void init(const bf16* A_, const bf16* B_, int M, int N, int K_, int G_, int c_) { A = (const char*)A_; B = (const char*)B_; K = K_; nM = M / BM; nN = N / BM; nwg = nM * nN; G = G_; c = c_; }
    __device__ __forceinline__ bool next(int i, Unit& u) const {
        int uidx; if (!split_index((long)i * G + c, nwg, G, uidx, u.roff, u.nai)) return false;
        const int wgid = xcd_remap(uidx, nwg);
        const int nig = WGM * nN, gid = wgid / nig, fm = gid * WGM, gsz = (nM - fm) < WGM ? (nM - fm) : WGM;
        u.pm = fm + ((wgid % nig) % gsz); u.pn = (wgid % nig) / gsz; u.e = 0; u.mt = 0; u.ord = i; return true;
    }
    __device__ __forceinline__ const char* a_ptr(const Unit& u) const { return A + (size_t)(u.pm * BM + u.roff) * K * 2; }
    __device__ __forceinline__ const char* b_ptr(const Unit& u) const { return B + (size_t)u.pn * BM * K * 2; }
    __device__ __forceinline__ int tok(const Unit&, int) const { return 0; }
};
struct MoeOrder {
    const char* A; const char* B; int K; size_t bstride;
    const LAS int* tab; const int* list; int RT, nwg, G, c;
    __device__ __forceinline__ bool next(int i, Unit& u) const {
        int uidx; if (!split_index((long)i * G + c, nwg, G, uidx, u.roff, u.nai)) return false;
        const int wgid = xcd_remap(uidx, nwg);
        const int rt = wgid >> 2; u.pm = rt; u.pn = wgid & 3; const int t = tab[rt]; u.e = t & 255; u.mt = t >> 8; u.ord = i; return true;
    }
    __device__ __forceinline__ const char* a_ptr(const Unit& u) const { return A + (size_t)(u.pm * BM + u.roff) * K * 2; }
    __device__ __forceinline__ const char* b_ptr(const Unit& u) const { return B + (size_t)u.e * bstride + (size_t)u.pn * BM * K * 2; }
    const LAS int* tokc;
    __device__ __forceinline__ int tok(const Unit& u, int r) const { return tokc[u.ord * BM + r]; }
    __device__ __forceinline__ void fill_tokc(LAS int* dst, int tid) {
        tokc = dst;
        int val[2], idx[2]; bool ok[2];
#pragma unroll
        for (int k = 0; k < 2; ++k) { const int i = (tid >> 8) + 2 * k, r = tid & 255; Unit u; const bool has = (i < 3) && next(i, u);
            const int cnt = has ? tab[RT_MAX + 1 + u.e] : 0; const int pos = has ? u.mt * BM + u.roff + r : 0;
            ok[k] = has; idx[k] = i * BM + r;
            val[k] = list[(size_t)(has ? u.e : 0) * TALL + pos];
            val[k] = (pos < cnt) ? val[k] : 0; }
#pragma unroll
        for (int k = 0; k < 2; ++k) if (ok[k]) dst[idx[k]] = val[k];
        __syncthreads();
    }
};

__device__ __forceinline__ unsigned cvt_pk_bf16(float lo, float hi) { unsigned r; asm volatile("v_cvt_pk_bf16_f32 %0, %1, %2" : "=v"(r) : "v"(lo), "v"(hi)); return r; }

template <class Epi, class Sched, bool GATHER>
__device__ __forceinline__ void gemm_phase(LAS unsigned char* lds, const int tid, const int K, const Sched& S, const Epi& E) {
    const int wid = __builtin_amdgcn_readfirstlane(tid >> 6), lane = tid & 63, wr = wid >> 2, wc = wid & 3, fr = lane & 15, fq = lane >> 4;
    const int nt = K / BK;
    unsigned voffA[2], voffB[2]; int RA[2], CA[2];
#pragma unroll
    for (int i = 0; i < 2; ++i) { int R, C; stage_rc(tid * 16 + i * 8192, R, C); const int Rb = Epi::PERM ? ((R & ~31) + perm32(R & 31)) : R;
        RA[i] = R; CA[i] = C; voffA[i] = (unsigned)(R * K + C) * 2u; voffB[i] = (unsigned)(Rb * K + C) * 2u; }
    const size_t kstep = (size_t)(BK * 2);
    const size_t hstep = (size_t)HALF * K * 2;
    const unsigned ldsw = (unsigned)wid * 1024u;
    const int aoff = lds_byte(wr * 64 + fr, fq * 8), boff = lds_byte(wc * 32 + fr, fq * 8);
#define PG8_SA(b, h) (((b) * 2 + (h)) * HTB)
#define PG8_SB(b, h) ((4 + (b) * 2 + (h)) * HTB)
#define PG8_STAGE(bufoff, gbase, voff) do { _Pragma("unroll") for (int _i = 0; _i < 2; ++_i) \
        __builtin_amdgcn_global_load_lds((const unsigned*)((const char*)(gbase) + (voff)[_i]), (LAS unsigned*)(lds + (bufoff) + ldsw + _i * 8192), 16, 0, 0); } while (0)
#define PG8_STAGE_A(bufoff, h, usenext, koff) do { if constexpr (GATHER) { unsigned _vo[2]; _vo[0] = (usenext) ? nvA[h][0] : vA[h][0]; _vo[1] = (usenext) ? nvA[h][1] : vA[h][1]; PG8_STAGE(bufoff, S.A + (koff), _vo); } \
        else { PG8_STAGE(bufoff, ((usenext) ? nA : cA) + (size_t)(h) * hstep + (koff), voffA); } } while (0)
#define PG8_LDA(dst, b, h) do { _Pragma("unroll") for (int m = 0; m < 4; ++m) _Pragma("unroll") for (int k = 0; k < 2; ++k) dst[m][k] = *(const LAS bf16x8*)(lds + PG8_SA(b, h) + aoff + m * 2048 + k * 1024); } while (0)
#define PG8_LDB(dst, b, h) do { _Pragma("unroll") for (int n = 0; n < 2; ++n) _Pragma("unroll") for (int k = 0; k < 2; ++k) dst[n][k] = *(const LAS bf16x8*)(lds + PG8_SB(b, h) + boff + n * 2048 + k * 1024); } while (0)
#define PG8_MMA(ai, bj, At, Bt) do { __builtin_amdgcn_s_setprio(1); _Pragma("unroll") for (int m = 0; m < 4; ++m) _Pragma("unroll") for (int n = 0; n < 2; ++n) _Pragma("unroll") for (int k = 0; k < 2; ++k) \
        acc[ai][bj][m][n] = __builtin_amdgcn_mfma_f32_16x16x32_bf16(Bt[n][k], At[m][k], acc[ai][bj][m][n], 0, 0, 0); __builtin_amdgcn_s_setprio(0); } while (0)
#define PG8_WAIT_V(n) asm volatile("s_waitcnt vmcnt(" #n ")" ::: "memory")
#define PG8_WAIT_L(n) asm volatile("s_waitcnt lgkmcnt(" #n ")" ::: "memory")
#define PG8_BAR __builtin_amdgcn_s_barrier()
#define PG8_SCHED __builtin_amdgcn_sched_barrier(0)
    Unit cur, nxt; int ui = 0;
    if (!S.next(0, cur)) return;
    f32x4 acc[2][2][4][2];
#pragma unroll
    for (int a = 0; a < 2; ++a)
#pragma unroll
        for (int b = 0; b < 2; ++b)
#pragma unroll
            for (int m = 0; m < 4; ++m)
#pragma unroll
                for (int n = 0; n < 2; ++n) acc[a][b][m][n] = (f32x4){0.f, 0.f, 0.f, 0.f};
    bf16x8 At[4][2], B0[2][2], B1[2][2];
    unsigned vA[2][2], nvA[2][2];
    if constexpr (GATHER) {
#pragma unroll
        for (int h = 0; h < 2; ++h)
#pragma unroll
            for (int i = 0; i < 2; ++i) { vA[h][i] = (unsigned)(S.tok(cur, h * HALF + RA[i]) * K + CA[i]) * 2u; nvA[h][i] = vA[h][i]; }
    }
    const char* cA = S.a_ptr(cur); const char* cB = S.b_ptr(cur); const char* nA = cA;
    PG8_STAGE(PG8_SB(0, 0), cB, voffB); PG8_STAGE(PG8_SB(0, 1), cB + hstep, voffB); PG8_STAGE_A(PG8_SA(0, 0), 0, false, 0); PG8_STAGE_A(PG8_SA(0, 1), 1, false, 0);
    if (wr == 1) PG8_BAR;
    PG8_WAIT_V(2); PG8_BAR;
    PG8_STAGE(PG8_SB(1, 0), cB + kstep, voffB); PG8_STAGE_A(PG8_SA(1, 0), 0, false, kstep); PG8_STAGE(PG8_SB(1, 1), cB + hstep + kstep, voffB);
    PG8_WAIT_V(6); PG8_BAR;
    for (;;) {
        const bool has_next = S.next(ui + 1, nxt);
        nA = has_next ? S.a_ptr(nxt) : cA; const char* nB = has_next ? S.b_ptr(nxt) : cB;
        if constexpr (GATHER) {
            if (has_next) {
#pragma unroll
                for (int h = 0; h < 2; ++h)
#pragma unroll
                    for (int i = 0; i < 2; ++i) nvA[h][i] = (unsigned)(S.tok(nxt, h * HALF + RA[i]) * K + CA[i]) * 2u;
            }
        }
        const bool full = (cur.nai == 2);
        for (int t = 0; t < nt; t += 2) {
            const bool last = (t == nt - 2);
            const size_t k1 = (size_t)(t + 1) * kstep;
            const size_t k2 = last ? 0 : (size_t)(t + 2) * kstep, k3 = k2 + kstep;
            const char* b2 = last ? nB : cB + (size_t)(t + 2) * kstep; const char* b3 = b2 + kstep;
            PG8_LDB(B0, 0, 0); PG8_LDB(B1, 0, 1); PG8_SCHED; PG8_LDA(At, 0, 0); PG8_STAGE_A(PG8_SA(1, 1), 1, false, k1);
            PG8_WAIT_V(8); PG8_WAIT_L(0); PG8_BAR; PG8_MMA(0, 0, At, B0); PG8_MMA(0, 1, At, B1); PG8_BAR; PG8_SCHED;
            if (full) PG8_LDA(At, 0, 1); PG8_STAGE(PG8_SB(0, 0), b2, voffB); PG8_STAGE(PG8_SB(0, 1), b2 + hstep, voffB); PG8_STAGE_A(PG8_SA(0, 0), 0, last, k2);
            PG8_WAIT_V(8); PG8_WAIT_L(0); PG8_BAR; if (full) { PG8_MMA(1, 0, At, B0); PG8_MMA(1, 1, At, B1); } PG8_BAR; PG8_SCHED;
            PG8_LDB(B0, 1, 0); PG8_LDB(B1, 1, 1); PG8_SCHED; PG8_LDA(At, 1, 0); PG8_STAGE_A(PG8_SA(0, 1), 1, last, k2);
            PG8_WAIT_V(8); PG8_WAIT_L(0); PG8_BAR; PG8_MMA(0, 0, At, B0); PG8_MMA(0, 1, At, B1); PG8_BAR; PG8_SCHED;
            if (full) PG8_LDA(At, 1, 1); PG8_STAGE(PG8_SB(1, 0), b3, voffB); PG8_STAGE(PG8_SB(1, 1), b3 + hstep, voffB); PG8_STAGE_A(PG8_SA(1, 0), 0, last, k3);
            PG8_WAIT_V(8); PG8_WAIT_L(0); PG8_BAR; if (full) { PG8_MMA(1, 0, At, B0); PG8_MMA(1, 1, At, B1); } PG8_BAR; PG8_SCHED;
        }
        if (wr == 0) PG8_BAR;
        E(acc, cur, wr, wc, fr, fq);
        if (!has_next) break;
#pragma unroll
        for (int a = 0; a < 2; ++a)
#pragma unroll
            for (int b = 0; b < 2; ++b)
#pragma unroll
                for (int m = 0; m < 4; ++m)
#pragma unroll
                    for (int n = 0; n < 2; ++n) acc[a][b][m][n] = (f32x4){0.f, 0.f, 0.f, 0.f};
        cur = nxt; cA = nA; cB = nB; ++ui;
        if constexpr (GATHER) {
#pragma unroll
            for (int h = 0; h < 2; ++h)
#pragma unroll
                for (int i = 0; i < 2; ++i) vA[h][i] = nvA[h][i];
        }
        if (wr == 1) PG8_BAR;
    }
    PG8_WAIT_V(0);
    PG8_BAR;
#undef PG8_SA
#undef PG8_SB
#undef PG8_STAGE
#undef PG8_STAGE_A
#undef PG8_LDA
#undef PG8_LDB
#undef PG8_MMA
#undef PG8_WAIT_V
#undef PG8_WAIT_L
#undef PG8_BAR
#undef PG8_SCHED
}
}

namespace pg8 {
__device__ __forceinline__ void row_bt(int row, int& b, int& tok) { if (row < TX) { b = row >> 11; tok = row & 2047; } else { const int r = row - TX; b = r >> 8; tok = SEQ + (r & 255); } }

struct EpiAttnIn {
    static constexpr bool PERM = true;
    bf16* QKV; bf16* VAT; bf16* VBT; const LAS float* rope;
    __device__ __forceinline__ void operator()(const f32x4 (&acc)[2][2][4][2], const Unit& u, int wr, int wc, int fr, int fq) const {
        const int row0 = u.pm * BM + u.roff + wr * 64 + fr; const int seg = u.pn >> 1;
        const bool latent = u.pm < (TX / BM);
        if (seg == 2 || seg == 5) {
#pragma unroll
            for (int ai = 0; ai < 2; ++ai) if (ai < u.nai)
#pragma unroll
                for (int m = 0; m < 4; ++m) { const int row = row0 + ai * HALF + m * 16; int b, tok; row_bt(row, b, tok);
#pragma unroll
                    for (int bj = 0; bj < 2; ++bj) { const int col = u.pn * BM + bj * HALF + wc * 32 + 8 * fq;
                        bf16* dst;
                        if (seg == 2) { const int cs = col - 1024; dst = VAT + ((size_t)(b * 4 + (cs >> 7)) * 128 + (cs & 127)) * NKEY + tok; }
                        else { const int cs = col - 2560; dst = VBT + ((size_t)(b * 8 + (cs >> 6)) * 64 + (cs & 63)) * NKEY + tok; }
#pragma unroll
                        for (int n = 0; n < 2; ++n)
#pragma unroll
                            for (int i = 0; i < 4; ++i) dst[(size_t)(4 * n + i) * NKEY] = (bf16)f2bf(acc[ai][bj][m][n][i]); } }
            return;
        }
        const bool dorope = latent && seg < 2;
        const float qs = (seg == 0 || seg == 3) ? 0.125f * LOG2E : 1.0f;
#pragma unroll
        for (int ai = 0; ai < 2; ++ai) if (ai < u.nai)
#pragma unroll
            for (int m = 0; m < 4; ++m) { const int row = row0 + ai * HALF + m * 16;
                f32x4 cs4[4];
                if (dorope) { const int t = row & 2047; const int pos = (wc & 1) ? (t & 63) : (t >> 6);
                    const LAS f32x4* rp = (const LAS f32x4*)(rope + (pos * 16 + 8 * (fq & 1)) * 2);
#pragma unroll
                    for (int j = 0; j < 4; ++j) cs4[j] = rp[j]; }
#pragma unroll
                for (int bj = 0; bj < 2; ++bj) { const int col = u.pn * BM + bj * HALF + wc * 32 + 8 * fq;
                    float v[8];
#pragma unroll
                    for (int n = 0; n < 2; ++n)
#pragma unroll
                        for (int i = 0; i < 4; ++i) v[4 * n + i] = acc[ai][bj][m][n][i];
                    if (dorope) {
#pragma unroll
                        for (int j = 0; j < 8; ++j) { const float other = __shfl_xor(v[j], 32); const float c = cs4[j >> 1][(j & 1) * 2], s = cs4[j >> 1][(j & 1) * 2 + 1];
                            v[j] = (fq < 2) ? (v[j] * c - other * s) : (v[j] * c + other * s); } }
                    u32x4 w; w.x = pk2(v[0] * qs, v[1] * qs); w.y = pk2(v[2] * qs, v[3] * qs); w.z = pk2(v[4] * qs, v[5] * qs); w.w = pk2(v[6] * qs, v[7] * qs);
                    *(u32x4*)(QKV + (size_t)row * NATT + col) = w; } }
    }
};
struct EpiGlaIn {
    static constexpr bool PERM = true;
    bf16* QKV2; bf16* VGT;
    __device__ __forceinline__ void operator()(const f32x4 (&acc)[2][2][4][2], const Unit& u, int wr, int wc, int fr, int fq) const {
        const int row0 = u.pm * BM + u.roff + wr * 64 + fr;
        if (u.pn >= 4 && u.pn < 8) {
#pragma unroll
            for (int ai = 0; ai < 2; ++ai) if (ai < u.nai)
#pragma unroll
                for (int m = 0; m < 4; ++m) { const int row = row0 + ai * HALF + m * 16; int b, tok; row_bt(row, b, tok);
#pragma unroll
                    for (int bj = 0; bj < 2; ++bj) { const int cs = u.pn * BM + bj * HALF + wc * 32 + 8 * fq - 1024;
                        bf16* dst = VGT + ((size_t)(b * 4 + (cs >> 8)) * 256 + (cs & 255)) * NKEY + tok;
#pragma unroll
                        for (int n = 0; n < 2; ++n)
#pragma unroll
                            for (int i = 0; i < 4; ++i) dst[(size_t)(4 * n + i) * NKEY] = (bf16)f2bf(acc[ai][bj][m][n][i]); } }
            return;
        }
        const float qs = (u.pn < 2) ? 0.08838834764831845f : 1.0f;
#pragma unroll
        for (int ai = 0; ai < 2; ++ai) if (ai < u.nai)
#pragma unroll
            for (int m = 0; m < 4; ++m) { const int row = row0 + ai * HALF + m * 16;
#pragma unroll
                for (int bj = 0; bj < 2; ++bj) { const int col = u.pn * BM + bj * HALF + wc * 32 + 8 * fq; const f32x4 a = acc[ai][bj][m][0] * qs, c = acc[ai][bj][m][1] * qs;
                    u32x4 w; w.x = pk2(a[0], a[1]); w.y = pk2(a[2], a[3]); w.z = pk2(c[0], c[1]); w.w = pk2(c[2], c[3]);
                    *(u32x4*)(QKV2 + (size_t)row * NGLA + col) = w; } }
    }
};
struct EpiResid {
    static constexpr bool PERM = false;
    const float* IL; const float* IC; float* XL; float* XC; const float* modv;
    __device__ __forceinline__ void operator()(const f32x4 (&acc)[2][2][4][2], const Unit& u, int wr, int wc, int fr, int fq) const {
        const int row0 = u.pm * BM + u.roff + wr * 64 + fr, col0 = u.pn * BM + wc * 32 + 4 * fq;
        const bool latent = u.pm < (TX / BM); const int bi = latent ? (u.pm >> 3) : 8;
        float* base = latent ? XL : (XC - (size_t)TX * D); const float* ibase = latent ? IL : (IC - (size_t)TX * D);
        f32x4 gv[2][2];
#pragma unroll
        for (int bj = 0; bj < 2; ++bj)
#pragma unroll
            for (int n = 0; n < 2; ++n) gv[bj][n] = *(const f32x4*)(modv + bi * 6144 + col0 + bj * HALF + n * 16);
#pragma unroll
        for (int ai = 0; ai < 2; ++ai) if (ai < u.nai) {
            f32x4 res[4][2][2];
#pragma unroll
            for (int m = 0; m < 4; ++m) { const size_t ro = (size_t)(row0 + ai * HALF + m * 16) * D + col0;
#pragma unroll
                for (int bj = 0; bj < 2; ++bj)
#pragma unroll
                    for (int n = 0; n < 2; ++n) res[m][bj][n] = *(const f32x4*)(ibase + ro + bj * HALF + n * 16); }
#pragma unroll
            for (int m = 0; m < 4; ++m) { const size_t ro = (size_t)(row0 + ai * HALF + m * 16) * D + col0;
#pragma unroll
                for (int bj = 0; bj < 2; ++bj)
#pragma unroll
                    for (int n = 0; n < 2; ++n) *(f32x4*)(base + ro + bj * HALF + n * 16) = res[m][bj][n] + gv[bj][n] * acc[ai][bj][m][n]; }
        }
    }
};
struct EpiMoe1 {
    static constexpr bool PERM = false;
    bf16* HB;
    __device__ __forceinline__ void operator()(const f32x4 (&acc)[2][2][4][2], const Unit& u, int wr, int wc, int fr, int fq) const {
        const int row0 = u.pm * BM + u.roff + wr * 64 + fr, col0 = u.pn * 128 + wc * 16 + 4 * fq;
#pragma unroll
        for (int ai = 0; ai < 2; ++ai) if (ai < u.nai)
#pragma unroll
            for (int m = 0; m < 4; ++m) { bf16* rowp = HB + (size_t)(row0 + ai * HALF + m * 16) * DEXP + col0;
#pragma unroll
                for (int bj = 0; bj < 2; ++bj) { const f32x4 a = acc[ai][bj][m][0], b = acc[ai][bj][m][1];
                    u32x2 w; w.x = pk2(silu_f(a[0]) * b[0], silu_f(a[1]) * b[1]); w.y = pk2(silu_f(a[2]) * b[2], silu_f(a[3]) * b[3]);
                    *(u32x2*)(rowp + bj * 64) = w; } }
    }
};
struct EpiBf16 {
    static constexpr bool PERM = true;
    bf16* O; int ldc;
    __device__ __forceinline__ void operator()(const f32x4 (&acc)[2][2][4][2], const Unit& u, int wr, int wc, int fr, int fq) const {
        const int row0 = u.pm * BM + u.roff + wr * 64 + fr, col0 = u.pn * BM + wc * 32 + 8 * fq;
#pragma unroll
        for (int ai = 0; ai < 2; ++ai) if (ai < u.nai)
#pragma unroll
            for (int m = 0; m < 4; ++m) { bf16* rowp = O + (size_t)(row0 + ai * HALF + m * 16) * ldc + col0;
#pragma unroll
                for (int bj = 0; bj < 2; ++bj) { const f32x4 a = acc[ai][bj][m][0], c = acc[ai][bj][m][1];
                    u32x4 w; w.x = pk2(a[0], a[1]); w.y = pk2(a[2], a[3]); w.z = pk2(c[0], c[1]); w.w = pk2(c[2], c[3]);
                    *(u32x4*)(rowp + bj * HALF) = w; } }
    }
};
}

struct Args {
    const float *x, *c, *ctx, *c_ctx, *w_mod, *b_mod, *norm_g, *final_g, *att_w_in, *att_w_out, *att_lambda, *att_subln_g, *na_bias,
                *gla_w_in, *gla_w_gate, *gla_b_gate, *gla_norm_g, *gla_w_out, *router_w, *router_bias, *moe_w1, *moe_w3, *moe_w2;
    float* out; unsigned char* ws; int ph_lo, ph_hi, rep, pad;
};

struct RowMapId { int off; __device__ __forceinline__ int operator()(int n) const { return off + n; } };
struct RowMapMoe { int which; __device__ __forceinline__ int operator()(int n) const { return 32 * (n >> 4) + 16 * which + (n & 15); } };
__device__ __forceinline__ void ti_load(float (&ld)[32], const float* W, int N, int item, int lane) {
    const int nblk = N / 32, kb = item / nblk, nb = item % nblk, k0 = 64 * kb, n0 = 32 * nb;
#pragma unroll
    for (int i = 0; i < 32; ++i) ld[i] = W[(size_t)(k0 + 2 * i + (lane >> 5)) * N + n0 + (lane & 31)];
}
template <class RM>
__device__ __forceinline__ void ti_finish(const float (&ld)[32], int K, int N, bf16* WT, LAS float* scr, int item, int lane, RM rm) {
    const int nblk = N / 32, kb = item / nblk, nb = item % nblk, k0 = 64 * kb, n0 = 32 * nb;
#pragma unroll
    for (int i = 0; i < 32; ++i) scr[(2 * i + (lane >> 5)) * 33 + (lane & 31)] = ld[i];
    LDS_WAIT(); asm volatile("" ::: "memory");
    const int c = lane & 7;
#pragma unroll
    for (int j = 0; j < 4; ++j) { const int n = (lane >> 3) + 8 * j; const LAS float* s = scr + (8 * c) * 33 + n;
        u32x4 o; o.x = pk2(s[0 * 33], s[1 * 33]); o.y = pk2(s[2 * 33], s[3 * 33]); o.z = pk2(s[4 * 33], s[5 * 33]); o.w = pk2(s[6 * 33], s[7 * 33]);
        *(u32x4*)(WT + (size_t)rm(n0 + n) * K + k0 + 8 * c) = o; }
    LDS_WAIT(); asm volatile("" ::: "memory");
}
template <class RM>
__device__ __forceinline__ void p0_transpose_item(const float* W, int K, int N, bf16* WT, LAS float* scr, int item, int lane, RM rm) {
    float ld[32]; ti_load(ld, W, N, item, lane); ti_finish(ld, K, N, WT, scr, item, lane, rm);
}

constexpr int CV_ATTIN = 1536, CV_ATTOUT = 512, CV_GLAIN = 1552, CV_GLAPAD = 28, CV_GLAOUT = 512, CV_W = 4096, CV_MOE = 3 * CV_W;
constexpr int CT_ATTN0 = CV_ATTIN + CV_ATTOUT, CT_MOE0 = CT_ATTN0 + CV_MOE, CT_GLA0 = CT_MOE0 + CV_GLAIN + CV_GLAPAD + CV_GLAOUT, CT_ATTN1 = CT_GLA0 + CV_ATTIN + CV_ATTOUT, CT_MOE1 = CT_ATTN1 + CV_MOE,
              CT_MOE2 = CT_MOE1 + CV_MOE, CT_GLA1 = CT_MOE2 + CV_GLAIN + CV_GLAPAD + CV_GLAOUT, CT_MOE3 = CT_GLA1 + CV_MOE, CV_TOTAL = CT_MOE3;
constexpr int CV_UNIT = 32;
struct ConvPtrs { const float *att_w_in, *att_w_out, *gla_w_in, *gla_w_out, *moe_w1, *moe_w3, *moe_w2; unsigned char* ws; };
struct RowMapAny { int moe, which; __device__ __forceinline__ int operator()(int n) const { return moe ? 32 * (n >> 4) + 16 * which + (n & 15) : n; } };
struct ConvDesc { const float* W; bf16* WT; int K, N, sub, kind  ; RowMapAny rm; };
__device__ __forceinline__ ConvDesc conv_decode(const ConvPtrs& P, int it, int hi) {
    ConvDesc d; d.W = nullptr; d.WT = nullptr; d.K = D; d.N = D; d.sub = 0; d.kind = 0; d.rm = RowMapAny{0, 0};
    if (it >= hi) return d;
    int kind, j, r;
    if (it < CT_ATTN0) { kind = 0; j = 0; r = it; } else if (it < CT_MOE0) { kind = 2; j = 0; r = it - CT_ATTN0; } else if (it < CT_GLA0) { kind = 1; j = 0; r = it - CT_MOE0; }
    else if (it < CT_ATTN1) { kind = 0; j = 1; r = it - CT_GLA0; } else if (it < CT_MOE1) { kind = 2; j = 1; r = it - CT_ATTN1; } else if (it < CT_MOE2) { kind = 2; j = 2; r = it - CT_MOE1; }
    else if (it < CT_GLA1) { kind = 1; j = 1; r = it - CT_MOE2; } else { kind = 2; j = 3; r = it - CT_GLA1; }
    d.kind = 1; d.sub = r;
    if (kind == 2) {
        const int which = r / CV_W, q = r % CV_W, e = q >> 8, je = j * 16 + e; d.sub = q & 255;
        if (which < 2) { d.W = (which ? P.moe_w3 : P.moe_w1) + (size_t)je * D * DEXP; d.N = DEXP; d.WT = (bf16*)(P.ws + WS_W13) + (size_t)je * D * D; d.rm.moe = 1; d.rm.which = which; }
        else { d.W = P.moe_w2 + (size_t)je * DEXP * D; d.K = DEXP; d.WT = (bf16*)(P.ws + WS_W2) + (size_t)je * D * DEXP; }
    } else if (kind == 0) {
        if (r < CV_ATTIN) { d.W = P.att_w_in + (size_t)j * D * NATT; d.N = NATT; d.WT = (bf16*)(P.ws + WS_WATTIN) + (size_t)j * NATT * D; }
        else { d.W = P.att_w_out + (size_t)j * D * D; d.WT = (bf16*)(P.ws + WS_WATTOUT) + (size_t)j * D * D; d.sub = r - CV_ATTIN; }
    } else {
        if (r < CV_GLAIN) { d.W = P.gla_w_in + (size_t)j * D * 3104; d.N = 3104; d.WT = (bf16*)(P.ws + WS_WGLAIN) + (size_t)j * NGLA * D; }
        else if (r < CV_GLAIN + CV_GLAPAD) { d.kind = 2; d.sub = (r - CV_GLAIN) * 1024; d.WT = (bf16*)(P.ws + WS_WGLAIN) + (size_t)j * NGLA * D + (size_t)3104 * D; }
        else { d.W = P.gla_w_out + (size_t)j * D * D; d.WT = (bf16*)(P.ws + WS_WGLAOUT) + (size_t)j * D * D; d.sub = r - CV_GLAIN - CV_GLAPAD; }
    }
    return d;
}
__device__ __forceinline__ void conv_load(const ConvDesc& d, float (&ld)[32], int lane) { if (d.kind == 1) ti_load(ld, d.W, d.N, d.sub, lane); }
__device__ __forceinline__ void conv_finish(const ConvDesc& d, const float (&ld)[32], LAS float* scr, int lane) {
    if (d.kind == 1) ti_finish(ld, d.K, d.N, d.WT, scr, d.sub, lane, d.rm);
    else if (d.kind == 2) { for (int i = lane; i < 1024; i += 64) *(u32x4*)(d.WT + (size_t)(d.sub + i) * 8) = (u32x4){0u, 0u, 0u, 0u}; }
}
__device__ __forceinline__ void conv_item(const ConvPtrs& P, int it, LAS float* scr, int lane) {
    const ConvDesc d = conv_decode(P, it, it + 1); float ld[32]; conv_load(d, ld, lane); conv_finish(d, ld, scr, lane);
}
__device__ __forceinline__ void conv_static(const ConvPtrs& P, int cur, int need, LAS unsigned char* lds, int lane, int wave, int vcu, int G) {
    LAS float* scr = (LAS float*)(lds + wave * 8448);
    for (int it = cur + vcu * 8 + wave; it < need; it += G * 8) conv_item(P, it, scr, lane);
}
__device__ __forceinline__ void conv_unit(const ConvPtrs& P, int i0, int hi, LAS unsigned char* lds, int lane, int wave) {
    LAS float* scr = (LAS float*)(lds + wave * 8448);
    constexpr int NPW = CV_UNIT / 8; static_assert(NPW == 4, "four items per wave");
    const int it0 = i0 + wave * NPW;
    float la[32], lb[32];
    ConvDesc dA = conv_decode(P, it0, hi); conv_load(dA, la, lane);
    ConvDesc dB = conv_decode(P, it0 + 1, hi); conv_load(dB, lb, lane);
    conv_finish(dA, la, scr, lane);
    dA = conv_decode(P, it0 + 2, hi); conv_load(dA, la, lane);
    conv_finish(dB, lb, scr, lane);
    dB = conv_decode(P, it0 + 3, hi); conv_load(dB, lb, lane);
    conv_finish(dA, la, scr, lane);
    conv_finish(dB, lb, scr, lane);
}

template <class AP> __device__ __forceinline__ void p0_prologue(const AP ap, LAS unsigned char* lds, int tid, int lane, int wave, int vcu, int G) {
    unsigned char* ws = ap->ws;
    LAS float* S9 = (LAS float*)(lds + 69632);
    LAS float* red = (LAS float*)(lds + 106496);
    { const ConvPtrs P{ap->att_w_in, ap->att_w_out, ap->gla_w_in, ap->gla_w_out, ap->moe_w1, ap->moe_w3, ap->moe_w2, ws};
      conv_static(P, 0, MK_CONVQ ? CT_ATTN0 : CV_TOTAL, lds, lane, wave, vcu, G); }
    __syncthreads();
    { const float* cc = ap->c; const float* cx = ap->c_ctx;
      for (int i = tid; i < 9 * 1024; i += 512) { const int bi = i >> 10, k = i & 1023; const float v = (bi < 8) ? cc[bi * D + k] : cx[k]; S9[i] = v / (1.0f + __expf(-v)); } }
    __syncthreads();
    const float* w_mod = ap->w_mod; const float* b_mod = ap->b_mod;
    for (int u = vcu; u < 4 * 96; u += G) {
        const int L = u / 96, n0 = (u % 96) * 64;
        const float* W = w_mod + (size_t)L * D * 6144 + n0 + lane;
        float acc[9];
#pragma unroll
        for (int bi = 0; bi < 9; ++bi) acc[bi] = 0.f;
        const int kb = wave * 128;
        for (int k0 = 0; k0 < 128; k0 += 32) { float wv[32];
#pragma unroll
            for (int k = 0; k < 32; ++k) wv[k] = W[(size_t)(kb + k0 + k) * 6144];
#pragma unroll
            for (int k = 0; k < 32; ++k)
#pragma unroll
                for (int bi = 0; bi < 9; ++bi) acc[bi] += S9[bi * 1024 + kb + k0 + k] * wv[k]; }
#pragma unroll
        for (int bi = 0; bi < 9; ++bi) red[(wave * 9 + bi) * 64 + lane] = acc[bi];
        __syncthreads();
        for (int i = tid; i < 9 * 64; i += 512) { const int bi = i >> 6, l = i & 63; float sm = b_mod[L * 6144 + n0 + l];
#pragma unroll
            for (int w = 0; w < 8; ++w) sm += red[(w * 9 + bi) * 64 + l];
            ((float*)(ws + WS_MODV))[(size_t)(L * 9 + bi) * 6144 + n0 + l] = sm; }
        __syncthreads();
    }
}

__device__ __forceinline__ float* xrow_ptr(float* XL, float* XC, int row) { return row < TX ? XL + (size_t)row * D : XC + (size_t)(row - TX) * D; }
__device__ __forceinline__ int row_bi(int row) { return row < TX ? (row >> 11) : 8; }

__device__ __forceinline__ void norm_mod_store(const f32x4 (&v)[4], const float* g, const float* sh, const float* sc, bf16* orow, int lane) {
    float ss = 0.f;
#pragma unroll
    for (int j = 0; j < 4; ++j) ss += (v[j].x * v[j].x + v[j].y * v[j].y) + (v[j].z * v[j].z + v[j].w * v[j].w);
    const float rs = __builtin_amdgcn_rsqf(wave_sum(ss) * (1.0f / D) + EPSF);
#pragma unroll
    for (int j = 0; j < 4; ++j) { const int c = 4 * lane + 256 * j; const f32x4 gg = *(const f32x4*)(g + c), s1 = *(const f32x4*)(sc + c), s0 = *(const f32x4*)(sh + c);
        const f32x4 y = (v[j] * rs) * gg * (1.0f + s1) + s0;
        u32x2 w; w.x = pk2(y.x, y.y); w.y = pk2(y.z, y.w); *(u32x2*)(orow + c) = w; }
}

constexpr int TROWS = 9;
__device__ __forceinline__ int thin_row(int vcu, int wave, int i) { return vcu * 8 + wave + 2048 * i; }

struct N1Row { f32x4 x[4], s0[4], s1[4]; };
__device__ __forceinline__ void n1_issue(N1Row& r, const float* XL, const float* XC, const float* modv, int row, int lane) {
    const f32x4* xr = (const f32x4*)(row < TX ? XL + (size_t)row * D : XC + (size_t)(row - TX) * D) + lane; const float* mv = modv + row_bi(row) * 6144;
#pragma unroll
    for (int j = 0; j < 4; ++j) { r.x[j] = xr[64 * j]; r.s0[j] = *(const f32x4*)(mv + 4 * lane + 256 * j); r.s1[j] = *(const f32x4*)(mv + 1024 + 4 * lane + 256 * j); }
}
__device__ __forceinline__ void n1_finish(const N1Row& r, const f32x4 (&gg)[4], bf16* orow, int lane) {
    float ss = 0.f;
#pragma unroll
    for (int j = 0; j < 4; ++j) ss += (r.x[j].x * r.x[j].x + r.x[j].y * r.x[j].y) + (r.x[j].z * r.x[j].z + r.x[j].w * r.x[j].w);
    const float rs = __builtin_amdgcn_rsqf(wave_sum(ss) * (1.0f / D) + EPSF);
#pragma unroll
    for (int j = 0; j < 4; ++j) { const f32x4 y = (r.x[j] * rs) * gg[j] * (1.0f + r.s1[j]) + r.s0[j];
        u32x2 w; w.x = pk2(y.x, y.y); w.y = pk2(y.z, y.w); *(u32x2*)(orow + 4 * lane + 256 * j) = w; }
}
__device__ __forceinline__ void phase_norm1(const float* XL, const float* XC, const float* g, const float* modv, bf16* H, int nrows, int lane, int wave, int vcu, int G) {
    f32x4 gg[4];
#pragma unroll
    for (int j = 0; j < 4; ++j) gg[j] = *(const f32x4*)(g + 4 * lane + 256 * j);
    N1Row ra, rb;
    n1_issue(ra, XL, XC, modv, thin_row(vcu, wave, 0), lane);
#pragma unroll
    for (int i = 0; i < TROWS; ++i) {
        const int row = thin_row(vcu, wave, i), rown = thin_row(vcu, wave, i + 1);
        if (i + 1 < TROWS) n1_issue((i & 1) ? ra : rb, XL, XC, modv, rown < nrows ? rown : row, lane);
        if (row < nrows) n1_finish((i & 1) ? rb : ra, gg, H + (size_t)row * D, lane);
    }
}

__device__ __forceinline__ void phase_router(float* XL, float* XC, const float* g, const float* modv, bf16* H, const float* router_w, const float* router_bias,
                                             unsigned* cnt  , int* list, int* toki, float* tokw, int nrows,
                                             LAS unsigned char* lds, int tid, int lane, int wave, int vcu, int G, int probe) {
    LAS float* RW = (LAS float*)lds;
    LAS int* lcnt = (LAS int*)(lds + 65536);
    LAS int* rinfo = (LAS int*)(lds + 65536 + 256);
    for (int it = 0; it < 8; ++it) { const int idx = tid + 512 * it, k = idx >> 2, q = idx & 3; const f32x4 w = *(const f32x4*)(router_w + k * 16 + 4 * q);
        RW[(4 * q + 0) * 1024 + k] = w.x; RW[(4 * q + 1) * 1024 + k] = w.y; RW[(4 * q + 2) * 1024 + k] = w.z; RW[(4 * q + 3) * 1024 + k] = w.w; }
    if (tid < 32) lcnt[tid] = 0;
    __syncthreads();
    const int rpb = nrows / G, rpw = rpb / 8;
    const int gI = lane >> 4;
    const f32x4 rb = *(const f32x4*)(router_bias + 4 * gI);
    f32x4 gg[4];
#pragma unroll
    for (int j = 0; j < 4; ++j) gg[j] = *(const f32x4*)(g + 4 * lane + 256 * j);
    const int rowbase = vcu * rpb + wave * rpw;
    f32x4 xa[3][4], xb[3][4];
#pragma unroll
    for (int r = 0; r < 3; ++r) { const f32x4* xr = (const f32x4*)xrow_ptr(XL, XC, rowbase + (r < rpw ? r : rpw - 1)) + lane;
#pragma unroll
        for (int j = 0; j < 4; ++j) xa[r][j] = xr[64 * j]; }
#pragma unroll
    for (int bt = 0; bt < 3; ++bt) {
        const int i0 = 3 * bt;
        asm volatile("" ::: "memory");
        f32x4 (&y)[3][4] = (bt & 1) ? xb : xa; f32x4 (&xn)[3][4] = (bt & 1) ? xa : xb;
        f32x4 s0v[3][4], s1v[3][4];
#pragma unroll
        for (int r = 0; r < 3; ++r) { const int ii = (i0 + r < rpw) ? i0 + r : rpw - 1; const float* mv = modv + row_bi(rowbase + ii) * 6144 + 3072;
#pragma unroll
            for (int j = 0; j < 4; ++j) { const int c = 4 * lane + 256 * j; s0v[r][j] = *(const f32x4*)(mv + c); s1v[r][j] = *(const f32x4*)(mv + 1024 + c); } }
        if (bt + 1 < 3) {
#pragma unroll
            for (int r = 0; r < 3; ++r) { const int ii = (i0 + 3 + r < rpw) ? i0 + 3 + r : rpw - 1; const f32x4* xr = (const f32x4*)xrow_ptr(XL, XC, rowbase + ii) + lane;
#pragma unroll
                for (int j = 0; j < 4; ++j) xn[r][j] = xr[64 * j]; } }
#pragma unroll
        for (int r = 0; r < 3; ++r) {
            const int ii = (i0 + r < rpw) ? i0 + r : rpw - 1; const int row = rowbase + ii;
            float ss = 0.f;
#pragma unroll
            for (int j = 0; j < 4; ++j) ss += (y[r][j].x * y[r][j].x + y[r][j].y * y[r][j].y) + (y[r][j].z * y[r][j].z + y[r][j].w * y[r][j].w);
            const float rs = __builtin_amdgcn_rsqf(wave_sum(ss) * (1.0f / D) + EPSF);
#pragma unroll
            for (int j = 0; j < 4; ++j) { const int c = 4 * lane + 256 * j;
                y[r][j] = (y[r][j] * rs) * gg[j] * (1.0f + s1v[r][j]) + s0v[r][j];
                u32x2 w; w.x = cvtpk(y[r][j].x, y[r][j].y); w.y = cvtpk(y[r][j].z, y[r][j].w); *(u32x2*)(H + (size_t)row * D + c) = w; }
        }
        float p[3][16];
#pragma unroll
        for (int e = 0; e < 16; ++e) {
#pragma unroll
            for (int r = 0; r < 3; ++r) p[r][e] = 0.f;
#pragma unroll
            for (int j = 0; j < 4; ++j) { const f32x4 w = *(const LAS f32x4*)(RW + e * 1024 + 4 * lane + 256 * j);
#pragma unroll
                for (int r = 0; r < 3; ++r) p[r][e] += (y[r][j].x * w.x + y[r][j].y * w.y) + (y[r][j].z * w.z + y[r][j].w * w.w); }
#pragma unroll
            for (int r = 0; r < 3; ++r) asm volatile("" : "+v"(p[r][e])); }
#pragma unroll
        for (int r = 0; r < 3; ++r) {
            float q8[8], lg[4];
#pragma unroll
            for (int j = 0; j < 8; ++j) q8[j] = swap32_add(p[r][j], p[r][j + 8]);
#pragma unroll
            for (int j = 0; j < 4; ++j) lg[j] = row_sum(swap16_add(q8[j], q8[j + 4]));
            float sc[4], sel[4];
#pragma unroll
            for (int j = 0; j < 4; ++j) { sc[j] = 1.0f / (1.0f + __expf(-lg[j])); sel[j] = sc[j] + rb[j]; }
            int i1 = 0, i2 = 0; float m1 = -1e30f, m2 = -1e30f, w1 = 0.f, w2 = 0.f;
#pragma unroll
            for (int j = 0; j < 4; ++j) { const float t = sel[j];
                if (t > m1) { m2 = m1; i2 = i1; w2 = w1; m1 = t; i1 = j; w1 = sc[j]; } else if (t > m2) { m2 = t; i2 = j; w2 = sc[j]; } }
            const float gs = m1 + m2;
            const float g0 = readlane_f(gs, 0), g1 = readlane_f(gs, 16), g2 = readlane_f(gs, 32), g3 = readlane_f(gs, 48);
            int bg = 0; float bgs = g0; if (g1 > bgs) { bgs = g1; bg = 1; } if (g2 > bgs) { bgs = g2; bg = 2; } if (g3 > bgs) { bgs = g3; bg = 3; }
            bg = __builtin_amdgcn_readfirstlane(bg);
            const int e0 = 4 * bg + __builtin_amdgcn_readlane(i1, 16 * bg), e1 = 4 * bg + __builtin_amdgcn_readlane(i2, 16 * bg);
            const float w0 = readlane_f(w1, 16 * bg), w1s = readlane_f(w2, 16 * bg);
            const float wn = 1.0f / (w0 + w1s);
            if (lane == 0 && i0 + r < rpw) { const int rl = wave * rpw + i0 + r;
                const int p0 = __hip_atomic_fetch_add(&lcnt[e0], 1, __ATOMIC_RELAXED, __HIP_MEMORY_SCOPE_WORKGROUP), p1 = __hip_atomic_fetch_add(&lcnt[e1], 1, __ATOMIC_RELAXED, __HIP_MEMORY_SCOPE_WORKGROUP);
                rinfo[rl * 6 + 0] = e0; rinfo[rl * 6 + 1] = p0; rinfo[rl * 6 + 2] = e1; rinfo[rl * 6 + 3] = p1;
                rinfo[rl * 6 + 4] = __builtin_bit_cast(int, w0 * wn); rinfo[rl * 6 + 5] = __builtin_bit_cast(int, w1s * wn); }
        }
    }
    __syncthreads();
    if (tid < 16) lcnt[16 + tid] = (int)__hip_atomic_fetch_add(cnt + 64 * tid, (unsigned)lcnt[tid], RLX_AGENT);
    __syncthreads();
    if (tid < rpb) { const int row = vcu * rpb + tid; const int e0 = rinfo[tid * 6 + 0], e1 = rinfo[tid * 6 + 2];
        const int p0 = lcnt[16 + e0] + rinfo[tid * 6 + 1], p1 = lcnt[16 + e1] + rinfo[tid * 6 + 3];
        list[(size_t)e0 * TALL + p0] = row; list[(size_t)e1 * TALL + p1] = row;
        toki[row * 4 + 0] = e0; toki[row * 4 + 1] = p0; toki[row * 4 + 2] = e1; toki[row * 4 + 3] = p1;
        tokw[row * 2 + 0] = __builtin_bit_cast(float, rinfo[tid * 6 + 4]); tokw[row * 2 + 1] = __builtin_bit_cast(float, rinfo[tid * 6 + 5]); }
    __syncthreads();
}

__device__ __forceinline__ int build_moe_table(const unsigned* cnt, LAS int* tab, int tid) {
    if (tid < 16) tab[RT_MAX + 1 + tid] = (int)__hip_atomic_load(cnt + 64 * tid, RLX_AGENT);
    __syncthreads();
    if (tid == 0) { int rt = 0;
        for (int e = 0; e < 16; ++e) { const int c = tab[RT_MAX + 1 + e]; const int nt = (c + 255) >> 8;
            for (int m = 0; m < nt; ++m) { if (rt < RT_MAX) tab[rt] = e | (m << 8); ++rt; } }
        tab[RT_MAX] = rt < RT_MAX ? rt : RT_MAX; }
    __syncthreads();
    return tab[RT_MAX];
}

struct CbTok { int e0, p0, e1, p1; float w0, w1; };
struct CbRow { f32x4 x[4], g2[4], s0[4], s1[4]; u32x2 ya[4], yb[4]; };
__device__ __forceinline__ void cb_tok(CbTok& t, const int* toki, const float* tokw, int row) {
    const int4 q = *(const int4*)(toki + row * 4); const float2 w = *(const float2*)(tokw + row * 2); t.e0 = q.x; t.p0 = q.y; t.e1 = q.z; t.p1 = q.w; t.w0 = w.x; t.w1 = w.y;
}
template <bool FINAL>
__device__ __forceinline__ void cb_issue(CbRow& r, const CbTok& t, int mybase, float* XL, float* XC, const float* modv, const float* modv_next, const bf16* YB, int row, int lane) {
    const int s0 = __shfl(mybase, t.e0) + t.p0, s1 = __shfl(mybase, t.e1) + t.p1;
    const float* xp = xrow_ptr(XL, XC, row); const int bi = row_bi(row); const float* g2 = modv + bi * 6144 + 5120; const float* mv = modv_next + bi * 6144;
#pragma unroll
    for (int j = 0; j < 4; ++j) { const int c = 4 * lane + 256 * j;
        r.ya[j] = *(const u32x2*)(YB + (size_t)s0 * D + c); r.yb[j] = *(const u32x2*)(YB + (size_t)s1 * D + c);
        r.x[j] = *(const f32x4*)(xp + c); r.g2[j] = *(const f32x4*)(g2 + c);
        if constexpr (!FINAL) { r.s0[j] = *(const f32x4*)(mv + c); r.s1[j] = *(const f32x4*)(mv + 1024 + c); } }
}
template <bool FINAL>
__device__ __forceinline__ void cb_finish(const CbRow& r, const CbTok& t, const f32x4 (&gn)[4], float* xp, bf16* hrow, int lane) {
    f32x4 v[4]; float ss = 0.f;
#pragma unroll
    for (int j = 0; j < 4; ++j) { const u32x2 a = r.ya[j], b = r.yb[j]; const float w0 = t.w0, w1 = t.w1;
        f32x4 y; y.x = w0 * bflo(a.x) + w1 * bflo(b.x); y.y = w0 * bfhi(a.x) + w1 * bfhi(b.x); y.z = w0 * bflo(a.y) + w1 * bflo(b.y); y.w = w0 * bfhi(a.y) + w1 * bfhi(b.y);
        v[j] = r.x[j] + r.g2[j] * y;
        ss += (v[j].x * v[j].x + v[j].y * v[j].y) + (v[j].z * v[j].z + v[j].w * v[j].w); }
    const float rs = __builtin_amdgcn_rsqf(wave_sum(ss) * (1.0f / D) + EPSF);
#pragma unroll
    for (int j = 0; j < 4; ++j) { const int c = 4 * lane + 256 * j;
        if constexpr (FINAL) *(f32x4*)(xp + c) = (v[j] * rs) * gn[j];
        else { *(f32x4*)(xp + c) = v[j];
            const f32x4 y = (v[j] * rs) * gn[j] * (1.0f + r.s1[j]) + r.s0[j];
            u32x2 w; w.x = pk2(y.x, y.y); w.y = pk2(y.z, y.w); *(u32x2*)(hrow + c) = w; } }
}
template <bool FINAL>
__device__ __forceinline__ void phase_combine(float* XL, float* XC, const float* modv  , const bf16* YB, const unsigned* cnt, const int* toki, const float* tokw,
                                              const float* gnext, const float* modv_next, bf16* H, int nrows, int lane, int wave, int vcu, int G) {
    int tiles = 0; if (lane < 16) tiles = ((int)__hip_atomic_load(cnt + 64 * lane, RLX_AGENT) + 255) >> 8;
    int incl = tiles;
#pragma unroll
    for (int o = 1; o < 16; o <<= 1) { const int t = __shfl_up(incl, o); if (lane >= o) incl += t; }
    const int mybase = (incl - tiles) * 256;
    f32x4 gn[4];
#pragma unroll
    for (int j = 0; j < 4; ++j) gn[j] = *(const f32x4*)(gnext + 4 * lane + 256 * j);
    CbTok ta, tb, tc; CbRow ra, rb;
    cb_tok(ta, toki, tokw, thin_row(vcu, wave, 0)); cb_tok(tb, toki, tokw, thin_row(vcu, wave, 1));
    cb_issue<FINAL>(ra, ta, mybase, XL, XC, modv, modv_next, YB, thin_row(vcu, wave, 0), lane);
#pragma unroll
    for (int i = 0; i < TROWS; ++i) {
        const int row = thin_row(vcu, wave, i), row1 = thin_row(vcu, wave, i + 1), row2 = thin_row(vcu, wave, i + 2);
        CbTok& tcur = (i % 3 == 0) ? ta : (i % 3 == 1) ? tb : tc; CbTok& tnx = (i % 3 == 0) ? tb : (i % 3 == 1) ? tc : ta; CbTok& tn2 = (i % 3 == 0) ? tc : (i % 3 == 1) ? ta : tb;
        if (i + 2 < TROWS) cb_tok(tn2, toki, tokw, row2 < nrows ? row2 : row);
        if (i + 1 < TROWS) cb_issue<FINAL>((i & 1) ? ra : rb, tnx, mybase, XL, XC, modv, modv_next, YB, row1 < nrows ? row1 : row, lane);
        if (row < nrows) cb_finish<FINAL>((i & 1) ? rb : ra, tcur, gn, xrow_ptr(XL, XC, row), H + (size_t)row * D, lane);
    }
}

struct RoRow { u32x2 a[4], b[4], gt[4]; };
__device__ __forceinline__ void ro_issue(RoRow& r, const bf16* OF, const bf16* OB, const bf16* QKV2, int row, int lane) {
#pragma unroll
    for (int j = 0; j < 4; ++j) { const int c = 4 * lane + 256 * j;
        r.a[j] = *(const u32x2*)(OF + (size_t)row * D + c); r.b[j] = *(const u32x2*)(OB + (size_t)row * D + c); r.gt[j] = *(const u32x2*)(QKV2 + (size_t)row * NGLA + 2048 + c); }
}
__device__ __forceinline__ void ro_finish(const RoRow& r, const f32x4 gg, bf16* orow, int lane) {
#pragma unroll
    for (int j = 0; j < 4; ++j) { const u32x2 a = r.a[j], b = r.b[j], gt = r.gt[j];
        f32x4 o; o.x = bflo(a.x) + bflo(b.x); o.y = bfhi(a.x) + bfhi(b.x); o.z = bflo(a.y) + bflo(b.y); o.w = bfhi(a.y) + bfhi(b.y);
        const float ss = wave_sum((o.x * o.x + o.y * o.y) + (o.z * o.z + o.w * o.w));
        const float rs = __builtin_amdgcn_rsqf(ss * (1.0f / 256.0f) + EPSF);
        f32x4 gv; gv.x = silu_f(bflo(gt.x)); gv.y = silu_f(bfhi(gt.x)); gv.z = silu_f(bflo(gt.y)); gv.w = silu_f(bfhi(gt.y));
        const f32x4 y = (o * rs) * gg * gv;
        u32x2 w; w.x = pk2(y.x, y.y); w.y = pk2(y.z, y.w); *(u32x2*)(orow + 4 * lane + 256 * j) = w; }
}
__device__ __forceinline__ void phase_readout(const bf16* OF, const bf16* OB, const bf16* QKV2, const float* ng, bf16* AOUT, int nrows, int lane, int wave, int vcu, int G) {
    const f32x4 gg = *(const f32x4*)(ng + 4 * lane);
    RoRow ra, rb, rc;
    ro_issue(ra, OF, OB, QKV2, thin_row(vcu, wave, 0), lane); ro_issue(rb, OF, OB, QKV2, thin_row(vcu, wave, 1), lane);
#pragma unroll
    for (int i = 0; i < TROWS; ++i) {
        const int row = thin_row(vcu, wave, i), row2 = thin_row(vcu, wave, i + 2);
        RoRow& cur = (i % 3 == 0) ? ra : (i % 3 == 1) ? rb : rc; RoRow& n2 = (i % 3 == 0) ? rc : (i % 3 == 1) ? ra : rb;
        if (i + 2 < TROWS) ro_issue(n2, OF, OB, QKV2, row2 < nrows ? row2 : row, lane);
        if (row < nrows) ro_finish(cur, gg, AOUT + (size_t)row * D, lane);
    }
}

__device__ __forceinline__ int na_r0(int r) { int v = r - 4; return v < 0 ? 0 : (v > 24 ? 24 : v); }
template <int NMAPS, int DV, bool NA>
__device__ __forceinline__ void attn_unit(LAS unsigned char* lds, int tid, int lane, int wave,
                                          const bf16* QKV, int qcol, int qrow0, int kcol, int krow_lat, int krow_ctx, const bf16* VT, int klo, int khi,
                                          int r_wave, int xq0, const LAS float* biasT,
                                          bf16* AOUT, int ocol, float lam, const float* subg, float outscale) {
    constexpr int KB = 9216;
    constexpr int BUFSZ = NMAPS * KB + DV * 144;
    constexpr int NVB = DV / 16, NVR = DV / 64;
    const int fr = lane & 15, g = lane >> 4;
    bf16x8 qf[NMAPS][2];
    { const bf16* qp = QKV + (size_t)(qrow0 + wave * 16 + fr) * NATT + qcol + 8 * g;
#pragma unroll
      for (int m = 0; m < NMAPS; ++m)
#pragma unroll
          for (int s = 0; s < 2; ++s) qf[m][s] = *(const bf16x8*)(qp + m * 64 + 32 * s); }
    f32x4 O[NMAPS][NVB]; float mrun[NMAPS]; float lrun[NMAPS];
#pragma unroll
    for (int m = 0; m < NMAPS; ++m) { mrun[m] = -1e30f; lrun[m] = 0.f;
#pragma unroll
        for (int vb = 0; vb < NVB; ++vb) O[m][vb] = (f32x4){0.f, 0.f, 0.f, 0.f}; }
    const int ntiles = 4 + (khi - klo);
    u32x4 kreg[NMAPS], vreg[NVR];
    const int lkey = tid >> 3, lch = tid & 7;
#define AT_LOAD(i) do { const int _i = (i); const int _rowg = (_i < 4 ? krow_ctx + 64 * _i : krow_lat + 64 * (klo + _i - 4)) + lkey; const int _tok0 = (_i < 4 ? SEQ + 64 * _i : 64 * (klo + _i - 4)); \
        _Pragma("unroll") for (int m = 0; m < NMAPS; ++m) kreg[m] = *(const u32x4*)(QKV + (size_t)_rowg * NATT + kcol + m * 64 + lch * 8); \
        _Pragma("unroll") for (int j = 0; j < NVR; ++j) { const int idx = tid + 512 * j; vreg[j] = *(const u32x4*)(VT + (size_t)(idx >> 3) * NKEY + _tok0 + (idx & 7) * 8); } } while (0)
#define AT_STORE(b) do { LAS unsigned char* _p = lds + (b) * BUFSZ; \
        _Pragma("unroll") for (int m = 0; m < NMAPS; ++m) *(LAS u32x4*)(_p + m * KB + lkey * 144 + lch * 16) = kreg[m]; \
        _Pragma("unroll") for (int j = 0; j < NVR; ++j) { const int idx = tid + 512 * j; *(LAS u32x4*)(_p + NMAPS * KB + (idx >> 3) * 144 + (idx & 7) * 16) = vreg[j]; } } while (0)
    AT_LOAD(0); AT_STORE(0); __syncthreads();
    const int kbase0 = (8 * (fr >> 2) + (fr & 3)) * 144 + 16 * g;
    const int vbase = fr * 144 + 16 * g;
    int r0w = 0, xq = 0, tmask = 3, c0w = 0; float pen[4][4];
    if constexpr (NA) { r0w = na_r0(r_wave); xq = xq0 + fr; int cs = xq - 8; cs = cs < 0 ? 0 : (cs > 48 ? 48 : cs);
        c0w = xq0 - 8; c0w = c0w < 0 ? 0 : (c0w > 32 ? 32 : c0w);
        tmask = 1;
#pragma unroll
        for (int kb = 0; kb < 4; ++kb)
#pragma unroll
            for (int ii = 0; ii < 4; ++ii) { const int y = c0w + 32 * (kb >> 1) + 8 * g + 4 * (kb & 1) + ii; pen[kb][ii] = (y >= cs && y < cs + 16) ? 0.f : -1e30f; } }
    for (int i = 0; i < ntiles; ++i) {
        if (i + 1 < ntiles) AT_LOAD(i + 1);
        const LAS unsigned char* buf = lds + (i & 1) * BUFSZ;
        bool active = true; int kr = 0; bool local = false;
        if constexpr (NA) { if (i >= 4) { local = true; kr = klo + i - 4; active = (kr >= r0w) && (kr < r0w + 8); } }
        if (active) {
            const int tm = local ? tmask : 3;
            const int koffw = local ? c0w * 144 : 0, voffw = local ? c0w * 2 : 0;
            bf16x8 kf[NMAPS][4][2];
#pragma unroll
            for (int m = 0; m < NMAPS; ++m)
#pragma unroll
                for (int kb = 0; kb < 4; ++kb)
#pragma unroll
                    for (int s = 0; s < 2; ++s) kf[m][kb][s] = *(const LAS bf16x8*)(buf + m * KB + kbase0 + koffw + (kb & 1) * (4 * 144) + (kb >> 1) * (32 * 144) + s * 64);
            __builtin_amdgcn_sched_barrier(0);
            f32x4 S[NMAPS][4];
#pragma unroll
            for (int m = 0; m < NMAPS; ++m)
#pragma unroll
                for (int kb = 0; kb < 4; ++kb) { S[m][kb] = (f32x4){0.f, 0.f, 0.f, 0.f};
                    if (!NA || (tm >> (kb >> 1)) & 1) {
#pragma unroll
                        for (int s = 0; s < 2; ++s) S[m][kb] = __builtin_amdgcn_mfma_f32_16x16x32_bf16(kf[m][kb][s], qf[m][s], S[m][kb], 0, 0, 0); } }
            bf16x8 vf0[4][2];
#pragma unroll
            for (int vb = 0; vb < 4; ++vb)
#pragma unroll
                for (int t = 0; t < 2; ++t) vf0[vb][t] = *(const LAS bf16x8*)(buf + NMAPS * KB + vbase + voffw + vb * (16 * 144) + t * 64);
            __builtin_amdgcn_sched_barrier(0);
            bf16x8 pf[NMAPS][2];
#pragma unroll
            for (int m = 0; m < NMAPS; ++m) {
                if constexpr (NA) { if (local) {
                        const LAS float* bp = biasT + (kr - r_wave + 7) * 31 + (c0w + 8 * g - xq + 15);
#pragma unroll
                        for (int kb = 0; kb < 4; ++kb)
#pragma unroll
                            for (int ii = 0; ii < 4; ++ii) { const float t = (tm >> (kb >> 1)) & 1 ? (S[m][kb][ii] + pen[kb][ii]) + bp[32 * (kb >> 1) + 4 * (kb & 1) + ii] : -1e30f; S[m][kb][ii] = t; } } }
                float mx = fmaxf(fmaxf(S[m][0][0], S[m][0][1]), fmaxf(S[m][0][2], S[m][0][3]));
#pragma unroll
                for (int kb = 1; kb < 4; ++kb) mx = fmaxf(fmaxf(mx, S[m][kb][0]), fmaxf(fmaxf(S[m][kb][1], S[m][kb][2]), S[m][kb][3]));
                mx = swap32_max(swap16_max(mx));
                if (__any(mx > mrun[m] + 8.0f)) {
                    const float mnew = fmaxf(mrun[m], mx), alpha = fexp2(mrun[m] - mnew); mrun[m] = mnew; lrun[m] = lrun[m] * alpha;
#pragma unroll
                    for (int vb = 0; vb < NVB; ++vb) O[m][vb] = O[m][vb] * alpha;
                }
                const float mm = mrun[m];
                unsigned pw[8]; float l0 = 0.f, l1 = 0.f;
#pragma unroll
                for (int kb = 0; kb < 4; ++kb) { const float a0 = fexp2(S[m][kb][0] - mm), a1 = fexp2(S[m][kb][1] - mm), a2 = fexp2(S[m][kb][2] - mm), a3 = fexp2(S[m][kb][3] - mm);
                    l0 += a0 + a1; l1 += a2 + a3;
                    pw[2 * kb] = cvtpk(a0, a1); pw[2 * kb + 1] = cvtpk(a2, a3); }
                lrun[m] += l0 + l1;
                pf[m][0] = __builtin_bit_cast(bf16x8, (u32x4){pw[0], pw[1], pw[2], pw[3]});
                pf[m][1] = __builtin_bit_cast(bf16x8, (u32x4){pw[4], pw[5], pw[6], pw[7]});
            }
            __builtin_amdgcn_sched_barrier(0);
            if constexpr (NVB == 8) {
                bf16x8 vf1[4][2];
#pragma unroll
                for (int vb = 0; vb < 4; ++vb)
#pragma unroll
                    for (int t = 0; t < 2; ++t) vf1[vb][t] = *(const LAS bf16x8*)(buf + NMAPS * KB + vbase + (4 + vb) * (16 * 144) + t * 64);
                __builtin_amdgcn_sched_barrier(0);
#pragma unroll
                for (int vb = 0; vb < 4; ++vb)
#pragma unroll
                    for (int t = 0; t < 2; ++t)
#pragma unroll
                        for (int m = 0; m < NMAPS; ++m) O[m][vb] = __builtin_amdgcn_mfma_f32_16x16x32_bf16(vf0[vb][t], pf[m][t], O[m][vb], 0, 0, 0);
                __builtin_amdgcn_sched_barrier(0);
#pragma unroll
                for (int vb = 0; vb < 4; ++vb)
#pragma unroll
                    for (int t = 0; t < 2; ++t)
#pragma unroll
                        for (int m = 0; m < NMAPS; ++m) O[m][4 + vb] = __builtin_amdgcn_mfma_f32_16x16x32_bf16(vf1[vb][t], pf[m][t], O[m][4 + vb], 0, 0, 0);
            } else {
#pragma unroll
                for (int vb = 0; vb < 4; ++vb)
#pragma unroll
                    for (int t = 0; t < 2; ++t) { if (!NA || (tm >> t) & 1) {
#pragma unroll
                            for (int m = 0; m < NMAPS; ++m) O[m][vb] = __builtin_amdgcn_mfma_f32_16x16x32_bf16(vf0[vb][t], pf[m][t], O[m][vb], 0, 0, 0); } }
            }
            __builtin_amdgcn_sched_barrier(0);
        }
        if (i + 1 < ntiles) AT_STORE((i + 1) & 1);
        __syncthreads();
    }
#undef AT_LOAD
#undef AT_STORE
    float inv[NMAPS];
#pragma unroll
    for (int m = 0; m < NMAPS; ++m) { float l = lrun[m]; l = swap16_add(l, l); l = swap32_add(l, l); inv[m] = 1.0f / l; }
    const int orow = qrow0 + wave * 16 + fr;
    if constexpr (NMAPS == 2) {
        float ss = 0.f; const float i1 = inv[0], i2 = lam * inv[1];
#pragma unroll
        for (int vb = 0; vb < NVB; ++vb) { O[0][vb] = O[0][vb] * i1 - O[1][vb] * i2; const f32x4 o = O[0][vb]; ss += (o.x * o.x + o.y * o.y) + (o.z * o.z + o.w * o.w); }
        ss = swap16_add(ss, ss); ss = swap32_add(ss, ss);
        const float rs = __builtin_amdgcn_rsqf(ss * (1.0f / DV) + EPSF) * outscale;
#pragma unroll
        for (int vb = 0; vb < NVB; ++vb) { const f32x4 gg = *(const f32x4*)(subg + 16 * vb + 4 * g); const f32x4 y = O[0][vb] * rs * gg;
            u32x2 w; w.x = cvtpk(y.x, y.y); w.y = cvtpk(y.z, y.w); *(u32x2*)(AOUT + (size_t)orow * D + ocol + 16 * vb + 4 * g) = w; }
    } else {
#pragma unroll
        for (int vb = 0; vb < NVB; ++vb) { const f32x4 y = O[0][vb] * inv[0];
            u32x2 w; w.x = cvtpk(y.x, y.y); w.y = cvtpk(y.z, y.w); *(u32x2*)(AOUT + (size_t)orow * D + ocol + 16 * vb + 4 * g) = w; }
    }
}


typedef float f32x16 __attribute__((ext_vector_type(16)));
__device__ __forceinline__ void diff_unit32(LAS unsigned char* lds, int tid, int lane, int wave,
                                            const bf16* QKV, int qcol, int qrow0, int kcol, int krow_lat, int krow_ctx, const bf16* VT, int khi,
                                            bf16* AOUT, int ocol, float lam, const float* subg, float outscale) {
    constexpr int KB = 9216, VOFF = 2 * KB, BUFSZ = 2 * KB + 128 * 144;
    const int r = lane & 31, hf = lane >> 5, map = wave >> 2, wq = wave & 3;
    const int swz = ((r >> 4) & 1) << 2;
    bf16x8 qf[4];
    { const bf16* qp = QKV + (size_t)(qrow0 + 32 * wq + r) * NATT + qcol + map * 64 + 8 * hf;
#pragma unroll
      for (int ks = 0; ks < 4; ++ks) qf[ks] = *(const bf16x8*)(qp + 16 * ks); }
    f32x16 O[4];
#pragma unroll
    for (int blk = 0; blk < 4; ++blk)
#pragma unroll
        for (int i = 0; i < 16; ++i) O[blk][i] = 0.f;
    float negm = 0.f, lrun = 0.f;
    const int ntiles = 4 + khi;
    u32x4 kreg[2], vreg[2];
    const int lkey = tid >> 3, lch = tid & 7;
    const int kst = lkey * 144 + ((lch ^ (((lkey >> 4) & 1) << 2)) * 16);
#define D32_LOAD(i) do { const int _i = (i); const int _rowg = (_i < 4 ? krow_ctx + 64 * _i : krow_lat + 64 * (_i - 4)) + lkey; const int _tok0 = (_i < 4 ? SEQ + 64 * _i : 64 * (_i - 4)); \
        _Pragma("unroll") for (int m = 0; m < 2; ++m) kreg[m] = *(const u32x4*)(QKV + (size_t)_rowg * NATT + kcol + m * 64 + lch * 8); \
        _Pragma("unroll") for (int j = 0; j < 2; ++j) { const int idx = tid + 512 * j; vreg[j] = *(const u32x4*)(VT + (size_t)(idx >> 3) * NKEY + _tok0 + (idx & 7) * 8); } } while (0)
#define D32_STORE(b) do { LAS unsigned char* _p = lds + (b) * BUFSZ; \
        _Pragma("unroll") for (int m = 0; m < 2; ++m) *(LAS u32x4*)(_p + m * KB + kst) = kreg[m]; \
        _Pragma("unroll") for (int j = 0; j < 2; ++j) { const int idx = tid + 512 * j, vr = idx >> 3; *(LAS u32x4*)(_p + VOFF + vr * 144 + (((idx & 7) ^ (((vr >> 4) & 1) << 2)) * 16)) = vreg[j]; } } while (0)
    D32_LOAD(0); D32_STORE(0); D32_STORE(2); __syncthreads();
    const int krow = (r & 0x13) | ((r & 4) << 1) | ((r & 8) >> 1);
    const int kbase = map * KB + krow * 144, vbase = VOFF + r * 144;
    bf16x8 pfp[2][2];
#pragma unroll
    for (int kb = 0; kb < 2; ++kb)
#pragma unroll
        for (int sx = 0; sx < 2; ++sx) pfp[kb][sx] = (bf16x8){0, 0, 0, 0, 0, 0, 0, 0};
    int slot = 0;
    for (int i = 0; i < ntiles; ++i) {
        if (i + 1 < ntiles) D32_LOAD(i + 1);
        const int slotn = slot == 2 ? 0 : slot + 1, slotp = slot == 0 ? 2 : slot - 1;
        const LAS unsigned char* buf = lds + slot * BUFSZ; const LAS unsigned char* bufp = lds + slotp * BUFSZ;
        f32x16 S[2];
#pragma unroll
        for (int kb = 0; kb < 2; ++kb) {
#pragma unroll
            for (int ii = 0; ii < 16; ++ii) S[kb][ii] = negm;
#pragma unroll
            for (int ks = 0; ks < 4; ++ks) { const bf16x8 kf = *(const LAS bf16x8*)(buf + kbase + kb * (32 * 144) + (((2 * ks + hf) ^ swz) * 16));
                S[kb] = __builtin_amdgcn_mfma_f32_32x32x16_bf16(kf, qf[ks], S[kb], 0, 0, 0); } }
        __builtin_amdgcn_sched_barrier(0);
        float mx = -1e30f;
#pragma unroll
        for (int kb = 0; kb < 2; ++kb)
#pragma unroll
            for (int ii = 0; ii < 16; ii += 4) mx = fmaxf(fmaxf(mx, S[kb][ii]), fmaxf(fmaxf(S[kb][ii + 1], S[kb][ii + 2]), S[kb][ii + 3]));
        mx = swap32_max(mx);
        const bool resc = (i == 0) || __any(mx > 8.0f);
        float alpha = 1.0f;
        if (resc) { const float dlt = (i == 0) ? mx : fmaxf(mx, 0.f); alpha = fexp2(-dlt); negm -= dlt; lrun *= alpha;
#pragma unroll
            for (int kb = 0; kb < 2; ++kb)
#pragma unroll
                for (int ii = 0; ii < 16; ++ii) S[kb][ii] -= dlt; }
        __builtin_amdgcn_sched_barrier(0);
        bf16x8 pf[2][2]; float l0 = 0.f, l1 = 0.f;
#pragma unroll
        for (int kb = 0; kb < 2; ++kb)
#pragma unroll
            for (int sx = 0; sx < 2; ++sx) { unsigned pw[4];
#pragma unroll
                for (int j = 0; j < 4; ++j) { const float a0 = fexp2(S[kb][8 * sx + 2 * j]), a1 = fexp2(S[kb][8 * sx + 2 * j + 1]); l0 += a0; l1 += a1; pw[j] = cvtpk(a0, a1); }
                pf[kb][sx] = __builtin_bit_cast(bf16x8, (u32x4){pw[0], pw[1], pw[2], pw[3]}); }
        lrun += l0 + l1;
#pragma unroll
        for (int blk = 0; blk < 4; ++blk)
#pragma unroll
            for (int kb = 0; kb < 2; ++kb)
#pragma unroll
                for (int sx = 0; sx < 2; ++sx) { const bf16x8 vf = *(const LAS bf16x8*)(bufp + vbase + blk * (32 * 144) + (((4 * kb + 2 * sx + hf) ^ swz) * 16));
                    O[blk] = __builtin_amdgcn_mfma_f32_32x32x16_bf16(vf, pfp[kb][sx], O[blk], 0, 0, 0); }
#pragma unroll
        for (int k = 0; k < 16; ++k) { __builtin_amdgcn_sched_group_barrier(0x100, 1, 0); __builtin_amdgcn_sched_group_barrier(0x008, 1, 0); __builtin_amdgcn_sched_group_barrier(0x400, 2, 0); __builtin_amdgcn_sched_group_barrier(0x002, 4, 0); }
        __builtin_amdgcn_sched_barrier(0);
        if (resc) {
#pragma unroll
            for (int blk = 0; blk < 4; ++blk) O[blk] = O[blk] * alpha; }
#pragma unroll
        for (int kb = 0; kb < 2; ++kb)
#pragma unroll
            for (int sx = 0; sx < 2; ++sx) pfp[kb][sx] = pf[kb][sx];
        if (i + 1 < ntiles) D32_STORE(slotn);
        slot = slotn;
        __syncthreads();
    }
    { const LAS unsigned char* bufp = lds + (slot == 0 ? 2 : slot - 1) * BUFSZ;
#pragma unroll
      for (int blk = 0; blk < 4; ++blk)
#pragma unroll
          for (int kb = 0; kb < 2; ++kb)
#pragma unroll
              for (int sx = 0; sx < 2; ++sx) { const bf16x8 vf = *(const LAS bf16x8*)(bufp + vbase + blk * (32 * 144) + (((4 * kb + 2 * sx + hf) ^ swz) * 16));
                  O[blk] = __builtin_amdgcn_mfma_f32_32x32x16_bf16(vf, pfp[kb][sx], O[blk], 0, 0, 0); } }
    __syncthreads();
#undef D32_LOAD
#undef D32_STORE
    float l = lrun; l = swap32_add(l, l); const float inv = 1.0f / l;
    LAS float* X = (LAS float*)lds + (size_t)wq * 4096 + lane;
    if (map == 1) {
#pragma unroll
        for (int blk = 0; blk < 4; ++blk)
#pragma unroll
            for (int i = 0; i < 16; ++i) X[(blk * 16 + i) * 64] = O[blk][i] * inv;
    }
    __syncthreads();
    if (map == 0) {
        float ss = 0.f;
#pragma unroll
        for (int blk = 0; blk < 4; ++blk)
#pragma unroll
            for (int i = 0; i < 16; ++i) { const float o = O[blk][i] * inv - lam * X[(blk * 16 + i) * 64]; O[blk][i] = o; ss += o * o; }
        ss = swap32_add(ss, ss);
        const float rs = __builtin_amdgcn_rsqf(ss * (1.0f / 128.0f) + EPSF) * outscale;
        bf16* op = AOUT + (size_t)(qrow0 + 32 * wq + r) * D + ocol + 4 * hf;
#pragma unroll
        for (int blk = 0; blk < 4; ++blk)
#pragma unroll
            for (int g4 = 0; g4 < 4; ++g4) { const int dv0 = 32 * blk + 8 * g4; const f32x4 gg = *(const f32x4*)(subg + dv0 + 4 * hf);
                u32x2 w; w.x = cvtpk(O[blk][4 * g4] * rs * gg.x, O[blk][4 * g4 + 1] * rs * gg.y); w.y = cvtpk(O[blk][4 * g4 + 2] * rs * gg.z, O[blk][4 * g4 + 3] * rs * gg.w);
                *(u32x2*)(op + dv0) = w; }
    }
    __syncthreads();
}

__device__ __forceinline__ void phase_attention(const bf16* QKV, const bf16* VAT, const bf16* VBT, bf16* AOUT, const float* lamp  , float lam_init, const float* subg, const float* nab  ,
                                                unsigned* naq, const ConvPtrs& CP, int clo, int chi, LAS unsigned char* lds, int tid, int lane, int wave) {
    LAS float* biasT = (LAS float*)(lds + LX_BIAS) + 64;
    constexpr int NATT_U = 576 + 1152;
    const int ncu = (chi - clo + CV_UNIT - 1) / CV_UNIT, nq = NATT_U + ncu;
    int mine = 0; if (tid == 0) mine = (int)__hip_atomic_fetch_add(naq, 1u, RLX_AGENT);
    for (;;) {
        __syncthreads();
        if (tid == 0) *(LAS int*)(lds + LX_MISC + 64) = mine;
        __syncthreads();
        const int q = *(LAS int*)(lds + LX_MISC + 64);
        if (q >= nq) break;
        if (tid == 0) mine = (int)__hip_atomic_fetch_add(naq, 1u, RLX_AGENT);
        const int ai = (int)(((long)q * NATT_U) / nq); const bool isatt = (int)(((long)(q + 1) * NATT_U) / nq) > ai;
        if (!isatt) { conv_unit(CP, clo + (q - ai) * CV_UNIT, chi, lds, lane, wave); continue; }
        if (ai < 512 || (ai >= 1536 && ai < 1600)) {
            int bh, qrow0, khi;
            if (ai < 512) { bh = ai >> 4; const int qt = ai & 15; qrow0 = (bh >> 2) * SEQ + qt * 128; khi = 32; }
            else { const int u = ai - 1536; bh = u >> 1; const int qt = u & 1; qrow0 = TX + (bh >> 2) * CTXL + qt * 128; khi = 0; }
            const int b = bh >> 2, h = bh & 3;
            const float lam = __expf(wave_sum(lamp[lane] * lamp[64 + lane])) - __expf(wave_sum(lamp[128 + lane] * lamp[192 + lane])) + lam_init;
            diff_unit32(lds, tid, lane, wave, QKV, h * 128, qrow0, 512 + h * 128, b * SEQ, TX + b * CTXL, VAT + (size_t)bh * 128 * NKEY, khi,
                        AOUT, h * 128, lam, subg, 1.0f - lam_init);
        } else {
            int bh, qrow0, klo, khi, rw;
            if (ai < 1536) { const int u = ai - 512; bh = u >> 4; const int rp = u & 15; qrow0 = (bh >> 3) * SEQ + rp * 128; klo = na_r0(2 * rp); khi = na_r0(2 * rp + 1) + 8; rw = 2 * rp + (wave >> 2); }
            else { const int u = ai - 1600; bh = u >> 1; const int qt = u & 1; qrow0 = TX + (bh >> 3) * CTXL + qt * 128; klo = 0; khi = 0; rw = 0; }
            const int b = bh >> 3, h = bh & 7;
            for (int i = tid; i < 640; i += 512) { const int k = i - 64; biasT[k] = (k >= 0 && k < 465) ? nab[h * 465 + k] * LOG2E : 0.f; }
            attn_unit<1, 64, true>(lds, tid, lane, wave, QKV, 1536 + h * 64, qrow0, 2048 + h * 64, b * SEQ, TX + b * CTXL, VBT + (size_t)bh * 64 * NKEY, klo, khi,
                                   rw, 16 * (wave & 3), biasT, AOUT, 512 + h * 64, 0.f, nullptr, 1.0f);
        }
    }
}

__device__ __forceinline__ void gla_chunk_rows(int b, int dir, int n, int& row0, int& tok0) {
    if (n < 4) { const int cc = dir ? 3 - n : n; row0 = TX + b * CTXL + 64 * cc; tok0 = SEQ + 64 * cc; } else { const int lc = dir ? 35 - n : n - 4; row0 = b * SEQ + 64 * lc; tok0 = 64 * lc; }
}
constexpr int GP_QM = 0, GP_KM = 17408, GP_VT = 34816, GP_LR = 71680, GP_SEG = 75776;
__device__ __forceinline__ void phase_gla_prep(const bf16* QKV2, const bf16* VGT, const float* wgate  , const float* bgate  ,
                                               bf16* QG, bf16* KET, float* FACD, bf16* OF, bf16* OB,
                                               LAS unsigned char* lds, int tid, int lane, int wave, int vcu, int G) {
    const int fr = lane & 15, g = lane >> 4;
    const int d = tid & 127, seg = tid >> 7;
    LAS float* LR = (LAS float*)(lds + GP_LR);
    LAS float* SEG = (LAS float*)(lds + GP_SEG);
    for (int ub = vcu * 9; ub < 2304; ub += G * 9) {
        const int q = ub / 36, n0 = ub % 36, dir = q & 1, hh = (q >> 1) & 3, b = q >> 3;
        bf16* OUT = dir ? OB : OF;
        float wg[16];
#pragma unroll
        for (int r = 0; r < 16; ++r) wg[r] = wgate[(dir * 16 + r) * 512 + hh * 128 + d];
        const float bgv = bgate[dir * 512 + hh * 128 + d];
        const bf16* vtb = VGT + (size_t)(b * 4 + hh) * 256 * NKEY;
        u32x4 qr[2], kr[2], vr[4], lr4;
#define GP_LOAD(n) do { int _row0, _tok0; gla_chunk_rows(b, dir, (n), _row0, _tok0); \
        _Pragma("unroll") for (int j = 0; j < 2; ++j) { const int idx = tid + 512 * j, p = idx >> 4, ch = idx & 15; const bf16* src = QKV2 + (size_t)(_row0 + p) * NGLA + hh * 128 + ch * 8; qr[j] = *(const u32x4*)src; kr[j] = *(const u32x4*)(src + 512); } \
        _Pragma("unroll") for (int j = 0; j < 4; ++j) { const int idx = tid + 512 * j; vr[j] = *(const u32x4*)(vtb + (size_t)(idx >> 3) * NKEY + _tok0 + (idx & 7) * 8); } \
        if (tid < 128) lr4 = *(const u32x4*)(QKV2 + (size_t)(_row0 + (tid >> 1)) * NGLA + 3072 + dir * 16 + (tid & 1) * 8); } while (0)
#define GP_N(i) (dir ? ((i) < 4 ? 3 - (i) : 39 - (i)) : (i))
        GP_LOAD(GP_N(n0));
        for (int k9 = 0; k9 < 9; ++k9) {
            const int n = GP_N(n0 + k9), u = ub - n0 + n; int row0, tok0; gla_chunk_rows(b, dir, n, row0, tok0);
#pragma unroll
            for (int j = 0; j < 2; ++j) { const int idx = tid + 512 * j, p = idx >> 4, ch = idx & 15;
                *(LAS u32x4*)(lds + GP_QM + p * 272 + ch * 16) = qr[j]; *(LAS u32x4*)(lds + GP_KM + p * 272 + ch * 16) = kr[j]; }
#pragma unroll
            for (int j = 0; j < 4; ++j) { const int idx = tid + 512 * j; *(LAS u32x4*)(lds + GP_VT + (idx >> 3) * 144 + (idx & 7) * 16) = vr[j]; }
            if (tid < 128) { LAS float* lp = LR + (tid >> 1) * 16 + (tid & 1) * 8;
                lp[0] = bflo(lr4.x); lp[1] = bfhi(lr4.x); lp[2] = bflo(lr4.y); lp[3] = bfhi(lr4.y); lp[4] = bflo(lr4.z); lp[5] = bfhi(lr4.z); lp[6] = bflo(lr4.w); lp[7] = bfhi(lr4.w); }
            __syncthreads();
            if (k9 + 1 < 9) GP_LOAD(GP_N(n0 + k9 + 1));
            float gc[16];
#pragma unroll
            for (int pi = 0; pi < 16; ++pi) { const LAS f32x4* lp = (const LAS f32x4*)(LR + (16 * seg + pi) * 16); float z = bgv;
#pragma unroll
                for (int k = 0; k < 4; ++k) { const f32x4 l4 = lp[k]; z += l4.x * wg[4 * k] + l4.y * wg[4 * k + 1] + l4.z * wg[4 * k + 2] + l4.w * wg[4 * k + 3]; }
                const float az = fabsf(z); gc[pi] = (fminf(z, 0.f) - flog(1.0f + fexp(-az))) * 0.0625f; }
            float run = 0.f;
            if (dir == 0) {
#pragma unroll
                for (int pi = 0; pi < 16; ++pi) { run += gc[pi]; gc[pi] = run; }
            } else {
#pragma unroll
                for (int pi = 15; pi >= 0; --pi) { run += gc[pi]; gc[pi] = run; }
            }
            SEG[seg * 128 + d] = run;
            __syncthreads();
            const float t0 = SEG[d], t1 = SEG[128 + d], t2 = SEG[256 + d], t3 = SEG[384 + d];
            float off, gmid; const float gend = (t0 + t1) + (t2 + t3);
            if (dir == 0) { off = (seg > 0 ? t0 : 0.f) + (seg > 1 ? t1 : 0.f) + (seg > 2 ? t2 : 0.f); gmid = t0 + t1; }
            else { off = (seg < 3 ? t3 : 0.f) + (seg < 2 ? t2 : 0.f) + (seg < 1 ? t1 : 0.f); gmid = t3 + t2; }
            const float emid = fexp(gmid), eend = fexp(gend - gmid);
            unsigned kep[8];
            bf16* qgp = QG + ((size_t)u * 64 + 16 * seg) * 128 + d;
#pragma unroll
            for (int pi = 0; pi < 16; ++pi) { const int p = 16 * seg + pi; const float rel = off + gc[pi] - gmid; const float Ep = fexp(rel), Ei = fexp(-rel);
                LAS bf16* qa = (LAS bf16*)(lds + GP_QM) + p * 136 + d; LAS bf16* ka = (LAS bf16*)(lds + GP_KM) + p * 136 + d;
                const float qv = bf2f(*qa), kv = bf2f(*ka);
                const float qm = qv * Ep, km = kv * Ei;
                const unsigned w1 = cvtpk(qm, qm * emid), w2 = cvtpk(km, km * eend);
                *qa = (bf16)(w1 & 0xffffu); qgp[pi * 128] = (bf16)(w1 >> 16); *ka = (bf16)(w2 & 0xffffu);
                if (pi & 1) kep[pi >> 1] |= (w2 & 0xffff0000u); else kep[pi >> 1] = w2 >> 16; }
            { u32x4* kt = (u32x4*)(KET + ((size_t)u * 128 + d) * 64 + 16 * seg); kt[0] = (u32x4){kep[0], kep[1], kep[2], kep[3]}; kt[1] = (u32x4){kep[4], kep[5], kep[6], kep[7]}; }
            if (seg == 0) FACD[(size_t)u * 128 + d] = fexp(gend);
            __syncthreads();
            { const int cb = wave & 3, half = wave >> 2;
              bf16x8 qfr[4];
#pragma unroll
              for (int ks = 0; ks < 4; ++ks) qfr[ks] = *(const LAS bf16x8*)(lds + GP_QM + (16 * cb + fr) * 272 + (8 * g + 32 * ks) * 2);
              f32x4 AT[4];
#pragma unroll
              for (int sb = 0; sb < 4; ++sb) { AT[sb] = (f32x4){0.f, 0.f, 0.f, 0.f};
#pragma unroll
                  for (int ks = 0; ks < 4; ++ks) { const bf16x8 af = *(const LAS bf16x8*)(lds + GP_KM + (16 * sb + fr) * 272 + (8 * g + 32 * ks) * 2);
                      AT[sb] = __builtin_amdgcn_mfma_f32_16x16x32_bf16(af, qfr[ks], AT[sb], 0, 0, 0); }
                  const int c = 16 * cb + fr;
#pragma unroll
                  for (int ii = 0; ii < 4; ++ii) { const int sp = 16 * sb + 4 * g + ii; const bool keep = dir ? (sp >= c) : (sp <= c); AT[sb][ii] = keep ? AT[sb][ii] : 0.f; } }
              bf16x8 pf[2];
#pragma unroll
              for (int t = 0; t < 2; ++t) { u32x4 w; w.x = pk2(AT[2 * t][0], AT[2 * t][1]); w.y = pk2(AT[2 * t][2], AT[2 * t][3]); w.z = pk2(AT[2 * t + 1][0], AT[2 * t + 1][1]); w.w = pk2(AT[2 * t + 1][2], AT[2 * t + 1][3]);
                  pf[t] = __builtin_bit_cast(bf16x8, w); }
#pragma unroll
              for (int v8 = 0; v8 < 8; ++v8) { const int vb = 8 * half + v8; f32x4 Oa = (f32x4){0.f, 0.f, 0.f, 0.f};
#pragma unroll
                  for (int t = 0; t < 2; ++t) { const LAS unsigned char* vp = lds + GP_VT + (16 * vb + fr) * 144 + (32 * t + 4 * g) * 2;
                      const u32x2 lo = *(const LAS u32x2*)vp, hi = *(const LAS u32x2*)(vp + 32);
                      u32x4 w; w.x = lo.x; w.y = lo.y; w.z = hi.x; w.w = hi.y;
                      Oa = __builtin_amdgcn_mfma_f32_16x16x32_bf16(__builtin_bit_cast(bf16x8, w), pf[t], Oa, 0, 0, 0); }
                  u32x2 w; w.x = pk2(Oa[0], Oa[1]); w.y = pk2(Oa[2], Oa[3]);
                  *(u32x2*)(OUT + (size_t)(row0 + 16 * cb + fr) * D + hh * 256 + 16 * vb + 4 * g) = w; }
            }
            __syncthreads();
        }
#undef GP_LOAD
#undef GP_N
    }
}

constexpr int GS_BUF = 45056, GS_QG = 0, GS_KET = 17408, GS_VT = 35840, GS_ST = 2 * GS_BUF, GS_DEC = GS_ST + 2 * 17408;
__device__ __forceinline__ void phase_gla(const bf16* VGT, bf16* OF, bf16* OB, const bf16* QG, const bf16* KET, const float* FACD,
                                          LAS unsigned char* lds, int tid, int lane, int wave, int vcu, int G) {
    const int fr = lane & 15, g = lane >> 4;
    for (int u = vcu; u < 256; u += G) {
        const int slab = u & 3, dir = (u >> 2) & 1, hh = (u >> 3) & 3, b = u >> 5;
        bf16* OUT = dir ? OB : OF;
        const int upb = ((b * 4 + hh) * 2 + dir) * 36;
        f32x4 Sacc[4];
#pragma unroll
        for (int vb = 0; vb < 4; ++vb) Sacc[vb] = (f32x4){0.f, 0.f, 0.f, 0.f};
        for (int i = tid; i < 17408 / 4; i += 512) ((LAS unsigned*)(lds + GS_ST))[i] = 0u;
        const bf16* vtb = VGT + ((size_t)(b * 4 + hh) * 256 + slab * 64) * NKEY;
        const int cb = wave & 3, vh = wave >> 2;
        const int ocol = hh * 256 + slab * 64 + 32 * vh + 4 * g;
        struct GsRegs { u32x4 qg[2], ket[2], v; u32x2 oi[2]; float dec; };
        GsRegs R0, R1; R0.dec = 0.f; R1.dec = 0.f;
#define GS_LOAD(R, n) do { int _row0, _tok0; gla_chunk_rows(b, dir, (n), _row0, _tok0); const size_t _u = (size_t)(upb + (n)); \
        _Pragma("unroll") for (int j = 0; j < 2; ++j) { const int idx = tid + 512 * j; R.qg[j] = *(const u32x4*)(QG + _u * 8192 + idx * 8); R.ket[j] = *(const u32x4*)(KET + _u * 8192 + idx * 8); } \
        R.v = *(const u32x4*)(vtb + (size_t)(tid >> 3) * NKEY + _tok0 + (tid & 7) * 8); \
        if (tid < 128) R.dec = FACD[_u * 128 + tid]; \
        _Pragma("unroll") for (int v2 = 0; v2 < 2; ++v2) R.oi[v2] = *(const u32x2*)(OUT + (size_t)(_row0 + 16 * cb + fr) * D + ocol + 16 * v2); } while (0)
#define GS_STORE(R, bf) do { LAS unsigned char* _p = lds + (bf) * GS_BUF; \
        _Pragma("unroll") for (int j = 0; j < 2; ++j) { const int idx = tid + 512 * j; *(LAS u32x4*)(_p + GS_QG + (idx >> 4) * 272 + (idx & 15) * 16) = R.qg[j]; *(LAS u32x4*)(_p + GS_KET + (idx >> 3) * 144 + (idx & 7) * 16) = R.ket[j]; } \
        *(LAS u32x4*)(_p + GS_VT + (tid >> 3) * 144 + (tid & 7) * 16) = R.v; \
        if (tid < 128) ((LAS float*)(lds + GS_DEC))[(bf) * 128 + tid] = R.dec; } while (0)
#define GS_ITER(n, RN, RF) do { const int _n = (n); int row0, tok0; gla_chunk_rows(b, dir, _n, row0, tok0); const int cur = _n & 1; \
            if (_n + 2 < 36) GS_LOAD(RF, _n + 2); \
            const LAS unsigned char* bufp = lds + cur * GS_BUF; const LAS unsigned char* stp = lds + GS_ST + cur * 17408; \
            { bf16x8 qfr[4]; \
              _Pragma("unroll") for (int ks = 0; ks < 4; ++ks) qfr[ks] = *(const LAS bf16x8*)(bufp + GS_QG + (16 * cb + fr) * 272 + (8 * g + 32 * ks) * 2); \
              _Pragma("unroll") for (int v2 = 0; v2 < 2; ++v2) { const int vb = 2 * vh + v2; const u32x2 oin = v2 ? oc1 : oc0; \
                  f32x4 Oa = (f32x4){bflo(oin.x), bfhi(oin.x), bflo(oin.y), bfhi(oin.y)}; \
                  _Pragma("unroll") for (int ks = 0; ks < 4; ++ks) { const bf16x8 af = *(const LAS bf16x8*)(stp + (16 * vb + fr) * 272 + (8 * g + 32 * ks) * 2); \
                      Oa = __builtin_amdgcn_mfma_f32_16x16x32_bf16(af, qfr[ks], Oa, 0, 0, 0); } \
                  u32x2 w; w.x = pk2(Oa[0], Oa[1]); w.y = pk2(Oa[2], Oa[3]); \
                  *(u32x2*)(OUT + (size_t)(row0 + 16 * cb + fr) * D + ocol + 16 * v2) = w; } } \
            { const f32x4 dec = *(const LAS f32x4*)((LAS float*)(lds + GS_DEC) + cur * 128 + 16 * wave + 4 * g); \
              LAS unsigned char* stn = lds + GS_ST + (cur ^ 1) * 17408; \
              _Pragma("unroll") for (int vb = 0; vb < 4; ++vb) { Sacc[vb] = Sacc[vb] * dec; \
                  _Pragma("unroll") for (int t = 0; t < 2; ++t) { const bf16x8 af = *(const LAS bf16x8*)(bufp + GS_KET + (16 * wave + fr) * 144 + (8 * g + 32 * t) * 2); \
                      const bf16x8 bfr = *(const LAS bf16x8*)(bufp + GS_VT + (16 * vb + fr) * 144 + (8 * g + 32 * t) * 2); \
                      Sacc[vb] = __builtin_amdgcn_mfma_f32_16x16x32_bf16(af, bfr, Sacc[vb], 0, 0, 0); } \
                  u32x2 w; w.x = pk2(Sacc[vb][0], Sacc[vb][1]); w.y = pk2(Sacc[vb][2], Sacc[vb][3]); \
                  *(LAS u32x2*)(stn + (16 * vb + fr) * 272 + (16 * wave + 4 * g) * 2) = w; } } \
            if (_n + 1 < 36) { GS_STORE(RN, cur ^ 1); oc0 = RN.oi[0]; oc1 = RN.oi[1]; } \
            __syncthreads(); } while (0)
        GS_LOAD(R0, 0); GS_STORE(R0, 0);
        u32x2 oc0 = R0.oi[0], oc1 = R0.oi[1];
        GS_LOAD(R0, 1);
        __syncthreads();
        for (int n = 0; n < 36; n += 2) { GS_ITER(n, R0, R1); GS_ITER(n + 1, R1, R0); }
#undef GS_ITER
#undef GS_LOAD
#undef GS_STORE
    }
}

constexpr int N_PHASES = 34;
typedef const Args __attribute__((address_space(4)))* KArgs;
__device__ __forceinline__ KArgs kargs() { KArgs p = (KArgs)__builtin_amdgcn_kernarg_segment_ptr(); asm volatile("" : "+s"(p)); return p; }
__global__ void __launch_bounds__(512, 2) fwd(Args a_unused) {
    extern __shared__ __attribute__((aligned(16))) unsigned char lds_raw[];
    LAS unsigned char* lds = (LAS unsigned char*)lds_raw;
    const int tid0 = threadIdx.x;
    const int G0 = gridDim.x; const int bx0 = blockIdx.x;
#define PH_ENTRY int tid = tid0; asm volatile("" : "+v"(tid)); int G = G0, bx = bx0; asm volatile("" : "+s"(G), "+s"(bx)); const int lane = tid & 63, wave = __builtin_amdgcn_readfirstlane(tid >> 6); \
        const int vcu = (G % 8 == 0) ? (bx % 8) * (G / 8) + bx / 8 : bx; (void)lane; (void)wave; (void)vcu
    const int tid = tid0;
    const int ph_lo = kargs()->ph_lo, ph_hi = kargs()->ph_hi;
    const int repmask = kargs()->rep;
    if (tid < 64) ((LAS unsigned*)(lds + LX_MISC))[tid] = 0u;
    for (int i = tid; i < 1024; i += 512) { const int pos = i >> 4, f = i & 15; const float inv = __builtin_amdgcn_exp2f(-(float)f * (13.287712379549449f / 16.0f)); const float ang = (float)pos * inv;
        ((LAS float*)(lds + LX_ROPE))[2 * i] = __cosf(ang); ((LAS float*)(lds + LX_ROPE))[2 * i + 1] = __sinf(ang); }
    __syncthreads();
    const bool single = (ph_hi - ph_lo) > 1;
    XcdBarrier bar; bar.bar = (unsigned*)(kargs()->ws + WS_CTL) + CW_BAR; bar.x = 0; bar.st = (volatile LAS unsigned*)(lds + LX_MISC);
    if (single) bar = xcd_barrier_post((unsigned*)(kargs()->ws + WS_CTL) + CW_BAR, (volatile LAS unsigned*)(lds + LX_MISC));
#define IN(k) (ph_lo <= (k) && (k) < ph_hi)
#define REPLOOP(t) for (int rep_ = 0, nrep_ = 1 + ((repmask >> (t)) & 1); rep_ < nrep_; ++rep_, (rep_ < nrep_ ? (bar.bar = (unsigned*)(kargs()->ws + WS_CTL) + CW_BAR, xcd_barrier(bar)) : (void)0))
#define SEAM(k) do { if (IN(k) && IN((k) + 1)) { bar.bar = (unsigned*)(kargs()->ws + WS_CTL) + CW_BAR; xcd_barrier(bar); if ((repmask >> 10) & 1) xcd_barrier(bar); } } while (0)
    LAS int* tab = (LAS int*)(lds + LX_MOETAB);
#define CONV_PTRS(A) ConvPtrs{(A)->att_w_in, (A)->att_w_out, (A)->gla_w_in, (A)->gla_w_out, (A)->moe_w1, (A)->moe_w3, (A)->moe_w2, (A)->ws}

    if (IN(0)) REPLOOP(0) { PH_ENTRY; p0_prologue(kargs(), lds, tid, lane, wave, vcu, G); } SEAM(0);
    if (IN(1)) { PH_ENTRY; KArgs A = kargs(); unsigned char* ws = A->ws; phase_norm1(A->x, A->ctx, A->norm_g, (float*)(ws + WS_MODV), (bf16*)(ws + WS_H), TALL, lane, wave, vcu, G); } SEAM(1);

#pragma nounroll
    for (int L = 0; L < 4; ++L) {
        const int pb = 2 + 8 * L; const bool isattn = !(L & 1); const int j = L >> 1; const bool lastL = (L == 3);
        const int nrows = lastL ? TX : TALL;
        if (IN(pb)) REPLOOP(isattn ? 1 : 3) {
            PH_ENTRY; KArgs A = kargs(); unsigned char* ws = A->ws; unsigned char* big = ws + WS_BIG; const bf16* H = (const bf16*)(ws + WS_H);
            if (isattn) {
                pg8::DenseOrder S; S.init(H, (const bf16*)(ws + WS_WATTIN) + (size_t)j * NATT * D, TALL, NATT, D, G, bx);
                pg8::EpiAttnIn E{(bf16*)(big + BG_QKV), (bf16*)(big + BG_VAT), (bf16*)(big + BG_VBT), (const LAS float*)(lds + LX_ROPE)};
                pg8::gemm_phase<pg8::EpiAttnIn, pg8::DenseOrder, false>(lds, tid, D, S, E);
            } else {
                pg8::DenseOrder S; S.init(H, (const bf16*)(ws + WS_WGLAIN) + (size_t)j * NGLA * D, TALL, NGLA, D, G, bx);
                pg8::EpiGlaIn E{(bf16*)(big + BG_QKV2), (bf16*)(big + BG_VGT)};
                pg8::gemm_phase<pg8::EpiGlaIn, pg8::DenseOrder, false>(lds, tid, D, S, E);
            }
        }
        SEAM(pb);
        if (!isattn && IN(pb + 1)) {
            for (int rep_ = 0; rep_ <= ((repmask >> 13) & 1); ++rep_)
            { PH_ENTRY; KArgs A = kargs(); unsigned char* ws = A->ws;
              phase_gla_prep((const bf16*)(ws + WS_BIG + BG_QKV2), (const bf16*)(ws + WS_BIG + BG_VGT), A->gla_w_gate + j * 2 * 16 * 512, A->gla_b_gate + j * 2 * 512,
                             (bf16*)(ws + WS_QG), (bf16*)(ws + WS_KET), (float*)(ws + WS_BIG + BG_FAC), (bf16*)(ws + WS_BIG + BG_OF), (bf16*)(ws + WS_BIG + BG_OB), lds, tid, lane, wave, vcu, G); }
            if (single) { bar.bar = (unsigned*)(kargs()->ws + WS_CTL) + CW_BAR; xcd_barrier(bar); }
        }
        if (IN(pb + 1)) REPLOOP(isattn ? 2 : 4) {
            PH_ENTRY; KArgs A = kargs(); unsigned char* ws = A->ws; unsigned char* big = ws + WS_BIG; bf16* AOUT = (bf16*)(ws + WS_AOUT);
            if (isattn) { const ConvPtrs CP = CONV_PTRS(A);
                phase_attention((const bf16*)(big + BG_QKV), (const bf16*)(big + BG_VAT), (const bf16*)(big + BG_VBT), AOUT, A->att_lambda + j * 256, (L == 0) ? 0.2f : 0.470713018f,
                                A->att_subln_g + j * 128, A->na_bias + j * 8 * 465, (unsigned*)(ws + WS_CTL) + CW_NAQ + 64 * j, CP,
                                MK_CONVQ ? (L == 0 ? CT_ATTN0 : CT_MOE1) : 0, MK_CONVQ ? (L == 0 ? CT_MOE1 : CT_MOE3) : 0, lds, tid, lane, wave); }
            else phase_gla((const bf16*)(big + BG_VGT), (bf16*)(big + BG_OF), (bf16*)(big + BG_OB), (const bf16*)(ws + WS_QG), (const bf16*)(ws + WS_KET), (const float*)(big + BG_FAC),
                           lds, tid, lane, wave, vcu, G);
        }
        SEAM(pb + 1);
        if (!isattn) {
            if (IN(pb + 2)) REPLOOP(5) { PH_ENTRY; KArgs A = kargs(); unsigned char* ws = A->ws; unsigned char* big = ws + WS_BIG;
                phase_readout((const bf16*)(big + BG_OF), (const bf16*)(big + BG_OB), (const bf16*)(big + BG_QKV2), A->gla_norm_g + j * 256, (bf16*)(ws + WS_AOUT), nrows, lane, wave, vcu, G); }
            SEAM(pb + 2);
        }
        if (IN(pb + 3)) {
            PH_ENTRY; KArgs A = kargs(); unsigned char* ws = A->ws;
            pg8::DenseOrder S; S.init((const bf16*)(ws + WS_AOUT), (const bf16*)(ws + (isattn ? WS_WATTOUT : WS_WGLAOUT)) + (size_t)j * D * D, nrows, D, D, G, bx);
            pg8::EpiResid E{L == 0 ? A->x : A->out, L == 0 ? A->ctx : (const float*)(ws + WS_CTX), A->out, (float*)(ws + WS_CTX), (const float*)(ws + WS_MODV) + (size_t)L * 9 * 6144 + 2048};
            pg8::gemm_phase<pg8::EpiResid, pg8::DenseOrder, false>(lds, tid, D, S, E);
        }
        SEAM(pb + 3);
        if (IN(pb + 4)) { PH_ENTRY; KArgs A = kargs(); unsigned char* ws = A->ws;
            phase_router(A->out, (float*)(ws + WS_CTX), A->norm_g + (L * 2 + 1) * D, (const float*)(ws + WS_MODV) + (size_t)L * 9 * 6144, (bf16*)(ws + WS_H), A->router_w, A->router_bias,
                         (unsigned*)(ws + WS_CTL) + CW_CNT + L * 16 * 64, (int*)(ws + WS_LIST), (int*)(ws + WS_TOKI), (float*)(ws + WS_TOKW), nrows, lds, tid, lane, wave, vcu, G, (repmask >> 11) & 1); }
        SEAM(pb + 4);
        if (IN(pb + 5)) REPLOOP(6) {
            PH_ENTRY; KArgs A = kargs(); unsigned char* ws = A->ws;
            const int RT = build_moe_table((unsigned*)(ws + WS_CTL) + CW_CNT + L * 16 * 64, tab, tid);
            pg8::MoeOrder S; S.A = (const char*)(ws + WS_H); S.B = (const char*)(ws + WS_W13) + (size_t)L * 16 * D * D * 2; S.K = D; S.bstride = (size_t)D * D * 2; S.tab = tab; S.list = (const int*)(ws + WS_LIST); S.RT = RT; S.nwg = RT * 4; S.G = G; S.c = bx;
            S.fill_tokc((LAS int*)(lds + LX_BIAS), tid);
            pg8::EpiMoe1 E{(bf16*)(ws + WS_BIG + BG_HB)};
            pg8::gemm_phase<pg8::EpiMoe1, pg8::MoeOrder, true>(lds, tid, D, S, E);
        }
        SEAM(pb + 5);
        if (IN(pb + 6)) REPLOOP(7) {
            PH_ENTRY; KArgs A = kargs(); unsigned char* ws = A->ws;
            const int RT = build_moe_table((unsigned*)(ws + WS_CTL) + CW_CNT + L * 16 * 64, tab, tid);
            pg8::MoeOrder S; S.A = (const char*)(ws + WS_BIG + BG_HB); S.B = (const char*)(ws + WS_W2) + (size_t)L * 16 * D * DEXP * 2; S.K = DEXP; S.bstride = (size_t)D * DEXP * 2; S.tab = tab; S.list = (const int*)(ws + WS_LIST); S.RT = RT; S.nwg = RT * 4; S.G = G; S.c = bx;
            pg8::EpiBf16 E{(bf16*)(ws + WS_BIG + BG_YB), D};
            pg8::gemm_phase<pg8::EpiBf16, pg8::MoeOrder, false>(lds, tid, DEXP, S, E);
        }
        SEAM(pb + 6);
        if (IN(pb + 7)) { PH_ENTRY; KArgs A = kargs(); unsigned char* ws = A->ws; const float* MODV = (const float*)(ws + WS_MODV);
            if (lastL) phase_combine<true>(A->out, (float*)(ws + WS_CTX), MODV + (size_t)L * 9 * 6144, (const bf16*)(ws + WS_BIG + BG_YB), (unsigned*)(ws + WS_CTL) + CW_CNT + L * 16 * 64, (const int*)(ws + WS_TOKI), (const float*)(ws + WS_TOKW),
                                           A->final_g, MODV + (size_t)L * 9 * 6144, (bf16*)(ws + WS_H), nrows, lane, wave, vcu, G);
            else phase_combine<false>(A->out, (float*)(ws + WS_CTX), MODV + (size_t)L * 9 * 6144, (const bf16*)(ws + WS_BIG + BG_YB), (unsigned*)(ws + WS_CTL) + CW_CNT + L * 16 * 64, (const int*)(ws + WS_TOKI), (const float*)(ws + WS_TOKW),
                                      A->norm_g + ((L + 1) * 2) * D, MODV + (size_t)(L + 1) * 9 * 6144, (bf16*)(ws + WS_H), nrows, lane, wave, vcu, G); }
        if (!lastL) SEAM(pb + 7);
    }
#undef IN
#undef REPLOOP
#undef SEAM
#undef CONV_PTRS

#undef PH_ENTRY
}

extern "C" void kernel_launch(void* const* d_in, const int* in_sizes, int n_in, void* d_out, int out_size, void* d_ws, size_t ws_size, hipStream_t stream) {
    static int ready = 0;
    if (ready == 0) {
        if (n_in != 23 || out_size != TX * D || ws_size < WS_END) { fprintf(stderr, "kernel_launch: unexpected shapes (n_in %d out %d ws %zu)\n", n_in, out_size, ws_size); ready = -1; return; }
        if (hipFuncSetAttribute((const void*)fwd, hipFuncAttributeMaxDynamicSharedMemorySize, LDS_BYTES) != hipSuccess) { fprintf(stderr, "kernel_launch: hipFuncSetAttribute failed\n"); ready = -1; return; }
        int per_cu = 0; (void)hipOccupancyMaxActiveBlocksPerMultiprocessor(&per_cu, (const void*)fwd, 512, LDS_BYTES); (void)hipGetLastError();
        if (per_cu < 1) fprintf(stderr, "kernel_launch: occupancy query reports %d blocks per CU\n", per_cu);
        ready = 1;
    }
    if (ready < 0) return;
    (void)hipMemsetAsync((char*)d_ws + WS_CTL, 0, CTL_ZERO_BYTES, stream);
    Args a{};
    const float** ap = (const float**)&a;
    for (int i = 0; i < 23; ++i) ap[i] = (const float*)d_in[i];
    a.out = (float*)d_out; a.ws = (unsigned char*)d_ws;
    const int grid = 256;
    a.ph_lo = 0; a.ph_hi = N_PHASES; a.rep = MK_REPMASK;
    hipLaunchKernelGGL(fwd, dim3(grid), dim3(512), LDS_BYTES, stream, a);
}
```

```cpp
#include <hip/hip_runtime.h>
#include <cstdio>
#include <cstdint>

#ifndef MK_CONVQ
#define MK_CONVQ 1
#endif
#ifndef MK_REPMASK
#define MK_REPMASK 0
#endif

#define GAS __attribute__((address_space(1)))
#define LAS __attribute__((address_space(3)))
typedef unsigned short bf16;
typedef short bf16x8 __attribute__((ext_vector_type(8)));
typedef short bf16x4 __attribute__((ext_vector_type(4)));
typedef float f32x4 __attribute__((ext_vector_type(4)));
typedef float f32x2 __attribute__((ext_vector_type(2)));
typedef unsigned u32x4 __attribute__((ext_vector_type(4)));
typedef unsigned u32x2 __attribute__((ext_vector_type(2)));

constexpr int D = 1024, NB = 8, SEQ = 2048, CTXL = 256;
constexpr int TX = NB * SEQ, TC = NB * CTXL, TALL = TX + TC;
constexpr int NKEY = SEQ + CTXL;
constexpr int NATT = 3072, NGLA = 3328;
constexpr float EPSF = 1e-6f;
constexpr float LOG2E = 1.4426950408889634f;
constexpr int NEXP = 16, DEXP = 512;
constexpr int RT_MAX = 160;

constexpr size_t MiB = 1u << 20;
constexpr size_t WS_CTL = 0, CTL_ZERO_BYTES = 65536;
constexpr size_t WS_MODV = 1 * MiB;
constexpr size_t WS_TOKI = 2 * MiB;
constexpr size_t WS_TOKW = 2 * MiB + 512 * 1024;
constexpr size_t WS_LIST = 3 * MiB;
constexpr size_t WS_CTX = 5 * MiB;
constexpr size_t WS_WATTIN = 13 * MiB;
constexpr size_t WS_WATTOUT = 25 * MiB;
constexpr size_t WS_WGLAIN = 29 * MiB;
constexpr size_t WS_WGLAOUT = 42 * MiB;
constexpr size_t WS_W13 = 46 * MiB;
constexpr size_t WS_W2 = 174 * MiB;
constexpr size_t WS_H = 238 * MiB;
constexpr size_t WS_AOUT = 274 * MiB;
constexpr size_t WS_BIG = 310 * MiB;
constexpr size_t WS_XB = 539 * MiB;
constexpr size_t WS_END = 575 * MiB;
constexpr size_t BG_QKV = 0;
constexpr size_t BG_VAT = 108 * MiB;
constexpr size_t BG_VBT = 126 * MiB;
constexpr size_t BG_QKV2 = 0;
constexpr size_t BG_VGT = 117 * MiB;
constexpr size_t BG_OF = 153 * MiB;
constexpr size_t BG_OB = 189 * MiB;
constexpr size_t BG_FAC = 225 * MiB;
constexpr size_t WS_QG = WS_H, WS_KET = WS_AOUT;
constexpr size_t BG_HB = 0;
constexpr size_t BG_YB = 40 * MiB;
constexpr int CW_TMO = 0;
constexpr int CW_BAR = 4096;
constexpr int CW_NAQ = 15360;
constexpr int CW_CNT = 8192;

constexpr int RING_BYTES = 131072;
constexpr int LX_OFF = RING_BYTES;
constexpr int LX_MISC = LX_OFF;
constexpr int LX_MOETAB = LX_OFF + 256;
constexpr int LX_ROPE = LX_OFF + 2048;
constexpr int LX_BIAS = LX_OFF + 2048 + 8192;
constexpr int LDS_BYTES = 147456;

#define LDS_WAIT() asm volatile("s_waitcnt lgkmcnt(0)" ::: "memory")
#define VM_WAIT() asm volatile("s_waitcnt vmcnt(0)" ::: "memory")
#define RLX_AGENT __ATOMIC_RELAXED, __HIP_MEMORY_SCOPE_AGENT
__device__ __forceinline__ unsigned f2bf(float f) { unsigned u = __builtin_bit_cast(unsigned, f); return (u + 0x7fffu + ((u >> 16) & 1u)) >> 16; }
typedef __bf16 hwbf16x2 __attribute__((ext_vector_type(2)));
__device__ __forceinline__ unsigned cvtpk(float lo, float hi) { const f32x2 v = {lo, hi}; const hwbf16x2 b = __builtin_convertvector(v, hwbf16x2); return __builtin_bit_cast(unsigned, b); }
__device__ __forceinline__ unsigned pk2(float lo, float hi) { return cvtpk(lo, hi); }
__device__ __forceinline__ float bf2f(unsigned short b) { return __builtin_bit_cast(float, ((unsigned)b) << 16); }
__device__ __forceinline__ float bflo(unsigned w) { return __builtin_bit_cast(float, w << 16); }
__device__ __forceinline__ float bfhi(unsigned w) { return __builtin_bit_cast(float, w & 0xffff0000u); }
template <int CTRL> __device__ __forceinline__ float dppf(float v) { return __builtin_bit_cast(float, __builtin_amdgcn_update_dpp(0, __builtin_bit_cast(int, v), CTRL, 0xf, 0xf, true)); }
__device__ __forceinline__ float row_sum(float v) { v += dppf<0xB1>(v); v += dppf<0x4E>(v); v += dppf<0x124>(v); v += dppf<0x128>(v); return v; }
__device__ __forceinline__ float swap16_add(float a, float b) { auto r = __builtin_amdgcn_permlane16_swap(__float_as_uint(a), __float_as_uint(b), false, false); const unsigned r0 = r[0], r1 = r[1]; return __uint_as_float(r0) + __uint_as_float(r1); }
__device__ __forceinline__ float swap32_add(float a, float b) { auto r = __builtin_amdgcn_permlane32_swap(__float_as_uint(a), __float_as_uint(b), false, false); const unsigned r0 = r[0], r1 = r[1]; return __uint_as_float(r0) + __uint_as_float(r1); }
__device__ __forceinline__ float swap16_max(float a) { auto r = __builtin_amdgcn_permlane16_swap(__float_as_uint(a), __float_as_uint(a), false, false); const unsigned r0 = r[0], r1 = r[1]; return fmaxf(__uint_as_float(r0), __uint_as_float(r1)); }
__device__ __forceinline__ float swap32_max(float a) { auto r = __builtin_amdgcn_permlane32_swap(__float_as_uint(a), __float_as_uint(a), false, false); const unsigned r0 = r[0], r1 = r[1]; return fmaxf(__uint_as_float(r0), __uint_as_float(r1)); }
__device__ __forceinline__ float readlane_f(float v, int l) { return __int_as_float(__builtin_amdgcn_readlane(__float_as_int(v), l)); }
__device__ __forceinline__ float wave_sum(float v) { v = row_sum(v); v = swap16_add(v, v); return swap32_add(v, v); }
__device__ __forceinline__ float fexp2(float x) { return __builtin_amdgcn_exp2f(x); }
__device__ __forceinline__ float fexp(float x) { return __builtin_amdgcn_exp2f(x * LOG2E); }
__device__ __forceinline__ float flog(float x) { return __builtin_amdgcn_logf(x) * 0.6931471805599453f; }
__device__ __forceinline__ float frcp(float x) { return __builtin_amdgcn_rcpf(x); }
__device__ __forceinline__ float silu_f(float x) { return x * frcp(1.0f + fexp(-x)); }

#define XB_TMO      128
#define XB_XCNT(j)  (256  + 64 * (j))
#define XB_XSUB(j)  (1280 + 64 * (j))
#define XB_XGEN(j)  (2304 + 64 * (j))
#define XB_TOP      3328
#define XB_TOPGEN   3392
#define XCD_BAR_WORDS 3456
#define XB_SPIN_CAP (1u << 18)
__device__ __forceinline__ unsigned xb_ld(unsigned* p)              { return __hip_atomic_load(p, __ATOMIC_RELAXED, __HIP_MEMORY_SCOPE_AGENT); }
__device__ __forceinline__ unsigned xb_add(unsigned* p, unsigned v) { return __hip_atomic_fetch_add(p, v, __ATOMIC_RELAXED, __HIP_MEMORY_SCOPE_AGENT); }
__device__ __forceinline__ unsigned xb_xcc_id() { return (unsigned)__builtin_amdgcn_s_getreg((3 << 11) | 20) & 0xFu; }
#define XB_SPIN(cond, bar) do { unsigned _sp = 0; while (cond) { __builtin_amdgcn_s_sleep(1); \
    if ((++_sp & 255u) == 0u) { if (xb_ld(&(bar)[XB_TMO])) break; if (_sp > XB_SPIN_CAP) { atomicAdd(&(bar)[XB_TMO], 1u); break; } } } } while (0)
struct XcdBarrier { unsigned* bar; unsigned x; volatile LAS unsigned* st; };
__device__ __forceinline__ XcdBarrier xcd_barrier_post(unsigned* bar, volatile LAS unsigned* st) {
    XcdBarrier b; b.bar = bar; b.x = xb_xcc_id(); b.st = st;
    if (threadIdx.x == 0) (void)xb_add(&bar[XB_XCNT(b.x)], 1u);
    return b;
}
__device__ __forceinline__ void xcd_barrier_complete(unsigned* bar, unsigned x, unsigned& nloc, unsigned& nx) {
    const unsigned G = gridDim.x * gridDim.y * gridDim.z;
    unsigned sum, cnt, mine, sp = 0u;
    for (;;) {
        sum = 0u; cnt = 0u; mine = 0u;
#pragma unroll
        for (unsigned j = 0; j < 16; ++j) { const unsigned c = xb_ld(&bar[XB_XCNT(j)]); sum += c; cnt += (c > 0u) ? 1u : 0u; mine = (j == x) ? c : mine; }
        if (sum == G) break;
        __builtin_amdgcn_s_sleep(1);
        if ((++sp & 255u) == 0u) { if (xb_ld(&bar[XB_TMO])) break; if (sp > XB_SPIN_CAP) { atomicAdd(&bar[XB_TMO], 1u); break; } }
    }
    nloc = mine > 0u ? mine : 1u; nx = cnt > 0u ? cnt : 1u;
}
__device__ __forceinline__ void xcd_barrier(const XcdBarrier& b) {
    asm volatile("s_waitcnt vmcnt(0)" ::: "memory");
    __syncthreads();
    if (threadIdx.x == 0) {
        unsigned* bar = b.bar;
        __builtin_amdgcn_s_waitcnt(0);
        unsigned nloc = b.st[0], nx = b.st[1];
        if (nloc == 0u) { xcd_barrier_complete(bar, b.x, nloc, nx); b.st[0] = nloc; b.st[1] = nx; }
        const unsigned old = xb_add(&bar[XB_XSUB(b.x)], 1u);
        const unsigned gen = old / nloc;
        if (old + 1u == (gen + 1u) * nloc) {
            __builtin_amdgcn_fence(__ATOMIC_RELEASE, "agent");
            asm volatile("s_waitcnt vmcnt(0)" ::: "memory");
            const unsigned og = xb_add(&bar[XB_TOP], 1u);
            const unsigned tg = og / nx;
            if (og + 1u == (tg + 1u) * nx) xb_add(&bar[XB_TOPGEN], 1u);
            else XB_SPIN(xb_ld(&bar[XB_TOPGEN]) == tg, bar);
            __builtin_amdgcn_fence(__ATOMIC_ACQUIRE, "agent");
            xb_add(&bar[XB_XGEN(b.x)], 1u);
            asm volatile("s_waitcnt vmcnt(0)" ::: "memory");
        } else {
            XB_SPIN(xb_ld(&bar[XB_XGEN(b.x)]) == gen, bar);
            __builtin_amdgcn_fence(__ATOMIC_ACQUIRE, "agent");
            asm volatile("s_waitcnt vmcnt(0)" ::: "memory");
        }
    }
    __syncthreads();
}

namespace pg8 {
constexpr int BM = 256, BK = 64, HALF = 128, HTB = HALF * BK * 2, STAGE_BYTES = 8 * HTB, NXCD = 8, WGM = 8;
__host__ __device__ __forceinline__ int lds_byte(int r, int c) { const int st = (r >> 4) * 2 + (c >> 5), rr = r & 15, cc = c & 31, ob = rr * 64 + cc * 2; return st * 1024 + (ob ^ (((ob >> 9) & 1) << 5)); }
__host__ __device__ __forceinline__ void stage_rc(int b, int& R, int& C) { const int st = b / 1024, sb = b % 1024, swz = sb ^ (((sb >> 9) & 1) << 5); R = (st >> 1) * 16 + swz / 64; C = (st & 1) * 32 + (swz % 64) / 2; }
__host__ __device__ __forceinline__ int perm32(int rho) { const int n = rho >> 4, i = rho & 15; return 8 * (i >> 2) + 4 * n + (i & 3); }

struct Unit { int pm, pn, e, mt, roff, nai, ord; };
__device__ __forceinline__ bool split_index(long L, int nwg, int G, int& uidx, int& roff, int& nai) {
    const int R = nwg / G, r = nwg % G; const bool split = (r > 0) && (2 * r <= G);
    if (L < (long)R * G || !split) { if (L >= nwg) return false; uidx = (int)L; roff = 0; nai = 2; return true; }
    const int h = (int)(L - (long)R * G); if (h >= 2 * r) return false; uidx = R * G + (h >> 1); roff = (h & 1) * 128; nai = 1; return true;
}

__device__ __forceinline__ int xcd_remap(int wgid, int nwg) { const int q = nwg / NXCD, r = nwg % NXCD, xcd = wgid % NXCD, off = wgid / NXCD; return (xcd < r ? xcd * (q + 1) : r * (q + 1) + (xcd - r) * q) + off; }

struct DenseOrder {
    const char* A; const char* B; int K; int nM, nN, nwg, G, c;
    __device__ __forceinline__ void init(const bf16* A_, const bf16* B_, int M, int N, int K_, int G_, int c_) { A = (const char*)A_; B = (const char*)B_; K = K_; nM = M / BM; nN = N / BM; nwg = nM * nN; G = G_; c = c_; }
    __device__ __forceinline__ bool next(int i, Unit& u) const {
        int uidx; if (!split_index((long)i * G + c, nwg, G, uidx, u.roff, u.nai)) return false;
        const int wgid = xcd_remap(uidx, nwg);
        const int nig = WGM * nN, gid = wgid / nig, fm = gid * WGM, gsz = (nM - fm) < WGM ? (nM - fm) : WGM;
        u.pm = fm + ((wgid % nig) % gsz); u.pn = (wgid % nig) / gsz; u.e = 0; u.mt = 0; u.ord = i; return true;
    }
    __device__ __forceinline__ const char* a_ptr(const Unit& u) const { return A + (size_t)(u.pm * BM + u.roff) * K * 2; }
    __device__ __forceinline__ const char* b_ptr(const Unit& u) const { return B + (size_t)u.pn * BM * K * 2; }
    __device__ __forceinline__ int tok(const Unit&, int) const { return 0; }
};
struct MoeOrder {
    const char* A; const char* B; int K; size_t bstride;
    const LAS int* tab; const int* list; int RT, nwg, G, c;
    __device__ __forceinline__ bool next(int i, Unit& u) const {
        int uidx; if (!split_index((long)i * G + c, nwg, G, uidx, u.roff, u.nai)) return false;
        const int wgid = xcd_remap(uidx, nwg);
        const int rt = wgid >> 2; u.pm = rt; u.pn = wgid & 3; const int t = tab[rt]; u.e = t & 255; u.mt = t >> 8; u.ord = i; return true;
    }
    __device__ __forceinline__ const char* a_ptr(const Unit& u) const { return A + (size_t)(u.pm * BM + u.roff) * K * 2; }
    __device__ __forceinline__ const char* b_ptr(const Unit& u) const { return B + (size_t)u.e * bstride + (size_t)u.pn * BM * K * 2; }
    const LAS int* tokc;
    __device__ __forceinline__ int tok(const Unit& u, int r) const { return tokc[u.ord * BM + r]; }
    __device__ __forceinline__ void fill_tokc(LAS int* dst, int tid) {
        tokc = dst;
        int val[2], idx[2]; bool ok[2];
#pragma unroll
        for (int k = 0; k < 2; ++k) { const int i = (tid >> 8) + 2 * k, r = tid & 255; Unit u; const bool has = (i < 3) && next(i, u);
            const int cnt = has ? tab[RT_MAX + 1 + u.e] : 0; const int pos = has ? u.mt * BM + u.roff + r : 0;
            ok[k] = has; idx[k] = i * BM + r;
            val[k] = list[(size_t)(has ? u.e : 0) * TALL + pos];
            val[k] = (pos < cnt) ? val[k] : 0; }
#pragma unroll
        for (int k = 0; k < 2; ++k) if (ok[k]) dst[idx[k]] = val[k];
        __syncthreads();
    }
};

__device__ __forceinline__ unsigned cvt_pk_bf16(float lo, float hi) { unsigned r; asm volatile("v_cvt_pk_bf16_f32 %0, %1, %2" : "=v"(r) : "v"(lo), "v"(hi)); return r; }

template <class Epi, class Sched, bool GATHER>
__device__ __forceinline__ void gemm_phase(LAS unsigned char* lds, const int tid, const int K, const Sched& S, const Epi& E) {
    const int wid = __builtin_amdgcn_readfirstlane(tid >> 6), lane = tid & 63, wr = wid >> 2, wc = wid & 3, fr = lane & 15, fq = lane >> 4;
    const int nt = K / BK;
    unsigned voffA[2], voffB[2]; int RA[2], CA[2];
#pragma unroll
    for (int i = 0; i < 2; ++i) { int R, C; stage_rc(tid * 16 + i * 8192, R, C); const int Rb = Epi::PERM ? ((R & ~31) + perm32(R & 31)) : R;
        RA[i] = R; CA[i] = C; voffA[i] = (unsigned)(R * K + C) * 2u; voffB[i] = (unsigned)(Rb * K + C) * 2u; }
    const size_t kstep = (size_t)(BK * 2);
    const size_t hstep = (size_t)HALF * K * 2;
    const unsigned ldsw = (unsigned)wid * 1024u;
    const int aoff = lds_byte(wr * 64 + fr, fq * 8), boff = lds_byte(wc * 32 + fr, fq * 8);
#define PG8_SA(b, h) (((b) * 2 + (h)) * HTB)
#define PG8_SB(b, h) ((4 + (b) * 2 + (h)) * HTB)
#define PG8_STAGE(bufoff, gbase, voff) do { _Pragma("unroll") for (int _i = 0; _i < 2; ++_i) \
        __builtin_amdgcn_global_load_lds((const unsigned*)((const char*)(gbase) + (voff)[_i]), (LAS unsigned*)(lds + (bufoff) + ldsw + _i * 8192), 16, 0, 0); } while (0)
#define PG8_STAGE_A(bufoff, h, usenext, koff) do { if constexpr (GATHER) { unsigned _vo[2]; _vo[0] = (usenext) ? nvA[h][0] : vA[h][0]; _vo[1] = (usenext) ? nvA[h][1] : vA[h][1]; PG8_STAGE(bufoff, S.A + (koff), _vo); } \
        else { PG8_STAGE(bufoff, ((usenext) ? nA : cA) + (size_t)(h) * hstep + (koff), voffA); } } while (0)
#define PG8_LDA(dst, b, h) do { _Pragma("unroll") for (int m = 0; m < 4; ++m) _Pragma("unroll") for (int k = 0; k < 2; ++k) dst[m][k] = *(const LAS bf16x8*)(lds + PG8_SA(b, h) + aoff + m * 2048 + k * 1024); } while (0)
#define PG8_LDB(dst, b, h) do { _Pragma("unroll") for (int n = 0; n < 2; ++n) _Pragma("unroll") for (int k = 0; k < 2; ++k) dst[n][k] = *(const LAS bf16x8*)(lds + PG8_SB(b, h) + boff + n * 2048 + k * 1024); } while (0)
#define PG8_MMA(ai, bj, At, Bt) do { __builtin_amdgcn_s_setprio(1); _Pragma("unroll") for (int m = 0; m < 4; ++m) _Pragma("unroll") for (int n = 0; n < 2; ++n) _Pragma("unroll") for (int k = 0; k < 2; ++k) \
        acc[ai][bj][m][n] = __builtin_amdgcn_mfma_f32_16x16x32_bf16(Bt[n][k], At[m][k], acc[ai][bj][m][n], 0, 0, 0); __builtin_amdgcn_s_setprio(0); } while (0)
#define PG8_WAIT_V(n) asm volatile("s_waitcnt vmcnt(" #n ")" ::: "memory")
#define PG8_WAIT_L(n) asm volatile("s_waitcnt lgkmcnt(" #n ")" ::: "memory")
#define PG8_BAR __builtin_amdgcn_s_barrier()
#define PG8_SCHED __builtin_amdgcn_sched_barrier(0)
    Unit cur, nxt; int ui = 0;
    if (!S.next(0, cur)) return;
    f32x4 acc[2][2][4][2];
#pragma unroll
    for (int a = 0; a < 2; ++a)
#pragma unroll
        for (int b = 0; b < 2; ++b)
#pragma unroll
            for (int m = 0; m < 4; ++m)
#pragma unroll
                for (int n = 0; n < 2; ++n) acc[a][b][m][n] = (f32x4){0.f, 0.f, 0.f, 0.f};
    bf16x8 At[4][2], B0[2][2], B1[2][2];
    unsigned vA[2][2], nvA[2][2];
    if constexpr (GATHER) {
#pragma unroll
        for (int h = 0; h < 2; ++h)
#pragma unroll
            for (int i = 0; i < 2; ++i) { vA[h][i] = (unsigned)(S.tok(cur, h * HALF + RA[i]) * K + CA[i]) * 2u; nvA[h][i] = vA[h][i]; }
    }
    const char* cA = S.a_ptr(cur); const char* cB = S.b_ptr(cur); const char* nA = cA;
    PG8_STAGE(PG8_SB(0, 0), cB, voffB); PG8_STAGE(PG8_SB(0, 1), cB + hstep, voffB); PG8_STAGE_A(PG8_SA(0, 0), 0, false, 0); PG8_STAGE_A(PG8_SA(0, 1), 1, false, 0);
    if (wr == 1) PG8_BAR;
    PG8_WAIT_V(2); PG8_BAR;
    PG8_STAGE(PG8_SB(1, 0), cB + kstep, voffB); PG8_STAGE_A(PG8_SA(1, 0), 0, false, kstep); PG8_STAGE(PG8_SB(1, 1), cB + hstep + kstep, voffB);
    PG8_WAIT_V(6); PG8_BAR;
    for (;;) {
        const bool has_next = S.next(ui + 1, nxt);
        nA = has_next ? S.a_ptr(nxt) : cA; const char* nB = has_next ? S.b_ptr(nxt) : cB;
        if constexpr (GATHER) {
            if (has_next) {
#pragma unroll
                for (int h = 0; h < 2; ++h)
#pragma unroll
                    for (int i = 0; i < 2; ++i) nvA[h][i] = (unsigned)(S.tok(nxt, h * HALF + RA[i]) * K + CA[i]) * 2u;
            }
        }
        const bool full = (cur.nai == 2);
        for (int t = 0; t < nt; t += 2) {
            const bool last = (t == nt - 2);
            const size_t k1 = (size_t)(t + 1) * kstep;
            const size_t k2 = last ? 0 : (size_t)(t + 2) * kstep, k3 = k2 + kstep;
            const char* b2 = last ? nB : cB + (size_t)(t + 2) * kstep; const char* b3 = b2 + kstep;
            PG8_LDB(B0, 0, 0); PG8_LDB(B1, 0, 1); PG8_SCHED; PG8_LDA(At, 0, 0); PG8_STAGE_A(PG8_SA(1, 1), 1, false, k1);
            PG8_WAIT_V(8); PG8_WAIT_L(0); PG8_BAR; PG8_MMA(0, 0, At, B0); PG8_MMA(0, 1, At, B1); PG8_BAR; PG8_SCHED;
            if (full) PG8_LDA(At, 0, 1); PG8_STAGE(PG8_SB(0, 0), b2, voffB); PG8_STAGE(PG8_SB(0, 1), b2 + hstep, voffB); PG8_STAGE_A(PG8_SA(0, 0), 0, last, k2);
            PG8_WAIT_V(8); PG8_WAIT_L(0); PG8_BAR; if (full) { PG8_MMA(1, 0, At, B0); PG8_MMA(1, 1, At, B1); } PG8_BAR; PG8_SCHED;
            PG8_LDB(B0, 1, 0); PG8_LDB(B1, 1, 1); PG8_SCHED; PG8_LDA(At, 1, 0); PG8_STAGE_A(PG8_SA(0, 1), 1, last, k2);
            PG8_WAIT_V(8); PG8_WAIT_L(0); PG8_BAR; PG8_MMA(0, 0, At, B0); PG8_MMA(0, 1, At, B1); PG8_BAR; PG8_SCHED;
            if (full) PG8_LDA(At, 1, 1); PG8_STAGE(PG8_SB(1, 0), b3, voffB); PG8_STAGE(PG8_SB(1, 1), b3 + hstep, voffB); PG8_STAGE_A(PG8_SA(1, 0), 0, last, k3);
            PG8_WAIT_V(8); PG8_WAIT_L(0); PG8_BAR; if (full) { PG8_MMA(1, 0, At, B0); PG8_MMA(1, 1, At, B1); } PG8_BAR; PG8_SCHED;
        }
        if (wr == 0) PG8_BAR;
        E(acc, cur, wr, wc, fr, fq);
        if (!has_next) break;
#pragma unroll
        for (int a = 0; a < 2; ++a)
#pragma unroll
            for (int b = 0; b < 2; ++b)
#pragma unroll
                for (int m = 0; m < 4; ++m)
#pragma unroll
                    for (int n = 0; n < 2; ++n) acc[a][b][m][n] = (f32x4){0.f, 0.f, 0.f, 0.f};
        cur = nxt; cA = nA; cB = nB; ++ui;
        if constexpr (GATHER) {
#pragma unroll
            for (int h = 0; h < 2; ++h)
#pragma unroll
                for (int i = 0; i < 2; ++i) vA[h][i] = nvA[h][i];
        }
        if (wr == 1) PG8_BAR;
    }
    PG8_WAIT_V(0);
    PG8_BAR;
#undef PG8_SA
#undef PG8_SB
#undef PG8_STAGE
#undef PG8_STAGE_A
#undef PG8_LDA
#undef PG8_LDB
#undef PG8_MMA
#undef PG8_WAIT_V
#undef PG8_WAIT_L
#undef PG8_BAR
#undef PG8_SCHED
}
}

namespace pg8 {
__device__ __forceinline__ void row_bt(int row, int& b, int& tok) { if (row < TX) { b = row >> 11; tok = row & 2047; } else { const int r = row - TX; b = r >> 8; tok = SEQ + (r & 255); } }

struct EpiAttnIn {
    static constexpr bool PERM = true;
    bf16* QKV; bf16* VAT; bf16* VBT; const LAS float* rope;
    __device__ __forceinline__ void operator()(const f32x4 (&acc)[2][2][4][2], const Unit& u, int wr, int wc, int fr, int fq) const {
        const int row0 = u.pm * BM + u.roff + wr * 64 + fr; const int seg = u.pn >> 1;
        const bool latent = u.pm < (TX / BM);
        if (seg == 2 || seg == 5) {
#pragma unroll
            for (int ai = 0; ai < 2; ++ai) if (ai < u.nai)
#pragma unroll
                for (int m = 0; m < 4; ++m) { const int row = row0 + ai * HALF + m * 16; int b, tok; row_bt(row, b, tok);
#pragma unroll
                    for (int bj = 0; bj < 2; ++bj) { const int col = u.pn * BM + bj * HALF + wc * 32 + 8 * fq;
                        bf16* dst;
                        if (seg == 2) { const int cs = col - 1024; dst = VAT + ((size_t)(b * 4 + (cs >> 7)) * 128 + (cs & 127)) * NKEY + tok; }
                        else { const int cs = col - 2560; dst = VBT + ((size_t)(b * 8 + (cs >> 6)) * 64 + (cs & 63)) * NKEY + tok; }
#pragma unroll
                        for (int n = 0; n < 2; ++n)
#pragma unroll
                            for (int i = 0; i < 4; ++i) dst[(size_t)(4 * n + i) * NKEY] = (bf16)f2bf(acc[ai][bj][m][n][i]); } }
            return;
        }
        const bool dorope = latent && seg < 2;
        const float qs = (seg == 0 || seg == 3) ? 0.125f * LOG2E : 1.0f;
#pragma unroll
        for (int ai = 0; ai < 2; ++ai) if (ai < u.nai)
#pragma unroll
            for (int m = 0; m < 4; ++m) { const int row = row0 + ai * HALF + m * 16;
                f32x4 cs4[4];
                if (dorope) { const int t = row & 2047; const int pos = (wc & 1) ? (t & 63) : (t >> 6);
                    const LAS f32x4* rp = (const LAS f32x4*)(rope + (pos * 16 + 8 * (fq & 1)) * 2);
#pragma unroll
                    for (int j = 0; j < 4; ++j) cs4[j] = rp[j]; }
#pragma unroll
                for (int bj = 0; bj < 2; ++bj) { const int col = u.pn * BM + bj * HALF + wc * 32 + 8 * fq;
                    float v[8];
#pragma unroll
                    for (int n = 0; n < 2; ++n)
#pragma unroll
                        for (int i = 0; i < 4; ++i) v[4 * n + i] = acc[ai][bj][m][n][i];
                    if (dorope) {
#pragma unroll
                        for (int j = 0; j < 8; ++j) { const float other = __shfl_xor(v[j], 32); const float c = cs4[j >> 1][(j & 1) * 2], s = cs4[j >> 1][(j & 1) * 2 + 1];
                            v[j] = (fq < 2) ? (v[j] * c - other * s) : (v[j] * c + other * s); } }
                    u32x4 w; w.x = pk2(v[0] * qs, v[1] * qs); w.y = pk2(v[2] * qs, v[3] * qs); w.z = pk2(v[4] * qs, v[5] * qs); w.w = pk2(v[6] * qs, v[7] * qs);
                    *(u32x4*)(QKV + (size_t)row * NATT + col) = w; } }
    }
};
struct EpiGlaIn {
    static constexpr bool PERM = true;
    bf16* QKV2; bf16* VGT;
    __device__ __forceinline__ void operator()(const f32x4 (&acc)[2][2][4][2], const Unit& u, int wr, int wc, int fr, int fq) const {
        const int row0 = u.pm * BM + u.roff + wr * 64 + fr;
        if (u.pn >= 4 && u.pn < 8) {
#pragma unroll
            for (int ai = 0; ai < 2; ++ai) if (ai < u.nai)
#pragma unroll
                for (int m = 0; m < 4; ++m) { const int row = row0 + ai * HALF + m * 16; int b, tok; row_bt(row, b, tok);
#pragma unroll
                    for (int bj = 0; bj < 2; ++bj) { const int cs = u.pn * BM + bj * HALF + wc * 32 + 8 * fq - 1024;
                        bf16* dst = VGT + ((size_t)(b * 4 + (cs >> 8)) * 256 + (cs & 255)) * NKEY + tok;
#pragma unroll
                        for (int n = 0; n < 2; ++n)
#pragma unroll
                            for (int i = 0; i < 4; ++i) dst[(size_t)(4 * n + i) * NKEY] = (bf16)f2bf(acc[ai][bj][m][n][i]); } }
            return;
        }
        const float qs = (u.pn < 2) ? 0.08838834764831845f : 1.0f;
#pragma unroll
        for (int ai = 0; ai < 2; ++ai) if (ai < u.nai)
#pragma unroll
            for (int m = 0; m < 4; ++m) { const int row = row0 + ai * HALF + m * 16;
#pragma unroll
                for (int bj = 0; bj < 2; ++bj) { const int col = u.pn * BM + bj * HALF + wc * 32 + 8 * fq; const f32x4 a = acc[ai][bj][m][0] * qs, c = acc[ai][bj][m][1] * qs;
                    u32x4 w; w.x = pk2(a[0], a[1]); w.y = pk2(a[2], a[3]); w.z = pk2(c[0], c[1]); w.w = pk2(c[2], c[3]);
                    *(u32x4*)(QKV2 + (size_t)row * NGLA + col) = w; } }
    }
};
template <bool F32IN>
struct EpiResid {
    static constexpr bool PERM = true;
    const float* IL; const float* IC; bf16* XB; const float* modv;
    __device__ __forceinline__ void operator()(const f32x4 (&acc)[2][2][4][2], const Unit& u, int wr, int wc, int fr, int fq) const {
        const int row0 = u.pm * BM + u.roff + wr * 64 + fr, col0 = u.pn * BM + wc * 32 + 8 * fq;
        const bool latent = u.pm < (TX / BM); const int bi = latent ? (u.pm >> 3) : 8;
        const float* ibase = latent ? IL : (IC - (size_t)TX * D);
        f32x4 gv[2][2];
#pragma unroll
        for (int bj = 0; bj < 2; ++bj)
#pragma unroll
            for (int n = 0; n < 2; ++n) gv[bj][n] = *(const f32x4*)(modv + bi * 6144 + col0 + bj * HALF + 4 * n);
#pragma unroll
        for (int ai = 0; ai < 2; ++ai) if (ai < u.nai) {
            f32x4 res[4][2][2];
#pragma unroll
            for (int m = 0; m < 4; ++m) { const size_t ro = (size_t)(row0 + ai * HALF + m * 16) * D + col0;
#pragma unroll
                for (int bj = 0; bj < 2; ++bj) {
                    if constexpr (F32IN) { res[m][bj][0] = *(const f32x4*)(ibase + ro + bj * HALF); res[m][bj][1] = *(const f32x4*)(ibase + ro + bj * HALF + 4); }
                    else { const u32x4 t = *(const u32x4*)(XB + ro + bj * HALF); res[m][bj][0] = (f32x4){bflo(t.x), bfhi(t.x), bflo(t.y), bfhi(t.y)}; res[m][bj][1] = (f32x4){bflo(t.z), bfhi(t.z), bflo(t.w), bfhi(t.w)}; } } }
#pragma unroll
            for (int m = 0; m < 4; ++m) { const size_t ro = (size_t)(row0 + ai * HALF + m * 16) * D + col0;
#pragma unroll
                for (int bj = 0; bj < 2; ++bj) { const f32x4 y0 = res[m][bj][0] + gv[bj][0] * acc[ai][bj][m][0], y1 = res[m][bj][1] + gv[bj][1] * acc[ai][bj][m][1];
                    u32x4 w; w.x = pk2(y0[0], y0[1]); w.y = pk2(y0[2], y0[3]); w.z = pk2(y1[0], y1[1]); w.w = pk2(y1[2], y1[3]);
                    *(u32x4*)(XB + ro + bj * HALF) = w; } }
        }
    }
};
struct EpiMoe1 {
    static constexpr bool PERM = false;
    bf16* HB;
    __device__ __forceinline__ void operator()(const f32x4 (&acc)[2][2][4][2], const Unit& u, int wr, int wc, int fr, int fq) const {
        const int row0 = u.pm * BM + u.roff + wr * 64 + fr, col0 = u.pn * 128 + wc * 16 + 4 * fq;
#pragma unroll
        for (int ai = 0; ai < 2; ++ai) if (ai < u.nai)
#pragma unroll
            for (int m = 0; m < 4; ++m) { bf16* rowp = HB + (size_t)(row0 + ai * HALF + m * 16) * DEXP + col0;
#pragma unroll
                for (int bj = 0; bj < 2; ++bj) { const f32x4 a = acc[ai][bj][m][0], b = acc[ai][bj][m][1];
                    u32x2 w; w.x = pk2(silu_f(a[0]) * b[0], silu_f(a[1]) * b[1]); w.y = pk2(silu_f(a[2]) * b[2], silu_f(a[3]) * b[3]);
                    *(u32x2*)(rowp + bj * 64) = w; } }
    }
};
struct EpiBf16 {
    static constexpr bool PERM = true;
    bf16* O; int ldc;
    __device__ __forceinline__ void operator()(const f32x4 (&acc)[2][2][4][2], const Unit& u, int wr, int wc, int fr, int fq) const {
        const int row0 = u.pm * BM + u.roff + wr * 64 + fr, col0 = u.pn * BM + wc * 32 + 8 * fq;
#pragma unroll
        for (int ai = 0; ai < 2; ++ai) if (ai < u.nai)
#pragma unroll
            for (int m = 0; m < 4; ++m) { bf16* rowp = O + (size_t)(row0 + ai * HALF + m * 16) * ldc + col0;
#pragma unroll
                for (int bj = 0; bj < 2; ++bj) { const f32x4 a = acc[ai][bj][m][0], c = acc[ai][bj][m][1];
                    u32x4 w; w.x = pk2(a[0], a[1]); w.y = pk2(a[2], a[3]); w.z = pk2(c[0], c[1]); w.w = pk2(c[2], c[3]);
                    *(u32x4*)(rowp + bj * HALF) = w; } }
    }
};
}

struct Args {
    const float *x, *c, *ctx, *c_ctx, *w_mod, *b_mod, *norm_g, *final_g, *att_w_in, *att_w_out, *att_lambda, *att_subln_g, *na_bias,
                *gla_w_in, *gla_w_gate, *gla_b_gate, *gla_norm_g, *gla_w_out, *router_w, *router_bias, *moe_w1, *moe_w3, *moe_w2;
    float* out; unsigned char* ws; int ph_lo, ph_hi, rep, pad;
};

struct RowMapId { int off; __device__ __forceinline__ int operator()(int n) const { return off + n; } };
struct RowMapMoe { int which; __device__ __forceinline__ int operator()(int n) const { return 32 * (n >> 4) + 16 * which + (n & 15); } };
__device__ __forceinline__ void ti_load(float (&ld)[32], const float* W, int N, int item, int lane) {
    const int nblk = N / 32, kb = item / nblk, nb = item % nblk, k0 = 64 * kb, n0 = 32 * nb;
#pragma unroll
    for (int i = 0; i < 32; ++i) ld[i] = W[(size_t)(k0 + 2 * i + (lane >> 5)) * N + n0 + (lane & 31)];
}
template <class RM>
__device__ __forceinline__ void ti_finish(const float (&ld)[32], int K, int N, bf16* WT, LAS float* scr, int item, int lane, RM rm) {
    const int nblk = N / 32, kb = item / nblk, nb = item % nblk, k0 = 64 * kb, n0 = 32 * nb;
#pragma unroll
    for (int i = 0; i < 32; ++i) scr[(2 * i + (lane >> 5)) * 33 + (lane & 31)] = ld[i];
    LDS_WAIT(); asm volatile("" ::: "memory");
    const int c = lane & 7;
#pragma unroll
    for (int j = 0; j < 4; ++j) { const int n = (lane >> 3) + 8 * j; const LAS float* s = scr + (8 * c) * 33 + n;
        u32x4 o; o.x = pk2(s[0 * 33], s[1 * 33]); o.y = pk2(s[2 * 33], s[3 * 33]); o.z = pk2(s[4 * 33], s[5 * 33]); o.w = pk2(s[6 * 33], s[7 * 33]);
        *(u32x4*)(WT + (size_t)rm(n0 + n) * K + k0 + 8 * c) = o; }
    LDS_WAIT(); asm volatile("" ::: "memory");
}
template <class RM>
__device__ __forceinline__ void p0_transpose_item(const float* W, int K, int N, bf16* WT, LAS float* scr, int item, int lane, RM rm) {
    float ld[32]; ti_load(ld, W, N, item, lane); ti_finish(ld, K, N, WT, scr, item, lane, rm);
}

constexpr int CV_ATTIN = 1536, CV_ATTOUT = 512, CV_GLAIN = 1552, CV_GLAPAD = 28, CV_GLAOUT = 512, CV_W = 4096, CV_MOE = 3 * CV_W;
constexpr int CT_ATTN0 = CV_ATTIN + CV_ATTOUT, CT_MOE0 = CT_ATTN0 + CV_MOE, CT_GLA0 = CT_MOE0 + CV_GLAIN + CV_GLAPAD + CV_GLAOUT, CT_ATTN1 = CT_GLA0 + CV_ATTIN + CV_ATTOUT, CT_MOE1 = CT_ATTN1 + CV_MOE,
              CT_MOE2 = CT_MOE1 + CV_MOE, CT_GLA1 = CT_MOE2 + CV_GLAIN + CV_GLAPAD + CV_GLAOUT, CT_MOE3 = CT_GLA1 + CV_MOE, CV_TOTAL = CT_MOE3;
constexpr int CV_UNIT = 32;
struct ConvPtrs { const float *att_w_in, *att_w_out, *gla_w_in, *gla_w_out, *moe_w1, *moe_w3, *moe_w2; unsigned char* ws; };
struct RowMapAny { int moe, which; __device__ __forceinline__ int operator()(int n) const { return moe ? 32 * (n >> 4) + 16 * which + (n & 15) : n; } };
struct ConvDesc { const float* W; bf16* WT; int K, N, sub, kind  ; RowMapAny rm; };
__device__ __forceinline__ ConvDesc conv_decode(const ConvPtrs& P, int it, int hi) {
    ConvDesc d; d.W = nullptr; d.WT = nullptr; d.K = D; d.N = D; d.sub = 0; d.kind = 0; d.rm = RowMapAny{0, 0};
    if (it >= hi) return d;
    int kind, j, r;
    if (it < CT_ATTN0) { kind = 0; j = 0; r = it; } else if (it < CT_MOE0) { kind = 2; j = 0; r = it - CT_ATTN0; } else if (it < CT_GLA0) { kind = 1; j = 0; r = it - CT_MOE0; }
    else if (it < CT_ATTN1) { kind = 0; j = 1; r = it - CT_GLA0; } else if (it < CT_MOE1) { kind = 2; j = 1; r = it - CT_ATTN1; } else if (it < CT_MOE2) { kind = 2; j = 2; r = it - CT_MOE1; }
    else if (it < CT_GLA1) { kind = 1; j = 1; r = it - CT_MOE2; } else { kind = 2; j = 3; r = it - CT_GLA1; }
    d.kind = 1; d.sub = r;
    if (kind == 2) {
        const int which = r / CV_W, q = r % CV_W, e = q >> 8, je = j * 16 + e; d.sub = q & 255;
        if (which < 2) { d.W = (which ? P.moe_w3 : P.moe_w1) + (size_t)je * D * DEXP; d.N = DEXP; d.WT = (bf16*)(P.ws + WS_W13) + (size_t)je * D * D; d.rm.moe = 1; d.rm.which = which; }
        else { d.W = P.moe_w2 + (size_t)je * DEXP * D; d.K = DEXP; d.WT = (bf16*)(P.ws + WS_W2) + (size_t)je * D * DEXP; }
    } else if (kind == 0) {
        if (r < CV_ATTIN) { d.W = P.att_w_in + (size_t)j * D * NATT; d.N = NATT; d.WT = (bf16*)(P.ws + WS_WATTIN) + (size_t)j * NATT * D; }
        else { d.W = P.att_w_out + (size_t)j * D * D; d.WT = (bf16*)(P.ws + WS_WATTOUT) + (size_t)j * D * D; d.sub = r - CV_ATTIN; }
    } else {
        if (r < CV_GLAIN) { d.W = P.gla_w_in + (size_t)j * D * 3104; d.N = 3104; d.WT = (bf16*)(P.ws + WS_WGLAIN) + (size_t)j * NGLA * D; }
        else if (r < CV_GLAIN + CV_GLAPAD) { d.kind = 2; d.sub = (r - CV_GLAIN) * 1024; d.WT = (bf16*)(P.ws + WS_WGLAIN) + (size_t)j * NGLA * D + (size_t)3104 * D; }
        else { d.W = P.gla_w_out + (size_t)j * D * D; d.WT = (bf16*)(P.ws + WS_WGLAOUT) + (size_t)j * D * D; d.sub = r - CV_GLAIN - CV_GLAPAD; }
    }
    return d;
}
__device__ __forceinline__ void conv_load(const ConvDesc& d, float (&ld)[32], int lane) { if (d.kind == 1) ti_load(ld, d.W, d.N, d.sub, lane); }
__device__ __forceinline__ void conv_finish(const ConvDesc& d, const float (&ld)[32], LAS float* scr, int lane) {
    if (d.kind == 1) ti_finish(ld, d.K, d.N, d.WT, scr, d.sub, lane, d.rm);
    else if (d.kind == 2) { for (int i = lane; i < 1024; i += 64) *(u32x4*)(d.WT + (size_t)(d.sub + i) * 8) = (u32x4){0u, 0u, 0u, 0u}; }
}
__device__ __forceinline__ void conv_item(const ConvPtrs& P, int it, LAS float* scr, int lane) {
    const ConvDesc d = conv_decode(P, it, it + 1); float ld[32]; conv_load(d, ld, lane); conv_finish(d, ld, scr, lane);
}
__device__ __forceinline__ void conv_static(const ConvPtrs& P, int cur, int need, LAS unsigned char* lds, int lane, int wave, int vcu, int G) {
    LAS float* scr = (LAS float*)(lds + wave * 8448);
    for (int it = cur + vcu * 8 + wave; it < need; it += G * 8) conv_item(P, it, scr, lane);
}
__device__ __forceinline__ void conv_unit(const ConvPtrs& P, int i0, int hi, LAS unsigned char* lds, int lane, int wave) {
    LAS float* scr = (LAS float*)(lds + wave * 8448);
    constexpr int NPW = CV_UNIT / 8; static_assert(NPW == 4, "four items per wave");
    const int it0 = i0 + wave * NPW;
    float la[32], lb[32];
    ConvDesc dA = conv_decode(P, it0, hi); conv_load(dA, la, lane);
    ConvDesc dB = conv_decode(P, it0 + 1, hi); conv_load(dB, lb, lane);
    conv_finish(dA, la, scr, lane);
    dA = conv_decode(P, it0 + 2, hi); conv_load(dA, la, lane);
    conv_finish(dB, lb, scr, lane);
    dB = conv_decode(P, it0 + 3, hi); conv_load(dB, lb, lane);
    conv_finish(dA, la, scr, lane);
    conv_finish(dB, lb, scr, lane);
}

template <class AP> __device__ __forceinline__ void p0_prologue(const AP ap, LAS unsigned char* lds, int tid, int lane, int wave, int vcu, int G) {
    unsigned char* ws = ap->ws;
    LAS float* S9 = (LAS float*)(lds + 69632);
    LAS float* red = (LAS float*)(lds + 106496);
    { const ConvPtrs P{ap->att_w_in, ap->att_w_out, ap->gla_w_in, ap->gla_w_out, ap->moe_w1, ap->moe_w3, ap->moe_w2, ws};
      conv_static(P, 0, MK_CONVQ ? CT_ATTN0 : CV_TOTAL, lds, lane, wave, vcu, G); }
    __syncthreads();
    { const float* cc = ap->c; const float* cx = ap->c_ctx;
      for (int i = tid; i < 9 * 1024; i += 512) { const int bi = i >> 10, k = i & 1023; const float v = (bi < 8) ? cc[bi * D + k] : cx[k]; S9[i] = v / (1.0f + __expf(-v)); } }
    __syncthreads();
    const float* w_mod = ap->w_mod; const float* b_mod = ap->b_mod;
    for (int u = vcu; u < 4 * 96; u += G) {
        const int L = u / 96, n0 = (u % 96) * 64;
        const float* W = w_mod + (size_t)L * D * 6144 + n0 + lane;
        float acc[9];
#pragma unroll
        for (int bi = 0; bi < 9; ++bi) acc[bi] = 0.f;
        const int kb = wave * 128;
        for (int k0 = 0; k0 < 128; k0 += 32) { float wv[32];
#pragma unroll
            for (int k = 0; k < 32; ++k) wv[k] = W[(size_t)(kb + k0 + k) * 6144];
#pragma unroll
            for (int k = 0; k < 32; ++k)
#pragma unroll
                for (int bi = 0; bi < 9; ++bi) acc[bi] += S9[bi * 1024 + kb + k0 + k] * wv[k]; }
#pragma unroll
        for (int bi = 0; bi < 9; ++bi) red[(wave * 9 + bi) * 64 + lane] = acc[bi];
        __syncthreads();
        for (int i = tid; i < 9 * 64; i += 512) { const int bi = i >> 6, l = i & 63; float sm = b_mod[L * 6144 + n0 + l];
#pragma unroll
            for (int w = 0; w < 8; ++w) sm += red[(w * 9 + bi) * 64 + l];
            ((float*)(ws + WS_MODV))[(size_t)(L * 9 + bi) * 6144 + n0 + l] = sm; }
        __syncthreads();
    }
}

__device__ __forceinline__ float* xrow_ptr(float* XL, float* XC, int row) { return row < TX ? XL + (size_t)row * D : XC + (size_t)(row - TX) * D; }
__device__ __forceinline__ int row_bi(int row) { return row < TX ? (row >> 11) : 8; }

__device__ __forceinline__ void norm_mod_store(const f32x4 (&v)[4], const float* g, const float* sh, const float* sc, bf16* orow, int lane) {
    float ss = 0.f;
#pragma unroll
    for (int j = 0; j < 4; ++j) ss += (v[j].x * v[j].x + v[j].y * v[j].y) + (v[j].z * v[j].z + v[j].w * v[j].w);
    const float rs = __builtin_amdgcn_rsqf(wave_sum(ss) * (1.0f / D) + EPSF);
#pragma unroll
    for (int j = 0; j < 4; ++j) { const int c = 4 * lane + 256 * j; const f32x4 gg = *(const f32x4*)(g + c), s1 = *(const f32x4*)(sc + c), s0 = *(const f32x4*)(sh + c);
        const f32x4 y = (v[j] * rs) * gg * (1.0f + s1) + s0;
        u32x2 w; w.x = pk2(y.x, y.y); w.y = pk2(y.z, y.w); *(u32x2*)(orow + c) = w; }
}

constexpr int TROWS = 9;
__device__ __forceinline__ int thin_row(int vcu, int wave, int i) { return vcu * 8 + wave + 2048 * i; }

struct N1Row { f32x4 x[4], s0[4], s1[4]; };
__device__ __forceinline__ void n1_issue(N1Row& r, const float* XL, const float* XC, const float* modv, int row, int lane) {
    const f32x4* xr = (const f32x4*)(row < TX ? XL + (size_t)row * D : XC + (size_t)(row - TX) * D) + lane; const float* mv = modv + row_bi(row) * 6144;
#pragma unroll
    for (int j = 0; j < 4; ++j) { r.x[j] = xr[64 * j]; r.s0[j] = *(const f32x4*)(mv + 4 * lane + 256 * j); r.s1[j] = *(const f32x4*)(mv + 1024 + 4 * lane + 256 * j); }
}
__device__ __forceinline__ void n1_finish(const N1Row& r, const f32x4 (&gg)[4], bf16* orow, int lane) {
    float ss = 0.f;
#pragma unroll
    for (int j = 0; j < 4; ++j) ss += (r.x[j].x * r.x[j].x + r.x[j].y * r.x[j].y) + (r.x[j].z * r.x[j].z + r.x[j].w * r.x[j].w);
    const float rs = __builtin_amdgcn_rsqf(wave_sum(ss) * (1.0f / D) + EPSF);
#pragma unroll
    for (int j = 0; j < 4; ++j) { const f32x4 y = (r.x[j] * rs) * gg[j] * (1.0f + r.s1[j]) + r.s0[j];
        u32x2 w; w.x = pk2(y.x, y.y); w.y = pk2(y.z, y.w); *(u32x2*)(orow + 4 * lane + 256 * j) = w; }
}
__device__ __forceinline__ void phase_norm1(const float* XL, const float* XC, const float* g, const float* modv, bf16* H, int nrows, int lane, int wave, int vcu, int G) {
    f32x4 gg[4];
#pragma unroll
    for (int j = 0; j < 4; ++j) gg[j] = *(const f32x4*)(g + 4 * lane + 256 * j);
    N1Row ra, rb;
    n1_issue(ra, XL, XC, modv, thin_row(vcu, wave, 0), lane);
#pragma unroll
    for (int i = 0; i < TROWS; ++i) {
        const int row = thin_row(vcu, wave, i), rown = thin_row(vcu, wave, i + 1);
        if (i + 1 < TROWS) n1_issue((i & 1) ? ra : rb, XL, XC, modv, rown < nrows ? rown : row, lane);
        if (row < nrows) n1_finish((i & 1) ? rb : ra, gg, H + (size_t)row * D, lane);
    }
}

__device__ __forceinline__ void phase_router(const bf16* XB, const float* g, const float* modv, bf16* H, const float* router_w, const float* router_bias,
                                             unsigned* cnt  , int* list, int* toki, float* tokw, int nrows,
                                             LAS unsigned char* lds, int tid, int lane, int wave, int vcu, int G, int probe) {
    LAS float* RW = (LAS float*)lds;
    LAS int* lcnt = (LAS int*)(lds + 65536);
    LAS int* rinfo = (LAS int*)(lds + 65536 + 256);
    for (int it = 0; it < 8; ++it) { const int idx = tid + 512 * it, k = idx >> 2, q = idx & 3; const f32x4 w = *(const f32x4*)(router_w + k * 16 + 4 * q);
        RW[(4 * q + 0) * 1024 + k] = w.x; RW[(4 * q + 1) * 1024 + k] = w.y; RW[(4 * q + 2) * 1024 + k] = w.z; RW[(4 * q + 3) * 1024 + k] = w.w; }
    if (tid < 32) lcnt[tid] = 0;
    __syncthreads();
    const int rpb = nrows / G, rpw = rpb / 8;
    const int gI = lane >> 4;
    const f32x4 rb = *(const f32x4*)(router_bias + 4 * gI);
    f32x4 gg[4];
#pragma unroll
    for (int j = 0; j < 4; ++j) gg[j] = *(const f32x4*)(g + 4 * lane + 256 * j);
    const int rowbase = vcu * rpb + wave * rpw;
    u32x2 xa[3][4], xb[3][4];
#pragma unroll
    for (int r = 0; r < 3; ++r) { const bf16* xr = XB + (size_t)(rowbase + (r < rpw ? r : rpw - 1)) * D + 4 * lane;
#pragma unroll
        for (int j = 0; j < 4; ++j) xa[r][j] = *(const u32x2*)(xr + 256 * j); }
#pragma unroll
    for (int bt = 0; bt < 3; ++bt) {
        const int i0 = 3 * bt;
        asm volatile("" ::: "memory");
        u32x2 (&xc)[3][4] = (bt & 1) ? xb : xa; u32x2 (&xn)[3][4] = (bt & 1) ? xa : xb; f32x4 y[3][4];
        f32x4 s0v[3][4], s1v[3][4];
#pragma unroll
        for (int r = 0; r < 3; ++r) { const int ii = (i0 + r < rpw) ? i0 + r : rpw - 1; const float* mv = modv + row_bi(rowbase + ii) * 6144 + 3072;
#pragma unroll
            for (int j = 0; j < 4; ++j) { const int c = 4 * lane + 256 * j; s0v[r][j] = *(const f32x4*)(mv + c); s1v[r][j] = *(const f32x4*)(mv + 1024 + c); } }
        if (bt + 1 < 3) {
#pragma unroll
            for (int r = 0; r < 3; ++r) { const int ii = (i0 + 3 + r < rpw) ? i0 + 3 + r : rpw - 1; const bf16* xr = XB + (size_t)(rowbase + ii) * D + 4 * lane;
#pragma unroll
                for (int j = 0; j < 4; ++j) xn[r][j] = *(const u32x2*)(xr + 256 * j); } }
#pragma unroll
        for (int r = 0; r < 3; ++r) {
            const int ii = (i0 + r < rpw) ? i0 + r : rpw - 1; const int row = rowbase + ii;
            float ss = 0.f;
#pragma unroll
            for (int j = 0; j < 4; ++j) { const u32x2 t = xc[r][j]; y[r][j] = (f32x4){bflo(t.x), bfhi(t.x), bflo(t.y), bfhi(t.y)};
                ss += (y[r][j].x * y[r][j].x + y[r][j].y * y[r][j].y) + (y[r][j].z * y[r][j].z + y[r][j].w * y[r][j].w); }
            const float rs = __builtin_amdgcn_rsqf(wave_sum(ss) * (1.0f / D) + EPSF);
#pragma unroll
            for (int j = 0; j < 4; ++j) { const int c = 4 * lane + 256 * j;
                y[r][j] = (y[r][j] * rs) * gg[j] * (1.0f + s1v[r][j]) + s0v[r][j];
                u32x2 w; w.x = cvtpk(y[r][j].x, y[r][j].y); w.y = cvtpk(y[r][j].z, y[r][j].w); *(u32x2*)(H + (size_t)row * D + c) = w; }
        }
        float p[3][16];
#pragma unroll
        for (int e = 0; e < 16; ++e) {
#pragma unroll
            for (int r = 0; r < 3; ++r) p[r][e] = 0.f;
#pragma unroll
            for (int j = 0; j < 4; ++j) { const f32x4 w = *(const LAS f32x4*)(RW + e * 1024 + 4 * lane + 256 * j);
#pragma unroll
                for (int r = 0; r < 3; ++r) p[r][e] += (y[r][j].x * w.x + y[r][j].y * w.y) + (y[r][j].z * w.z + y[r][j].w * w.w); }
#pragma unroll
            for (int r = 0; r < 3; ++r) asm volatile("" : "+v"(p[r][e])); }
#pragma unroll
        for (int r = 0; r < 3; ++r) {
            float q8[8], lg[4];
#pragma unroll
            for (int j = 0; j < 8; ++j) q8[j] = swap32_add(p[r][j], p[r][j + 8]);
#pragma unroll
            for (int j = 0; j < 4; ++j) lg[j] = row_sum(swap16_add(q8[j], q8[j + 4]));
            float sc[4], sel[4];
#pragma unroll
            for (int j = 0; j < 4; ++j) { sc[j] = 1.0f / (1.0f + __expf(-lg[j])); sel[j] = sc[j] + rb[j]; }
            int i1 = 0, i2 = 0; float m1 = -1e30f, m2 = -1e30f, w1 = 0.f, w2 = 0.f;
#pragma unroll
            for (int j = 0; j < 4; ++j) { const float t = sel[j];
                if (t > m1) { m2 = m1; i2 = i1; w2 = w1; m1 = t; i1 = j; w1 = sc[j]; } else if (t > m2) { m2 = t; i2 = j; w2 = sc[j]; } }
            const float gs = m1 + m2;
            const float g0 = readlane_f(gs, 0), g1 = readlane_f(gs, 16), g2 = readlane_f(gs, 32), g3 = readlane_f(gs, 48);
            int bg = 0; float bgs = g0; if (g1 > bgs) { bgs = g1; bg = 1; } if (g2 > bgs) { bgs = g2; bg = 2; } if (g3 > bgs) { bgs = g3; bg = 3; }
            bg = __builtin_amdgcn_readfirstlane(bg);
            const int e0 = 4 * bg + __builtin_amdgcn_readlane(i1, 16 * bg), e1 = 4 * bg + __builtin_amdgcn_readlane(i2, 16 * bg);
            const float w0 = readlane_f(w1, 16 * bg), w1s = readlane_f(w2, 16 * bg);
            const float wn = 1.0f / (w0 + w1s);
            if (lane == 0 && i0 + r < rpw) { const int rl = wave * rpw + i0 + r;
                const int p0 = __hip_atomic_fetch_add(&lcnt[e0], 1, __ATOMIC_RELAXED, __HIP_MEMORY_SCOPE_WORKGROUP), p1 = __hip_atomic_fetch_add(&lcnt[e1], 1, __ATOMIC_RELAXED, __HIP_MEMORY_SCOPE_WORKGROUP);
                rinfo[rl * 6 + 0] = e0; rinfo[rl * 6 + 1] = p0; rinfo[rl * 6 + 2] = e1; rinfo[rl * 6 + 3] = p1;
                rinfo[rl * 6 + 4] = __builtin_bit_cast(int, w0 * wn); rinfo[rl * 6 + 5] = __builtin_bit_cast(int, w1s * wn); }
        }
    }
    __syncthreads();
    if (tid < 16) lcnt[16 + tid] = (int)__hip_atomic_fetch_add(cnt + 64 * tid, (unsigned)lcnt[tid], RLX_AGENT);
    __syncthreads();
    if (tid < rpb) { const int row = vcu * rpb + tid; const int e0 = rinfo[tid * 6 + 0], e1 = rinfo[tid * 6 + 2];
        const int p0 = lcnt[16 + e0] + rinfo[tid * 6 + 1], p1 = lcnt[16 + e1] + rinfo[tid * 6 + 3];
        list[(size_t)e0 * TALL + p0] = row; list[(size_t)e1 * TALL + p1] = row;
        toki[row * 4 + 0] = e0; toki[row * 4 + 1] = p0; toki[row * 4 + 2] = e1; toki[row * 4 + 3] = p1;
        tokw[row * 2 + 0] = __builtin_bit_cast(float, rinfo[tid * 6 + 4]); tokw[row * 2 + 1] = __builtin_bit_cast(float, rinfo[tid * 6 + 5]); }
    __syncthreads();
}

__device__ __forceinline__ int build_moe_table(const unsigned* cnt, LAS int* tab, int tid) {
    if (tid < 16) tab[RT_MAX + 1 + tid] = (int)__hip_atomic_load(cnt + 64 * tid, RLX_AGENT);
    __syncthreads();
    if (tid == 0) { int rt = 0;
        for (int e = 0; e < 16; ++e) { const int c = tab[RT_MAX + 1 + e]; const int nt = (c + 255) >> 8;
            for (int m = 0; m < nt; ++m) { if (rt < RT_MAX) tab[rt] = e | (m << 8); ++rt; } }
        tab[RT_MAX] = rt < RT_MAX ? rt : RT_MAX; }
    __syncthreads();
    return tab[RT_MAX];
}

struct CbTok { int e0, p0, e1, p1; float w0, w1; };
struct CbRow { f32x4 g2[4], s0[4], s1[4]; u32x2 x[4], ya[4], yb[4]; };
__device__ __forceinline__ void cb_tok(CbTok& t, const int* toki, const float* tokw, int row) {
    const int4 q = *(const int4*)(toki + row * 4); const float2 w = *(const float2*)(tokw + row * 2); t.e0 = q.x; t.p0 = q.y; t.e1 = q.z; t.p1 = q.w; t.w0 = w.x; t.w1 = w.y;
}
template <bool FINAL>
__device__ __forceinline__ void cb_issue(CbRow& r, const CbTok& t, int mybase, const bf16* XB, const float* modv, const float* modv_next, const bf16* YB, int row, int lane) {
    const int s0 = __shfl(mybase, t.e0) + t.p0, s1 = __shfl(mybase, t.e1) + t.p1;
    const bf16* xp = XB + (size_t)row * D; const int bi = row_bi(row); const float* g2 = modv + bi * 6144 + 5120; const float* mv = modv_next + bi * 6144;
#pragma unroll
    for (int j = 0; j < 4; ++j) { const int c = 4 * lane + 256 * j;
        r.ya[j] = *(const u32x2*)(YB + (size_t)s0 * D + c); r.yb[j] = *(const u32x2*)(YB + (size_t)s1 * D + c);
        r.x[j] = *(const u32x2*)(xp + c); r.g2[j] = *(const f32x4*)(g2 + c);
        if constexpr (!FINAL) { r.s0[j] = *(const f32x4*)(mv + c); r.s1[j] = *(const f32x4*)(mv + 1024 + c); } }
}
template <bool FINAL>
__device__ __forceinline__ void cb_finish(const CbRow& r, const CbTok& t, const f32x4 (&gn)[4], bf16* xp, float* orow, bf16* hrow, int lane) {
    f32x4 v[4]; float ss = 0.f;
#pragma unroll
    for (int j = 0; j < 4; ++j) { const u32x2 a = r.ya[j], b = r.yb[j]; const float w0 = t.w0, w1 = t.w1;
        f32x4 y; y.x = w0 * bflo(a.x) + w1 * bflo(b.x); y.y = w0 * bfhi(a.x) + w1 * bfhi(b.x); y.z = w0 * bflo(a.y) + w1 * bflo(b.y); y.w = w0 * bfhi(a.y) + w1 * bfhi(b.y);
        const u32x2 xt = r.x[j]; v[j] = (f32x4){bflo(xt.x), bfhi(xt.x), bflo(xt.y), bfhi(xt.y)} + r.g2[j] * y;
        ss += (v[j].x * v[j].x + v[j].y * v[j].y) + (v[j].z * v[j].z + v[j].w * v[j].w); }
    const float rs = __builtin_amdgcn_rsqf(wave_sum(ss) * (1.0f / D) + EPSF);
#pragma unroll
    for (int j = 0; j < 4; ++j) { const int c = 4 * lane + 256 * j;
        if constexpr (FINAL) *(f32x4*)(orow + c) = (v[j] * rs) * gn[j];
        else { u32x2 xw; xw.x = pk2(v[j].x, v[j].y); xw.y = pk2(v[j].z, v[j].w); *(u32x2*)(xp + c) = xw;
            const f32x4 y = (v[j] * rs) * gn[j] * (1.0f + r.s1[j]) + r.s0[j];
            u32x2 w; w.x = pk2(y.x, y.y); w.y = pk2(y.z, y.w); *(u32x2*)(hrow + c) = w; } }
}
template <bool FINAL>
__device__ __forceinline__ void phase_combine(bf16* XB, float* OUT, const float* modv  , const bf16* YB, const unsigned* cnt, const int* toki, const float* tokw,
                                              const float* gnext, const float* modv_next, bf16* H, int nrows, int lane, int wave, int vcu, int G) {
    int tiles = 0; if (lane < 16) tiles = ((int)__hip_atomic_load(cnt + 64 * lane, RLX_AGENT) + 255) >> 8;
    int incl = tiles;
#pragma unroll
    for (int o = 1; o < 16; o <<= 1) { const int t = __shfl_up(incl, o); if (lane >= o) incl += t; }
    const int mybase = (incl - tiles) * 256;
    f32x4 gn[4];
#pragma unroll
    for (int j = 0; j < 4; ++j) gn[j] = *(const f32x4*)(gnext + 4 * lane + 256 * j);
    CbTok ta, tb, tc; CbRow ra, rb;
    cb_tok(ta, toki, tokw, thin_row(vcu, wave, 0)); cb_tok(tb, toki, tokw, thin_row(vcu, wave, 1));
    cb_issue<FINAL>(ra, ta, mybase, XB, modv, modv_next, YB, thin_row(vcu, wave, 0), lane);
#pragma unroll
    for (int i = 0; i < TROWS; ++i) {
        const int row = thin_row(vcu, wave, i), row1 = thin_row(vcu, wave, i + 1), row2 = thin_row(vcu, wave, i + 2);
        CbTok& tcur = (i % 3 == 0) ? ta : (i % 3 == 1) ? tb : tc; CbTok& tnx = (i % 3 == 0) ? tb : (i % 3 == 1) ? tc : ta; CbTok& tn2 = (i % 3 == 0) ? tc : (i % 3 == 1) ? ta : tb;
        if (i + 2 < TROWS) cb_tok(tn2, toki, tokw, row2 < nrows ? row2 : row);
        if (i + 1 < TROWS) cb_issue<FINAL>((i & 1) ? ra : rb, tnx, mybase, XB, modv, modv_next, YB, row1 < nrows ? row1 : row, lane);
        if (row < nrows) cb_finish<FINAL>((i & 1) ? rb : ra, tcur, gn, XB + (size_t)row * D, OUT + (size_t)row * D, H + (size_t)row * D, lane);
    }
}

struct RoRow { u32x2 a[4], b[4], gt[4]; };
__device__ __forceinline__ void ro_issue(RoRow& r, const bf16* OF, const bf16* OB, const bf16* QKV2, int row, int lane) {
#pragma unroll
    for (int j = 0; j < 4; ++j) { const int c = 4 * lane + 256 * j;
        r.a[j] = *(const u32x2*)(OF + (size_t)row * D + c); r.b[j] = *(const u32x2*)(OB + (size_t)row * D + c); r.gt[j] = *(const u32x2*)(QKV2 + (size_t)row * NGLA + 2048 + c); }
}
__device__ __forceinline__ void ro_finish(const RoRow& r, const f32x4 gg, bf16* orow, int lane) {
#pragma unroll
    for (int j = 0; j < 4; ++j) { const u32x2 a = r.a[j], b = r.b[j], gt = r.gt[j];
        f32x4 o; o.x = bflo(a.x) + bflo(b.x); o.y = bfhi(a.x) + bfhi(b.x); o.z = bflo(a.y) + bflo(b.y); o.w = bfhi(a.y) + bfhi(b.y);
        const float ss = wave_sum((o.x * o.x + o.y * o.y) + (o.z * o.z + o.w * o.w));
        const float rs = __builtin_amdgcn_rsqf(ss * (1.0f / 256.0f) + EPSF);
        f32x4 gv; gv.x = silu_f(bflo(gt.x)); gv.y = silu_f(bfhi(gt.x)); gv.z = silu_f(bflo(gt.y)); gv.w = silu_f(bfhi(gt.y));
        const f32x4 y = (o * rs) * gg * gv;
        u32x2 w; w.x = pk2(y.x, y.y); w.y = pk2(y.z, y.w); *(u32x2*)(orow + 4 * lane + 256 * j) = w; }
}
__device__ __forceinline__ void phase_readout(const bf16* OF, const bf16* OB, const bf16* QKV2, const float* ng, bf16* AOUT, int nrows, int lane, int wave, int vcu, int G) {
    const f32x4 gg = *(const f32x4*)(ng + 4 * lane);
    RoRow ra, rb, rc;
    ro_issue(ra, OF, OB, QKV2, thin_row(vcu, wave, 0), lane); ro_issue(rb, OF, OB, QKV2, thin_row(vcu, wave, 1), lane);
#pragma unroll
    for (int i = 0; i < TROWS; ++i) {
        const int row = thin_row(vcu, wave, i), row2 = thin_row(vcu, wave, i + 2);
        RoRow& cur = (i % 3 == 0) ? ra : (i % 3 == 1) ? rb : rc; RoRow& n2 = (i % 3 == 0) ? rc : (i % 3 == 1) ? ra : rb;
        if (i + 2 < TROWS) ro_issue(n2, OF, OB, QKV2, row2 < nrows ? row2 : row, lane);
        if (row < nrows) ro_finish(cur, gg, AOUT + (size_t)row * D, lane);
    }
}

__device__ __forceinline__ int na_r0(int r) { int v = r - 4; return v < 0 ? 0 : (v > 24 ? 24 : v); }
template <int NMAPS, int DV, bool NA>
__device__ __forceinline__ void attn_unit(LAS unsigned char* lds, int tid, int lane, int wave,
                                          const bf16* QKV, int qcol, int qrow0, int kcol, int krow_lat, int krow_ctx, const bf16* VT, int klo, int khi,
                                          int r_wave, int xq0, const LAS float* biasT,
                                          bf16* AOUT, int ocol, float lam, const float* subg, float outscale) {
    constexpr int KB = 9216;
    constexpr int BUFSZ = NMAPS * KB + DV * 144;
    constexpr int NVB = DV / 16, NVR = DV / 64;
    const int fr = lane & 15, g = lane >> 4;
    bf16x8 qf[NMAPS][2];
    { const bf16* qp = QKV + (size_t)(qrow0 + wave * 16 + fr) * NATT + qcol + 8 * g;
#pragma unroll
      for (int m = 0; m < NMAPS; ++m)
#pragma unroll
          for (int s = 0; s < 2; ++s) qf[m][s] = *(const bf16x8*)(qp + m * 64 + 32 * s); }
    f32x4 O[NMAPS][NVB]; float mrun[NMAPS]; float lrun[NMAPS];
#pragma unroll
    for (int m = 0; m < NMAPS; ++m) { mrun[m] = -1e30f; lrun[m] = 0.f;
#pragma unroll
        for (int vb = 0; vb < NVB; ++vb) O[m][vb] = (f32x4){0.f, 0.f, 0.f, 0.f}; }
    const int ntiles = 4 + (khi - klo);
    u32x4 kreg[NMAPS], vreg[NVR];
    const int lkey = tid >> 3, lch = tid & 7;
#define AT_LOAD(i) do { const int _i = (i); const int _rowg = (_i < 4 ? krow_ctx + 64 * _i : krow_lat + 64 * (klo + _i - 4)) + lkey; const int _tok0 = (_i < 4 ? SEQ + 64 * _i : 64 * (klo + _i - 4)); \
        _Pragma("unroll") for (int m = 0; m < NMAPS; ++m) kreg[m] = *(const u32x4*)(QKV + (size_t)_rowg * NATT + kcol + m * 64 + lch * 8); \
        _Pragma("unroll") for (int j = 0; j < NVR; ++j) { const int idx = tid + 512 * j; vreg[j] = *(const u32x4*)(VT + (size_t)(idx >> 3) * NKEY + _tok0 + (idx & 7) * 8); } } while (0)
#define AT_STORE(b) do { LAS unsigned char* _p = lds + (b) * BUFSZ; \
        _Pragma("unroll") for (int m = 0; m < NMAPS; ++m) *(LAS u32x4*)(_p + m * KB + lkey * 144 + lch * 16) = kreg[m]; \
        _Pragma("unroll") for (int j = 0; j < NVR; ++j) { const int idx = tid + 512 * j; *(LAS u32x4*)(_p + NMAPS * KB + (idx >> 3) * 144 + (idx & 7) * 16) = vreg[j]; } } while (0)
    AT_LOAD(0); AT_STORE(0); __syncthreads();
    const int kbase0 = (8 * (fr >> 2) + (fr & 3)) * 144 + 16 * g;
    const int vbase = fr * 144 + 16 * g;
    int r0w = 0, xq = 0, tmask = 3, c0w = 0; float pen[4][4];
    if constexpr (NA) { r0w = na_r0(r_wave); xq = xq0 + fr; int cs = xq - 8; cs = cs < 0 ? 0 : (cs > 48 ? 48 : cs);
        c0w = xq0 - 8; c0w = c0w < 0 ? 0 : (c0w > 32 ? 32 : c0w);
        tmask = 1;
#pragma unroll
        for (int kb = 0; kb < 4; ++kb)
#pragma unroll
            for (int ii = 0; ii < 4; ++ii) { const int y = c0w + 32 * (kb >> 1) + 8 * g + 4 * (kb & 1) + ii; pen[kb][ii] = (y >= cs && y < cs + 16) ? 0.f : -1e30f; } }
    for (int i = 0; i < ntiles; ++i) {
        if (i + 1 < ntiles) AT_LOAD(i + 1);
        const LAS unsigned char* buf = lds + (i & 1) * BUFSZ;
        bool active = true; int kr = 0; bool local = false;
        if constexpr (NA) { if (i >= 4) { local = true; kr = klo + i - 4; active = (kr >= r0w) && (kr < r0w + 8); } }
        if (active) {
            const int tm = local ? tmask : 3;
            const int koffw = local ? c0w * 144 : 0, voffw = local ? c0w * 2 : 0;
            bf16x8 kf[NMAPS][4][2];
#pragma unroll
            for (int m = 0; m < NMAPS; ++m)
#pragma unroll
                for (int kb = 0; kb < 4; ++kb)
#pragma unroll
                    for (int s = 0; s < 2; ++s) kf[m][kb][s] = *(const LAS bf16x8*)(buf + m * KB + kbase0 + koffw + (kb & 1) * (4 * 144) + (kb >> 1) * (32 * 144) + s * 64);
            __builtin_amdgcn_sched_barrier(0);
            f32x4 S[NMAPS][4];
#pragma unroll
            for (int m = 0; m < NMAPS; ++m)
#pragma unroll
                for (int kb = 0; kb < 4; ++kb) { S[m][kb] = (f32x4){0.f, 0.f, 0.f, 0.f};
                    if (!NA || (tm >> (kb >> 1)) & 1) {
#pragma unroll
                        for (int s = 0; s < 2; ++s) S[m][kb] = __builtin_amdgcn_mfma_f32_16x16x32_bf16(kf[m][kb][s], qf[m][s], S[m][kb], 0, 0, 0); } }
            bf16x8 vf0[4][2];
#pragma unroll
            for (int vb = 0; vb < 4; ++vb)
#pragma unroll
                for (int t = 0; t < 2; ++t) vf0[vb][t] = *(const LAS bf16x8*)(buf + NMAPS * KB + vbase + voffw + vb * (16 * 144) + t * 64);
            __builtin_amdgcn_sched_barrier(0);
            bf16x8 pf[NMAPS][2];
#pragma unroll
            for (int m = 0; m < NMAPS; ++m) {
                if constexpr (NA) { if (local) {
                        const LAS float* bp = biasT + (kr - r_wave + 7) * 31 + (c0w + 8 * g - xq + 15);
#pragma unroll
                        for (int kb = 0; kb < 4; ++kb)
#pragma unroll
                            for (int ii = 0; ii < 4; ++ii) { const float t = (tm >> (kb >> 1)) & 1 ? (S[m][kb][ii] + pen[kb][ii]) + bp[32 * (kb >> 1) + 4 * (kb & 1) + ii] : -1e30f; S[m][kb][ii] = t; } } }
                float mx = fmaxf(fmaxf(S[m][0][0], S[m][0][1]), fmaxf(S[m][0][2], S[m][0][3]));
#pragma unroll
                for (int kb = 1; kb < 4; ++kb) mx = fmaxf(fmaxf(mx, S[m][kb][0]), fmaxf(fmaxf(S[m][kb][1], S[m][kb][2]), S[m][kb][3]));
                mx = swap32_max(swap16_max(mx));
                if (__any(mx > mrun[m] + 8.0f)) {
                    const float mnew = fmaxf(mrun[m], mx), alpha = fexp2(mrun[m] - mnew); mrun[m] = mnew; lrun[m] = lrun[m] * alpha;
#pragma unroll
                    for (int vb = 0; vb < NVB; ++vb) O[m][vb] = O[m][vb] * alpha;
                }
                const float mm = mrun[m];
                unsigned pw[8]; float l0 = 0.f, l1 = 0.f;
#pragma unroll
                for (int kb = 0; kb < 4; ++kb) { const float a0 = fexp2(S[m][kb][0] - mm), a1 = fexp2(S[m][kb][1] - mm), a2 = fexp2(S[m][kb][2] - mm), a3 = fexp2(S[m][kb][3] - mm);
                    l0 += a0 + a1; l1 += a2 + a3;
                    pw[2 * kb] = cvtpk(a0, a1); pw[2 * kb + 1] = cvtpk(a2, a3); }
                lrun[m] += l0 + l1;
                pf[m][0] = __builtin_bit_cast(bf16x8, (u32x4){pw[0], pw[1], pw[2], pw[3]});
                pf[m][1] = __builtin_bit_cast(bf16x8, (u32x4){pw[4], pw[5], pw[6], pw[7]});
            }
            __builtin_amdgcn_sched_barrier(0);
            if constexpr (NVB == 8) {
                bf16x8 vf1[4][2];
#pragma unroll
                for (int vb = 0; vb < 4; ++vb)
#pragma unroll
                    for (int t = 0; t < 2; ++t) vf1[vb][t] = *(const LAS bf16x8*)(buf + NMAPS * KB + vbase + (4 + vb) * (16 * 144) + t * 64);
                __builtin_amdgcn_sched_barrier(0);
#pragma unroll
                for (int vb = 0; vb < 4; ++vb)
#pragma unroll
                    for (int t = 0; t < 2; ++t)
#pragma unroll
                        for (int m = 0; m < NMAPS; ++m) O[m][vb] = __builtin_amdgcn_mfma_f32_16x16x32_bf16(vf0[vb][t], pf[m][t], O[m][vb], 0, 0, 0);
                __builtin_amdgcn_sched_barrier(0);
#pragma unroll
                for (int vb = 0; vb < 4; ++vb)
#pragma unroll
                    for (int t = 0; t < 2; ++t)
#pragma unroll
                        for (int m = 0; m < NMAPS; ++m) O[m][4 + vb] = __builtin_amdgcn_mfma_f32_16x16x32_bf16(vf1[vb][t], pf[m][t], O[m][4 + vb], 0, 0, 0);
            } else {
#pragma unroll
                for (int vb = 0; vb < 4; ++vb)
#pragma unroll
                    for (int t = 0; t < 2; ++t) { if (!NA || (tm >> t) & 1) {
#pragma unroll
                            for (int m = 0; m < NMAPS; ++m) O[m][vb] = __builtin_amdgcn_mfma_f32_16x16x32_bf16(vf0[vb][t], pf[m][t], O[m][vb], 0, 0, 0); } }
            }
            __builtin_amdgcn_sched_barrier(0);
        }
        if (i + 1 < ntiles) AT_STORE((i + 1) & 1);
        __syncthreads();
    }
#undef AT_LOAD
#undef AT_STORE
    float inv[NMAPS];
#pragma unroll
    for (int m = 0; m < NMAPS; ++m) { float l = lrun[m]; l = swap16_add(l, l); l = swap32_add(l, l); inv[m] = 1.0f / l; }
    const int orow = qrow0 + wave * 16 + fr;
    if constexpr (NMAPS == 2) {
        float ss = 0.f; const float i1 = inv[0], i2 = lam * inv[1];
#pragma unroll
        for (int vb = 0; vb < NVB; ++vb) { O[0][vb] = O[0][vb] * i1 - O[1][vb] * i2; const f32x4 o = O[0][vb]; ss += (o.x * o.x + o.y * o.y) + (o.z * o.z + o.w * o.w); }
        ss = swap16_add(ss, ss); ss = swap32_add(ss, ss);
        const float rs = __builtin_amdgcn_rsqf(ss * (1.0f / DV) + EPSF) * outscale;
#pragma unroll
        for (int vb = 0; vb < NVB; ++vb) { const f32x4 gg = *(const f32x4*)(subg + 16 * vb + 4 * g); const f32x4 y = O[0][vb] * rs * gg;
            u32x2 w; w.x = cvtpk(y.x, y.y); w.y = cvtpk(y.z, y.w); *(u32x2*)(AOUT + (size_t)orow * D + ocol + 16 * vb + 4 * g) = w; }
    } else {
#pragma unroll
        for (int vb = 0; vb < NVB; ++vb) { const f32x4 y = O[0][vb] * inv[0];
            u32x2 w; w.x = cvtpk(y.x, y.y); w.y = cvtpk(y.z, y.w); *(u32x2*)(AOUT + (size_t)orow * D + ocol + 16 * vb + 4 * g) = w; }
    }
}


typedef float f32x16 __attribute__((ext_vector_type(16)));
__device__ __forceinline__ void diff_unit32(LAS unsigned char* lds, int tid, int lane, int wave,
                                            const bf16* QKV, int qcol, int qrow0, int kcol, int krow_lat, int krow_ctx, const bf16* VT, int khi,
                                            bf16* AOUT, int ocol, float lam, const float* subg, float outscale) {
    constexpr int KB = 9216, VOFF = 2 * KB, BUFSZ = 2 * KB + 128 * 144;
    const int r = lane & 31, hf = lane >> 5, map = wave >> 2, wq = wave & 3;
    const int swz = ((r >> 4) & 1) << 2;
    bf16x8 qf[4];
    { const bf16* qp = QKV + (size_t)(qrow0 + 32 * wq + r) * NATT + qcol + map * 64 + 8 * hf;
#pragma unroll
      for (int ks = 0; ks < 4; ++ks) qf[ks] = *(const bf16x8*)(qp + 16 * ks); }
    f32x16 O[4];
#pragma unroll
    for (int blk = 0; blk < 4; ++blk)
#pragma unroll
        for (int i = 0; i < 16; ++i) O[blk][i] = 0.f;
    float negm = 0.f, lrun = 0.f;
    const int ntiles = 4 + khi;
    u32x4 kreg[2], vreg[2];
    const int lkey = tid >> 3, lch = tid & 7;
    const int kst = lkey * 144 + ((lch ^ (((lkey >> 4) & 1) << 2)) * 16);
#define D32_LOAD(i) do { const int _i = (i); const int _rowg = (_i < 4 ? krow_ctx + 64 * _i : krow_lat + 64 * (_i - 4)) + lkey; const int _tok0 = (_i < 4 ? SEQ + 64 * _i : 64 * (_i - 4)); \
        _Pragma("unroll") for (int m = 0; m < 2; ++m) kreg[m] = *(const u32x4*)(QKV + (size_t)_rowg * NATT + kcol + m * 64 + lch * 8); \
        _Pragma("unroll") for (int j = 0; j < 2; ++j) { const int idx = tid + 512 * j; vreg[j] = *(const u32x4*)(VT + (size_t)(idx >> 3) * NKEY + _tok0 + (idx & 7) * 8); } } while (0)
#define D32_STORE(b) do { LAS unsigned char* _p = lds + (b) * BUFSZ; \
        _Pragma("unroll") for (int m = 0; m < 2; ++m) *(LAS u32x4*)(_p + m * KB + kst) = kreg[m]; \
        _Pragma("unroll") for (int j = 0; j < 2; ++j) { const int idx = tid + 512 * j, vr = idx >> 3; *(LAS u32x4*)(_p + VOFF + vr * 144 + (((idx & 7) ^ (((vr >> 4) & 1) << 2)) * 16)) = vreg[j]; } } while (0)
    D32_LOAD(0); D32_STORE(0); D32_STORE(2); __syncthreads();
    const int krow = (r & 0x13) | ((r & 4) << 1) | ((r & 8) >> 1);
    const int kbase = map * KB + krow * 144, vbase = VOFF + r * 144;
    bf16x8 pfp[2][2];
#pragma unroll
    for (int kb = 0; kb < 2; ++kb)
#pragma unroll
        for (int sx = 0; sx < 2; ++sx) pfp[kb][sx] = (bf16x8){0, 0, 0, 0, 0, 0, 0, 0};
    int slot = 0;
    for (int i = 0; i < ntiles; ++i) {
        if (i + 1 < ntiles) D32_LOAD(i + 1);
        const int slotn = slot == 2 ? 0 : slot + 1, slotp = slot == 0 ? 2 : slot - 1;
        const LAS unsigned char* buf = lds + slot * BUFSZ; const LAS unsigned char* bufp = lds + slotp * BUFSZ;
        f32x16 S[2];
#pragma unroll
        for (int kb = 0; kb < 2; ++kb) {
#pragma unroll
            for (int ii = 0; ii < 16; ++ii) S[kb][ii] = negm;
#pragma unroll
            for (int ks = 0; ks < 4; ++ks) { const bf16x8 kf = *(const LAS bf16x8*)(buf + kbase + kb * (32 * 144) + (((2 * ks + hf) ^ swz) * 16));
                S[kb] = __builtin_amdgcn_mfma_f32_32x32x16_bf16(kf, qf[ks], S[kb], 0, 0, 0); } }
        __builtin_amdgcn_sched_barrier(0);
        float mx = -1e30f;
#pragma unroll
        for (int kb = 0; kb < 2; ++kb)
#pragma unroll
            for (int ii = 0; ii < 16; ii += 4) mx = fmaxf(fmaxf(mx, S[kb][ii]), fmaxf(fmaxf(S[kb][ii + 1], S[kb][ii + 2]), S[kb][ii + 3]));
        mx = swap32_max(mx);
        const bool resc = (i == 0) || __any(mx > 8.0f);
        float alpha = 1.0f;
        if (resc) { const float dlt = (i == 0) ? mx : fmaxf(mx, 0.f); alpha = fexp2(-dlt); negm -= dlt; lrun *= alpha;
#pragma unroll
            for (int kb = 0; kb < 2; ++kb)
#pragma unroll
                for (int ii = 0; ii < 16; ++ii) S[kb][ii] -= dlt; }
        __builtin_amdgcn_sched_barrier(0);
        bf16x8 pf[2][2]; float l0 = 0.f, l1 = 0.f;
#pragma unroll
        for (int kb = 0; kb < 2; ++kb)
#pragma unroll
            for (int sx = 0; sx < 2; ++sx) { unsigned pw[4];
#pragma unroll
                for (int j = 0; j < 4; ++j) { const float a0 = fexp2(S[kb][8 * sx + 2 * j]), a1 = fexp2(S[kb][8 * sx + 2 * j + 1]); l0 += a0; l1 += a1; pw[j] = cvtpk(a0, a1); }
                pf[kb][sx] = __builtin_bit_cast(bf16x8, (u32x4){pw[0], pw[1], pw[2], pw[3]}); }
        lrun += l0 + l1;
#pragma unroll
        for (int blk = 0; blk < 4; ++blk)
#pragma unroll
            for (int kb = 0; kb < 2; ++kb)
#pragma unroll
                for (int sx = 0; sx < 2; ++sx) { const bf16x8 vf = *(const LAS bf16x8*)(bufp + vbase + blk * (32 * 144) + (((4 * kb + 2 * sx + hf) ^ swz) * 16));
                    O[blk] = __builtin_amdgcn_mfma_f32_32x32x16_bf16(vf, pfp[kb][sx], O[blk], 0, 0, 0); }
#pragma unroll
        for (int k = 0; k < 16; ++k) { __builtin_amdgcn_sched_group_barrier(0x100, 1, 0); __builtin_amdgcn_sched_group_barrier(0x008, 1, 0); __builtin_amdgcn_sched_group_barrier(0x400, 2, 0); __builtin_amdgcn_sched_group_barrier(0x002, 4, 0); }
        __builtin_amdgcn_sched_barrier(0);
        if (resc) {
#pragma unroll
            for (int blk = 0; blk < 4; ++blk) O[blk] = O[blk] * alpha; }
#pragma unroll
        for (int kb = 0; kb < 2; ++kb)
#pragma unroll
            for (int sx = 0; sx < 2; ++sx) pfp[kb][sx] = pf[kb][sx];
        if (i + 1 < ntiles) D32_STORE(slotn);
        slot = slotn;
        __syncthreads();
    }
    { const LAS unsigned char* bufp = lds + (slot == 0 ? 2 : slot - 1) * BUFSZ;
#pragma unroll
      for (int blk = 0; blk < 4; ++blk)
#pragma unroll
          for (int kb = 0; kb < 2; ++kb)
#pragma unroll
              for (int sx = 0; sx < 2; ++sx) { const bf16x8 vf = *(const LAS bf16x8*)(bufp + vbase + blk * (32 * 144) + (((4 * kb + 2 * sx + hf) ^ swz) * 16));
                  O[blk] = __builtin_amdgcn_mfma_f32_32x32x16_bf16(vf, pfp[kb][sx], O[blk], 0, 0, 0); } }
    __syncthreads();
#undef D32_LOAD
#undef D32_STORE
    float l = lrun; l = swap32_add(l, l); const float inv = 1.0f / l;
    LAS float* X = (LAS float*)lds + (size_t)wq * 4096 + lane;
    if (map == 1) {
#pragma unroll
        for (int blk = 0; blk < 4; ++blk)
#pragma unroll
            for (int i = 0; i < 16; ++i) X[(blk * 16 + i) * 64] = O[blk][i] * inv;
    }
    __syncthreads();
    if (map == 0) {
        float ss = 0.f;
#pragma unroll
        for (int blk = 0; blk < 4; ++blk)
#pragma unroll
            for (int i = 0; i < 16; ++i) { const float o = O[blk][i] * inv - lam * X[(blk * 16 + i) * 64]; O[blk][i] = o; ss += o * o; }
        ss = swap32_add(ss, ss);
        const float rs = __builtin_amdgcn_rsqf(ss * (1.0f / 128.0f) + EPSF) * outscale;
        bf16* op = AOUT + (size_t)(qrow0 + 32 * wq + r) * D + ocol + 4 * hf;
#pragma unroll
        for (int blk = 0; blk < 4; ++blk)
#pragma unroll
            for (int g4 = 0; g4 < 4; ++g4) { const int dv0 = 32 * blk + 8 * g4; const f32x4 gg = *(const f32x4*)(subg + dv0 + 4 * hf);
                u32x2 w; w.x = cvtpk(O[blk][4 * g4] * rs * gg.x, O[blk][4 * g4 + 1] * rs * gg.y); w.y = cvtpk(O[blk][4 * g4 + 2] * rs * gg.z, O[blk][4 * g4 + 3] * rs * gg.w);
                *(u32x2*)(op + dv0) = w; }
    }
    __syncthreads();
}

__device__ __forceinline__ void phase_attention(const bf16* QKV, const bf16* VAT, const bf16* VBT, bf16* AOUT, const float* lamp  , float lam_init, const float* subg, const float* nab  ,
                                                unsigned* naq, const ConvPtrs& CP, int clo, int chi, LAS unsigned char* lds, int tid, int lane, int wave) {
    LAS float* biasT = (LAS float*)(lds + LX_BIAS) + 64;
    constexpr int NATT_U = 576 + 1152;
    const int ncu = (chi - clo + CV_UNIT - 1) / CV_UNIT, nq = NATT_U + ncu;
    int mine = 0; if (tid == 0) mine = (int)__hip_atomic_fetch_add(naq, 1u, RLX_AGENT);
    for (;;) {
        __syncthreads();
        if (tid == 0) *(LAS int*)(lds + LX_MISC + 64) = mine;
        __syncthreads();
        const int q = *(LAS int*)(lds + LX_MISC + 64);
        if (q >= nq) break;
        if (tid == 0) mine = (int)__hip_atomic_fetch_add(naq, 1u, RLX_AGENT);
        const int ai = (int)(((long)q * NATT_U) / nq); const bool isatt = (int)(((long)(q + 1) * NATT_U) / nq) > ai;
        if (!isatt) { conv_unit(CP, clo + (q - ai) * CV_UNIT, chi, lds, lane, wave); continue; }
        if (ai < 512 || (ai >= 1536 && ai < 1600)) {
            int bh, qrow0, khi;
            if (ai < 512) { bh = ai >> 4; const int qt = ai & 15; qrow0 = (bh >> 2) * SEQ + qt * 128; khi = 32; }
            else { const int u = ai - 1536; bh = u >> 1; const int qt = u & 1; qrow0 = TX + (bh >> 2) * CTXL + qt * 128; khi = 0; }
            const int b = bh >> 2, h = bh & 3;
            const float lam = __expf(wave_sum(lamp[lane] * lamp[64 + lane])) - __expf(wave_sum(lamp[128 + lane] * lamp[192 + lane])) + lam_init;
            diff_unit32(lds, tid, lane, wave, QKV, h * 128, qrow0, 512 + h * 128, b * SEQ, TX + b * CTXL, VAT + (size_t)bh * 128 * NKEY, khi,
                        AOUT, h * 128, lam, subg, 1.0f - lam_init);
        } else {
            int bh, qrow0, klo, khi, rw;
            if (ai < 1536) { const int u = ai - 512; bh = u >> 4; const int rp = u & 15; qrow0 = (bh >> 3) * SEQ + rp * 128; klo = na_r0(2 * rp); khi = na_r0(2 * rp + 1) + 8; rw = 2 * rp + (wave >> 2); }
            else { const int u = ai - 1600; bh = u >> 1; const int qt = u & 1; qrow0 = TX + (bh >> 3) * CTXL + qt * 128; klo = 0; khi = 0; rw = 0; }
            const int b = bh >> 3, h = bh & 7;
            for (int i = tid; i < 640; i += 512) { const int k = i - 64; biasT[k] = (k >= 0 && k < 465) ? nab[h * 465 + k] * LOG2E : 0.f; }
            attn_unit<1, 64, true>(lds, tid, lane, wave, QKV, 1536 + h * 64, qrow0, 2048 + h * 64, b * SEQ, TX + b * CTXL, VBT + (size_t)bh * 64 * NKEY, klo, khi,
                                   rw, 16 * (wave & 3), biasT, AOUT, 512 + h * 64, 0.f, nullptr, 1.0f);
        }
    }
}

__device__ __forceinline__ void gla_chunk_rows(int b, int dir, int n, int& row0, int& tok0) {
    if (n < 4) { const int cc = dir ? 3 - n : n; row0 = TX + b * CTXL + 64 * cc; tok0 = SEQ + 64 * cc; } else { const int lc = dir ? 35 - n : n - 4; row0 = b * SEQ + 64 * lc; tok0 = 64 * lc; }
}
constexpr int GP_QM = 0, GP_KM = 17408, GP_VT = 34816, GP_LR = 71680, GP_SEG = 75776;
__device__ __forceinline__ void phase_gla_prep(const bf16* QKV2, const bf16* VGT, const float* wgate  , const float* bgate  ,
                                               bf16* QG, bf16* KET, float* FACD, bf16* OF, bf16* OB,
                                               LAS unsigned char* lds, int tid, int lane, int wave, int vcu, int G) {
    const int fr = lane & 15, g = lane >> 4;
    const int d = tid & 127, seg = tid >> 7;
    LAS float* LR = (LAS float*)(lds + GP_LR);
    LAS float* SEG = (LAS float*)(lds + GP_SEG);
    for (int ub = vcu * 9; ub < 2304; ub += G * 9) {
        const int q = ub / 36, n0 = ub % 36, dir = q & 1, hh = (q >> 1) & 3, b = q >> 3;
        bf16* OUT = dir ? OB : OF;
        float wg[16];
#pragma unroll
        for (int r = 0; r < 16; ++r) wg[r] = wgate[(dir * 16 + r) * 512 + hh * 128 + d];
        const float bgv = bgate[dir * 512 + hh * 128 + d];
        const bf16* vtb = VGT + (size_t)(b * 4 + hh) * 256 * NKEY;
        u32x4 qr[2], kr[2], vr[4], lr4;
#define GP_LOAD(n) do { int _row0, _tok0; gla_chunk_rows(b, dir, (n), _row0, _tok0); \
        _Pragma("unroll") for (int j = 0; j < 2; ++j) { const int idx = tid + 512 * j, p = idx >> 4, ch = idx & 15; const bf16* src = QKV2 + (size_t)(_row0 + p) * NGLA + hh * 128 + ch * 8; qr[j] = *(const u32x4*)src; kr[j] = *(const u32x4*)(src + 512); } \
        _Pragma("unroll") for (int j = 0; j < 4; ++j) { const int idx = tid + 512 * j; vr[j] = *(const u32x4*)(vtb + (size_t)(idx >> 3) * NKEY + _tok0 + (idx & 7) * 8); } \
        if (tid < 128) lr4 = *(const u32x4*)(QKV2 + (size_t)(_row0 + (tid >> 1)) * NGLA + 3072 + dir * 16 + (tid & 1) * 8); } while (0)
#define GP_N(i) (dir ? ((i) < 4 ? 3 - (i) : 39 - (i)) : (i))
        GP_LOAD(GP_N(n0));
        for (int k9 = 0; k9 < 9; ++k9) {
            const int n = GP_N(n0 + k9), u = ub - n0 + n; int row0, tok0; gla_chunk_rows(b, dir, n, row0, tok0);
#pragma unroll
            for (int j = 0; j < 2; ++j) { const int idx = tid + 512 * j, p = idx >> 4, ch = idx & 15;
                *(LAS u32x4*)(lds + GP_QM + p * 272 + ch * 16) = qr[j]; *(LAS u32x4*)(lds + GP_KM + p * 272 + ch * 16) = kr[j]; }
#pragma unroll
            for (int j = 0; j < 4; ++j) { const int idx = tid + 512 * j; *(LAS u32x4*)(lds + GP_VT + (idx >> 3) * 144 + (idx & 7) * 16) = vr[j]; }
            if (tid < 128) { LAS float* lp = LR + (tid >> 1) * 16 + (tid & 1) * 8;
                lp[0] = bflo(lr4.x); lp[1] = bfhi(lr4.x); lp[2] = bflo(lr4.y); lp[3] = bfhi(lr4.y); lp[4] = bflo(lr4.z); lp[5] = bfhi(lr4.z); lp[6] = bflo(lr4.w); lp[7] = bfhi(lr4.w); }
            __syncthreads();
            if (k9 + 1 < 9) GP_LOAD(GP_N(n0 + k9 + 1));
            float gc[16];
#pragma unroll
            for (int pi = 0; pi < 16; ++pi) { const LAS f32x4* lp = (const LAS f32x4*)(LR + (16 * seg + pi) * 16); float z = bgv;
#pragma unroll
                for (int k = 0; k < 4; ++k) { const f32x4 l4 = lp[k]; z += l4.x * wg[4 * k] + l4.y * wg[4 * k + 1] + l4.z * wg[4 * k + 2] + l4.w * wg[4 * k + 3]; }
                const float az = fabsf(z); gc[pi] = (fminf(z, 0.f) - flog(1.0f + fexp(-az))) * 0.0625f; }
            float run = 0.f;
            if (dir == 0) {
#pragma unroll
                for (int pi = 0; pi < 16; ++pi) { run += gc[pi]; gc[pi] = run; }
            } else {
#pragma unroll
                for (int pi = 15; pi >= 0; --pi) { run += gc[pi]; gc[pi] = run; }
            }
            SEG[seg * 128 + d] = run;
            __syncthreads();
            const float t0 = SEG[d], t1 = SEG[128 + d], t2 = SEG[256 + d], t3 = SEG[384 + d];
            float off, gmid; const float gend = (t0 + t1) + (t2 + t3);
            if (dir == 0) { off = (seg > 0 ? t0 : 0.f) + (seg > 1 ? t1 : 0.f) + (seg > 2 ? t2 : 0.f); gmid = t0 + t1; }
            else { off = (seg < 3 ? t3 : 0.f) + (seg < 2 ? t2 : 0.f) + (seg < 1 ? t1 : 0.f); gmid = t3 + t2; }
            const float emid = fexp(gmid), eend = fexp(gend - gmid);
            unsigned kep[8];
            bf16* qgp = QG + ((size_t)u * 64 + 16 * seg) * 128 + d;
#pragma unroll
            for (int pi = 0; pi < 16; ++pi) { const int p = 16 * seg + pi; const float rel = off + gc[pi] - gmid; const float Ep = fexp(rel), Ei = fexp(-rel);
                LAS bf16* qa = (LAS bf16*)(lds + GP_QM) + p * 136 + d; LAS bf16* ka = (LAS bf16*)(lds + GP_KM) + p * 136 + d;
                const float qv = bf2f(*qa), kv = bf2f(*ka);
                const float qm = qv * Ep, km = kv * Ei;
                const unsigned w1 = cvtpk(qm, qm * emid), w2 = cvtpk(km, km * eend);
                *qa = (bf16)(w1 & 0xffffu); qgp[pi * 128] = (bf16)(w1 >> 16); *ka = (bf16)(w2 & 0xffffu);
                if (pi & 1) kep[pi >> 1] |= (w2 & 0xffff0000u); else kep[pi >> 1] = w2 >> 16; }
            { u32x4* kt = (u32x4*)(KET + ((size_t)u * 128 + d) * 64 + 16 * seg); kt[0] = (u32x4){kep[0], kep[1], kep[2], kep[3]}; kt[1] = (u32x4){kep[4], kep[5], kep[6], kep[7]}; }
            if (seg == 0) FACD[(size_t)u * 128 + d] = fexp(gend);
            __syncthreads();
            { const int cb = wave & 3, half = wave >> 2;
              bf16x8 qfr[4];
#pragma unroll
              for (int ks = 0; ks < 4; ++ks) qfr[ks] = *(const LAS bf16x8*)(lds + GP_QM + (16 * cb + fr) * 272 + (8 * g + 32 * ks) * 2);
              f32x4 AT[4];
#pragma unroll
              for (int sb = 0; sb < 4; ++sb) { AT[sb] = (f32x4){0.f, 0.f, 0.f, 0.f};
#pragma unroll
                  for (int ks = 0; ks < 4; ++ks) { const bf16x8 af = *(const LAS bf16x8*)(lds + GP_KM + (16 * sb + fr) * 272 + (8 * g + 32 * ks) * 2);
                      AT[sb] = __builtin_amdgcn_mfma_f32_16x16x32_bf16(af, qfr[ks], AT[sb], 0, 0, 0); }
                  const int c = 16 * cb + fr;
#pragma unroll
                  for (int ii = 0; ii < 4; ++ii) { const int sp = 16 * sb + 4 * g + ii; const bool keep = dir ? (sp >= c) : (sp <= c); AT[sb][ii] = keep ? AT[sb][ii] : 0.f; } }
              bf16x8 pf[2];
#pragma unroll
              for (int t = 0; t < 2; ++t) { u32x4 w; w.x = pk2(AT[2 * t][0], AT[2 * t][1]); w.y = pk2(AT[2 * t][2], AT[2 * t][3]); w.z = pk2(AT[2 * t + 1][0], AT[2 * t + 1][1]); w.w = pk2(AT[2 * t + 1][2], AT[2 * t + 1][3]);
                  pf[t] = __builtin_bit_cast(bf16x8, w); }
#pragma unroll
              for (int v8 = 0; v8 < 8; ++v8) { const int vb = 8 * half + v8; f32x4 Oa = (f32x4){0.f, 0.f, 0.f, 0.f};
#pragma unroll
                  for (int t = 0; t < 2; ++t) { const LAS unsigned char* vp = lds + GP_VT + (16 * vb + fr) * 144 + (32 * t + 4 * g) * 2;
                      const u32x2 lo = *(const LAS u32x2*)vp, hi = *(const LAS u32x2*)(vp + 32);
                      u32x4 w; w.x = lo.x; w.y = lo.y; w.z = hi.x; w.w = hi.y;
                      Oa = __builtin_amdgcn_mfma_f32_16x16x32_bf16(__builtin_bit_cast(bf16x8, w), pf[t], Oa, 0, 0, 0); }
                  u32x2 w; w.x = pk2(Oa[0], Oa[1]); w.y = pk2(Oa[2], Oa[3]);
                  *(u32x2*)(OUT + (size_t)(row0 + 16 * cb + fr) * D + hh * 256 + 16 * vb + 4 * g) = w; }
            }
            __syncthreads();
        }
#undef GP_LOAD
#undef GP_N
    }
}

constexpr int GS_BUF = 45056, GS_QG = 0, GS_KET = 17408, GS_VT = 35840, GS_ST = 2 * GS_BUF, GS_DEC = GS_ST + 2 * 17408;
__device__ __forceinline__ void phase_gla(const bf16* VGT, bf16* OF, bf16* OB, const bf16* QG, const bf16* KET, const float* FACD,
                                          LAS unsigned char* lds, int tid, int lane, int wave, int vcu, int G) {
    const int fr = lane & 15, g = lane >> 4;
    for (int u = vcu; u < 256; u += G) {
        const int slab = u & 3, dir = (u >> 2) & 1, hh = (u >> 3) & 3, b = u >> 5;
        bf16* OUT = dir ? OB : OF;
        const int upb = ((b * 4 + hh) * 2 + dir) * 36;
        f32x4 Sacc[4];
#pragma unroll
        for (int vb = 0; vb < 4; ++vb) Sacc[vb] = (f32x4){0.f, 0.f, 0.f, 0.f};
        for (int i = tid; i < 17408 / 4; i += 512) ((LAS unsigned*)(lds + GS_ST))[i] = 0u;
        const bf16* vtb = VGT + ((size_t)(b * 4 + hh) * 256 + slab * 64) * NKEY;
        const int cb = wave & 3, vh = wave >> 2;
        const int ocol = hh * 256 + slab * 64 + 32 * vh + 4 * g;
        struct GsRegs { u32x4 qg[2], ket[2], v; u32x2 oi[2]; float dec; };
        GsRegs R0, R1; R0.dec = 0.f; R1.dec = 0.f;
#define GS_LOAD(R, n) do { int _row0, _tok0; gla_chunk_rows(b, dir, (n), _row0, _tok0); const size_t _u = (size_t)(upb + (n)); \
        _Pragma("unroll") for (int j = 0; j < 2; ++j) { const int idx = tid + 512 * j; R.qg[j] = *(const u32x4*)(QG + _u * 8192 + idx * 8); R.ket[j] = *(const u32x4*)(KET + _u * 8192 + idx * 8); } \
        R.v = *(const u32x4*)(vtb + (size_t)(tid >> 3) * NKEY + _tok0 + (tid & 7) * 8); \
        if (tid < 128) R.dec = FACD[_u * 128 + tid]; \
        _Pragma("unroll") for (int v2 = 0; v2 < 2; ++v2) R.oi[v2] = *(const u32x2*)(OUT + (size_t)(_row0 + 16 * cb + fr) * D + ocol + 16 * v2); } while (0)
#define GS_STORE(R, bf) do { LAS unsigned char* _p = lds + (bf) * GS_BUF; \
        _Pragma("unroll") for (int j = 0; j < 2; ++j) { const int idx = tid + 512 * j; *(LAS u32x4*)(_p + GS_QG + (idx >> 4) * 272 + (idx & 15) * 16) = R.qg[j]; *(LAS u32x4*)(_p + GS_KET + (idx >> 3) * 144 + (idx & 7) * 16) = R.ket[j]; } \
        *(LAS u32x4*)(_p + GS_VT + (tid >> 3) * 144 + (tid & 7) * 16) = R.v; \
        if (tid < 128) ((LAS float*)(lds + GS_DEC))[(bf) * 128 + tid] = R.dec; } while (0)
#define GS_ITER(n, RN, RF) do { const int _n = (n); int row0, tok0; gla_chunk_rows(b, dir, _n, row0, tok0); const int cur = _n & 1; \
            if (_n + 2 < 36) GS_LOAD(RF, _n + 2); \
            const LAS unsigned char* bufp = lds + cur * GS_BUF; const LAS unsigned char* stp = lds + GS_ST + cur * 17408; \
            { bf16x8 qfr[4]; \
              _Pragma("unroll") for (int ks = 0; ks < 4; ++ks) qfr[ks] = *(const LAS bf16x8*)(bufp + GS_QG + (16 * cb + fr) * 272 + (8 * g + 32 * ks) * 2); \
              _Pragma("unroll") for (int v2 = 0; v2 < 2; ++v2) { const int vb = 2 * vh + v2; const u32x2 oin = v2 ? oc1 : oc0; \
                  f32x4 Oa = (f32x4){bflo(oin.x), bfhi(oin.x), bflo(oin.y), bfhi(oin.y)}; \
                  _Pragma("unroll") for (int ks = 0; ks < 4; ++ks) { const bf16x8 af = *(const LAS bf16x8*)(stp + (16 * vb + fr) * 272 + (8 * g + 32 * ks) * 2); \
                      Oa = __builtin_amdgcn_mfma_f32_16x16x32_bf16(af, qfr[ks], Oa, 0, 0, 0); } \
                  u32x2 w; w.x = pk2(Oa[0], Oa[1]); w.y = pk2(Oa[2], Oa[3]); \
                  *(u32x2*)(OUT + (size_t)(row0 + 16 * cb + fr) * D + ocol + 16 * v2) = w; } } \
            { const f32x4 dec = *(const LAS f32x4*)((LAS float*)(lds + GS_DEC) + cur * 128 + 16 * wave + 4 * g); \
              LAS unsigned char* stn = lds + GS_ST + (cur ^ 1) * 17408; \
              _Pragma("unroll") for (int vb = 0; vb < 4; ++vb) { Sacc[vb] = Sacc[vb] * dec; \
                  _Pragma("unroll") for (int t = 0; t < 2; ++t) { const bf16x8 af = *(const LAS bf16x8*)(bufp + GS_KET + (16 * wave + fr) * 144 + (8 * g + 32 * t) * 2); \
                      const bf16x8 bfr = *(const LAS bf16x8*)(bufp + GS_VT + (16 * vb + fr) * 144 + (8 * g + 32 * t) * 2); \
                      Sacc[vb] = __builtin_amdgcn_mfma_f32_16x16x32_bf16(af, bfr, Sacc[vb], 0, 0, 0); } \
                  u32x2 w; w.x = pk2(Sacc[vb][0], Sacc[vb][1]); w.y = pk2(Sacc[vb][2], Sacc[vb][3]); \
                  *(LAS u32x2*)(stn + (16 * vb + fr) * 272 + (16 * wave + 4 * g) * 2) = w; } } \
            if (_n + 1 < 36) { GS_STORE(RN, cur ^ 1); oc0 = RN.oi[0]; oc1 = RN.oi[1]; } \
            __syncthreads(); } while (0)
        GS_LOAD(R0, 0); GS_STORE(R0, 0);
        u32x2 oc0 = R0.oi[0], oc1 = R0.oi[1];
        GS_LOAD(R0, 1);
        __syncthreads();
        for (int n = 0; n < 36; n += 2) { GS_ITER(n, R0, R1); GS_ITER(n + 1, R1, R0); }
#undef GS_ITER
#undef GS_LOAD
#undef GS_STORE
    }
}

constexpr int N_PHASES = 34;
typedef const Args __attribute__((address_space(4)))* KArgs;
__device__ __forceinline__ KArgs kargs() { KArgs p = (KArgs)__builtin_amdgcn_kernarg_segment_ptr(); asm volatile("" : "+s"(p)); return p; }
__global__ void __launch_bounds__(512, 2) fwd(Args a_unused) {
    extern __shared__ __attribute__((aligned(16))) unsigned char lds_raw[];
    LAS unsigned char* lds = (LAS unsigned char*)lds_raw;
    const int tid0 = threadIdx.x;
    const int G0 = gridDim.x; const int bx0 = blockIdx.x;
#define PH_ENTRY int tid = tid0; asm volatile("" : "+v"(tid)); int G = G0, bx = bx0; asm volatile("" : "+s"(G), "+s"(bx)); const int lane = tid & 63, wave = __builtin_amdgcn_readfirstlane(tid >> 6); \
        const int vcu = (G % 8 == 0) ? (bx % 8) * (G / 8) + bx / 8 : bx; (void)lane; (void)wave; (void)vcu
    const int tid = tid0;
    const int ph_lo = kargs()->ph_lo, ph_hi = kargs()->ph_hi;
    const int repmask = kargs()->rep;
    if (tid < 64) ((LAS unsigned*)(lds + LX_MISC))[tid] = 0u;
    for (int i = tid; i < 1024; i += 512) { const int pos = i >> 4, f = i & 15; const float inv = __builtin_amdgcn_exp2f(-(float)f * (13.287712379549449f / 16.0f)); const float ang = (float)pos * inv;
        ((LAS float*)(lds + LX_ROPE))[2 * i] = __cosf(ang); ((LAS float*)(lds + LX_ROPE))[2 * i + 1] = __sinf(ang); }
    __syncthreads();
    const bool single = (ph_hi - ph_lo) > 1;
    XcdBarrier bar; bar.bar = (unsigned*)(kargs()->ws + WS_CTL) + CW_BAR; bar.x = 0; bar.st = (volatile LAS unsigned*)(lds + LX_MISC);
    if (single) bar = xcd_barrier_post((unsigned*)(kargs()->ws + WS_CTL) + CW_BAR, (volatile LAS unsigned*)(lds + LX_MISC));
#define IN(k) (ph_lo <= (k) && (k) < ph_hi)
#define REPLOOP(t) for (int rep_ = 0, nrep_ = 1 + ((repmask >> (t)) & 1); rep_ < nrep_; ++rep_, (rep_ < nrep_ ? (bar.bar = (unsigned*)(kargs()->ws + WS_CTL) + CW_BAR, xcd_barrier(bar)) : (void)0))
#define SEAM(k) do { if (IN(k) && IN((k) + 1)) { bar.bar = (unsigned*)(kargs()->ws + WS_CTL) + CW_BAR; xcd_barrier(bar); if ((repmask >> 10) & 1) xcd_barrier(bar); } } while (0)
    LAS int* tab = (LAS int*)(lds + LX_MOETAB);
#define CONV_PTRS(A) ConvPtrs{(A)->att_w_in, (A)->att_w_out, (A)->gla_w_in, (A)->gla_w_out, (A)->moe_w1, (A)->moe_w3, (A)->moe_w2, (A)->ws}

    if (IN(0)) REPLOOP(0) { PH_ENTRY; p0_prologue(kargs(), lds, tid, lane, wave, vcu, G); } SEAM(0);
    if (IN(1)) { PH_ENTRY; KArgs A = kargs(); unsigned char* ws = A->ws; phase_norm1(A->x, A->ctx, A->norm_g, (float*)(ws + WS_MODV), (bf16*)(ws + WS_H), TALL, lane, wave, vcu, G); } SEAM(1);

#pragma nounroll
    for (int L = 0; L < 4; ++L) {
        const int pb = 2 + 8 * L; const bool isattn = !(L & 1); const int j = L >> 1; const bool lastL = (L == 3);
        const int nrows = lastL ? TX : TALL;
        if (IN(pb)) REPLOOP(isattn ? 1 : 3) {
            PH_ENTRY; KArgs A = kargs(); unsigned char* ws = A->ws; unsigned char* big = ws + WS_BIG; const bf16* H = (const bf16*)(ws + WS_H);
            if (isattn) {
                pg8::DenseOrder S; S.init(H, (const bf16*)(ws + WS_WATTIN) + (size_t)j * NATT * D, TALL, NATT, D, G, bx);
                pg8::EpiAttnIn E{(bf16*)(big + BG_QKV), (bf16*)(big + BG_VAT), (bf16*)(big + BG_VBT), (const LAS float*)(lds + LX_ROPE)};
                pg8::gemm_phase<pg8::EpiAttnIn, pg8::DenseOrder, false>(lds, tid, D, S, E);
            } else {
                pg8::DenseOrder S; S.init(H, (const bf16*)(ws + WS_WGLAIN) + (size_t)j * NGLA * D, TALL, NGLA, D, G, bx);
                pg8::EpiGlaIn E{(bf16*)(big + BG_QKV2), (bf16*)(big + BG_VGT)};
                pg8::gemm_phase<pg8::EpiGlaIn, pg8::DenseOrder, false>(lds, tid, D, S, E);
            }
        }
        SEAM(pb);
        if (!isattn && IN(pb + 1)) {
            for (int rep_ = 0; rep_ <= ((repmask >> 13) & 1); ++rep_)
            { PH_ENTRY; KArgs A = kargs(); unsigned char* ws = A->ws;
              phase_gla_prep((const bf16*)(ws + WS_BIG + BG_QKV2), (const bf16*)(ws + WS_BIG + BG_VGT), A->gla_w_gate + j * 2 * 16 * 512, A->gla_b_gate + j * 2 * 512,
                             (bf16*)(ws + WS_QG), (bf16*)(ws + WS_KET), (float*)(ws + WS_BIG + BG_FAC), (bf16*)(ws + WS_BIG + BG_OF), (bf16*)(ws + WS_BIG + BG_OB), lds, tid, lane, wave, vcu, G); }
            if (single) { bar.bar = (unsigned*)(kargs()->ws + WS_CTL) + CW_BAR; xcd_barrier(bar); }
        }
        if (IN(pb + 1)) REPLOOP(isattn ? 2 : 4) {
            PH_ENTRY; KArgs A = kargs(); unsigned char* ws = A->ws; unsigned char* big = ws + WS_BIG; bf16* AOUT = (bf16*)(ws + WS_AOUT);
            if (isattn) { const ConvPtrs CP = CONV_PTRS(A);
                phase_attention((const bf16*)(big + BG_QKV), (const bf16*)(big + BG_VAT), (const bf16*)(big + BG_VBT), AOUT, A->att_lambda + j * 256, (L == 0) ? 0.2f : 0.470713018f,
                                A->att_subln_g + j * 128, A->na_bias + j * 8 * 465, (unsigned*)(ws + WS_CTL) + CW_NAQ + 64 * j, CP,
                                MK_CONVQ ? (L == 0 ? CT_ATTN0 : CT_MOE1) : 0, MK_CONVQ ? (L == 0 ? CT_MOE1 : CT_MOE3) : 0, lds, tid, lane, wave); }
            else phase_gla((const bf16*)(big + BG_VGT), (bf16*)(big + BG_OF), (bf16*)(big + BG_OB), (const bf16*)(ws + WS_QG), (const bf16*)(ws + WS_KET), (const float*)(big + BG_FAC),
                           lds, tid, lane, wave, vcu, G);
        }
        SEAM(pb + 1);
        if (!isattn) {
            if (IN(pb + 2)) REPLOOP(5) { PH_ENTRY; KArgs A = kargs(); unsigned char* ws = A->ws; unsigned char* big = ws + WS_BIG;
                phase_readout((const bf16*)(big + BG_OF), (const bf16*)(big + BG_OB), (const bf16*)(big + BG_QKV2), A->gla_norm_g + j * 256, (bf16*)(ws + WS_AOUT), nrows, lane, wave, vcu, G); }
            SEAM(pb + 2);
        }
        if (IN(pb + 3)) {
            PH_ENTRY; KArgs A = kargs(); unsigned char* ws = A->ws;
            pg8::DenseOrder S; S.init((const bf16*)(ws + WS_AOUT), (const bf16*)(ws + (isattn ? WS_WATTOUT : WS_WGLAOUT)) + (size_t)j * D * D, nrows, D, D, G, bx);
            if (L == 0) { pg8::EpiResid<true> E{A->x, A->ctx, (bf16*)(ws + WS_XB), (const float*)(ws + WS_MODV) + (size_t)L * 9 * 6144 + 2048};
                pg8::gemm_phase<pg8::EpiResid<true>, pg8::DenseOrder, false>(lds, tid, D, S, E); }
            else { pg8::EpiResid<false> E{nullptr, nullptr, (bf16*)(ws + WS_XB), (const float*)(ws + WS_MODV) + (size_t)L * 9 * 6144 + 2048};
                pg8::gemm_phase<pg8::EpiResid<false>, pg8::DenseOrder, false>(lds, tid, D, S, E); }
        }
        SEAM(pb + 3);
        if (IN(pb + 4)) { PH_ENTRY; KArgs A = kargs(); unsigned char* ws = A->ws;
            phase_router((const bf16*)(ws + WS_XB), A->norm_g + (L * 2 + 1) * D, (const float*)(ws + WS_MODV) + (size_t)L * 9 * 6144, (bf16*)(ws + WS_H), A->router_w, A->router_bias,
                         (unsigned*)(ws + WS_CTL) + CW_CNT + L * 16 * 64, (int*)(ws + WS_LIST), (int*)(ws + WS_TOKI), (float*)(ws + WS_TOKW), nrows, lds, tid, lane, wave, vcu, G, (repmask >> 11) & 1); }
        SEAM(pb + 4);
        if (IN(pb + 5)) REPLOOP(6) {
            PH_ENTRY; KArgs A = kargs(); unsigned char* ws = A->ws;
            const int RT = build_moe_table((unsigned*)(ws + WS_CTL) + CW_CNT + L * 16 * 64, tab, tid);
            pg8::MoeOrder S; S.A = (const char*)(ws + WS_H); S.B = (const char*)(ws + WS_W13) + (size_t)L * 16 * D * D * 2; S.K = D; S.bstride = (size_t)D * D * 2; S.tab = tab; S.list = (const int*)(ws + WS_LIST); S.RT = RT; S.nwg = RT * 4; S.G = G; S.c = bx;
            S.fill_tokc((LAS int*)(lds + LX_BIAS), tid);
            pg8::EpiMoe1 E{(bf16*)(ws + WS_BIG + BG_HB)};
            pg8::gemm_phase<pg8::EpiMoe1, pg8::MoeOrder, true>(lds, tid, D, S, E);
        }
        SEAM(pb + 5);
        if (IN(pb + 6)) REPLOOP(7) {
            PH_ENTRY; KArgs A = kargs(); unsigned char* ws = A->ws;
            const int RT = build_moe_table((unsigned*)(ws + WS_CTL) + CW_CNT + L * 16 * 64, tab, tid);
            pg8::MoeOrder S; S.A = (const char*)(ws + WS_BIG + BG_HB); S.B = (const char*)(ws + WS_W2) + (size_t)L * 16 * D * DEXP * 2; S.K = DEXP; S.bstride = (size_t)D * DEXP * 2; S.tab = tab; S.list = (const int*)(ws + WS_LIST); S.RT = RT; S.nwg = RT * 4; S.G = G; S.c = bx;
            pg8::EpiBf16 E{(bf16*)(ws + WS_BIG + BG_YB), D};
            pg8::gemm_phase<pg8::EpiBf16, pg8::MoeOrder, false>(lds, tid, DEXP, S, E);
        }
        SEAM(pb + 6);
        if (IN(pb + 7)) { PH_ENTRY; KArgs A = kargs(); unsigned char* ws = A->ws; const float* MODV = (const float*)(ws + WS_MODV);
            if (lastL) phase_combine<true>((bf16*)(ws + WS_XB), A->out, MODV + (size_t)L * 9 * 6144, (const bf16*)(ws + WS_BIG + BG_YB), (unsigned*)(ws + WS_CTL) + CW_CNT + L * 16 * 64, (const int*)(ws + WS_TOKI), (const float*)(ws + WS_TOKW),
                                           A->final_g, MODV + (size_t)L * 9 * 6144, (bf16*)(ws + WS_H), nrows, lane, wave, vcu, G);
            else phase_combine<false>((bf16*)(ws + WS_XB), A->out, MODV + (size_t)L * 9 * 6144, (const bf16*)(ws + WS_BIG + BG_YB), (unsigned*)(ws + WS_CTL) + CW_CNT + L * 16 * 64, (const int*)(ws + WS_TOKI), (const float*)(ws + WS_TOKW),
                                      A->norm_g + ((L + 1) * 2) * D, MODV + (size_t)(L + 1) * 9 * 6144, (bf16*)(ws + WS_H), nrows, lane, wave, vcu, G); }
        if (!lastL) SEAM(pb + 7);
    }
#undef IN
#undef REPLOOP
#undef SEAM
#undef CONV_PTRS

#undef PH_ENTRY
}

extern "C" void kernel_launch(void* const* d_in, const int* in_sizes, int n_in, void* d_out, int out_size, void* d_ws, size_t ws_size, hipStream_t stream) {
    static int ready = 0;
    if (ready == 0) {
        if (n_in != 23 || out_size != TX * D || ws_size < WS_END) { fprintf(stderr, "kernel_launch: unexpected shapes (n_in %d out %d ws %zu)\n", n_in, out_size, ws_size); ready = -1; return; }
        if (hipFuncSetAttribute((const void*)fwd, hipFuncAttributeMaxDynamicSharedMemorySize, LDS_BYTES) != hipSuccess) { fprintf(stderr, "kernel_launch: hipFuncSetAttribute failed\n"); ready = -1; return; }
        int per_cu = 0; (void)hipOccupancyMaxActiveBlocksPerMultiprocessor(&per_cu, (const void*)fwd, 512, LDS_BYTES); (void)hipGetLastError();
        if (per_cu < 1) fprintf(stderr, "kernel_launch: occupancy query reports %d blocks per CU\n", per_cu);
        ready = 1;
    }
    if (ready < 0) return;
    (void)hipMemsetAsync((char*)d_ws + WS_CTL, 0, CTL_ZERO_BYTES, stream);
    Args a{};
    const float** ap = (const float**)&a;
    for (int i = 0; i < 23; ++i) ap[i] = (const float*)d_in[i];
    a.out = (float*)d_out; a.ws = (unsigned char*)d_ws;
    const int grid = 256;
    a.ph_lo = 0; a.ph_hi = N_PHASES; a.rep = MK_REPMASK;
    hipLaunchKernelGGL(fwd, dim3(grid), dim3(512), LDS_BYTES, stream, a);
}
```

```cpp
#include <hip/hip_runtime.h>
#include <cstdio>
#include <cstdint>

#ifndef MK_CONVQ
#define MK_CONVQ 1
#endif
#ifndef MK_REPMASK
#define MK_REPMASK 0
#endif

#define GAS __attribute__((address_space(1)))
#define LAS __attribute__((address_space(3)))
typedef unsigned short bf16;
typedef short bf16x8 __attribute__((ext_vector_type(8)));
typedef short bf16x4 __attribute__((ext_vector_type(4)));
typedef float f32x4 __attribute__((ext_vector_type(4)));
typedef float f32x2 __attribute__((ext_vector_type(2)));
typedef unsigned u32x4 __attribute__((ext_vector_type(4)));
typedef unsigned u32x2 __attribute__((ext_vector_type(2)));

constexpr int D = 1024, NB = 8, SEQ = 2048, CTXL = 256;
constexpr int TX = NB * SEQ, TC = NB * CTXL, TALL = TX + TC;
constexpr int NKEY = SEQ + CTXL;
constexpr int NATT = 3072, NGLA = 3328;
constexpr float EPSF = 1e-6f;
constexpr float LOG2E = 1.4426950408889634f;
constexpr int NEXP = 16, DEXP = 512;
constexpr int RT_MAX = 160;

constexpr size_t MiB = 1u << 20;
constexpr size_t WS_CTL = 0, CTL_ZERO_BYTES = 65536;
constexpr size_t WS_MODV = 1 * MiB;
constexpr size_t WS_TOKI = 2 * MiB;
constexpr size_t WS_TOKW = 2 * MiB + 512 * 1024;
constexpr size_t WS_LIST = 3 * MiB;
constexpr size_t WS_CTX = 5 * MiB;
constexpr size_t WS_WATTIN = 13 * MiB;
constexpr size_t WS_WATTOUT = 25 * MiB;
constexpr size_t WS_WGLAIN = 29 * MiB;
constexpr size_t WS_WGLAOUT = 42 * MiB;
constexpr size_t WS_W13 = 46 * MiB;
constexpr size_t WS_W2 = 174 * MiB;
constexpr size_t WS_H = 238 * MiB;
constexpr size_t WS_AOUT = 274 * MiB;
constexpr size_t WS_BIG = 310 * MiB;
constexpr size_t WS_XB = 539 * MiB;
constexpr size_t WS_END = 575 * MiB;
constexpr size_t BG_QKV = 0;
constexpr size_t BG_VAT = 108 * MiB;
constexpr size_t BG_VBT = 126 * MiB;
constexpr size_t BG_QKV2 = 0;
constexpr size_t BG_VGT = 117 * MiB;
constexpr size_t BG_OF = 153 * MiB;
constexpr size_t BG_OB = 189 * MiB;
constexpr size_t BG_FAC = 225 * MiB;
constexpr size_t WS_QG = WS_H, WS_KET = WS_AOUT;
constexpr size_t BG_HB = 0;
constexpr size_t BG_YB = 40 * MiB;
constexpr int CW_TMO = 0;
constexpr int CW_BAR = 4096;
constexpr int CW_NAQ = 15360;
constexpr int CW_CNT = 8192;

constexpr int RING_BYTES = 131072;
constexpr int LX_OFF = RING_BYTES;
constexpr int LX_MISC = LX_OFF;
constexpr int LX_MOETAB = LX_OFF + 256;
constexpr int LX_ROPE = LX_OFF + 2048;
constexpr int LX_BIAS = LX_OFF + 2048 + 8192;
constexpr int LDS_BYTES = 147456;

#define LDS_WAIT() asm volatile("s_waitcnt lgkmcnt(0)" ::: "memory")
#define VM_WAIT() asm volatile("s_waitcnt vmcnt(0)" ::: "memory")
#define RLX_AGENT __ATOMIC_RELAXED, __HIP_MEMORY_SCOPE_AGENT
__device__ __forceinline__ unsigned f2bf(float f) { unsigned u = __builtin_bit_cast(unsigned, f); return (u + 0x7fffu + ((u >> 16) & 1u)) >> 16; }
typedef __bf16 hwbf16x2 __attribute__((ext_vector_type(2)));
__device__ __forceinline__ unsigned cvtpk(float lo, float hi) { const f32x2 v = {lo, hi}; const hwbf16x2 b = __builtin_convertvector(v, hwbf16x2); return __builtin_bit_cast(unsigned, b); }
__device__ __forceinline__ unsigned pk2(float lo, float hi) { return cvtpk(lo, hi); }
__device__ __forceinline__ float bf2f(unsigned short b) { return __builtin_bit_cast(float, ((unsigned)b) << 16); }
__device__ __forceinline__ float bflo(unsigned w) { return __builtin_bit_cast(float, w << 16); }
__device__ __forceinline__ float bfhi(unsigned w) { return __builtin_bit_cast(float, w & 0xffff0000u); }
template <int CTRL> __device__ __forceinline__ float dppf(float v) { return __builtin_bit_cast(float, __builtin_amdgcn_update_dpp(0, __builtin_bit_cast(int, v), CTRL, 0xf, 0xf, true)); }
__device__ __forceinline__ float row_sum(float v) { v += dppf<0xB1>(v); v += dppf<0x4E>(v); v += dppf<0x124>(v); v += dppf<0x128>(v); return v; }
__device__ __forceinline__ float swap16_add(float a, float b) { auto r = __builtin_amdgcn_permlane16_swap(__float_as_uint(a), __float_as_uint(b), false, false); const unsigned r0 = r[0], r1 = r[1]; return __uint_as_float(r0) + __uint_as_float(r1); }
__device__ __forceinline__ float swap32_add(float a, float b) { auto r = __builtin_amdgcn_permlane32_swap(__float_as_uint(a), __float_as_uint(b), false, false); const unsigned r0 = r[0], r1 = r[1]; return __uint_as_float(r0) + __uint_as_float(r1); }
__device__ __forceinline__ float swap16_max(float a) { auto r = __builtin_amdgcn_permlane16_swap(__float_as_uint(a), __float_as_uint(a), false, false); const unsigned r0 = r[0], r1 = r[1]; return fmaxf(__uint_as_float(r0), __uint_as_float(r1)); }
__device__ __forceinline__ float swap32_max(float a) { auto r = __builtin_amdgcn_permlane32_swap(__float_as_uint(a), __float_as_uint(a), false, false); const unsigned r0 = r[0], r1 = r[1]; return fmaxf(__uint_as_float(r0), __uint_as_float(r1)); }
__device__ __forceinline__ float readlane_f(float v, int l) { return __int_as_float(__builtin_amdgcn_readlane(__float_as_int(v), l)); }
__device__ __forceinline__ float wave_sum(float v) { v = row_sum(v); v = swap16_add(v, v); return swap32_add(v, v); }
__device__ __forceinline__ float fexp2(float x) { return __builtin_amdgcn_exp2f(x); }
__device__ __forceinline__ float fexp(float x) { return __builtin_amdgcn_exp2f(x * LOG2E); }
__device__ __forceinline__ float flog(float x) { return __builtin_amdgcn_logf(x) * 0.6931471805599453f; }
__device__ __forceinline__ float frcp(float x) { return __builtin_amdgcn_rcpf(x); }
__device__ __forceinline__ float silu_f(float x) { return x * frcp(1.0f + fexp(-x)); }

#define XB_TMO      128
#define XB_XCNT(j)  (256  + 64 * (j))
#define XB_XSUB(j)  (1280 + 64 * (j))
#define XB_XGEN(j)  (2304 + 64 * (j))
#define XB_TOP      3328
#define XB_TOPGEN   3392
#define XCD_BAR_WORDS 3456
#define XB_SPIN_CAP (1u << 18)
__device__ __forceinline__ unsigned xb_ld(unsigned* p)              { return __hip_atomic_load(p, __ATOMIC_RELAXED, __HIP_MEMORY_SCOPE_AGENT); }
__device__ __forceinline__ unsigned xb_add(unsigned* p, unsigned v) { return __hip_atomic_fetch_add(p, v, __ATOMIC_RELAXED, __HIP_MEMORY_SCOPE_AGENT); }
__device__ __forceinline__ unsigned xb_xcc_id() { return (unsigned)__builtin_amdgcn_s_getreg((3 << 11) | 20) & 0xFu; }
#define XB_SPIN(cond, bar) do { unsigned _sp = 0; while (cond) { __builtin_amdgcn_s_sleep(1); \
    if ((++_sp & 255u) == 0u) { if (xb_ld(&(bar)[XB_TMO])) break; if (_sp > XB_SPIN_CAP) { atomicAdd(&(bar)[XB_TMO], 1u); break; } } } } while (0)
struct XcdBarrier { unsigned* bar; unsigned x; volatile LAS unsigned* st; };
__device__ __forceinline__ XcdBarrier xcd_barrier_post(unsigned* bar, volatile LAS unsigned* st) {
    XcdBarrier b; b.bar = bar; b.x = xb_xcc_id(); b.st = st;
    if (threadIdx.x == 0) (void)xb_add(&bar[XB_XCNT(b.x)], 1u);
    return b;
}
__device__ __forceinline__ void xcd_barrier_complete(unsigned* bar, unsigned x, unsigned& nloc, unsigned& nx) {
    const unsigned G = gridDim.x * gridDim.y * gridDim.z;
    unsigned sum, cnt, mine, sp = 0u;
    for (;;) {
        sum = 0u; cnt = 0u; mine = 0u;
#pragma unroll
        for (unsigned j = 0; j < 16; ++j) { const unsigned c = xb_ld(&bar[XB_XCNT(j)]); sum += c; cnt += (c > 0u) ? 1u : 0u; mine = (j == x) ? c : mine; }
        if (sum == G) break;
        __builtin_amdgcn_s_sleep(1);
        if ((++sp & 255u) == 0u) { if (xb_ld(&bar[XB_TMO])) break; if (sp > XB_SPIN_CAP) { atomicAdd(&bar[XB_TMO], 1u); break; } }
    }
    nloc = mine > 0u ? mine : 1u; nx = cnt > 0u ? cnt : 1u;
}
__device__ __forceinline__ void xcd_barrier(const XcdBarrier& b) {
    asm volatile("s_waitcnt vmcnt(0)" ::: "memory");
    __syncthreads();
    if (threadIdx.x == 0) {
        unsigned* bar = b.bar;
        __builtin_amdgcn_s_waitcnt(0);
        unsigned nloc = b.st[0], nx = b.st[1];
        if (nloc == 0u) { xcd_barrier_complete(bar, b.x, nloc, nx); b.st[0] = nloc; b.st[1] = nx; }
        const unsigned old = xb_add(&bar[XB_XSUB(b.x)], 1u);
        const unsigned gen = old / nloc;
        if (old + 1u == (gen + 1u) * nloc) {
            __builtin_amdgcn_fence(__ATOMIC_RELEASE, "agent");
            asm volatile("s_waitcnt vmcnt(0)" ::: "memory");
            const unsigned og = xb_add(&bar[XB_TOP], 1u);
            const unsigned tg = og / nx;
            if (og + 1u == (tg + 1u) * nx) xb_add(&bar[XB_TOPGEN], 1u);
            else XB_SPIN(xb_ld(&bar[XB_TOPGEN]) == tg, bar);
            __builtin_amdgcn_fence(__ATOMIC_ACQUIRE, "agent");
            xb_add(&bar[XB_XGEN(b.x)], 1u);
            asm volatile("s_waitcnt vmcnt(0)" ::: "memory");
        } else {
            XB_SPIN(xb_ld(&bar[XB_XGEN(b.x)]) == gen, bar);
            __builtin_amdgcn_fence(__ATOMIC_ACQUIRE, "agent");
            asm volatile("s_waitcnt vmcnt(0)" ::: "memory");
        }
    }
    __syncthreads();
}

namespace pg8 {
constexpr int BM = 256, BK = 64, HALF = 128, HTB = HALF * BK * 2, STAGE_BYTES = 8 * HTB, NXCD = 8, WGM = 8;
__host__ __device__ __forceinline__ int lds_byte(int r, int c) { const int st = (r >> 4) * 2 + (c >> 5), rr = r & 15, cc = c & 31, ob = rr * 64 + cc * 2; return st * 1024 + (ob ^ (((ob >> 9) & 1) << 5)); }
__host__ __device__ __forceinline__ void stage_rc(int b, int& R, int& C) { const int st = b / 1024, sb = b % 1024, swz = sb ^ (((sb >> 9) & 1) << 5); R = (st >> 1) * 16 + swz / 64; C = (st & 1) * 32 + (swz % 64) / 2; }
__host__ __device__ __forceinline__ int perm32(int rho) { const int n = rho >> 4, i = rho & 15; return 8 * (i >> 2) + 4 * n + (i & 3); }

struct Unit { int pm, pn, e, mt, roff, nai, ord; };
__device__ __forceinline__ bool split_index(long L, int nwg, int G, int& uidx, int& roff, int& nai) {
    const int R = nwg / G, r = nwg % G; const bool split = (r > 0) && (2 * r <= G);
    if (L < (long)R * G || !split) { if (L >= nwg) return false; uidx = (int)L; roff = 0; nai = 2; return true; }
    const int h = (int)(L - (long)R * G); if (h >= 2 * r) return false; uidx = R * G + (h >> 1); roff = (h & 1) * 128; nai = 1; return true;
}

__device__ __forceinline__ int xcd_remap(int wgid, int nwg) { const int q = nwg / NXCD, r = nwg % NXCD, xcd = wgid % NXCD, off = wgid / NXCD; return (xcd < r ? xcd * (q + 1) : r * (q + 1) + (xcd - r) * q) + off; }

struct DenseOrder {
    const char* A; const char* B; int K; int nM, nN, nwg, G, c;
    __device__ __forceinline__ void init(const bf16* A_, const bf16* B_, int M, int N, int K_, int G_, int c_) { A = (const char*)A_; B = (const char*)B_; K = K_; nM = M / BM; nN = N / BM; nwg = nM * nN; G = G_; c = c_; }
    __device__ __forceinline__ bool next(int i, Unit& u) const {
        int uidx; if (!split_index((long)i * G + c, nwg, G, uidx, u.roff, u.nai)) return false;
        const int wgid = xcd_remap(uidx, nwg);
        const int nig = WGM * nN, gid = wgid / nig, fm = gid * WGM, gsz = (nM - fm) < WGM ? (nM - fm) : WGM;
        u.pm = fm + ((wgid % nig) % gsz); u.pn = (wgid % nig) / gsz; u.e = 0; u.mt = 0; u.ord = i; return true;
    }
    __device__ __forceinline__ const char* a_ptr(const Unit& u) const { return A + (size_t)(u.pm * BM + u.roff) * K * 2; }
    __device__ __forceinline__ const char* b_ptr(const Unit& u) const { return B + (size_t)u.pn * BM * K * 2; }
    __device__ __forceinline__ int tok(const Unit&, int) const { return 0; }
};
struct MoeOrder {
    const char* A; const char* B; int K; size_t bstride;
    const LAS int* tab; const int* list; int RT, nwg, G, c;
    __device__ __forceinline__ bool next(int i, Unit& u) const {
        int uidx; if (!split_index((long)i * G + c, nwg, G, uidx, u.roff, u.nai)) return false;
        const int wgid = xcd_remap(uidx, nwg);
        const int rt = wgid >> 2; u.pm = rt; u.pn = wgid & 3; const int t = tab[rt]; u.e = t & 255; u.mt = t >> 8; u.ord = i; return true;
    }
    __device__ __forceinline__ const char* a_ptr(const Unit& u) const { return A + (size_t)(u.pm * BM + u.roff) * K * 2; }
    __device__ __forceinline__ const char* b_ptr(const Unit& u) const { return B + (size_t)u.e * bstride + (size_t)u.pn * BM * K * 2; }
    const LAS int* tokc;
    __device__ __forceinline__ int tok(const Unit& u, int r) const { return tokc[u.ord * BM + r]; }
    __device__ __forceinline__ void fill_tokc(LAS int* dst, int tid) {
        tokc = dst;
        int val[2], idx[2]; bool ok[2];
#pragma unroll
        for (int k = 0; k < 2; ++k) { const int i = (tid >> 8) + 2 * k, r = tid & 255; Unit u; const bool has = (i < 3) && next(i, u);
            const int cnt = has ? tab[RT_MAX + 1 + u.e] : 0; const int pos = has ? u.mt * BM + u.roff + r : 0;
            ok[k] = has; idx[k] = i * BM + r;
            val[k] = list[(size_t)(has ? u.e : 0) * TALL + pos];
            val[k] = (pos < cnt) ? val[k] : 0; }
#pragma unroll
        for (int k = 0; k < 2; ++k) if (ok[k]) dst[idx[k]] = val[k];
        __syncthreads();
    }
};

__device__ __forceinline__ unsigned cvt_pk_bf16(float lo, float hi) { unsigned r; asm volatile("v_cvt_pk_bf16_f32 %0, %1, %2" : "=v"(r) : "v"(lo), "v"(hi)); return r; }

template <class Epi, class Sched, bool GATHER>
__device__ __forceinline__ void gemm_phase(LAS unsigned char* lds, const int tid, const int K, const Sched& S, const Epi& E) {
    const int wid = __builtin_amdgcn_readfirstlane(tid >> 6), lane = tid & 63, wr = wid >> 2, wc = wid & 3, fr = lane & 15, fq = lane >> 4;
    const int nt = K / BK;
    unsigned voffA[2], voffB[2]; int RA[2], CA[2];
#pragma unroll
    for (int i = 0; i < 2; ++i) { int R, C; stage_rc(tid * 16 + i * 8192, R, C); const int Rb = Epi::PERM ? ((R & ~31) + perm32(R & 31)) : R;
        RA[i] = R; CA[i] = C; voffA[i] = (unsigned)(R * K + C) * 2u; voffB[i] = (unsigned)(Rb * K + C) * 2u; }
    const size_t kstep = (size_t)(BK * 2);
    const size_t hstep = (size_t)HALF * K * 2;
    const unsigned ldsw = (unsigned)wid * 1024u;
    const int aoff = lds_byte(wr * 64 + fr, fq * 8), boff = lds_byte(wc * 32 + fr, fq * 8);
#define PG8_SA(b, h) (((b) * 2 + (h)) * HTB)
#define PG8_SB(b, h) ((4 + (b) * 2 + (h)) * HTB)
#define PG8_STAGE(bufoff, gbase, voff) do { _Pragma("unroll") for (int _i = 0; _i < 2; ++_i) \
        __builtin_amdgcn_global_load_lds((const unsigned*)((const char*)(gbase) + (voff)[_i]), (LAS unsigned*)(lds + (bufoff) + ldsw + _i * 8192), 16, 0, 0); } while (0)
#define PG8_STAGE_A(bufoff, h, usenext, koff) do { if constexpr (GATHER) { unsigned _vo[2]; _vo[0] = (usenext) ? nvA[h][0] : vA[h][0]; _vo[1] = (usenext) ? nvA[h][1] : vA[h][1]; PG8_STAGE(bufoff, S.A + (koff), _vo); } \
        else { PG8_STAGE(bufoff, ((usenext) ? nA : cA) + (size_t)(h) * hstep + (koff), voffA); } } while (0)
#define PG8_LDA(dst, b, h) do { _Pragma("unroll") for (int m = 0; m < 4; ++m) _Pragma("unroll") for (int k = 0; k < 2; ++k) dst[m][k] = *(const LAS bf16x8*)(lds + PG8_SA(b, h) + aoff + m * 2048 + k * 1024); } while (0)
#define PG8_LDB(dst, b, h) do { _Pragma("unroll") for (int n = 0; n < 2; ++n) _Pragma("unroll") for (int k = 0; k < 2; ++k) dst[n][k] = *(const LAS bf16x8*)(lds + PG8_SB(b, h) + boff + n * 2048 + k * 1024); } while (0)
#define PG8_MMA(ai, bj, At, Bt) do { __builtin_amdgcn_s_setprio(1); _Pragma("unroll") for (int m = 0; m < 4; ++m) _Pragma("unroll") for (int n = 0; n < 2; ++n) _Pragma("unroll") for (int k = 0; k < 2; ++k) \
        acc[ai][bj][m][n] = __builtin_amdgcn_mfma_f32_16x16x32_bf16(Bt[n][k], At[m][k], acc[ai][bj][m][n], 0, 0, 0); __builtin_amdgcn_s_setprio(0); } while (0)
#define PG8_WAIT_V(n) asm volatile("s_waitcnt vmcnt(" #n ")" ::: "memory")
#define PG8_WAIT_L(n) asm volatile("s_waitcnt lgkmcnt(" #n ")" ::: "memory")
#define PG8_BAR __builtin_amdgcn_s_barrier()
#define PG8_SCHED __builtin_amdgcn_sched_barrier(0)
    Unit cur, nxt; int ui = 0;
    if (!S.next(0, cur)) return;
    f32x4 acc[2][2][4][2];
#pragma unroll
    for (int a = 0; a < 2; ++a)
#pragma unroll
        for (int b = 0; b < 2; ++b)
#pragma unroll
            for (int m = 0; m < 4; ++m)
#pragma unroll
                for (int n = 0; n < 2; ++n) acc[a][b][m][n] = (f32x4){0.f, 0.f, 0.f, 0.f};
    bf16x8 At[4][2], B0[2][2], B1[2][2];
    unsigned vA[2][2], nvA[2][2];
    if constexpr (GATHER) {
#pragma unroll
        for (int h = 0; h < 2; ++h)
#pragma unroll
            for (int i = 0; i < 2; ++i) { vA[h][i] = (unsigned)(S.tok(cur, h * HALF + RA[i]) * K + CA[i]) * 2u; nvA[h][i] = vA[h][i]; }
    }
    const char* cA = S.a_ptr(cur); const char* cB = S.b_ptr(cur); const char* nA = cA;
    PG8_STAGE(PG8_SB(0, 0), cB, voffB); PG8_STAGE(PG8_SB(0, 1), cB + hstep, voffB); PG8_STAGE_A(PG8_SA(0, 0), 0, false, 0); PG8_STAGE_A(PG8_SA(0, 1), 1, false, 0);
    if (wr == 1) PG8_BAR;
    PG8_WAIT_V(2); PG8_BAR;
    PG8_STAGE(PG8_SB(1, 0), cB + kstep, voffB); PG8_STAGE_A(PG8_SA(1, 0), 0, false, kstep); PG8_STAGE(PG8_SB(1, 1), cB + hstep + kstep, voffB);
    PG8_WAIT_V(6); PG8_BAR;
    for (;;) {
        const bool has_next = S.next(ui + 1, nxt);
        nA = has_next ? S.a_ptr(nxt) : cA; const char* nB = has_next ? S.b_ptr(nxt) : cB;
        if constexpr (GATHER) {
            if (has_next) {
#pragma unroll
                for (int h = 0; h < 2; ++h)
#pragma unroll
                    for (int i = 0; i < 2; ++i) nvA[h][i] = (unsigned)(S.tok(nxt, h * HALF + RA[i]) * K + CA[i]) * 2u;
            }
        }
        const bool full = (cur.nai == 2);
        for (int t = 0; t < nt; t += 2) {
            const bool last = (t == nt - 2);
            const size_t k1 = (size_t)(t + 1) * kstep;
            const size_t k2 = last ? 0 : (size_t)(t + 2) * kstep, k3 = k2 + kstep;
            const char* b2 = last ? nB : cB + (size_t)(t + 2) * kstep; const char* b3 = b2 + kstep;
            PG8_LDB(B0, 0, 0); PG8_LDB(B1, 0, 1); PG8_SCHED; PG8_LDA(At, 0, 0); PG8_STAGE_A(PG8_SA(1, 1), 1, false, k1);
            PG8_WAIT_V(8); PG8_WAIT_L(0); PG8_BAR; PG8_MMA(0, 0, At, B0); PG8_MMA(0, 1, At, B1); PG8_BAR; PG8_SCHED;
            if (full) PG8_LDA(At, 0, 1); PG8_STAGE(PG8_SB(0, 0), b2, voffB); PG8_STAGE(PG8_SB(0, 1), b2 + hstep, voffB); PG8_STAGE_A(PG8_SA(0, 0), 0, last, k2);
            PG8_WAIT_V(8); PG8_WAIT_L(0); PG8_BAR; if (full) { PG8_MMA(1, 0, At, B0); PG8_MMA(1, 1, At, B1); } PG8_BAR; PG8_SCHED;
            PG8_LDB(B0, 1, 0); PG8_LDB(B1, 1, 1); PG8_SCHED; PG8_LDA(At, 1, 0); PG8_STAGE_A(PG8_SA(0, 1), 1, last, k2);
            PG8_WAIT_V(8); PG8_WAIT_L(0); PG8_BAR; PG8_MMA(0, 0, At, B0); PG8_MMA(0, 1, At, B1); PG8_BAR; PG8_SCHED;
            if (full) PG8_LDA(At, 1, 1); PG8_STAGE(PG8_SB(1, 0), b3, voffB); PG8_STAGE(PG8_SB(1, 1), b3 + hstep, voffB); PG8_STAGE_A(PG8_SA(1, 0), 0, last, k3);
            PG8_WAIT_V(8); PG8_WAIT_L(0); PG8_BAR; if (full) { PG8_MMA(1, 0, At, B0); PG8_MMA(1, 1, At, B1); } PG8_BAR; PG8_SCHED;
        }
        if (wr == 0) PG8_BAR;
        E(acc, cur, wr, wc, fr, fq);
        if (!has_next) break;
#pragma unroll
        for (int a = 0; a < 2; ++a)
#pragma unroll
            for (int b = 0; b < 2; ++b)
#pragma unroll
                for (int m = 0; m < 4; ++m)
#pragma unroll
                    for (int n = 0; n < 2; ++n) acc[a][b][m][n] = (f32x4){0.f, 0.f, 0.f, 0.f};
        cur = nxt; cA = nA; cB = nB; ++ui;
        if constexpr (GATHER) {
#pragma unroll
            for (int h = 0; h < 2; ++h)
#pragma unroll
                for (int i = 0; i < 2; ++i) vA[h][i] = nvA[h][i];
        }
        if (wr == 1) PG8_BAR;
    }
    PG8_WAIT_V(0);
    PG8_BAR;
#undef PG8_SA
#undef PG8_SB
#undef PG8_STAGE
#undef PG8_STAGE_A
#undef PG8_LDA
#undef PG8_LDB
#undef PG8_MMA
#undef PG8_WAIT_V
#undef PG8_WAIT_L
#undef PG8_BAR
#undef PG8_SCHED
}
}

namespace pg8 {
__device__ __forceinline__ void row_bt(int row, int& b, int& tok) { if (row < TX) { b = row >> 11; tok = row & 2047; } else { const int r = row - TX; b = r >> 8; tok = SEQ + (r & 255); } }

struct EpiAttnIn {
    static constexpr bool PERM = true;
    bf16* QKV; bf16* VAT; bf16* VBT; const LAS float* rope;
    __device__ __forceinline__ void operator()(const f32x4 (&acc)[2][2][4][2], const Unit& u, int wr, int wc, int fr, int fq) const {
        const int row0 = u.pm * BM + u.roff + wr * 64 + fr; const int seg = u.pn >> 1;
        const bool latent = u.pm < (TX / BM);
        if (seg == 2 || seg == 5) {
#pragma unroll
            for (int ai = 0; ai < 2; ++ai) if (ai < u.nai)
#pragma unroll
                for (int m = 0; m < 4; ++m) { const int row = row0 + ai * HALF + m * 16; int b, tok; row_bt(row, b, tok);
#pragma unroll
                    for (int bj = 0; bj < 2; ++bj) { const int col = u.pn * BM + bj * HALF + wc * 32 + 8 * fq;
                        bf16* dst;
                        if (seg == 2) { const int cs = col - 1024; dst = VAT + ((size_t)(b * 4 + (cs >> 7)) * 128 + (cs & 127)) * NKEY + tok; }
                        else { const int cs = col - 2560; dst = VBT + ((size_t)(b * 8 + (cs >> 6)) * 64 + (cs & 63)) * NKEY + tok; }
#pragma unroll
                        for (int n = 0; n < 2; ++n)
#pragma unroll
                            for (int i = 0; i < 4; ++i) dst[(size_t)(4 * n + i) * NKEY] = (bf16)f2bf(acc[ai][bj][m][n][i]); } }
            return;
        }
        const bool dorope = latent && seg < 2;
        const float qs = (seg == 0 || seg == 3) ? 0.125f * LOG2E : 1.0f;
#pragma unroll
        for (int ai = 0; ai < 2; ++ai) if (ai < u.nai)
#pragma unroll
            for (int m = 0; m < 4; ++m) { const int row = row0 + ai * HALF + m * 16;
                f32x4 cs4[4];
                if (dorope) { const int t = row & 2047; const int pos = (wc & 1) ? (t & 63) : (t >> 6);
                    const LAS f32x4* rp = (const LAS f32x4*)(rope + (pos * 16 + 8 * (fq & 1)) * 2);
#pragma unroll
                    for (int j = 0; j < 4; ++j) cs4[j] = rp[j]; }
#pragma unroll
                for (int bj = 0; bj < 2; ++bj) { const int col = u.pn * BM + bj * HALF + wc * 32 + 8 * fq;
                    float v[8];
#pragma unroll
                    for (int n = 0; n < 2; ++n)
#pragma unroll
                        for (int i = 0; i < 4; ++i) v[4 * n + i] = acc[ai][bj][m][n][i];
                    if (dorope) {
#pragma unroll
                        for (int j = 0; j < 8; ++j) { const float other = __shfl_xor(v[j], 32); const float c = cs4[j >> 1][(j & 1) * 2], s = cs4[j >> 1][(j & 1) * 2 + 1];
                            v[j] = (fq < 2) ? (v[j] * c - other * s) : (v[j] * c + other * s); } }
                    u32x4 w; w.x = pk2(v[0] * qs, v[1] * qs); w.y = pk2(v[2] * qs, v[3] * qs); w.z = pk2(v[4] * qs, v[5] * qs); w.w = pk2(v[6] * qs, v[7] * qs);
                    *(u32x4*)(QKV + (size_t)row * NATT + col) = w; } }
    }
};
struct EpiGlaIn {
    static constexpr bool PERM = true;
    bf16* QKV2; bf16* VGT;
    __device__ __forceinline__ void operator()(const f32x4 (&acc)[2][2][4][2], const Unit& u, int wr, int wc, int fr, int fq) const {
        const int row0 = u.pm * BM + u.roff + wr * 64 + fr;
        if (u.pn >= 4 && u.pn < 8) {
#pragma unroll
            for (int ai = 0; ai < 2; ++ai) if (ai < u.nai)
#pragma unroll
                for (int m = 0; m < 4; ++m) { const int row = row0 + ai * HALF + m * 16; int b, tok; row_bt(row, b, tok);
#pragma unroll
                    for (int bj = 0; bj < 2; ++bj) { const int cs = u.pn * BM + bj * HALF + wc * 32 + 8 * fq - 1024;
                        bf16* dst = VGT + ((size_t)(b * 4 + (cs >> 8)) * 256 + (cs & 255)) * NKEY + tok;
#pragma unroll
                        for (int n = 0; n < 2; ++n)
#pragma unroll
                            for (int i = 0; i < 4; ++i) dst[(size_t)(4 * n + i) * NKEY] = (bf16)f2bf(acc[ai][bj][m][n][i]); } }
            return;
        }
        const float qs = (u.pn < 2) ? 0.08838834764831845f : 1.0f;
#pragma unroll
        for (int ai = 0; ai < 2; ++ai) if (ai < u.nai)
#pragma unroll
            for (int m = 0; m < 4; ++m) { const int row = row0 + ai * HALF + m * 16;
#pragma unroll
                for (int bj = 0; bj < 2; ++bj) { const int col = u.pn * BM + bj * HALF + wc * 32 + 8 * fq; const f32x4 a = acc[ai][bj][m][0] * qs, c = acc[ai][bj][m][1] * qs;
                    u32x4 w; w.x = pk2(a[0], a[1]); w.y = pk2(a[2], a[3]); w.z = pk2(c[0], c[1]); w.w = pk2(c[2], c[3]);
                    *(u32x4*)(QKV2 + (size_t)row * NGLA + col) = w; } }
    }
};
template <bool F32IN>
struct EpiResid {
    static constexpr bool PERM = true;
    const float* IL; const float* IC; bf16* XB; const float* modv;
    __device__ __forceinline__ void operator()(const f32x4 (&acc)[2][2][4][2], const Unit& u, int wr, int wc, int fr, int fq) const {
        const int row0 = u.pm * BM + u.roff + wr * 64 + fr, col0 = u.pn * BM + wc * 32 + 8 * fq;
        const bool latent = u.pm < (TX / BM); const int bi = latent ? (u.pm >> 3) : 8;
        const float* ibase = latent ? IL : (IC - (size_t)TX * D);
        f32x4 gv[2][2];
#pragma unroll
        for (int bj = 0; bj < 2; ++bj)
#pragma unroll
            for (int n = 0; n < 2; ++n) gv[bj][n] = *(const f32x4*)(modv + bi * 6144 + col0 + bj * HALF + 4 * n);
#pragma unroll
        for (int ai = 0; ai < 2; ++ai) if (ai < u.nai) {
            f32x4 res[4][2][2];
#pragma unroll
            for (int m = 0; m < 4; ++m) { const size_t ro = (size_t)(row0 + ai * HALF + m * 16) * D + col0;
#pragma unroll
                for (int bj = 0; bj < 2; ++bj) {
                    if constexpr (F32IN) { res[m][bj][0] = *(const f32x4*)(ibase + ro + bj * HALF); res[m][bj][1] = *(const f32x4*)(ibase + ro + bj * HALF + 4); }
                    else { const u32x4 t = *(const u32x4*)(XB + ro + bj * HALF); res[m][bj][0] = (f32x4){bflo(t.x), bfhi(t.x), bflo(t.y), bfhi(t.y)}; res[m][bj][1] = (f32x4){bflo(t.z), bfhi(t.z), bflo(t.w), bfhi(t.w)}; } } }
#pragma unroll
            for (int m = 0; m < 4; ++m) { const size_t ro = (size_t)(row0 + ai * HALF + m * 16) * D + col0;
#pragma unroll
                for (int bj = 0; bj < 2; ++bj) { const f32x4 y0 = res[m][bj][0] + gv[bj][0] * acc[ai][bj][m][0], y1 = res[m][bj][1] + gv[bj][1] * acc[ai][bj][m][1];
                    u32x4 w; w.x = pk2(y0[0], y0[1]); w.y = pk2(y0[2], y0[3]); w.z = pk2(y1[0], y1[1]); w.w = pk2(y1[2], y1[3]);
                    *(u32x4*)(XB + ro + bj * HALF) = w; } }
        }
    }
};
struct EpiMoe1 {
    static constexpr bool PERM = false;
    bf16* HB;
    __device__ __forceinline__ void operator()(const f32x4 (&acc)[2][2][4][2], const Unit& u, int wr, int wc, int fr, int fq) const {
        const int row0 = u.pm * BM + u.roff + wr * 64 + fr, col0 = u.pn * 128 + wc * 16 + 4 * fq;
#pragma unroll
        for (int ai = 0; ai < 2; ++ai) if (ai < u.nai)
#pragma unroll
            for (int m = 0; m < 4; ++m) { bf16* rowp = HB + (size_t)(row0 + ai * HALF + m * 16) * DEXP + col0;
#pragma unroll
                for (int bj = 0; bj < 2; ++bj) { const f32x4 a = acc[ai][bj][m][0], b = acc[ai][bj][m][1];
                    u32x2 w; w.x = pk2(silu_f(a[0]) * b[0], silu_f(a[1]) * b[1]); w.y = pk2(silu_f(a[2]) * b[2], silu_f(a[3]) * b[3]);
                    *(u32x2*)(rowp + bj * 64) = w; } }
    }
};
struct EpiBf16 {
    static constexpr bool PERM = true;
    bf16* O; int ldc;
    __device__ __forceinline__ void operator()(const f32x4 (&acc)[2][2][4][2], const Unit& u, int wr, int wc, int fr, int fq) const {
        const int row0 = u.pm * BM + u.roff + wr * 64 + fr, col0 = u.pn * BM + wc * 32 + 8 * fq;
#pragma unroll
        for (int ai = 0; ai < 2; ++ai) if (ai < u.nai)
#pragma unroll
            for (int m = 0; m < 4; ++m) { bf16* rowp = O + (size_t)(row0 + ai * HALF + m * 16) * ldc + col0;
#pragma unroll
                for (int bj = 0; bj < 2; ++bj) { const f32x4 a = acc[ai][bj][m][0], c = acc[ai][bj][m][1];
                    u32x4 w; w.x = pk2(a[0], a[1]); w.y = pk2(a[2], a[3]); w.z = pk2(c[0], c[1]); w.w = pk2(c[2], c[3]);
                    *(u32x4*)(rowp + bj * HALF) = w; } }
    }
};
}

struct Args {
    const float *x, *c, *ctx, *c_ctx, *w_mod, *b_mod, *norm_g, *final_g, *att_w_in, *att_w_out, *att_lambda, *att_subln_g, *na_bias,
                *gla_w_in, *gla_w_gate, *gla_b_gate, *gla_norm_g, *gla_w_out, *router_w, *router_bias, *moe_w1, *moe_w3, *moe_w2;
    float* out; unsigned char* ws; int ph_lo, ph_hi, rep, pad;
};

struct RowMapId { int off; __device__ __forceinline__ int operator()(int n) const { return off + n; } };
struct RowMapMoe { int which; __device__ __forceinline__ int operator()(int n) const { return 32 * (n >> 4) + 16 * which + (n & 15); } };
__device__ __forceinline__ void ti_load(float (&ld)[32], const float* W, int N, int item, int lane) {
    const int nblk = N / 32, kb = item / nblk, nb = item % nblk, k0 = 64 * kb, n0 = 32 * nb;
#pragma unroll
    for (int i = 0; i < 32; ++i) ld[i] = W[(size_t)(k0 + 2 * i + (lane >> 5)) * N + n0 + (lane & 31)];
}
template <class RM>
__device__ __forceinline__ void ti_finish(const float (&ld)[32], int K, int N, bf16* WT, LAS float* scr, int item, int lane, RM rm) {
    const int nblk = N / 32, kb = item / nblk, nb = item % nblk, k0 = 64 * kb, n0 = 32 * nb;
#pragma unroll
    for (int i = 0; i < 32; ++i) scr[(2 * i + (lane >> 5)) * 33 + (lane & 31)] = ld[i];
    LDS_WAIT(); asm volatile("" ::: "memory");
    const int c = lane & 7;
#pragma unroll
    for (int j = 0; j < 4; ++j) { const int n = (lane >> 3) + 8 * j; const LAS float* s = scr + (8 * c) * 33 + n;
        u32x4 o; o.x = pk2(s[0 * 33], s[1 * 33]); o.y = pk2(s[2 * 33], s[3 * 33]); o.z = pk2(s[4 * 33], s[5 * 33]); o.w = pk2(s[6 * 33], s[7 * 33]);
        *(u32x4*)(WT + (size_t)rm(n0 + n) * K + k0 + 8 * c) = o; }
    LDS_WAIT(); asm volatile("" ::: "memory");
}
template <class RM>
__device__ __forceinline__ void p0_transpose_item(const float* W, int K, int N, bf16* WT, LAS float* scr, int item, int lane, RM rm) {
    float ld[32]; ti_load(ld, W, N, item, lane); ti_finish(ld, K, N, WT, scr, item, lane, rm);
}

constexpr int CV_ATTIN = 1536, CV_ATTOUT = 512, CV_GLAIN = 1552, CV_GLAPAD = 28, CV_GLAOUT = 512, CV_W = 4096, CV_MOE = 3 * CV_W;
constexpr int CT_ATTN0 = CV_ATTIN + CV_ATTOUT, CT_MOE0 = CT_ATTN0 + CV_MOE, CT_GLA0 = CT_MOE0 + CV_GLAIN + CV_GLAPAD + CV_GLAOUT, CT_ATTN1 = CT_GLA0 + CV_ATTIN + CV_ATTOUT, CT_MOE1 = CT_ATTN1 + CV_MOE,
              CT_MOE2 = CT_MOE1 + CV_MOE, CT_GLA1 = CT_MOE2 + CV_GLAIN + CV_GLAPAD + CV_GLAOUT, CT_MOE3 = CT_GLA1 + CV_MOE, CV_TOTAL = CT_MOE3;
constexpr int CV_UNIT = 32;
struct ConvPtrs { const float *att_w_in, *att_w_out, *gla_w_in, *gla_w_out, *moe_w1, *moe_w3, *moe_w2; unsigned char* ws; };
struct RowMapAny { int moe, which; __device__ __forceinline__ int operator()(int n) const { return moe ? 32 * (n >> 4) + 16 * which + (n & 15) : n; } };
struct ConvDesc { const float* W; bf16* WT; int K, N, sub, kind  ; RowMapAny rm; };
__device__ __forceinline__ ConvDesc conv_decode(const ConvPtrs& P, int it, int hi) {
    ConvDesc d; d.W = nullptr; d.WT = nullptr; d.K = D; d.N = D; d.sub = 0; d.kind = 0; d.rm = RowMapAny{0, 0};
    if (it >= hi) return d;
    int kind, j, r;
    if (it < CT_ATTN0) { kind = 0; j = 0; r = it; } else if (it < CT_MOE0) { kind = 2; j = 0; r = it - CT_ATTN0; } else if (it < CT_GLA0) { kind = 1; j = 0; r = it - CT_MOE0; }
    else if (it < CT_ATTN1) { kind = 0; j = 1; r = it - CT_GLA0; } else if (it < CT_MOE1) { kind = 2; j = 1; r = it - CT_ATTN1; } else if (it < CT_MOE2) { kind = 2; j = 2; r = it - CT_MOE1; }
    else if (it < CT_GLA1) { kind = 1; j = 1; r = it - CT_MOE2; } else { kind = 2; j = 3; r = it - CT_GLA1; }
    d.kind = 1; d.sub = r;
    if (kind == 2) {
        const int which = r / CV_W, q = r % CV_W, e = q >> 8, je = j * 16 + e; d.sub = q & 255;
        if (which < 2) { d.W = (which ? P.moe_w3 : P.moe_w1) + (size_t)je * D * DEXP; d.N = DEXP; d.WT = (bf16*)(P.ws + WS_W13) + (size_t)je * D * D; d.rm.moe = 1; d.rm.which = which; }
        else { d.W = P.moe_w2 + (size_t)je * DEXP * D; d.K = DEXP; d.WT = (bf16*)(P.ws + WS_W2) + (size_t)je * D * DEXP; }
    } else if (kind == 0) {
        if (r < CV_ATTIN) { d.W = P.att_w_in + (size_t)j * D * NATT; d.N = NATT; d.WT = (bf16*)(P.ws + WS_WATTIN) + (size_t)j * NATT * D; }
        else { d.W = P.att_w_out + (size_t)j * D * D; d.WT = (bf16*)(P.ws + WS_WATTOUT) + (size_t)j * D * D; d.sub = r - CV_ATTIN; }
    } else {
        if (r < CV_GLAIN) { d.W = P.gla_w_in + (size_t)j * D * 3104; d.N = 3104; d.WT = (bf16*)(P.ws + WS_WGLAIN) + (size_t)j * NGLA * D; }
        else if (r < CV_GLAIN + CV_GLAPAD) { d.kind = 2; d.sub = (r - CV_GLAIN) * 1024; d.WT = (bf16*)(P.ws + WS_WGLAIN) + (size_t)j * NGLA * D + (size_t)3104 * D; }
        else { d.W = P.gla_w_out + (size_t)j * D * D; d.WT = (bf16*)(P.ws + WS_WGLAOUT) + (size_t)j * D * D; d.sub = r - CV_GLAIN - CV_GLAPAD; }
    }
    return d;
}
__device__ __forceinline__ void conv_load(const ConvDesc& d, float (&ld)[32], int lane) { if (d.kind == 1) ti_load(ld, d.W, d.N, d.sub, lane); }
__device__ __forceinline__ void conv_finish(const ConvDesc& d, const float (&ld)[32], LAS float* scr, int lane) {
    if (d.kind == 1) ti_finish(ld, d.K, d.N, d.WT, scr, d.sub, lane, d.rm);
    else if (d.kind == 2) { for (int i = lane; i < 1024; i += 64) *(u32x4*)(d.WT + (size_t)(d.sub + i) * 8) = (u32x4){0u, 0u, 0u, 0u}; }
}
__device__ __forceinline__ void conv_item(const ConvPtrs& P, int it, LAS float* scr, int lane) {
    const ConvDesc d = conv_decode(P, it, it + 1); float ld[32]; conv_load(d, ld, lane); conv_finish(d, ld, scr, lane);
}
__device__ __forceinline__ void conv_static(const ConvPtrs& P, int cur, int need, LAS unsigned char* lds, int lane, int wave, int vcu, int G) {
    LAS float* scr = (LAS float*)(lds + wave * 8448);
    for (int it = cur + vcu * 8 + wave; it < need; it += G * 8) conv_item(P, it, scr, lane);
}
__device__ __forceinline__ void conv_unit(const ConvPtrs& P, int i0, int hi, LAS unsigned char* lds, int lane, int wave) {
    LAS float* scr = (LAS float*)(lds + wave * 8448);
    constexpr int NPW = CV_UNIT / 8; static_assert(NPW == 4, "four items per wave");
    const int it0 = i0 + wave * NPW;
    float la[32], lb[32];
    ConvDesc dA = conv_decode(P, it0, hi); conv_load(dA, la, lane);
    ConvDesc dB = conv_decode(P, it0 + 1, hi); conv_load(dB, lb, lane);
    conv_finish(dA, la, scr, lane);
    dA = conv_decode(P, it0 + 2, hi); conv_load(dA, la, lane);
    conv_finish(dB, lb, scr, lane);
    dB = conv_decode(P, it0 + 3, hi); conv_load(dB, lb, lane);
    conv_finish(dA, la, scr, lane);
    conv_finish(dB, lb, scr, lane);
}

template <class AP> __device__ __forceinline__ void p0_prologue(const AP ap, LAS unsigned char* lds, int tid, int lane, int wave, int vcu, int G) {
    unsigned char* ws = ap->ws;
    LAS float* S9 = (LAS float*)(lds + 69632);
    LAS float* red = (LAS float*)(lds + 106496);
    { const ConvPtrs P{ap->att_w_in, ap->att_w_out, ap->gla_w_in, ap->gla_w_out, ap->moe_w1, ap->moe_w3, ap->moe_w2, ws};
      conv_static(P, 0, MK_CONVQ ? CT_ATTN0 : CV_TOTAL, lds, lane, wave, vcu, G); }
    __syncthreads();
    { const float* cc = ap->c; const float* cx = ap->c_ctx;
      for (int i = tid; i < 9 * 1024; i += 512) { const int bi = i >> 10, k = i & 1023; const float v = (bi < 8) ? cc[bi * D + k] : cx[k]; S9[i] = v / (1.0f + __expf(-v)); } }
    __syncthreads();
    const float* w_mod = ap->w_mod; const float* b_mod = ap->b_mod;
    for (int u = vcu; u < 4 * 96; u += G) {
        const int L = u / 96, n0 = (u % 96) * 64;
        const float* W = w_mod + (size_t)L * D * 6144 + n0 + lane;
        float acc[9];
#pragma unroll
        for (int bi = 0; bi < 9; ++bi) acc[bi] = 0.f;
        const int kb = wave * 128;
        for (int k0 = 0; k0 < 128; k0 += 32) { float wv[32];
#pragma unroll
            for (int k = 0; k < 32; ++k) wv[k] = W[(size_t)(kb + k0 + k) * 6144];
#pragma unroll
            for (int k = 0; k < 32; ++k)
#pragma unroll
                for (int bi = 0; bi < 9; ++bi) acc[bi] += S9[bi * 1024 + kb + k0 + k] * wv[k]; }
#pragma unroll
        for (int bi = 0; bi < 9; ++bi) red[(wave * 9 + bi) * 64 + lane] = acc[bi];
        __syncthreads();
        for (int i = tid; i < 9 * 64; i += 512) { const int bi = i >> 6, l = i & 63; float sm = b_mod[L * 6144 + n0 + l];
#pragma unroll
            for (int w = 0; w < 8; ++w) sm += red[(w * 9 + bi) * 64 + l];
            ((float*)(ws + WS_MODV))[(size_t)(L * 9 + bi) * 6144 + n0 + l] = sm; }
        __syncthreads();
    }
}

__device__ __forceinline__ float* xrow_ptr(float* XL, float* XC, int row) { return row < TX ? XL + (size_t)row * D : XC + (size_t)(row - TX) * D; }
__device__ __forceinline__ int row_bi(int row) { return row < TX ? (row >> 11) : 8; }

__device__ __forceinline__ void norm_mod_store(const f32x4 (&v)[4], const float* g, const float* sh, const float* sc, bf16* orow, int lane) {
    float ss = 0.f;
#pragma unroll
    for (int j = 0; j < 4; ++j) ss += (v[j].x * v[j].x + v[j].y * v[j].y) + (v[j].z * v[j].z + v[j].w * v[j].w);
    const float rs = __builtin_amdgcn_rsqf(wave_sum(ss) * (1.0f / D) + EPSF);
#pragma unroll
    for (int j = 0; j < 4; ++j) { const int c = 4 * lane + 256 * j; const f32x4 gg = *(const f32x4*)(g + c), s1 = *(const f32x4*)(sc + c), s0 = *(const f32x4*)(sh + c);
        const f32x4 y = (v[j] * rs) * gg * (1.0f + s1) + s0;
        u32x2 w; w.x = pk2(y.x, y.y); w.y = pk2(y.z, y.w); *(u32x2*)(orow + c) = w; }
}

constexpr int TROWS = 9;
__device__ __forceinline__ int thin_row(int vcu, int wave, int i) { return vcu * 8 + wave + 2048 * i; }

struct N1Row { f32x4 x[4], s0[4], s1[4]; };
__device__ __forceinline__ void n1_issue(N1Row& r, const float* XL, const float* XC, const float* modv, int row, int lane) {
    const f32x4* xr = (const f32x4*)(row < TX ? XL + (size_t)row * D : XC + (size_t)(row - TX) * D) + lane; const float* mv = modv + row_bi(row) * 6144;
#pragma unroll
    for (int j = 0; j < 4; ++j) { r.x[j] = xr[64 * j]; r.s0[j] = *(const f32x4*)(mv + 4 * lane + 256 * j); r.s1[j] = *(const f32x4*)(mv + 1024 + 4 * lane + 256 * j); }
}
__device__ __forceinline__ void n1_finish(const N1Row& r, const f32x4 (&gg)[4], bf16* orow, int lane) {
    float ss = 0.f;
#pragma unroll
    for (int j = 0; j < 4; ++j) ss += (r.x[j].x * r.x[j].x + r.x[j].y * r.x[j].y) + (r.x[j].z * r.x[j].z + r.x[j].w * r.x[j].w);
    const float rs = __builtin_amdgcn_rsqf(wave_sum(ss) * (1.0f / D) + EPSF);
#pragma unroll
    for (int j = 0; j < 4; ++j) { const f32x4 y = (r.x[j] * rs) * gg[j] * (1.0f + r.s1[j]) + r.s0[j];
        u32x2 w; w.x = pk2(y.x, y.y); w.y = pk2(y.z, y.w); *(u32x2*)(orow + 4 * lane + 256 * j) = w; }
}
__device__ __forceinline__ void phase_norm1(const float* XL, const float* XC, const float* g, const float* modv, bf16* H, int nrows, int lane, int wave, int vcu, int G) {
    f32x4 gg[4];
#pragma unroll
    for (int j = 0; j < 4; ++j) gg[j] = *(const f32x4*)(g + 4 * lane + 256 * j);
    N1Row ra, rb;
    n1_issue(ra, XL, XC, modv, thin_row(vcu, wave, 0), lane);
#pragma unroll
    for (int i = 0; i < TROWS; ++i) {
        const int row = thin_row(vcu, wave, i), rown = thin_row(vcu, wave, i + 1);
        if (i + 1 < TROWS) n1_issue((i & 1) ? ra : rb, XL, XC, modv, rown < nrows ? rown : row, lane);
        if (row < nrows) n1_finish((i & 1) ? rb : ra, gg, H + (size_t)row * D, lane);
    }
}

__device__ __forceinline__ void phase_router(const bf16* XB, const float* g, const float* modv, bf16* H, const float* router_w, const float* router_bias,
                                             unsigned* cnt  , int* list, int* toki, float* tokw, int nrows,
                                             LAS unsigned char* lds, int tid, int lane, int wave, int vcu, int G, int probe) {
    LAS float* RW = (LAS float*)lds;
    LAS int* lcnt = (LAS int*)(lds + 65536);
    LAS int* rinfo = (LAS int*)(lds + 65536 + 256);
    for (int it = 0; it < 8; ++it) { const int idx = tid + 512 * it, k = idx >> 2, q = idx & 3; const f32x4 w = *(const f32x4*)(router_w + k * 16 + 4 * q);
        RW[(4 * q + 0) * 1024 + k] = w.x; RW[(4 * q + 1) * 1024 + k] = w.y; RW[(4 * q + 2) * 1024 + k] = w.z; RW[(4 * q + 3) * 1024 + k] = w.w; }
    if (tid < 32) lcnt[tid] = 0;
    __syncthreads();
    const int rpb = nrows / G, rpw = rpb / 8;
    const int gI = lane >> 4;
    const f32x4 rb = *(const f32x4*)(router_bias + 4 * gI);
    f32x4 gg[4];
#pragma unroll
    for (int j = 0; j < 4; ++j) gg[j] = *(const f32x4*)(g + 4 * lane + 256 * j);
    const int rowbase = vcu * rpb + wave * rpw;
    u32x2 xa[3][4], xb[3][4];
#pragma unroll
    for (int r = 0; r < 3; ++r) { const bf16* xr = XB + (size_t)(rowbase + (r < rpw ? r : rpw - 1)) * D + 4 * lane;
#pragma unroll
        for (int j = 0; j < 4; ++j) xa[r][j] = *(const u32x2*)(xr + 256 * j); }
#pragma unroll
    for (int bt = 0; bt < 3; ++bt) {
        const int i0 = 3 * bt;
        asm volatile("" ::: "memory");
        u32x2 (&xc)[3][4] = (bt & 1) ? xb : xa; u32x2 (&xn)[3][4] = (bt & 1) ? xa : xb; f32x4 y[3][4];
        f32x4 s0v[3][4], s1v[3][4];
#pragma unroll
        for (int r = 0; r < 3; ++r) { const int ii = (i0 + r < rpw) ? i0 + r : rpw - 1; const float* mv = modv + row_bi(rowbase + ii) * 6144 + 3072;
#pragma unroll
            for (int j = 0; j < 4; ++j) { const int c = 4 * lane + 256 * j; s0v[r][j] = *(const f32x4*)(mv + c); s1v[r][j] = *(const f32x4*)(mv + 1024 + c); } }
        if (bt + 1 < 3) {
#pragma unroll
            for (int r = 0; r < 3; ++r) { const int ii = (i0 + 3 + r < rpw) ? i0 + 3 + r : rpw - 1; const bf16* xr = XB + (size_t)(rowbase + ii) * D + 4 * lane;
#pragma unroll
                for (int j = 0; j < 4; ++j) xn[r][j] = *(const u32x2*)(xr + 256 * j); } }
#pragma unroll
        for (int r = 0; r < 3; ++r) {
            const int ii = (i0 + r < rpw) ? i0 + r : rpw - 1; const int row = rowbase + ii;
            float ss = 0.f;
#pragma unroll
            for (int j = 0; j < 4; ++j) { const u32x2 t = xc[r][j]; y[r][j] = (f32x4){bflo(t.x), bfhi(t.x), bflo(t.y), bfhi(t.y)};
                ss += (y[r][j].x * y[r][j].x + y[r][j].y * y[r][j].y) + (y[r][j].z * y[r][j].z + y[r][j].w * y[r][j].w); }
            const float rs = __builtin_amdgcn_rsqf(wave_sum(ss) * (1.0f / D) + EPSF);
#pragma unroll
            for (int j = 0; j < 4; ++j) { const int c = 4 * lane + 256 * j;
                y[r][j] = (y[r][j] * rs) * gg[j] * (1.0f + s1v[r][j]) + s0v[r][j];
                u32x2 w; w.x = cvtpk(y[r][j].x, y[r][j].y); w.y = cvtpk(y[r][j].z, y[r][j].w); *(u32x2*)(H + (size_t)row * D + c) = w; }
        }
        float p[3][16];
#pragma unroll
        for (int e = 0; e < 16; ++e) {
            f32x2 a2[3];
#pragma unroll
            for (int r = 0; r < 3; ++r) a2[r] = (f32x2){0.f, 0.f};
#pragma unroll
            for (int j = 0; j < 4; ++j) { const f32x4 w = *(const LAS f32x4*)(RW + e * 1024 + 4 * lane + 256 * j); const f32x2 wlo = __builtin_shufflevector(w, w, 0, 1), whi = __builtin_shufflevector(w, w, 2, 3);
#pragma unroll
                for (int r = 0; r < 3; ++r) { a2[r] = __builtin_elementwise_fma(__builtin_shufflevector(y[r][j], y[r][j], 0, 1), wlo, a2[r]); a2[r] = __builtin_elementwise_fma(__builtin_shufflevector(y[r][j], y[r][j], 2, 3), whi, a2[r]); } }
#pragma unroll
            for (int r = 0; r < 3; ++r) { p[r][e] = a2[r].x + a2[r].y; asm volatile("" : "+v"(p[r][e])); } }
#pragma unroll
        for (int r = 0; r < 3; ++r) {
            float q8[8], lg[4];
#pragma unroll
            for (int j = 0; j < 8; ++j) q8[j] = swap32_add(p[r][j], p[r][j + 8]);
#pragma unroll
            for (int j = 0; j < 4; ++j) lg[j] = row_sum(swap16_add(q8[j], q8[j + 4]));
            float sc[4], sel[4];
#pragma unroll
            for (int j = 0; j < 4; ++j) { sc[j] = 1.0f / (1.0f + __expf(-lg[j])); sel[j] = sc[j] + rb[j]; }
            int i1 = 0, i2 = 0; float m1 = -1e30f, m2 = -1e30f, w1 = 0.f, w2 = 0.f;
#pragma unroll
            for (int j = 0; j < 4; ++j) { const float t = sel[j];
                if (t > m1) { m2 = m1; i2 = i1; w2 = w1; m1 = t; i1 = j; w1 = sc[j]; } else if (t > m2) { m2 = t; i2 = j; w2 = sc[j]; } }
            const float gs = m1 + m2;
            const float g0 = readlane_f(gs, 0), g1 = readlane_f(gs, 16), g2 = readlane_f(gs, 32), g3 = readlane_f(gs, 48);
            int bg = 0; float bgs = g0; if (g1 > bgs) { bgs = g1; bg = 1; } if (g2 > bgs) { bgs = g2; bg = 2; } if (g3 > bgs) { bgs = g3; bg = 3; }
            bg = __builtin_amdgcn_readfirstlane(bg);
            const int e0 = 4 * bg + __builtin_amdgcn_readlane(i1, 16 * bg), e1 = 4 * bg + __builtin_amdgcn_readlane(i2, 16 * bg);
            const float w0 = readlane_f(w1, 16 * bg), w1s = readlane_f(w2, 16 * bg);
            const float wn = 1.0f / (w0 + w1s);
            if (lane == 0 && i0 + r < rpw) { const int rl = wave * rpw + i0 + r;
                const int p0 = __hip_atomic_fetch_add(&lcnt[e0], 1, __ATOMIC_RELAXED, __HIP_MEMORY_SCOPE_WORKGROUP), p1 = __hip_atomic_fetch_add(&lcnt[e1], 1, __ATOMIC_RELAXED, __HIP_MEMORY_SCOPE_WORKGROUP);
                rinfo[rl * 6 + 0] = e0; rinfo[rl * 6 + 1] = p0; rinfo[rl * 6 + 2] = e1; rinfo[rl * 6 + 3] = p1;
                rinfo[rl * 6 + 4] = __builtin_bit_cast(int, w0 * wn); rinfo[rl * 6 + 5] = __builtin_bit_cast(int, w1s * wn); }
        }
    }
    __syncthreads();
    if (tid < 16) lcnt[16 + tid] = (int)__hip_atomic_fetch_add(cnt + 64 * tid, (unsigned)lcnt[tid], RLX_AGENT);
    __syncthreads();
    if (tid < rpb) { const int row = vcu * rpb + tid; const int e0 = rinfo[tid * 6 + 0], e1 = rinfo[tid * 6 + 2];
        const int p0 = lcnt[16 + e0] + rinfo[tid * 6 + 1], p1 = lcnt[16 + e1] + rinfo[tid * 6 + 3];
        list[(size_t)e0 * TALL + p0] = row; list[(size_t)e1 * TALL + p1] = row;
        toki[row * 4 + 0] = e0; toki[row * 4 + 1] = p0; toki[row * 4 + 2] = e1; toki[row * 4 + 3] = p1;
        tokw[row * 2 + 0] = __builtin_bit_cast(float, rinfo[tid * 6 + 4]); tokw[row * 2 + 1] = __builtin_bit_cast(float, rinfo[tid * 6 + 5]); }
    __syncthreads();
}

__device__ __forceinline__ int build_moe_table(const unsigned* cnt, LAS int* tab, int tid) {
    if (tid < 16) tab[RT_MAX + 1 + tid] = (int)__hip_atomic_load(cnt + 64 * tid, RLX_AGENT);
    __syncthreads();
    if (tid == 0) { int rt = 0;
        for (int e = 0; e < 16; ++e) { const int c = tab[RT_MAX + 1 + e]; const int nt = (c + 255) >> 8;
            for (int m = 0; m < nt; ++m) { if (rt < RT_MAX) tab[rt] = e | (m << 8); ++rt; } }
        tab[RT_MAX] = rt < RT_MAX ? rt : RT_MAX; }
    __syncthreads();
    return tab[RT_MAX];
}

struct CbTok { int e0, p0, e1, p1; float w0, w1; };
struct CbRow { f32x4 g2[4], s0[4], s1[4]; u32x2 x[4], ya[4], yb[4]; };
__device__ __forceinline__ void cb_tok(CbTok& t, const int* toki, const float* tokw, int row) {
    const int4 q = *(const int4*)(toki + row * 4); const float2 w = *(const float2*)(tokw + row * 2); t.e0 = q.x; t.p0 = q.y; t.e1 = q.z; t.p1 = q.w; t.w0 = w.x; t.w1 = w.y;
}
template <bool FINAL>
__device__ __forceinline__ void cb_issue(CbRow& r, const CbTok& t, int mybase, const bf16* XB, const float* modv, const float* modv_next, const bf16* YB, int row, int lane) {
    const int s0 = __shfl(mybase, t.e0) + t.p0, s1 = __shfl(mybase, t.e1) + t.p1;
    const bf16* xp = XB + (size_t)row * D; const int bi = row_bi(row); const float* g2 = modv + bi * 6144 + 5120; const float* mv = modv_next + bi * 6144;
#pragma unroll
    for (int j = 0; j < 4; ++j) { const int c = 4 * lane + 256 * j;
        r.ya[j] = *(const u32x2*)(YB + (size_t)s0 * D + c); r.yb[j] = *(const u32x2*)(YB + (size_t)s1 * D + c);
        r.x[j] = *(const u32x2*)(xp + c); r.g2[j] = *(const f32x4*)(g2 + c);
        if constexpr (!FINAL) { r.s0[j] = *(const f32x4*)(mv + c); r.s1[j] = *(const f32x4*)(mv + 1024 + c); } }
}
template <bool FINAL>
__device__ __forceinline__ void cb_finish(const CbRow& r, const CbTok& t, const f32x4 (&gn)[4], bf16* xp, float* orow, bf16* hrow, int lane) {
    f32x4 v[4]; float ss = 0.f;
#pragma unroll
    for (int j = 0; j < 4; ++j) { const u32x2 a = r.ya[j], b = r.yb[j]; const float w0 = t.w0, w1 = t.w1;
        f32x4 y; y.x = w0 * bflo(a.x) + w1 * bflo(b.x); y.y = w0 * bfhi(a.x) + w1 * bfhi(b.x); y.z = w0 * bflo(a.y) + w1 * bflo(b.y); y.w = w0 * bfhi(a.y) + w1 * bfhi(b.y);
        const u32x2 xt = r.x[j]; v[j] = (f32x4){bflo(xt.x), bfhi(xt.x), bflo(xt.y), bfhi(xt.y)} + r.g2[j] * y;
        ss += (v[j].x * v[j].x + v[j].y * v[j].y) + (v[j].z * v[j].z + v[j].w * v[j].w); }
    const float rs = __builtin_amdgcn_rsqf(wave_sum(ss) * (1.0f / D) + EPSF);
#pragma unroll
    for (int j = 0; j < 4; ++j) { const int c = 4 * lane + 256 * j;
        if constexpr (FINAL) *(f32x4*)(orow + c) = (v[j] * rs) * gn[j];
        else { u32x2 xw; xw.x = pk2(v[j].x, v[j].y); xw.y = pk2(v[j].z, v[j].w); *(u32x2*)(xp + c) = xw;
            const f32x4 y = (v[j] * rs) * gn[j] * (1.0f + r.s1[j]) + r.s0[j];
            u32x2 w; w.x = pk2(y.x, y.y); w.y = pk2(y.z, y.w); *(u32x2*)(hrow + c) = w; } }
}
template <bool FINAL>
__device__ __forceinline__ void phase_combine(bf16* XB, float* OUT, const float* modv  , const bf16* YB, const unsigned* cnt, const int* toki, const float* tokw,
                                              const float* gnext, const float* modv_next, bf16* H, int nrows, int lane, int wave, int vcu, int G) {
    int tiles = 0; if (lane < 16) tiles = ((int)__hip_atomic_load(cnt + 64 * lane, RLX_AGENT) + 255) >> 8;
    int incl = tiles;
#pragma unroll
    for (int o = 1; o < 16; o <<= 1) { const int t = __shfl_up(incl, o); if (lane >= o) incl += t; }
    const int mybase = (incl - tiles) * 256;
    f32x4 gn[4];
#pragma unroll
    for (int j = 0; j < 4; ++j) gn[j] = *(const f32x4*)(gnext + 4 * lane + 256 * j);
    CbTok ta, tb, tc; CbRow ra, rb;
    cb_tok(ta, toki, tokw, thin_row(vcu, wave, 0)); cb_tok(tb, toki, tokw, thin_row(vcu, wave, 1));
    cb_issue<FINAL>(ra, ta, mybase, XB, modv, modv_next, YB, thin_row(vcu, wave, 0), lane);
#pragma unroll
    for (int i = 0; i < TROWS; ++i) {
        const int row = thin_row(vcu, wave, i), row1 = thin_row(vcu, wave, i + 1), row2 = thin_row(vcu, wave, i + 2);
        CbTok& tcur = (i % 3 == 0) ? ta : (i % 3 == 1) ? tb : tc; CbTok& tnx = (i % 3 == 0) ? tb : (i % 3 == 1) ? tc : ta; CbTok& tn2 = (i % 3 == 0) ? tc : (i % 3 == 1) ? ta : tb;
        if (i + 2 < TROWS) cb_tok(tn2, toki, tokw, row2 < nrows ? row2 : row);
        if (i + 1 < TROWS) cb_issue<FINAL>((i & 1) ? ra : rb, tnx, mybase, XB, modv, modv_next, YB, row1 < nrows ? row1 : row, lane);
        if (row < nrows) cb_finish<FINAL>((i & 1) ? rb : ra, tcur, gn, XB + (size_t)row * D, OUT + (size_t)row * D, H + (size_t)row * D, lane);
    }
}

struct RoRow { u32x2 a[4], b[4], gt[4]; };
__device__ __forceinline__ void ro_issue(RoRow& r, const bf16* OF, const bf16* OB, const bf16* QKV2, int row, int lane) {
#pragma unroll
    for (int j = 0; j < 4; ++j) { const int c = 4 * lane + 256 * j;
        r.a[j] = *(const u32x2*)(OF + (size_t)row * D + c); r.b[j] = *(const u32x2*)(OB + (size_t)row * D + c); r.gt[j] = *(const u32x2*)(QKV2 + (size_t)row * NGLA + 2048 + c); }
}
__device__ __forceinline__ void ro_finish(const RoRow& r, const f32x4 gg, bf16* orow, int lane) {
#pragma unroll
    for (int j = 0; j < 4; ++j) { const u32x2 a = r.a[j], b = r.b[j], gt = r.gt[j];
        f32x4 o; o.x = bflo(a.x) + bflo(b.x); o.y = bfhi(a.x) + bfhi(b.x); o.z = bflo(a.y) + bflo(b.y); o.w = bfhi(a.y) + bfhi(b.y);
        const float ss = wave_sum((o.x * o.x + o.y * o.y) + (o.z * o.z + o.w * o.w));
        const float rs = __builtin_amdgcn_rsqf(ss * (1.0f / 256.0f) + EPSF);
        f32x4 gv; gv.x = silu_f(bflo(gt.x)); gv.y = silu_f(bfhi(gt.x)); gv.z = silu_f(bflo(gt.y)); gv.w = silu_f(bfhi(gt.y));
        const f32x4 y = (o * rs) * gg * gv;
        u32x2 w; w.x = pk2(y.x, y.y); w.y = pk2(y.z, y.w); *(u32x2*)(orow + 4 * lane + 256 * j) = w; }
}
__device__ __forceinline__ void phase_readout(const bf16* OF, const bf16* OB, const bf16* QKV2, const float* ng, bf16* AOUT, int nrows, int lane, int wave, int vcu, int G) {
    const f32x4 gg = *(const f32x4*)(ng + 4 * lane);
    RoRow ra, rb, rc;
    ro_issue(ra, OF, OB, QKV2, thin_row(vcu, wave, 0), lane); ro_issue(rb, OF, OB, QKV2, thin_row(vcu, wave, 1), lane);
#pragma unroll
    for (int i = 0; i < TROWS; ++i) {
        const int row = thin_row(vcu, wave, i), row2 = thin_row(vcu, wave, i + 2);
        RoRow& cur = (i % 3 == 0) ? ra : (i % 3 == 1) ? rb : rc; RoRow& n2 = (i % 3 == 0) ? rc : (i % 3 == 1) ? ra : rb;
        if (i + 2 < TROWS) ro_issue(n2, OF, OB, QKV2, row2 < nrows ? row2 : row, lane);
        if (row < nrows) ro_finish(cur, gg, AOUT + (size_t)row * D, lane);
    }
}

__device__ __forceinline__ int na_r0(int r) { int v = r - 4; return v < 0 ? 0 : (v > 24 ? 24 : v); }
template <int NMAPS, int DV, bool NA>
__device__ __forceinline__ void attn_unit(LAS unsigned char* lds, int tid, int lane, int wave,
                                          const bf16* QKV, int qcol, int qrow0, int kcol, int krow_lat, int krow_ctx, const bf16* VT, int klo, int khi,
                                          int r_wave, int xq0, const LAS float* biasT,
                                          bf16* AOUT, int ocol, float lam, const float* subg, float outscale) {
    constexpr int KB = 9216;
    constexpr int BUFSZ = NMAPS * KB + DV * 144;
    constexpr int NVB = DV / 16, NVR = DV / 64;
    const int fr = lane & 15, g = lane >> 4;
    bf16x8 qf[NMAPS][2];
    { const bf16* qp = QKV + (size_t)(qrow0 + wave * 16 + fr) * NATT + qcol + 8 * g;
#pragma unroll
      for (int m = 0; m < NMAPS; ++m)
#pragma unroll
          for (int s = 0; s < 2; ++s) qf[m][s] = *(const bf16x8*)(qp + m * 64 + 32 * s); }
    f32x4 O[NMAPS][NVB]; float mrun[NMAPS]; float lrun[NMAPS];
#pragma unroll
    for (int m = 0; m < NMAPS; ++m) { mrun[m] = -1e30f; lrun[m] = 0.f;
#pragma unroll
        for (int vb = 0; vb < NVB; ++vb) O[m][vb] = (f32x4){0.f, 0.f, 0.f, 0.f}; }
    const int ntiles = 4 + (khi - klo);
    u32x4 kreg[NMAPS], vreg[NVR];
    const int lkey = tid >> 3, lch = tid & 7;
#define AT_LOAD(i) do { const int _i = (i); const int _rowg = (_i < 4 ? krow_ctx + 64 * _i : krow_lat + 64 * (klo + _i - 4)) + lkey; const int _tok0 = (_i < 4 ? SEQ + 64 * _i : 64 * (klo + _i - 4)); \
        _Pragma("unroll") for (int m = 0; m < NMAPS; ++m) kreg[m] = *(const u32x4*)(QKV + (size_t)_rowg * NATT + kcol + m * 64 + lch * 8); \
        _Pragma("unroll") for (int j = 0; j < NVR; ++j) { const int idx = tid + 512 * j; vreg[j] = *(const u32x4*)(VT + (size_t)(idx >> 3) * NKEY + _tok0 + (idx & 7) * 8); } } while (0)
#define AT_STORE(b) do { LAS unsigned char* _p = lds + (b) * BUFSZ; \
        _Pragma("unroll") for (int m = 0; m < NMAPS; ++m) *(LAS u32x4*)(_p + m * KB + lkey * 144 + lch * 16) = kreg[m]; \
        _Pragma("unroll") for (int j = 0; j < NVR; ++j) { const int idx = tid + 512 * j; *(LAS u32x4*)(_p + NMAPS * KB + (idx >> 3) * 144 + (idx & 7) * 16) = vreg[j]; } } while (0)
    AT_LOAD(0); AT_STORE(0); __syncthreads();
    const int kbase0 = (8 * (fr >> 2) + (fr & 3)) * 144 + 16 * g;
    const int vbase = fr * 144 + 16 * g;
    int r0w = 0, xq = 0, tmask = 3, c0w = 0; float pen[4][4];
    if constexpr (NA) { r0w = na_r0(r_wave); xq = xq0 + fr; int cs = xq - 8; cs = cs < 0 ? 0 : (cs > 48 ? 48 : cs);
        c0w = xq0 - 8; c0w = c0w < 0 ? 0 : (c0w > 32 ? 32 : c0w);
        tmask = 1;
#pragma unroll
        for (int kb = 0; kb < 4; ++kb)
#pragma unroll
            for (int ii = 0; ii < 4; ++ii) { const int y = c0w + 32 * (kb >> 1) + 8 * g + 4 * (kb & 1) + ii; pen[kb][ii] = (y >= cs && y < cs + 16) ? 0.f : -1e30f; } }
    for (int i = 0; i < ntiles; ++i) {
        if (i + 1 < ntiles) AT_LOAD(i + 1);
        const LAS unsigned char* buf = lds + (i & 1) * BUFSZ;
        bool active = true; int kr = 0; bool local = false;
        if constexpr (NA) { if (i >= 4) { local = true; kr = klo + i - 4; active = (kr >= r0w) && (kr < r0w + 8); } }
        if (active) {
            const int tm = local ? tmask : 3;
            const int koffw = local ? c0w * 144 : 0, voffw = local ? c0w * 2 : 0;
            bf16x8 kf[NMAPS][4][2];
#pragma unroll
            for (int m = 0; m < NMAPS; ++m)
#pragma unroll
                for (int kb = 0; kb < 4; ++kb)
#pragma unroll
                    for (int s = 0; s < 2; ++s) kf[m][kb][s] = *(const LAS bf16x8*)(buf + m * KB + kbase0 + koffw + (kb & 1) * (4 * 144) + (kb >> 1) * (32 * 144) + s * 64);
            __builtin_amdgcn_sched_barrier(0);
            f32x4 S[NMAPS][4];
#pragma unroll
            for (int m = 0; m < NMAPS; ++m)
#pragma unroll
                for (int kb = 0; kb < 4; ++kb) { S[m][kb] = (f32x4){0.f, 0.f, 0.f, 0.f};
                    if (!NA || (tm >> (kb >> 1)) & 1) {
#pragma unroll
                        for (int s = 0; s < 2; ++s) S[m][kb] = __builtin_amdgcn_mfma_f32_16x16x32_bf16(kf[m][kb][s], qf[m][s], S[m][kb], 0, 0, 0); } }
            bf16x8 vf0[4][2];
#pragma unroll
            for (int vb = 0; vb < 4; ++vb)
#pragma unroll
                for (int t = 0; t < 2; ++t) vf0[vb][t] = *(const LAS bf16x8*)(buf + NMAPS * KB + vbase + voffw + vb * (16 * 144) + t * 64);
            __builtin_amdgcn_sched_barrier(0);
            bf16x8 pf[NMAPS][2];
#pragma unroll
            for (int m = 0; m < NMAPS; ++m) {
                if constexpr (NA) { if (local) {
                        const LAS float* bp = biasT + (kr - r_wave + 7) * 31 + (c0w + 8 * g - xq + 15);
#pragma unroll
                        for (int kb = 0; kb < 4; ++kb)
#pragma unroll
                            for (int ii = 0; ii < 4; ++ii) { const float t = (tm >> (kb >> 1)) & 1 ? (S[m][kb][ii] + pen[kb][ii]) + bp[32 * (kb >> 1) + 4 * (kb & 1) + ii] : -1e30f; S[m][kb][ii] = t; } } }
                float mx = fmaxf(fmaxf(S[m][0][0], S[m][0][1]), fmaxf(S[m][0][2], S[m][0][3]));
#pragma unroll
                for (int kb = 1; kb < 4; ++kb) mx = fmaxf(fmaxf(mx, S[m][kb][0]), fmaxf(fmaxf(S[m][kb][1], S[m][kb][2]), S[m][kb][3]));
                mx = swap32_max(swap16_max(mx));
                if (__any(mx > mrun[m] + 8.0f)) {
                    const float mnew = fmaxf(mrun[m], mx), alpha = fexp2(mrun[m] - mnew); mrun[m] = mnew; lrun[m] = lrun[m] * alpha;
#pragma unroll
                    for (int vb = 0; vb < NVB; ++vb) O[m][vb] = O[m][vb] * alpha;
                }
                const float mm = mrun[m];
                unsigned pw[8]; float l0 = 0.f, l1 = 0.f;
#pragma unroll
                for (int kb = 0; kb < 4; ++kb) { const float a0 = fexp2(S[m][kb][0] - mm), a1 = fexp2(S[m][kb][1] - mm), a2 = fexp2(S[m][kb][2] - mm), a3 = fexp2(S[m][kb][3] - mm);
                    l0 += a0 + a1; l1 += a2 + a3;
                    pw[2 * kb] = cvtpk(a0, a1); pw[2 * kb + 1] = cvtpk(a2, a3); }
                lrun[m] += l0 + l1;
                pf[m][0] = __builtin_bit_cast(bf16x8, (u32x4){pw[0], pw[1], pw[2], pw[3]});
                pf[m][1] = __builtin_bit_cast(bf16x8, (u32x4){pw[4], pw[5], pw[6], pw[7]});
            }
            __builtin_amdgcn_sched_barrier(0);
            if constexpr (NVB == 8) {
                bf16x8 vf1[4][2];
#pragma unroll
                for (int vb = 0; vb < 4; ++vb)
#pragma unroll
                    for (int t = 0; t < 2; ++t) vf1[vb][t] = *(const LAS bf16x8*)(buf + NMAPS * KB + vbase + (4 + vb) * (16 * 144) + t * 64);
                __builtin_amdgcn_sched_barrier(0);
#pragma unroll
                for (int vb = 0; vb < 4; ++vb)
#pragma unroll
                    for (int t = 0; t < 2; ++t)
#pragma unroll
                        for (int m = 0; m < NMAPS; ++m) O[m][vb] = __builtin_amdgcn_mfma_f32_16x16x32_bf16(vf0[vb][t], pf[m][t], O[m][vb], 0, 0, 0);
                __builtin_amdgcn_sched_barrier(0);
#pragma unroll
                for (int vb = 0; vb < 4; ++vb)
#pragma unroll
                    for (int t = 0; t < 2; ++t)
#pragma unroll
                        for (int m = 0; m < NMAPS; ++m) O[m][4 + vb] = __builtin_amdgcn_mfma_f32_16x16x32_bf16(vf1[vb][t], pf[m][t], O[m][4 + vb], 0, 0, 0);
            } else {
#pragma unroll
                for (int vb = 0; vb < 4; ++vb)
#pragma unroll
                    for (int t = 0; t < 2; ++t) { if (!NA || (tm >> t) & 1) {
#pragma unroll
                            for (int m = 0; m < NMAPS; ++m) O[m][vb] = __builtin_amdgcn_mfma_f32_16x16x32_bf16(vf0[vb][t], pf[m][t], O[m][vb], 0, 0, 0); } }
            }
            __builtin_amdgcn_sched_barrier(0);
        }
        if (i + 1 < ntiles) AT_STORE((i + 1) & 1);
        __syncthreads();
    }
#undef AT_LOAD
#undef AT_STORE
    float inv[NMAPS];
#pragma unroll
    for (int m = 0; m < NMAPS; ++m) { float l = lrun[m]; l = swap16_add(l, l); l = swap32_add(l, l); inv[m] = 1.0f / l; }
    const int orow = qrow0 + wave * 16 + fr;
    if constexpr (NMAPS == 2) {
        float ss = 0.f; const float i1 = inv[0], i2 = lam * inv[1];
#pragma unroll
        for (int vb = 0; vb < NVB; ++vb) { O[0][vb] = O[0][vb] * i1 - O[1][vb] * i2; const f32x4 o = O[0][vb]; ss += (o.x * o.x + o.y * o.y) + (o.z * o.z + o.w * o.w); }
        ss = swap16_add(ss, ss); ss = swap32_add(ss, ss);
        const float rs = __builtin_amdgcn_rsqf(ss * (1.0f / DV) + EPSF) * outscale;
#pragma unroll
        for (int vb = 0; vb < NVB; ++vb) { const f32x4 gg = *(const f32x4*)(subg + 16 * vb + 4 * g); const f32x4 y = O[0][vb] * rs * gg;
            u32x2 w; w.x = cvtpk(y.x, y.y); w.y = cvtpk(y.z, y.w); *(u32x2*)(AOUT + (size_t)orow * D + ocol + 16 * vb + 4 * g) = w; }
    } else {
#pragma unroll
        for (int vb = 0; vb < NVB; ++vb) { const f32x4 y = O[0][vb] * inv[0];
            u32x2 w; w.x = cvtpk(y.x, y.y); w.y = cvtpk(y.z, y.w); *(u32x2*)(AOUT + (size_t)orow * D + ocol + 16 * vb + 4 * g) = w; }
    }
}


typedef float f32x16 __attribute__((ext_vector_type(16)));
__device__ __forceinline__ void diff_unit32(LAS unsigned char* lds, int tid, int lane, int wave,
                                            const bf16* QKV, int qcol, int qrow0, int kcol, int krow_lat, int krow_ctx, const bf16* VT, int khi,
                                            bf16* AOUT, int ocol, float lam, const float* subg, float outscale) {
    constexpr int KB = 9216, VOFF = 2 * KB, BUFSZ = 2 * KB + 128 * 144;
    const int r = lane & 31, hf = lane >> 5, map = wave >> 2, wq = wave & 3;
    const int swz = ((r >> 4) & 1) << 2;
    bf16x8 qf[4];
    { const bf16* qp = QKV + (size_t)(qrow0 + 32 * wq + r) * NATT + qcol + map * 64 + 8 * hf;
#pragma unroll
      for (int ks = 0; ks < 4; ++ks) qf[ks] = *(const bf16x8*)(qp + 16 * ks); }
    f32x16 O[4];
#pragma unroll
    for (int blk = 0; blk < 4; ++blk)
#pragma unroll
        for (int i = 0; i < 16; ++i) O[blk][i] = 0.f;
    float negm = 0.f, lrun = 0.f;
    const int ntiles = 4 + khi;
    u32x4 kreg[2], vreg[2];
    const int lkey = tid >> 3, lch = tid & 7;
    const int kst = lkey * 144 + ((lch ^ (((lkey >> 4) & 1) << 2)) * 16);
#define D32_LOAD(i) do { const int _i = (i); const int _rowg = (_i < 4 ? krow_ctx + 64 * _i : krow_lat + 64 * (_i - 4)) + lkey; const int _tok0 = (_i < 4 ? SEQ + 64 * _i : 64 * (_i - 4)); \
        _Pragma("unroll") for (int m = 0; m < 2; ++m) kreg[m] = *(const u32x4*)(QKV + (size_t)_rowg * NATT + kcol + m * 64 + lch * 8); \
        _Pragma("unroll") for (int j = 0; j < 2; ++j) { const int idx = tid + 512 * j; vreg[j] = *(const u32x4*)(VT + (size_t)(idx >> 3) * NKEY + _tok0 + (idx & 7) * 8); } } while (0)
#define D32_STORE(b) do { LAS unsigned char* _p = lds + (b) * BUFSZ; \
        _Pragma("unroll") for (int m = 0; m < 2; ++m) *(LAS u32x4*)(_p + m * KB + kst) = kreg[m]; \
        _Pragma("unroll") for (int j = 0; j < 2; ++j) { const int idx = tid + 512 * j, vr = idx >> 3; *(LAS u32x4*)(_p + VOFF + vr * 144 + (((idx & 7) ^ (((vr >> 4) & 1) << 2)) * 16)) = vreg[j]; } } while (0)
    D32_LOAD(0); D32_STORE(0); D32_STORE(2); __syncthreads();
    const int krow = (r & 0x13) | ((r & 4) << 1) | ((r & 8) >> 1);
    const int kbase = map * KB + krow * 144, vbase = VOFF + r * 144;
    bf16x8 pfp[2][2];
#pragma unroll
    for (int kb = 0; kb < 2; ++kb)
#pragma unroll
        for (int sx = 0; sx < 2; ++sx) pfp[kb][sx] = (bf16x8){0, 0, 0, 0, 0, 0, 0, 0};
    int slot = 0;
    for (int i = 0; i < ntiles; ++i) {
        if (i + 1 < ntiles) D32_LOAD(i + 1);
        const int slotn = slot == 2 ? 0 : slot + 1, slotp = slot == 0 ? 2 : slot - 1;
        const LAS unsigned char* buf = lds + slot * BUFSZ; const LAS unsigned char* bufp = lds + slotp * BUFSZ;
        f32x16 S[2];
#pragma unroll
        for (int kb = 0; kb < 2; ++kb) {
#pragma unroll
            for (int ii = 0; ii < 16; ++ii) S[kb][ii] = negm;
#pragma unroll
            for (int ks = 0; ks < 4; ++ks) { const bf16x8 kf = *(const LAS bf16x8*)(buf + kbase + kb * (32 * 144) + (((2 * ks + hf) ^ swz) * 16));
                S[kb] = __builtin_amdgcn_mfma_f32_32x32x16_bf16(kf, qf[ks], S[kb], 0, 0, 0); } }
        __builtin_amdgcn_sched_barrier(0);
        float mx = -1e30f;
#pragma unroll
        for (int kb = 0; kb < 2; ++kb)
#pragma unroll
            for (int ii = 0; ii < 16; ii += 4) mx = fmaxf(fmaxf(mx, S[kb][ii]), fmaxf(fmaxf(S[kb][ii + 1], S[kb][ii + 2]), S[kb][ii + 3]));
        mx = swap32_max(mx);
        const bool resc = (i == 0) || __any(mx > 8.0f);
        float alpha = 1.0f;
        if (resc) { const float dlt = (i == 0) ? mx : fmaxf(mx, 0.f); alpha = fexp2(-dlt); negm -= dlt; lrun *= alpha;
#pragma unroll
            for (int kb = 0; kb < 2; ++kb)
#pragma unroll
                for (int ii = 0; ii < 16; ++ii) S[kb][ii] -= dlt; }
        __builtin_amdgcn_sched_barrier(0);
        bf16x8 pf[2][2]; float l0 = 0.f, l1 = 0.f;
#pragma unroll
        for (int kb = 0; kb < 2; ++kb)
#pragma unroll
            for (int sx = 0; sx < 2; ++sx) { unsigned pw[4];
#pragma unroll
                for (int j = 0; j < 4; ++j) { const float a0 = fexp2(S[kb][8 * sx + 2 * j]), a1 = fexp2(S[kb][8 * sx + 2 * j + 1]); l0 += a0; l1 += a1; pw[j] = cvtpk(a0, a1); }
                pf[kb][sx] = __builtin_bit_cast(bf16x8, (u32x4){pw[0], pw[1], pw[2], pw[3]}); }
        lrun += l0 + l1;
#pragma unroll
        for (int blk = 0; blk < 4; ++blk)
#pragma unroll
            for (int kb = 0; kb < 2; ++kb)
#pragma unroll
                for (int sx = 0; sx < 2; ++sx) { const bf16x8 vf = *(const LAS bf16x8*)(bufp + vbase + blk * (32 * 144) + (((4 * kb + 2 * sx + hf) ^ swz) * 16));
                    O[blk] = __builtin_amdgcn_mfma_f32_32x32x16_bf16(vf, pfp[kb][sx], O[blk], 0, 0, 0); }
#pragma unroll
        for (int k = 0; k < 16; ++k) { __builtin_amdgcn_sched_group_barrier(0x100, 1, 0); __builtin_amdgcn_sched_group_barrier(0x008, 1, 0); __builtin_amdgcn_sched_group_barrier(0x400, 2, 0); __builtin_amdgcn_sched_group_barrier(0x002, 4, 0); }
        __builtin_amdgcn_sched_barrier(0);
        if (resc) {
#pragma unroll
            for (int blk = 0; blk < 4; ++blk) O[blk] = O[blk] * alpha; }
#pragma unroll
        for (int kb = 0; kb < 2; ++kb)
#pragma unroll
            for (int sx = 0; sx < 2; ++sx) pfp[kb][sx] = pf[kb][sx];
        if (i + 1 < ntiles) D32_STORE(slotn);
        slot = slotn;
        __syncthreads();
    }
    { const LAS unsigned char* bufp = lds + (slot == 0 ? 2 : slot - 1) * BUFSZ;
#pragma unroll
      for (int blk = 0; blk < 4; ++blk)
#pragma unroll
          for (int kb = 0; kb < 2; ++kb)
#pragma unroll
              for (int sx = 0; sx < 2; ++sx) { const bf16x8 vf = *(const LAS bf16x8*)(bufp + vbase + blk * (32 * 144) + (((4 * kb + 2 * sx + hf) ^ swz) * 16));
                  O[blk] = __builtin_amdgcn_mfma_f32_32x32x16_bf16(vf, pfp[kb][sx], O[blk], 0, 0, 0); } }
    __syncthreads();
#undef D32_LOAD
#undef D32_STORE
    float l = lrun; l = swap32_add(l, l); const float inv = 1.0f / l;
    LAS float* X = (LAS float*)lds + (size_t)wq * 4096 + lane;
    if (map == 1) {
#pragma unroll
        for (int blk = 0; blk < 4; ++blk)
#pragma unroll
            for (int i = 0; i < 16; ++i) X[(blk * 16 + i) * 64] = O[blk][i] * inv;
    }
    __syncthreads();
    if (map == 0) {
        float ss = 0.f;
#pragma unroll
        for (int blk = 0; blk < 4; ++blk)
#pragma unroll
            for (int i = 0; i < 16; ++i) { const float o = O[blk][i] * inv - lam * X[(blk * 16 + i) * 64]; O[blk][i] = o; ss += o * o; }
        ss = swap32_add(ss, ss);
        const float rs = __builtin_amdgcn_rsqf(ss * (1.0f / 128.0f) + EPSF) * outscale;
        bf16* op = AOUT + (size_t)(qrow0 + 32 * wq + r) * D + ocol + 4 * hf;
#pragma unroll
        for (int blk = 0; blk < 4; ++blk)
#pragma unroll
            for (int g4 = 0; g4 < 4; ++g4) { const int dv0 = 32 * blk + 8 * g4; const f32x4 gg = *(const f32x4*)(subg + dv0 + 4 * hf);
                u32x2 w; w.x = cvtpk(O[blk][4 * g4] * rs * gg.x, O[blk][4 * g4 + 1] * rs * gg.y); w.y = cvtpk(O[blk][4 * g4 + 2] * rs * gg.z, O[blk][4 * g4 + 3] * rs * gg.w);
                *(u32x2*)(op + dv0) = w; }
    }
    __syncthreads();
}

__device__ __forceinline__ void phase_attention(const bf16* QKV, const bf16* VAT, const bf16* VBT, bf16* AOUT, const float* lamp  , float lam_init, const float* subg, const float* nab  ,
                                                unsigned* naq, const ConvPtrs& CP, int clo, int chi, LAS unsigned char* lds, int tid, int lane, int wave) {
    LAS float* biasT = (LAS float*)(lds + LX_BIAS) + 64;
    constexpr int NATT_U = 576 + 1152;
    const int ncu = (chi - clo + CV_UNIT - 1) / CV_UNIT, nq = NATT_U + ncu;
    int mine = 0; if (tid == 0) mine = (int)__hip_atomic_fetch_add(naq, 1u, RLX_AGENT);
    for (;;) {
        __syncthreads();
        if (tid == 0) *(LAS int*)(lds + LX_MISC + 64) = mine;
        __syncthreads();
        const int q = *(LAS int*)(lds + LX_MISC + 64);
        if (q >= nq) break;
        if (tid == 0) mine = (int)__hip_atomic_fetch_add(naq, 1u, RLX_AGENT);
        const int ai = (int)(((long)q * NATT_U) / nq); const bool isatt = (int)(((long)(q + 1) * NATT_U) / nq) > ai;
        if (!isatt) { conv_unit(CP, clo + (q - ai) * CV_UNIT, chi, lds, lane, wave); continue; }
        if (ai < 512 || (ai >= 1536 && ai < 1600)) {
            int bh, qrow0, khi;
            if (ai < 512) { bh = ai >> 4; const int qt = ai & 15; qrow0 = (bh >> 2) * SEQ + qt * 128; khi = 32; }
            else { const int u = ai - 1536; bh = u >> 1; const int qt = u & 1; qrow0 = TX + (bh >> 2) * CTXL + qt * 128; khi = 0; }
            const int b = bh >> 2, h = bh & 3;
            const float lam = __expf(wave_sum(lamp[lane] * lamp[64 + lane])) - __expf(wave_sum(lamp[128 + lane] * lamp[192 + lane])) + lam_init;
            diff_unit32(lds, tid, lane, wave, QKV, h * 128, qrow0, 512 + h * 128, b * SEQ, TX + b * CTXL, VAT + (size_t)bh * 128 * NKEY, khi,
                        AOUT, h * 128, lam, subg, 1.0f - lam_init);
        } else {
            int bh, qrow0, klo, khi, rw;
            if (ai < 1536) { const int u = ai - 512; bh = u >> 4; const int rp = u & 15; qrow0 = (bh >> 3) * SEQ + rp * 128; klo = na_r0(2 * rp); khi = na_r0(2 * rp + 1) + 8; rw = 2 * rp + (wave >> 2); }
            else { const int u = ai - 1600; bh = u >> 1; const int qt = u & 1; qrow0 = TX + (bh >> 3) * CTXL + qt * 128; klo = 0; khi = 0; rw = 0; }
            const int b = bh >> 3, h = bh & 7;
            for (int i = tid; i < 640; i += 512) { const int k = i - 64; biasT[k] = (k >= 0 && k < 465) ? nab[h * 465 + k] * LOG2E : 0.f; }
            attn_unit<1, 64, true>(lds, tid, lane, wave, QKV, 1536 + h * 64, qrow0, 2048 + h * 64, b * SEQ, TX + b * CTXL, VBT + (size_t)bh * 64 * NKEY, klo, khi,
                                   rw, 16 * (wave & 3), biasT, AOUT, 512 + h * 64, 0.f, nullptr, 1.0f);
        }
    }
}

__device__ __forceinline__ void gla_chunk_rows(int b, int dir, int n, int& row0, int& tok0) {
    if (n < 4) { const int cc = dir ? 3 - n : n; row0 = TX + b * CTXL + 64 * cc; tok0 = SEQ + 64 * cc; } else { const int lc = dir ? 35 - n : n - 4; row0 = b * SEQ + 64 * lc; tok0 = 64 * lc; }
}
constexpr int GP_QM = 0, GP_KM = 17408, GP_VT = 34816, GP_LR = 71680, GP_SEG = 75776;
__device__ __forceinline__ void phase_gla_prep(const bf16* QKV2, const bf16* VGT, const float* wgate  , const float* bgate  ,
                                               bf16* QG, bf16* KET, float* FACD, bf16* OF, bf16* OB,
                                               LAS unsigned char* lds, int tid, int lane, int wave, int vcu, int G) {
    const int fr = lane & 15, g = lane >> 4;
    const int d = tid & 127, seg = tid >> 7;
    LAS float* LR = (LAS float*)(lds + GP_LR);
    LAS float* SEG = (LAS float*)(lds + GP_SEG);
    for (int ub = vcu * 9; ub < 2304; ub += G * 9) {
        const int q = ub / 36, n0 = ub % 36, dir = q & 1, hh = (q >> 1) & 3, b = q >> 3;
        bf16* OUT = dir ? OB : OF;
        float wg[16];
#pragma unroll
        for (int r = 0; r < 16; ++r) wg[r] = wgate[(dir * 16 + r) * 512 + hh * 128 + d];
        const float bgv = bgate[dir * 512 + hh * 128 + d];
        const bf16* vtb = VGT + (size_t)(b * 4 + hh) * 256 * NKEY;
        u32x4 qr[2], kr[2], vr[4], lr4;
#define GP_LOAD(n) do { int _row0, _tok0; gla_chunk_rows(b, dir, (n), _row0, _tok0); \
        _Pragma("unroll") for (int j = 0; j < 2; ++j) { const int idx = tid + 512 * j, p = idx >> 4, ch = idx & 15; const bf16* src = QKV2 + (size_t)(_row0 + p) * NGLA + hh * 128 + ch * 8; qr[j] = *(const u32x4*)src; kr[j] = *(const u32x4*)(src + 512); } \
        _Pragma("unroll") for (int j = 0; j < 4; ++j) { const int idx = tid + 512 * j; vr[j] = *(const u32x4*)(vtb + (size_t)(idx >> 3) * NKEY + _tok0 + (idx & 7) * 8); } \
        if (tid < 128) lr4 = *(const u32x4*)(QKV2 + (size_t)(_row0 + (tid >> 1)) * NGLA + 3072 + dir * 16 + (tid & 1) * 8); } while (0)
#define GP_N(i) (dir ? ((i) < 4 ? 3 - (i) : 39 - (i)) : (i))
        GP_LOAD(GP_N(n0));
        for (int k9 = 0; k9 < 9; ++k9) {
            const int n = GP_N(n0 + k9), u = ub - n0 + n; int row0, tok0; gla_chunk_rows(b, dir, n, row0, tok0);
#pragma unroll
            for (int j = 0; j < 2; ++j) { const int idx = tid + 512 * j, p = idx >> 4, ch = idx & 15;
                *(LAS u32x4*)(lds + GP_QM + p * 272 + ch * 16) = qr[j]; *(LAS u32x4*)(lds + GP_KM + p * 272 + ch * 16) = kr[j]; }
#pragma unroll
            for (int j = 0; j < 4; ++j) { const int idx = tid + 512 * j; *(LAS u32x4*)(lds + GP_VT + (idx >> 3) * 144 + (idx & 7) * 16) = vr[j]; }
            if (tid < 128) { LAS float* lp = LR + (tid >> 1) * 16 + (tid & 1) * 8;
                lp[0] = bflo(lr4.x); lp[1] = bfhi(lr4.x); lp[2] = bflo(lr4.y); lp[3] = bfhi(lr4.y); lp[4] = bflo(lr4.z); lp[5] = bfhi(lr4.z); lp[6] = bflo(lr4.w); lp[7] = bfhi(lr4.w); }
            __syncthreads();
            if (k9 + 1 < 9) GP_LOAD(GP_N(n0 + k9 + 1));
            float gc[16];
#pragma unroll
            for (int pi = 0; pi < 16; ++pi) { const LAS f32x4* lp = (const LAS f32x4*)(LR + (16 * seg + pi) * 16); f32x2 z2 = (f32x2){bgv, 0.f};
#pragma unroll
                for (int k = 0; k < 4; ++k) { const f32x4 l4 = lp[k];
                    z2 = __builtin_elementwise_fma(__builtin_shufflevector(l4, l4, 0, 1), (f32x2){wg[4 * k], wg[4 * k + 1]}, z2);
                    z2 = __builtin_elementwise_fma(__builtin_shufflevector(l4, l4, 2, 3), (f32x2){wg[4 * k + 2], wg[4 * k + 3]}, z2); }
                const float z = z2.x + z2.y;
                const float az = fabsf(z); gc[pi] = (fminf(z, 0.f) - flog(1.0f + fexp(-az))) * 0.0625f; }
            float run = 0.f;
            if (dir == 0) {
#pragma unroll
                for (int pi = 0; pi < 16; ++pi) { run += gc[pi]; gc[pi] = run; }
            } else {
#pragma unroll
                for (int pi = 15; pi >= 0; --pi) { run += gc[pi]; gc[pi] = run; }
            }
            SEG[seg * 128 + d] = run;
            __syncthreads();
            const float t0 = SEG[d], t1 = SEG[128 + d], t2 = SEG[256 + d], t3 = SEG[384 + d];
            float off, gmid; const float gend = (t0 + t1) + (t2 + t3);
            if (dir == 0) { off = (seg > 0 ? t0 : 0.f) + (seg > 1 ? t1 : 0.f) + (seg > 2 ? t2 : 0.f); gmid = t0 + t1; }
            else { off = (seg < 3 ? t3 : 0.f) + (seg < 2 ? t2 : 0.f) + (seg < 1 ? t1 : 0.f); gmid = t3 + t2; }
            const float emid = fexp(gmid), eend = fexp(gend - gmid);
            unsigned kep[8];
            bf16* qgp = QG + ((size_t)u * 64 + 16 * seg) * 128 + d;
#pragma unroll
            for (int pi = 0; pi < 16; ++pi) { const int p = 16 * seg + pi; const float rel = off + gc[pi] - gmid; const float Ep = fexp(rel), Ei = fexp(-rel);
                LAS bf16* qa = (LAS bf16*)(lds + GP_QM) + p * 136 + d; LAS bf16* ka = (LAS bf16*)(lds + GP_KM) + p * 136 + d;
                const float qv = bf2f(*qa), kv = bf2f(*ka);
                const float qm = qv * Ep, km = kv * Ei;
                const unsigned w1 = cvtpk(qm, qm * emid), w2 = cvtpk(km, km * eend);
                *qa = (bf16)(w1 & 0xffffu); qgp[pi * 128] = (bf16)(w1 >> 16); *ka = (bf16)(w2 & 0xffffu);
                if (pi & 1) kep[pi >> 1] |= (w2 & 0xffff0000u); else kep[pi >> 1] = w2 >> 16; }
            { u32x4* kt = (u32x4*)(KET + ((size_t)u * 128 + d) * 64 + 16 * seg); kt[0] = (u32x4){kep[0], kep[1], kep[2], kep[3]}; kt[1] = (u32x4){kep[4], kep[5], kep[6], kep[7]}; }
            if (seg == 0) FACD[(size_t)u * 128 + d] = fexp(gend);
            __syncthreads();
            { const int cb = wave & 3, half = wave >> 2;
              bf16x8 qfr[4];
#pragma unroll
              for (int ks = 0; ks < 4; ++ks) qfr[ks] = *(const LAS bf16x8*)(lds + GP_QM + (16 * cb + fr) * 272 + (8 * g + 32 * ks) * 2);
              f32x4 AT[4];
#pragma unroll
              for (int sb = 0; sb < 4; ++sb) { AT[sb] = (f32x4){0.f, 0.f, 0.f, 0.f};
#pragma unroll
                  for (int ks = 0; ks < 4; ++ks) { const bf16x8 af = *(const LAS bf16x8*)(lds + GP_KM + (16 * sb + fr) * 272 + (8 * g + 32 * ks) * 2);
                      AT[sb] = __builtin_amdgcn_mfma_f32_16x16x32_bf16(af, qfr[ks], AT[sb], 0, 0, 0); }
                  const int c = 16 * cb + fr;
#pragma unroll
                  for (int ii = 0; ii < 4; ++ii) { const int sp = 16 * sb + 4 * g + ii; const bool keep = dir ? (sp >= c) : (sp <= c); AT[sb][ii] = keep ? AT[sb][ii] : 0.f; } }
              bf16x8 pf[2];
#pragma unroll
              for (int t = 0; t < 2; ++t) { u32x4 w; w.x = pk2(AT[2 * t][0], AT[2 * t][1]); w.y = pk2(AT[2 * t][2], AT[2 * t][3]); w.z = pk2(AT[2 * t + 1][0], AT[2 * t + 1][1]); w.w = pk2(AT[2 * t + 1][2], AT[2 * t + 1][3]);
                  pf[t] = __builtin_bit_cast(bf16x8, w); }
#pragma unroll
              for (int v8 = 0; v8 < 8; ++v8) { const int vb = 8 * half + v8; f32x4 Oa = (f32x4){0.f, 0.f, 0.f, 0.f};
#pragma unroll
                  for (int t = 0; t < 2; ++t) { const LAS unsigned char* vp = lds + GP_VT + (16 * vb + fr) * 144 + (32 * t + 4 * g) * 2;
                      const u32x2 lo = *(const LAS u32x2*)vp, hi = *(const LAS u32x2*)(vp + 32);
                      u32x4 w; w.x = lo.x; w.y = lo.y; w.z = hi.x; w.w = hi.y;
                      Oa = __builtin_amdgcn_mfma_f32_16x16x32_bf16(__builtin_bit_cast(bf16x8, w), pf[t], Oa, 0, 0, 0); }
                  u32x2 w; w.x = pk2(Oa[0], Oa[1]); w.y = pk2(Oa[2], Oa[3]);
                  *(u32x2*)(OUT + (size_t)(row0 + 16 * cb + fr) * D + hh * 256 + 16 * vb + 4 * g) = w; }
            }
            __syncthreads();
        }
#undef GP_LOAD
#undef GP_N
    }
}

constexpr int GS_BUF = 45056, GS_QG = 0, GS_KET = 17408, GS_VT = 35840, GS_ST = 2 * GS_BUF, GS_DEC = GS_ST + 2 * 17408;
__device__ __forceinline__ void phase_gla(const bf16* VGT, bf16* OF, bf16* OB, const bf16* QG, const bf16* KET, const float* FACD,
                                          LAS unsigned char* lds, int tid, int lane, int wave, int vcu, int G) {
    const int fr = lane & 15, g = lane >> 4;
    for (int u = vcu; u < 256; u += G) {
        const int slab = u & 3, dir = (u >> 2) & 1, hh = (u >> 3) & 3, b = u >> 5;
        bf16* OUT = dir ? OB : OF;
        const int upb = ((b * 4 + hh) * 2 + dir) * 36;
        f32x4 Sacc[4];
#pragma unroll
        for (int vb = 0; vb < 4; ++vb) Sacc[vb] = (f32x4){0.f, 0.f, 0.f, 0.f};
        for (int i = tid; i < 17408 / 4; i += 512) ((LAS unsigned*)(lds + GS_ST))[i] = 0u;
        const bf16* vtb = VGT + ((size_t)(b * 4 + hh) * 256 + slab * 64) * NKEY;
        const int cb = wave & 3, vh = wave >> 2;
        const int ocol = hh * 256 + slab * 64 + 32 * vh + 4 * g;
        struct GsRegs { u32x4 qg[2], ket[2], v; u32x2 oi[2]; float dec; };
        GsRegs R0, R1; R0.dec = 0.f; R1.dec = 0.f;
#define GS_LOAD(R, n) do { int _row0, _tok0; gla_chunk_rows(b, dir, (n), _row0, _tok0); const size_t _u = (size_t)(upb + (n)); \
        _Pragma("unroll") for (int j = 0; j < 2; ++j) { const int idx = tid + 512 * j; R.qg[j] = *(const u32x4*)(QG + _u * 8192 + idx * 8); R.ket[j] = *(const u32x4*)(KET + _u * 8192 + idx * 8); } \
        R.v = *(const u32x4*)(vtb + (size_t)(tid >> 3) * NKEY + _tok0 + (tid & 7) * 8); \
        if (tid < 128) R.dec = FACD[_u * 128 + tid]; \
        _Pragma("unroll") for (int v2 = 0; v2 < 2; ++v2) R.oi[v2] = *(const u32x2*)(OUT + (size_t)(_row0 + 16 * cb + fr) * D + ocol + 16 * v2); } while (0)
#define GS_STORE(R, bf) do { LAS unsigned char* _p = lds + (bf) * GS_BUF; \
        _Pragma("unroll") for (int j = 0; j < 2; ++j) { const int idx = tid + 512 * j; *(LAS u32x4*)(_p + GS_QG + (idx >> 4) * 272 + (idx & 15) * 16) = R.qg[j]; *(LAS u32x4*)(_p + GS_KET + (idx >> 3) * 144 + (idx & 7) * 16) = R.ket[j]; } \
        *(LAS u32x4*)(_p + GS_VT + (tid >> 3) * 144 + (tid & 7) * 16) = R.v; \
        if (tid < 128) ((LAS float*)(lds + GS_DEC))[(bf) * 128 + tid] = R.dec; } while (0)
#define GS_ITER(n, RN, RF) do { const int _n = (n); int row0, tok0; gla_chunk_rows(b, dir, _n, row0, tok0); const int cur = _n & 1; \
            if (_n + 2 < 36) GS_LOAD(RF, _n + 2); \
            const LAS unsigned char* bufp = lds + cur * GS_BUF; const LAS unsigned char* stp = lds + GS_ST + cur * 17408; \
            { bf16x8 qfr[4]; \
              _Pragma("unroll") for (int ks = 0; ks < 4; ++ks) qfr[ks] = *(const LAS bf16x8*)(bufp + GS_QG + (16 * cb + fr) * 272 + (8 * g + 32 * ks) * 2); \
              _Pragma("unroll") for (int v2 = 0; v2 < 2; ++v2) { const int vb = 2 * vh + v2; const u32x2 oin = v2 ? oc1 : oc0; \
                  f32x4 Oa = (f32x4){bflo(oin.x), bfhi(oin.x), bflo(oin.y), bfhi(oin.y)}; \
                  _Pragma("unroll") for (int ks = 0; ks < 4; ++ks) { const bf16x8 af = *(const LAS bf16x8*)(stp + (16 * vb + fr) * 272 + (8 * g + 32 * ks) * 2); \
                      Oa = __builtin_amdgcn_mfma_f32_16x16x32_bf16(af, qfr[ks], Oa, 0, 0, 0); } \
                  u32x2 w; w.x = pk2(Oa[0], Oa[1]); w.y = pk2(Oa[2], Oa[3]); \
                  *(u32x2*)(OUT + (size_t)(row0 + 16 * cb + fr) * D + ocol + 16 * v2) = w; } } \
            { const f32x4 dec = *(const LAS f32x4*)((LAS float*)(lds + GS_DEC) + cur * 128 + 16 * wave + 4 * g); \
              LAS unsigned char* stn = lds + GS_ST + (cur ^ 1) * 17408; \
              _Pragma("unroll") for (int vb = 0; vb < 4; ++vb) { Sacc[vb] = Sacc[vb] * dec; \
                  _Pragma("unroll") for (int t = 0; t < 2; ++t) { const bf16x8 af = *(const LAS bf16x8*)(bufp + GS_KET + (16 * wave + fr) * 144 + (8 * g + 32 * t) * 2); \
                      const bf16x8 bfr = *(const LAS bf16x8*)(bufp + GS_VT + (16 * vb + fr) * 144 + (8 * g + 32 * t) * 2); \
                      Sacc[vb] = __builtin_amdgcn_mfma_f32_16x16x32_bf16(af, bfr, Sacc[vb], 0, 0, 0); } \
                  u32x2 w; w.x = pk2(Sacc[vb][0], Sacc[vb][1]); w.y = pk2(Sacc[vb][2], Sacc[vb][3]); \
                  *(LAS u32x2*)(stn + (16 * vb + fr) * 272 + (16 * wave + 4 * g) * 2) = w; } } \
            if (_n + 1 < 36) { GS_STORE(RN, cur ^ 1); oc0 = RN.oi[0]; oc1 = RN.oi[1]; } \
            __syncthreads(); } while (0)
        GS_LOAD(R0, 0); GS_STORE(R0, 0);
        u32x2 oc0 = R0.oi[0], oc1 = R0.oi[1];
        GS_LOAD(R0, 1);
        __syncthreads();
        for (int n = 0; n < 36; n += 2) { GS_ITER(n, R0, R1); GS_ITER(n + 1, R1, R0); }
#undef GS_ITER
#undef GS_LOAD
#undef GS_STORE
    }
}

constexpr int N_PHASES = 34;
typedef const Args __attribute__((address_space(4)))* KArgs;
__device__ __forceinline__ KArgs kargs() { KArgs p = (KArgs)__builtin_amdgcn_kernarg_segment_ptr(); asm volatile("" : "+s"(p)); return p; }
__global__ void __launch_bounds__(512, 2) fwd(Args a_unused) {
    extern __shared__ __attribute__((aligned(16))) unsigned char lds_raw[];
    LAS unsigned char* lds = (LAS unsigned char*)lds_raw;
    const int tid0 = threadIdx.x;
    const int G0 = gridDim.x; const int bx0 = blockIdx.x;
#define PH_ENTRY int tid = tid0; asm volatile("" : "+v"(tid)); int G = G0, bx = bx0; asm volatile("" : "+s"(G), "+s"(bx)); const int lane = tid & 63, wave = __builtin_amdgcn_readfirstlane(tid >> 6); \
        const int vcu = (G % 8 == 0) ? (bx % 8) * (G / 8) + bx / 8 : bx; (void)lane; (void)wave; (void)vcu
    const int tid = tid0;
    const int ph_lo = kargs()->ph_lo, ph_hi = kargs()->ph_hi;
    const int repmask = kargs()->rep;
    if (tid < 64) ((LAS unsigned*)(lds + LX_MISC))[tid] = 0u;
    for (int i = tid; i < 1024; i += 512) { const int pos = i >> 4, f = i & 15; const float inv = __builtin_amdgcn_exp2f(-(float)f * (13.287712379549449f / 16.0f)); const float ang = (float)pos * inv;
        ((LAS float*)(lds + LX_ROPE))[2 * i] = __cosf(ang); ((LAS float*)(lds + LX_ROPE))[2 * i + 1] = __sinf(ang); }
    __syncthreads();
    const bool single = (ph_hi - ph_lo) > 1;
    XcdBarrier bar; bar.bar = (unsigned*)(kargs()->ws + WS_CTL) + CW_BAR; bar.x = 0; bar.st = (volatile LAS unsigned*)(lds + LX_MISC);
    if (single) bar = xcd_barrier_post((unsigned*)(kargs()->ws + WS_CTL) + CW_BAR, (volatile LAS unsigned*)(lds + LX_MISC));
#define IN(k) (ph_lo <= (k) && (k) < ph_hi)
#define REPLOOP(t) for (int rep_ = 0, nrep_ = 1 + ((repmask >> (t)) & 1); rep_ < nrep_; ++rep_, (rep_ < nrep_ ? (bar.bar = (unsigned*)(kargs()->ws + WS_CTL) + CW_BAR, xcd_barrier(bar)) : (void)0))
#define SEAM(k) do { if (IN(k) && IN((k) + 1)) { bar.bar = (unsigned*)(kargs()->ws + WS_CTL) + CW_BAR; xcd_barrier(bar); if ((repmask >> 10) & 1) xcd_barrier(bar); } } while (0)
    LAS int* tab = (LAS int*)(lds + LX_MOETAB);
#define CONV_PTRS(A) ConvPtrs{(A)->att_w_in, (A)->att_w_out, (A)->gla_w_in, (A)->gla_w_out, (A)->moe_w1, (A)->moe_w3, (A)->moe_w2, (A)->ws}

    if (IN(0)) REPLOOP(0) { PH_ENTRY; p0_prologue(kargs(), lds, tid, lane, wave, vcu, G); } SEAM(0);
    if (IN(1)) { PH_ENTRY; KArgs A = kargs(); unsigned char* ws = A->ws; phase_norm1(A->x, A->ctx, A->norm_g, (float*)(ws + WS_MODV), (bf16*)(ws + WS_H), TALL, lane, wave, vcu, G); } SEAM(1);

#pragma nounroll
    for (int L = 0; L < 4; ++L) {
        const int pb = 2 + 8 * L; const bool isattn = !(L & 1); const int j = L >> 1; const bool lastL = (L == 3);
        const int nrows = lastL ? TX : TALL;
        if (IN(pb)) REPLOOP(isattn ? 1 : 3) {
            PH_ENTRY; KArgs A = kargs(); unsigned char* ws = A->ws; unsigned char* big = ws + WS_BIG; const bf16* H = (const bf16*)(ws + WS_H);
            if (isattn) {
                pg8::DenseOrder S; S.init(H, (const bf16*)(ws + WS_WATTIN) + (size_t)j * NATT * D, TALL, NATT, D, G, bx);
                pg8::EpiAttnIn E{(bf16*)(big + BG_QKV), (bf16*)(big + BG_VAT), (bf16*)(big + BG_VBT), (const LAS float*)(lds + LX_ROPE)};
                pg8::gemm_phase<pg8::EpiAttnIn, pg8::DenseOrder, false>(lds, tid, D, S, E);
            } else {
                pg8::DenseOrder S; S.init(H, (const bf16*)(ws + WS_WGLAIN) + (size_t)j * NGLA * D, TALL, NGLA, D, G, bx);
                pg8::EpiGlaIn E{(bf16*)(big + BG_QKV2), (bf16*)(big + BG_VGT)};
                pg8::gemm_phase<pg8::EpiGlaIn, pg8::DenseOrder, false>(lds, tid, D, S, E);
            }
        }
        SEAM(pb);
        if (!isattn && IN(pb + 1)) {
            for (int rep_ = 0; rep_ <= ((repmask >> 13) & 1); ++rep_)
            { PH_ENTRY; KArgs A = kargs(); unsigned char* ws = A->ws;
              phase_gla_prep((const bf16*)(ws + WS_BIG + BG_QKV2), (const bf16*)(ws + WS_BIG + BG_VGT), A->gla_w_gate + j * 2 * 16 * 512, A->gla_b_gate + j * 2 * 512,
                             (bf16*)(ws + WS_QG), (bf16*)(ws + WS_KET), (float*)(ws + WS_BIG + BG_FAC), (bf16*)(ws + WS_BIG + BG_OF), (bf16*)(ws + WS_BIG + BG_OB), lds, tid, lane, wave, vcu, G); }
            if (single) { bar.bar = (unsigned*)(kargs()->ws + WS_CTL) + CW_BAR; xcd_barrier(bar); }
        }
        if (IN(pb + 1)) REPLOOP(isattn ? 2 : 4) {
            PH_ENTRY; KArgs A = kargs(); unsigned char* ws = A->ws; unsigned char* big = ws + WS_BIG; bf16* AOUT = (bf16*)(ws + WS_AOUT);
            if (isattn) { const ConvPtrs CP = CONV_PTRS(A);
                phase_attention((const bf16*)(big + BG_QKV), (const bf16*)(big + BG_VAT), (const bf16*)(big + BG_VBT), AOUT, A->att_lambda + j * 256, (L == 0) ? 0.2f : 0.470713018f,
                                A->att_subln_g + j * 128, A->na_bias + j * 8 * 465, (unsigned*)(ws + WS_CTL) + CW_NAQ + 64 * j, CP,
                                MK_CONVQ ? (L == 0 ? CT_ATTN0 : CT_MOE1) : 0, MK_CONVQ ? (L == 0 ? CT_MOE1 : CT_MOE3) : 0, lds, tid, lane, wave); }
            else phase_gla((const bf16*)(big + BG_VGT), (bf16*)(big + BG_OF), (bf16*)(big + BG_OB), (const bf16*)(ws + WS_QG), (const bf16*)(ws + WS_KET), (const float*)(big + BG_FAC),
                           lds, tid, lane, wave, vcu, G);
        }
        SEAM(pb + 1);
        if (!isattn) {
            if (IN(pb + 2)) REPLOOP(5) { PH_ENTRY; KArgs A = kargs(); unsigned char* ws = A->ws; unsigned char* big = ws + WS_BIG;
                phase_readout((const bf16*)(big + BG_OF), (const bf16*)(big + BG_OB), (const bf16*)(big + BG_QKV2), A->gla_norm_g + j * 256, (bf16*)(ws + WS_AOUT), nrows, lane, wave, vcu, G); }
            SEAM(pb + 2);
        }
        if (IN(pb + 3)) {
            PH_ENTRY; KArgs A = kargs(); unsigned char* ws = A->ws;
            pg8::DenseOrder S; S.init((const bf16*)(ws + WS_AOUT), (const bf16*)(ws + (isattn ? WS_WATTOUT : WS_WGLAOUT)) + (size_t)j * D * D, nrows, D, D, G, bx);
            if (L == 0) { pg8::EpiResid<true> E{A->x, A->ctx, (bf16*)(ws + WS_XB), (const float*)(ws + WS_MODV) + (size_t)L * 9 * 6144 + 2048};
                pg8::gemm_phase<pg8::EpiResid<true>, pg8::DenseOrder, false>(lds, tid, D, S, E); }
            else { pg8::EpiResid<false> E{nullptr, nullptr, (bf16*)(ws + WS_XB), (const float*)(ws + WS_MODV) + (size_t)L * 9 * 6144 + 2048};
                pg8::gemm_phase<pg8::EpiResid<false>, pg8::DenseOrder, false>(lds, tid, D, S, E); }
        }
        SEAM(pb + 3);
        if (IN(pb + 4)) { PH_ENTRY; KArgs A = kargs(); unsigned char* ws = A->ws;
            phase_router((const bf16*)(ws + WS_XB), A->norm_g + (L * 2 + 1) * D, (const float*)(ws + WS_MODV) + (size_t)L * 9 * 6144, (bf16*)(ws + WS_H), A->router_w, A->router_bias,
                         (unsigned*)(ws + WS_CTL) + CW_CNT + L * 16 * 64, (int*)(ws + WS_LIST), (int*)(ws + WS_TOKI), (float*)(ws + WS_TOKW), nrows, lds, tid, lane, wave, vcu, G, (repmask >> 11) & 1); }
        SEAM(pb + 4);
        if (IN(pb + 5)) REPLOOP(6) {
            PH_ENTRY; KArgs A = kargs(); unsigned char* ws = A->ws;
            const int RT = build_moe_table((unsigned*)(ws + WS_CTL) + CW_CNT + L * 16 * 64, tab, tid);
            pg8::MoeOrder S; S.A = (const char*)(ws + WS_H); S.B = (const char*)(ws + WS_W13) + (size_t)L * 16 * D * D * 2; S.K = D; S.bstride = (size_t)D * D * 2; S.tab = tab; S.list = (const int*)(ws + WS_LIST); S.RT = RT; S.nwg = RT * 4; S.G = G; S.c = bx;
            S.fill_tokc((LAS int*)(lds + LX_BIAS), tid);
            pg8::EpiMoe1 E{(bf16*)(ws + WS_BIG + BG_HB)};
            pg8::gemm_phase<pg8::EpiMoe1, pg8::MoeOrder, true>(lds, tid, D, S, E);
        }
        SEAM(pb + 5);
        if (IN(pb + 6)) REPLOOP(7) {
            PH_ENTRY; KArgs A = kargs(); unsigned char* ws = A->ws;
            const int RT = build_moe_table((unsigned*)(ws + WS_CTL) + CW_CNT + L * 16 * 64, tab, tid);
            pg8::MoeOrder S; S.A = (const char*)(ws + WS_BIG + BG_HB); S.B = (const char*)(ws + WS_W2) + (size_t)L * 16 * D * DEXP * 2; S.K = DEXP; S.bstride = (size_t)D * DEXP * 2; S.tab = tab; S.list = (const int*)(ws + WS_LIST); S.RT = RT; S.nwg = RT * 4; S.G = G; S.c = bx;
            pg8::EpiBf16 E{(bf16*)(ws + WS_BIG + BG_YB), D};
            pg8::gemm_phase<pg8::EpiBf16, pg8::MoeOrder, false>(lds, tid, DEXP, S, E);
        }
        SEAM(pb + 6);
        if (IN(pb + 7)) { PH_ENTRY; KArgs A = kargs(); unsigned char* ws = A->ws; const float* MODV = (const float*)(ws + WS_MODV);
            if (lastL) phase_combine<true>((bf16*)(ws + WS_XB), A->out, MODV + (size_t)L * 9 * 6144, (const bf16*)(ws + WS_BIG + BG_YB), (unsigned*)(ws + WS_CTL) + CW_CNT + L * 16 * 64, (const int*)(ws + WS_TOKI), (const float*)(ws + WS_TOKW),
                                           A->final_g, MODV + (size_t)L * 9 * 6144, (bf16*)(ws + WS_H), nrows, lane, wave, vcu, G);
            else phase_combine<false>((bf16*)(ws + WS_XB), A->out, MODV + (size_t)L * 9 * 6144, (const bf16*)(ws + WS_BIG + BG_YB), (unsigned*)(ws + WS_CTL) + CW_CNT + L * 16 * 64, (const int*)(ws + WS_TOKI), (const float*)(ws + WS_TOKW),
                                      A->norm_g + ((L + 1) * 2) * D, MODV + (size_t)(L + 1) * 9 * 6144, (bf16*)(ws + WS_H), nrows, lane, wave, vcu, G); }
        if (!lastL) SEAM(pb + 7);
    }
#undef IN
#undef REPLOOP
#undef SEAM
#undef CONV_PTRS

#undef PH_ENTRY
}

extern "C" void kernel_launch(void* const* d_in, const int* in_sizes, int n_in, void* d_out, int out_size, void* d_ws, size_t ws_size, hipStream_t stream) {
    static int ready = 0;
    if (ready == 0) {
        if (n_in != 23 || out_size != TX * D || ws_size < WS_END) { fprintf(stderr, "kernel_launch: unexpected shapes (n_in %d out %d ws %zu)\n", n_in, out_size, ws_size); ready = -1; return; }
        if (hipFuncSetAttribute((const void*)fwd, hipFuncAttributeMaxDynamicSharedMemorySize, LDS_BYTES) != hipSuccess) { fprintf(stderr, "kernel_launch: hipFuncSetAttribute failed\n"); ready = -1; return; }
        int per_cu = 0; (void)hipOccupancyMaxActiveBlocksPerMultiprocessor(&per_cu, (const void*)fwd, 512, LDS_BYTES); (void)hipGetLastError();
        if (per_cu < 1) fprintf(stderr, "kernel_launch: occupancy query reports %d blocks per CU\n", per_cu);
        ready = 1;
    }
    if (ready < 0) return;
    (void)hipMemsetAsync((char*)d_ws + WS_CTL, 0, CTL_ZERO_BYTES, stream);
    Args a{};
    const float** ap = (const float**)&a;
    for (int i = 0; i < 23; ++i) ap[i] = (const float*)d_in[i];
    a.out = (float*)d_out; a.ws = (unsigned char*)d_ws;
    const int grid = 256;
    a.ph_lo = 0; a.ph_hi = N_PHASES; a.rep = MK_REPMASK;
    hipLaunchKernelGGL(fwd, dim3(grid), dim3(512), LDS_BYTES, stream, a);
}
```

```cpp
#include <hip/hip_runtime.h>
#include <cstdio>
#include <cstdint>

#ifndef MK_CONVQ
#define MK_CONVQ 1
#endif
#ifndef MK_REPMASK
#define MK_REPMASK 0
#endif

#define GAS __attribute__((address_space(1)))
#define LAS __attribute__((address_space(3)))
typedef unsigned short bf16;
typedef short bf16x8 __attribute__((ext_vector_type(8)));
typedef short bf16x4 __attribute__((ext_vector_type(4)));
typedef float f32x4 __attribute__((ext_vector_type(4)));
typedef float f32x2 __attribute__((ext_vector_type(2)));
typedef unsigned u32x4 __attribute__((ext_vector_type(4)));
typedef unsigned u32x2 __attribute__((ext_vector_type(2)));

constexpr int D = 1024, NB = 8, SEQ = 2048, CTXL = 256;
constexpr int TX = NB * SEQ, TC = NB * CTXL, TALL = TX + TC;
constexpr int NKEY = SEQ + CTXL;
constexpr int NATT = 3072, NGLA = 3328;
constexpr float EPSF = 1e-6f;
constexpr float LOG2E = 1.4426950408889634f;
constexpr int NEXP = 16, DEXP = 512;
constexpr int RT_MAX = 160;

constexpr size_t MiB = 1u << 20;
constexpr size_t WS_CTL = 0, CTL_ZERO_BYTES = 65536;
constexpr size_t WS_MODV = 1 * MiB;
constexpr size_t WS_TOKI = 2 * MiB;
constexpr size_t WS_TOKW = 2 * MiB + 512 * 1024;
constexpr size_t WS_LIST = 3 * MiB;
constexpr size_t WS_CTX = 5 * MiB;
constexpr size_t WS_WATTIN = 13 * MiB;
constexpr size_t WS_WATTOUT = 25 * MiB;
constexpr size_t WS_WGLAIN = 29 * MiB;
constexpr size_t WS_WGLAOUT = 42 * MiB;
constexpr size_t WS_W13 = 46 * MiB;
constexpr size_t WS_W2 = 174 * MiB;
constexpr size_t WS_H = 238 * MiB;
constexpr size_t WS_AOUT = 274 * MiB;
constexpr size_t WS_BIG = 310 * MiB;
constexpr size_t WS_XB = 539 * MiB;
constexpr size_t WS_END = 575 * MiB;
constexpr size_t BG_QKV = 0;
constexpr size_t BG_VAT = 108 * MiB;
constexpr size_t BG_VBT = 126 * MiB;
constexpr size_t BG_QKV2 = 0;
constexpr size_t BG_VGT = 117 * MiB;
constexpr size_t BG_OF = 153 * MiB;
constexpr size_t BG_OB = 189 * MiB;
constexpr size_t BG_FAC = 225 * MiB;
constexpr size_t WS_QG = WS_H, WS_KET = WS_AOUT;
constexpr size_t BG_HB = 0;
constexpr size_t BG_YB = 40 * MiB;
constexpr int CW_TMO = 0;
constexpr int CW_BAR = 4096;
constexpr int CW_NAQ = 15360;
constexpr int CW_CNT = 8192;

constexpr int RING_BYTES = 131072;
constexpr int LX_OFF = RING_BYTES;
constexpr int LX_MISC = LX_OFF;
constexpr int LX_MOETAB = LX_OFF + 256;
constexpr int LX_ROPE = LX_OFF + 2048;
constexpr int LX_BIAS = LX_OFF + 2048 + 8192;
constexpr int LDS_BYTES = 147456;

#define LDS_WAIT() asm volatile("s_waitcnt lgkmcnt(0)" ::: "memory")
#define VM_WAIT() asm volatile("s_waitcnt vmcnt(0)" ::: "memory")
#define RLX_AGENT __ATOMIC_RELAXED, __HIP_MEMORY_SCOPE_AGENT
__device__ __forceinline__ unsigned f2bf(float f) { unsigned u = __builtin_bit_cast(unsigned, f); return (u + 0x7fffu + ((u >> 16) & 1u)) >> 16; }
typedef __bf16 hwbf16x2 __attribute__((ext_vector_type(2)));
__device__ __forceinline__ unsigned cvtpk(float lo, float hi) { const f32x2 v = {lo, hi}; const hwbf16x2 b = __builtin_convertvector(v, hwbf16x2); return __builtin_bit_cast(unsigned, b); }
__device__ __forceinline__ unsigned pk2(float lo, float hi) { return cvtpk(lo, hi); }
__device__ __forceinline__ float bf2f(unsigned short b) { return __builtin_bit_cast(float, ((unsigned)b) << 16); }
__device__ __forceinline__ float bflo(unsigned w) { return __builtin_bit_cast(float, w << 16); }
__device__ __forceinline__ float bfhi(unsigned w) { return __builtin_bit_cast(float, w & 0xffff0000u); }
template <int CTRL> __device__ __forceinline__ float dppf(float v) { return __builtin_bit_cast(float, __builtin_amdgcn_update_dpp(0, __builtin_bit_cast(int, v), CTRL, 0xf, 0xf, true)); }
__device__ __forceinline__ float row_sum(float v) { v += dppf<0xB1>(v); v += dppf<0x4E>(v); v += dppf<0x124>(v); v += dppf<0x128>(v); return v; }
__device__ __forceinline__ float swap16_add(float a, float b) { auto r = __builtin_amdgcn_permlane16_swap(__float_as_uint(a), __float_as_uint(b), false, false); const unsigned r0 = r[0], r1 = r[1]; return __uint_as_float(r0) + __uint_as_float(r1); }
__device__ __forceinline__ float swap32_add(float a, float b) { auto r = __builtin_amdgcn_permlane32_swap(__float_as_uint(a), __float_as_uint(b), false, false); const unsigned r0 = r[0], r1 = r[1]; return __uint_as_float(r0) + __uint_as_float(r1); }
__device__ __forceinline__ float swap16_max(float a) { auto r = __builtin_amdgcn_permlane16_swap(__float_as_uint(a), __float_as_uint(a), false, false); const unsigned r0 = r[0], r1 = r[1]; return fmaxf(__uint_as_float(r0), __uint_as_float(r1)); }
__device__ __forceinline__ float swap32_max(float a) { auto r = __builtin_amdgcn_permlane32_swap(__float_as_uint(a), __float_as_uint(a), false, false); const unsigned r0 = r[0], r1 = r[1]; return fmaxf(__uint_as_float(r0), __uint_as_float(r1)); }
__device__ __forceinline__ float readlane_f(float v, int l) { return __int_as_float(__builtin_amdgcn_readlane(__float_as_int(v), l)); }
__device__ __forceinline__ float wave_sum(float v) { v = row_sum(v); v = swap16_add(v, v); return swap32_add(v, v); }
__device__ __forceinline__ float fexp2(float x) { return __builtin_amdgcn_exp2f(x); }
__device__ __forceinline__ float fexp(float x) { return __builtin_amdgcn_exp2f(x * LOG2E); }
__device__ __forceinline__ float flog(float x) { return __builtin_amdgcn_logf(x) * 0.6931471805599453f; }
__device__ __forceinline__ float frcp(float x) { return __builtin_amdgcn_rcpf(x); }
__device__ __forceinline__ float silu_f(float x) { return x * frcp(1.0f + fexp(-x)); }

#define XB_TMO      128
#define XB_XCNT(j)  (256  + 64 * (j))
#define XB_XSUB(j)  (1280 + 64 * (j))
#define XB_XGEN(j)  (2304 + 64 * (j))
#define XB_TOP      3328
#define XB_TOPGEN   3392
#define XCD_BAR_WORDS 3456
#define XB_SPIN_CAP (1u << 18)
__device__ __forceinline__ unsigned xb_ld(unsigned* p)              { return __hip_atomic_load(p, __ATOMIC_RELAXED, __HIP_MEMORY_SCOPE_AGENT); }
__device__ __forceinline__ unsigned xb_add(unsigned* p, unsigned v) { return __hip_atomic_fetch_add(p, v, __ATOMIC_RELAXED, __HIP_MEMORY_SCOPE_AGENT); }
__device__ __forceinline__ unsigned xb_xcc_id() { return (unsigned)__builtin_amdgcn_s_getreg((3 << 11) | 20) & 0xFu; }
#define XB_SPIN(cond, bar) do { unsigned _sp = 0; while (cond) { __builtin_amdgcn_s_sleep(1); \
    if ((++_sp & 255u) == 0u) { if (xb_ld(&(bar)[XB_TMO])) break; if (_sp > XB_SPIN_CAP) { atomicAdd(&(bar)[XB_TMO], 1u); break; } } } } while (0)
struct XcdBarrier { unsigned* bar; unsigned x; volatile LAS unsigned* st; };
__device__ __forceinline__ XcdBarrier xcd_barrier_post(unsigned* bar, volatile LAS unsigned* st) {
    XcdBarrier b; b.bar = bar; b.x = xb_xcc_id(); b.st = st;
    if (threadIdx.x == 0) (void)xb_add(&bar[XB_XCNT(b.x)], 1u);
    return b;
}
__device__ __forceinline__ void xcd_barrier_complete(unsigned* bar, unsigned x, unsigned& nloc, unsigned& nx) {
    const unsigned G = gridDim.x * gridDim.y * gridDim.z;
    unsigned sum, cnt, mine, sp = 0u;
    for (;;) {
        sum = 0u; cnt = 0u; mine = 0u;
#pragma unroll
        for (unsigned j = 0; j < 16; ++j) { const unsigned c = xb_ld(&bar[XB_XCNT(j)]); sum += c; cnt += (c > 0u) ? 1u : 0u; mine = (j == x) ? c : mine; }
        if (sum == G) break;
        __builtin_amdgcn_s_sleep(1);
        if ((++sp & 255u) == 0u) { if (xb_ld(&bar[XB_TMO])) break; if (sp > XB_SPIN_CAP) { atomicAdd(&bar[XB_TMO], 1u); break; } }
    }
    nloc = mine > 0u ? mine : 1u; nx = cnt > 0u ? cnt : 1u;
}
__device__ __forceinline__ void xcd_barrier(const XcdBarrier& b) {
    asm volatile("s_waitcnt vmcnt(0)" ::: "memory");
    __syncthreads();
    if (threadIdx.x == 0) {
        unsigned* bar = b.bar;
        __builtin_amdgcn_s_waitcnt(0);
        unsigned nloc = b.st[0], nx = b.st[1];
        if (nloc == 0u) { xcd_barrier_complete(bar, b.x, nloc, nx); b.st[0] = nloc; b.st[1] = nx; }
        const unsigned old = xb_add(&bar[XB_XSUB(b.x)], 1u);
        const unsigned gen = old / nloc;
        if (old + 1u == (gen + 1u) * nloc) {
            __builtin_amdgcn_fence(__ATOMIC_RELEASE, "agent");
            asm volatile("s_waitcnt vmcnt(0)" ::: "memory");
            const unsigned og = xb_add(&bar[XB_TOP], 1u);
            const unsigned tg = og / nx;
            if (og + 1u == (tg + 1u) * nx) xb_add(&bar[XB_TOPGEN], 1u);
            else XB_SPIN(xb_ld(&bar[XB_TOPGEN]) == tg, bar);
            __builtin_amdgcn_fence(__ATOMIC_ACQUIRE, "agent");
            xb_add(&bar[XB_XGEN(b.x)], 1u);
            asm volatile("s_waitcnt vmcnt(0)" ::: "memory");
        } else {
            XB_SPIN(xb_ld(&bar[XB_XGEN(b.x)]) == gen, bar);
            __builtin_amdgcn_fence(__ATOMIC_ACQUIRE, "agent");
            asm volatile("s_waitcnt vmcnt(0)" ::: "memory");
        }
    }
    __syncthreads();
}

namespace pg8 {
constexpr int BM = 256, BK = 64, HALF = 128, HTB = HALF * BK * 2, STAGE_BYTES = 8 * HTB, NXCD = 8, WGM = 8;
__host__ __device__ __forceinline__ int lds_byte(int r, int c) { const int st = (r >> 4) * 2 + (c >> 5), rr = r & 15, cc = c & 31, ob = rr * 64 + cc * 2; return st * 1024 + (ob ^ (((ob >> 9) & 1) << 5)); }
__host__ __device__ __forceinline__ void stage_rc(int b, int& R, int& C) { const int st = b / 1024, sb = b % 1024, swz = sb ^ (((sb >> 9) & 1) << 5); R = (st >> 1) * 16 + swz / 64; C = (st & 1) * 32 + (swz % 64) / 2; }
__host__ __device__ __forceinline__ int perm32(int rho) { const int n = rho >> 4, i = rho & 15; return 8 * (i >> 2) + 4 * n + (i & 3); }

struct Unit { int pm, pn, e, mt, roff, nai, ord; };
__device__ __forceinline__ bool split_index(long L, int nwg, int G, int& uidx, int& roff, int& nai) {
    const int R = nwg / G, r = nwg % G; const bool split = (r > 0) && (2 * r <= G);
    if (L < (long)R * G || !split) { if (L >= nwg) return false; uidx = (int)L; roff = 0; nai = 2; return true; }
    const int h = (int)(L - (long)R * G); if (h >= 2 * r) return false; uidx = R * G + (h >> 1); roff = (h & 1) * 128; nai = 1; return true;
}

__device__ __forceinline__ int xcd_remap(int wgid, int nwg) { const int q = nwg / NXCD, r = nwg % NXCD, xcd = wgid % NXCD, off = wgid / NXCD; return (xcd < r ? xcd * (q + 1) : r * (q + 1) + (xcd - r) * q) + off; }

struct DenseOrder {
    const char* A; const char* B; int K; int nM, nN, nwg, G, c;
    __device__ __forceinline__ void init(const bf16* A_, const bf16* B_, int M, int N, int K_, int G_, int c_) { A = (const char*)A_; B = (const char*)B_; K = K_; nM = M / BM; nN = N / BM; nwg = nM * nN; G = G_; c = c_; }
    __device__ __forceinline__ bool next(int i, Unit& u) const {
        int uidx; if (!split_index((long)i * G + c, nwg, G, uidx, u.roff, u.nai)) return false;
        const int wgid = xcd_remap(uidx, nwg);
        const int nig = WGM * nN, gid = wgid / nig, fm = gid * WGM, gsz = (nM - fm) < WGM ? (nM - fm) : WGM;
        u.pm = fm + ((wgid % nig) % gsz); u.pn = (wgid % nig) / gsz; u.e = 0; u.mt = 0; u.ord = i; return true;
    }
    __device__ __forceinline__ const char* a_ptr(const Unit& u) const { return A + (size_t)(u.pm * BM + u.roff) * K * 2; }
    __device__ __forceinline__ const char* b_ptr(const Unit& u) const { return B + (size_t)u.pn * BM * K * 2; }
    __device__ __forceinline__ int tok(const Unit&, int) const { return 0; }
};
struct MoeOrder {
    const char* A; const char* B; int K; size_t bstride;
    const LAS int* tab; const int* list; int RT, nwg, G, c;
    __device__ __forceinline__ bool next(int i, Unit& u) const {
        int uidx; if (!split_index((long)i * G + c, nwg, G, uidx, u.roff, u.nai)) return false;
        const int wgid = xcd_remap(uidx, nwg);
        const int rt = wgid >> 2; u.pm = rt; u.pn = wgid & 3; const int t = tab[rt]; u.e = t & 255; u.mt = t >> 8; u.ord = i; return true;
    }
    __device__ __forceinline__ const char* a_ptr(const Unit& u) const { return A + (size_t)(u.pm * BM + u.roff) * K * 2; }
    __device__ __forceinline__ const char* b_ptr(const Unit& u) const { return B + (size_t)u.e * bstride + (size_t)u.pn * BM * K * 2; }
    const LAS int* tokc;
    __device__ __forceinline__ int tok(const Unit& u, int r) const { return tokc[u.ord * BM + r]; }
    __device__ __forceinline__ void fill_tokc(LAS int* dst, int tid) {
        tokc = dst;
        int val[2], idx[2]; bool ok[2];
#pragma unroll
        for (int k = 0; k < 2; ++k) { const int i = (tid >> 8) + 2 * k, r = tid & 255; Unit u; const bool has = (i < 3) && next(i, u);
            const int cnt = has ? tab[RT_MAX + 1 + u.e] : 0; const int pos = has ? u.mt * BM + u.roff + r : 0;
            ok[k] = has; idx[k] = i * BM + r;
            val[k] = list[(size_t)(has ? u.e : 0) * TALL + pos];
            val[k] = (pos < cnt) ? val[k] : 0; }
#pragma unroll
        for (int k = 0; k < 2; ++k) if (ok[k]) dst[idx[k]] = val[k];
        __syncthreads();
    }
};

__device__ __forceinline__ unsigned cvt_pk_bf16(float lo, float hi) { unsigned r; asm volatile("v_cvt_pk_bf16_f32 %0, %1, %2" : "=v"(r) : "v"(lo), "v"(hi)); return r; }

template <class Epi, class Sched, bool GATHER>
__device__ __forceinline__ void gemm_phase(LAS unsigned char* lds, const int tid, const int K, const Sched& S, const Epi& E) {
    const int wid = __builtin_amdgcn_readfirstlane(tid >> 6), lane = tid & 63, wr = wid >> 2, wc = wid & 3, fr = lane & 15, fq = lane >> 4;
    const int nt = K / BK;
    unsigned voffA[2], voffB[2]; int RA[2], CA[2];
#pragma unroll
    for (int i = 0; i < 2; ++i) { int R, C; stage_rc(tid * 16 + i * 8192, R, C); const int Rb = Epi::PERM ? ((R & ~31) + perm32(R & 31)) : R;
        RA[i] = R; CA[i] = C; voffA[i] = (unsigned)(R * K + C) * 2u; voffB[i] = (unsigned)(Rb * K + C) * 2u; }
    const size_t kstep = (size_t)(BK * 2);
    const size_t hstep = (size_t)HALF * K * 2;
    const unsigned ldsw = (unsigned)wid * 1024u;
    const int aoff = lds_byte(wr * 64 + fr, fq * 8), boff = lds_byte(wc * 32 + fr, fq * 8);
#define PG8_SA(b, h) (((b) * 2 + (h)) * HTB)
#define PG8_SB(b, h) ((4 + (b) * 2 + (h)) * HTB)
#define PG8_STAGE(bufoff, gbase, voff) do { _Pragma("unroll") for (int _i = 0; _i < 2; ++_i) \
        __builtin_amdgcn_global_load_lds((const unsigned*)((const char*)(gbase) + (voff)[_i]), (LAS unsigned*)(lds + (bufoff) + ldsw + _i * 8192), 16, 0, 0); } while (0)
#define PG8_STAGE_A(bufoff, h, usenext, koff) do { if constexpr (GATHER) { unsigned _vo[2]; _vo[0] = (usenext) ? nvA[h][0] : vA[h][0]; _vo[1] = (usenext) ? nvA[h][1] : vA[h][1]; PG8_STAGE(bufoff, S.A + (koff), _vo); } \
        else { PG8_STAGE(bufoff, ((usenext) ? nA : cA) + (size_t)(h) * hstep + (koff), voffA); } } while (0)
#define PG8_LDA(dst, b, h) do { _Pragma("unroll") for (int m = 0; m < 4; ++m) _Pragma("unroll") for (int k = 0; k < 2; ++k) dst[m][k] = *(const LAS bf16x8*)(lds + PG8_SA(b, h) + aoff + m * 2048 + k * 1024); } while (0)
#define PG8_LDB(dst, b, h) do { _Pragma("unroll") for (int n = 0; n < 2; ++n) _Pragma("unroll") for (int k = 0; k < 2; ++k) dst[n][k] = *(const LAS bf16x8*)(lds + PG8_SB(b, h) + boff + n * 2048 + k * 1024); } while (0)
#define PG8_MMA(ai, bj, At, Bt) do { __builtin_amdgcn_s_setprio(1); _Pragma("unroll") for (int m = 0; m < 4; ++m) _Pragma("unroll") for (int n = 0; n < 2; ++n) _Pragma("unroll") for (int k = 0; k < 2; ++k) \
        acc[ai][bj][m][n] = __builtin_amdgcn_mfma_f32_16x16x32_bf16(Bt[n][k], At[m][k], acc[ai][bj][m][n], 0, 0, 0); __builtin_amdgcn_s_setprio(0); } while (0)
#define PG8_WAIT_V(n) asm volatile("s_waitcnt vmcnt(" #n ")" ::: "memory")
#define PG8_WAIT_L(n) asm volatile("s_waitcnt lgkmcnt(" #n ")" ::: "memory")
#define PG8_BAR __builtin_amdgcn_s_barrier()
#define PG8_SCHED __builtin_amdgcn_sched_barrier(0)
    Unit cur, nxt; int ui = 0;
    if (!S.next(0, cur)) return;
    f32x4 acc[2][2][4][2];
#pragma unroll
    for (int a = 0; a < 2; ++a)
#pragma unroll
        for (int b = 0; b < 2; ++b)
#pragma unroll
            for (int m = 0; m < 4; ++m)
#pragma unroll
                for (int n = 0; n < 2; ++n) acc[a][b][m][n] = (f32x4){0.f, 0.f, 0.f, 0.f};
    bf16x8 At[4][2], B0[2][2], B1[2][2];
    unsigned vA[2][2], nvA[2][2];
    if constexpr (GATHER) {
#pragma unroll
        for (int h = 0; h < 2; ++h)
#pragma unroll
            for (int i = 0; i < 2; ++i) { vA[h][i] = (unsigned)(S.tok(cur, h * HALF + RA[i]) * K + CA[i]) * 2u; nvA[h][i] = vA[h][i]; }
    }
    const char* cA = S.a_ptr(cur); const char* cB = S.b_ptr(cur); const char* nA = cA;
    PG8_STAGE(PG8_SB(0, 0), cB, voffB); PG8_STAGE(PG8_SB(0, 1), cB + hstep, voffB); PG8_STAGE_A(PG8_SA(0, 0), 0, false, 0); PG8_STAGE_A(PG8_SA(0, 1), 1, false, 0);
    if (wr == 1) PG8_BAR;
    PG8_WAIT_V(2); PG8_BAR;
    PG8_STAGE(PG8_SB(1, 0), cB + kstep, voffB); PG8_STAGE_A(PG8_SA(1, 0), 0, false, kstep); PG8_STAGE(PG8_SB(1, 1), cB + hstep + kstep, voffB);
    PG8_WAIT_V(6); PG8_BAR;
    for (;;) {
        const bool has_next = S.next(ui + 1, nxt);
        nA = has_next ? S.a_ptr(nxt) : cA; const char* nB = has_next ? S.b_ptr(nxt) : cB;
        if constexpr (GATHER) {
            if (has_next) {
#pragma unroll
                for (int h = 0; h < 2; ++h)
#pragma unroll
                    for (int i = 0; i < 2; ++i) nvA[h][i] = (unsigned)(S.tok(nxt, h * HALF + RA[i]) * K + CA[i]) * 2u;
            }
        }
        const bool full = (cur.nai == 2);
        for (int t = 0; t < nt; t += 2) {
            const bool last = (t == nt - 2);
            const size_t k1 = (size_t)(t + 1) * kstep;
            const size_t k2 = last ? 0 : (size_t)(t + 2) * kstep, k3 = k2 + kstep;
            const char* b2 = last ? nB : cB + (size_t)(t + 2) * kstep; const char* b3 = b2 + kstep;
            PG8_LDB(B0, 0, 0); PG8_LDB(B1, 0, 1); PG8_SCHED; PG8_LDA(At, 0, 0); PG8_STAGE_A(PG8_SA(1, 1), 1, false, k1);
            PG8_WAIT_V(8); PG8_WAIT_L(0); PG8_BAR; PG8_MMA(0, 0, At, B0); PG8_MMA(0, 1, At, B1); PG8_BAR; PG8_SCHED;
            if (full) PG8_LDA(At, 0, 1); PG8_STAGE(PG8_SB(0, 0), b2, voffB); PG8_STAGE(PG8_SB(0, 1), b2 + hstep, voffB); PG8_STAGE_A(PG8_SA(0, 0), 0, last, k2);
            PG8_WAIT_V(8); PG8_WAIT_L(0); PG8_BAR; if (full) { PG8_MMA(1, 0, At, B0); PG8_MMA(1, 1, At, B1); } PG8_BAR; PG8_SCHED;
            PG8_LDB(B0, 1, 0); PG8_LDB(B1, 1, 1); PG8_SCHED; PG8_LDA(At, 1, 0); PG8_STAGE_A(PG8_SA(0, 1), 1, last, k2);
            PG8_WAIT_V(8); PG8_WAIT_L(0); PG8_BAR; PG8_MMA(0, 0, At, B0); PG8_MMA(0, 1, At, B1); PG8_BAR; PG8_SCHED;
            if (full) PG8_LDA(At, 1, 1); PG8_STAGE(PG8_SB(1, 0), b3, voffB); PG8_STAGE(PG8_SB(1, 1), b3 + hstep, voffB); PG8_STAGE_A(PG8_SA(1, 0), 0, last, k3);
            PG8_WAIT_V(8); PG8_WAIT_L(0); PG8_BAR; if (full) { PG8_MMA(1, 0, At, B0); PG8_MMA(1, 1, At, B1); } PG8_BAR; PG8_SCHED;
        }
        if (wr == 0) PG8_BAR;
        E(acc, cur, wr, wc, fr, fq);
        if (!has_next) break;
#pragma unroll
        for (int a = 0; a < 2; ++a)
#pragma unroll
            for (int b = 0; b < 2; ++b)
#pragma unroll
                for (int m = 0; m < 4; ++m)
#pragma unroll
                    for (int n = 0; n < 2; ++n) acc[a][b][m][n] = (f32x4){0.f, 0.f, 0.f, 0.f};
        cur = nxt; cA = nA; cB = nB; ++ui;
        if constexpr (GATHER) {
#pragma unroll
            for (int h = 0; h < 2; ++h)
#pragma unroll
                for (int i = 0; i < 2; ++i) vA[h][i] = nvA[h][i];
        }
        if (wr == 1) PG8_BAR;
    }
    PG8_WAIT_V(0);
    PG8_BAR;
#undef PG8_SA
#undef PG8_SB
#undef PG8_STAGE
#undef PG8_STAGE_A
#undef PG8_LDA
#undef PG8_LDB
#undef PG8_MMA
#undef PG8_WAIT_V
#undef PG8_WAIT_L
#undef PG8_BAR
#undef PG8_SCHED
}
}

namespace pg8 {
__device__ __forceinline__ void row_bt(int row, int& b, int& tok) { if (row < TX) { b = row >> 11; tok = row & 2047; } else { const int r = row - TX; b = r >> 8; tok = SEQ + (r & 255); } }

struct EpiAttnIn {
    static constexpr bool PERM = true;
    bf16* QKV; bf16* VAT; bf16* VBT; const LAS float* rope;
    __device__ __forceinline__ void operator()(const f32x4 (&acc)[2][2][4][2], const Unit& u, int wr, int wc, int fr, int fq) const {
        const int row0 = u.pm * BM + u.roff + wr * 64 + fr; const int seg = u.pn >> 1;
        const bool latent = u.pm < (TX / BM);
        if (seg == 2 || seg == 5) {
#pragma unroll
            for (int ai = 0; ai < 2; ++ai) if (ai < u.nai)
#pragma unroll
                for (int m = 0; m < 4; ++m) { const int row = row0 + ai * HALF + m * 16; int b, tok; row_bt(row, b, tok);
#pragma unroll
                    for (int bj = 0; bj < 2; ++bj) { const int col = u.pn * BM + bj * HALF + wc * 32 + 8 * fq;
                        bf16* dst;
                        if (seg == 2) { const int cs = col - 1024; dst = VAT + ((size_t)(b * 4 + (cs >> 7)) * 128 + (cs & 127)) * NKEY + tok; }
                        else { const int cs = col - 2560; dst = VBT + ((size_t)(b * 8 + (cs >> 6)) * 64 + (cs & 63)) * NKEY + tok; }
#pragma unroll
                        for (int n = 0; n < 2; ++n)
#pragma unroll
                            for (int i = 0; i < 4; ++i) dst[(size_t)(4 * n + i) * NKEY] = (bf16)f2bf(acc[ai][bj][m][n][i]); } }
            return;
        }
        const bool dorope = latent && seg < 2;
        const float qs = (seg == 0 || seg == 3) ? 0.125f * LOG2E : 1.0f;
#pragma unroll
        for (int ai = 0; ai < 2; ++ai) if (ai < u.nai)
#pragma unroll
            for (int m = 0; m < 4; ++m) { const int row = row0 + ai * HALF + m * 16;
                f32x4 cs4[4];
                if (dorope) { const int t = row & 2047; const int pos = (wc & 1) ? (t & 63) : (t >> 6);
                    const LAS f32x4* rp = (const LAS f32x4*)(rope + (pos * 16 + 8 * (fq & 1)) * 2);
#pragma unroll
                    for (int j = 0; j < 4; ++j) cs4[j] = rp[j]; }
#pragma unroll
                for (int bj = 0; bj < 2; ++bj) { const int col = u.pn * BM + bj * HALF + wc * 32 + 8 * fq;
                    float v[8];
#pragma unroll
                    for (int n = 0; n < 2; ++n)
#pragma unroll
                        for (int i = 0; i < 4; ++i) v[4 * n + i] = acc[ai][bj][m][n][i];
                    if (dorope) {
#pragma unroll
                        for (int j = 0; j < 8; ++j) { const float other = __shfl_xor(v[j], 32); const float c = cs4[j >> 1][(j & 1) * 2], s = cs4[j >> 1][(j & 1) * 2 + 1];
                            v[j] = (fq < 2) ? (v[j] * c - other * s) : (v[j] * c + other * s); } }
                    u32x4 w; w.x = pk2(v[0] * qs, v[1] * qs); w.y = pk2(v[2] * qs, v[3] * qs); w.z = pk2(v[4] * qs, v[5] * qs); w.w = pk2(v[6] * qs, v[7] * qs);
                    *(u32x4*)(QKV + (size_t)row * NATT + col) = w; } }
    }
};
struct EpiGlaIn {
    static constexpr bool PERM = true;
    bf16* QKV2; bf16* VGT;
    __device__ __forceinline__ void operator()(const f32x4 (&acc)[2][2][4][2], const Unit& u, int wr, int wc, int fr, int fq) const {
        const int row0 = u.pm * BM + u.roff + wr * 64 + fr;
        if (u.pn >= 4 && u.pn < 8) {
#pragma unroll
            for (int ai = 0; ai < 2; ++ai) if (ai < u.nai)
#pragma unroll
                for (int m = 0; m < 4; ++m) { const int row = row0 + ai * HALF + m * 16; int b, tok; row_bt(row, b, tok);
#pragma unroll
                    for (int bj = 0; bj < 2; ++bj) { const int cs = u.pn * BM + bj * HALF + wc * 32 + 8 * fq - 1024;
                        bf16* dst = VGT + ((size_t)(b * 4 + (cs >> 8)) * 256 + (cs & 255)) * NKEY + tok;
#pragma unroll
                        for (int n = 0; n < 2; ++n)
#pragma unroll
                            for (int i = 0; i < 4; ++i) dst[(size_t)(4 * n + i) * NKEY] = (bf16)f2bf(acc[ai][bj][m][n][i]); } }
            return;
        }
        const float qs = (u.pn < 2) ? 0.08838834764831845f : 1.0f;
#pragma unroll
        for (int ai = 0; ai < 2; ++ai) if (ai < u.nai)
#pragma unroll
            for (int m = 0; m < 4; ++m) { const int row = row0 + ai * HALF + m * 16;
#pragma unroll
                for (int bj = 0; bj < 2; ++bj) { const int col = u.pn * BM + bj * HALF + wc * 32 + 8 * fq; const f32x4 a = acc[ai][bj][m][0] * qs, c = acc[ai][bj][m][1] * qs;
                    u32x4 w; w.x = pk2(a[0], a[1]); w.y = pk2(a[2], a[3]); w.z = pk2(c[0], c[1]); w.w = pk2(c[2], c[3]);
                    *(u32x4*)(QKV2 + (size_t)row * NGLA + col) = w; } }
    }
};
template <bool F32IN>
struct EpiResid {
    static constexpr bool PERM = true;
    const float* IL; const float* IC; bf16* XB; const float* modv;
    __device__ __forceinline__ void operator()(const f32x4 (&acc)[2][2][4][2], const Unit& u, int wr, int wc, int fr, int fq) const {
        const int row0 = u.pm * BM + u.roff + wr * 64 + fr, col0 = u.pn * BM + wc * 32 + 8 * fq;
        const bool latent = u.pm < (TX / BM); const int bi = latent ? (u.pm >> 3) : 8;
        const float* ibase = latent ? IL : (IC - (size_t)TX * D);
        f32x4 gv[2][2];
#pragma unroll
        for (int bj = 0; bj < 2; ++bj)
#pragma unroll
            for (int n = 0; n < 2; ++n) gv[bj][n] = *(const f32x4*)(modv + bi * 6144 + col0 + bj * HALF + 4 * n);
#pragma unroll
        for (int ai = 0; ai < 2; ++ai) if (ai < u.nai) {
            f32x4 res[4][2][2];
#pragma unroll
            for (int m = 0; m < 4; ++m) { const size_t ro = (size_t)(row0 + ai * HALF + m * 16) * D + col0;
#pragma unroll
                for (int bj = 0; bj < 2; ++bj) {
                    if constexpr (F32IN) { res[m][bj][0] = *(const f32x4*)(ibase + ro + bj * HALF); res[m][bj][1] = *(const f32x4*)(ibase + ro + bj * HALF + 4); }
                    else { const u32x4 t = *(const u32x4*)(XB + ro + bj * HALF); res[m][bj][0] = (f32x4){bflo(t.x), bfhi(t.x), bflo(t.y), bfhi(t.y)}; res[m][bj][1] = (f32x4){bflo(t.z), bfhi(t.z), bflo(t.w), bfhi(t.w)}; } } }
#pragma unroll
            for (int m = 0; m < 4; ++m) { const size_t ro = (size_t)(row0 + ai * HALF + m * 16) * D + col0;
#pragma unroll
                for (int bj = 0; bj < 2; ++bj) { const f32x4 y0 = res[m][bj][0] + gv[bj][0] * acc[ai][bj][m][0], y1 = res[m][bj][1] + gv[bj][1] * acc[ai][bj][m][1];
                    u32x4 w; w.x = pk2(y0[0], y0[1]); w.y = pk2(y0[2], y0[3]); w.z = pk2(y1[0], y1[1]); w.w = pk2(y1[2], y1[3]);
                    *(u32x4*)(XB + ro + bj * HALF) = w; } }
        }
    }
};
struct EpiMoe1 {
    static constexpr bool PERM = false;
    bf16* HB;
    __device__ __forceinline__ void operator()(const f32x4 (&acc)[2][2][4][2], const Unit& u, int wr, int wc, int fr, int fq) const {
        const int row0 = u.pm * BM + u.roff + wr * 64 + fr, col0 = u.pn * 128 + wc * 16 + 4 * fq;
#pragma unroll
        for (int ai = 0; ai < 2; ++ai) if (ai < u.nai)
#pragma unroll
            for (int m = 0; m < 4; ++m) { bf16* rowp = HB + (size_t)(row0 + ai * HALF + m * 16) * DEXP + col0;
#pragma unroll
                for (int bj = 0; bj < 2; ++bj) { const f32x4 a = acc[ai][bj][m][0], b = acc[ai][bj][m][1];
                    u32x2 w; w.x = pk2(silu_f(a[0]) * b[0], silu_f(a[1]) * b[1]); w.y = pk2(silu_f(a[2]) * b[2], silu_f(a[3]) * b[3]);
                    *(u32x2*)(rowp + bj * 64) = w; } }
    }
};
struct EpiBf16 {
    static constexpr bool PERM = true;
    bf16* O; int ldc;
    __device__ __forceinline__ void operator()(const f32x4 (&acc)[2][2][4][2], const Unit& u, int wr, int wc, int fr, int fq) const {
        const int row0 = u.pm * BM + u.roff + wr * 64 + fr, col0 = u.pn * BM + wc * 32 + 8 * fq;
#pragma unroll
        for (int ai = 0; ai < 2; ++ai) if (ai < u.nai)
#pragma unroll
            for (int m = 0; m < 4; ++m) { bf16* rowp = O + (size_t)(row0 + ai * HALF + m * 16) * ldc + col0;
#pragma unroll
                for (int bj = 0; bj < 2; ++bj) { const f32x4 a = acc[ai][bj][m][0], c = acc[ai][bj][m][1];
                    u32x4 w; w.x = pk2(a[0], a[1]); w.y = pk2(a[2], a[3]); w.z = pk2(c[0], c[1]); w.w = pk2(c[2], c[3]);
                    *(u32x4*)(rowp + bj * HALF) = w; } }
    }
};
}

struct Args {
    const float *x, *c, *ctx, *c_ctx, *w_mod, *b_mod, *norm_g, *final_g, *att_w_in, *att_w_out, *att_lambda, *att_subln_g, *na_bias,
                *gla_w_in, *gla_w_gate, *gla_b_gate, *gla_norm_g, *gla_w_out, *router_w, *router_bias, *moe_w1, *moe_w3, *moe_w2;
    float* out; unsigned char* ws; int ph_lo, ph_hi, rep, pad;
};

struct RowMapId { int off; __device__ __forceinline__ int operator()(int n) const { return off + n; } };
struct RowMapMoe { int which; __device__ __forceinline__ int operator()(int n) const { return 32 * (n >> 4) + 16 * which + (n & 15); } };
__device__ __forceinline__ void ti_load(float (&ld)[32], const float* W, int N, int item, int lane) {
    const int nblk = N / 32, kb = item / nblk, nb = item % nblk, k0 = 64 * kb, n0 = 32 * nb;
#pragma unroll
    for (int i = 0; i < 32; ++i) ld[i] = W[(size_t)(k0 + 2 * i + (lane >> 5)) * N + n0 + (lane & 31)];
}
template <class RM>
__device__ __forceinline__ void ti_finish(const float (&ld)[32], int K, int N, bf16* WT, LAS float* scr, int item, int lane, RM rm) {
    const int nblk = N / 32, kb = item / nblk, nb = item % nblk, k0 = 64 * kb, n0 = 32 * nb;
#pragma unroll
    for (int i = 0; i < 32; ++i) scr[(2 * i + (lane >> 5)) * 33 + (lane & 31)] = ld[i];
    LDS_WAIT(); asm volatile("" ::: "memory");
    const int c = lane & 7;
#pragma unroll
    for (int j = 0; j < 4; ++j) { const int n = (lane >> 3) + 8 * j; const LAS float* s = scr + (8 * c) * 33 + n;
        u32x4 o; o.x = pk2(s[0 * 33], s[1 * 33]); o.y = pk2(s[2 * 33], s[3 * 33]); o.z = pk2(s[4 * 33], s[5 * 33]); o.w = pk2(s[6 * 33], s[7 * 33]);
        *(u32x4*)(WT + (size_t)rm(n0 + n) * K + k0 + 8 * c) = o; }
    LDS_WAIT(); asm volatile("" ::: "memory");
}
template <class RM>
__device__ __forceinline__ void p0_transpose_item(const float* W, int K, int N, bf16* WT, LAS float* scr, int item, int lane, RM rm) {
    float ld[32]; ti_load(ld, W, N, item, lane); ti_finish(ld, K, N, WT, scr, item, lane, rm);
}

constexpr int CV_ATTIN = 1536, CV_ATTOUT = 512, CV_GLAIN = 1552, CV_GLAPAD = 28, CV_GLAOUT = 512, CV_W = 4096, CV_MOE = 3 * CV_W;
constexpr int CT_ATTN0 = CV_ATTIN + CV_ATTOUT, CT_MOE0 = CT_ATTN0 + CV_MOE, CT_GLA0 = CT_MOE0 + CV_GLAIN + CV_GLAPAD + CV_GLAOUT, CT_ATTN1 = CT_GLA0 + CV_ATTIN + CV_ATTOUT, CT_MOE1 = CT_ATTN1 + CV_MOE,
              CT_MOE2 = CT_MOE1 + CV_MOE, CT_GLA1 = CT_MOE2 + CV_GLAIN + CV_GLAPAD + CV_GLAOUT, CT_MOE3 = CT_GLA1 + CV_MOE, CV_TOTAL = CT_MOE3;
constexpr int CV_UNIT = 32;
struct ConvPtrs { const float *att_w_in, *att_w_out, *gla_w_in, *gla_w_out, *moe_w1, *moe_w3, *moe_w2; unsigned char* ws; };
struct RowMapAny { int moe, which; __device__ __forceinline__ int operator()(int n) const { return moe ? 32 * (n >> 4) + 16 * which + (n & 15) : n; } };
struct ConvDesc { const float* W; bf16* WT; int K, N, sub, kind  ; RowMapAny rm; };
__device__ __forceinline__ ConvDesc conv_decode(const ConvPtrs& P, int it, int hi) {
    ConvDesc d; d.W = nullptr; d.WT = nullptr; d.K = D; d.N = D; d.sub = 0; d.kind = 0; d.rm = RowMapAny{0, 0};
    if (it >= hi) return d;
    int kind, j, r;
    if (it < CT_ATTN0) { kind = 0; j = 0; r = it; } else if (it < CT_MOE0) { kind = 2; j = 0; r = it - CT_ATTN0; } else if (it < CT_GLA0) { kind = 1; j = 0; r = it - CT_MOE0; }
    else if (it < CT_ATTN1) { kind = 0; j = 1; r = it - CT_GLA0; } else if (it < CT_MOE1) { kind = 2; j = 1; r = it - CT_ATTN1; } else if (it < CT_MOE2) { kind = 2; j = 2; r = it - CT_MOE1; }
    else if (it < CT_GLA1) { kind = 1; j = 1; r = it - CT_MOE2; } else { kind = 2; j = 3; r = it - CT_GLA1; }
    d.kind = 1; d.sub = r;
    if (kind == 2) {
        const int which = r / CV_W, q = r % CV_W, e = q >> 8, je = j * 16 + e; d.sub = q & 255;
        if (which < 2) { d.W = (which ? P.moe_w3 : P.moe_w1) + (size_t)je * D * DEXP; d.N = DEXP; d.WT = (bf16*)(P.ws + WS_W13) + (size_t)je * D * D; d.rm.moe = 1; d.rm.which = which; }
        else { d.W = P.moe_w2 + (size_t)je * DEXP * D; d.K = DEXP; d.WT = (bf16*)(P.ws + WS_W2) + (size_t)je * D * DEXP; }
    } else if (kind == 0) {
        if (r < CV_ATTIN) { d.W = P.att_w_in + (size_t)j * D * NATT; d.N = NATT; d.WT = (bf16*)(P.ws + WS_WATTIN) + (size_t)j * NATT * D; }
        else { d.W = P.att_w_out + (size_t)j * D * D; d.WT = (bf16*)(P.ws + WS_WATTOUT) + (size_t)j * D * D; d.sub = r - CV_ATTIN; }
    } else {
        if (r < CV_GLAIN) { d.W = P.gla_w_in + (size_t)j * D * 3104; d.N = 3104; d.WT = (bf16*)(P.ws + WS_WGLAIN) + (size_t)j * NGLA * D; }
        else if (r < CV_GLAIN + CV_GLAPAD) { d.kind = 2; d.sub = (r - CV_GLAIN) * 1024; d.WT = (bf16*)(P.ws + WS_WGLAIN) + (size_t)j * NGLA * D + (size_t)3104 * D; }
        else { d.W = P.gla_w_out + (size_t)j * D * D; d.WT = (bf16*)(P.ws + WS_WGLAOUT) + (size_t)j * D * D; d.sub = r - CV_GLAIN - CV_GLAPAD; }
    }
    return d;
}
__device__ __forceinline__ void conv_load(const ConvDesc& d, float (&ld)[32], int lane) { if (d.kind == 1) ti_load(ld, d.W, d.N, d.sub, lane); }
__device__ __forceinline__ void conv_finish(const ConvDesc& d, const float (&ld)[32], LAS float* scr, int lane) {
    if (d.kind == 1) ti_finish(ld, d.K, d.N, d.WT, scr, d.sub, lane, d.rm);
    else if (d.kind == 2) { for (int i = lane; i < 1024; i += 64) *(u32x4*)(d.WT + (size_t)(d.sub + i) * 8) = (u32x4){0u, 0u, 0u, 0u}; }
}
__device__ __forceinline__ void conv_item(const ConvPtrs& P, int it, LAS float* scr, int lane) {
    const ConvDesc d = conv_decode(P, it, it + 1); float ld[32]; conv_load(d, ld, lane); conv_finish(d, ld, scr, lane);
}
__device__ __forceinline__ void conv_static(const ConvPtrs& P, int cur, int need, LAS unsigned char* lds, int lane, int wave, int vcu, int G) {
    LAS float* scr = (LAS float*)(lds + wave * 8448);
    for (int it = cur + vcu * 8 + wave; it < need; it += G * 8) conv_item(P, it, scr, lane);
}
__device__ __forceinline__ void conv_unit(const ConvPtrs& P, int i0, int hi, LAS unsigned char* lds, int lane, int wave) {
    LAS float* scr = (LAS float*)(lds + wave * 8448);
    constexpr int NPW = CV_UNIT / 8; static_assert(NPW == 4, "four items per wave");
    const int it0 = i0 + wave * NPW;
    float la[32], lb[32];
    ConvDesc dA = conv_decode(P, it0, hi); conv_load(dA, la, lane);
    ConvDesc dB = conv_decode(P, it0 + 1, hi); conv_load(dB, lb, lane);
    conv_finish(dA, la, scr, lane);
    dA = conv_decode(P, it0 + 2, hi); conv_load(dA, la, lane);
    conv_finish(dB, lb, scr, lane);
    dB = conv_decode(P, it0 + 3, hi); conv_load(dB, lb, lane);
    conv_finish(dA, la, scr, lane);
    conv_finish(dB, lb, scr, lane);
}

template <class AP> __device__ __forceinline__ void p0_prologue(const AP ap, LAS unsigned char* lds, int tid, int lane, int wave, int vcu, int G) {
    unsigned char* ws = ap->ws;
    LAS float* S9 = (LAS float*)(lds + 69632);
    LAS float* red = (LAS float*)(lds + 106496);
    { const ConvPtrs P{ap->att_w_in, ap->att_w_out, ap->gla_w_in, ap->gla_w_out, ap->moe_w1, ap->moe_w3, ap->moe_w2, ws};
      conv_static(P, 0, MK_CONVQ ? CT_ATTN0 : CV_TOTAL, lds, lane, wave, vcu, G); }
    __syncthreads();
    { const float* cc = ap->c; const float* cx = ap->c_ctx;
      for (int i = tid; i < 9 * 1024; i += 512) { const int bi = i >> 10, k = i & 1023; const float v = (bi < 8) ? cc[bi * D + k] : cx[k]; S9[i] = v / (1.0f + __expf(-v)); } }
    __syncthreads();
    const float* w_mod = ap->w_mod; const float* b_mod = ap->b_mod;
    for (int u = vcu; u < 4 * 192; u += G) {
        const int L = u / 192, n0 = (u % 192) * 32;
        const float* W = w_mod + (size_t)L * D * 6144 + n0 + 4 * (lane & 7);
        f32x4 acc[9];
#pragma unroll
        for (int bi = 0; bi < 9; ++bi) acc[bi] = (f32x4){0.f, 0.f, 0.f, 0.f};
        const int kb = wave * 128 + (lane >> 3);
        f32x4 wv[16];
#pragma unroll
        for (int i = 0; i < 16; ++i) wv[i] = *(const f32x4*)(W + (size_t)(kb + 8 * i) * 6144);
#pragma unroll
        for (int i = 0; i < 16; ++i)
#pragma unroll
            for (int bi = 0; bi < 9; ++bi) { const float sv = S9[bi * 1024 + kb + 8 * i]; acc[bi] = __builtin_elementwise_fma(wv[i], (f32x4){sv, sv, sv, sv}, acc[bi]); }
#pragma unroll
        for (int bi = 0; bi < 9; ++bi) { f32x4 t;
#pragma unroll
            for (int j = 0; j < 4; ++j) { float v = acc[bi][j]; v += dppf<0x128>(v); v = swap16_add(v, v); t[j] = swap32_add(v, v); }
            if (lane < 8) *(LAS f32x4*)(red + (wave * 9 + bi) * 32 + 4 * lane) = t; }
        __syncthreads();
        if (tid < 9 * 32) { const int bi = tid >> 5, l = tid & 31; float sm = b_mod[L * 6144 + n0 + l];
#pragma unroll
            for (int w = 0; w < 8; ++w) sm += red[(w * 9 + bi) * 32 + l];
            ((float*)(ws + WS_MODV))[(size_t)(L * 9 + bi) * 6144 + n0 + l] = sm; }
        __syncthreads();
    }
}

__device__ __forceinline__ float* xrow_ptr(float* XL, float* XC, int row) { return row < TX ? XL + (size_t)row * D : XC + (size_t)(row - TX) * D; }
__device__ __forceinline__ int row_bi(int row) { return row < TX ? (row >> 11) : 8; }

__device__ __forceinline__ void norm_mod_store(const f32x4 (&v)[4], const float* g, const float* sh, const float* sc, bf16* orow, int lane) {
    float ss = 0.f;
#pragma unroll
    for (int j = 0; j < 4; ++j) ss += (v[j].x * v[j].x + v[j].y * v[j].y) + (v[j].z * v[j].z + v[j].w * v[j].w);
    const float rs = __builtin_amdgcn_rsqf(wave_sum(ss) * (1.0f / D) + EPSF);
#pragma unroll
    for (int j = 0; j < 4; ++j) { const int c = 4 * lane + 256 * j; const f32x4 gg = *(const f32x4*)(g + c), s1 = *(const f32x4*)(sc + c), s0 = *(const f32x4*)(sh + c);
        const f32x4 y = (v[j] * rs) * gg * (1.0f + s1) + s0;
        u32x2 w; w.x = pk2(y.x, y.y); w.y = pk2(y.z, y.w); *(u32x2*)(orow + c) = w; }
}

constexpr int TROWS = 9;
__device__ __forceinline__ int thin_row(int vcu, int wave, int i) { return vcu * 8 + wave + 2048 * i; }

struct N1Row { f32x4 x[4], s0[4], s1[4]; };
__device__ __forceinline__ void n1_issue(N1Row& r, const float* XL, const float* XC, const float* modv, int row, int lane) {
    const f32x4* xr = (const f32x4*)(row < TX ? XL + (size_t)row * D : XC + (size_t)(row - TX) * D) + lane; const float* mv = modv + row_bi(row) * 6144;
#pragma unroll
    for (int j = 0; j < 4; ++j) { r.x[j] = xr[64 * j]; r.s0[j] = *(const f32x4*)(mv + 4 * lane + 256 * j); r.s1[j] = *(const f32x4*)(mv + 1024 + 4 * lane + 256 * j); }
}
__device__ __forceinline__ void n1_finish(const N1Row& r, const f32x4 (&gg)[4], bf16* orow, int lane) {
    float ss = 0.f;
#pragma unroll
    for (int j = 0; j < 4; ++j) ss += (r.x[j].x * r.x[j].x + r.x[j].y * r.x[j].y) + (r.x[j].z * r.x[j].z + r.x[j].w * r.x[j].w);
    const float rs = __builtin_amdgcn_rsqf(wave_sum(ss) * (1.0f / D) + EPSF);
#pragma unroll
    for (int j = 0; j < 4; ++j) { const f32x4 y = (r.x[j] * rs) * gg[j] * (1.0f + r.s1[j]) + r.s0[j];
        u32x2 w; w.x = pk2(y.x, y.y); w.y = pk2(y.z, y.w); *(u32x2*)(orow + 4 * lane + 256 * j) = w; }
}
__device__ __forceinline__ void phase_norm1(const float* XL, const float* XC, const float* g, const float* modv, bf16* H, int nrows, int lane, int wave, int vcu, int G) {
    f32x4 gg[4];
#pragma unroll
    for (int j = 0; j < 4; ++j) gg[j] = *(const f32x4*)(g + 4 * lane + 256 * j);
    N1Row ra, rb;
    n1_issue(ra, XL, XC, modv, thin_row(vcu, wave, 0), lane);
#pragma unroll
    for (int i = 0; i < TROWS; ++i) {
        const int row = thin_row(vcu, wave, i), rown = thin_row(vcu, wave, i + 1);
        if (i + 1 < TROWS) n1_issue((i & 1) ? ra : rb, XL, XC, modv, rown < nrows ? rown : row, lane);
        if (row < nrows) n1_finish((i & 1) ? rb : ra, gg, H + (size_t)row * D, lane);
    }
}

__device__ __forceinline__ void phase_router(const bf16* XB, const float* g, const float* modv, bf16* H, const float* router_w, const float* router_bias,
                                             unsigned* cnt  , int* list, int* toki, float* tokw, int nrows,
                                             LAS unsigned char* lds, int tid, int lane, int wave, int vcu, int G, int probe) {
    LAS float* RW = (LAS float*)lds;
    LAS int* lcnt = (LAS int*)(lds + 65536);
    LAS int* rinfo = (LAS int*)(lds + 65536 + 256);
    for (int it = 0; it < 8; ++it) { const int idx = tid + 512 * it, k = idx >> 2, q = idx & 3; const f32x4 w = *(const f32x4*)(router_w + k * 16 + 4 * q);
        RW[(4 * q + 0) * 1024 + k] = w.x; RW[(4 * q + 1) * 1024 + k] = w.y; RW[(4 * q + 2) * 1024 + k] = w.z; RW[(4 * q + 3) * 1024 + k] = w.w; }
    if (tid < 32) lcnt[tid] = 0;
    __syncthreads();
    const int rpb = nrows / G, rpw = rpb / 8;
    const int gI = lane >> 4;
    const f32x4 rb = *(const f32x4*)(router_bias + 4 * gI);
    f32x4 gg[4];
#pragma unroll
    for (int j = 0; j < 4; ++j) gg[j] = *(const f32x4*)(g + 4 * lane + 256 * j);
    const int rowbase = vcu * rpb + wave * rpw;
    u32x2 xa[3][4], xb[3][4];
#pragma unroll
    for (int r = 0; r < 3; ++r) { const bf16* xr = XB + (size_t)(rowbase + (r < rpw ? r : rpw - 1)) * D + 4 * lane;
#pragma unroll
        for (int j = 0; j < 4; ++j) xa[r][j] = *(const u32x2*)(xr + 256 * j); }
#pragma unroll
    for (int bt = 0; bt < 3; ++bt) {
        const int i0 = 3 * bt;
        asm volatile("" ::: "memory");
        u32x2 (&xc)[3][4] = (bt & 1) ? xb : xa; u32x2 (&xn)[3][4] = (bt & 1) ? xa : xb; f32x4 y[3][4];
        f32x4 s0v[3][4], s1v[3][4];
#pragma unroll
        for (int r = 0; r < 3; ++r) { const int ii = (i0 + r < rpw) ? i0 + r : rpw - 1; const float* mv = modv + row_bi(rowbase + ii) * 6144 + 3072;
#pragma unroll
            for (int j = 0; j < 4; ++j) { const int c = 4 * lane + 256 * j; s0v[r][j] = *(const f32x4*)(mv + c); s1v[r][j] = *(const f32x4*)(mv + 1024 + c); } }
        if (bt + 1 < 3) {
#pragma unroll
            for (int r = 0; r < 3; ++r) { const int ii = (i0 + 3 + r < rpw) ? i0 + 3 + r : rpw - 1; const bf16* xr = XB + (size_t)(rowbase + ii) * D + 4 * lane;
#pragma unroll
                for (int j = 0; j < 4; ++j) xn[r][j] = *(const u32x2*)(xr + 256 * j); } }
#pragma unroll
        for (int r = 0; r < 3; ++r) {
            const int ii = (i0 + r < rpw) ? i0 + r : rpw - 1; const int row = rowbase + ii;
            float ss = 0.f;
#pragma unroll
            for (int j = 0; j < 4; ++j) { const u32x2 t = xc[r][j]; y[r][j] = (f32x4){bflo(t.x), bfhi(t.x), bflo(t.y), bfhi(t.y)};
                ss += (y[r][j].x * y[r][j].x + y[r][j].y * y[r][j].y) + (y[r][j].z * y[r][j].z + y[r][j].w * y[r][j].w); }
            const float rs = __builtin_amdgcn_rsqf(wave_sum(ss) * (1.0f / D) + EPSF);
#pragma unroll
            for (int j = 0; j < 4; ++j) { const int c = 4 * lane + 256 * j;
                y[r][j] = (y[r][j] * rs) * gg[j] * (1.0f + s1v[r][j]) + s0v[r][j];
                u32x2 w; w.x = cvtpk(y[r][j].x, y[r][j].y); w.y = cvtpk(y[r][j].z, y[r][j].w); *(u32x2*)(H + (size_t)row * D + c) = w; }
        }
        float p[3][16];
#pragma unroll
        for (int e = 0; e < 16; ++e) {
            f32x2 a2[3];
#pragma unroll
            for (int r = 0; r < 3; ++r) a2[r] = (f32x2){0.f, 0.f};
#pragma unroll
            for (int j = 0; j < 4; ++j) { const f32x4 w = *(const LAS f32x4*)(RW + e * 1024 + 4 * lane + 256 * j); const f32x2 wlo = __builtin_shufflevector(w, w, 0, 1), whi = __builtin_shufflevector(w, w, 2, 3);
#pragma unroll
                for (int r = 0; r < 3; ++r) { a2[r] = __builtin_elementwise_fma(__builtin_shufflevector(y[r][j], y[r][j], 0, 1), wlo, a2[r]); a2[r] = __builtin_elementwise_fma(__builtin_shufflevector(y[r][j], y[r][j], 2, 3), whi, a2[r]); } }
#pragma unroll
            for (int r = 0; r < 3; ++r) { p[r][e] = a2[r].x + a2[r].y; asm volatile("" : "+v"(p[r][e])); } }
#pragma unroll
        for (int r = 0; r < 3; ++r) {
            float q8[8], lg[4];
#pragma unroll
            for (int j = 0; j < 8; ++j) q8[j] = swap32_add(p[r][j], p[r][j + 8]);
#pragma unroll
            for (int j = 0; j < 4; ++j) lg[j] = row_sum(swap16_add(q8[j], q8[j + 4]));
            float sc[4], sel[4];
#pragma unroll
            for (int j = 0; j < 4; ++j) { sc[j] = 1.0f / (1.0f + __expf(-lg[j])); sel[j] = sc[j] + rb[j]; }
            int i1 = 0, i2 = 0; float m1 = -1e30f, m2 = -1e30f, w1 = 0.f, w2 = 0.f;
#pragma unroll
            for (int j = 0; j < 4; ++j) { const float t = sel[j];
                if (t > m1) { m2 = m1; i2 = i1; w2 = w1; m1 = t; i1 = j; w1 = sc[j]; } else if (t > m2) { m2 = t; i2 = j; w2 = sc[j]; } }
            const float gs = m1 + m2;
            const float g0 = readlane_f(gs, 0), g1 = readlane_f(gs, 16), g2 = readlane_f(gs, 32), g3 = readlane_f(gs, 48);
            int bg = 0; float bgs = g0; if (g1 > bgs) { bgs = g1; bg = 1; } if (g2 > bgs) { bgs = g2; bg = 2; } if (g3 > bgs) { bgs = g3; bg = 3; }
            bg = __builtin_amdgcn_readfirstlane(bg);
            const int e0 = 4 * bg + __builtin_amdgcn_readlane(i1, 16 * bg), e1 = 4 * bg + __builtin_amdgcn_readlane(i2, 16 * bg);
            const float w0 = readlane_f(w1, 16 * bg), w1s = readlane_f(w2, 16 * bg);
            const float wn = 1.0f / (w0 + w1s);
            if (lane == 0 && i0 + r < rpw) { const int rl = wave * rpw + i0 + r;
                const int p0 = __hip_atomic_fetch_add(&lcnt[e0], 1, __ATOMIC_RELAXED, __HIP_MEMORY_SCOPE_WORKGROUP), p1 = __hip_atomic_fetch_add(&lcnt[e1], 1, __ATOMIC_RELAXED, __HIP_MEMORY_SCOPE_WORKGROUP);
                rinfo[rl * 6 + 0] = e0; rinfo[rl * 6 + 1] = p0; rinfo[rl * 6 + 2] = e1; rinfo[rl * 6 + 3] = p1;
                rinfo[rl * 6 + 4] = __builtin_bit_cast(int, w0 * wn); rinfo[rl * 6 + 5] = __builtin_bit_cast(int, w1s * wn); }
        }
    }
    __syncthreads();
    if (tid < 16) lcnt[16 + tid] = (int)__hip_atomic_fetch_add(cnt + 64 * tid, (unsigned)lcnt[tid], RLX_AGENT);
    __syncthreads();
    if (tid < rpb) { const int row = vcu * rpb + tid; const int e0 = rinfo[tid * 6 + 0], e1 = rinfo[tid * 6 + 2];
        const int p0 = lcnt[16 + e0] + rinfo[tid * 6 + 1], p1 = lcnt[16 + e1] + rinfo[tid * 6 + 3];
        list[(size_t)e0 * TALL + p0] = row; list[(size_t)e1 * TALL + p1] = row;
        toki[row * 4 + 0] = e0; toki[row * 4 + 1] = p0; toki[row * 4 + 2] = e1; toki[row * 4 + 3] = p1;
        tokw[row * 2 + 0] = __builtin_bit_cast(float, rinfo[tid * 6 + 4]); tokw[row * 2 + 1] = __builtin_bit_cast(float, rinfo[tid * 6 + 5]); }
    __syncthreads();
}

__device__ __forceinline__ int build_moe_table(const unsigned* cnt, LAS int* tab, int tid) {
    if (tid < 16) tab[RT_MAX + 1 + tid] = (int)__hip_atomic_load(cnt + 64 * tid, RLX_AGENT);
    __syncthreads();
    if (tid == 0) { int rt = 0;
        for (int e = 0; e < 16; ++e) { const int c = tab[RT_MAX + 1 + e]; const int nt = (c + 255) >> 8;
            for (int m = 0; m < nt; ++m) { if (rt < RT_MAX) tab[rt] = e | (m << 8); ++rt; } }
        tab[RT_MAX] = rt < RT_MAX ? rt : RT_MAX; }
    __syncthreads();
    return tab[RT_MAX];
}

struct CbTok { int e0, p0, e1, p1; float w0, w1; };
struct CbRow { f32x4 g2[4], s0[4], s1[4]; u32x2 x[4], ya[4], yb[4]; };
__device__ __forceinline__ void cb_tok(CbTok& t, const int* toki, const float* tokw, int row) {
    const int4 q = *(const int4*)(toki + row * 4); const float2 w = *(const float2*)(tokw + row * 2); t.e0 = q.x; t.p0 = q.y; t.e1 = q.z; t.p1 = q.w; t.w0 = w.x; t.w1 = w.y;
}
template <bool FINAL>
__device__ __forceinline__ void cb_issue(CbRow& r, const CbTok& t, int mybase, const bf16* XB, const float* modv, const float* modv_next, const bf16* YB, int row, int lane) {
    const int s0 = __shfl(mybase, t.e0) + t.p0, s1 = __shfl(mybase, t.e1) + t.p1;
    const bf16* xp = XB + (size_t)row * D; const int bi = row_bi(row); const float* g2 = modv + bi * 6144 + 5120; const float* mv = modv_next + bi * 6144;
#pragma unroll
    for (int j = 0; j < 4; ++j) { const int c = 4 * lane + 256 * j;
        r.ya[j] = *(const u32x2*)(YB + (size_t)s0 * D + c); r.yb[j] = *(const u32x2*)(YB + (size_t)s1 * D + c);
        r.x[j] = *(const u32x2*)(xp + c); r.g2[j] = *(const f32x4*)(g2 + c);
        if constexpr (!FINAL) { r.s0[j] = *(const f32x4*)(mv + c); r.s1[j] = *(const f32x4*)(mv + 1024 + c); } }
}
template <bool FINAL>
__device__ __forceinline__ void cb_finish(const CbRow& r, const CbTok& t, const f32x4 (&gn)[4], bf16* xp, float* orow, bf16* hrow, int lane) {
    f32x4 v[4]; float ss = 0.f;
#pragma unroll
    for (int j = 0; j < 4; ++j) { const u32x2 a = r.ya[j], b = r.yb[j]; const float w0 = t.w0, w1 = t.w1;
        f32x4 y; y.x = w0 * bflo(a.x) + w1 * bflo(b.x); y.y = w0 * bfhi(a.x) + w1 * bfhi(b.x); y.z = w0 * bflo(a.y) + w1 * bflo(b.y); y.w = w0 * bfhi(a.y) + w1 * bfhi(b.y);
        const u32x2 xt = r.x[j]; v[j] = (f32x4){bflo(xt.x), bfhi(xt.x), bflo(xt.y), bfhi(xt.y)} + r.g2[j] * y;
        ss += (v[j].x * v[j].x + v[j].y * v[j].y) + (v[j].z * v[j].z + v[j].w * v[j].w); }
    const float rs = __builtin_amdgcn_rsqf(wave_sum(ss) * (1.0f / D) + EPSF);
#pragma unroll
    for (int j = 0; j < 4; ++j) { const int c = 4 * lane + 256 * j;
        if constexpr (FINAL) *(f32x4*)(orow + c) = (v[j] * rs) * gn[j];
        else { u32x2 xw; xw.x = pk2(v[j].x, v[j].y); xw.y = pk2(v[j].z, v[j].w); *(u32x2*)(xp + c) = xw;
            const f32x4 y = (v[j] * rs) * gn[j] * (1.0f + r.s1[j]) + r.s0[j];
            u32x2 w; w.x = pk2(y.x, y.y); w.y = pk2(y.z, y.w); *(u32x2*)(hrow + c) = w; } }
}
template <bool FINAL>
__device__ __forceinline__ void phase_combine(bf16* XB, float* OUT, const float* modv  , const bf16* YB, const unsigned* cnt, const int* toki, const float* tokw,
                                              const float* gnext, const float* modv_next, bf16* H, int nrows, int lane, int wave, int vcu, int G) {
    int tiles = 0; if (lane < 16) tiles = ((int)__hip_atomic_load(cnt + 64 * lane, RLX_AGENT) + 255) >> 8;
    int incl = tiles;
#pragma unroll
    for (int o = 1; o < 16; o <<= 1) { const int t = __shfl_up(incl, o); if (lane >= o) incl += t; }
    const int mybase = (incl - tiles) * 256;
    f32x4 gn[4];
#pragma unroll
    for (int j = 0; j < 4; ++j) gn[j] = *(const f32x4*)(gnext + 4 * lane + 256 * j);
    CbTok ta, tb, tc; CbRow ra, rb;
    cb_tok(ta, toki, tokw, thin_row(vcu, wave, 0)); cb_tok(tb, toki, tokw, thin_row(vcu, wave, 1));
    cb_issue<FINAL>(ra, ta, mybase, XB, modv, modv_next, YB, thin_row(vcu, wave, 0), lane);
#pragma unroll
    for (int i = 0; i < TROWS; ++i) {
        const int row = thin_row(vcu, wave, i), row1 = thin_row(vcu, wave, i + 1), row2 = thin_row(vcu, wave, i + 2);
        CbTok& tcur = (i % 3 == 0) ? ta : (i % 3 == 1) ? tb : tc; CbTok& tnx = (i % 3 == 0) ? tb : (i % 3 == 1) ? tc : ta; CbTok& tn2 = (i % 3 == 0) ? tc : (i % 3 == 1) ? ta : tb;
        if (i + 2 < TROWS) cb_tok(tn2, toki, tokw, row2 < nrows ? row2 : row);
        if (i + 1 < TROWS) cb_issue<FINAL>((i & 1) ? ra : rb, tnx, mybase, XB, modv, modv_next, YB, row1 < nrows ? row1 : row, lane);
        if (row < nrows) cb_finish<FINAL>((i & 1) ? rb : ra, tcur, gn, XB + (size_t)row * D, OUT + (size_t)row * D, H + (size_t)row * D, lane);
    }
}

struct RoRow { u32x2 a[4], b[4], gt[4]; };
__device__ __forceinline__ void ro_issue(RoRow& r, const bf16* OF, const bf16* OB, const bf16* QKV2, int row, int lane) {
#pragma unroll
    for (int j = 0; j < 4; ++j) { const int c = 4 * lane + 256 * j;
        r.a[j] = *(const u32x2*)(OF + (size_t)row * D + c); r.b[j] = *(const u32x2*)(OB + (size_t)row * D + c); r.gt[j] = *(const u32x2*)(QKV2 + (size_t)row * NGLA + 2048 + c); }
}
__device__ __forceinline__ void ro_finish(const RoRow& r, const f32x4 gg, bf16* orow, int lane) {
#pragma unroll
    for (int j = 0; j < 4; ++j) { const u32x2 a = r.a[j], b = r.b[j], gt = r.gt[j];
        f32x4 o; o.x = bflo(a.x) + bflo(b.x); o.y = bfhi(a.x) + bfhi(b.x); o.z = bflo(a.y) + bflo(b.y); o.w = bfhi(a.y) + bfhi(b.y);
        const float ss = wave_sum((o.x * o.x + o.y * o.y) + (o.z * o.z + o.w * o.w));
        const float rs = __builtin_amdgcn_rsqf(ss * (1.0f / 256.0f) + EPSF);
        f32x4 gv; gv.x = silu_f(bflo(gt.x)); gv.y = silu_f(bfhi(gt.x)); gv.z = silu_f(bflo(gt.y)); gv.w = silu_f(bfhi(gt.y));
        const f32x4 y = (o * rs) * gg * gv;
        u32x2 w; w.x = pk2(y.x, y.y); w.y = pk2(y.z, y.w); *(u32x2*)(orow + 4 * lane + 256 * j) = w; }
}
__device__ __forceinline__ void phase_readout(const bf16* OF, const bf16* OB, const bf16* QKV2, const float* ng, bf16* AOUT, int nrows, int lane, int wave, int vcu, int G) {
    const f32x4 gg = *(const f32x4*)(ng + 4 * lane);
    RoRow ra, rb, rc;
    ro_issue(ra, OF, OB, QKV2, thin_row(vcu, wave, 0), lane); ro_issue(rb, OF, OB, QKV2, thin_row(vcu, wave, 1), lane);
#pragma unroll
    for (int i = 0; i < TROWS; ++i) {
        const int row = thin_row(vcu, wave, i), row2 = thin_row(vcu, wave, i + 2);
        RoRow& cur = (i % 3 == 0) ? ra : (i % 3 == 1) ? rb : rc; RoRow& n2 = (i % 3 == 0) ? rc : (i % 3 == 1) ? ra : rb;
        if (i + 2 < TROWS) ro_issue(n2, OF, OB, QKV2, row2 < nrows ? row2 : row, lane);
        if (row < nrows) ro_finish(cur, gg, AOUT + (size_t)row * D, lane);
    }
}

__device__ __forceinline__ int na_r0(int r) { int v = r - 4; return v < 0 ? 0 : (v > 24 ? 24 : v); }
template <int NMAPS, int DV, bool NA>
__device__ __forceinline__ void attn_unit(LAS unsigned char* lds, int tid, int lane, int wave,
                                          const bf16* QKV, int qcol, int qrow0, int kcol, int krow_lat, int krow_ctx, const bf16* VT, int klo, int khi,
                                          int r_wave, int xq0, const LAS float* biasT,
                                          bf16* AOUT, int ocol, float lam, const float* subg, float outscale) {
    constexpr int KB = 9216;
    constexpr int BUFSZ = NMAPS * KB + DV * 144;
    constexpr int NVB = DV / 16, NVR = DV / 64;
    const int fr = lane & 15, g = lane >> 4;
    bf16x8 qf[NMAPS][2];
    { const bf16* qp = QKV + (size_t)(qrow0 + wave * 16 + fr) * NATT + qcol + 8 * g;
#pragma unroll
      for (int m = 0; m < NMAPS; ++m)
#pragma unroll
          for (int s = 0; s < 2; ++s) qf[m][s] = *(const bf16x8*)(qp + m * 64 + 32 * s); }
    f32x4 O[NMAPS][NVB]; float mrun[NMAPS]; float lrun[NMAPS];
#pragma unroll
    for (int m = 0; m < NMAPS; ++m) { mrun[m] = -1e30f; lrun[m] = 0.f;
#pragma unroll
        for (int vb = 0; vb < NVB; ++vb) O[m][vb] = (f32x4){0.f, 0.f, 0.f, 0.f}; }
    const int ntiles = 4 + (khi - klo);
    u32x4 kreg[NMAPS], vreg[NVR];
    const int lkey = tid >> 3, lch = tid & 7;
#define AT_LOAD(i) do { const int _i = (i); const int _rowg = (_i < 4 ? krow_ctx + 64 * _i : krow_lat + 64 * (klo + _i - 4)) + lkey; const int _tok0 = (_i < 4 ? SEQ + 64 * _i : 64 * (klo + _i - 4)); \
        _Pragma("unroll") for (int m = 0; m < NMAPS; ++m) kreg[m] = *(const u32x4*)(QKV + (size_t)_rowg * NATT + kcol + m * 64 + lch * 8); \
        _Pragma("unroll") for (int j = 0; j < NVR; ++j) { const int idx = tid + 512 * j; vreg[j] = *(const u32x4*)(VT + (size_t)(idx >> 3) * NKEY + _tok0 + (idx & 7) * 8); } } while (0)
#define AT_STORE(b) do { LAS unsigned char* _p = lds + (b) * BUFSZ; \
        _Pragma("unroll") for (int m = 0; m < NMAPS; ++m) *(LAS u32x4*)(_p + m * KB + lkey * 144 + lch * 16) = kreg[m]; \
        _Pragma("unroll") for (int j = 0; j < NVR; ++j) { const int idx = tid + 512 * j; *(LAS u32x4*)(_p + NMAPS * KB + (idx >> 3) * 144 + (idx & 7) * 16) = vreg[j]; } } while (0)
    AT_LOAD(0); AT_STORE(0); __syncthreads();
    const int kbase0 = (8 * (fr >> 2) + (fr & 3)) * 144 + 16 * g;
    const int vbase = fr * 144 + 16 * g;
    int r0w = 0, xq = 0, tmask = 3, c0w = 0; float pen[4][4];
    if constexpr (NA) { r0w = na_r0(r_wave); xq = xq0 + fr; int cs = xq - 8; cs = cs < 0 ? 0 : (cs > 48 ? 48 : cs);
        c0w = xq0 - 8; c0w = c0w < 0 ? 0 : (c0w > 32 ? 32 : c0w);
        tmask = 1;
#pragma unroll
        for (int kb = 0; kb < 4; ++kb)
#pragma unroll
            for (int ii = 0; ii < 4; ++ii) { const int y = c0w + 32 * (kb >> 1) + 8 * g + 4 * (kb & 1) + ii; pen[kb][ii] = (y >= cs && y < cs + 16) ? 0.f : -1e30f; } }
    for (int i = 0; i < ntiles; ++i) {
        if (i + 1 < ntiles) AT_LOAD(i + 1);
        const LAS unsigned char* buf = lds + (i & 1) * BUFSZ;
        bool active = true; int kr = 0; bool local = false;
        if constexpr (NA) { if (i >= 4) { local = true; kr = klo + i - 4; active = (kr >= r0w) && (kr < r0w + 8); } }
        if (active) {
            const int tm = local ? tmask : 3;
            const int koffw = local ? c0w * 144 : 0, voffw = local ? c0w * 2 : 0;
            bf16x8 kf[NMAPS][4][2];
#pragma unroll
            for (int m = 0; m < NMAPS; ++m)
#pragma unroll
                for (int kb = 0; kb < 4; ++kb)
#pragma unroll
                    for (int s = 0; s < 2; ++s) kf[m][kb][s] = *(const LAS bf16x8*)(buf + m * KB + kbase0 + koffw + (kb & 1) * (4 * 144) + (kb >> 1) * (32 * 144) + s * 64);
            __builtin_amdgcn_sched_barrier(0);
            f32x4 S[NMAPS][4];
#pragma unroll
            for (int m = 0; m < NMAPS; ++m)
#pragma unroll
                for (int kb = 0; kb < 4; ++kb) { S[m][kb] = (f32x4){0.f, 0.f, 0.f, 0.f};
                    if (!NA || (tm >> (kb >> 1)) & 1) {
#pragma unroll
                        for (int s = 0; s < 2; ++s) S[m][kb] = __builtin_amdgcn_mfma_f32_16x16x32_bf16(kf[m][kb][s], qf[m][s], S[m][kb], 0, 0, 0); } }
            bf16x8 vf0[4][2];
#pragma unroll
            for (int vb = 0; vb < 4; ++vb)
#pragma unroll
                for (int t = 0; t < 2; ++t) vf0[vb][t] = *(const LAS bf16x8*)(buf + NMAPS * KB + vbase + voffw + vb * (16 * 144) + t * 64);
            __builtin_amdgcn_sched_barrier(0);
            bf16x8 pf[NMAPS][2];
#pragma unroll
            for (int m = 0; m < NMAPS; ++m) {
                if constexpr (NA) { if (local) {
                        const LAS float* bp = biasT + (kr - r_wave + 7) * 31 + (c0w + 8 * g - xq + 15);
#pragma unroll
                        for (int kb = 0; kb < 4; ++kb)
#pragma unroll
                            for (int ii = 0; ii < 4; ++ii) { const float t = (tm >> (kb >> 1)) & 1 ? (S[m][kb][ii] + pen[kb][ii]) + bp[32 * (kb >> 1) + 4 * (kb & 1) + ii] : -1e30f; S[m][kb][ii] = t; } } }
                float mx = fmaxf(fmaxf(S[m][0][0], S[m][0][1]), fmaxf(S[m][0][2], S[m][0][3]));
#pragma unroll
                for (int kb = 1; kb < 4; ++kb) mx = fmaxf(fmaxf(mx, S[m][kb][0]), fmaxf(fmaxf(S[m][kb][1], S[m][kb][2]), S[m][kb][3]));
                mx = swap32_max(swap16_max(mx));
                if (__any(mx > mrun[m] + 8.0f)) {
                    const float mnew = fmaxf(mrun[m], mx), alpha = fexp2(mrun[m] - mnew); mrun[m] = mnew; lrun[m] = lrun[m] * alpha;
#pragma unroll
                    for (int vb = 0; vb < NVB; ++vb) O[m][vb] = O[m][vb] * alpha;
                }
                const float mm = mrun[m];
                unsigned pw[8]; float l0 = 0.f, l1 = 0.f;
#pragma unroll
                for (int kb = 0; kb < 4; ++kb) { const float a0 = fexp2(S[m][kb][0] - mm), a1 = fexp2(S[m][kb][1] - mm), a2 = fexp2(S[m][kb][2] - mm), a3 = fexp2(S[m][kb][3] - mm);
                    l0 += a0 + a1; l1 += a2 + a3;
                    pw[2 * kb] = cvtpk(a0, a1); pw[2 * kb + 1] = cvtpk(a2, a3); }
                lrun[m] += l0 + l1;
                pf[m][0] = __builtin_bit_cast(bf16x8, (u32x4){pw[0], pw[1], pw[2], pw[3]});
                pf[m][1] = __builtin_bit_cast(bf16x8, (u32x4){pw[4], pw[5], pw[6], pw[7]});
            }
            __builtin_amdgcn_sched_barrier(0);
            if constexpr (NVB == 8) {
                bf16x8 vf1[4][2];
#pragma unroll
                for (int vb = 0; vb < 4; ++vb)
#pragma unroll
                    for (int t = 0; t < 2; ++t) vf1[vb][t] = *(const LAS bf16x8*)(buf + NMAPS * KB + vbase + (4 + vb) * (16 * 144) + t * 64);
                __builtin_amdgcn_sched_barrier(0);
#pragma unroll
                for (int vb = 0; vb < 4; ++vb)
#pragma unroll
                    for (int t = 0; t < 2; ++t)
#pragma unroll
                        for (int m = 0; m < NMAPS; ++m) O[m][vb] = __builtin_amdgcn_mfma_f32_16x16x32_bf16(vf0[vb][t], pf[m][t], O[m][vb], 0, 0, 0);
                __builtin_amdgcn_sched_barrier(0);
#pragma unroll
                for (int vb = 0; vb < 4; ++vb)
#pragma unroll
                    for (int t = 0; t < 2; ++t)
#pragma unroll
                        for (int m = 0; m < NMAPS; ++m) O[m][4 + vb] = __builtin_amdgcn_mfma_f32_16x16x32_bf16(vf1[vb][t], pf[m][t], O[m][4 + vb], 0, 0, 0);
            } else {
#pragma unroll
                for (int vb = 0; vb < 4; ++vb)
#pragma unroll
                    for (int t = 0; t < 2; ++t) { if (!NA || (tm >> t) & 1) {
#pragma unroll
                            for (int m = 0; m < NMAPS; ++m) O[m][vb] = __builtin_amdgcn_mfma_f32_16x16x32_bf16(vf0[vb][t], pf[m][t], O[m][vb], 0, 0, 0); } }
            }
            __builtin_amdgcn_sched_barrier(0);
        }
        if (i + 1 < ntiles) AT_STORE((i + 1) & 1);
        __syncthreads();
    }
#undef AT_LOAD
#undef AT_STORE
    float inv[NMAPS];
#pragma unroll
    for (int m = 0; m < NMAPS; ++m) { float l = lrun[m]; l = swap16_add(l, l); l = swap32_add(l, l); inv[m] = 1.0f / l; }
    const int orow = qrow0 + wave * 16 + fr;
    if constexpr (NMAPS == 2) {
        float ss = 0.f; const float i1 = inv[0], i2 = lam * inv[1];
#pragma unroll
        for (int vb = 0; vb < NVB; ++vb) { O[0][vb] = O[0][vb] * i1 - O[1][vb] * i2; const f32x4 o = O[0][vb]; ss += (o.x * o.x + o.y * o.y) + (o.z * o.z + o.w * o.w); }
        ss = swap16_add(ss, ss); ss = swap32_add(ss, ss);
        const float rs = __builtin_amdgcn_rsqf(ss * (1.0f / DV) + EPSF) * outscale;
#pragma unroll
        for (int vb = 0; vb < NVB; ++vb) { const f32x4 gg = *(const f32x4*)(subg + 16 * vb + 4 * g); const f32x4 y = O[0][vb] * rs * gg;
            u32x2 w; w.x = cvtpk(y.x, y.y); w.y = cvtpk(y.z, y.w); *(u32x2*)(AOUT + (size_t)orow * D + ocol + 16 * vb + 4 * g) = w; }
    } else {
#pragma unroll
        for (int vb = 0; vb < NVB; ++vb) { const f32x4 y = O[0][vb] * inv[0];
            u32x2 w; w.x = cvtpk(y.x, y.y); w.y = cvtpk(y.z, y.w); *(u32x2*)(AOUT + (size_t)orow * D + ocol + 16 * vb + 4 * g) = w; }
    }
}


typedef float f32x16 __attribute__((ext_vector_type(16)));
__device__ __forceinline__ void diff_unit32(LAS unsigned char* lds, int tid, int lane, int wave,
                                            const bf16* QKV, int qcol, int qrow0, int kcol, int krow_lat, int krow_ctx, const bf16* VT, int khi,
                                            bf16* AOUT, int ocol, float lam, const float* subg, float outscale) {
    constexpr int KB = 9216, VOFF = 2 * KB, BUFSZ = 2 * KB + 128 * 144;
    const int r = lane & 31, hf = lane >> 5, map = wave >> 2, wq = wave & 3;
    const int swz = ((r >> 4) & 1) << 2;
    bf16x8 qf[4];
    { const bf16* qp = QKV + (size_t)(qrow0 + 32 * wq + r) * NATT + qcol + map * 64 + 8 * hf;
#pragma unroll
      for (int ks = 0; ks < 4; ++ks) qf[ks] = *(const bf16x8*)(qp + 16 * ks); }
    f32x16 O[4];
#pragma unroll
    for (int blk = 0; blk < 4; ++blk)
#pragma unroll
        for (int i = 0; i < 16; ++i) O[blk][i] = 0.f;
    float negm = 0.f, lrun = 0.f;
    const int ntiles = 4 + khi;
    u32x4 kreg[2], vreg[2];
    const int lkey = tid >> 3, lch = tid & 7;
    const int kst = lkey * 144 + ((lch ^ (((lkey >> 4) & 1) << 2)) * 16);
#define D32_LOAD(i) do { const int _i = (i); const int _rowg = (_i < 4 ? krow_ctx + 64 * _i : krow_lat + 64 * (_i - 4)) + lkey; const int _tok0 = (_i < 4 ? SEQ + 64 * _i : 64 * (_i - 4)); \
        _Pragma("unroll") for (int m = 0; m < 2; ++m) kreg[m] = *(const u32x4*)(QKV + (size_t)_rowg * NATT + kcol + m * 64 + lch * 8); \
        _Pragma("unroll") for (int j = 0; j < 2; ++j) { const int idx = tid + 512 * j; vreg[j] = *(const u32x4*)(VT + (size_t)(idx >> 3) * NKEY + _tok0 + (idx & 7) * 8); } } while (0)
#define D32_STORE(b) do { LAS unsigned char* _p = lds + (b) * BUFSZ; \
        _Pragma("unroll") for (int m = 0; m < 2; ++m) *(LAS u32x4*)(_p + m * KB + kst) = kreg[m]; \
        _Pragma("unroll") for (int j = 0; j < 2; ++j) { const int idx = tid + 512 * j, vr = idx >> 3; *(LAS u32x4*)(_p + VOFF + vr * 144 + (((idx & 7) ^ (((vr >> 4) & 1) << 2)) * 16)) = vreg[j]; } } while (0)
    D32_LOAD(0); D32_STORE(0); D32_STORE(2); __syncthreads();
    const int krow = (r & 0x13) | ((r & 4) << 1) | ((r & 8) >> 1);
    const int kbase = map * KB + krow * 144, vbase = VOFF + r * 144;
    bf16x8 pfp[2][2];
#pragma unroll
    for (int kb = 0; kb < 2; ++kb)
#pragma unroll
        for (int sx = 0; sx < 2; ++sx) pfp[kb][sx] = (bf16x8){0, 0, 0, 0, 0, 0, 0, 0};
    int slot = 0;
    for (int i = 0; i < ntiles; ++i) {
        if (i + 1 < ntiles) D32_LOAD(i + 1);
        const int slotn = slot == 2 ? 0 : slot + 1, slotp = slot == 0 ? 2 : slot - 1;
        const LAS unsigned char* buf = lds + slot * BUFSZ; const LAS unsigned char* bufp = lds + slotp * BUFSZ;
        f32x16 S[2];
#pragma unroll
        for (int kb = 0; kb < 2; ++kb) {
#pragma unroll
            for (int ii = 0; ii < 16; ++ii) S[kb][ii] = negm;
#pragma unroll
            for (int ks = 0; ks < 4; ++ks) { const bf16x8 kf = *(const LAS bf16x8*)(buf + kbase + kb * (32 * 144) + (((2 * ks + hf) ^ swz) * 16));
                S[kb] = __builtin_amdgcn_mfma_f32_32x32x16_bf16(kf, qf[ks], S[kb], 0, 0, 0); } }
        __builtin_amdgcn_sched_barrier(0);
        float mx = -1e30f;
#pragma unroll
        for (int kb = 0; kb < 2; ++kb)
#pragma unroll
            for (int ii = 0; ii < 16; ii += 4) mx = fmaxf(fmaxf(mx, S[kb][ii]), fmaxf(fmaxf(S[kb][ii + 1], S[kb][ii + 2]), S[kb][ii + 3]));
        mx = swap32_max(mx);
        const bool resc = (i == 0) || __any(mx > 8.0f);
        float alpha = 1.0f;
        if (resc) { const float dlt = (i == 0) ? mx : fmaxf(mx, 0.f); alpha = fexp2(-dlt); negm -= dlt; lrun *= alpha;
#pragma unroll
            for (int kb = 0; kb < 2; ++kb)
#pragma unroll
                for (int ii = 0; ii < 16; ++ii) S[kb][ii] -= dlt; }
        __builtin_amdgcn_sched_barrier(0);
        bf16x8 pf[2][2]; float l0 = 0.f, l1 = 0.f;
#pragma unroll
        for (int kb = 0; kb < 2; ++kb)
#pragma unroll
            for (int sx = 0; sx < 2; ++sx) { unsigned pw[4];
#pragma unroll
                for (int j = 0; j < 4; ++j) { const float a0 = fexp2(S[kb][8 * sx + 2 * j]), a1 = fexp2(S[kb][8 * sx + 2 * j + 1]); l0 += a0; l1 += a1; pw[j] = cvtpk(a0, a1); }
                pf[kb][sx] = __builtin_bit_cast(bf16x8, (u32x4){pw[0], pw[1], pw[2], pw[3]}); }
        lrun += l0 + l1;
#pragma unroll
        for (int blk = 0; blk < 4; ++blk)
#pragma unroll
            for (int kb = 0; kb < 2; ++kb)
#pragma unroll
                for (int sx = 0; sx < 2; ++sx) { const bf16x8 vf = *(const LAS bf16x8*)(bufp + vbase + blk * (32 * 144) + (((4 * kb + 2 * sx + hf) ^ swz) * 16));
                    O[blk] = __builtin_amdgcn_mfma_f32_32x32x16_bf16(vf, pfp[kb][sx], O[blk], 0, 0, 0); }
#pragma unroll
        for (int k = 0; k < 16; ++k) { __builtin_amdgcn_sched_group_barrier(0x100, 1, 0); __builtin_amdgcn_sched_group_barrier(0x008, 1, 0); __builtin_amdgcn_sched_group_barrier(0x400, 2, 0); __builtin_amdgcn_sched_group_barrier(0x002, 4, 0); }
        __builtin_amdgcn_sched_barrier(0);
        if (resc) {
#pragma unroll
            for (int blk = 0; blk < 4; ++blk) O[blk] = O[blk] * alpha; }
#pragma unroll
        for (int kb = 0; kb < 2; ++kb)
#pragma unroll
            for (int sx = 0; sx < 2; ++sx) pfp[kb][sx] = pf[kb][sx];
        if (i + 1 < ntiles) D32_STORE(slotn);
        slot = slotn;
        __syncthreads();
    }
    { const LAS unsigned char* bufp = lds + (slot == 0 ? 2 : slot - 1) * BUFSZ;
#pragma unroll
      for (int blk = 0; blk < 4; ++blk)
#pragma unroll
          for (int kb = 0; kb < 2; ++kb)
#pragma unroll
              for (int sx = 0; sx < 2; ++sx) { const bf16x8 vf = *(const LAS bf16x8*)(bufp + vbase + blk * (32 * 144) + (((4 * kb + 2 * sx + hf) ^ swz) * 16));
                  O[blk] = __builtin_amdgcn_mfma_f32_32x32x16_bf16(vf, pfp[kb][sx], O[blk], 0, 0, 0); } }
    __syncthreads();
#undef D32_LOAD
#undef D32_STORE
    float l = lrun; l = swap32_add(l, l); const float inv = 1.0f / l;
    LAS float* X = (LAS float*)lds + (size_t)wq * 4096 + lane;
    if (map == 1) {
#pragma unroll
        for (int blk = 0; blk < 4; ++blk)
#pragma unroll
            for (int i = 0; i < 16; ++i) X[(blk * 16 + i) * 64] = O[blk][i] * inv;
    }
    __syncthreads();
    if (map == 0) {
        float ss = 0.f;
#pragma unroll
        for (int blk = 0; blk < 4; ++blk)
#pragma unroll
            for (int i = 0; i < 16; ++i) { const float o = O[blk][i] * inv - lam * X[(blk * 16 + i) * 64]; O[blk][i] = o; ss += o * o; }
        ss = swap32_add(ss, ss);
        const float rs = __builtin_amdgcn_rsqf(ss * (1.0f / 128.0f) + EPSF) * outscale;
        bf16* op = AOUT + (size_t)(qrow0 + 32 * wq + r) * D + ocol + 4 * hf;
#pragma unroll
        for (int blk = 0; blk < 4; ++blk)
#pragma unroll
            for (int g4 = 0; g4 < 4; ++g4) { const int dv0 = 32 * blk + 8 * g4; const f32x4 gg = *(const f32x4*)(subg + dv0 + 4 * hf);
                u32x2 w; w.x = cvtpk(O[blk][4 * g4] * rs * gg.x, O[blk][4 * g4 + 1] * rs * gg.y); w.y = cvtpk(O[blk][4 * g4 + 2] * rs * gg.z, O[blk][4 * g4 + 3] * rs * gg.w);
                *(u32x2*)(op + dv0) = w; }
    }
    __syncthreads();
}

__device__ __forceinline__ void phase_attention(const bf16* QKV, const bf16* VAT, const bf16* VBT, bf16* AOUT, const float* lamp  , float lam_init, const float* subg, const float* nab  ,
                                                unsigned* naq, const ConvPtrs& CP, int clo, int chi, LAS unsigned char* lds, int tid, int lane, int wave) {
    LAS float* biasT = (LAS float*)(lds + LX_BIAS) + 64;
    constexpr int NATT_U = 576 + 1152;
    const int ncu = (chi - clo + CV_UNIT - 1) / CV_UNIT, nq = NATT_U + ncu;
    int mine = 0; if (tid == 0) mine = (int)__hip_atomic_fetch_add(naq, 1u, RLX_AGENT);
    for (;;) {
        __syncthreads();
        if (tid == 0) *(LAS int*)(lds + LX_MISC + 64) = mine;
        __syncthreads();
        const int q = *(LAS int*)(lds + LX_MISC + 64);
        if (q >= nq) break;
        if (tid == 0) mine = (int)__hip_atomic_fetch_add(naq, 1u, RLX_AGENT);
        const int ai = (int)(((long)q * NATT_U) / nq); const bool isatt = (int)(((long)(q + 1) * NATT_U) / nq) > ai;
        if (!isatt) { conv_unit(CP, clo + (q - ai) * CV_UNIT, chi, lds, lane, wave); continue; }
        if (ai < 512 || (ai >= 1536 && ai < 1600)) {
            int bh, qrow0, khi;
            if (ai < 512) { bh = ai >> 4; const int qt = ai & 15; qrow0 = (bh >> 2) * SEQ + qt * 128; khi = 32; }
            else { const int u = ai - 1536; bh = u >> 1; const int qt = u & 1; qrow0 = TX + (bh >> 2) * CTXL + qt * 128; khi = 0; }
            const int b = bh >> 2, h = bh & 3;
            const float lam = __expf(wave_sum(lamp[lane] * lamp[64 + lane])) - __expf(wave_sum(lamp[128 + lane] * lamp[192 + lane])) + lam_init;
            diff_unit32(lds, tid, lane, wave, QKV, h * 128, qrow0, 512 + h * 128, b * SEQ, TX + b * CTXL, VAT + (size_t)bh * 128 * NKEY, khi,
                        AOUT, h * 128, lam, subg, 1.0f - lam_init);
        } else {
            int bh, qrow0, klo, khi, rw;
            if (ai < 1536) { const int u = ai - 512; bh = u >> 4; const int rp = u & 15; qrow0 = (bh >> 3) * SEQ + rp * 128; klo = na_r0(2 * rp); khi = na_r0(2 * rp + 1) + 8; rw = 2 * rp + (wave >> 2); }
            else { const int u = ai - 1600; bh = u >> 1; const int qt = u & 1; qrow0 = TX + (bh >> 3) * CTXL + qt * 128; klo = 0; khi = 0; rw = 0; }
            const int b = bh >> 3, h = bh & 7;
            for (int i = tid; i < 640; i += 512) { const int k = i - 64; biasT[k] = (k >= 0 && k < 465) ? nab[h * 465 + k] * LOG2E : 0.f; }
            attn_unit<1, 64, true>(lds, tid, lane, wave, QKV, 1536 + h * 64, qrow0, 2048 + h * 64, b * SEQ, TX + b * CTXL, VBT + (size_t)bh * 64 * NKEY, klo, khi,
                                   rw, 16 * (wave & 3), biasT, AOUT, 512 + h * 64, 0.f, nullptr, 1.0f);
        }
    }
}

__device__ __forceinline__ void gla_chunk_rows(int b, int dir, int n, int& row0, int& tok0) {
    if (n < 4) { const int cc = dir ? 3 - n : n; row0 = TX + b * CTXL + 64 * cc; tok0 = SEQ + 64 * cc; } else { const int lc = dir ? 35 - n : n - 4; row0 = b * SEQ + 64 * lc; tok0 = 64 * lc; }
}
constexpr int GP_QM = 0, GP_KM = 17408, GP_VT = 34816, GP_LR = 71680, GP_SEG = 75776;
__device__ __forceinline__ void phase_gla_prep(const bf16* QKV2, const bf16* VGT, const float* wgate  , const float* bgate  ,
                                               bf16* QG, bf16* KET, float* FACD, bf16* OF, bf16* OB,
                                               LAS unsigned char* lds, int tid, int lane, int wave, int vcu, int G) {
    const int fr = lane & 15, g = lane >> 4;
    const int d = tid & 127, seg = tid >> 7;
    LAS float* LR = (LAS float*)(lds + GP_LR);
    LAS float* SEG = (LAS float*)(lds + GP_SEG);
    for (int ub = vcu * 9; ub < 2304; ub += G * 9) {
        const int q = ub / 36, n0 = ub % 36, dir = q & 1, hh = (q >> 1) & 3, b = q >> 3;
        bf16* OUT = dir ? OB : OF;
        float wg[16];
#pragma unroll
        for (int r = 0; r < 16; ++r) wg[r] = wgate[(dir * 16 + r) * 512 + hh * 128 + d];
        const float bgv = bgate[dir * 512 + hh * 128 + d];
        const bf16* vtb = VGT + (size_t)(b * 4 + hh) * 256 * NKEY;
        u32x4 qr[2], kr[2], vr[4], lr4;
#define GP_LOAD(n) do { int _row0, _tok0; gla_chunk_rows(b, dir, (n), _row0, _tok0); \
        _Pragma("unroll") for (int j = 0; j < 2; ++j) { const int idx = tid + 512 * j, p = idx >> 4, ch = idx & 15; const bf16* src = QKV2 + (size_t)(_row0 + p) * NGLA + hh * 128 + ch * 8; qr[j] = *(const u32x4*)src; kr[j] = *(const u32x4*)(src + 512); } \
        _Pragma("unroll") for (int j = 0; j < 4; ++j) { const int idx = tid + 512 * j; vr[j] = *(const u32x4*)(vtb + (size_t)(idx >> 3) * NKEY + _tok0 + (idx & 7) * 8); } \
        if (tid < 128) lr4 = *(const u32x4*)(QKV2 + (size_t)(_row0 + (tid >> 1)) * NGLA + 3072 + dir * 16 + (tid & 1) * 8); } while (0)
#define GP_N(i) (dir ? ((i) < 4 ? 3 - (i) : 39 - (i)) : (i))
        GP_LOAD(GP_N(n0));
        for (int k9 = 0; k9 < 9; ++k9) {
            const int n = GP_N(n0 + k9), u = ub - n0 + n; int row0, tok0; gla_chunk_rows(b, dir, n, row0, tok0);
#pragma unroll
            for (int j = 0; j < 2; ++j) { const int idx = tid + 512 * j, p = idx >> 4, ch = idx & 15;
                *(LAS u32x4*)(lds + GP_QM + p * 272 + ch * 16) = qr[j]; *(LAS u32x4*)(lds + GP_KM + p * 272 + ch * 16) = kr[j]; }
#pragma unroll
            for (int j = 0; j < 4; ++j) { const int idx = tid + 512 * j; *(LAS u32x4*)(lds + GP_VT + (idx >> 3) * 144 + (idx & 7) * 16) = vr[j]; }
            if (tid < 128) { LAS float* lp = LR + (tid >> 1) * 16 + (tid & 1) * 8;
                lp[0] = bflo(lr4.x); lp[1] = bfhi(lr4.x); lp[2] = bflo(lr4.y); lp[3] = bfhi(lr4.y); lp[4] = bflo(lr4.z); lp[5] = bfhi(lr4.z); lp[6] = bflo(lr4.w); lp[7] = bfhi(lr4.w); }
            __syncthreads();
            if (k9 + 1 < 9) GP_LOAD(GP_N(n0 + k9 + 1));
            float gc[16];
#pragma unroll
            for (int pi = 0; pi < 16; ++pi) { const LAS f32x4* lp = (const LAS f32x4*)(LR + (16 * seg + pi) * 16); f32x2 z2 = (f32x2){bgv, 0.f};
#pragma unroll
                for (int k = 0; k < 4; ++k) { const f32x4 l4 = lp[k];
                    z2 = __builtin_elementwise_fma(__builtin_shufflevector(l4, l4, 0, 1), (f32x2){wg[4 * k], wg[4 * k + 1]}, z2);
                    z2 = __builtin_elementwise_fma(__builtin_shufflevector(l4, l4, 2, 3), (f32x2){wg[4 * k + 2], wg[4 * k + 3]}, z2); }
                const float z = z2.x + z2.y;
                const float az = fabsf(z); gc[pi] = (fminf(z, 0.f) - flog(1.0f + fexp(-az))) * 0.0625f; }
            float run = 0.f;
            if (dir == 0) {
#pragma unroll
                for (int pi = 0; pi < 16; ++pi) { run += gc[pi]; gc[pi] = run; }
            } else {
#pragma unroll
                for (int pi = 15; pi >= 0; --pi) { run += gc[pi]; gc[pi] = run; }
            }
            SEG[seg * 128 + d] = run;
            __syncthreads();
            const float t0 = SEG[d], t1 = SEG[128 + d], t2 = SEG[256 + d], t3 = SEG[384 + d];
            float off, gmid; const float gend = (t0 + t1) + (t2 + t3);
            if (dir == 0) { off = (seg > 0 ? t0 : 0.f) + (seg > 1 ? t1 : 0.f) + (seg > 2 ? t2 : 0.f); gmid = t0 + t1; }
            else { off = (seg < 3 ? t3 : 0.f) + (seg < 2 ? t2 : 0.f) + (seg < 1 ? t1 : 0.f); gmid = t3 + t2; }
            const float emid = fexp(gmid), eend = fexp(gend - gmid);
            unsigned kep[8];
            bf16* qgp = QG + ((size_t)u * 64 + 16 * seg) * 128 + d;
#pragma unroll
            for (int pi = 0; pi < 16; ++pi) { const int p = 16 * seg + pi; const float rel = off + gc[pi] - gmid; const float Ep = fexp(rel), Ei = fexp(-rel);
                LAS bf16* qa = (LAS bf16*)(lds + GP_QM) + p * 136 + d; LAS bf16* ka = (LAS bf16*)(lds + GP_KM) + p * 136 + d;
                const float qv = bf2f(*qa), kv = bf2f(*ka);
                const float qm = qv * Ep, km = kv * Ei;
                const unsigned w1 = cvtpk(qm, qm * emid), w2 = cvtpk(km, km * eend);
                *qa = (bf16)(w1 & 0xffffu); qgp[pi * 128] = (bf16)(w1 >> 16); *ka = (bf16)(w2 & 0xffffu);
                if (pi & 1) kep[pi >> 1] |= (w2 & 0xffff0000u); else kep[pi >> 1] = w2 >> 16; }
            { u32x4* kt = (u32x4*)(KET + ((size_t)u * 128 + d) * 64 + 16 * seg); kt[0] = (u32x4){kep[0], kep[1], kep[2], kep[3]}; kt[1] = (u32x4){kep[4], kep[5], kep[6], kep[7]}; }
            if (seg == 0) FACD[(size_t)u * 128 + d] = fexp(gend);
            __syncthreads();
            { const int cb = wave & 3, half = wave >> 2;
              bf16x8 qfr[4];
#pragma unroll
              for (int ks = 0; ks < 4; ++ks) qfr[ks] = *(const LAS bf16x8*)(lds + GP_QM + (16 * cb + fr) * 272 + (8 * g + 32 * ks) * 2);
              f32x4 AT[4];
#pragma unroll
              for (int sb = 0; sb < 4; ++sb) { AT[sb] = (f32x4){0.f, 0.f, 0.f, 0.f};
#pragma unroll
                  for (int ks = 0; ks < 4; ++ks) { const bf16x8 af = *(const LAS bf16x8*)(lds + GP_KM + (16 * sb + fr) * 272 + (8 * g + 32 * ks) * 2);
                      AT[sb] = __builtin_amdgcn_mfma_f32_16x16x32_bf16(af, qfr[ks], AT[sb], 0, 0, 0); }
                  const int c = 16 * cb + fr;
#pragma unroll
                  for (int ii = 0; ii < 4; ++ii) { const int sp = 16 * sb + 4 * g + ii; const bool keep = dir ? (sp >= c) : (sp <= c); AT[sb][ii] = keep ? AT[sb][ii] : 0.f; } }
              bf16x8 pf[2];
#pragma unroll
              for (int t = 0; t < 2; ++t) { u32x4 w; w.x = pk2(AT[2 * t][0], AT[2 * t][1]); w.y = pk2(AT[2 * t][2], AT[2 * t][3]); w.z = pk2(AT[2 * t + 1][0], AT[2 * t + 1][1]); w.w = pk2(AT[2 * t + 1][2], AT[2 * t + 1][3]);
                  pf[t] = __builtin_bit_cast(bf16x8, w); }
#pragma unroll
              for (int v8 = 0; v8 < 8; ++v8) { const int vb = 8 * half + v8; f32x4 Oa = (f32x4){0.f, 0.f, 0.f, 0.f};
#pragma unroll
                  for (int t = 0; t < 2; ++t) { const LAS unsigned char* vp = lds + GP_VT + (16 * vb + fr) * 144 + (32 * t + 4 * g) * 2;
                      const u32x2 lo = *(const LAS u32x2*)vp, hi = *(const LAS u32x2*)(vp + 32);
                      u32x4 w; w.x = lo.x; w.y = lo.y; w.z = hi.x; w.w = hi.y;
                      Oa = __builtin_amdgcn_mfma_f32_16x16x32_bf16(__builtin_bit_cast(bf16x8, w), pf[t], Oa, 0, 0, 0); }
                  u32x2 w; w.x = pk2(Oa[0], Oa[1]); w.y = pk2(Oa[2], Oa[3]);
                  *(u32x2*)(OUT + (size_t)(row0 + 16 * cb + fr) * D + hh * 256 + 16 * vb + 4 * g) = w; }
            }
            __syncthreads();
        }
#undef GP_LOAD
#undef GP_N
    }
}

constexpr int GS_BUF = 45056, GS_QG = 0, GS_KET = 17408, GS_VT = 35840, GS_ST = 2 * GS_BUF, GS_DEC = GS_ST + 2 * 17408;
__device__ __forceinline__ void phase_gla(const bf16* VGT, bf16* OF, bf16* OB, const bf16* QG, const bf16* KET, const float* FACD,
                                          LAS unsigned char* lds, int tid, int lane, int wave, int vcu, int G) {
    const int fr = lane & 15, g = lane >> 4;
    for (int u = vcu; u < 256; u += G) {
        const int slab = u & 3, dir = (u >> 2) & 1, hh = (u >> 3) & 3, b = u >> 5;
        bf16* OUT = dir ? OB : OF;
        const int upb = ((b * 4 + hh) * 2 + dir) * 36;
        f32x4 Sacc[4];
#pragma unroll
        for (int vb = 0; vb < 4; ++vb) Sacc[vb] = (f32x4){0.f, 0.f, 0.f, 0.f};
        for (int i = tid; i < 17408 / 4; i += 512) ((LAS unsigned*)(lds + GS_ST))[i] = 0u;
        const bf16* vtb = VGT + ((size_t)(b * 4 + hh) * 256 + slab * 64) * NKEY;
        const int cb = wave & 3, vh = wave >> 2;
        const int ocol = hh * 256 + slab * 64 + 32 * vh + 4 * g;
        struct GsRegs { u32x4 qg[2], ket[2], v; u32x2 oi[2]; float dec; };
        GsRegs R0, R1; R0.dec = 0.f; R1.dec = 0.f;
#define GS_LOAD(R, n) do { int _row0, _tok0; gla_chunk_rows(b, dir, (n), _row0, _tok0); const size_t _u = (size_t)(upb + (n)); \
        _Pragma("unroll") for (int j = 0; j < 2; ++j) { const int idx = tid + 512 * j; R.qg[j] = *(const u32x4*)(QG + _u * 8192 + idx * 8); R.ket[j] = *(const u32x4*)(KET + _u * 8192 + idx * 8); } \
        R.v = *(const u32x4*)(vtb + (size_t)(tid >> 3) * NKEY + _tok0 + (tid & 7) * 8); \
        if (tid < 128) R.dec = FACD[_u * 128 + tid]; \
        _Pragma("unroll") for (int v2 = 0; v2 < 2; ++v2) R.oi[v2] = *(const u32x2*)(OUT + (size_t)(_row0 + 16 * cb + fr) * D + ocol + 16 * v2); } while (0)
#define GS_STORE(R, bf) do { LAS unsigned char* _p = lds + (bf) * GS_BUF; \
        _Pragma("unroll") for (int j = 0; j < 2; ++j) { const int idx = tid + 512 * j; *(LAS u32x4*)(_p + GS_QG + (idx >> 4) * 272 + (idx & 15) * 16) = R.qg[j]; *(LAS u32x4*)(_p + GS_KET + (idx >> 3) * 144 + (idx & 7) * 16) = R.ket[j]; } \
        *(LAS u32x4*)(_p + GS_VT + (tid >> 3) * 144 + (tid & 7) * 16) = R.v; \
        if (tid < 128) ((LAS float*)(lds + GS_DEC))[(bf) * 128 + tid] = R.dec; } while (0)
#define GS_ITER(n, RN, RF) do { const int _n = (n); int row0, tok0; gla_chunk_rows(b, dir, _n, row0, tok0); const int cur = _n & 1; \
            if (_n + 2 < 36) GS_LOAD(RF, _n + 2); \
            const LAS unsigned char* bufp = lds + cur * GS_BUF; const LAS unsigned char* stp = lds + GS_ST + cur * 17408; \
            { bf16x8 qfr[4]; \
              _Pragma("unroll") for (int ks = 0; ks < 4; ++ks) qfr[ks] = *(const LAS bf16x8*)(bufp + GS_QG + (16 * cb + fr) * 272 + (8 * g + 32 * ks) * 2); \
              _Pragma("unroll") for (int v2 = 0; v2 < 2; ++v2) { const int vb = 2 * vh + v2; const u32x2 oin = v2 ? oc1 : oc0; \
                  f32x4 Oa = (f32x4){bflo(oin.x), bfhi(oin.x), bflo(oin.y), bfhi(oin.y)}; \
                  _Pragma("unroll") for (int ks = 0; ks < 4; ++ks) { const bf16x8 af = *(const LAS bf16x8*)(stp + (16 * vb + fr) * 272 + (8 * g + 32 * ks) * 2); \
                      Oa = __builtin_amdgcn_mfma_f32_16x16x32_bf16(af, qfr[ks], Oa, 0, 0, 0); } \
                  u32x2 w; w.x = pk2(Oa[0], Oa[1]); w.y = pk2(Oa[2], Oa[3]); \
                  *(u32x2*)(OUT + (size_t)(row0 + 16 * cb + fr) * D + ocol + 16 * v2) = w; } } \
            { const f32x4 dec = *(const LAS f32x4*)((LAS float*)(lds + GS_DEC) + cur * 128 + 16 * wave + 4 * g); \
              LAS unsigned char* stn = lds + GS_ST + (cur ^ 1) * 17408; \
              _Pragma("unroll") for (int vb = 0; vb < 4; ++vb) { Sacc[vb] = Sacc[vb] * dec; \
                  _Pragma("unroll") for (int t = 0; t < 2; ++t) { const bf16x8 af = *(const LAS bf16x8*)(bufp + GS_KET + (16 * wave + fr) * 144 + (8 * g + 32 * t) * 2); \
                      const bf16x8 bfr = *(const LAS bf16x8*)(bufp + GS_VT + (16 * vb + fr) * 144 + (8 * g + 32 * t) * 2); \
                      Sacc[vb] = __builtin_amdgcn_mfma_f32_16x16x32_bf16(af, bfr, Sacc[vb], 0, 0, 0); } \
                  u32x2 w; w.x = pk2(Sacc[vb][0], Sacc[vb][1]); w.y = pk2(Sacc[vb][2], Sacc[vb][3]); \
                  *(LAS u32x2*)(stn + (16 * vb + fr) * 272 + (16 * wave + 4 * g) * 2) = w; } } \
            if (_n + 1 < 36) { GS_STORE(RN, cur ^ 1); oc0 = RN.oi[0]; oc1 = RN.oi[1]; } \
            __syncthreads(); } while (0)
        GS_LOAD(R0, 0); GS_STORE(R0, 0);
        u32x2 oc0 = R0.oi[0], oc1 = R0.oi[1];
        GS_LOAD(R0, 1);
        __syncthreads();
        for (int n = 0; n < 36; n += 2) { GS_ITER(n, R0, R1); GS_ITER(n + 1, R1, R0); }
#undef GS_ITER
#undef GS_LOAD
#undef GS_STORE
    }
}

constexpr int N_PHASES = 34;
typedef const Args __attribute__((address_space(4)))* KArgs;
__device__ __forceinline__ KArgs kargs() { KArgs p = (KArgs)__builtin_amdgcn_kernarg_segment_ptr(); asm volatile("" : "+s"(p)); return p; }
__global__ void __launch_bounds__(512, 2) fwd(Args a_unused) {
    extern __shared__ __attribute__((aligned(16))) unsigned char lds_raw[];
    LAS unsigned char* lds = (LAS unsigned char*)lds_raw;
    const int tid0 = threadIdx.x;
    const int G0 = gridDim.x; const int bx0 = blockIdx.x;
#define PH_ENTRY int tid = tid0; asm volatile("" : "+v"(tid)); int G = G0, bx = bx0; asm volatile("" : "+s"(G), "+s"(bx)); const int lane = tid & 63, wave = __builtin_amdgcn_readfirstlane(tid >> 6); \
        const int vcu = (G % 8 == 0) ? (bx % 8) * (G / 8) + bx / 8 : bx; (void)lane; (void)wave; (void)vcu
    const int tid = tid0;
    const int ph_lo = kargs()->ph_lo, ph_hi = kargs()->ph_hi;
    const int repmask = kargs()->rep;
    if (tid < 64) ((LAS unsigned*)(lds + LX_MISC))[tid] = 0u;
    for (int i = tid; i < 1024; i += 512) { const int pos = i >> 4, f = i & 15; const float inv = __builtin_amdgcn_exp2f(-(float)f * (13.287712379549449f / 16.0f)); const float ang = (float)pos * inv;
        ((LAS float*)(lds + LX_ROPE))[2 * i] = __cosf(ang); ((LAS float*)(lds + LX_ROPE))[2 * i + 1] = __sinf(ang); }
    __syncthreads();
    const bool single = (ph_hi - ph_lo) > 1;
    XcdBarrier bar; bar.bar = (unsigned*)(kargs()->ws + WS_CTL) + CW_BAR; bar.x = 0; bar.st = (volatile LAS unsigned*)(lds + LX_MISC);
    if (single) bar = xcd_barrier_post((unsigned*)(kargs()->ws + WS_CTL) + CW_BAR, (volatile LAS unsigned*)(lds + LX_MISC));
#define IN(k) (ph_lo <= (k) && (k) < ph_hi)
#define REPLOOP(t) for (int rep_ = 0, nrep_ = 1 + ((repmask >> (t)) & 1); rep_ < nrep_; ++rep_, (rep_ < nrep_ ? (bar.bar = (unsigned*)(kargs()->ws + WS_CTL) + CW_BAR, xcd_barrier(bar)) : (void)0))
#define SEAM(k) do { if (IN(k) && IN((k) + 1)) { bar.bar = (unsigned*)(kargs()->ws + WS_CTL) + CW_BAR; xcd_barrier(bar); if ((repmask >> 10) & 1) xcd_barrier(bar); } } while (0)
    LAS int* tab = (LAS int*)(lds + LX_MOETAB);
#define CONV_PTRS(A) ConvPtrs{(A)->att_w_in, (A)->att_w_out, (A)->gla_w_in, (A)->gla_w_out, (A)->moe_w1, (A)->moe_w3, (A)->moe_w2, (A)->ws}

    if (IN(0)) REPLOOP(0) { PH_ENTRY; p0_prologue(kargs(), lds, tid, lane, wave, vcu, G); } SEAM(0);
    if (IN(1)) { PH_ENTRY; KArgs A = kargs(); unsigned char* ws = A->ws; phase_norm1(A->x, A->ctx, A->norm_g, (float*)(ws + WS_MODV), (bf16*)(ws + WS_H), TALL, lane, wave, vcu, G); } SEAM(1);

#pragma nounroll
    for (int L = 0; L < 4; ++L) {
        const int pb = 2 + 8 * L; const bool isattn = !(L & 1); const int j = L >> 1; const bool lastL = (L == 3);
        const int nrows = lastL ? TX : TALL;
        if (IN(pb)) REPLOOP(isattn ? 1 : 3) {
            PH_ENTRY; KArgs A = kargs(); unsigned char* ws = A->ws; unsigned char* big = ws + WS_BIG; const bf16* H = (const bf16*)(ws + WS_H);
            if (isattn) {
                pg8::DenseOrder S; S.init(H, (const bf16*)(ws + WS_WATTIN) + (size_t)j * NATT * D, TALL, NATT, D, G, bx);
                pg8::EpiAttnIn E{(bf16*)(big + BG_QKV), (bf16*)(big + BG_VAT), (bf16*)(big + BG_VBT), (const LAS float*)(lds + LX_ROPE)};
                pg8::gemm_phase<pg8::EpiAttnIn, pg8::DenseOrder, false>(lds, tid, D, S, E);
            } else {
                pg8::DenseOrder S; S.init(H, (const bf16*)(ws + WS_WGLAIN) + (size_t)j * NGLA * D, TALL, NGLA, D, G, bx);
                pg8::EpiGlaIn E{(bf16*)(big + BG_QKV2), (bf16*)(big + BG_VGT)};
                pg8::gemm_phase<pg8::EpiGlaIn, pg8::DenseOrder, false>(lds, tid, D, S, E);
            }
        }
        SEAM(pb);
        if (!isattn && IN(pb + 1)) {
            for (int rep_ = 0; rep_ <= ((repmask >> 13) & 1); ++rep_)
            { PH_ENTRY; KArgs A = kargs(); unsigned char* ws = A->ws;
              phase_gla_prep((const bf16*)(ws + WS_BIG + BG_QKV2), (const bf16*)(ws + WS_BIG + BG_VGT), A->gla_w_gate + j * 2 * 16 * 512, A->gla_b_gate + j * 2 * 512,
                             (bf16*)(ws + WS_QG), (bf16*)(ws + WS_KET), (float*)(ws + WS_BIG + BG_FAC), (bf16*)(ws + WS_BIG + BG_OF), (bf16*)(ws + WS_BIG + BG_OB), lds, tid, lane, wave, vcu, G); }
            if (single) { bar.bar = (unsigned*)(kargs()->ws + WS_CTL) + CW_BAR; xcd_barrier(bar); }
        }
        if (IN(pb + 1)) REPLOOP(isattn ? 2 : 4) {
            PH_ENTRY; KArgs A = kargs(); unsigned char* ws = A->ws; unsigned char* big = ws + WS_BIG; bf16* AOUT = (bf16*)(ws + WS_AOUT);
            if (isattn) { const ConvPtrs CP = CONV_PTRS(A);
                phase_attention((const bf16*)(big + BG_QKV), (const bf16*)(big + BG_VAT), (const bf16*)(big + BG_VBT), AOUT, A->att_lambda + j * 256, (L == 0) ? 0.2f : 0.470713018f,
                                A->att_subln_g + j * 128, A->na_bias + j * 8 * 465, (unsigned*)(ws + WS_CTL) + CW_NAQ + 64 * j, CP,
                                MK_CONVQ ? (L == 0 ? CT_ATTN0 : CT_MOE1) : 0, MK_CONVQ ? (L == 0 ? CT_MOE1 : CT_MOE3) : 0, lds, tid, lane, wave); }
            else phase_gla((const bf16*)(big + BG_VGT), (bf16*)(big + BG_OF), (bf16*)(big + BG_OB), (const bf16*)(ws + WS_QG), (const bf16*)(ws + WS_KET), (const float*)(big + BG_FAC),
                           lds, tid, lane, wave, vcu, G);
        }
        SEAM(pb + 1);
        if (!isattn) {
            if (IN(pb + 2)) REPLOOP(5) { PH_ENTRY; KArgs A = kargs(); unsigned char* ws = A->ws; unsigned char* big = ws + WS_BIG;
                phase_readout((const bf16*)(big + BG_OF), (const bf16*)(big + BG_OB), (const bf16*)(big + BG_QKV2), A->gla_norm_g + j * 256, (bf16*)(ws + WS_AOUT), nrows, lane, wave, vcu, G); }
            SEAM(pb + 2);
        }
        if (IN(pb + 3)) {
            PH_ENTRY; KArgs A = kargs(); unsigned char* ws = A->ws;
            pg8::DenseOrder S; S.init((const bf16*)(ws + WS_AOUT), (const bf16*)(ws + (isattn ? WS_WATTOUT : WS_WGLAOUT)) + (size_t)j * D * D, nrows, D, D, G, bx);
            if (L == 0) { pg8::EpiResid<true> E{A->x, A->ctx, (bf16*)(ws + WS_XB), (const float*)(ws + WS_MODV) + (size_t)L * 9 * 6144 + 2048};
                pg8::gemm_phase<pg8::EpiResid<true>, pg8::DenseOrder, false>(lds, tid, D, S, E); }
            else { pg8::EpiResid<false> E{nullptr, nullptr, (bf16*)(ws + WS_XB), (const float*)(ws + WS_MODV) + (size_t)L * 9 * 6144 + 2048};
                pg8::gemm_phase<pg8::EpiResid<false>, pg8::DenseOrder, false>(lds, tid, D, S, E); }
        }
        SEAM(pb + 3);
        if (IN(pb + 4)) { PH_ENTRY; KArgs A = kargs(); unsigned char* ws = A->ws;
            phase_router((const bf16*)(ws + WS_XB), A->norm_g + (L * 2 + 1) * D, (const float*)(ws + WS_MODV) + (size_t)L * 9 * 6144, (bf16*)(ws + WS_H), A->router_w, A->router_bias,
                         (unsigned*)(ws + WS_CTL) + CW_CNT + L * 16 * 64, (int*)(ws + WS_LIST), (int*)(ws + WS_TOKI), (float*)(ws + WS_TOKW), nrows, lds, tid, lane, wave, vcu, G, (repmask >> 11) & 1); }
        SEAM(pb + 4);
        if (IN(pb + 5)) REPLOOP(6) {
            PH_ENTRY; KArgs A = kargs(); unsigned char* ws = A->ws;
            const int RT = build_moe_table((unsigned*)(ws + WS_CTL) + CW_CNT + L * 16 * 64, tab, tid);
            pg8::MoeOrder S; S.A = (const char*)(ws + WS_H); S.B = (const char*)(ws + WS_W13) + (size_t)L * 16 * D * D * 2; S.K = D; S.bstride = (size_t)D * D * 2; S.tab = tab; S.list = (const int*)(ws + WS_LIST); S.RT = RT; S.nwg = RT * 4; S.G = G; S.c = bx;
            S.fill_tokc((LAS int*)(lds + LX_BIAS), tid);
            pg8::EpiMoe1 E{(bf16*)(ws + WS_BIG + BG_HB)};
            pg8::gemm_phase<pg8::EpiMoe1, pg8::MoeOrder, true>(lds, tid, D, S, E);
        }
        SEAM(pb + 5);
        if (IN(pb + 6)) REPLOOP(7) {
            PH_ENTRY; KArgs A = kargs(); unsigned char* ws = A->ws;
            const int RT = build_moe_table((unsigned*)(ws + WS_CTL) + CW_CNT + L * 16 * 64, tab, tid);
            pg8::MoeOrder S; S.A = (const char*)(ws + WS_BIG + BG_HB); S.B = (const char*)(ws + WS_W2) + (size_t)L * 16 * D * DEXP * 2; S.K = DEXP; S.bstride = (size_t)D * DEXP * 2; S.tab = tab; S.list = (const int*)(ws + WS_LIST); S.RT = RT; S.nwg = RT * 4; S.G = G; S.c = bx;
            pg8::EpiBf16 E{(bf16*)(ws + WS_BIG + BG_YB), D};
            pg8::gemm_phase<pg8::EpiBf16, pg8::MoeOrder, false>(lds, tid, DEXP, S, E);
        }
        SEAM(pb + 6);
        if (IN(pb + 7)) { PH_ENTRY; KArgs A = kargs(); unsigned char* ws = A->ws; const float* MODV = (const float*)(ws + WS_MODV);
            if (lastL) phase_combine<true>((bf16*)(ws + WS_XB), A->out, MODV + (size_t)L * 9 * 6144, (const bf16*)(ws + WS_BIG + BG_YB), (unsigned*)(ws + WS_CTL) + CW_CNT + L * 16 * 64, (const int*)(ws + WS_TOKI), (const float*)(ws + WS_TOKW),
                                           A->final_g, MODV + (size_t)L * 9 * 6144, (bf16*)(ws + WS_H), nrows, lane, wave, vcu, G);
            else phase_combine<false>((bf16*)(ws + WS_XB), A->out, MODV + (size_t)L * 9 * 6144, (const bf16*)(ws + WS_BIG + BG_YB), (unsigned*)(ws + WS_CTL) + CW_CNT + L * 16 * 64, (const int*)(ws + WS_TOKI), (const float*)(ws + WS_TOKW),
                                      A->norm_g + ((L + 1) * 2) * D, MODV + (size_t)(L + 1) * 9 * 6144, (bf16*)(ws + WS_H), nrows, lane, wave, vcu, G); }
        if (!lastL) SEAM(pb + 7);
    }
#undef IN
#undef REPLOOP
#undef SEAM
#undef CONV_PTRS

#undef PH_ENTRY
}

extern "C" void kernel_launch(void* const* d_in, const int* in_sizes, int n_in, void* d_out, int out_size, void* d_ws, size_t ws_size, hipStream_t stream) {
    static int ready = 0;
    if (ready == 0) {
        if (n_in != 23 || out_size != TX * D || ws_size < WS_END) { fprintf(stderr, "kernel_launch: unexpected shapes (n_in %d out %d ws %zu)\n", n_in, out_size, ws_size); ready = -1; return; }
        if (hipFuncSetAttribute((const void*)fwd, hipFuncAttributeMaxDynamicSharedMemorySize, LDS_BYTES) != hipSuccess) { fprintf(stderr, "kernel_launch: hipFuncSetAttribute failed\n"); ready = -1; return; }
        int per_cu = 0; (void)hipOccupancyMaxActiveBlocksPerMultiprocessor(&per_cu, (const void*)fwd, 512, LDS_BYTES); (void)hipGetLastError();
        if (per_cu < 1) fprintf(stderr, "kernel_launch: occupancy query reports %d blocks per CU\n", per_cu);
        ready = 1;
    }
    if (ready < 0) return;
    (void)hipMemsetAsync((char*)d_ws + WS_CTL, 0, CTL_ZERO_BYTES, stream);
    Args a{};
    const float** ap = (const float**)&a;
    for (int i = 0; i < 23; ++i) ap[i] = (const float*)d_in[i];
    a.out = (float*)d_out; a.ws = (unsigned char*)d_ws;
    const int grid = 256;
    a.ph_lo = 0; a.ph_hi = N_PHASES; a.rep = MK_REPMASK;
    hipLaunchKernelGGL(fwd, dim3(grid), dim3(512), LDS_BYTES, stream, a);
}
```

```cpp
#include <hip/hip_runtime.h>
#include <cstdio>
#include <cstdint>

#ifndef MK_CONVQ
#define MK_CONVQ 1
#endif
#ifndef MK_REPMASK
#define MK_REPMASK 0
#endif

#define GAS __attribute__((address_space(1)))
#define LAS __attribute__((address_space(3)))
typedef unsigned short bf16;
typedef short bf16x8 __attribute__((ext_vector_type(8)));
typedef short bf16x4 __attribute__((ext_vector_type(4)));
typedef float f32x4 __attribute__((ext_vector_type(4)));
typedef float f32x2 __attribute__((ext_vector_type(2)));
typedef unsigned u32x4 __attribute__((ext_vector_type(4)));
typedef unsigned u32x2 __attribute__((ext_vector_type(2)));

constexpr int D = 1024, NB = 8, SEQ = 2048, CTXL = 256;
constexpr int TX = NB * SEQ, TC = NB * CTXL, TALL = TX + TC;
constexpr int NKEY = SEQ + CTXL;
constexpr int NATT = 3072, NGLA = 3328;
constexpr float EPSF = 1e-6f;
constexpr float LOG2E = 1.4426950408889634f;
constexpr int NEXP = 16, DEXP = 512;
constexpr int RT_MAX = 160;

constexpr size_t MiB = 1u << 20;
constexpr size_t WS_CTL = 0, CTL_ZERO_BYTES = 65536;
constexpr size_t WS_MODV = 1 * MiB;
constexpr size_t WS_TOKI = 2 * MiB;
constexpr size_t WS_TOKW = 2 * MiB + 512 * 1024;
constexpr size_t WS_LIST = 3 * MiB;
constexpr size_t WS_CTX = 5 * MiB;
constexpr size_t WS_WATTIN = 13 * MiB;
constexpr size_t WS_WATTOUT = 25 * MiB;
constexpr size_t WS_WGLAIN = 29 * MiB;
constexpr size_t WS_WGLAOUT = 42 * MiB;
constexpr size_t WS_W13 = 46 * MiB;
constexpr size_t WS_W2 = 174 * MiB;
constexpr size_t WS_H = 238 * MiB;
constexpr size_t WS_AOUT = 274 * MiB;
constexpr size_t WS_BIG = 310 * MiB;
constexpr size_t WS_XB = 539 * MiB;
constexpr size_t WS_END = 575 * MiB;
constexpr size_t BG_QKV = 0;
constexpr size_t BG_VAT = 108 * MiB;
constexpr size_t BG_VBT = 126 * MiB;
constexpr size_t BG_QKV2 = 0;
constexpr size_t BG_VGT = 117 * MiB;
constexpr size_t BG_OF = 153 * MiB;
constexpr size_t BG_OB = 189 * MiB;
constexpr size_t BG_FAC = 225 * MiB;
constexpr size_t WS_QG = WS_H, WS_KET = WS_AOUT;
constexpr size_t BG_HB = 0;
constexpr size_t BG_YB = 40 * MiB;
constexpr int CW_TMO = 0;
constexpr int CW_BAR = 4096;
constexpr int CW_NAQ = 15360;
constexpr int CW_CNT = 8192;

constexpr int RING_BYTES = 131072;
constexpr int LX_OFF = RING_BYTES;
constexpr int LX_MISC = LX_OFF;
constexpr int LX_MOETAB = LX_OFF + 256;
constexpr int LX_ROPE = LX_OFF + 2048;
constexpr int LX_BIAS = LX_OFF + 2048 + 8192;
constexpr int LDS_BYTES = 147456;

#define LDS_WAIT() asm volatile("s_waitcnt lgkmcnt(0)" ::: "memory")
#define VM_WAIT() asm volatile("s_waitcnt vmcnt(0)" ::: "memory")
#define RLX_AGENT __ATOMIC_RELAXED, __HIP_MEMORY_SCOPE_AGENT
__device__ __forceinline__ unsigned f2bf(float f) { unsigned u = __builtin_bit_cast(unsigned, f); return (u + 0x7fffu + ((u >> 16) & 1u)) >> 16; }
typedef __bf16 hwbf16x2 __attribute__((ext_vector_type(2)));
__device__ __forceinline__ unsigned cvtpk(float lo, float hi) { const f32x2 v = {lo, hi}; const hwbf16x2 b = __builtin_convertvector(v, hwbf16x2); return __builtin_bit_cast(unsigned, b); }
__device__ __forceinline__ unsigned pk2(float lo, float hi) { return cvtpk(lo, hi); }
__device__ __forceinline__ float bf2f(unsigned short b) { return __builtin_bit_cast(float, ((unsigned)b) << 16); }
__device__ __forceinline__ float bflo(unsigned w) { return __builtin_bit_cast(float, w << 16); }
__device__ __forceinline__ float bfhi(unsigned w) { return __builtin_bit_cast(float, w & 0xffff0000u); }
template <int CTRL> __device__ __forceinline__ float dppf(float v) { return __builtin_bit_cast(float, __builtin_amdgcn_update_dpp(0, __builtin_bit_cast(int, v), CTRL, 0xf, 0xf, true)); }
__device__ __forceinline__ float row_sum(float v) { v += dppf<0xB1>(v); v += dppf<0x4E>(v); v += dppf<0x124>(v); v += dppf<0x128>(v); return v; }
__device__ __forceinline__ float swap16_add(float a, float b) { auto r = __builtin_amdgcn_permlane16_swap(__float_as_uint(a), __float_as_uint(b), false, false); const unsigned r0 = r[0], r1 = r[1]; return __uint_as_float(r0) + __uint_as_float(r1); }
__device__ __forceinline__ float swap32_add(float a, float b) { auto r = __builtin_amdgcn_permlane32_swap(__float_as_uint(a), __float_as_uint(b), false, false); const unsigned r0 = r[0], r1 = r[1]; return __uint_as_float(r0) + __uint_as_float(r1); }
__device__ __forceinline__ float swap16_max(float a) { auto r = __builtin_amdgcn_permlane16_swap(__float_as_uint(a), __float_as_uint(a), false, false); const unsigned r0 = r[0], r1 = r[1]; return fmaxf(__uint_as_float(r0), __uint_as_float(r1)); }
__device__ __forceinline__ float swap32_max(float a) { auto r = __builtin_amdgcn_permlane32_swap(__float_as_uint(a), __float_as_uint(a), false, false); const unsigned r0 = r[0], r1 = r[1]; return fmaxf(__uint_as_float(r0), __uint_as_float(r1)); }
__device__ __forceinline__ float readlane_f(float v, int l) { return __int_as_float(__builtin_amdgcn_readlane(__float_as_int(v), l)); }
__device__ __forceinline__ float wave_sum(float v) { v = row_sum(v); v = swap16_add(v, v); return swap32_add(v, v); }
__device__ __forceinline__ float fexp2(float x) { return __builtin_amdgcn_exp2f(x); }
__device__ __forceinline__ float fexp(float x) { return __builtin_amdgcn_exp2f(x * LOG2E); }
__device__ __forceinline__ float flog(float x) { return __builtin_amdgcn_logf(x) * 0.6931471805599453f; }
__device__ __forceinline__ float frcp(float x) { return __builtin_amdgcn_rcpf(x); }
__device__ __forceinline__ float silu_f(float x) { return x * frcp(1.0f + fexp(-x)); }

#define XB_TMO      128
#define XB_XCNT(j)  (256  + 64 * (j))
#define XB_XSUB(j)  (1280 + 64 * (j))
#define XB_XGEN(j)  (2304 + 64 * (j))
#define XB_TOP      3328
#define XB_TOPGEN   3392
#define XCD_BAR_WORDS 3456
#define XB_SPIN_CAP (1u << 18)
__device__ __forceinline__ unsigned xb_ld(unsigned* p)              { return __hip_atomic_load(p, __ATOMIC_RELAXED, __HIP_MEMORY_SCOPE_AGENT); }
__device__ __forceinline__ unsigned xb_add(unsigned* p, unsigned v) { return __hip_atomic_fetch_add(p, v, __ATOMIC_RELAXED, __HIP_MEMORY_SCOPE_AGENT); }
__device__ __forceinline__ unsigned xb_xcc_id() { return (unsigned)__builtin_amdgcn_s_getreg((3 << 11) | 20) & 0xFu; }
#define XB_SPIN(cond, bar) do { unsigned _sp = 0; while (cond) { __builtin_amdgcn_s_sleep(1); \
    if ((++_sp & 255u) == 0u) { if (xb_ld(&(bar)[XB_TMO])) break; if (_sp > XB_SPIN_CAP) { atomicAdd(&(bar)[XB_TMO], 1u); break; } } } } while (0)
struct XcdBarrier { unsigned* bar; unsigned x; volatile LAS unsigned* st; };
__device__ __forceinline__ XcdBarrier xcd_barrier_post(unsigned* bar, volatile LAS unsigned* st) {
    XcdBarrier b; b.bar = bar; b.x = xb_xcc_id(); b.st = st;
    if (threadIdx.x == 0) (void)xb_add(&bar[XB_XCNT(b.x)], 1u);
    return b;
}
__device__ __forceinline__ void xcd_barrier_complete(unsigned* bar, unsigned x, unsigned& nloc, unsigned& nx) {
    const unsigned G = gridDim.x * gridDim.y * gridDim.z;
    unsigned sum, cnt, mine, sp = 0u;
    for (;;) {
        sum = 0u; cnt = 0u; mine = 0u;
#pragma unroll
        for (unsigned j = 0; j < 16; ++j) { const unsigned c = xb_ld(&bar[XB_XCNT(j)]); sum += c; cnt += (c > 0u) ? 1u : 0u; mine = (j == x) ? c : mine; }
        if (sum == G) break;
        __builtin_amdgcn_s_sleep(1);
        if ((++sp & 255u) == 0u) { if (xb_ld(&bar[XB_TMO])) break; if (sp > XB_SPIN_CAP) { atomicAdd(&bar[XB_TMO], 1u); break; } }
    }
    nloc = mine > 0u ? mine : 1u; nx = cnt > 0u ? cnt : 1u;
}
__device__ __forceinline__ void xcd_barrier(const XcdBarrier& b) {
    asm volatile("s_waitcnt vmcnt(0)" ::: "memory");
    __syncthreads();
    if (threadIdx.x == 0) {
        unsigned* bar = b.bar;
        __builtin_amdgcn_s_waitcnt(0);
        unsigned nloc = b.st[0], nx = b.st[1];
        if (nloc == 0u) { xcd_barrier_complete(bar, b.x, nloc, nx); b.st[0] = nloc; b.st[1] = nx; }
        const unsigned old = xb_add(&bar[XB_XSUB(b.x)], 1u);
        const unsigned gen = old / nloc;
        if (old + 1u == (gen + 1u) * nloc) {
            __builtin_amdgcn_fence(__ATOMIC_RELEASE, "agent");
            asm volatile("s_waitcnt vmcnt(0)" ::: "memory");
            const unsigned og = xb_add(&bar[XB_TOP], 1u);
            const unsigned tg = og / nx;
            if (og + 1u == (tg + 1u) * nx) xb_add(&bar[XB_TOPGEN], 1u);
            else XB_SPIN(xb_ld(&bar[XB_TOPGEN]) == tg, bar);
            __builtin_amdgcn_fence(__ATOMIC_ACQUIRE, "agent");
            xb_add(&bar[XB_XGEN(b.x)], 1u);
            asm volatile("s_waitcnt vmcnt(0)" ::: "memory");
        } else {
            XB_SPIN(xb_ld(&bar[XB_XGEN(b.x)]) == gen, bar);
            __builtin_amdgcn_fence(__ATOMIC_ACQUIRE, "agent");
            asm volatile("s_waitcnt vmcnt(0)" ::: "memory");
        }
    }
    __syncthreads();
}

namespace pg8 {
constexpr int BM = 256, BK = 64, HALF = 128, HTB = HALF * BK * 2, STAGE_BYTES = 8 * HTB, NXCD = 8, WGM = 8;
__host__ __device__ __forceinline__ int lds_byte(int r, int c) { const int st = (r >> 4) * 2 + (c >> 5), rr = r & 15, cc = c & 31, ob = rr * 64 + cc * 2; return st * 1024 + (ob ^ (((ob >> 9) & 1) << 5)); }
__host__ __device__ __forceinline__ void stage_rc(int b, int& R, int& C) { const int st = b / 1024, sb = b % 1024, swz = sb ^ (((sb >> 9) & 1) << 5); R = (st >> 1) * 16 + swz / 64; C = (st & 1) * 32 + (swz % 64) / 2; }
__host__ __device__ __forceinline__ int perm32(int rho) { const int n = rho >> 4, i = rho & 15; return 8 * (i >> 2) + 4 * n + (i & 3); }

struct Unit { int pm, pn, e, mt, roff, nai, ord; };
__device__ __forceinline__ bool split_index(long L, int nwg, int G, int& uidx, int& roff, int& nai) {
    const int R = nwg / G, r = nwg % G; const bool split = (r > 0) && (2 * r <= G);
    if (L < (long)R * G || !split) { if (L >= nwg) return false; uidx = (int)L; roff = 0; nai = 2; return true; }
    const int h = (int)(L - (long)R * G); if (h >= 2 * r) return false; uidx = R * G + (h >> 1); roff = (h & 1) * 128; nai = 1; return true;
}

__device__ __forceinline__ int xcd_remap(int wgid, int nwg) { const int q = nwg / NXCD, r = nwg % NXCD, xcd = wgid % NXCD, off = wgid / NXCD; return (xcd < r ? xcd * (q + 1) : r * (q + 1) + (xcd - r) * q) + off; }

struct DenseOrder {
    const char* A; const char* B; int K; int nM, nN, nwg, G, c;
    __device__ __forceinline__ void init(const bf16* A_, const bf16* B_, int M, int N, int K_, int G_, int c_) { A = (const char*)A_; B = (const char*)B_; K = K_; nM = M / BM; nN = N / BM; nwg = nM * nN; G = G_; c = c_; }
    __device__ __forceinline__ bool next(int i, Unit& u) const {
        int uidx; if (!split_index((long)i * G + c, nwg, G, uidx, u.roff, u.nai)) return false;
        const int wgid = xcd_remap(uidx, nwg);
        const int nig = WGM * nN, gid = wgid / nig, fm = gid * WGM, gsz = (nM - fm) < WGM ? (nM - fm) : WGM;
        u.pm = fm + ((wgid % nig) % gsz); u.pn = (wgid % nig) / gsz; u.e = 0; u.mt = 0; u.ord = i; return true;
    }
    __device__ __forceinline__ const char* a_ptr(const Unit& u) const { return A + (size_t)(u.pm * BM + u.roff) * K * 2; }
    __device__ __forceinline__ const char* b_ptr(const Unit& u) const { return B + (size_t)u.pn * BM * K * 2; }
    __device__ __forceinline__ int tok(const Unit&, int) const { return 0; }
};
struct MoeOrder {
    const char* A; const char* B; int K; size_t bstride;
    const LAS int* tab; const int* list; int RT, nwg, G, c;
    __device__ __forceinline__ bool next(int i, Unit& u) const {
        int uidx; if (!split_index((long)i * G + c, nwg, G, uidx, u.roff, u.nai)) return false;
        const int wgid = xcd_remap(uidx, nwg);
        const int rt = wgid >> 2; u.pm = rt; u.pn = wgid & 3; const int t = tab[rt]; u.e = t & 255; u.mt = t >> 8; u.ord = i; return true;
    }
    __device__ __forceinline__ const char* a_ptr(const Unit& u) const { return A + (size_t)(u.pm * BM + u.roff) * K * 2; }
    __device__ __forceinline__ const char* b_ptr(const Unit& u) const { return B + (size_t)u.e * bstride + (size_t)u.pn * BM * K * 2; }
    const LAS int* tokc;
    __device__ __forceinline__ int tok(const Unit& u, int r) const { return tokc[u.ord * BM + r]; }
    __device__ __forceinline__ void fill_tokc(LAS int* dst, int tid) {
        tokc = dst;
        int val[2], idx[2]; bool ok[2];
#pragma unroll
        for (int k = 0; k < 2; ++k) { const int i = (tid >> 8) + 2 * k, r = tid & 255; Unit u; const bool has = (i < 3) && next(i, u);
            const int cnt = has ? tab[RT_MAX + 1 + u.e] : 0; const int pos = has ? u.mt * BM + u.roff + r : 0;
            ok[k] = has; idx[k] = i * BM + r;
            val[k] = list[(size_t)(has ? u.e : 0) * TALL + pos];
            val[k] = (pos < cnt) ? val[k] : 0; }
#pragma unroll
        for (int k = 0; k < 2; ++k) if (ok[k]) dst[idx[k]] = val[k];
        __syncthreads();
    }
};

__device__ __forceinline__ unsigned cvt_pk_bf16(float lo, float hi) { unsigned r; asm volatile("v_cvt_pk_bf16_f32 %0, %1, %2" : "=v"(r) : "v"(lo), "v"(hi)); return r; }

template <class Epi, class Sched, bool GATHER>
__device__ __forceinline__ void gemm_phase(LAS unsigned char* lds, const int tid, const int K, const Sched& S, const Epi& E) {
    const int wid = __builtin_amdgcn_readfirstlane(tid >> 6), lane = tid & 63, wr = wid >> 2, wc = wid & 3, fr = lane & 15, fq = lane >> 4;
    const int nt = K / BK;
    unsigned voffA[2], voffB[2]; int RA[2], CA[2];
#pragma unroll
    for (int i = 0; i < 2; ++i) { int R, C; stage_rc(tid * 16 + i * 8192, R, C); const int Rb = Epi::PERM ? ((R & ~31) + perm32(R & 31)) : R;
        RA[i] = R; CA[i] = C; voffA[i] = (unsigned)(R * K + C) * 2u; voffB[i] = (unsigned)(Rb * K + C) * 2u; }
    const size_t kstep = (size_t)(BK * 2);
    const size_t hstep = (size_t)HALF * K * 2;
    const unsigned ldsw = (unsigned)wid * 1024u;
    const int aoff = lds_byte(wr * 64 + fr, fq * 8), boff = lds_byte(wc * 32 + fr, fq * 8);
#define PG8_SA(b, h) (((b) * 2 + (h)) * HTB)
#define PG8_SB(b, h) ((4 + (b) * 2 + (h)) * HTB)
#define PG8_STAGE(bufoff, gbase, voff) do { _Pragma("unroll") for (int _i = 0; _i < 2; ++_i) \
        __builtin_amdgcn_global_load_lds((const unsigned*)((const char*)(gbase) + (voff)[_i]), (LAS unsigned*)(lds + (bufoff) + ldsw + _i * 8192), 16, 0, 0); } while (0)
#define PG8_STAGE_A(bufoff, h, usenext, koff) do { if constexpr (GATHER) { unsigned _vo[2]; _vo[0] = (usenext) ? nvA[h][0] : vA[h][0]; _vo[1] = (usenext) ? nvA[h][1] : vA[h][1]; PG8_STAGE(bufoff, S.A + (koff), _vo); } \
        else { PG8_STAGE(bufoff, ((usenext) ? nA : cA) + (size_t)(h) * hstep + (koff), voffA); } } while (0)
#define PG8_LDA(dst, b, h) do { _Pragma("unroll") for (int m = 0; m < 4; ++m) _Pragma("unroll") for (int k = 0; k < 2; ++k) dst[m][k] = *(const LAS bf16x8*)(lds + PG8_SA(b, h) + aoff + m * 2048 + k * 1024); } while (0)
#define PG8_LDB(dst, b, h) do { _Pragma("unroll") for (int n = 0; n < 2; ++n) _Pragma("unroll") for (int k = 0; k < 2; ++k) dst[n][k] = *(const LAS bf16x8*)(lds + PG8_SB(b, h) + boff + n * 2048 + k * 1024); } while (0)
#define PG8_MMA(ai, bj, At, Bt) do { __builtin_amdgcn_s_setprio(1); _Pragma("unroll") for (int m = 0; m < 4; ++m) _Pragma("unroll") for (int n = 0; n < 2; ++n) _Pragma("unroll") for (int k = 0; k < 2; ++k) \
        acc[ai][bj][m][n] = __builtin_amdgcn_mfma_f32_16x16x32_bf16(Bt[n][k], At[m][k], acc[ai][bj][m][n], 0, 0, 0); __builtin_amdgcn_s_setprio(0); } while (0)
#define PG8_WAIT_V(n) asm volatile("s_waitcnt vmcnt(" #n ")" ::: "memory")
#define PG8_WAIT_L(n) asm volatile("s_waitcnt lgkmcnt(" #n ")" ::: "memory")
#define PG8_BAR __builtin_amdgcn_s_barrier()
#define PG8_SCHED __builtin_amdgcn_sched_barrier(0)
    Unit cur, nxt; int ui = 0;
    if (!S.next(0, cur)) return;
    f32x4 acc[2][2][4][2];
#pragma unroll
    for (int a = 0; a < 2; ++a)
#pragma unroll
        for (int b = 0; b < 2; ++b)
#pragma unroll
            for (int m = 0; m < 4; ++m)
#pragma unroll
                for (int n = 0; n < 2; ++n) acc[a][b][m][n] = (f32x4){0.f, 0.f, 0.f, 0.f};
    bf16x8 At[4][2], B0[2][2], B1[2][2];
    unsigned vA[2][2], nvA[2][2];
    if constexpr (GATHER) {
#pragma unroll
        for (int h = 0; h < 2; ++h)
#pragma unroll
            for (int i = 0; i < 2; ++i) { vA[h][i] = (unsigned)(S.tok(cur, h * HALF + RA[i]) * K + CA[i]) * 2u; nvA[h][i] = vA[h][i]; }
    }
    const char* cA = S.a_ptr(cur); const char* cB = S.b_ptr(cur); const char* nA = cA;
    PG8_STAGE(PG8_SB(0, 0), cB, voffB); PG8_STAGE(PG8_SB(0, 1), cB + hstep, voffB); PG8_STAGE_A(PG8_SA(0, 0), 0, false, 0); PG8_STAGE_A(PG8_SA(0, 1), 1, false, 0);
    if (wr == 1) PG8_BAR;
    PG8_WAIT_V(2); PG8_BAR;
    PG8_STAGE(PG8_SB(1, 0), cB + kstep, voffB); PG8_STAGE_A(PG8_SA(1, 0), 0, false, kstep); PG8_STAGE(PG8_SB(1, 1), cB + hstep + kstep, voffB);
    PG8_WAIT_V(6); PG8_BAR;
    for (;;) {
        const bool has_next = S.next(ui + 1, nxt);
        nA = has_next ? S.a_ptr(nxt) : cA; const char* nB = has_next ? S.b_ptr(nxt) : cB;
        if constexpr (GATHER) {
            if (has_next) {
#pragma unroll
                for (int h = 0; h < 2; ++h)
#pragma unroll
                    for (int i = 0; i < 2; ++i) nvA[h][i] = (unsigned)(S.tok(nxt, h * HALF + RA[i]) * K + CA[i]) * 2u;
            }
        }
        const bool full = (cur.nai == 2);
        for (int t = 0; t < nt; t += 2) {
            const bool last = (t == nt - 2);
            const size_t k1 = (size_t)(t + 1) * kstep;
            const size_t k2 = last ? 0 : (size_t)(t + 2) * kstep, k3 = k2 + kstep;
            const char* b2 = last ? nB : cB + (size_t)(t + 2) * kstep; const char* b3 = b2 + kstep;
            PG8_LDB(B0, 0, 0); PG8_LDB(B1, 0, 1); PG8_SCHED; PG8_LDA(At, 0, 0); PG8_STAGE_A(PG8_SA(1, 1), 1, false, k1);
            PG8_WAIT_V(8); PG8_WAIT_L(0); PG8_BAR; PG8_MMA(0, 0, At, B0); PG8_MMA(0, 1, At, B1); PG8_BAR; PG8_SCHED;
            if (full) PG8_LDA(At, 0, 1); PG8_STAGE(PG8_SB(0, 0), b2, voffB); PG8_STAGE(PG8_SB(0, 1), b2 + hstep, voffB); PG8_STAGE_A(PG8_SA(0, 0), 0, last, k2);
            PG8_WAIT_V(8); PG8_WAIT_L(0); PG8_BAR; if (full) { PG8_MMA(1, 0, At, B0); PG8_MMA(1, 1, At, B1); } PG8_BAR; PG8_SCHED;
            PG8_LDB(B0, 1, 0); PG8_LDB(B1, 1, 1); PG8_SCHED; PG8_LDA(At, 1, 0); PG8_STAGE_A(PG8_SA(0, 1), 1, last, k2);
            PG8_WAIT_V(8); PG8_WAIT_L(0); PG8_BAR; PG8_MMA(0, 0, At, B0); PG8_MMA(0, 1, At, B1); PG8_BAR; PG8_SCHED;
            if (full) PG8_LDA(At, 1, 1); PG8_STAGE(PG8_SB(1, 0), b3, voffB); PG8_STAGE(PG8_SB(1, 1), b3 + hstep, voffB); PG8_STAGE_A(PG8_SA(1, 0), 0, last, k3);
            PG8_WAIT_V(8); PG8_WAIT_L(0); PG8_BAR; if (full) { PG8_MMA(1, 0, At, B0); PG8_MMA(1, 1, At, B1); } PG8_BAR; PG8_SCHED;
        }
        if (wr == 0) PG8_BAR;
        E(acc, cur, wr, wc, fr, fq);
        if (!has_next) break;
#pragma unroll
        for (int a = 0; a < 2; ++a)
#pragma unroll
            for (int b = 0; b < 2; ++b)
#pragma unroll
                for (int m = 0; m < 4; ++m)
#pragma unroll
                    for (int n = 0; n < 2; ++n) acc[a][b][m][n] = (f32x4){0.f, 0.f, 0.f, 0.f};
        cur = nxt; cA = nA; cB = nB; ++ui;
        if constexpr (GATHER) {
#pragma unroll
            for (int h = 0; h < 2; ++h)
#pragma unroll
                for (int i = 0; i < 2; ++i) vA[h][i] = nvA[h][i];
        }
        if (wr == 1) PG8_BAR;
    }
    PG8_WAIT_V(0);
    PG8_BAR;
#undef PG8_SA
#undef PG8_SB
#undef PG8_STAGE
#undef PG8_STAGE_A
#undef PG8_LDA
#undef PG8_LDB
#undef PG8_MMA
#undef PG8_WAIT_V
#undef PG8_WAIT_L
#undef PG8_BAR
#undef PG8_SCHED
}
}

namespace pg8 {
__device__ __forceinline__ void row_bt(int row, int& b, int& tok) { if (row < TX) { b = row >> 11; tok = row & 2047; } else { const int r = row - TX; b = r >> 8; tok = SEQ + (r & 255); } }

struct EpiAttnIn {
    static constexpr bool PERM = true;
    bf16* QKV; bf16* VAT; bf16* VBT; const LAS float* rope;
    __device__ __forceinline__ void operator()(const f32x4 (&acc)[2][2][4][2], const Unit& u, int wr, int wc, int fr, int fq) const {
        const int row0 = u.pm * BM + u.roff + wr * 64 + fr; const int seg = u.pn >> 1;
        const bool latent = u.pm < (TX / BM);
        if (seg == 2 || seg == 5) {
#pragma unroll
            for (int ai = 0; ai < 2; ++ai) if (ai < u.nai)
#pragma unroll
                for (int m = 0; m < 4; ++m) { const int row = row0 + ai * HALF + m * 16; int b, tok; row_bt(row, b, tok);
#pragma unroll
                    for (int bj = 0; bj < 2; ++bj) { const int col = u.pn * BM + bj * HALF + wc * 32 + 8 * fq;
                        bf16* dst;
                        if (seg == 2) { const int cs = col - 1024; dst = VAT + ((size_t)(b * 4 + (cs >> 7)) * 128 + (cs & 127)) * NKEY + tok; }
                        else { const int cs = col - 2560; dst = VBT + ((size_t)(b * 8 + (cs >> 6)) * 64 + (cs & 63)) * NKEY + tok; }
#pragma unroll
                        for (int n = 0; n < 2; ++n)
#pragma unroll
                            for (int i = 0; i < 4; ++i) dst[(size_t)(4 * n + i) * NKEY] = (bf16)f2bf(acc[ai][bj][m][n][i]); } }
            return;
        }
        const bool dorope = latent && seg < 2;
        const float qs = (seg == 0 || seg == 3) ? 0.125f * LOG2E : 1.0f;
#pragma unroll
        for (int ai = 0; ai < 2; ++ai) if (ai < u.nai)
#pragma unroll
            for (int m = 0; m < 4; ++m) { const int row = row0 + ai * HALF + m * 16;
                f32x4 cs4[4];
                if (dorope) { const int t = row & 2047; const int pos = (wc & 1) ? (t & 63) : (t >> 6);
                    const LAS f32x4* rp = (const LAS f32x4*)(rope + (pos * 16 + 8 * (fq & 1)) * 2);
#pragma unroll
                    for (int j = 0; j < 4; ++j) cs4[j] = rp[j]; }
#pragma unroll
                for (int bj = 0; bj < 2; ++bj) { const int col = u.pn * BM + bj * HALF + wc * 32 + 8 * fq;
                    float v[8];
#pragma unroll
                    for (int n = 0; n < 2; ++n)
#pragma unroll
                        for (int i = 0; i < 4; ++i) v[4 * n + i] = acc[ai][bj][m][n][i];
                    if (dorope) {
#pragma unroll
                        for (int j = 0; j < 8; ++j) { const float other = __shfl_xor(v[j], 32); const float c = cs4[j >> 1][(j & 1) * 2], s = cs4[j >> 1][(j & 1) * 2 + 1];
                            v[j] = (fq < 2) ? (v[j] * c - other * s) : (v[j] * c + other * s); } }
                    u32x4 w; w.x = pk2(v[0] * qs, v[1] * qs); w.y = pk2(v[2] * qs, v[3] * qs); w.z = pk2(v[4] * qs, v[5] * qs); w.w = pk2(v[6] * qs, v[7] * qs);
                    *(u32x4*)(QKV + (size_t)row * NATT + col) = w; } }
    }
};
struct EpiGlaIn {
    static constexpr bool PERM = true;
    bf16* QKV2; bf16* VGT;
    __device__ __forceinline__ void operator()(const f32x4 (&acc)[2][2][4][2], const Unit& u, int wr, int wc, int fr, int fq) const {
        const int row0 = u.pm * BM + u.roff + wr * 64 + fr;
        if (u.pn >= 4 && u.pn < 8) {
#pragma unroll
            for (int ai = 0; ai < 2; ++ai) if (ai < u.nai)
#pragma unroll
                for (int m = 0; m < 4; ++m) { const int row = row0 + ai * HALF + m * 16; int b, tok; row_bt(row, b, tok);
#pragma unroll
                    for (int bj = 0; bj < 2; ++bj) { const int cs = u.pn * BM + bj * HALF + wc * 32 + 8 * fq - 1024;
                        bf16* dst = VGT + ((size_t)(b * 4 + (cs >> 8)) * 256 + (cs & 255)) * NKEY + tok;
#pragma unroll
                        for (int n = 0; n < 2; ++n)
#pragma unroll
                            for (int i = 0; i < 4; ++i) dst[(size_t)(4 * n + i) * NKEY] = (bf16)f2bf(acc[ai][bj][m][n][i]); } }
            return;
        }
        const float qs = (u.pn < 2) ? 0.08838834764831845f : 1.0f;
#pragma unroll
        for (int ai = 0; ai < 2; ++ai) if (ai < u.nai)
#pragma unroll
            for (int m = 0; m < 4; ++m) { const int row = row0 + ai * HALF + m * 16;
#pragma unroll
                for (int bj = 0; bj < 2; ++bj) { const int col = u.pn * BM + bj * HALF + wc * 32 + 8 * fq; const f32x4 a = acc[ai][bj][m][0] * qs, c = acc[ai][bj][m][1] * qs;
                    u32x4 w; w.x = pk2(a[0], a[1]); w.y = pk2(a[2], a[3]); w.z = pk2(c[0], c[1]); w.w = pk2(c[2], c[3]);
                    *(u32x4*)(QKV2 + (size_t)row * NGLA + col) = w; } }
    }
};
template <bool F32IN>
struct EpiResid {
    static constexpr bool PERM = true;
    const float* IL; const float* IC; bf16* XB; const float* modv;
    __device__ __forceinline__ void operator()(const f32x4 (&acc)[2][2][4][2], const Unit& u, int wr, int wc, int fr, int fq) const {
        const int row0 = u.pm * BM + u.roff + wr * 64 + fr, col0 = u.pn * BM + wc * 32 + 8 * fq;
        const bool latent = u.pm < (TX / BM); const int bi = latent ? (u.pm >> 3) : 8;
        const float* ibase = latent ? IL : (IC - (size_t)TX * D);
        f32x4 gv[2][2];
#pragma unroll
        for (int bj = 0; bj < 2; ++bj)
#pragma unroll
            for (int n = 0; n < 2; ++n) gv[bj][n] = *(const f32x4*)(modv + bi * 6144 + col0 + bj * HALF + 4 * n);
#pragma unroll
        for (int ai = 0; ai < 2; ++ai) if (ai < u.nai) {
            f32x4 res[4][2][2];
#pragma unroll
            for (int m = 0; m < 4; ++m) { const size_t ro = (size_t)(row0 + ai * HALF + m * 16) * D + col0;
#pragma unroll
                for (int bj = 0; bj < 2; ++bj) {
                    if constexpr (F32IN) { res[m][bj][0] = *(const f32x4*)(ibase + ro + bj * HALF); res[m][bj][1] = *(const f32x4*)(ibase + ro + bj * HALF + 4); }
                    else { const u32x4 t = *(const u32x4*)(XB + ro + bj * HALF); res[m][bj][0] = (f32x4){bflo(t.x), bfhi(t.x), bflo(t.y), bfhi(t.y)}; res[m][bj][1] = (f32x4){bflo(t.z), bfhi(t.z), bflo(t.w), bfhi(t.w)}; } } }
#pragma unroll
            for (int m = 0; m < 4; ++m) { const size_t ro = (size_t)(row0 + ai * HALF + m * 16) * D + col0;
#pragma unroll
                for (int bj = 0; bj < 2; ++bj) { const f32x4 y0 = res[m][bj][0] + gv[bj][0] * acc[ai][bj][m][0], y1 = res[m][bj][1] + gv[bj][1] * acc[ai][bj][m][1];
                    u32x4 w; w.x = pk2(y0[0], y0[1]); w.y = pk2(y0[2], y0[3]); w.z = pk2(y1[0], y1[1]); w.w = pk2(y1[2], y1[3]);
                    *(u32x4*)(XB + ro + bj * HALF) = w; } }
        }
    }
};
struct EpiMoe1 {
    static constexpr bool PERM = false;
    bf16* HB;
    __device__ __forceinline__ void operator()(const f32x4 (&acc)[2][2][4][2], const Unit& u, int wr, int wc, int fr, int fq) const {
        const int row0 = u.pm * BM + u.roff + wr * 64 + fr, col0 = u.pn * 128 + wc * 16 + 4 * fq;
#pragma unroll
        for (int ai = 0; ai < 2; ++ai) if (ai < u.nai)
#pragma unroll
            for (int m = 0; m < 4; ++m) { bf16* rowp = HB + (size_t)(row0 + ai * HALF + m * 16) * DEXP + col0;
#pragma unroll
                for (int bj = 0; bj < 2; ++bj) { const f32x4 a = acc[ai][bj][m][0], b = acc[ai][bj][m][1];
                    u32x2 w; w.x = pk2(silu_f(a[0]) * b[0], silu_f(a[1]) * b[1]); w.y = pk2(silu_f(a[2]) * b[2], silu_f(a[3]) * b[3]);
                    *(u32x2*)(rowp + bj * 64) = w; } }
    }
};
struct EpiBf16 {
    static constexpr bool PERM = true;
    bf16* O; int ldc;
    __device__ __forceinline__ void operator()(const f32x4 (&acc)[2][2][4][2], const Unit& u, int wr, int wc, int fr, int fq) const {
        const int row0 = u.pm * BM + u.roff + wr * 64 + fr, col0 = u.pn * BM + wc * 32 + 8 * fq;
#pragma unroll
        for (int ai = 0; ai < 2; ++ai) if (ai < u.nai)
#pragma unroll
            for (int m = 0; m < 4; ++m) { bf16* rowp = O + (size_t)(row0 + ai * HALF + m * 16) * ldc + col0;
#pragma unroll
                for (int bj = 0; bj < 2; ++bj) { const f32x4 a = acc[ai][bj][m][0], c = acc[ai][bj][m][1];
                    u32x4 w; w.x = pk2(a[0], a[1]); w.y = pk2(a[2], a[3]); w.z = pk2(c[0], c[1]); w.w = pk2(c[2], c[3]);
                    *(u32x4*)(rowp + bj * HALF) = w; } }
    }
};
}

struct Args {
    const float *x, *c, *ctx, *c_ctx, *w_mod, *b_mod, *norm_g, *final_g, *att_w_in, *att_w_out, *att_lambda, *att_subln_g, *na_bias,
                *gla_w_in, *gla_w_gate, *gla_b_gate, *gla_norm_g, *gla_w_out, *router_w, *router_bias, *moe_w1, *moe_w3, *moe_w2;
    float* out; unsigned char* ws; int ph_lo, ph_hi, rep, pad;
};

struct RowMapId { int off; __device__ __forceinline__ int operator()(int n) const { return off + n; } };
struct RowMapMoe { int which; __device__ __forceinline__ int operator()(int n) const { return 32 * (n >> 4) + 16 * which + (n & 15); } };
__device__ __forceinline__ void ti_load(float (&ld)[32], const float* W, int N, int item, int lane) {
    const int nblk = N / 32, kb = item / nblk, nb = item % nblk, k0 = 64 * kb, n0 = 32 * nb;
#pragma unroll
    for (int i = 0; i < 32; ++i) ld[i] = W[(size_t)(k0 + 2 * i + (lane >> 5)) * N + n0 + (lane & 31)];
}
template <class RM>
__device__ __forceinline__ void ti_finish(const float (&ld)[32], int K, int N, bf16* WT, LAS float* scr, int item, int lane, RM rm) {
    const int nblk = N / 32, kb = item / nblk, nb = item % nblk, k0 = 64 * kb, n0 = 32 * nb;
#pragma unroll
    for (int i = 0; i < 32; ++i) scr[(2 * i + (lane >> 5)) * 33 + (lane & 31)] = ld[i];
    LDS_WAIT(); asm volatile("" ::: "memory");
    const int c = lane & 7;
#pragma unroll
    for (int j = 0; j < 4; ++j) { const int n = (lane >> 3) + 8 * j; const LAS float* s = scr + (8 * c) * 33 + n;
        u32x4 o; o.x = pk2(s[0 * 33], s[1 * 33]); o.y = pk2(s[2 * 33], s[3 * 33]); o.z = pk2(s[4 * 33], s[5 * 33]); o.w = pk2(s[6 * 33], s[7 * 33]);
        *(u32x4*)(WT + (size_t)rm(n0 + n) * K + k0 + 8 * c) = o; }
    LDS_WAIT(); asm volatile("" ::: "memory");
}
template <class RM>
__device__ __forceinline__ void p0_transpose_item(const float* W, int K, int N, bf16* WT, LAS float* scr, int item, int lane, RM rm) {
    float ld[32]; ti_load(ld, W, N, item, lane); ti_finish(ld, K, N, WT, scr, item, lane, rm);
}

constexpr int CV_ATTIN = 1536, CV_ATTOUT = 512, CV_GLAIN = 1552, CV_GLAPAD = 28, CV_GLAOUT = 512, CV_W = 4096, CV_MOE = 3 * CV_W;
constexpr int CT_ATTN0 = CV_ATTIN + CV_ATTOUT, CT_MOE0 = CT_ATTN0 + CV_MOE, CT_GLA0 = CT_MOE0 + CV_GLAIN + CV_GLAPAD + CV_GLAOUT, CT_ATTN1 = CT_GLA0 + CV_ATTIN + CV_ATTOUT, CT_MOE1 = CT_ATTN1 + CV_MOE,
              CT_MOE2 = CT_MOE1 + CV_MOE, CT_GLA1 = CT_MOE2 + CV_GLAIN + CV_GLAPAD + CV_GLAOUT, CT_MOE3 = CT_GLA1 + CV_MOE, CV_TOTAL = CT_MOE3;
constexpr int CV_UNIT = 32;
struct ConvPtrs { const float *att_w_in, *att_w_out, *gla_w_in, *gla_w_out, *moe_w1, *moe_w3, *moe_w2; unsigned char* ws; };
struct RowMapAny { int moe, which; __device__ __forceinline__ int operator()(int n) const { return moe ? 32 * (n >> 4) + 16 * which + (n & 15) : n; } };
struct ConvDesc { const float* W; bf16* WT; int K, N, sub, kind  ; RowMapAny rm; };
__device__ __forceinline__ ConvDesc conv_decode(const ConvPtrs& P, int it, int hi) {
    ConvDesc d; d.W = nullptr; d.WT = nullptr; d.K = D; d.N = D; d.sub = 0; d.kind = 0; d.rm = RowMapAny{0, 0};
    if (it >= hi) return d;
    int kind, j, r;
    if (it < CT_ATTN0) { kind = 0; j = 0; r = it; } else if (it < CT_MOE0) { kind = 2; j = 0; r = it - CT_ATTN0; } else if (it < CT_GLA0) { kind = 1; j = 0; r = it - CT_MOE0; }
    else if (it < CT_ATTN1) { kind = 0; j = 1; r = it - CT_GLA0; } else if (it < CT_MOE1) { kind = 2; j = 1; r = it - CT_ATTN1; } else if (it < CT_MOE2) { kind = 2; j = 2; r = it - CT_MOE1; }
    else if (it < CT_GLA1) { kind = 1; j = 1; r = it - CT_MOE2; } else { kind = 2; j = 3; r = it - CT_GLA1; }
    d.kind = 1; d.sub = r;
    if (kind == 2) {
        const int which = r / CV_W, q = r % CV_W, e = q >> 8, je = j * 16 + e; d.sub = q & 255;
        if (which < 2) { d.W = (which ? P.moe_w3 : P.moe_w1) + (size_t)je * D * DEXP; d.N = DEXP; d.WT = (bf16*)(P.ws + WS_W13) + (size_t)je * D * D; d.rm.moe = 1; d.rm.which = which; }
        else { d.W = P.moe_w2 + (size_t)je * DEXP * D; d.K = DEXP; d.WT = (bf16*)(P.ws + WS_W2) + (size_t)je * D * DEXP; }
    } else if (kind == 0) {
        if (r < CV_ATTIN) { d.W = P.att_w_in + (size_t)j * D * NATT; d.N = NATT; d.WT = (bf16*)(P.ws + WS_WATTIN) + (size_t)j * NATT * D; }
        else { d.W = P.att_w_out + (size_t)j * D * D; d.WT = (bf16*)(P.ws + WS_WATTOUT) + (size_t)j * D * D; d.sub = r - CV_ATTIN; }
    } else {
        if (r < CV_GLAIN) { d.W = P.gla_w_in + (size_t)j * D * 3104; d.N = 3104; d.WT = (bf16*)(P.ws + WS_WGLAIN) + (size_t)j * NGLA * D; }
        else if (r < CV_GLAIN + CV_GLAPAD) { d.kind = 2; d.sub = (r - CV_GLAIN) * 1024; d.WT = (bf16*)(P.ws + WS_WGLAIN) + (size_t)j * NGLA * D + (size_t)3104 * D; }
        else { d.W = P.gla_w_out + (size_t)j * D * D; d.WT = (bf16*)(P.ws + WS_WGLAOUT) + (size_t)j * D * D; d.sub = r - CV_GLAIN - CV_GLAPAD; }
    }
    return d;
}
__device__ __forceinline__ void conv_load(const ConvDesc& d, float (&ld)[32], int lane) { if (d.kind == 1) ti_load(ld, d.W, d.N, d.sub, lane); }
__device__ __forceinline__ void conv_finish(const ConvDesc& d, const float (&ld)[32], LAS float* scr, int lane) {
    if (d.kind == 1) ti_finish(ld, d.K, d.N, d.WT, scr, d.sub, lane, d.rm);
    else if (d.kind == 2) { for (int i = lane; i < 1024; i += 64) *(u32x4*)(d.WT + (size_t)(d.sub + i) * 8) = (u32x4){0u, 0u, 0u, 0u}; }
}
__device__ __forceinline__ void conv_item(const ConvPtrs& P, int it, LAS float* scr, int lane) {
    const ConvDesc d = conv_decode(P, it, it + 1); float ld[32]; conv_load(d, ld, lane); conv_finish(d, ld, scr, lane);
}
__device__ __forceinline__ void conv_static(const ConvPtrs& P, int cur, int need, LAS unsigned char* lds, int lane, int wave, int vcu, int G) {
    LAS float* scr = (LAS float*)(lds + wave * 8448);
    for (int it = cur + vcu * 8 + wave; it < need; it += G * 8) conv_item(P, it, scr, lane);
}
__device__ __forceinline__ void conv_unit(const ConvPtrs& P, int i0, int hi, LAS unsigned char* lds, int lane, int wave) {
    LAS float* scr = (LAS float*)(lds + wave * 8448);
    constexpr int NPW = CV_UNIT / 8; static_assert(NPW == 4, "four items per wave");
    const int it0 = i0 + wave * NPW;
    float la[32], lb[32];
    ConvDesc dA = conv_decode(P, it0, hi); conv_load(dA, la, lane);
    ConvDesc dB = conv_decode(P, it0 + 1, hi); conv_load(dB, lb, lane);
    conv_finish(dA, la, scr, lane);
    dA = conv_decode(P, it0 + 2, hi); conv_load(dA, la, lane);
    conv_finish(dB, lb, scr, lane);
    dB = conv_decode(P, it0 + 3, hi); conv_load(dB, lb, lane);
    conv_finish(dA, la, scr, lane);
    conv_finish(dB, lb, scr, lane);
}

template <class AP> __device__ __forceinline__ void p0_prologue(const AP ap, LAS unsigned char* lds, int tid, int lane, int wave, int vcu, int G) {
    unsigned char* ws = ap->ws;
    LAS float* S9 = (LAS float*)(lds + 69632);
    LAS float* red = (LAS float*)(lds + 106496);
    { const ConvPtrs P{ap->att_w_in, ap->att_w_out, ap->gla_w_in, ap->gla_w_out, ap->moe_w1, ap->moe_w3, ap->moe_w2, ws};
      conv_static(P, 0, MK_CONVQ ? CT_ATTN0 : CV_TOTAL, lds, lane, wave, vcu, G); }
    __syncthreads();
    { const float* cc = ap->c; const float* cx = ap->c_ctx;
      for (int i = tid; i < 9 * 1024; i += 512) { const int bi = i >> 10, k = i & 1023; const float v = (bi < 8) ? cc[bi * D + k] : cx[k]; S9[i] = v / (1.0f + __expf(-v)); } }
    __syncthreads();
    const float* w_mod = ap->w_mod; const float* b_mod = ap->b_mod;
    for (int u = vcu; u < 4 * 192; u += G) {
        const int L = u / 192, n0 = (u % 192) * 32;
        const float* W = w_mod + (size_t)L * D * 6144 + n0 + 4 * (lane & 7);
        f32x4 acc[9];
#pragma unroll
        for (int bi = 0; bi < 9; ++bi) acc[bi] = (f32x4){0.f, 0.f, 0.f, 0.f};
        const int kb = wave * 128 + (lane >> 3);
        f32x4 wv[16];
#pragma unroll
        for (int i = 0; i < 16; ++i) wv[i] = *(const f32x4*)(W + (size_t)(kb + 8 * i) * 6144);
#pragma unroll
        for (int i = 0; i < 16; ++i)
#pragma unroll
            for (int bi = 0; bi < 9; ++bi) { const float sv = S9[bi * 1024 + kb + 8 * i]; acc[bi] = __builtin_elementwise_fma(wv[i], (f32x4){sv, sv, sv, sv}, acc[bi]); }
#pragma unroll
        for (int bi = 0; bi < 9; ++bi) { f32x4 t;
#pragma unroll
            for (int j = 0; j < 4; ++j) { float v = acc[bi][j]; v += dppf<0x128>(v); v = swap16_add(v, v); t[j] = swap32_add(v, v); }
            if (lane < 8) *(LAS f32x4*)(red + (wave * 9 + bi) * 32 + 4 * lane) = t; }
        __syncthreads();
        if (tid < 9 * 32) { const int bi = tid >> 5, l = tid & 31; float sm = b_mod[L * 6144 + n0 + l];
#pragma unroll
            for (int w = 0; w < 8; ++w) sm += red[(w * 9 + bi) * 32 + l];
            ((float*)(ws + WS_MODV))[(size_t)(L * 9 + bi) * 6144 + n0 + l] = sm; }
        __syncthreads();
    }
}

__device__ __forceinline__ float* xrow_ptr(float* XL, float* XC, int row) { return row < TX ? XL + (size_t)row * D : XC + (size_t)(row - TX) * D; }
__device__ __forceinline__ int row_bi(int row) { return row < TX ? (row >> 11) : 8; }

__device__ __forceinline__ void norm_mod_store(const f32x4 (&v)[4], const float* g, const float* sh, const float* sc, bf16* orow, int lane) {
    float ss = 0.f;
#pragma unroll
    for (int j = 0; j < 4; ++j) ss += (v[j].x * v[j].x + v[j].y * v[j].y) + (v[j].z * v[j].z + v[j].w * v[j].w);
    const float rs = __builtin_amdgcn_rsqf(wave_sum(ss) * (1.0f / D) + EPSF);
#pragma unroll
    for (int j = 0; j < 4; ++j) { const int c = 4 * lane + 256 * j; const f32x4 gg = *(const f32x4*)(g + c), s1 = *(const f32x4*)(sc + c), s0 = *(const f32x4*)(sh + c);
        const f32x4 y = (v[j] * rs) * gg * (1.0f + s1) + s0;
        u32x2 w; w.x = pk2(y.x, y.y); w.y = pk2(y.z, y.w); *(u32x2*)(orow + c) = w; }
}

constexpr int TROWS = 9;
__device__ __forceinline__ int thin_row(int vcu, int wave, int i) { return vcu * 8 + wave + 2048 * i; }

struct N1Row { f32x4 x[4], s0[4], s1[4]; };
__device__ __forceinline__ void n1_issue(N1Row& r, const float* XL, const float* XC, const float* modv, int row, int lane) {
    const f32x4* xr = (const f32x4*)(row < TX ? XL + (size_t)row * D : XC + (size_t)(row - TX) * D) + lane; const float* mv = modv + row_bi(row) * 6144;
#pragma unroll
    for (int j = 0; j < 4; ++j) { r.x[j] = xr[64 * j]; r.s0[j] = *(const f32x4*)(mv + 4 * lane + 256 * j); r.s1[j] = *(const f32x4*)(mv + 1024 + 4 * lane + 256 * j); }
}
__device__ __forceinline__ void n1_finish(const N1Row& r, const f32x4 (&gg)[4], bf16* orow, int lane) {
    float ss = 0.f;
#pragma unroll
    for (int j = 0; j < 4; ++j) ss += (r.x[j].x * r.x[j].x + r.x[j].y * r.x[j].y) + (r.x[j].z * r.x[j].z + r.x[j].w * r.x[j].w);
    const float rs = __builtin_amdgcn_rsqf(wave_sum(ss) * (1.0f / D) + EPSF);
#pragma unroll
    for (int j = 0; j < 4; ++j) { const f32x4 y = (r.x[j] * rs) * gg[j] * (1.0f + r.s1[j]) + r.s0[j];
        u32x2 w; w.x = pk2(y.x, y.y); w.y = pk2(y.z, y.w); *(u32x2*)(orow + 4 * lane + 256 * j) = w; }
}
__device__ __forceinline__ void phase_norm1(const float* XL, const float* XC, const float* g, const float* modv, bf16* H, int nrows, int lane, int wave, int vcu, int G) {
    f32x4 gg[4];
#pragma unroll
    for (int j = 0; j < 4; ++j) gg[j] = *(const f32x4*)(g + 4 * lane + 256 * j);
    N1Row ra, rb;
    n1_issue(ra, XL, XC, modv, thin_row(vcu, wave, 0), lane);
#pragma unroll
    for (int i = 0; i < TROWS; ++i) {
        const int row = thin_row(vcu, wave, i), rown = thin_row(vcu, wave, i + 1);
        if (i + 1 < TROWS) n1_issue((i & 1) ? ra : rb, XL, XC, modv, rown < nrows ? rown : row, lane);
        if (row < nrows) n1_finish((i & 1) ? rb : ra, gg, H + (size_t)row * D, lane);
    }
}

__device__ __forceinline__ void phase_router(const bf16* XB, const float* g, const float* modv, bf16* H, const float* router_w, const float* router_bias,
                                             unsigned* cnt  , int* list, int* toki, float* tokw, int nrows,
                                             LAS unsigned char* lds, int tid, int lane, int wave, int vcu, int G, int probe) {
    LAS float* RW = (LAS float*)lds;
    LAS int* lcnt = (LAS int*)(lds + 65536);
    LAS int* rinfo = (LAS int*)(lds + 65536 + 256);
    const int rpb = nrows / G, rpw = rpb / 8;
    const int gI = lane >> 4;
    const f32x4 rb = *(const f32x4*)(router_bias + 4 * gI);
    f32x4 gg[4];
#pragma unroll
    for (int j = 0; j < 4; ++j) gg[j] = *(const f32x4*)(g + 4 * lane + 256 * j);
    const int rowbase = vcu * rpb + wave * rpw;
    u32x2 xa[3][4], xb[3][4];
#pragma unroll
    for (int r = 0; r < 3; ++r) { const bf16* xr = XB + (size_t)(rowbase + (r < rpw ? r : rpw - 1)) * D + 4 * lane;
#pragma unroll
        for (int j = 0; j < 4; ++j) xa[r][j] = *(const u32x2*)(xr + 256 * j); }
    for (int it = 0; it < 8; ++it) { const int idx = tid + 512 * it, k = idx >> 2, q = idx & 3; const f32x4 w = *(const f32x4*)(router_w + k * 16 + 4 * q);
        RW[(4 * q + 0) * 1024 + k] = w.x; RW[(4 * q + 1) * 1024 + k] = w.y; RW[(4 * q + 2) * 1024 + k] = w.z; RW[(4 * q + 3) * 1024 + k] = w.w; }
    if (tid < 32) lcnt[tid] = 0;
    __syncthreads();
#pragma unroll
    for (int bt = 0; bt < 3; ++bt) {
        const int i0 = 3 * bt;
        asm volatile("" ::: "memory");
        u32x2 (&xc)[3][4] = (bt & 1) ? xb : xa; u32x2 (&xn)[3][4] = (bt & 1) ? xa : xb; f32x4 y[3][4];
        f32x4 s0v[3][4], s1v[3][4];
#pragma unroll
        for (int r = 0; r < 3; ++r) { const int ii = (i0 + r < rpw) ? i0 + r : rpw - 1; const float* mv = modv + row_bi(rowbase + ii) * 6144 + 3072;
#pragma unroll
            for (int j = 0; j < 4; ++j) { const int c = 4 * lane + 256 * j; s0v[r][j] = *(const f32x4*)(mv + c); s1v[r][j] = *(const f32x4*)(mv + 1024 + c); } }
        if (bt + 1 < 3) {
#pragma unroll
            for (int r = 0; r < 3; ++r) { const int ii = (i0 + 3 + r < rpw) ? i0 + 3 + r : rpw - 1; const bf16* xr = XB + (size_t)(rowbase + ii) * D + 4 * lane;
#pragma unroll
                for (int j = 0; j < 4; ++j) xn[r][j] = *(const u32x2*)(xr + 256 * j); } }
#pragma unroll
        for (int r = 0; r < 3; ++r) {
            const int ii = (i0 + r < rpw) ? i0 + r : rpw - 1; const int row = rowbase + ii;
            float ss = 0.f;
#pragma unroll
            for (int j = 0; j < 4; ++j) { const u32x2 t = xc[r][j]; y[r][j] = (f32x4){bflo(t.x), bfhi(t.x), bflo(t.y), bfhi(t.y)};
                ss += (y[r][j].x * y[r][j].x + y[r][j].y * y[r][j].y) + (y[r][j].z * y[r][j].z + y[r][j].w * y[r][j].w); }
            const float rs = __builtin_amdgcn_rsqf(wave_sum(ss) * (1.0f / D) + EPSF);
#pragma unroll
            for (int j = 0; j < 4; ++j) { const int c = 4 * lane + 256 * j;
                y[r][j] = (y[r][j] * rs) * gg[j] * (1.0f + s1v[r][j]) + s0v[r][j];
                u32x2 w; w.x = cvtpk(y[r][j].x, y[r][j].y); w.y = cvtpk(y[r][j].z, y[r][j].w); *(u32x2*)(H + (size_t)row * D + c) = w; }
        }
        float p[3][16];
#pragma unroll
        for (int e = 0; e < 16; ++e) {
            f32x2 a2[3];
#pragma unroll
            for (int r = 0; r < 3; ++r) a2[r] = (f32x2){0.f, 0.f};
#pragma unroll
            for (int j = 0; j < 4; ++j) { const f32x4 w = *(const LAS f32x4*)(RW + e * 1024 + 4 * lane + 256 * j); const f32x2 wlo = __builtin_shufflevector(w, w, 0, 1), whi = __builtin_shufflevector(w, w, 2, 3);
#pragma unroll
                for (int r = 0; r < 3; ++r) { a2[r] = __builtin_elementwise_fma(__builtin_shufflevector(y[r][j], y[r][j], 0, 1), wlo, a2[r]); a2[r] = __builtin_elementwise_fma(__builtin_shufflevector(y[r][j], y[r][j], 2, 3), whi, a2[r]); } }
#pragma unroll
            for (int r = 0; r < 3; ++r) { p[r][e] = a2[r].x + a2[r].y; asm volatile("" : "+v"(p[r][e])); } }
#pragma unroll
        for (int r = 0; r < 3; ++r) {
            float q8[8], lg[4];
#pragma unroll
            for (int j = 0; j < 8; ++j) q8[j] = swap32_add(p[r][j], p[r][j + 8]);
#pragma unroll
            for (int j = 0; j < 4; ++j) lg[j] = row_sum(swap16_add(q8[j], q8[j + 4]));
            float sc[4], sel[4];
#pragma unroll
            for (int j = 0; j < 4; ++j) { sc[j] = 1.0f / (1.0f + __expf(-lg[j])); sel[j] = sc[j] + rb[j]; }
            int i1 = 0, i2 = 0; float m1 = -1e30f, m2 = -1e30f, w1 = 0.f, w2 = 0.f;
#pragma unroll
            for (int j = 0; j < 4; ++j) { const float t = sel[j];
                if (t > m1) { m2 = m1; i2 = i1; w2 = w1; m1 = t; i1 = j; w1 = sc[j]; } else if (t > m2) { m2 = t; i2 = j; w2 = sc[j]; } }
            const float gs = m1 + m2;
            const float g0 = readlane_f(gs, 0), g1 = readlane_f(gs, 16), g2 = readlane_f(gs, 32), g3 = readlane_f(gs, 48);
            int bg = 0; float bgs = g0; if (g1 > bgs) { bgs = g1; bg = 1; } if (g2 > bgs) { bgs = g2; bg = 2; } if (g3 > bgs) { bgs = g3; bg = 3; }
            bg = __builtin_amdgcn_readfirstlane(bg);
            const int e0 = 4 * bg + __builtin_amdgcn_readlane(i1, 16 * bg), e1 = 4 * bg + __builtin_amdgcn_readlane(i2, 16 * bg);
            const float w0 = readlane_f(w1, 16 * bg), w1s = readlane_f(w2, 16 * bg);
            const float wn = 1.0f / (w0 + w1s);
            if (lane == 0 && i0 + r < rpw) { const int rl = wave * rpw + i0 + r;
                const int p0 = __hip_atomic_fetch_add(&lcnt[e0], 1, __ATOMIC_RELAXED, __HIP_MEMORY_SCOPE_WORKGROUP), p1 = __hip_atomic_fetch_add(&lcnt[e1], 1, __ATOMIC_RELAXED, __HIP_MEMORY_SCOPE_WORKGROUP);
                rinfo[rl * 6 + 0] = e0; rinfo[rl * 6 + 1] = p0; rinfo[rl * 6 + 2] = e1; rinfo[rl * 6 + 3] = p1;
                rinfo[rl * 6 + 4] = __builtin_bit_cast(int, w0 * wn); rinfo[rl * 6 + 5] = __builtin_bit_cast(int, w1s * wn); }
        }
    }
    __syncthreads();
    if (tid < 16) lcnt[16 + tid] = (int)__hip_atomic_fetch_add(cnt + 64 * tid, (unsigned)lcnt[tid], RLX_AGENT);
    __syncthreads();
    if (tid < rpb) { const int row = vcu * rpb + tid; const int e0 = rinfo[tid * 6 + 0], e1 = rinfo[tid * 6 + 2];
        const int p0 = lcnt[16 + e0] + rinfo[tid * 6 + 1], p1 = lcnt[16 + e1] + rinfo[tid * 6 + 3];
        list[(size_t)e0 * TALL + p0] = row; list[(size_t)e1 * TALL + p1] = row;
        toki[row * 4 + 0] = e0; toki[row * 4 + 1] = p0; toki[row * 4 + 2] = e1; toki[row * 4 + 3] = p1;
        tokw[row * 2 + 0] = __builtin_bit_cast(float, rinfo[tid * 6 + 4]); tokw[row * 2 + 1] = __builtin_bit_cast(float, rinfo[tid * 6 + 5]); }
    __syncthreads();
}

__device__ __forceinline__ int build_moe_table(const unsigned* cnt, LAS int* tab, int tid) {
    if (tid < 16) tab[RT_MAX + 1 + tid] = (int)__hip_atomic_load(cnt + 64 * tid, RLX_AGENT);
    __syncthreads();
    if (tid < RT_MAX) { int acc = 0, ef = -1, mf = 0;
#pragma unroll
        for (int e = 0; e < 16; ++e) { const int nt = (tab[RT_MAX + 1 + e] + 255) >> 8; if (ef < 0 && tid < acc + nt) { ef = e; mf = tid - acc; } acc += nt; }
        if (ef >= 0) tab[tid] = ef | (mf << 8);
        if (tid == 0) tab[RT_MAX] = acc < RT_MAX ? acc : RT_MAX; }
    __syncthreads();
    return tab[RT_MAX];
}

struct CbTok { int e0, p0, e1, p1; float w0, w1; };
struct CbRow { f32x4 g2[4], s0[4], s1[4]; u32x2 x[4], ya[4], yb[4]; };
__device__ __forceinline__ void cb_tok(CbTok& t, const int* toki, const float* tokw, int row) {
    const int4 q = *(const int4*)(toki + row * 4); const float2 w = *(const float2*)(tokw + row * 2); t.e0 = q.x; t.p0 = q.y; t.e1 = q.z; t.p1 = q.w; t.w0 = w.x; t.w1 = w.y;
}
template <bool FINAL>
__device__ __forceinline__ void cb_issue(CbRow& r, const CbTok& t, int mybase, const bf16* XB, const float* modv, const float* modv_next, const bf16* YB, int row, int lane) {
    const int s0 = __shfl(mybase, t.e0) + t.p0, s1 = __shfl(mybase, t.e1) + t.p1;
    const bf16* xp = XB + (size_t)row * D; const int bi = row_bi(row); const float* g2 = modv + bi * 6144 + 5120; const float* mv = modv_next + bi * 6144;
#pragma unroll
    for (int j = 0; j < 4; ++j) { const int c = 4 * lane + 256 * j;
        r.ya[j] = *(const u32x2*)(YB + (size_t)s0 * D + c); r.yb[j] = *(const u32x2*)(YB + (size_t)s1 * D + c);
        r.x[j] = *(const u32x2*)(xp + c); r.g2[j] = *(const f32x4*)(g2 + c);
        if constexpr (!FINAL) { r.s0[j] = *(const f32x4*)(mv + c); r.s1[j] = *(const f32x4*)(mv + 1024 + c); } }
}
template <bool FINAL>
__device__ __forceinline__ void cb_finish(const CbRow& r, const CbTok& t, const f32x4 (&gn)[4], bf16* xp, float* orow, bf16* hrow, int lane) {
    f32x4 v[4]; float ss = 0.f;
#pragma unroll
    for (int j = 0; j < 4; ++j) { const u32x2 a = r.ya[j], b = r.yb[j]; const float w0 = t.w0, w1 = t.w1;
        f32x4 y; y.x = w0 * bflo(a.x) + w1 * bflo(b.x); y.y = w0 * bfhi(a.x) + w1 * bfhi(b.x); y.z = w0 * bflo(a.y) + w1 * bflo(b.y); y.w = w0 * bfhi(a.y) + w1 * bfhi(b.y);
        const u32x2 xt = r.x[j]; v[j] = (f32x4){bflo(xt.x), bfhi(xt.x), bflo(xt.y), bfhi(xt.y)} + r.g2[j] * y;
        ss += (v[j].x * v[j].x + v[j].y * v[j].y) + (v[j].z * v[j].z + v[j].w * v[j].w); }
    const float rs = __builtin_amdgcn_rsqf(wave_sum(ss) * (1.0f / D) + EPSF);
#pragma unroll
    for (int j = 0; j < 4; ++j) { const int c = 4 * lane + 256 * j;
        if constexpr (FINAL) *(f32x4*)(orow + c) = (v[j] * rs) * gn[j];
        else { u32x2 xw; xw.x = pk2(v[j].x, v[j].y); xw.y = pk2(v[j].z, v[j].w); *(u32x2*)(xp + c) = xw;
            const f32x4 y = (v[j] * rs) * gn[j] * (1.0f + r.s1[j]) + r.s0[j];
            u32x2 w; w.x = pk2(y.x, y.y); w.y = pk2(y.z, y.w); *(u32x2*)(hrow + c) = w; } }
}
template <bool FINAL>
__device__ __forceinline__ void phase_combine(bf16* XB, float* OUT, const float* modv  , const bf16* YB, const unsigned* cnt, const int* toki, const float* tokw,
                                              const float* gnext, const float* modv_next, bf16* H, int nrows, int lane, int wave, int vcu, int G) {
    int tiles = 0; if (lane < 16) tiles = ((int)__hip_atomic_load(cnt + 64 * lane, RLX_AGENT) + 255) >> 8;
    int incl = tiles;
#pragma unroll
    for (int o = 1; o < 16; o <<= 1) { const int t = __shfl_up(incl, o); if (lane >= o) incl += t; }
    const int mybase = (incl - tiles) * 256;
    f32x4 gn[4];
#pragma unroll
    for (int j = 0; j < 4; ++j) gn[j] = *(const f32x4*)(gnext + 4 * lane + 256 * j);
    CbTok ta, tb, tc; CbRow ra, rb;
    cb_tok(ta, toki, tokw, thin_row(vcu, wave, 0)); cb_tok(tb, toki, tokw, thin_row(vcu, wave, 1));
    cb_issue<FINAL>(ra, ta, mybase, XB, modv, modv_next, YB, thin_row(vcu, wave, 0), lane);
#pragma unroll
    for (int i = 0; i < TROWS; ++i) {
        const int row = thin_row(vcu, wave, i), row1 = thin_row(vcu, wave, i + 1), row2 = thin_row(vcu, wave, i + 2);
        CbTok& tcur = (i % 3 == 0) ? ta : (i % 3 == 1) ? tb : tc; CbTok& tnx = (i % 3 == 0) ? tb : (i % 3 == 1) ? tc : ta; CbTok& tn2 = (i % 3 == 0) ? tc : (i % 3 == 1) ? ta : tb;
        if (i + 2 < TROWS) cb_tok(tn2, toki, tokw, row2 < nrows ? row2 : row);
        if (i + 1 < TROWS) cb_issue<FINAL>((i & 1) ? ra : rb, tnx, mybase, XB, modv, modv_next, YB, row1 < nrows ? row1 : row, lane);
        if (row < nrows) cb_finish<FINAL>((i & 1) ? rb : ra, tcur, gn, XB + (size_t)row * D, OUT + (size_t)row * D, H + (size_t)row * D, lane);
    }
}

struct RoRow { u32x2 a[4], b[4], gt[4]; };
__device__ __forceinline__ void ro_issue(RoRow& r, const bf16* OF, const bf16* OB, const bf16* QKV2, int row, int lane) {
#pragma unroll
    for (int j = 0; j < 4; ++j) { const int c = 4 * lane + 256 * j;
        r.a[j] = *(const u32x2*)(OF + (size_t)row * D + c); r.b[j] = *(const u32x2*)(OB + (size_t)row * D + c); r.gt[j] = *(const u32x2*)(QKV2 + (size_t)row * NGLA + 2048 + c); }
}
__device__ __forceinline__ void ro_finish(const RoRow& r, const f32x4 gg, bf16* orow, int lane) {
#pragma unroll
    for (int j = 0; j < 4; ++j) { const u32x2 a = r.a[j], b = r.b[j], gt = r.gt[j];
        f32x4 o; o.x = bflo(a.x) + bflo(b.x); o.y = bfhi(a.x) + bfhi(b.x); o.z = bflo(a.y) + bflo(b.y); o.w = bfhi(a.y) + bfhi(b.y);
        const float ss = wave_sum((o.x * o.x + o.y * o.y) + (o.z * o.z + o.w * o.w));
        const float rs = __builtin_amdgcn_rsqf(ss * (1.0f / 256.0f) + EPSF);
        f32x4 gv; gv.x = silu_f(bflo(gt.x)); gv.y = silu_f(bfhi(gt.x)); gv.z = silu_f(bflo(gt.y)); gv.w = silu_f(bfhi(gt.y));
        const f32x4 y = (o * rs) * gg * gv;
        u32x2 w; w.x = pk2(y.x, y.y); w.y = pk2(y.z, y.w); *(u32x2*)(orow + 4 * lane + 256 * j) = w; }
}
__device__ __forceinline__ void phase_readout(const bf16* OF, const bf16* OB, const bf16* QKV2, const float* ng, bf16* AOUT, int nrows, int lane, int wave, int vcu, int G) {
    const f32x4 gg = *(const f32x4*)(ng + 4 * lane);
    RoRow ra, rb, rc;
    ro_issue(ra, OF, OB, QKV2, thin_row(vcu, wave, 0), lane); ro_issue(rb, OF, OB, QKV2, thin_row(vcu, wave, 1), lane);
#pragma unroll
    for (int i = 0; i < TROWS; ++i) {
        const int row = thin_row(vcu, wave, i), row2 = thin_row(vcu, wave, i + 2);
        RoRow& cur = (i % 3 == 0) ? ra : (i % 3 == 1) ? rb : rc; RoRow& n2 = (i % 3 == 0) ? rc : (i % 3 == 1) ? ra : rb;
        if (i + 2 < TROWS) ro_issue(n2, OF, OB, QKV2, row2 < nrows ? row2 : row, lane);
        if (row < nrows) ro_finish(cur, gg, AOUT + (size_t)row * D, lane);
    }
}

__device__ __forceinline__ int na_r0(int r) { int v = r - 4; return v < 0 ? 0 : (v > 24 ? 24 : v); }
template <int NMAPS, int DV, bool NA>
__device__ __forceinline__ void attn_unit(LAS unsigned char* lds, int tid, int lane, int wave,
                                          const bf16* QKV, int qcol, int qrow0, int kcol, int krow_lat, int krow_ctx, const bf16* VT, int klo, int khi,
                                          int r_wave, int xq0, const LAS float* biasT,
                                          bf16* AOUT, int ocol, float lam, const float* subg, float outscale) {
    constexpr int KB = 9216;
    constexpr int BUFSZ = NMAPS * KB + DV * 144;
    constexpr int NVB = DV / 16, NVR = DV / 64;
    const int fr = lane & 15, g = lane >> 4;
    bf16x8 qf[NMAPS][2];
    { const bf16* qp = QKV + (size_t)(qrow0 + wave * 16 + fr) * NATT + qcol + 8 * g;
#pragma unroll
      for (int m = 0; m < NMAPS; ++m)
#pragma unroll
          for (int s = 0; s < 2; ++s) qf[m][s] = *(const bf16x8*)(qp + m * 64 + 32 * s); }
    f32x4 O[NMAPS][NVB]; float mrun[NMAPS]; float lrun[NMAPS];
#pragma unroll
    for (int m = 0; m < NMAPS; ++m) { mrun[m] = -1e30f; lrun[m] = 0.f;
#pragma unroll
        for (int vb = 0; vb < NVB; ++vb) O[m][vb] = (f32x4){0.f, 0.f, 0.f, 0.f}; }
    const int ntiles = 4 + (khi - klo);
    u32x4 kreg[NMAPS], vreg[NVR];
    const int lkey = tid >> 3, lch = tid & 7;
#define AT_LOAD(i) do { const int _i = (i); const int _rowg = (_i < 4 ? krow_ctx + 64 * _i : krow_lat + 64 * (klo + _i - 4)) + lkey; const int _tok0 = (_i < 4 ? SEQ + 64 * _i : 64 * (klo + _i - 4)); \
        _Pragma("unroll") for (int m = 0; m < NMAPS; ++m) kreg[m] = *(const u32x4*)(QKV + (size_t)_rowg * NATT + kcol + m * 64 + lch * 8); \
        _Pragma("unroll") for (int j = 0; j < NVR; ++j) { const int idx = tid + 512 * j; vreg[j] = *(const u32x4*)(VT + (size_t)(idx >> 3) * NKEY + _tok0 + (idx & 7) * 8); } } while (0)
#define AT_STORE(b) do { LAS unsigned char* _p = lds + (b) * BUFSZ; \
        _Pragma("unroll") for (int m = 0; m < NMAPS; ++m) *(LAS u32x4*)(_p + m * KB + lkey * 144 + lch * 16) = kreg[m]; \
        _Pragma("unroll") for (int j = 0; j < NVR; ++j) { const int idx = tid + 512 * j; *(LAS u32x4*)(_p + NMAPS * KB + (idx >> 3) * 144 + (idx & 7) * 16) = vreg[j]; } } while (0)
    AT_LOAD(0); AT_STORE(0); __syncthreads();
    const int kbase0 = (8 * (fr >> 2) + (fr & 3)) * 144 + 16 * g;
    const int vbase = fr * 144 + 16 * g;
    int r0w = 0, xq = 0, tmask = 3, c0w = 0; float pen[4][4];
    if constexpr (NA) { r0w = na_r0(r_wave); xq = xq0 + fr; int cs = xq - 8; cs = cs < 0 ? 0 : (cs > 48 ? 48 : cs);
        c0w = xq0 - 8; c0w = c0w < 0 ? 0 : (c0w > 32 ? 32 : c0w);
        tmask = 1;
#pragma unroll
        for (int kb = 0; kb < 4; ++kb)
#pragma unroll
            for (int ii = 0; ii < 4; ++ii) { const int y = c0w + 32 * (kb >> 1) + 8 * g + 4 * (kb & 1) + ii; pen[kb][ii] = (y >= cs && y < cs + 16) ? 0.f : -1e30f; } }
    for (int i = 0; i < ntiles; ++i) {
        if (i + 1 < ntiles) AT_LOAD(i + 1);
        const LAS unsigned char* buf = lds + (i & 1) * BUFSZ;
        bool active = true; int kr = 0; bool local = false;
        if constexpr (NA) { if (i >= 4) { local = true; kr = klo + i - 4; active = (kr >= r0w) && (kr < r0w + 8); } }
        if (active) {
            const int tm = local ? tmask : 3;
            const int koffw = local ? c0w * 144 : 0, voffw = local ? c0w * 2 : 0;
            bf16x8 kf[NMAPS][4][2];
#pragma unroll
            for (int m = 0; m < NMAPS; ++m)
#pragma unroll
                for (int kb = 0; kb < 4; ++kb)
#pragma unroll
                    for (int s = 0; s < 2; ++s) kf[m][kb][s] = *(const LAS bf16x8*)(buf + m * KB + kbase0 + koffw + (kb & 1) * (4 * 144) + (kb >> 1) * (32 * 144) + s * 64);
            __builtin_amdgcn_sched_barrier(0);
            f32x4 S[NMAPS][4];
#pragma unroll
            for (int m = 0; m < NMAPS; ++m)
#pragma unroll
                for (int kb = 0; kb < 4; ++kb) { S[m][kb] = (f32x4){0.f, 0.f, 0.f, 0.f};
                    if (!NA || (tm >> (kb >> 1)) & 1) {
#pragma unroll
                        for (int s = 0; s < 2; ++s) S[m][kb] = __builtin_amdgcn_mfma_f32_16x16x32_bf16(kf[m][kb][s], qf[m][s], S[m][kb], 0, 0, 0); } }
            bf16x8 vf0[4][2];
#pragma unroll
            for (int vb = 0; vb < 4; ++vb)
#pragma unroll
                for (int t = 0; t < 2; ++t) vf0[vb][t] = *(const LAS bf16x8*)(buf + NMAPS * KB + vbase + voffw + vb * (16 * 144) + t * 64);
            __builtin_amdgcn_sched_barrier(0);
            bf16x8 pf[NMAPS][2];
#pragma unroll
            for (int m = 0; m < NMAPS; ++m) {
                if constexpr (NA) { if (local) {
                        const LAS float* bp = biasT + (kr - r_wave + 7) * 31 + (c0w + 8 * g - xq + 15);
#pragma unroll
                        for (int kb = 0; kb < 4; ++kb)
#pragma unroll
                            for (int ii = 0; ii < 4; ++ii) { const float t = (tm >> (kb >> 1)) & 1 ? (S[m][kb][ii] + pen[kb][ii]) + bp[32 * (kb >> 1) + 4 * (kb & 1) + ii] : -1e30f; S[m][kb][ii] = t; } } }
                float mx = fmaxf(fmaxf(S[m][0][0], S[m][0][1]), fmaxf(S[m][0][2], S[m][0][3]));
#pragma unroll
                for (int kb = 1; kb < 4; ++kb) mx = fmaxf(fmaxf(mx, S[m][kb][0]), fmaxf(fmaxf(S[m][kb][1], S[m][kb][2]), S[m][kb][3]));
                mx = swap32_max(swap16_max(mx));
                if (__any(mx > mrun[m] + 8.0f)) {
                    const float mnew = fmaxf(mrun[m], mx), alpha = fexp2(mrun[m] - mnew); mrun[m] = mnew; lrun[m] = lrun[m] * alpha;
#pragma unroll
                    for (int vb = 0; vb < NVB; ++vb) O[m][vb] = O[m][vb] * alpha;
                }
                const float mm = mrun[m];
                unsigned pw[8]; float l0 = 0.f, l1 = 0.f;
#pragma unroll
                for (int kb = 0; kb < 4; ++kb) { const float a0 = fexp2(S[m][kb][0] - mm), a1 = fexp2(S[m][kb][1] - mm), a2 = fexp2(S[m][kb][2] - mm), a3 = fexp2(S[m][kb][3] - mm);
                    l0 += a0 + a1; l1 += a2 + a3;
                    pw[2 * kb] = cvtpk(a0, a1); pw[2 * kb + 1] = cvtpk(a2, a3); }
                lrun[m] += l0 + l1;
                pf[m][0] = __builtin_bit_cast(bf16x8, (u32x4){pw[0], pw[1], pw[2], pw[3]});
                pf[m][1] = __builtin_bit_cast(bf16x8, (u32x4){pw[4], pw[5], pw[6], pw[7]});
            }
            __builtin_amdgcn_sched_barrier(0);
            if constexpr (NVB == 8) {
                bf16x8 vf1[4][2];
#pragma unroll
                for (int vb = 0; vb < 4; ++vb)
#pragma unroll
                    for (int t = 0; t < 2; ++t) vf1[vb][t] = *(const LAS bf16x8*)(buf + NMAPS * KB + vbase + (4 + vb) * (16 * 144) + t * 64);
                __builtin_amdgcn_sched_barrier(0);
#pragma unroll
                for (int vb = 0; vb < 4; ++vb)
#pragma unroll
                    for (int t = 0; t < 2; ++t)
#pragma unroll
                        for (int m = 0; m < NMAPS; ++m) O[m][vb] = __builtin_amdgcn_mfma_f32_16x16x32_bf16(vf0[vb][t], pf[m][t], O[m][vb], 0, 0, 0);
                __builtin_amdgcn_sched_barrier(0);
#pragma unroll
                for (int vb = 0; vb < 4; ++vb)
#pragma unroll
                    for (int t = 0; t < 2; ++t)
#pragma unroll
                        for (int m = 0; m < NMAPS; ++m) O[m][4 + vb] = __builtin_amdgcn_mfma_f32_16x16x32_bf16(vf1[vb][t], pf[m][t], O[m][4 + vb], 0, 0, 0);
            } else {
#pragma unroll
                for (int vb = 0; vb < 4; ++vb)
#pragma unroll
                    for (int t = 0; t < 2; ++t) { if (!NA || (tm >> t) & 1) {
#pragma unroll
                            for (int m = 0; m < NMAPS; ++m) O[m][vb] = __builtin_amdgcn_mfma_f32_16x16x32_bf16(vf0[vb][t], pf[m][t], O[m][vb], 0, 0, 0); } }
            }
            __builtin_amdgcn_sched_barrier(0);
        }
        if (i + 1 < ntiles) AT_STORE((i + 1) & 1);
        __syncthreads();
    }
#undef AT_LOAD
#undef AT_STORE
    float inv[NMAPS];
#pragma unroll
    for (int m = 0; m < NMAPS; ++m) { float l = lrun[m]; l = swap16_add(l, l); l = swap32_add(l, l); inv[m] = 1.0f / l; }
    const int orow = qrow0 + wave * 16 + fr;
    if constexpr (NMAPS == 2) {
        float ss = 0.f; const float i1 = inv[0], i2 = lam * inv[1];
#pragma unroll
        for (int vb = 0; vb < NVB; ++vb) { O[0][vb] = O[0][vb] * i1 - O[1][vb] * i2; const f32x4 o = O[0][vb]; ss += (o.x * o.x + o.y * o.y) + (o.z * o.z + o.w * o.w); }
        ss = swap16_add(ss, ss); ss = swap32_add(ss, ss);
        const float rs = __builtin_amdgcn_rsqf(ss * (1.0f / DV) + EPSF) * outscale;
#pragma unroll
        for (int vb = 0; vb < NVB; ++vb) { const f32x4 gg = *(const f32x4*)(subg + 16 * vb + 4 * g); const f32x4 y = O[0][vb] * rs * gg;
            u32x2 w; w.x = cvtpk(y.x, y.y); w.y = cvtpk(y.z, y.w); *(u32x2*)(AOUT + (size_t)orow * D + ocol + 16 * vb + 4 * g) = w; }
    } else {
#pragma unroll
        for (int vb = 0; vb < NVB; ++vb) { const f32x4 y = O[0][vb] * inv[0];
            u32x2 w; w.x = cvtpk(y.x, y.y); w.y = cvtpk(y.z, y.w); *(u32x2*)(AOUT + (size_t)orow * D + ocol + 16 * vb + 4 * g) = w; }
    }
}


typedef float f32x16 __attribute__((ext_vector_type(16)));
__device__ __forceinline__ void diff_unit32(LAS unsigned char* lds, int tid, int lane, int wave,
                                            const bf16* QKV, int qcol, int qrow0, int kcol, int krow_lat, int krow_ctx, const bf16* VT, int khi,
                                            bf16* AOUT, int ocol, float lam, const float* subg, float outscale) {
    constexpr int KB = 9216, VOFF = 2 * KB, BUFSZ = 2 * KB + 128 * 144;
    const int r = lane & 31, hf = lane >> 5, map = wave >> 2, wq = wave & 3;
    const int swz = ((r >> 4) & 1) << 2;
    bf16x8 qf[4];
    { const bf16* qp = QKV + (size_t)(qrow0 + 32 * wq + r) * NATT + qcol + map * 64 + 8 * hf;
#pragma unroll
      for (int ks = 0; ks < 4; ++ks) qf[ks] = *(const bf16x8*)(qp + 16 * ks); }
    f32x16 O[4];
#pragma unroll
    for (int blk = 0; blk < 4; ++blk)
#pragma unroll
        for (int i = 0; i < 16; ++i) O[blk][i] = 0.f;
    float negm = 0.f, lrun = 0.f;
    const int ntiles = 4 + khi;
    u32x4 kreg[2], vreg[2];
    const int lkey = tid >> 3, lch = tid & 7;
    const int kst = lkey * 144 + ((lch ^ (((lkey >> 4) & 1) << 2)) * 16);
#define D32_LOAD(i) do { const int _i = (i); const int _rowg = (_i < 4 ? krow_ctx + 64 * _i : krow_lat + 64 * (_i - 4)) + lkey; const int _tok0 = (_i < 4 ? SEQ + 64 * _i : 64 * (_i - 4)); \
        _Pragma("unroll") for (int m = 0; m < 2; ++m) kreg[m] = *(const u32x4*)(QKV + (size_t)_rowg * NATT + kcol + m * 64 + lch * 8); \
        _Pragma("unroll") for (int j = 0; j < 2; ++j) { const int idx = tid + 512 * j; vreg[j] = *(const u32x4*)(VT + (size_t)(idx >> 3) * NKEY + _tok0 + (idx & 7) * 8); } } while (0)
#define D32_STORE(b) do { LAS unsigned char* _p = lds + (b) * BUFSZ; \
        _Pragma("unroll") for (int m = 0; m < 2; ++m) *(LAS u32x4*)(_p + m * KB + kst) = kreg[m]; \
        _Pragma("unroll") for (int j = 0; j < 2; ++j) { const int idx = tid + 512 * j, vr = idx >> 3; *(LAS u32x4*)(_p + VOFF + vr * 144 + (((idx & 7) ^ (((vr >> 4) & 1) << 2)) * 16)) = vreg[j]; } } while (0)
    D32_LOAD(0); D32_STORE(0); D32_STORE(2); __syncthreads();
    const int krow = (r & 0x13) | ((r & 4) << 1) | ((r & 8) >> 1);
    const int kbase = map * KB + krow * 144, vbase = VOFF + r * 144;
    bf16x8 pfp[2][2];
#pragma unroll
    for (int kb = 0; kb < 2; ++kb)
#pragma unroll
        for (int sx = 0; sx < 2; ++sx) pfp[kb][sx] = (bf16x8){0, 0, 0, 0, 0, 0, 0, 0};
    int slot = 0;
    for (int i = 0; i < ntiles; ++i) {
        if (i + 1 < ntiles) D32_LOAD(i + 1);
        const int slotn = slot == 2 ? 0 : slot + 1, slotp = slot == 0 ? 2 : slot - 1;
        const LAS unsigned char* buf = lds + slot * BUFSZ; const LAS unsigned char* bufp = lds + slotp * BUFSZ;
        f32x16 S[2];
#pragma unroll
        for (int kb = 0; kb < 2; ++kb) {
#pragma unroll
            for (int ii = 0; ii < 16; ++ii) S[kb][ii] = negm;
#pragma unroll
            for (int ks = 0; ks < 4; ++ks) { const bf16x8 kf = *(const LAS bf16x8*)(buf + kbase + kb * (32 * 144) + (((2 * ks + hf) ^ swz) * 16));
                S[kb] = __builtin_amdgcn_mfma_f32_32x32x16_bf16(kf, qf[ks], S[kb], 0, 0, 0); } }
        __builtin_amdgcn_sched_barrier(0);
        float mx = -1e30f;
#pragma unroll
        for (int kb = 0; kb < 2; ++kb)
#pragma unroll
            for (int ii = 0; ii < 16; ii += 4) mx = fmaxf(fmaxf(mx, S[kb][ii]), fmaxf(fmaxf(S[kb][ii + 1], S[kb][ii + 2]), S[kb][ii + 3]));
        mx = swap32_max(mx);
        const bool resc = (i == 0) || __any(mx > 8.0f);
        float alpha = 1.0f;
        if (resc) { const float dlt = (i == 0) ? mx : fmaxf(mx, 0.f); alpha = fexp2(-dlt); negm -= dlt; lrun *= alpha;
#pragma unroll
            for (int kb = 0; kb < 2; ++kb)
#pragma unroll
                for (int ii = 0; ii < 16; ++ii) S[kb][ii] -= dlt; }
        __builtin_amdgcn_sched_barrier(0);
        bf16x8 pf[2][2]; float l0 = 0.f, l1 = 0.f;
#pragma unroll
        for (int kb = 0; kb < 2; ++kb)
#pragma unroll
            for (int sx = 0; sx < 2; ++sx) { unsigned pw[4];
#pragma unroll
                for (int j = 0; j < 4; ++j) { const float a0 = fexp2(S[kb][8 * sx + 2 * j]), a1 = fexp2(S[kb][8 * sx + 2 * j + 1]); l0 += a0; l1 += a1; pw[j] = cvtpk(a0, a1); }
                pf[kb][sx] = __builtin_bit_cast(bf16x8, (u32x4){pw[0], pw[1], pw[2], pw[3]}); }
        lrun += l0 + l1;
#pragma unroll
        for (int blk = 0; blk < 4; ++blk)
#pragma unroll
            for (int kb = 0; kb < 2; ++kb)
#pragma unroll
                for (int sx = 0; sx < 2; ++sx) { const bf16x8 vf = *(const LAS bf16x8*)(bufp + vbase + blk * (32 * 144) + (((4 * kb + 2 * sx + hf) ^ swz) * 16));
                    O[blk] = __builtin_amdgcn_mfma_f32_32x32x16_bf16(vf, pfp[kb][sx], O[blk], 0, 0, 0); }
#pragma unroll
        for (int k = 0; k < 16; ++k) { __builtin_amdgcn_sched_group_barrier(0x100, 1, 0); __builtin_amdgcn_sched_group_barrier(0x008, 1, 0); __builtin_amdgcn_sched_group_barrier(0x400, 2, 0); __builtin_amdgcn_sched_group_barrier(0x002, 4, 0); }
        __builtin_amdgcn_sched_barrier(0);
        if (resc) {
#pragma unroll
            for (int blk = 0; blk < 4; ++blk) O[blk] = O[blk] * alpha; }
#pragma unroll
        for (int kb = 0; kb < 2; ++kb)
#pragma unroll
            for (int sx = 0; sx < 2; ++sx) pfp[kb][sx] = pf[kb][sx];
        if (i + 1 < ntiles) D32_STORE(slotn);
        slot = slotn;
        __syncthreads();
    }
    { const LAS unsigned char* bufp = lds + (slot == 0 ? 2 : slot - 1) * BUFSZ;
#pragma unroll
      for (int blk = 0; blk < 4; ++blk)
#pragma unroll
          for (int kb = 0; kb < 2; ++kb)
#pragma unroll
              for (int sx = 0; sx < 2; ++sx) { const bf16x8 vf = *(const LAS bf16x8*)(bufp + vbase + blk * (32 * 144) + (((4 * kb + 2 * sx + hf) ^ swz) * 16));
                  O[blk] = __builtin_amdgcn_mfma_f32_32x32x16_bf16(vf, pfp[kb][sx], O[blk], 0, 0, 0); } }
    __syncthreads();
#undef D32_LOAD
#undef D32_STORE
    float l = lrun; l = swap32_add(l, l); const float inv = 1.0f / l;
    LAS float* X = (LAS float*)lds + (size_t)wq * 4096 + lane;
    if (map == 1) {
#pragma unroll
        for (int blk = 0; blk < 4; ++blk)
#pragma unroll
            for (int i = 0; i < 16; ++i) X[(blk * 16 + i) * 64] = O[blk][i] * inv;
    }
    __syncthreads();
    if (map == 0) {
        float ss = 0.f;
#pragma unroll
        for (int blk = 0; blk < 4; ++blk)
#pragma unroll
            for (int i = 0; i < 16; ++i) { const float o = O[blk][i] * inv - lam * X[(blk * 16 + i) * 64]; O[blk][i] = o; ss += o * o; }
        ss = swap32_add(ss, ss);
        const float rs = __builtin_amdgcn_rsqf(ss * (1.0f / 128.0f) + EPSF) * outscale;
        bf16* op = AOUT + (size_t)(qrow0 + 32 * wq + r) * D + ocol + 4 * hf;
#pragma unroll
        for (int blk = 0; blk < 4; ++blk)
#pragma unroll
            for (int g4 = 0; g4 < 4; ++g4) { const int dv0 = 32 * blk + 8 * g4; const f32x4 gg = *(const f32x4*)(subg + dv0 + 4 * hf);
                u32x2 w; w.x = cvtpk(O[blk][4 * g4] * rs * gg.x, O[blk][4 * g4 + 1] * rs * gg.y); w.y = cvtpk(O[blk][4 * g4 + 2] * rs * gg.z, O[blk][4 * g4 + 3] * rs * gg.w);
                *(u32x2*)(op + dv0) = w; }
    }
    __syncthreads();
}

__device__ __forceinline__ void phase_attention(const bf16* QKV, const bf16* VAT, const bf16* VBT, bf16* AOUT, const float* lamp  , float lam_init, const float* subg, const float* nab  ,
                                                unsigned* naq, const ConvPtrs& CP, int clo, int chi, LAS unsigned char* lds, int tid, int lane, int wave) {
    LAS float* biasT = (LAS float*)(lds + LX_BIAS) + 64;
    constexpr int NATT_U = 576 + 1152;
    const int ncu = (chi - clo + CV_UNIT - 1) / CV_UNIT, nq = NATT_U + ncu;
    int mine = 0; if (tid == 0) mine = (int)__hip_atomic_fetch_add(naq, 1u, RLX_AGENT);
    for (;;) {
        __syncthreads();
        if (tid == 0) *(LAS int*)(lds + LX_MISC + 64) = mine;
        __syncthreads();
        const int q = *(LAS int*)(lds + LX_MISC + 64);
        if (q >= nq) break;
        if (tid == 0) mine = (int)__hip_atomic_fetch_add(naq, 1u, RLX_AGENT);
        const int ai = (int)(((long)q * NATT_U) / nq); const bool isatt = (int)(((long)(q + 1) * NATT_U) / nq) > ai;
        if (!isatt) { conv_unit(CP, clo + (q - ai) * CV_UNIT, chi, lds, lane, wave); continue; }
        if (ai < 512 || (ai >= 1536 && ai < 1600)) {
            int bh, qrow0, khi;
            if (ai < 512) { bh = ai >> 4; const int qt = ai & 15; qrow0 = (bh >> 2) * SEQ + qt * 128; khi = 32; }
            else { const int u = ai - 1536; bh = u >> 1; const int qt = u & 1; qrow0 = TX + (bh >> 2) * CTXL + qt * 128; khi = 0; }
            const int b = bh >> 2, h = bh & 3;
            const float lam = __expf(wave_sum(lamp[lane] * lamp[64 + lane])) - __expf(wave_sum(lamp[128 + lane] * lamp[192 + lane])) + lam_init;
            diff_unit32(lds, tid, lane, wave, QKV, h * 128, qrow0, 512 + h * 128, b * SEQ, TX + b * CTXL, VAT + (size_t)bh * 128 * NKEY, khi,
                        AOUT, h * 128, lam, subg, 1.0f - lam_init);
        } else {
            int bh, qrow0, klo, khi, rw;
            if (ai < 1536) { const int u = ai - 512; bh = u >> 4; const int rp = u & 15; qrow0 = (bh >> 3) * SEQ + rp * 128; klo = na_r0(2 * rp); khi = na_r0(2 * rp + 1) + 8; rw = 2 * rp + (wave >> 2); }
            else { const int u = ai - 1600; bh = u >> 1; const int qt = u & 1; qrow0 = TX + (bh >> 3) * CTXL + qt * 128; klo = 0; khi = 0; rw = 0; }
            const int b = bh >> 3, h = bh & 7;
            for (int i = tid; i < 640; i += 512) { const int k = i - 64; biasT[k] = (k >= 0 && k < 465) ? nab[h * 465 + k] * LOG2E : 0.f; }
            attn_unit<1, 64, true>(lds, tid, lane, wave, QKV, 1536 + h * 64, qrow0, 2048 + h * 64, b * SEQ, TX + b * CTXL, VBT + (size_t)bh * 64 * NKEY, klo, khi,
                                   rw, 16 * (wave & 3), biasT, AOUT, 512 + h * 64, 0.f, nullptr, 1.0f);
        }
    }
}

__device__ __forceinline__ void gla_chunk_rows(int b, int dir, int n, int& row0, int& tok0) {
    if (n < 4) { const int cc = dir ? 3 - n : n; row0 = TX + b * CTXL + 64 * cc; tok0 = SEQ + 64 * cc; } else { const int lc = dir ? 35 - n : n - 4; row0 = b * SEQ + 64 * lc; tok0 = 64 * lc; }
}
constexpr int GP_QM = 0, GP_KM = 17408, GP_VT = 34816, GP_LR = 71680, GP_SEG = 75776;
__device__ __forceinline__ void phase_gla_prep(const bf16* QKV2, const bf16* VGT, const float* wgate  , const float* bgate  ,
                                               bf16* QG, bf16* KET, float* FACD, bf16* OF, bf16* OB,
                                               LAS unsigned char* lds, int tid, int lane, int wave, int vcu, int G) {
    const int fr = lane & 15, g = lane >> 4;
    const int d = tid & 127, seg = tid >> 7;
    LAS float* LR = (LAS float*)(lds + GP_LR);
    LAS float* SEG = (LAS float*)(lds + GP_SEG);
    for (int ub = vcu * 9; ub < 2304; ub += G * 9) {
        const int q = ub / 36, n0 = ub % 36, dir = q & 1, hh = (q >> 1) & 3, b = q >> 3;
        bf16* OUT = dir ? OB : OF;
        float wg[16];
#pragma unroll
        for (int r = 0; r < 16; ++r) wg[r] = wgate[(dir * 16 + r) * 512 + hh * 128 + d];
        const float bgv = bgate[dir * 512 + hh * 128 + d];
        const bf16* vtb = VGT + (size_t)(b * 4 + hh) * 256 * NKEY;
        u32x4 qr[2], kr[2], vr[4], lr4;
#define GP_LOAD(n) do { int _row0, _tok0; gla_chunk_rows(b, dir, (n), _row0, _tok0); \
        _Pragma("unroll") for (int j = 0; j < 2; ++j) { const int idx = tid + 512 * j, p = idx >> 4, ch = idx & 15; const bf16* src = QKV2 + (size_t)(_row0 + p) * NGLA + hh * 128 + ch * 8; qr[j] = *(const u32x4*)src; kr[j] = *(const u32x4*)(src + 512); } \
        _Pragma("unroll") for (int j = 0; j < 4; ++j) { const int idx = tid + 512 * j; vr[j] = *(const u32x4*)(vtb + (size_t)(idx >> 3) * NKEY + _tok0 + (idx & 7) * 8); } \
        if (tid < 128) lr4 = *(const u32x4*)(QKV2 + (size_t)(_row0 + (tid >> 1)) * NGLA + 3072 + dir * 16 + (tid & 1) * 8); } while (0)
#define GP_N(i) (dir ? ((i) < 4 ? 3 - (i) : 39 - (i)) : (i))
        GP_LOAD(GP_N(n0));
        for (int k9 = 0; k9 < 9; ++k9) {
            const int n = GP_N(n0 + k9), u = ub - n0 + n; int row0, tok0; gla_chunk_rows(b, dir, n, row0, tok0);
#pragma unroll
            for (int j = 0; j < 2; ++j) { const int idx = tid + 512 * j, p = idx >> 4, ch = idx & 15;
                *(LAS u32x4*)(lds + GP_QM + p * 272 + ch * 16) = qr[j]; *(LAS u32x4*)(lds + GP_KM + p * 272 + ch * 16) = kr[j]; }
#pragma unroll
            for (int j = 0; j < 4; ++j) { const int idx = tid + 512 * j; *(LAS u32x4*)(lds + GP_VT + (idx >> 3) * 144 + (idx & 7) * 16) = vr[j]; }
            if (tid < 128) { LAS float* lp = LR + (tid >> 1) * 16 + (tid & 1) * 8;
                lp[0] = bflo(lr4.x); lp[1] = bfhi(lr4.x); lp[2] = bflo(lr4.y); lp[3] = bfhi(lr4.y); lp[4] = bflo(lr4.z); lp[5] = bfhi(lr4.z); lp[6] = bflo(lr4.w); lp[7] = bfhi(lr4.w); }
            __syncthreads();
            if (k9 + 1 < 9) GP_LOAD(GP_N(n0 + k9 + 1));
            float gc[16];
#pragma unroll
            for (int pi = 0; pi < 16; ++pi) { const LAS f32x4* lp = (const LAS f32x4*)(LR + (16 * seg + pi) * 16); f32x2 z2 = (f32x2){bgv, 0.f};
#pragma unroll
                for (int k = 0; k < 4; ++k) { const f32x4 l4 = lp[k];
                    z2 = __builtin_elementwise_fma(__builtin_shufflevector(l4, l4, 0, 1), (f32x2){wg[4 * k], wg[4 * k + 1]}, z2);
                    z2 = __builtin_elementwise_fma(__builtin_shufflevector(l4, l4, 2, 3), (f32x2){wg[4 * k + 2], wg[4 * k + 3]}, z2); }
                const float z = z2.x + z2.y;
                const float az = fabsf(z); gc[pi] = (fminf(z, 0.f) - flog(1.0f + fexp(-az))) * 0.0625f; }
            float run = 0.f;
            if (dir == 0) {
#pragma unroll
                for (int pi = 0; pi < 16; ++pi) { run += gc[pi]; gc[pi] = run; }
            } else {
#pragma unroll
                for (int pi = 15; pi >= 0; --pi) { run += gc[pi]; gc[pi] = run; }
            }
            SEG[seg * 128 + d] = run;
            __syncthreads();
            const float t0 = SEG[d], t1 = SEG[128 + d], t2 = SEG[256 + d], t3 = SEG[384 + d];
            float off, gmid; const float gend = (t0 + t1) + (t2 + t3);
            if (dir == 0) { off = (seg > 0 ? t0 : 0.f) + (seg > 1 ? t1 : 0.f) + (seg > 2 ? t2 : 0.f); gmid = t0 + t1; }
            else { off = (seg < 3 ? t3 : 0.f) + (seg < 2 ? t2 : 0.f) + (seg < 1 ? t1 : 0.f); gmid = t3 + t2; }
            const float emid = fexp(gmid), eend = fexp(gend - gmid);
            unsigned kep[8];
            bf16* qgp = QG + ((size_t)u * 64 + 16 * seg) * 128 + d;
#pragma unroll
            for (int pi = 0; pi < 16; ++pi) { const int p = 16 * seg + pi; const float rel = off + gc[pi] - gmid; const float Ep = fexp(rel), Ei = fexp(-rel);
                LAS bf16* qa = (LAS bf16*)(lds + GP_QM) + p * 136 + d; LAS bf16* ka = (LAS bf16*)(lds + GP_KM) + p * 136 + d;
                const float qv = bf2f(*qa), kv = bf2f(*ka);
                const float qm = qv * Ep, km = kv * Ei;
                const unsigned w1 = cvtpk(qm, qm * emid), w2 = cvtpk(km, km * eend);
                *qa = (bf16)(w1 & 0xffffu); qgp[pi * 128] = (bf16)(w1 >> 16); *ka = (bf16)(w2 & 0xffffu);
                if (pi & 1) kep[pi >> 1] |= (w2 & 0xffff0000u); else kep[pi >> 1] = w2 >> 16; }
            { u32x4* kt = (u32x4*)(KET + ((size_t)u * 128 + d) * 64 + 16 * seg); kt[0] = (u32x4){kep[0], kep[1], kep[2], kep[3]}; kt[1] = (u32x4){kep[4], kep[5], kep[6], kep[7]}; }
            if (seg == 0) FACD[(size_t)u * 128 + d] = fexp(gend);
            __syncthreads();
            { const int cb = wave & 3, half = wave >> 2;
              bf16x8 qfr[4];
#pragma unroll
              for (int ks = 0; ks < 4; ++ks) qfr[ks] = *(const LAS bf16x8*)(lds + GP_QM + (16 * cb + fr) * 272 + (8 * g + 32 * ks) * 2);
              f32x4 AT[4];
#pragma unroll
              for (int sb = 0; sb < 4; ++sb) { AT[sb] = (f32x4){0.f, 0.f, 0.f, 0.f};
#pragma unroll
                  for (int ks = 0; ks < 4; ++ks) { const bf16x8 af = *(const LAS bf16x8*)(lds + GP_KM + (16 * sb + fr) * 272 + (8 * g + 32 * ks) * 2);
                      AT[sb] = __builtin_amdgcn_mfma_f32_16x16x32_bf16(af, qfr[ks], AT[sb], 0, 0, 0); }
                  const int c = 16 * cb + fr;
#pragma unroll
                  for (int ii = 0; ii < 4; ++ii) { const int sp = 16 * sb + 4 * g + ii; const bool keep = dir ? (sp >= c) : (sp <= c); AT[sb][ii] = keep ? AT[sb][ii] : 0.f; } }
              bf16x8 pf[2];
#pragma unroll
              for (int t = 0; t < 2; ++t) { u32x4 w; w.x = pk2(AT[2 * t][0], AT[2 * t][1]); w.y = pk2(AT[2 * t][2], AT[2 * t][3]); w.z = pk2(AT[2 * t + 1][0], AT[2 * t + 1][1]); w.w = pk2(AT[2 * t + 1][2], AT[2 * t + 1][3]);
                  pf[t] = __builtin_bit_cast(bf16x8, w); }
#pragma unroll
              for (int v8 = 0; v8 < 8; ++v8) { const int vb = 8 * half + v8; f32x4 Oa = (f32x4){0.f, 0.f, 0.f, 0.f};
#pragma unroll
                  for (int t = 0; t < 2; ++t) { const LAS unsigned char* vp = lds + GP_VT + (16 * vb + fr) * 144 + (32 * t + 4 * g) * 2;
                      const u32x2 lo = *(const LAS u32x2*)vp, hi = *(const LAS u32x2*)(vp + 32);
                      u32x4 w; w.x = lo.x; w.y = lo.y; w.z = hi.x; w.w = hi.y;
                      Oa = __builtin_amdgcn_mfma_f32_16x16x32_bf16(__builtin_bit_cast(bf16x8, w), pf[t], Oa, 0, 0, 0); }
                  u32x2 w; w.x = pk2(Oa[0], Oa[1]); w.y = pk2(Oa[2], Oa[3]);
                  *(u32x2*)(OUT + (size_t)(row0 + 16 * cb + fr) * D + hh * 256 + 16 * vb + 4 * g) = w; }
            }
            __syncthreads();
        }
#undef GP_LOAD
#undef GP_N
    }
}

constexpr int GS_BUF = 45056, GS_QG = 0, GS_KET = 17408, GS_VT = 35840, GS_ST = 2 * GS_BUF, GS_DEC = GS_ST + 2 * 17408;
__device__ __forceinline__ void phase_gla(const bf16* VGT, bf16* OF, bf16* OB, const bf16* QG, const bf16* KET, const float* FACD,
                                          LAS unsigned char* lds, int tid, int lane, int wave, int vcu, int G) {
    const int fr = lane & 15, g = lane >> 4;
    for (int u = vcu; u < 256; u += G) {
        const int slab = u & 3, dir = (u >> 2) & 1, hh = (u >> 3) & 3, b = u >> 5;
        bf16* OUT = dir ? OB : OF;
        const int upb = ((b * 4 + hh) * 2 + dir) * 36;
        f32x4 Sacc[4];
#pragma unroll
        for (int vb = 0; vb < 4; ++vb) Sacc[vb] = (f32x4){0.f, 0.f, 0.f, 0.f};
        for (int i = tid; i < 17408 / 4; i += 512) ((LAS unsigned*)(lds + GS_ST))[i] = 0u;
        const bf16* vtb = VGT + ((size_t)(b * 4 + hh) * 256 + slab * 64) * NKEY;
        const int cb = wave & 3, vh = wave >> 2;
        const int ocol = hh * 256 + slab * 64 + 32 * vh + 4 * g;
        struct GsRegs { u32x4 qg[2], ket[2], v; u32x2 oi[2]; float dec; };
        GsRegs R0, R1; R0.dec = 0.f; R1.dec = 0.f;
#define GS_LOAD(R, n) do { int _row0, _tok0; gla_chunk_rows(b, dir, (n), _row0, _tok0); const size_t _u = (size_t)(upb + (n)); \
        _Pragma("unroll") for (int j = 0; j < 2; ++j) { const int idx = tid + 512 * j; R.qg[j] = *(const u32x4*)(QG + _u * 8192 + idx * 8); R.ket[j] = *(const u32x4*)(KET + _u * 8192 + idx * 8); } \
        R.v = *(const u32x4*)(vtb + (size_t)(tid >> 3) * NKEY + _tok0 + (tid & 7) * 8); \
        if (tid < 128) R.dec = FACD[_u * 128 + tid]; \
        _Pragma("unroll") for (int v2 = 0; v2 < 2; ++v2) R.oi[v2] = *(const u32x2*)(OUT + (size_t)(_row0 + 16 * cb + fr) * D + ocol + 16 * v2); } while (0)
#define GS_STORE(R, bf) do { LAS unsigned char* _p = lds + (bf) * GS_BUF; \
        _Pragma("unroll") for (int j = 0; j < 2; ++j) { const int idx = tid + 512 * j; *(LAS u32x4*)(_p + GS_QG + (idx >> 4) * 272 + (idx & 15) * 16) = R.qg[j]; *(LAS u32x4*)(_p + GS_KET + (idx >> 3) * 144 + (idx & 7) * 16) = R.ket[j]; } \
        *(LAS u32x4*)(_p + GS_VT + (tid >> 3) * 144 + (tid & 7) * 16) = R.v; \
        if (tid < 128) ((LAS float*)(lds + GS_DEC))[(bf) * 128 + tid] = R.dec; } while (0)
#define GS_ITER(n, RN, RF) do { const int _n = (n); int row0, tok0; gla_chunk_rows(b, dir, _n, row0, tok0); const int cur = _n & 1; \
            if (_n + 2 < 36) GS_LOAD(RF, _n + 2); \
            const LAS unsigned char* bufp = lds + cur * GS_BUF; const LAS unsigned char* stp = lds + GS_ST + cur * 17408; \
            { bf16x8 qfr[4]; \
              _Pragma("unroll") for (int ks = 0; ks < 4; ++ks) qfr[ks] = *(const LAS bf16x8*)(bufp + GS_QG + (16 * cb + fr) * 272 + (8 * g + 32 * ks) * 2); \
              _Pragma("unroll") for (int v2 = 0; v2 < 2; ++v2) { const int vb = 2 * vh + v2; const u32x2 oin = v2 ? oc1 : oc0; \
                  f32x4 Oa = (f32x4){bflo(oin.x), bfhi(oin.x), bflo(oin.y), bfhi(oin.y)}; \
                  _Pragma("unroll") for (int ks = 0; ks < 4; ++ks) { const bf16x8 af = *(const LAS bf16x8*)(stp + (16 * vb + fr) * 272 + (8 * g + 32 * ks) * 2); \
                      Oa = __builtin_amdgcn_mfma_f32_16x16x32_bf16(af, qfr[ks], Oa, 0, 0, 0); } \
                  u32x2 w; w.x = pk2(Oa[0], Oa[1]); w.y = pk2(Oa[2], Oa[3]); \
                  *(u32x2*)(OUT + (size_t)(row0 + 16 * cb + fr) * D + ocol + 16 * v2) = w; } } \
            { const f32x4 dec = *(const LAS f32x4*)((LAS float*)(lds + GS_DEC) + cur * 128 + 16 * wave + 4 * g); \
              LAS unsigned char* stn = lds + GS_ST + (cur ^ 1) * 17408; \
              _Pragma("unroll") for (int vb = 0; vb < 4; ++vb) { Sacc[vb] = Sacc[vb] * dec; \
                  _Pragma("unroll") for (int t = 0; t < 2; ++t) { const bf16x8 af = *(const LAS bf16x8*)(bufp + GS_KET + (16 * wave + fr) * 144 + (8 * g + 32 * t) * 2); \
                      const bf16x8 bfr = *(const LAS bf16x8*)(bufp + GS_VT + (16 * vb + fr) * 144 + (8 * g + 32 * t) * 2); \
                      Sacc[vb] = __builtin_amdgcn_mfma_f32_16x16x32_bf16(af, bfr, Sacc[vb], 0, 0, 0); } \
                  u32x2 w; w.x = pk2(Sacc[vb][0], Sacc[vb][1]); w.y = pk2(Sacc[vb][2], Sacc[vb][3]); \
                  *(LAS u32x2*)(stn + (16 * vb + fr) * 272 + (16 * wave + 4 * g) * 2) = w; } } \
            if (_n + 1 < 36) { GS_STORE(RN, cur ^ 1); oc0 = RN.oi[0]; oc1 = RN.oi[1]; } \
            __syncthreads(); } while (0)
        GS_LOAD(R0, 0); GS_STORE(R0, 0);
        u32x2 oc0 = R0.oi[0], oc1 = R0.oi[1];
        GS_LOAD(R0, 1);
        __syncthreads();
        for (int n = 0; n < 36; n += 2) { GS_ITER(n, R0, R1); GS_ITER(n + 1, R1, R0); }
#undef GS_ITER
#undef GS_LOAD
#undef GS_STORE
    }
}

constexpr int N_PHASES = 34;
typedef const Args __attribute__((address_space(4)))* KArgs;
__device__ __forceinline__ KArgs kargs() { KArgs p = (KArgs)__builtin_amdgcn_kernarg_segment_ptr(); asm volatile("" : "+s"(p)); return p; }
__global__ void __launch_bounds__(512, 2) fwd(Args a_unused) {
    extern __shared__ __attribute__((aligned(16))) unsigned char lds_raw[];
    LAS unsigned char* lds = (LAS unsigned char*)lds_raw;
    const int tid0 = threadIdx.x;
    const int G0 = gridDim.x; const int bx0 = blockIdx.x;
#define PH_ENTRY int tid = tid0; asm volatile("" : "+v"(tid)); int G = G0, bx = bx0; asm volatile("" : "+s"(G), "+s"(bx)); const int lane = tid & 63, wave = __builtin_amdgcn_readfirstlane(tid >> 6); \
        const int vcu = (G % 8 == 0) ? (bx % 8) * (G / 8) + bx / 8 : bx; (void)lane; (void)wave; (void)vcu
    const int tid = tid0;
    const int ph_lo = kargs()->ph_lo, ph_hi = kargs()->ph_hi;
    const int repmask = kargs()->rep;
    if (tid < 64) ((LAS unsigned*)(lds + LX_MISC))[tid] = 0u;
    for (int i = tid; i < 1024; i += 512) { const int pos = i >> 4, f = i & 15; const float inv = __builtin_amdgcn_exp2f(-(float)f * (13.287712379549449f / 16.0f)); const float ang = (float)pos * inv;
        ((LAS float*)(lds + LX_ROPE))[2 * i] = __cosf(ang); ((LAS float*)(lds + LX_ROPE))[2 * i + 1] = __sinf(ang); }
    __syncthreads();
    const bool single = (ph_hi - ph_lo) > 1;
    XcdBarrier bar; bar.bar = (unsigned*)(kargs()->ws + WS_CTL) + CW_BAR; bar.x = 0; bar.st = (volatile LAS unsigned*)(lds + LX_MISC);
    if (single) bar = xcd_barrier_post((unsigned*)(kargs()->ws + WS_CTL) + CW_BAR, (volatile LAS unsigned*)(lds + LX_MISC));
#define IN(k) (ph_lo <= (k) && (k) < ph_hi)
#define REPLOOP(t) for (int rep_ = 0, nrep_ = 1 + ((repmask >> (t)) & 1); rep_ < nrep_; ++rep_, (rep_ < nrep_ ? (bar.bar = (unsigned*)(kargs()->ws + WS_CTL) + CW_BAR, xcd_barrier(bar)) : (void)0))
#define SEAM(k) do { if (IN(k) && IN((k) + 1)) { bar.bar = (unsigned*)(kargs()->ws + WS_CTL) + CW_BAR; xcd_barrier(bar); if ((repmask >> 10) & 1) xcd_barrier(bar); } } while (0)
    LAS int* tab = (LAS int*)(lds + LX_MOETAB);
#define CONV_PTRS(A) ConvPtrs{(A)->att_w_in, (A)->att_w_out, (A)->gla_w_in, (A)->gla_w_out, (A)->moe_w1, (A)->moe_w3, (A)->moe_w2, (A)->ws}

    if (IN(0)) REPLOOP(0) { PH_ENTRY; p0_prologue(kargs(), lds, tid, lane, wave, vcu, G); } SEAM(0);
    if (IN(1)) { PH_ENTRY; KArgs A = kargs(); unsigned char* ws = A->ws; phase_norm1(A->x, A->ctx, A->norm_g, (float*)(ws + WS_MODV), (bf16*)(ws + WS_H), TALL, lane, wave, vcu, G); } SEAM(1);

#pragma nounroll
    for (int L = 0; L < 4; ++L) {
        const int pb = 2 + 8 * L; const bool isattn = !(L & 1); const int j = L >> 1; const bool lastL = (L == 3);
        const int nrows = lastL ? TX : TALL;
        if (IN(pb)) REPLOOP(isattn ? 1 : 3) {
            PH_ENTRY; KArgs A = kargs(); unsigned char* ws = A->ws; unsigned char* big = ws + WS_BIG; const bf16* H = (const bf16*)(ws + WS_H);
            if (isattn) {
                pg8::DenseOrder S; S.init(H, (const bf16*)(ws + WS_WATTIN) + (size_t)j * NATT * D, TALL, NATT, D, G, bx);
                pg8::EpiAttnIn E{(bf16*)(big + BG_QKV), (bf16*)(big + BG_VAT), (bf16*)(big + BG_VBT), (const LAS float*)(lds + LX_ROPE)};
                pg8::gemm_phase<pg8::EpiAttnIn, pg8::DenseOrder, false>(lds, tid, D, S, E);
            } else {
                pg8::DenseOrder S; S.init(H, (const bf16*)(ws + WS_WGLAIN) + (size_t)j * NGLA * D, TALL, NGLA, D, G, bx);
                pg8::EpiGlaIn E{(bf16*)(big + BG_QKV2), (bf16*)(big + BG_VGT)};
                pg8::gemm_phase<pg8::EpiGlaIn, pg8::DenseOrder, false>(lds, tid, D, S, E);
            }
        }
        SEAM(pb);
        if (!isattn && IN(pb + 1)) {
            for (int rep_ = 0; rep_ <= ((repmask >> 13) & 1); ++rep_)
            { PH_ENTRY; KArgs A = kargs(); unsigned char* ws = A->ws;
              phase_gla_prep((const bf16*)(ws + WS_BIG + BG_QKV2), (const bf16*)(ws + WS_BIG + BG_VGT), A->gla_w_gate + j * 2 * 16 * 512, A->gla_b_gate + j * 2 * 512,
                             (bf16*)(ws + WS_QG), (bf16*)(ws + WS_KET), (float*)(ws + WS_BIG + BG_FAC), (bf16*)(ws + WS_BIG + BG_OF), (bf16*)(ws + WS_BIG + BG_OB), lds, tid, lane, wave, vcu, G); }
            if (single) { bar.bar = (unsigned*)(kargs()->ws + WS_CTL) + CW_BAR; xcd_barrier(bar); }
        }
        if (IN(pb + 1)) REPLOOP(isattn ? 2 : 4) {
            PH_ENTRY; KArgs A = kargs(); unsigned char* ws = A->ws; unsigned char* big = ws + WS_BIG; bf16* AOUT = (bf16*)(ws + WS_AOUT);
            if (isattn) { const ConvPtrs CP = CONV_PTRS(A);
                phase_attention((const bf16*)(big + BG_QKV), (const bf16*)(big + BG_VAT), (const bf16*)(big + BG_VBT), AOUT, A->att_lambda + j * 256, (L == 0) ? 0.2f : 0.470713018f,
                                A->att_subln_g + j * 128, A->na_bias + j * 8 * 465, (unsigned*)(ws + WS_CTL) + CW_NAQ + 64 * j, CP,
                                MK_CONVQ ? (L == 0 ? CT_ATTN0 : CT_MOE1) : 0, MK_CONVQ ? (L == 0 ? CT_MOE1 : CT_MOE3) : 0, lds, tid, lane, wave); }
            else phase_gla((const bf16*)(big + BG_VGT), (bf16*)(big + BG_OF), (bf16*)(big + BG_OB), (const bf16*)(ws + WS_QG), (const bf16*)(ws + WS_KET), (const float*)(big + BG_FAC),
                           lds, tid, lane, wave, vcu, G);
        }
        SEAM(pb + 1);
        if (!isattn) {
            if (IN(pb + 2)) REPLOOP(5) { PH_ENTRY; KArgs A = kargs(); unsigned char* ws = A->ws; unsigned char* big = ws + WS_BIG;
                phase_readout((const bf16*)(big + BG_OF), (const bf16*)(big + BG_OB), (const bf16*)(big + BG_QKV2), A->gla_norm_g + j * 256, (bf16*)(ws + WS_AOUT), nrows, lane, wave, vcu, G); }
            SEAM(pb + 2);
        }
        if (IN(pb + 3)) {
            PH_ENTRY; KArgs A = kargs(); unsigned char* ws = A->ws;
            pg8::DenseOrder S; S.init((const bf16*)(ws + WS_AOUT), (const bf16*)(ws + (isattn ? WS_WATTOUT : WS_WGLAOUT)) + (size_t)j * D * D, nrows, D, D, G, bx);
            if (L == 0) { pg8::EpiResid<true> E{A->x, A->ctx, (bf16*)(ws + WS_XB), (const float*)(ws + WS_MODV) + (size_t)L * 9 * 6144 + 2048};
                pg8::gemm_phase<pg8::EpiResid<true>, pg8::DenseOrder, false>(lds, tid, D, S, E); }
            else { pg8::EpiResid<false> E{nullptr, nullptr, (bf16*)(ws + WS_XB), (const float*)(ws + WS_MODV) + (size_t)L * 9 * 6144 + 2048};
                pg8::gemm_phase<pg8::EpiResid<false>, pg8::DenseOrder, false>(lds, tid, D, S, E); }
        }
        SEAM(pb + 3);
        if (IN(pb + 4)) { PH_ENTRY; KArgs A = kargs(); unsigned char* ws = A->ws;
            phase_router((const bf16*)(ws + WS_XB), A->norm_g + (L * 2 + 1) * D, (const float*)(ws + WS_MODV) + (size_t)L * 9 * 6144, (bf16*)(ws + WS_H), A->router_w, A->router_bias,
                         (unsigned*)(ws + WS_CTL) + CW_CNT + L * 16 * 64, (int*)(ws + WS_LIST), (int*)(ws + WS_TOKI), (float*)(ws + WS_TOKW), nrows, lds, tid, lane, wave, vcu, G, (repmask >> 11) & 1); }
        SEAM(pb + 4);
        if (IN(pb + 5)) REPLOOP(6) {
            PH_ENTRY; KArgs A = kargs(); unsigned char* ws = A->ws;
            const int RT = build_moe_table((unsigned*)(ws + WS_CTL) + CW_CNT + L * 16 * 64, tab, tid);
            pg8::MoeOrder S; S.A = (const char*)(ws + WS_H); S.B = (const char*)(ws + WS_W13) + (size_t)L * 16 * D * D * 2; S.K = D; S.bstride = (size_t)D * D * 2; S.tab = tab; S.list = (const int*)(ws + WS_LIST); S.RT = RT; S.nwg = RT * 4; S.G = G; S.c = bx;
            S.fill_tokc((LAS int*)(lds + LX_BIAS), tid);
            pg8::EpiMoe1 E{(bf16*)(ws + WS_BIG + BG_HB)};
            pg8::gemm_phase<pg8::EpiMoe1, pg8::MoeOrder, true>(lds, tid, D, S, E);
        }
        SEAM(pb + 5);
        if (IN(pb + 6)) REPLOOP(7) {
            PH_ENTRY; KArgs A = kargs(); unsigned char* ws = A->ws;
            const int RT = single ? tab[RT_MAX] : build_moe_table((unsigned*)(ws + WS_CTL) + CW_CNT + L * 16 * 64, tab, tid);
            pg8::MoeOrder S; S.A = (const char*)(ws + WS_BIG + BG_HB); S.B = (const char*)(ws + WS_W2) + (size_t)L * 16 * D * DEXP * 2; S.K = DEXP; S.bstride = (size_t)D * DEXP * 2; S.tab = tab; S.list = (const int*)(ws + WS_LIST); S.RT = RT; S.nwg = RT * 4; S.G = G; S.c = bx;
            pg8::EpiBf16 E{(bf16*)(ws + WS_BIG + BG_YB), D};
            pg8::gemm_phase<pg8::EpiBf16, pg8::MoeOrder, false>(lds, tid, DEXP, S, E);
        }
        SEAM(pb + 6);
        if (IN(pb + 7)) { PH_ENTRY; KArgs A = kargs(); unsigned char* ws = A->ws; const float* MODV = (const float*)(ws + WS_MODV);
            if (lastL) phase_combine<true>((bf16*)(ws + WS_XB), A->out, MODV + (size_t)L * 9 * 6144, (const bf16*)(ws + WS_BIG + BG_YB), (unsigned*)(ws + WS_CTL) + CW_CNT + L * 16 * 64, (const int*)(ws + WS_TOKI), (const float*)(ws + WS_TOKW),
                                           A->final_g, MODV + (size_t)L * 9 * 6144, (bf16*)(ws + WS_H), nrows, lane, wave, vcu, G);
            else phase_combine<false>((bf16*)(ws + WS_XB), A->out, MODV + (size_t)L * 9 * 6144, (const bf16*)(ws + WS_BIG + BG_YB), (unsigned*)(ws + WS_CTL) + CW_CNT + L * 16 * 64, (const int*)(ws + WS_TOKI), (const float*)(ws + WS_TOKW),
                                      A->norm_g + ((L + 1) * 2) * D, MODV + (size_t)(L + 1) * 9 * 6144, (bf16*)(ws + WS_H), nrows, lane, wave, vcu, G); }
        if (!lastL) SEAM(pb + 7);
    }
#undef IN
#undef REPLOOP
#undef SEAM
#undef CONV_PTRS

#undef PH_ENTRY
}

extern "C" void kernel_launch(void* const* d_in, const int* in_sizes, int n_in, void* d_out, int out_size, void* d_ws, size_t ws_size, hipStream_t stream) {
    static int ready = 0;
    if (ready == 0) {
        if (n_in != 23 || out_size != TX * D || ws_size < WS_END) { fprintf(stderr, "kernel_launch: unexpected shapes (n_in %d out %d ws %zu)\n", n_in, out_size, ws_size); ready = -1; return; }
        if (hipFuncSetAttribute((const void*)fwd, hipFuncAttributeMaxDynamicSharedMemorySize, LDS_BYTES) != hipSuccess) { fprintf(stderr, "kernel_launch: hipFuncSetAttribute failed\n"); ready = -1; return; }
        int per_cu = 0; (void)hipOccupancyMaxActiveBlocksPerMultiprocessor(&per_cu, (const void*)fwd, 512, LDS_BYTES); (void)hipGetLastError();
        if (per_cu < 1) fprintf(stderr, "kernel_launch: occupancy query reports %d blocks per CU\n", per_cu);
        ready = 1;
    }
    if (ready < 0) return;
    (void)hipMemsetAsync((char*)d_ws + WS_CTL, 0, CTL_ZERO_BYTES, stream);
    Args a{};
    const float** ap = (const float**)&a;
    for (int i = 0; i < 23; ++i) ap[i] = (const float*)d_in[i];
    a.out = (float*)d_out; a.ws = (unsigned char*)d_ws;
    const int grid = 256;
    a.ph_lo = 0; a.ph_hi = N_PHASES; a.rep = MK_REPMASK;
    hipLaunchKernelGGL(fwd, dim3(grid), dim3(512), LDS_BYTES, stream, a);
}
```

```cpp
#include <hip/hip_runtime.h>
#include <cstdio>
#include <cstdint>

#ifndef MK_CONVQ
#define MK_CONVQ 1
#endif
#ifndef MK_REPMASK
#define MK_REPMASK 0
#endif

#define GAS __attribute__((address_space(1)))
#define LAS __attribute__((address_space(3)))
typedef unsigned short bf16;
typedef short bf16x8 __attribute__((ext_vector_type(8)));
typedef short bf16x4 __attribute__((ext_vector_type(4)));
typedef float f32x4 __attribute__((ext_vector_type(4)));
typedef float f32x2 __attribute__((ext_vector_type(2)));
typedef unsigned u32x4 __attribute__((ext_vector_type(4)));
typedef unsigned u32x2 __attribute__((ext_vector_type(2)));

constexpr int D = 1024, NB = 8, SEQ = 2048, CTXL = 256;
constexpr int TX = NB * SEQ, TC = NB * CTXL, TALL = TX + TC;
constexpr int NKEY = SEQ + CTXL;
constexpr int NATT = 3072, NGLA = 3328;
constexpr float EPSF = 1e-6f;
constexpr float LOG2E = 1.4426950408889634f;
constexpr int NEXP = 16, DEXP = 512;
constexpr int RT_MAX = 160;

constexpr size_t MiB = 1u << 20;
constexpr size_t WS_CTL = 0, CTL_ZERO_BYTES = 65536;
constexpr size_t WS_MODV = 1 * MiB;
constexpr size_t WS_TOKI = 2 * MiB;
constexpr size_t WS_TOKW = 2 * MiB + 512 * 1024;
constexpr size_t WS_LIST = 3 * MiB;
constexpr size_t WS_CTX = 5 * MiB;
constexpr size_t WS_WATTIN = 13 * MiB;
constexpr size_t WS_WATTOUT = 25 * MiB;
constexpr size_t WS_WGLAIN = 29 * MiB;
constexpr size_t WS_WGLAOUT = 42 * MiB;
constexpr size_t WS_W13 = 46 * MiB;
constexpr size_t WS_W2 = 174 * MiB;
constexpr size_t WS_H = 238 * MiB;
constexpr size_t WS_AOUT = 274 * MiB;
constexpr size_t WS_BIG = 310 * MiB;
constexpr size_t WS_XB = 539 * MiB;
constexpr size_t WS_END = 575 * MiB;
constexpr size_t BG_QKV = 0;
constexpr size_t BG_VAT = 108 * MiB;
constexpr size_t BG_VBT = 126 * MiB;
constexpr size_t BG_QKV2 = 0;
constexpr size_t BG_VGT = 117 * MiB;
constexpr size_t BG_OF = 153 * MiB;
constexpr size_t BG_OB = 189 * MiB;
constexpr size_t BG_FAC = 225 * MiB;
constexpr size_t WS_QG = WS_H, WS_KET = WS_AOUT;
constexpr size_t BG_HB = 0;
constexpr size_t BG_YB = 40 * MiB;
constexpr int CW_TMO = 0;
constexpr int CW_BAR = 4096;
constexpr int CW_NAQ = 15360;
constexpr int CW_CNT = 8192;

constexpr int RING_BYTES = 131072;
constexpr int LX_OFF = RING_BYTES;
constexpr int LX_MISC = LX_OFF;
constexpr int LX_MOETAB = LX_OFF + 256;
constexpr int LX_ROPE = LX_OFF + 2048;
constexpr int LX_BIAS = LX_OFF + 2048 + 8192;
constexpr int LDS_BYTES = 147456;

#define LDS_WAIT() asm volatile("s_waitcnt lgkmcnt(0)" ::: "memory")
#define VM_WAIT() asm volatile("s_waitcnt vmcnt(0)" ::: "memory")
#define RLX_AGENT __ATOMIC_RELAXED, __HIP_MEMORY_SCOPE_AGENT
__device__ __forceinline__ unsigned f2bf(float f) { unsigned u = __builtin_bit_cast(unsigned, f); return (u + 0x7fffu + ((u >> 16) & 1u)) >> 16; }
typedef __bf16 hwbf16x2 __attribute__((ext_vector_type(2)));
__device__ __forceinline__ unsigned cvtpk(float lo, float hi) { const f32x2 v = {lo, hi}; const hwbf16x2 b = __builtin_convertvector(v, hwbf16x2); return __builtin_bit_cast(unsigned, b); }
__device__ __forceinline__ unsigned pk2(float lo, float hi) { return cvtpk(lo, hi); }
__device__ __forceinline__ float bf2f(unsigned short b) { return __builtin_bit_cast(float, ((unsigned)b) << 16); }
__device__ __forceinline__ float bflo(unsigned w) { return __builtin_bit_cast(float, w << 16); }
__device__ __forceinline__ float bfhi(unsigned w) { return __builtin_bit_cast(float, w & 0xffff0000u); }
template <int CTRL> __device__ __forceinline__ float dppf(float v) { return __builtin_bit_cast(float, __builtin_amdgcn_update_dpp(0, __builtin_bit_cast(int, v), CTRL, 0xf, 0xf, true)); }
__device__ __forceinline__ float row_sum(float v) { v += dppf<0xB1>(v); v += dppf<0x4E>(v); v += dppf<0x124>(v); v += dppf<0x128>(v); return v; }
__device__ __forceinline__ float swap16_add(float a, float b) { auto r = __builtin_amdgcn_permlane16_swap(__float_as_uint(a), __float_as_uint(b), false, false); const unsigned r0 = r[0], r1 = r[1]; return __uint_as_float(r0) + __uint_as_float(r1); }
__device__ __forceinline__ float swap32_add(float a, float b) { auto r = __builtin_amdgcn_permlane32_swap(__float_as_uint(a), __float_as_uint(b), false, false); const unsigned r0 = r[0], r1 = r[1]; return __uint_as_float(r0) + __uint_as_float(r1); }
__device__ __forceinline__ float swap16_max(float a) { auto r = __builtin_amdgcn_permlane16_swap(__float_as_uint(a), __float_as_uint(a), false, false); const unsigned r0 = r[0], r1 = r[1]; return fmaxf(__uint_as_float(r0), __uint_as_float(r1)); }
__device__ __forceinline__ float swap32_max(float a) { auto r = __builtin_amdgcn_permlane32_swap(__float_as_uint(a), __float_as_uint(a), false, false); const unsigned r0 = r[0], r1 = r[1]; return fmaxf(__uint_as_float(r0), __uint_as_float(r1)); }
__device__ __forceinline__ float readlane_f(float v, int l) { return __int_as_float(__builtin_amdgcn_readlane(__float_as_int(v), l)); }
__device__ __forceinline__ float wave_sum(float v) { v = row_sum(v); v = swap16_add(v, v); return swap32_add(v, v); }
__device__ __forceinline__ float fexp2(float x) { return __builtin_amdgcn_exp2f(x); }
__device__ __forceinline__ float fexp(float x) { return __builtin_amdgcn_exp2f(x * LOG2E); }
__device__ __forceinline__ float flog(float x) { return __builtin_amdgcn_logf(x) * 0.6931471805599453f; }
__device__ __forceinline__ float frcp(float x) { return __builtin_amdgcn_rcpf(x); }
__device__ __forceinline__ float silu_f(float x) { return x * frcp(1.0f + fexp(-x)); }

#define XB_TMO      128
#define XB_XCNT(j)  (256  + 64 * (j))
#define XB_XSUB(j)  (1280 + 64 * (j))
#define XB_XGEN(j)  (2304 + 64 * (j))
#define XB_TOP      3328
#define XB_TOPGEN   3392
#define XCD_BAR_WORDS 3456
#define XB_SPIN_CAP (1u << 18)
__device__ __forceinline__ unsigned xb_ld(unsigned* p)              { return __hip_atomic_load(p, __ATOMIC_RELAXED, __HIP_MEMORY_SCOPE_AGENT); }
__device__ __forceinline__ unsigned xb_add(unsigned* p, unsigned v) { return __hip_atomic_fetch_add(p, v, __ATOMIC_RELAXED, __HIP_MEMORY_SCOPE_AGENT); }
__device__ __forceinline__ unsigned xb_xcc_id() { return (unsigned)__builtin_amdgcn_s_getreg((3 << 11) | 20) & 0xFu; }
#define XB_SPIN(cond, bar) do { unsigned _sp = 0; while (cond) { __builtin_amdgcn_s_sleep(1); \
    if ((++_sp & 255u) == 0u) { if (xb_ld(&(bar)[XB_TMO])) break; if (_sp > XB_SPIN_CAP) { atomicAdd(&(bar)[XB_TMO], 1u); break; } } } } while (0)
struct XcdBarrier { unsigned* bar; unsigned x; volatile LAS unsigned* st; };
__device__ __forceinline__ XcdBarrier xcd_barrier_post(unsigned* bar, volatile LAS unsigned* st) {
    XcdBarrier b; b.bar = bar; b.x = xb_xcc_id(); b.st = st;
    if (threadIdx.x == 0) (void)xb_add(&bar[XB_XCNT(b.x)], 1u);
    return b;
}
__device__ __forceinline__ void xcd_barrier_complete(unsigned* bar, unsigned x, unsigned& nloc, unsigned& nx) {
    const unsigned G = gridDim.x * gridDim.y * gridDim.z;
    unsigned sum, cnt, mine, sp = 0u;
    for (;;) {
        sum = 0u; cnt = 0u; mine = 0u;
#pragma unroll
        for (unsigned j = 0; j < 16; ++j) { const unsigned c = xb_ld(&bar[XB_XCNT(j)]); sum += c; cnt += (c > 0u) ? 1u : 0u; mine = (j == x) ? c : mine; }
        if (sum == G) break;
        __builtin_amdgcn_s_sleep(1);
        if ((++sp & 255u) == 0u) { if (xb_ld(&bar[XB_TMO])) break; if (sp > XB_SPIN_CAP) { atomicAdd(&bar[XB_TMO], 1u); break; } }
    }
    nloc = mine > 0u ? mine : 1u; nx = cnt > 0u ? cnt : 1u;
}
__device__ __forceinline__ void xcd_barrier_setup(const XcdBarrier& b) {
    if (threadIdx.x == 0) { unsigned nloc, nx; xcd_barrier_complete(b.bar, b.x, nloc, nx); b.st[0] = nloc; b.st[1] = nx; }
    __syncthreads();
}
__device__ __forceinline__ void xcd_barrier(const XcdBarrier& b_) {
    XcdBarrier b = b_; asm volatile("" : "+s"(b.x));
    asm volatile("s_waitcnt vmcnt(0)" ::: "memory");
    __syncthreads();
    if (threadIdx.x == 0) {
        unsigned* bar = b.bar;
        __builtin_amdgcn_s_waitcnt(0);
        const unsigned nloc = b.st[0], nx = b.st[1];
        const unsigned old = xb_add(&bar[XB_XSUB(b.x)], 1u);
        const unsigned gen = old / nloc;
        if (old + 1u == (gen + 1u) * nloc) {
            __builtin_amdgcn_fence(__ATOMIC_RELEASE, "agent");
            asm volatile("s_waitcnt vmcnt(0)" ::: "memory");
            const unsigned og = xb_add(&bar[XB_TOP], 1u);
            const unsigned tg = og / nx;
            if (og + 1u == (tg + 1u) * nx) xb_add(&bar[XB_TOPGEN], 1u);
            else XB_SPIN(xb_ld(&bar[XB_TOPGEN]) == tg, bar);
            __builtin_amdgcn_fence(__ATOMIC_ACQUIRE, "agent");
            xb_add(&bar[XB_XGEN(b.x)], 1u);
            asm volatile("s_waitcnt vmcnt(0)" ::: "memory");
        } else {
            XB_SPIN(xb_ld(&bar[XB_XGEN(b.x)]) == gen, bar);
            __builtin_amdgcn_fence(__ATOMIC_ACQUIRE, "agent");
            asm volatile("s_waitcnt vmcnt(0)" ::: "memory");
        }
    }
    __syncthreads();
}

namespace pg8 {
constexpr int BM = 256, BK = 64, HALF = 128, HTB = HALF * BK * 2, STAGE_BYTES = 8 * HTB, NXCD = 8, WGM = 8;
__host__ __device__ __forceinline__ int lds_byte(int r, int c) { const int st = (r >> 4) * 2 + (c >> 5), rr = r & 15, cc = c & 31, ob = rr * 64 + cc * 2; return st * 1024 + (ob ^ (((ob >> 9) & 1) << 5)); }
__host__ __device__ __forceinline__ void stage_rc(int b, int& R, int& C) { const int st = b / 1024, sb = b % 1024, swz = sb ^ (((sb >> 9) & 1) << 5); R = (st >> 1) * 16 + swz / 64; C = (st & 1) * 32 + (swz % 64) / 2; }
__host__ __device__ __forceinline__ int perm32(int rho) { const int n = rho >> 4, i = rho & 15; return 8 * (i >> 2) + 4 * n + (i & 3); }

struct Unit { int pm, pn, e, mt, roff, nai, ord; };
__device__ __forceinline__ bool split_index(long L, int nwg, int G, int& uidx, int& roff, int& nai) {
    const int R = nwg / G, r = nwg % G;
    if (L < (long)R * G || r == 0) { if (L >= nwg) return false; uidx = (int)L; roff = 0; nai = 2; return true; }
    const int t = (int)(L - (long)R * G), nf = (2 * r > G) ? 2 * r - G : 0, nh = 2 * (r - nf);
    if (t < nf) { uidx = R * G + t; roff = 0; nai = 2; return true; }
    const int h = t - nf; if (h >= nh) return false; uidx = R * G + nf + (h >> 1); roff = (h & 1) * 128; nai = 1; return true;
}

__device__ __forceinline__ int stagger_index(int i, int nwg, int G, int c) {
    const int R = nwg / G, r = nwg % G, nf = (2 * r > G) ? 2 * r - G : 0, nh = 2 * (r - nf);
    if (r > 0 && c >= nf && c < nf + nh && ((c >> 3) & 1)) return (i == 0) ? R : (i <= R ? i - 1 : i);
    return i;
}
__device__ __forceinline__ int xcd_remap(int wgid, int nwg) { const int q = nwg / NXCD, r = nwg % NXCD, xcd = wgid % NXCD, off = wgid / NXCD; return (xcd < r ? xcd * (q + 1) : r * (q + 1) + (xcd - r) * q) + off; }

struct DenseOrder {
    const char* A; const char* B; int K; int nM, nN, nwg, G, c;
    __device__ __forceinline__ void init(const bf16* A_, const bf16* B_, int M, int N, int K_, int G_, int c_) { A = (const char*)A_; B = (const char*)B_; K = K_; nM = M / BM; nN = N / BM; nwg = nM * nN; G = G_; c = c_; }
    __device__ __forceinline__ bool next(int i, Unit& u) const {
        int uidx; if (!split_index((long)stagger_index(i, nwg, G, c) * G + c, nwg, G, uidx, u.roff, u.nai)) return false;
        const int wgid = xcd_remap(uidx, nwg);
        const int nig = WGM * nN, gid = wgid / nig, fm = gid * WGM, gsz = (nM - fm) < WGM ? (nM - fm) : WGM;
        u.pm = fm + ((wgid % nig) % gsz); u.pn = (wgid % nig) / gsz; u.e = 0; u.mt = 0; u.ord = i; return true;
    }
    __device__ __forceinline__ const char* a_ptr(const Unit& u) const { return A + (size_t)(u.pm * BM + u.roff) * K * 2; }
    __device__ __forceinline__ const char* b_ptr(const Unit& u) const { return B + (size_t)u.pn * BM * K * 2; }
    __device__ __forceinline__ int tok(const Unit&, int) const { return 0; }
};
struct MoeOrder {
    const char* A; const char* B; int K; size_t bstride;
    const LAS int* tab; const int* list; int RT, nwg, G, c;
    __device__ __forceinline__ bool next(int i, Unit& u) const {
        int uidx; if (!split_index((long)stagger_index(i, nwg, G, c) * G + c, nwg, G, uidx, u.roff, u.nai)) return false;
        const int wgid = xcd_remap(uidx, nwg);
        const int rt = wgid >> 2; u.pm = rt; u.pn = wgid & 3; const int t = tab[rt]; u.e = t & 255; u.mt = t >> 8; u.ord = i; return true;
    }
    __device__ __forceinline__ const char* a_ptr(const Unit& u) const { return A + (size_t)(u.pm * BM + u.roff) * K * 2; }
    __device__ __forceinline__ const char* b_ptr(const Unit& u) const { return B + (size_t)u.e * bstride + (size_t)u.pn * BM * K * 2; }
    const LAS int* tokc;
    __device__ __forceinline__ int tok(const Unit& u, int r) const { return tokc[u.ord * BM + r]; }
    __device__ __forceinline__ void fill_tokc(LAS int* dst, int tid) {
        tokc = dst;
        int val[2], idx[2]; bool ok[2];
#pragma unroll
        for (int k = 0; k < 2; ++k) { const int i = (tid >> 8) + 2 * k, r = tid & 255; Unit u; const bool has = (i < 3) && next(i, u);
            const int cnt = has ? tab[RT_MAX + 1 + u.e] : 0; const int pos = has ? u.mt * BM + u.roff + r : 0;
            ok[k] = has; idx[k] = i * BM + r;
            val[k] = list[(size_t)(has ? u.e : 0) * TALL + pos];
            val[k] = (pos < cnt) ? val[k] : 0; }
#pragma unroll
        for (int k = 0; k < 2; ++k) if (ok[k]) dst[idx[k]] = val[k];
        __syncthreads();
    }
};

__device__ __forceinline__ unsigned cvt_pk_bf16(float lo, float hi) { unsigned r; asm volatile("v_cvt_pk_bf16_f32 %0, %1, %2" : "=v"(r) : "v"(lo), "v"(hi)); return r; }

template <class Epi, class Sched, bool GATHER>
__device__ __forceinline__ void gemm_phase(LAS unsigned char* lds, const int tid, const int K, const Sched& S, const Epi& E) {
    const int wid = __builtin_amdgcn_readfirstlane(tid >> 6), lane = tid & 63, wr = wid >> 2, wc = wid & 3, fr = lane & 15, fq = lane >> 4;
    const int nt = K / BK;
    unsigned voffA[2], voffB[2]; int RA[2], CA[2];
#pragma unroll
    for (int i = 0; i < 2; ++i) { int R, C; stage_rc(tid * 16 + i * 8192, R, C); const int Rb = Epi::PERM ? ((R & ~31) + perm32(R & 31)) : R;
        RA[i] = R; CA[i] = C; voffA[i] = (unsigned)(R * K + C) * 2u; voffB[i] = (unsigned)(Rb * K + C) * 2u; }
    const size_t kstep = (size_t)(BK * 2);
    const size_t hstep = (size_t)HALF * K * 2;
    const unsigned ldsw = (unsigned)wid * 1024u;
    const int aoff = lds_byte(wr * 64 + fr, fq * 8), boff = lds_byte(wc * 32 + fr, fq * 8);
#define PG8_SA(b, h) (((b) * 2 + (h)) * HTB)
#define PG8_SB(b, h) ((4 + (b) * 2 + (h)) * HTB)
#define PG8_STAGE(bufoff, gbase, voff) do { _Pragma("unroll") for (int _i = 0; _i < 2; ++_i) \
        __builtin_amdgcn_global_load_lds((const unsigned*)((const char*)(gbase) + (voff)[_i]), (LAS unsigned*)(lds + (bufoff) + ldsw + _i * 8192), 16, 0, 0); } while (0)
#define PG8_STAGE_A(bufoff, h, usenext, koff) do { if constexpr (GATHER) { unsigned _vo[2]; _vo[0] = (usenext) ? nvA[h][0] : vA[h][0]; _vo[1] = (usenext) ? nvA[h][1] : vA[h][1]; PG8_STAGE(bufoff, S.A + (koff), _vo); } \
        else { PG8_STAGE(bufoff, ((usenext) ? nA : cA) + (size_t)(h) * hstep + (koff), voffA); } } while (0)
#define PG8_LDA(dst, b, h) do { _Pragma("unroll") for (int m = 0; m < 4; ++m) _Pragma("unroll") for (int k = 0; k < 2; ++k) dst[m][k] = *(const LAS bf16x8*)(lds + PG8_SA(b, h) + aoff + m * 2048 + k * 1024); } while (0)
#define PG8_LDB(dst, b, h) do { _Pragma("unroll") for (int n = 0; n < 2; ++n) _Pragma("unroll") for (int k = 0; k < 2; ++k) dst[n][k] = *(const LAS bf16x8*)(lds + PG8_SB(b, h) + boff + n * 2048 + k * 1024); } while (0)
#define PG8_MMA(ai, bj, At, Bt) do { __builtin_amdgcn_s_setprio(1); _Pragma("unroll") for (int m = 0; m < 4; ++m) _Pragma("unroll") for (int n = 0; n < 2; ++n) _Pragma("unroll") for (int k = 0; k < 2; ++k) \
        acc[ai][bj][m][n] = __builtin_amdgcn_mfma_f32_16x16x32_bf16(Bt[n][k], At[m][k], acc[ai][bj][m][n], 0, 0, 0); __builtin_amdgcn_s_setprio(0); } while (0)
#define PG8_WAIT_V(n) asm volatile("s_waitcnt vmcnt(" #n ")" ::: "memory")
#define PG8_WAIT_L(n) asm volatile("s_waitcnt lgkmcnt(" #n ")" ::: "memory")
#define PG8_BAR __builtin_amdgcn_s_barrier()
#define PG8_SCHED __builtin_amdgcn_sched_barrier(0)
    Unit cur, nxt; int ui = 0;
    if (!S.next(0, cur)) return;
    f32x4 acc[2][2][4][2];
#pragma unroll
    for (int a = 0; a < 2; ++a)
#pragma unroll
        for (int b = 0; b < 2; ++b)
#pragma unroll
            for (int m = 0; m < 4; ++m)
#pragma unroll
                for (int n = 0; n < 2; ++n) acc[a][b][m][n] = (f32x4){0.f, 0.f, 0.f, 0.f};
    bf16x8 At[4][2], B0[2][2], B1[2][2];
    unsigned vA[2][2], nvA[2][2];
    if constexpr (GATHER) {
#pragma unroll
        for (int h = 0; h < 2; ++h)
#pragma unroll
            for (int i = 0; i < 2; ++i) { vA[h][i] = (unsigned)(S.tok(cur, h * HALF + RA[i]) * K + CA[i]) * 2u; nvA[h][i] = vA[h][i]; }
    }
    const char* cA = S.a_ptr(cur); const char* cB = S.b_ptr(cur); const char* nA = cA;
    PG8_STAGE(PG8_SB(0, 0), cB, voffB); PG8_STAGE(PG8_SB(0, 1), cB + hstep, voffB); PG8_STAGE_A(PG8_SA(0, 0), 0, false, 0); PG8_STAGE_A(PG8_SA(0, 1), 1, false, 0);
    if (wr == 1) PG8_BAR;
    PG8_WAIT_V(2); PG8_BAR;
    PG8_STAGE(PG8_SB(1, 0), cB + kstep, voffB); PG8_STAGE_A(PG8_SA(1, 0), 0, false, kstep); PG8_STAGE(PG8_SB(1, 1), cB + hstep + kstep, voffB);
    PG8_WAIT_V(6); PG8_BAR;
    for (;;) {
        const bool has_next = S.next(ui + 1, nxt);
        nA = has_next ? S.a_ptr(nxt) : cA; const char* nB = has_next ? S.b_ptr(nxt) : cB;
        if constexpr (GATHER) {
            if (has_next) {
#pragma unroll
                for (int h = 0; h < 2; ++h)
#pragma unroll
                    for (int i = 0; i < 2; ++i) nvA[h][i] = (unsigned)(S.tok(nxt, h * HALF + RA[i]) * K + CA[i]) * 2u;
            }
        }
        const bool full = (cur.nai == 2);
        for (int t = 0; t < nt; t += 2) {
            const bool last = (t == nt - 2);
            const size_t k1 = (size_t)(t + 1) * kstep;
            const size_t k2 = last ? 0 : (size_t)(t + 2) * kstep, k3 = k2 + kstep;
            const char* b2 = last ? nB : cB + (size_t)(t + 2) * kstep; const char* b3 = b2 + kstep;
            PG8_LDB(B0, 0, 0); PG8_LDB(B1, 0, 1); PG8_SCHED; PG8_LDA(At, 0, 0); PG8_STAGE_A(PG8_SA(1, 1), 1, false, k1);
            PG8_WAIT_V(8); PG8_WAIT_L(0); PG8_BAR; PG8_MMA(0, 0, At, B0); PG8_MMA(0, 1, At, B1); PG8_BAR; PG8_SCHED;
            if (full) PG8_LDA(At, 0, 1); PG8_STAGE(PG8_SB(0, 0), b2, voffB); PG8_STAGE(PG8_SB(0, 1), b2 + hstep, voffB); PG8_STAGE_A(PG8_SA(0, 0), 0, last, k2);
            PG8_WAIT_V(8); PG8_WAIT_L(0); PG8_BAR; if (full) { PG8_MMA(1, 0, At, B0); PG8_MMA(1, 1, At, B1); } PG8_BAR; PG8_SCHED;
            PG8_LDB(B0, 1, 0); PG8_LDB(B1, 1, 1); PG8_SCHED; PG8_LDA(At, 1, 0); PG8_STAGE_A(PG8_SA(0, 1), 1, last, k2);
            PG8_WAIT_V(8); PG8_WAIT_L(0); PG8_BAR; PG8_MMA(0, 0, At, B0); PG8_MMA(0, 1, At, B1); PG8_BAR; PG8_SCHED;
            if (full) PG8_LDA(At, 1, 1); PG8_STAGE(PG8_SB(1, 0), b3, voffB); PG8_STAGE(PG8_SB(1, 1), b3 + hstep, voffB); PG8_STAGE_A(PG8_SA(1, 0), 0, last, k3);
            PG8_WAIT_V(8); PG8_WAIT_L(0); PG8_BAR; if (full) { PG8_MMA(1, 0, At, B0); PG8_MMA(1, 1, At, B1); } PG8_BAR; PG8_SCHED;
        }
        if (wr == 0) PG8_BAR;
        E(acc, cur, wr, wc, fr, fq);
        if (!has_next) break;
#pragma unroll
        for (int a = 0; a < 2; ++a)
#pragma unroll
            for (int b = 0; b < 2; ++b)
#pragma unroll
                for (int m = 0; m < 4; ++m)
#pragma unroll
                    for (int n = 0; n < 2; ++n) acc[a][b][m][n] = (f32x4){0.f, 0.f, 0.f, 0.f};
        cur = nxt; cA = nA; cB = nB; ++ui;
        if constexpr (GATHER) {
#pragma unroll
            for (int h = 0; h < 2; ++h)
#pragma unroll
                for (int i = 0; i < 2; ++i) vA[h][i] = nvA[h][i];
        }
        if (wr == 1) PG8_BAR;
    }
    PG8_WAIT_V(0);
    PG8_BAR;
#undef PG8_SA
#undef PG8_SB
#undef PG8_STAGE
#undef PG8_STAGE_A
#undef PG8_LDA
#undef PG8_LDB
#undef PG8_MMA
#undef PG8_WAIT_V
#undef PG8_WAIT_L
#undef PG8_BAR
#undef PG8_SCHED
}
}

namespace pg8 {
__device__ __forceinline__ void row_bt(int row, int& b, int& tok) { if (row < TX) { b = row >> 11; tok = row & 2047; } else { const int r = row - TX; b = r >> 8; tok = SEQ + (r & 255); } }

struct EpiAttnIn {
    static constexpr bool PERM = true;
    bf16* QKV; bf16* VAT; bf16* VBT; const LAS float* rope;
    __device__ __forceinline__ void operator()(const f32x4 (&acc)[2][2][4][2], const Unit& u, int wr, int wc, int fr, int fq) const {
        const int row0 = u.pm * BM + u.roff + wr * 64 + fr; const int seg = u.pn >> 1;
        const bool latent = u.pm < (TX / BM);
        if (seg == 2 || seg == 5) {
#pragma unroll
            for (int ai = 0; ai < 2; ++ai) if (ai < u.nai)
#pragma unroll
                for (int m = 0; m < 4; ++m) { const int row = row0 + ai * HALF + m * 16; int b, tok; row_bt(row, b, tok);
#pragma unroll
                    for (int bj = 0; bj < 2; ++bj) { const int col = u.pn * BM + bj * HALF + wc * 32 + 8 * fq;
                        bf16* dst;
                        if (seg == 2) { const int cs = col - 1024; dst = VAT + ((size_t)(b * 4 + (cs >> 7)) * 128 + (cs & 127)) * NKEY + tok; }
                        else { const int cs = col - 2560; dst = VBT + ((size_t)(b * 8 + (cs >> 6)) * 64 + (cs & 63)) * NKEY + tok; }
#pragma unroll
                        for (int n = 0; n < 2; ++n)
#pragma unroll
                            for (int i = 0; i < 4; ++i) dst[(size_t)(4 * n + i) * NKEY] = (bf16)f2bf(acc[ai][bj][m][n][i]); } }
            return;
        }
        const bool dorope = latent && seg < 2;
        const float qs = (seg == 0 || seg == 3) ? 0.125f * LOG2E : 1.0f;
#pragma unroll
        for (int ai = 0; ai < 2; ++ai) if (ai < u.nai)
#pragma unroll
            for (int m = 0; m < 4; ++m) { const int row = row0 + ai * HALF + m * 16;
                f32x4 cs4[4];
                if (dorope) { const int t = row & 2047; const int pos = (wc & 1) ? (t & 63) : (t >> 6);
                    const LAS f32x4* rp = (const LAS f32x4*)(rope + (pos * 16 + 8 * (fq & 1)) * 2);
#pragma unroll
                    for (int j = 0; j < 4; ++j) cs4[j] = rp[j]; }
#pragma unroll
                for (int bj = 0; bj < 2; ++bj) { const int col = u.pn * BM + bj * HALF + wc * 32 + 8 * fq;
                    float v[8];
#pragma unroll
                    for (int n = 0; n < 2; ++n)
#pragma unroll
                        for (int i = 0; i < 4; ++i) v[4 * n + i] = acc[ai][bj][m][n][i];
                    if (dorope) {
#pragma unroll
                        for (int j = 0; j < 8; ++j) { const float other = __shfl_xor(v[j], 32); const float c = cs4[j >> 1][(j & 1) * 2], s = cs4[j >> 1][(j & 1) * 2 + 1];
                            v[j] = (fq < 2) ? (v[j] * c - other * s) : (v[j] * c + other * s); } }
                    u32x4 w; w.x = pk2(v[0] * qs, v[1] * qs); w.y = pk2(v[2] * qs, v[3] * qs); w.z = pk2(v[4] * qs, v[5] * qs); w.w = pk2(v[6] * qs, v[7] * qs);
                    *(u32x4*)(QKV + (size_t)row * NATT + col) = w; } }
    }
};
struct EpiGlaIn {
    static constexpr bool PERM = true;
    bf16* QKV2; bf16* VGT;
    __device__ __forceinline__ void operator()(const f32x4 (&acc)[2][2][4][2], const Unit& u, int wr, int wc, int fr, int fq) const {
        const int row0 = u.pm * BM + u.roff + wr * 64 + fr;
        if (u.pn >= 4 && u.pn < 8) {
#pragma unroll
            for (int ai = 0; ai < 2; ++ai) if (ai < u.nai)
#pragma unroll
                for (int m = 0; m < 4; ++m) { const int row = row0 + ai * HALF + m * 16; int b, tok; row_bt(row, b, tok);
#pragma unroll
                    for (int bj = 0; bj < 2; ++bj) { const int cs = u.pn * BM + bj * HALF + wc * 32 + 8 * fq - 1024;
                        bf16* dst = VGT + ((size_t)(b * 4 + (cs >> 8)) * 256 + (cs & 255)) * NKEY + tok;
#pragma unroll
                        for (int n = 0; n < 2; ++n)
#pragma unroll
                            for (int i = 0; i < 4; ++i) dst[(size_t)(4 * n + i) * NKEY] = (bf16)f2bf(acc[ai][bj][m][n][i]); } }
            return;
        }
        const float qs = (u.pn < 2) ? 0.08838834764831845f : 1.0f;
#pragma unroll
        for (int ai = 0; ai < 2; ++ai) if (ai < u.nai)
#pragma unroll
            for (int m = 0; m < 4; ++m) { const int row = row0 + ai * HALF + m * 16;
#pragma unroll
                for (int bj = 0; bj < 2; ++bj) { const int col = u.pn * BM + bj * HALF + wc * 32 + 8 * fq; const f32x4 a = acc[ai][bj][m][0] * qs, c = acc[ai][bj][m][1] * qs;
                    u32x4 w; w.x = pk2(a[0], a[1]); w.y = pk2(a[2], a[3]); w.z = pk2(c[0], c[1]); w.w = pk2(c[2], c[3]);
                    *(u32x4*)(QKV2 + (size_t)row * NGLA + col) = w; } }
    }
};
template <bool F32IN>
struct EpiResid {
    static constexpr bool PERM = true;
    const float* IL; const float* IC; bf16* XB; const float* modv;
    __device__ __forceinline__ void operator()(const f32x4 (&acc)[2][2][4][2], const Unit& u, int wr, int wc, int fr, int fq) const {
        const int row0 = u.pm * BM + u.roff + wr * 64 + fr, col0 = u.pn * BM + wc * 32 + 8 * fq;
        const bool latent = u.pm < (TX / BM); const int bi = latent ? (u.pm >> 3) : 8;
        const float* ibase = latent ? IL : (IC - (size_t)TX * D);
        f32x4 gv[2][2];
#pragma unroll
        for (int bj = 0; bj < 2; ++bj)
#pragma unroll
            for (int n = 0; n < 2; ++n) gv[bj][n] = *(const f32x4*)(modv + bi * 6144 + col0 + bj * HALF + 4 * n);
#pragma unroll
        for (int ai = 0; ai < 2; ++ai) if (ai < u.nai) {
            if constexpr (F32IN) {
#pragma unroll
                for (int mh = 0; mh < 2; ++mh) {
                    f32x4 res[2][2][2];
#pragma unroll
                    for (int m2 = 0; m2 < 2; ++m2) { const size_t ro = (size_t)(row0 + ai * HALF + (2 * mh + m2) * 16) * D + col0;
#pragma unroll
                        for (int bj = 0; bj < 2; ++bj) { res[m2][bj][0] = *(const f32x4*)(ibase + ro + bj * HALF); res[m2][bj][1] = *(const f32x4*)(ibase + ro + bj * HALF + 4); } }
#pragma unroll
                    for (int m2 = 0; m2 < 2; ++m2) { const int m = 2 * mh + m2; const size_t ro = (size_t)(row0 + ai * HALF + m * 16) * D + col0;
#pragma unroll
                        for (int bj = 0; bj < 2; ++bj) { const f32x4 y0 = res[m2][bj][0] + gv[bj][0] * acc[ai][bj][m][0], y1 = res[m2][bj][1] + gv[bj][1] * acc[ai][bj][m][1];
                            u32x4 w; w.x = pk2(y0[0], y0[1]); w.y = pk2(y0[2], y0[3]); w.z = pk2(y1[0], y1[1]); w.w = pk2(y1[2], y1[3]);
                            *(u32x4*)(XB + ro + bj * HALF) = w; } }
                }
            } else {
                u32x4 raw[4][2];
#pragma unroll
                for (int m = 0; m < 4; ++m) { const size_t ro = (size_t)(row0 + ai * HALF + m * 16) * D + col0;
#pragma unroll
                    for (int bj = 0; bj < 2; ++bj) raw[m][bj] = *(const u32x4*)(XB + ro + bj * HALF); }
#pragma unroll
                for (int m = 0; m < 4; ++m) { const size_t ro = (size_t)(row0 + ai * HALF + m * 16) * D + col0;
#pragma unroll
                    for (int bj = 0; bj < 2; ++bj) { const u32x4 t = raw[m][bj];
                        const f32x4 y0 = (f32x4){bflo(t.x), bfhi(t.x), bflo(t.y), bfhi(t.y)} + gv[bj][0] * acc[ai][bj][m][0], y1 = (f32x4){bflo(t.z), bfhi(t.z), bflo(t.w), bfhi(t.w)} + gv[bj][1] * acc[ai][bj][m][1];
                        u32x4 w; w.x = pk2(y0[0], y0[1]); w.y = pk2(y0[2], y0[3]); w.z = pk2(y1[0], y1[1]); w.w = pk2(y1[2], y1[3]);
                        *(u32x4*)(XB + ro + bj * HALF) = w; } }
            }
        }
    }
};
struct EpiMoe1 {
    static constexpr bool PERM = false;
    bf16* HB;
    __device__ __forceinline__ void operator()(const f32x4 (&acc)[2][2][4][2], const Unit& u, int wr, int wc, int fr, int fq) const {
        const int row0 = u.pm * BM + u.roff + wr * 64 + fr, col0 = u.pn * 128 + wc * 16 + 4 * fq;
#pragma unroll
        for (int ai = 0; ai < 2; ++ai) if (ai < u.nai)
#pragma unroll
            for (int m = 0; m < 4; ++m) { bf16* rowp = HB + (size_t)(row0 + ai * HALF + m * 16) * DEXP + col0;
#pragma unroll
                for (int bj = 0; bj < 2; ++bj) { const f32x4 a = acc[ai][bj][m][0], b = acc[ai][bj][m][1];
                    u32x2 w; w.x = pk2(silu_f(a[0]) * b[0], silu_f(a[1]) * b[1]); w.y = pk2(silu_f(a[2]) * b[2], silu_f(a[3]) * b[3]);
                    *(u32x2*)(rowp + bj * 64) = w; } }
    }
};
struct EpiBf16 {
    static constexpr bool PERM = true;
    bf16* O; int ldc;
    __device__ __forceinline__ void operator()(const f32x4 (&acc)[2][2][4][2], const Unit& u, int wr, int wc, int fr, int fq) const {
        const int row0 = u.pm * BM + u.roff + wr * 64 + fr, col0 = u.pn * BM + wc * 32 + 8 * fq;
#pragma unroll
        for (int ai = 0; ai < 2; ++ai) if (ai < u.nai)
#pragma unroll
            for (int m = 0; m < 4; ++m) { bf16* rowp = O + (size_t)(row0 + ai * HALF + m * 16) * ldc + col0;
#pragma unroll
                for (int bj = 0; bj < 2; ++bj) { const f32x4 a = acc[ai][bj][m][0], c = acc[ai][bj][m][1];
                    u32x4 w; w.x = pk2(a[0], a[1]); w.y = pk2(a[2], a[3]); w.z = pk2(c[0], c[1]); w.w = pk2(c[2], c[3]);
                    *(u32x4*)(rowp + bj * HALF) = w; } }
    }
};
}

struct Args {
    const float *x, *c, *ctx, *c_ctx, *w_mod, *b_mod, *norm_g, *final_g, *att_w_in, *att_w_out, *att_lambda, *att_subln_g, *na_bias,
                *gla_w_in, *gla_w_gate, *gla_b_gate, *gla_norm_g, *gla_w_out, *router_w, *router_bias, *moe_w1, *moe_w3, *moe_w2;
    float* out; unsigned char* ws; int ph_lo, ph_hi, rep, pad;
};

struct RowMapId { int off; __device__ __forceinline__ int operator()(int n) const { return off + n; } };
struct RowMapMoe { int which; __device__ __forceinline__ int operator()(int n) const { return 32 * (n >> 4) + 16 * which + (n & 15); } };
__device__ __forceinline__ void ti_load(float (&ld)[32], const float* W, int N, int item, int lane) {
    const int nblk = N / 32, kb = item / nblk, nb = item % nblk, k0 = 64 * kb, n0 = 32 * nb;
#pragma unroll
    for (int i = 0; i < 32; ++i) ld[i] = W[(size_t)(k0 + 2 * i + (lane >> 5)) * N + n0 + (lane & 31)];
}
template <class RM>
__device__ __forceinline__ void ti_finish(const float (&ld)[32], int K, int N, bf16* WT, LAS float* scr, int item, int lane, RM rm) {
    const int nblk = N / 32, kb = item / nblk, nb = item % nblk, k0 = 64 * kb, n0 = 32 * nb;
#pragma unroll
    for (int i = 0; i < 32; ++i) scr[(2 * i + (lane >> 5)) * 33 + (lane & 31)] = ld[i];
    LDS_WAIT(); asm volatile("" ::: "memory");
    const int c = lane & 7;
#pragma unroll
    for (int j = 0; j < 4; ++j) { const int n = (lane >> 3) + 8 * j; const LAS float* s = scr + (8 * c) * 33 + n;
        u32x4 o; o.x = pk2(s[0 * 33], s[1 * 33]); o.y = pk2(s[2 * 33], s[3 * 33]); o.z = pk2(s[4 * 33], s[5 * 33]); o.w = pk2(s[6 * 33], s[7 * 33]);
        *(u32x4*)(WT + (size_t)rm(n0 + n) * K + k0 + 8 * c) = o; }
    LDS_WAIT(); asm volatile("" ::: "memory");
}
template <class RM>
__device__ __forceinline__ void p0_transpose_item(const float* W, int K, int N, bf16* WT, LAS float* scr, int item, int lane, RM rm) {
    float ld[32]; ti_load(ld, W, N, item, lane); ti_finish(ld, K, N, WT, scr, item, lane, rm);
}

constexpr int CV_ATTIN = 1536, CV_ATTOUT = 512, CV_GLAIN = 1552, CV_GLAPAD = 28, CV_GLAOUT = 512, CV_W = 4096, CV_MOE = 3 * CV_W;
constexpr int CT_ATTN0 = CV_ATTIN + CV_ATTOUT, CT_MOE0 = CT_ATTN0 + CV_MOE, CT_GLA0 = CT_MOE0 + CV_GLAIN + CV_GLAPAD + CV_GLAOUT, CT_ATTN1 = CT_GLA0 + CV_ATTIN + CV_ATTOUT, CT_MOE1 = CT_ATTN1 + CV_MOE,
              CT_MOE2 = CT_MOE1 + CV_MOE, CT_GLA1 = CT_MOE2 + CV_GLAIN + CV_GLAPAD + CV_GLAOUT, CT_MOE3 = CT_GLA1 + CV_MOE, CV_TOTAL = CT_MOE3;
constexpr int CV_UNIT = 32;
struct ConvPtrs { const float *att_w_in, *att_w_out, *gla_w_in, *gla_w_out, *moe_w1, *moe_w3, *moe_w2; unsigned char* ws; };
struct RowMapAny { int moe, which; __device__ __forceinline__ int operator()(int n) const { return moe ? 32 * (n >> 4) + 16 * which + (n & 15) : n; } };
struct ConvDesc { const float* W; bf16* WT; int K, N, sub, kind  ; RowMapAny rm; };
__device__ __forceinline__ ConvDesc conv_decode(const ConvPtrs& P, int it, int hi) {
    ConvDesc d; d.W = nullptr; d.WT = nullptr; d.K = D; d.N = D; d.sub = 0; d.kind = 0; d.rm = RowMapAny{0, 0};
    if (it >= hi) return d;
    int kind, j, r;
    if (it < CT_ATTN0) { kind = 0; j = 0; r = it; } else if (it < CT_MOE0) { kind = 2; j = 0; r = it - CT_ATTN0; } else if (it < CT_GLA0) { kind = 1; j = 0; r = it - CT_MOE0; }
    else if (it < CT_ATTN1) { kind = 0; j = 1; r = it - CT_GLA0; } else if (it < CT_MOE1) { kind = 2; j = 1; r = it - CT_ATTN1; } else if (it < CT_MOE2) { kind = 2; j = 2; r = it - CT_MOE1; }
    else if (it < CT_GLA1) { kind = 1; j = 1; r = it - CT_MOE2; } else { kind = 2; j = 3; r = it - CT_GLA1; }
    d.kind = 1; d.sub = r;
    if (kind == 2) {
        const int which = r / CV_W, q = r % CV_W, e = q >> 8, je = j * 16 + e; d.sub = q & 255;
        if (which < 2) { d.W = (which ? P.moe_w3 : P.moe_w1) + (size_t)je * D * DEXP; d.N = DEXP; d.WT = (bf16*)(P.ws + WS_W13) + (size_t)je * D * D; d.rm.moe = 1; d.rm.which = which; }
        else { d.W = P.moe_w2 + (size_t)je * DEXP * D; d.K = DEXP; d.WT = (bf16*)(P.ws + WS_W2) + (size_t)je * D * DEXP; }
    } else if (kind == 0) {
        if (r < CV_ATTIN) { d.W = P.att_w_in + (size_t)j * D * NATT; d.N = NATT; d.WT = (bf16*)(P.ws + WS_WATTIN) + (size_t)j * NATT * D; }
        else { d.W = P.att_w_out + (size_t)j * D * D; d.WT = (bf16*)(P.ws + WS_WATTOUT) + (size_t)j * D * D; d.sub = r - CV_ATTIN; }
    } else {
        if (r < CV_GLAIN) { d.W = P.gla_w_in + (size_t)j * D * 3104; d.N = 3104; d.WT = (bf16*)(P.ws + WS_WGLAIN) + (size_t)j * NGLA * D; }
        else if (r < CV_GLAIN + CV_GLAPAD) { d.kind = 2; d.sub = (r - CV_GLAIN) * 1024; d.WT = (bf16*)(P.ws + WS_WGLAIN) + (size_t)j * NGLA * D + (size_t)3104 * D; }
        else { d.W = P.gla_w_out + (size_t)j * D * D; d.WT = (bf16*)(P.ws + WS_WGLAOUT) + (size_t)j * D * D; d.sub = r - CV_GLAIN - CV_GLAPAD; }
    }
    return d;
}
__device__ __forceinline__ void conv_load(const ConvDesc& d, float (&ld)[32], int lane) { if (d.kind == 1) ti_load(ld, d.W, d.N, d.sub, lane); }
__device__ __forceinline__ void conv_finish(const ConvDesc& d, const float (&ld)[32], LAS float* scr, int lane) {
    if (d.kind == 1) ti_finish(ld, d.K, d.N, d.WT, scr, d.sub, lane, d.rm);
    else if (d.kind == 2) { for (int i = lane; i < 1024; i += 64) *(u32x4*)(d.WT + (size_t)(d.sub + i) * 8) = (u32x4){0u, 0u, 0u, 0u}; }
}
__device__ __forceinline__ void conv_item(const ConvPtrs& P, int it, LAS float* scr, int lane) {
    const ConvDesc d = conv_decode(P, it, it + 1); float ld[32]; conv_load(d, ld, lane); conv_finish(d, ld, scr, lane);
}
__device__ __forceinline__ void conv_static(const ConvPtrs& P, int cur, int need, LAS unsigned char* lds, int lane, int wave, int vcu, int G) {
    LAS float* scr = (LAS float*)(lds + wave * 8448);
    for (int it = cur + vcu * 8 + wave; it < need; it += G * 8) conv_item(P, it, scr, lane);
}
__device__ __forceinline__ void conv_unit(const ConvPtrs& P, int i0, int hi, LAS unsigned char* lds, int lane, int wave) {
    LAS float* scr = (LAS float*)(lds + wave * 8448);
    constexpr int NPW = CV_UNIT / 8; static_assert(NPW == 4, "four items per wave");
    const int it0 = i0 + wave * NPW;
    float la[32], lb[32];
    ConvDesc dA = conv_decode(P, it0, hi); conv_load(dA, la, lane);
    ConvDesc dB = conv_decode(P, it0 + 1, hi); conv_load(dB, lb, lane);
    conv_finish(dA, la, scr, lane);
    dA = conv_decode(P, it0 + 2, hi); conv_load(dA, la, lane);
    conv_finish(dB, lb, scr, lane);
    dB = conv_decode(P, it0 + 3, hi); conv_load(dB, lb, lane);
    conv_finish(dA, la, scr, lane);
    conv_finish(dB, lb, scr, lane);
}

template <class AP> __device__ __forceinline__ void p0_prologue(const AP ap, LAS unsigned char* lds, int tid, int lane, int wave, int vcu, int G) {
    unsigned char* ws = ap->ws;
    LAS float* S9 = (LAS float*)(lds + 69632);
    LAS float* red = (LAS float*)(lds + 106496);
    { const ConvPtrs P{ap->att_w_in, ap->att_w_out, ap->gla_w_in, ap->gla_w_out, ap->moe_w1, ap->moe_w3, ap->moe_w2, ws};
      conv_static(P, 0, MK_CONVQ ? CT_ATTN0 : CV_TOTAL, lds, lane, wave, vcu, G); }
    __syncthreads();
    { const float* cc = ap->c; const float* cx = ap->c_ctx;
      for (int i = tid; i < 9 * 1024; i += 512) { const int bi = i >> 10, k = i & 1023; const float v = (bi < 8) ? cc[bi * D + k] : cx[k]; S9[i] = v / (1.0f + __expf(-v)); } }
    __syncthreads();
    const float* w_mod = ap->w_mod; const float* b_mod = ap->b_mod;
    for (int u = vcu; u < 4 * 192; u += G) {
        const int L = u / 192, n0 = (u % 192) * 32;
        const float* W = w_mod + (size_t)L * D * 6144 + n0 + 4 * (lane & 7);
        f32x4 acc[9];
#pragma unroll
        for (int bi = 0; bi < 9; ++bi) acc[bi] = (f32x4){0.f, 0.f, 0.f, 0.f};
        const int kb = wave * 128 + (lane >> 3);
        f32x4 wv[16];
#pragma unroll
        for (int i = 0; i < 16; ++i) wv[i] = *(const f32x4*)(W + (size_t)(kb + 8 * i) * 6144);
#pragma unroll
        for (int i = 0; i < 16; ++i)
#pragma unroll
            for (int bi = 0; bi < 9; ++bi) { const float sv = S9[bi * 1024 + kb + 8 * i]; acc[bi] = __builtin_elementwise_fma(wv[i], (f32x4){sv, sv, sv, sv}, acc[bi]); }
#pragma unroll
        for (int bi = 0; bi < 9; ++bi) { f32x4 t;
#pragma unroll
            for (int j = 0; j < 4; ++j) { float v = acc[bi][j]; v += dppf<0x128>(v); v = swap16_add(v, v); t[j] = swap32_add(v, v); }
            if (lane < 8) *(LAS f32x4*)(red + (wave * 9 + bi) * 32 + 4 * lane) = t; }
        __syncthreads();
        if (tid < 9 * 32) { const int bi = tid >> 5, l = tid & 31; float sm = b_mod[L * 6144 + n0 + l];
#pragma unroll
            for (int w = 0; w < 8; ++w) sm += red[(w * 9 + bi) * 32 + l];
            ((float*)(ws + WS_MODV))[(size_t)(L * 9 + bi) * 6144 + n0 + l] = sm; }
        __syncthreads();
    }
}

__device__ __forceinline__ float* xrow_ptr(float* XL, float* XC, int row) { return row < TX ? XL + (size_t)row * D : XC + (size_t)(row - TX) * D; }
__device__ __forceinline__ int row_bi(int row) { return row < TX ? (row >> 11) : 8; }

__device__ __forceinline__ void norm_mod_store(const f32x4 (&v)[4], const float* g, const float* sh, const float* sc, bf16* orow, int lane) {
    float ss = 0.f;
#pragma unroll
    for (int j = 0; j < 4; ++j) ss += (v[j].x * v[j].x + v[j].y * v[j].y) + (v[j].z * v[j].z + v[j].w * v[j].w);
    const float rs = __builtin_amdgcn_rsqf(wave_sum(ss) * (1.0f / D) + EPSF);
#pragma unroll
    for (int j = 0; j < 4; ++j) { const int c = 4 * lane + 256 * j; const f32x4 gg = *(const f32x4*)(g + c), s1 = *(const f32x4*)(sc + c), s0 = *(const f32x4*)(sh + c);
        const f32x4 y = (v[j] * rs) * gg * (1.0f + s1) + s0;
        u32x2 w; w.x = pk2(y.x, y.y); w.y = pk2(y.z, y.w); *(u32x2*)(orow + c) = w; }
}

constexpr int TROWS = 9;
__device__ __forceinline__ int thin_row(int vcu, int wave, int i) { return vcu * 8 + wave + 2048 * i; }

struct N1Row { f32x4 x[4], s0[4], s1[4]; };
__device__ __forceinline__ void n1_issue(N1Row& r, const float* XL, const float* XC, const float* modv, int row, int lane) {
    const f32x4* xr = (const f32x4*)(row < TX ? XL + (size_t)row * D : XC + (size_t)(row - TX) * D) + lane; const float* mv = modv + row_bi(row) * 6144;
#pragma unroll
    for (int j = 0; j < 4; ++j) { r.x[j] = xr[64 * j]; r.s0[j] = *(const f32x4*)(mv + 4 * lane + 256 * j); r.s1[j] = *(const f32x4*)(mv + 1024 + 4 * lane + 256 * j); }
}
__device__ __forceinline__ void n1_finish(const N1Row& r, const f32x4 (&gg)[4], bf16* orow, int lane) {
    float ss = 0.f;
#pragma unroll
    for (int j = 0; j < 4; ++j) ss += (r.x[j].x * r.x[j].x + r.x[j].y * r.x[j].y) + (r.x[j].z * r.x[j].z + r.x[j].w * r.x[j].w);
    const float rs = __builtin_amdgcn_rsqf(wave_sum(ss) * (1.0f / D) + EPSF);
#pragma unroll
    for (int j = 0; j < 4; ++j) { const f32x4 y = (r.x[j] * rs) * gg[j] * (1.0f + r.s1[j]) + r.s0[j];
        u32x2 w; w.x = pk2(y.x, y.y); w.y = pk2(y.z, y.w); *(u32x2*)(orow + 4 * lane + 256 * j) = w; }
}
__device__ __forceinline__ void phase_norm1(const float* XL, const float* XC, const float* g, const float* modv, bf16* H, int nrows, int lane, int wave, int vcu, int G) {
    f32x4 gg[4];
#pragma unroll
    for (int j = 0; j < 4; ++j) gg[j] = *(const f32x4*)(g + 4 * lane + 256 * j);
    N1Row ra, rb;
    n1_issue(ra, XL, XC, modv, thin_row(vcu, wave, 0), lane);
#pragma unroll
    for (int i = 0; i < TROWS; ++i) {
        const int row = thin_row(vcu, wave, i), rown = thin_row(vcu, wave, i + 1);
        if (i + 1 < TROWS) n1_issue((i & 1) ? ra : rb, XL, XC, modv, rown < nrows ? rown : row, lane);
        if (row < nrows) n1_finish((i & 1) ? rb : ra, gg, H + (size_t)row * D, lane);
    }
}

__device__ __forceinline__ void phase_router(const bf16* XB, const float* g, const float* modv, bf16* H, const float* router_w, const float* router_bias,
                                             unsigned* cnt  , int* list, int* toki, float* tokw, int nrows,
                                             LAS unsigned char* lds, int tid, int lane, int wave, int vcu, int G, int probe) {
    LAS float* RW = (LAS float*)lds;
    LAS int* lcnt = (LAS int*)(lds + 65536);
    LAS int* rinfo = (LAS int*)(lds + 65536 + 256);
    const int rpb = nrows / G, rpw = rpb / 8;
    const int gI = lane >> 4;
    const f32x4 rb = *(const f32x4*)(router_bias + 4 * gI);
    f32x4 gg[4];
#pragma unroll
    for (int j = 0; j < 4; ++j) gg[j] = *(const f32x4*)(g + 4 * lane + 256 * j);
    const int rowbase = vcu * rpb + wave * rpw;
    u32x2 xa[3][4], xb[3][4];
#pragma unroll
    for (int r = 0; r < 3; ++r) { const bf16* xr = XB + (size_t)(rowbase + (r < rpw ? r : rpw - 1)) * D + 4 * lane;
#pragma unroll
        for (int j = 0; j < 4; ++j) xa[r][j] = *(const u32x2*)(xr + 256 * j); }
    for (int it = 0; it < 8; ++it) { const int idx = tid + 512 * it, k = idx >> 2, q = idx & 3; const f32x4 w = *(const f32x4*)(router_w + k * 16 + 4 * q);
        RW[(4 * q + 0) * 1024 + k] = w.x; RW[(4 * q + 1) * 1024 + k] = w.y; RW[(4 * q + 2) * 1024 + k] = w.z; RW[(4 * q + 3) * 1024 + k] = w.w; }
    if (tid < 32) lcnt[tid] = 0;
    __syncthreads();
#pragma unroll
    for (int bt = 0; bt < 3; ++bt) {
        const int i0 = 3 * bt;
        asm volatile("" ::: "memory");
        u32x2 (&xc)[3][4] = (bt & 1) ? xb : xa; u32x2 (&xn)[3][4] = (bt & 1) ? xa : xb; f32x4 y[3][4];
        f32x4 s0v[3][4], s1v[3][4];
#pragma unroll
        for (int r = 0; r < 3; ++r) { const int ii = (i0 + r < rpw) ? i0 + r : rpw - 1; const float* mv = modv + row_bi(rowbase + ii) * 6144 + 3072;
#pragma unroll
            for (int j = 0; j < 4; ++j) { const int c = 4 * lane + 256 * j; s0v[r][j] = *(const f32x4*)(mv + c); s1v[r][j] = *(const f32x4*)(mv + 1024 + c); } }
        if (bt + 1 < 3) {
#pragma unroll
            for (int r = 0; r < 3; ++r) { const int ii = (i0 + 3 + r < rpw) ? i0 + 3 + r : rpw - 1; const bf16* xr = XB + (size_t)(rowbase + ii) * D + 4 * lane;
#pragma unroll
                for (int j = 0; j < 4; ++j) xn[r][j] = *(const u32x2*)(xr + 256 * j); } }
#pragma unroll
        for (int r = 0; r < 3; ++r) {
            const int ii = (i0 + r < rpw) ? i0 + r : rpw - 1; const int row = rowbase + ii;
            float ss = 0.f;
#pragma unroll
            for (int j = 0; j < 4; ++j) { const u32x2 t = xc[r][j]; y[r][j] = (f32x4){bflo(t.x), bfhi(t.x), bflo(t.y), bfhi(t.y)};
                ss += (y[r][j].x * y[r][j].x + y[r][j].y * y[r][j].y) + (y[r][j].z * y[r][j].z + y[r][j].w * y[r][j].w); }
            const float rs = __builtin_amdgcn_rsqf(wave_sum(ss) * (1.0f / D) + EPSF);
#pragma unroll
            for (int j = 0; j < 4; ++j) { const int c = 4 * lane + 256 * j;
                y[r][j] = (y[r][j] * rs) * gg[j] * (1.0f + s1v[r][j]) + s0v[r][j];
                u32x2 w; w.x = cvtpk(y[r][j].x, y[r][j].y); w.y = cvtpk(y[r][j].z, y[r][j].w); *(u32x2*)(H + (size_t)row * D + c) = w; }
        }
        float p[3][16];
#pragma unroll
        for (int e = 0; e < 16; ++e) {
            f32x2 a2[3];
#pragma unroll
            for (int r = 0; r < 3; ++r) a2[r] = (f32x2){0.f, 0.f};
#pragma unroll
            for (int j = 0; j < 4; ++j) { const f32x4 w = *(const LAS f32x4*)(RW + e * 1024 + 4 * lane + 256 * j); const f32x2 wlo = __builtin_shufflevector(w, w, 0, 1), whi = __builtin_shufflevector(w, w, 2, 3);
#pragma unroll
                for (int r = 0; r < 3; ++r) { a2[r] = __builtin_elementwise_fma(__builtin_shufflevector(y[r][j], y[r][j], 0, 1), wlo, a2[r]); a2[r] = __builtin_elementwise_fma(__builtin_shufflevector(y[r][j], y[r][j], 2, 3), whi, a2[r]); } }
#pragma unroll
            for (int r = 0; r < 3; ++r) { p[r][e] = a2[r].x + a2[r].y; asm volatile("" : "+v"(p[r][e])); } }
#pragma unroll
        for (int r = 0; r < 3; ++r) {
            float q8[8], lg[4];
#pragma unroll
            for (int j = 0; j < 8; ++j) q8[j] = swap32_add(p[r][j], p[r][j + 8]);
#pragma unroll
            for (int j = 0; j < 4; ++j) lg[j] = row_sum(swap16_add(q8[j], q8[j + 4]));
            float sc[4], sel[4];
#pragma unroll
            for (int j = 0; j < 4; ++j) { sc[j] = 1.0f / (1.0f + __expf(-lg[j])); sel[j] = sc[j] + rb[j]; }
            int i1 = 0, i2 = 0; float m1 = -1e30f, m2 = -1e30f, w1 = 0.f, w2 = 0.f;
#pragma unroll
            for (int j = 0; j < 4; ++j) { const float t = sel[j];
                if (t > m1) { m2 = m1; i2 = i1; w2 = w1; m1 = t; i1 = j; w1 = sc[j]; } else if (t > m2) { m2 = t; i2 = j; w2 = sc[j]; } }
            const float gs = m1 + m2;
            const float g0 = readlane_f(gs, 0), g1 = readlane_f(gs, 16), g2 = readlane_f(gs, 32), g3 = readlane_f(gs, 48);
            int bg = 0; float bgs = g0; if (g1 > bgs) { bgs = g1; bg = 1; } if (g2 > bgs) { bgs = g2; bg = 2; } if (g3 > bgs) { bgs = g3; bg = 3; }
            bg = __builtin_amdgcn_readfirstlane(bg);
            const int e0 = 4 * bg + __builtin_amdgcn_readlane(i1, 16 * bg), e1 = 4 * bg + __builtin_amdgcn_readlane(i2, 16 * bg);
            const float w0 = readlane_f(w1, 16 * bg), w1s = readlane_f(w2, 16 * bg);
            const float wn = 1.0f / (w0 + w1s);
            if (lane == 0 && i0 + r < rpw) { const int rl = wave * rpw + i0 + r;
                const int p0 = __hip_atomic_fetch_add(&lcnt[e0], 1, __ATOMIC_RELAXED, __HIP_MEMORY_SCOPE_WORKGROUP), p1 = __hip_atomic_fetch_add(&lcnt[e1], 1, __ATOMIC_RELAXED, __HIP_MEMORY_SCOPE_WORKGROUP);
                rinfo[rl * 6 + 0] = e0; rinfo[rl * 6 + 1] = p0; rinfo[rl * 6 + 2] = e1; rinfo[rl * 6 + 3] = p1;
                rinfo[rl * 6 + 4] = __builtin_bit_cast(int, w0 * wn); rinfo[rl * 6 + 5] = __builtin_bit_cast(int, w1s * wn); }
        }
    }
    __syncthreads();
    if (tid < 16) lcnt[16 + tid] = (int)__hip_atomic_fetch_add(cnt + 64 * tid, (unsigned)lcnt[tid], RLX_AGENT);
    __syncthreads();
    if (tid < rpb) { const int row = vcu * rpb + tid; const int e0 = rinfo[tid * 6 + 0], e1 = rinfo[tid * 6 + 2];
        const int p0 = lcnt[16 + e0] + rinfo[tid * 6 + 1], p1 = lcnt[16 + e1] + rinfo[tid * 6 + 3];
        list[(size_t)e0 * TALL + p0] = row; list[(size_t)e1 * TALL + p1] = row;
        toki[row * 4 + 0] = e0; toki[row * 4 + 1] = p0; toki[row * 4 + 2] = e1; toki[row * 4 + 3] = p1;
        tokw[row * 2 + 0] = __builtin_bit_cast(float, rinfo[tid * 6 + 4]); tokw[row * 2 + 1] = __builtin_bit_cast(float, rinfo[tid * 6 + 5]); }
    __syncthreads();
}

__device__ __forceinline__ int build_moe_table(const unsigned* cnt, LAS int* tab, int tid) {
    if (tid < 16) tab[RT_MAX + 1 + tid] = (int)__hip_atomic_load(cnt + 64 * tid, RLX_AGENT);
    __syncthreads();
    if (tid < RT_MAX) { int acc = 0, ef = -1, mf = 0;
#pragma unroll
        for (int e = 0; e < 16; ++e) { const int nt = (tab[RT_MAX + 1 + e] + 255) >> 8; if (ef < 0 && tid < acc + nt) { ef = e; mf = tid - acc; } acc += nt; }
        if (ef >= 0) tab[tid] = ef | (mf << 8);
        if (tid == 0) tab[RT_MAX] = acc < RT_MAX ? acc : RT_MAX; }
    __syncthreads();
    return tab[RT_MAX];
}

struct CbTok { int e0, p0, e1, p1; float w0, w1; };
struct CbRow { f32x4 g2[4], s0[4], s1[4]; u32x2 x[4], ya[4], yb[4]; };
__device__ __forceinline__ void cb_tok(CbTok& t, const int* toki, const float* tokw, int row) {
    const int4 q = *(const int4*)(toki + row * 4); const float2 w = *(const float2*)(tokw + row * 2); t.e0 = q.x; t.p0 = q.y; t.e1 = q.z; t.p1 = q.w; t.w0 = w.x; t.w1 = w.y;
}
template <bool FINAL>
__device__ __forceinline__ void cb_issue(CbRow& r, const CbTok& t, int mybase, const bf16* XB, const float* modv, const float* modv_next, const bf16* YB, int row, int lane) {
    const int s0 = __shfl(mybase, t.e0) + t.p0, s1 = __shfl(mybase, t.e1) + t.p1;
    const bf16* xp = XB + (size_t)row * D; const int bi = row_bi(row); const float* g2 = modv + bi * 6144 + 5120; const float* mv = modv_next + bi * 6144;
#pragma unroll
    for (int j = 0; j < 4; ++j) { const int c = 4 * lane + 256 * j;
        r.ya[j] = *(const u32x2*)(YB + (size_t)s0 * D + c); r.yb[j] = *(const u32x2*)(YB + (size_t)s1 * D + c);
        r.x[j] = *(const u32x2*)(xp + c); r.g2[j] = *(const f32x4*)(g2 + c);
        if constexpr (!FINAL) { r.s0[j] = *(const f32x4*)(mv + c); r.s1[j] = *(const f32x4*)(mv + 1024 + c); } }
}
template <bool FINAL>
__device__ __forceinline__ void cb_finish(const CbRow& r, const CbTok& t, const f32x4 (&gn)[4], bf16* xp, float* orow, bf16* hrow, int lane) {
    f32x4 v[4]; float ss = 0.f;
#pragma unroll
    for (int j = 0; j < 4; ++j) { const u32x2 a = r.ya[j], b = r.yb[j]; const float w0 = t.w0, w1 = t.w1;
        f32x4 y; y.x = w0 * bflo(a.x) + w1 * bflo(b.x); y.y = w0 * bfhi(a.x) + w1 * bfhi(b.x); y.z = w0 * bflo(a.y) + w1 * bflo(b.y); y.w = w0 * bfhi(a.y) + w1 * bfhi(b.y);
        const u32x2 xt = r.x[j]; v[j] = (f32x4){bflo(xt.x), bfhi(xt.x), bflo(xt.y), bfhi(xt.y)} + r.g2[j] * y;
        ss += (v[j].x * v[j].x + v[j].y * v[j].y) + (v[j].z * v[j].z + v[j].w * v[j].w); }
    const float rs = __builtin_amdgcn_rsqf(wave_sum(ss) * (1.0f / D) + EPSF);
#pragma unroll
    for (int j = 0; j < 4; ++j) { const int c = 4 * lane + 256 * j;
        if constexpr (FINAL) *(f32x4*)(orow + c) = (v[j] * rs) * gn[j];
        else { u32x2 xw; xw.x = pk2(v[j].x, v[j].y); xw.y = pk2(v[j].z, v[j].w); *(u32x2*)(xp + c) = xw;
            const f32x4 y = (v[j] * rs) * gn[j] * (1.0f + r.s1[j]) + r.s0[j];
            u32x2 w; w.x = pk2(y.x, y.y); w.y = pk2(y.z, y.w); *(u32x2*)(hrow + c) = w; } }
}
template <bool FINAL>
__device__ __forceinline__ void phase_combine(bf16* XB, float* OUT, const float* modv  , const bf16* YB, const unsigned* cnt, const int* toki, const float* tokw,
                                              const float* gnext, const float* modv_next, bf16* H, int nrows, int lane, int wave, int vcu, int G) {
    int tiles = 0; if (lane < 16) tiles = ((int)__hip_atomic_load(cnt + 64 * lane, RLX_AGENT) + 255) >> 8;
    int incl = tiles;
#pragma unroll
    for (int o = 1; o < 16; o <<= 1) { const int t = __shfl_up(incl, o); if (lane >= o) incl += t; }
    const int mybase = (incl - tiles) * 256;
    f32x4 gn[4];
#pragma unroll
    for (int j = 0; j < 4; ++j) gn[j] = *(const f32x4*)(gnext + 4 * lane + 256 * j);
    CbTok ta, tb, tc; CbRow ra, rb;
    cb_tok(ta, toki, tokw, thin_row(vcu, wave, 0)); cb_tok(tb, toki, tokw, thin_row(vcu, wave, 1));
    cb_issue<FINAL>(ra, ta, mybase, XB, modv, modv_next, YB, thin_row(vcu, wave, 0), lane);
#pragma unroll
    for (int i = 0; i < TROWS; ++i) {
        const int row = thin_row(vcu, wave, i), row1 = thin_row(vcu, wave, i + 1), row2 = thin_row(vcu, wave, i + 2);
        CbTok& tcur = (i % 3 == 0) ? ta : (i % 3 == 1) ? tb : tc; CbTok& tnx = (i % 3 == 0) ? tb : (i % 3 == 1) ? tc : ta; CbTok& tn2 = (i % 3 == 0) ? tc : (i % 3 == 1) ? ta : tb;
        if (i + 2 < TROWS) cb_tok(tn2, toki, tokw, row2 < nrows ? row2 : row);
        if (i + 1 < TROWS) cb_issue<FINAL>((i & 1) ? ra : rb, tnx, mybase, XB, modv, modv_next, YB, row1 < nrows ? row1 : row, lane);
        if (row < nrows) cb_finish<FINAL>((i & 1) ? rb : ra, tcur, gn, XB + (size_t)row * D, OUT + (size_t)row * D, H + (size_t)row * D, lane);
    }
}

struct RoRow { u32x2 a[4], b[4], gt[4]; };
__device__ __forceinline__ void ro_issue(RoRow& r, const bf16* OF, const bf16* OB, const bf16* QKV2, int row, int lane) {
#pragma unroll
    for (int j = 0; j < 4; ++j) { const int c = 4 * lane + 256 * j;
        r.a[j] = *(const u32x2*)(OF + (size_t)row * D + c); r.b[j] = *(const u32x2*)(OB + (size_t)row * D + c); r.gt[j] = *(const u32x2*)(QKV2 + (size_t)row * NGLA + 2048 + c); }
}
__device__ __forceinline__ void ro_finish(const RoRow& r, const f32x4 gg, bf16* orow, int lane) {
#pragma unroll
    for (int j = 0; j < 4; ++j) { const u32x2 a = r.a[j], b = r.b[j], gt = r.gt[j];
        f32x4 o; o.x = bflo(a.x) + bflo(b.x); o.y = bfhi(a.x) + bfhi(b.x); o.z = bflo(a.y) + bflo(b.y); o.w = bfhi(a.y) + bfhi(b.y);
        const float ss = wave_sum((o.x * o.x + o.y * o.y) + (o.z * o.z + o.w * o.w));
        const float rs = __builtin_amdgcn_rsqf(ss * (1.0f / 256.0f) + EPSF);
        f32x4 gv; gv.x = silu_f(bflo(gt.x)); gv.y = silu_f(bfhi(gt.x)); gv.z = silu_f(bflo(gt.y)); gv.w = silu_f(bfhi(gt.y));
        const f32x4 y = (o * rs) * gg * gv;
        u32x2 w; w.x = pk2(y.x, y.y); w.y = pk2(y.z, y.w); *(u32x2*)(orow + 4 * lane + 256 * j) = w; }
}
__device__ __forceinline__ void phase_readout(const bf16* OF, const bf16* OB, const bf16* QKV2, const float* ng, bf16* AOUT, int nrows, int lane, int wave, int vcu, int G) {
    const f32x4 gg = *(const f32x4*)(ng + 4 * lane);
    RoRow ra, rb, rc;
    ro_issue(ra, OF, OB, QKV2, thin_row(vcu, wave, 0), lane); ro_issue(rb, OF, OB, QKV2, thin_row(vcu, wave, 1), lane);
#pragma unroll
    for (int i = 0; i < TROWS; ++i) {
        const int row = thin_row(vcu, wave, i), row2 = thin_row(vcu, wave, i + 2);
        RoRow& cur = (i % 3 == 0) ? ra : (i % 3 == 1) ? rb : rc; RoRow& n2 = (i % 3 == 0) ? rc : (i % 3 == 1) ? ra : rb;
        if (i + 2 < TROWS) ro_issue(n2, OF, OB, QKV2, row2 < nrows ? row2 : row, lane);
        if (row < nrows) ro_finish(cur, gg, AOUT + (size_t)row * D, lane);
    }
}

__device__ __forceinline__ int na_r0(int r) { int v = r - 4; return v < 0 ? 0 : (v > 24 ? 24 : v); }
template <int NMAPS, int DV, bool NA>
__device__ __forceinline__ void attn_unit(LAS unsigned char* lds, int tid, int lane, int wave,
                                          const bf16* QKV, int qcol, int qrow0, int kcol, int krow_lat, int krow_ctx, const bf16* VT, int klo, int khi,
                                          int r_wave, int xq0, const LAS float* biasT,
                                          bf16* AOUT, int ocol, float lam, const float* subg, float outscale) {
    constexpr int KB = 9216;
    constexpr int BUFSZ = NMAPS * KB + DV * 144;
    constexpr int NVB = DV / 16, NVR = DV / 64;
    const int fr = lane & 15, g = lane >> 4;
    bf16x8 qf[NMAPS][2];
    { const bf16* qp = QKV + (size_t)(qrow0 + wave * 16 + fr) * NATT + qcol + 8 * g;
#pragma unroll
      for (int m = 0; m < NMAPS; ++m)
#pragma unroll
          for (int s = 0; s < 2; ++s) qf[m][s] = *(const bf16x8*)(qp + m * 64 + 32 * s); }
    f32x4 O[NMAPS][NVB]; float mrun[NMAPS]; float lrun[NMAPS];
#pragma unroll
    for (int m = 0; m < NMAPS; ++m) { mrun[m] = -1e30f; lrun[m] = 0.f;
#pragma unroll
        for (int vb = 0; vb < NVB; ++vb) O[m][vb] = (f32x4){0.f, 0.f, 0.f, 0.f}; }
    const int ntiles = 4 + (khi - klo);
    u32x4 kreg[NMAPS], vreg[NVR];
    const int lkey = tid >> 3, lch = tid & 7;
#define AT_LOAD(i) do { const int _i = (i); const int _rowg = (_i < 4 ? krow_ctx + 64 * _i : krow_lat + 64 * (klo + _i - 4)) + lkey; const int _tok0 = (_i < 4 ? SEQ + 64 * _i : 64 * (klo + _i - 4)); \
        _Pragma("unroll") for (int m = 0; m < NMAPS; ++m) kreg[m] = *(const u32x4*)(QKV + (size_t)_rowg * NATT + kcol + m * 64 + lch * 8); \
        _Pragma("unroll") for (int j = 0; j < NVR; ++j) { const int idx = tid + 512 * j; vreg[j] = *(const u32x4*)(VT + (size_t)(idx >> 3) * NKEY + _tok0 + (idx & 7) * 8); } } while (0)
#define AT_STORE(b) do { LAS unsigned char* _p = lds + (b) * BUFSZ; \
        _Pragma("unroll") for (int m = 0; m < NMAPS; ++m) *(LAS u32x4*)(_p + m * KB + lkey * 144 + lch * 16) = kreg[m]; \
        _Pragma("unroll") for (int j = 0; j < NVR; ++j) { const int idx = tid + 512 * j; *(LAS u32x4*)(_p + NMAPS * KB + (idx >> 3) * 144 + (idx & 7) * 16) = vreg[j]; } } while (0)
    AT_LOAD(0); AT_STORE(0); __syncthreads();
    const int kbase0 = (8 * (fr >> 2) + (fr & 3)) * 144 + 16 * g;
    const int vbase = fr * 144 + 16 * g;
    int r0w = 0, xq = 0, tmask = 3, c0w = 0; float pen[4][4];
    if constexpr (NA) { r0w = na_r0(r_wave); xq = xq0 + fr; int cs = xq - 8; cs = cs < 0 ? 0 : (cs > 48 ? 48 : cs);
        c0w = xq0 - 8; c0w = c0w < 0 ? 0 : (c0w > 32 ? 32 : c0w);
        tmask = 1;
#pragma unroll
        for (int kb = 0; kb < 4; ++kb)
#pragma unroll
            for (int ii = 0; ii < 4; ++ii) { const int y = c0w + 32 * (kb >> 1) + 8 * g + 4 * (kb & 1) + ii; pen[kb][ii] = (y >= cs && y < cs + 16) ? 0.f : -1e30f; } }
    for (int i = 0; i < ntiles; ++i) {
        if (i + 1 < ntiles) AT_LOAD(i + 1);
        const LAS unsigned char* buf = lds + (i & 1) * BUFSZ;
        bool active = true; int kr = 0; bool local = false;
        if constexpr (NA) { if (i >= 4) { local = true; kr = klo + i - 4; active = (kr >= r0w) && (kr < r0w + 8); } }
        if (active) {
            const int tm = local ? tmask : 3;
            const int koffw = local ? c0w * 144 : 0, voffw = local ? c0w * 2 : 0;
            bf16x8 kf[NMAPS][4][2];
#pragma unroll
            for (int m = 0; m < NMAPS; ++m)
#pragma unroll
                for (int kb = 0; kb < 4; ++kb)
#pragma unroll
                    for (int s = 0; s < 2; ++s) kf[m][kb][s] = *(const LAS bf16x8*)(buf + m * KB + kbase0 + koffw + (kb & 1) * (4 * 144) + (kb >> 1) * (32 * 144) + s * 64);
            __builtin_amdgcn_sched_barrier(0);
            f32x4 S[NMAPS][4];
#pragma unroll
            for (int m = 0; m < NMAPS; ++m)
#pragma unroll
                for (int kb = 0; kb < 4; ++kb) { S[m][kb] = (f32x4){0.f, 0.f, 0.f, 0.f};
                    if (!NA || (tm >> (kb >> 1)) & 1) {
#pragma unroll
                        for (int s = 0; s < 2; ++s) S[m][kb] = __builtin_amdgcn_mfma_f32_16x16x32_bf16(kf[m][kb][s], qf[m][s], S[m][kb], 0, 0, 0); } }
            bf16x8 vf0[4][2];
#pragma unroll
            for (int vb = 0; vb < 4; ++vb)
#pragma unroll
                for (int t = 0; t < 2; ++t) vf0[vb][t] = *(const LAS bf16x8*)(buf + NMAPS * KB + vbase + voffw + vb * (16 * 144) + t * 64);
            __builtin_amdgcn_sched_barrier(0);
            bf16x8 pf[NMAPS][2];
#pragma unroll
            for (int m = 0; m < NMAPS; ++m) {
                if constexpr (NA) { if (local) {
                        const LAS float* bp = biasT + (kr - r_wave + 7) * 31 + (c0w + 8 * g - xq + 15);
#pragma unroll
                        for (int kb = 0; kb < 4; ++kb)
#pragma unroll
                            for (int ii = 0; ii < 4; ++ii) { const float t = (tm >> (kb >> 1)) & 1 ? (S[m][kb][ii] + pen[kb][ii]) + bp[32 * (kb >> 1) + 4 * (kb & 1) + ii] : -1e30f; S[m][kb][ii] = t; } } }
                float mx = fmaxf(fmaxf(S[m][0][0], S[m][0][1]), fmaxf(S[m][0][2], S[m][0][3]));
#pragma unroll
                for (int kb = 1; kb < 4; ++kb) mx = fmaxf(fmaxf(mx, S[m][kb][0]), fmaxf(fmaxf(S[m][kb][1], S[m][kb][2]), S[m][kb][3]));
                mx = swap32_max(swap16_max(mx));
                if (__any(mx > mrun[m] + 8.0f)) {
                    const float mnew = fmaxf(mrun[m], mx), alpha = fexp2(mrun[m] - mnew); mrun[m] = mnew; lrun[m] = lrun[m] * alpha;
#pragma unroll
                    for (int vb = 0; vb < NVB; ++vb) O[m][vb] = O[m][vb] * alpha;
                }
                const float mm = mrun[m];
                unsigned pw[8]; float l0 = 0.f, l1 = 0.f;
#pragma unroll
                for (int kb = 0; kb < 4; ++kb) { const float a0 = fexp2(S[m][kb][0] - mm), a1 = fexp2(S[m][kb][1] - mm), a2 = fexp2(S[m][kb][2] - mm), a3 = fexp2(S[m][kb][3] - mm);
                    l0 += a0 + a1; l1 += a2 + a3;
                    pw[2 * kb] = cvtpk(a0, a1); pw[2 * kb + 1] = cvtpk(a2, a3); }
                lrun[m] += l0 + l1;
                pf[m][0] = __builtin_bit_cast(bf16x8, (u32x4){pw[0], pw[1], pw[2], pw[3]});
                pf[m][1] = __builtin_bit_cast(bf16x8, (u32x4){pw[4], pw[5], pw[6], pw[7]});
            }
            __builtin_amdgcn_sched_barrier(0);
            if constexpr (NVB == 8) {
                bf16x8 vf1[4][2];
#pragma unroll
                for (int vb = 0; vb < 4; ++vb)
#pragma unroll
                    for (int t = 0; t < 2; ++t) vf1[vb][t] = *(const LAS bf16x8*)(buf + NMAPS * KB + vbase + (4 + vb) * (16 * 144) + t * 64);
                __builtin_amdgcn_sched_barrier(0);
#pragma unroll
                for (int vb = 0; vb < 4; ++vb)
#pragma unroll
                    for (int t = 0; t < 2; ++t)
#pragma unroll
                        for (int m = 0; m < NMAPS; ++m) O[m][vb] = __builtin_amdgcn_mfma_f32_16x16x32_bf16(vf0[vb][t], pf[m][t], O[m][vb], 0, 0, 0);
                __builtin_amdgcn_sched_barrier(0);
#pragma unroll
                for (int vb = 0; vb < 4; ++vb)
#pragma unroll
                    for (int t = 0; t < 2; ++t)
#pragma unroll
                        for (int m = 0; m < NMAPS; ++m) O[m][4 + vb] = __builtin_amdgcn_mfma_f32_16x16x32_bf16(vf1[vb][t], pf[m][t], O[m][4 + vb], 0, 0, 0);
            } else {
#pragma unroll
                for (int vb = 0; vb < 4; ++vb)
#pragma unroll
                    for (int t = 0; t < 2; ++t) { if (!NA || (tm >> t) & 1) {
#pragma unroll
                            for (int m = 0; m < NMAPS; ++m) O[m][vb] = __builtin_amdgcn_mfma_f32_16x16x32_bf16(vf0[vb][t], pf[m][t], O[m][vb], 0, 0, 0); } }
            }
            __builtin_amdgcn_sched_barrier(0);
        }
        if (i + 1 < ntiles) AT_STORE((i + 1) & 1);
        __syncthreads();
    }
#undef AT_LOAD
#undef AT_STORE
    float inv[NMAPS];
#pragma unroll
    for (int m = 0; m < NMAPS; ++m) { float l = lrun[m]; l = swap16_add(l, l); l = swap32_add(l, l); inv[m] = 1.0f / l; }
    const int orow = qrow0 + wave * 16 + fr;
    if constexpr (NMAPS == 2) {
        float ss = 0.f; const float i1 = inv[0], i2 = lam * inv[1];
#pragma unroll
        for (int vb = 0; vb < NVB; ++vb) { O[0][vb] = O[0][vb] * i1 - O[1][vb] * i2; const f32x4 o = O[0][vb]; ss += (o.x * o.x + o.y * o.y) + (o.z * o.z + o.w * o.w); }
        ss = swap16_add(ss, ss); ss = swap32_add(ss, ss);
        const float rs = __builtin_amdgcn_rsqf(ss * (1.0f / DV) + EPSF) * outscale;
#pragma unroll
        for (int vb = 0; vb < NVB; ++vb) { const f32x4 gg = *(const f32x4*)(subg + 16 * vb + 4 * g); const f32x4 y = O[0][vb] * rs * gg;
            u32x2 w; w.x = cvtpk(y.x, y.y); w.y = cvtpk(y.z, y.w); *(u32x2*)(AOUT + (size_t)orow * D + ocol + 16 * vb + 4 * g) = w; }
    } else {
#pragma unroll
        for (int vb = 0; vb < NVB; ++vb) { const f32x4 y = O[0][vb] * inv[0];
            u32x2 w; w.x = cvtpk(y.x, y.y); w.y = cvtpk(y.z, y.w); *(u32x2*)(AOUT + (size_t)orow * D + ocol + 16 * vb + 4 * g) = w; }
    }
}


typedef float f32x16 __attribute__((ext_vector_type(16)));
__device__ __forceinline__ void diff_unit32(LAS unsigned char* lds, int tid, int lane, int wave,
                                            const bf16* QKV, int qcol, int qrow0, int kcol, int krow_lat, int krow_ctx, const bf16* VT, int khi,
                                            bf16* AOUT, int ocol, float lam, const float* subg, float outscale) {
    constexpr int KB = 9216, VOFF = 2 * KB, BUFSZ = 2 * KB + 128 * 144;
    const int r = lane & 31, hf = lane >> 5, map = wave >> 2, wq = wave & 3;
    const int swz = ((r >> 4) & 1) << 2;
    bf16x8 qf[4];
    { const bf16* qp = QKV + (size_t)(qrow0 + 32 * wq + r) * NATT + qcol + map * 64 + 8 * hf;
#pragma unroll
      for (int ks = 0; ks < 4; ++ks) qf[ks] = *(const bf16x8*)(qp + 16 * ks); }
    f32x16 O[4];
#pragma unroll
    for (int blk = 0; blk < 4; ++blk)
#pragma unroll
        for (int i = 0; i < 16; ++i) O[blk][i] = 0.f;
    float negm = 0.f, lrun = 0.f;
    const int ntiles = 4 + khi;
    u32x4 kreg[2], vreg[2];
    const int lkey = tid >> 3, lch = tid & 7;
    const int kst = lkey * 144 + ((lch ^ (((lkey >> 4) & 1) << 2)) * 16);
#define D32_LOAD(i) do { const int _i = (i); const int _rowg = (_i < 4 ? krow_ctx + 64 * _i : krow_lat + 64 * (_i - 4)) + lkey; const int _tok0 = (_i < 4 ? SEQ + 64 * _i : 64 * (_i - 4)); \
        _Pragma("unroll") for (int m = 0; m < 2; ++m) kreg[m] = *(const u32x4*)(QKV + (size_t)_rowg * NATT + kcol + m * 64 + lch * 8); \
        _Pragma("unroll") for (int j = 0; j < 2; ++j) { const int idx = tid + 512 * j; vreg[j] = *(const u32x4*)(VT + (size_t)(idx >> 3) * NKEY + _tok0 + (idx & 7) * 8); } } while (0)
#define D32_STORE(b) do { LAS unsigned char* _p = lds + (b) * BUFSZ; \
        _Pragma("unroll") for (int m = 0; m < 2; ++m) *(LAS u32x4*)(_p + m * KB + kst) = kreg[m]; \
        _Pragma("unroll") for (int j = 0; j < 2; ++j) { const int idx = tid + 512 * j, vr = idx >> 3; *(LAS u32x4*)(_p + VOFF + vr * 144 + (((idx & 7) ^ (((vr >> 4) & 1) << 2)) * 16)) = vreg[j]; } } while (0)
    D32_LOAD(0); D32_STORE(0); D32_STORE(2); __syncthreads();
    const int krow = (r & 0x13) | ((r & 4) << 1) | ((r & 8) >> 1);
    const int kbase = map * KB + krow * 144, vbase = VOFF + r * 144;
    bf16x8 pfp[2][2];
#pragma unroll
    for (int kb = 0; kb < 2; ++kb)
#pragma unroll
        for (int sx = 0; sx < 2; ++sx) pfp[kb][sx] = (bf16x8){0, 0, 0, 0, 0, 0, 0, 0};
    int slot = 0;
    for (int i = 0; i < ntiles; ++i) {
        if (i + 1 < ntiles) D32_LOAD(i + 1);
        const int slotn = slot == 2 ? 0 : slot + 1, slotp = slot == 0 ? 2 : slot - 1;
        const LAS unsigned char* buf = lds + slot * BUFSZ; const LAS unsigned char* bufp = lds + slotp * BUFSZ;
        f32x16 S[2];
#pragma unroll
        for (int kb = 0; kb < 2; ++kb) {
#pragma unroll
            for (int ii = 0; ii < 16; ++ii) S[kb][ii] = negm;
#pragma unroll
            for (int ks = 0; ks < 4; ++ks) { const bf16x8 kf = *(const LAS bf16x8*)(buf + kbase + kb * (32 * 144) + (((2 * ks + hf) ^ swz) * 16));
                S[kb] = __builtin_amdgcn_mfma_f32_32x32x16_bf16(kf, qf[ks], S[kb], 0, 0, 0); } }
        __builtin_amdgcn_sched_barrier(0);
        float mx = -1e30f;
#pragma unroll
        for (int kb = 0; kb < 2; ++kb)
#pragma unroll
            for (int ii = 0; ii < 16; ii += 4) mx = fmaxf(fmaxf(mx, S[kb][ii]), fmaxf(fmaxf(S[kb][ii + 1], S[kb][ii + 2]), S[kb][ii + 3]));
        mx = swap32_max(mx);
        const bool resc = (i == 0) || __any(mx > 8.0f);
        float alpha = 1.0f;
        if (resc) { const float dlt = (i == 0) ? mx : fmaxf(mx, 0.f); alpha = fexp2(-dlt); negm -= dlt; lrun *= alpha;
#pragma unroll
            for (int kb = 0; kb < 2; ++kb)
#pragma unroll
                for (int ii = 0; ii < 16; ++ii) S[kb][ii] -= dlt; }
        __builtin_amdgcn_sched_barrier(0);
        bf16x8 pf[2][2]; float l0 = 0.f, l1 = 0.f;
#pragma unroll
        for (int kb = 0; kb < 2; ++kb)
#pragma unroll
            for (int sx = 0; sx < 2; ++sx) { unsigned pw[4];
#pragma unroll
                for (int j = 0; j < 4; ++j) { const float a0 = fexp2(S[kb][8 * sx + 2 * j]), a1 = fexp2(S[kb][8 * sx + 2 * j + 1]); l0 += a0; l1 += a1; pw[j] = cvtpk(a0, a1); }
                pf[kb][sx] = __builtin_bit_cast(bf16x8, (u32x4){pw[0], pw[1], pw[2], pw[3]}); }
        lrun += l0 + l1;
#pragma unroll
        for (int blk = 0; blk < 4; ++blk)
#pragma unroll
            for (int kb = 0; kb < 2; ++kb)
#pragma unroll
                for (int sx = 0; sx < 2; ++sx) { const bf16x8 vf = *(const LAS bf16x8*)(bufp + vbase + blk * (32 * 144) + (((4 * kb + 2 * sx + hf) ^ swz) * 16));
                    O[blk] = __builtin_amdgcn_mfma_f32_32x32x16_bf16(vf, pfp[kb][sx], O[blk], 0, 0, 0); }
#pragma unroll
        for (int k = 0; k < 16; ++k) { __builtin_amdgcn_sched_group_barrier(0x100, 1, 0); __builtin_amdgcn_sched_group_barrier(0x008, 1, 0); __builtin_amdgcn_sched_group_barrier(0x400, 2, 0); __builtin_amdgcn_sched_group_barrier(0x002, 4, 0); }
        __builtin_amdgcn_sched_barrier(0);
        if (resc) {
#pragma unroll
            for (int blk = 0; blk < 4; ++blk) O[blk] = O[blk] * alpha; }
#pragma unroll
        for (int kb = 0; kb < 2; ++kb)
#pragma unroll
            for (int sx = 0; sx < 2; ++sx) pfp[kb][sx] = pf[kb][sx];
        if (i + 1 < ntiles) D32_STORE(slotn);
        slot = slotn;
        __syncthreads();
    }
    { const LAS unsigned char* bufp = lds + (slot == 0 ? 2 : slot - 1) * BUFSZ;
#pragma unroll
      for (int blk = 0; blk < 4; ++blk)
#pragma unroll
          for (int kb = 0; kb < 2; ++kb)
#pragma unroll
              for (int sx = 0; sx < 2; ++sx) { const bf16x8 vf = *(const LAS bf16x8*)(bufp + vbase + blk * (32 * 144) + (((4 * kb + 2 * sx + hf) ^ swz) * 16));
                  O[blk] = __builtin_amdgcn_mfma_f32_32x32x16_bf16(vf, pfp[kb][sx], O[blk], 0, 0, 0); } }
    __syncthreads();
#undef D32_LOAD
#undef D32_STORE
    float l = lrun; l = swap32_add(l, l); const float inv = 1.0f / l;
    LAS float* X = (LAS float*)lds + (size_t)wq * 4096 + lane;
    if (map == 1) {
#pragma unroll
        for (int blk = 0; blk < 4; ++blk)
#pragma unroll
            for (int i = 0; i < 16; ++i) X[(blk * 16 + i) * 64] = O[blk][i] * inv;
    }
    __syncthreads();
    if (map == 0) {
        float ss = 0.f;
#pragma unroll
        for (int blk = 0; blk < 4; ++blk)
#pragma unroll
            for (int i = 0; i < 16; ++i) { const float o = O[blk][i] * inv - lam * X[(blk * 16 + i) * 64]; O[blk][i] = o; ss += o * o; }
        ss = swap32_add(ss, ss);
        const float rs = __builtin_amdgcn_rsqf(ss * (1.0f / 128.0f) + EPSF) * outscale;
        bf16* op = AOUT + (size_t)(qrow0 + 32 * wq + r) * D + ocol + 4 * hf;
#pragma unroll
        for (int blk = 0; blk < 4; ++blk)
#pragma unroll
            for (int g4 = 0; g4 < 4; ++g4) { const int dv0 = 32 * blk + 8 * g4; const f32x4 gg = *(const f32x4*)(subg + dv0 + 4 * hf);
                u32x2 w; w.x = cvtpk(O[blk][4 * g4] * rs * gg.x, O[blk][4 * g4 + 1] * rs * gg.y); w.y = cvtpk(O[blk][4 * g4 + 2] * rs * gg.z, O[blk][4 * g4 + 3] * rs * gg.w);
                *(u32x2*)(op + dv0) = w; }
    }
    __syncthreads();
}

__device__ __forceinline__ void phase_attention(const bf16* QKV, const bf16* VAT, const bf16* VBT, bf16* AOUT, const float* lamp  , float lam_init, const float* subg, const float* nab  ,
                                                unsigned* naq, const ConvPtrs& CP, int clo, int chi, LAS unsigned char* lds, int tid, int lane, int wave) {
    LAS float* biasT = (LAS float*)(lds + LX_BIAS) + 64;
    constexpr int NATT_U = 576 + 1152;
    const int ncu = (chi - clo + CV_UNIT - 1) / CV_UNIT, nq = NATT_U + ncu;
    int mine = 0; if (tid == 0) mine = (int)__hip_atomic_fetch_add(naq, 1u, RLX_AGENT);
    for (;;) {
        __syncthreads();
        if (tid == 0) *(LAS int*)(lds + LX_MISC + 64) = mine;
        __syncthreads();
        const int q = *(LAS int*)(lds + LX_MISC + 64);
        if (q >= nq) break;
        if (tid == 0) mine = (int)__hip_atomic_fetch_add(naq, 1u, RLX_AGENT);
        const int ai = (int)(((long)q * NATT_U) / nq); const bool isatt = (int)(((long)(q + 1) * NATT_U) / nq) > ai;
        if (!isatt) { conv_unit(CP, clo + (q - ai) * CV_UNIT, chi, lds, lane, wave); continue; }
        if (ai < 512 || (ai >= 1536 && ai < 1600)) {
            int bh, qrow0, khi;
            if (ai < 512) { bh = ai >> 4; const int qt = ai & 15; qrow0 = (bh >> 2) * SEQ + qt * 128; khi = 32; }
            else { const int u = ai - 1536; bh = u >> 1; const int qt = u & 1; qrow0 = TX + (bh >> 2) * CTXL + qt * 128; khi = 0; }
            const int b = bh >> 2, h = bh & 3;
            const float lam = __expf(wave_sum(lamp[lane] * lamp[64 + lane])) - __expf(wave_sum(lamp[128 + lane] * lamp[192 + lane])) + lam_init;
            diff_unit32(lds, tid, lane, wave, QKV, h * 128, qrow0, 512 + h * 128, b * SEQ, TX + b * CTXL, VAT + (size_t)bh * 128 * NKEY, khi,
                        AOUT, h * 128, lam, subg, 1.0f - lam_init);
        } else {
            int bh, qrow0, klo, khi, rw;
            if (ai < 1536) { const int u = ai - 512; bh = u >> 4; const int rp = u & 15; qrow0 = (bh >> 3) * SEQ + rp * 128; klo = na_r0(2 * rp); khi = na_r0(2 * rp + 1) + 8; rw = 2 * rp + (wave >> 2); }
            else { const int u = ai - 1600; bh = u >> 1; const int qt = u & 1; qrow0 = TX + (bh >> 3) * CTXL + qt * 128; klo = 0; khi = 0; rw = 0; }
            const int b = bh >> 3, h = bh & 7;
            for (int i = tid; i < 640; i += 512) { const int k = i - 64; biasT[k] = (k >= 0 && k < 465) ? nab[h * 465 + k] * LOG2E : 0.f; }
            attn_unit<1, 64, true>(lds, tid, lane, wave, QKV, 1536 + h * 64, qrow0, 2048 + h * 64, b * SEQ, TX + b * CTXL, VBT + (size_t)bh * 64 * NKEY, klo, khi,
                                   rw, 16 * (wave & 3), biasT, AOUT, 512 + h * 64, 0.f, nullptr, 1.0f);
        }
    }
}

__device__ __forceinline__ void gla_chunk_rows(int b, int dir, int n, int& row0, int& tok0) {
    if (n < 4) { const int cc = dir ? 3 - n : n; row0 = TX + b * CTXL + 64 * cc; tok0 = SEQ + 64 * cc; } else { const int lc = dir ? 35 - n : n - 4; row0 = b * SEQ + 64 * lc; tok0 = 64 * lc; }
}
constexpr int GP_QM = 0, GP_KM = 17408, GP_VT = 34816, GP_LR = 71680, GP_SEG = 75776;
__device__ __forceinline__ void phase_gla_prep(const bf16* QKV2, const bf16* VGT, const float* wgate  , const float* bgate  ,
                                               bf16* QG, bf16* KET, float* FACD, bf16* OF, bf16* OB,
                                               LAS unsigned char* lds, int tid, int lane, int wave, int vcu, int G) {
    const int fr = lane & 15, g = lane >> 4;
    const int d = tid & 127, seg = tid >> 7;
    LAS float* LR = (LAS float*)(lds + GP_LR);
    LAS float* SEG = (LAS float*)(lds + GP_SEG);
    for (int ub = vcu * 9; ub < 2304; ub += G * 9) {
        const int q = ub / 36, n0 = ub % 36, dir = q & 1, hh = (q >> 1) & 3, b = q >> 3;
        bf16* OUT = dir ? OB : OF;
        float wg[16];
#pragma unroll
        for (int r = 0; r < 16; ++r) wg[r] = wgate[(dir * 16 + r) * 512 + hh * 128 + d];
        const float bgv = bgate[dir * 512 + hh * 128 + d];
        const bf16* vtb = VGT + (size_t)(b * 4 + hh) * 256 * NKEY;
        u32x4 qr[2], kr[2], vr[4], lr4;
#define GP_LOAD(n) do { int _row0, _tok0; gla_chunk_rows(b, dir, (n), _row0, _tok0); \
        _Pragma("unroll") for (int j = 0; j < 2; ++j) { const int idx = tid + 512 * j, p = idx >> 4, ch = idx & 15; const bf16* src = QKV2 + (size_t)(_row0 + p) * NGLA + hh * 128 + ch * 8; qr[j] = *(const u32x4*)src; kr[j] = *(const u32x4*)(src + 512); } \
        _Pragma("unroll") for (int j = 0; j < 4; ++j) { const int idx = tid + 512 * j; vr[j] = *(const u32x4*)(vtb + (size_t)(idx >> 3) * NKEY + _tok0 + (idx & 7) * 8); } \
        lr4 = *(const u32x4*)(QKV2 + (size_t)(_row0 + ((tid & 127) >> 1)) * NGLA + 3072 + dir * 16 + (tid & 1) * 8); } while (0)
#define GP_N(i) (dir ? ((i) < 4 ? 3 - (i) : 39 - (i)) : (i))
        GP_LOAD(GP_N(n0));
#define GP_STAGE() do { \
_Pragma("unroll") \
            for (int j = 0; j < 2; ++j) { const int idx = tid + 512 * j, p = idx >> 4, ch = idx & 15; \
                *(LAS u32x4*)(lds + GP_QM + p * 272 + ch * 16) = qr[j]; *(LAS u32x4*)(lds + GP_KM + p * 272 + ch * 16) = kr[j]; } \
_Pragma("unroll") \
            for (int j = 0; j < 4; ++j) { const int idx = tid + 512 * j; *(LAS u32x4*)(lds + GP_VT + (idx >> 3) * 144 + (idx & 7) * 16) = vr[j]; } \
            if (tid < 128) { LAS float* lp = LR + (tid >> 1) * 16 + (tid & 1) * 8; \
                lp[0] = bflo(lr4.x); lp[1] = bfhi(lr4.x); lp[2] = bflo(lr4.y); lp[3] = bfhi(lr4.y); lp[4] = bflo(lr4.z); lp[5] = bfhi(lr4.z); lp[6] = bflo(lr4.w); lp[7] = bfhi(lr4.w); } \
            } while (0)
        GP_STAGE();
        __syncthreads();
        for (int k9 = 0; k9 < 9; ++k9) {
            const int n = GP_N(n0 + k9), u = ub - n0 + n; int row0, tok0; gla_chunk_rows(b, dir, n, row0, tok0);
            GP_LOAD(GP_N(n0 + (k9 + 1 < 9 ? k9 + 1 : 8)));
            float gc[16];
#pragma unroll
            for (int pi = 0; pi < 16; ++pi) { const LAS f32x4* lp = (const LAS f32x4*)(LR + (16 * seg + pi) * 16); f32x2 z2 = (f32x2){bgv, 0.f};
#pragma unroll
                for (int k = 0; k < 4; ++k) { const f32x4 l4 = lp[k];
                    z2 = __builtin_elementwise_fma(__builtin_shufflevector(l4, l4, 0, 1), (f32x2){wg[4 * k], wg[4 * k + 1]}, z2);
                    z2 = __builtin_elementwise_fma(__builtin_shufflevector(l4, l4, 2, 3), (f32x2){wg[4 * k + 2], wg[4 * k + 3]}, z2); }
                const float z = z2.x + z2.y;
                const float az = fabsf(z); gc[pi] = (fminf(z, 0.f) - flog(1.0f + fexp(-az))) * 0.0625f; }
            float run = 0.f;
            if (dir == 0) {
#pragma unroll
                for (int pi = 0; pi < 16; ++pi) { run += gc[pi]; gc[pi] = run; }
            } else {
#pragma unroll
                for (int pi = 15; pi >= 0; --pi) { run += gc[pi]; gc[pi] = run; }
            }
            SEG[seg * 128 + d] = run;
            __syncthreads();
            const float t0 = SEG[d], t1 = SEG[128 + d], t2 = SEG[256 + d], t3 = SEG[384 + d];
            float off, gmid; const float gend = (t0 + t1) + (t2 + t3);
            if (dir == 0) { off = (seg > 0 ? t0 : 0.f) + (seg > 1 ? t1 : 0.f) + (seg > 2 ? t2 : 0.f); gmid = t0 + t1; }
            else { off = (seg < 3 ? t3 : 0.f) + (seg < 2 ? t2 : 0.f) + (seg < 1 ? t1 : 0.f); gmid = t3 + t2; }
            const float emid = fexp(gmid), eend = fexp(gend - gmid);
            unsigned kep[8];
            bf16* qgp = QG + ((size_t)u * 64 + 16 * seg) * 128 + d;
#pragma unroll
            for (int pi = 0; pi < 16; ++pi) { const int p = 16 * seg + pi; const float rel = off + gc[pi] - gmid; const float Ep = fexp(rel), Ei = fexp(-rel);
                LAS bf16* qa = (LAS bf16*)(lds + GP_QM) + p * 136 + d; LAS bf16* ka = (LAS bf16*)(lds + GP_KM) + p * 136 + d;
                const float qv = bf2f(*qa), kv = bf2f(*ka);
                const float qm = qv * Ep, km = kv * Ei;
                const unsigned w1 = cvtpk(qm, qm * emid), w2 = cvtpk(km, km * eend);
                *qa = (bf16)(w1 & 0xffffu); qgp[pi * 128] = (bf16)(w1 >> 16); *ka = (bf16)(w2 & 0xffffu);
                if (pi & 1) kep[pi >> 1] |= (w2 & 0xffff0000u); else kep[pi >> 1] = w2 >> 16; }
            { u32x4* kt = (u32x4*)(KET + ((size_t)u * 128 + d) * 64 + 16 * seg); kt[0] = (u32x4){kep[0], kep[1], kep[2], kep[3]}; kt[1] = (u32x4){kep[4], kep[5], kep[6], kep[7]}; }
            if (seg == 0) FACD[(size_t)u * 128 + d] = fexp(gend);
            __syncthreads();
            { const int cb = wave & 3, half = wave >> 2;
              bf16x8 qfr[4];
#pragma unroll
              for (int ks = 0; ks < 4; ++ks) qfr[ks] = *(const LAS bf16x8*)(lds + GP_QM + (16 * cb + fr) * 272 + (8 * g + 32 * ks) * 2);
              f32x4 AT[4];
#pragma unroll
              for (int sb = 0; sb < 4; ++sb) { AT[sb] = (f32x4){0.f, 0.f, 0.f, 0.f};
#pragma unroll
                  for (int ks = 0; ks < 4; ++ks) { const bf16x8 af = *(const LAS bf16x8*)(lds + GP_KM + (16 * sb + fr) * 272 + (8 * g + 32 * ks) * 2);
                      AT[sb] = __builtin_amdgcn_mfma_f32_16x16x32_bf16(af, qfr[ks], AT[sb], 0, 0, 0); }
                  const int c = 16 * cb + fr;
#pragma unroll
                  for (int ii = 0; ii < 4; ++ii) { const int sp = 16 * sb + 4 * g + ii; const bool keep = dir ? (sp >= c) : (sp <= c); AT[sb][ii] = keep ? AT[sb][ii] : 0.f; } }
              bf16x8 pf[2];
#pragma unroll
              for (int t = 0; t < 2; ++t) { u32x4 w; w.x = pk2(AT[2 * t][0], AT[2 * t][1]); w.y = pk2(AT[2 * t][2], AT[2 * t][3]); w.z = pk2(AT[2 * t + 1][0], AT[2 * t + 1][1]); w.w = pk2(AT[2 * t + 1][2], AT[2 * t + 1][3]);
                  pf[t] = __builtin_bit_cast(bf16x8, w); }
#pragma unroll
              for (int v8 = 0; v8 < 8; ++v8) { const int vb = 8 * half + v8; f32x4 Oa = (f32x4){0.f, 0.f, 0.f, 0.f};
#pragma unroll
                  for (int t = 0; t < 2; ++t) { const LAS unsigned char* vp = lds + GP_VT + (16 * vb + fr) * 144 + (32 * t + 4 * g) * 2;
                      const u32x2 lo = *(const LAS u32x2*)vp, hi = *(const LAS u32x2*)(vp + 32);
                      u32x4 w; w.x = lo.x; w.y = lo.y; w.z = hi.x; w.w = hi.y;
                      Oa = __builtin_amdgcn_mfma_f32_16x16x32_bf16(__builtin_bit_cast(bf16x8, w), pf[t], Oa, 0, 0, 0); }
                  u32x2 w; w.x = pk2(Oa[0], Oa[1]); w.y = pk2(Oa[2], Oa[3]);
                  *(u32x2*)(OUT + (size_t)(row0 + 16 * cb + fr) * D + hh * 256 + 16 * vb + 4 * g) = w; }
            }
            __syncthreads();
            GP_STAGE();
            __syncthreads();
        }
#undef GP_STAGE
#undef GP_LOAD
#undef GP_N
    }
}

constexpr int GS_BUF = 45056, GS_QG = 0, GS_KET = 17408, GS_VT = 35840, GS_ST = 2 * GS_BUF, GS_DEC = GS_ST + 2 * 17408;
__device__ __forceinline__ void phase_gla(const bf16* VGT, bf16* OF, bf16* OB, const bf16* QG, const bf16* KET, const float* FACD,
                                          LAS unsigned char* lds, int tid, int lane, int wave, int vcu, int G) {
    const int fr = lane & 15, g = lane >> 4;
    for (int u = vcu; u < 256; u += G) {
        const int slab = u & 3, dir = (u >> 2) & 1, hh = (u >> 3) & 3, b = u >> 5;
        bf16* OUT = dir ? OB : OF;
        const int upb = ((b * 4 + hh) * 2 + dir) * 36;
        f32x4 Sacc[4];
#pragma unroll
        for (int vb = 0; vb < 4; ++vb) Sacc[vb] = (f32x4){0.f, 0.f, 0.f, 0.f};
        for (int i = tid; i < 17408 / 4; i += 512) ((LAS unsigned*)(lds + GS_ST))[i] = 0u;
        const bf16* vtb = VGT + ((size_t)(b * 4 + hh) * 256 + slab * 64) * NKEY;
        const int cb = wave & 3, vh = wave >> 2;
        const int ocol = hh * 256 + slab * 64 + 32 * vh + 4 * g;
        struct GsRegs { u32x4 qg[2], ket[2], v; u32x2 oi[2]; float dec; };
        GsRegs R0, R1; R0.dec = 0.f; R1.dec = 0.f;
#define GS_LOAD(R, n) do { int _row0, _tok0; gla_chunk_rows(b, dir, (n), _row0, _tok0); const size_t _u = (size_t)(upb + (n)); \
        _Pragma("unroll") for (int j = 0; j < 2; ++j) { const int idx = tid + 512 * j; R.qg[j] = *(const u32x4*)(QG + _u * 8192 + idx * 8); R.ket[j] = *(const u32x4*)(KET + _u * 8192 + idx * 8); } \
        R.v = *(const u32x4*)(vtb + (size_t)(tid >> 3) * NKEY + _tok0 + (tid & 7) * 8); \
        if (tid < 128) R.dec = FACD[_u * 128 + tid]; \
        _Pragma("unroll") for (int v2 = 0; v2 < 2; ++v2) R.oi[v2] = *(const u32x2*)(OUT + (size_t)(_row0 + 16 * cb + fr) * D + ocol + 16 * v2); } while (0)
#define GS_STORE(R, bf) do { LAS unsigned char* _p = lds + (bf) * GS_BUF; \
        _Pragma("unroll") for (int j = 0; j < 2; ++j) { const int idx = tid + 512 * j; *(LAS u32x4*)(_p + GS_QG + (idx >> 4) * 272 + (idx & 15) * 16) = R.qg[j]; *(LAS u32x4*)(_p + GS_KET + (idx >> 3) * 144 + (idx & 7) * 16) = R.ket[j]; } \
        *(LAS u32x4*)(_p + GS_VT + (tid >> 3) * 144 + (tid & 7) * 16) = R.v; \
        if (tid < 128) ((LAS float*)(lds + GS_DEC))[(bf) * 128 + tid] = R.dec; } while (0)
#define GS_ITER(n, RN, RF) do { const int _n = (n); int row0, tok0; gla_chunk_rows(b, dir, _n, row0, tok0); const int cur = _n & 1; \
            if (_n + 2 < 36) GS_LOAD(RF, _n + 2); \
            const LAS unsigned char* bufp = lds + cur * GS_BUF; const LAS unsigned char* stp = lds + GS_ST + cur * 17408; \
            { bf16x8 qfr[4]; \
              _Pragma("unroll") for (int ks = 0; ks < 4; ++ks) qfr[ks] = *(const LAS bf16x8*)(bufp + GS_QG + (16 * cb + fr) * 272 + (8 * g + 32 * ks) * 2); \
              _Pragma("unroll") for (int v2 = 0; v2 < 2; ++v2) { const int vb = 2 * vh + v2; const u32x2 oin = v2 ? oc1 : oc0; \
                  f32x4 Oa = (f32x4){bflo(oin.x), bfhi(oin.x), bflo(oin.y), bfhi(oin.y)}; \
                  _Pragma("unroll") for (int ks = 0; ks < 4; ++ks) { const bf16x8 af = *(const LAS bf16x8*)(stp + (16 * vb + fr) * 272 + (8 * g + 32 * ks) * 2); \
                      Oa = __builtin_amdgcn_mfma_f32_16x16x32_bf16(af, qfr[ks], Oa, 0, 0, 0); } \
                  u32x2 w; w.x = pk2(Oa[0], Oa[1]); w.y = pk2(Oa[2], Oa[3]); \
                  *(u32x2*)(OUT + (size_t)(row0 + 16 * cb + fr) * D + ocol + 16 * v2) = w; } } \
            { const f32x4 dec = *(const LAS f32x4*)((LAS float*)(lds + GS_DEC) + cur * 128 + 16 * wave + 4 * g); \
              LAS unsigned char* stn = lds + GS_ST + (cur ^ 1) * 17408; \
              _Pragma("unroll") for (int vb = 0; vb < 4; ++vb) { Sacc[vb] = Sacc[vb] * dec; \
                  _Pragma("unroll") for (int t = 0; t < 2; ++t) { const bf16x8 af = *(const LAS bf16x8*)(bufp + GS_KET + (16 * wave + fr) * 144 + (8 * g + 32 * t) * 2); \
                      const bf16x8 bfr = *(const LAS bf16x8*)(bufp + GS_VT + (16 * vb + fr) * 144 + (8 * g + 32 * t) * 2); \
                      Sacc[vb] = __builtin_amdgcn_mfma_f32_16x16x32_bf16(af, bfr, Sacc[vb], 0, 0, 0); } \
                  u32x2 w; w.x = pk2(Sacc[vb][0], Sacc[vb][1]); w.y = pk2(Sacc[vb][2], Sacc[vb][3]); \
                  *(LAS u32x2*)(stn + (16 * vb + fr) * 272 + (16 * wave + 4 * g) * 2) = w; } } \
            if (_n + 1 < 36) { GS_STORE(RN, cur ^ 1); oc0 = RN.oi[0]; oc1 = RN.oi[1]; } \
            __syncthreads(); } while (0)
        GS_LOAD(R0, 0); GS_STORE(R0, 0);
        u32x2 oc0 = R0.oi[0], oc1 = R0.oi[1];
        GS_LOAD(R0, 1);
        __syncthreads();
        for (int n = 0; n < 36; n += 2) { GS_ITER(n, R0, R1); GS_ITER(n + 1, R1, R0); }
#undef GS_ITER
#undef GS_LOAD
#undef GS_STORE
    }
}

constexpr int N_PHASES = 34;
typedef const Args __attribute__((address_space(4)))* KArgs;
__device__ __forceinline__ KArgs kargs() { KArgs p = (KArgs)__builtin_amdgcn_kernarg_segment_ptr(); asm volatile("" : "+s"(p)); return p; }
__global__ void __launch_bounds__(512, 2) fwd(Args a_unused) {
    extern __shared__ __attribute__((aligned(16))) unsigned char lds_raw[];
    LAS unsigned char* lds = (LAS unsigned char*)lds_raw;
    const int tid0 = threadIdx.x;
    constexpr int G0 = 256; const int bx0 = blockIdx.x;
#define PH_ENTRY int tid = tid0; asm volatile("" : "+v"(tid)); constexpr int G = G0; int bx = bx0; asm volatile("" : "+s"(bx)); const int lane = tid & 63, wave = __builtin_amdgcn_readfirstlane(tid >> 6); \
        const int vcu = (G % 8 == 0) ? (bx % 8) * (G / 8) + bx / 8 : bx; (void)lane; (void)wave; (void)vcu
    const int tid = tid0;
    constexpr int ph_lo = 0, ph_hi = N_PHASES;
    constexpr int repmask = MK_REPMASK;
    if (tid < 64) ((LAS unsigned*)(lds + LX_MISC))[tid] = 0u;
    for (int i = tid; i < 1024; i += 512) { const int pos = i >> 4, f = i & 15; const float inv = __builtin_amdgcn_exp2f(-(float)f * (13.287712379549449f / 16.0f)); const float ang = (float)pos * inv;
        ((LAS float*)(lds + LX_ROPE))[2 * i] = __cosf(ang); ((LAS float*)(lds + LX_ROPE))[2 * i + 1] = __sinf(ang); }
    __syncthreads();
    const bool single = (ph_hi - ph_lo) > 1;
    XcdBarrier bar; bar.bar = (unsigned*)(kargs()->ws + WS_CTL) + CW_BAR; bar.x = 0; bar.st = (volatile LAS unsigned*)(lds + LX_MISC);
    if (single) { bar = xcd_barrier_post((unsigned*)(kargs()->ws + WS_CTL) + CW_BAR, (volatile LAS unsigned*)(lds + LX_MISC)); xcd_barrier_setup(bar); }
#define IN(k) (ph_lo <= (k) && (k) < ph_hi)
#define REPLOOP(t) for (int rep_ = 0, nrep_ = 1 + ((repmask >> (t)) & 1); rep_ < nrep_; ++rep_, (rep_ < nrep_ ? (bar.bar = (unsigned*)(kargs()->ws + WS_CTL) + CW_BAR, xcd_barrier(bar)) : (void)0))
#define SEAM(k) do { if (IN(k) && IN((k) + 1)) { bar.bar = (unsigned*)(kargs()->ws + WS_CTL) + CW_BAR; xcd_barrier(bar); if ((repmask >> 10) & 1) xcd_barrier(bar); } } while (0)
    LAS int* tab = (LAS int*)(lds + LX_MOETAB);
#define CONV_PTRS(A) ConvPtrs{(A)->att_w_in, (A)->att_w_out, (A)->gla_w_in, (A)->gla_w_out, (A)->moe_w1, (A)->moe_w3, (A)->moe_w2, (A)->ws}

    if (IN(0)) REPLOOP(0) { PH_ENTRY; p0_prologue(kargs(), lds, tid, lane, wave, vcu, G); } SEAM(0);
    if (IN(1)) { PH_ENTRY; KArgs A = kargs(); unsigned char* ws = A->ws; phase_norm1(A->x, A->ctx, A->norm_g, (float*)(ws + WS_MODV), (bf16*)(ws + WS_H), TALL, lane, wave, vcu, G); } SEAM(1);

#pragma nounroll
    for (int L = 0; L < 4; ++L) {
        const int pb = 2 + 8 * L; const bool isattn = !(L & 1); const int j = L >> 1; const bool lastL = (L == 3);
        const int nrows = lastL ? TX : TALL;
        if (IN(pb)) REPLOOP(isattn ? 1 : 3) {
            PH_ENTRY; KArgs A = kargs(); unsigned char* ws = A->ws; unsigned char* big = ws + WS_BIG; const bf16* H = (const bf16*)(ws + WS_H);
            if (isattn) {
                pg8::DenseOrder S; S.init(H, (const bf16*)(ws + WS_WATTIN) + (size_t)j * NATT * D, TALL, NATT, D, G, bx);
                pg8::EpiAttnIn E{(bf16*)(big + BG_QKV), (bf16*)(big + BG_VAT), (bf16*)(big + BG_VBT), (const LAS float*)(lds + LX_ROPE)};
                pg8::gemm_phase<pg8::EpiAttnIn, pg8::DenseOrder, false>(lds, tid, D, S, E);
            } else {
                pg8::DenseOrder S; S.init(H, (const bf16*)(ws + WS_WGLAIN) + (size_t)j * NGLA * D, TALL, NGLA, D, G, bx);
                pg8::EpiGlaIn E{(bf16*)(big + BG_QKV2), (bf16*)(big + BG_VGT)};
                pg8::gemm_phase<pg8::EpiGlaIn, pg8::DenseOrder, false>(lds, tid, D, S, E);
            }
        }
        SEAM(pb);
        if (!isattn && IN(pb + 1)) {
            for (int rep_ = 0; rep_ <= ((repmask >> 13) & 1); ++rep_)
            { PH_ENTRY; KArgs A = kargs(); unsigned char* ws = A->ws;
              phase_gla_prep((const bf16*)(ws + WS_BIG + BG_QKV2), (const bf16*)(ws + WS_BIG + BG_VGT), A->gla_w_gate + j * 2 * 16 * 512, A->gla_b_gate + j * 2 * 512,
                             (bf16*)(ws + WS_QG), (bf16*)(ws + WS_KET), (float*)(ws + WS_BIG + BG_FAC), (bf16*)(ws + WS_BIG + BG_OF), (bf16*)(ws + WS_BIG + BG_OB), lds, tid, lane, wave, vcu, G); }
            if (single) { bar.bar = (unsigned*)(kargs()->ws + WS_CTL) + CW_BAR; xcd_barrier(bar); }
        }
        if (IN(pb + 1)) REPLOOP(isattn ? 2 : 4) {
            PH_ENTRY; KArgs A = kargs(); unsigned char* ws = A->ws; unsigned char* big = ws + WS_BIG; bf16* AOUT = (bf16*)(ws + WS_AOUT);
            if (isattn) { const ConvPtrs CP = CONV_PTRS(A);
                phase_attention((const bf16*)(big + BG_QKV), (const bf16*)(big + BG_VAT), (const bf16*)(big + BG_VBT), AOUT, A->att_lambda + j * 256, (L == 0) ? 0.2f : 0.470713018f,
                                A->att_subln_g + j * 128, A->na_bias + j * 8 * 465, (unsigned*)(ws + WS_CTL) + CW_NAQ + 64 * j, CP,
                                MK_CONVQ ? (L == 0 ? CT_ATTN0 : CT_MOE1) : 0, MK_CONVQ ? (L == 0 ? CT_MOE1 : CT_MOE3) : 0, lds, tid, lane, wave); }
            else phase_gla((const bf16*)(big + BG_VGT), (bf16*)(big + BG_OF), (bf16*)(big + BG_OB), (const bf16*)(ws + WS_QG), (const bf16*)(ws + WS_KET), (const float*)(big + BG_FAC),
                           lds, tid, lane, wave, vcu, G);
        }
        SEAM(pb + 1);
        if (!isattn) {
            if (IN(pb + 2)) REPLOOP(5) { PH_ENTRY; KArgs A = kargs(); unsigned char* ws = A->ws; unsigned char* big = ws + WS_BIG;
                phase_readout((const bf16*)(big + BG_OF), (const bf16*)(big + BG_OB), (const bf16*)(big + BG_QKV2), A->gla_norm_g + j * 256, (bf16*)(ws + WS_AOUT), nrows, lane, wave, vcu, G); }
            SEAM(pb + 2);
        }
        if (IN(pb + 3)) {
            PH_ENTRY; KArgs A = kargs(); unsigned char* ws = A->ws;
            pg8::DenseOrder S; S.init((const bf16*)(ws + WS_AOUT), (const bf16*)(ws + (isattn ? WS_WATTOUT : WS_WGLAOUT)) + (size_t)j * D * D, nrows, D, D, G, bx);
            if (L == 0) { pg8::EpiResid<true> E{A->x, A->ctx, (bf16*)(ws + WS_XB), (const float*)(ws + WS_MODV) + (size_t)L * 9 * 6144 + 2048};
                pg8::gemm_phase<pg8::EpiResid<true>, pg8::DenseOrder, false>(lds, tid, D, S, E); }
            else { pg8::EpiResid<false> E{nullptr, nullptr, (bf16*)(ws + WS_XB), (const float*)(ws + WS_MODV) + (size_t)L * 9 * 6144 + 2048};
                pg8::gemm_phase<pg8::EpiResid<false>, pg8::DenseOrder, false>(lds, tid, D, S, E); }
        }
        SEAM(pb + 3);
        if (IN(pb + 4)) { PH_ENTRY; KArgs A = kargs(); unsigned char* ws = A->ws;
            phase_router((const bf16*)(ws + WS_XB), A->norm_g + (L * 2 + 1) * D, (const float*)(ws + WS_MODV) + (size_t)L * 9 * 6144, (bf16*)(ws + WS_H), A->router_w, A->router_bias,
                         (unsigned*)(ws + WS_CTL) + CW_CNT + L * 16 * 64, (int*)(ws + WS_LIST), (int*)(ws + WS_TOKI), (float*)(ws + WS_TOKW), nrows, lds, tid, lane, wave, vcu, G, (repmask >> 11) & 1); }
        SEAM(pb + 4);
        if (IN(pb + 5)) REPLOOP(6) {
            PH_ENTRY; KArgs A = kargs(); unsigned char* ws = A->ws;
            const int RT = build_moe_table((unsigned*)(ws + WS_CTL) + CW_CNT + L * 16 * 64, tab, tid);
            pg8::MoeOrder S; S.A = (const char*)(ws + WS_H); S.B = (const char*)(ws + WS_W13) + (size_t)L * 16 * D * D * 2; S.K = D; S.bstride = (size_t)D * D * 2; S.tab = tab; S.list = (const int*)(ws + WS_LIST); S.RT = RT; S.nwg = RT * 4; S.G = G; S.c = bx;
            S.fill_tokc((LAS int*)(lds + LX_BIAS), tid);
            pg8::EpiMoe1 E{(bf16*)(ws + WS_BIG + BG_HB)};
            pg8::gemm_phase<pg8::EpiMoe1, pg8::MoeOrder, true>(lds, tid, D, S, E);
        }
        SEAM(pb + 5);
        if (IN(pb + 6)) REPLOOP(7) {
            PH_ENTRY; KArgs A = kargs(); unsigned char* ws = A->ws;
            const int RT = single ? tab[RT_MAX] : build_moe_table((unsigned*)(ws + WS_CTL) + CW_CNT + L * 16 * 64, tab, tid);
            pg8::MoeOrder S; S.A = (const char*)(ws + WS_BIG + BG_HB); S.B = (const char*)(ws + WS_W2) + (size_t)L * 16 * D * DEXP * 2; S.K = DEXP; S.bstride = (size_t)D * DEXP * 2; S.tab = tab; S.list = (const int*)(ws + WS_LIST); S.RT = RT; S.nwg = RT * 4; S.G = G; S.c = bx;
            pg8::EpiBf16 E{(bf16*)(ws + WS_BIG + BG_YB), D};
            pg8::gemm_phase<pg8::EpiBf16, pg8::MoeOrder, false>(lds, tid, DEXP, S, E);
        }
        SEAM(pb + 6);
        if (IN(pb + 7)) { PH_ENTRY; KArgs A = kargs(); unsigned char* ws = A->ws; const float* MODV = (const float*)(ws + WS_MODV);
            if (lastL) phase_combine<true>((bf16*)(ws + WS_XB), A->out, MODV + (size_t)L * 9 * 6144, (const bf16*)(ws + WS_BIG + BG_YB), (unsigned*)(ws + WS_CTL) + CW_CNT + L * 16 * 64, (const int*)(ws + WS_TOKI), (const float*)(ws + WS_TOKW),
                                           A->final_g, MODV + (size_t)L * 9 * 6144, (bf16*)(ws + WS_H), nrows, lane, wave, vcu, G);
            else phase_combine<false>((bf16*)(ws + WS_XB), A->out, MODV + (size_t)L * 9 * 6144, (const bf16*)(ws + WS_BIG + BG_YB), (unsigned*)(ws + WS_CTL) + CW_CNT + L * 16 * 64, (const int*)(ws + WS_TOKI), (const float*)(ws + WS_TOKW),
                                      A->norm_g + ((L + 1) * 2) * D, MODV + (size_t)(L + 1) * 9 * 6144, (bf16*)(ws + WS_H), nrows, lane, wave, vcu, G); }
        if (!lastL) SEAM(pb + 7);
    }
#undef IN
#undef REPLOOP
#undef SEAM
#undef CONV_PTRS

#undef PH_ENTRY
}

extern "C" void kernel_launch(void* const* d_in, const int* in_sizes, int n_in, void* d_out, int out_size, void* d_ws, size_t ws_size, hipStream_t stream) {
    static int ready = 0;
    if (ready == 0) {
        if (n_in != 23 || out_size != TX * D || ws_size < WS_END) { fprintf(stderr, "kernel_launch: unexpected shapes (n_in %d out %d ws %zu)\n", n_in, out_size, ws_size); ready = -1; return; }
        if (hipFuncSetAttribute((const void*)fwd, hipFuncAttributeMaxDynamicSharedMemorySize, LDS_BYTES) != hipSuccess) { fprintf(stderr, "kernel_launch: hipFuncSetAttribute failed\n"); ready = -1; return; }
        int per_cu = 0; (void)hipOccupancyMaxActiveBlocksPerMultiprocessor(&per_cu, (const void*)fwd, 512, LDS_BYTES); (void)hipGetLastError();
        if (per_cu < 1) fprintf(stderr, "kernel_launch: occupancy query reports %d blocks per CU\n", per_cu);
        ready = 1;
    }
    if (ready < 0) return;
    (void)hipMemsetAsync((char*)d_ws + WS_CTL, 0, CTL_ZERO_BYTES, stream);
    Args a{};
    const float** ap = (const float**)&a;
    for (int i = 0; i < 23; ++i) ap[i] = (const float*)d_in[i];
    a.out = (float*)d_out; a.ws = (unsigned char*)d_ws;
    const int grid = 256;
    a.ph_lo = 0; a.ph_hi = N_PHASES; a.rep = MK_REPMASK;
    hipLaunchKernelGGL(fwd, dim3(grid), dim3(512), LDS_BYTES, stream, a);
}
```
